# Optimizing an MI355X kernel written in HIP

```python
import jax, jax.numpy as jnp
from jax import lax
import numpy as np


D_MODEL = 1024
BATCH = 8
SEQ = 8192
DEPTH = 1

D_MIX = D_MODEL
ATT_HEADS = 8
ATT_KV_HEADS = 2
ATT_HEAD_DIM = 64
ATT_GROUP = ATT_HEADS // ATT_KV_HEADS
WINDOW = 128
ATT_BLOCK = WINDOW
ROPE_THETA = 10000.0
MLSTM_HEADS = 4
MLSTM_V_DIM = D_MIX // 2 // MLSTM_HEADS
MLSTM_QK_DIM = MLSTM_V_DIM // 2
MLSTM_CHUNK = 64
CONV_WIDTH = 4
F_BIAS_LO = 3.0
F_BIAS_HI = 6.0
PEER_HEADS = 8
PEER_KEYS = 128
PEER_EXPERTS = PEER_KEYS * PEER_KEYS
PEER_QUERY_DIM = 256
PEER_HALF = PEER_QUERY_DIM // 2
PEER_TOPK = 16
PEER_BLOCK = 64
N_MOD = 6
NORM_EPS = 1e-6

ATT_WIDTH = ATT_HEADS * ATT_HEAD_DIM
ATT_KV_WIDTH = ATT_KV_HEADS * ATT_HEAD_DIM
MLSTM_QK_WIDTH = MLSTM_HEADS * MLSTM_QK_DIM
MLSTM_WIDTH = MLSTM_HEADS * MLSTM_V_DIM
IN_SIZES = (ATT_WIDTH, ATT_KV_WIDTH, ATT_KV_WIDTH, MLSTM_QK_WIDTH, MLSTM_QK_WIDTH, MLSTM_WIDTH, MLSTM_HEADS, MLSTM_HEADS, MLSTM_WIDTH)
IN_SPLITS = tuple(int(s) for s in np.cumsum(IN_SIZES)[:-1])
D_IN = int(sum(IN_SIZES))

kernel_name = 'hymba_swa_mlstm_peer_adaln'


def rmsnorm(x, g):
    xf = x.astype(jnp.float32)
    y = xf * lax.rsqrt(jnp.mean(xf * xf, axis=-1, keepdims=True) + NORM_EPS)
    return (y * g.astype(jnp.float32)).astype(x.dtype)


def rope(x, positions):
    dh = x.shape[-1]
    inv_freq = ROPE_THETA ** (-jnp.arange(0, dh, 2, dtype=jnp.float32) / dh)
    ang = positions.astype(jnp.float32)[..., None] * inv_freq
    cos = jnp.cos(ang)[:, :, None, :]
    sin = jnp.sin(ang)[:, :, None, :]
    xf = x.astype(jnp.float32)
    x1, x2 = jnp.split(xf, 2, axis=-1)
    return jnp.concatenate([x1 * cos - x2 * sin, x2 * cos + x1 * sin], axis=-1).astype(x.dtype)


def sliding_window_attention(q, k, v, sinks):
    B, S, H, Dh = q.shape
    nb = S // ATT_BLOCK
    qb = q.reshape(B, nb, ATT_BLOCK, ATT_KV_HEADS, ATT_GROUP, Dh)

    def band(t):
        tb = t.reshape(B, nb, ATT_BLOCK, ATT_KV_HEADS, Dh)
        prev = jnp.pad(tb, ((0, 0), (1, 0), (0, 0), (0, 0), (0, 0)))[:, :-1]
        return jnp.concatenate([prev, tb], axis=2)

    kb = band(k)
    vb = band(v)
    scores = jnp.einsum('bnqkgd,bnskd->bnkgqs', qb, kb).astype(jnp.float32) * (Dh ** -0.5)
    qi = jnp.arange(ATT_BLOCK)[:, None]
    si = jnp.arange(2 * ATT_BLOCK)[None, :]
    delta = qi + ATT_BLOCK - si
    key_pos = jnp.arange(nb)[:, None, None] * ATT_BLOCK + si - ATT_BLOCK
    valid = (delta >= 0) & (delta < WINDOW) & (key_pos >= 0)
    scores = jnp.where(valid[None, :, None, None], scores, -jnp.inf)
    sink = sinks.astype(jnp.float32).reshape(1, 1, ATT_KV_HEADS, ATT_GROUP, 1, 1)
    m = jnp.maximum(scores.max(axis=-1, keepdims=True), sink)
    p = jnp.exp(scores - m)
    probs = (p / (p.sum(axis=-1, keepdims=True) + jnp.exp(sink - m))).astype(v.dtype)
    out = jnp.einsum('bnkgqs,bnskd->bnqkgd', probs, vb)
    return out.reshape(B, S, H * Dh)


def causal_dwconv(x, w):
    S = x.shape[1]
    xp = jnp.pad(x, ((0, 0), (CONV_WIDTH - 1, 0), (0, 0)))
    acc = xp[:, 0:S] * w[0]
    for j in range(1, CONV_WIDTH):
        acc = acc + xp[:, j:j + S] * w[j]
    return acc


def mlstm_chunkwise(q, k, v, i_pre, f_pre):
    B, S, H, Dk = q.shape
    Dv = v.shape[-1]
    L = MLSTM_CHUNK
    nc = S // L
    f32 = jnp.float32

    def to_chunks(t):
        t = t.astype(f32).reshape((B, nc, L) + t.shape[2:])
        return jnp.moveaxis(t, 1, 0)

    qc = to_chunks(q) * (Dk ** -0.5)
    kc = to_chunks(k)
    vc = to_chunks(v)
    ic = to_chunks(i_pre)
    fc = to_chunks(jax.nn.log_sigmoid(f_pre.astype(f32)))
    causal = jnp.tril(jnp.ones((L, L), dtype=bool))

    def step(carry, xs):
        C, n, m_prev = carry
        qt, kt, vt, it, lf = xs
        b = jnp.cumsum(lf, axis=1)
        bh = b.transpose(0, 2, 1)
        ih = it.transpose(0, 2, 1)
        dlog = bh[..., :, None] - bh[..., None, :] + ih[..., None, :]
        dlog = jnp.where(causal, dlog, -jnp.inf)
        m_inter = bh + m_prev[..., None]
        m_t = jnp.maximum(m_inter, dlog.max(axis=-1))
        w_intra = jnp.exp(dlog - m_t[..., None])
        a_inter = jnp.exp(m_inter - m_t)
        s = jnp.einsum('blhd,bshd->bhls', qt, kt) * w_intra
        a_bl = a_inter.transpose(0, 2, 1)[..., None]
        num = jnp.einsum('bhls,bshv->blhv', s, vt) + a_bl * jnp.einsum('blhd,bhvd->blhv', qt, C)
        den = s.sum(axis=-1) + a_inter * jnp.einsum('blhd,bhd->bhl', qt, n)
        denom = jnp.maximum(jnp.abs(den), jnp.exp(-m_t)).transpose(0, 2, 1)[..., None]
        h = num / denom
        bL = b[:, -1, :]
        g = bL[:, None, :] - b + it
        m_new = jnp.maximum(bL + m_prev, g.max(axis=1))
        w = jnp.exp(g - m_new[:, None, :])
        decay = jnp.exp(bL + m_prev - m_new)
        C_new = decay[..., None, None] * C + jnp.einsum('bsh,bshv,bshd->bhvd', w, vt, kt)
        n_new = decay[..., None] * n + jnp.einsum('bsh,bshd->bhd', w, kt)
        return (C_new, n_new, m_new), h

    init = (jnp.zeros((B, H, Dv, Dk), f32), jnp.zeros((B, H, Dk), f32), jnp.zeros((B, H), f32))
    _, hs = lax.scan(step, init, (qc, kc, vc, ic, fc))
    return jnp.moveaxis(hs, 0, 1).reshape(B, S, H, Dv)


def peer_ffn(h, w_q, keys1, keys2, u, v):
    B, S, D = h.shape
    nblk = S // PEER_BLOCK
    hb = h.reshape(B, nblk, PEER_BLOCK, D).swapaxes(0, 1).reshape(nblk, B * PEER_BLOCK, D)

    def block(ht):
        T = ht.shape[0]
        q = (ht @ w_q).reshape(T, PEER_HEADS, 2, PEER_HALF)
        s1 = jnp.einsum('thd,hkd->thk', q[:, :, 0], keys1).astype(jnp.float32)
        s2 = jnp.einsum('thd,hkd->thk', q[:, :, 1], keys2).astype(jnp.float32)
        v1, i1 = lax.top_k(s1, PEER_TOPK)
        v2, i2 = lax.top_k(s2, PEER_TOPK)
        cand = (v1[..., :, None] + v2[..., None, :]).reshape(T, PEER_HEADS, PEER_TOPK * PEER_TOPK)
        cidx = (i1[..., :, None] * PEER_KEYS + i2[..., None, :]).reshape(T, PEER_HEADS, PEER_TOPK * PEER_TOPK)
        top, pos = lax.top_k(cand, PEER_TOPK)
        eidx = jnp.take_along_axis(cidx, pos, axis=-1)
        gate = jax.nn.softmax(top, axis=-1)
        ug = u[eidx]
        act = jax.nn.gelu(jnp.einsum('thkd,td->thk', ug, ht).astype(jnp.float32), approximate=False) * gate
        vg = v[eidx]
        return jnp.einsum('thk,thkd->td', act.astype(ht.dtype), vg)

    yb = lax.map(block, hb)
    return yb.reshape(nblk, B, PEER_BLOCK, D).swapaxes(0, 1).reshape(B, S, D)


def setup_inputs(seed: int = 0) -> dict:
    key = jax.random.key(seed)
    ks = jax.random.split(key, 22)
    f32 = jnp.float32

    def nrm(k, shape, scale):
        return jax.random.normal(k, shape, f32) * scale

    x = nrm(ks[0], (BATCH, SEQ, D_MODEL), 1.0)
    c = nrm(ks[1], (BATCH, D_MODEL), 1.0)
    positions = jnp.broadcast_to(jnp.arange(SEQ, dtype=jnp.int32), (BATCH, SEQ))
    w_mod = nrm(ks[2], (DEPTH, D_MODEL, N_MOD * D_MODEL), 0.3 * D_MODEL ** -0.5)
    b_mod = nrm(ks[3], (DEPTH, N_MOD * D_MODEL), 0.02)
    g_pre_mix = 1.0 + nrm(ks[4], (DEPTH, D_MODEL), 0.05)
    g_post_mix = 1.0 + nrm(ks[5], (DEPTH, D_MODEL), 0.05)
    w_in = nrm(ks[6], (DEPTH, D_MODEL, D_IN), D_MODEL ** -0.5)
    conv_w = nrm(ks[7], (DEPTH, CONV_WIDTH, 2 * MLSTM_QK_WIDTH), CONV_WIDTH ** -0.5)
    b_igate = nrm(ks[8], (DEPTH, MLSTM_HEADS), 0.1)
    b_fgate = jnp.linspace(F_BIAS_LO, F_BIAS_HI, MLSTM_HEADS, dtype=f32)[None, :] + nrm(ks[9], (DEPTH, MLSTM_HEADS), 0.1)
    mlstm_norm_g = 1.0 + nrm(ks[10], (DEPTH, MLSTM_HEADS, MLSTM_V_DIM), 0.05)
    att_sinks = nrm(ks[11], (DEPTH, ATT_HEADS), 0.5)
    w_out = nrm(ks[12], (DEPTH, D_MIX, D_MODEL), D_MIX ** -0.5)
    g_pre_ffn = 1.0 + nrm(ks[13], (DEPTH, D_MODEL), 0.05)
    g_post_ffn = 1.0 + nrm(ks[14], (DEPTH, D_MODEL), 0.05)
    peer_wq = nrm(ks[15], (DEPTH, D_MODEL, PEER_HEADS * PEER_QUERY_DIM), D_MODEL ** -0.5)
    peer_keys1 = nrm(ks[16], (DEPTH, PEER_HEADS, PEER_KEYS, PEER_HALF), PEER_HALF ** -0.5)
    peer_keys2 = nrm(ks[17], (DEPTH, PEER_HEADS, PEER_KEYS, PEER_HALF), PEER_HALF ** -0.5)
    peer_u = nrm(ks[18], (DEPTH, PEER_EXPERTS, D_MODEL), D_MODEL ** -0.5)
    peer_v = nrm(ks[19], (DEPTH, PEER_EXPERTS, D_MODEL), (PEER_HEADS * PEER_TOPK) ** -0.5)
    return {'x': x, 'c': c, 'positions': positions, 'w_mod': w_mod, 'b_mod': b_mod,
            'g_pre_mix': g_pre_mix, 'g_post_mix': g_post_mix, 'w_in': w_in, 'conv_w': conv_w,
            'b_igate': b_igate, 'b_fgate': b_fgate, 'mlstm_norm_g': mlstm_norm_g,
            'att_sinks': att_sinks, 'w_out': w_out, 'g_pre_ffn': g_pre_ffn, 'g_post_ffn': g_post_ffn,
            'peer_wq': peer_wq, 'peer_keys1': peer_keys1, 'peer_keys2': peer_keys2,
            'peer_u': peer_u, 'peer_v': peer_v}


def reference(x, c, positions, w_mod, b_mod, g_pre_mix, g_post_mix, w_in, conv_w, b_igate, b_fgate,
              mlstm_norm_g, att_sinks, w_out, g_pre_ffn, g_post_ffn, peer_wq, peer_keys1, peer_keys2,
              peer_u, peer_v):
    B, S, D = x.shape
    for l in range(DEPTH):
        mod = (c @ w_mod[l] + b_mod[l])[:, None, :]
        shift1, scale1, gate1, shift2, scale2, gate2 = jnp.split(mod, N_MOD, axis=-1)

        h = rmsnorm(x, g_pre_mix[l]) * (1.0 + scale1) + shift1
        proj = h @ w_in[l]
        aq, ak, av, mq, mk, mv, mi, mf, mo = jnp.split(proj, IN_SPLITS, axis=-1)

        aq = rope(aq.reshape(B, S, ATT_HEADS, ATT_HEAD_DIM), positions)
        ak = rope(ak.reshape(B, S, ATT_KV_HEADS, ATT_HEAD_DIM), positions)
        av = av.reshape(B, S, ATT_KV_HEADS, ATT_HEAD_DIM)
        att = sliding_window_attention(aq, ak, av, att_sinks[l])

        mqk = jax.nn.silu(causal_dwconv(jnp.concatenate([mq, mk], axis=-1), conv_w[l]))
        mq, mk = jnp.split(mqk, 2, axis=-1)
        mh = mlstm_chunkwise(mq.reshape(B, S, MLSTM_HEADS, MLSTM_QK_DIM),
                             mk.reshape(B, S, MLSTM_HEADS, MLSTM_QK_DIM),
                             mv.reshape(B, S, MLSTM_HEADS, MLSTM_V_DIM),
                             mi + b_igate[l], mf + b_fgate[l])
        mh = rmsnorm(mh, mlstm_norm_g[l]).astype(x.dtype)
        mh = (mh * jax.nn.sigmoid(mo).reshape(B, S, MLSTM_HEADS, MLSTM_V_DIM)).reshape(B, S, MLSTM_WIDTH)

        mix = jnp.concatenate([att, mh], axis=-1) @ w_out[l]
        x = x + gate1 * rmsnorm(mix, g_post_mix[l])

        h2 = rmsnorm(x, g_pre_ffn[l]) * (1.0 + scale2) + shift2
        y = peer_ffn(h2, peer_wq[l], peer_keys1[l], peer_keys2[l], peer_u[l], peer_v[l])
        x = x + gate2 * rmsnorm(y, g_post_ffn[l])
    return x
```

```cpp
#include <hip/hip_runtime.h>
#include <hip/hip_cooperative_groups.h>
#include <cstdio>
#include <cstdint>
namespace cg = cooperative_groups;
namespace pg8 {
#define PG8_LAS __attribute__((address_space(3)))
typedef unsigned short bf16_t;
typedef short bf16x8 __attribute__((ext_vector_type(8)));
typedef float f32x4 __attribute__((ext_vector_type(4)));
typedef unsigned u32x4 __attribute__((ext_vector_type(4)));
constexpr int BM = 256, BK = 64, HALF = 128, HTB = HALF * BK * 2  , STAGE_BYTES = 8 * HTB, NXCD = 8, WGM = 8;

__host__ __device__ __forceinline__ int lds_byte(int r, int c) { const int st = (r >> 4) * 2 + (c >> 5), rr = r & 15, cc = c & 31, ob = rr * 64 + cc * 2; return st * 1024 + (ob ^ (((ob >> 9) & 1) << 5)); }
__host__ __device__ __forceinline__ void stage_rc(int b, int& R, int& C) { const int st = b / 1024, sb = b % 1024, swz = sb ^ (((sb >> 9) & 1) << 5); R = (st >> 1) * 16 + swz / 64; C = (st & 1) * 32 + (swz % 64) / 2; }
__host__ __device__ __forceinline__ int perm32(int rho) { const int n = rho >> 4, i = rho & 15; return 8 * (i >> 2) + 4 * n + (i & 3); }

struct Unit { int pm, pn; };
struct Gemm { const bf16_t* A; const bf16_t* Bt; int M, N, K; };

struct StaticOrder {
    int nM, nN, nwg, G, c;
    __host__ __device__ void init(int M, int N, int G_, int c_) { nM = M / BM; nN = N / BM; nwg = nM * nN; G = G_; c = c_; }
    __host__ __device__ bool next(int i, Unit& u) const {
        const long L = (long)i * G + c; if (L >= nwg) return false;
        int wgid = (int)L; { const int q = nwg / NXCD, r = nwg % NXCD, xcd = wgid % NXCD, off = wgid / NXCD; wgid = (xcd < r ? xcd * (q + 1) : r * (q + 1) + (xcd - r) * q) + off; }
        const int nig = WGM * nN, gid = wgid / nig, fm = gid * WGM, gsz = (nM - fm) < WGM ? (nM - fm) : WGM;
        u.pm = fm + ((wgid % nig) % gsz); u.pn = (wgid % nig) / gsz; return true;
    }
    __device__ __forceinline__ void a_ready(const Unit&) const {}
    __device__ __forceinline__ void done(const Unit&) const {}
};

__device__ __forceinline__ unsigned cvt_pk_bf16(float lo, float hi) { unsigned r; asm volatile("v_cvt_pk_bf16_f32 %0, %1, %2" : "=v"(r) : "v"(lo), "v"(hi)); return r; }
typedef float f32x2 __attribute__((ext_vector_type(2)));
__device__ __forceinline__ f32x2 gelu_pk(f32x2 v) {
    const f32x2 av = __builtin_elementwise_abs(v), d = av * 0.2316418882f + 1.0f;
    f32x2 t; t.x = __builtin_amdgcn_rcpf(d.x); t.y = __builtin_amdgcn_rcpf(d.y);
    f32x2 q = t * 0.5307027145f + (-0.7265760135f); q = q * t + 0.7107068705f; q = q * t + (-0.142248368f); q = q * t + 0.127414796f; q = q * t;
    const f32x2 s = (v * v) * (-0.72134752044f);
    f32x2 e; e.x = __builtin_amdgcn_exp2f(s.x); e.y = __builtin_amdgcn_exp2f(s.y);
    const f32x2 m = v * (q * e), r = v - m;
    f32x2 o; o.x = v.x < 0.f ? m.x : r.x; o.y = v.y < 0.f ? m.y : r.y; return o;
}

__device__ __forceinline__ u32x4 pack8(const f32x4 v0, const f32x4 v1) { u32x4 w; w.x = cvt_pk_bf16(v0[0], v0[1]); w.y = cvt_pk_bf16(v0[2], v0[3]); w.z = cvt_pk_bf16(v1[0], v1[1]); w.w = cvt_pk_bf16(v1[2], v1[3]); return w; }

struct EpiPlain {
    static constexpr bool PERM = true, AFTER_DRAIN = false;
    bf16_t* O; int ldc;
    __device__ __forceinline__ void operator()(const f32x4 (&acc)[2][2][4][2], const Unit& u, int wr, int wc, int fr, int fq) const {
        const int row0 = u.pm * BM + wr * 64 + fr, col0 = u.pn * BM + wc * 32 + 8 * fq;
#pragma unroll
        for (int ai = 0; ai < 2; ++ai)
#pragma unroll
            for (int m = 0; m < 4; ++m) { bf16_t* rowp = O + (size_t)(row0 + ai * HALF + m * 16) * ldc + col0;
#pragma unroll
                for (int bj = 0; bj < 2; ++bj) *(u32x4*)(rowp + bj * HALF) = pack8(acc[ai][bj][m][0], acc[ai][bj][m][1]); }
    }
};

struct EpiProj {
    static constexpr bool PERM = true, AFTER_DRAIN = false;
    bf16_t* P; int ldc; float* gates; const int* pos; const float* b_i; const float* b_f;
    __device__ __forceinline__ void operator()(const f32x4 (&acc)[2][2][4][2], const Unit& u, int wr, int wc, int fr, int fq) const {
        const int row0 = u.pm * BM + wr * 64 + fr, col0 = u.pn * BM + wc * 32 + 8 * fq, pn = u.pn;
        if (pn == 9) {
            if (wc == 0 && fq == 0) {
                const f32x4 bi = {b_i[0], b_i[1], b_i[2], b_i[3]}, bf = {b_f[0], b_f[1], b_f[2], b_f[3]};
#pragma unroll
                for (int ai = 0; ai < 2; ++ai)
#pragma unroll
                    for (int m = 0; m < 4; ++m) { const int row = row0 + ai * HALF + m * 16;
                        const f32x4 iv = acc[ai][0][m][0] + bi, fv = acc[ai][0][m][1] + bf; f32x4 lf;
#pragma unroll
                        for (int j = 0; j < 4; ++j) lf[j] = fminf(fv[j], 0.f) - log1pf(__expf(-fabsf(fv[j])));
                        *(f32x4*)(gates + (size_t)row * 8) = iv; *(f32x4*)(gates + (size_t)row * 8 + 4) = lf; }
            }
            return;
        }
#pragma unroll
        for (int ai = 0; ai < 2; ++ai)
#pragma unroll
            for (int m = 0; m < 4; ++m) { const int row = row0 + ai * HALF + m * 16; bf16_t* rowp = P + (size_t)row * ldc + col0;
                const float posf = (pn <= 2) ? (float)pos[row] : 0.f;
#pragma unroll
                for (int bj = 0; bj < 2; ++bj) { f32x4 v0 = acc[ai][bj][m][0], v1 = acc[ai][bj][m][1];
                    const bool rope = (pn < 2) || (pn == 2 && bj == 0);
                    if (rope) {
                        const int p0 = ((col0 + bj * HALF) & 63) >> 1; const float sc = (pn < 2) ? 0.125f : 1.0f;
                        float x[8] = {v0[0], v0[1], v0[2], v0[3], v1[0], v1[1], v1[2], v1[3]};
#pragma unroll
                        for (int q = 0; q < 4; ++q) { const float invf = __builtin_amdgcn_exp2f(-(float)(p0 + q) * 0.41524101186092029f);
                            float r = posf * invf * 0.15915494309189535f; r = r - floorf(r);
                            const float c = __builtin_amdgcn_cosf(r) * sc, s = __builtin_amdgcn_sinf(r) * sc;
                            const float x1 = x[2 * q], x2 = x[2 * q + 1]; x[2 * q] = x1 * c - x2 * s; x[2 * q + 1] = x2 * c + x1 * s; }
                        v0 = (f32x4){x[0], x[1], x[2], x[3]}; v1 = (f32x4){x[4], x[5], x[6], x[7]};
                    } else if (pn >= 7) {
#pragma unroll
                        for (int j = 0; j < 4; ++j) { v0[j] = __builtin_amdgcn_rcpf(1.f + __expf(-v0[j])); v1[j] = __builtin_amdgcn_rcpf(1.f + __expf(-v1[j])); }
                    }
                    *(u32x4*)(rowp + bj * HALF) = pack8(v0, v1); } }
    }
};

struct EpiMix {
    static constexpr bool PERM = true, AFTER_DRAIN = false;
    bf16_t* O; int ldc; float* sumsq;
    __device__ __forceinline__ void operator()(const f32x4 (&acc)[2][2][4][2], const Unit& u, int wr, int wc, int fr, int fq) const {
        const int row0 = u.pm * BM + wr * 64 + fr, col0 = u.pn * BM + wc * 32 + 8 * fq;
#pragma unroll
        for (int ai = 0; ai < 2; ++ai)
#pragma unroll
            for (int m = 0; m < 4; ++m) { const int row = row0 + ai * HALF + m * 16; bf16_t* rowp = O + (size_t)row * ldc + col0; float s = 0.f;
#pragma unroll
                for (int bj = 0; bj < 2; ++bj) { const f32x4 v0 = acc[ai][bj][m][0], v1 = acc[ai][bj][m][1];
                    s += (v0[0] * v0[0] + v0[1] * v0[1]) + (v0[2] * v0[2] + v0[3] * v0[3]) + (v1[0] * v1[0] + v1[1] * v1[1]) + (v1[2] * v1[2] + v1[3] * v1[3]);
                    *(u32x4*)(rowp + bj * HALF) = pack8(v0, v1); }
                s += __shfl_xor(s, 16); s += __shfl_xor(s, 32);
                if (fq == 0) unsafeAtomicAdd(sumsq + row, s); }
    }
};
template <class Epi, class Sched, bool ALIGN_EPI = false, bool SP2 = false>
__device__ __forceinline__ void gemm_phase(PG8_LAS unsigned char* lds, const Gemm g, const Sched& S, const Epi& E) {
    const int tid = threadIdx.x, wid = __builtin_amdgcn_readfirstlane(tid >> 6), lane = tid & 63, wr = wid >> 2, wc = wid & 3, fr = lane & 15, fq = lane >> 4;
    const int K = g.K, nt = K / BK;
    unsigned voffA[2], voffB[2];
#pragma unroll
    for (int i = 0; i < 2; ++i) { int R, C; stage_rc(tid * 16 + i * 8192, R, C); const int Rb = Epi::PERM ? ((R & ~31) + perm32(R & 31)) : R;
        voffA[i] = (unsigned)(R * K + C) * 2u; voffB[i] = (unsigned)(Rb * K + C) * 2u; }
    const size_t kstep = (size_t)(BK * 2);
    const size_t hstep = (size_t)HALF * K * 2;
    const size_t tstep = 2 * hstep;
    const unsigned ldsw = (unsigned)wid * 1024u;
    const int aoff = lds_byte(wr * 64 + fr, fq * 8), boff = lds_byte(wc * 32 + fr, fq * 8);
#define PG8_SA(b, h) (((b) * 2 + (h)) * HTB)
#define PG8_SB(b, h) ((4 + (b) * 2 + (h)) * HTB)
#define PG8_STAGE(bufoff, gbase, voff) do { _Pragma("unroll") for (int _i = 0; _i < 2; ++_i) \
        __builtin_amdgcn_global_load_lds((const unsigned*)((const char*)(gbase) + (voff)[_i]), (PG8_LAS unsigned*)(lds + (bufoff) + ldsw + _i * 8192), 16, 0, 0); } while (0)
#define PG8_LDA(dst, b, h) do { _Pragma("unroll") for (int m = 0; m < 4; ++m) _Pragma("unroll") for (int k = 0; k < 2; ++k) dst[m][k] = *(const PG8_LAS bf16x8*)(lds + PG8_SA(b, h) + aoff + m * 2048 + k * 1024); } while (0)
#define PG8_LDB(dst, b, h) do { _Pragma("unroll") for (int n = 0; n < 2; ++n) _Pragma("unroll") for (int k = 0; k < 2; ++k) dst[n][k] = *(const PG8_LAS bf16x8*)(lds + PG8_SB(b, h) + boff + n * 2048 + k * 1024); } while (0)
#define PG8_MMA(ai, bj, At, Bt) do { __builtin_amdgcn_s_setprio(1); _Pragma("unroll") for (int m = 0; m < 4; ++m) _Pragma("unroll") for (int n = 0; n < 2; ++n) _Pragma("unroll") for (int k = 0; k < 2; ++k) \
        acc[ai][bj][m][n] = __builtin_amdgcn_mfma_f32_16x16x32_bf16(Bt[n][k], At[m][k], acc[ai][bj][m][n], 0, 0, 0); __builtin_amdgcn_s_setprio(0); } while (0)
#define PG8_WAIT_V(n) asm volatile("s_waitcnt vmcnt(" #n ")" ::: "memory")
#define PG8_WAIT_L(n) asm volatile("s_waitcnt lgkmcnt(" #n ")" ::: "memory")
#define PG8_BAR __builtin_amdgcn_s_barrier()
#define PG8_SCHED __builtin_amdgcn_sched_barrier(0)
    Unit cur, nxt; int ui = 0;
    if (!S.next(0, cur)) return;
    f32x4 acc[2][2][4][2];
#pragma unroll
    for (int a = 0; a < 2; ++a)
#pragma unroll
        for (int b = 0; b < 2; ++b)
#pragma unroll
            for (int m = 0; m < 4; ++m)
#pragma unroll
                for (int n = 0; n < 2; ++n) acc[a][b][m][n] = (f32x4){0.f, 0.f, 0.f, 0.f};
    bf16x8 At[4][2], B0[2][2], B1[2][2];
    const char* cA = (const char*)g.A + (size_t)cur.pm * tstep; const char* cB = (const char*)g.Bt + (size_t)cur.pn * tstep;
    S.a_ready(cur);
    if constexpr (SP2) {
        PG8_STAGE(PG8_SB(0, 0), cB, voffB); PG8_STAGE(PG8_SB(0, 1), cB + hstep, voffB); PG8_STAGE(PG8_SA(0, 0), cA, voffA); PG8_STAGE(PG8_SA(0, 1), cA + hstep, voffA);
        if (wr == 1) PG8_BAR;
        PG8_WAIT_V(2); PG8_BAR;
        PG8_STAGE(PG8_SB(1, 0), cB + kstep, voffB); PG8_STAGE(PG8_SA(1, 0), cA + kstep, voffA); PG8_STAGE(PG8_SB(1, 1), cB + hstep + kstep, voffB);
        PG8_WAIT_V(6); PG8_BAR;
    } else {
        PG8_STAGE(PG8_SB(0, 0), cB, voffB); PG8_STAGE(PG8_SA(0, 0), cA, voffA); PG8_STAGE(PG8_SB(0, 1), cB + hstep, voffB); PG8_STAGE(PG8_SA(0, 1), cA + hstep, voffA);
        if (wr == 1) PG8_BAR;
        PG8_WAIT_V(4); PG8_BAR;
        PG8_STAGE(PG8_SB(1, 0), cB + kstep, voffB); PG8_STAGE(PG8_SA(1, 0), cA + kstep, voffA); PG8_STAGE(PG8_SB(1, 1), cB + hstep + kstep, voffB);
        PG8_WAIT_V(6); PG8_BAR;
    }
    for (;;) {
        const bool has_next = S.next(ui + 1, nxt);
        const char* nA = has_next ? (const char*)g.A + (size_t)nxt.pm * tstep : cA; const char* nB = has_next ? (const char*)g.Bt + (size_t)nxt.pn * tstep : cB;
        for (int t = 0; t < nt; t += 2) {
            const bool last = (t == nt - 2);
            const char* a1 = cA + (size_t)(t + 1) * kstep;
            const char* a2 = last ? nA : cA + (size_t)(t + 2) * kstep; const char* b2 = last ? nB : cB + (size_t)(t + 2) * kstep;
            const char* a3 = a2 + kstep; const char* b3 = b2 + kstep;
            if (last && has_next) S.a_ready(nxt);
            if constexpr (SP2) {
            PG8_LDB(B0, 0, 0); PG8_LDB(B1, 0, 1); PG8_SCHED; PG8_LDA(At, 0, 0); PG8_STAGE(PG8_SA(1, 1), a1 + hstep, voffA);
            PG8_WAIT_V(8); PG8_WAIT_L(0); PG8_BAR; PG8_MMA(0, 0, At, B0); PG8_MMA(0, 1, At, B1); PG8_BAR; PG8_SCHED;
            PG8_LDA(At, 0, 1); PG8_STAGE(PG8_SB(0, 0), b2, voffB); PG8_STAGE(PG8_SB(0, 1), b2 + hstep, voffB); PG8_STAGE(PG8_SA(0, 0), a2, voffA);
            PG8_WAIT_V(8); PG8_WAIT_L(0); PG8_BAR; PG8_MMA(1, 0, At, B0); PG8_MMA(1, 1, At, B1); PG8_BAR; PG8_SCHED;
            PG8_LDB(B0, 1, 0); PG8_LDB(B1, 1, 1); PG8_SCHED; PG8_LDA(At, 1, 0); PG8_STAGE(PG8_SA(0, 1), a2 + hstep, voffA);
            PG8_WAIT_V(8); PG8_WAIT_L(0); PG8_BAR; PG8_MMA(0, 0, At, B0); PG8_MMA(0, 1, At, B1); PG8_BAR; PG8_SCHED;
            PG8_LDA(At, 1, 1); PG8_STAGE(PG8_SB(1, 0), b3, voffB); PG8_STAGE(PG8_SB(1, 1), b3 + hstep, voffB); PG8_STAGE(PG8_SA(1, 0), a3, voffA);
            PG8_WAIT_V(8); PG8_WAIT_L(0); PG8_BAR; PG8_MMA(1, 0, At, B0); PG8_MMA(1, 1, At, B1); PG8_BAR; PG8_SCHED;
            } else {
            PG8_LDB(B0, 0, 0); PG8_SCHED; PG8_LDA(At, 0, 0); PG8_STAGE(PG8_SA(1, 1), a1 + hstep, voffA);
            PG8_WAIT_L(8); PG8_BAR; PG8_WAIT_L(0); PG8_MMA(0, 0, At, B0); PG8_BAR; PG8_SCHED;
            PG8_LDB(B1, 0, 1); PG8_STAGE(PG8_SB(0, 0), b2, voffB);
            PG8_BAR; PG8_WAIT_L(0); PG8_MMA(0, 1, At, B1); PG8_BAR;
            PG8_LDA(At, 0, 1); PG8_STAGE(PG8_SA(0, 0), a2, voffA);
            PG8_BAR; PG8_WAIT_L(0); PG8_MMA(1, 0, At, B0); PG8_BAR; PG8_SCHED;
            PG8_STAGE(PG8_SB(0, 1), b2 + hstep, voffB);
            PG8_WAIT_V(6); PG8_BAR; PG8_MMA(1, 1, At, B1); PG8_BAR;
            PG8_LDB(B0, 1, 0); PG8_SCHED; PG8_LDA(At, 1, 0); PG8_STAGE(PG8_SA(0, 1), a2 + hstep, voffA);
            PG8_WAIT_L(8); PG8_BAR; PG8_WAIT_L(0); PG8_MMA(0, 0, At, B0); PG8_BAR; PG8_SCHED;
            PG8_LDB(B1, 1, 1); PG8_STAGE(PG8_SB(1, 0), b3, voffB);
            PG8_BAR; PG8_WAIT_L(0); PG8_MMA(0, 1, At, B1); PG8_BAR;
            PG8_LDA(At, 1, 1); PG8_STAGE(PG8_SA(1, 0), a3, voffA);
            PG8_BAR; PG8_WAIT_L(0); PG8_MMA(1, 0, At, B0); PG8_BAR; PG8_SCHED;
            PG8_STAGE(PG8_SB(1, 1), b3 + hstep, voffB);
            PG8_WAIT_V(6); PG8_BAR; PG8_MMA(1, 1, At, B1); PG8_BAR;
            }
        }
        if constexpr (ALIGN_EPI) { if (wr == 0) PG8_BAR; }
        if constexpr (!Epi::AFTER_DRAIN) { E(acc, cur, wr, wc, fr, fq); S.done(cur); }
        if (!has_next) break;
#pragma unroll
        for (int a = 0; a < 2; ++a)
#pragma unroll
            for (int b = 0; b < 2; ++b)
#pragma unroll
                for (int m = 0; m < 4; ++m)
#pragma unroll
                    for (int n = 0; n < 2; ++n) acc[a][b][m][n] = (f32x4){0.f, 0.f, 0.f, 0.f};
        cur = nxt; cA = nA; cB = nB; ++ui;
        if constexpr (ALIGN_EPI) { if (wr == 1) PG8_BAR; }
    }
    PG8_WAIT_V(0);
    if constexpr (!ALIGN_EPI) { if (wr == 0) PG8_BAR; }
    PG8_BAR;
    if constexpr (Epi::AFTER_DRAIN) { E.fused(acc, cur, wr, wc, fr, fq, lds, wid, lane); S.done(cur); }
#undef PG8_SA
#undef PG8_SB
#undef PG8_STAGE
#undef PG8_LDA
#undef PG8_LDB
#undef PG8_MMA
#undef PG8_WAIT_V
#undef PG8_WAIT_L
#undef PG8_BAR
#undef PG8_SCHED
}
}
constexpr int NB = 8, SEQ = 8192, D = 1024, M = NB * SEQ;
constexpr int DIN = 2312, NPROJ = 2304, NIN_PAD = 2560;
constexpr int C_AQ = 0, C_AK = 512, C_AV = 640, C_MQ = 768, C_MK = 1024, C_MV = 1280, C_MO = 1792;
constexpr int NEXP = 16384, NSLOT = 128;
constexpr float EPS = 1e-6f;
constexpr int NWAVES = 8, NTHR = 512;

constexpr size_t MiB = 1u << 20;
constexpr size_t WS_CTL = 0, CTL_ZERO_BYTES = 1 * MiB;
constexpr size_t WS_MOD = 1 * MiB;
constexpr size_t WS_WIN = 2 * MiB;
constexpr size_t WS_WOUT = 8 * MiB;
constexpr size_t WS_WQ = 10 * MiB;
constexpr size_t WS_KEYS = 14 * MiB;
constexpr size_t WS_GATES = 16 * MiB;
constexpr size_t WS_MST = 20 * MiB;
constexpr size_t WS_U = 32 * MiB, WS_V = 64 * MiB;
constexpr size_t WS_H = 96 * MiB;
constexpr size_t WS_PROJ = 224 * MiB;
constexpr size_t WS_MIXIN = 512 * MiB;
constexpr size_t WS_MIX = 640 * MiB;
constexpr size_t WS_EIDX = 768 * MiB, WS_GATE = 800 * MiB;
constexpr size_t WS_END = 832 * MiB;
constexpr int CW_BAR = 4096;
constexpr int CW_SUMSQ = 65536;
static_assert((CW_SUMSQ + M) * 4 <= (int)CTL_ZERO_BYTES, "ctl");

constexpr int RING_BYTES = 131072, MISC_OFF = RING_BYTES + 320, LDS_BYTES = 147456;

#define GAS __attribute__((address_space(1)))
#define LAS __attribute__((address_space(3)))
typedef unsigned short bf16;
typedef unsigned v4u __attribute__((ext_vector_type(4)));
typedef unsigned v2u __attribute__((ext_vector_type(2)));
typedef float f32x4 __attribute__((ext_vector_type(4)));
typedef GAS unsigned gu32;
#define LDS_WAIT() asm volatile("s_waitcnt lgkmcnt(0)" ::: "memory")
#define VM_WAIT() asm volatile("s_waitcnt vmcnt(0)" ::: "memory")
__device__ __forceinline__ unsigned f2bf(float f) { unsigned u = __builtin_bit_cast(unsigned, f); return (u + 0x7fffu + ((u >> 16) & 1u)) >> 16; }
__device__ __forceinline__ unsigned pk2(float lo, float hi) { return f2bf(lo) | (f2bf(hi) << 16); }
__device__ __forceinline__ float bflo(unsigned w) { return __builtin_bit_cast(float, w << 16); }
__device__ __forceinline__ float bfhi(unsigned w) { return __builtin_bit_cast(float, w & 0xffff0000u); }
__device__ __forceinline__ float bf1(bf16 h) { return __builtin_bit_cast(float, (unsigned)h << 16); }
__device__ __forceinline__ float wave_sum(float v) {
#pragma unroll
    for (int o = 1; o < 64; o <<= 1) v += __shfl_xor(v, o);
    return v;
}
__device__ __forceinline__ float wave_max(float v) {
#pragma unroll
    for (int o = 1; o < 64; o <<= 1) v = fmaxf(v, __shfl_xor(v, o));
    return v;
}
struct Args { const void* in[21]; float* out; unsigned char* ws; int ph_lo, ph_hi; };
enum { I_X = 0, I_C, I_POS, I_WMOD, I_BMOD, I_GPRE1, I_GPOST1, I_WIN, I_CONVW, I_BI, I_BF, I_MNG, I_SINK, I_WOUT, I_GPRE2, I_GPOST2, I_WQ, I_K1, I_K2, I_U, I_V };

__device__ __forceinline__ int newcol(int o) {
    if (o < 640) { const int hd = o >> 6, d = o & 63; return (hd << 6) + 2 * (d & 31) + (d >> 5); }
    if (o < 1792) return o;
    if (o < 1800) return 2304 + (o - 1792);
    return o - 8;
}
template <bool REMAP>
__device__ __forceinline__ void p0_transpose_item(const float* W, int K, int N, bf16* WT, LAS float* scr, int item, int lane) {
    const int nblk = (N + 31) / 32, kb = item / nblk, nb = item % nblk, k0 = 64 * kb, n0 = 32 * nb;
    const int ncol = n0 + (lane & 31);
#pragma unroll 8
    for (int i = 0; i < 32; ++i) { const int kk = 2 * i + (lane >> 5); scr[kk * 33 + (lane & 31)] = (ncol < N) ? W[(size_t)(k0 + kk) * N + ncol] : 0.f; }
    LDS_WAIT(); asm volatile("" ::: "memory");
    const int c = lane & 7;
#pragma unroll
    for (int j = 0; j < 4; ++j) { const int n = (lane >> 3) + 8 * j; const LAS float* s = scr + (8 * c) * 33 + n;
        v4u o; o.x = pk2(s[0 * 33], s[1 * 33]); o.y = pk2(s[2 * 33], s[3 * 33]); o.z = pk2(s[4 * 33], s[5 * 33]); o.w = pk2(s[6 * 33], s[7 * 33]);
        if (n0 + n < N) { const int drow = REMAP ? newcol(n0 + n) : (n0 + n); *(GAS v4u*)(WT + (size_t)drow * K + k0 + 8 * c) = o; } }
    LDS_WAIT(); asm volatile("" ::: "memory");
}
__device__ __forceinline__ void p0_convert(const float* src, bf16* dst, size_t n, int gt, int ngt) {
    for (size_t i = (size_t)gt * 8; i < n; i += (size_t)ngt * 8) {
        const f32x4 a = *(const GAS f32x4*)(src + i), b = *(const GAS f32x4*)(src + i + 4);
        v4u o; o.x = pk2(a[0], a[1]); o.y = pk2(a[2], a[3]); o.z = pk2(b[0], b[1]); o.w = pk2(b[2], b[3]);
        *(GAS v4u*)(dst + i) = o; }
}
__device__ __forceinline__ void phase_prologue(const Args& A, LAS unsigned char* lds) {
    const int tid = threadIdx.x, lane = tid & 63, wave = tid >> 6, G = gridDim.x, blk = blockIdx.x;
    unsigned char* ws = A.ws;
    {
        const float* c = (const float*)A.in[I_C]; const float* wm = (const float*)A.in[I_WMOD]; const float* bm = (const float*)A.in[I_BMOD];
        float* mod = (float*)(ws + WS_MOD); LAS float* red = (LAS float*)lds;
        for (int it = blk; it < 6144 / 32; it += G) {
            const int kg = tid >> 5, col = tid & 31, j = it * 32 + col; float acc[8];
#pragma unroll
            for (int b = 0; b < 8; ++b) acc[b] = 0.f;
            for (int i = 0; i < 64; ++i) { const int k = kg + 16 * i; const float w = wm[(size_t)k * 6144 + j];
#pragma unroll
                for (int b = 0; b < 8; ++b) acc[b] += c[b * 1024 + k] * w; }
#pragma unroll
            for (int b = 0; b < 8; ++b) red[(kg * 32 + col) * 8 + b] = acc[b];
            __syncthreads();
            if (tid < 256) { const int b = tid >> 5, cc = tid & 31; float s = 0.f;
#pragma unroll
                for (int g = 0; g < 16; ++g) s += red[(g * 32 + cc) * 8 + b];
                mod[b * 6144 + it * 32 + cc] = s + bm[it * 32 + cc]; }
            __syncthreads();
        }
    }
    {
        LAS float* scr = (LAS float*)(lds + wave * 16384);
        const int gw = blk * NWAVES + wave, NGW = G * NWAVES;
        const int I_IN = (D / 64) * ((DIN + 31) / 32), I_OUT = (D / 64) * (D / 32), I_Q = (D / 64) * (2048 / 32);
        bf16* win = (bf16*)(ws + WS_WIN); bf16* wout = (bf16*)(ws + WS_WOUT); bf16* wq = (bf16*)(ws + WS_WQ);
        for (int it = gw; it < I_IN + I_OUT + I_Q; it += NGW) {
            int r = it;
            if (r < I_IN) { p0_transpose_item<true>((const float*)A.in[I_WIN], D, DIN, win, scr, r, lane); continue; } r -= I_IN;
            if (r < I_OUT) { p0_transpose_item<false>((const float*)A.in[I_WOUT], D, D, wout, scr, r, lane); continue; } r -= I_OUT;
            p0_transpose_item<false>((const float*)A.in[I_WQ], D, 2048, wq, scr, r, lane);
        }
        const int gt = blk * NTHR + tid, ngt = G * NTHR;
        for (int i = gt; i < (NIN_PAD - DIN) * D / 8; i += ngt) *(GAS v4u*)(win + (size_t)DIN * D + (size_t)i * 8) = (v4u){0u, 0u, 0u, 0u};
        p0_convert((const float*)A.in[I_K1], (bf16*)(ws + WS_KEYS), (size_t)8 * 128 * 128, gt, ngt);
        p0_convert((const float*)A.in[I_K2], (bf16*)(ws + WS_KEYS) + 8 * 128 * 128, (size_t)8 * 128 * 128, gt, ngt);
        p0_convert((const float*)A.in[I_U], (bf16*)(ws + WS_U), (size_t)NEXP * D, gt, ngt);
        p0_convert((const float*)A.in[I_V], (bf16*)(ws + WS_V), (size_t)NEXP * D, gt, ngt);
    }
}

__device__ __forceinline__ void phase_prenorm(const Args& A) {
    const int tid = threadIdx.x, lane = tid & 63, wave = tid >> 6, G = gridDim.x;
    const float* x = (const float*)A.in[I_X]; const float* g = (const float*)A.in[I_GPRE1]; const float* mod = (const float*)(A.ws + WS_MOD);
    bf16* H = (bf16*)(A.ws + WS_H);
    for (int row = blockIdx.x * NWAVES + wave; row < M; row += G * NWAVES) {
        const int b = row / SEQ; const GAS f32x4* xr = (const GAS f32x4*)(x + (size_t)row * D) + lane;
        f32x4 v[4]; float s = 0.f;
#pragma unroll
        for (int j = 0; j < 4; ++j) { v[j] = xr[64 * j]; s += (v[j][0] * v[j][0] + v[j][1] * v[j][1]) + (v[j][2] * v[j][2] + v[j][3] * v[j][3]); }
        const float rstd = 1.0f / sqrtf(wave_sum(s) * (1.f / D) + EPS);
        GAS v2u* o = (GAS v2u*)(H + (size_t)row * D) + lane;
#pragma unroll
        for (int j = 0; j < 4; ++j) { const int k = 4 * (lane + 64 * j);
            const f32x4 gg = *(const GAS f32x4*)(g + k), sh = *(const GAS f32x4*)(mod + b * 6144 + k), sc = *(const GAS f32x4*)(mod + b * 6144 + 1024 + k);
            f32x4 y;
#pragma unroll
            for (int i = 0; i < 4; ++i) y[i] = v[j][i] * rstd * gg[i] * (1.f + sc[i]) + sh[i];
            v2u w; w.x = pk2(y[0], y[1]); w.y = pk2(y[2], y[3]); o[64 * j] = w; }
    }
}

__device__ __forceinline__ void phase_mid(const Args& A) {
    const int tid = threadIdx.x, lane = tid & 63, wave = tid >> 6, G = gridDim.x;
    const float* x = (const float*)A.in[I_X]; const float* gpost = (const float*)A.in[I_GPOST1]; const float* gpre = (const float*)A.in[I_GPRE2];
    const float* mod = (const float*)(A.ws + WS_MOD); const float* sumsq = (const float*)(A.ws + WS_CTL) + CW_SUMSQ;
    const bf16* MIX = (const bf16*)(A.ws + WS_MIX); bf16* H = (bf16*)(A.ws + WS_H); float* out = A.out;
    for (int row = blockIdx.x * NWAVES + wave; row < M; row += G * NWAVES) {
        const int b = row / SEQ; const GAS f32x4* xr = (const GAS f32x4*)(x + (size_t)row * D) + lane; const GAS v2u* mr = (const GAS v2u*)(MIX + (size_t)row * D) + lane;
        const float rm = 1.0f / sqrtf(sumsq[row] * (1.f / D) + EPS);
        f32x4 v[4]; float s = 0.f;
#pragma unroll
        for (int j = 0; j < 4; ++j) { const int k = 4 * (lane + 64 * j); const f32x4 xv = xr[64 * j]; const v2u mw = mr[64 * j];
            const f32x4 gp = *(const GAS f32x4*)(gpost + k), g1 = *(const GAS f32x4*)(mod + b * 6144 + 2048 + k);
            const float mx[4] = {bflo(mw.x), bfhi(mw.x), bflo(mw.y), bfhi(mw.y)};
#pragma unroll
            for (int i = 0; i < 4; ++i) { v[j][i] = xv[i] + g1[i] * (mx[i] * rm * gp[i]); s += v[j][i] * v[j][i]; }
            *((GAS f32x4*)(out + (size_t)row * D) + lane + 64 * j) = v[j]; }
        const float rstd = 1.0f / sqrtf(wave_sum(s) * (1.f / D) + EPS);
        GAS v2u* o = (GAS v2u*)(H + (size_t)row * D) + lane;
#pragma unroll
        for (int j = 0; j < 4; ++j) { const int k = 4 * (lane + 64 * j);
            const f32x4 gg = *(const GAS f32x4*)(gpre + k), sh = *(const GAS f32x4*)(mod + b * 6144 + 3072 + k), sc = *(const GAS f32x4*)(mod + b * 6144 + 4096 + k);
            f32x4 y;
#pragma unroll
            for (int i = 0; i < 4; ++i) y[i] = v[j][i] * rstd * gg[i] * (1.f + sc[i]) + sh[i];
            v2u w; w.x = pk2(y[0], y[1]); w.y = pk2(y[2], y[3]); o[64 * j] = w; }
    }
}
__device__ __forceinline__ void load64bf(const bf16* p, float (&o)[64]) {
#pragma unroll
    for (int i = 0; i < 8; ++i) { const v4u w = *(const GAS v4u*)(p + 8 * i);
        o[8 * i + 0] = bflo(w.x); o[8 * i + 1] = bfhi(w.x); o[8 * i + 2] = bflo(w.y); o[8 * i + 3] = bfhi(w.y);
        o[8 * i + 4] = bflo(w.z); o[8 * i + 5] = bfhi(w.z); o[8 * i + 6] = bflo(w.w); o[8 * i + 7] = bfhi(w.w); }
}
__device__ __forceinline__ void phase_attn_naive(const Args& A, int vb, int nvb) {
    const bf16* P = (const bf16*)(A.ws + WS_PROJ); bf16* MI = (bf16*)(A.ws + WS_MIXIN); const float* sinks = (const float*)A.in[I_SINK];
    for (int task = vb * NTHR + (int)threadIdx.x; task < 8 * M; task += nvb * NTHR) {
        const int h = task / M, t = task % M, s = t % SEQ, kvh = h >> 2;
        float q[64], o[64];
        load64bf(P + (size_t)t * NPROJ + C_AQ + h * 64, q);
#pragma unroll
        for (int d = 0; d < 64; ++d) o[d] = 0.f;
        float mx = sinks[h], l = 1.f;
        for (int j = 0; j < 128; ++j) {
            const int sj = s - 127 + j; const bool valid = sj >= 0; const int tk = valid ? (t - 127 + j) : t;
            const bf16* kr = P + (size_t)tk * NPROJ + C_AK + kvh * 64; float sc = 0.f;
#pragma unroll
            for (int i = 0; i < 8; ++i) { const v4u w = *(const GAS v4u*)(kr + 8 * i);
                sc += q[8 * i + 0] * bflo(w.x) + q[8 * i + 1] * bfhi(w.x) + q[8 * i + 2] * bflo(w.y) + q[8 * i + 3] * bfhi(w.y)
                    + q[8 * i + 4] * bflo(w.z) + q[8 * i + 5] * bfhi(w.z) + q[8 * i + 6] * bflo(w.w) + q[8 * i + 7] * bfhi(w.w); }
            if (valid) {
                const float mn = fmaxf(mx, sc), al = __expf(mx - mn), p = __expf(sc - mn); mx = mn; l = l * al + p;
                const bf16* vr = P + (size_t)tk * NPROJ + C_AV + kvh * 64;
#pragma unroll
                for (int i = 0; i < 8; ++i) { const v4u w = *(const GAS v4u*)(vr + 8 * i);
                    o[8 * i + 0] = o[8 * i + 0] * al + p * bflo(w.x); o[8 * i + 1] = o[8 * i + 1] * al + p * bfhi(w.x);
                    o[8 * i + 2] = o[8 * i + 2] * al + p * bflo(w.y); o[8 * i + 3] = o[8 * i + 3] * al + p * bfhi(w.y);
                    o[8 * i + 4] = o[8 * i + 4] * al + p * bflo(w.z); o[8 * i + 5] = o[8 * i + 5] * al + p * bfhi(w.z);
                    o[8 * i + 6] = o[8 * i + 6] * al + p * bflo(w.w); o[8 * i + 7] = o[8 * i + 7] * al + p * bfhi(w.w); }
            }
        }
        const float il = 1.f / l; bf16* orow = MI + (size_t)t * D + h * 64;
#pragma unroll
        for (int i = 0; i < 8; ++i) { v4u w; w.x = pk2(o[8 * i] * il, o[8 * i + 1] * il); w.y = pk2(o[8 * i + 2] * il, o[8 * i + 3] * il);
            w.z = pk2(o[8 * i + 4] * il, o[8 * i + 5] * il); w.w = pk2(o[8 * i + 6] * il, o[8 * i + 7] * il); *(GAS v4u*)(orow + 8 * i) = w; }
    }
}

__device__ __forceinline__ void phase_mlstm_naive(const Args& A, LAS unsigned char* lds, int bh) {
    const int tid = threadIdx.x, lane = tid & 63, wave = tid >> 6, b = bh >> 2, h = bh & 3, dv = tid >> 2, part = tid & 3;
    const bf16* P = (const bf16*)(A.ws + WS_PROJ); bf16* MI = (bf16*)(A.ws + WS_MIXIN); const float* gates = (const float*)(A.ws + WS_GATES);
    const float* cw = (const float*)A.in[I_CONVW]; const float* ng = (const float*)A.in[I_MNG];
    LAS float* qs = (LAS float*)lds; LAS float* ks = qs + 64 * 64; LAS float* vs = ks + 64 * 64; LAS float* ig = vs + 64 * 128; LAS float* lfg = ig + 64; LAS float* hb = lfg + 64;
    float C[16], n[16]; float m = 0.f;
#pragma unroll
    for (int j = 0; j < 16; ++j) { C[j] = 0.f; n[j] = 0.f; }
    for (int ch = 0; ch < SEQ / 64; ++ch) {
        const int s0 = ch * 64; const size_t t0 = (size_t)b * SEQ + s0;
        for (int e = tid; e < 64 * 64; e += NTHR) { const int l = e >> 6, dk = e & 63; float aq = 0.f, ak = 0.f;
#pragma unroll
            for (int j = 0; j < 4; ++j) { const int sj = s0 + l - 3 + j; if (sj >= 0) { const bf16* r = P + ((size_t)b * SEQ + sj) * NPROJ;
                aq += cw[j * 512 + h * 64 + dk] * bf1(r[C_MQ + h * 64 + dk]); ak += cw[j * 512 + 256 + h * 64 + dk] * bf1(r[C_MK + h * 64 + dk]); } }
            qs[e] = 0.125f * aq / (1.f + __expf(-aq)); ks[e] = ak / (1.f + __expf(-ak)); }
        for (int e = tid; e < 64 * 128; e += NTHR) { const int l = e >> 7, d = e & 127; vs[e] = bf1(P[(t0 + l) * NPROJ + C_MV + h * 128 + d]); }
        if (tid < 64) { ig[tid] = gates[(t0 + tid) * 8 + h]; lfg[tid] = gates[(t0 + tid) * 8 + 4 + h]; }
        __syncthreads();
        for (int l = 0; l < 64; ++l) {
            const float lf = lfg[l], ii = ig[l], mn = fmaxf(lf + m, ii), fd = __expf(lf + m - mn), iw = __expf(ii - mn), vv = vs[l * 128 + dv] * iw;
            float num = 0.f, den = 0.f;
#pragma unroll
            for (int j = 0; j < 16; ++j) { const float kk = ks[l * 64 + part * 16 + j], qq = qs[l * 64 + part * 16 + j];
                C[j] = fd * C[j] + vv * kk; n[j] = fd * n[j] + iw * kk; num += C[j] * qq; den += n[j] * qq; }
            num += __shfl_xor(num, 1); num += __shfl_xor(num, 2); den += __shfl_xor(den, 1); den += __shfl_xor(den, 2);
            if (part == 0) hb[l * 128 + dv] = num / fmaxf(fabsf(den), __expf(-mn));
            m = mn;
        }
        __syncthreads();
        for (int l = wave * 8; l < wave * 8 + 8; ++l) { const float a0 = hb[l * 128 + lane], a1 = hb[l * 128 + 64 + lane];
            const float r = 1.0f / sqrtf(wave_sum(a0 * a0 + a1 * a1) * (1.f / 128.f) + EPS);
            const bf16* pr = P + (t0 + l) * NPROJ + C_MO + h * 128; bf16* orow = MI + (t0 + l) * D + 512 + h * 128;
            orow[lane] = (bf16)f2bf(a0 * r * ng[h * 128 + lane] * bf1(pr[lane])); orow[64 + lane] = (bf16)f2bf(a1 * r * ng[h * 128 + 64 + lane] * bf1(pr[64 + lane])); }
        __syncthreads();
    }
}

__device__ __forceinline__ void phase_topk_naive(const Args& A, LAS unsigned char* lds) {
    const int tid = threadIdx.x, lane = tid & 63, wave = tid >> 6, G = gridDim.x;
    const bf16* Q = (const bf16*)(A.ws + WS_PROJ); int* EI = (int*)(A.ws + WS_EIDX); float* GT = (float*)(A.ws + WS_GATE);
    LAS float* k1 = (LAS float*)lds; LAS float* k2 = k1 + 128 * 129;
    const float NEG = -3.0e38f;
    for (int unit = blockIdx.x; unit < 8 * (M / 256); unit += G) {
        const int h = unit % 8, tb = unit / 8;
        __syncthreads();
        const float* g1 = (const float*)A.in[I_K1] + (size_t)h * 128 * 128; const float* g2 = (const float*)A.in[I_K2] + (size_t)h * 128 * 128;
        for (int e = tid; e < 128 * 128; e += NTHR) { const int r = e >> 7, c = e & 127; k1[r * 129 + c] = g1[e]; k2[r * 129 + c] = g2[e]; }
        __syncthreads();
        for (int tt = 0; tt < 32; ++tt) {
            const int t = tb * 256 + wave * 32 + tt;
            const v2u qw = *(const GAS v2u*)(Q + (size_t)t * 2048 + h * 256 + 4 * lane);
            const float q0 = bflo(qw.x), q1 = bfhi(qw.x), q2 = bflo(qw.y), q3 = bfhi(qw.y);
            float a0 = 0.f, a1 = 0.f, c0 = 0.f, c1 = 0.f;
#pragma unroll 4
            for (int l2 = 0; l2 < 32; ++l2) {
                const float s0 = __shfl(q0, l2), s1 = __shfl(q1, l2), s2 = __shfl(q2, l2), s3 = __shfl(q3, l2);
                const float u0 = __shfl(q0, 32 + l2), u1 = __shfl(q1, 32 + l2), u2 = __shfl(q2, 32 + l2), u3 = __shfl(q3, 32 + l2);
                const int d = 4 * l2;
                a0 += s0 * k1[lane * 129 + d] + s1 * k1[lane * 129 + d + 1] + s2 * k1[lane * 129 + d + 2] + s3 * k1[lane * 129 + d + 3];
                a1 += s0 * k1[(lane + 64) * 129 + d] + s1 * k1[(lane + 64) * 129 + d + 1] + s2 * k1[(lane + 64) * 129 + d + 2] + s3 * k1[(lane + 64) * 129 + d + 3];
                c0 += u0 * k2[lane * 129 + d] + u1 * k2[lane * 129 + d + 1] + u2 * k2[lane * 129 + d + 2] + u3 * k2[lane * 129 + d + 3];
                c1 += u0 * k2[(lane + 64) * 129 + d] + u1 * k2[(lane + 64) * 129 + d + 1] + u2 * k2[(lane + 64) * 129 + d + 2] + u3 * k2[(lane + 64) * 129 + d + 3];
            }
            float v1 = NEG, v2 = NEG; int i1 = 0, i2 = 0;
            for (int r = 0; r < 16; ++r) {
                { const float cm = fmaxf(a0, a1), wm = wave_max(cm); const unsigned long long mk = __ballot(cm == wm); const int src = __ffsll((long long)mk) - 1;
                  const int mykey = (a0 == wm) ? lane : lane + 64; const int key = __shfl(mykey, src);
                  if (lane == src) { if (a0 == wm) a0 = NEG; else a1 = NEG; }
                  if (lane == r) { v1 = wm; i1 = key; } }
                { const float cm = fmaxf(c0, c1), wm = wave_max(cm); const unsigned long long mk = __ballot(cm == wm); const int src = __ffsll((long long)mk) - 1;
                  const int mykey = (c0 == wm) ? lane : lane + 64; const int key = __shfl(mykey, src);
                  if (lane == src) { if (c0 == wm) c0 = NEG; else c1 = NEG; }
                  if (lane == r) { v2 = wm; i2 = key; } }
            }
            const float va = __shfl(v1, lane >> 2); const int ia = __shfl(i1, lane >> 2);
            float cd[4]; int ce[4];
#pragma unroll
            for (int j = 0; j < 4; ++j) { cd[j] = va + __shfl(v2, 4 * (lane & 3) + j); ce[j] = ia * 128 + __shfl(i2, 4 * (lane & 3) + j); }
            float top = NEG; int te = 0;
            for (int r = 0; r < 16; ++r) {
                const float cm = fmaxf(fmaxf(cd[0], cd[1]), fmaxf(cd[2], cd[3])), wm = wave_max(cm); const unsigned long long mk = __ballot(cm == wm); const int src = __ffsll((long long)mk) - 1;
                int mye = ce[3]; asm volatile("" : "+v"(mye)); mye = (cd[2] == wm) ? ce[2] : mye; asm volatile("" : "+v"(mye)); mye = (cd[1] == wm) ? ce[1] : mye; asm volatile("" : "+v"(mye)); mye = (cd[0] == wm) ? ce[0] : mye;
                const int e = __shfl(mye, src);
                if (lane == src) { if (cd[0] == wm) cd[0] = NEG; else if (cd[1] == wm) cd[1] = NEG; else if (cd[2] == wm) cd[2] = NEG; else cd[3] = NEG; }
                if (lane == r) { top = wm; te = e; }
            }
            const float tmax = __shfl(top, 0); const float ex = (lane < 16) ? __expf(top - tmax) : 0.f; const float sum = wave_sum(ex);
            if (lane < 16) { EI[(size_t)t * NSLOT + h * 16 + lane] = te; GT[(size_t)t * NSLOT + h * 16 + lane] = ex / sum; }
        }
    }
}

__device__ __forceinline__ void ld16bf(const bf16* p, float (&o)[16]) {
    const v4u w0 = *(const GAS v4u*)p, w1 = *(const GAS v4u*)(p + 8);
    o[0] = bflo(w0.x); o[1] = bfhi(w0.x); o[2] = bflo(w0.y); o[3] = bfhi(w0.y); o[4] = bflo(w0.z); o[5] = bfhi(w0.z); o[6] = bflo(w0.w); o[7] = bfhi(w0.w);
    o[8] = bflo(w1.x); o[9] = bfhi(w1.x); o[10] = bflo(w1.y); o[11] = bfhi(w1.y); o[12] = bflo(w1.z); o[13] = bfhi(w1.z); o[14] = bflo(w1.w); o[15] = bfhi(w1.w);
}
__device__ __forceinline__ void phase_peer(const Args& A) {
    const int tid = threadIdx.x, lane = tid & 63, wave = tid >> 6, G = gridDim.x;
    const bf16* H = (const bf16*)(A.ws + WS_H); const bf16* U = (const bf16*)(A.ws + WS_U); const bf16* V = (const bf16*)(A.ws + WS_V);
    const int* EI = (const int*)(A.ws + WS_EIDX); const float* GT = (const float*)(A.ws + WS_GATE);
    const float* mod = (const float*)(A.ws + WS_MOD); const float* gpost = (const float*)A.in[I_GPOST2]; float* out = A.out;
    const int vidx = ((lane >> 5) & 1) * 8 + ((lane >> 4) & 1) * 4 + ((lane >> 3) & 1) * 2 + ((lane >> 2) & 1);
    for (int t = blockIdx.x * NWAVES + wave; t < M; t += G * NWAVES) {
        const int b = t / SEQ;
        float hv[16], y[16];
        ld16bf(H + (size_t)t * D + 16 * lane, hv);
#pragma unroll
        for (int i = 0; i < 16; ++i) y[i] = 0.f;
        const int e_lo = EI[(size_t)t * NSLOT + lane], e_hi = EI[(size_t)t * NSLOT + 64 + lane];
        for (int hd = 0; hd < 8; ++hd) {
            float p[16];
#pragma unroll
            for (int k = 0; k < 16; ++k) { const int s = hd * 16 + k; const int e = __shfl(s < 64 ? e_lo : e_hi, s & 63);
                float uu[16]; ld16bf(U + (size_t)e * D + 16 * lane, uu); float d = 0.f;
#pragma unroll
                for (int i = 0; i < 16; ++i) d += uu[i] * hv[i];
                p[k] = d; }
#pragma unroll
            for (int i = 0; i < 8; ++i) { const bool up = (lane & 32) != 0; const float keep = up ? p[i + 8] : p[i], send = up ? p[i] : p[i + 8]; p[i] = keep + __shfl_xor(send, 32); }
#pragma unroll
            for (int i = 0; i < 4; ++i) { const bool up = (lane & 16) != 0; const float keep = up ? p[i + 4] : p[i], send = up ? p[i] : p[i + 4]; p[i] = keep + __shfl_xor(send, 16); }
#pragma unroll
            for (int i = 0; i < 2; ++i) { const bool up = (lane & 8) != 0; const float keep = up ? p[i + 2] : p[i], send = up ? p[i] : p[i + 2]; p[i] = keep + __shfl_xor(send, 8); }
            { const bool up = (lane & 4) != 0; const float keep = up ? p[1] : p[0], send = up ? p[0] : p[1]; p[0] = keep + __shfl_xor(send, 4); }
            float dot = p[0]; dot += __shfl_xor(dot, 2); dot += __shfl_xor(dot, 1);
            const float gt = GT[(size_t)t * NSLOT + hd * 16 + vidx];
            const float act = 0.5f * dot * (1.f + erff(dot * 0.70710678118654752f)) * gt;
#pragma unroll
            for (int k = 0; k < 16; ++k) { const int s = hd * 16 + k; const int e = __shfl(s < 64 ? e_lo : e_hi, s & 63);
                const int src = ((k >> 3) & 1) * 32 + ((k >> 2) & 1) * 16 + ((k >> 1) & 1) * 8 + (k & 1) * 4;
                const float a = __shfl(act, src);
                float vv[16]; ld16bf(V + (size_t)e * D + 16 * lane, vv);
#pragma unroll
                for (int i = 0; i < 16; ++i) y[i] += a * vv[i]; }
        }
        float ss = 0.f;
#pragma unroll
        for (int i = 0; i < 16; ++i) ss += y[i] * y[i];
        const float rstd = 1.0f / sqrtf(wave_sum(ss) * (1.f / D) + EPS);
        float* orow = out + (size_t)t * D + 16 * lane; const float* g2 = mod + b * 6144 + 5120 + 16 * lane; const float* gp = gpost + 16 * lane;
#pragma unroll
        for (int i = 0; i < 4; ++i) { f32x4 xv = *(GAS f32x4*)(orow + 4 * i); const f32x4 gg = *(const GAS f32x4*)(g2 + 4 * i), pp = *(const GAS f32x4*)(gp + 4 * i);
#pragma unroll
            for (int j = 0; j < 4; ++j) xv[j] += gg[j] * (y[4 * i + j] * rstd * pp[j]);
            *(GAS f32x4*)(orow + 4 * i) = xv; }
    }
}
#ifndef MK_N_LAUNCHES
#define MK_N_LAUNCHES 9
#endif
constexpr int N_PHASES = 9;
__global__ void __launch_bounds__(NTHR, 2) hymba_fwd(Args A) {
    extern __shared__ __attribute__((aligned(16))) unsigned char lds_raw[];
    LAS unsigned char* lds = (LAS unsigned char*)lds_raw;
    const int lo = A.ph_lo, hi = A.ph_hi;
    unsigned char* ws = A.ws;
#define IN(k) (lo <= (k) && (k) < hi)
#define SEAM(k) do { if (IN(k) && IN((k) + 1)) { cg::this_grid().sync(); } } while (0)

    if (IN(0)) { phase_prologue(A, lds); } SEAM(0);
    if (IN(1)) { phase_prenorm(A); } SEAM(1);
    if (IN(2)) {
        pg8::Gemm g{(const pg8::bf16_t*)(ws + WS_H), (const pg8::bf16_t*)(ws + WS_WIN), M, NIN_PAD, D}; pg8::StaticOrder S; S.init(M, NIN_PAD, gridDim.x, (int)blockIdx.x);
        pg8::EpiProj E{(pg8::bf16_t*)(ws + WS_PROJ), NPROJ, (float*)(ws + WS_GATES), (const int*)A.in[I_POS], (const float*)A.in[I_BI], (const float*)A.in[I_BF]};
        pg8::gemm_phase<pg8::EpiProj, pg8::StaticOrder, true, true>(lds, g, S, E);
    } SEAM(2);
    if (IN(3)) {
        if (blockIdx.x < 32) phase_mlstm_naive(A, lds, (int)blockIdx.x);
        else phase_attn_naive(A, (int)blockIdx.x - 32, (int)gridDim.x - 32);
    } SEAM(3);
    if (IN(4)) {
        pg8::Gemm g{(const pg8::bf16_t*)(ws + WS_MIXIN), (const pg8::bf16_t*)(ws + WS_WOUT), M, D, D}; pg8::StaticOrder S; S.init(M, D, gridDim.x, (int)blockIdx.x);
        pg8::EpiMix E{(pg8::bf16_t*)(ws + WS_MIX), D, (float*)(ws + WS_CTL) + CW_SUMSQ};
        pg8::gemm_phase<pg8::EpiMix, pg8::StaticOrder, true, true>(lds, g, S, E);
    } SEAM(4);
    if (IN(5)) { phase_mid(A); } SEAM(5);
    if (IN(6)) {
        pg8::Gemm g{(const pg8::bf16_t*)(ws + WS_H), (const pg8::bf16_t*)(ws + WS_WQ), M, 2048, D}; pg8::StaticOrder S; S.init(M, 2048, gridDim.x, (int)blockIdx.x);
        pg8::EpiPlain E{(pg8::bf16_t*)(ws + WS_PROJ), 2048};
        pg8::gemm_phase<pg8::EpiPlain, pg8::StaticOrder, true, true>(lds, g, S, E);
    } SEAM(6);
    if (IN(7)) { phase_topk_naive(A, lds); } SEAM(7);
    if (IN(8)) { phase_peer(A); }
#undef IN
#undef SEAM
}

extern "C" void kernel_launch(void* const* d_in, const int* in_sizes, int n_in, void* d_out, int out_size, void* d_ws, size_t ws_size, hipStream_t stream) {
    static int grid = 0;
    if (grid == 0) {
        if (n_in != 21 || in_sizes[0] != M * D || out_size != M * D || ws_size < WS_END) { fprintf(stderr, "kernel_launch: unexpected shapes (n_in %d, in0 %d, out %d, ws %zu < %zu)\n", n_in, n_in > 0 ? in_sizes[0] : -1, out_size, ws_size, (size_t)WS_END); grid = -1; return; }
        int dev = 0, cus = 0, per_cu = 0;
        if (hipGetDevice(&dev) != hipSuccess || hipDeviceGetAttribute(&cus, hipDeviceAttributeMultiprocessorCount, dev) != hipSuccess) { grid = -1; return; }
        if (hipFuncSetAttribute((const void*)hymba_fwd, hipFuncAttributeMaxDynamicSharedMemorySize, LDS_BYTES) != hipSuccess) { fprintf(stderr, "kernel_launch: hipFuncSetAttribute failed\n"); grid = -1; return; }
        if (hipOccupancyMaxActiveBlocksPerMultiprocessor(&per_cu, (const void*)hymba_fwd, NTHR, LDS_BYTES) != hipSuccess || per_cu < 1) { fprintf(stderr, "kernel_launch: occupancy query says %d blocks per CU\n", per_cu); per_cu = 1; }
        (void)hipGetLastError();
        grid = cus;
        if (grid != 256) fprintf(stderr, "kernel_launch: note: %d CUs (built for 256)\n", grid);
    }
    if (grid < 0) return;
    (void)hipMemsetAsync((char*)d_ws + WS_CTL, 0, CTL_ZERO_BYTES, stream);
    Args a{};
    for (int i = 0; i < 21; ++i) a.in[i] = d_in[i];
    a.out = (float*)d_out; a.ws = (unsigned char*)d_ws;
    if (MK_N_LAUNCHES == 1) {
        a.ph_lo = 0; a.ph_hi = N_PHASES;
        void* args[] = {&a};
        const hipError_t e = hipLaunchCooperativeKernel((const void*)hymba_fwd, dim3(grid), dim3(NTHR), args, LDS_BYTES, stream);
        if (e != hipSuccess) fprintf(stderr, "kernel_launch: cooperative launch failed: %s (grid %d)\n", hipGetErrorString(e), grid);
    } else {
        for (int p = 0; p < N_PHASES; ++p) { a.ph_lo = p; a.ph_hi = p + 1; hipLaunchKernelGGL(hymba_fwd, dim3(grid), dim3(NTHR), LDS_BYTES, stream, a); }
    }
}
```

```cpp
#include <hip/hip_runtime.h>
#include <hip/hip_cooperative_groups.h>
#include <cstdio>
#include <cstdint>
namespace cg = cooperative_groups;
namespace pg8 {
#define PG8_LAS __attribute__((address_space(3)))
typedef unsigned short bf16_t;
typedef short bf16x8 __attribute__((ext_vector_type(8)));
typedef float f32x4 __attribute__((ext_vector_type(4)));
typedef unsigned u32x4 __attribute__((ext_vector_type(4)));
constexpr int BM = 256, BK = 64, HALF = 128, HTB = HALF * BK * 2  , STAGE_BYTES = 8 * HTB, NXCD = 8, WGM = 8;

__host__ __device__ __forceinline__ int lds_byte(int r, int c) { const int st = (r >> 4) * 2 + (c >> 5), rr = r & 15, cc = c & 31, ob = rr * 64 + cc * 2; return st * 1024 + (ob ^ (((ob >> 9) & 1) << 5)); }
__host__ __device__ __forceinline__ void stage_rc(int b, int& R, int& C) { const int st = b / 1024, sb = b % 1024, swz = sb ^ (((sb >> 9) & 1) << 5); R = (st >> 1) * 16 + swz / 64; C = (st & 1) * 32 + (swz % 64) / 2; }
__host__ __device__ __forceinline__ int perm32(int rho) { const int n = rho >> 4, i = rho & 15; return 8 * (i >> 2) + 4 * n + (i & 3); }

struct Unit { int pm, pn; };
struct Gemm { const bf16_t* A; const bf16_t* Bt; int M, N, K; };

struct StaticOrder {
    int nM, nN, nwg, G, c;
    __host__ __device__ void init(int M, int N, int G_, int c_) { nM = M / BM; nN = N / BM; nwg = nM * nN; G = G_; c = c_; }
    __host__ __device__ bool next(int i, Unit& u) const {
        const long L = (long)i * G + c; if (L >= nwg) return false;
        int wgid = (int)L; { const int q = nwg / NXCD, r = nwg % NXCD, xcd = wgid % NXCD, off = wgid / NXCD; wgid = (xcd < r ? xcd * (q + 1) : r * (q + 1) + (xcd - r) * q) + off; }
        const int nig = WGM * nN, gid = wgid / nig, fm = gid * WGM, gsz = (nM - fm) < WGM ? (nM - fm) : WGM;
        u.pm = fm + ((wgid % nig) % gsz); u.pn = (wgid % nig) / gsz; return true;
    }
    __device__ __forceinline__ void a_ready(const Unit&) const {}
    __device__ __forceinline__ void done(const Unit&) const {}
};

__device__ __forceinline__ unsigned cvt_pk_bf16(float lo, float hi) { unsigned r; asm volatile("v_cvt_pk_bf16_f32 %0, %1, %2" : "=v"(r) : "v"(lo), "v"(hi)); return r; }
typedef float f32x2 __attribute__((ext_vector_type(2)));
__device__ __forceinline__ f32x2 gelu_pk(f32x2 v) {
    const f32x2 av = __builtin_elementwise_abs(v), d = av * 0.2316418882f + 1.0f;
    f32x2 t; t.x = __builtin_amdgcn_rcpf(d.x); t.y = __builtin_amdgcn_rcpf(d.y);
    f32x2 q = t * 0.5307027145f + (-0.7265760135f); q = q * t + 0.7107068705f; q = q * t + (-0.142248368f); q = q * t + 0.127414796f; q = q * t;
    const f32x2 s = (v * v) * (-0.72134752044f);
    f32x2 e; e.x = __builtin_amdgcn_exp2f(s.x); e.y = __builtin_amdgcn_exp2f(s.y);
    const f32x2 m = v * (q * e), r = v - m;
    f32x2 o; o.x = v.x < 0.f ? m.x : r.x; o.y = v.y < 0.f ? m.y : r.y; return o;
}

__device__ __forceinline__ u32x4 pack8(const f32x4 v0, const f32x4 v1) { u32x4 w; w.x = cvt_pk_bf16(v0[0], v0[1]); w.y = cvt_pk_bf16(v0[2], v0[3]); w.z = cvt_pk_bf16(v1[0], v1[1]); w.w = cvt_pk_bf16(v1[2], v1[3]); return w; }

struct EpiPlain {
    static constexpr bool PERM = true, AFTER_DRAIN = false;
    bf16_t* O; int ldc;
    __device__ __forceinline__ void operator()(const f32x4 (&acc)[2][2][4][2], const Unit& u, int wr, int wc, int fr, int fq) const {
        const int row0 = u.pm * BM + wr * 64 + fr, col0 = u.pn * BM + wc * 32 + 8 * fq;
#pragma unroll
        for (int ai = 0; ai < 2; ++ai)
#pragma unroll
            for (int m = 0; m < 4; ++m) { bf16_t* rowp = O + (size_t)(row0 + ai * HALF + m * 16) * ldc + col0;
#pragma unroll
                for (int bj = 0; bj < 2; ++bj) *(u32x4*)(rowp + bj * HALF) = pack8(acc[ai][bj][m][0], acc[ai][bj][m][1]); }
    }
};

struct EpiProj {
    static constexpr bool PERM = true, AFTER_DRAIN = false;
    bf16_t* P; int ldc; float* gates; const int* pos; const float* b_i; const float* b_f;
    __device__ __forceinline__ void operator()(const f32x4 (&acc)[2][2][4][2], const Unit& u, int wr, int wc, int fr, int fq) const {
        const int row0 = u.pm * BM + wr * 64 + fr, col0 = u.pn * BM + wc * 32 + 8 * fq, pn = u.pn;
        if (pn == 9) {
            if (wc == 0 && fq == 0) {
                const f32x4 bi = {b_i[0], b_i[1], b_i[2], b_i[3]}, bf = {b_f[0], b_f[1], b_f[2], b_f[3]};
#pragma unroll
                for (int ai = 0; ai < 2; ++ai)
#pragma unroll
                    for (int m = 0; m < 4; ++m) { const int row = row0 + ai * HALF + m * 16;
                        const f32x4 iv = acc[ai][0][m][0] + bi, fv = acc[ai][0][m][1] + bf; f32x4 lf;
#pragma unroll
                        for (int j = 0; j < 4; ++j) lf[j] = fminf(fv[j], 0.f) - log1pf(__expf(-fabsf(fv[j])));
                        *(f32x4*)(gates + (size_t)row * 8) = iv; *(f32x4*)(gates + (size_t)row * 8 + 4) = lf; }
            }
            return;
        }
#pragma unroll
        for (int ai = 0; ai < 2; ++ai)
#pragma unroll
            for (int m = 0; m < 4; ++m) { const int row = row0 + ai * HALF + m * 16; bf16_t* rowp = P + (size_t)row * ldc + col0;
                const float posf = (pn <= 2) ? (float)pos[row] : 0.f;
#pragma unroll
                for (int bj = 0; bj < 2; ++bj) { f32x4 v0 = acc[ai][bj][m][0], v1 = acc[ai][bj][m][1];
                    const bool rope = (pn < 2) || (pn == 2 && bj == 0);
                    if (rope) {
                        const int p0 = ((col0 + bj * HALF) & 63) >> 1; const float sc = (pn < 2) ? 0.125f : 1.0f;
                        float x[8] = {v0[0], v0[1], v0[2], v0[3], v1[0], v1[1], v1[2], v1[3]};
#pragma unroll
                        for (int q = 0; q < 4; ++q) { const float invf = __builtin_amdgcn_exp2f(-(float)(p0 + q) * 0.41524101186092029f);
                            float r = posf * invf * 0.15915494309189535f; r = r - floorf(r);
                            const float c = __builtin_amdgcn_cosf(r) * sc, s = __builtin_amdgcn_sinf(r) * sc;
                            const float x1 = x[2 * q], x2 = x[2 * q + 1]; x[2 * q] = x1 * c - x2 * s; x[2 * q + 1] = x2 * c + x1 * s; }
                        v0 = (f32x4){x[0], x[1], x[2], x[3]}; v1 = (f32x4){x[4], x[5], x[6], x[7]};
                    } else if (pn >= 7) {
#pragma unroll
                        for (int j = 0; j < 4; ++j) { v0[j] = __builtin_amdgcn_rcpf(1.f + __expf(-v0[j])); v1[j] = __builtin_amdgcn_rcpf(1.f + __expf(-v1[j])); }
                    }
                    *(u32x4*)(rowp + bj * HALF) = pack8(v0, v1); } }
    }
};

struct EpiMix {
    static constexpr bool PERM = true, AFTER_DRAIN = false;
    bf16_t* O; int ldc; float* sumsq;
    __device__ __forceinline__ void operator()(const f32x4 (&acc)[2][2][4][2], const Unit& u, int wr, int wc, int fr, int fq) const {
        const int row0 = u.pm * BM + wr * 64 + fr, col0 = u.pn * BM + wc * 32 + 8 * fq;
#pragma unroll
        for (int ai = 0; ai < 2; ++ai)
#pragma unroll
            for (int m = 0; m < 4; ++m) { const int row = row0 + ai * HALF + m * 16; bf16_t* rowp = O + (size_t)row * ldc + col0; float s = 0.f;
#pragma unroll
                for (int bj = 0; bj < 2; ++bj) { const f32x4 v0 = acc[ai][bj][m][0], v1 = acc[ai][bj][m][1];
                    s += (v0[0] * v0[0] + v0[1] * v0[1]) + (v0[2] * v0[2] + v0[3] * v0[3]) + (v1[0] * v1[0] + v1[1] * v1[1]) + (v1[2] * v1[2] + v1[3] * v1[3]);
                    *(u32x4*)(rowp + bj * HALF) = pack8(v0, v1); }
                s += __shfl_xor(s, 16); s += __shfl_xor(s, 32);
                if (fq == 0) unsafeAtomicAdd(sumsq + row, s); }
    }
};
template <class Epi, class Sched, bool ALIGN_EPI = false, bool SP2 = false>
__device__ __forceinline__ void gemm_phase(PG8_LAS unsigned char* lds, const Gemm g, const Sched& S, const Epi& E) {
    const int tid = threadIdx.x, wid = __builtin_amdgcn_readfirstlane(tid >> 6), lane = tid & 63, wr = wid >> 2, wc = wid & 3, fr = lane & 15, fq = lane >> 4;
    const int K = g.K, nt = K / BK;
    unsigned voffA[2], voffB[2];
#pragma unroll
    for (int i = 0; i < 2; ++i) { int R, C; stage_rc(tid * 16 + i * 8192, R, C); const int Rb = Epi::PERM ? ((R & ~31) + perm32(R & 31)) : R;
        voffA[i] = (unsigned)(R * K + C) * 2u; voffB[i] = (unsigned)(Rb * K + C) * 2u; }
    const size_t kstep = (size_t)(BK * 2);
    const size_t hstep = (size_t)HALF * K * 2;
    const size_t tstep = 2 * hstep;
    const unsigned ldsw = (unsigned)wid * 1024u;
    const int aoff = lds_byte(wr * 64 + fr, fq * 8), boff = lds_byte(wc * 32 + fr, fq * 8);
#define PG8_SA(b, h) (((b) * 2 + (h)) * HTB)
#define PG8_SB(b, h) ((4 + (b) * 2 + (h)) * HTB)
#define PG8_STAGE(bufoff, gbase, voff) do { _Pragma("unroll") for (int _i = 0; _i < 2; ++_i) \
        __builtin_amdgcn_global_load_lds((const unsigned*)((const char*)(gbase) + (voff)[_i]), (PG8_LAS unsigned*)(lds + (bufoff) + ldsw + _i * 8192), 16, 0, 0); } while (0)
#define PG8_LDA(dst, b, h) do { _Pragma("unroll") for (int m = 0; m < 4; ++m) _Pragma("unroll") for (int k = 0; k < 2; ++k) dst[m][k] = *(const PG8_LAS bf16x8*)(lds + PG8_SA(b, h) + aoff + m * 2048 + k * 1024); } while (0)
#define PG8_LDB(dst, b, h) do { _Pragma("unroll") for (int n = 0; n < 2; ++n) _Pragma("unroll") for (int k = 0; k < 2; ++k) dst[n][k] = *(const PG8_LAS bf16x8*)(lds + PG8_SB(b, h) + boff + n * 2048 + k * 1024); } while (0)
#define PG8_MMA(ai, bj, At, Bt) do { __builtin_amdgcn_s_setprio(1); _Pragma("unroll") for (int m = 0; m < 4; ++m) _Pragma("unroll") for (int n = 0; n < 2; ++n) _Pragma("unroll") for (int k = 0; k < 2; ++k) \
        acc[ai][bj][m][n] = __builtin_amdgcn_mfma_f32_16x16x32_bf16(Bt[n][k], At[m][k], acc[ai][bj][m][n], 0, 0, 0); __builtin_amdgcn_s_setprio(0); } while (0)
#define PG8_WAIT_V(n) asm volatile("s_waitcnt vmcnt(" #n ")" ::: "memory")
#define PG8_WAIT_L(n) asm volatile("s_waitcnt lgkmcnt(" #n ")" ::: "memory")
#define PG8_BAR __builtin_amdgcn_s_barrier()
#define PG8_SCHED __builtin_amdgcn_sched_barrier(0)
    Unit cur, nxt; int ui = 0;
    if (!S.next(0, cur)) return;
    f32x4 acc[2][2][4][2];
#pragma unroll
    for (int a = 0; a < 2; ++a)
#pragma unroll
        for (int b = 0; b < 2; ++b)
#pragma unroll
            for (int m = 0; m < 4; ++m)
#pragma unroll
                for (int n = 0; n < 2; ++n) acc[a][b][m][n] = (f32x4){0.f, 0.f, 0.f, 0.f};
    bf16x8 At[4][2], B0[2][2], B1[2][2];
    const char* cA = (const char*)g.A + (size_t)cur.pm * tstep; const char* cB = (const char*)g.Bt + (size_t)cur.pn * tstep;
    S.a_ready(cur);
    if constexpr (SP2) {
        PG8_STAGE(PG8_SB(0, 0), cB, voffB); PG8_STAGE(PG8_SB(0, 1), cB + hstep, voffB); PG8_STAGE(PG8_SA(0, 0), cA, voffA); PG8_STAGE(PG8_SA(0, 1), cA + hstep, voffA);
        if (wr == 1) PG8_BAR;
        PG8_WAIT_V(2); PG8_BAR;
        PG8_STAGE(PG8_SB(1, 0), cB + kstep, voffB); PG8_STAGE(PG8_SA(1, 0), cA + kstep, voffA); PG8_STAGE(PG8_SB(1, 1), cB + hstep + kstep, voffB);
        PG8_WAIT_V(6); PG8_BAR;
    } else {
        PG8_STAGE(PG8_SB(0, 0), cB, voffB); PG8_STAGE(PG8_SA(0, 0), cA, voffA); PG8_STAGE(PG8_SB(0, 1), cB + hstep, voffB); PG8_STAGE(PG8_SA(0, 1), cA + hstep, voffA);
        if (wr == 1) PG8_BAR;
        PG8_WAIT_V(4); PG8_BAR;
        PG8_STAGE(PG8_SB(1, 0), cB + kstep, voffB); PG8_STAGE(PG8_SA(1, 0), cA + kstep, voffA); PG8_STAGE(PG8_SB(1, 1), cB + hstep + kstep, voffB);
        PG8_WAIT_V(6); PG8_BAR;
    }
    for (;;) {
        const bool has_next = S.next(ui + 1, nxt);
        const char* nA = has_next ? (const char*)g.A + (size_t)nxt.pm * tstep : cA; const char* nB = has_next ? (const char*)g.Bt + (size_t)nxt.pn * tstep : cB;
        for (int t = 0; t < nt; t += 2) {
            const bool last = (t == nt - 2);
            const char* a1 = cA + (size_t)(t + 1) * kstep;
            const char* a2 = last ? nA : cA + (size_t)(t + 2) * kstep; const char* b2 = last ? nB : cB + (size_t)(t + 2) * kstep;
            const char* a3 = a2 + kstep; const char* b3 = b2 + kstep;
            if (last && has_next) S.a_ready(nxt);
            if constexpr (SP2) {
            PG8_LDB(B0, 0, 0); PG8_LDB(B1, 0, 1); PG8_SCHED; PG8_LDA(At, 0, 0); PG8_STAGE(PG8_SA(1, 1), a1 + hstep, voffA);
            PG8_WAIT_V(8); PG8_WAIT_L(0); PG8_BAR; PG8_MMA(0, 0, At, B0); PG8_MMA(0, 1, At, B1); PG8_BAR; PG8_SCHED;
            PG8_LDA(At, 0, 1); PG8_STAGE(PG8_SB(0, 0), b2, voffB); PG8_STAGE(PG8_SB(0, 1), b2 + hstep, voffB); PG8_STAGE(PG8_SA(0, 0), a2, voffA);
            PG8_WAIT_V(8); PG8_WAIT_L(0); PG8_BAR; PG8_MMA(1, 0, At, B0); PG8_MMA(1, 1, At, B1); PG8_BAR; PG8_SCHED;
            PG8_LDB(B0, 1, 0); PG8_LDB(B1, 1, 1); PG8_SCHED; PG8_LDA(At, 1, 0); PG8_STAGE(PG8_SA(0, 1), a2 + hstep, voffA);
            PG8_WAIT_V(8); PG8_WAIT_L(0); PG8_BAR; PG8_MMA(0, 0, At, B0); PG8_MMA(0, 1, At, B1); PG8_BAR; PG8_SCHED;
            PG8_LDA(At, 1, 1); PG8_STAGE(PG8_SB(1, 0), b3, voffB); PG8_STAGE(PG8_SB(1, 1), b3 + hstep, voffB); PG8_STAGE(PG8_SA(1, 0), a3, voffA);
            PG8_WAIT_V(8); PG8_WAIT_L(0); PG8_BAR; PG8_MMA(1, 0, At, B0); PG8_MMA(1, 1, At, B1); PG8_BAR; PG8_SCHED;
            } else {
            PG8_LDB(B0, 0, 0); PG8_SCHED; PG8_LDA(At, 0, 0); PG8_STAGE(PG8_SA(1, 1), a1 + hstep, voffA);
            PG8_WAIT_L(8); PG8_BAR; PG8_WAIT_L(0); PG8_MMA(0, 0, At, B0); PG8_BAR; PG8_SCHED;
            PG8_LDB(B1, 0, 1); PG8_STAGE(PG8_SB(0, 0), b2, voffB);
            PG8_BAR; PG8_WAIT_L(0); PG8_MMA(0, 1, At, B1); PG8_BAR;
            PG8_LDA(At, 0, 1); PG8_STAGE(PG8_SA(0, 0), a2, voffA);
            PG8_BAR; PG8_WAIT_L(0); PG8_MMA(1, 0, At, B0); PG8_BAR; PG8_SCHED;
            PG8_STAGE(PG8_SB(0, 1), b2 + hstep, voffB);
            PG8_WAIT_V(6); PG8_BAR; PG8_MMA(1, 1, At, B1); PG8_BAR;
            PG8_LDB(B0, 1, 0); PG8_SCHED; PG8_LDA(At, 1, 0); PG8_STAGE(PG8_SA(0, 1), a2 + hstep, voffA);
            PG8_WAIT_L(8); PG8_BAR; PG8_WAIT_L(0); PG8_MMA(0, 0, At, B0); PG8_BAR; PG8_SCHED;
            PG8_LDB(B1, 1, 1); PG8_STAGE(PG8_SB(1, 0), b3, voffB);
            PG8_BAR; PG8_WAIT_L(0); PG8_MMA(0, 1, At, B1); PG8_BAR;
            PG8_LDA(At, 1, 1); PG8_STAGE(PG8_SA(1, 0), a3, voffA);
            PG8_BAR; PG8_WAIT_L(0); PG8_MMA(1, 0, At, B0); PG8_BAR; PG8_SCHED;
            PG8_STAGE(PG8_SB(1, 1), b3 + hstep, voffB);
            PG8_WAIT_V(6); PG8_BAR; PG8_MMA(1, 1, At, B1); PG8_BAR;
            }
        }
        if constexpr (ALIGN_EPI) { if (wr == 0) PG8_BAR; }
        if constexpr (!Epi::AFTER_DRAIN) { E(acc, cur, wr, wc, fr, fq); S.done(cur); }
        if (!has_next) break;
#pragma unroll
        for (int a = 0; a < 2; ++a)
#pragma unroll
            for (int b = 0; b < 2; ++b)
#pragma unroll
                for (int m = 0; m < 4; ++m)
#pragma unroll
                    for (int n = 0; n < 2; ++n) acc[a][b][m][n] = (f32x4){0.f, 0.f, 0.f, 0.f};
        cur = nxt; cA = nA; cB = nB; ++ui;
        if constexpr (ALIGN_EPI) { if (wr == 1) PG8_BAR; }
    }
    PG8_WAIT_V(0);
    if constexpr (!ALIGN_EPI) { if (wr == 0) PG8_BAR; }
    PG8_BAR;
    if constexpr (Epi::AFTER_DRAIN) { E.fused(acc, cur, wr, wc, fr, fq, lds, wid, lane); S.done(cur); }
#undef PG8_SA
#undef PG8_SB
#undef PG8_STAGE
#undef PG8_LDA
#undef PG8_LDB
#undef PG8_MMA
#undef PG8_WAIT_V
#undef PG8_WAIT_L
#undef PG8_BAR
#undef PG8_SCHED
}
}
constexpr int NB = 8, SEQ = 8192, D = 1024, M = NB * SEQ;
constexpr int DIN = 2312, NPROJ = 2304, NIN_PAD = 2560;
constexpr int C_AQ = 0, C_AK = 512, C_AV = 640, C_MQ = 768, C_MK = 1024, C_MV = 1280, C_MO = 1792;
constexpr int NEXP = 16384, NSLOT = 128;
constexpr float EPS = 1e-6f;
constexpr int NWAVES = 8, NTHR = 512;

constexpr size_t MiB = 1u << 20;
constexpr size_t WS_CTL = 0, CTL_ZERO_BYTES = 1 * MiB;
constexpr size_t WS_MOD = 1 * MiB;
constexpr size_t WS_WIN = 2 * MiB;
constexpr size_t WS_WOUT = 8 * MiB;
constexpr size_t WS_WQ = 10 * MiB;
constexpr size_t WS_KEYS = 14 * MiB;
constexpr size_t WS_GATES = 16 * MiB;
constexpr size_t WS_MST = 20 * MiB;
constexpr size_t WS_U = 32 * MiB, WS_V = 64 * MiB;
constexpr size_t WS_H = 96 * MiB;
constexpr size_t WS_PROJ = 224 * MiB;
constexpr size_t WS_MIXIN = 512 * MiB;
constexpr size_t WS_MIX = 640 * MiB;
constexpr size_t WS_EIDX = 768 * MiB, WS_GATE = 800 * MiB;
constexpr size_t WS_END = 832 * MiB;
constexpr int CW_BAR = 4096;
constexpr int CW_SUMSQ = 65536;
static_assert((CW_SUMSQ + M) * 4 <= (int)CTL_ZERO_BYTES, "ctl");

constexpr int RING_BYTES = 131072, MISC_OFF = RING_BYTES + 320, LDS_BYTES = 147456;

#define GAS __attribute__((address_space(1)))
#define LAS __attribute__((address_space(3)))
typedef unsigned short bf16;
typedef unsigned v4u __attribute__((ext_vector_type(4)));
typedef unsigned v2u __attribute__((ext_vector_type(2)));
typedef float f32x4 __attribute__((ext_vector_type(4)));
typedef GAS unsigned gu32;
#define LDS_WAIT() asm volatile("s_waitcnt lgkmcnt(0)" ::: "memory")
#define VM_WAIT() asm volatile("s_waitcnt vmcnt(0)" ::: "memory")
__device__ __forceinline__ unsigned f2bf(float f) { unsigned u = __builtin_bit_cast(unsigned, f); return (u + 0x7fffu + ((u >> 16) & 1u)) >> 16; }
__device__ __forceinline__ unsigned pk2(float lo, float hi) { return f2bf(lo) | (f2bf(hi) << 16); }
__device__ __forceinline__ float bflo(unsigned w) { return __builtin_bit_cast(float, w << 16); }
__device__ __forceinline__ float bfhi(unsigned w) { return __builtin_bit_cast(float, w & 0xffff0000u); }
__device__ __forceinline__ float bf1(bf16 h) { return __builtin_bit_cast(float, (unsigned)h << 16); }
__device__ __forceinline__ float wave_sum(float v) {
#pragma unroll
    for (int o = 1; o < 64; o <<= 1) v += __shfl_xor(v, o);
    return v;
}
__device__ __forceinline__ float wave_max(float v) {
#pragma unroll
    for (int o = 1; o < 64; o <<= 1) v = fmaxf(v, __shfl_xor(v, o));
    return v;
}
struct Args { const void* in[21]; float* out; unsigned char* ws; int ph_lo, ph_hi; };
enum { I_X = 0, I_C, I_POS, I_WMOD, I_BMOD, I_GPRE1, I_GPOST1, I_WIN, I_CONVW, I_BI, I_BF, I_MNG, I_SINK, I_WOUT, I_GPRE2, I_GPOST2, I_WQ, I_K1, I_K2, I_U, I_V };

__device__ __forceinline__ int newcol(int o) {
    if (o < 640) { const int hd = o >> 6, d = o & 63; return (hd << 6) + 2 * (d & 31) + (d >> 5); }
    if (o < 1792) return o;
    if (o < 1800) return 2304 + (o - 1792);
    return o - 8;
}
template <bool REMAP>
__device__ __forceinline__ void p0_transpose_item(const float* W, int K, int N, bf16* WT, LAS float* scr, int item, int lane) {
    const int nblk = (N + 31) / 32, kb = item / nblk, nb = item % nblk, k0 = 64 * kb, n0 = 32 * nb;
    const int ncol = n0 + (lane & 31);
#pragma unroll 8
    for (int i = 0; i < 32; ++i) { const int kk = 2 * i + (lane >> 5); scr[kk * 33 + (lane & 31)] = (ncol < N) ? W[(size_t)(k0 + kk) * N + ncol] : 0.f; }
    LDS_WAIT(); asm volatile("" ::: "memory");
    const int c = lane & 7;
#pragma unroll
    for (int j = 0; j < 4; ++j) { const int n = (lane >> 3) + 8 * j; const LAS float* s = scr + (8 * c) * 33 + n;
        v4u o; o.x = pk2(s[0 * 33], s[1 * 33]); o.y = pk2(s[2 * 33], s[3 * 33]); o.z = pk2(s[4 * 33], s[5 * 33]); o.w = pk2(s[6 * 33], s[7 * 33]);
        if (n0 + n < N) { const int drow = REMAP ? newcol(n0 + n) : (n0 + n); *(GAS v4u*)(WT + (size_t)drow * K + k0 + 8 * c) = o; } }
    LDS_WAIT(); asm volatile("" ::: "memory");
}
__device__ __forceinline__ void p0_convert(const float* src, bf16* dst, size_t n, int gt, int ngt) {
    for (size_t i = (size_t)gt * 8; i < n; i += (size_t)ngt * 8) {
        const f32x4 a = *(const GAS f32x4*)(src + i), b = *(const GAS f32x4*)(src + i + 4);
        v4u o; o.x = pk2(a[0], a[1]); o.y = pk2(a[2], a[3]); o.z = pk2(b[0], b[1]); o.w = pk2(b[2], b[3]);
        *(GAS v4u*)(dst + i) = o; }
}
__device__ __forceinline__ void phase_prologue(const Args& A, LAS unsigned char* lds) {
    const int tid = threadIdx.x, lane = tid & 63, wave = tid >> 6, G = gridDim.x, blk = blockIdx.x;
    unsigned char* ws = A.ws;
    {
        const float* c = (const float*)A.in[I_C]; const float* wm = (const float*)A.in[I_WMOD]; const float* bm = (const float*)A.in[I_BMOD];
        float* mod = (float*)(ws + WS_MOD); LAS float* red = (LAS float*)lds;
        for (int it = blk; it < 6144 / 32; it += G) {
            const int kg = tid >> 5, col = tid & 31, j = it * 32 + col; float acc[8];
#pragma unroll
            for (int b = 0; b < 8; ++b) acc[b] = 0.f;
            for (int i = 0; i < 64; ++i) { const int k = kg + 16 * i; const float w = wm[(size_t)k * 6144 + j];
#pragma unroll
                for (int b = 0; b < 8; ++b) acc[b] += c[b * 1024 + k] * w; }
#pragma unroll
            for (int b = 0; b < 8; ++b) red[(kg * 32 + col) * 8 + b] = acc[b];
            __syncthreads();
            if (tid < 256) { const int b = tid >> 5, cc = tid & 31; float s = 0.f;
#pragma unroll
                for (int g = 0; g < 16; ++g) s += red[(g * 32 + cc) * 8 + b];
                mod[b * 6144 + it * 32 + cc] = s + bm[it * 32 + cc]; }
            __syncthreads();
        }
    }
    {
        LAS float* scr = (LAS float*)(lds + wave * 16384);
        const int gw = blk * NWAVES + wave, NGW = G * NWAVES;
        const int I_IN = (D / 64) * ((DIN + 31) / 32), I_OUT = (D / 64) * (D / 32), I_Q = (D / 64) * (2048 / 32);
        bf16* win = (bf16*)(ws + WS_WIN); bf16* wout = (bf16*)(ws + WS_WOUT); bf16* wq = (bf16*)(ws + WS_WQ);
        for (int it = gw; it < I_IN + I_OUT + I_Q; it += NGW) {
            int r = it;
            if (r < I_IN) { p0_transpose_item<true>((const float*)A.in[I_WIN], D, DIN, win, scr, r, lane); continue; } r -= I_IN;
            if (r < I_OUT) { p0_transpose_item<false>((const float*)A.in[I_WOUT], D, D, wout, scr, r, lane); continue; } r -= I_OUT;
            p0_transpose_item<false>((const float*)A.in[I_WQ], D, 2048, wq, scr, r, lane);
        }
        const int gt = blk * NTHR + tid, ngt = G * NTHR;
        for (int i = gt; i < (NIN_PAD - DIN) * D / 8; i += ngt) *(GAS v4u*)(win + (size_t)DIN * D + (size_t)i * 8) = (v4u){0u, 0u, 0u, 0u};
        p0_convert((const float*)A.in[I_K1], (bf16*)(ws + WS_KEYS), (size_t)8 * 128 * 128, gt, ngt);
        p0_convert((const float*)A.in[I_K2], (bf16*)(ws + WS_KEYS) + 8 * 128 * 128, (size_t)8 * 128 * 128, gt, ngt);
        p0_convert((const float*)A.in[I_U], (bf16*)(ws + WS_U), (size_t)NEXP * D, gt, ngt);
        p0_convert((const float*)A.in[I_V], (bf16*)(ws + WS_V), (size_t)NEXP * D, gt, ngt);
    }
}

__device__ __forceinline__ void phase_prenorm(const Args& A) {
    const int tid = threadIdx.x, lane = tid & 63, wave = tid >> 6, G = gridDim.x;
    const float* x = (const float*)A.in[I_X]; const float* g = (const float*)A.in[I_GPRE1]; const float* mod = (const float*)(A.ws + WS_MOD);
    bf16* H = (bf16*)(A.ws + WS_H);
    for (int row = blockIdx.x * NWAVES + wave; row < M; row += G * NWAVES) {
        const int b = row / SEQ; const GAS f32x4* xr = (const GAS f32x4*)(x + (size_t)row * D) + lane;
        f32x4 v[4]; float s = 0.f;
#pragma unroll
        for (int j = 0; j < 4; ++j) { v[j] = xr[64 * j]; s += (v[j][0] * v[j][0] + v[j][1] * v[j][1]) + (v[j][2] * v[j][2] + v[j][3] * v[j][3]); }
        const float rstd = 1.0f / sqrtf(wave_sum(s) * (1.f / D) + EPS);
        GAS v2u* o = (GAS v2u*)(H + (size_t)row * D) + lane;
#pragma unroll
        for (int j = 0; j < 4; ++j) { const int k = 4 * (lane + 64 * j);
            const f32x4 gg = *(const GAS f32x4*)(g + k), sh = *(const GAS f32x4*)(mod + b * 6144 + k), sc = *(const GAS f32x4*)(mod + b * 6144 + 1024 + k);
            f32x4 y;
#pragma unroll
            for (int i = 0; i < 4; ++i) y[i] = v[j][i] * rstd * gg[i] * (1.f + sc[i]) + sh[i];
            v2u w; w.x = pk2(y[0], y[1]); w.y = pk2(y[2], y[3]); o[64 * j] = w; }
    }
}

__device__ __forceinline__ void phase_mid(const Args& A) {
    const int tid = threadIdx.x, lane = tid & 63, wave = tid >> 6, G = gridDim.x;
    const float* x = (const float*)A.in[I_X]; const float* gpost = (const float*)A.in[I_GPOST1]; const float* gpre = (const float*)A.in[I_GPRE2];
    const float* mod = (const float*)(A.ws + WS_MOD); const float* sumsq = (const float*)(A.ws + WS_CTL) + CW_SUMSQ;
    const bf16* MIX = (const bf16*)(A.ws + WS_MIX); bf16* H = (bf16*)(A.ws + WS_H); float* out = A.out;
    for (int row = blockIdx.x * NWAVES + wave; row < M; row += G * NWAVES) {
        const int b = row / SEQ; const GAS f32x4* xr = (const GAS f32x4*)(x + (size_t)row * D) + lane; const GAS v2u* mr = (const GAS v2u*)(MIX + (size_t)row * D) + lane;
        const float rm = 1.0f / sqrtf(sumsq[row] * (1.f / D) + EPS);
        f32x4 v[4]; float s = 0.f;
#pragma unroll
        for (int j = 0; j < 4; ++j) { const int k = 4 * (lane + 64 * j); const f32x4 xv = xr[64 * j]; const v2u mw = mr[64 * j];
            const f32x4 gp = *(const GAS f32x4*)(gpost + k), g1 = *(const GAS f32x4*)(mod + b * 6144 + 2048 + k);
            const float mx[4] = {bflo(mw.x), bfhi(mw.x), bflo(mw.y), bfhi(mw.y)};
#pragma unroll
            for (int i = 0; i < 4; ++i) { v[j][i] = xv[i] + g1[i] * (mx[i] * rm * gp[i]); s += v[j][i] * v[j][i]; }
            *((GAS f32x4*)(out + (size_t)row * D) + lane + 64 * j) = v[j]; }
        const float rstd = 1.0f / sqrtf(wave_sum(s) * (1.f / D) + EPS);
        GAS v2u* o = (GAS v2u*)(H + (size_t)row * D) + lane;
#pragma unroll
        for (int j = 0; j < 4; ++j) { const int k = 4 * (lane + 64 * j);
            const f32x4 gg = *(const GAS f32x4*)(gpre + k), sh = *(const GAS f32x4*)(mod + b * 6144 + 3072 + k), sc = *(const GAS f32x4*)(mod + b * 6144 + 4096 + k);
            f32x4 y;
#pragma unroll
            for (int i = 0; i < 4; ++i) y[i] = v[j][i] * rstd * gg[i] * (1.f + sc[i]) + sh[i];
            v2u w; w.x = pk2(y[0], y[1]); w.y = pk2(y[2], y[3]); o[64 * j] = w; }
    }
}
__device__ __forceinline__ void load64bf(const bf16* p, float (&o)[64]) {
#pragma unroll
    for (int i = 0; i < 8; ++i) { const v4u w = *(const GAS v4u*)(p + 8 * i);
        o[8 * i + 0] = bflo(w.x); o[8 * i + 1] = bfhi(w.x); o[8 * i + 2] = bflo(w.y); o[8 * i + 3] = bfhi(w.y);
        o[8 * i + 4] = bflo(w.z); o[8 * i + 5] = bfhi(w.z); o[8 * i + 6] = bflo(w.w); o[8 * i + 7] = bfhi(w.w); }
}
__device__ __forceinline__ void phase_attn_naive(const Args& A, int vb, int nvb) {
    const bf16* P = (const bf16*)(A.ws + WS_PROJ); bf16* MI = (bf16*)(A.ws + WS_MIXIN); const float* sinks = (const float*)A.in[I_SINK];
    for (int task = vb * NTHR + (int)threadIdx.x; task < 8 * M; task += nvb * NTHR) {
        const int h = task / M, t = task % M, s = t % SEQ, kvh = h >> 2;
        float q[64], o[64];
        load64bf(P + (size_t)t * NPROJ + C_AQ + h * 64, q);
#pragma unroll
        for (int d = 0; d < 64; ++d) o[d] = 0.f;
        float mx = sinks[h], l = 1.f;
        for (int j = 0; j < 128; ++j) {
            const int sj = s - 127 + j; const bool valid = sj >= 0; const int tk = valid ? (t - 127 + j) : t;
            const bf16* kr = P + (size_t)tk * NPROJ + C_AK + kvh * 64; float sc = 0.f;
#pragma unroll
            for (int i = 0; i < 8; ++i) { const v4u w = *(const GAS v4u*)(kr + 8 * i);
                sc += q[8 * i + 0] * bflo(w.x) + q[8 * i + 1] * bfhi(w.x) + q[8 * i + 2] * bflo(w.y) + q[8 * i + 3] * bfhi(w.y)
                    + q[8 * i + 4] * bflo(w.z) + q[8 * i + 5] * bfhi(w.z) + q[8 * i + 6] * bflo(w.w) + q[8 * i + 7] * bfhi(w.w); }
            if (valid) {
                const float mn = fmaxf(mx, sc), al = __expf(mx - mn), p = __expf(sc - mn); mx = mn; l = l * al + p;
                const bf16* vr = P + (size_t)tk * NPROJ + C_AV + kvh * 64;
#pragma unroll
                for (int i = 0; i < 8; ++i) { const v4u w = *(const GAS v4u*)(vr + 8 * i);
                    o[8 * i + 0] = o[8 * i + 0] * al + p * bflo(w.x); o[8 * i + 1] = o[8 * i + 1] * al + p * bfhi(w.x);
                    o[8 * i + 2] = o[8 * i + 2] * al + p * bflo(w.y); o[8 * i + 3] = o[8 * i + 3] * al + p * bfhi(w.y);
                    o[8 * i + 4] = o[8 * i + 4] * al + p * bflo(w.z); o[8 * i + 5] = o[8 * i + 5] * al + p * bfhi(w.z);
                    o[8 * i + 6] = o[8 * i + 6] * al + p * bflo(w.w); o[8 * i + 7] = o[8 * i + 7] * al + p * bfhi(w.w); }
            }
        }
        const float il = 1.f / l; bf16* orow = MI + (size_t)t * D + h * 64;
#pragma unroll
        for (int i = 0; i < 8; ++i) { v4u w; w.x = pk2(o[8 * i] * il, o[8 * i + 1] * il); w.y = pk2(o[8 * i + 2] * il, o[8 * i + 3] * il);
            w.z = pk2(o[8 * i + 4] * il, o[8 * i + 5] * il); w.w = pk2(o[8 * i + 6] * il, o[8 * i + 7] * il); *(GAS v4u*)(orow + 8 * i) = w; }
    }
}

__device__ __forceinline__ void phase_mlstm_naive(const Args& A, LAS unsigned char* lds, int bh) {
    const int tid = threadIdx.x, lane = tid & 63, wave = tid >> 6, b = bh >> 2, h = bh & 3, dv = tid >> 2, part = tid & 3;
    const bf16* P = (const bf16*)(A.ws + WS_PROJ); bf16* MI = (bf16*)(A.ws + WS_MIXIN); const float* gates = (const float*)(A.ws + WS_GATES);
    const float* cw = (const float*)A.in[I_CONVW]; const float* ng = (const float*)A.in[I_MNG];
    LAS float* qs = (LAS float*)lds; LAS float* ks = qs + 64 * 64; LAS float* vs = ks + 64 * 64; LAS float* ig = vs + 64 * 128; LAS float* lfg = ig + 64; LAS float* hb = lfg + 64;
    float C[16], n[16]; float m = 0.f;
#pragma unroll
    for (int j = 0; j < 16; ++j) { C[j] = 0.f; n[j] = 0.f; }
    for (int ch = 0; ch < SEQ / 64; ++ch) {
        const int s0 = ch * 64; const size_t t0 = (size_t)b * SEQ + s0;
        for (int e = tid; e < 64 * 64; e += NTHR) { const int l = e >> 6, dk = e & 63; float aq = 0.f, ak = 0.f;
#pragma unroll
            for (int j = 0; j < 4; ++j) { const int sj = s0 + l - 3 + j; if (sj >= 0) { const bf16* r = P + ((size_t)b * SEQ + sj) * NPROJ;
                aq += cw[j * 512 + h * 64 + dk] * bf1(r[C_MQ + h * 64 + dk]); ak += cw[j * 512 + 256 + h * 64 + dk] * bf1(r[C_MK + h * 64 + dk]); } }
            qs[e] = 0.125f * aq / (1.f + __expf(-aq)); ks[e] = ak / (1.f + __expf(-ak)); }
        for (int e = tid; e < 64 * 128; e += NTHR) { const int l = e >> 7, d = e & 127; vs[e] = bf1(P[(t0 + l) * NPROJ + C_MV + h * 128 + d]); }
        if (tid < 64) { ig[tid] = gates[(t0 + tid) * 8 + h]; lfg[tid] = gates[(t0 + tid) * 8 + 4 + h]; }
        __syncthreads();
        for (int l = 0; l < 64; ++l) {
            const float lf = lfg[l], ii = ig[l], mn = fmaxf(lf + m, ii), fd = __expf(lf + m - mn), iw = __expf(ii - mn), vv = vs[l * 128 + dv] * iw;
            float num = 0.f, den = 0.f;
#pragma unroll
            for (int j = 0; j < 16; ++j) { const float kk = ks[l * 64 + part * 16 + j], qq = qs[l * 64 + part * 16 + j];
                C[j] = fd * C[j] + vv * kk; n[j] = fd * n[j] + iw * kk; num += C[j] * qq; den += n[j] * qq; }
            num += __shfl_xor(num, 1); num += __shfl_xor(num, 2); den += __shfl_xor(den, 1); den += __shfl_xor(den, 2);
            if (part == 0) hb[l * 128 + dv] = num / fmaxf(fabsf(den), __expf(-mn));
            m = mn;
        }
        __syncthreads();
        for (int l = wave * 8; l < wave * 8 + 8; ++l) { const float a0 = hb[l * 128 + lane], a1 = hb[l * 128 + 64 + lane];
            const float r = 1.0f / sqrtf(wave_sum(a0 * a0 + a1 * a1) * (1.f / 128.f) + EPS);
            const bf16* pr = P + (t0 + l) * NPROJ + C_MO + h * 128; bf16* orow = MI + (t0 + l) * D + 512 + h * 128;
            orow[lane] = (bf16)f2bf(a0 * r * ng[h * 128 + lane] * bf1(pr[lane])); orow[64 + lane] = (bf16)f2bf(a1 * r * ng[h * 128 + 64 + lane] * bf1(pr[64 + lane])); }
        __syncthreads();
    }
}

__device__ __forceinline__ void phase_topk_naive(const Args& A, LAS unsigned char* lds) {
    const int tid = threadIdx.x, lane = tid & 63, wave = tid >> 6, G = gridDim.x;
    const bf16* Q = (const bf16*)(A.ws + WS_PROJ); int* EI = (int*)(A.ws + WS_EIDX); float* GT = (float*)(A.ws + WS_GATE);
    LAS float* k1 = (LAS float*)lds; LAS float* k2 = k1 + 128 * 129;
    const float NEG = -3.0e38f;
    for (int unit = blockIdx.x; unit < 8 * (M / 256); unit += G) {
        const int h = unit % 8, tb = unit / 8;
        __syncthreads();
        const float* g1 = (const float*)A.in[I_K1] + (size_t)h * 128 * 128; const float* g2 = (const float*)A.in[I_K2] + (size_t)h * 128 * 128;
        for (int e = tid; e < 128 * 128; e += NTHR) { const int r = e >> 7, c = e & 127; k1[r * 129 + c] = g1[e]; k2[r * 129 + c] = g2[e]; }
        __syncthreads();
        for (int tt = 0; tt < 32; ++tt) {
            const int t = tb * 256 + wave * 32 + tt;
            const v2u qw = *(const GAS v2u*)(Q + (size_t)t * 2048 + h * 256 + 4 * lane);
            const float q0 = bflo(qw.x), q1 = bfhi(qw.x), q2 = bflo(qw.y), q3 = bfhi(qw.y);
            float a0 = 0.f, a1 = 0.f, c0 = 0.f, c1 = 0.f;
#pragma unroll 4
            for (int l2 = 0; l2 < 32; ++l2) {
                const float s0 = __shfl(q0, l2), s1 = __shfl(q1, l2), s2 = __shfl(q2, l2), s3 = __shfl(q3, l2);
                const float u0 = __shfl(q0, 32 + l2), u1 = __shfl(q1, 32 + l2), u2 = __shfl(q2, 32 + l2), u3 = __shfl(q3, 32 + l2);
                const int d = 4 * l2;
                a0 += s0 * k1[lane * 129 + d] + s1 * k1[lane * 129 + d + 1] + s2 * k1[lane * 129 + d + 2] + s3 * k1[lane * 129 + d + 3];
                a1 += s0 * k1[(lane + 64) * 129 + d] + s1 * k1[(lane + 64) * 129 + d + 1] + s2 * k1[(lane + 64) * 129 + d + 2] + s3 * k1[(lane + 64) * 129 + d + 3];
                c0 += u0 * k2[lane * 129 + d] + u1 * k2[lane * 129 + d + 1] + u2 * k2[lane * 129 + d + 2] + u3 * k2[lane * 129 + d + 3];
                c1 += u0 * k2[(lane + 64) * 129 + d] + u1 * k2[(lane + 64) * 129 + d + 1] + u2 * k2[(lane + 64) * 129 + d + 2] + u3 * k2[(lane + 64) * 129 + d + 3];
            }
            float v1 = NEG, v2 = NEG; int i1 = 0, i2 = 0;
            for (int r = 0; r < 16; ++r) {
                { const float cm = fmaxf(a0, a1), wm = wave_max(cm); const unsigned long long mk = __ballot(cm == wm); const int src = __ffsll((long long)mk) - 1;
                  const int mykey = (a0 == wm) ? lane : lane + 64; const int key = __shfl(mykey, src);
                  if (lane == src) { if (a0 == wm) a0 = NEG; else a1 = NEG; }
                  if (lane == r) { v1 = wm; i1 = key; } }
                { const float cm = fmaxf(c0, c1), wm = wave_max(cm); const unsigned long long mk = __ballot(cm == wm); const int src = __ffsll((long long)mk) - 1;
                  const int mykey = (c0 == wm) ? lane : lane + 64; const int key = __shfl(mykey, src);
                  if (lane == src) { if (c0 == wm) c0 = NEG; else c1 = NEG; }
                  if (lane == r) { v2 = wm; i2 = key; } }
            }
            const float va = __shfl(v1, lane >> 2); const int ia = __shfl(i1, lane >> 2);
            float cd[4]; int ce[4];
#pragma unroll
            for (int j = 0; j < 4; ++j) { cd[j] = va + __shfl(v2, 4 * (lane & 3) + j); ce[j] = ia * 128 + __shfl(i2, 4 * (lane & 3) + j); }
            float top = NEG; int te = 0;
            for (int r = 0; r < 16; ++r) {
                const float cm = fmaxf(fmaxf(cd[0], cd[1]), fmaxf(cd[2], cd[3])), wm = wave_max(cm); const unsigned long long mk = __ballot(cm == wm); const int src = __ffsll((long long)mk) - 1;
                int mye = ce[3]; asm volatile("" : "+v"(mye)); mye = (cd[2] == wm) ? ce[2] : mye; asm volatile("" : "+v"(mye)); mye = (cd[1] == wm) ? ce[1] : mye; asm volatile("" : "+v"(mye)); mye = (cd[0] == wm) ? ce[0] : mye;
                const int e = __shfl(mye, src);
                if (lane == src) { if (cd[0] == wm) cd[0] = NEG; else if (cd[1] == wm) cd[1] = NEG; else if (cd[2] == wm) cd[2] = NEG; else cd[3] = NEG; }
                if (lane == r) { top = wm; te = e; }
            }
            const float tmax = __shfl(top, 0); const float ex = (lane < 16) ? __expf(top - tmax) : 0.f; const float sum = wave_sum(ex);
            if (lane < 16) { EI[(size_t)t * NSLOT + h * 16 + lane] = te; GT[(size_t)t * NSLOT + h * 16 + lane] = ex / sum; }
        }
    }
}

__device__ __forceinline__ void ld16bf(const bf16* p, float (&o)[16]) {
    const v4u w0 = *(const GAS v4u*)p, w1 = *(const GAS v4u*)(p + 8);
    o[0] = bflo(w0.x); o[1] = bfhi(w0.x); o[2] = bflo(w0.y); o[3] = bfhi(w0.y); o[4] = bflo(w0.z); o[5] = bfhi(w0.z); o[6] = bflo(w0.w); o[7] = bfhi(w0.w);
    o[8] = bflo(w1.x); o[9] = bfhi(w1.x); o[10] = bflo(w1.y); o[11] = bfhi(w1.y); o[12] = bflo(w1.z); o[13] = bfhi(w1.z); o[14] = bflo(w1.w); o[15] = bfhi(w1.w);
}
__device__ __forceinline__ void phase_peer(const Args& A) {
    const int tid = threadIdx.x, lane = tid & 63, wave = tid >> 6, G = gridDim.x;
    const bf16* H = (const bf16*)(A.ws + WS_H); const bf16* U = (const bf16*)(A.ws + WS_U); const bf16* V = (const bf16*)(A.ws + WS_V);
    const int* EI = (const int*)(A.ws + WS_EIDX); const float* GT = (const float*)(A.ws + WS_GATE);
    const float* mod = (const float*)(A.ws + WS_MOD); const float* gpost = (const float*)A.in[I_GPOST2]; float* out = A.out;
    const int vidx = ((lane >> 5) & 1) * 8 + ((lane >> 4) & 1) * 4 + ((lane >> 3) & 1) * 2 + ((lane >> 2) & 1);
    for (int t = blockIdx.x * NWAVES + wave; t < M; t += G * NWAVES) {
        const int b = t / SEQ;
        float hv[16], y[16];
        ld16bf(H + (size_t)t * D + 16 * lane, hv);
#pragma unroll
        for (int i = 0; i < 16; ++i) y[i] = 0.f;
        const int e_lo = EI[(size_t)t * NSLOT + lane], e_hi = EI[(size_t)t * NSLOT + 64 + lane];
        for (int hd = 0; hd < 8; ++hd) {
            float p[16];
#pragma unroll
            for (int k = 0; k < 16; ++k) { const int s = hd * 16 + k; const int e = __shfl(s < 64 ? e_lo : e_hi, s & 63);
                float uu[16]; ld16bf(U + (size_t)e * D + 16 * lane, uu); float d = 0.f;
#pragma unroll
                for (int i = 0; i < 16; ++i) d += uu[i] * hv[i];
                p[k] = d; }
#pragma unroll
            for (int i = 0; i < 8; ++i) { const bool up = (lane & 32) != 0; const float keep = up ? p[i + 8] : p[i], send = up ? p[i] : p[i + 8]; p[i] = keep + __shfl_xor(send, 32); }
#pragma unroll
            for (int i = 0; i < 4; ++i) { const bool up = (lane & 16) != 0; const float keep = up ? p[i + 4] : p[i], send = up ? p[i] : p[i + 4]; p[i] = keep + __shfl_xor(send, 16); }
#pragma unroll
            for (int i = 0; i < 2; ++i) { const bool up = (lane & 8) != 0; const float keep = up ? p[i + 2] : p[i], send = up ? p[i] : p[i + 2]; p[i] = keep + __shfl_xor(send, 8); }
            { const bool up = (lane & 4) != 0; const float keep = up ? p[1] : p[0], send = up ? p[0] : p[1]; p[0] = keep + __shfl_xor(send, 4); }
            float dot = p[0]; dot += __shfl_xor(dot, 2); dot += __shfl_xor(dot, 1);
            const float gt = GT[(size_t)t * NSLOT + hd * 16 + vidx];
            const float act = 0.5f * dot * (1.f + erff(dot * 0.70710678118654752f)) * gt;
#pragma unroll
            for (int k = 0; k < 16; ++k) { const int s = hd * 16 + k; const int e = __shfl(s < 64 ? e_lo : e_hi, s & 63);
                const int src = ((k >> 3) & 1) * 32 + ((k >> 2) & 1) * 16 + ((k >> 1) & 1) * 8 + (k & 1) * 4;
                const float a = __shfl(act, src);
                float vv[16]; ld16bf(V + (size_t)e * D + 16 * lane, vv);
#pragma unroll
                for (int i = 0; i < 16; ++i) y[i] += a * vv[i]; }
        }
        float ss = 0.f;
#pragma unroll
        for (int i = 0; i < 16; ++i) ss += y[i] * y[i];
        const float rstd = 1.0f / sqrtf(wave_sum(ss) * (1.f / D) + EPS);
        float* orow = out + (size_t)t * D + 16 * lane; const float* g2 = mod + b * 6144 + 5120 + 16 * lane; const float* gp = gpost + 16 * lane;
#pragma unroll
        for (int i = 0; i < 4; ++i) { f32x4 xv = *(GAS f32x4*)(orow + 4 * i); const f32x4 gg = *(const GAS f32x4*)(g2 + 4 * i), pp = *(const GAS f32x4*)(gp + 4 * i);
#pragma unroll
            for (int j = 0; j < 4; ++j) xv[j] += gg[j] * (y[4 * i + j] * rstd * pp[j]);
            *(GAS f32x4*)(orow + 4 * i) = xv; }
    }
}
#ifndef MK_N_LAUNCHES
#define MK_N_LAUNCHES 1
#endif
constexpr int N_PHASES = 9;
__global__ void __launch_bounds__(NTHR, 2) hymba_fwd(Args A) {
    extern __shared__ __attribute__((aligned(16))) unsigned char lds_raw[];
    LAS unsigned char* lds = (LAS unsigned char*)lds_raw;
    const int lo = A.ph_lo, hi = A.ph_hi;
    unsigned char* ws = A.ws;
#define IN(k) (lo <= (k) && (k) < hi)
#define SEAM(k) do { if (IN(k) && IN((k) + 1)) { cg::this_grid().sync(); } } while (0)

    if (IN(0)) { phase_prologue(A, lds); } SEAM(0);
    if (IN(1)) { phase_prenorm(A); } SEAM(1);
    if (IN(2)) {
        pg8::Gemm g{(const pg8::bf16_t*)(ws + WS_H), (const pg8::bf16_t*)(ws + WS_WIN), M, NIN_PAD, D}; pg8::StaticOrder S; S.init(M, NIN_PAD, gridDim.x, (int)blockIdx.x);
        pg8::EpiProj E{(pg8::bf16_t*)(ws + WS_PROJ), NPROJ, (float*)(ws + WS_GATES), (const int*)A.in[I_POS], (const float*)A.in[I_BI], (const float*)A.in[I_BF]};
        pg8::gemm_phase<pg8::EpiProj, pg8::StaticOrder, true, true>(lds, g, S, E);
    } SEAM(2);
    if (IN(3)) {
        if (blockIdx.x < 32) phase_mlstm_naive(A, lds, (int)blockIdx.x);
        else phase_attn_naive(A, (int)blockIdx.x - 32, (int)gridDim.x - 32);
    } SEAM(3);
    if (IN(4)) {
        pg8::Gemm g{(const pg8::bf16_t*)(ws + WS_MIXIN), (const pg8::bf16_t*)(ws + WS_WOUT), M, D, D}; pg8::StaticOrder S; S.init(M, D, gridDim.x, (int)blockIdx.x);
        pg8::EpiMix E{(pg8::bf16_t*)(ws + WS_MIX), D, (float*)(ws + WS_CTL) + CW_SUMSQ};
        pg8::gemm_phase<pg8::EpiMix, pg8::StaticOrder, true, true>(lds, g, S, E);
    } SEAM(4);
    if (IN(5)) { phase_mid(A); } SEAM(5);
    if (IN(6)) {
        pg8::Gemm g{(const pg8::bf16_t*)(ws + WS_H), (const pg8::bf16_t*)(ws + WS_WQ), M, 2048, D}; pg8::StaticOrder S; S.init(M, 2048, gridDim.x, (int)blockIdx.x);
        pg8::EpiPlain E{(pg8::bf16_t*)(ws + WS_PROJ), 2048};
        pg8::gemm_phase<pg8::EpiPlain, pg8::StaticOrder, true, true>(lds, g, S, E);
    } SEAM(6);
    if (IN(7)) { phase_topk_naive(A, lds); } SEAM(7);
    if (IN(8)) { phase_peer(A); }
#undef IN
#undef SEAM
}

extern "C" void kernel_launch(void* const* d_in, const int* in_sizes, int n_in, void* d_out, int out_size, void* d_ws, size_t ws_size, hipStream_t stream) {
    static int grid = 0;
    if (grid == 0) {
        if (n_in != 21 || in_sizes[0] != M * D || out_size != M * D || ws_size < WS_END) { fprintf(stderr, "kernel_launch: unexpected shapes (n_in %d, in0 %d, out %d, ws %zu < %zu)\n", n_in, n_in > 0 ? in_sizes[0] : -1, out_size, ws_size, (size_t)WS_END); grid = -1; return; }
        int dev = 0, cus = 0, per_cu = 0;
        if (hipGetDevice(&dev) != hipSuccess || hipDeviceGetAttribute(&cus, hipDeviceAttributeMultiprocessorCount, dev) != hipSuccess) { grid = -1; return; }
        if (hipFuncSetAttribute((const void*)hymba_fwd, hipFuncAttributeMaxDynamicSharedMemorySize, LDS_BYTES) != hipSuccess) { fprintf(stderr, "kernel_launch: hipFuncSetAttribute failed\n"); grid = -1; return; }
        if (hipOccupancyMaxActiveBlocksPerMultiprocessor(&per_cu, (const void*)hymba_fwd, NTHR, LDS_BYTES) != hipSuccess || per_cu < 1) { fprintf(stderr, "kernel_launch: occupancy query says %d blocks per CU\n", per_cu); per_cu = 1; }
        (void)hipGetLastError();
        grid = cus;
        if (grid != 256) fprintf(stderr, "kernel_launch: note: %d CUs (built for 256)\n", grid);
    }
    if (grid < 0) return;
    (void)hipMemsetAsync((char*)d_ws + WS_CTL, 0, CTL_ZERO_BYTES, stream);
    Args a{};
    for (int i = 0; i < 21; ++i) a.in[i] = d_in[i];
    a.out = (float*)d_out; a.ws = (unsigned char*)d_ws;
    if (MK_N_LAUNCHES == 1) {
        a.ph_lo = 0; a.ph_hi = N_PHASES;
        void* args[] = {&a};
        const hipError_t e = hipLaunchCooperativeKernel((const void*)hymba_fwd, dim3(grid), dim3(NTHR), args, LDS_BYTES, stream);
        if (e != hipSuccess) fprintf(stderr, "kernel_launch: cooperative launch failed: %s (grid %d)\n", hipGetErrorString(e), grid);
    } else {
        for (int p = 0; p < N_PHASES; ++p) { a.ph_lo = p; a.ph_hi = p + 1; hipLaunchKernelGGL(hymba_fwd, dim3(grid), dim3(NTHR), LDS_BYTES, stream, a); }
    }
}
```

```cpp
#include <hip/hip_runtime.h>
#include <hip/hip_cooperative_groups.h>
#include <cstdio>
#include <cstdint>
namespace cg = cooperative_groups;
namespace pg8 {
#define PG8_LAS __attribute__((address_space(3)))
typedef unsigned short bf16_t;
typedef short bf16x8 __attribute__((ext_vector_type(8)));
typedef float f32x4 __attribute__((ext_vector_type(4)));
typedef unsigned u32x4 __attribute__((ext_vector_type(4)));
constexpr int BM = 256, BK = 64, HALF = 128, HTB = HALF * BK * 2  , STAGE_BYTES = 8 * HTB, NXCD = 8, WGM = 8;

__host__ __device__ __forceinline__ int lds_byte(int r, int c) { const int st = (r >> 4) * 2 + (c >> 5), rr = r & 15, cc = c & 31, ob = rr * 64 + cc * 2; return st * 1024 + (ob ^ (((ob >> 9) & 1) << 5)); }
__host__ __device__ __forceinline__ void stage_rc(int b, int& R, int& C) { const int st = b / 1024, sb = b % 1024, swz = sb ^ (((sb >> 9) & 1) << 5); R = (st >> 1) * 16 + swz / 64; C = (st & 1) * 32 + (swz % 64) / 2; }
__host__ __device__ __forceinline__ int perm32(int rho) { const int n = rho >> 4, i = rho & 15; return 8 * (i >> 2) + 4 * n + (i & 3); }

struct Unit { int pm, pn; };
struct Gemm { const bf16_t* A; const bf16_t* Bt; int M, N, K; };

struct StaticOrder {
    int nM, nN, nwg, G, c;
    __host__ __device__ void init(int M, int N, int G_, int c_) { nM = M / BM; nN = N / BM; nwg = nM * nN; G = G_; c = c_; }
    __host__ __device__ bool next(int i, Unit& u) const {
        const long L = (long)i * G + c; if (L >= nwg) return false;
        int wgid = (int)L; { const int q = nwg / NXCD, r = nwg % NXCD, xcd = wgid % NXCD, off = wgid / NXCD; wgid = (xcd < r ? xcd * (q + 1) : r * (q + 1) + (xcd - r) * q) + off; }
        const int nig = WGM * nN, gid = wgid / nig, fm = gid * WGM, gsz = (nM - fm) < WGM ? (nM - fm) : WGM;
        u.pm = fm + ((wgid % nig) % gsz); u.pn = (wgid % nig) / gsz; return true;
    }
    __device__ __forceinline__ void a_ready(const Unit&) const {}
    __device__ __forceinline__ void done(const Unit&) const {}
};

__device__ __forceinline__ unsigned cvt_pk_bf16(float lo, float hi) { unsigned r; asm volatile("v_cvt_pk_bf16_f32 %0, %1, %2" : "=v"(r) : "v"(lo), "v"(hi)); return r; }
typedef float f32x2 __attribute__((ext_vector_type(2)));
__device__ __forceinline__ f32x2 gelu_pk(f32x2 v) {
    const f32x2 av = __builtin_elementwise_abs(v), d = av * 0.2316418882f + 1.0f;
    f32x2 t; t.x = __builtin_amdgcn_rcpf(d.x); t.y = __builtin_amdgcn_rcpf(d.y);
    f32x2 q = t * 0.5307027145f + (-0.7265760135f); q = q * t + 0.7107068705f; q = q * t + (-0.142248368f); q = q * t + 0.127414796f; q = q * t;
    const f32x2 s = (v * v) * (-0.72134752044f);
    f32x2 e; e.x = __builtin_amdgcn_exp2f(s.x); e.y = __builtin_amdgcn_exp2f(s.y);
    const f32x2 m = v * (q * e), r = v - m;
    f32x2 o; o.x = v.x < 0.f ? m.x : r.x; o.y = v.y < 0.f ? m.y : r.y; return o;
}

__device__ __forceinline__ u32x4 pack8(const f32x4 v0, const f32x4 v1) { u32x4 w; w.x = cvt_pk_bf16(v0[0], v0[1]); w.y = cvt_pk_bf16(v0[2], v0[3]); w.z = cvt_pk_bf16(v1[0], v1[1]); w.w = cvt_pk_bf16(v1[2], v1[3]); return w; }

struct EpiPlain {
    static constexpr bool PERM = true, AFTER_DRAIN = false;
    bf16_t* O; int ldc;
    __device__ __forceinline__ void operator()(const f32x4 (&acc)[2][2][4][2], const Unit& u, int wr, int wc, int fr, int fq) const {
        const int row0 = u.pm * BM + wr * 64 + fr, col0 = u.pn * BM + wc * 32 + 8 * fq;
#pragma unroll
        for (int ai = 0; ai < 2; ++ai)
#pragma unroll
            for (int m = 0; m < 4; ++m) { bf16_t* rowp = O + (size_t)(row0 + ai * HALF + m * 16) * ldc + col0;
#pragma unroll
                for (int bj = 0; bj < 2; ++bj) *(u32x4*)(rowp + bj * HALF) = pack8(acc[ai][bj][m][0], acc[ai][bj][m][1]); }
    }
};

struct EpiProj {
    static constexpr bool PERM = true, AFTER_DRAIN = false;
    bf16_t* P; int ldc; float* gates; const int* pos; const float* b_i; const float* b_f;
    __device__ __forceinline__ void operator()(const f32x4 (&acc)[2][2][4][2], const Unit& u, int wr, int wc, int fr, int fq) const {
        const int row0 = u.pm * BM + wr * 64 + fr, col0 = u.pn * BM + wc * 32 + 8 * fq, pn = u.pn;
        if (pn == 9) {
            if (wc == 0 && fq == 0) {
                const f32x4 bi = {b_i[0], b_i[1], b_i[2], b_i[3]}, bf = {b_f[0], b_f[1], b_f[2], b_f[3]};
#pragma unroll
                for (int ai = 0; ai < 2; ++ai)
#pragma unroll
                    for (int m = 0; m < 4; ++m) { const int row = row0 + ai * HALF + m * 16;
                        const f32x4 iv = acc[ai][0][m][0] + bi, fv = acc[ai][0][m][1] + bf; f32x4 lf;
#pragma unroll
                        for (int j = 0; j < 4; ++j) lf[j] = fminf(fv[j], 0.f) - log1pf(__expf(-fabsf(fv[j])));
                        *(f32x4*)(gates + (size_t)row * 8) = iv; *(f32x4*)(gates + (size_t)row * 8 + 4) = lf; }
            }
            return;
        }
#pragma unroll
        for (int ai = 0; ai < 2; ++ai)
#pragma unroll
            for (int m = 0; m < 4; ++m) { const int row = row0 + ai * HALF + m * 16; bf16_t* rowp = P + (size_t)row * ldc + col0;
                const float posf = (pn <= 2) ? (float)pos[row] : 0.f;
#pragma unroll
                for (int bj = 0; bj < 2; ++bj) { f32x4 v0 = acc[ai][bj][m][0], v1 = acc[ai][bj][m][1];
                    const bool rope = (pn < 2) || (pn == 2 && bj == 0);
                    if (rope) {
                        const int p0 = ((col0 + bj * HALF) & 63) >> 1; const float sc = (pn < 2) ? 0.125f : 1.0f;
                        float x[8] = {v0[0], v0[1], v0[2], v0[3], v1[0], v1[1], v1[2], v1[3]};
#pragma unroll
                        for (int q = 0; q < 4; ++q) { const float invf = __builtin_amdgcn_exp2f(-(float)(p0 + q) * 0.41524101186092029f);
                            float r = posf * invf * 0.15915494309189535f; r = r - floorf(r);
                            const float c = __builtin_amdgcn_cosf(r) * sc, s = __builtin_amdgcn_sinf(r) * sc;
                            const float x1 = x[2 * q], x2 = x[2 * q + 1]; x[2 * q] = x1 * c - x2 * s; x[2 * q + 1] = x2 * c + x1 * s; }
                        v0 = (f32x4){x[0], x[1], x[2], x[3]}; v1 = (f32x4){x[4], x[5], x[6], x[7]};
                    } else if (pn >= 7) {
#pragma unroll
                        for (int j = 0; j < 4; ++j) { v0[j] = __builtin_amdgcn_rcpf(1.f + __expf(-v0[j])); v1[j] = __builtin_amdgcn_rcpf(1.f + __expf(-v1[j])); }
                    }
                    *(u32x4*)(rowp + bj * HALF) = pack8(v0, v1); } }
    }
};

struct EpiMix {
    static constexpr bool PERM = true, AFTER_DRAIN = false;
    bf16_t* O; int ldc; float* sumsq;
    __device__ __forceinline__ void operator()(const f32x4 (&acc)[2][2][4][2], const Unit& u, int wr, int wc, int fr, int fq) const {
        const int row0 = u.pm * BM + wr * 64 + fr, col0 = u.pn * BM + wc * 32 + 8 * fq;
#pragma unroll
        for (int ai = 0; ai < 2; ++ai)
#pragma unroll
            for (int m = 0; m < 4; ++m) { const int row = row0 + ai * HALF + m * 16; bf16_t* rowp = O + (size_t)row * ldc + col0; float s = 0.f;
#pragma unroll
                for (int bj = 0; bj < 2; ++bj) { const f32x4 v0 = acc[ai][bj][m][0], v1 = acc[ai][bj][m][1];
                    s += (v0[0] * v0[0] + v0[1] * v0[1]) + (v0[2] * v0[2] + v0[3] * v0[3]) + (v1[0] * v1[0] + v1[1] * v1[1]) + (v1[2] * v1[2] + v1[3] * v1[3]);
                    *(u32x4*)(rowp + bj * HALF) = pack8(v0, v1); }
                s += __shfl_xor(s, 16); s += __shfl_xor(s, 32);
                if (fq == 0) sumsq[(size_t)row * 16 + u.pn * 4 + wc] = s; }
    }
};
template <class Epi, class Sched, bool ALIGN_EPI = false, bool SP2 = false>
__device__ __forceinline__ void gemm_phase(PG8_LAS unsigned char* lds, const Gemm g, const Sched& S, const Epi& E) {
    const int tid = threadIdx.x, wid = __builtin_amdgcn_readfirstlane(tid >> 6), lane = tid & 63, wr = wid >> 2, wc = wid & 3, fr = lane & 15, fq = lane >> 4;
    const int K = g.K, nt = K / BK;
    unsigned voffA[2], voffB[2];
#pragma unroll
    for (int i = 0; i < 2; ++i) { int R, C; stage_rc(tid * 16 + i * 8192, R, C); const int Rb = Epi::PERM ? ((R & ~31) + perm32(R & 31)) : R;
        voffA[i] = (unsigned)(R * K + C) * 2u; voffB[i] = (unsigned)(Rb * K + C) * 2u; }
    const size_t kstep = (size_t)(BK * 2);
    const size_t hstep = (size_t)HALF * K * 2;
    const size_t tstep = 2 * hstep;
    const unsigned ldsw = (unsigned)wid * 1024u;
    const int aoff = lds_byte(wr * 64 + fr, fq * 8), boff = lds_byte(wc * 32 + fr, fq * 8);
#define PG8_SA(b, h) (((b) * 2 + (h)) * HTB)
#define PG8_SB(b, h) ((4 + (b) * 2 + (h)) * HTB)
#define PG8_STAGE(bufoff, gbase, voff) do { _Pragma("unroll") for (int _i = 0; _i < 2; ++_i) \
        __builtin_amdgcn_global_load_lds((const unsigned*)((const char*)(gbase) + (voff)[_i]), (PG8_LAS unsigned*)(lds + (bufoff) + ldsw + _i * 8192), 16, 0, 0); } while (0)
#define PG8_LDA(dst, b, h) do { _Pragma("unroll") for (int m = 0; m < 4; ++m) _Pragma("unroll") for (int k = 0; k < 2; ++k) dst[m][k] = *(const PG8_LAS bf16x8*)(lds + PG8_SA(b, h) + aoff + m * 2048 + k * 1024); } while (0)
#define PG8_LDB(dst, b, h) do { _Pragma("unroll") for (int n = 0; n < 2; ++n) _Pragma("unroll") for (int k = 0; k < 2; ++k) dst[n][k] = *(const PG8_LAS bf16x8*)(lds + PG8_SB(b, h) + boff + n * 2048 + k * 1024); } while (0)
#define PG8_MMA(ai, bj, At, Bt) do { __builtin_amdgcn_s_setprio(1); _Pragma("unroll") for (int m = 0; m < 4; ++m) _Pragma("unroll") for (int n = 0; n < 2; ++n) _Pragma("unroll") for (int k = 0; k < 2; ++k) \
        acc[ai][bj][m][n] = __builtin_amdgcn_mfma_f32_16x16x32_bf16(Bt[n][k], At[m][k], acc[ai][bj][m][n], 0, 0, 0); __builtin_amdgcn_s_setprio(0); } while (0)
#define PG8_WAIT_V(n) asm volatile("s_waitcnt vmcnt(" #n ")" ::: "memory")
#define PG8_WAIT_L(n) asm volatile("s_waitcnt lgkmcnt(" #n ")" ::: "memory")
#define PG8_BAR __builtin_amdgcn_s_barrier()
#define PG8_SCHED __builtin_amdgcn_sched_barrier(0)
    Unit cur, nxt; int ui = 0;
    if (!S.next(0, cur)) return;
    f32x4 acc[2][2][4][2];
#pragma unroll
    for (int a = 0; a < 2; ++a)
#pragma unroll
        for (int b = 0; b < 2; ++b)
#pragma unroll
            for (int m = 0; m < 4; ++m)
#pragma unroll
                for (int n = 0; n < 2; ++n) acc[a][b][m][n] = (f32x4){0.f, 0.f, 0.f, 0.f};
    bf16x8 At[4][2], B0[2][2], B1[2][2];
    const char* cA = (const char*)g.A + (size_t)cur.pm * tstep; const char* cB = (const char*)g.Bt + (size_t)cur.pn * tstep;
    S.a_ready(cur);
    if constexpr (SP2) {
        PG8_STAGE(PG8_SB(0, 0), cB, voffB); PG8_STAGE(PG8_SB(0, 1), cB + hstep, voffB); PG8_STAGE(PG8_SA(0, 0), cA, voffA); PG8_STAGE(PG8_SA(0, 1), cA + hstep, voffA);
        if (wr == 1) PG8_BAR;
        PG8_WAIT_V(2); PG8_BAR;
        PG8_STAGE(PG8_SB(1, 0), cB + kstep, voffB); PG8_STAGE(PG8_SA(1, 0), cA + kstep, voffA); PG8_STAGE(PG8_SB(1, 1), cB + hstep + kstep, voffB);
        PG8_WAIT_V(6); PG8_BAR;
    } else {
        PG8_STAGE(PG8_SB(0, 0), cB, voffB); PG8_STAGE(PG8_SA(0, 0), cA, voffA); PG8_STAGE(PG8_SB(0, 1), cB + hstep, voffB); PG8_STAGE(PG8_SA(0, 1), cA + hstep, voffA);
        if (wr == 1) PG8_BAR;
        PG8_WAIT_V(4); PG8_BAR;
        PG8_STAGE(PG8_SB(1, 0), cB + kstep, voffB); PG8_STAGE(PG8_SA(1, 0), cA + kstep, voffA); PG8_STAGE(PG8_SB(1, 1), cB + hstep + kstep, voffB);
        PG8_WAIT_V(6); PG8_BAR;
    }
    for (;;) {
        const bool has_next = S.next(ui + 1, nxt);
        const char* nA = has_next ? (const char*)g.A + (size_t)nxt.pm * tstep : cA; const char* nB = has_next ? (const char*)g.Bt + (size_t)nxt.pn * tstep : cB;
        for (int t = 0; t < nt; t += 2) {
            const bool last = (t == nt - 2);
            const char* a1 = cA + (size_t)(t + 1) * kstep;
            const char* a2 = last ? nA : cA + (size_t)(t + 2) * kstep; const char* b2 = last ? nB : cB + (size_t)(t + 2) * kstep;
            const char* a3 = a2 + kstep; const char* b3 = b2 + kstep;
            if (last && has_next) S.a_ready(nxt);
            if constexpr (SP2) {
            PG8_LDB(B0, 0, 0); PG8_LDB(B1, 0, 1); PG8_SCHED; PG8_LDA(At, 0, 0); PG8_STAGE(PG8_SA(1, 1), a1 + hstep, voffA);
            PG8_WAIT_V(8); PG8_WAIT_L(0); PG8_BAR; PG8_MMA(0, 0, At, B0); PG8_MMA(0, 1, At, B1); PG8_BAR; PG8_SCHED;
            PG8_LDA(At, 0, 1); PG8_STAGE(PG8_SB(0, 0), b2, voffB); PG8_STAGE(PG8_SB(0, 1), b2 + hstep, voffB); PG8_STAGE(PG8_SA(0, 0), a2, voffA);
            PG8_WAIT_V(8); PG8_WAIT_L(0); PG8_BAR; PG8_MMA(1, 0, At, B0); PG8_MMA(1, 1, At, B1); PG8_BAR; PG8_SCHED;
            PG8_LDB(B0, 1, 0); PG8_LDB(B1, 1, 1); PG8_SCHED; PG8_LDA(At, 1, 0); PG8_STAGE(PG8_SA(0, 1), a2 + hstep, voffA);
            PG8_WAIT_V(8); PG8_WAIT_L(0); PG8_BAR; PG8_MMA(0, 0, At, B0); PG8_MMA(0, 1, At, B1); PG8_BAR; PG8_SCHED;
            PG8_LDA(At, 1, 1); PG8_STAGE(PG8_SB(1, 0), b3, voffB); PG8_STAGE(PG8_SB(1, 1), b3 + hstep, voffB); PG8_STAGE(PG8_SA(1, 0), a3, voffA);
            PG8_WAIT_V(8); PG8_WAIT_L(0); PG8_BAR; PG8_MMA(1, 0, At, B0); PG8_MMA(1, 1, At, B1); PG8_BAR; PG8_SCHED;
            } else {
            PG8_LDB(B0, 0, 0); PG8_SCHED; PG8_LDA(At, 0, 0); PG8_STAGE(PG8_SA(1, 1), a1 + hstep, voffA);
            PG8_WAIT_L(8); PG8_BAR; PG8_WAIT_L(0); PG8_MMA(0, 0, At, B0); PG8_BAR; PG8_SCHED;
            PG8_LDB(B1, 0, 1); PG8_STAGE(PG8_SB(0, 0), b2, voffB);
            PG8_BAR; PG8_WAIT_L(0); PG8_MMA(0, 1, At, B1); PG8_BAR;
            PG8_LDA(At, 0, 1); PG8_STAGE(PG8_SA(0, 0), a2, voffA);
            PG8_BAR; PG8_WAIT_L(0); PG8_MMA(1, 0, At, B0); PG8_BAR; PG8_SCHED;
            PG8_STAGE(PG8_SB(0, 1), b2 + hstep, voffB);
            PG8_WAIT_V(6); PG8_BAR; PG8_MMA(1, 1, At, B1); PG8_BAR;
            PG8_LDB(B0, 1, 0); PG8_SCHED; PG8_LDA(At, 1, 0); PG8_STAGE(PG8_SA(0, 1), a2 + hstep, voffA);
            PG8_WAIT_L(8); PG8_BAR; PG8_WAIT_L(0); PG8_MMA(0, 0, At, B0); PG8_BAR; PG8_SCHED;
            PG8_LDB(B1, 1, 1); PG8_STAGE(PG8_SB(1, 0), b3, voffB);
            PG8_BAR; PG8_WAIT_L(0); PG8_MMA(0, 1, At, B1); PG8_BAR;
            PG8_LDA(At, 1, 1); PG8_STAGE(PG8_SA(1, 0), a3, voffA);
            PG8_BAR; PG8_WAIT_L(0); PG8_MMA(1, 0, At, B0); PG8_BAR; PG8_SCHED;
            PG8_STAGE(PG8_SB(1, 1), b3 + hstep, voffB);
            PG8_WAIT_V(6); PG8_BAR; PG8_MMA(1, 1, At, B1); PG8_BAR;
            }
        }
        if constexpr (ALIGN_EPI) { if (wr == 0) PG8_BAR; }
        if constexpr (!Epi::AFTER_DRAIN) { E(acc, cur, wr, wc, fr, fq); S.done(cur); }
        if (!has_next) break;
#pragma unroll
        for (int a = 0; a < 2; ++a)
#pragma unroll
            for (int b = 0; b < 2; ++b)
#pragma unroll
                for (int m = 0; m < 4; ++m)
#pragma unroll
                    for (int n = 0; n < 2; ++n) acc[a][b][m][n] = (f32x4){0.f, 0.f, 0.f, 0.f};
        cur = nxt; cA = nA; cB = nB; ++ui;
        if constexpr (ALIGN_EPI) { if (wr == 1) PG8_BAR; }
    }
    PG8_WAIT_V(0);
    if constexpr (!ALIGN_EPI) { if (wr == 0) PG8_BAR; }
    PG8_BAR;
    if constexpr (Epi::AFTER_DRAIN) { E.fused(acc, cur, wr, wc, fr, fq, lds, wid, lane); S.done(cur); }
#undef PG8_SA
#undef PG8_SB
#undef PG8_STAGE
#undef PG8_LDA
#undef PG8_LDB
#undef PG8_MMA
#undef PG8_WAIT_V
#undef PG8_WAIT_L
#undef PG8_BAR
#undef PG8_SCHED
}
}
constexpr int NB = 8, SEQ = 8192, D = 1024, M = NB * SEQ;
constexpr int DIN = 2312, NPROJ = 2304, NIN_PAD = 2560;
constexpr int C_AQ = 0, C_AK = 512, C_AV = 640, C_MQ = 768, C_MK = 1024, C_MV = 1280, C_MO = 1792;
constexpr int NEXP = 16384, NSLOT = 128;
constexpr float EPS = 1e-6f;
constexpr int NWAVES = 8, NTHR = 512;

constexpr size_t MiB = 1u << 20;
constexpr size_t WS_CTL = 0, CTL_ZERO_BYTES = 1 * MiB;
constexpr size_t WS_MOD = 1 * MiB;
constexpr size_t WS_WIN = 2 * MiB;
constexpr size_t WS_WOUT = 8 * MiB;
constexpr size_t WS_WQ = 10 * MiB;
constexpr size_t WS_KEYS = 14 * MiB;
constexpr size_t WS_GATES = 16 * MiB;
constexpr size_t WS_SSQ = 832 * MiB;
constexpr size_t WS_MST = 20 * MiB;
constexpr size_t WS_U = 32 * MiB, WS_V = 64 * MiB;
constexpr size_t WS_H = 96 * MiB;
constexpr size_t WS_PROJ = 224 * MiB;
constexpr size_t WS_MIXIN = 512 * MiB;
constexpr size_t WS_MIX = 640 * MiB;
constexpr size_t WS_EIDX = 768 * MiB, WS_GATE = 800 * MiB;
constexpr size_t WS_END = 836 * MiB;
constexpr int CW_BAR = 4096;
constexpr int CW_SUMSQ = 65536;
static_assert((CW_SUMSQ + M) * 4 <= (int)CTL_ZERO_BYTES, "ctl");

constexpr int RING_BYTES = 131072, MISC_OFF = RING_BYTES + 320, LDS_BYTES = 147456;

#define GAS __attribute__((address_space(1)))
#define LAS __attribute__((address_space(3)))
typedef unsigned short bf16;
typedef unsigned v4u __attribute__((ext_vector_type(4)));
typedef unsigned v2u __attribute__((ext_vector_type(2)));
typedef float f32x4 __attribute__((ext_vector_type(4)));
typedef GAS unsigned gu32;
#define LDS_WAIT() asm volatile("s_waitcnt lgkmcnt(0)" ::: "memory")
#define VM_WAIT() asm volatile("s_waitcnt vmcnt(0)" ::: "memory")
__device__ __forceinline__ unsigned f2bf(float f) { unsigned u = __builtin_bit_cast(unsigned, f); return (u + 0x7fffu + ((u >> 16) & 1u)) >> 16; }
__device__ __forceinline__ unsigned pk2(float lo, float hi) { return f2bf(lo) | (f2bf(hi) << 16); }
__device__ __forceinline__ float bflo(unsigned w) { return __builtin_bit_cast(float, w << 16); }
__device__ __forceinline__ float bfhi(unsigned w) { return __builtin_bit_cast(float, w & 0xffff0000u); }
__device__ __forceinline__ float bf1(bf16 h) { return __builtin_bit_cast(float, (unsigned)h << 16); }
__device__ __forceinline__ float wave_sum(float v) {
#pragma unroll
    for (int o = 1; o < 64; o <<= 1) v += __shfl_xor(v, o);
    return v;
}
__device__ __forceinline__ float wave_max(float v) {
#pragma unroll
    for (int o = 1; o < 64; o <<= 1) v = fmaxf(v, __shfl_xor(v, o));
    return v;
}
struct Args { const void* in[21]; float* out; unsigned char* ws; int ph_lo, ph_hi; };
enum { I_X = 0, I_C, I_POS, I_WMOD, I_BMOD, I_GPRE1, I_GPOST1, I_WIN, I_CONVW, I_BI, I_BF, I_MNG, I_SINK, I_WOUT, I_GPRE2, I_GPOST2, I_WQ, I_K1, I_K2, I_U, I_V };

__device__ __forceinline__ int newcol(int o) {
    if (o < 640) { const int hd = o >> 6, d = o & 63; return (hd << 6) + 2 * (d & 31) + (d >> 5); }
    if (o < 1792) return o;
    if (o < 1800) return 2304 + (o - 1792);
    return o - 8;
}
template <bool REMAP>
__device__ __forceinline__ void p0_transpose_item(const float* W, int K, int N, bf16* WT, LAS float* scr, int item, int lane) {
    const int nblk = (N + 31) / 32, kb = item / nblk, nb = item % nblk, k0 = 64 * kb, n0 = 32 * nb;
    const int ncol = n0 + (lane & 31);
#pragma unroll 8
    for (int i = 0; i < 32; ++i) { const int kk = 2 * i + (lane >> 5); scr[kk * 33 + (lane & 31)] = (ncol < N) ? W[(size_t)(k0 + kk) * N + ncol] : 0.f; }
    LDS_WAIT(); asm volatile("" ::: "memory");
    const int c = lane & 7;
#pragma unroll
    for (int j = 0; j < 4; ++j) { const int n = (lane >> 3) + 8 * j; const LAS float* s = scr + (8 * c) * 33 + n;
        v4u o; o.x = pk2(s[0 * 33], s[1 * 33]); o.y = pk2(s[2 * 33], s[3 * 33]); o.z = pk2(s[4 * 33], s[5 * 33]); o.w = pk2(s[6 * 33], s[7 * 33]);
        if (n0 + n < N) { const int drow = REMAP ? newcol(n0 + n) : (n0 + n); *(GAS v4u*)(WT + (size_t)drow * K + k0 + 8 * c) = o; } }
    LDS_WAIT(); asm volatile("" ::: "memory");
}
__device__ __forceinline__ void p0_convert(const float* src, bf16* dst, size_t n, int gt, int ngt) {
    for (size_t i = (size_t)gt * 8; i < n; i += (size_t)ngt * 8) {
        const f32x4 a = *(const GAS f32x4*)(src + i), b = *(const GAS f32x4*)(src + i + 4);
        v4u o; o.x = pk2(a[0], a[1]); o.y = pk2(a[2], a[3]); o.z = pk2(b[0], b[1]); o.w = pk2(b[2], b[3]);
        *(GAS v4u*)(dst + i) = o; }
}
__device__ __forceinline__ void phase_prologue(const Args& A, LAS unsigned char* lds) {
    const int tid = threadIdx.x, lane = tid & 63, wave = tid >> 6, G = gridDim.x, blk = blockIdx.x;
    unsigned char* ws = A.ws;
    {
        const float* c = (const float*)A.in[I_C]; const float* wm = (const float*)A.in[I_WMOD]; const float* bm = (const float*)A.in[I_BMOD];
        float* mod = (float*)(ws + WS_MOD); LAS float* red = (LAS float*)lds;
        for (int it = blk; it < 6144 / 32; it += G) {
            const int kg = tid >> 5, col = tid & 31, j = it * 32 + col; float acc[8];
#pragma unroll
            for (int b = 0; b < 8; ++b) acc[b] = 0.f;
            for (int i = 0; i < 64; ++i) { const int k = kg + 16 * i; const float w = wm[(size_t)k * 6144 + j];
#pragma unroll
                for (int b = 0; b < 8; ++b) acc[b] += c[b * 1024 + k] * w; }
#pragma unroll
            for (int b = 0; b < 8; ++b) red[(kg * 32 + col) * 8 + b] = acc[b];
            __syncthreads();
            if (tid < 256) { const int b = tid >> 5, cc = tid & 31; float s = 0.f;
#pragma unroll
                for (int g = 0; g < 16; ++g) s += red[(g * 32 + cc) * 8 + b];
                mod[b * 6144 + it * 32 + cc] = s + bm[it * 32 + cc]; }
            __syncthreads();
        }
    }
    {
        LAS float* scr = (LAS float*)(lds + wave * 16384);
        const int gw = blk * NWAVES + wave, NGW = G * NWAVES;
        const int I_IN = (D / 64) * ((DIN + 31) / 32), I_OUT = (D / 64) * (D / 32), I_Q = (D / 64) * (2048 / 32);
        bf16* win = (bf16*)(ws + WS_WIN); bf16* wout = (bf16*)(ws + WS_WOUT); bf16* wq = (bf16*)(ws + WS_WQ);
        for (int it = gw; it < I_IN + I_OUT + I_Q; it += NGW) {
            int r = it;
            if (r < I_IN) { p0_transpose_item<true>((const float*)A.in[I_WIN], D, DIN, win, scr, r, lane); continue; } r -= I_IN;
            if (r < I_OUT) { p0_transpose_item<false>((const float*)A.in[I_WOUT], D, D, wout, scr, r, lane); continue; } r -= I_OUT;
            p0_transpose_item<false>((const float*)A.in[I_WQ], D, 2048, wq, scr, r, lane);
        }
        const int gt = blk * NTHR + tid, ngt = G * NTHR;
        for (int i = gt; i < (NIN_PAD - DIN) * D / 8; i += ngt) *(GAS v4u*)(win + (size_t)DIN * D + (size_t)i * 8) = (v4u){0u, 0u, 0u, 0u};
        p0_convert((const float*)A.in[I_K1], (bf16*)(ws + WS_KEYS), (size_t)8 * 128 * 128, gt, ngt);
        p0_convert((const float*)A.in[I_K2], (bf16*)(ws + WS_KEYS) + 8 * 128 * 128, (size_t)8 * 128 * 128, gt, ngt);
        p0_convert((const float*)A.in[I_U], (bf16*)(ws + WS_U), (size_t)NEXP * D, gt, ngt);
        p0_convert((const float*)A.in[I_V], (bf16*)(ws + WS_V), (size_t)NEXP * D, gt, ngt);
    }
}

__device__ __forceinline__ void phase_prenorm(const Args& A) {
    const int tid = threadIdx.x, lane = tid & 63, wave = tid >> 6, G = gridDim.x;
    const float* x = (const float*)A.in[I_X]; const float* g = (const float*)A.in[I_GPRE1]; const float* mod = (const float*)(A.ws + WS_MOD);
    bf16* H = (bf16*)(A.ws + WS_H);
    for (int row = blockIdx.x * NWAVES + wave; row < M; row += G * NWAVES) {
        const int b = row / SEQ; const GAS f32x4* xr = (const GAS f32x4*)(x + (size_t)row * D) + lane;
        f32x4 v[4]; float s = 0.f;
#pragma unroll
        for (int j = 0; j < 4; ++j) { v[j] = xr[64 * j]; s += (v[j][0] * v[j][0] + v[j][1] * v[j][1]) + (v[j][2] * v[j][2] + v[j][3] * v[j][3]); }
        const float rstd = 1.0f / sqrtf(wave_sum(s) * (1.f / D) + EPS);
        GAS v2u* o = (GAS v2u*)(H + (size_t)row * D) + lane;
#pragma unroll
        for (int j = 0; j < 4; ++j) { const int k = 4 * (lane + 64 * j);
            const f32x4 gg = *(const GAS f32x4*)(g + k), sh = *(const GAS f32x4*)(mod + b * 6144 + k), sc = *(const GAS f32x4*)(mod + b * 6144 + 1024 + k);
            f32x4 y;
#pragma unroll
            for (int i = 0; i < 4; ++i) y[i] = v[j][i] * rstd * gg[i] * (1.f + sc[i]) + sh[i];
            v2u w; w.x = pk2(y[0], y[1]); w.y = pk2(y[2], y[3]); o[64 * j] = w; }
    }
}

__device__ __forceinline__ void phase_mid(const Args& A) {
    const int tid = threadIdx.x, lane = tid & 63, wave = tid >> 6, G = gridDim.x;
    const float* x = (const float*)A.in[I_X]; const float* gpost = (const float*)A.in[I_GPOST1]; const float* gpre = (const float*)A.in[I_GPRE2];
    const float* mod = (const float*)(A.ws + WS_MOD); const float* sumsq = (const float*)(A.ws + WS_SSQ);
    const bf16* MIX = (const bf16*)(A.ws + WS_MIX); bf16* H = (bf16*)(A.ws + WS_H); float* out = A.out;
    for (int row = blockIdx.x * NWAVES + wave; row < M; row += G * NWAVES) {
        const int b = row / SEQ; const GAS f32x4* xr = (const GAS f32x4*)(x + (size_t)row * D) + lane; const GAS v2u* mr = (const GAS v2u*)(MIX + (size_t)row * D) + lane;
        const f32x4 q0 = *(const GAS f32x4*)(sumsq + (size_t)row * 16), q1 = *(const GAS f32x4*)(sumsq + (size_t)row * 16 + 4), q2 = *(const GAS f32x4*)(sumsq + (size_t)row * 16 + 8), q3 = *(const GAS f32x4*)(sumsq + (size_t)row * 16 + 12);
        const float rm = 1.0f / sqrtf(((((q0[0] + q0[1]) + (q0[2] + q0[3])) + ((q1[0] + q1[1]) + (q1[2] + q1[3]))) + (((q2[0] + q2[1]) + (q2[2] + q2[3])) + ((q3[0] + q3[1]) + (q3[2] + q3[3])))) * (1.f / D) + EPS);
        f32x4 v[4]; float s = 0.f;
#pragma unroll
        for (int j = 0; j < 4; ++j) { const int k = 4 * (lane + 64 * j); const f32x4 xv = xr[64 * j]; const v2u mw = mr[64 * j];
            const f32x4 gp = *(const GAS f32x4*)(gpost + k), g1 = *(const GAS f32x4*)(mod + b * 6144 + 2048 + k);
            const float mx[4] = {bflo(mw.x), bfhi(mw.x), bflo(mw.y), bfhi(mw.y)};
#pragma unroll
            for (int i = 0; i < 4; ++i) { v[j][i] = xv[i] + g1[i] * (mx[i] * rm * gp[i]); s += v[j][i] * v[j][i]; }
            *((GAS f32x4*)(out + (size_t)row * D) + lane + 64 * j) = v[j]; }
        const float rstd = 1.0f / sqrtf(wave_sum(s) * (1.f / D) + EPS);
        GAS v2u* o = (GAS v2u*)(H + (size_t)row * D) + lane;
#pragma unroll
        for (int j = 0; j < 4; ++j) { const int k = 4 * (lane + 64 * j);
            const f32x4 gg = *(const GAS f32x4*)(gpre + k), sh = *(const GAS f32x4*)(mod + b * 6144 + 3072 + k), sc = *(const GAS f32x4*)(mod + b * 6144 + 4096 + k);
            f32x4 y;
#pragma unroll
            for (int i = 0; i < 4; ++i) y[i] = v[j][i] * rstd * gg[i] * (1.f + sc[i]) + sh[i];
            v2u w; w.x = pk2(y[0], y[1]); w.y = pk2(y[2], y[3]); o[64 * j] = w; }
    }
}
__device__ __forceinline__ void load64bf(const bf16* p, float (&o)[64]) {
#pragma unroll
    for (int i = 0; i < 8; ++i) { const v4u w = *(const GAS v4u*)(p + 8 * i);
        o[8 * i + 0] = bflo(w.x); o[8 * i + 1] = bfhi(w.x); o[8 * i + 2] = bflo(w.y); o[8 * i + 3] = bfhi(w.y);
        o[8 * i + 4] = bflo(w.z); o[8 * i + 5] = bfhi(w.z); o[8 * i + 6] = bflo(w.w); o[8 * i + 7] = bfhi(w.w); }
}
__device__ __forceinline__ void phase_attn_naive(const Args& A, int vb, int nvb) {
    const bf16* P = (const bf16*)(A.ws + WS_PROJ); bf16* MI = (bf16*)(A.ws + WS_MIXIN); const float* sinks = (const float*)A.in[I_SINK];
    for (int task = vb * NTHR + (int)threadIdx.x; task < 8 * M; task += nvb * NTHR) {
        const int h = task / M, t = task % M, s = t % SEQ, kvh = h >> 2;
        float q[64], o[64];
        load64bf(P + (size_t)t * NPROJ + C_AQ + h * 64, q);
#pragma unroll
        for (int d = 0; d < 64; ++d) o[d] = 0.f;
        float mx = sinks[h], l = 1.f;
        for (int j = 0; j < 128; ++j) {
            const int sj = s - 127 + j; const bool valid = sj >= 0; const int tk = valid ? (t - 127 + j) : t;
            const bf16* kr = P + (size_t)tk * NPROJ + C_AK + kvh * 64; float sc = 0.f;
#pragma unroll
            for (int i = 0; i < 8; ++i) { const v4u w = *(const GAS v4u*)(kr + 8 * i);
                sc += q[8 * i + 0] * bflo(w.x) + q[8 * i + 1] * bfhi(w.x) + q[8 * i + 2] * bflo(w.y) + q[8 * i + 3] * bfhi(w.y)
                    + q[8 * i + 4] * bflo(w.z) + q[8 * i + 5] * bfhi(w.z) + q[8 * i + 6] * bflo(w.w) + q[8 * i + 7] * bfhi(w.w); }
            if (valid) {
                const float mn = fmaxf(mx, sc), al = __expf(mx - mn), p = __expf(sc - mn); mx = mn; l = l * al + p;
                const bf16* vr = P + (size_t)tk * NPROJ + C_AV + kvh * 64;
#pragma unroll
                for (int i = 0; i < 8; ++i) { const v4u w = *(const GAS v4u*)(vr + 8 * i);
                    o[8 * i + 0] = o[8 * i + 0] * al + p * bflo(w.x); o[8 * i + 1] = o[8 * i + 1] * al + p * bfhi(w.x);
                    o[8 * i + 2] = o[8 * i + 2] * al + p * bflo(w.y); o[8 * i + 3] = o[8 * i + 3] * al + p * bfhi(w.y);
                    o[8 * i + 4] = o[8 * i + 4] * al + p * bflo(w.z); o[8 * i + 5] = o[8 * i + 5] * al + p * bfhi(w.z);
                    o[8 * i + 6] = o[8 * i + 6] * al + p * bflo(w.w); o[8 * i + 7] = o[8 * i + 7] * al + p * bfhi(w.w); }
            }
        }
        const float il = 1.f / l; bf16* orow = MI + (size_t)t * D + h * 64;
#pragma unroll
        for (int i = 0; i < 8; ++i) { v4u w; w.x = pk2(o[8 * i] * il, o[8 * i + 1] * il); w.y = pk2(o[8 * i + 2] * il, o[8 * i + 3] * il);
            w.z = pk2(o[8 * i + 4] * il, o[8 * i + 5] * il); w.w = pk2(o[8 * i + 6] * il, o[8 * i + 7] * il); *(GAS v4u*)(orow + 8 * i) = w; }
    }
}

__device__ __forceinline__ void phase_mlstm_naive(const Args& A, LAS unsigned char* lds, int bh) {
    const int tid = threadIdx.x, lane = tid & 63, wave = tid >> 6, b = bh >> 2, h = bh & 3, dv = tid >> 2, part = tid & 3;
    const bf16* P = (const bf16*)(A.ws + WS_PROJ); bf16* MI = (bf16*)(A.ws + WS_MIXIN); const float* gates = (const float*)(A.ws + WS_GATES);
    const float* cw = (const float*)A.in[I_CONVW]; const float* ng = (const float*)A.in[I_MNG];
    LAS float* qs = (LAS float*)lds; LAS float* ks = qs + 64 * 64; LAS float* vs = ks + 64 * 64; LAS float* ig = vs + 64 * 128; LAS float* lfg = ig + 64; LAS float* hb = lfg + 64;
    float C[16], n[16]; float m = 0.f;
#pragma unroll
    for (int j = 0; j < 16; ++j) { C[j] = 0.f; n[j] = 0.f; }
    for (int ch = 0; ch < SEQ / 64; ++ch) {
        const int s0 = ch * 64; const size_t t0 = (size_t)b * SEQ + s0;
        for (int e = tid; e < 64 * 64; e += NTHR) { const int l = e >> 6, dk = e & 63; float aq = 0.f, ak = 0.f;
#pragma unroll
            for (int j = 0; j < 4; ++j) { const int sj = s0 + l - 3 + j; if (sj >= 0) { const bf16* r = P + ((size_t)b * SEQ + sj) * NPROJ;
                aq += cw[j * 512 + h * 64 + dk] * bf1(r[C_MQ + h * 64 + dk]); ak += cw[j * 512 + 256 + h * 64 + dk] * bf1(r[C_MK + h * 64 + dk]); } }
            qs[e] = 0.125f * aq / (1.f + __expf(-aq)); ks[e] = ak / (1.f + __expf(-ak)); }
        for (int e = tid; e < 64 * 128; e += NTHR) { const int l = e >> 7, d = e & 127; vs[e] = bf1(P[(t0 + l) * NPROJ + C_MV + h * 128 + d]); }
        if (tid < 64) { ig[tid] = gates[(t0 + tid) * 8 + h]; lfg[tid] = gates[(t0 + tid) * 8 + 4 + h]; }
        __syncthreads();
        for (int l = 0; l < 64; ++l) {
            const float lf = lfg[l], ii = ig[l], mn = fmaxf(lf + m, ii), fd = __expf(lf + m - mn), iw = __expf(ii - mn), vv = vs[l * 128 + dv] * iw;
            float num = 0.f, den = 0.f;
#pragma unroll
            for (int j = 0; j < 16; ++j) { const float kk = ks[l * 64 + part * 16 + j], qq = qs[l * 64 + part * 16 + j];
                C[j] = fd * C[j] + vv * kk; n[j] = fd * n[j] + iw * kk; num += C[j] * qq; den += n[j] * qq; }
            num += __shfl_xor(num, 1); num += __shfl_xor(num, 2); den += __shfl_xor(den, 1); den += __shfl_xor(den, 2);
            if (part == 0) hb[l * 128 + dv] = num / fmaxf(fabsf(den), __expf(-mn));
            m = mn;
        }
        __syncthreads();
        for (int l = wave * 8; l < wave * 8 + 8; ++l) { const float a0 = hb[l * 128 + lane], a1 = hb[l * 128 + 64 + lane];
            const float r = 1.0f / sqrtf(wave_sum(a0 * a0 + a1 * a1) * (1.f / 128.f) + EPS);
            const bf16* pr = P + (t0 + l) * NPROJ + C_MO + h * 128; bf16* orow = MI + (t0 + l) * D + 512 + h * 128;
            orow[lane] = (bf16)f2bf(a0 * r * ng[h * 128 + lane] * bf1(pr[lane])); orow[64 + lane] = (bf16)f2bf(a1 * r * ng[h * 128 + 64 + lane] * bf1(pr[64 + lane])); }
        __syncthreads();
    }
}

__device__ __forceinline__ void phase_topk_naive(const Args& A, LAS unsigned char* lds) {
    const int tid = threadIdx.x, lane = tid & 63, wave = tid >> 6, G = gridDim.x;
    const bf16* Q = (const bf16*)(A.ws + WS_PROJ); int* EI = (int*)(A.ws + WS_EIDX); float* GT = (float*)(A.ws + WS_GATE);
    LAS float* k1 = (LAS float*)lds; LAS float* k2 = k1 + 128 * 129;
    const float NEG = -3.0e38f;
    for (int unit = blockIdx.x; unit < 8 * (M / 256); unit += G) {
        const int h = unit % 8, tb = unit / 8;
        __syncthreads();
        const float* g1 = (const float*)A.in[I_K1] + (size_t)h * 128 * 128; const float* g2 = (const float*)A.in[I_K2] + (size_t)h * 128 * 128;
        for (int e = tid; e < 128 * 128; e += NTHR) { const int r = e >> 7, c = e & 127; k1[r * 129 + c] = g1[e]; k2[r * 129 + c] = g2[e]; }
        __syncthreads();
        for (int tt = 0; tt < 32; ++tt) {
            const int t = tb * 256 + wave * 32 + tt;
            const v2u qw = *(const GAS v2u*)(Q + (size_t)t * 2048 + h * 256 + 4 * lane);
            const float q0 = bflo(qw.x), q1 = bfhi(qw.x), q2 = bflo(qw.y), q3 = bfhi(qw.y);
            float a0 = 0.f, a1 = 0.f, c0 = 0.f, c1 = 0.f;
#pragma unroll 4
            for (int l2 = 0; l2 < 32; ++l2) {
                const float s0 = __shfl(q0, l2), s1 = __shfl(q1, l2), s2 = __shfl(q2, l2), s3 = __shfl(q3, l2);
                const float u0 = __shfl(q0, 32 + l2), u1 = __shfl(q1, 32 + l2), u2 = __shfl(q2, 32 + l2), u3 = __shfl(q3, 32 + l2);
                const int d = 4 * l2;
                a0 += s0 * k1[lane * 129 + d] + s1 * k1[lane * 129 + d + 1] + s2 * k1[lane * 129 + d + 2] + s3 * k1[lane * 129 + d + 3];
                a1 += s0 * k1[(lane + 64) * 129 + d] + s1 * k1[(lane + 64) * 129 + d + 1] + s2 * k1[(lane + 64) * 129 + d + 2] + s3 * k1[(lane + 64) * 129 + d + 3];
                c0 += u0 * k2[lane * 129 + d] + u1 * k2[lane * 129 + d + 1] + u2 * k2[lane * 129 + d + 2] + u3 * k2[lane * 129 + d + 3];
                c1 += u0 * k2[(lane + 64) * 129 + d] + u1 * k2[(lane + 64) * 129 + d + 1] + u2 * k2[(lane + 64) * 129 + d + 2] + u3 * k2[(lane + 64) * 129 + d + 3];
            }
            float v1 = NEG, v2 = NEG; int i1 = 0, i2 = 0;
            for (int r = 0; r < 16; ++r) {
                { const float cm = fmaxf(a0, a1), wm = wave_max(cm); const unsigned long long mk = __ballot(cm == wm); const int src = __ffsll((long long)mk) - 1;
                  const int mykey = (a0 == wm) ? lane : lane + 64; const int key = __shfl(mykey, src);
                  if (lane == src) { if (a0 == wm) a0 = NEG; else a1 = NEG; }
                  if (lane == r) { v1 = wm; i1 = key; } }
                { const float cm = fmaxf(c0, c1), wm = wave_max(cm); const unsigned long long mk = __ballot(cm == wm); const int src = __ffsll((long long)mk) - 1;
                  const int mykey = (c0 == wm) ? lane : lane + 64; const int key = __shfl(mykey, src);
                  if (lane == src) { if (c0 == wm) c0 = NEG; else c1 = NEG; }
                  if (lane == r) { v2 = wm; i2 = key; } }
            }
            const float va = __shfl(v1, lane >> 2); const int ia = __shfl(i1, lane >> 2);
            float cd[4]; int ce[4];
#pragma unroll
            for (int j = 0; j < 4; ++j) { cd[j] = va + __shfl(v2, 4 * (lane & 3) + j); ce[j] = ia * 128 + __shfl(i2, 4 * (lane & 3) + j); }
            float top = NEG; int te = 0;
            for (int r = 0; r < 16; ++r) {
                const float cm = fmaxf(fmaxf(cd[0], cd[1]), fmaxf(cd[2], cd[3])), wm = wave_max(cm); const unsigned long long mk = __ballot(cm == wm); const int src = __ffsll((long long)mk) - 1;
                int mye = ce[3]; asm volatile("" : "+v"(mye)); mye = (cd[2] == wm) ? ce[2] : mye; asm volatile("" : "+v"(mye)); mye = (cd[1] == wm) ? ce[1] : mye; asm volatile("" : "+v"(mye)); mye = (cd[0] == wm) ? ce[0] : mye;
                const int e = __shfl(mye, src);
                if (lane == src) { if (cd[0] == wm) cd[0] = NEG; else if (cd[1] == wm) cd[1] = NEG; else if (cd[2] == wm) cd[2] = NEG; else cd[3] = NEG; }
                if (lane == r) { top = wm; te = e; }
            }
            const float tmax = __shfl(top, 0); const float ex = (lane < 16) ? __expf(top - tmax) : 0.f; const float sum = wave_sum(ex);
            if (lane < 16) { EI[(size_t)t * NSLOT + h * 16 + lane] = te; GT[(size_t)t * NSLOT + h * 16 + lane] = ex / sum; }
        }
    }
}

__device__ __forceinline__ void ld16bf(const bf16* p, float (&o)[16]) {
    const v4u w0 = *(const GAS v4u*)p, w1 = *(const GAS v4u*)(p + 8);
    o[0] = bflo(w0.x); o[1] = bfhi(w0.x); o[2] = bflo(w0.y); o[3] = bfhi(w0.y); o[4] = bflo(w0.z); o[5] = bfhi(w0.z); o[6] = bflo(w0.w); o[7] = bfhi(w0.w);
    o[8] = bflo(w1.x); o[9] = bfhi(w1.x); o[10] = bflo(w1.y); o[11] = bfhi(w1.y); o[12] = bflo(w1.z); o[13] = bfhi(w1.z); o[14] = bflo(w1.w); o[15] = bfhi(w1.w);
}
__device__ __forceinline__ void phase_peer(const Args& A) {
    const int tid = threadIdx.x, lane = tid & 63, wave = tid >> 6, G = gridDim.x;
    const bf16* H = (const bf16*)(A.ws + WS_H); const bf16* U = (const bf16*)(A.ws + WS_U); const bf16* V = (const bf16*)(A.ws + WS_V);
    const int* EI = (const int*)(A.ws + WS_EIDX); const float* GT = (const float*)(A.ws + WS_GATE);
    const float* mod = (const float*)(A.ws + WS_MOD); const float* gpost = (const float*)A.in[I_GPOST2]; float* out = A.out;
    const int vidx = ((lane >> 5) & 1) * 8 + ((lane >> 4) & 1) * 4 + ((lane >> 3) & 1) * 2 + ((lane >> 2) & 1);
    for (int t = blockIdx.x * NWAVES + wave; t < M; t += G * NWAVES) {
        const int b = t / SEQ;
        float hv[16], y[16];
        ld16bf(H + (size_t)t * D + 16 * lane, hv);
#pragma unroll
        for (int i = 0; i < 16; ++i) y[i] = 0.f;
        const int e_lo = EI[(size_t)t * NSLOT + lane], e_hi = EI[(size_t)t * NSLOT + 64 + lane];
        for (int hd = 0; hd < 8; ++hd) {
            float p[16];
#pragma unroll
            for (int k = 0; k < 16; ++k) { const int s = hd * 16 + k; const int e = __shfl(s < 64 ? e_lo : e_hi, s & 63);
                float uu[16]; ld16bf(U + (size_t)e * D + 16 * lane, uu); float d = 0.f;
#pragma unroll
                for (int i = 0; i < 16; ++i) d += uu[i] * hv[i];
                p[k] = d; }
#pragma unroll
            for (int i = 0; i < 8; ++i) { const bool up = (lane & 32) != 0; const float keep = up ? p[i + 8] : p[i], send = up ? p[i] : p[i + 8]; p[i] = keep + __shfl_xor(send, 32); }
#pragma unroll
            for (int i = 0; i < 4; ++i) { const bool up = (lane & 16) != 0; const float keep = up ? p[i + 4] : p[i], send = up ? p[i] : p[i + 4]; p[i] = keep + __shfl_xor(send, 16); }
#pragma unroll
            for (int i = 0; i < 2; ++i) { const bool up = (lane & 8) != 0; const float keep = up ? p[i + 2] : p[i], send = up ? p[i] : p[i + 2]; p[i] = keep + __shfl_xor(send, 8); }
            { const bool up = (lane & 4) != 0; const float keep = up ? p[1] : p[0], send = up ? p[0] : p[1]; p[0] = keep + __shfl_xor(send, 4); }
            float dot = p[0]; dot += __shfl_xor(dot, 2); dot += __shfl_xor(dot, 1);
            const float gt = GT[(size_t)t * NSLOT + hd * 16 + vidx];
            const float act = 0.5f * dot * (1.f + erff(dot * 0.70710678118654752f)) * gt;
#pragma unroll
            for (int k = 0; k < 16; ++k) { const int s = hd * 16 + k; const int e = __shfl(s < 64 ? e_lo : e_hi, s & 63);
                const int src = ((k >> 3) & 1) * 32 + ((k >> 2) & 1) * 16 + ((k >> 1) & 1) * 8 + (k & 1) * 4;
                const float a = __shfl(act, src);
                float vv[16]; ld16bf(V + (size_t)e * D + 16 * lane, vv);
#pragma unroll
                for (int i = 0; i < 16; ++i) y[i] += a * vv[i]; }
        }
        float ss = 0.f;
#pragma unroll
        for (int i = 0; i < 16; ++i) ss += y[i] * y[i];
        const float rstd = 1.0f / sqrtf(wave_sum(ss) * (1.f / D) + EPS);
        float* orow = out + (size_t)t * D + 16 * lane; const float* g2 = mod + b * 6144 + 5120 + 16 * lane; const float* gp = gpost + 16 * lane;
#pragma unroll
        for (int i = 0; i < 4; ++i) { f32x4 xv = *(GAS f32x4*)(orow + 4 * i); const f32x4 gg = *(const GAS f32x4*)(g2 + 4 * i), pp = *(const GAS f32x4*)(gp + 4 * i);
#pragma unroll
            for (int j = 0; j < 4; ++j) xv[j] += gg[j] * (y[4 * i + j] * rstd * pp[j]);
            *(GAS f32x4*)(orow + 4 * i) = xv; }
    }
}
typedef short bf16x8 __attribute__((ext_vector_type(8)));
#define MFMA16(a, b, c) __builtin_amdgcn_mfma_f32_16x16x32_bf16((a), (b), (c), 0, 0, 0)
__device__ __forceinline__ bf16x8 ldfrag(LAS const unsigned char* img, int row, int kbyte) { return *(LAS const bf16x8*)(img + row * 144 + kbyte); }
__device__ __forceinline__ unsigned cvtpk(float lo, float hi) { unsigned r; asm volatile("v_cvt_pk_bf16_f32 %0, %1, %2" : "=v"(r) : "v"(lo), "v"(hi)); return r; }

namespace ml {
constexpr int O_Q = 0, O_QA = 9216, O_K = 18432, O_KWT = 27648, O_VT = 36864, O_CX = 57600, CXB = 20736, O_S = 99072, O_GB = 108288, O_GA = O_GB + 4096, O_GC = O_GA + 4096, O_DEN = O_GC + 4096, O_SSQ = O_DEN + 256, O_END = O_SSQ + 2048;
static_assert(O_END <= 131072, "mlstm LDS");
constexpr size_t MST_SC = 11 * MiB;
}
template <bool OUT>
__device__ __forceinline__ void mlstm_group(const Args& A, LAS unsigned char* lds, int wg) {
    using namespace ml;
    const int tid = threadIdx.x, lane = tid & 63, wave = __builtin_amdgcn_readfirstlane(tid >> 6), fr = lane & 15, fq = lane >> 4;
    const int bh = wg >> 3, grp = wg & 7, b = bh >> 2, h = bh & 3;
    const size_t tg0 = (size_t)b * SEQ + (size_t)grp * 1024;
    const bf16* P = (const bf16*)(A.ws + WS_PROJ); bf16* MI = (bf16*)(A.ws + WS_MIXIN); const float* gates = (const float*)(A.ws + WS_GATES);
    const float* cw = (const float*)A.in[I_CONVW]; const float* ng = (const float*)A.in[I_MNG];
    float* MST = (float*)(A.ws + WS_MST); float* MSC = (float*)(A.ws + WS_MST + MST_SC);
    LAS float* GB = (LAS float*)(lds + O_GB); LAS float* GA = (LAS float*)(lds + O_GA); LAS float* GC = (LAS float*)(lds + O_GC);
    LAS float* DEN = (LAS float*)(lds + O_DEN); LAS float* SSQ = (LAS float*)(lds + O_SSQ);
    __syncthreads();
#pragma unroll
    for (int cc = 0; cc < 2; ++cc) { const int c = 2 * wave + cc; const size_t t = tg0 + c * 64 + lane;
        float bc = gates[t * 8 + 4 + h]; const float ii = gates[t * 8 + h];
#pragma unroll
        for (int o = 1; o < 64; o <<= 1) { const float v = __shfl_up(bc, o); if (lane >= o) bc += v; }
        const float a = ii - bc; float cm = a;
#pragma unroll
        for (int o = 1; o < 64; o <<= 1) { const float v = __shfl_up(cm, o); if (lane >= o) cm = fmaxf(cm, v); }
        GB[c * 64 + lane] = bc; GA[c * 64 + lane] = a; GC[c * 64 + lane] = cm; }
    for (int e = tid; e < 16 * 32; e += NTHR) { const int r = e >> 5, cpair = e & 31; *(LAS unsigned*)(lds + O_VT + (128 + r) * 144 + cpair * 4) = (r == 0) ? 0x3F803F80u : 0u; }
    f32x4 st[5];
#pragma unroll
    for (int i = 0; i < 5; ++i) st[i] = (f32x4){0.f, 0.f, 0.f, 0.f};
    float m = OUT ? 0.f : -__builtin_inff(); float Btot = 0.f;
    if (OUT) {
        for (int gp = 0; gp < grp; ++gp) { const int wgp = bh * 8 + gp; const float mg = MSC[wgp * 2], Bg = MSC[wgp * 2 + 1];
            const float mn = fmaxf(Bg + m, mg), f0 = __expf(Bg + m - mn), f1 = __expf(mg - mn);
#pragma unroll
            for (int i = 0; i < 5; ++i)
#pragma unroll
                for (int r = 0; r < 4; ++r) st[i][r] = f0 * st[i][r] + f1 * MST[((size_t)wgp * 20 + i * 4 + r) * NTHR + tid];
            m = mn; }
#pragma unroll
        for (int j = 0; j < 4; ++j)
#pragma unroll
            for (int r = 0; r < 4; ++r) *(LAS bf16*)(lds + O_CX + (16 * wave + 4 * fq + r) * 144 + (16 * j + fr) * 2) = (bf16)f2bf(st[j][r]);
        if (wave < 4) {
#pragma unroll
            for (int r = 0; r < 4; ++r) *(LAS bf16*)(lds + O_CX + (128 + 4 * fq + r) * 144 + (16 * wave + fr) * 2) = (bf16)f2bf(st[4][r]); }
    }
    float gsc[4];
#pragma unroll
    for (int r = 0; r < 4; ++r) gsc[r] = ng[h * 128 + 16 * wave + 4 * fq + r];
    const int sl = tid >> 3, cg = tid & 7;
    __syncthreads();
    for (int c = 0; c < 16; ++c) {
        const float bL = GB[c * 64 + 63], M63 = fmaxf(m, GC[c * 64 + 63]), decay = __expf(m - M63);
        const size_t tc0 = tg0 + (size_t)c * 64;
        {
            const int sabs = grp * 1024 + c * 64 + sl;
            float aq[8], ak[8];
#pragma unroll
            for (int i = 0; i < 8; ++i) { aq[i] = 0.f; ak[i] = 0.f; }
#pragma unroll
            for (int j = 0; j < 4; ++j) { const int sj = sabs - 3 + j;
                if (sj >= 0) { const bf16* rp = P + ((size_t)b * SEQ + sj) * NPROJ;
                    const v4u wq = *(const GAS v4u*)(rp + C_MQ + h * 64 + 8 * cg), wk = *(const GAS v4u*)(rp + C_MK + h * 64 + 8 * cg);
                    const f32x4 q0 = *(const GAS f32x4*)(cw + j * 512 + h * 64 + 8 * cg), q1 = *(const GAS f32x4*)(cw + j * 512 + h * 64 + 8 * cg + 4);
                    const f32x4 k0 = *(const GAS f32x4*)(cw + j * 512 + 256 + h * 64 + 8 * cg), k1 = *(const GAS f32x4*)(cw + j * 512 + 256 + h * 64 + 8 * cg + 4);
                    aq[0] += q0[0] * bflo(wq.x); aq[1] += q0[1] * bfhi(wq.x); aq[2] += q0[2] * bflo(wq.y); aq[3] += q0[3] * bfhi(wq.y);
                    aq[4] += q1[0] * bflo(wq.z); aq[5] += q1[1] * bfhi(wq.z); aq[6] += q1[2] * bflo(wq.w); aq[7] += q1[3] * bfhi(wq.w);
                    ak[0] += k0[0] * bflo(wk.x); ak[1] += k0[1] * bfhi(wk.x); ak[2] += k0[2] * bflo(wk.y); ak[3] += k0[3] * bfhi(wk.y);
                    ak[4] += k1[0] * bflo(wk.z); ak[5] += k1[1] * bfhi(wk.z); ak[6] += k1[2] * bflo(wk.w); ak[7] += k1[3] * bfhi(wk.w); } }
            const float Ml = fmaxf(m, GC[c * 64 + sl]), ainter = __expf(m - Ml), wsv = __expf(GA[c * 64 + sl] - M63);
            float qv[8], kv[8];
#pragma unroll
            for (int i = 0; i < 8; ++i) { qv[i] = 0.125f * aq[i] * __builtin_amdgcn_rcpf(1.f + __expf(-aq[i])); kv[i] = ak[i] * __builtin_amdgcn_rcpf(1.f + __expf(-ak[i])); }
            if (OUT) {
                v4u w; w.x = pk2(qv[0], qv[1]); w.y = pk2(qv[2], qv[3]); w.z = pk2(qv[4], qv[5]); w.w = pk2(qv[6], qv[7]); *(LAS v4u*)(lds + O_Q + sl * 144 + cg * 16) = w;
                w.x = pk2(qv[0] * ainter, qv[1] * ainter); w.y = pk2(qv[2] * ainter, qv[3] * ainter); w.z = pk2(qv[4] * ainter, qv[5] * ainter); w.w = pk2(qv[6] * ainter, qv[7] * ainter); *(LAS v4u*)(lds + O_QA + sl * 144 + cg * 16) = w;
                w.x = pk2(kv[0], kv[1]); w.y = pk2(kv[2], kv[3]); w.z = pk2(kv[4], kv[5]); w.w = pk2(kv[6], kv[7]); *(LAS v4u*)(lds + O_K + sl * 144 + cg * 16) = w;
            }
#pragma unroll
            for (int i = 0; i < 8; ++i) *(LAS bf16*)(lds + O_KWT + (8 * cg + i) * 144 + sl * 2) = (bf16)f2bf(kv[i] * wsv);
#pragma unroll
            for (int gi = 0; gi < 2; ++gi) { const int g8 = cg + 8 * gi; const v4u wv = *(const GAS v4u*)(P + (tc0 + sl) * NPROJ + C_MV + h * 128 + 8 * g8);
                const unsigned ww[4] = {wv.x, wv.y, wv.z, wv.w};
#pragma unroll
                for (int i = 0; i < 4; ++i) { *(LAS bf16*)(lds + O_VT + (8 * g8 + 2 * i) * 144 + sl * 2) = (bf16)(ww[i] & 0xffffu); *(LAS bf16*)(lds + O_VT + (8 * g8 + 2 * i + 1) * 144 + sl * 2) = (bf16)(ww[i] >> 16); } }
        }
        __syncthreads();
        if (OUT) {
            const int lt = wave >> 1, l = 16 * lt + fr; const float Ml = fmaxf(m, GC[c * 64 + l]);
            const bf16x8 bq0 = ldfrag(lds + O_Q, 16 * lt + fr, 16 * fq), bq1 = ldfrag(lds + O_Q, 16 * lt + fr, 64 + 16 * fq);
#pragma unroll
            for (int u = 0; u < 2; ++u) { const int stl = 2 * (wave & 1) + u; f32x4 acc = {0.f, 0.f, 0.f, 0.f};
                acc = MFMA16(ldfrag(lds + O_K, 16 * stl + fr, 16 * fq), bq0, acc); acc = MFMA16(ldfrag(lds + O_K, 16 * stl + fr, 64 + 16 * fq), bq1, acc);
                const f32x4 av = *(LAS const f32x4*)(GA + c * 64 + 16 * stl + 4 * fq); float wv[4];
#pragma unroll
                for (int r = 0; r < 4; ++r) { const int s = 16 * stl + 4 * fq + r; wv[r] = (s <= l) ? acc[r] * __expf(av[r] - Ml) : 0.f; }
                v2u w; w.x = cvtpk(wv[0], wv[1]); w.y = cvtpk(wv[2], wv[3]); *(LAS v2u*)(lds + O_S + l * 144 + (16 * stl + 4 * fq) * 2) = w; }
        }
        {
            const bf16x8 va0 = ldfrag(lds + O_VT, 16 * wave + fr, 16 * fq), va1 = ldfrag(lds + O_VT, 16 * wave + fr, 64 + 16 * fq);
#pragma unroll
            for (int j = 0; j < 4; ++j) { st[j] = st[j] * decay;
                st[j] = MFMA16(va0, ldfrag(lds + O_KWT, 16 * j + fr, 16 * fq), st[j]); st[j] = MFMA16(va1, ldfrag(lds + O_KWT, 16 * j + fr, 64 + 16 * fq), st[j]); }
            if (wave < 4) { st[4] = st[4] * decay;
                st[4] = MFMA16(ldfrag(lds + O_VT, 128 + fr, 16 * fq), ldfrag(lds + O_KWT, 16 * wave + fr, 16 * fq), st[4]);
                st[4] = MFMA16(ldfrag(lds + O_VT, 128 + fr, 64 + 16 * fq), ldfrag(lds + O_KWT, 16 * wave + fr, 64 + 16 * fq), st[4]); }
        }
        if (OUT) {
            __syncthreads();
            LAS const unsigned char* cx = lds + O_CX + (c & 1) * CXB;
            f32x4 nt[4], nd = {0.f, 0.f, 0.f, 0.f};
            {
                const bf16x8 va0 = ldfrag(lds + O_VT, 16 * wave + fr, 16 * fq), va1 = ldfrag(lds + O_VT, 16 * wave + fr, 64 + 16 * fq);
                const bf16x8 ca0 = ldfrag(cx, 16 * wave + fr, 16 * fq), ca1 = ldfrag(cx, 16 * wave + fr, 64 + 16 * fq);
#pragma unroll
                for (int lt = 0; lt < 4; ++lt) { f32x4 acc = {0.f, 0.f, 0.f, 0.f};
                    acc = MFMA16(va0, ldfrag(lds + O_S, 16 * lt + fr, 16 * fq), acc); acc = MFMA16(va1, ldfrag(lds + O_S, 16 * lt + fr, 64 + 16 * fq), acc);
                    acc = MFMA16(ca0, ldfrag(lds + O_QA, 16 * lt + fr, 16 * fq), acc); acc = MFMA16(ca1, ldfrag(lds + O_QA, 16 * lt + fr, 64 + 16 * fq), acc); nt[lt] = acc; }
                if (wave >= 4) { const int lt = wave - 4;
                    nd = MFMA16(ldfrag(lds + O_VT, 128 + fr, 16 * fq), ldfrag(lds + O_S, 16 * lt + fr, 16 * fq), nd); nd = MFMA16(ldfrag(lds + O_VT, 128 + fr, 64 + 16 * fq), ldfrag(lds + O_S, 16 * lt + fr, 64 + 16 * fq), nd);
                    nd = MFMA16(ldfrag(cx, 128 + fr, 16 * fq), ldfrag(lds + O_QA, 16 * lt + fr, 16 * fq), nd); nd = MFMA16(ldfrag(cx, 128 + fr, 64 + 16 * fq), ldfrag(lds + O_QA, 16 * lt + fr, 64 + 16 * fq), nd);
                    if (fq == 0) DEN[16 * lt + fr] = nd[0]; }
            }
            v2u mo[4];
#pragma unroll
            for (int lt = 0; lt < 4; ++lt) mo[lt] = *(const GAS v2u*)(P + (tc0 + 16 * lt + fr) * NPROJ + C_MO + h * 128 + 16 * wave + 4 * fq);
            __syncthreads();
#pragma unroll
            for (int lt = 0; lt < 4; ++lt) { const int l = 16 * lt + fr; const float Ml = fmaxf(m, GC[c * 64 + l]);
                const float inv = 1.0f / fmaxf(fabsf(DEN[l]), __expf(-(GB[c * 64 + l] + Ml)));
                nt[lt] = nt[lt] * inv; float ss = (nt[lt][0] * nt[lt][0] + nt[lt][1] * nt[lt][1]) + (nt[lt][2] * nt[lt][2] + nt[lt][3] * nt[lt][3]);
                ss += __shfl_xor(ss, 16); ss += __shfl_xor(ss, 32);
                if (fq == 0) SSQ[wave * 64 + l] = ss; }
            LAS unsigned char* cxn = lds + O_CX + ((c + 1) & 1) * CXB;
#pragma unroll
            for (int j = 0; j < 4; ++j)
#pragma unroll
                for (int r = 0; r < 4; ++r) *(LAS bf16*)(cxn + (16 * wave + 4 * fq + r) * 144 + (16 * j + fr) * 2) = (bf16)f2bf(st[j][r]);
            if (wave < 4) {
#pragma unroll
                for (int r = 0; r < 4; ++r) *(LAS bf16*)(cxn + (128 + 4 * fq + r) * 144 + (16 * wave + fr) * 2) = (bf16)f2bf(st[4][r]); }
            __syncthreads();
#pragma unroll
            for (int lt = 0; lt < 4; ++lt) { const int l = 16 * lt + fr; float tot = 0.f;
#pragma unroll
                for (int w2 = 0; w2 < 8; ++w2) tot += SSQ[w2 * 64 + l];
                const float rn = 1.0f / sqrtf(tot * (1.f / 128.f) + EPS);
                const float o0 = nt[lt][0] * rn * gsc[0] * bflo(mo[lt].x), o1 = nt[lt][1] * rn * gsc[1] * bfhi(mo[lt].x), o2 = nt[lt][2] * rn * gsc[2] * bflo(mo[lt].y), o3 = nt[lt][3] * rn * gsc[3] * bfhi(mo[lt].y);
                v2u w; w.x = pk2(o0, o1); w.y = pk2(o2, o3);
                *(GAS v2u*)(MI + (tc0 + l) * D + 512 + h * 128 + 16 * wave + 4 * fq) = w; }
        } else {
            __syncthreads();
        }
        m = bL + M63; Btot += bL;
    }
    if (!OUT) {
#pragma unroll
        for (int i = 0; i < 5; ++i)
#pragma unroll
            for (int r = 0; r < 4; ++r) MST[((size_t)wg * 20 + i * 4 + r) * NTHR + tid] = st[i][r];
        if (tid == 0) { MSC[wg * 2] = m; MSC[wg * 2 + 1] = Btot; }
    }
}

namespace at {
constexpr int O_K = 0, O_VT = 36864, VTS = 560  , O_END = O_VT + 64 * VTS;
static_assert(O_END <= 131072, "attention LDS");
}
__device__ __forceinline__ void phase_attn(const Args& A, LAS unsigned char* lds) {
    using namespace at;
    const int tid = threadIdx.x, lane = tid & 63, wave = __builtin_amdgcn_readfirstlane(tid >> 6), fr = lane & 15, fq = lane >> 4, G = gridDim.x;
    const bf16* P = (const bf16*)(A.ws + WS_PROJ); bf16* MI = (bf16*)(A.ws + WS_MIXIN); const float* sinks = (const float*)A.in[I_SINK];
    __syncthreads();
    for (int e = tid; e < 64 * 12; e += NTHR) { const int r = e / 12, cpair = e % 12; *(LAS unsigned*)(lds + O_VT + r * VTS + 512 + cpair * 4) = 0u; }
    for (int unit = blockIdx.x; unit < NB * 64 * 2; unit += G) {
        const int g = unit & 1, n = (unit >> 1) & 63, b = unit >> 7;
        const size_t tq0 = (size_t)b * SEQ + (size_t)n * 128;
        __syncthreads();
#pragma unroll
        for (int i = 0; i < 4; ++i) { const int item = tid + NTHR * i, row = item >> 3, ch = item & 7;
            v4u wk = {0u, 0u, 0u, 0u}, wv = {0u, 0u, 0u, 0u};
            if (n > 0 || row >= 128) { const bf16* rp = P + (tq0 - 128 + row) * NPROJ; wk = *(const GAS v4u*)(rp + C_AK + g * 64 + 8 * ch); wv = *(const GAS v4u*)(rp + C_AV + g * 64 + 8 * ch); }
            *(LAS v4u*)(lds + O_K + row * 144 + ch * 16) = wk;
            const unsigned ww[4] = {wv.x, wv.y, wv.z, wv.w};
#pragma unroll
            for (int k = 0; k < 4; ++k) { *(LAS bf16*)(lds + O_VT + (8 * ch + 2 * k) * VTS + row * 2) = (bf16)(ww[k] & 0xffffu); *(LAS bf16*)(lds + O_VT + (8 * ch + 2 * k + 1) * VTS + row * 2) = (bf16)(ww[k] >> 16); } }
        const int hq = 4 * g + (wave >> 1), qr0 = 64 * (wave & 1); const float sink = sinks[hq];
        __syncthreads();
        for (int qt = 0; qt < 4; ++qt) {
            const int i0 = qr0 + 16 * qt, st0 = i0 >> 4, iq = i0 + fr;
            const bf16* qp = P + (tq0 + iq) * NPROJ + C_AQ + hq * 64 + 8 * fq;
            const bf16x8 bq0 = *(const GAS bf16x8*)qp, bq1 = *(const GAS bf16x8*)(qp + 32);
            f32x4 sc[9]; float mx = sink;
#pragma unroll
            for (int t = 0; t < 9; ++t) { const int sb0 = 16 * (st0 + t); f32x4 acc = {0.f, 0.f, 0.f, 0.f};
                acc = MFMA16(ldfrag(lds + O_K, sb0 + fr, 16 * fq), bq0, acc); acc = MFMA16(ldfrag(lds + O_K, sb0 + fr, 64 + 16 * fq), bq1, acc);
#pragma unroll
                for (int r = 0; r < 4; ++r) { const int sb = sb0 + 4 * fq + r; const bool valid = (sb > iq) && (sb <= iq + 128) && (n > 0 || sb >= 128);
                    acc[r] = valid ? acc[r] : -3.0e38f; mx = fmaxf(mx, acc[r]); }
                sc[t] = acc; }
            mx = fmaxf(mx, __shfl_xor(mx, 16)); mx = fmaxf(mx, __shfl_xor(mx, 32));
            float lsum = 0.f;
#pragma unroll
            for (int t = 0; t < 9; ++t)
#pragma unroll
                for (int r = 0; r < 4; ++r) { const float p = (sc[t][r] > -1.0e38f) ? __expf(sc[t][r] - mx) : 0.f; sc[t][r] = p; lsum += p; }
            lsum += __shfl_xor(lsum, 16); lsum += __shfl_xor(lsum, 32); lsum += __expf(sink - mx);
            f32x4 oacc[4];
#pragma unroll
            for (int dt = 0; dt < 4; ++dt) oacc[dt] = (f32x4){0.f, 0.f, 0.f, 0.f};
#pragma unroll
            for (int ks = 0; ks < 5; ++ks) {
                union { bf16x8 v; unsigned u[4]; } pb;
                pb.u[0] = cvtpk(sc[2 * ks][0], sc[2 * ks][1]); pb.u[1] = cvtpk(sc[2 * ks][2], sc[2 * ks][3]);
                if (ks < 4) { pb.u[2] = cvtpk(sc[2 * ks + 1][0], sc[2 * ks + 1][1]); pb.u[3] = cvtpk(sc[2 * ks + 1][2], sc[2 * ks + 1][3]); } else { pb.u[2] = 0u; pb.u[3] = 0u; }
                const int sbb = 16 * (st0 + 2 * ks) + 4 * fq;
#pragma unroll
                for (int dt = 0; dt < 4; ++dt) { LAS const unsigned char* vp = lds + O_VT + (16 * dt + fr) * VTS + sbb * 2;
                    union { bf16x8 v; v2u h[2]; } va; va.h[0] = *(LAS const v2u*)vp; va.h[1] = *(LAS const v2u*)(vp + 32);
                    oacc[dt] = MFMA16(va.v, pb.v, oacc[dt]); } }
            const float il = 1.0f / lsum;
#pragma unroll
            for (int dt = 0; dt < 4; ++dt) { v2u w; w.x = pk2(oacc[dt][0] * il, oacc[dt][1] * il); w.y = pk2(oacc[dt][2] * il, oacc[dt][3] * il);
                *(GAS v2u*)(MI + (tq0 + iq) * D + hq * 64 + 16 * dt + 4 * fq) = w; }
        }
    }
}
typedef float f32x16 __attribute__((ext_vector_type(16)));
__device__ __forceinline__ unsigned fbits(float f) { return __builtin_bit_cast(unsigned, f); }
__device__ __forceinline__ float bfloat(unsigned u) { return __builtin_bit_cast(float, u); }

#define CE_DESC(a, b) do { const float _mx = __builtin_fmaxf(a, b), _mn = __builtin_fminf(a, b); a = _mx; b = _mn; } while (0)
__device__ __forceinline__ void bsort16(float (&v)[16]) {
#pragma unroll
    for (int k = 2; k <= 16; k <<= 1)
#pragma unroll
        for (int j = k >> 1; j > 0; j >>= 1)
#pragma unroll
            for (int i = 0; i < 16; ++i) { const int l = i ^ j; if (l > i) { if ((i & k) == 0) CE_DESC(v[i], v[l]); else CE_DESC(v[l], v[i]); } }
}
__device__ __forceinline__ void bmerge16(float (&v)[16], const float (&w)[16]) {
#pragma unroll
    for (int i = 0; i < 16; ++i) v[i] = __builtin_fmaxf(v[i], w[15 - i]);
#pragma unroll
    for (int j = 8; j > 0; j >>= 1)
#pragma unroll
        for (int i = 0; i < 16; ++i) { const int l = i ^ j; if (l > i) CE_DESC(v[i], v[l]); }
}
namespace tk {
constexpr int KS = 272;
constexpr int O_K1 = 0, O_K2 = 128 * KS, O_X = 2 * 128 * KS, O_END = O_X + 8 * 4096;
static_assert(O_END <= 131072, "topk LDS");
constexpr unsigned char CAND[64] = {
    0x00, 0x01, 0x02, 0x03, 0x04, 0x05, 0x06, 0x07, 0x08, 0x09, 0x0a, 0x0b, 0x0c, 0x0d, 0x0e, 0x0f,
    0x10, 0x11, 0x12, 0x13, 0x14, 0x15, 0x16, 0x17, 0x80, 0x90, 0xa0, 0xb0, 0xc0, 0xd0, 0xe0, 0xf0,
    0x20, 0x21, 0x22, 0x23, 0x24, 0x30, 0x31, 0x32, 0x33, 0x40, 0x41, 0x42, 0x50, 0x51, 0x60, 0x61,
    0x70, 0x71, 0xff, 0xff, 0xff, 0xff, 0xff, 0xff, 0xff, 0xff, 0xff, 0xff, 0xff, 0xff, 0xff, 0xff};
}
__device__ __forceinline__ void side_top16(const f32x16 (&acc)[4], int hh, float (&T)[16]) {
    float g1[16], g2[16];
#pragma unroll
    for (int r = 0; r < 16; ++r) { const unsigned key = (r & 3) + 8 * (r >> 2) + 4 * hh;
        T[r] = bfloat((fbits(acc[0][r]) & 0xffffff80u) | key);
        g1[r] = bfloat((fbits(acc[1][r]) & 0xffffff80u) | (32u + key)); }
    bsort16(T); bsort16(g1); bmerge16(T, g1);
#pragma unroll
    for (int r = 0; r < 16; ++r) { const unsigned key = (r & 3) + 8 * (r >> 2) + 4 * hh;
        g1[r] = bfloat((fbits(acc[2][r]) & 0xffffff80u) | (64u + key));
        g2[r] = bfloat((fbits(acc[3][r]) & 0xffffff80u) | (96u + key)); }
    bsort16(g1); bsort16(g2); bmerge16(g1, g2); bmerge16(T, g1);
#pragma unroll
    for (int r = 0; r < 16; ++r) g1[r] = __shfl_xor(T[r], 32);
    bmerge16(T, g1);
}
template <int SD> __device__ __forceinline__ void topk_side(const bf16* Q, LAS unsigned char* lds, int t, int h, int r32, int hh, float (&T)[16]) {
    using namespace tk;
    f32x16 acc[4];
#pragma unroll
    for (int mt = 0; mt < 4; ++mt)
#pragma unroll
        for (int r = 0; r < 16; ++r) acc[mt][r] = 0.f;
    const bf16* qp = Q + (size_t)t * 2048 + h * 256 + SD * 128 + 8 * hh; LAS const unsigned char* kimg = lds + (SD ? O_K2 : O_K1);
#pragma unroll
    for (int ks = 0; ks < 8; ++ks) { const bf16x8 bq = *(const GAS bf16x8*)(qp + 16 * ks);
#pragma unroll
        for (int mt = 0; mt < 4; ++mt) acc[mt] = __builtin_amdgcn_mfma_f32_32x32x16_bf16(*(LAS const bf16x8*)(kimg + (32 * mt + r32) * KS + 32 * ks + 16 * hh), bq, acc[mt], 0, 0, 0); }
    side_top16(acc, hh, T);
}
template <int Q> __device__ __forceinline__ float cand_val(const float (&T1)[16], const float (&T2)[16], int hh) {
    constexpr unsigned c0 = tk::CAND[2 * Q], c1 = tk::CAND[2 * Q + 1];
    const float s = (hh ? T1[(c1 >> 4) & 15] : T1[(c0 >> 4) & 15]) + (hh ? T2[c1 & 15] : T2[c0 & 15]); const unsigned code = hh ? c1 : c0;
    return (code == 0xffu) ? -3.0e38f : bfloat((fbits(s) & 0xffffff00u) | code);
}
__device__ __forceinline__ void phase_topk(const Args& A, LAS unsigned char* lds) {
    using namespace tk;
    const int tid = threadIdx.x, lane = tid & 63, wave = __builtin_amdgcn_readfirstlane(tid >> 6), G = gridDim.x;
    const bf16* Q = (const bf16*)(A.ws + WS_PROJ); const bf16* KB = (const bf16*)(A.ws + WS_KEYS);
    int* EI = (int*)(A.ws + WS_EIDX); float* GT = (float*)(A.ws + WS_GATE);
    const int h = blockIdx.x & 7, r32 = lane & 31, hh = lane >> 5;
    __syncthreads();
    for (int e = tid; e < 2 * 128 * 16; e += NTHR) { const int s = e >> 11, row = (e >> 4) & 127, ch = e & 15;
        *(LAS v4u*)(lds + (s ? O_K2 : O_K1) + row * KS + ch * 16) = *(const GAS v4u*)(KB + (size_t)s * 8 * 128 * 128 + ((size_t)h * 128 + row) * 128 + ch * 8); }
    __syncthreads();
    LAS float* XW = (LAS float*)(lds + O_X + wave * 4096) + r32 * 32;
    for (int tile = (int)(blockIdx.x >> 3); tile < M / 256; tile += (G >> 3)) {
        const int t = tile * 256 + 32 * wave + r32;
        float T1[16], T2[16];
        topk_side<0>(Q, lds, t, h, r32, hh, T1);
        topk_side<1>(Q, lds, t, h, r32, hh, T2);
        float c[16], w[16];
        c[0] = cand_val<0>(T1, T2, hh); w[0] = cand_val<16>(T1, T2, hh);
        c[1] = cand_val<1>(T1, T2, hh); w[1] = cand_val<17>(T1, T2, hh);
        c[2] = cand_val<2>(T1, T2, hh); w[2] = cand_val<18>(T1, T2, hh);
        c[3] = cand_val<3>(T1, T2, hh); w[3] = cand_val<19>(T1, T2, hh);
        c[4] = cand_val<4>(T1, T2, hh); w[4] = cand_val<20>(T1, T2, hh);
        c[5] = cand_val<5>(T1, T2, hh); w[5] = cand_val<21>(T1, T2, hh);
        c[6] = cand_val<6>(T1, T2, hh); w[6] = cand_val<22>(T1, T2, hh);
        c[7] = cand_val<7>(T1, T2, hh); w[7] = cand_val<23>(T1, T2, hh);
        c[8] = cand_val<8>(T1, T2, hh); w[8] = cand_val<24>(T1, T2, hh);
        c[9] = cand_val<9>(T1, T2, hh); w[9] = cand_val<25>(T1, T2, hh);
        c[10] = cand_val<10>(T1, T2, hh); w[10] = cand_val<26>(T1, T2, hh);
        c[11] = cand_val<11>(T1, T2, hh); w[11] = cand_val<27>(T1, T2, hh);
        c[12] = cand_val<12>(T1, T2, hh); w[12] = cand_val<28>(T1, T2, hh);
        c[13] = cand_val<13>(T1, T2, hh); w[13] = cand_val<29>(T1, T2, hh);
        c[14] = cand_val<14>(T1, T2, hh); w[14] = cand_val<30>(T1, T2, hh);
        c[15] = cand_val<15>(T1, T2, hh); w[15] = cand_val<31>(T1, T2, hh);
        bsort16(c); bsort16(w); bmerge16(c, w);
#pragma unroll
        for (int r = 0; r < 16; ++r) w[r] = __shfl_xor(c[r], 32);
        bmerge16(c, w);
        if (hh == 0) {
#pragma unroll
            for (int q4 = 0; q4 < 4; ++q4) { *(LAS f32x4*)(XW + 4 * q4) = (f32x4){T1[4 * q4], T1[4 * q4 + 1], T1[4 * q4 + 2], T1[4 * q4 + 3]};
                *(LAS f32x4*)(XW + 16 + 4 * q4) = (f32x4){T2[4 * q4], T2[4 * q4 + 1], T2[4 * q4 + 2], T2[4 * q4 + 3]}; } }
        asm volatile("s_waitcnt lgkmcnt(0)" ::: "memory");
        float ex[16], sum = 0.f; const float tmax = bfloat(fbits(c[0]) & 0xffffff00u);
#pragma unroll
        for (int r = 0; r < 16; ++r) { ex[r] = __expf(bfloat(fbits(c[r]) & 0xffffff00u) - tmax); sum += ex[r]; }
        const float isum = 1.0f / sum; const size_t ob = (size_t)t * NSLOT + h * 16 + 8 * hh;
        unsigned eo[8]; float go[8];
#pragma unroll
        for (int r = 0; r < 8; ++r) { float ca = c[r], cb = c[8 + r], ea = ex[r], eb = ex[8 + r]; asm volatile("" : "+v"(ca), "+v"(cb), "+v"(ea), "+v"(eb)); const float cv = hh ? cb : ca, ev = hh ? eb : ea;
            const unsigned code = fbits(cv) & 0xffu;
            const unsigned i1 = fbits(XW[code >> 4]) & 127u, i2 = fbits(XW[16 + (code & 15)]) & 127u;
            eo[r] = i1 * 128u + i2; go[r] = ev * isum; }
        *(GAS v4u*)(EI + ob) = (v4u){eo[0], eo[1], eo[2], eo[3]}; *(GAS v4u*)(EI + ob + 4) = (v4u){eo[4], eo[5], eo[6], eo[7]};
        *(GAS f32x4*)(GT + ob) = (f32x4){go[0], go[1], go[2], go[3]}; *(GAS f32x4*)(GT + ob + 4) = (f32x4){go[4], go[5], go[6], go[7]};
        asm volatile("s_waitcnt lgkmcnt(0)" ::: "memory");
    }
}
#ifndef MK_N_LAUNCHES
#define MK_N_LAUNCHES 1
#endif
constexpr int N_PHASES = 10;
__global__ void __launch_bounds__(NTHR, 2) hymba_fwd(Args A) {
    extern __shared__ __attribute__((aligned(16))) unsigned char lds_raw[];
    LAS unsigned char* lds = (LAS unsigned char*)lds_raw;
    const int lo = A.ph_lo, hi = A.ph_hi;
    unsigned char* ws = A.ws;
#define IN(k) (lo <= (k) && (k) < hi)
#define SEAM(k) do { if (IN(k) && IN((k) + 1)) { cg::this_grid().sync(); } } while (0)

    if (IN(0)) { phase_prologue(A, lds); } SEAM(0);
    if (IN(1)) { phase_prenorm(A); } SEAM(1);
    if (IN(2)) {
        pg8::Gemm g{(const pg8::bf16_t*)(ws + WS_H), (const pg8::bf16_t*)(ws + WS_WIN), M, NIN_PAD, D}; pg8::StaticOrder S; S.init(M, NIN_PAD, gridDim.x, (int)blockIdx.x);
        pg8::EpiProj E{(pg8::bf16_t*)(ws + WS_PROJ), NPROJ, (float*)(ws + WS_GATES), (const int*)A.in[I_POS], (const float*)A.in[I_BI], (const float*)A.in[I_BF]};
        pg8::gemm_phase<pg8::EpiProj, pg8::StaticOrder, true, true>(lds, g, S, E);
    } SEAM(2);
    if (IN(3)) {
        phase_attn(A, lds);
        for (int wg = blockIdx.x; wg < 256; wg += gridDim.x) mlstm_group<false>(A, lds, wg);
    } SEAM(3);
    if (IN(4)) { for (int wg = blockIdx.x; wg < 256; wg += gridDim.x) mlstm_group<true>(A, lds, wg); } SEAM(4);
    if (IN(5)) {
        pg8::Gemm g{(const pg8::bf16_t*)(ws + WS_MIXIN), (const pg8::bf16_t*)(ws + WS_WOUT), M, D, D}; pg8::StaticOrder S; S.init(M, D, gridDim.x, (int)blockIdx.x);
        pg8::EpiMix E{(pg8::bf16_t*)(ws + WS_MIX), D, (float*)(ws + WS_SSQ)};
        pg8::gemm_phase<pg8::EpiMix, pg8::StaticOrder, true, true>(lds, g, S, E);
    } SEAM(5);
    if (IN(6)) { phase_mid(A); } SEAM(6);
    if (IN(7)) {
        pg8::Gemm g{(const pg8::bf16_t*)(ws + WS_H), (const pg8::bf16_t*)(ws + WS_WQ), M, 2048, D}; pg8::StaticOrder S; S.init(M, 2048, gridDim.x, (int)blockIdx.x);
        pg8::EpiPlain E{(pg8::bf16_t*)(ws + WS_PROJ), 2048};
        pg8::gemm_phase<pg8::EpiPlain, pg8::StaticOrder, true, true>(lds, g, S, E);
    } SEAM(7);
    if (IN(8)) { phase_topk(A, lds); } SEAM(8);
    if (IN(9)) { phase_peer(A); }
#undef IN
#undef SEAM
}

extern "C" void kernel_launch(void* const* d_in, const int* in_sizes, int n_in, void* d_out, int out_size, void* d_ws, size_t ws_size, hipStream_t stream) {
    static int grid = 0;
    if (grid == 0) {
        if (n_in != 21 || in_sizes[0] != M * D || out_size != M * D || ws_size < WS_END) { fprintf(stderr, "kernel_launch: unexpected shapes (n_in %d, in0 %d, out %d, ws %zu < %zu)\n", n_in, n_in > 0 ? in_sizes[0] : -1, out_size, ws_size, (size_t)WS_END); grid = -1; return; }
        int dev = 0, cus = 0, per_cu = 0;
        if (hipGetDevice(&dev) != hipSuccess || hipDeviceGetAttribute(&cus, hipDeviceAttributeMultiprocessorCount, dev) != hipSuccess) { grid = -1; return; }
        if (hipFuncSetAttribute((const void*)hymba_fwd, hipFuncAttributeMaxDynamicSharedMemorySize, LDS_BYTES) != hipSuccess) { fprintf(stderr, "kernel_launch: hipFuncSetAttribute failed\n"); grid = -1; return; }
        if (hipOccupancyMaxActiveBlocksPerMultiprocessor(&per_cu, (const void*)hymba_fwd, NTHR, LDS_BYTES) != hipSuccess || per_cu < 1) { fprintf(stderr, "kernel_launch: occupancy query says %d blocks per CU\n", per_cu); per_cu = 1; }
        (void)hipGetLastError();
        grid = cus;
        if (grid != 256) fprintf(stderr, "kernel_launch: note: %d CUs (built for 256)\n", grid);
    }
    if (grid < 0) return;
    (void)hipMemsetAsync((char*)d_ws + WS_CTL, 0, CTL_ZERO_BYTES, stream);
    Args a{};
    for (int i = 0; i < 21; ++i) a.in[i] = d_in[i];
    a.out = (float*)d_out; a.ws = (unsigned char*)d_ws;
    if (MK_N_LAUNCHES == 1) {
        a.ph_lo = 0; a.ph_hi = N_PHASES;
        void* args[] = {&a};
        const hipError_t e = hipLaunchCooperativeKernel((const void*)hymba_fwd, dim3(grid), dim3(NTHR), args, LDS_BYTES, stream);
        if (e != hipSuccess) fprintf(stderr, "kernel_launch: cooperative launch failed: %s (grid %d)\n", hipGetErrorString(e), grid);
    } else {
        for (int p = 0; p < N_PHASES; ++p) { a.ph_lo = p; a.ph_hi = p + 1; hipLaunchKernelGGL(hymba_fwd, dim3(grid), dim3(NTHR), LDS_BYTES, stream, a); }
    }
}
```

```cpp
#include <hip/hip_runtime.h>
#include <hip/hip_cooperative_groups.h>
#include <cstdio>
#include <cstdint>
namespace cg = cooperative_groups;
namespace pg8 {
#define PG8_LAS __attribute__((address_space(3)))
typedef unsigned short bf16_t;
typedef short bf16x8 __attribute__((ext_vector_type(8)));
typedef float f32x4 __attribute__((ext_vector_type(4)));
typedef unsigned u32x4 __attribute__((ext_vector_type(4)));
constexpr int BM = 256, BK = 64, HALF = 128, HTB = HALF * BK * 2  , STAGE_BYTES = 8 * HTB, NXCD = 8, WGM = 8;

__host__ __device__ __forceinline__ int lds_byte(int r, int c) { const int st = (r >> 4) * 2 + (c >> 5), rr = r & 15, cc = c & 31, ob = rr * 64 + cc * 2; return st * 1024 + (ob ^ (((ob >> 9) & 1) << 5)); }
__host__ __device__ __forceinline__ void stage_rc(int b, int& R, int& C) { const int st = b / 1024, sb = b % 1024, swz = sb ^ (((sb >> 9) & 1) << 5); R = (st >> 1) * 16 + swz / 64; C = (st & 1) * 32 + (swz % 64) / 2; }
__host__ __device__ __forceinline__ int perm32(int rho) { const int n = rho >> 4, i = rho & 15; return 8 * (i >> 2) + 4 * n + (i & 3); }

struct Unit { int pm, pn; };
struct Gemm { const bf16_t* A; const bf16_t* Bt; int M, N, K; };

struct StaticOrder {
    int nM, nN, nwg, G, c;
    __host__ __device__ void init(int M, int N, int G_, int c_) { nM = M / BM; nN = N / BM; nwg = nM * nN; G = G_; c = c_; }
    __host__ __device__ bool next(int i, Unit& u) const {
        const long L = (long)i * G + c; if (L >= nwg) return false;
        int wgid = (int)L; { const int q = nwg / NXCD, r = nwg % NXCD, xcd = wgid % NXCD, off = wgid / NXCD; wgid = (xcd < r ? xcd * (q + 1) : r * (q + 1) + (xcd - r) * q) + off; }
        const int nig = WGM * nN, gid = wgid / nig, fm = gid * WGM, gsz = (nM - fm) < WGM ? (nM - fm) : WGM;
        u.pm = fm + ((wgid % nig) % gsz); u.pn = (wgid % nig) / gsz; return true;
    }
    __device__ __forceinline__ void a_ready(const Unit&) const {}
    __device__ __forceinline__ void done(const Unit&) const {}
};

__device__ __forceinline__ unsigned cvt_pk_bf16(float lo, float hi) { unsigned r; asm volatile("v_cvt_pk_bf16_f32 %0, %1, %2" : "=v"(r) : "v"(lo), "v"(hi)); return r; }
typedef float f32x2 __attribute__((ext_vector_type(2)));
__device__ __forceinline__ f32x2 gelu_pk(f32x2 v) {
    const f32x2 av = __builtin_elementwise_abs(v), d = av * 0.2316418882f + 1.0f;
    f32x2 t; t.x = __builtin_amdgcn_rcpf(d.x); t.y = __builtin_amdgcn_rcpf(d.y);
    f32x2 q = t * 0.5307027145f + (-0.7265760135f); q = q * t + 0.7107068705f; q = q * t + (-0.142248368f); q = q * t + 0.127414796f; q = q * t;
    const f32x2 s = (v * v) * (-0.72134752044f);
    f32x2 e; e.x = __builtin_amdgcn_exp2f(s.x); e.y = __builtin_amdgcn_exp2f(s.y);
    const f32x2 m = v * (q * e), r = v - m;
    f32x2 o; o.x = v.x < 0.f ? m.x : r.x; o.y = v.y < 0.f ? m.y : r.y; return o;
}

__device__ __forceinline__ u32x4 pack8(const f32x4 v0, const f32x4 v1) { u32x4 w; w.x = cvt_pk_bf16(v0[0], v0[1]); w.y = cvt_pk_bf16(v0[2], v0[3]); w.z = cvt_pk_bf16(v1[0], v1[1]); w.w = cvt_pk_bf16(v1[2], v1[3]); return w; }

struct EpiPlain {
    static constexpr bool PERM = true, AFTER_DRAIN = false;
    bf16_t* O; int ldc;
    __device__ __forceinline__ void operator()(const f32x4 (&acc)[2][2][4][2], const Unit& u, int wr, int wc, int fr, int fq) const {
        const int row0 = u.pm * BM + wr * 64 + fr, col0 = u.pn * BM + wc * 32 + 8 * fq;
#pragma unroll
        for (int ai = 0; ai < 2; ++ai)
#pragma unroll
            for (int m = 0; m < 4; ++m) { bf16_t* rowp = O + (size_t)(row0 + ai * HALF + m * 16) * ldc + col0;
#pragma unroll
                for (int bj = 0; bj < 2; ++bj) *(u32x4*)(rowp + bj * HALF) = pack8(acc[ai][bj][m][0], acc[ai][bj][m][1]); }
    }
};

struct EpiProj {
    static constexpr bool PERM = true, AFTER_DRAIN = false;
    bf16_t* P; int ldc; float* gates; const int* pos; const float* b_i; const float* b_f;
    __device__ __forceinline__ void operator()(const f32x4 (&acc)[2][2][4][2], const Unit& u, int wr, int wc, int fr, int fq) const {
        const int row0 = u.pm * BM + wr * 64 + fr, col0 = u.pn * BM + wc * 32 + 8 * fq, pn = u.pn;
        if (pn == 9) {
            if (wc == 0 && fq == 0) {
                const f32x4 bi = {b_i[0], b_i[1], b_i[2], b_i[3]}, bf = {b_f[0], b_f[1], b_f[2], b_f[3]};
#pragma unroll
                for (int ai = 0; ai < 2; ++ai)
#pragma unroll
                    for (int m = 0; m < 4; ++m) { const int row = row0 + ai * HALF + m * 16;
                        const f32x4 iv = acc[ai][0][m][0] + bi, fv = acc[ai][0][m][1] + bf; f32x4 lf;
#pragma unroll
                        for (int j = 0; j < 4; ++j) lf[j] = fminf(fv[j], 0.f) - log1pf(__expf(-fabsf(fv[j])));
                        *(f32x4*)(gates + (size_t)row * 8) = iv; *(f32x4*)(gates + (size_t)row * 8 + 4) = lf; }
            }
            return;
        }
#pragma unroll
        for (int ai = 0; ai < 2; ++ai)
#pragma unroll
            for (int m = 0; m < 4; ++m) { const int row = row0 + ai * HALF + m * 16; bf16_t* rowp = P + (size_t)row * ldc + col0;
                const float posf = (pn <= 2) ? (float)pos[row] : 0.f;
#pragma unroll
                for (int bj = 0; bj < 2; ++bj) { f32x4 v0 = acc[ai][bj][m][0], v1 = acc[ai][bj][m][1];
                    const bool rope = (pn < 2) || (pn == 2 && bj == 0);
                    if (rope) {
                        const int p0 = ((col0 + bj * HALF) & 63) >> 1; const float sc = (pn < 2) ? 0.125f : 1.0f;
                        float x[8] = {v0[0], v0[1], v0[2], v0[3], v1[0], v1[1], v1[2], v1[3]};
#pragma unroll
                        for (int q = 0; q < 4; ++q) { const float invf = __builtin_amdgcn_exp2f(-(float)(p0 + q) * 0.41524101186092029f);
                            float r = posf * invf * 0.15915494309189535f; r = r - floorf(r);
                            const float c = __builtin_amdgcn_cosf(r) * sc, s = __builtin_amdgcn_sinf(r) * sc;
                            const float x1 = x[2 * q], x2 = x[2 * q + 1]; x[2 * q] = x1 * c - x2 * s; x[2 * q + 1] = x2 * c + x1 * s; }
                        v0 = (f32x4){x[0], x[1], x[2], x[3]}; v1 = (f32x4){x[4], x[5], x[6], x[7]};
                    } else if (pn >= 7) {
#pragma unroll
                        for (int j = 0; j < 4; ++j) { v0[j] = __builtin_amdgcn_rcpf(1.f + __expf(-v0[j])); v1[j] = __builtin_amdgcn_rcpf(1.f + __expf(-v1[j])); }
                    }
                    *(u32x4*)(rowp + bj * HALF) = pack8(v0, v1); } }
    }
};

struct EpiMix {
    static constexpr bool PERM = true, AFTER_DRAIN = false;
    bf16_t* O; int ldc; float* sumsq;
    __device__ __forceinline__ void operator()(const f32x4 (&acc)[2][2][4][2], const Unit& u, int wr, int wc, int fr, int fq) const {
        const int row0 = u.pm * BM + wr * 64 + fr, col0 = u.pn * BM + wc * 32 + 8 * fq;
#pragma unroll
        for (int ai = 0; ai < 2; ++ai)
#pragma unroll
            for (int m = 0; m < 4; ++m) { const int row = row0 + ai * HALF + m * 16; bf16_t* rowp = O + (size_t)row * ldc + col0; float s = 0.f;
#pragma unroll
                for (int bj = 0; bj < 2; ++bj) { const f32x4 v0 = acc[ai][bj][m][0], v1 = acc[ai][bj][m][1];
                    s += (v0[0] * v0[0] + v0[1] * v0[1]) + (v0[2] * v0[2] + v0[3] * v0[3]) + (v1[0] * v1[0] + v1[1] * v1[1]) + (v1[2] * v1[2] + v1[3] * v1[3]);
                    *(u32x4*)(rowp + bj * HALF) = pack8(v0, v1); }
                s += __shfl_xor(s, 16); s += __shfl_xor(s, 32);
                if (fq == 0) sumsq[(size_t)row * 16 + u.pn * 4 + wc] = s; }
    }
};
template <class Epi, class Sched, bool ALIGN_EPI = false, bool SP2 = false>
__device__ __forceinline__ void gemm_phase(PG8_LAS unsigned char* lds, const Gemm g, const Sched& S, const Epi& E) {
    const int tid = threadIdx.x, wid = __builtin_amdgcn_readfirstlane(tid >> 6), lane = tid & 63, wr = wid >> 2, wc = wid & 3, fr = lane & 15, fq = lane >> 4;
    const int K = g.K, nt = K / BK;
    unsigned voffA[2], voffB[2];
#pragma unroll
    for (int i = 0; i < 2; ++i) { int R, C; stage_rc(tid * 16 + i * 8192, R, C); const int Rb = Epi::PERM ? ((R & ~31) + perm32(R & 31)) : R;
        voffA[i] = (unsigned)(R * K + C) * 2u; voffB[i] = (unsigned)(Rb * K + C) * 2u; }
    const size_t kstep = (size_t)(BK * 2);
    const size_t hstep = (size_t)HALF * K * 2;
    const size_t tstep = 2 * hstep;
    const unsigned ldsw = (unsigned)wid * 1024u;
    const int aoff = lds_byte(wr * 64 + fr, fq * 8), boff = lds_byte(wc * 32 + fr, fq * 8);
#define PG8_SA(b, h) (((b) * 2 + (h)) * HTB)
#define PG8_SB(b, h) ((4 + (b) * 2 + (h)) * HTB)
#define PG8_STAGE(bufoff, gbase, voff) do { _Pragma("unroll") for (int _i = 0; _i < 2; ++_i) \
        __builtin_amdgcn_global_load_lds((const unsigned*)((const char*)(gbase) + (voff)[_i]), (PG8_LAS unsigned*)(lds + (bufoff) + ldsw + _i * 8192), 16, 0, 0); } while (0)
#define PG8_LDA(dst, b, h) do { _Pragma("unroll") for (int m = 0; m < 4; ++m) _Pragma("unroll") for (int k = 0; k < 2; ++k) dst[m][k] = *(const PG8_LAS bf16x8*)(lds + PG8_SA(b, h) + aoff + m * 2048 + k * 1024); } while (0)
#define PG8_LDB(dst, b, h) do { _Pragma("unroll") for (int n = 0; n < 2; ++n) _Pragma("unroll") for (int k = 0; k < 2; ++k) dst[n][k] = *(const PG8_LAS bf16x8*)(lds + PG8_SB(b, h) + boff + n * 2048 + k * 1024); } while (0)
#define PG8_MMA(ai, bj, At, Bt) do { __builtin_amdgcn_s_setprio(1); _Pragma("unroll") for (int m = 0; m < 4; ++m) _Pragma("unroll") for (int n = 0; n < 2; ++n) _Pragma("unroll") for (int k = 0; k < 2; ++k) \
        acc[ai][bj][m][n] = __builtin_amdgcn_mfma_f32_16x16x32_bf16(Bt[n][k], At[m][k], acc[ai][bj][m][n], 0, 0, 0); __builtin_amdgcn_s_setprio(0); } while (0)
#define PG8_WAIT_V(n) asm volatile("s_waitcnt vmcnt(" #n ")" ::: "memory")
#define PG8_WAIT_L(n) asm volatile("s_waitcnt lgkmcnt(" #n ")" ::: "memory")
#define PG8_BAR __builtin_amdgcn_s_barrier()
#define PG8_SCHED __builtin_amdgcn_sched_barrier(0)
    Unit cur, nxt; int ui = 0;
    if (!S.next(0, cur)) return;
    f32x4 acc[2][2][4][2];
#pragma unroll
    for (int a = 0; a < 2; ++a)
#pragma unroll
        for (int b = 0; b < 2; ++b)
#pragma unroll
            for (int m = 0; m < 4; ++m)
#pragma unroll
                for (int n = 0; n < 2; ++n) acc[a][b][m][n] = (f32x4){0.f, 0.f, 0.f, 0.f};
    bf16x8 At[4][2], B0[2][2], B1[2][2];
    const char* cA = (const char*)g.A + (size_t)cur.pm * tstep; const char* cB = (const char*)g.Bt + (size_t)cur.pn * tstep;
    S.a_ready(cur);
    if constexpr (SP2) {
        PG8_STAGE(PG8_SB(0, 0), cB, voffB); PG8_STAGE(PG8_SB(0, 1), cB + hstep, voffB); PG8_STAGE(PG8_SA(0, 0), cA, voffA); PG8_STAGE(PG8_SA(0, 1), cA + hstep, voffA);
        if (wr == 1) PG8_BAR;
        PG8_WAIT_V(2); PG8_BAR;
        PG8_STAGE(PG8_SB(1, 0), cB + kstep, voffB); PG8_STAGE(PG8_SA(1, 0), cA + kstep, voffA); PG8_STAGE(PG8_SB(1, 1), cB + hstep + kstep, voffB);
        PG8_WAIT_V(6); PG8_BAR;
    } else {
        PG8_STAGE(PG8_SB(0, 0), cB, voffB); PG8_STAGE(PG8_SA(0, 0), cA, voffA); PG8_STAGE(PG8_SB(0, 1), cB + hstep, voffB); PG8_STAGE(PG8_SA(0, 1), cA + hstep, voffA);
        if (wr == 1) PG8_BAR;
        PG8_WAIT_V(4); PG8_BAR;
        PG8_STAGE(PG8_SB(1, 0), cB + kstep, voffB); PG8_STAGE(PG8_SA(1, 0), cA + kstep, voffA); PG8_STAGE(PG8_SB(1, 1), cB + hstep + kstep, voffB);
        PG8_WAIT_V(6); PG8_BAR;
    }
    for (;;) {
        const bool has_next = S.next(ui + 1, nxt);
        const char* nA = has_next ? (const char*)g.A + (size_t)nxt.pm * tstep : cA; const char* nB = has_next ? (const char*)g.Bt + (size_t)nxt.pn * tstep : cB;
        for (int t = 0; t < nt; t += 2) {
            const bool last = (t == nt - 2);
            const char* a1 = cA + (size_t)(t + 1) * kstep;
            const char* a2 = last ? nA : cA + (size_t)(t + 2) * kstep; const char* b2 = last ? nB : cB + (size_t)(t + 2) * kstep;
            const char* a3 = a2 + kstep; const char* b3 = b2 + kstep;
            if (last && has_next) S.a_ready(nxt);
            if constexpr (SP2) {
            PG8_LDB(B0, 0, 0); PG8_LDB(B1, 0, 1); PG8_SCHED; PG8_LDA(At, 0, 0); PG8_STAGE(PG8_SA(1, 1), a1 + hstep, voffA);
            PG8_WAIT_V(8); PG8_WAIT_L(0); PG8_BAR; PG8_MMA(0, 0, At, B0); PG8_MMA(0, 1, At, B1); PG8_BAR; PG8_SCHED;
            PG8_LDA(At, 0, 1); PG8_STAGE(PG8_SB(0, 0), b2, voffB); PG8_STAGE(PG8_SB(0, 1), b2 + hstep, voffB); PG8_STAGE(PG8_SA(0, 0), a2, voffA);
            PG8_WAIT_V(8); PG8_WAIT_L(0); PG8_BAR; PG8_MMA(1, 0, At, B0); PG8_MMA(1, 1, At, B1); PG8_BAR; PG8_SCHED;
            PG8_LDB(B0, 1, 0); PG8_LDB(B1, 1, 1); PG8_SCHED; PG8_LDA(At, 1, 0); PG8_STAGE(PG8_SA(0, 1), a2 + hstep, voffA);
            PG8_WAIT_V(8); PG8_WAIT_L(0); PG8_BAR; PG8_MMA(0, 0, At, B0); PG8_MMA(0, 1, At, B1); PG8_BAR; PG8_SCHED;
            PG8_LDA(At, 1, 1); PG8_STAGE(PG8_SB(1, 0), b3, voffB); PG8_STAGE(PG8_SB(1, 1), b3 + hstep, voffB); PG8_STAGE(PG8_SA(1, 0), a3, voffA);
            PG8_WAIT_V(8); PG8_WAIT_L(0); PG8_BAR; PG8_MMA(1, 0, At, B0); PG8_MMA(1, 1, At, B1); PG8_BAR; PG8_SCHED;
            } else {
            PG8_LDB(B0, 0, 0); PG8_SCHED; PG8_LDA(At, 0, 0); PG8_STAGE(PG8_SA(1, 1), a1 + hstep, voffA);
            PG8_WAIT_L(8); PG8_BAR; PG8_WAIT_L(0); PG8_MMA(0, 0, At, B0); PG8_BAR; PG8_SCHED;
            PG8_LDB(B1, 0, 1); PG8_STAGE(PG8_SB(0, 0), b2, voffB);
            PG8_BAR; PG8_WAIT_L(0); PG8_MMA(0, 1, At, B1); PG8_BAR;
            PG8_LDA(At, 0, 1); PG8_STAGE(PG8_SA(0, 0), a2, voffA);
            PG8_BAR; PG8_WAIT_L(0); PG8_MMA(1, 0, At, B0); PG8_BAR; PG8_SCHED;
            PG8_STAGE(PG8_SB(0, 1), b2 + hstep, voffB);
            PG8_WAIT_V(6); PG8_BAR; PG8_MMA(1, 1, At, B1); PG8_BAR;
            PG8_LDB(B0, 1, 0); PG8_SCHED; PG8_LDA(At, 1, 0); PG8_STAGE(PG8_SA(0, 1), a2 + hstep, voffA);
            PG8_WAIT_L(8); PG8_BAR; PG8_WAIT_L(0); PG8_MMA(0, 0, At, B0); PG8_BAR; PG8_SCHED;
            PG8_LDB(B1, 1, 1); PG8_STAGE(PG8_SB(1, 0), b3, voffB);
            PG8_BAR; PG8_WAIT_L(0); PG8_MMA(0, 1, At, B1); PG8_BAR;
            PG8_LDA(At, 1, 1); PG8_STAGE(PG8_SA(1, 0), a3, voffA);
            PG8_BAR; PG8_WAIT_L(0); PG8_MMA(1, 0, At, B0); PG8_BAR; PG8_SCHED;
            PG8_STAGE(PG8_SB(1, 1), b3 + hstep, voffB);
            PG8_WAIT_V(6); PG8_BAR; PG8_MMA(1, 1, At, B1); PG8_BAR;
            }
        }
        if constexpr (ALIGN_EPI) { if (wr == 0) PG8_BAR; }
        if constexpr (!Epi::AFTER_DRAIN) { E(acc, cur, wr, wc, fr, fq); S.done(cur); }
        if (!has_next) break;
#pragma unroll
        for (int a = 0; a < 2; ++a)
#pragma unroll
            for (int b = 0; b < 2; ++b)
#pragma unroll
                for (int m = 0; m < 4; ++m)
#pragma unroll
                    for (int n = 0; n < 2; ++n) acc[a][b][m][n] = (f32x4){0.f, 0.f, 0.f, 0.f};
        cur = nxt; cA = nA; cB = nB; ++ui;
        if constexpr (ALIGN_EPI) { if (wr == 1) PG8_BAR; }
    }
    PG8_WAIT_V(0);
    if constexpr (!ALIGN_EPI) { if (wr == 0) PG8_BAR; }
    PG8_BAR;
    if constexpr (Epi::AFTER_DRAIN) { E.fused(acc, cur, wr, wc, fr, fq, lds, wid, lane); S.done(cur); }
#undef PG8_SA
#undef PG8_SB
#undef PG8_STAGE
#undef PG8_LDA
#undef PG8_LDB
#undef PG8_MMA
#undef PG8_WAIT_V
#undef PG8_WAIT_L
#undef PG8_BAR
#undef PG8_SCHED
}
}
constexpr int NB = 8, SEQ = 8192, D = 1024, M = NB * SEQ;
constexpr int DIN = 2312, NPROJ = 2304, NIN_PAD = 2560;
constexpr int C_AQ = 0, C_AK = 512, C_AV = 640, C_MQ = 768, C_MK = 1024, C_MV = 1280, C_MO = 1792;
constexpr int NEXP = 16384, NSLOT = 128;
constexpr float EPS = 1e-6f;
constexpr int NWAVES = 8, NTHR = 512;

constexpr size_t MiB = 1u << 20;
constexpr size_t WS_CTL = 0, CTL_ZERO_BYTES = 1 * MiB;
constexpr size_t WS_MOD = 1 * MiB;
constexpr size_t WS_WIN = 2 * MiB;
constexpr size_t WS_WOUT = 8 * MiB;
constexpr size_t WS_WQ = 10 * MiB;
constexpr size_t WS_KEYS = 14 * MiB;
constexpr size_t WS_GATES = 16 * MiB;
constexpr size_t WS_SSQ = 832 * MiB;
constexpr size_t WS_MST = 20 * MiB;
constexpr size_t WS_U8 = 32 * MiB, WS_V8 = 48 * MiB;
constexpr size_t WS_SC = 64 * MiB;
constexpr size_t WS_H = 96 * MiB;
constexpr size_t WS_PROJ = 224 * MiB;
constexpr size_t WS_MIXIN = 512 * MiB;
constexpr size_t WS_MIX = 640 * MiB;
constexpr size_t WS_EIDX = 768 * MiB, WS_GATE = 800 * MiB;
constexpr size_t WS_PD = 512 * MiB;
constexpr size_t WS_ACT = 840 * MiB;
constexpr size_t WS_SSY = 872 * MiB;
constexpr size_t WS_END = 876 * MiB;
constexpr int CW_BAR = 4096;
constexpr int CW_SUMSQ = 65536;
static_assert((CW_SUMSQ + M) * 4 <= (int)CTL_ZERO_BYTES, "ctl");

constexpr int RING_BYTES = 131072, MISC_OFF = RING_BYTES + 320, LDS_BYTES = 147456;

#define GAS __attribute__((address_space(1)))
#define LAS __attribute__((address_space(3)))
typedef unsigned short bf16;
typedef unsigned v4u __attribute__((ext_vector_type(4)));
typedef unsigned v2u __attribute__((ext_vector_type(2)));
typedef float f32x4 __attribute__((ext_vector_type(4)));
typedef GAS unsigned gu32;
#define LDS_WAIT() asm volatile("s_waitcnt lgkmcnt(0)" ::: "memory")
#define VM_WAIT() asm volatile("s_waitcnt vmcnt(0)" ::: "memory")
__device__ __forceinline__ unsigned f2bf(float f) { unsigned u = __builtin_bit_cast(unsigned, f); return (u + 0x7fffu + ((u >> 16) & 1u)) >> 16; }
__device__ __forceinline__ unsigned pk2(float lo, float hi) { return f2bf(lo) | (f2bf(hi) << 16); }
__device__ __forceinline__ float bflo(unsigned w) { return __builtin_bit_cast(float, w << 16); }
__device__ __forceinline__ float bfhi(unsigned w) { return __builtin_bit_cast(float, w & 0xffff0000u); }
__device__ __forceinline__ float bf1(bf16 h) { return __builtin_bit_cast(float, (unsigned)h << 16); }
__device__ __forceinline__ float wave_sum(float v) {
#pragma unroll
    for (int o = 1; o < 64; o <<= 1) v += __shfl_xor(v, o);
    return v;
}
__device__ __forceinline__ float wave_max(float v) {
#pragma unroll
    for (int o = 1; o < 64; o <<= 1) v = fmaxf(v, __shfl_xor(v, o));
    return v;
}

typedef float f32x2 __attribute__((ext_vector_type(2)));
__device__ __forceinline__ void cvt16_fp8(const v4u w, float (&o)[16]) {
    const unsigned ww[4] = {w.x, w.y, w.z, w.w};
#pragma unroll
    for (int i = 0; i < 4; ++i) { const f32x2 a = __builtin_amdgcn_cvt_pk_f32_fp8((int)ww[i], false), b = __builtin_amdgcn_cvt_pk_f32_fp8((int)ww[i], true);
        o[4 * i] = a.x; o[4 * i + 1] = a.y; o[4 * i + 2] = b.x; o[4 * i + 3] = b.y; }
}
__device__ __forceinline__ void p0_row_fp8(const float* src, unsigned char* dst, float* sc, int row, int lane) {
    const GAS f32x4* sp = (const GAS f32x4*)(src + (size_t)row * D + 16 * lane);
    const f32x4 a = sp[0], b = sp[1], c = sp[2], d = sp[3];
    float mx = 0.f;
#pragma unroll
    for (int i = 0; i < 4; ++i) mx = fmaxf(fmaxf(fmaxf(mx, fabsf(a[i])), fmaxf(fabsf(b[i]), fabsf(c[i]))), fabsf(d[i]));
    mx = wave_max(mx); const float s = mx > 0.f ? 224.0f / mx : 1.0f;
    v4u o; int w;
    w = __builtin_amdgcn_cvt_pk_fp8_f32(a[0] * s, a[1] * s, 0, false); w = __builtin_amdgcn_cvt_pk_fp8_f32(a[2] * s, a[3] * s, w, true); o.x = (unsigned)w;
    w = __builtin_amdgcn_cvt_pk_fp8_f32(b[0] * s, b[1] * s, 0, false); w = __builtin_amdgcn_cvt_pk_fp8_f32(b[2] * s, b[3] * s, w, true); o.y = (unsigned)w;
    w = __builtin_amdgcn_cvt_pk_fp8_f32(c[0] * s, c[1] * s, 0, false); w = __builtin_amdgcn_cvt_pk_fp8_f32(c[2] * s, c[3] * s, w, true); o.z = (unsigned)w;
    w = __builtin_amdgcn_cvt_pk_fp8_f32(d[0] * s, d[1] * s, 0, false); w = __builtin_amdgcn_cvt_pk_fp8_f32(d[2] * s, d[3] * s, w, true); o.w = (unsigned)w;
    *(GAS v4u*)(dst + (size_t)row * D + 16 * lane) = o;
    if (lane == 0) sc[row] = mx > 0.f ? mx * (1.0f / 224.0f) : 1.0f;
}
struct Args { const void* in[21]; float* out; unsigned char* ws; int ph_lo, ph_hi; };
enum { I_X = 0, I_C, I_POS, I_WMOD, I_BMOD, I_GPRE1, I_GPOST1, I_WIN, I_CONVW, I_BI, I_BF, I_MNG, I_SINK, I_WOUT, I_GPRE2, I_GPOST2, I_WQ, I_K1, I_K2, I_U, I_V };

__device__ __forceinline__ int newcol(int o) {
    if (o < 640) { const int hd = o >> 6, d = o & 63; return (hd << 6) + 2 * (d & 31) + (d >> 5); }
    if (o < 1792) return o;
    if (o < 1800) return 2304 + (o - 1792);
    return o - 8;
}
template <bool REMAP>
__device__ __forceinline__ void p0_transpose_item(const float* W, int K, int N, bf16* WT, LAS float* scr, int item, int lane) {
    const int nblk = (N + 31) / 32, kb = item / nblk, nb = item % nblk, k0 = 64 * kb, n0 = 32 * nb;
    const int ncol = n0 + (lane & 31);
#pragma unroll 8
    for (int i = 0; i < 32; ++i) { const int kk = 2 * i + (lane >> 5); scr[kk * 33 + (lane & 31)] = (ncol < N) ? W[(size_t)(k0 + kk) * N + ncol] : 0.f; }
    LDS_WAIT(); asm volatile("" ::: "memory");
    const int c = lane & 7;
#pragma unroll
    for (int j = 0; j < 4; ++j) { const int n = (lane >> 3) + 8 * j; const LAS float* s = scr + (8 * c) * 33 + n;
        v4u o; o.x = pk2(s[0 * 33], s[1 * 33]); o.y = pk2(s[2 * 33], s[3 * 33]); o.z = pk2(s[4 * 33], s[5 * 33]); o.w = pk2(s[6 * 33], s[7 * 33]);
        if (n0 + n < N) { const int drow = REMAP ? newcol(n0 + n) : (n0 + n); *(GAS v4u*)(WT + (size_t)drow * K + k0 + 8 * c) = o; } }
    LDS_WAIT(); asm volatile("" ::: "memory");
}
__device__ __forceinline__ void p0_convert(const float* src, bf16* dst, size_t n, int gt, int ngt) {
    for (size_t i = (size_t)gt * 8; i < n; i += (size_t)ngt * 8) {
        const f32x4 a = *(const GAS f32x4*)(src + i), b = *(const GAS f32x4*)(src + i + 4);
        v4u o; o.x = pk2(a[0], a[1]); o.y = pk2(a[2], a[3]); o.z = pk2(b[0], b[1]); o.w = pk2(b[2], b[3]);
        *(GAS v4u*)(dst + i) = o; }
}
__device__ __forceinline__ void phase_prologue(const Args& A, LAS unsigned char* lds) {
    const int tid = threadIdx.x, lane = tid & 63, wave = tid >> 6, G = gridDim.x, blk = blockIdx.x;
    unsigned char* ws = A.ws;
    {
        const float* c = (const float*)A.in[I_C]; const float* wm = (const float*)A.in[I_WMOD]; const float* bm = (const float*)A.in[I_BMOD];
        float* mod = (float*)(ws + WS_MOD); LAS float* red = (LAS float*)lds;
        for (int it = blk; it < 6144 / 32; it += G) {
            const int kg = tid >> 5, col = tid & 31, j = it * 32 + col; float acc[8];
#pragma unroll
            for (int b = 0; b < 8; ++b) acc[b] = 0.f;
            for (int i = 0; i < 64; ++i) { const int k = kg + 16 * i; const float w = wm[(size_t)k * 6144 + j];
#pragma unroll
                for (int b = 0; b < 8; ++b) acc[b] += c[b * 1024 + k] * w; }
#pragma unroll
            for (int b = 0; b < 8; ++b) red[(kg * 32 + col) * 8 + b] = acc[b];
            __syncthreads();
            if (tid < 256) { const int b = tid >> 5, cc = tid & 31; float s = 0.f;
#pragma unroll
                for (int g = 0; g < 16; ++g) s += red[(g * 32 + cc) * 8 + b];
                mod[b * 6144 + it * 32 + cc] = s + bm[it * 32 + cc]; }
            __syncthreads();
        }
    }
    {
        LAS float* scr = (LAS float*)(lds + wave * 16384);
        const int gw = blk * NWAVES + wave, NGW = G * NWAVES;
        const int I_IN = (D / 64) * ((DIN + 31) / 32), I_OUT = (D / 64) * (D / 32), I_Q = (D / 64) * (2048 / 32);
        bf16* win = (bf16*)(ws + WS_WIN); bf16* wout = (bf16*)(ws + WS_WOUT); bf16* wq = (bf16*)(ws + WS_WQ);
        for (int it = gw; it < I_IN + I_OUT + I_Q; it += NGW) {
            int r = it;
            if (r < I_IN) { p0_transpose_item<true>((const float*)A.in[I_WIN], D, DIN, win, scr, r, lane); continue; } r -= I_IN;
            if (r < I_OUT) { p0_transpose_item<false>((const float*)A.in[I_WOUT], D, D, wout, scr, r, lane); continue; } r -= I_OUT;
            p0_transpose_item<false>((const float*)A.in[I_WQ], D, 2048, wq, scr, r, lane);
        }
        const int gt = blk * NTHR + tid, ngt = G * NTHR;
        for (int i = gt; i < (NIN_PAD - DIN) * D / 8; i += ngt) *(GAS v4u*)(win + (size_t)DIN * D + (size_t)i * 8) = (v4u){0u, 0u, 0u, 0u};
        p0_convert((const float*)A.in[I_K1], (bf16*)(ws + WS_KEYS), (size_t)8 * 128 * 128, gt, ngt);
        p0_convert((const float*)A.in[I_K2], (bf16*)(ws + WS_KEYS) + 8 * 128 * 128, (size_t)8 * 128 * 128, gt, ngt);
        for (int r = gw; r < 2 * NEXP; r += NGW) { if (r < NEXP) p0_row_fp8((const float*)A.in[I_U], ws + WS_U8, (float*)(ws + WS_SC), r, lane); else p0_row_fp8((const float*)A.in[I_V], ws + WS_V8, (float*)(ws + WS_SC) + NEXP, r - NEXP, lane); }
    }
}

__device__ __forceinline__ void phase_prenorm(const Args& A) {
    const int tid = threadIdx.x, lane = tid & 63, wave = tid >> 6, G = gridDim.x;
    const float* x = (const float*)A.in[I_X]; const float* g = (const float*)A.in[I_GPRE1]; const float* mod = (const float*)(A.ws + WS_MOD);
    bf16* H = (bf16*)(A.ws + WS_H);
    for (int row = blockIdx.x * NWAVES + wave; row < M; row += G * NWAVES) {
        const int b = row / SEQ; const GAS f32x4* xr = (const GAS f32x4*)(x + (size_t)row * D) + lane;
        f32x4 v[4]; float s = 0.f;
#pragma unroll
        for (int j = 0; j < 4; ++j) { v[j] = xr[64 * j]; s += (v[j][0] * v[j][0] + v[j][1] * v[j][1]) + (v[j][2] * v[j][2] + v[j][3] * v[j][3]); }
        const float rstd = 1.0f / sqrtf(wave_sum(s) * (1.f / D) + EPS);
        GAS v2u* o = (GAS v2u*)(H + (size_t)row * D) + lane;
#pragma unroll
        for (int j = 0; j < 4; ++j) { const int k = 4 * (lane + 64 * j);
            const f32x4 gg = *(const GAS f32x4*)(g + k), sh = *(const GAS f32x4*)(mod + b * 6144 + k), sc = *(const GAS f32x4*)(mod + b * 6144 + 1024 + k);
            f32x4 y;
#pragma unroll
            for (int i = 0; i < 4; ++i) y[i] = v[j][i] * rstd * gg[i] * (1.f + sc[i]) + sh[i];
            v2u w; w.x = pk2(y[0], y[1]); w.y = pk2(y[2], y[3]); o[64 * j] = w; }
    }
}

__device__ __forceinline__ void phase_mid(const Args& A) {
    const int tid = threadIdx.x, lane = tid & 63, wave = tid >> 6, G = gridDim.x;
    const float* x = (const float*)A.in[I_X]; const float* gpost = (const float*)A.in[I_GPOST1]; const float* gpre = (const float*)A.in[I_GPRE2];
    const float* mod = (const float*)(A.ws + WS_MOD); const float* sumsq = (const float*)(A.ws + WS_SSQ);
    const bf16* MIX = (const bf16*)(A.ws + WS_MIX); bf16* H = (bf16*)(A.ws + WS_H); float* out = A.out;
    for (int row = blockIdx.x * NWAVES + wave; row < M; row += G * NWAVES) {
        const int b = row / SEQ; const GAS f32x4* xr = (const GAS f32x4*)(x + (size_t)row * D) + lane; const GAS v2u* mr = (const GAS v2u*)(MIX + (size_t)row * D) + lane;
        const f32x4 q0 = *(const GAS f32x4*)(sumsq + (size_t)row * 16), q1 = *(const GAS f32x4*)(sumsq + (size_t)row * 16 + 4), q2 = *(const GAS f32x4*)(sumsq + (size_t)row * 16 + 8), q3 = *(const GAS f32x4*)(sumsq + (size_t)row * 16 + 12);
        const float rm = 1.0f / sqrtf(((((q0[0] + q0[1]) + (q0[2] + q0[3])) + ((q1[0] + q1[1]) + (q1[2] + q1[3]))) + (((q2[0] + q2[1]) + (q2[2] + q2[3])) + ((q3[0] + q3[1]) + (q3[2] + q3[3])))) * (1.f / D) + EPS);
        f32x4 v[4]; float s = 0.f;
#pragma unroll
        for (int j = 0; j < 4; ++j) { const int k = 4 * (lane + 64 * j); const f32x4 xv = xr[64 * j]; const v2u mw = mr[64 * j];
            const f32x4 gp = *(const GAS f32x4*)(gpost + k), g1 = *(const GAS f32x4*)(mod + b * 6144 + 2048 + k);
            const float mx[4] = {bflo(mw.x), bfhi(mw.x), bflo(mw.y), bfhi(mw.y)};
#pragma unroll
            for (int i = 0; i < 4; ++i) { v[j][i] = xv[i] + g1[i] * (mx[i] * rm * gp[i]); s += v[j][i] * v[j][i]; }
            *((GAS f32x4*)(out + (size_t)row * D) + lane + 64 * j) = v[j]; }
        const float rstd = 1.0f / sqrtf(wave_sum(s) * (1.f / D) + EPS);
        GAS v2u* o = (GAS v2u*)(H + (size_t)row * D) + lane;
#pragma unroll
        for (int j = 0; j < 4; ++j) { const int k = 4 * (lane + 64 * j);
            const f32x4 gg = *(const GAS f32x4*)(gpre + k), sh = *(const GAS f32x4*)(mod + b * 6144 + 3072 + k), sc = *(const GAS f32x4*)(mod + b * 6144 + 4096 + k);
            f32x4 y;
#pragma unroll
            for (int i = 0; i < 4; ++i) y[i] = v[j][i] * rstd * gg[i] * (1.f + sc[i]) + sh[i];
            v2u w; w.x = pk2(y[0], y[1]); w.y = pk2(y[2], y[3]); o[64 * j] = w; }
    }
}
__device__ __forceinline__ void load64bf(const bf16* p, float (&o)[64]) {
#pragma unroll
    for (int i = 0; i < 8; ++i) { const v4u w = *(const GAS v4u*)(p + 8 * i);
        o[8 * i + 0] = bflo(w.x); o[8 * i + 1] = bfhi(w.x); o[8 * i + 2] = bflo(w.y); o[8 * i + 3] = bfhi(w.y);
        o[8 * i + 4] = bflo(w.z); o[8 * i + 5] = bfhi(w.z); o[8 * i + 6] = bflo(w.w); o[8 * i + 7] = bfhi(w.w); }
}
__device__ __forceinline__ void phase_attn_naive(const Args& A, int vb, int nvb) {
    const bf16* P = (const bf16*)(A.ws + WS_PROJ); bf16* MI = (bf16*)(A.ws + WS_MIXIN); const float* sinks = (const float*)A.in[I_SINK];
    for (int task = vb * NTHR + (int)threadIdx.x; task < 8 * M; task += nvb * NTHR) {
        const int h = task / M, t = task % M, s = t % SEQ, kvh = h >> 2;
        float q[64], o[64];
        load64bf(P + (size_t)t * NPROJ + C_AQ + h * 64, q);
#pragma unroll
        for (int d = 0; d < 64; ++d) o[d] = 0.f;
        float mx = sinks[h], l = 1.f;
        for (int j = 0; j < 128; ++j) {
            const int sj = s - 127 + j; const bool valid = sj >= 0; const int tk = valid ? (t - 127 + j) : t;
            const bf16* kr = P + (size_t)tk * NPROJ + C_AK + kvh * 64; float sc = 0.f;
#pragma unroll
            for (int i = 0; i < 8; ++i) { const v4u w = *(const GAS v4u*)(kr + 8 * i);
                sc += q[8 * i + 0] * bflo(w.x) + q[8 * i + 1] * bfhi(w.x) + q[8 * i + 2] * bflo(w.y) + q[8 * i + 3] * bfhi(w.y)
                    + q[8 * i + 4] * bflo(w.z) + q[8 * i + 5] * bfhi(w.z) + q[8 * i + 6] * bflo(w.w) + q[8 * i + 7] * bfhi(w.w); }
            if (valid) {
                const float mn = fmaxf(mx, sc), al = __expf(mx - mn), p = __expf(sc - mn); mx = mn; l = l * al + p;
                const bf16* vr = P + (size_t)tk * NPROJ + C_AV + kvh * 64;
#pragma unroll
                for (int i = 0; i < 8; ++i) { const v4u w = *(const GAS v4u*)(vr + 8 * i);
                    o[8 * i + 0] = o[8 * i + 0] * al + p * bflo(w.x); o[8 * i + 1] = o[8 * i + 1] * al + p * bfhi(w.x);
                    o[8 * i + 2] = o[8 * i + 2] * al + p * bflo(w.y); o[8 * i + 3] = o[8 * i + 3] * al + p * bfhi(w.y);
                    o[8 * i + 4] = o[8 * i + 4] * al + p * bflo(w.z); o[8 * i + 5] = o[8 * i + 5] * al + p * bfhi(w.z);
                    o[8 * i + 6] = o[8 * i + 6] * al + p * bflo(w.w); o[8 * i + 7] = o[8 * i + 7] * al + p * bfhi(w.w); }
            }
        }
        const float il = 1.f / l; bf16* orow = MI + (size_t)t * D + h * 64;
#pragma unroll
        for (int i = 0; i < 8; ++i) { v4u w; w.x = pk2(o[8 * i] * il, o[8 * i + 1] * il); w.y = pk2(o[8 * i + 2] * il, o[8 * i + 3] * il);
            w.z = pk2(o[8 * i + 4] * il, o[8 * i + 5] * il); w.w = pk2(o[8 * i + 6] * il, o[8 * i + 7] * il); *(GAS v4u*)(orow + 8 * i) = w; }
    }
}

__device__ __forceinline__ void phase_mlstm_naive(const Args& A, LAS unsigned char* lds, int bh) {
    const int tid = threadIdx.x, lane = tid & 63, wave = tid >> 6, b = bh >> 2, h = bh & 3, dv = tid >> 2, part = tid & 3;
    const bf16* P = (const bf16*)(A.ws + WS_PROJ); bf16* MI = (bf16*)(A.ws + WS_MIXIN); const float* gates = (const float*)(A.ws + WS_GATES);
    const float* cw = (const float*)A.in[I_CONVW]; const float* ng = (const float*)A.in[I_MNG];
    LAS float* qs = (LAS float*)lds; LAS float* ks = qs + 64 * 64; LAS float* vs = ks + 64 * 64; LAS float* ig = vs + 64 * 128; LAS float* lfg = ig + 64; LAS float* hb = lfg + 64;
    float C[16], n[16]; float m = 0.f;
#pragma unroll
    for (int j = 0; j < 16; ++j) { C[j] = 0.f; n[j] = 0.f; }
    for (int ch = 0; ch < SEQ / 64; ++ch) {
        const int s0 = ch * 64; const size_t t0 = (size_t)b * SEQ + s0;
        for (int e = tid; e < 64 * 64; e += NTHR) { const int l = e >> 6, dk = e & 63; float aq = 0.f, ak = 0.f;
#pragma unroll
            for (int j = 0; j < 4; ++j) { const int sj = s0 + l - 3 + j; if (sj >= 0) { const bf16* r = P + ((size_t)b * SEQ + sj) * NPROJ;
                aq += cw[j * 512 + h * 64 + dk] * bf1(r[C_MQ + h * 64 + dk]); ak += cw[j * 512 + 256 + h * 64 + dk] * bf1(r[C_MK + h * 64 + dk]); } }
            qs[e] = 0.125f * aq / (1.f + __expf(-aq)); ks[e] = ak / (1.f + __expf(-ak)); }
        for (int e = tid; e < 64 * 128; e += NTHR) { const int l = e >> 7, d = e & 127; vs[e] = bf1(P[(t0 + l) * NPROJ + C_MV + h * 128 + d]); }
        if (tid < 64) { ig[tid] = gates[(t0 + tid) * 8 + h]; lfg[tid] = gates[(t0 + tid) * 8 + 4 + h]; }
        __syncthreads();
        for (int l = 0; l < 64; ++l) {
            const float lf = lfg[l], ii = ig[l], mn = fmaxf(lf + m, ii), fd = __expf(lf + m - mn), iw = __expf(ii - mn), vv = vs[l * 128 + dv] * iw;
            float num = 0.f, den = 0.f;
#pragma unroll
            for (int j = 0; j < 16; ++j) { const float kk = ks[l * 64 + part * 16 + j], qq = qs[l * 64 + part * 16 + j];
                C[j] = fd * C[j] + vv * kk; n[j] = fd * n[j] + iw * kk; num += C[j] * qq; den += n[j] * qq; }
            num += __shfl_xor(num, 1); num += __shfl_xor(num, 2); den += __shfl_xor(den, 1); den += __shfl_xor(den, 2);
            if (part == 0) hb[l * 128 + dv] = num / fmaxf(fabsf(den), __expf(-mn));
            m = mn;
        }
        __syncthreads();
        for (int l = wave * 8; l < wave * 8 + 8; ++l) { const float a0 = hb[l * 128 + lane], a1 = hb[l * 128 + 64 + lane];
            const float r = 1.0f / sqrtf(wave_sum(a0 * a0 + a1 * a1) * (1.f / 128.f) + EPS);
            const bf16* pr = P + (t0 + l) * NPROJ + C_MO + h * 128; bf16* orow = MI + (t0 + l) * D + 512 + h * 128;
            orow[lane] = (bf16)f2bf(a0 * r * ng[h * 128 + lane] * bf1(pr[lane])); orow[64 + lane] = (bf16)f2bf(a1 * r * ng[h * 128 + 64 + lane] * bf1(pr[64 + lane])); }
        __syncthreads();
    }
}

__device__ __forceinline__ void ld16bf(const bf16* p, float (&o)[16]) {
    const v4u w0 = *(const GAS v4u*)p, w1 = *(const GAS v4u*)(p + 8);
    o[0] = bflo(w0.x); o[1] = bfhi(w0.x); o[2] = bflo(w0.y); o[3] = bfhi(w0.y); o[4] = bflo(w0.z); o[5] = bfhi(w0.z); o[6] = bflo(w0.w); o[7] = bfhi(w0.w);
    o[8] = bflo(w1.x); o[9] = bfhi(w1.x); o[10] = bflo(w1.y); o[11] = bfhi(w1.y); o[12] = bflo(w1.z); o[13] = bfhi(w1.z); o[14] = bflo(w1.w); o[15] = bfhi(w1.w);
}
typedef short bf16x8 __attribute__((ext_vector_type(8)));
#define MFMA16(a, b, c) __builtin_amdgcn_mfma_f32_16x16x32_bf16((a), (b), (c), 0, 0, 0)
__device__ __forceinline__ bf16x8 ldfrag(LAS const unsigned char* img, int row, int kbyte) { return *(LAS const bf16x8*)(img + row * 144 + kbyte); }
__device__ __forceinline__ unsigned cvtpk(float lo, float hi) { unsigned r; asm volatile("v_cvt_pk_bf16_f32 %0, %1, %2" : "=v"(r) : "v"(lo), "v"(hi)); return r; }

namespace ml {
constexpr int O_Q = 0, O_QA = 9216, O_K = 18432, O_KWT = 27648, O_VT = 36864, O_CX = 57600, CXB = 20736, O_S = 99072, O_GB = 108288, O_GA = O_GB + 4096, O_GC = O_GA + 4096, O_DEN = O_GC + 4096, O_SSQ = O_DEN + 256, O_END = O_SSQ + 2048;
static_assert(O_END <= 131072, "mlstm LDS");
constexpr size_t MST_SC = 11 * MiB;
}
template <bool OUT>
__device__ __forceinline__ void mlstm_group(const Args& A, LAS unsigned char* lds, int wg) {
    using namespace ml;
    const int tid = threadIdx.x, lane = tid & 63, wave = __builtin_amdgcn_readfirstlane(tid >> 6), fr = lane & 15, fq = lane >> 4;
    const int bh = wg >> 3, grp = wg & 7, b = bh >> 2, h = bh & 3;
    const size_t tg0 = (size_t)b * SEQ + (size_t)grp * 1024;
    const bf16* P = (const bf16*)(A.ws + WS_PROJ); bf16* MI = (bf16*)(A.ws + WS_MIXIN); const float* gates = (const float*)(A.ws + WS_GATES);
    const float* cw = (const float*)A.in[I_CONVW]; const float* ng = (const float*)A.in[I_MNG];
    float* MST = (float*)(A.ws + WS_MST); float* MSC = (float*)(A.ws + WS_MST + MST_SC);
    LAS float* GB = (LAS float*)(lds + O_GB); LAS float* GA = (LAS float*)(lds + O_GA); LAS float* GC = (LAS float*)(lds + O_GC);
    LAS float* DEN = (LAS float*)(lds + O_DEN); LAS float* SSQ = (LAS float*)(lds + O_SSQ);
    __syncthreads();
#pragma unroll
    for (int cc = 0; cc < 2; ++cc) { const int c = 2 * wave + cc; const size_t t = tg0 + c * 64 + lane;
        float bc = gates[t * 8 + 4 + h]; const float ii = gates[t * 8 + h];
#pragma unroll
        for (int o = 1; o < 64; o <<= 1) { const float v = __shfl_up(bc, o); if (lane >= o) bc += v; }
        const float a = ii - bc; float cm = a;
#pragma unroll
        for (int o = 1; o < 64; o <<= 1) { const float v = __shfl_up(cm, o); if (lane >= o) cm = fmaxf(cm, v); }
        GB[c * 64 + lane] = bc; GA[c * 64 + lane] = a; GC[c * 64 + lane] = cm; }
    for (int e = tid; e < 16 * 32; e += NTHR) { const int r = e >> 5, cpair = e & 31; *(LAS unsigned*)(lds + O_VT + (128 + r) * 144 + cpair * 4) = (r == 0) ? 0x3F803F80u : 0u; }
    f32x4 st[5];
#pragma unroll
    for (int i = 0; i < 5; ++i) st[i] = (f32x4){0.f, 0.f, 0.f, 0.f};
    float m = OUT ? 0.f : -__builtin_inff(); float Btot = 0.f;
    if (OUT) {
        for (int gp = 0; gp < grp; ++gp) { const int wgp = bh * 8 + gp; const float mg = MSC[wgp * 2], Bg = MSC[wgp * 2 + 1];
            const float mn = fmaxf(Bg + m, mg), f0 = __expf(Bg + m - mn), f1 = __expf(mg - mn);
#pragma unroll
            for (int i = 0; i < 5; ++i)
#pragma unroll
                for (int r = 0; r < 4; ++r) st[i][r] = f0 * st[i][r] + f1 * MST[((size_t)wgp * 20 + i * 4 + r) * NTHR + tid];
            m = mn; }
#pragma unroll
        for (int j = 0; j < 4; ++j)
#pragma unroll
            for (int r = 0; r < 4; ++r) *(LAS bf16*)(lds + O_CX + (16 * wave + 4 * fq + r) * 144 + (16 * j + fr) * 2) = (bf16)f2bf(st[j][r]);
        if (wave < 4) {
#pragma unroll
            for (int r = 0; r < 4; ++r) *(LAS bf16*)(lds + O_CX + (128 + 4 * fq + r) * 144 + (16 * wave + fr) * 2) = (bf16)f2bf(st[4][r]); }
    }
    float gsc[4];
#pragma unroll
    for (int r = 0; r < 4; ++r) gsc[r] = ng[h * 128 + 16 * wave + 4 * fq + r];
    const int sl = tid >> 3, cg = tid & 7;
    __syncthreads();
    for (int c = 0; c < 16; ++c) {
        const float bL = GB[c * 64 + 63], M63 = fmaxf(m, GC[c * 64 + 63]), decay = __expf(m - M63);
        const size_t tc0 = tg0 + (size_t)c * 64;
        {
            const int sabs = grp * 1024 + c * 64 + sl;
            float aq[8], ak[8];
#pragma unroll
            for (int i = 0; i < 8; ++i) { aq[i] = 0.f; ak[i] = 0.f; }
#pragma unroll
            for (int j = 0; j < 4; ++j) { const int sj = sabs - 3 + j;
                if (sj >= 0) { const bf16* rp = P + ((size_t)b * SEQ + sj) * NPROJ;
                    const v4u wq = *(const GAS v4u*)(rp + C_MQ + h * 64 + 8 * cg), wk = *(const GAS v4u*)(rp + C_MK + h * 64 + 8 * cg);
                    const f32x4 q0 = *(const GAS f32x4*)(cw + j * 512 + h * 64 + 8 * cg), q1 = *(const GAS f32x4*)(cw + j * 512 + h * 64 + 8 * cg + 4);
                    const f32x4 k0 = *(const GAS f32x4*)(cw + j * 512 + 256 + h * 64 + 8 * cg), k1 = *(const GAS f32x4*)(cw + j * 512 + 256 + h * 64 + 8 * cg + 4);
                    aq[0] += q0[0] * bflo(wq.x); aq[1] += q0[1] * bfhi(wq.x); aq[2] += q0[2] * bflo(wq.y); aq[3] += q0[3] * bfhi(wq.y);
                    aq[4] += q1[0] * bflo(wq.z); aq[5] += q1[1] * bfhi(wq.z); aq[6] += q1[2] * bflo(wq.w); aq[7] += q1[3] * bfhi(wq.w);
                    ak[0] += k0[0] * bflo(wk.x); ak[1] += k0[1] * bfhi(wk.x); ak[2] += k0[2] * bflo(wk.y); ak[3] += k0[3] * bfhi(wk.y);
                    ak[4] += k1[0] * bflo(wk.z); ak[5] += k1[1] * bfhi(wk.z); ak[6] += k1[2] * bflo(wk.w); ak[7] += k1[3] * bfhi(wk.w); } }
            const float Ml = fmaxf(m, GC[c * 64 + sl]), ainter = __expf(m - Ml), wsv = __expf(GA[c * 64 + sl] - M63);
            float qv[8], kv[8];
#pragma unroll
            for (int i = 0; i < 8; ++i) { qv[i] = 0.125f * aq[i] * __builtin_amdgcn_rcpf(1.f + __expf(-aq[i])); kv[i] = ak[i] * __builtin_amdgcn_rcpf(1.f + __expf(-ak[i])); }
            if (OUT) {
                v4u w; w.x = pk2(qv[0], qv[1]); w.y = pk2(qv[2], qv[3]); w.z = pk2(qv[4], qv[5]); w.w = pk2(qv[6], qv[7]); *(LAS v4u*)(lds + O_Q + sl * 144 + cg * 16) = w;
                w.x = pk2(qv[0] * ainter, qv[1] * ainter); w.y = pk2(qv[2] * ainter, qv[3] * ainter); w.z = pk2(qv[4] * ainter, qv[5] * ainter); w.w = pk2(qv[6] * ainter, qv[7] * ainter); *(LAS v4u*)(lds + O_QA + sl * 144 + cg * 16) = w;
                w.x = pk2(kv[0], kv[1]); w.y = pk2(kv[2], kv[3]); w.z = pk2(kv[4], kv[5]); w.w = pk2(kv[6], kv[7]); *(LAS v4u*)(lds + O_K + sl * 144 + cg * 16) = w;
            }
#pragma unroll
            for (int i = 0; i < 8; ++i) *(LAS bf16*)(lds + O_KWT + (8 * cg + i) * 144 + sl * 2) = (bf16)f2bf(kv[i] * wsv);
#pragma unroll
            for (int gi = 0; gi < 2; ++gi) { const int g8 = cg + 8 * gi; const v4u wv = *(const GAS v4u*)(P + (tc0 + sl) * NPROJ + C_MV + h * 128 + 8 * g8);
                const unsigned ww[4] = {wv.x, wv.y, wv.z, wv.w};
#pragma unroll
                for (int i = 0; i < 4; ++i) { *(LAS bf16*)(lds + O_VT + (8 * g8 + 2 * i) * 144 + sl * 2) = (bf16)(ww[i] & 0xffffu); *(LAS bf16*)(lds + O_VT + (8 * g8 + 2 * i + 1) * 144 + sl * 2) = (bf16)(ww[i] >> 16); } }
        }
        __syncthreads();
        if (OUT) {
            const int lt = wave >> 1, l = 16 * lt + fr; const float Ml = fmaxf(m, GC[c * 64 + l]);
            const bf16x8 bq0 = ldfrag(lds + O_Q, 16 * lt + fr, 16 * fq), bq1 = ldfrag(lds + O_Q, 16 * lt + fr, 64 + 16 * fq);
#pragma unroll
            for (int u = 0; u < 2; ++u) { const int stl = 2 * (wave & 1) + u; f32x4 acc = {0.f, 0.f, 0.f, 0.f};
                acc = MFMA16(ldfrag(lds + O_K, 16 * stl + fr, 16 * fq), bq0, acc); acc = MFMA16(ldfrag(lds + O_K, 16 * stl + fr, 64 + 16 * fq), bq1, acc);
                const f32x4 av = *(LAS const f32x4*)(GA + c * 64 + 16 * stl + 4 * fq); float wv[4];
#pragma unroll
                for (int r = 0; r < 4; ++r) { const int s = 16 * stl + 4 * fq + r; wv[r] = (s <= l) ? acc[r] * __expf(av[r] - Ml) : 0.f; }
                v2u w; w.x = cvtpk(wv[0], wv[1]); w.y = cvtpk(wv[2], wv[3]); *(LAS v2u*)(lds + O_S + l * 144 + (16 * stl + 4 * fq) * 2) = w; }
        }
        {
            const bf16x8 va0 = ldfrag(lds + O_VT, 16 * wave + fr, 16 * fq), va1 = ldfrag(lds + O_VT, 16 * wave + fr, 64 + 16 * fq);
#pragma unroll
            for (int j = 0; j < 4; ++j) { st[j] = st[j] * decay;
                st[j] = MFMA16(va0, ldfrag(lds + O_KWT, 16 * j + fr, 16 * fq), st[j]); st[j] = MFMA16(va1, ldfrag(lds + O_KWT, 16 * j + fr, 64 + 16 * fq), st[j]); }
            if (wave < 4) { st[4] = st[4] * decay;
                st[4] = MFMA16(ldfrag(lds + O_VT, 128 + fr, 16 * fq), ldfrag(lds + O_KWT, 16 * wave + fr, 16 * fq), st[4]);
                st[4] = MFMA16(ldfrag(lds + O_VT, 128 + fr, 64 + 16 * fq), ldfrag(lds + O_KWT, 16 * wave + fr, 64 + 16 * fq), st[4]); }
        }
        if (OUT) {
            __syncthreads();
            LAS const unsigned char* cx = lds + O_CX + (c & 1) * CXB;
            f32x4 nt[4], nd = {0.f, 0.f, 0.f, 0.f};
            {
                const bf16x8 va0 = ldfrag(lds + O_VT, 16 * wave + fr, 16 * fq), va1 = ldfrag(lds + O_VT, 16 * wave + fr, 64 + 16 * fq);
                const bf16x8 ca0 = ldfrag(cx, 16 * wave + fr, 16 * fq), ca1 = ldfrag(cx, 16 * wave + fr, 64 + 16 * fq);
#pragma unroll
                for (int lt = 0; lt < 4; ++lt) { f32x4 acc = {0.f, 0.f, 0.f, 0.f};
                    acc = MFMA16(va0, ldfrag(lds + O_S, 16 * lt + fr, 16 * fq), acc); acc = MFMA16(va1, ldfrag(lds + O_S, 16 * lt + fr, 64 + 16 * fq), acc);
                    acc = MFMA16(ca0, ldfrag(lds + O_QA, 16 * lt + fr, 16 * fq), acc); acc = MFMA16(ca1, ldfrag(lds + O_QA, 16 * lt + fr, 64 + 16 * fq), acc); nt[lt] = acc; }
                if (wave >= 4) { const int lt = wave - 4;
                    nd = MFMA16(ldfrag(lds + O_VT, 128 + fr, 16 * fq), ldfrag(lds + O_S, 16 * lt + fr, 16 * fq), nd); nd = MFMA16(ldfrag(lds + O_VT, 128 + fr, 64 + 16 * fq), ldfrag(lds + O_S, 16 * lt + fr, 64 + 16 * fq), nd);
                    nd = MFMA16(ldfrag(cx, 128 + fr, 16 * fq), ldfrag(lds + O_QA, 16 * lt + fr, 16 * fq), nd); nd = MFMA16(ldfrag(cx, 128 + fr, 64 + 16 * fq), ldfrag(lds + O_QA, 16 * lt + fr, 64 + 16 * fq), nd);
                    if (fq == 0) DEN[16 * lt + fr] = nd[0]; }
            }
            v2u mo[4];
#pragma unroll
            for (int lt = 0; lt < 4; ++lt) mo[lt] = *(const GAS v2u*)(P + (tc0 + 16 * lt + fr) * NPROJ + C_MO + h * 128 + 16 * wave + 4 * fq);
            __syncthreads();
#pragma unroll
            for (int lt = 0; lt < 4; ++lt) { const int l = 16 * lt + fr; const float Ml = fmaxf(m, GC[c * 64 + l]);
                const float inv = 1.0f / fmaxf(fabsf(DEN[l]), __expf(-(GB[c * 64 + l] + Ml)));
                nt[lt] = nt[lt] * inv; float ss = (nt[lt][0] * nt[lt][0] + nt[lt][1] * nt[lt][1]) + (nt[lt][2] * nt[lt][2] + nt[lt][3] * nt[lt][3]);
                ss += __shfl_xor(ss, 16); ss += __shfl_xor(ss, 32);
                if (fq == 0) SSQ[wave * 64 + l] = ss; }
            LAS unsigned char* cxn = lds + O_CX + ((c + 1) & 1) * CXB;
#pragma unroll
            for (int j = 0; j < 4; ++j)
#pragma unroll
                for (int r = 0; r < 4; ++r) *(LAS bf16*)(cxn + (16 * wave + 4 * fq + r) * 144 + (16 * j + fr) * 2) = (bf16)f2bf(st[j][r]);
            if (wave < 4) {
#pragma unroll
                for (int r = 0; r < 4; ++r) *(LAS bf16*)(cxn + (128 + 4 * fq + r) * 144 + (16 * wave + fr) * 2) = (bf16)f2bf(st[4][r]); }
            __syncthreads();
#pragma unroll
            for (int lt = 0; lt < 4; ++lt) { const int l = 16 * lt + fr; float tot = 0.f;
#pragma unroll
                for (int w2 = 0; w2 < 8; ++w2) tot += SSQ[w2 * 64 + l];
                const float rn = 1.0f / sqrtf(tot * (1.f / 128.f) + EPS);
                const float o0 = nt[lt][0] * rn * gsc[0] * bflo(mo[lt].x), o1 = nt[lt][1] * rn * gsc[1] * bfhi(mo[lt].x), o2 = nt[lt][2] * rn * gsc[2] * bflo(mo[lt].y), o3 = nt[lt][3] * rn * gsc[3] * bfhi(mo[lt].y);
                v2u w; w.x = pk2(o0, o1); w.y = pk2(o2, o3);
                *(GAS v2u*)(MI + (tc0 + l) * D + 512 + h * 128 + 16 * wave + 4 * fq) = w; }
        } else {
            __syncthreads();
        }
        m = bL + M63; Btot += bL;
    }
    if (!OUT) {
#pragma unroll
        for (int i = 0; i < 5; ++i)
#pragma unroll
            for (int r = 0; r < 4; ++r) MST[((size_t)wg * 20 + i * 4 + r) * NTHR + tid] = st[i][r];
        if (tid == 0) { MSC[wg * 2] = m; MSC[wg * 2 + 1] = Btot; }
    }
}

namespace at {
constexpr int O_K = 0, O_VT = 36864, VTS = 560  , O_END = O_VT + 64 * VTS;
static_assert(O_END <= 131072, "attention LDS");
}
__device__ __forceinline__ void phase_attn(const Args& A, LAS unsigned char* lds) {
    using namespace at;
    const int tid = threadIdx.x, lane = tid & 63, wave = __builtin_amdgcn_readfirstlane(tid >> 6), fr = lane & 15, fq = lane >> 4, G = gridDim.x;
    const bf16* P = (const bf16*)(A.ws + WS_PROJ); bf16* MI = (bf16*)(A.ws + WS_MIXIN); const float* sinks = (const float*)A.in[I_SINK];
    __syncthreads();
    for (int e = tid; e < 64 * 12; e += NTHR) { const int r = e / 12, cpair = e % 12; *(LAS unsigned*)(lds + O_VT + r * VTS + 512 + cpair * 4) = 0u; }
    for (int unit = blockIdx.x; unit < NB * 64 * 2; unit += G) {
        const int g = unit & 1, n = (unit >> 1) & 63, b = unit >> 7;
        const size_t tq0 = (size_t)b * SEQ + (size_t)n * 128;
        __syncthreads();
#pragma unroll
        for (int i = 0; i < 4; ++i) { const int item = tid + NTHR * i, row = item >> 3, ch = item & 7;
            v4u wk = {0u, 0u, 0u, 0u}, wv = {0u, 0u, 0u, 0u};
            if (n > 0 || row >= 128) { const bf16* rp = P + (tq0 - 128 + row) * NPROJ; wk = *(const GAS v4u*)(rp + C_AK + g * 64 + 8 * ch); wv = *(const GAS v4u*)(rp + C_AV + g * 64 + 8 * ch); }
            *(LAS v4u*)(lds + O_K + row * 144 + ch * 16) = wk;
            const unsigned ww[4] = {wv.x, wv.y, wv.z, wv.w};
#pragma unroll
            for (int k = 0; k < 4; ++k) { *(LAS bf16*)(lds + O_VT + (8 * ch + 2 * k) * VTS + row * 2) = (bf16)(ww[k] & 0xffffu); *(LAS bf16*)(lds + O_VT + (8 * ch + 2 * k + 1) * VTS + row * 2) = (bf16)(ww[k] >> 16); } }
        const int hq = 4 * g + (wave >> 1), qr0 = 64 * (wave & 1); const float sink = sinks[hq];
        __syncthreads();
        for (int qt = 0; qt < 4; ++qt) {
            const int i0 = qr0 + 16 * qt, st0 = i0 >> 4, iq = i0 + fr;
            const bf16* qp = P + (tq0 + iq) * NPROJ + C_AQ + hq * 64 + 8 * fq;
            const bf16x8 bq0 = *(const GAS bf16x8*)qp, bq1 = *(const GAS bf16x8*)(qp + 32);
            f32x4 sc[9]; float mx = sink;
#pragma unroll
            for (int t = 0; t < 9; ++t) { const int sb0 = 16 * (st0 + t); f32x4 acc = {0.f, 0.f, 0.f, 0.f};
                acc = MFMA16(ldfrag(lds + O_K, sb0 + fr, 16 * fq), bq0, acc); acc = MFMA16(ldfrag(lds + O_K, sb0 + fr, 64 + 16 * fq), bq1, acc);
#pragma unroll
                for (int r = 0; r < 4; ++r) { const int sb = sb0 + 4 * fq + r; const bool valid = (sb > iq) && (sb <= iq + 128) && (n > 0 || sb >= 128);
                    acc[r] = valid ? acc[r] : -3.0e38f; mx = fmaxf(mx, acc[r]); }
                sc[t] = acc; }
            mx = fmaxf(mx, __shfl_xor(mx, 16)); mx = fmaxf(mx, __shfl_xor(mx, 32));
            float lsum = 0.f;
#pragma unroll
            for (int t = 0; t < 9; ++t)
#pragma unroll
                for (int r = 0; r < 4; ++r) { const float p = (sc[t][r] > -1.0e38f) ? __expf(sc[t][r] - mx) : 0.f; sc[t][r] = p; lsum += p; }
            lsum += __shfl_xor(lsum, 16); lsum += __shfl_xor(lsum, 32); lsum += __expf(sink - mx);
            f32x4 oacc[4];
#pragma unroll
            for (int dt = 0; dt < 4; ++dt) oacc[dt] = (f32x4){0.f, 0.f, 0.f, 0.f};
#pragma unroll
            for (int ks = 0; ks < 5; ++ks) {
                union { bf16x8 v; unsigned u[4]; } pb;
                pb.u[0] = cvtpk(sc[2 * ks][0], sc[2 * ks][1]); pb.u[1] = cvtpk(sc[2 * ks][2], sc[2 * ks][3]);
                if (ks < 4) { pb.u[2] = cvtpk(sc[2 * ks + 1][0], sc[2 * ks + 1][1]); pb.u[3] = cvtpk(sc[2 * ks + 1][2], sc[2 * ks + 1][3]); } else { pb.u[2] = 0u; pb.u[3] = 0u; }
                const int sbb = 16 * (st0 + 2 * ks) + 4 * fq;
#pragma unroll
                for (int dt = 0; dt < 4; ++dt) { LAS const unsigned char* vp = lds + O_VT + (16 * dt + fr) * VTS + sbb * 2;
                    union { bf16x8 v; v2u h[2]; } va; va.h[0] = *(LAS const v2u*)vp; va.h[1] = *(LAS const v2u*)(vp + 32);
                    oacc[dt] = MFMA16(va.v, pb.v, oacc[dt]); } }
            const float il = 1.0f / lsum;
#pragma unroll
            for (int dt = 0; dt < 4; ++dt) { v2u w; w.x = pk2(oacc[dt][0] * il, oacc[dt][1] * il); w.y = pk2(oacc[dt][2] * il, oacc[dt][3] * il);
                *(GAS v2u*)(MI + (tq0 + iq) * D + hq * 64 + 16 * dt + 4 * fq) = w; }
        }
    }
}
typedef float f32x16 __attribute__((ext_vector_type(16)));
__device__ __forceinline__ unsigned fbits(float f) { return __builtin_bit_cast(unsigned, f); }
__device__ __forceinline__ float bfloat(unsigned u) { return __builtin_bit_cast(float, u); }

#define CE_DESC(a, b) do { const float _mx = __builtin_fmaxf(a, b), _mn = __builtin_fminf(a, b); a = _mx; b = _mn; } while (0)
__device__ __forceinline__ void bsort16(float (&v)[16]) {
#pragma unroll
    for (int k = 2; k <= 16; k <<= 1)
#pragma unroll
        for (int j = k >> 1; j > 0; j >>= 1)
#pragma unroll
            for (int i = 0; i < 16; ++i) { const int l = i ^ j; if (l > i) { if ((i & k) == 0) CE_DESC(v[i], v[l]); else CE_DESC(v[l], v[i]); } }
}
__device__ __forceinline__ void bmerge16(float (&v)[16], const float (&w)[16]) {
#pragma unroll
    for (int i = 0; i < 16; ++i) v[i] = __builtin_fmaxf(v[i], w[15 - i]);
#pragma unroll
    for (int j = 8; j > 0; j >>= 1)
#pragma unroll
        for (int i = 0; i < 16; ++i) { const int l = i ^ j; if (l > i) CE_DESC(v[i], v[l]); }
}
namespace tk {
constexpr int KS = 272;
constexpr int O_K1 = 0, O_K2 = 128 * KS, O_X = 2 * 128 * KS, O_END = O_X + 8 * 4096;
static_assert(O_END <= 131072, "topk LDS");
constexpr unsigned char CAND[64] = {
    0x00, 0x01, 0x02, 0x03, 0x04, 0x05, 0x06, 0x07, 0x08, 0x09, 0x0a, 0x0b, 0x0c, 0x0d, 0x0e, 0x0f,
    0x10, 0x11, 0x12, 0x13, 0x14, 0x15, 0x16, 0x17, 0x80, 0x90, 0xa0, 0xb0, 0xc0, 0xd0, 0xe0, 0xf0,
    0x20, 0x21, 0x22, 0x23, 0x24, 0x30, 0x31, 0x32, 0x33, 0x40, 0x41, 0x42, 0x50, 0x51, 0x60, 0x61,
    0x70, 0x71, 0xff, 0xff, 0xff, 0xff, 0xff, 0xff, 0xff, 0xff, 0xff, 0xff, 0xff, 0xff, 0xff, 0xff};
}
__device__ __forceinline__ void side_top16(const f32x16 (&acc)[4], int hh, float (&T)[16]) {
    float g1[16], g2[16];
#pragma unroll
    for (int r = 0; r < 16; ++r) { const unsigned key = (r & 3) + 8 * (r >> 2) + 4 * hh;
        T[r] = bfloat((fbits(acc[0][r]) & 0xffffff80u) | key);
        g1[r] = bfloat((fbits(acc[1][r]) & 0xffffff80u) | (32u + key)); }
    bsort16(T); bsort16(g1); bmerge16(T, g1);
#pragma unroll
    for (int r = 0; r < 16; ++r) { const unsigned key = (r & 3) + 8 * (r >> 2) + 4 * hh;
        g1[r] = bfloat((fbits(acc[2][r]) & 0xffffff80u) | (64u + key));
        g2[r] = bfloat((fbits(acc[3][r]) & 0xffffff80u) | (96u + key)); }
    bsort16(g1); bsort16(g2); bmerge16(g1, g2); bmerge16(T, g1);
#pragma unroll
    for (int r = 0; r < 16; ++r) g1[r] = __shfl_xor(T[r], 32);
    bmerge16(T, g1);
}
template <int SD> __device__ __forceinline__ void topk_side(const bf16* Q, LAS unsigned char* lds, int t, int h, int r32, int hh, float (&T)[16]) {
    using namespace tk;
    f32x16 acc[4];
#pragma unroll
    for (int mt = 0; mt < 4; ++mt)
#pragma unroll
        for (int r = 0; r < 16; ++r) acc[mt][r] = 0.f;
    const bf16* qp = Q + (size_t)t * 2048 + h * 256 + SD * 128 + 8 * hh; LAS const unsigned char* kimg = lds + (SD ? O_K2 : O_K1);
#pragma unroll
    for (int ks = 0; ks < 8; ++ks) { const bf16x8 bq = *(const GAS bf16x8*)(qp + 16 * ks);
#pragma unroll
        for (int mt = 0; mt < 4; ++mt) acc[mt] = __builtin_amdgcn_mfma_f32_32x32x16_bf16(*(LAS const bf16x8*)(kimg + (32 * mt + r32) * KS + 32 * ks + 16 * hh), bq, acc[mt], 0, 0, 0); }
    side_top16(acc, hh, T);
}
template <int Q> __device__ __forceinline__ float cand_val(const float (&T1)[16], const float (&T2)[16], int hh) {
    constexpr unsigned c0 = tk::CAND[2 * Q], c1 = tk::CAND[2 * Q + 1];
    const float s = (hh ? T1[(c1 >> 4) & 15] : T1[(c0 >> 4) & 15]) + (hh ? T2[c1 & 15] : T2[c0 & 15]); const unsigned code = hh ? c1 : c0;
    return (code == 0xffu) ? -3.0e38f : bfloat((fbits(s) & 0xffffff00u) | code);
}
__device__ __forceinline__ void phase_topk(const Args& A, LAS unsigned char* lds) {
    using namespace tk;
    const int tid = threadIdx.x, lane = tid & 63, wave = __builtin_amdgcn_readfirstlane(tid >> 6), G = gridDim.x;
    const bf16* Q = (const bf16*)(A.ws + WS_PROJ); const bf16* KB = (const bf16*)(A.ws + WS_KEYS);
    unsigned short* EI = (unsigned short*)(A.ws + WS_EIDX); float* GT = (float*)(A.ws + WS_GATE);
    const int h = blockIdx.x & 7, r32 = lane & 31, hh = lane >> 5;
    __syncthreads();
    for (int e = tid; e < 2 * 128 * 16; e += NTHR) { const int s = e >> 11, row = (e >> 4) & 127, ch = e & 15;
        *(LAS v4u*)(lds + (s ? O_K2 : O_K1) + row * KS + ch * 16) = *(const GAS v4u*)(KB + (size_t)s * 8 * 128 * 128 + ((size_t)h * 128 + row) * 128 + ch * 8); }
    __syncthreads();
    LAS float* XW = (LAS float*)(lds + O_X + wave * 4096) + r32 * 32;
    for (int tile = (int)(blockIdx.x >> 3); tile < M / 256; tile += (G >> 3)) {
        const int t = tile * 256 + 32 * wave + r32;
        float T1[16], T2[16];
        topk_side<0>(Q, lds, t, h, r32, hh, T1);
        topk_side<1>(Q, lds, t, h, r32, hh, T2);
        float c[16], w[16];
        c[0] = cand_val<0>(T1, T2, hh); w[0] = cand_val<16>(T1, T2, hh);
        c[1] = cand_val<1>(T1, T2, hh); w[1] = cand_val<17>(T1, T2, hh);
        c[2] = cand_val<2>(T1, T2, hh); w[2] = cand_val<18>(T1, T2, hh);
        c[3] = cand_val<3>(T1, T2, hh); w[3] = cand_val<19>(T1, T2, hh);
        c[4] = cand_val<4>(T1, T2, hh); w[4] = cand_val<20>(T1, T2, hh);
        c[5] = cand_val<5>(T1, T2, hh); w[5] = cand_val<21>(T1, T2, hh);
        c[6] = cand_val<6>(T1, T2, hh); w[6] = cand_val<22>(T1, T2, hh);
        c[7] = cand_val<7>(T1, T2, hh); w[7] = cand_val<23>(T1, T2, hh);
        c[8] = cand_val<8>(T1, T2, hh); w[8] = cand_val<24>(T1, T2, hh);
        c[9] = cand_val<9>(T1, T2, hh); w[9] = cand_val<25>(T1, T2, hh);
        c[10] = cand_val<10>(T1, T2, hh); w[10] = cand_val<26>(T1, T2, hh);
        c[11] = cand_val<11>(T1, T2, hh); w[11] = cand_val<27>(T1, T2, hh);
        c[12] = cand_val<12>(T1, T2, hh); w[12] = cand_val<28>(T1, T2, hh);
        c[13] = cand_val<13>(T1, T2, hh); w[13] = cand_val<29>(T1, T2, hh);
        c[14] = cand_val<14>(T1, T2, hh); w[14] = cand_val<30>(T1, T2, hh);
        c[15] = cand_val<15>(T1, T2, hh); w[15] = cand_val<31>(T1, T2, hh);
        bsort16(c); bsort16(w); bmerge16(c, w);
#pragma unroll
        for (int r = 0; r < 16; ++r) w[r] = __shfl_xor(c[r], 32);
        bmerge16(c, w);
        if (hh == 0) {
#pragma unroll
            for (int q4 = 0; q4 < 4; ++q4) { *(LAS f32x4*)(XW + 4 * q4) = (f32x4){T1[4 * q4], T1[4 * q4 + 1], T1[4 * q4 + 2], T1[4 * q4 + 3]};
                *(LAS f32x4*)(XW + 16 + 4 * q4) = (f32x4){T2[4 * q4], T2[4 * q4 + 1], T2[4 * q4 + 2], T2[4 * q4 + 3]}; } }
        asm volatile("s_waitcnt lgkmcnt(0)" ::: "memory");
        float ex[16], sum = 0.f; const float tmax = bfloat(fbits(c[0]) & 0xffffff00u);
#pragma unroll
        for (int r = 0; r < 16; ++r) { ex[r] = __expf(bfloat(fbits(c[r]) & 0xffffff00u) - tmax); sum += ex[r]; }
        const float isum = 1.0f / sum; const size_t ob = (size_t)t * NSLOT + h * 16 + 8 * hh;
        unsigned eo[8]; float go[8];
#pragma unroll
        for (int r = 0; r < 8; ++r) { float ca = c[r], cb = c[8 + r], ea = ex[r], eb = ex[8 + r]; asm volatile("" : "+v"(ca), "+v"(cb), "+v"(ea), "+v"(eb)); const float cv = hh ? cb : ca, ev = hh ? eb : ea;
            const unsigned code = fbits(cv) & 0xffu;
            const unsigned i1 = fbits(XW[code >> 4]) & 127u, i2 = fbits(XW[16 + (code & 15)]) & 127u;
            eo[r] = i1 * 128u + i2; go[r] = ev * isum; }
        *(GAS v4u*)(EI + ob) = (v4u){eo[0] | (eo[1] << 16), eo[2] | (eo[3] << 16), eo[4] | (eo[5] << 16), eo[6] | (eo[7] << 16)};
        *(GAS f32x4*)(GT + ob) = (f32x4){go[0], go[1], go[2], go[3]}; *(GAS f32x4*)(GT + ob + 4) = (f32x4){go[4], go[5], go[6], go[7]};
        asm volatile("s_waitcnt lgkmcnt(0)" ::: "memory");
    }
}
__device__ __forceinline__ void phase_peer_u(const Args& A) {
    const int tid = threadIdx.x, lane = tid & 63, wave = tid >> 6, p = blockIdx.x & 7, j = blockIdx.x >> 3, nj = gridDim.x >> 3, g = lane >> 3, c = lane & 7;
    const bf16* H = (const bf16*)(A.ws + WS_H); const unsigned char* U8 = (const unsigned char*)(A.ws + WS_U8); const unsigned short* EI = (const unsigned short*)(A.ws + WS_EIDX);
    float* PD = (float*)(A.ws + WS_PD) + (size_t)p * M * NSLOT;
    const int tper = M / nj;
    for (int t = j * tper + wave; t < (j + 1) * tper; t += NWAVES) {
        float hv[16]; ld16bf(H + (size_t)t * D + 128 * p + 16 * c, hv);
        const v4u e0 = *(const GAS v4u*)(EI + (size_t)t * NSLOT + 16 * g), e1 = *(const GAS v4u*)(EI + (size_t)t * NSLOT + 16 * g + 8);
        const unsigned ew[8] = {e0.x, e0.y, e0.z, e0.w, e1.x, e1.y, e1.z, e1.w};
        float d[16]; v4u raw[16];
#pragma unroll
        for (int k = 0; k < 16; ++k) { const unsigned e = (k & 1) ? (ew[k >> 1] >> 16) : (ew[k >> 1] & 0xffffu); raw[k] = *(const GAS v4u*)(U8 + (size_t)e * D + 128 * p + 16 * c); }
        __builtin_amdgcn_sched_barrier(0);
#pragma unroll
        for (int k = 0; k < 16; ++k) { float uf[16]; cvt16_fp8(raw[k], uf); float s = 0.f;
#pragma unroll
            for (int i = 0; i < 16; ++i) s += uf[i] * hv[i];
            d[k] = s; __builtin_amdgcn_sched_barrier(0); }
#pragma unroll
        for (int i = 0; i < 8; ++i) { const bool up = (lane & 4) != 0; const float keep = up ? d[i + 8] : d[i], send = up ? d[i] : d[i + 8]; d[i] = keep + __shfl_xor(send, 4); }
#pragma unroll
        for (int i = 0; i < 4; ++i) { const bool up = (lane & 2) != 0; const float keep = up ? d[i + 4] : d[i], send = up ? d[i] : d[i + 4]; d[i] = keep + __shfl_xor(send, 2); }
#pragma unroll
        for (int i = 0; i < 2; ++i) { const bool up = (lane & 1) != 0; const float keep = up ? d[i + 2] : d[i], send = up ? d[i] : d[i + 2]; d[i] = keep + __shfl_xor(send, 1); }
        *(GAS f32x2*)(PD + (size_t)t * NSLOT + 16 * g + 2 * c) = (f32x2){d[0], d[1]};
    }
}
__device__ __forceinline__ void phase_peer_act(const Args& A) {
    const float* PD = (const float*)(A.ws + WS_PD); const unsigned short* EI = (const unsigned short*)(A.ws + WS_EIDX); const float* GT = (const float*)(A.ws + WS_GATE);
    const float* usc = (const float*)(A.ws + WS_SC); const float* vsc = usc + NEXP; float* ACT = (float*)(A.ws + WS_ACT);
    for (size_t i = (size_t)blockIdx.x * NTHR + threadIdx.x; i < (size_t)M * NSLOT; i += (size_t)gridDim.x * NTHR) {
        float s = 0.f;
#pragma unroll
        for (int p = 0; p < 8; ++p) s += PD[(size_t)p * M * NSLOT + i];
        const unsigned e = EI[i]; s *= usc[e];
        ACT[i] = 0.5f * s * (1.f + erff(s * 0.70710678118654752f)) * GT[i] * vsc[e];
    }
}
__device__ __forceinline__ void phase_peer_v(const Args& A) {
    const int tid = threadIdx.x, lane = tid & 63, wave = tid >> 6, p = blockIdx.x & 7, j = blockIdx.x >> 3, nj = gridDim.x >> 3, g = lane >> 3, c = lane & 7;
    const unsigned char* V8 = (const unsigned char*)(A.ws + WS_V8); const unsigned short* EI = (const unsigned short*)(A.ws + WS_EIDX); const float* ACT = (const float*)(A.ws + WS_ACT);
    bf16* Y = (bf16*)(A.ws + WS_H); float* SSY = (float*)(A.ws + WS_SSY);
    const int tper = M / nj;
    for (int t = j * tper + wave; t < (j + 1) * tper; t += NWAVES) {
        const v4u e0 = *(const GAS v4u*)(EI + (size_t)t * NSLOT + 16 * g), e1 = *(const GAS v4u*)(EI + (size_t)t * NSLOT + 16 * g + 8);
        const unsigned ew[8] = {e0.x, e0.y, e0.z, e0.w, e1.x, e1.y, e1.z, e1.w};
        const GAS f32x4* ap = (const GAS f32x4*)(ACT + (size_t)t * NSLOT + 16 * g); const f32x4 a0 = ap[0], a1 = ap[1], a2 = ap[2], a3 = ap[3];
        const float av[16] = {a0[0], a0[1], a0[2], a0[3], a1[0], a1[1], a1[2], a1[3], a2[0], a2[1], a2[2], a2[3], a3[0], a3[1], a3[2], a3[3]};
        float y[16];
#pragma unroll
        for (int i = 0; i < 16; ++i) y[i] = 0.f;
        v4u raw[16];
#pragma unroll
        for (int k = 0; k < 16; ++k) { const unsigned e = (k & 1) ? (ew[k >> 1] >> 16) : (ew[k >> 1] & 0xffffu); raw[k] = *(const GAS v4u*)(V8 + (size_t)e * D + 128 * p + 16 * c); }
        __builtin_amdgcn_sched_barrier(0);
#pragma unroll
        for (int k = 0; k < 16; ++k) { float vf[16]; cvt16_fp8(raw[k], vf);
#pragma unroll
            for (int i = 0; i < 16; ++i) y[i] += av[k] * vf[i];
            __builtin_amdgcn_sched_barrier(0); }
#pragma unroll
        for (int i = 0; i < 8; ++i) { const bool up = (lane & 32) != 0; const float keep = up ? y[i + 8] : y[i], send = up ? y[i] : y[i + 8]; y[i] = keep + __shfl_xor(send, 32); }
#pragma unroll
        for (int i = 0; i < 4; ++i) { const bool up = (lane & 16) != 0; const float keep = up ? y[i + 4] : y[i], send = up ? y[i] : y[i + 4]; y[i] = keep + __shfl_xor(send, 16); }
#pragma unroll
        for (int i = 0; i < 2; ++i) { const bool up = (lane & 8) != 0; const float keep = up ? y[i + 2] : y[i], send = up ? y[i] : y[i + 2]; y[i] = keep + __shfl_xor(send, 8); }
        *(GAS unsigned*)(Y + (size_t)t * D + 128 * p + 16 * c + 2 * g) = pk2(y[0], y[1]);
        const float ss = wave_sum(y[0] * y[0] + y[1] * y[1]);
        if (lane == 0) SSY[(size_t)t * 8 + p] = ss;
    }
}
__device__ __forceinline__ void phase_peer_final(const Args& A) {
    const int tid = threadIdx.x, lane = tid & 63, wave = tid >> 6, G = gridDim.x;
    const bf16* Y = (const bf16*)(A.ws + WS_H); const float* SSY = (const float*)(A.ws + WS_SSY); const float* mod = (const float*)(A.ws + WS_MOD); const float* gpost = (const float*)A.in[I_GPOST2]; float* out = A.out;
    for (int row = blockIdx.x * NWAVES + wave; row < M; row += G * NWAVES) {
        const int b = row / SEQ; const f32x4 s0 = *(const GAS f32x4*)(SSY + (size_t)row * 8), s1 = *(const GAS f32x4*)(SSY + (size_t)row * 8 + 4);
        const float rstd = 1.0f / sqrtf((((s0[0] + s0[1]) + (s0[2] + s0[3])) + ((s1[0] + s1[1]) + (s1[2] + s1[3]))) * (1.f / D) + EPS);
        GAS f32x4* orow = (GAS f32x4*)(out + (size_t)row * D) + lane; const GAS v2u* yr = (const GAS v2u*)(Y + (size_t)row * D) + lane;
#pragma unroll
        for (int q = 0; q < 4; ++q) { const int k = 4 * (lane + 64 * q); f32x4 xv = orow[64 * q]; const v2u yw = yr[64 * q];
            const f32x4 g2 = *(const GAS f32x4*)(mod + b * 6144 + 5120 + k), gp = *(const GAS f32x4*)(gpost + k);
            xv[0] += g2[0] * (bflo(yw.x) * rstd * gp[0]); xv[1] += g2[1] * (bfhi(yw.x) * rstd * gp[1]); xv[2] += g2[2] * (bflo(yw.y) * rstd * gp[2]); xv[3] += g2[3] * (bfhi(yw.y) * rstd * gp[3]);
            orow[64 * q] = xv; }
    }
}
#ifndef MK_N_LAUNCHES
#define MK_N_LAUNCHES 1
#endif
constexpr int N_PHASES = 13;
typedef const __attribute__((address_space(4))) Args* KArgP;
__device__ __forceinline__ const Args& kargs() { KArgP p = (KArgP)__builtin_amdgcn_kernarg_segment_ptr(); asm volatile("" : "+s"(p)); return *(const Args*)p; }
__global__ void __launch_bounds__(NTHR, 2) hymba_fwd(Args A_) {
    extern __shared__ __attribute__((aligned(16))) unsigned char lds_raw[];
    LAS unsigned char* lds = (LAS unsigned char*)lds_raw;
    const int lo = A_.ph_lo, hi = A_.ph_hi;
#define A kargs()
#define ws (kargs().ws)
#define IN(k) (lo <= (k) && (k) < hi)
#define SEAM(k) do { if (IN(k) && IN((k) + 1)) { cg::this_grid().sync(); } } while (0)

    if (IN(0)) { phase_prologue(A, lds); } SEAM(0);
    if (IN(1)) { phase_prenorm(A); } SEAM(1);
    if (IN(2)) {
        pg8::Gemm g{(const pg8::bf16_t*)(ws + WS_H), (const pg8::bf16_t*)(ws + WS_WIN), M, NIN_PAD, D}; pg8::StaticOrder S; S.init(M, NIN_PAD, gridDim.x, (int)blockIdx.x);
        pg8::EpiProj E{(pg8::bf16_t*)(ws + WS_PROJ), NPROJ, (float*)(ws + WS_GATES), (const int*)A.in[I_POS], (const float*)A.in[I_BI], (const float*)A.in[I_BF]};
        pg8::gemm_phase<pg8::EpiProj, pg8::StaticOrder, true, true>(lds, g, S, E);
    } SEAM(2);
    if (IN(3)) {
        phase_attn(A, lds);
        for (int wg = blockIdx.x; wg < 256; wg += gridDim.x) mlstm_group<false>(A, lds, wg);
    } SEAM(3);
    if (IN(4)) { for (int wg = blockIdx.x; wg < 256; wg += gridDim.x) mlstm_group<true>(A, lds, wg); } SEAM(4);
    if (IN(5)) {
        pg8::Gemm g{(const pg8::bf16_t*)(ws + WS_MIXIN), (const pg8::bf16_t*)(ws + WS_WOUT), M, D, D}; pg8::StaticOrder S; S.init(M, D, gridDim.x, (int)blockIdx.x);
        pg8::EpiMix E{(pg8::bf16_t*)(ws + WS_MIX), D, (float*)(ws + WS_SSQ)};
        pg8::gemm_phase<pg8::EpiMix, pg8::StaticOrder, true, true>(lds, g, S, E);
    } SEAM(5);
    if (IN(6)) { phase_mid(A); } SEAM(6);
    if (IN(7)) {
        pg8::Gemm g{(const pg8::bf16_t*)(ws + WS_H), (const pg8::bf16_t*)(ws + WS_WQ), M, 2048, D}; pg8::StaticOrder S; S.init(M, 2048, gridDim.x, (int)blockIdx.x);
        pg8::EpiPlain E{(pg8::bf16_t*)(ws + WS_PROJ), 2048};
        pg8::gemm_phase<pg8::EpiPlain, pg8::StaticOrder, true, true>(lds, g, S, E);
    } SEAM(7);
    if (IN(8)) { phase_topk(A, lds); } SEAM(8);
    if (IN(9)) { phase_peer_u(A); } SEAM(9);
    if (IN(10)) { phase_peer_act(A); } SEAM(10);
    if (IN(11)) { phase_peer_v(A); } SEAM(11);
    if (IN(12)) { phase_peer_final(A); }
#undef IN
#undef SEAM
#undef A
#undef ws
}

extern "C" void kernel_launch(void* const* d_in, const int* in_sizes, int n_in, void* d_out, int out_size, void* d_ws, size_t ws_size, hipStream_t stream) {
    static int grid = 0;
    if (grid == 0) {
        if (n_in != 21 || in_sizes[0] != M * D || out_size != M * D || ws_size < WS_END) { fprintf(stderr, "kernel_launch: unexpected shapes (n_in %d, in0 %d, out %d, ws %zu < %zu)\n", n_in, n_in > 0 ? in_sizes[0] : -1, out_size, ws_size, (size_t)WS_END); grid = -1; return; }
        int dev = 0, cus = 0, per_cu = 0;
        if (hipGetDevice(&dev) != hipSuccess || hipDeviceGetAttribute(&cus, hipDeviceAttributeMultiprocessorCount, dev) != hipSuccess) { grid = -1; return; }
        if (hipFuncSetAttribute((const void*)hymba_fwd, hipFuncAttributeMaxDynamicSharedMemorySize, LDS_BYTES) != hipSuccess) { fprintf(stderr, "kernel_launch: hipFuncSetAttribute failed\n"); grid = -1; return; }
        if (hipOccupancyMaxActiveBlocksPerMultiprocessor(&per_cu, (const void*)hymba_fwd, NTHR, LDS_BYTES) != hipSuccess || per_cu < 1) { fprintf(stderr, "kernel_launch: occupancy query says %d blocks per CU\n", per_cu); per_cu = 1; }
        (void)hipGetLastError();
        grid = cus;
        if (grid != 256) fprintf(stderr, "kernel_launch: note: %d CUs (built for 256)\n", grid);
    }
    if (grid < 0) return;
    (void)hipMemsetAsync((char*)d_ws + WS_CTL, 0, CTL_ZERO_BYTES, stream);
    Args a{};
    for (int i = 0; i < 21; ++i) a.in[i] = d_in[i];
    a.out = (float*)d_out; a.ws = (unsigned char*)d_ws;
    if (MK_N_LAUNCHES == 1) {
        a.ph_lo = 0; a.ph_hi = N_PHASES;
        void* args[] = {&a};
        const hipError_t e = hipLaunchCooperativeKernel((const void*)hymba_fwd, dim3(grid), dim3(NTHR), args, LDS_BYTES, stream);
        if (e != hipSuccess) fprintf(stderr, "kernel_launch: cooperative launch failed: %s (grid %d)\n", hipGetErrorString(e), grid);
    } else {
        for (int p = 0; p < N_PHASES; ++p) { a.ph_lo = p; a.ph_hi = p + 1; hipLaunchKernelGGL(hymba_fwd, dim3(grid), dim3(NTHR), LDS_BYTES, stream, a); }
    }
}
```

```cpp
#include <hip/hip_runtime.h>
#include <hip/hip_cooperative_groups.h>
#include <cstdio>
#include <cstdint>
namespace cg = cooperative_groups;
namespace pg8 {
#define PG8_LAS __attribute__((address_space(3)))
typedef unsigned short bf16_t;
typedef short bf16x8 __attribute__((ext_vector_type(8)));
typedef float f32x4 __attribute__((ext_vector_type(4)));
typedef unsigned u32x4 __attribute__((ext_vector_type(4)));
constexpr int BM = 256, BK = 64, HALF = 128, HTB = HALF * BK * 2  , STAGE_BYTES = 8 * HTB, NXCD = 8, WGM = 8;

__host__ __device__ __forceinline__ int lds_byte(int r, int c) { const int st = (r >> 4) * 2 + (c >> 5), rr = r & 15, cc = c & 31, ob = rr * 64 + cc * 2; return st * 1024 + (ob ^ (((ob >> 9) & 1) << 5)); }
__host__ __device__ __forceinline__ void stage_rc(int b, int& R, int& C) { const int st = b / 1024, sb = b % 1024, swz = sb ^ (((sb >> 9) & 1) << 5); R = (st >> 1) * 16 + swz / 64; C = (st & 1) * 32 + (swz % 64) / 2; }
__host__ __device__ __forceinline__ int perm32(int rho) { const int n = rho >> 4, i = rho & 15; return 8 * (i >> 2) + 4 * n + (i & 3); }

struct Unit { int pm, pn; };
struct Gemm { const bf16_t* A; const bf16_t* Bt; int M, N, K; };

struct StaticOrder {
    int nM, nN, nwg, G, c;
    __host__ __device__ void init(int M, int N, int G_, int c_) { nM = M / BM; nN = N / BM; nwg = nM * nN; G = G_; c = c_; }
    __host__ __device__ bool next(int i, Unit& u) const {
        const long L = (long)i * G + c; if (L >= nwg) return false;
        int wgid = (int)L; { const int q = nwg / NXCD, r = nwg % NXCD, xcd = wgid % NXCD, off = wgid / NXCD; wgid = (xcd < r ? xcd * (q + 1) : r * (q + 1) + (xcd - r) * q) + off; }
        const int nig = WGM * nN, gid = wgid / nig, fm = gid * WGM, gsz = (nM - fm) < WGM ? (nM - fm) : WGM;
        u.pm = fm + ((wgid % nig) % gsz); u.pn = (wgid % nig) / gsz; return true;
    }
    __device__ __forceinline__ void a_ready(const Unit&) const {}
    __device__ __forceinline__ void done(const Unit&) const {}
};

__device__ __forceinline__ unsigned cvt_pk_bf16(float lo, float hi) { unsigned r; asm volatile("v_cvt_pk_bf16_f32 %0, %1, %2" : "=v"(r) : "v"(lo), "v"(hi)); return r; }
typedef float f32x2 __attribute__((ext_vector_type(2)));
__device__ __forceinline__ f32x2 gelu_pk(f32x2 v) {
    const f32x2 av = __builtin_elementwise_abs(v), d = av * 0.2316418882f + 1.0f;
    f32x2 t; t.x = __builtin_amdgcn_rcpf(d.x); t.y = __builtin_amdgcn_rcpf(d.y);
    f32x2 q = t * 0.5307027145f + (-0.7265760135f); q = q * t + 0.7107068705f; q = q * t + (-0.142248368f); q = q * t + 0.127414796f; q = q * t;
    const f32x2 s = (v * v) * (-0.72134752044f);
    f32x2 e; e.x = __builtin_amdgcn_exp2f(s.x); e.y = __builtin_amdgcn_exp2f(s.y);
    const f32x2 m = v * (q * e), r = v - m;
    f32x2 o; o.x = v.x < 0.f ? m.x : r.x; o.y = v.y < 0.f ? m.y : r.y; return o;
}

__device__ __forceinline__ u32x4 pack8(const f32x4 v0, const f32x4 v1) { u32x4 w; w.x = cvt_pk_bf16(v0[0], v0[1]); w.y = cvt_pk_bf16(v0[2], v0[3]); w.z = cvt_pk_bf16(v1[0], v1[1]); w.w = cvt_pk_bf16(v1[2], v1[3]); return w; }

struct EpiPlain {
    static constexpr bool PERM = true, AFTER_DRAIN = false;
    bf16_t* O; int ldc;
    __device__ __forceinline__ void operator()(const f32x4 (&acc)[2][2][4][2], const Unit& u, int wr, int wc, int fr, int fq) const {
        const int row0 = u.pm * BM + wr * 64 + fr, col0 = u.pn * BM + wc * 32 + 8 * fq;
#pragma unroll
        for (int ai = 0; ai < 2; ++ai)
#pragma unroll
            for (int m = 0; m < 4; ++m) { bf16_t* rowp = O + (size_t)(row0 + ai * HALF + m * 16) * ldc + col0;
#pragma unroll
                for (int bj = 0; bj < 2; ++bj) *(u32x4*)(rowp + bj * HALF) = pack8(acc[ai][bj][m][0], acc[ai][bj][m][1]); }
    }
};

struct EpiProj {
    static constexpr bool PERM = true, AFTER_DRAIN = false;
    bf16_t* P; int ldc; float* gates; const int* pos; const float* b_i; const float* b_f;
    __device__ __forceinline__ void operator()(const f32x4 (&acc)[2][2][4][2], const Unit& u, int wr, int wc, int fr, int fq) const {
        const int row0 = u.pm * BM + wr * 64 + fr, col0 = u.pn * BM + wc * 32 + 8 * fq, pn = u.pn;
        if (pn == 9) {
            if (wc == 0 && fq == 0) {
                const f32x4 bi = {b_i[0], b_i[1], b_i[2], b_i[3]}, bf = {b_f[0], b_f[1], b_f[2], b_f[3]};
#pragma unroll
                for (int ai = 0; ai < 2; ++ai)
#pragma unroll
                    for (int m = 0; m < 4; ++m) { const int row = row0 + ai * HALF + m * 16;
                        const f32x4 iv = acc[ai][0][m][0] + bi, fv = acc[ai][0][m][1] + bf; f32x4 lf;
#pragma unroll
                        for (int j = 0; j < 4; ++j) lf[j] = fminf(fv[j], 0.f) - log1pf(__expf(-fabsf(fv[j])));
                        *(f32x4*)(gates + (size_t)row * 8) = iv; *(f32x4*)(gates + (size_t)row * 8 + 4) = lf; }
            }
            return;
        }
#pragma unroll
        for (int ai = 0; ai < 2; ++ai)
#pragma unroll
            for (int m = 0; m < 4; ++m) { const int row = row0 + ai * HALF + m * 16; bf16_t* rowp = P + (size_t)row * ldc + col0;
                const float posf = (pn <= 2) ? (float)pos[row] : 0.f;
#pragma unroll
                for (int bj = 0; bj < 2; ++bj) { f32x4 v0 = acc[ai][bj][m][0], v1 = acc[ai][bj][m][1];
                    const bool rope = (pn < 2) || (pn == 2 && bj == 0);
                    if (rope) {
                        const int p0 = ((col0 + bj * HALF) & 63) >> 1; const float sc = (pn < 2) ? 0.125f : 1.0f;
                        float x[8] = {v0[0], v0[1], v0[2], v0[3], v1[0], v1[1], v1[2], v1[3]};
#pragma unroll
                        for (int q = 0; q < 4; ++q) { const float invf = __builtin_amdgcn_exp2f(-(float)(p0 + q) * 0.41524101186092029f);
                            float r = posf * invf * 0.15915494309189535f; r = r - floorf(r);
                            const float c = __builtin_amdgcn_cosf(r) * sc, s = __builtin_amdgcn_sinf(r) * sc;
                            const float x1 = x[2 * q], x2 = x[2 * q + 1]; x[2 * q] = x1 * c - x2 * s; x[2 * q + 1] = x2 * c + x1 * s; }
                        v0 = (f32x4){x[0], x[1], x[2], x[3]}; v1 = (f32x4){x[4], x[5], x[6], x[7]};
                    } else if (pn >= 7) {
#pragma unroll
                        for (int j = 0; j < 4; ++j) { v0[j] = __builtin_amdgcn_rcpf(1.f + __expf(-v0[j])); v1[j] = __builtin_amdgcn_rcpf(1.f + __expf(-v1[j])); }
                    }
                    *(u32x4*)(rowp + bj * HALF) = pack8(v0, v1); } }
    }
};

struct EpiMix {
    static constexpr bool PERM = true, AFTER_DRAIN = false;
    bf16_t* O; int ldc; float* sumsq;
    __device__ __forceinline__ void operator()(const f32x4 (&acc)[2][2][4][2], const Unit& u, int wr, int wc, int fr, int fq) const {
        const int row0 = u.pm * BM + wr * 64 + fr, col0 = u.pn * BM + wc * 32 + 8 * fq;
#pragma unroll
        for (int ai = 0; ai < 2; ++ai)
#pragma unroll
            for (int m = 0; m < 4; ++m) { const int row = row0 + ai * HALF + m * 16; bf16_t* rowp = O + (size_t)row * ldc + col0; float s = 0.f;
#pragma unroll
                for (int bj = 0; bj < 2; ++bj) { const f32x4 v0 = acc[ai][bj][m][0], v1 = acc[ai][bj][m][1];
                    s += (v0[0] * v0[0] + v0[1] * v0[1]) + (v0[2] * v0[2] + v0[3] * v0[3]) + (v1[0] * v1[0] + v1[1] * v1[1]) + (v1[2] * v1[2] + v1[3] * v1[3]);
                    *(u32x4*)(rowp + bj * HALF) = pack8(v0, v1); }
                s += __shfl_xor(s, 16); s += __shfl_xor(s, 32);
                if (fq == 0) sumsq[(size_t)row * 16 + u.pn * 4 + wc] = s; }
    }
};
template <class Epi, class Sched, bool ALIGN_EPI = false, bool SP2 = false>
__device__ __forceinline__ void gemm_phase(PG8_LAS unsigned char* lds, const Gemm g, const Sched& S, const Epi& E) {
    const int tid = threadIdx.x, wid = __builtin_amdgcn_readfirstlane(tid >> 6), lane = tid & 63, wr = wid >> 2, wc = wid & 3, fr = lane & 15, fq = lane >> 4;
    const int K = g.K, nt = K / BK;
    unsigned voffA[2], voffB[2];
#pragma unroll
    for (int i = 0; i < 2; ++i) { int R, C; stage_rc(tid * 16 + i * 8192, R, C); const int Rb = Epi::PERM ? ((R & ~31) + perm32(R & 31)) : R;
        voffA[i] = (unsigned)(R * K + C) * 2u; voffB[i] = (unsigned)(Rb * K + C) * 2u; }
    const size_t kstep = (size_t)(BK * 2);
    const size_t hstep = (size_t)HALF * K * 2;
    const size_t tstep = 2 * hstep;
    const unsigned ldsw = (unsigned)wid * 1024u;
    const int aoff = lds_byte(wr * 64 + fr, fq * 8), boff = lds_byte(wc * 32 + fr, fq * 8);
#define PG8_SA(b, h) (((b) * 2 + (h)) * HTB)
#define PG8_SB(b, h) ((4 + (b) * 2 + (h)) * HTB)
#define PG8_STAGE(bufoff, gbase, voff) do { _Pragma("unroll") for (int _i = 0; _i < 2; ++_i) \
        __builtin_amdgcn_global_load_lds((const unsigned*)((const char*)(gbase) + (voff)[_i]), (PG8_LAS unsigned*)(lds + (bufoff) + ldsw + _i * 8192), 16, 0, 0); } while (0)
#define PG8_LDA(dst, b, h) do { _Pragma("unroll") for (int m = 0; m < 4; ++m) _Pragma("unroll") for (int k = 0; k < 2; ++k) dst[m][k] = *(const PG8_LAS bf16x8*)(lds + PG8_SA(b, h) + aoff + m * 2048 + k * 1024); } while (0)
#define PG8_LDB(dst, b, h) do { _Pragma("unroll") for (int n = 0; n < 2; ++n) _Pragma("unroll") for (int k = 0; k < 2; ++k) dst[n][k] = *(const PG8_LAS bf16x8*)(lds + PG8_SB(b, h) + boff + n * 2048 + k * 1024); } while (0)
#define PG8_MMA(ai, bj, At, Bt) do { __builtin_amdgcn_s_setprio(1); _Pragma("unroll") for (int m = 0; m < 4; ++m) _Pragma("unroll") for (int n = 0; n < 2; ++n) _Pragma("unroll") for (int k = 0; k < 2; ++k) \
        acc[ai][bj][m][n] = __builtin_amdgcn_mfma_f32_16x16x32_bf16(Bt[n][k], At[m][k], acc[ai][bj][m][n], 0, 0, 0); __builtin_amdgcn_s_setprio(0); } while (0)
#define PG8_WAIT_V(n) asm volatile("s_waitcnt vmcnt(" #n ")" ::: "memory")
#define PG8_WAIT_L(n) asm volatile("s_waitcnt lgkmcnt(" #n ")" ::: "memory")
#define PG8_BAR __builtin_amdgcn_s_barrier()
#define PG8_SCHED __builtin_amdgcn_sched_barrier(0)
    Unit cur, nxt; int ui = 0;
    if (!S.next(0, cur)) return;
    f32x4 acc[2][2][4][2];
#pragma unroll
    for (int a = 0; a < 2; ++a)
#pragma unroll
        for (int b = 0; b < 2; ++b)
#pragma unroll
            for (int m = 0; m < 4; ++m)
#pragma unroll
                for (int n = 0; n < 2; ++n) acc[a][b][m][n] = (f32x4){0.f, 0.f, 0.f, 0.f};
    bf16x8 At[4][2], B0[2][2], B1[2][2];
    const char* cA = (const char*)g.A + (size_t)cur.pm * tstep; const char* cB = (const char*)g.Bt + (size_t)cur.pn * tstep;
    S.a_ready(cur);
    if constexpr (SP2) {
        PG8_STAGE(PG8_SB(0, 0), cB, voffB); PG8_STAGE(PG8_SB(0, 1), cB + hstep, voffB); PG8_STAGE(PG8_SA(0, 0), cA, voffA); PG8_STAGE(PG8_SA(0, 1), cA + hstep, voffA);
        if (wr == 1) PG8_BAR;
        PG8_WAIT_V(2); PG8_BAR;
        PG8_STAGE(PG8_SB(1, 0), cB + kstep, voffB); PG8_STAGE(PG8_SA(1, 0), cA + kstep, voffA); PG8_STAGE(PG8_SB(1, 1), cB + hstep + kstep, voffB);
        PG8_WAIT_V(6); PG8_BAR;
    } else {
        PG8_STAGE(PG8_SB(0, 0), cB, voffB); PG8_STAGE(PG8_SA(0, 0), cA, voffA); PG8_STAGE(PG8_SB(0, 1), cB + hstep, voffB); PG8_STAGE(PG8_SA(0, 1), cA + hstep, voffA);
        if (wr == 1) PG8_BAR;
        PG8_WAIT_V(4); PG8_BAR;
        PG8_STAGE(PG8_SB(1, 0), cB + kstep, voffB); PG8_STAGE(PG8_SA(1, 0), cA + kstep, voffA); PG8_STAGE(PG8_SB(1, 1), cB + hstep + kstep, voffB);
        PG8_WAIT_V(6); PG8_BAR;
    }
    for (;;) {
        const bool has_next = S.next(ui + 1, nxt);
        const char* nA = has_next ? (const char*)g.A + (size_t)nxt.pm * tstep : cA; const char* nB = has_next ? (const char*)g.Bt + (size_t)nxt.pn * tstep : cB;
        for (int t = 0; t < nt; t += 2) {
            const bool last = (t == nt - 2);
            const char* a1 = cA + (size_t)(t + 1) * kstep;
            const char* a2 = last ? nA : cA + (size_t)(t + 2) * kstep; const char* b2 = last ? nB : cB + (size_t)(t + 2) * kstep;
            const char* a3 = a2 + kstep; const char* b3 = b2 + kstep;
            if (last && has_next) S.a_ready(nxt);
            if constexpr (SP2) {
            PG8_LDB(B0, 0, 0); PG8_LDB(B1, 0, 1); PG8_SCHED; PG8_LDA(At, 0, 0); PG8_STAGE(PG8_SA(1, 1), a1 + hstep, voffA);
            PG8_WAIT_V(8); PG8_WAIT_L(0); PG8_BAR; PG8_MMA(0, 0, At, B0); PG8_MMA(0, 1, At, B1); PG8_BAR; PG8_SCHED;
            PG8_LDA(At, 0, 1); PG8_STAGE(PG8_SB(0, 0), b2, voffB); PG8_STAGE(PG8_SB(0, 1), b2 + hstep, voffB); PG8_STAGE(PG8_SA(0, 0), a2, voffA);
            PG8_WAIT_V(8); PG8_WAIT_L(0); PG8_BAR; PG8_MMA(1, 0, At, B0); PG8_MMA(1, 1, At, B1); PG8_BAR; PG8_SCHED;
            PG8_LDB(B0, 1, 0); PG8_LDB(B1, 1, 1); PG8_SCHED; PG8_LDA(At, 1, 0); PG8_STAGE(PG8_SA(0, 1), a2 + hstep, voffA);
            PG8_WAIT_V(8); PG8_WAIT_L(0); PG8_BAR; PG8_MMA(0, 0, At, B0); PG8_MMA(0, 1, At, B1); PG8_BAR; PG8_SCHED;
            PG8_LDA(At, 1, 1); PG8_STAGE(PG8_SB(1, 0), b3, voffB); PG8_STAGE(PG8_SB(1, 1), b3 + hstep, voffB); PG8_STAGE(PG8_SA(1, 0), a3, voffA);
            PG8_WAIT_V(8); PG8_WAIT_L(0); PG8_BAR; PG8_MMA(1, 0, At, B0); PG8_MMA(1, 1, At, B1); PG8_BAR; PG8_SCHED;
            } else {
            PG8_LDB(B0, 0, 0); PG8_SCHED; PG8_LDA(At, 0, 0); PG8_STAGE(PG8_SA(1, 1), a1 + hstep, voffA);
            PG8_WAIT_L(8); PG8_BAR; PG8_WAIT_L(0); PG8_MMA(0, 0, At, B0); PG8_BAR; PG8_SCHED;
            PG8_LDB(B1, 0, 1); PG8_STAGE(PG8_SB(0, 0), b2, voffB);
            PG8_BAR; PG8_WAIT_L(0); PG8_MMA(0, 1, At, B1); PG8_BAR;
            PG8_LDA(At, 0, 1); PG8_STAGE(PG8_SA(0, 0), a2, voffA);
            PG8_BAR; PG8_WAIT_L(0); PG8_MMA(1, 0, At, B0); PG8_BAR; PG8_SCHED;
            PG8_STAGE(PG8_SB(0, 1), b2 + hstep, voffB);
            PG8_WAIT_V(6); PG8_BAR; PG8_MMA(1, 1, At, B1); PG8_BAR;
            PG8_LDB(B0, 1, 0); PG8_SCHED; PG8_LDA(At, 1, 0); PG8_STAGE(PG8_SA(0, 1), a2 + hstep, voffA);
            PG8_WAIT_L(8); PG8_BAR; PG8_WAIT_L(0); PG8_MMA(0, 0, At, B0); PG8_BAR; PG8_SCHED;
            PG8_LDB(B1, 1, 1); PG8_STAGE(PG8_SB(1, 0), b3, voffB);
            PG8_BAR; PG8_WAIT_L(0); PG8_MMA(0, 1, At, B1); PG8_BAR;
            PG8_LDA(At, 1, 1); PG8_STAGE(PG8_SA(1, 0), a3, voffA);
            PG8_BAR; PG8_WAIT_L(0); PG8_MMA(1, 0, At, B0); PG8_BAR; PG8_SCHED;
            PG8_STAGE(PG8_SB(1, 1), b3 + hstep, voffB);
            PG8_WAIT_V(6); PG8_BAR; PG8_MMA(1, 1, At, B1); PG8_BAR;
            }
        }
        if constexpr (ALIGN_EPI) { if (wr == 0) PG8_BAR; }
        if constexpr (!Epi::AFTER_DRAIN) { E(acc, cur, wr, wc, fr, fq); S.done(cur); }
        if (!has_next) break;
#pragma unroll
        for (int a = 0; a < 2; ++a)
#pragma unroll
            for (int b = 0; b < 2; ++b)
#pragma unroll
                for (int m = 0; m < 4; ++m)
#pragma unroll
                    for (int n = 0; n < 2; ++n) acc[a][b][m][n] = (f32x4){0.f, 0.f, 0.f, 0.f};
        cur = nxt; cA = nA; cB = nB; ++ui;
        if constexpr (ALIGN_EPI) { if (wr == 1) PG8_BAR; }
    }
    PG8_WAIT_V(0);
    if constexpr (!ALIGN_EPI) { if (wr == 0) PG8_BAR; }
    PG8_BAR;
    if constexpr (Epi::AFTER_DRAIN) { E.fused(acc, cur, wr, wc, fr, fq, lds, wid, lane); S.done(cur); }
#undef PG8_SA
#undef PG8_SB
#undef PG8_STAGE
#undef PG8_LDA
#undef PG8_LDB
#undef PG8_MMA
#undef PG8_WAIT_V
#undef PG8_WAIT_L
#undef PG8_BAR
#undef PG8_SCHED
}
}
constexpr int NB = 8, SEQ = 8192, D = 1024, M = NB * SEQ;
constexpr int DIN = 2312, NPROJ = 2304, NIN_PAD = 2560;
constexpr int C_AQ = 0, C_AK = 512, C_AV = 640, C_MQ = 768, C_MK = 1024, C_MV = 1280, C_MO = 1792;
constexpr int NEXP = 16384, NSLOT = 128;
constexpr float EPS = 1e-6f;
constexpr int NWAVES = 8, NTHR = 512;

constexpr size_t MiB = 1u << 20;
constexpr size_t WS_CTL = 0, CTL_ZERO_BYTES = 1 * MiB;
constexpr size_t WS_MOD = 1 * MiB;
constexpr size_t WS_WIN = 2 * MiB;
constexpr size_t WS_WOUT = 8 * MiB;
constexpr size_t WS_WQ = 10 * MiB;
constexpr size_t WS_KEYS = 14 * MiB;
constexpr size_t WS_GATES = 16 * MiB;
constexpr size_t WS_SSQ = 832 * MiB;
constexpr size_t WS_MST = 20 * MiB;
constexpr size_t WS_U8 = 32 * MiB, WS_V8 = 48 * MiB;
constexpr size_t WS_SC = 64 * MiB;
constexpr size_t WS_H = 96 * MiB;
constexpr size_t WS_PROJ = 224 * MiB;
constexpr size_t WS_MIXIN = 512 * MiB;
constexpr size_t WS_MIX = 640 * MiB;
constexpr size_t WS_EIDX = 768 * MiB, WS_GATE = 800 * MiB;
constexpr size_t WS_PD = 512 * MiB;
constexpr size_t WS_ACT = 840 * MiB;
constexpr size_t WS_SSY = 872 * MiB;
constexpr size_t WS_END = 876 * MiB;
constexpr int CW_BAR = 4096;
constexpr int CW_SUMSQ = 65536;
static_assert((CW_SUMSQ + M) * 4 <= (int)CTL_ZERO_BYTES, "ctl");

constexpr int RING_BYTES = 131072, MISC_OFF = RING_BYTES + 320, LDS_BYTES = 147456;

#define GAS __attribute__((address_space(1)))
#define LAS __attribute__((address_space(3)))
typedef unsigned short bf16;
typedef unsigned v4u __attribute__((ext_vector_type(4)));
typedef unsigned v2u __attribute__((ext_vector_type(2)));
typedef float f32x4 __attribute__((ext_vector_type(4)));
typedef GAS unsigned gu32;
#define LDS_WAIT() asm volatile("s_waitcnt lgkmcnt(0)" ::: "memory")
#define VM_WAIT() asm volatile("s_waitcnt vmcnt(0)" ::: "memory")
__device__ __forceinline__ unsigned f2bf(float f) { unsigned u = __builtin_bit_cast(unsigned, f); return (u + 0x7fffu + ((u >> 16) & 1u)) >> 16; }
__device__ __forceinline__ unsigned pk2(float lo, float hi) { return f2bf(lo) | (f2bf(hi) << 16); }
__device__ __forceinline__ float bflo(unsigned w) { return __builtin_bit_cast(float, w << 16); }
__device__ __forceinline__ float bfhi(unsigned w) { return __builtin_bit_cast(float, w & 0xffff0000u); }
__device__ __forceinline__ float bf1(bf16 h) { return __builtin_bit_cast(float, (unsigned)h << 16); }
__device__ __forceinline__ float wave_sum(float v) {
#pragma unroll
    for (int o = 1; o < 64; o <<= 1) v += __shfl_xor(v, o);
    return v;
}
__device__ __forceinline__ float wave_max(float v) {
#pragma unroll
    for (int o = 1; o < 64; o <<= 1) v = fmaxf(v, __shfl_xor(v, o));
    return v;
}

typedef float f32x2 __attribute__((ext_vector_type(2)));
__device__ __forceinline__ void cvt16_fp8(const v4u w, float (&o)[16]) {
    const unsigned ww[4] = {w.x, w.y, w.z, w.w};
#pragma unroll
    for (int i = 0; i < 4; ++i) { const f32x2 a = __builtin_amdgcn_cvt_pk_f32_fp8((int)ww[i], false), b = __builtin_amdgcn_cvt_pk_f32_fp8((int)ww[i], true);
        o[4 * i] = a.x; o[4 * i + 1] = a.y; o[4 * i + 2] = b.x; o[4 * i + 3] = b.y; }
}
__device__ __forceinline__ void p0_row_fp8(const float* src, unsigned char* dst, float* sc, int row, int lane) {
    const GAS f32x4* sp = (const GAS f32x4*)(src + (size_t)row * D + 16 * lane);
    const f32x4 a = sp[0], b = sp[1], c = sp[2], d = sp[3];
    float mx = 0.f;
#pragma unroll
    for (int i = 0; i < 4; ++i) mx = fmaxf(fmaxf(fmaxf(mx, fabsf(a[i])), fmaxf(fabsf(b[i]), fabsf(c[i]))), fabsf(d[i]));
    mx = wave_max(mx); const float s = mx > 0.f ? 224.0f / mx : 1.0f;
    v4u o; int w;
    w = __builtin_amdgcn_cvt_pk_fp8_f32(a[0] * s, a[1] * s, 0, false); w = __builtin_amdgcn_cvt_pk_fp8_f32(a[2] * s, a[3] * s, w, true); o.x = (unsigned)w;
    w = __builtin_amdgcn_cvt_pk_fp8_f32(b[0] * s, b[1] * s, 0, false); w = __builtin_amdgcn_cvt_pk_fp8_f32(b[2] * s, b[3] * s, w, true); o.y = (unsigned)w;
    w = __builtin_amdgcn_cvt_pk_fp8_f32(c[0] * s, c[1] * s, 0, false); w = __builtin_amdgcn_cvt_pk_fp8_f32(c[2] * s, c[3] * s, w, true); o.z = (unsigned)w;
    w = __builtin_amdgcn_cvt_pk_fp8_f32(d[0] * s, d[1] * s, 0, false); w = __builtin_amdgcn_cvt_pk_fp8_f32(d[2] * s, d[3] * s, w, true); o.w = (unsigned)w;
    *(GAS v4u*)(dst + (size_t)row * D + 16 * lane) = o;
    if (lane == 0) sc[row] = mx > 0.f ? mx * (1.0f / 224.0f) : 1.0f;
}
#define XB_TMO      128
#define XB_XCNT(j)  (256  + 64 * (j))
#define XB_XSUB(j)  (1280 + 64 * (j))
#define XB_XGEN(j)  (2304 + 64 * (j))
#define XB_TOP      3328
#define XB_TOPGEN   3392
#define XCD_BAR_WORDS 3456
#define XB_SPIN_CAP (1u << 18)

__device__ __forceinline__ unsigned xb_ld(unsigned* p)              { return __hip_atomic_load(p, __ATOMIC_RELAXED, __HIP_MEMORY_SCOPE_AGENT); }
__device__ __forceinline__ unsigned xb_add(unsigned* p, unsigned v) { return __hip_atomic_fetch_add(p, v, __ATOMIC_RELAXED, __HIP_MEMORY_SCOPE_AGENT); }
__device__ __forceinline__ unsigned xb_xcc_id() { return (unsigned)__builtin_amdgcn_s_getreg((3 << 11) | 20) & 0xFu; }
#define XB_SPIN(cond, bar) do { unsigned _sp = 0; while (cond) { __builtin_amdgcn_s_sleep(1); \
    if ((++_sp & 255u) == 0u) { if (xb_ld(&(bar)[XB_TMO])) break; if (_sp > XB_SPIN_CAP) { atomicAdd(&(bar)[XB_TMO], 1u); break; } } } } while (0)

struct XcdBarrier {
    unsigned* bar; unsigned x;
    volatile LAS unsigned* st;
};

__device__ __forceinline__ XcdBarrier xcd_barrier_post(unsigned* bar, volatile LAS unsigned* st) {
    XcdBarrier b; b.bar = bar; b.x = xb_xcc_id(); b.st = st;
    if (threadIdx.x == 0) (void)xb_add(&bar[XB_XCNT(b.x)], 1u);
    return b;
}
__device__ __forceinline__ void xcd_barrier_complete(unsigned* bar, unsigned x, unsigned& nloc, unsigned& nx) {
    const unsigned G = gridDim.x * gridDim.y * gridDim.z;
    unsigned sum, cnt, mine, sp = 0u;
    for (;;) {
        sum = 0u; cnt = 0u; mine = 0u;
#pragma unroll
        for (unsigned j = 0; j < 16; ++j) { const unsigned c = xb_ld(&bar[XB_XCNT(j)]); sum += c; cnt += (c > 0u) ? 1u : 0u; mine = (j == x) ? c : mine; }
        if (sum == G) break;
        __builtin_amdgcn_s_sleep(1);
        if ((++sp & 255u) == 0u) { if (xb_ld(&bar[XB_TMO])) break; if (sp > XB_SPIN_CAP) { atomicAdd(&bar[XB_TMO], 1u); break; } }
    }
    nloc = mine > 0u ? mine : 1u; nx = cnt > 0u ? cnt : 1u;
}

__device__ __forceinline__ void xcd_barrier(const XcdBarrier& b) {
    asm volatile("s_waitcnt vmcnt(0)" ::: "memory");
    __syncthreads();
    if (threadIdx.x == 0) {
        unsigned* bar = b.bar;
        __builtin_amdgcn_s_waitcnt(0);
        unsigned nloc = b.st[0], nx = b.st[1];
        if (nloc == 0u) { xcd_barrier_complete(bar, b.x, nloc, nx); b.st[0] = nloc; b.st[1] = nx; }
        const unsigned old = xb_add(&bar[XB_XSUB(b.x)], 1u);
        const unsigned gen = old / nloc;
        if (old + 1u == (gen + 1u) * nloc) {
            __builtin_amdgcn_fence(__ATOMIC_RELEASE, "agent");
            asm volatile("s_waitcnt vmcnt(0)" ::: "memory");
            const unsigned og = xb_add(&bar[XB_TOP], 1u);
            const unsigned tg = og / nx;
            if (og + 1u == (tg + 1u) * nx) xb_add(&bar[XB_TOPGEN], 1u);
            else XB_SPIN(xb_ld(&bar[XB_TOPGEN]) == tg, bar);
            __builtin_amdgcn_fence(__ATOMIC_ACQUIRE, "agent");
            xb_add(&bar[XB_XGEN(b.x)], 1u);
            asm volatile("s_waitcnt vmcnt(0)" ::: "memory");
        } else {
            XB_SPIN(xb_ld(&bar[XB_XGEN(b.x)]) == gen, bar);
            __builtin_amdgcn_fence(__ATOMIC_ACQUIRE, "agent");
            asm volatile("s_waitcnt vmcnt(0)" ::: "memory");
        }
    }
    __syncthreads();
}
struct Args { const void* in[21]; float* out; unsigned char* ws; int ph_lo, ph_hi; };
enum { I_X = 0, I_C, I_POS, I_WMOD, I_BMOD, I_GPRE1, I_GPOST1, I_WIN, I_CONVW, I_BI, I_BF, I_MNG, I_SINK, I_WOUT, I_GPRE2, I_GPOST2, I_WQ, I_K1, I_K2, I_U, I_V };

__device__ __forceinline__ int newcol(int o) {
    if (o < 640) { const int hd = o >> 6, d = o & 63; return (hd << 6) + 2 * (d & 31) + (d >> 5); }
    if (o < 1792) return o;
    if (o < 1800) return 2304 + (o - 1792);
    return o - 8;
}
template <bool REMAP>
__device__ __forceinline__ void p0_transpose_item(const float* W, int K, int N, bf16* WT, LAS float* scr, int item, int lane) {
    const int nblk = (N + 31) / 32, kb = item / nblk, nb = item % nblk, k0 = 64 * kb, n0 = 32 * nb;
    const int ncol = n0 + (lane & 31);
#pragma unroll 8
    for (int i = 0; i < 32; ++i) { const int kk = 2 * i + (lane >> 5); scr[kk * 33 + (lane & 31)] = (ncol < N) ? W[(size_t)(k0 + kk) * N + ncol] : 0.f; }
    LDS_WAIT(); asm volatile("" ::: "memory");
    const int c = lane & 7;
#pragma unroll
    for (int j = 0; j < 4; ++j) { const int n = (lane >> 3) + 8 * j; const LAS float* s = scr + (8 * c) * 33 + n;
        v4u o; o.x = pk2(s[0 * 33], s[1 * 33]); o.y = pk2(s[2 * 33], s[3 * 33]); o.z = pk2(s[4 * 33], s[5 * 33]); o.w = pk2(s[6 * 33], s[7 * 33]);
        if (n0 + n < N) { const int drow = REMAP ? newcol(n0 + n) : (n0 + n); *(GAS v4u*)(WT + (size_t)drow * K + k0 + 8 * c) = o; } }
    LDS_WAIT(); asm volatile("" ::: "memory");
}
__device__ __forceinline__ void p0_convert(const float* src, bf16* dst, size_t n, int gt, int ngt) {
    for (size_t i = (size_t)gt * 8; i < n; i += (size_t)ngt * 8) {
        const f32x4 a = *(const GAS f32x4*)(src + i), b = *(const GAS f32x4*)(src + i + 4);
        v4u o; o.x = pk2(a[0], a[1]); o.y = pk2(a[2], a[3]); o.z = pk2(b[0], b[1]); o.w = pk2(b[2], b[3]);
        *(GAS v4u*)(dst + i) = o; }
}
__device__ __forceinline__ void phase_prologue(const Args& A, LAS unsigned char* lds) {
    const int tid = threadIdx.x, lane = tid & 63, wave = tid >> 6, G = gridDim.x, blk = blockIdx.x;
    unsigned char* ws = A.ws;
    {
        const float* c = (const float*)A.in[I_C]; const float* wm = (const float*)A.in[I_WMOD]; const float* bm = (const float*)A.in[I_BMOD];
        float* mod = (float*)(ws + WS_MOD); LAS float* red = (LAS float*)lds;
        for (int it = blk; it < 6144 / 32; it += G) {
            const int kg = tid >> 5, col = tid & 31, j = it * 32 + col; float acc[8];
#pragma unroll
            for (int b = 0; b < 8; ++b) acc[b] = 0.f;
            for (int i = 0; i < 64; ++i) { const int k = kg + 16 * i; const float w = wm[(size_t)k * 6144 + j];
#pragma unroll
                for (int b = 0; b < 8; ++b) acc[b] += c[b * 1024 + k] * w; }
#pragma unroll
            for (int b = 0; b < 8; ++b) red[(kg * 32 + col) * 8 + b] = acc[b];
            __syncthreads();
            if (tid < 256) { const int b = tid >> 5, cc = tid & 31; float s = 0.f;
#pragma unroll
                for (int g = 0; g < 16; ++g) s += red[(g * 32 + cc) * 8 + b];
                mod[b * 6144 + it * 32 + cc] = s + bm[it * 32 + cc]; }
            __syncthreads();
        }
    }
    {
        LAS float* scr = (LAS float*)(lds + wave * 16384);
        const int gw = blk * NWAVES + wave, NGW = G * NWAVES;
        const int I_IN = (D / 64) * ((DIN + 31) / 32), I_OUT = (D / 64) * (D / 32), I_Q = (D / 64) * (2048 / 32);
        bf16* win = (bf16*)(ws + WS_WIN); bf16* wout = (bf16*)(ws + WS_WOUT); bf16* wq = (bf16*)(ws + WS_WQ);
        for (int it = gw; it < I_IN + I_OUT + I_Q; it += NGW) {
            int r = it;
            if (r < I_IN) { p0_transpose_item<true>((const float*)A.in[I_WIN], D, DIN, win, scr, r, lane); continue; } r -= I_IN;
            if (r < I_OUT) { p0_transpose_item<false>((const float*)A.in[I_WOUT], D, D, wout, scr, r, lane); continue; } r -= I_OUT;
            p0_transpose_item<false>((const float*)A.in[I_WQ], D, 2048, wq, scr, r, lane);
        }
        const int gt = blk * NTHR + tid, ngt = G * NTHR;
        for (int i = gt; i < (NIN_PAD - DIN) * D / 8; i += ngt) *(GAS v4u*)(win + (size_t)DIN * D + (size_t)i * 8) = (v4u){0u, 0u, 0u, 0u};
        p0_convert((const float*)A.in[I_K1], (bf16*)(ws + WS_KEYS), (size_t)8 * 128 * 128, gt, ngt);
        p0_convert((const float*)A.in[I_K2], (bf16*)(ws + WS_KEYS) + 8 * 128 * 128, (size_t)8 * 128 * 128, gt, ngt);
        for (int r = gw; r < 2 * NEXP; r += NGW) { if (r < NEXP) p0_row_fp8((const float*)A.in[I_U], ws + WS_U8, (float*)(ws + WS_SC), r, lane); else p0_row_fp8((const float*)A.in[I_V], ws + WS_V8, (float*)(ws + WS_SC) + NEXP, r - NEXP, lane); }
    }
}

__device__ __forceinline__ void phase_prenorm(const Args& A) {
    const int tid = threadIdx.x, lane = tid & 63, wave = tid >> 6, G = gridDim.x;
    const float* x = (const float*)A.in[I_X]; const float* g = (const float*)A.in[I_GPRE1]; const float* mod = (const float*)(A.ws + WS_MOD);
    bf16* H = (bf16*)(A.ws + WS_H);
    for (int row = blockIdx.x * NWAVES + wave; row < M; row += G * NWAVES) {
        const int b = row / SEQ; const GAS f32x4* xr = (const GAS f32x4*)(x + (size_t)row * D) + lane;
        f32x4 v[4]; float s = 0.f;
#pragma unroll
        for (int j = 0; j < 4; ++j) { v[j] = xr[64 * j]; s += (v[j][0] * v[j][0] + v[j][1] * v[j][1]) + (v[j][2] * v[j][2] + v[j][3] * v[j][3]); }
        const float rstd = 1.0f / sqrtf(wave_sum(s) * (1.f / D) + EPS);
        GAS v2u* o = (GAS v2u*)(H + (size_t)row * D) + lane;
#pragma unroll
        for (int j = 0; j < 4; ++j) { const int k = 4 * (lane + 64 * j);
            const f32x4 gg = *(const GAS f32x4*)(g + k), sh = *(const GAS f32x4*)(mod + b * 6144 + k), sc = *(const GAS f32x4*)(mod + b * 6144 + 1024 + k);
            f32x4 y;
#pragma unroll
            for (int i = 0; i < 4; ++i) y[i] = v[j][i] * rstd * gg[i] * (1.f + sc[i]) + sh[i];
            v2u w; w.x = pk2(y[0], y[1]); w.y = pk2(y[2], y[3]); o[64 * j] = w; }
    }
}

__device__ __forceinline__ void phase_mid(const Args& A) {
    const int tid = threadIdx.x, lane = tid & 63, wave = tid >> 6, G = gridDim.x;
    const float* x = (const float*)A.in[I_X]; const float* gpost = (const float*)A.in[I_GPOST1]; const float* gpre = (const float*)A.in[I_GPRE2];
    const float* mod = (const float*)(A.ws + WS_MOD); const float* sumsq = (const float*)(A.ws + WS_SSQ);
    const bf16* MIX = (const bf16*)(A.ws + WS_MIX); bf16* H = (bf16*)(A.ws + WS_H); float* out = A.out;
    for (int row = blockIdx.x * NWAVES + wave; row < M; row += G * NWAVES) {
        const int b = row / SEQ; const GAS f32x4* xr = (const GAS f32x4*)(x + (size_t)row * D) + lane; const GAS v2u* mr = (const GAS v2u*)(MIX + (size_t)row * D) + lane;
        const f32x4 q0 = *(const GAS f32x4*)(sumsq + (size_t)row * 16), q1 = *(const GAS f32x4*)(sumsq + (size_t)row * 16 + 4), q2 = *(const GAS f32x4*)(sumsq + (size_t)row * 16 + 8), q3 = *(const GAS f32x4*)(sumsq + (size_t)row * 16 + 12);
        const float rm = 1.0f / sqrtf(((((q0[0] + q0[1]) + (q0[2] + q0[3])) + ((q1[0] + q1[1]) + (q1[2] + q1[3]))) + (((q2[0] + q2[1]) + (q2[2] + q2[3])) + ((q3[0] + q3[1]) + (q3[2] + q3[3])))) * (1.f / D) + EPS);
        f32x4 v[4]; float s = 0.f;
#pragma unroll
        for (int j = 0; j < 4; ++j) { const int k = 4 * (lane + 64 * j); const f32x4 xv = xr[64 * j]; const v2u mw = mr[64 * j];
            const f32x4 gp = *(const GAS f32x4*)(gpost + k), g1 = *(const GAS f32x4*)(mod + b * 6144 + 2048 + k);
            const float mx[4] = {bflo(mw.x), bfhi(mw.x), bflo(mw.y), bfhi(mw.y)};
#pragma unroll
            for (int i = 0; i < 4; ++i) { v[j][i] = xv[i] + g1[i] * (mx[i] * rm * gp[i]); s += v[j][i] * v[j][i]; }
            *((GAS f32x4*)(out + (size_t)row * D) + lane + 64 * j) = v[j]; }
        const float rstd = 1.0f / sqrtf(wave_sum(s) * (1.f / D) + EPS);
        GAS v2u* o = (GAS v2u*)(H + (size_t)row * D) + lane;
#pragma unroll
        for (int j = 0; j < 4; ++j) { const int k = 4 * (lane + 64 * j);
            const f32x4 gg = *(const GAS f32x4*)(gpre + k), sh = *(const GAS f32x4*)(mod + b * 6144 + 3072 + k), sc = *(const GAS f32x4*)(mod + b * 6144 + 4096 + k);
            f32x4 y;
#pragma unroll
            for (int i = 0; i < 4; ++i) y[i] = v[j][i] * rstd * gg[i] * (1.f + sc[i]) + sh[i];
            v2u w; w.x = pk2(y[0], y[1]); w.y = pk2(y[2], y[3]); o[64 * j] = w; }
    }
}
__device__ __forceinline__ void load64bf(const bf16* p, float (&o)[64]) {
#pragma unroll
    for (int i = 0; i < 8; ++i) { const v4u w = *(const GAS v4u*)(p + 8 * i);
        o[8 * i + 0] = bflo(w.x); o[8 * i + 1] = bfhi(w.x); o[8 * i + 2] = bflo(w.y); o[8 * i + 3] = bfhi(w.y);
        o[8 * i + 4] = bflo(w.z); o[8 * i + 5] = bfhi(w.z); o[8 * i + 6] = bflo(w.w); o[8 * i + 7] = bfhi(w.w); }
}
__device__ __forceinline__ void phase_attn_naive(const Args& A, int vb, int nvb) {
    const bf16* P = (const bf16*)(A.ws + WS_PROJ); bf16* MI = (bf16*)(A.ws + WS_MIXIN); const float* sinks = (const float*)A.in[I_SINK];
    for (int task = vb * NTHR + (int)threadIdx.x; task < 8 * M; task += nvb * NTHR) {
        const int h = task / M, t = task % M, s = t % SEQ, kvh = h >> 2;
        float q[64], o[64];
        load64bf(P + (size_t)t * NPROJ + C_AQ + h * 64, q);
#pragma unroll
        for (int d = 0; d < 64; ++d) o[d] = 0.f;
        float mx = sinks[h], l = 1.f;
        for (int j = 0; j < 128; ++j) {
            const int sj = s - 127 + j; const bool valid = sj >= 0; const int tk = valid ? (t - 127 + j) : t;
            const bf16* kr = P + (size_t)tk * NPROJ + C_AK + kvh * 64; float sc = 0.f;
#pragma unroll
            for (int i = 0; i < 8; ++i) { const v4u w = *(const GAS v4u*)(kr + 8 * i);
                sc += q[8 * i + 0] * bflo(w.x) + q[8 * i + 1] * bfhi(w.x) + q[8 * i + 2] * bflo(w.y) + q[8 * i + 3] * bfhi(w.y)
                    + q[8 * i + 4] * bflo(w.z) + q[8 * i + 5] * bfhi(w.z) + q[8 * i + 6] * bflo(w.w) + q[8 * i + 7] * bfhi(w.w); }
            if (valid) {
                const float mn = fmaxf(mx, sc), al = __expf(mx - mn), p = __expf(sc - mn); mx = mn; l = l * al + p;
                const bf16* vr = P + (size_t)tk * NPROJ + C_AV + kvh * 64;
#pragma unroll
                for (int i = 0; i < 8; ++i) { const v4u w = *(const GAS v4u*)(vr + 8 * i);
                    o[8 * i + 0] = o[8 * i + 0] * al + p * bflo(w.x); o[8 * i + 1] = o[8 * i + 1] * al + p * bfhi(w.x);
                    o[8 * i + 2] = o[8 * i + 2] * al + p * bflo(w.y); o[8 * i + 3] = o[8 * i + 3] * al + p * bfhi(w.y);
                    o[8 * i + 4] = o[8 * i + 4] * al + p * bflo(w.z); o[8 * i + 5] = o[8 * i + 5] * al + p * bfhi(w.z);
                    o[8 * i + 6] = o[8 * i + 6] * al + p * bflo(w.w); o[8 * i + 7] = o[8 * i + 7] * al + p * bfhi(w.w); }
            }
        }
        const float il = 1.f / l; bf16* orow = MI + (size_t)t * D + h * 64;
#pragma unroll
        for (int i = 0; i < 8; ++i) { v4u w; w.x = pk2(o[8 * i] * il, o[8 * i + 1] * il); w.y = pk2(o[8 * i + 2] * il, o[8 * i + 3] * il);
            w.z = pk2(o[8 * i + 4] * il, o[8 * i + 5] * il); w.w = pk2(o[8 * i + 6] * il, o[8 * i + 7] * il); *(GAS v4u*)(orow + 8 * i) = w; }
    }
}

__device__ __forceinline__ void phase_mlstm_naive(const Args& A, LAS unsigned char* lds, int bh) {
    const int tid = threadIdx.x, lane = tid & 63, wave = tid >> 6, b = bh >> 2, h = bh & 3, dv = tid >> 2, part = tid & 3;
    const bf16* P = (const bf16*)(A.ws + WS_PROJ); bf16* MI = (bf16*)(A.ws + WS_MIXIN); const float* gates = (const float*)(A.ws + WS_GATES);
    const float* cw = (const float*)A.in[I_CONVW]; const float* ng = (const float*)A.in[I_MNG];
    LAS float* qs = (LAS float*)lds; LAS float* ks = qs + 64 * 64; LAS float* vs = ks + 64 * 64; LAS float* ig = vs + 64 * 128; LAS float* lfg = ig + 64; LAS float* hb = lfg + 64;
    float C[16], n[16]; float m = 0.f;
#pragma unroll
    for (int j = 0; j < 16; ++j) { C[j] = 0.f; n[j] = 0.f; }
    for (int ch = 0; ch < SEQ / 64; ++ch) {
        const int s0 = ch * 64; const size_t t0 = (size_t)b * SEQ + s0;
        for (int e = tid; e < 64 * 64; e += NTHR) { const int l = e >> 6, dk = e & 63; float aq = 0.f, ak = 0.f;
#pragma unroll
            for (int j = 0; j < 4; ++j) { const int sj = s0 + l - 3 + j; if (sj >= 0) { const bf16* r = P + ((size_t)b * SEQ + sj) * NPROJ;
                aq += cw[j * 512 + h * 64 + dk] * bf1(r[C_MQ + h * 64 + dk]); ak += cw[j * 512 + 256 + h * 64 + dk] * bf1(r[C_MK + h * 64 + dk]); } }
            qs[e] = 0.125f * aq / (1.f + __expf(-aq)); ks[e] = ak / (1.f + __expf(-ak)); }
        for (int e = tid; e < 64 * 128; e += NTHR) { const int l = e >> 7, d = e & 127; vs[e] = bf1(P[(t0 + l) * NPROJ + C_MV + h * 128 + d]); }
        if (tid < 64) { ig[tid] = gates[(t0 + tid) * 8 + h]; lfg[tid] = gates[(t0 + tid) * 8 + 4 + h]; }
        __syncthreads();
        for (int l = 0; l < 64; ++l) {
            const float lf = lfg[l], ii = ig[l], mn = fmaxf(lf + m, ii), fd = __expf(lf + m - mn), iw = __expf(ii - mn), vv = vs[l * 128 + dv] * iw;
            float num = 0.f, den = 0.f;
#pragma unroll
            for (int j = 0; j < 16; ++j) { const float kk = ks[l * 64 + part * 16 + j], qq = qs[l * 64 + part * 16 + j];
                C[j] = fd * C[j] + vv * kk; n[j] = fd * n[j] + iw * kk; num += C[j] * qq; den += n[j] * qq; }
            num += __shfl_xor(num, 1); num += __shfl_xor(num, 2); den += __shfl_xor(den, 1); den += __shfl_xor(den, 2);
            if (part == 0) hb[l * 128 + dv] = num / fmaxf(fabsf(den), __expf(-mn));
            m = mn;
        }
        __syncthreads();
        for (int l = wave * 8; l < wave * 8 + 8; ++l) { const float a0 = hb[l * 128 + lane], a1 = hb[l * 128 + 64 + lane];
            const float r = 1.0f / sqrtf(wave_sum(a0 * a0 + a1 * a1) * (1.f / 128.f) + EPS);
            const bf16* pr = P + (t0 + l) * NPROJ + C_MO + h * 128; bf16* orow = MI + (t0 + l) * D + 512 + h * 128;
            orow[lane] = (bf16)f2bf(a0 * r * ng[h * 128 + lane] * bf1(pr[lane])); orow[64 + lane] = (bf16)f2bf(a1 * r * ng[h * 128 + 64 + lane] * bf1(pr[64 + lane])); }
        __syncthreads();
    }
}

__device__ __forceinline__ void ld16bf(const bf16* p, float (&o)[16]) {
    const v4u w0 = *(const GAS v4u*)p, w1 = *(const GAS v4u*)(p + 8);
    o[0] = bflo(w0.x); o[1] = bfhi(w0.x); o[2] = bflo(w0.y); o[3] = bfhi(w0.y); o[4] = bflo(w0.z); o[5] = bfhi(w0.z); o[6] = bflo(w0.w); o[7] = bfhi(w0.w);
    o[8] = bflo(w1.x); o[9] = bfhi(w1.x); o[10] = bflo(w1.y); o[11] = bfhi(w1.y); o[12] = bflo(w1.z); o[13] = bfhi(w1.z); o[14] = bflo(w1.w); o[15] = bfhi(w1.w);
}
typedef short bf16x8 __attribute__((ext_vector_type(8)));
#define MFMA16(a, b, c) __builtin_amdgcn_mfma_f32_16x16x32_bf16((a), (b), (c), 0, 0, 0)
__device__ __forceinline__ bf16x8 ldfrag(LAS const unsigned char* img, int row, int kbyte) { return *(LAS const bf16x8*)(img + row * 144 + kbyte); }
__device__ __forceinline__ unsigned cvtpk(float lo, float hi) { unsigned r; asm volatile("v_cvt_pk_bf16_f32 %0, %1, %2" : "=v"(r) : "v"(lo), "v"(hi)); return r; }

namespace ml {
constexpr int O_Q = 0, O_QA = 9216, O_K = 18432, O_KWT = 27648, O_VT = 36864, O_CX = 57600, CXB = 20736, O_S = 99072, O_GB = 108288, O_GA = O_GB + 4096, O_GC = O_GA + 4096, O_DEN = O_GC + 4096, O_SSQ = O_DEN + 256, O_END = O_SSQ + 2048;
static_assert(O_END <= 131072, "mlstm LDS");
constexpr size_t MST_SC = 11 * MiB;
}
template <bool OUT>
__device__ __forceinline__ void mlstm_group(const Args& A, LAS unsigned char* lds, int wg) {
    using namespace ml;
    const int tid = threadIdx.x, lane = tid & 63, wave = __builtin_amdgcn_readfirstlane(tid >> 6), fr = lane & 15, fq = lane >> 4;
    const int bh = wg >> 3, grp = wg & 7, b = bh >> 2, h = bh & 3;
    const size_t tg0 = (size_t)b * SEQ + (size_t)grp * 1024;
    const bf16* P = (const bf16*)(A.ws + WS_PROJ); bf16* MI = (bf16*)(A.ws + WS_MIXIN); const float* gates = (const float*)(A.ws + WS_GATES);
    const float* cw = (const float*)A.in[I_CONVW]; const float* ng = (const float*)A.in[I_MNG];
    float* MST = (float*)(A.ws + WS_MST); float* MSC = (float*)(A.ws + WS_MST + MST_SC);
    LAS float* GB = (LAS float*)(lds + O_GB); LAS float* GA = (LAS float*)(lds + O_GA); LAS float* GC = (LAS float*)(lds + O_GC);
    LAS float* DEN = (LAS float*)(lds + O_DEN); LAS float* SSQ = (LAS float*)(lds + O_SSQ);
    __syncthreads();
#pragma unroll
    for (int cc = 0; cc < 2; ++cc) { const int c = 2 * wave + cc; const size_t t = tg0 + c * 64 + lane;
        float bc = gates[t * 8 + 4 + h]; const float ii = gates[t * 8 + h];
#pragma unroll
        for (int o = 1; o < 64; o <<= 1) { const float v = __shfl_up(bc, o); if (lane >= o) bc += v; }
        const float a = ii - bc; float cm = a;
#pragma unroll
        for (int o = 1; o < 64; o <<= 1) { const float v = __shfl_up(cm, o); if (lane >= o) cm = fmaxf(cm, v); }
        GB[c * 64 + lane] = bc; GA[c * 64 + lane] = a; GC[c * 64 + lane] = cm; }
    for (int e = tid; e < 16 * 32; e += NTHR) { const int r = e >> 5, cpair = e & 31; *(LAS unsigned*)(lds + O_VT + (128 + r) * 144 + cpair * 4) = (r == 0) ? 0x3F803F80u : 0u; }
    f32x4 st[5];
#pragma unroll
    for (int i = 0; i < 5; ++i) st[i] = (f32x4){0.f, 0.f, 0.f, 0.f};
    float m = OUT ? 0.f : -__builtin_inff(); float Btot = 0.f;
    if (OUT) {
        for (int gp = 0; gp < grp; ++gp) { const int wgp = bh * 8 + gp; const float mg = MSC[wgp * 2], Bg = MSC[wgp * 2 + 1];
            const float mn = fmaxf(Bg + m, mg), f0 = __expf(Bg + m - mn), f1 = __expf(mg - mn);
#pragma unroll
            for (int i = 0; i < 5; ++i)
#pragma unroll
                for (int r = 0; r < 4; ++r) st[i][r] = f0 * st[i][r] + f1 * MST[((size_t)wgp * 20 + i * 4 + r) * NTHR + tid];
            m = mn; }
#pragma unroll
        for (int j = 0; j < 4; ++j)
#pragma unroll
            for (int r = 0; r < 4; ++r) *(LAS bf16*)(lds + O_CX + (16 * wave + 4 * fq + r) * 144 + (16 * j + fr) * 2) = (bf16)f2bf(st[j][r]);
        if (wave < 4) {
#pragma unroll
            for (int r = 0; r < 4; ++r) *(LAS bf16*)(lds + O_CX + (128 + 4 * fq + r) * 144 + (16 * wave + fr) * 2) = (bf16)f2bf(st[4][r]); }
    }
    float gsc[4];
#pragma unroll
    for (int r = 0; r < 4; ++r) gsc[r] = ng[h * 128 + 16 * wave + 4 * fq + r];
    const int sl = tid >> 3, cg = tid & 7;
    __syncthreads();
    for (int c = 0; c < 16; ++c) {
        const float bL = GB[c * 64 + 63], M63 = fmaxf(m, GC[c * 64 + 63]), decay = __expf(m - M63);
        const size_t tc0 = tg0 + (size_t)c * 64;
        {
            const int sabs = grp * 1024 + c * 64 + sl;
            float aq[8], ak[8];
#pragma unroll
            for (int i = 0; i < 8; ++i) { aq[i] = 0.f; ak[i] = 0.f; }
#pragma unroll
            for (int j = 0; j < 4; ++j) { const int sj = sabs - 3 + j;
                if (sj >= 0) { const bf16* rp = P + ((size_t)b * SEQ + sj) * NPROJ;
                    const v4u wq = *(const GAS v4u*)(rp + C_MQ + h * 64 + 8 * cg), wk = *(const GAS v4u*)(rp + C_MK + h * 64 + 8 * cg);
                    const f32x4 q0 = *(const GAS f32x4*)(cw + j * 512 + h * 64 + 8 * cg), q1 = *(const GAS f32x4*)(cw + j * 512 + h * 64 + 8 * cg + 4);
                    const f32x4 k0 = *(const GAS f32x4*)(cw + j * 512 + 256 + h * 64 + 8 * cg), k1 = *(const GAS f32x4*)(cw + j * 512 + 256 + h * 64 + 8 * cg + 4);
                    aq[0] += q0[0] * bflo(wq.x); aq[1] += q0[1] * bfhi(wq.x); aq[2] += q0[2] * bflo(wq.y); aq[3] += q0[3] * bfhi(wq.y);
                    aq[4] += q1[0] * bflo(wq.z); aq[5] += q1[1] * bfhi(wq.z); aq[6] += q1[2] * bflo(wq.w); aq[7] += q1[3] * bfhi(wq.w);
                    ak[0] += k0[0] * bflo(wk.x); ak[1] += k0[1] * bfhi(wk.x); ak[2] += k0[2] * bflo(wk.y); ak[3] += k0[3] * bfhi(wk.y);
                    ak[4] += k1[0] * bflo(wk.z); ak[5] += k1[1] * bfhi(wk.z); ak[6] += k1[2] * bflo(wk.w); ak[7] += k1[3] * bfhi(wk.w); } }
            const float Ml = fmaxf(m, GC[c * 64 + sl]), ainter = __expf(m - Ml), wsv = __expf(GA[c * 64 + sl] - M63);
            float qv[8], kv[8];
#pragma unroll
            for (int i = 0; i < 8; ++i) { qv[i] = 0.125f * aq[i] * __builtin_amdgcn_rcpf(1.f + __expf(-aq[i])); kv[i] = ak[i] * __builtin_amdgcn_rcpf(1.f + __expf(-ak[i])); }
            if (OUT) {
                v4u w; w.x = pk2(qv[0], qv[1]); w.y = pk2(qv[2], qv[3]); w.z = pk2(qv[4], qv[5]); w.w = pk2(qv[6], qv[7]); *(LAS v4u*)(lds + O_Q + sl * 144 + cg * 16) = w;
                w.x = pk2(qv[0] * ainter, qv[1] * ainter); w.y = pk2(qv[2] * ainter, qv[3] * ainter); w.z = pk2(qv[4] * ainter, qv[5] * ainter); w.w = pk2(qv[6] * ainter, qv[7] * ainter); *(LAS v4u*)(lds + O_QA + sl * 144 + cg * 16) = w;
                w.x = pk2(kv[0], kv[1]); w.y = pk2(kv[2], kv[3]); w.z = pk2(kv[4], kv[5]); w.w = pk2(kv[6], kv[7]); *(LAS v4u*)(lds + O_K + sl * 144 + cg * 16) = w;
            }
#pragma unroll
            for (int i = 0; i < 8; ++i) *(LAS bf16*)(lds + O_KWT + (8 * cg + i) * 144 + sl * 2) = (bf16)f2bf(kv[i] * wsv);
#pragma unroll
            for (int gi = 0; gi < 2; ++gi) { const int g8 = cg + 8 * gi; const v4u wv = *(const GAS v4u*)(P + (tc0 + sl) * NPROJ + C_MV + h * 128 + 8 * g8);
                const unsigned ww[4] = {wv.x, wv.y, wv.z, wv.w};
#pragma unroll
                for (int i = 0; i < 4; ++i) { *(LAS bf16*)(lds + O_VT + (8 * g8 + 2 * i) * 144 + sl * 2) = (bf16)(ww[i] & 0xffffu); *(LAS bf16*)(lds + O_VT + (8 * g8 + 2 * i + 1) * 144 + sl * 2) = (bf16)(ww[i] >> 16); } }
        }
        __syncthreads();
        if (OUT) {
            const int lt = wave >> 1, l = 16 * lt + fr; const float Ml = fmaxf(m, GC[c * 64 + l]);
            const bf16x8 bq0 = ldfrag(lds + O_Q, 16 * lt + fr, 16 * fq), bq1 = ldfrag(lds + O_Q, 16 * lt + fr, 64 + 16 * fq);
#pragma unroll
            for (int u = 0; u < 2; ++u) { const int stl = 2 * (wave & 1) + u; f32x4 acc = {0.f, 0.f, 0.f, 0.f};
                acc = MFMA16(ldfrag(lds + O_K, 16 * stl + fr, 16 * fq), bq0, acc); acc = MFMA16(ldfrag(lds + O_K, 16 * stl + fr, 64 + 16 * fq), bq1, acc);
                const f32x4 av = *(LAS const f32x4*)(GA + c * 64 + 16 * stl + 4 * fq); float wv[4];
#pragma unroll
                for (int r = 0; r < 4; ++r) { const int s = 16 * stl + 4 * fq + r; wv[r] = (s <= l) ? acc[r] * __expf(av[r] - Ml) : 0.f; }
                v2u w; w.x = cvtpk(wv[0], wv[1]); w.y = cvtpk(wv[2], wv[3]); *(LAS v2u*)(lds + O_S + l * 144 + (16 * stl + 4 * fq) * 2) = w; }
        }
        {
            const bf16x8 va0 = ldfrag(lds + O_VT, 16 * wave + fr, 16 * fq), va1 = ldfrag(lds + O_VT, 16 * wave + fr, 64 + 16 * fq);
#pragma unroll
            for (int j = 0; j < 4; ++j) { st[j] = st[j] * decay;
                st[j] = MFMA16(va0, ldfrag(lds + O_KWT, 16 * j + fr, 16 * fq), st[j]); st[j] = MFMA16(va1, ldfrag(lds + O_KWT, 16 * j + fr, 64 + 16 * fq), st[j]); }
            if (wave < 4) { st[4] = st[4] * decay;
                st[4] = MFMA16(ldfrag(lds + O_VT, 128 + fr, 16 * fq), ldfrag(lds + O_KWT, 16 * wave + fr, 16 * fq), st[4]);
                st[4] = MFMA16(ldfrag(lds + O_VT, 128 + fr, 64 + 16 * fq), ldfrag(lds + O_KWT, 16 * wave + fr, 64 + 16 * fq), st[4]); }
        }
        if (OUT) {
            __syncthreads();
            LAS const unsigned char* cx = lds + O_CX + (c & 1) * CXB;
            f32x4 nt[4], nd = {0.f, 0.f, 0.f, 0.f};
            {
                const bf16x8 va0 = ldfrag(lds + O_VT, 16 * wave + fr, 16 * fq), va1 = ldfrag(lds + O_VT, 16 * wave + fr, 64 + 16 * fq);
                const bf16x8 ca0 = ldfrag(cx, 16 * wave + fr, 16 * fq), ca1 = ldfrag(cx, 16 * wave + fr, 64 + 16 * fq);
#pragma unroll
                for (int lt = 0; lt < 4; ++lt) { f32x4 acc = {0.f, 0.f, 0.f, 0.f};
                    acc = MFMA16(va0, ldfrag(lds + O_S, 16 * lt + fr, 16 * fq), acc); acc = MFMA16(va1, ldfrag(lds + O_S, 16 * lt + fr, 64 + 16 * fq), acc);
                    acc = MFMA16(ca0, ldfrag(lds + O_QA, 16 * lt + fr, 16 * fq), acc); acc = MFMA16(ca1, ldfrag(lds + O_QA, 16 * lt + fr, 64 + 16 * fq), acc); nt[lt] = acc; }
                if (wave >= 4) { const int lt = wave - 4;
                    nd = MFMA16(ldfrag(lds + O_VT, 128 + fr, 16 * fq), ldfrag(lds + O_S, 16 * lt + fr, 16 * fq), nd); nd = MFMA16(ldfrag(lds + O_VT, 128 + fr, 64 + 16 * fq), ldfrag(lds + O_S, 16 * lt + fr, 64 + 16 * fq), nd);
                    nd = MFMA16(ldfrag(cx, 128 + fr, 16 * fq), ldfrag(lds + O_QA, 16 * lt + fr, 16 * fq), nd); nd = MFMA16(ldfrag(cx, 128 + fr, 64 + 16 * fq), ldfrag(lds + O_QA, 16 * lt + fr, 64 + 16 * fq), nd);
                    if (fq == 0) DEN[16 * lt + fr] = nd[0]; }
            }
            v2u mo[4];
#pragma unroll
            for (int lt = 0; lt < 4; ++lt) mo[lt] = *(const GAS v2u*)(P + (tc0 + 16 * lt + fr) * NPROJ + C_MO + h * 128 + 16 * wave + 4 * fq);
            __syncthreads();
#pragma unroll
            for (int lt = 0; lt < 4; ++lt) { const int l = 16 * lt + fr; const float Ml = fmaxf(m, GC[c * 64 + l]);
                const float inv = 1.0f / fmaxf(fabsf(DEN[l]), __expf(-(GB[c * 64 + l] + Ml)));
                nt[lt] = nt[lt] * inv; float ss = (nt[lt][0] * nt[lt][0] + nt[lt][1] * nt[lt][1]) + (nt[lt][2] * nt[lt][2] + nt[lt][3] * nt[lt][3]);
                ss += __shfl_xor(ss, 16); ss += __shfl_xor(ss, 32);
                if (fq == 0) SSQ[wave * 64 + l] = ss; }
            LAS unsigned char* cxn = lds + O_CX + ((c + 1) & 1) * CXB;
#pragma unroll
            for (int j = 0; j < 4; ++j)
#pragma unroll
                for (int r = 0; r < 4; ++r) *(LAS bf16*)(cxn + (16 * wave + 4 * fq + r) * 144 + (16 * j + fr) * 2) = (bf16)f2bf(st[j][r]);
            if (wave < 4) {
#pragma unroll
                for (int r = 0; r < 4; ++r) *(LAS bf16*)(cxn + (128 + 4 * fq + r) * 144 + (16 * wave + fr) * 2) = (bf16)f2bf(st[4][r]); }
            __syncthreads();
#pragma unroll
            for (int lt = 0; lt < 4; ++lt) { const int l = 16 * lt + fr; float tot = 0.f;
#pragma unroll
                for (int w2 = 0; w2 < 8; ++w2) tot += SSQ[w2 * 64 + l];
                const float rn = 1.0f / sqrtf(tot * (1.f / 128.f) + EPS);
                const float o0 = nt[lt][0] * rn * gsc[0] * bflo(mo[lt].x), o1 = nt[lt][1] * rn * gsc[1] * bfhi(mo[lt].x), o2 = nt[lt][2] * rn * gsc[2] * bflo(mo[lt].y), o3 = nt[lt][3] * rn * gsc[3] * bfhi(mo[lt].y);
                v2u w; w.x = pk2(o0, o1); w.y = pk2(o2, o3);
                *(GAS v2u*)(MI + (tc0 + l) * D + 512 + h * 128 + 16 * wave + 4 * fq) = w; }
        } else {
            __syncthreads();
        }
        m = bL + M63; Btot += bL;
    }
    if (!OUT) {
#pragma unroll
        for (int i = 0; i < 5; ++i)
#pragma unroll
            for (int r = 0; r < 4; ++r) MST[((size_t)wg * 20 + i * 4 + r) * NTHR + tid] = st[i][r];
        if (tid == 0) { MSC[wg * 2] = m; MSC[wg * 2 + 1] = Btot; }
    }
}

namespace at {
constexpr int O_K = 0, O_VT = 36864, VTS = 560  , O_END = O_VT + 64 * VTS;
static_assert(O_END <= 131072, "attention LDS");
}
__device__ __forceinline__ void phase_attn(const Args& A, LAS unsigned char* lds) {
    using namespace at;
    const int tid = threadIdx.x, lane = tid & 63, wave = __builtin_amdgcn_readfirstlane(tid >> 6), fr = lane & 15, fq = lane >> 4, G = gridDim.x;
    const bf16* P = (const bf16*)(A.ws + WS_PROJ); bf16* MI = (bf16*)(A.ws + WS_MIXIN); const float* sinks = (const float*)A.in[I_SINK];
    __syncthreads();
    for (int e = tid; e < 64 * 12; e += NTHR) { const int r = e / 12, cpair = e % 12; *(LAS unsigned*)(lds + O_VT + r * VTS + 512 + cpair * 4) = 0u; }
    for (int unit = blockIdx.x; unit < NB * 64 * 2; unit += G) {
        const int g = unit & 1, n = (unit >> 1) & 63, b = unit >> 7;
        const size_t tq0 = (size_t)b * SEQ + (size_t)n * 128;
        __syncthreads();
#pragma unroll
        for (int i = 0; i < 4; ++i) { const int item = tid + NTHR * i, row = item >> 3, ch = item & 7;
            v4u wk = {0u, 0u, 0u, 0u}, wv = {0u, 0u, 0u, 0u};
            if (n > 0 || row >= 128) { const bf16* rp = P + (tq0 - 128 + row) * NPROJ; wk = *(const GAS v4u*)(rp + C_AK + g * 64 + 8 * ch); wv = *(const GAS v4u*)(rp + C_AV + g * 64 + 8 * ch); }
            *(LAS v4u*)(lds + O_K + row * 144 + ch * 16) = wk;
            const unsigned ww[4] = {wv.x, wv.y, wv.z, wv.w};
#pragma unroll
            for (int k = 0; k < 4; ++k) { *(LAS bf16*)(lds + O_VT + (8 * ch + 2 * k) * VTS + row * 2) = (bf16)(ww[k] & 0xffffu); *(LAS bf16*)(lds + O_VT + (8 * ch + 2 * k + 1) * VTS + row * 2) = (bf16)(ww[k] >> 16); } }
        const int hq = 4 * g + (wave >> 1), qr0 = 64 * (wave & 1); const float sink = sinks[hq];
        __syncthreads();
        for (int qt = 0; qt < 4; ++qt) {
            const int i0 = qr0 + 16 * qt, st0 = i0 >> 4, iq = i0 + fr;
            const bf16* qp = P + (tq0 + iq) * NPROJ + C_AQ + hq * 64 + 8 * fq;
            const bf16x8 bq0 = *(const GAS bf16x8*)qp, bq1 = *(const GAS bf16x8*)(qp + 32);
            f32x4 sc[9]; float mx = sink;
#pragma unroll
            for (int t = 0; t < 9; ++t) { const int sb0 = 16 * (st0 + t); f32x4 acc = {0.f, 0.f, 0.f, 0.f};
                acc = MFMA16(ldfrag(lds + O_K, sb0 + fr, 16 * fq), bq0, acc); acc = MFMA16(ldfrag(lds + O_K, sb0 + fr, 64 + 16 * fq), bq1, acc);
#pragma unroll
                for (int r = 0; r < 4; ++r) { const int sb = sb0 + 4 * fq + r; const bool valid = (sb > iq) && (sb <= iq + 128) && (n > 0 || sb >= 128);
                    acc[r] = valid ? acc[r] : -3.0e38f; mx = fmaxf(mx, acc[r]); }
                sc[t] = acc; }
            mx = fmaxf(mx, __shfl_xor(mx, 16)); mx = fmaxf(mx, __shfl_xor(mx, 32));
            float lsum = 0.f;
#pragma unroll
            for (int t = 0; t < 9; ++t)
#pragma unroll
                for (int r = 0; r < 4; ++r) { const float p = (sc[t][r] > -1.0e38f) ? __expf(sc[t][r] - mx) : 0.f; sc[t][r] = p; lsum += p; }
            lsum += __shfl_xor(lsum, 16); lsum += __shfl_xor(lsum, 32); lsum += __expf(sink - mx);
            f32x4 oacc[4];
#pragma unroll
            for (int dt = 0; dt < 4; ++dt) oacc[dt] = (f32x4){0.f, 0.f, 0.f, 0.f};
#pragma unroll
            for (int ks = 0; ks < 5; ++ks) {
                union { bf16x8 v; unsigned u[4]; } pb;
                pb.u[0] = cvtpk(sc[2 * ks][0], sc[2 * ks][1]); pb.u[1] = cvtpk(sc[2 * ks][2], sc[2 * ks][3]);
                if (ks < 4) { pb.u[2] = cvtpk(sc[2 * ks + 1][0], sc[2 * ks + 1][1]); pb.u[3] = cvtpk(sc[2 * ks + 1][2], sc[2 * ks + 1][3]); } else { pb.u[2] = 0u; pb.u[3] = 0u; }
                const int sbb = 16 * (st0 + 2 * ks) + 4 * fq;
#pragma unroll
                for (int dt = 0; dt < 4; ++dt) { LAS const unsigned char* vp = lds + O_VT + (16 * dt + fr) * VTS + sbb * 2;
                    union { bf16x8 v; v2u h[2]; } va; va.h[0] = *(LAS const v2u*)vp; va.h[1] = *(LAS const v2u*)(vp + 32);
                    oacc[dt] = MFMA16(va.v, pb.v, oacc[dt]); } }
            const float il = 1.0f / lsum;
#pragma unroll
            for (int dt = 0; dt < 4; ++dt) { v2u w; w.x = pk2(oacc[dt][0] * il, oacc[dt][1] * il); w.y = pk2(oacc[dt][2] * il, oacc[dt][3] * il);
                *(GAS v2u*)(MI + (tq0 + iq) * D + hq * 64 + 16 * dt + 4 * fq) = w; }
        }
    }
}
typedef float f32x16 __attribute__((ext_vector_type(16)));
__device__ __forceinline__ unsigned fbits(float f) { return __builtin_bit_cast(unsigned, f); }
__device__ __forceinline__ float bfloat(unsigned u) { return __builtin_bit_cast(float, u); }

#define CE_DESC(a, b) do { const float _mx = __builtin_fmaxf(a, b), _mn = __builtin_fminf(a, b); a = _mx; b = _mn; } while (0)
__device__ __forceinline__ void bsort16(float (&v)[16]) {
#pragma unroll
    for (int k = 2; k <= 16; k <<= 1)
#pragma unroll
        for (int j = k >> 1; j > 0; j >>= 1)
#pragma unroll
            for (int i = 0; i < 16; ++i) { const int l = i ^ j; if (l > i) { if ((i & k) == 0) CE_DESC(v[i], v[l]); else CE_DESC(v[l], v[i]); } }
}
__device__ __forceinline__ void bmerge16(float (&v)[16], const float (&w)[16]) {
#pragma unroll
    for (int i = 0; i < 16; ++i) v[i] = __builtin_fmaxf(v[i], w[15 - i]);
#pragma unroll
    for (int j = 8; j > 0; j >>= 1)
#pragma unroll
        for (int i = 0; i < 16; ++i) { const int l = i ^ j; if (l > i) CE_DESC(v[i], v[l]); }
}
namespace tk {
constexpr int KS = 272;
constexpr int O_K1 = 0, O_K2 = 128 * KS, O_X = 2 * 128 * KS, O_END = O_X + 8 * 4096;
static_assert(O_END <= 131072, "topk LDS");
constexpr unsigned char CAND[64] = {
    0x00, 0x01, 0x02, 0x03, 0x04, 0x05, 0x06, 0x07, 0x08, 0x09, 0x0a, 0x0b, 0x0c, 0x0d, 0x0e, 0x0f,
    0x10, 0x11, 0x12, 0x13, 0x14, 0x15, 0x16, 0x17, 0x80, 0x90, 0xa0, 0xb0, 0xc0, 0xd0, 0xe0, 0xf0,
    0x20, 0x21, 0x22, 0x23, 0x24, 0x30, 0x31, 0x32, 0x33, 0x40, 0x41, 0x42, 0x50, 0x51, 0x60, 0x61,
    0x70, 0x71, 0xff, 0xff, 0xff, 0xff, 0xff, 0xff, 0xff, 0xff, 0xff, 0xff, 0xff, 0xff, 0xff, 0xff};
}
__device__ __forceinline__ void side_top16(const f32x16 (&acc)[4], int hh, float (&T)[16]) {
    float g1[16], g2[16];
#pragma unroll
    for (int r = 0; r < 16; ++r) { const unsigned key = (r & 3) + 8 * (r >> 2) + 4 * hh;
        T[r] = bfloat((fbits(acc[0][r]) & 0xffffff80u) | key);
        g1[r] = bfloat((fbits(acc[1][r]) & 0xffffff80u) | (32u + key)); }
    bsort16(T); bsort16(g1); bmerge16(T, g1);
#pragma unroll
    for (int r = 0; r < 16; ++r) { const unsigned key = (r & 3) + 8 * (r >> 2) + 4 * hh;
        g1[r] = bfloat((fbits(acc[2][r]) & 0xffffff80u) | (64u + key));
        g2[r] = bfloat((fbits(acc[3][r]) & 0xffffff80u) | (96u + key)); }
    bsort16(g1); bsort16(g2); bmerge16(g1, g2); bmerge16(T, g1);
#pragma unroll
    for (int r = 0; r < 16; ++r) g1[r] = __shfl_xor(T[r], 32);
    bmerge16(T, g1);
}
template <int SD> __device__ __forceinline__ void topk_side(const bf16* Q, LAS unsigned char* lds, int t, int h, int r32, int hh, float (&T)[16]) {
    using namespace tk;
    f32x16 acc[4];
#pragma unroll
    for (int mt = 0; mt < 4; ++mt)
#pragma unroll
        for (int r = 0; r < 16; ++r) acc[mt][r] = 0.f;
    const bf16* qp = Q + (size_t)t * 2048 + h * 256 + SD * 128 + 8 * hh; LAS const unsigned char* kimg = lds + (SD ? O_K2 : O_K1);
#pragma unroll
    for (int ks = 0; ks < 8; ++ks) { const bf16x8 bq = *(const GAS bf16x8*)(qp + 16 * ks);
#pragma unroll
        for (int mt = 0; mt < 4; ++mt) acc[mt] = __builtin_amdgcn_mfma_f32_32x32x16_bf16(*(LAS const bf16x8*)(kimg + (32 * mt + r32) * KS + 32 * ks + 16 * hh), bq, acc[mt], 0, 0, 0); }
    side_top16(acc, hh, T);
}
template <int Q> __device__ __forceinline__ float cand_val(const float (&T1)[16], const float (&T2)[16], int hh) {
    constexpr unsigned c0 = tk::CAND[2 * Q], c1 = tk::CAND[2 * Q + 1];
    const float s = (hh ? T1[(c1 >> 4) & 15] : T1[(c0 >> 4) & 15]) + (hh ? T2[c1 & 15] : T2[c0 & 15]); const unsigned code = hh ? c1 : c0;
    return (code == 0xffu) ? -3.0e38f : bfloat((fbits(s) & 0xffffff00u) | code);
}
__device__ __forceinline__ void phase_topk(const Args& A, LAS unsigned char* lds) {
    using namespace tk;
    const int tid = threadIdx.x, lane = tid & 63, wave = __builtin_amdgcn_readfirstlane(tid >> 6), G = gridDim.x;
    const bf16* Q = (const bf16*)(A.ws + WS_PROJ); const bf16* KB = (const bf16*)(A.ws + WS_KEYS);
    unsigned short* EI = (unsigned short*)(A.ws + WS_EIDX); float* GT = (float*)(A.ws + WS_GATE);
    const int h = blockIdx.x & 7, r32 = lane & 31, hh = lane >> 5;
    __syncthreads();
    for (int e = tid; e < 2 * 128 * 16; e += NTHR) { const int s = e >> 11, row = (e >> 4) & 127, ch = e & 15;
        *(LAS v4u*)(lds + (s ? O_K2 : O_K1) + row * KS + ch * 16) = *(const GAS v4u*)(KB + (size_t)s * 8 * 128 * 128 + ((size_t)h * 128 + row) * 128 + ch * 8); }
    __syncthreads();
    LAS float* XW = (LAS float*)(lds + O_X + wave * 4096) + r32 * 32;
    for (int tile = (int)(blockIdx.x >> 3); tile < M / 256; tile += (G >> 3)) {
        const int t = tile * 256 + 32 * wave + r32;
        float T1[16], T2[16];
        topk_side<0>(Q, lds, t, h, r32, hh, T1);
        topk_side<1>(Q, lds, t, h, r32, hh, T2);
        float c[16], w[16];
        c[0] = cand_val<0>(T1, T2, hh); w[0] = cand_val<16>(T1, T2, hh);
        c[1] = cand_val<1>(T1, T2, hh); w[1] = cand_val<17>(T1, T2, hh);
        c[2] = cand_val<2>(T1, T2, hh); w[2] = cand_val<18>(T1, T2, hh);
        c[3] = cand_val<3>(T1, T2, hh); w[3] = cand_val<19>(T1, T2, hh);
        c[4] = cand_val<4>(T1, T2, hh); w[4] = cand_val<20>(T1, T2, hh);
        c[5] = cand_val<5>(T1, T2, hh); w[5] = cand_val<21>(T1, T2, hh);
        c[6] = cand_val<6>(T1, T2, hh); w[6] = cand_val<22>(T1, T2, hh);
        c[7] = cand_val<7>(T1, T2, hh); w[7] = cand_val<23>(T1, T2, hh);
        c[8] = cand_val<8>(T1, T2, hh); w[8] = cand_val<24>(T1, T2, hh);
        c[9] = cand_val<9>(T1, T2, hh); w[9] = cand_val<25>(T1, T2, hh);
        c[10] = cand_val<10>(T1, T2, hh); w[10] = cand_val<26>(T1, T2, hh);
        c[11] = cand_val<11>(T1, T2, hh); w[11] = cand_val<27>(T1, T2, hh);
        c[12] = cand_val<12>(T1, T2, hh); w[12] = cand_val<28>(T1, T2, hh);
        c[13] = cand_val<13>(T1, T2, hh); w[13] = cand_val<29>(T1, T2, hh);
        c[14] = cand_val<14>(T1, T2, hh); w[14] = cand_val<30>(T1, T2, hh);
        c[15] = cand_val<15>(T1, T2, hh); w[15] = cand_val<31>(T1, T2, hh);
        bsort16(c); bsort16(w); bmerge16(c, w);
#pragma unroll
        for (int r = 0; r < 16; ++r) w[r] = __shfl_xor(c[r], 32);
        bmerge16(c, w);
        if (hh == 0) {
#pragma unroll
            for (int q4 = 0; q4 < 4; ++q4) { *(LAS f32x4*)(XW + 4 * q4) = (f32x4){T1[4 * q4], T1[4 * q4 + 1], T1[4 * q4 + 2], T1[4 * q4 + 3]};
                *(LAS f32x4*)(XW + 16 + 4 * q4) = (f32x4){T2[4 * q4], T2[4 * q4 + 1], T2[4 * q4 + 2], T2[4 * q4 + 3]}; } }
        asm volatile("s_waitcnt lgkmcnt(0)" ::: "memory");
        float ex[16], sum = 0.f; const float tmax = bfloat(fbits(c[0]) & 0xffffff00u);
#pragma unroll
        for (int r = 0; r < 16; ++r) { ex[r] = __expf(bfloat(fbits(c[r]) & 0xffffff00u) - tmax); sum += ex[r]; }
        const float isum = 1.0f / sum; const size_t ob = (size_t)t * NSLOT + h * 16 + 8 * hh;
        unsigned eo[8]; float go[8];
#pragma unroll
        for (int r = 0; r < 8; ++r) { float ca = c[r], cb = c[8 + r], ea = ex[r], eb = ex[8 + r]; asm volatile("" : "+v"(ca), "+v"(cb), "+v"(ea), "+v"(eb)); const float cv = hh ? cb : ca, ev = hh ? eb : ea;
            const unsigned code = fbits(cv) & 0xffu;
            const unsigned i1 = fbits(XW[code >> 4]) & 127u, i2 = fbits(XW[16 + (code & 15)]) & 127u;
            eo[r] = i1 * 128u + i2; go[r] = ev * isum; }
        *(GAS v4u*)(EI + ob) = (v4u){eo[0] | (eo[1] << 16), eo[2] | (eo[3] << 16), eo[4] | (eo[5] << 16), eo[6] | (eo[7] << 16)};
        *(GAS f32x4*)(GT + ob) = (f32x4){go[0], go[1], go[2], go[3]}; *(GAS f32x4*)(GT + ob + 4) = (f32x4){go[4], go[5], go[6], go[7]};
        asm volatile("s_waitcnt lgkmcnt(0)" ::: "memory");
    }
}
__device__ __forceinline__ void phase_peer_u(const Args& A) {
    const int tid = threadIdx.x, lane = tid & 63, wave = tid >> 6, p = blockIdx.x & 7, j = blockIdx.x >> 3, nj = gridDim.x >> 3, g = lane >> 3, c = lane & 7;
    const bf16* H = (const bf16*)(A.ws + WS_H); const unsigned char* U8 = (const unsigned char*)(A.ws + WS_U8); const unsigned short* EI = (const unsigned short*)(A.ws + WS_EIDX);
    float* PD = (float*)(A.ws + WS_PD) + (size_t)p * M * NSLOT;
    const int tper = M / nj;
    for (int t = j * tper + wave; t < (j + 1) * tper; t += NWAVES) {
        float hv[16]; ld16bf(H + (size_t)t * D + 128 * p + 16 * c, hv);
        const v4u e0 = *(const GAS v4u*)(EI + (size_t)t * NSLOT + 16 * g), e1 = *(const GAS v4u*)(EI + (size_t)t * NSLOT + 16 * g + 8);
        const unsigned ew[8] = {e0.x, e0.y, e0.z, e0.w, e1.x, e1.y, e1.z, e1.w};
        float d[16]; v4u raw[16];
#pragma unroll
        for (int k = 0; k < 16; ++k) { const unsigned e = (k & 1) ? (ew[k >> 1] >> 16) : (ew[k >> 1] & 0xffffu); raw[k] = *(const GAS v4u*)(U8 + (size_t)e * D + 128 * p + 16 * c); }
        __builtin_amdgcn_sched_barrier(0);
#pragma unroll
        for (int k = 0; k < 16; ++k) { float uf[16]; cvt16_fp8(raw[k], uf); float s = 0.f;
#pragma unroll
            for (int i = 0; i < 16; ++i) s += uf[i] * hv[i];
            d[k] = s; __builtin_amdgcn_sched_barrier(0); }
#pragma unroll
        for (int i = 0; i < 8; ++i) { const bool up = (lane & 4) != 0; const float keep = up ? d[i + 8] : d[i], send = up ? d[i] : d[i + 8]; d[i] = keep + __shfl_xor(send, 4); }
#pragma unroll
        for (int i = 0; i < 4; ++i) { const bool up = (lane & 2) != 0; const float keep = up ? d[i + 4] : d[i], send = up ? d[i] : d[i + 4]; d[i] = keep + __shfl_xor(send, 2); }
#pragma unroll
        for (int i = 0; i < 2; ++i) { const bool up = (lane & 1) != 0; const float keep = up ? d[i + 2] : d[i], send = up ? d[i] : d[i + 2]; d[i] = keep + __shfl_xor(send, 1); }
        *(GAS f32x2*)(PD + (size_t)t * NSLOT + 16 * g + 2 * c) = (f32x2){d[0], d[1]};
    }
}
__device__ __forceinline__ void phase_peer_act(const Args& A) {
    const float* PD = (const float*)(A.ws + WS_PD); const unsigned short* EI = (const unsigned short*)(A.ws + WS_EIDX); const float* GT = (const float*)(A.ws + WS_GATE);
    const float* usc = (const float*)(A.ws + WS_SC); const float* vsc = usc + NEXP; float* ACT = (float*)(A.ws + WS_ACT);
    for (size_t i = (size_t)blockIdx.x * NTHR + threadIdx.x; i < (size_t)M * NSLOT; i += (size_t)gridDim.x * NTHR) {
        float s = 0.f;
#pragma unroll
        for (int p = 0; p < 8; ++p) s += PD[(size_t)p * M * NSLOT + i];
        const unsigned e = EI[i]; s *= usc[e];
        ACT[i] = 0.5f * s * (1.f + erff(s * 0.70710678118654752f)) * GT[i] * vsc[e];
    }
}
__device__ __forceinline__ void phase_peer_v(const Args& A) {
    const int tid = threadIdx.x, lane = tid & 63, wave = tid >> 6, p = blockIdx.x & 7, j = blockIdx.x >> 3, nj = gridDim.x >> 3, g = lane >> 3, c = lane & 7;
    const unsigned char* V8 = (const unsigned char*)(A.ws + WS_V8); const unsigned short* EI = (const unsigned short*)(A.ws + WS_EIDX); const float* ACT = (const float*)(A.ws + WS_ACT);
    bf16* Y = (bf16*)(A.ws + WS_H); float* SSY = (float*)(A.ws + WS_SSY);
    const int tper = M / nj;
    for (int t = j * tper + wave; t < (j + 1) * tper; t += NWAVES) {
        const v4u e0 = *(const GAS v4u*)(EI + (size_t)t * NSLOT + 16 * g), e1 = *(const GAS v4u*)(EI + (size_t)t * NSLOT + 16 * g + 8);
        const unsigned ew[8] = {e0.x, e0.y, e0.z, e0.w, e1.x, e1.y, e1.z, e1.w};
        const GAS f32x4* ap = (const GAS f32x4*)(ACT + (size_t)t * NSLOT + 16 * g); const f32x4 a0 = ap[0], a1 = ap[1], a2 = ap[2], a3 = ap[3];
        const float av[16] = {a0[0], a0[1], a0[2], a0[3], a1[0], a1[1], a1[2], a1[3], a2[0], a2[1], a2[2], a2[3], a3[0], a3[1], a3[2], a3[3]};
        float y[16];
#pragma unroll
        for (int i = 0; i < 16; ++i) y[i] = 0.f;
        v4u raw[16];
#pragma unroll
        for (int k = 0; k < 16; ++k) { const unsigned e = (k & 1) ? (ew[k >> 1] >> 16) : (ew[k >> 1] & 0xffffu); raw[k] = *(const GAS v4u*)(V8 + (size_t)e * D + 128 * p + 16 * c); }
        __builtin_amdgcn_sched_barrier(0);
#pragma unroll
        for (int k = 0; k < 16; ++k) { float vf[16]; cvt16_fp8(raw[k], vf);
#pragma unroll
            for (int i = 0; i < 16; ++i) y[i] += av[k] * vf[i];
            __builtin_amdgcn_sched_barrier(0); }
#pragma unroll
        for (int i = 0; i < 8; ++i) { const bool up = (lane & 32) != 0; const float keep = up ? y[i + 8] : y[i], send = up ? y[i] : y[i + 8]; y[i] = keep + __shfl_xor(send, 32); }
#pragma unroll
        for (int i = 0; i < 4; ++i) { const bool up = (lane & 16) != 0; const float keep = up ? y[i + 4] : y[i], send = up ? y[i] : y[i + 4]; y[i] = keep + __shfl_xor(send, 16); }
#pragma unroll
        for (int i = 0; i < 2; ++i) { const bool up = (lane & 8) != 0; const float keep = up ? y[i + 2] : y[i], send = up ? y[i] : y[i + 2]; y[i] = keep + __shfl_xor(send, 8); }
        *(GAS unsigned*)(Y + (size_t)t * D + 128 * p + 16 * c + 2 * g) = pk2(y[0], y[1]);
        const float ss = wave_sum(y[0] * y[0] + y[1] * y[1]);
        if (lane == 0) SSY[(size_t)t * 8 + p] = ss;
    }
}
__device__ __forceinline__ void phase_peer_final(const Args& A) {
    const int tid = threadIdx.x, lane = tid & 63, wave = tid >> 6, G = gridDim.x;
    const bf16* Y = (const bf16*)(A.ws + WS_H); const float* SSY = (const float*)(A.ws + WS_SSY); const float* mod = (const float*)(A.ws + WS_MOD); const float* gpost = (const float*)A.in[I_GPOST2]; float* out = A.out;
    for (int row = blockIdx.x * NWAVES + wave; row < M; row += G * NWAVES) {
        const int b = row / SEQ; const f32x4 s0 = *(const GAS f32x4*)(SSY + (size_t)row * 8), s1 = *(const GAS f32x4*)(SSY + (size_t)row * 8 + 4);
        const float rstd = 1.0f / sqrtf((((s0[0] + s0[1]) + (s0[2] + s0[3])) + ((s1[0] + s1[1]) + (s1[2] + s1[3]))) * (1.f / D) + EPS);
        GAS f32x4* orow = (GAS f32x4*)(out + (size_t)row * D) + lane; const GAS v2u* yr = (const GAS v2u*)(Y + (size_t)row * D) + lane;
#pragma unroll
        for (int q = 0; q < 4; ++q) { const int k = 4 * (lane + 64 * q); f32x4 xv = orow[64 * q]; const v2u yw = yr[64 * q];
            const f32x4 g2 = *(const GAS f32x4*)(mod + b * 6144 + 5120 + k), gp = *(const GAS f32x4*)(gpost + k);
            xv[0] += g2[0] * (bflo(yw.x) * rstd * gp[0]); xv[1] += g2[1] * (bfhi(yw.x) * rstd * gp[1]); xv[2] += g2[2] * (bflo(yw.y) * rstd * gp[2]); xv[3] += g2[3] * (bfhi(yw.y) * rstd * gp[3]);
            orow[64 * q] = xv; }
    }
}
#ifndef MK_N_LAUNCHES
#define MK_N_LAUNCHES 1
#endif
constexpr int N_PHASES = 13;
typedef const __attribute__((address_space(4))) Args* KArgP;
__device__ __forceinline__ const Args& kargs() { KArgP p = (KArgP)__builtin_amdgcn_kernarg_segment_ptr(); asm volatile("" : "+s"(p)); return *(const Args*)p; }
__global__ void __launch_bounds__(NTHR, 2) hymba_fwd(Args A_) {
    extern __shared__ __attribute__((aligned(16))) unsigned char lds_raw[];
    LAS unsigned char* lds = (LAS unsigned char*)lds_raw;
    const int lo = A_.ph_lo, hi = A_.ph_hi;
#define A kargs()
#define ws (kargs().ws)
#ifndef DBLMASK
#define DBLMASK 0
#endif
#define IN(k) (lo <= (k) && (k) < hi)
#define REP(k) for (int _rep = 0; _rep < (((DBLMASK) >> (k)) & 1) + 1; ++_rep)
    for (int u = threadIdx.x; u < (LDS_BYTES - RING_BYTES) / 4; u += NTHR) ((LAS unsigned*)(lds + RING_BYTES))[u] = 0u;
    __syncthreads();
    XcdBarrier xbar = xcd_barrier_post((unsigned*)(ws + WS_CTL) + CW_BAR, (volatile LAS unsigned*)(lds + MISC_OFF + 32));
#define SEAM(k) do { if (IN(k) && IN((k) + 1)) { if ((k) == 0) cg::this_grid().sync(); else xcd_barrier(xbar); } } while (0)

    if (IN(0)) REP(0) { phase_prologue(A, lds); } SEAM(0);
    if (IN(1)) REP(1) { phase_prenorm(A); } SEAM(1);
    if (IN(2)) REP(2) {
        pg8::Gemm g{(const pg8::bf16_t*)(ws + WS_H), (const pg8::bf16_t*)(ws + WS_WIN), M, NIN_PAD, D}; pg8::StaticOrder S; S.init(M, NIN_PAD, gridDim.x, (int)blockIdx.x);
        pg8::EpiProj E{(pg8::bf16_t*)(ws + WS_PROJ), NPROJ, (float*)(ws + WS_GATES), (const int*)A.in[I_POS], (const float*)A.in[I_BI], (const float*)A.in[I_BF]};
        pg8::gemm_phase<pg8::EpiProj, pg8::StaticOrder, true, true>(lds, g, S, E);
    } SEAM(2);
    if (IN(3)) REP(3) {
        phase_attn(A, lds);
        for (int wg = blockIdx.x; wg < 256; wg += gridDim.x) mlstm_group<false>(A, lds, wg);
    } SEAM(3);
    if (IN(4)) REP(4) { for (int wg = blockIdx.x; wg < 256; wg += gridDim.x) mlstm_group<true>(A, lds, wg); } SEAM(4);
    if (IN(5)) REP(5) {
        pg8::Gemm g{(const pg8::bf16_t*)(ws + WS_MIXIN), (const pg8::bf16_t*)(ws + WS_WOUT), M, D, D}; pg8::StaticOrder S; S.init(M, D, gridDim.x, (int)blockIdx.x);
        pg8::EpiMix E{(pg8::bf16_t*)(ws + WS_MIX), D, (float*)(ws + WS_SSQ)};
        pg8::gemm_phase<pg8::EpiMix, pg8::StaticOrder, true, true>(lds, g, S, E);
    } SEAM(5);
    if (IN(6)) REP(6) { phase_mid(A); } SEAM(6);
    if (IN(7)) REP(7) {
        pg8::Gemm g{(const pg8::bf16_t*)(ws + WS_H), (const pg8::bf16_t*)(ws + WS_WQ), M, 2048, D}; pg8::StaticOrder S; S.init(M, 2048, gridDim.x, (int)blockIdx.x);
        pg8::EpiPlain E{(pg8::bf16_t*)(ws + WS_PROJ), 2048};
        pg8::gemm_phase<pg8::EpiPlain, pg8::StaticOrder, true, true>(lds, g, S, E);
    } SEAM(7);
    if (IN(8)) REP(8) { phase_topk(A, lds); } SEAM(8);
    if (IN(9)) REP(9) { phase_peer_u(A); } SEAM(9);
    if (IN(10)) REP(10) { phase_peer_act(A); } SEAM(10);
    if (IN(11)) REP(11) { phase_peer_v(A); } SEAM(11);
    if (IN(12)) REP(12) { phase_peer_final(A); }
#undef IN
#undef SEAM
#undef A
#undef ws
}

extern "C" void kernel_launch(void* const* d_in, const int* in_sizes, int n_in, void* d_out, int out_size, void* d_ws, size_t ws_size, hipStream_t stream) {
    static int grid = 0;
    if (grid == 0) {
        if (n_in != 21 || in_sizes[0] != M * D || out_size != M * D || ws_size < WS_END) { fprintf(stderr, "kernel_launch: unexpected shapes (n_in %d, in0 %d, out %d, ws %zu < %zu)\n", n_in, n_in > 0 ? in_sizes[0] : -1, out_size, ws_size, (size_t)WS_END); grid = -1; return; }
        int dev = 0, cus = 0, per_cu = 0;
        if (hipGetDevice(&dev) != hipSuccess || hipDeviceGetAttribute(&cus, hipDeviceAttributeMultiprocessorCount, dev) != hipSuccess) { grid = -1; return; }
        if (hipFuncSetAttribute((const void*)hymba_fwd, hipFuncAttributeMaxDynamicSharedMemorySize, LDS_BYTES) != hipSuccess) { fprintf(stderr, "kernel_launch: hipFuncSetAttribute failed\n"); grid = -1; return; }
        if (hipOccupancyMaxActiveBlocksPerMultiprocessor(&per_cu, (const void*)hymba_fwd, NTHR, LDS_BYTES) != hipSuccess || per_cu < 1) { fprintf(stderr, "kernel_launch: occupancy query says %d blocks per CU\n", per_cu); per_cu = 1; }
        (void)hipGetLastError();
        grid = cus;
        if (grid != 256) fprintf(stderr, "kernel_launch: note: %d CUs (built for 256)\n", grid);
    }
    if (grid < 0) return;
    (void)hipMemsetAsync((char*)d_ws + WS_CTL, 0, CTL_ZERO_BYTES, stream);
    Args a{};
    for (int i = 0; i < 21; ++i) a.in[i] = d_in[i];
    a.out = (float*)d_out; a.ws = (unsigned char*)d_ws;
    if (MK_N_LAUNCHES == 1) {
        a.ph_lo = 0; a.ph_hi = N_PHASES;
        void* args[] = {&a};
        const hipError_t e = hipLaunchCooperativeKernel((const void*)hymba_fwd, dim3(grid), dim3(NTHR), args, LDS_BYTES, stream);
        if (e != hipSuccess) fprintf(stderr, "kernel_launch: cooperative launch failed: %s (grid %d)\n", hipGetErrorString(e), grid);
    } else {
        for (int p = 0; p < N_PHASES; ++p) { a.ph_lo = p; a.ph_hi = p + 1; hipLaunchKernelGGL(hymba_fwd, dim3(grid), dim3(NTHR), LDS_BYTES, stream, a); }
    }
}
```

```cpp
#include <hip/hip_runtime.h>
#include <hip/hip_cooperative_groups.h>
#include <cstdio>
#include <cstdint>
namespace cg = cooperative_groups;
namespace pg8 {
#define PG8_LAS __attribute__((address_space(3)))
typedef unsigned short bf16_t;
typedef short bf16x8 __attribute__((ext_vector_type(8)));
typedef float f32x4 __attribute__((ext_vector_type(4)));
typedef unsigned u32x4 __attribute__((ext_vector_type(4)));
constexpr int BM = 256, BK = 64, HALF = 128, HTB = HALF * BK * 2  , STAGE_BYTES = 8 * HTB, NXCD = 8, WGM = 8;

__host__ __device__ __forceinline__ int lds_byte(int r, int c) { const int st = (r >> 4) * 2 + (c >> 5), rr = r & 15, cc = c & 31, ob = rr * 64 + cc * 2; return st * 1024 + (ob ^ (((ob >> 9) & 1) << 5)); }
__host__ __device__ __forceinline__ void stage_rc(int b, int& R, int& C) { const int st = b / 1024, sb = b % 1024, swz = sb ^ (((sb >> 9) & 1) << 5); R = (st >> 1) * 16 + swz / 64; C = (st & 1) * 32 + (swz % 64) / 2; }
__host__ __device__ __forceinline__ int perm32(int rho) { const int n = rho >> 4, i = rho & 15; return 8 * (i >> 2) + 4 * n + (i & 3); }

struct Unit { int pm, pn; };
struct Gemm { const bf16_t* A; const bf16_t* Bt; int M, N, K; };

struct StaticOrder {
    int nM, nN, nwg, G, c;
    __host__ __device__ void init(int M, int N, int G_, int c_) { nM = M / BM; nN = N / BM; nwg = nM * nN; G = G_; c = c_; }
    __host__ __device__ bool next(int i, Unit& u) const {
        const long L = (long)i * G + c; if (L >= nwg) return false;
        int wgid = (int)L; { const int q = nwg / NXCD, r = nwg % NXCD, xcd = wgid % NXCD, off = wgid / NXCD; wgid = (xcd < r ? xcd * (q + 1) : r * (q + 1) + (xcd - r) * q) + off; }
        const int nig = WGM * nN, gid = wgid / nig, fm = gid * WGM, gsz = (nM - fm) < WGM ? (nM - fm) : WGM;
        u.pm = fm + ((wgid % nig) % gsz); u.pn = (wgid % nig) / gsz; return true;
    }
    __device__ __forceinline__ void a_ready(const Unit&) const {}
    __device__ __forceinline__ void done(const Unit&) const {}
};

__device__ __forceinline__ unsigned cvt_pk_bf16(float lo, float hi) { unsigned r; asm volatile("v_cvt_pk_bf16_f32 %0, %1, %2" : "=v"(r) : "v"(lo), "v"(hi)); return r; }
typedef float f32x2 __attribute__((ext_vector_type(2)));
__device__ __forceinline__ f32x2 gelu_pk(f32x2 v) {
    const f32x2 av = __builtin_elementwise_abs(v), d = av * 0.2316418882f + 1.0f;
    f32x2 t; t.x = __builtin_amdgcn_rcpf(d.x); t.y = __builtin_amdgcn_rcpf(d.y);
    f32x2 q = t * 0.5307027145f + (-0.7265760135f); q = q * t + 0.7107068705f; q = q * t + (-0.142248368f); q = q * t + 0.127414796f; q = q * t;
    const f32x2 s = (v * v) * (-0.72134752044f);
    f32x2 e; e.x = __builtin_amdgcn_exp2f(s.x); e.y = __builtin_amdgcn_exp2f(s.y);
    const f32x2 m = v * (q * e), r = v - m;
    f32x2 o; o.x = v.x < 0.f ? m.x : r.x; o.y = v.y < 0.f ? m.y : r.y; return o;
}

__device__ __forceinline__ u32x4 pack8(const f32x4 v0, const f32x4 v1) { u32x4 w; w.x = cvt_pk_bf16(v0[0], v0[1]); w.y = cvt_pk_bf16(v0[2], v0[3]); w.z = cvt_pk_bf16(v1[0], v1[1]); w.w = cvt_pk_bf16(v1[2], v1[3]); return w; }

struct EpiPlain {
    static constexpr bool PERM = true, AFTER_DRAIN = false;
    bf16_t* O; int ldc;
    __device__ __forceinline__ void operator()(const f32x4 (&acc)[2][2][4][2], const Unit& u, int wr, int wc, int fr, int fq) const {
        const int row0 = u.pm * BM + wr * 64 + fr, col0 = u.pn * BM + wc * 32 + 8 * fq;
#pragma unroll
        for (int ai = 0; ai < 2; ++ai)
#pragma unroll
            for (int m = 0; m < 4; ++m) { bf16_t* rowp = O + (size_t)(row0 + ai * HALF + m * 16) * ldc + col0;
#pragma unroll
                for (int bj = 0; bj < 2; ++bj) *(u32x4*)(rowp + bj * HALF) = pack8(acc[ai][bj][m][0], acc[ai][bj][m][1]); }
    }
};

struct EpiProj {
    static constexpr bool PERM = true, AFTER_DRAIN = false;
    bf16_t* P; int ldc; float* gates; const int* pos; const float* b_i; const float* b_f;
    __device__ __forceinline__ void operator()(const f32x4 (&acc)[2][2][4][2], const Unit& u, int wr, int wc, int fr, int fq) const {
        const int row0 = u.pm * BM + wr * 64 + fr, col0 = u.pn * BM + wc * 32 + 8 * fq, pn = u.pn;
        if (pn == 9) {
            if (wc == 0 && fq == 0) {
                const f32x4 bi = {b_i[0], b_i[1], b_i[2], b_i[3]}, bf = {b_f[0], b_f[1], b_f[2], b_f[3]};
#pragma unroll
                for (int ai = 0; ai < 2; ++ai)
#pragma unroll
                    for (int m = 0; m < 4; ++m) { const int row = row0 + ai * HALF + m * 16;
                        const f32x4 iv = acc[ai][0][m][0] + bi, fv = acc[ai][0][m][1] + bf; f32x4 lf;
#pragma unroll
                        for (int j = 0; j < 4; ++j) lf[j] = fminf(fv[j], 0.f) - log1pf(__expf(-fabsf(fv[j])));
                        *(f32x4*)(gates + (size_t)row * 8) = iv; *(f32x4*)(gates + (size_t)row * 8 + 4) = lf; }
            }
            return;
        }
#pragma unroll
        for (int ai = 0; ai < 2; ++ai)
#pragma unroll
            for (int m = 0; m < 4; ++m) { const int row = row0 + ai * HALF + m * 16; bf16_t* rowp = P + (size_t)row * ldc + col0;
                const float posf = (pn <= 2) ? (float)pos[row] : 0.f;
#pragma unroll
                for (int bj = 0; bj < 2; ++bj) { f32x4 v0 = acc[ai][bj][m][0], v1 = acc[ai][bj][m][1];
                    const bool rope = (pn < 2) || (pn == 2 && bj == 0);
                    if (rope) {
                        const int p0 = ((col0 + bj * HALF) & 63) >> 1; const float sc = (pn < 2) ? 0.125f : 1.0f;
                        float x[8] = {v0[0], v0[1], v0[2], v0[3], v1[0], v1[1], v1[2], v1[3]};
#pragma unroll
                        for (int q = 0; q < 4; ++q) { const float invf = __builtin_amdgcn_exp2f(-(float)(p0 + q) * 0.41524101186092029f);
                            float r = posf * invf * 0.15915494309189535f; r = r - floorf(r);
                            const float c = __builtin_amdgcn_cosf(r) * sc, s = __builtin_amdgcn_sinf(r) * sc;
                            const float x1 = x[2 * q], x2 = x[2 * q + 1]; x[2 * q] = x1 * c - x2 * s; x[2 * q + 1] = x2 * c + x1 * s; }
                        v0 = (f32x4){x[0], x[1], x[2], x[3]}; v1 = (f32x4){x[4], x[5], x[6], x[7]};
                    } else if (pn >= 7) {
#pragma unroll
                        for (int j = 0; j < 4; ++j) { v0[j] = __builtin_amdgcn_rcpf(1.f + __expf(-v0[j])); v1[j] = __builtin_amdgcn_rcpf(1.f + __expf(-v1[j])); }
                    }
                    *(u32x4*)(rowp + bj * HALF) = pack8(v0, v1); } }
    }
};

struct EpiMix {
    static constexpr bool PERM = true, AFTER_DRAIN = false;
    bf16_t* O; int ldc; float* sumsq;
    __device__ __forceinline__ void operator()(const f32x4 (&acc)[2][2][4][2], const Unit& u, int wr, int wc, int fr, int fq) const {
        const int row0 = u.pm * BM + wr * 64 + fr, col0 = u.pn * BM + wc * 32 + 8 * fq;
#pragma unroll
        for (int ai = 0; ai < 2; ++ai)
#pragma unroll
            for (int m = 0; m < 4; ++m) { const int row = row0 + ai * HALF + m * 16; bf16_t* rowp = O + (size_t)row * ldc + col0; float s = 0.f;
#pragma unroll
                for (int bj = 0; bj < 2; ++bj) { const f32x4 v0 = acc[ai][bj][m][0], v1 = acc[ai][bj][m][1];
                    s += (v0[0] * v0[0] + v0[1] * v0[1]) + (v0[2] * v0[2] + v0[3] * v0[3]) + (v1[0] * v1[0] + v1[1] * v1[1]) + (v1[2] * v1[2] + v1[3] * v1[3]);
                    *(u32x4*)(rowp + bj * HALF) = pack8(v0, v1); }
                s += __shfl_xor(s, 16); s += __shfl_xor(s, 32);
                if (fq == 0) sumsq[(size_t)row * 16 + u.pn * 4 + wc] = s; }
    }
};
template <class Epi, class Sched, bool ALIGN_EPI = false, bool SP2 = false>
__device__ __forceinline__ void gemm_phase(PG8_LAS unsigned char* lds, const Gemm g, const Sched& S, const Epi& E) {
    const int tid = threadIdx.x, wid = __builtin_amdgcn_readfirstlane(tid >> 6), lane = tid & 63, wr = wid >> 2, wc = wid & 3, fr = lane & 15, fq = lane >> 4;
    const int K = g.K, nt = K / BK;
    unsigned voffA[2], voffB[2];
#pragma unroll
    for (int i = 0; i < 2; ++i) { int R, C; stage_rc(tid * 16 + i * 8192, R, C); const int Rb = Epi::PERM ? ((R & ~31) + perm32(R & 31)) : R;
        voffA[i] = (unsigned)(R * K + C) * 2u; voffB[i] = (unsigned)(Rb * K + C) * 2u; }
    const size_t kstep = (size_t)(BK * 2);
    const size_t hstep = (size_t)HALF * K * 2;
    const size_t tstep = 2 * hstep;
    const unsigned ldsw = (unsigned)wid * 1024u;
    const int aoff = lds_byte(wr * 64 + fr, fq * 8), boff = lds_byte(wc * 32 + fr, fq * 8);
#define PG8_SA(b, h) (((b) * 2 + (h)) * HTB)
#define PG8_SB(b, h) ((4 + (b) * 2 + (h)) * HTB)
#define PG8_STAGE(bufoff, gbase, voff) do { _Pragma("unroll") for (int _i = 0; _i < 2; ++_i) \
        __builtin_amdgcn_global_load_lds((const unsigned*)((const char*)(gbase) + (voff)[_i]), (PG8_LAS unsigned*)(lds + (bufoff) + ldsw + _i * 8192), 16, 0, 0); } while (0)
#define PG8_LDA(dst, b, h) do { _Pragma("unroll") for (int m = 0; m < 4; ++m) _Pragma("unroll") for (int k = 0; k < 2; ++k) dst[m][k] = *(const PG8_LAS bf16x8*)(lds + PG8_SA(b, h) + aoff + m * 2048 + k * 1024); } while (0)
#define PG8_LDB(dst, b, h) do { _Pragma("unroll") for (int n = 0; n < 2; ++n) _Pragma("unroll") for (int k = 0; k < 2; ++k) dst[n][k] = *(const PG8_LAS bf16x8*)(lds + PG8_SB(b, h) + boff + n * 2048 + k * 1024); } while (0)
#define PG8_MMA(ai, bj, At, Bt) do { __builtin_amdgcn_s_setprio(1); _Pragma("unroll") for (int m = 0; m < 4; ++m) _Pragma("unroll") for (int n = 0; n < 2; ++n) _Pragma("unroll") for (int k = 0; k < 2; ++k) \
        acc[ai][bj][m][n] = __builtin_amdgcn_mfma_f32_16x16x32_bf16(Bt[n][k], At[m][k], acc[ai][bj][m][n], 0, 0, 0); __builtin_amdgcn_s_setprio(0); } while (0)
#define PG8_WAIT_V(n) asm volatile("s_waitcnt vmcnt(" #n ")" ::: "memory")
#define PG8_WAIT_L(n) asm volatile("s_waitcnt lgkmcnt(" #n ")" ::: "memory")
#define PG8_BAR __builtin_amdgcn_s_barrier()
#define PG8_SCHED __builtin_amdgcn_sched_barrier(0)
    Unit cur, nxt; int ui = 0;
    if (!S.next(0, cur)) return;
    f32x4 acc[2][2][4][2];
#pragma unroll
    for (int a = 0; a < 2; ++a)
#pragma unroll
        for (int b = 0; b < 2; ++b)
#pragma unroll
            for (int m = 0; m < 4; ++m)
#pragma unroll
                for (int n = 0; n < 2; ++n) acc[a][b][m][n] = (f32x4){0.f, 0.f, 0.f, 0.f};
    bf16x8 At[4][2], B0[2][2], B1[2][2];
    const char* cA = (const char*)g.A + (size_t)cur.pm * tstep; const char* cB = (const char*)g.Bt + (size_t)cur.pn * tstep;
    S.a_ready(cur);
    if constexpr (SP2) {
        PG8_STAGE(PG8_SB(0, 0), cB, voffB); PG8_STAGE(PG8_SB(0, 1), cB + hstep, voffB); PG8_STAGE(PG8_SA(0, 0), cA, voffA); PG8_STAGE(PG8_SA(0, 1), cA + hstep, voffA);
        if (wr == 1) PG8_BAR;
        PG8_WAIT_V(2); PG8_BAR;
        PG8_STAGE(PG8_SB(1, 0), cB + kstep, voffB); PG8_STAGE(PG8_SA(1, 0), cA + kstep, voffA); PG8_STAGE(PG8_SB(1, 1), cB + hstep + kstep, voffB);
        PG8_WAIT_V(6); PG8_BAR;
    } else {
        PG8_STAGE(PG8_SB(0, 0), cB, voffB); PG8_STAGE(PG8_SA(0, 0), cA, voffA); PG8_STAGE(PG8_SB(0, 1), cB + hstep, voffB); PG8_STAGE(PG8_SA(0, 1), cA + hstep, voffA);
        if (wr == 1) PG8_BAR;
        PG8_WAIT_V(4); PG8_BAR;
        PG8_STAGE(PG8_SB(1, 0), cB + kstep, voffB); PG8_STAGE(PG8_SA(1, 0), cA + kstep, voffA); PG8_STAGE(PG8_SB(1, 1), cB + hstep + kstep, voffB);
        PG8_WAIT_V(6); PG8_BAR;
    }
    for (;;) {
        const bool has_next = S.next(ui + 1, nxt);
        const char* nA = has_next ? (const char*)g.A + (size_t)nxt.pm * tstep : cA; const char* nB = has_next ? (const char*)g.Bt + (size_t)nxt.pn * tstep : cB;
        for (int t = 0; t < nt; t += 2) {
            const bool last = (t == nt - 2);
            const char* a1 = cA + (size_t)(t + 1) * kstep;
            const char* a2 = last ? nA : cA + (size_t)(t + 2) * kstep; const char* b2 = last ? nB : cB + (size_t)(t + 2) * kstep;
            const char* a3 = a2 + kstep; const char* b3 = b2 + kstep;
            if (last && has_next) S.a_ready(nxt);
            if constexpr (SP2) {
            PG8_LDB(B0, 0, 0); PG8_LDB(B1, 0, 1); PG8_SCHED; PG8_LDA(At, 0, 0); PG8_STAGE(PG8_SA(1, 1), a1 + hstep, voffA);
            PG8_WAIT_V(8); PG8_WAIT_L(0); PG8_BAR; PG8_MMA(0, 0, At, B0); PG8_MMA(0, 1, At, B1); PG8_BAR; PG8_SCHED;
            PG8_LDA(At, 0, 1); PG8_STAGE(PG8_SB(0, 0), b2, voffB); PG8_STAGE(PG8_SB(0, 1), b2 + hstep, voffB); PG8_STAGE(PG8_SA(0, 0), a2, voffA);
            PG8_WAIT_V(8); PG8_WAIT_L(0); PG8_BAR; PG8_MMA(1, 0, At, B0); PG8_MMA(1, 1, At, B1); PG8_BAR; PG8_SCHED;
            PG8_LDB(B0, 1, 0); PG8_LDB(B1, 1, 1); PG8_SCHED; PG8_LDA(At, 1, 0); PG8_STAGE(PG8_SA(0, 1), a2 + hstep, voffA);
            PG8_WAIT_V(8); PG8_WAIT_L(0); PG8_BAR; PG8_MMA(0, 0, At, B0); PG8_MMA(0, 1, At, B1); PG8_BAR; PG8_SCHED;
            PG8_LDA(At, 1, 1); PG8_STAGE(PG8_SB(1, 0), b3, voffB); PG8_STAGE(PG8_SB(1, 1), b3 + hstep, voffB); PG8_STAGE(PG8_SA(1, 0), a3, voffA);
            PG8_WAIT_V(8); PG8_WAIT_L(0); PG8_BAR; PG8_MMA(1, 0, At, B0); PG8_MMA(1, 1, At, B1); PG8_BAR; PG8_SCHED;
            } else {
            PG8_LDB(B0, 0, 0); PG8_SCHED; PG8_LDA(At, 0, 0); PG8_STAGE(PG8_SA(1, 1), a1 + hstep, voffA);
            PG8_WAIT_L(8); PG8_BAR; PG8_WAIT_L(0); PG8_MMA(0, 0, At, B0); PG8_BAR; PG8_SCHED;
            PG8_LDB(B1, 0, 1); PG8_STAGE(PG8_SB(0, 0), b2, voffB);
            PG8_BAR; PG8_WAIT_L(0); PG8_MMA(0, 1, At, B1); PG8_BAR;
            PG8_LDA(At, 0, 1); PG8_STAGE(PG8_SA(0, 0), a2, voffA);
            PG8_BAR; PG8_WAIT_L(0); PG8_MMA(1, 0, At, B0); PG8_BAR; PG8_SCHED;
            PG8_STAGE(PG8_SB(0, 1), b2 + hstep, voffB);
            PG8_WAIT_V(6); PG8_BAR; PG8_MMA(1, 1, At, B1); PG8_BAR;
            PG8_LDB(B0, 1, 0); PG8_SCHED; PG8_LDA(At, 1, 0); PG8_STAGE(PG8_SA(0, 1), a2 + hstep, voffA);
            PG8_WAIT_L(8); PG8_BAR; PG8_WAIT_L(0); PG8_MMA(0, 0, At, B0); PG8_BAR; PG8_SCHED;
            PG8_LDB(B1, 1, 1); PG8_STAGE(PG8_SB(1, 0), b3, voffB);
            PG8_BAR; PG8_WAIT_L(0); PG8_MMA(0, 1, At, B1); PG8_BAR;
            PG8_LDA(At, 1, 1); PG8_STAGE(PG8_SA(1, 0), a3, voffA);
            PG8_BAR; PG8_WAIT_L(0); PG8_MMA(1, 0, At, B0); PG8_BAR; PG8_SCHED;
            PG8_STAGE(PG8_SB(1, 1), b3 + hstep, voffB);
            PG8_WAIT_V(6); PG8_BAR; PG8_MMA(1, 1, At, B1); PG8_BAR;
            }
        }
        if constexpr (ALIGN_EPI) { if (wr == 0) PG8_BAR; }
        if constexpr (!Epi::AFTER_DRAIN) { E(acc, cur, wr, wc, fr, fq); S.done(cur); }
        if (!has_next) break;
#pragma unroll
        for (int a = 0; a < 2; ++a)
#pragma unroll
            for (int b = 0; b < 2; ++b)
#pragma unroll
                for (int m = 0; m < 4; ++m)
#pragma unroll
                    for (int n = 0; n < 2; ++n) acc[a][b][m][n] = (f32x4){0.f, 0.f, 0.f, 0.f};
        cur = nxt; cA = nA; cB = nB; ++ui;
        if constexpr (ALIGN_EPI) { if (wr == 1) PG8_BAR; }
    }
    PG8_WAIT_V(0);
    if constexpr (!ALIGN_EPI) { if (wr == 0) PG8_BAR; }
    PG8_BAR;
    if constexpr (Epi::AFTER_DRAIN) { E.fused(acc, cur, wr, wc, fr, fq, lds, wid, lane); S.done(cur); }
#undef PG8_SA
#undef PG8_SB
#undef PG8_STAGE
#undef PG8_LDA
#undef PG8_LDB
#undef PG8_MMA
#undef PG8_WAIT_V
#undef PG8_WAIT_L
#undef PG8_BAR
#undef PG8_SCHED
}
}
constexpr int NB = 8, SEQ = 8192, D = 1024, M = NB * SEQ;
constexpr int DIN = 2312, NPROJ = 2304, NIN_PAD = 2560;
constexpr int C_AQ = 0, C_AK = 512, C_AV = 640, C_MQ = 768, C_MK = 1024, C_MV = 1280, C_MO = 1792;
constexpr int NEXP = 16384, NSLOT = 128;
constexpr float EPS = 1e-6f;
constexpr int NWAVES = 8, NTHR = 512;

constexpr size_t MiB = 1u << 20;
constexpr size_t WS_CTL = 0, CTL_ZERO_BYTES = 1 * MiB;
constexpr size_t WS_MOD = 1 * MiB;
constexpr size_t WS_WIN = 2 * MiB;
constexpr size_t WS_WOUT = 8 * MiB;
constexpr size_t WS_WQ = 10 * MiB;
constexpr size_t WS_KEYS = 14 * MiB;
constexpr size_t WS_GATES = 16 * MiB;
constexpr size_t WS_SSQ = 832 * MiB;
constexpr size_t WS_MST = 20 * MiB;
constexpr size_t WS_U8 = 32 * MiB, WS_V8 = 48 * MiB;
constexpr size_t WS_SC = 64 * MiB;
constexpr size_t WS_H = 96 * MiB;
constexpr size_t WS_PROJ = 224 * MiB;
constexpr size_t WS_MIXIN = 512 * MiB;
constexpr size_t WS_MIX = 640 * MiB;
constexpr size_t WS_EIDX = 768 * MiB, WS_GATE = 800 * MiB;
constexpr size_t WS_PD = 512 * MiB;
constexpr size_t WS_ACT = 840 * MiB;
constexpr size_t WS_SSY = 872 * MiB;
constexpr size_t WS_END = 876 * MiB;
constexpr int CW_BAR = 4096;
constexpr int CW_SUMSQ = 65536;
static_assert((CW_SUMSQ + M) * 4 <= (int)CTL_ZERO_BYTES, "ctl");

constexpr int RING_BYTES = 131072, MISC_OFF = RING_BYTES + 320, LDS_BYTES = 147456;

#define GAS __attribute__((address_space(1)))
#define LAS __attribute__((address_space(3)))
typedef unsigned short bf16;
typedef unsigned v4u __attribute__((ext_vector_type(4)));
typedef unsigned v2u __attribute__((ext_vector_type(2)));
typedef float f32x4 __attribute__((ext_vector_type(4)));
typedef GAS unsigned gu32;
#define LDS_WAIT() asm volatile("s_waitcnt lgkmcnt(0)" ::: "memory")
#define VM_WAIT() asm volatile("s_waitcnt vmcnt(0)" ::: "memory")
__device__ __forceinline__ unsigned f2bf(float f) { unsigned u = __builtin_bit_cast(unsigned, f); return (u + 0x7fffu + ((u >> 16) & 1u)) >> 16; }
__device__ __forceinline__ unsigned pk2(float lo, float hi) { return f2bf(lo) | (f2bf(hi) << 16); }
__device__ __forceinline__ float bflo(unsigned w) { return __builtin_bit_cast(float, w << 16); }
__device__ __forceinline__ float bfhi(unsigned w) { return __builtin_bit_cast(float, w & 0xffff0000u); }
__device__ __forceinline__ float bf1(bf16 h) { return __builtin_bit_cast(float, (unsigned)h << 16); }
__device__ __forceinline__ float wave_sum(float v) {
#pragma unroll
    for (int o = 1; o < 64; o <<= 1) v += __shfl_xor(v, o);
    return v;
}
__device__ __forceinline__ float wave_max(float v) {
#pragma unroll
    for (int o = 1; o < 64; o <<= 1) v = fmaxf(v, __shfl_xor(v, o));
    return v;
}

typedef float f32x2 __attribute__((ext_vector_type(2)));
__device__ __forceinline__ void cvt16_fp8(const v4u w, float (&o)[16]) {
    const unsigned ww[4] = {w.x, w.y, w.z, w.w};
#pragma unroll
    for (int i = 0; i < 4; ++i) { const f32x2 a = __builtin_amdgcn_cvt_pk_f32_fp8((int)ww[i], false), b = __builtin_amdgcn_cvt_pk_f32_fp8((int)ww[i], true);
        o[4 * i] = a.x; o[4 * i + 1] = a.y; o[4 * i + 2] = b.x; o[4 * i + 3] = b.y; }
}
__device__ __forceinline__ void p0_row_fp8(const float* src, unsigned char* dst, float* sc, int row, int lane) {
    const GAS f32x4* sp = (const GAS f32x4*)(src + (size_t)row * D + 16 * lane);
    const f32x4 a = sp[0], b = sp[1], c = sp[2], d = sp[3];
    float mx = 0.f;
#pragma unroll
    for (int i = 0; i < 4; ++i) mx = fmaxf(fmaxf(fmaxf(mx, fabsf(a[i])), fmaxf(fabsf(b[i]), fabsf(c[i]))), fabsf(d[i]));
    mx = wave_max(mx); const float s = mx > 0.f ? 224.0f / mx : 1.0f;
    v4u o; int w;
    w = __builtin_amdgcn_cvt_pk_fp8_f32(a[0] * s, a[1] * s, 0, false); w = __builtin_amdgcn_cvt_pk_fp8_f32(a[2] * s, a[3] * s, w, true); o.x = (unsigned)w;
    w = __builtin_amdgcn_cvt_pk_fp8_f32(b[0] * s, b[1] * s, 0, false); w = __builtin_amdgcn_cvt_pk_fp8_f32(b[2] * s, b[3] * s, w, true); o.y = (unsigned)w;
    w = __builtin_amdgcn_cvt_pk_fp8_f32(c[0] * s, c[1] * s, 0, false); w = __builtin_amdgcn_cvt_pk_fp8_f32(c[2] * s, c[3] * s, w, true); o.z = (unsigned)w;
    w = __builtin_amdgcn_cvt_pk_fp8_f32(d[0] * s, d[1] * s, 0, false); w = __builtin_amdgcn_cvt_pk_fp8_f32(d[2] * s, d[3] * s, w, true); o.w = (unsigned)w;
    *(GAS v4u*)(dst + (size_t)row * D + 16 * lane) = o;
    if (lane == 0) sc[row] = mx > 0.f ? mx * (1.0f / 224.0f) : 1.0f;
}
#define XB_TMO      128
#define XB_XCNT(j)  (256  + 64 * (j))
#define XB_XSUB(j)  (1280 + 64 * (j))
#define XB_XGEN(j)  (2304 + 64 * (j))
#define XB_TOP      3328
#define XB_TOPGEN   3392
#define XCD_BAR_WORDS 3456
#define XB_SPIN_CAP (1u << 18)

__device__ __forceinline__ unsigned xb_ld(unsigned* p)              { return __hip_atomic_load(p, __ATOMIC_RELAXED, __HIP_MEMORY_SCOPE_AGENT); }
__device__ __forceinline__ unsigned xb_add(unsigned* p, unsigned v) { return __hip_atomic_fetch_add(p, v, __ATOMIC_RELAXED, __HIP_MEMORY_SCOPE_AGENT); }
__device__ __forceinline__ unsigned xb_xcc_id() { return (unsigned)__builtin_amdgcn_s_getreg((3 << 11) | 20) & 0xFu; }
#define XB_SPIN(cond, bar) do { unsigned _sp = 0; while (cond) { __builtin_amdgcn_s_sleep(1); \
    if ((++_sp & 255u) == 0u) { if (xb_ld(&(bar)[XB_TMO])) break; if (_sp > XB_SPIN_CAP) { atomicAdd(&(bar)[XB_TMO], 1u); break; } } } } while (0)

struct XcdBarrier {
    unsigned* bar; unsigned x;
    volatile LAS unsigned* st;
};

__device__ __forceinline__ XcdBarrier xcd_barrier_post(unsigned* bar, volatile LAS unsigned* st) {
    XcdBarrier b; b.bar = bar; b.x = xb_xcc_id(); b.st = st;
    if (threadIdx.x == 0) (void)xb_add(&bar[XB_XCNT(b.x)], 1u);
    return b;
}
__device__ __forceinline__ void xcd_barrier_complete(unsigned* bar, unsigned x, unsigned& nloc, unsigned& nx) {
    const unsigned G = gridDim.x * gridDim.y * gridDim.z;
    unsigned sum, cnt, mine, sp = 0u;
    for (;;) {
        sum = 0u; cnt = 0u; mine = 0u;
#pragma unroll
        for (unsigned j = 0; j < 16; ++j) { const unsigned c = xb_ld(&bar[XB_XCNT(j)]); sum += c; cnt += (c > 0u) ? 1u : 0u; mine = (j == x) ? c : mine; }
        if (sum == G) break;
        __builtin_amdgcn_s_sleep(1);
        if ((++sp & 255u) == 0u) { if (xb_ld(&bar[XB_TMO])) break; if (sp > XB_SPIN_CAP) { atomicAdd(&bar[XB_TMO], 1u); break; } }
    }
    nloc = mine > 0u ? mine : 1u; nx = cnt > 0u ? cnt : 1u;
}

__device__ __forceinline__ void xcd_barrier(const XcdBarrier& b) {
    asm volatile("s_waitcnt vmcnt(0)" ::: "memory");
    __syncthreads();
    if (threadIdx.x == 0) {
        unsigned* bar = b.bar;
        __builtin_amdgcn_s_waitcnt(0);
        unsigned nloc = b.st[0], nx = b.st[1];
        if (nloc == 0u) { xcd_barrier_complete(bar, b.x, nloc, nx); b.st[0] = nloc; b.st[1] = nx; }
        const unsigned old = xb_add(&bar[XB_XSUB(b.x)], 1u);
        const unsigned gen = old / nloc;
        if (old + 1u == (gen + 1u) * nloc) {
            __builtin_amdgcn_fence(__ATOMIC_RELEASE, "agent");
            asm volatile("s_waitcnt vmcnt(0)" ::: "memory");
            const unsigned og = xb_add(&bar[XB_TOP], 1u);
            const unsigned tg = og / nx;
            if (og + 1u == (tg + 1u) * nx) xb_add(&bar[XB_TOPGEN], 1u);
            else XB_SPIN(xb_ld(&bar[XB_TOPGEN]) == tg, bar);
            __builtin_amdgcn_fence(__ATOMIC_ACQUIRE, "agent");
            xb_add(&bar[XB_XGEN(b.x)], 1u);
            asm volatile("s_waitcnt vmcnt(0)" ::: "memory");
        } else {
            XB_SPIN(xb_ld(&bar[XB_XGEN(b.x)]) == gen, bar);
            __builtin_amdgcn_fence(__ATOMIC_ACQUIRE, "agent");
            asm volatile("s_waitcnt vmcnt(0)" ::: "memory");
        }
    }
    __syncthreads();
}
struct Args { const void* in[21]; float* out; unsigned char* ws; int ph_lo, ph_hi; };
enum { I_X = 0, I_C, I_POS, I_WMOD, I_BMOD, I_GPRE1, I_GPOST1, I_WIN, I_CONVW, I_BI, I_BF, I_MNG, I_SINK, I_WOUT, I_GPRE2, I_GPOST2, I_WQ, I_K1, I_K2, I_U, I_V };

__device__ __forceinline__ int newcol(int o) {
    if (o < 640) { const int hd = o >> 6, d = o & 63; return (hd << 6) + 2 * (d & 31) + (d >> 5); }
    if (o < 1792) return o;
    if (o < 1800) return 2304 + (o - 1792);
    return o - 8;
}
template <bool REMAP>
__device__ __forceinline__ void p0_transpose_item(const float* W, int K, int N, bf16* WT, LAS float* scr, int item, int lane) {
    const int nblk = (N + 31) / 32, kb = item / nblk, nb = item % nblk, k0 = 64 * kb, n0 = 32 * nb;
    const int ncol = n0 + (lane & 31);
#pragma unroll 8
    for (int i = 0; i < 32; ++i) { const int kk = 2 * i + (lane >> 5); scr[kk * 33 + (lane & 31)] = (ncol < N) ? W[(size_t)(k0 + kk) * N + ncol] : 0.f; }
    LDS_WAIT(); asm volatile("" ::: "memory");
    const int c = lane & 7;
#pragma unroll
    for (int j = 0; j < 4; ++j) { const int n = (lane >> 3) + 8 * j; const LAS float* s = scr + (8 * c) * 33 + n;
        v4u o; o.x = pk2(s[0 * 33], s[1 * 33]); o.y = pk2(s[2 * 33], s[3 * 33]); o.z = pk2(s[4 * 33], s[5 * 33]); o.w = pk2(s[6 * 33], s[7 * 33]);
        if (n0 + n < N) { const int drow = REMAP ? newcol(n0 + n) : (n0 + n); *(GAS v4u*)(WT + (size_t)drow * K + k0 + 8 * c) = o; } }
    LDS_WAIT(); asm volatile("" ::: "memory");
}
__device__ __forceinline__ void p0_convert(const float* src, bf16* dst, size_t n, int gt, int ngt) {
    for (size_t i = (size_t)gt * 8; i < n; i += (size_t)ngt * 8) {
        const f32x4 a = *(const GAS f32x4*)(src + i), b = *(const GAS f32x4*)(src + i + 4);
        v4u o; o.x = pk2(a[0], a[1]); o.y = pk2(a[2], a[3]); o.z = pk2(b[0], b[1]); o.w = pk2(b[2], b[3]);
        *(GAS v4u*)(dst + i) = o; }
}
__device__ __forceinline__ void phase_prologue(const Args& A, LAS unsigned char* lds) {
    const int tid = threadIdx.x, lane = tid & 63, wave = tid >> 6, G = gridDim.x, blk = blockIdx.x;
    unsigned char* ws = A.ws;
    {
        const float* c = (const float*)A.in[I_C]; const float* wm = (const float*)A.in[I_WMOD]; const float* bm = (const float*)A.in[I_BMOD];
        float* mod = (float*)(ws + WS_MOD); LAS float* red = (LAS float*)lds;
        for (int it = blk; it < 6144 / 32; it += G) {
            const int kg = tid >> 5, col = tid & 31, j = it * 32 + col; float acc[8];
#pragma unroll
            for (int b = 0; b < 8; ++b) acc[b] = 0.f;
            for (int i = 0; i < 64; ++i) { const int k = kg + 16 * i; const float w = wm[(size_t)k * 6144 + j];
#pragma unroll
                for (int b = 0; b < 8; ++b) acc[b] += c[b * 1024 + k] * w; }
#pragma unroll
            for (int b = 0; b < 8; ++b) red[(kg * 32 + col) * 8 + b] = acc[b];
            __syncthreads();
            if (tid < 256) { const int b = tid >> 5, cc = tid & 31; float s = 0.f;
#pragma unroll
                for (int g = 0; g < 16; ++g) s += red[(g * 32 + cc) * 8 + b];
                mod[b * 6144 + it * 32 + cc] = s + bm[it * 32 + cc]; }
            __syncthreads();
        }
    }
    {
        LAS float* scr = (LAS float*)(lds + wave * 16384);
        const int gw = blk * NWAVES + wave, NGW = G * NWAVES;
        const int I_IN = (D / 64) * ((DIN + 31) / 32), I_OUT = (D / 64) * (D / 32), I_Q = (D / 64) * (2048 / 32);
        bf16* win = (bf16*)(ws + WS_WIN); bf16* wout = (bf16*)(ws + WS_WOUT); bf16* wq = (bf16*)(ws + WS_WQ);
        for (int it = gw; it < I_IN + I_OUT + I_Q; it += NGW) {
            int r = it;
            if (r < I_IN) { p0_transpose_item<true>((const float*)A.in[I_WIN], D, DIN, win, scr, r, lane); continue; } r -= I_IN;
            if (r < I_OUT) { p0_transpose_item<false>((const float*)A.in[I_WOUT], D, D, wout, scr, r, lane); continue; } r -= I_OUT;
            p0_transpose_item<false>((const float*)A.in[I_WQ], D, 2048, wq, scr, r, lane);
        }
        const int gt = blk * NTHR + tid, ngt = G * NTHR;
        for (int i = gt; i < (NIN_PAD - DIN) * D / 8; i += ngt) *(GAS v4u*)(win + (size_t)DIN * D + (size_t)i * 8) = (v4u){0u, 0u, 0u, 0u};
        p0_convert((const float*)A.in[I_K1], (bf16*)(ws + WS_KEYS), (size_t)8 * 128 * 128, gt, ngt);
        p0_convert((const float*)A.in[I_K2], (bf16*)(ws + WS_KEYS) + 8 * 128 * 128, (size_t)8 * 128 * 128, gt, ngt);
        for (int r = gw; r < 2 * NEXP; r += NGW) { if (r < NEXP) p0_row_fp8((const float*)A.in[I_U], ws + WS_U8, (float*)(ws + WS_SC), r, lane); else p0_row_fp8((const float*)A.in[I_V], ws + WS_V8, (float*)(ws + WS_SC) + NEXP, r - NEXP, lane); }
    }
}

__device__ __forceinline__ void phase_prenorm(const Args& A) {
    const int tid = threadIdx.x, lane = tid & 63, wave = tid >> 6, G = gridDim.x;
    const float* x = (const float*)A.in[I_X]; const float* g = (const float*)A.in[I_GPRE1]; const float* mod = (const float*)(A.ws + WS_MOD);
    bf16* H = (bf16*)(A.ws + WS_H);
    for (int row = blockIdx.x * NWAVES + wave; row < M; row += G * NWAVES) {
        const int b = row / SEQ; const GAS f32x4* xr = (const GAS f32x4*)(x + (size_t)row * D) + lane;
        f32x4 v[4]; float s = 0.f;
#pragma unroll
        for (int j = 0; j < 4; ++j) { v[j] = xr[64 * j]; s += (v[j][0] * v[j][0] + v[j][1] * v[j][1]) + (v[j][2] * v[j][2] + v[j][3] * v[j][3]); }
        const float rstd = 1.0f / sqrtf(wave_sum(s) * (1.f / D) + EPS);
        GAS v2u* o = (GAS v2u*)(H + (size_t)row * D) + lane;
#pragma unroll
        for (int j = 0; j < 4; ++j) { const int k = 4 * (lane + 64 * j);
            const f32x4 gg = *(const GAS f32x4*)(g + k), sh = *(const GAS f32x4*)(mod + b * 6144 + k), sc = *(const GAS f32x4*)(mod + b * 6144 + 1024 + k);
            f32x4 y;
#pragma unroll
            for (int i = 0; i < 4; ++i) y[i] = v[j][i] * rstd * gg[i] * (1.f + sc[i]) + sh[i];
            v2u w; w.x = pk2(y[0], y[1]); w.y = pk2(y[2], y[3]); o[64 * j] = w; }
    }
}

__device__ __forceinline__ void phase_mid(const Args& A) {
    const int tid = threadIdx.x, lane = tid & 63, wave = tid >> 6, G = gridDim.x;
    const float* x = (const float*)A.in[I_X]; const float* gpost = (const float*)A.in[I_GPOST1]; const float* gpre = (const float*)A.in[I_GPRE2];
    const float* mod = (const float*)(A.ws + WS_MOD); const float* sumsq = (const float*)(A.ws + WS_SSQ);
    const bf16* MIX = (const bf16*)(A.ws + WS_MIX); bf16* H = (bf16*)(A.ws + WS_H); float* out = A.out;
    for (int row = blockIdx.x * NWAVES + wave; row < M; row += G * NWAVES) {
        const int b = row / SEQ; const GAS f32x4* xr = (const GAS f32x4*)(x + (size_t)row * D) + lane; const GAS v2u* mr = (const GAS v2u*)(MIX + (size_t)row * D) + lane;
        const f32x4 q0 = *(const GAS f32x4*)(sumsq + (size_t)row * 16), q1 = *(const GAS f32x4*)(sumsq + (size_t)row * 16 + 4), q2 = *(const GAS f32x4*)(sumsq + (size_t)row * 16 + 8), q3 = *(const GAS f32x4*)(sumsq + (size_t)row * 16 + 12);
        const float rm = 1.0f / sqrtf(((((q0[0] + q0[1]) + (q0[2] + q0[3])) + ((q1[0] + q1[1]) + (q1[2] + q1[3]))) + (((q2[0] + q2[1]) + (q2[2] + q2[3])) + ((q3[0] + q3[1]) + (q3[2] + q3[3])))) * (1.f / D) + EPS);
        f32x4 v[4]; float s = 0.f;
#pragma unroll
        for (int j = 0; j < 4; ++j) { const int k = 4 * (lane + 64 * j); const f32x4 xv = xr[64 * j]; const v2u mw = mr[64 * j];
            const f32x4 gp = *(const GAS f32x4*)(gpost + k), g1 = *(const GAS f32x4*)(mod + b * 6144 + 2048 + k);
            const float mx[4] = {bflo(mw.x), bfhi(mw.x), bflo(mw.y), bfhi(mw.y)};
#pragma unroll
            for (int i = 0; i < 4; ++i) { v[j][i] = xv[i] + g1[i] * (mx[i] * rm * gp[i]); s += v[j][i] * v[j][i]; }
            *((GAS f32x4*)(out + (size_t)row * D) + lane + 64 * j) = v[j]; }
        const float rstd = 1.0f / sqrtf(wave_sum(s) * (1.f / D) + EPS);
        GAS v2u* o = (GAS v2u*)(H + (size_t)row * D) + lane;
#pragma unroll
        for (int j = 0; j < 4; ++j) { const int k = 4 * (lane + 64 * j);
            const f32x4 gg = *(const GAS f32x4*)(gpre + k), sh = *(const GAS f32x4*)(mod + b * 6144 + 3072 + k), sc = *(const GAS f32x4*)(mod + b * 6144 + 4096 + k);
            f32x4 y;
#pragma unroll
            for (int i = 0; i < 4; ++i) y[i] = v[j][i] * rstd * gg[i] * (1.f + sc[i]) + sh[i];
            v2u w; w.x = pk2(y[0], y[1]); w.y = pk2(y[2], y[3]); o[64 * j] = w; }
    }
}
__device__ __forceinline__ void load64bf(const bf16* p, float (&o)[64]) {
#pragma unroll
    for (int i = 0; i < 8; ++i) { const v4u w = *(const GAS v4u*)(p + 8 * i);
        o[8 * i + 0] = bflo(w.x); o[8 * i + 1] = bfhi(w.x); o[8 * i + 2] = bflo(w.y); o[8 * i + 3] = bfhi(w.y);
        o[8 * i + 4] = bflo(w.z); o[8 * i + 5] = bfhi(w.z); o[8 * i + 6] = bflo(w.w); o[8 * i + 7] = bfhi(w.w); }
}
__device__ __forceinline__ void phase_attn_naive(const Args& A, int vb, int nvb) {
    const bf16* P = (const bf16*)(A.ws + WS_PROJ); bf16* MI = (bf16*)(A.ws + WS_MIXIN); const float* sinks = (const float*)A.in[I_SINK];
    for (int task = vb * NTHR + (int)threadIdx.x; task < 8 * M; task += nvb * NTHR) {
        const int h = task / M, t = task % M, s = t % SEQ, kvh = h >> 2;
        float q[64], o[64];
        load64bf(P + (size_t)t * NPROJ + C_AQ + h * 64, q);
#pragma unroll
        for (int d = 0; d < 64; ++d) o[d] = 0.f;
        float mx = sinks[h], l = 1.f;
        for (int j = 0; j < 128; ++j) {
            const int sj = s - 127 + j; const bool valid = sj >= 0; const int tk = valid ? (t - 127 + j) : t;
            const bf16* kr = P + (size_t)tk * NPROJ + C_AK + kvh * 64; float sc = 0.f;
#pragma unroll
            for (int i = 0; i < 8; ++i) { const v4u w = *(const GAS v4u*)(kr + 8 * i);
                sc += q[8 * i + 0] * bflo(w.x) + q[8 * i + 1] * bfhi(w.x) + q[8 * i + 2] * bflo(w.y) + q[8 * i + 3] * bfhi(w.y)
                    + q[8 * i + 4] * bflo(w.z) + q[8 * i + 5] * bfhi(w.z) + q[8 * i + 6] * bflo(w.w) + q[8 * i + 7] * bfhi(w.w); }
            if (valid) {
                const float mn = fmaxf(mx, sc), al = __expf(mx - mn), p = __expf(sc - mn); mx = mn; l = l * al + p;
                const bf16* vr = P + (size_t)tk * NPROJ + C_AV + kvh * 64;
#pragma unroll
                for (int i = 0; i < 8; ++i) { const v4u w = *(const GAS v4u*)(vr + 8 * i);
                    o[8 * i + 0] = o[8 * i + 0] * al + p * bflo(w.x); o[8 * i + 1] = o[8 * i + 1] * al + p * bfhi(w.x);
                    o[8 * i + 2] = o[8 * i + 2] * al + p * bflo(w.y); o[8 * i + 3] = o[8 * i + 3] * al + p * bfhi(w.y);
                    o[8 * i + 4] = o[8 * i + 4] * al + p * bflo(w.z); o[8 * i + 5] = o[8 * i + 5] * al + p * bfhi(w.z);
                    o[8 * i + 6] = o[8 * i + 6] * al + p * bflo(w.w); o[8 * i + 7] = o[8 * i + 7] * al + p * bfhi(w.w); }
            }
        }
        const float il = 1.f / l; bf16* orow = MI + (size_t)t * D + h * 64;
#pragma unroll
        for (int i = 0; i < 8; ++i) { v4u w; w.x = pk2(o[8 * i] * il, o[8 * i + 1] * il); w.y = pk2(o[8 * i + 2] * il, o[8 * i + 3] * il);
            w.z = pk2(o[8 * i + 4] * il, o[8 * i + 5] * il); w.w = pk2(o[8 * i + 6] * il, o[8 * i + 7] * il); *(GAS v4u*)(orow + 8 * i) = w; }
    }
}

__device__ __forceinline__ void phase_mlstm_naive(const Args& A, LAS unsigned char* lds, int bh) {
    const int tid = threadIdx.x, lane = tid & 63, wave = tid >> 6, b = bh >> 2, h = bh & 3, dv = tid >> 2, part = tid & 3;
    const bf16* P = (const bf16*)(A.ws + WS_PROJ); bf16* MI = (bf16*)(A.ws + WS_MIXIN); const float* gates = (const float*)(A.ws + WS_GATES);
    const float* cw = (const float*)A.in[I_CONVW]; const float* ng = (const float*)A.in[I_MNG];
    LAS float* qs = (LAS float*)lds; LAS float* ks = qs + 64 * 64; LAS float* vs = ks + 64 * 64; LAS float* ig = vs + 64 * 128; LAS float* lfg = ig + 64; LAS float* hb = lfg + 64;
    float C[16], n[16]; float m = 0.f;
#pragma unroll
    for (int j = 0; j < 16; ++j) { C[j] = 0.f; n[j] = 0.f; }
    for (int ch = 0; ch < SEQ / 64; ++ch) {
        const int s0 = ch * 64; const size_t t0 = (size_t)b * SEQ + s0;
        for (int e = tid; e < 64 * 64; e += NTHR) { const int l = e >> 6, dk = e & 63; float aq = 0.f, ak = 0.f;
#pragma unroll
            for (int j = 0; j < 4; ++j) { const int sj = s0 + l - 3 + j; if (sj >= 0) { const bf16* r = P + ((size_t)b * SEQ + sj) * NPROJ;
                aq += cw[j * 512 + h * 64 + dk] * bf1(r[C_MQ + h * 64 + dk]); ak += cw[j * 512 + 256 + h * 64 + dk] * bf1(r[C_MK + h * 64 + dk]); } }
            qs[e] = 0.125f * aq / (1.f + __expf(-aq)); ks[e] = ak / (1.f + __expf(-ak)); }
        for (int e = tid; e < 64 * 128; e += NTHR) { const int l = e >> 7, d = e & 127; vs[e] = bf1(P[(t0 + l) * NPROJ + C_MV + h * 128 + d]); }
        if (tid < 64) { ig[tid] = gates[(t0 + tid) * 8 + h]; lfg[tid] = gates[(t0 + tid) * 8 + 4 + h]; }
        __syncthreads();
        for (int l = 0; l < 64; ++l) {
            const float lf = lfg[l], ii = ig[l], mn = fmaxf(lf + m, ii), fd = __expf(lf + m - mn), iw = __expf(ii - mn), vv = vs[l * 128 + dv] * iw;
            float num = 0.f, den = 0.f;
#pragma unroll
            for (int j = 0; j < 16; ++j) { const float kk = ks[l * 64 + part * 16 + j], qq = qs[l * 64 + part * 16 + j];
                C[j] = fd * C[j] + vv * kk; n[j] = fd * n[j] + iw * kk; num += C[j] * qq; den += n[j] * qq; }
            num += __shfl_xor(num, 1); num += __shfl_xor(num, 2); den += __shfl_xor(den, 1); den += __shfl_xor(den, 2);
            if (part == 0) hb[l * 128 + dv] = num / fmaxf(fabsf(den), __expf(-mn));
            m = mn;
        }
        __syncthreads();
        for (int l = wave * 8; l < wave * 8 + 8; ++l) { const float a0 = hb[l * 128 + lane], a1 = hb[l * 128 + 64 + lane];
            const float r = 1.0f / sqrtf(wave_sum(a0 * a0 + a1 * a1) * (1.f / 128.f) + EPS);
            const bf16* pr = P + (t0 + l) * NPROJ + C_MO + h * 128; bf16* orow = MI + (t0 + l) * D + 512 + h * 128;
            orow[lane] = (bf16)f2bf(a0 * r * ng[h * 128 + lane] * bf1(pr[lane])); orow[64 + lane] = (bf16)f2bf(a1 * r * ng[h * 128 + 64 + lane] * bf1(pr[64 + lane])); }
        __syncthreads();
    }
}

__device__ __forceinline__ void ld16bf(const bf16* p, float (&o)[16]) {
    const v4u w0 = *(const GAS v4u*)p, w1 = *(const GAS v4u*)(p + 8);
    o[0] = bflo(w0.x); o[1] = bfhi(w0.x); o[2] = bflo(w0.y); o[3] = bfhi(w0.y); o[4] = bflo(w0.z); o[5] = bfhi(w0.z); o[6] = bflo(w0.w); o[7] = bfhi(w0.w);
    o[8] = bflo(w1.x); o[9] = bfhi(w1.x); o[10] = bflo(w1.y); o[11] = bfhi(w1.y); o[12] = bflo(w1.z); o[13] = bfhi(w1.z); o[14] = bflo(w1.w); o[15] = bfhi(w1.w);
}
typedef short bf16x8 __attribute__((ext_vector_type(8)));
#define MFMA16(a, b, c) __builtin_amdgcn_mfma_f32_16x16x32_bf16((a), (b), (c), 0, 0, 0)
__device__ __forceinline__ bf16x8 ldfrag(LAS const unsigned char* img, int row, int kbyte) { return *(LAS const bf16x8*)(img + row * 144 + kbyte); }
__device__ __forceinline__ unsigned cvtpk(float lo, float hi) { unsigned r; asm volatile("v_cvt_pk_bf16_f32 %0, %1, %2" : "=v"(r) : "v"(lo), "v"(hi)); return r; }

namespace ml {
constexpr int O_Q = 0, O_QA = 9216, O_K = 18432, O_KWT = 27648, O_VT = 36864, O_CX = 57600, CXB = 20736, O_S = 99072, O_GB = 108288, O_GA = O_GB + 4096, O_GC = O_GA + 4096, O_DEN = O_GC + 4096, O_SSQ = O_DEN + 256, O_END = O_SSQ + 2048;
static_assert(O_END <= 131072, "mlstm LDS");
constexpr size_t MST_SC = 11 * MiB;
}
template <bool OUT>
__device__ __forceinline__ void mlstm_group(const Args& A, LAS unsigned char* lds, int wg) {
    using namespace ml;
    const int tid = threadIdx.x, lane = tid & 63, wave = __builtin_amdgcn_readfirstlane(tid >> 6), fr = lane & 15, fq = lane >> 4;
    const int bh = wg >> 3, grp = wg & 7, b = bh >> 2, h = bh & 3;
    const size_t tg0 = (size_t)b * SEQ + (size_t)grp * 1024;
    const bf16* P = (const bf16*)(A.ws + WS_PROJ); bf16* MI = (bf16*)(A.ws + WS_MIXIN); const float* gates = (const float*)(A.ws + WS_GATES);
    const float* cw = (const float*)A.in[I_CONVW]; const float* ng = (const float*)A.in[I_MNG];
    float* MST = (float*)(A.ws + WS_MST); float* MSC = (float*)(A.ws + WS_MST + MST_SC);
    LAS float* GB = (LAS float*)(lds + O_GB); LAS float* GA = (LAS float*)(lds + O_GA); LAS float* GC = (LAS float*)(lds + O_GC);
    LAS float* DEN = (LAS float*)(lds + O_DEN); LAS float* SSQ = (LAS float*)(lds + O_SSQ);
    __syncthreads();
#pragma unroll
    for (int cc = 0; cc < 2; ++cc) { const int c = 2 * wave + cc; const size_t t = tg0 + c * 64 + lane;
        float bc = gates[t * 8 + 4 + h]; const float ii = gates[t * 8 + h];
#pragma unroll
        for (int o = 1; o < 64; o <<= 1) { const float v = __shfl_up(bc, o); if (lane >= o) bc += v; }
        const float a = ii - bc; float cm = a;
#pragma unroll
        for (int o = 1; o < 64; o <<= 1) { const float v = __shfl_up(cm, o); if (lane >= o) cm = fmaxf(cm, v); }
        GB[c * 64 + lane] = bc; GA[c * 64 + lane] = a; GC[c * 64 + lane] = cm; }
    for (int e = tid; e < 16 * 32; e += NTHR) { const int r = e >> 5, cpair = e & 31; *(LAS unsigned*)(lds + O_VT + (128 + r) * 144 + cpair * 4) = (r == 0) ? 0x3F803F80u : 0u; }
    f32x4 st[5];
#pragma unroll
    for (int i = 0; i < 5; ++i) st[i] = (f32x4){0.f, 0.f, 0.f, 0.f};
    float m = OUT ? 0.f : -__builtin_inff(); float Btot = 0.f;
    if (OUT) {
        for (int gp = 0; gp < grp; ++gp) { const int wgp = bh * 8 + gp; const float mg = MSC[wgp * 2], Bg = MSC[wgp * 2 + 1];
            const float mn = fmaxf(Bg + m, mg), f0 = __expf(Bg + m - mn), f1 = __expf(mg - mn);
#pragma unroll
            for (int i = 0; i < 5; ++i)
#pragma unroll
                for (int r = 0; r < 4; ++r) st[i][r] = f0 * st[i][r] + f1 * MST[((size_t)wgp * 20 + i * 4 + r) * NTHR + tid];
            m = mn; }
#pragma unroll
        for (int j = 0; j < 4; ++j)
#pragma unroll
            for (int r = 0; r < 4; ++r) *(LAS bf16*)(lds + O_CX + (16 * wave + 4 * fq + r) * 144 + (16 * j + fr) * 2) = (bf16)f2bf(st[j][r]);
        if (wave < 4) {
#pragma unroll
            for (int r = 0; r < 4; ++r) *(LAS bf16*)(lds + O_CX + (128 + 4 * fq + r) * 144 + (16 * wave + fr) * 2) = (bf16)f2bf(st[4][r]); }
    }
    float gsc[4];
#pragma unroll
    for (int r = 0; r < 4; ++r) gsc[r] = ng[h * 128 + 16 * wave + 4 * fq + r];
    const int sl = tid >> 3, cg = tid & 7;
    __syncthreads();
    for (int c = 0; c < 16; ++c) {
        const float bL = GB[c * 64 + 63], M63 = fmaxf(m, GC[c * 64 + 63]), decay = __expf(m - M63);
        const size_t tc0 = tg0 + (size_t)c * 64;
        {
            const int sabs = grp * 1024 + c * 64 + sl;
            float aq[8], ak[8];
#pragma unroll
            for (int i = 0; i < 8; ++i) { aq[i] = 0.f; ak[i] = 0.f; }
#pragma unroll
            for (int j = 0; j < 4; ++j) { const int sj = sabs - 3 + j;
                if (sj >= 0) { const bf16* rp = P + ((size_t)b * SEQ + sj) * NPROJ;
                    const v4u wq = *(const GAS v4u*)(rp + C_MQ + h * 64 + 8 * cg), wk = *(const GAS v4u*)(rp + C_MK + h * 64 + 8 * cg);
                    const f32x4 q0 = *(const GAS f32x4*)(cw + j * 512 + h * 64 + 8 * cg), q1 = *(const GAS f32x4*)(cw + j * 512 + h * 64 + 8 * cg + 4);
                    const f32x4 k0 = *(const GAS f32x4*)(cw + j * 512 + 256 + h * 64 + 8 * cg), k1 = *(const GAS f32x4*)(cw + j * 512 + 256 + h * 64 + 8 * cg + 4);
                    aq[0] += q0[0] * bflo(wq.x); aq[1] += q0[1] * bfhi(wq.x); aq[2] += q0[2] * bflo(wq.y); aq[3] += q0[3] * bfhi(wq.y);
                    aq[4] += q1[0] * bflo(wq.z); aq[5] += q1[1] * bfhi(wq.z); aq[6] += q1[2] * bflo(wq.w); aq[7] += q1[3] * bfhi(wq.w);
                    ak[0] += k0[0] * bflo(wk.x); ak[1] += k0[1] * bfhi(wk.x); ak[2] += k0[2] * bflo(wk.y); ak[3] += k0[3] * bfhi(wk.y);
                    ak[4] += k1[0] * bflo(wk.z); ak[5] += k1[1] * bfhi(wk.z); ak[6] += k1[2] * bflo(wk.w); ak[7] += k1[3] * bfhi(wk.w); } }
            const float Ml = fmaxf(m, GC[c * 64 + sl]), ainter = __expf(m - Ml), wsv = __expf(GA[c * 64 + sl] - M63);
            float qv[8], kv[8];
#pragma unroll
            for (int i = 0; i < 8; ++i) { qv[i] = 0.125f * aq[i] * __builtin_amdgcn_rcpf(1.f + __expf(-aq[i])); kv[i] = ak[i] * __builtin_amdgcn_rcpf(1.f + __expf(-ak[i])); }
            if (OUT) {
                v4u w; w.x = pk2(qv[0], qv[1]); w.y = pk2(qv[2], qv[3]); w.z = pk2(qv[4], qv[5]); w.w = pk2(qv[6], qv[7]); *(LAS v4u*)(lds + O_Q + sl * 144 + cg * 16) = w;
                w.x = pk2(qv[0] * ainter, qv[1] * ainter); w.y = pk2(qv[2] * ainter, qv[3] * ainter); w.z = pk2(qv[4] * ainter, qv[5] * ainter); w.w = pk2(qv[6] * ainter, qv[7] * ainter); *(LAS v4u*)(lds + O_QA + sl * 144 + cg * 16) = w;
                w.x = pk2(kv[0], kv[1]); w.y = pk2(kv[2], kv[3]); w.z = pk2(kv[4], kv[5]); w.w = pk2(kv[6], kv[7]); *(LAS v4u*)(lds + O_K + sl * 144 + cg * 16) = w;
            }
#pragma unroll
            for (int i = 0; i < 8; ++i) *(LAS bf16*)(lds + O_KWT + (8 * cg + i) * 144 + sl * 2) = (bf16)f2bf(kv[i] * wsv);
#pragma unroll
            for (int gi = 0; gi < 2; ++gi) { const int g8 = cg + 8 * gi; const v4u wv = *(const GAS v4u*)(P + (tc0 + sl) * NPROJ + C_MV + h * 128 + 8 * g8);
                const unsigned ww[4] = {wv.x, wv.y, wv.z, wv.w};
#pragma unroll
                for (int i = 0; i < 4; ++i) { *(LAS bf16*)(lds + O_VT + (8 * g8 + 2 * i) * 144 + sl * 2) = (bf16)(ww[i] & 0xffffu); *(LAS bf16*)(lds + O_VT + (8 * g8 + 2 * i + 1) * 144 + sl * 2) = (bf16)(ww[i] >> 16); } }
        }
        __syncthreads();
        if (OUT) {
            const int lt = wave >> 1, l = 16 * lt + fr; const float Ml = fmaxf(m, GC[c * 64 + l]);
            const bf16x8 bq0 = ldfrag(lds + O_Q, 16 * lt + fr, 16 * fq), bq1 = ldfrag(lds + O_Q, 16 * lt + fr, 64 + 16 * fq);
#pragma unroll
            for (int u = 0; u < 2; ++u) { const int stl = 2 * (wave & 1) + u; f32x4 acc = {0.f, 0.f, 0.f, 0.f};
                acc = MFMA16(ldfrag(lds + O_K, 16 * stl + fr, 16 * fq), bq0, acc); acc = MFMA16(ldfrag(lds + O_K, 16 * stl + fr, 64 + 16 * fq), bq1, acc);
                const f32x4 av = *(LAS const f32x4*)(GA + c * 64 + 16 * stl + 4 * fq); float wv[4];
#pragma unroll
                for (int r = 0; r < 4; ++r) { const int s = 16 * stl + 4 * fq + r; wv[r] = (s <= l) ? acc[r] * __expf(av[r] - Ml) : 0.f; }
                v2u w; w.x = cvtpk(wv[0], wv[1]); w.y = cvtpk(wv[2], wv[3]); *(LAS v2u*)(lds + O_S + l * 144 + (16 * stl + 4 * fq) * 2) = w; }
        }
        {
            const bf16x8 va0 = ldfrag(lds + O_VT, 16 * wave + fr, 16 * fq), va1 = ldfrag(lds + O_VT, 16 * wave + fr, 64 + 16 * fq);
#pragma unroll
            for (int j = 0; j < 4; ++j) { st[j] = st[j] * decay;
                st[j] = MFMA16(va0, ldfrag(lds + O_KWT, 16 * j + fr, 16 * fq), st[j]); st[j] = MFMA16(va1, ldfrag(lds + O_KWT, 16 * j + fr, 64 + 16 * fq), st[j]); }
            if (wave < 4) { st[4] = st[4] * decay;
                st[4] = MFMA16(ldfrag(lds + O_VT, 128 + fr, 16 * fq), ldfrag(lds + O_KWT, 16 * wave + fr, 16 * fq), st[4]);
                st[4] = MFMA16(ldfrag(lds + O_VT, 128 + fr, 64 + 16 * fq), ldfrag(lds + O_KWT, 16 * wave + fr, 64 + 16 * fq), st[4]); }
        }
        if (OUT) {
            __syncthreads();
            LAS const unsigned char* cx = lds + O_CX + (c & 1) * CXB;
            f32x4 nt[4], nd = {0.f, 0.f, 0.f, 0.f};
            {
                const bf16x8 va0 = ldfrag(lds + O_VT, 16 * wave + fr, 16 * fq), va1 = ldfrag(lds + O_VT, 16 * wave + fr, 64 + 16 * fq);
                const bf16x8 ca0 = ldfrag(cx, 16 * wave + fr, 16 * fq), ca1 = ldfrag(cx, 16 * wave + fr, 64 + 16 * fq);
#pragma unroll
                for (int lt = 0; lt < 4; ++lt) { f32x4 acc = {0.f, 0.f, 0.f, 0.f};
                    acc = MFMA16(va0, ldfrag(lds + O_S, 16 * lt + fr, 16 * fq), acc); acc = MFMA16(va1, ldfrag(lds + O_S, 16 * lt + fr, 64 + 16 * fq), acc);
                    acc = MFMA16(ca0, ldfrag(lds + O_QA, 16 * lt + fr, 16 * fq), acc); acc = MFMA16(ca1, ldfrag(lds + O_QA, 16 * lt + fr, 64 + 16 * fq), acc); nt[lt] = acc; }
                if (wave >= 4) { const int lt = wave - 4;
                    nd = MFMA16(ldfrag(lds + O_VT, 128 + fr, 16 * fq), ldfrag(lds + O_S, 16 * lt + fr, 16 * fq), nd); nd = MFMA16(ldfrag(lds + O_VT, 128 + fr, 64 + 16 * fq), ldfrag(lds + O_S, 16 * lt + fr, 64 + 16 * fq), nd);
                    nd = MFMA16(ldfrag(cx, 128 + fr, 16 * fq), ldfrag(lds + O_QA, 16 * lt + fr, 16 * fq), nd); nd = MFMA16(ldfrag(cx, 128 + fr, 64 + 16 * fq), ldfrag(lds + O_QA, 16 * lt + fr, 64 + 16 * fq), nd);
                    if (fq == 0) DEN[16 * lt + fr] = nd[0]; }
            }
            v2u mo[4];
#pragma unroll
            for (int lt = 0; lt < 4; ++lt) mo[lt] = *(const GAS v2u*)(P + (tc0 + 16 * lt + fr) * NPROJ + C_MO + h * 128 + 16 * wave + 4 * fq);
            __syncthreads();
#pragma unroll
            for (int lt = 0; lt < 4; ++lt) { const int l = 16 * lt + fr; const float Ml = fmaxf(m, GC[c * 64 + l]);
                const float inv = 1.0f / fmaxf(fabsf(DEN[l]), __expf(-(GB[c * 64 + l] + Ml)));
                nt[lt] = nt[lt] * inv; float ss = (nt[lt][0] * nt[lt][0] + nt[lt][1] * nt[lt][1]) + (nt[lt][2] * nt[lt][2] + nt[lt][3] * nt[lt][3]);
                ss += __shfl_xor(ss, 16); ss += __shfl_xor(ss, 32);
                if (fq == 0) SSQ[wave * 64 + l] = ss; }
            LAS unsigned char* cxn = lds + O_CX + ((c + 1) & 1) * CXB;
#pragma unroll
            for (int j = 0; j < 4; ++j)
#pragma unroll
                for (int r = 0; r < 4; ++r) *(LAS bf16*)(cxn + (16 * wave + 4 * fq + r) * 144 + (16 * j + fr) * 2) = (bf16)f2bf(st[j][r]);
            if (wave < 4) {
#pragma unroll
                for (int r = 0; r < 4; ++r) *(LAS bf16*)(cxn + (128 + 4 * fq + r) * 144 + (16 * wave + fr) * 2) = (bf16)f2bf(st[4][r]); }
            __syncthreads();
#pragma unroll
            for (int lt = 0; lt < 4; ++lt) { const int l = 16 * lt + fr; float tot = 0.f;
#pragma unroll
                for (int w2 = 0; w2 < 8; ++w2) tot += SSQ[w2 * 64 + l];
                const float rn = 1.0f / sqrtf(tot * (1.f / 128.f) + EPS);
                const float o0 = nt[lt][0] * rn * gsc[0] * bflo(mo[lt].x), o1 = nt[lt][1] * rn * gsc[1] * bfhi(mo[lt].x), o2 = nt[lt][2] * rn * gsc[2] * bflo(mo[lt].y), o3 = nt[lt][3] * rn * gsc[3] * bfhi(mo[lt].y);
                v2u w; w.x = pk2(o0, o1); w.y = pk2(o2, o3);
                *(GAS v2u*)(MI + (tc0 + l) * D + 512 + h * 128 + 16 * wave + 4 * fq) = w; }
        } else {
            __syncthreads();
        }
        m = bL + M63; Btot += bL;
    }
    if (!OUT) {
#pragma unroll
        for (int i = 0; i < 5; ++i)
#pragma unroll
            for (int r = 0; r < 4; ++r) MST[((size_t)wg * 20 + i * 4 + r) * NTHR + tid] = st[i][r];
        if (tid == 0) { MSC[wg * 2] = m; MSC[wg * 2 + 1] = Btot; }
    }
}

namespace at {
constexpr int O_K = 0, O_VT = 36864, VTS = 560  , O_END = O_VT + 64 * VTS;
static_assert(O_END <= 131072, "attention LDS");
}
__device__ __forceinline__ void phase_attn(const Args& A, LAS unsigned char* lds) {
    using namespace at;
    const int tid = threadIdx.x, lane = tid & 63, wave = __builtin_amdgcn_readfirstlane(tid >> 6), fr = lane & 15, fq = lane >> 4, G = gridDim.x;
    const bf16* P = (const bf16*)(A.ws + WS_PROJ); bf16* MI = (bf16*)(A.ws + WS_MIXIN); const float* sinks = (const float*)A.in[I_SINK];
    __syncthreads();
    for (int e = tid; e < 64 * 12; e += NTHR) { const int r = e / 12, cpair = e % 12; *(LAS unsigned*)(lds + O_VT + r * VTS + 512 + cpair * 4) = 0u; }
    for (int unit = blockIdx.x; unit < NB * 64 * 2; unit += G) {
        const int g = unit & 1, n = (unit >> 1) & 63, b = unit >> 7;
        const size_t tq0 = (size_t)b * SEQ + (size_t)n * 128;
        __syncthreads();
#pragma unroll
        for (int i = 0; i < 4; ++i) { const int item = tid + NTHR * i, row = item >> 3, ch = item & 7;
            v4u wk = {0u, 0u, 0u, 0u}, wv = {0u, 0u, 0u, 0u};
            if (n > 0 || row >= 128) { const bf16* rp = P + (tq0 - 128 + row) * NPROJ; wk = *(const GAS v4u*)(rp + C_AK + g * 64 + 8 * ch); wv = *(const GAS v4u*)(rp + C_AV + g * 64 + 8 * ch); }
            *(LAS v4u*)(lds + O_K + row * 144 + ch * 16) = wk;
            const unsigned ww[4] = {wv.x, wv.y, wv.z, wv.w};
#pragma unroll
            for (int k = 0; k < 4; ++k) { *(LAS bf16*)(lds + O_VT + (8 * ch + 2 * k) * VTS + row * 2) = (bf16)(ww[k] & 0xffffu); *(LAS bf16*)(lds + O_VT + (8 * ch + 2 * k + 1) * VTS + row * 2) = (bf16)(ww[k] >> 16); } }
        const int hq = 4 * g + (wave >> 1), qr0 = 64 * (wave & 1); const float sink = sinks[hq];
        __syncthreads();
        for (int qt = 0; qt < 4; ++qt) {
            const int i0 = qr0 + 16 * qt, st0 = i0 >> 4, iq = i0 + fr;
            const bf16* qp = P + (tq0 + iq) * NPROJ + C_AQ + hq * 64 + 8 * fq;
            const bf16x8 bq0 = *(const GAS bf16x8*)qp, bq1 = *(const GAS bf16x8*)(qp + 32);
            f32x4 sc[9]; float mx = sink;
#pragma unroll
            for (int t = 0; t < 9; ++t) { const int sb0 = 16 * (st0 + t); f32x4 acc = {0.f, 0.f, 0.f, 0.f};
                acc = MFMA16(ldfrag(lds + O_K, sb0 + fr, 16 * fq), bq0, acc); acc = MFMA16(ldfrag(lds + O_K, sb0 + fr, 64 + 16 * fq), bq1, acc);
#pragma unroll
                for (int r = 0; r < 4; ++r) { const int sb = sb0 + 4 * fq + r; const bool valid = (sb > iq) && (sb <= iq + 128) && (n > 0 || sb >= 128);
                    acc[r] = valid ? acc[r] : -3.0e38f; mx = fmaxf(mx, acc[r]); }
                sc[t] = acc; }
            mx = fmaxf(mx, __shfl_xor(mx, 16)); mx = fmaxf(mx, __shfl_xor(mx, 32));
            float lsum = 0.f;
#pragma unroll
            for (int t = 0; t < 9; ++t)
#pragma unroll
                for (int r = 0; r < 4; ++r) { const float p = (sc[t][r] > -1.0e38f) ? __expf(sc[t][r] - mx) : 0.f; sc[t][r] = p; lsum += p; }
            lsum += __shfl_xor(lsum, 16); lsum += __shfl_xor(lsum, 32); lsum += __expf(sink - mx);
            f32x4 oacc[4];
#pragma unroll
            for (int dt = 0; dt < 4; ++dt) oacc[dt] = (f32x4){0.f, 0.f, 0.f, 0.f};
#pragma unroll
            for (int ks = 0; ks < 5; ++ks) {
                union { bf16x8 v; unsigned u[4]; } pb;
                pb.u[0] = cvtpk(sc[2 * ks][0], sc[2 * ks][1]); pb.u[1] = cvtpk(sc[2 * ks][2], sc[2 * ks][3]);
                if (ks < 4) { pb.u[2] = cvtpk(sc[2 * ks + 1][0], sc[2 * ks + 1][1]); pb.u[3] = cvtpk(sc[2 * ks + 1][2], sc[2 * ks + 1][3]); } else { pb.u[2] = 0u; pb.u[3] = 0u; }
                const int sbb = 16 * (st0 + 2 * ks) + 4 * fq;
#pragma unroll
                for (int dt = 0; dt < 4; ++dt) { LAS const unsigned char* vp = lds + O_VT + (16 * dt + fr) * VTS + sbb * 2;
                    union { bf16x8 v; v2u h[2]; } va; va.h[0] = *(LAS const v2u*)vp; va.h[1] = *(LAS const v2u*)(vp + 32);
                    oacc[dt] = MFMA16(va.v, pb.v, oacc[dt]); } }
            const float il = 1.0f / lsum;
#pragma unroll
            for (int dt = 0; dt < 4; ++dt) { v2u w; w.x = pk2(oacc[dt][0] * il, oacc[dt][1] * il); w.y = pk2(oacc[dt][2] * il, oacc[dt][3] * il);
                *(GAS v2u*)(MI + (tq0 + iq) * D + hq * 64 + 16 * dt + 4 * fq) = w; }
        }
    }
}
typedef float f32x16 __attribute__((ext_vector_type(16)));
__device__ __forceinline__ unsigned fbits(float f) { return __builtin_bit_cast(unsigned, f); }
__device__ __forceinline__ float bfloat(unsigned u) { return __builtin_bit_cast(float, u); }

#define CE_DESC(a, b) do { const float _mx = __builtin_fmaxf(a, b), _mn = __builtin_fminf(a, b); a = _mx; b = _mn; } while (0)
__device__ __forceinline__ void bsort16(float (&v)[16]) {
#pragma unroll
    for (int k = 2; k <= 16; k <<= 1)
#pragma unroll
        for (int j = k >> 1; j > 0; j >>= 1)
#pragma unroll
            for (int i = 0; i < 16; ++i) { const int l = i ^ j; if (l > i) { if ((i & k) == 0) CE_DESC(v[i], v[l]); else CE_DESC(v[l], v[i]); } }
}
__device__ __forceinline__ void bmerge16(float (&v)[16], const float (&w)[16]) {
#pragma unroll
    for (int i = 0; i < 16; ++i) v[i] = __builtin_fmaxf(v[i], w[15 - i]);
#pragma unroll
    for (int j = 8; j > 0; j >>= 1)
#pragma unroll
        for (int i = 0; i < 16; ++i) { const int l = i ^ j; if (l > i) CE_DESC(v[i], v[l]); }
}
namespace tk {
constexpr int KS = 272;
constexpr int O_K1 = 0, O_K2 = 128 * KS, O_X = 2 * 128 * KS, O_END = O_X + 8 * 4096;
static_assert(O_END <= 131072, "topk LDS");
constexpr unsigned char CAND[64] = {
    0x00, 0x01, 0x02, 0x03, 0x04, 0x05, 0x06, 0x07, 0x08, 0x09, 0x0a, 0x0b, 0x0c, 0x0d, 0x0e, 0x0f,
    0x10, 0x11, 0x12, 0x13, 0x14, 0x15, 0x16, 0x17, 0x80, 0x90, 0xa0, 0xb0, 0xc0, 0xd0, 0xe0, 0xf0,
    0x20, 0x21, 0x22, 0x23, 0x24, 0x30, 0x31, 0x32, 0x33, 0x40, 0x41, 0x42, 0x50, 0x51, 0x60, 0x61,
    0x70, 0x71, 0xff, 0xff, 0xff, 0xff, 0xff, 0xff, 0xff, 0xff, 0xff, 0xff, 0xff, 0xff, 0xff, 0xff};
}
__device__ __forceinline__ void side_top16(const f32x16 (&acc)[4], int hh, float (&T)[16]) {
    float g1[16], g2[16];
#pragma unroll
    for (int r = 0; r < 16; ++r) { const unsigned key = (r & 3) + 8 * (r >> 2) + 4 * hh;
        T[r] = bfloat((fbits(acc[0][r]) & 0xffffff80u) | key);
        g1[r] = bfloat((fbits(acc[1][r]) & 0xffffff80u) | (32u + key)); }
    bsort16(T); bsort16(g1); bmerge16(T, g1);
#pragma unroll
    for (int r = 0; r < 16; ++r) { const unsigned key = (r & 3) + 8 * (r >> 2) + 4 * hh;
        g1[r] = bfloat((fbits(acc[2][r]) & 0xffffff80u) | (64u + key));
        g2[r] = bfloat((fbits(acc[3][r]) & 0xffffff80u) | (96u + key)); }
    bsort16(g1); bsort16(g2); bmerge16(g1, g2); bmerge16(T, g1);
#pragma unroll
    for (int r = 0; r < 16; ++r) g1[r] = __shfl_xor(T[r], 32);
    bmerge16(T, g1);
}
template <int SD> __device__ __forceinline__ void topk_side(const bf16* Q, LAS unsigned char* lds, int t, int h, int r32, int hh, float (&T)[16]) {
    using namespace tk;
    f32x16 acc[4];
#pragma unroll
    for (int mt = 0; mt < 4; ++mt)
#pragma unroll
        for (int r = 0; r < 16; ++r) acc[mt][r] = 0.f;
    const bf16* qp = Q + (size_t)t * 2048 + h * 256 + SD * 128 + 8 * hh; LAS const unsigned char* kimg = lds + (SD ? O_K2 : O_K1);
#pragma unroll
    for (int ks = 0; ks < 8; ++ks) { const bf16x8 bq = *(const GAS bf16x8*)(qp + 16 * ks);
#pragma unroll
        for (int mt = 0; mt < 4; ++mt) acc[mt] = __builtin_amdgcn_mfma_f32_32x32x16_bf16(*(LAS const bf16x8*)(kimg + (32 * mt + r32) * KS + 32 * ks + 16 * hh), bq, acc[mt], 0, 0, 0); }
    side_top16(acc, hh, T);
}
template <int Q> __device__ __forceinline__ float cand_val(const float (&T1)[16], const float (&T2)[16], int hh) {
    constexpr unsigned c0 = tk::CAND[2 * Q], c1 = tk::CAND[2 * Q + 1];
    const float s = (hh ? T1[(c1 >> 4) & 15] : T1[(c0 >> 4) & 15]) + (hh ? T2[c1 & 15] : T2[c0 & 15]); const unsigned code = hh ? c1 : c0;
    return (code == 0xffu) ? -3.0e38f : bfloat((fbits(s) & 0xffffff00u) | code);
}
__device__ __forceinline__ void phase_topk(const Args& A, LAS unsigned char* lds) {
    using namespace tk;
    const int tid = threadIdx.x, lane = tid & 63, wave = __builtin_amdgcn_readfirstlane(tid >> 6), G = gridDim.x;
    const bf16* Q = (const bf16*)(A.ws + WS_PROJ); const bf16* KB = (const bf16*)(A.ws + WS_KEYS);
    unsigned short* EI = (unsigned short*)(A.ws + WS_EIDX); float* GT = (float*)(A.ws + WS_GATE);
    const int h = blockIdx.x & 7, r32 = lane & 31, hh = lane >> 5;
    __syncthreads();
    for (int e = tid; e < 2 * 128 * 16; e += NTHR) { const int s = e >> 11, row = (e >> 4) & 127, ch = e & 15;
        *(LAS v4u*)(lds + (s ? O_K2 : O_K1) + row * KS + ch * 16) = *(const GAS v4u*)(KB + (size_t)s * 8 * 128 * 128 + ((size_t)h * 128 + row) * 128 + ch * 8); }
    __syncthreads();
    LAS float* XW = (LAS float*)(lds + O_X + wave * 4096) + r32 * 32;
    for (int tile = (int)(blockIdx.x >> 3); tile < M / 256; tile += (G >> 3)) {
        const int t = tile * 256 + 32 * wave + r32;
        float T1[16], T2[16];
        topk_side<0>(Q, lds, t, h, r32, hh, T1);
        topk_side<1>(Q, lds, t, h, r32, hh, T2);
        float c[16], w[16];
        c[0] = cand_val<0>(T1, T2, hh); w[0] = cand_val<16>(T1, T2, hh);
        c[1] = cand_val<1>(T1, T2, hh); w[1] = cand_val<17>(T1, T2, hh);
        c[2] = cand_val<2>(T1, T2, hh); w[2] = cand_val<18>(T1, T2, hh);
        c[3] = cand_val<3>(T1, T2, hh); w[3] = cand_val<19>(T1, T2, hh);
        c[4] = cand_val<4>(T1, T2, hh); w[4] = cand_val<20>(T1, T2, hh);
        c[5] = cand_val<5>(T1, T2, hh); w[5] = cand_val<21>(T1, T2, hh);
        c[6] = cand_val<6>(T1, T2, hh); w[6] = cand_val<22>(T1, T2, hh);
        c[7] = cand_val<7>(T1, T2, hh); w[7] = cand_val<23>(T1, T2, hh);
        c[8] = cand_val<8>(T1, T2, hh); w[8] = cand_val<24>(T1, T2, hh);
        c[9] = cand_val<9>(T1, T2, hh); w[9] = cand_val<25>(T1, T2, hh);
        c[10] = cand_val<10>(T1, T2, hh); w[10] = cand_val<26>(T1, T2, hh);
        c[11] = cand_val<11>(T1, T2, hh); w[11] = cand_val<27>(T1, T2, hh);
        c[12] = cand_val<12>(T1, T2, hh); w[12] = cand_val<28>(T1, T2, hh);
        c[13] = cand_val<13>(T1, T2, hh); w[13] = cand_val<29>(T1, T2, hh);
        c[14] = cand_val<14>(T1, T2, hh); w[14] = cand_val<30>(T1, T2, hh);
        c[15] = cand_val<15>(T1, T2, hh); w[15] = cand_val<31>(T1, T2, hh);
        bsort16(c); bsort16(w); bmerge16(c, w);
#pragma unroll
        for (int r = 0; r < 16; ++r) w[r] = __shfl_xor(c[r], 32);
        bmerge16(c, w);
        if (hh == 0) {
#pragma unroll
            for (int q4 = 0; q4 < 4; ++q4) { *(LAS f32x4*)(XW + 4 * q4) = (f32x4){T1[4 * q4], T1[4 * q4 + 1], T1[4 * q4 + 2], T1[4 * q4 + 3]};
                *(LAS f32x4*)(XW + 16 + 4 * q4) = (f32x4){T2[4 * q4], T2[4 * q4 + 1], T2[4 * q4 + 2], T2[4 * q4 + 3]}; } }
        asm volatile("s_waitcnt lgkmcnt(0)" ::: "memory");
        float ex[16], sum = 0.f; const float tmax = bfloat(fbits(c[0]) & 0xffffff00u);
#pragma unroll
        for (int r = 0; r < 16; ++r) { ex[r] = __expf(bfloat(fbits(c[r]) & 0xffffff00u) - tmax); sum += ex[r]; }
        const float isum = 1.0f / sum; const size_t ob = (size_t)t * NSLOT + h * 16 + 8 * hh;
        unsigned eo[8]; float go[8];
#pragma unroll
        for (int r = 0; r < 8; ++r) { float ca = c[r], cb = c[8 + r], ea = ex[r], eb = ex[8 + r]; asm volatile("" : "+v"(ca), "+v"(cb), "+v"(ea), "+v"(eb)); const float cv = hh ? cb : ca, ev = hh ? eb : ea;
            const unsigned code = fbits(cv) & 0xffu;
            const unsigned i1 = fbits(XW[code >> 4]) & 127u, i2 = fbits(XW[16 + (code & 15)]) & 127u;
            eo[r] = i1 * 128u + i2; go[r] = ev * isum; }
        *(GAS v4u*)(EI + ob) = (v4u){eo[0] | (eo[1] << 16), eo[2] | (eo[3] << 16), eo[4] | (eo[5] << 16), eo[6] | (eo[7] << 16)};
        *(GAS f32x4*)(GT + ob) = (f32x4){go[0], go[1], go[2], go[3]}; *(GAS f32x4*)(GT + ob + 4) = (f32x4){go[4], go[5], go[6], go[7]};
        asm volatile("s_waitcnt lgkmcnt(0)" ::: "memory");
    }
}
struct PeerIdx { v4u e0, e1; };
__device__ __forceinline__ PeerIdx peer_ld_idx(const unsigned short* EI, int t, int g) { PeerIdx r; r.e0 = *(const GAS v4u*)(EI + (size_t)t * NSLOT + 16 * g); r.e1 = *(const GAS v4u*)(EI + (size_t)t * NSLOT + 16 * g + 8); return r; }
__device__ __forceinline__ void peer_gather(const unsigned char* T8, const PeerIdx& ix, int colb, v4u (&raw)[16]) {
    const unsigned ew[8] = {ix.e0.x, ix.e0.y, ix.e0.z, ix.e0.w, ix.e1.x, ix.e1.y, ix.e1.z, ix.e1.w};
#pragma unroll
    for (int k = 0; k < 16; ++k) { const unsigned e = (k & 1) ? (ew[k >> 1] >> 16) : (ew[k >> 1] & 0xffffu); raw[k] = *(const GAS v4u*)(T8 + (size_t)e * D + colb); }
}
__device__ __forceinline__ void cvt16_fp8_pk(const v4u w, f32x2 (&o)[8]) {
    const unsigned ww[4] = {w.x, w.y, w.z, w.w};
#pragma unroll
    for (int i = 0; i < 4; ++i) { o[2 * i] = __builtin_amdgcn_cvt_pk_f32_fp8((int)ww[i], false); o[2 * i + 1] = __builtin_amdgcn_cvt_pk_f32_fp8((int)ww[i], true); }
}
__device__ __forceinline__ void peer_u_reduce(const v4u (&raw)[16], const f32x2 (&hv)[8], float* PDrow, int lane, int g, int c) {
    float d[16];
#pragma unroll
    for (int k = 0; k < 16; ++k) { f32x2 uf[8]; cvt16_fp8_pk(raw[k], uf); f32x2 s = uf[0] * hv[0];
#pragma unroll
        for (int i = 1; i < 8; ++i) s += uf[i] * hv[i];
        d[k] = s.x + s.y; }
#pragma unroll
    for (int i = 0; i < 8; ++i) { const bool up = (lane & 4) != 0; const float keep = up ? d[i + 8] : d[i], send = up ? d[i] : d[i + 8]; d[i] = keep + __shfl_xor(send, 4); }
#pragma unroll
    for (int i = 0; i < 4; ++i) { const bool up = (lane & 2) != 0; const float keep = up ? d[i + 4] : d[i], send = up ? d[i] : d[i + 4]; d[i] = keep + __shfl_xor(send, 2); }
#pragma unroll
    for (int i = 0; i < 2; ++i) { const bool up = (lane & 1) != 0; const float keep = up ? d[i + 2] : d[i], send = up ? d[i] : d[i + 2]; d[i] = keep + __shfl_xor(send, 1); }
    *(GAS f32x2*)(PDrow + 16 * g + 2 * c) = (f32x2){d[0], d[1]};
}
__device__ __forceinline__ void ld16bf_pk(const bf16* p, f32x2 (&o)[8]) {
    const v4u w0 = *(const GAS v4u*)p, w1 = *(const GAS v4u*)(p + 8); const unsigned ww[8] = {w0.x, w0.y, w0.z, w0.w, w1.x, w1.y, w1.z, w1.w};
#pragma unroll
    for (int i = 0; i < 8; ++i) o[i] = (f32x2){bflo(ww[i]), bfhi(ww[i])};
}
__device__ __forceinline__ void phase_peer_u(const Args& A) {
    const int tid = threadIdx.x, lane = tid & 63, wave = tid >> 6, p = blockIdx.x & 7, j = blockIdx.x >> 3, nj = gridDim.x >> 3, g = lane >> 3, c = lane & 7;
    const bf16* H = (const bf16*)(A.ws + WS_H); const unsigned char* U8 = (const unsigned char*)(A.ws + WS_U8); const unsigned short* EI = (const unsigned short*)(A.ws + WS_EIDX);
    float* PD = (float*)(A.ws + WS_PD) + (size_t)p * M * NSLOT;
    const int tper = M / nj, colb = 128 * p + 16 * c, tend = (j + 1) * tper, tlast = tend - NWAVES + wave;
    int t = j * tper + wave;
    PeerIdx ix1 = peer_ld_idx(EI, min(t + NWAVES, tlast), g), ix2 = peer_ld_idx(EI, min(t + 2 * NWAVES, tlast), g);
    v4u rawa[16], rawb[16]; f32x2 hva[8], hvb[8];
    { const PeerIdx ix0 = peer_ld_idx(EI, t, g); peer_gather(U8, ix0, colb, rawa); ld16bf_pk(H + (size_t)t * D + colb, hva); }
    for (; t < tend; t += 2 * NWAVES) {
        const int t1 = t + NWAVES, t2 = min(t + 2 * NWAVES, tlast), t3 = min(t + 3 * NWAVES, tlast), t4 = min(t + 4 * NWAVES, tlast);
        const PeerIdx ix3 = peer_ld_idx(EI, t3, g);
        peer_gather(U8, ix1, colb, rawb); ld16bf_pk(H + (size_t)t1 * D + colb, hvb);
        peer_u_reduce(rawa, hva, PD + (size_t)t * NSLOT, lane, g, c);
        const PeerIdx ix4 = peer_ld_idx(EI, t4, g);
        peer_gather(U8, ix2, colb, rawa); ld16bf_pk(H + (size_t)t2 * D + colb, hva);
        peer_u_reduce(rawb, hvb, PD + (size_t)t1 * NSLOT, lane, g, c);
        ix1 = ix3; ix2 = ix4;
    }
}
__device__ __forceinline__ void phase_peer_act(const Args& A) {
    const float* PD = (const float*)(A.ws + WS_PD); const unsigned short* EI = (const unsigned short*)(A.ws + WS_EIDX); const float* GT = (const float*)(A.ws + WS_GATE);
    const float* usc = (const float*)(A.ws + WS_SC); const float* vsc = usc + NEXP; float* ACT = (float*)(A.ws + WS_ACT);
    for (size_t i = (size_t)blockIdx.x * NTHR + threadIdx.x; i < (size_t)M * NSLOT; i += (size_t)gridDim.x * NTHR) {
        float s = 0.f;
#pragma unroll
        for (int p = 0; p < 8; ++p) s += PD[(size_t)p * M * NSLOT + i];
        const unsigned e = EI[i]; s *= usc[e];
        ACT[i] = 0.5f * s * (1.f + erff(s * 0.70710678118654752f)) * GT[i] * vsc[e];
    }
}
struct PeerAct { f32x4 a0, a1, a2, a3; };
__device__ __forceinline__ PeerAct peer_ld_act(const float* ACT, int t, int g) { const GAS f32x4* ap = (const GAS f32x4*)(ACT + (size_t)t * NSLOT + 16 * g); PeerAct r; r.a0 = ap[0]; r.a1 = ap[1]; r.a2 = ap[2]; r.a3 = ap[3]; return r; }
__device__ __forceinline__ void peer_v_reduce(const v4u (&raw)[16], const PeerAct& pa, bf16* Yrow, float* ssy, int lane, int g, int c) {
    const float av[16] = {pa.a0[0], pa.a0[1], pa.a0[2], pa.a0[3], pa.a1[0], pa.a1[1], pa.a1[2], pa.a1[3], pa.a2[0], pa.a2[1], pa.a2[2], pa.a2[3], pa.a3[0], pa.a3[1], pa.a3[2], pa.a3[3]};
    f32x2 y2[8];
#pragma unroll
    for (int i = 0; i < 8; ++i) y2[i] = (f32x2){0.f, 0.f};
#pragma unroll
    for (int k = 0; k < 16; ++k) { f32x2 vf[8]; cvt16_fp8_pk(raw[k], vf); const f32x2 a2 = (f32x2){av[k], av[k]};
#pragma unroll
        for (int i = 0; i < 8; ++i) y2[i] += a2 * vf[i]; }
    float y[16];
#pragma unroll
    for (int i = 0; i < 8; ++i) { y[2 * i] = y2[i].x; y[2 * i + 1] = y2[i].y; }
#pragma unroll
    for (int i = 0; i < 8; ++i) { const bool up = (lane & 32) != 0; const float keep = up ? y[i + 8] : y[i], send = up ? y[i] : y[i + 8]; y[i] = keep + __shfl_xor(send, 32); }
#pragma unroll
    for (int i = 0; i < 4; ++i) { const bool up = (lane & 16) != 0; const float keep = up ? y[i + 4] : y[i], send = up ? y[i] : y[i + 4]; y[i] = keep + __shfl_xor(send, 16); }
#pragma unroll
    for (int i = 0; i < 2; ++i) { const bool up = (lane & 8) != 0; const float keep = up ? y[i + 2] : y[i], send = up ? y[i] : y[i + 2]; y[i] = keep + __shfl_xor(send, 8); }
    *(GAS unsigned*)(Yrow + 16 * c + 2 * g) = pk2(y[0], y[1]);
    const float ss = wave_sum(y[0] * y[0] + y[1] * y[1]);
    if (lane == 0) *ssy = ss;
}
__device__ __forceinline__ void phase_peer_v(const Args& A) {
    const int tid = threadIdx.x, lane = tid & 63, wave = tid >> 6, p = blockIdx.x & 7, j = blockIdx.x >> 3, nj = gridDim.x >> 3, g = lane >> 3, c = lane & 7;
    const unsigned char* V8 = (const unsigned char*)(A.ws + WS_V8); const unsigned short* EI = (const unsigned short*)(A.ws + WS_EIDX); const float* ACT = (const float*)(A.ws + WS_ACT);
    bf16* Y = (bf16*)(A.ws + WS_H); float* SSY = (float*)(A.ws + WS_SSY);
    const int tper = M / nj, colb = 128 * p + 16 * c, tend = (j + 1) * tper, tlast = tend - NWAVES + wave;
    int t = j * tper + wave;
    PeerIdx ix1 = peer_ld_idx(EI, min(t + NWAVES, tlast), g), ix2 = peer_ld_idx(EI, min(t + 2 * NWAVES, tlast), g);
    v4u rawa[16], rawb[16]; PeerAct aca, acb;
    { const PeerIdx ix0 = peer_ld_idx(EI, t, g); peer_gather(V8, ix0, colb, rawa); aca = peer_ld_act(ACT, t, g); }
    for (; t < tend; t += 2 * NWAVES) {
        const int t1 = t + NWAVES, t2 = min(t + 2 * NWAVES, tlast), t3 = min(t + 3 * NWAVES, tlast), t4 = min(t + 4 * NWAVES, tlast);
        const PeerIdx ix3 = peer_ld_idx(EI, t3, g);
        peer_gather(V8, ix1, colb, rawb); acb = peer_ld_act(ACT, t1, g);
        peer_v_reduce(rawa, aca, Y + (size_t)t * D + 128 * p, SSY + (size_t)t * 8 + p, lane, g, c);
        const PeerIdx ix4 = peer_ld_idx(EI, t4, g);
        peer_gather(V8, ix2, colb, rawa); aca = peer_ld_act(ACT, t2, g);
        peer_v_reduce(rawb, acb, Y + (size_t)t1 * D + 128 * p, SSY + (size_t)t1 * 8 + p, lane, g, c);
        ix1 = ix3; ix2 = ix4;
    }
}
__device__ __forceinline__ void phase_peer_final(const Args& A) {
    const int tid = threadIdx.x, lane = tid & 63, wave = tid >> 6, G = gridDim.x;
    const bf16* Y = (const bf16*)(A.ws + WS_H); const float* SSY = (const float*)(A.ws + WS_SSY); const float* mod = (const float*)(A.ws + WS_MOD); const float* gpost = (const float*)A.in[I_GPOST2]; float* out = A.out;
    for (int row = blockIdx.x * NWAVES + wave; row < M; row += G * NWAVES) {
        const int b = row / SEQ; const f32x4 s0 = *(const GAS f32x4*)(SSY + (size_t)row * 8), s1 = *(const GAS f32x4*)(SSY + (size_t)row * 8 + 4);
        const float rstd = 1.0f / sqrtf((((s0[0] + s0[1]) + (s0[2] + s0[3])) + ((s1[0] + s1[1]) + (s1[2] + s1[3]))) * (1.f / D) + EPS);
        GAS f32x4* orow = (GAS f32x4*)(out + (size_t)row * D) + lane; const GAS v2u* yr = (const GAS v2u*)(Y + (size_t)row * D) + lane;
#pragma unroll
        for (int q = 0; q < 4; ++q) { const int k = 4 * (lane + 64 * q); f32x4 xv = orow[64 * q]; const v2u yw = yr[64 * q];
            const f32x4 g2 = *(const GAS f32x4*)(mod + b * 6144 + 5120 + k), gp = *(const GAS f32x4*)(gpost + k);
            xv[0] += g2[0] * (bflo(yw.x) * rstd * gp[0]); xv[1] += g2[1] * (bfhi(yw.x) * rstd * gp[1]); xv[2] += g2[2] * (bflo(yw.y) * rstd * gp[2]); xv[3] += g2[3] * (bfhi(yw.y) * rstd * gp[3]);
            orow[64 * q] = xv; }
    }
}

#ifdef PROBE_V_LOADS
__device__ __forceinline__ void probe_v_loads(const Args& A) {
    const int tid = threadIdx.x, lane = tid & 63, wave = tid >> 6, p = blockIdx.x & 7, j = blockIdx.x >> 3, nj = gridDim.x >> 3, g = lane >> 3, c = lane & 7;
    const unsigned char* V8 = (const unsigned char*)(A.ws + WS_V8); const unsigned short* EI = (const unsigned short*)(A.ws + WS_EIDX); const float* ACT = (const float*)(A.ws + WS_ACT);
    unsigned* DUMP = (unsigned*)(A.ws + WS_PD);
    const int tper = M / nj, colb = 128 * p + 16 * c, tend = (j + 1) * tper, tlast = tend - NWAVES + wave;
    int t = j * tper + wave;
    PeerIdx ix1 = peer_ld_idx(EI, min(t + NWAVES, tlast), g), ix2 = peer_ld_idx(EI, min(t + 2 * NWAVES, tlast), g);
    v4u rawa[16], rawb[16]; PeerAct aca, acb;
    { const PeerIdx ix0 = peer_ld_idx(EI, t, g); peer_gather(V8, ix0, colb, rawa); aca = peer_ld_act(ACT, t, g); }
    for (; t < tend; t += 2 * NWAVES) {
        const int t1 = t + NWAVES, t2 = min(t + 2 * NWAVES, tlast), t3 = min(t + 3 * NWAVES, tlast), t4 = min(t + 4 * NWAVES, tlast);
        const PeerIdx ix3 = peer_ld_idx(EI, t3, g);
        peer_gather(V8, ix1, colb, rawb); acb = peer_ld_act(ACT, t1, g);
        { unsigned s = __builtin_bit_cast(unsigned, aca.a0[0]) + __builtin_bit_cast(unsigned, aca.a3[3]);
#pragma unroll
          for (int k = 0; k < 16; ++k) s += (rawa[k].x + rawa[k].y) + (rawa[k].z + rawa[k].w);
          DUMP[(size_t)t * 512 + p * 64 + lane] = s; }
        const PeerIdx ix4 = peer_ld_idx(EI, t4, g);
        peer_gather(V8, ix2, colb, rawa); aca = peer_ld_act(ACT, t2, g);
        { unsigned s = __builtin_bit_cast(unsigned, acb.a0[0]) + __builtin_bit_cast(unsigned, acb.a3[3]);
#pragma unroll
          for (int k = 0; k < 16; ++k) s += (rawb[k].x + rawb[k].y) + (rawb[k].z + rawb[k].w);
          DUMP[(size_t)t1 * 512 + p * 64 + lane] = s; }
        ix1 = ix3; ix2 = ix4;
    }
}
#endif
#ifndef MK_N_LAUNCHES
#define MK_N_LAUNCHES 1
#endif
constexpr int N_PHASES = 13;
typedef const __attribute__((address_space(4))) Args* KArgP;
__device__ __forceinline__ const Args& kargs() { KArgP p = (KArgP)__builtin_amdgcn_kernarg_segment_ptr(); asm volatile("" : "+s"(p)); return *(const Args*)p; }
__global__ void __launch_bounds__(NTHR, 2) hymba_fwd(Args A_) {
    extern __shared__ __attribute__((aligned(16))) unsigned char lds_raw[];
    LAS unsigned char* lds = (LAS unsigned char*)lds_raw;
    const int lo = A_.ph_lo, hi = A_.ph_hi;
#define A kargs()
#define ws (kargs().ws)
#ifndef DBLMASK
#define DBLMASK 0
#endif
#define IN(k) (lo <= (k) && (k) < hi)
#define REP(k) for (int _rep = 0; _rep < (((DBLMASK) >> (k)) & 1) + 1; ++_rep)
    for (int u = threadIdx.x; u < (LDS_BYTES - RING_BYTES) / 4; u += NTHR) ((LAS unsigned*)(lds + RING_BYTES))[u] = 0u;
    __syncthreads();
    XcdBarrier xbar = xcd_barrier_post((unsigned*)(ws + WS_CTL) + CW_BAR, (volatile LAS unsigned*)(lds + MISC_OFF + 32));
#define SEAM(k) do { if (IN(k) && IN((k) + 1)) { if ((k) == 0) cg::this_grid().sync(); else xcd_barrier(xbar); } } while (0)

    if (IN(0)) REP(0) { phase_prologue(A, lds); } SEAM(0);
    if (IN(1)) REP(1) { phase_prenorm(A); } SEAM(1);
    if (IN(2)) REP(2) {
        pg8::Gemm g{(const pg8::bf16_t*)(ws + WS_H), (const pg8::bf16_t*)(ws + WS_WIN), M, NIN_PAD, D}; pg8::StaticOrder S; S.init(M, NIN_PAD, gridDim.x, (int)blockIdx.x);
        pg8::EpiProj E{(pg8::bf16_t*)(ws + WS_PROJ), NPROJ, (float*)(ws + WS_GATES), (const int*)A.in[I_POS], (const float*)A.in[I_BI], (const float*)A.in[I_BF]};
        pg8::gemm_phase<pg8::EpiProj, pg8::StaticOrder, true, true>(lds, g, S, E);
    } SEAM(2);
    if (IN(3)) REP(3) {
        phase_attn(A, lds);
        for (int wg = blockIdx.x; wg < 256; wg += gridDim.x) mlstm_group<false>(A, lds, wg);
    } SEAM(3);
    if (IN(4)) REP(4) { for (int wg = blockIdx.x; wg < 256; wg += gridDim.x) mlstm_group<true>(A, lds, wg); } SEAM(4);
    if (IN(5)) REP(5) {
        pg8::Gemm g{(const pg8::bf16_t*)(ws + WS_MIXIN), (const pg8::bf16_t*)(ws + WS_WOUT), M, D, D}; pg8::StaticOrder S; S.init(M, D, gridDim.x, (int)blockIdx.x);
        pg8::EpiMix E{(pg8::bf16_t*)(ws + WS_MIX), D, (float*)(ws + WS_SSQ)};
        pg8::gemm_phase<pg8::EpiMix, pg8::StaticOrder, true, true>(lds, g, S, E);
    } SEAM(5);
    if (IN(6)) REP(6) { phase_mid(A); } SEAM(6);
    if (IN(7)) REP(7) {
        pg8::Gemm g{(const pg8::bf16_t*)(ws + WS_H), (const pg8::bf16_t*)(ws + WS_WQ), M, 2048, D}; pg8::StaticOrder S; S.init(M, 2048, gridDim.x, (int)blockIdx.x);
        pg8::EpiPlain E{(pg8::bf16_t*)(ws + WS_PROJ), 2048};
        pg8::gemm_phase<pg8::EpiPlain, pg8::StaticOrder, true, true>(lds, g, S, E);
    } SEAM(7);
    if (IN(8)) REP(8) { phase_topk(A, lds); } SEAM(8);
    if (IN(9)) REP(9) { phase_peer_u(A); } SEAM(9);
    if (IN(10)) REP(10) { phase_peer_act(A); } SEAM(10);
#ifdef PROBE_V_LOADS
    if (IN(11)) { probe_v_loads(A); }
#endif
    if (IN(11)) REP(11) { phase_peer_v(A); } SEAM(11);
    if (IN(12)) REP(12) { phase_peer_final(A); }
#undef IN
#undef SEAM
#undef A
#undef ws
}

extern "C" void kernel_launch(void* const* d_in, const int* in_sizes, int n_in, void* d_out, int out_size, void* d_ws, size_t ws_size, hipStream_t stream) {
    static int grid = 0;
    if (grid == 0) {
        if (n_in != 21 || in_sizes[0] != M * D || out_size != M * D || ws_size < WS_END) { fprintf(stderr, "kernel_launch: unexpected shapes (n_in %d, in0 %d, out %d, ws %zu < %zu)\n", n_in, n_in > 0 ? in_sizes[0] : -1, out_size, ws_size, (size_t)WS_END); grid = -1; return; }
        int dev = 0, cus = 0, per_cu = 0;
        if (hipGetDevice(&dev) != hipSuccess || hipDeviceGetAttribute(&cus, hipDeviceAttributeMultiprocessorCount, dev) != hipSuccess) { grid = -1; return; }
        if (hipFuncSetAttribute((const void*)hymba_fwd, hipFuncAttributeMaxDynamicSharedMemorySize, LDS_BYTES) != hipSuccess) { fprintf(stderr, "kernel_launch: hipFuncSetAttribute failed\n"); grid = -1; return; }
        if (hipOccupancyMaxActiveBlocksPerMultiprocessor(&per_cu, (const void*)hymba_fwd, NTHR, LDS_BYTES) != hipSuccess || per_cu < 1) { fprintf(stderr, "kernel_launch: occupancy query says %d blocks per CU\n", per_cu); per_cu = 1; }
        (void)hipGetLastError();
        grid = cus;
        if (grid != 256) fprintf(stderr, "kernel_launch: note: %d CUs (built for 256)\n", grid);
    }
    if (grid < 0) return;
    (void)hipMemsetAsync((char*)d_ws + WS_CTL, 0, CTL_ZERO_BYTES, stream);
    Args a{};
    for (int i = 0; i < 21; ++i) a.in[i] = d_in[i];
    a.out = (float*)d_out; a.ws = (unsigned char*)d_ws;
    if (MK_N_LAUNCHES == 1) {
        a.ph_lo = 0; a.ph_hi = N_PHASES;
        void* args[] = {&a};
        const hipError_t e = hipLaunchCooperativeKernel((const void*)hymba_fwd, dim3(grid), dim3(NTHR), args, LDS_BYTES, stream);
        if (e != hipSuccess) fprintf(stderr, "kernel_launch: cooperative launch failed: %s (grid %d)\n", hipGetErrorString(e), grid);
    } else {
        for (int p = 0; p < N_PHASES; ++p) { a.ph_lo = p; a.ph_hi = p + 1; hipLaunchKernelGGL(hymba_fwd, dim3(grid), dim3(NTHR), LDS_BYTES, stream, a); }
    }
}
```

```cpp
#include <hip/hip_runtime.h>
#include <hip/hip_cooperative_groups.h>
#include <cstdio>
#include <cstdint>
namespace cg = cooperative_groups;
namespace pg8 {
#define PG8_LAS __attribute__((address_space(3)))
typedef unsigned short bf16_t;
typedef short bf16x8 __attribute__((ext_vector_type(8)));
typedef float f32x4 __attribute__((ext_vector_type(4)));
typedef unsigned u32x4 __attribute__((ext_vector_type(4)));
constexpr int BM = 256, BK = 64, HALF = 128, HTB = HALF * BK * 2  , STAGE_BYTES = 8 * HTB, NXCD = 8, WGM = 8;

__host__ __device__ __forceinline__ int lds_byte(int r, int c) { const int st = (r >> 4) * 2 + (c >> 5), rr = r & 15, cc = c & 31, ob = rr * 64 + cc * 2; return st * 1024 + (ob ^ (((ob >> 9) & 1) << 5)); }
__host__ __device__ __forceinline__ void stage_rc(int b, int& R, int& C) { const int st = b / 1024, sb = b % 1024, swz = sb ^ (((sb >> 9) & 1) << 5); R = (st >> 1) * 16 + swz / 64; C = (st & 1) * 32 + (swz % 64) / 2; }
__host__ __device__ __forceinline__ int perm32(int rho) { const int n = rho >> 4, i = rho & 15; return 8 * (i >> 2) + 4 * n + (i & 3); }

struct Unit { int pm, pn; };
struct Gemm { const bf16_t* A; const bf16_t* Bt; int M, N, K; };

struct StaticOrder {
    int nM, nN, nwg, G, c;
    __host__ __device__ void init(int M, int N, int G_, int c_) { nM = M / BM; nN = N / BM; nwg = nM * nN; G = G_; c = c_; }
    __host__ __device__ bool next(int i, Unit& u) const {
        const long L = (long)i * G + c; if (L >= nwg) return false;
        int wgid = (int)L; { const int q = nwg / NXCD, r = nwg % NXCD, xcd = wgid % NXCD, off = wgid / NXCD; wgid = (xcd < r ? xcd * (q + 1) : r * (q + 1) + (xcd - r) * q) + off; }
        const int nig = WGM * nN, gid = wgid / nig, fm = gid * WGM, gsz = (nM - fm) < WGM ? (nM - fm) : WGM;
        u.pm = fm + ((wgid % nig) % gsz); u.pn = (wgid % nig) / gsz; return true;
    }
    __device__ __forceinline__ void a_ready(const Unit&) const {}
    __device__ __forceinline__ void done(const Unit&) const {}
};

__device__ __forceinline__ unsigned cvt_pk_bf16(float lo, float hi) { unsigned r; asm volatile("v_cvt_pk_bf16_f32 %0, %1, %2" : "=v"(r) : "v"(lo), "v"(hi)); return r; }
typedef float f32x2 __attribute__((ext_vector_type(2)));
__device__ __forceinline__ f32x2 gelu_pk(f32x2 v) {
    const f32x2 av = __builtin_elementwise_abs(v), d = av * 0.2316418882f + 1.0f;
    f32x2 t; t.x = __builtin_amdgcn_rcpf(d.x); t.y = __builtin_amdgcn_rcpf(d.y);
    f32x2 q = t * 0.5307027145f + (-0.7265760135f); q = q * t + 0.7107068705f; q = q * t + (-0.142248368f); q = q * t + 0.127414796f; q = q * t;
    const f32x2 s = (v * v) * (-0.72134752044f);
    f32x2 e; e.x = __builtin_amdgcn_exp2f(s.x); e.y = __builtin_amdgcn_exp2f(s.y);
    const f32x2 m = v * (q * e), r = v - m;
    f32x2 o; o.x = v.x < 0.f ? m.x : r.x; o.y = v.y < 0.f ? m.y : r.y; return o;
}

__device__ __forceinline__ u32x4 pack8(const f32x4 v0, const f32x4 v1) { u32x4 w; w.x = cvt_pk_bf16(v0[0], v0[1]); w.y = cvt_pk_bf16(v0[2], v0[3]); w.z = cvt_pk_bf16(v1[0], v1[1]); w.w = cvt_pk_bf16(v1[2], v1[3]); return w; }

struct EpiPlain {
    static constexpr bool PERM = true, AFTER_DRAIN = false;
    bf16_t* O; int ldc;
    __device__ __forceinline__ void operator()(const f32x4 (&acc)[2][2][4][2], const Unit& u, int wr, int wc, int fr, int fq) const {
        const int row0 = u.pm * BM + wr * 64 + fr, col0 = u.pn * BM + wc * 32 + 8 * fq;
#pragma unroll
        for (int ai = 0; ai < 2; ++ai)
#pragma unroll
            for (int m = 0; m < 4; ++m) { bf16_t* rowp = O + (size_t)(row0 + ai * HALF + m * 16) * ldc + col0;
#pragma unroll
                for (int bj = 0; bj < 2; ++bj) *(u32x4*)(rowp + bj * HALF) = pack8(acc[ai][bj][m][0], acc[ai][bj][m][1]); }
    }
};

struct EpiProj {
    static constexpr bool PERM = true, AFTER_DRAIN = false;
    bf16_t* P; int ldc; float* gates; const int* pos; const float* b_i; const float* b_f;
    __device__ __forceinline__ void operator()(const f32x4 (&acc)[2][2][4][2], const Unit& u, int wr, int wc, int fr, int fq) const {
        const int row0 = u.pm * BM + wr * 64 + fr, col0 = u.pn * BM + wc * 32 + 8 * fq, pn = u.pn;
        if (pn == 9) {
            if (wc == 0 && fq == 0) {
                const f32x4 bi = {b_i[0], b_i[1], b_i[2], b_i[3]}, bf = {b_f[0], b_f[1], b_f[2], b_f[3]};
#pragma unroll
                for (int ai = 0; ai < 2; ++ai)
#pragma unroll
                    for (int m = 0; m < 4; ++m) { const int row = row0 + ai * HALF + m * 16;
                        const f32x4 iv = acc[ai][0][m][0] + bi, fv = acc[ai][0][m][1] + bf; f32x4 lf;
#pragma unroll
                        for (int j = 0; j < 4; ++j) lf[j] = fminf(fv[j], 0.f) - log1pf(__expf(-fabsf(fv[j])));
                        *(f32x4*)(gates + (size_t)row * 8) = iv; *(f32x4*)(gates + (size_t)row * 8 + 4) = lf; }
            }
            return;
        }
#pragma unroll
        for (int ai = 0; ai < 2; ++ai)
#pragma unroll
            for (int m = 0; m < 4; ++m) { const int row = row0 + ai * HALF + m * 16; bf16_t* rowp = P + (size_t)row * ldc + col0;
                const float posf = (pn <= 2) ? (float)pos[row] : 0.f;
#pragma unroll
                for (int bj = 0; bj < 2; ++bj) { f32x4 v0 = acc[ai][bj][m][0], v1 = acc[ai][bj][m][1];
                    const bool rope = (pn < 2) || (pn == 2 && bj == 0);
                    if (rope) {
                        const int p0 = ((col0 + bj * HALF) & 63) >> 1; const float sc = (pn < 2) ? 0.125f : 1.0f;
                        float x[8] = {v0[0], v0[1], v0[2], v0[3], v1[0], v1[1], v1[2], v1[3]};
#pragma unroll
                        for (int q = 0; q < 4; ++q) { const float invf = __builtin_amdgcn_exp2f(-(float)(p0 + q) * 0.41524101186092029f);
                            float r = posf * invf * 0.15915494309189535f; r = r - floorf(r);
                            const float c = __builtin_amdgcn_cosf(r) * sc, s = __builtin_amdgcn_sinf(r) * sc;
                            const float x1 = x[2 * q], x2 = x[2 * q + 1]; x[2 * q] = x1 * c - x2 * s; x[2 * q + 1] = x2 * c + x1 * s; }
                        v0 = (f32x4){x[0], x[1], x[2], x[3]}; v1 = (f32x4){x[4], x[5], x[6], x[7]};
                    } else if (pn >= 7) {
#pragma unroll
                        for (int j = 0; j < 4; ++j) { v0[j] = __builtin_amdgcn_rcpf(1.f + __expf(-v0[j])); v1[j] = __builtin_amdgcn_rcpf(1.f + __expf(-v1[j])); }
                    }
                    *(u32x4*)(rowp + bj * HALF) = pack8(v0, v1); } }
    }
};

struct EpiMix {
    static constexpr bool PERM = true, AFTER_DRAIN = false;
    bf16_t* O; int ldc; float* sumsq;
    __device__ __forceinline__ void operator()(const f32x4 (&acc)[2][2][4][2], const Unit& u, int wr, int wc, int fr, int fq) const {
        const int row0 = u.pm * BM + wr * 64 + fr, col0 = u.pn * BM + wc * 32 + 8 * fq;
#pragma unroll
        for (int ai = 0; ai < 2; ++ai)
#pragma unroll
            for (int m = 0; m < 4; ++m) { const int row = row0 + ai * HALF + m * 16; bf16_t* rowp = O + (size_t)row * ldc + col0; float s = 0.f;
#pragma unroll
                for (int bj = 0; bj < 2; ++bj) { const f32x4 v0 = acc[ai][bj][m][0], v1 = acc[ai][bj][m][1];
                    s += (v0[0] * v0[0] + v0[1] * v0[1]) + (v0[2] * v0[2] + v0[3] * v0[3]) + (v1[0] * v1[0] + v1[1] * v1[1]) + (v1[2] * v1[2] + v1[3] * v1[3]);
                    *(u32x4*)(rowp + bj * HALF) = pack8(v0, v1); }
                s += __shfl_xor(s, 16); s += __shfl_xor(s, 32);
                if (fq == 0) sumsq[(size_t)row * 16 + u.pn * 4 + wc] = s; }
    }
};
template <class Epi, class Sched, bool ALIGN_EPI = false, bool SP2 = false>
__device__ __forceinline__ void gemm_phase(PG8_LAS unsigned char* lds, const Gemm g, const Sched& S, const Epi& E) {
    const int tid = threadIdx.x, wid = __builtin_amdgcn_readfirstlane(tid >> 6), lane = tid & 63, wr = wid >> 2, wc = wid & 3, fr = lane & 15, fq = lane >> 4;
    const int K = g.K, nt = K / BK;
    unsigned voffA[2], voffB[2];
#pragma unroll
    for (int i = 0; i < 2; ++i) { int R, C; stage_rc(tid * 16 + i * 8192, R, C); const int Rb = Epi::PERM ? ((R & ~31) + perm32(R & 31)) : R;
        voffA[i] = (unsigned)(R * K + C) * 2u; voffB[i] = (unsigned)(Rb * K + C) * 2u; }
    const size_t kstep = (size_t)(BK * 2);
    const size_t hstep = (size_t)HALF * K * 2;
    const size_t tstep = 2 * hstep;
    const unsigned ldsw = (unsigned)wid * 1024u;
    const int aoff = lds_byte(wr * 64 + fr, fq * 8), boff = lds_byte(wc * 32 + fr, fq * 8);
#define PG8_SA(b, h) (((b) * 2 + (h)) * HTB)
#define PG8_SB(b, h) ((4 + (b) * 2 + (h)) * HTB)
#define PG8_STAGE(bufoff, gbase, voff) do { _Pragma("unroll") for (int _i = 0; _i < 2; ++_i) \
        __builtin_amdgcn_global_load_lds((const unsigned*)((const char*)(gbase) + (voff)[_i]), (PG8_LAS unsigned*)(lds + (bufoff) + ldsw + _i * 8192), 16, 0, 0); } while (0)
#define PG8_LDA(dst, b, h) do { _Pragma("unroll") for (int m = 0; m < 4; ++m) _Pragma("unroll") for (int k = 0; k < 2; ++k) dst[m][k] = *(const PG8_LAS bf16x8*)(lds + PG8_SA(b, h) + aoff + m * 2048 + k * 1024); } while (0)
#define PG8_LDB(dst, b, h) do { _Pragma("unroll") for (int n = 0; n < 2; ++n) _Pragma("unroll") for (int k = 0; k < 2; ++k) dst[n][k] = *(const PG8_LAS bf16x8*)(lds + PG8_SB(b, h) + boff + n * 2048 + k * 1024); } while (0)
#define PG8_MMA(ai, bj, At, Bt) do { __builtin_amdgcn_s_setprio(1); _Pragma("unroll") for (int m = 0; m < 4; ++m) _Pragma("unroll") for (int n = 0; n < 2; ++n) _Pragma("unroll") for (int k = 0; k < 2; ++k) \
        acc[ai][bj][m][n] = __builtin_amdgcn_mfma_f32_16x16x32_bf16(Bt[n][k], At[m][k], acc[ai][bj][m][n], 0, 0, 0); __builtin_amdgcn_s_setprio(0); } while (0)
#define PG8_WAIT_V(n) asm volatile("s_waitcnt vmcnt(" #n ")" ::: "memory")
#define PG8_WAIT_L(n) asm volatile("s_waitcnt lgkmcnt(" #n ")" ::: "memory")
#define PG8_BAR __builtin_amdgcn_s_barrier()
#define PG8_SCHED __builtin_amdgcn_sched_barrier(0)
    Unit cur, nxt; int ui = 0;
    if (!S.next(0, cur)) return;
    f32x4 acc[2][2][4][2];
#pragma unroll
    for (int a = 0; a < 2; ++a)
#pragma unroll
        for (int b = 0; b < 2; ++b)
#pragma unroll
            for (int m = 0; m < 4; ++m)
#pragma unroll
                for (int n = 0; n < 2; ++n) acc[a][b][m][n] = (f32x4){0.f, 0.f, 0.f, 0.f};
    bf16x8 At[4][2], B0[2][2], B1[2][2];
    const char* cA = (const char*)g.A + (size_t)cur.pm * tstep; const char* cB = (const char*)g.Bt + (size_t)cur.pn * tstep;
    S.a_ready(cur);
    if constexpr (SP2) {
        PG8_STAGE(PG8_SB(0, 0), cB, voffB); PG8_STAGE(PG8_SB(0, 1), cB + hstep, voffB); PG8_STAGE(PG8_SA(0, 0), cA, voffA); PG8_STAGE(PG8_SA(0, 1), cA + hstep, voffA);
        if (wr == 1) PG8_BAR;
        PG8_WAIT_V(2); PG8_BAR;
        PG8_STAGE(PG8_SB(1, 0), cB + kstep, voffB); PG8_STAGE(PG8_SA(1, 0), cA + kstep, voffA); PG8_STAGE(PG8_SB(1, 1), cB + hstep + kstep, voffB);
        PG8_WAIT_V(6); PG8_BAR;
    } else {
        PG8_STAGE(PG8_SB(0, 0), cB, voffB); PG8_STAGE(PG8_SA(0, 0), cA, voffA); PG8_STAGE(PG8_SB(0, 1), cB + hstep, voffB); PG8_STAGE(PG8_SA(0, 1), cA + hstep, voffA);
        if (wr == 1) PG8_BAR;
        PG8_WAIT_V(4); PG8_BAR;
        PG8_STAGE(PG8_SB(1, 0), cB + kstep, voffB); PG8_STAGE(PG8_SA(1, 0), cA + kstep, voffA); PG8_STAGE(PG8_SB(1, 1), cB + hstep + kstep, voffB);
        PG8_WAIT_V(6); PG8_BAR;
    }
    for (;;) {
        const bool has_next = S.next(ui + 1, nxt);
        const char* nA = has_next ? (const char*)g.A + (size_t)nxt.pm * tstep : cA; const char* nB = has_next ? (const char*)g.Bt + (size_t)nxt.pn * tstep : cB;
        for (int t = 0; t < nt; t += 2) {
            const bool last = (t == nt - 2);
            const char* a1 = cA + (size_t)(t + 1) * kstep;
            const char* a2 = last ? nA : cA + (size_t)(t + 2) * kstep; const char* b2 = last ? nB : cB + (size_t)(t + 2) * kstep;
            const char* a3 = a2 + kstep; const char* b3 = b2 + kstep;
            if (last && has_next) S.a_ready(nxt);
            if constexpr (SP2) {
            PG8_LDB(B0, 0, 0); PG8_LDB(B1, 0, 1); PG8_SCHED; PG8_LDA(At, 0, 0); PG8_STAGE(PG8_SA(1, 1), a1 + hstep, voffA);
            PG8_WAIT_V(8); PG8_WAIT_L(0); PG8_BAR; PG8_MMA(0, 0, At, B0); PG8_MMA(0, 1, At, B1); PG8_BAR; PG8_SCHED;
            PG8_LDA(At, 0, 1); PG8_STAGE(PG8_SB(0, 0), b2, voffB); PG8_STAGE(PG8_SB(0, 1), b2 + hstep, voffB); PG8_STAGE(PG8_SA(0, 0), a2, voffA);
            PG8_WAIT_V(8); PG8_WAIT_L(0); PG8_BAR; PG8_MMA(1, 0, At, B0); PG8_MMA(1, 1, At, B1); PG8_BAR; PG8_SCHED;
            PG8_LDB(B0, 1, 0); PG8_LDB(B1, 1, 1); PG8_SCHED; PG8_LDA(At, 1, 0); PG8_STAGE(PG8_SA(0, 1), a2 + hstep, voffA);
            PG8_WAIT_V(8); PG8_WAIT_L(0); PG8_BAR; PG8_MMA(0, 0, At, B0); PG8_MMA(0, 1, At, B1); PG8_BAR; PG8_SCHED;
            PG8_LDA(At, 1, 1); PG8_STAGE(PG8_SB(1, 0), b3, voffB); PG8_STAGE(PG8_SB(1, 1), b3 + hstep, voffB); PG8_STAGE(PG8_SA(1, 0), a3, voffA);
            PG8_WAIT_V(8); PG8_WAIT_L(0); PG8_BAR; PG8_MMA(1, 0, At, B0); PG8_MMA(1, 1, At, B1); PG8_BAR; PG8_SCHED;
            } else {
            PG8_LDB(B0, 0, 0); PG8_SCHED; PG8_LDA(At, 0, 0); PG8_STAGE(PG8_SA(1, 1), a1 + hstep, voffA);
            PG8_WAIT_L(8); PG8_BAR; PG8_WAIT_L(0); PG8_MMA(0, 0, At, B0); PG8_BAR; PG8_SCHED;
            PG8_LDB(B1, 0, 1); PG8_STAGE(PG8_SB(0, 0), b2, voffB);
            PG8_BAR; PG8_WAIT_L(0); PG8_MMA(0, 1, At, B1); PG8_BAR;
            PG8_LDA(At, 0, 1); PG8_STAGE(PG8_SA(0, 0), a2, voffA);
            PG8_BAR; PG8_WAIT_L(0); PG8_MMA(1, 0, At, B0); PG8_BAR; PG8_SCHED;
            PG8_STAGE(PG8_SB(0, 1), b2 + hstep, voffB);
            PG8_WAIT_V(6); PG8_BAR; PG8_MMA(1, 1, At, B1); PG8_BAR;
            PG8_LDB(B0, 1, 0); PG8_SCHED; PG8_LDA(At, 1, 0); PG8_STAGE(PG8_SA(0, 1), a2 + hstep, voffA);
            PG8_WAIT_L(8); PG8_BAR; PG8_WAIT_L(0); PG8_MMA(0, 0, At, B0); PG8_BAR; PG8_SCHED;
            PG8_LDB(B1, 1, 1); PG8_STAGE(PG8_SB(1, 0), b3, voffB);
            PG8_BAR; PG8_WAIT_L(0); PG8_MMA(0, 1, At, B1); PG8_BAR;
            PG8_LDA(At, 1, 1); PG8_STAGE(PG8_SA(1, 0), a3, voffA);
            PG8_BAR; PG8_WAIT_L(0); PG8_MMA(1, 0, At, B0); PG8_BAR; PG8_SCHED;
            PG8_STAGE(PG8_SB(1, 1), b3 + hstep, voffB);
            PG8_WAIT_V(6); PG8_BAR; PG8_MMA(1, 1, At, B1); PG8_BAR;
            }
        }
        if constexpr (ALIGN_EPI) { if (wr == 0) PG8_BAR; }
        if constexpr (!Epi::AFTER_DRAIN) { E(acc, cur, wr, wc, fr, fq); S.done(cur); }
        if (!has_next) break;
#pragma unroll
        for (int a = 0; a < 2; ++a)
#pragma unroll
            for (int b = 0; b < 2; ++b)
#pragma unroll
                for (int m = 0; m < 4; ++m)
#pragma unroll
                    for (int n = 0; n < 2; ++n) acc[a][b][m][n] = (f32x4){0.f, 0.f, 0.f, 0.f};
        cur = nxt; cA = nA; cB = nB; ++ui;
        if constexpr (ALIGN_EPI) { if (wr == 1) PG8_BAR; }
    }
    PG8_WAIT_V(0);
    if constexpr (!ALIGN_EPI) { if (wr == 0) PG8_BAR; }
    PG8_BAR;
    if constexpr (Epi::AFTER_DRAIN) { E.fused(acc, cur, wr, wc, fr, fq, lds, wid, lane); S.done(cur); }
#undef PG8_SA
#undef PG8_SB
#undef PG8_STAGE
#undef PG8_LDA
#undef PG8_LDB
#undef PG8_MMA
#undef PG8_WAIT_V
#undef PG8_WAIT_L
#undef PG8_BAR
#undef PG8_SCHED
}
}
constexpr int NB = 8, SEQ = 8192, D = 1024, M = NB * SEQ;
constexpr int DIN = 2312, NPROJ = 2304, NIN_PAD = 2560;
constexpr int C_AQ = 0, C_AK = 512, C_AV = 640, C_MQ = 768, C_MK = 1024, C_MV = 1280, C_MO = 1792;
constexpr int NEXP = 16384, NSLOT = 128;
constexpr float EPS = 1e-6f;
constexpr int NWAVES = 8, NTHR = 512;

constexpr size_t MiB = 1u << 20;
constexpr size_t WS_CTL = 0, CTL_ZERO_BYTES = 1 * MiB;
constexpr size_t WS_MOD = 1 * MiB;
constexpr size_t WS_WIN = 2 * MiB;
constexpr size_t WS_WOUT = 8 * MiB;
constexpr size_t WS_WQ = 10 * MiB;
constexpr size_t WS_KEYS = 14 * MiB;
constexpr size_t WS_GATES = 16 * MiB;
constexpr size_t WS_SSQ = 832 * MiB;
constexpr size_t WS_MST = 20 * MiB;
constexpr size_t WS_U8 = 32 * MiB, WS_V8 = 48 * MiB;
constexpr size_t WS_SC = 64 * MiB;
constexpr size_t WS_H = 96 * MiB;
constexpr size_t WS_PROJ = 224 * MiB;
constexpr size_t WS_MIXIN = 512 * MiB;
constexpr size_t WS_MIX = 640 * MiB;
constexpr size_t WS_EIDX = 768 * MiB, WS_GATE = 800 * MiB;
constexpr size_t WS_PD = 224 * MiB;
constexpr size_t WS_X1 = 512 * MiB;
constexpr size_t WS_ACT = 840 * MiB;
constexpr size_t WS_SSY = 872 * MiB;
constexpr size_t WS_H8 = 880 * MiB;
constexpr size_t WS_HS = 944 * MiB;
constexpr size_t WS_END = 945 * MiB;
constexpr int CW_BAR = 4096;
constexpr int CW_SUMSQ = 65536;
static_assert((CW_SUMSQ + M) * 4 <= (int)CTL_ZERO_BYTES, "ctl");

constexpr int RING_BYTES = 131072, MISC_OFF = RING_BYTES + 320, LDS_BYTES = 147456;

#define GAS __attribute__((address_space(1)))
#define LAS __attribute__((address_space(3)))
typedef unsigned short bf16;
typedef unsigned v4u __attribute__((ext_vector_type(4)));
typedef unsigned v2u __attribute__((ext_vector_type(2)));
typedef float f32x4 __attribute__((ext_vector_type(4)));
typedef GAS unsigned gu32;
#define LDS_WAIT() asm volatile("s_waitcnt lgkmcnt(0)" ::: "memory")
#define VM_WAIT() asm volatile("s_waitcnt vmcnt(0)" ::: "memory")
__device__ __forceinline__ unsigned f2bf(float f) { unsigned u = __builtin_bit_cast(unsigned, f); return (u + 0x7fffu + ((u >> 16) & 1u)) >> 16; }
__device__ __forceinline__ unsigned pk2(float lo, float hi) { return f2bf(lo) | (f2bf(hi) << 16); }
__device__ __forceinline__ float bflo(unsigned w) { return __builtin_bit_cast(float, w << 16); }
__device__ __forceinline__ float bfhi(unsigned w) { return __builtin_bit_cast(float, w & 0xffff0000u); }
__device__ __forceinline__ float bf1(bf16 h) { return __builtin_bit_cast(float, (unsigned)h << 16); }
__device__ __forceinline__ float wave_sum(float v) {
#pragma unroll
    for (int o = 1; o < 64; o <<= 1) v += __shfl_xor(v, o);
    return v;
}
__device__ __forceinline__ float wave_max(float v) {
#pragma unroll
    for (int o = 1; o < 64; o <<= 1) v = fmaxf(v, __shfl_xor(v, o));
    return v;
}

typedef float f32x2 __attribute__((ext_vector_type(2)));
__device__ __forceinline__ void cvt16_fp8(const v4u w, float (&o)[16]) {
    const unsigned ww[4] = {w.x, w.y, w.z, w.w};
#pragma unroll
    for (int i = 0; i < 4; ++i) { const f32x2 a = __builtin_amdgcn_cvt_pk_f32_fp8((int)ww[i], false), b = __builtin_amdgcn_cvt_pk_f32_fp8((int)ww[i], true);
        o[4 * i] = a.x; o[4 * i + 1] = a.y; o[4 * i + 2] = b.x; o[4 * i + 3] = b.y; }
}
__device__ __forceinline__ void p0_row_fp8(const float* src, unsigned char* dst, float* sc, int row, int lane) {
    const GAS f32x4* sp = (const GAS f32x4*)(src + (size_t)row * D + 16 * lane);
    const f32x4 a = sp[0], b = sp[1], c = sp[2], d = sp[3];
    float mx = 0.f;
#pragma unroll
    for (int i = 0; i < 4; ++i) mx = fmaxf(fmaxf(fmaxf(mx, fabsf(a[i])), fmaxf(fabsf(b[i]), fabsf(c[i]))), fabsf(d[i]));
    mx = wave_max(mx); const float s = mx > 0.f ? 224.0f / mx : 1.0f;
    v4u o; int w;
    w = __builtin_amdgcn_cvt_pk_fp8_f32(a[0] * s, a[1] * s, 0, false); w = __builtin_amdgcn_cvt_pk_fp8_f32(a[2] * s, a[3] * s, w, true); o.x = (unsigned)w;
    w = __builtin_amdgcn_cvt_pk_fp8_f32(b[0] * s, b[1] * s, 0, false); w = __builtin_amdgcn_cvt_pk_fp8_f32(b[2] * s, b[3] * s, w, true); o.y = (unsigned)w;
    w = __builtin_amdgcn_cvt_pk_fp8_f32(c[0] * s, c[1] * s, 0, false); w = __builtin_amdgcn_cvt_pk_fp8_f32(c[2] * s, c[3] * s, w, true); o.z = (unsigned)w;
    w = __builtin_amdgcn_cvt_pk_fp8_f32(d[0] * s, d[1] * s, 0, false); w = __builtin_amdgcn_cvt_pk_fp8_f32(d[2] * s, d[3] * s, w, true); o.w = (unsigned)w;
    *(GAS v4u*)(dst + (size_t)row * D + 16 * lane) = o;
    if (lane == 0) sc[row] = mx > 0.f ? mx * (1.0f / 224.0f) : 1.0f;
}

__device__ __forceinline__ unsigned pack4_i8(float a, float b, float c, float d) { return ((unsigned)__float2int_rn(a) & 0xffu) | (((unsigned)__float2int_rn(b) & 0xffu) << 8) | (((unsigned)__float2int_rn(c) & 0xffu) << 16) | (((unsigned)__float2int_rn(d) & 0xffu) << 24); }
__device__ __forceinline__ void p0_row_i8(const float* src, unsigned char* dst, float* sc, int row, int lane) {
    const GAS f32x4* sp = (const GAS f32x4*)(src + (size_t)row * D + 16 * lane);
    const f32x4 a = sp[0], b = sp[1], c = sp[2], d = sp[3];
    float mx = 0.f;
#pragma unroll
    for (int i = 0; i < 4; ++i) mx = fmaxf(fmaxf(fmaxf(mx, fabsf(a[i])), fmaxf(fabsf(b[i]), fabsf(c[i]))), fabsf(d[i]));
    mx = wave_max(mx); const float s = mx > 0.f ? 127.0f / mx : 1.0f;
    v4u o; o.x = pack4_i8(a[0] * s, a[1] * s, a[2] * s, a[3] * s); o.y = pack4_i8(b[0] * s, b[1] * s, b[2] * s, b[3] * s); o.z = pack4_i8(c[0] * s, c[1] * s, c[2] * s, c[3] * s); o.w = pack4_i8(d[0] * s, d[1] * s, d[2] * s, d[3] * s);
    *(GAS v4u*)(dst + (size_t)row * D + 16 * lane) = o;
    if (lane == 0) sc[row] = mx > 0.f ? mx * (1.0f / 127.0f) : 1.0f;
}

__device__ __forceinline__ unsigned pack8_i4(const f32x4 a, const f32x4 b, float s) {
    unsigned w = 0;
#pragma unroll
    for (int i = 0; i < 4; ++i) { const int qa = max(-8, min(7, __float2int_rn(a[i] * s))), qb = max(-8, min(7, __float2int_rn(b[i] * s))); w |= ((unsigned)qa & 15u) << (4 * i); w |= ((unsigned)qb & 15u) << (16 + 4 * i); }
    return w;
}
__device__ __forceinline__ void p0_row_i4(const float* src, unsigned char* dst, float* sc, int row, int lane) {
    const GAS f32x4* sp = (const GAS f32x4*)(src + (size_t)row * D + 16 * lane);
    const f32x4 a = sp[0], b = sp[1], c = sp[2], d = sp[3];
    float ss = 0.f;
#pragma unroll
    for (int i = 0; i < 4; ++i) ss += (a[i] * a[i] + b[i] * b[i]) + (c[i] * c[i] + d[i] * d[i]);
    ss = wave_sum(ss); const float sig = sqrtf(ss * (1.f / D)), s = sig > 0.f ? 3.0f / sig : 1.0f;
    v2u o; o.x = pack8_i4(a, b, s); o.y = pack8_i4(c, d, s);
    *(GAS v2u*)(dst + (size_t)row * (D / 2) + 8 * lane) = o;
    if (lane == 0) sc[row] = sig > 0.f ? sig * (1.0f / 3.0f) : 1.0f;
}
#define XB_TMO      128
#define XB_XCNT(j)  (256  + 64 * (j))
#define XB_XSUB(j)  (1280 + 64 * (j))
#define XB_XGEN(j)  (2304 + 64 * (j))
#define XB_TOP      3328
#define XB_TOPGEN   3392
#define XCD_BAR_WORDS 3456
#define XB_SPIN_CAP (1u << 18)

__device__ __forceinline__ unsigned xb_ld(unsigned* p)              { return __hip_atomic_load(p, __ATOMIC_RELAXED, __HIP_MEMORY_SCOPE_AGENT); }
__device__ __forceinline__ unsigned xb_add(unsigned* p, unsigned v) { return __hip_atomic_fetch_add(p, v, __ATOMIC_RELAXED, __HIP_MEMORY_SCOPE_AGENT); }
__device__ __forceinline__ unsigned xb_xcc_id() { return (unsigned)__builtin_amdgcn_s_getreg((3 << 11) | 20) & 0xFu; }
#define XB_SPIN(cond, bar) do { unsigned _sp = 0; while (cond) { __builtin_amdgcn_s_sleep(1); \
    if ((++_sp & 255u) == 0u) { if (xb_ld(&(bar)[XB_TMO])) break; if (_sp > XB_SPIN_CAP) { atomicAdd(&(bar)[XB_TMO], 1u); break; } } } } while (0)

struct XcdBarrier {
    unsigned* bar; unsigned x;
    volatile LAS unsigned* st;
};

__device__ __forceinline__ XcdBarrier xcd_barrier_post(unsigned* bar, volatile LAS unsigned* st) {
    XcdBarrier b; b.bar = bar; b.x = xb_xcc_id(); b.st = st;
    if (threadIdx.x == 0) (void)xb_add(&bar[XB_XCNT(b.x)], 1u);
    return b;
}
__device__ __forceinline__ void xcd_barrier_complete(unsigned* bar, unsigned x, unsigned& nloc, unsigned& nx) {
    const unsigned G = gridDim.x * gridDim.y * gridDim.z;
    unsigned sum, cnt, mine, sp = 0u;
    for (;;) {
        sum = 0u; cnt = 0u; mine = 0u;
#pragma unroll
        for (unsigned j = 0; j < 16; ++j) { const unsigned c = xb_ld(&bar[XB_XCNT(j)]); sum += c; cnt += (c > 0u) ? 1u : 0u; mine = (j == x) ? c : mine; }
        if (sum == G) break;
        __builtin_amdgcn_s_sleep(1);
        if ((++sp & 255u) == 0u) { if (xb_ld(&bar[XB_TMO])) break; if (sp > XB_SPIN_CAP) { atomicAdd(&bar[XB_TMO], 1u); break; } }
    }
    nloc = mine > 0u ? mine : 1u; nx = cnt > 0u ? cnt : 1u;
}

__device__ __forceinline__ void xcd_barrier(const XcdBarrier& b) {
    asm volatile("s_waitcnt vmcnt(0)" ::: "memory");
    __syncthreads();
    if (threadIdx.x == 0) {
        unsigned* bar = b.bar;
        __builtin_amdgcn_s_waitcnt(0);
        unsigned nloc = b.st[0], nx = b.st[1];
        if (nloc == 0u) { xcd_barrier_complete(bar, b.x, nloc, nx); b.st[0] = nloc; b.st[1] = nx; }
        const unsigned old = xb_add(&bar[XB_XSUB(b.x)], 1u);
        const unsigned gen = old / nloc;
        if (old + 1u == (gen + 1u) * nloc) {
            __builtin_amdgcn_fence(__ATOMIC_RELEASE, "agent");
            asm volatile("s_waitcnt vmcnt(0)" ::: "memory");
            const unsigned og = xb_add(&bar[XB_TOP], 1u);
            const unsigned tg = og / nx;
            if (og + 1u == (tg + 1u) * nx) xb_add(&bar[XB_TOPGEN], 1u);
            else XB_SPIN(xb_ld(&bar[XB_TOPGEN]) == tg, bar);
            __builtin_amdgcn_fence(__ATOMIC_ACQUIRE, "agent");
            xb_add(&bar[XB_XGEN(b.x)], 1u);
            asm volatile("s_waitcnt vmcnt(0)" ::: "memory");
        } else {
            XB_SPIN(xb_ld(&bar[XB_XGEN(b.x)]) == gen, bar);
            __builtin_amdgcn_fence(__ATOMIC_ACQUIRE, "agent");
            asm volatile("s_waitcnt vmcnt(0)" ::: "memory");
        }
    }
    __syncthreads();
}
struct Args { const void* in[21]; float* out; unsigned char* ws; int ph_lo, ph_hi; };
enum { I_X = 0, I_C, I_POS, I_WMOD, I_BMOD, I_GPRE1, I_GPOST1, I_WIN, I_CONVW, I_BI, I_BF, I_MNG, I_SINK, I_WOUT, I_GPRE2, I_GPOST2, I_WQ, I_K1, I_K2, I_U, I_V };

__device__ __forceinline__ int newcol(int o) {
    if (o < 640) { const int hd = o >> 6, d = o & 63; return (hd << 6) + 2 * (d & 31) + (d >> 5); }
    if (o < 1792) return o;
    if (o < 1800) return 2304 + (o - 1792);
    return o - 8;
}
template <bool REMAP>
__device__ __forceinline__ void p0_transpose_item(const float* W, int K, int N, bf16* WT, LAS float* scr, int item, int lane) {
    const int nblk = (N + 31) / 32, kb = item / nblk, nb = item % nblk, k0 = 64 * kb, n0 = 32 * nb;
    const int ncol = n0 + (lane & 31);
#pragma unroll 8
    for (int i = 0; i < 32; ++i) { const int kk = 2 * i + (lane >> 5); scr[kk * 33 + (lane & 31)] = (ncol < N) ? W[(size_t)(k0 + kk) * N + ncol] : 0.f; }
    LDS_WAIT(); asm volatile("" ::: "memory");
    const int c = lane & 7;
#pragma unroll
    for (int j = 0; j < 4; ++j) { const int n = (lane >> 3) + 8 * j; const LAS float* s = scr + (8 * c) * 33 + n;
        v4u o; o.x = pk2(s[0 * 33], s[1 * 33]); o.y = pk2(s[2 * 33], s[3 * 33]); o.z = pk2(s[4 * 33], s[5 * 33]); o.w = pk2(s[6 * 33], s[7 * 33]);
        if (n0 + n < N) { const int drow = REMAP ? newcol(n0 + n) : (n0 + n); *(GAS v4u*)(WT + (size_t)drow * K + k0 + 8 * c) = o; } }
    LDS_WAIT(); asm volatile("" ::: "memory");
}
__device__ __forceinline__ void p0_convert(const float* src, bf16* dst, size_t n, int gt, int ngt) {
    for (size_t i = (size_t)gt * 8; i < n; i += (size_t)ngt * 8) {
        const f32x4 a = *(const GAS f32x4*)(src + i), b = *(const GAS f32x4*)(src + i + 4);
        v4u o; o.x = pk2(a[0], a[1]); o.y = pk2(a[2], a[3]); o.z = pk2(b[0], b[1]); o.w = pk2(b[2], b[3]);
        *(GAS v4u*)(dst + i) = o; }
}
__device__ __forceinline__ void phase_mod(const Args& A, LAS unsigned char* lds) {
    const int tid = threadIdx.x, G = gridDim.x, blk = blockIdx.x;
    unsigned char* ws = A.ws;
    const float* c = (const float*)A.in[I_C]; const float* wm = (const float*)A.in[I_WMOD]; const float* bm = (const float*)A.in[I_BMOD];
    float* mod = (float*)(ws + WS_MOD); LAS float* cs = (LAS float*)lds; LAS float* red = cs + 8 * 1024;
    for (int e = tid; e < 8 * 1024 / 4; e += NTHR) *(LAS f32x4*)(cs + 4 * e) = *(const GAS f32x4*)(c + 4 * e);
    __syncthreads();
    for (int it = blk; it < 6144 / 24; it += G) {
        const int kg = tid >> 5, col = tid & 31, j = it * 24 + (col < 24 ? col : 23); float acc[8];
#pragma unroll
        for (int b = 0; b < 8; ++b) acc[b] = 0.f;
#pragma unroll 16
        for (int i = 0; i < 64; ++i) { const int k = kg + 16 * i; const float w = wm[(size_t)k * 6144 + j];
#pragma unroll
            for (int b = 0; b < 8; ++b) acc[b] += cs[b * 1024 + k] * w; }
#pragma unroll
        for (int b = 0; b < 8; ++b) red[(kg * 32 + col) * 8 + b] = acc[b];
        __syncthreads();
        if (tid < 256) { const int b = tid >> 5, cc = tid & 31; float s = 0.f;
#pragma unroll
            for (int g = 0; g < 16; ++g) s += red[(g * 32 + cc) * 8 + b];
            if (cc < 24) mod[b * 6144 + it * 24 + cc] = s + bm[it * 24 + cc]; }
        __syncthreads();
    }
}
__device__ __forceinline__ void phase_convert(const Args& A, LAS unsigned char* lds) {
    const int tid = threadIdx.x, lane = tid & 63, wave = tid >> 6, G = gridDim.x, blk = blockIdx.x;
    unsigned char* ws = A.ws;
    {
        LAS float* scr = (LAS float*)(lds + wave * 16384);
        const int gw = blk * NWAVES + wave, NGW = G * NWAVES;
        const int I_IN = (D / 64) * ((DIN + 31) / 32), I_OUT = (D / 64) * (D / 32), I_Q = (D / 64) * (2048 / 32);
        bf16* win = (bf16*)(ws + WS_WIN); bf16* wout = (bf16*)(ws + WS_WOUT); bf16* wq = (bf16*)(ws + WS_WQ);
        for (int it = gw; it < I_IN + I_OUT + I_Q; it += NGW) {
            int r = it;
            if (r < I_IN) { p0_transpose_item<true>((const float*)A.in[I_WIN], D, DIN, win, scr, r, lane); continue; } r -= I_IN;
            if (r < I_OUT) { p0_transpose_item<false>((const float*)A.in[I_WOUT], D, D, wout, scr, r, lane); continue; } r -= I_OUT;
            p0_transpose_item<false>((const float*)A.in[I_WQ], D, 2048, wq, scr, r, lane);
        }
        const int gt = blk * NTHR + tid, ngt = G * NTHR;
        for (int i = gt; i < (NIN_PAD - DIN) * D / 8; i += ngt) *(GAS v4u*)(win + (size_t)DIN * D + (size_t)i * 8) = (v4u){0u, 0u, 0u, 0u};
        p0_convert((const float*)A.in[I_K1], (bf16*)(ws + WS_KEYS), (size_t)8 * 128 * 128, gt, ngt);
        p0_convert((const float*)A.in[I_K2], (bf16*)(ws + WS_KEYS) + 8 * 128 * 128, (size_t)8 * 128 * 128, gt, ngt);
        for (int r = gw; r < 2 * NEXP; r += NGW) { if (r < NEXP) p0_row_i4((const float*)A.in[I_U], ws + WS_U8, (float*)(ws + WS_SC), r, lane); else p0_row_fp8((const float*)A.in[I_V], ws + WS_V8, (float*)(ws + WS_SC) + NEXP, r - NEXP, lane); }
    }
}

__device__ __forceinline__ void phase_prenorm(const Args& A) {
    const int tid = threadIdx.x, lane = tid & 63, wave = tid >> 6, G = gridDim.x;
    const float* x = (const float*)A.in[I_X]; const float* g = (const float*)A.in[I_GPRE1]; const float* mod = (const float*)(A.ws + WS_MOD);
    bf16* H = (bf16*)(A.ws + WS_H);
    for (int row = blockIdx.x * NWAVES + wave; row < M; row += G * NWAVES) {
        const int b = row / SEQ; const GAS f32x4* xr = (const GAS f32x4*)(x + (size_t)row * D) + lane;
        f32x4 v[4]; float s = 0.f;
#pragma unroll
        for (int j = 0; j < 4; ++j) { v[j] = xr[64 * j]; s += (v[j][0] * v[j][0] + v[j][1] * v[j][1]) + (v[j][2] * v[j][2] + v[j][3] * v[j][3]); }
        const float rstd = 1.0f / sqrtf(wave_sum(s) * (1.f / D) + EPS);
        GAS v2u* o = (GAS v2u*)(H + (size_t)row * D) + lane;
#pragma unroll
        for (int j = 0; j < 4; ++j) { const int k = 4 * (lane + 64 * j);
            const f32x4 gg = *(const GAS f32x4*)(g + k), sh = *(const GAS f32x4*)(mod + b * 6144 + k), sc = *(const GAS f32x4*)(mod + b * 6144 + 1024 + k);
            f32x4 y;
#pragma unroll
            for (int i = 0; i < 4; ++i) y[i] = v[j][i] * rstd * gg[i] * (1.f + sc[i]) + sh[i];
            v2u w; w.x = pk2(y[0], y[1]); w.y = pk2(y[2], y[3]); o[64 * j] = w; }
    }
}

__device__ __forceinline__ void phase_mid(const Args& A) {
    const int tid = threadIdx.x, lane = tid & 63, wave = tid >> 6, G = gridDim.x;
    const float* x = (const float*)A.in[I_X]; const float* gpost = (const float*)A.in[I_GPOST1]; const float* gpre = (const float*)A.in[I_GPRE2];
    const float* mod = (const float*)(A.ws + WS_MOD); const float* sumsq = (const float*)(A.ws + WS_SSQ);
    const bf16* MIX = (const bf16*)(A.ws + WS_MIX); bf16* H = (bf16*)(A.ws + WS_H); bf16* X1 = (bf16*)(A.ws + WS_X1);
    for (int row = blockIdx.x * NWAVES + wave; row < M; row += G * NWAVES) {
        const int b = row / SEQ; const GAS f32x4* xr = (const GAS f32x4*)(x + (size_t)row * D) + lane; const GAS v2u* mr = (const GAS v2u*)(MIX + (size_t)row * D) + lane;
        const f32x4 q0 = *(const GAS f32x4*)(sumsq + (size_t)row * 16), q1 = *(const GAS f32x4*)(sumsq + (size_t)row * 16 + 4), q2 = *(const GAS f32x4*)(sumsq + (size_t)row * 16 + 8), q3 = *(const GAS f32x4*)(sumsq + (size_t)row * 16 + 12);
        const float rm = 1.0f / sqrtf(((((q0[0] + q0[1]) + (q0[2] + q0[3])) + ((q1[0] + q1[1]) + (q1[2] + q1[3]))) + (((q2[0] + q2[1]) + (q2[2] + q2[3])) + ((q3[0] + q3[1]) + (q3[2] + q3[3])))) * (1.f / D) + EPS);
        f32x4 v[4]; float s = 0.f;
#pragma unroll
        for (int j = 0; j < 4; ++j) { const int k = 4 * (lane + 64 * j); const f32x4 xv = xr[64 * j]; const v2u mw = mr[64 * j];
            const f32x4 gp = *(const GAS f32x4*)(gpost + k), g1 = *(const GAS f32x4*)(mod + b * 6144 + 2048 + k);
            const float mx[4] = {bflo(mw.x), bfhi(mw.x), bflo(mw.y), bfhi(mw.y)};
#pragma unroll
            for (int i = 0; i < 4; ++i) { v[j][i] = xv[i] + g1[i] * (mx[i] * rm * gp[i]); s += v[j][i] * v[j][i]; }
            { v2u w; w.x = pk2(v[j][0], v[j][1]); w.y = pk2(v[j][2], v[j][3]); *((GAS v2u*)(X1 + (size_t)row * D) + lane + 64 * j) = w; } }
        const float rstd = 1.0f / sqrtf(wave_sum(s) * (1.f / D) + EPS);
        GAS v2u* o = (GAS v2u*)(H + (size_t)row * D) + lane; float amx = 0.f;
#pragma unroll
        for (int j = 0; j < 4; ++j) { const int k = 4 * (lane + 64 * j);
            const f32x4 gg = *(const GAS f32x4*)(gpre + k), sh = *(const GAS f32x4*)(mod + b * 6144 + 3072 + k), sc = *(const GAS f32x4*)(mod + b * 6144 + 4096 + k);
#pragma unroll
            for (int i = 0; i < 4; ++i) { v[j][i] = v[j][i] * rstd * gg[i] * (1.f + sc[i]) + sh[i]; amx = fmaxf(amx, fabsf(v[j][i])); }
            v2u w; w.x = pk2(v[j][0], v[j][1]); w.y = pk2(v[j][2], v[j][3]); o[64 * j] = w; }
        amx = wave_max(amx); const float s8 = amx > 0.f ? 119.0f / amx : 1.0f;
        GAS unsigned short* ohh = (GAS unsigned short*)((unsigned char*)A.ws + WS_H8 + (size_t)row * (D / 2)) + lane; GAS unsigned short* ohl = (GAS unsigned short*)((unsigned char*)A.ws + WS_H8 + 32 * MiB + (size_t)row * (D / 2)) + lane;
#pragma unroll
        for (int j = 0; j < 4; ++j) { unsigned whh = 0, whl = 0;
#pragma unroll
            for (int i = 0; i < 4; ++i) { const int tq = __float2int_rn(v[j][i] * s8) + 8; whh |= ((unsigned)(tq >> 4) & 15u) << (4 * i); whl |= ((unsigned)((tq & 15) - 8) & 15u) << (4 * i); }
            ohh[64 * j] = (unsigned short)whh; ohl[64 * j] = (unsigned short)whl; }
        if (lane == 0) ((float*)(A.ws + WS_HS))[row] = amx > 0.f ? amx * (1.0f / 119.0f) : 1.0f;
    }
}
__device__ __forceinline__ void load64bf(const bf16* p, float (&o)[64]) {
#pragma unroll
    for (int i = 0; i < 8; ++i) { const v4u w = *(const GAS v4u*)(p + 8 * i);
        o[8 * i + 0] = bflo(w.x); o[8 * i + 1] = bfhi(w.x); o[8 * i + 2] = bflo(w.y); o[8 * i + 3] = bfhi(w.y);
        o[8 * i + 4] = bflo(w.z); o[8 * i + 5] = bfhi(w.z); o[8 * i + 6] = bflo(w.w); o[8 * i + 7] = bfhi(w.w); }
}
__device__ __forceinline__ void phase_attn_naive(const Args& A, int vb, int nvb) {
    const bf16* P = (const bf16*)(A.ws + WS_PROJ); bf16* MI = (bf16*)(A.ws + WS_MIXIN); const float* sinks = (const float*)A.in[I_SINK];
    for (int task = vb * NTHR + (int)threadIdx.x; task < 8 * M; task += nvb * NTHR) {
        const int h = task / M, t = task % M, s = t % SEQ, kvh = h >> 2;
        float q[64], o[64];
        load64bf(P + (size_t)t * NPROJ + C_AQ + h * 64, q);
#pragma unroll
        for (int d = 0; d < 64; ++d) o[d] = 0.f;
        float mx = sinks[h], l = 1.f;
        for (int j = 0; j < 128; ++j) {
            const int sj = s - 127 + j; const bool valid = sj >= 0; const int tk = valid ? (t - 127 + j) : t;
            const bf16* kr = P + (size_t)tk * NPROJ + C_AK + kvh * 64; float sc = 0.f;
#pragma unroll
            for (int i = 0; i < 8; ++i) { const v4u w = *(const GAS v4u*)(kr + 8 * i);
                sc += q[8 * i + 0] * bflo(w.x) + q[8 * i + 1] * bfhi(w.x) + q[8 * i + 2] * bflo(w.y) + q[8 * i + 3] * bfhi(w.y)
                    + q[8 * i + 4] * bflo(w.z) + q[8 * i + 5] * bfhi(w.z) + q[8 * i + 6] * bflo(w.w) + q[8 * i + 7] * bfhi(w.w); }
            if (valid) {
                const float mn = fmaxf(mx, sc), al = __expf(mx - mn), p = __expf(sc - mn); mx = mn; l = l * al + p;
                const bf16* vr = P + (size_t)tk * NPROJ + C_AV + kvh * 64;
#pragma unroll
                for (int i = 0; i < 8; ++i) { const v4u w = *(const GAS v4u*)(vr + 8 * i);
                    o[8 * i + 0] = o[8 * i + 0] * al + p * bflo(w.x); o[8 * i + 1] = o[8 * i + 1] * al + p * bfhi(w.x);
                    o[8 * i + 2] = o[8 * i + 2] * al + p * bflo(w.y); o[8 * i + 3] = o[8 * i + 3] * al + p * bfhi(w.y);
                    o[8 * i + 4] = o[8 * i + 4] * al + p * bflo(w.z); o[8 * i + 5] = o[8 * i + 5] * al + p * bfhi(w.z);
                    o[8 * i + 6] = o[8 * i + 6] * al + p * bflo(w.w); o[8 * i + 7] = o[8 * i + 7] * al + p * bfhi(w.w); }
            }
        }
        const float il = 1.f / l; bf16* orow = MI + (size_t)t * D + h * 64;
#pragma unroll
        for (int i = 0; i < 8; ++i) { v4u w; w.x = pk2(o[8 * i] * il, o[8 * i + 1] * il); w.y = pk2(o[8 * i + 2] * il, o[8 * i + 3] * il);
            w.z = pk2(o[8 * i + 4] * il, o[8 * i + 5] * il); w.w = pk2(o[8 * i + 6] * il, o[8 * i + 7] * il); *(GAS v4u*)(orow + 8 * i) = w; }
    }
}

__device__ __forceinline__ void phase_mlstm_naive(const Args& A, LAS unsigned char* lds, int bh) {
    const int tid = threadIdx.x, lane = tid & 63, wave = tid >> 6, b = bh >> 2, h = bh & 3, dv = tid >> 2, part = tid & 3;
    const bf16* P = (const bf16*)(A.ws + WS_PROJ); bf16* MI = (bf16*)(A.ws + WS_MIXIN); const float* gates = (const float*)(A.ws + WS_GATES);
    const float* cw = (const float*)A.in[I_CONVW]; const float* ng = (const float*)A.in[I_MNG];
    LAS float* qs = (LAS float*)lds; LAS float* ks = qs + 64 * 64; LAS float* vs = ks + 64 * 64; LAS float* ig = vs + 64 * 128; LAS float* lfg = ig + 64; LAS float* hb = lfg + 64;
    float C[16], n[16]; float m = 0.f;
#pragma unroll
    for (int j = 0; j < 16; ++j) { C[j] = 0.f; n[j] = 0.f; }
    for (int ch = 0; ch < SEQ / 64; ++ch) {
        const int s0 = ch * 64; const size_t t0 = (size_t)b * SEQ + s0;
        for (int e = tid; e < 64 * 64; e += NTHR) { const int l = e >> 6, dk = e & 63; float aq = 0.f, ak = 0.f;
#pragma unroll
            for (int j = 0; j < 4; ++j) { const int sj = s0 + l - 3 + j; if (sj >= 0) { const bf16* r = P + ((size_t)b * SEQ + sj) * NPROJ;
                aq += cw[j * 512 + h * 64 + dk] * bf1(r[C_MQ + h * 64 + dk]); ak += cw[j * 512 + 256 + h * 64 + dk] * bf1(r[C_MK + h * 64 + dk]); } }
            qs[e] = 0.125f * aq / (1.f + __expf(-aq)); ks[e] = ak / (1.f + __expf(-ak)); }
        for (int e = tid; e < 64 * 128; e += NTHR) { const int l = e >> 7, d = e & 127; vs[e] = bf1(P[(t0 + l) * NPROJ + C_MV + h * 128 + d]); }
        if (tid < 64) { ig[tid] = gates[(t0 + tid) * 8 + h]; lfg[tid] = gates[(t0 + tid) * 8 + 4 + h]; }
        __syncthreads();
        for (int l = 0; l < 64; ++l) {
            const float lf = lfg[l], ii = ig[l], mn = fmaxf(lf + m, ii), fd = __expf(lf + m - mn), iw = __expf(ii - mn), vv = vs[l * 128 + dv] * iw;
            float num = 0.f, den = 0.f;
#pragma unroll
            for (int j = 0; j < 16; ++j) { const float kk = ks[l * 64 + part * 16 + j], qq = qs[l * 64 + part * 16 + j];
                C[j] = fd * C[j] + vv * kk; n[j] = fd * n[j] + iw * kk; num += C[j] * qq; den += n[j] * qq; }
            num += __shfl_xor(num, 1); num += __shfl_xor(num, 2); den += __shfl_xor(den, 1); den += __shfl_xor(den, 2);
            if (part == 0) hb[l * 128 + dv] = num / fmaxf(fabsf(den), __expf(-mn));
            m = mn;
        }
        __syncthreads();
        for (int l = wave * 8; l < wave * 8 + 8; ++l) { const float a0 = hb[l * 128 + lane], a1 = hb[l * 128 + 64 + lane];
            const float r = 1.0f / sqrtf(wave_sum(a0 * a0 + a1 * a1) * (1.f / 128.f) + EPS);
            const bf16* pr = P + (t0 + l) * NPROJ + C_MO + h * 128; bf16* orow = MI + (t0 + l) * D + 512 + h * 128;
            orow[lane] = (bf16)f2bf(a0 * r * ng[h * 128 + lane] * bf1(pr[lane])); orow[64 + lane] = (bf16)f2bf(a1 * r * ng[h * 128 + 64 + lane] * bf1(pr[64 + lane])); }
        __syncthreads();
    }
}

__device__ __forceinline__ void ld16bf(const bf16* p, float (&o)[16]) {
    const v4u w0 = *(const GAS v4u*)p, w1 = *(const GAS v4u*)(p + 8);
    o[0] = bflo(w0.x); o[1] = bfhi(w0.x); o[2] = bflo(w0.y); o[3] = bfhi(w0.y); o[4] = bflo(w0.z); o[5] = bfhi(w0.z); o[6] = bflo(w0.w); o[7] = bfhi(w0.w);
    o[8] = bflo(w1.x); o[9] = bfhi(w1.x); o[10] = bflo(w1.y); o[11] = bfhi(w1.y); o[12] = bflo(w1.z); o[13] = bfhi(w1.z); o[14] = bflo(w1.w); o[15] = bfhi(w1.w);
}
typedef short bf16x8 __attribute__((ext_vector_type(8)));
#define MFMA16(a, b, c) __builtin_amdgcn_mfma_f32_16x16x32_bf16((a), (b), (c), 0, 0, 0)
__device__ __forceinline__ bf16x8 ldfrag(LAS const unsigned char* img, int row, int kbyte) { return *(LAS const bf16x8*)(img + row * 144 + kbyte); }
__device__ __forceinline__ unsigned cvtpk(float lo, float hi) { unsigned r; asm volatile("v_cvt_pk_bf16_f32 %0, %1, %2" : "=v"(r) : "v"(lo), "v"(hi)); return r; }

namespace ml {
constexpr int O_Q = 0, O_QA = 9216, O_K = 18432, O_KWT = 27648, O_VT = 36864, O_CX = 57600, CXB = 20736, O_S = 99072, O_GB = 108288, O_GA = O_GB + 4096, O_GC = O_GA + 4096, O_DEN = O_GC + 4096, O_SSQ = O_DEN + 256, O_END = O_SSQ + 2048;
static_assert(O_END <= 131072, "mlstm LDS");
constexpr size_t MST_SC = 11 * MiB;
}
template <bool OUT>
__device__ __forceinline__ void mlstm_group(const Args& A, LAS unsigned char* lds, int wg) {
    using namespace ml;
    const int tid = threadIdx.x, lane = tid & 63, wave = __builtin_amdgcn_readfirstlane(tid >> 6), fr = lane & 15, fq = lane >> 4;
    const int bh = wg >> 3, grp = wg & 7, b = bh >> 2, h = bh & 3;
    const size_t tg0 = (size_t)b * SEQ + (size_t)grp * 1024;
    const bf16* P = (const bf16*)(A.ws + WS_PROJ); bf16* MI = (bf16*)(A.ws + WS_MIXIN); const float* gates = (const float*)(A.ws + WS_GATES);
    const float* cw = (const float*)A.in[I_CONVW]; const float* ng = (const float*)A.in[I_MNG];
    float* MST = (float*)(A.ws + WS_MST); float* MSC = (float*)(A.ws + WS_MST + MST_SC);
    LAS float* GB = (LAS float*)(lds + O_GB); LAS float* GA = (LAS float*)(lds + O_GA); LAS float* GC = (LAS float*)(lds + O_GC);
    LAS float* DEN = (LAS float*)(lds + O_DEN); LAS float* SSQ = (LAS float*)(lds + O_SSQ);
    __syncthreads();
#pragma unroll
    for (int cc = 0; cc < 2; ++cc) { const int c = 2 * wave + cc; const size_t t = tg0 + c * 64 + lane;
        float bc = gates[t * 8 + 4 + h]; const float ii = gates[t * 8 + h];
#pragma unroll
        for (int o = 1; o < 64; o <<= 1) { const float v = __shfl_up(bc, o); if (lane >= o) bc += v; }
        const float a = ii - bc; float cm = a;
#pragma unroll
        for (int o = 1; o < 64; o <<= 1) { const float v = __shfl_up(cm, o); if (lane >= o) cm = fmaxf(cm, v); }
        GB[c * 64 + lane] = bc; GA[c * 64 + lane] = a; GC[c * 64 + lane] = cm; }
    for (int e = tid; e < 16 * 32; e += NTHR) { const int r = e >> 5, cpair = e & 31; *(LAS unsigned*)(lds + O_VT + (128 + r) * 144 + cpair * 4) = (r == 0) ? 0x3F803F80u : 0u; }
    f32x4 st[5];
#pragma unroll
    for (int i = 0; i < 5; ++i) st[i] = (f32x4){0.f, 0.f, 0.f, 0.f};
    float m = OUT ? 0.f : -__builtin_inff(); float Btot = 0.f;
    if (OUT) {
        for (int gp = 0; gp < grp; ++gp) { const int wgp = bh * 8 + gp; const float mg = MSC[wgp * 2], Bg = MSC[wgp * 2 + 1];
            const float mn = fmaxf(Bg + m, mg), f0 = __expf(Bg + m - mn), f1 = __expf(mg - mn);
#pragma unroll
            for (int i = 0; i < 5; ++i)
#pragma unroll
                for (int r = 0; r < 4; ++r) st[i][r] = f0 * st[i][r] + f1 * MST[((size_t)wgp * 20 + i * 4 + r) * NTHR + tid];
            m = mn; }
#pragma unroll
        for (int j = 0; j < 4; ++j)
#pragma unroll
            for (int r = 0; r < 4; ++r) *(LAS bf16*)(lds + O_CX + (16 * wave + 4 * fq + r) * 144 + (16 * j + fr) * 2) = (bf16)f2bf(st[j][r]);
        if (wave < 4) {
#pragma unroll
            for (int r = 0; r < 4; ++r) *(LAS bf16*)(lds + O_CX + (128 + 4 * fq + r) * 144 + (16 * wave + fr) * 2) = (bf16)f2bf(st[4][r]); }
    }
    float gsc[4];
#pragma unroll
    for (int r = 0; r < 4; ++r) gsc[r] = ng[h * 128 + 16 * wave + 4 * fq + r];
    const int sl = tid >> 3, cg = tid & 7;
    __syncthreads();
    for (int c = 0; c < 16; ++c) {
        const float bL = GB[c * 64 + 63], M63 = fmaxf(m, GC[c * 64 + 63]), decay = __expf(m - M63);
        const size_t tc0 = tg0 + (size_t)c * 64;
        {
            const int sabs = grp * 1024 + c * 64 + sl;
            float aq[8], ak[8];
#pragma unroll
            for (int i = 0; i < 8; ++i) { aq[i] = 0.f; ak[i] = 0.f; }
#pragma unroll
            for (int j = 0; j < 4; ++j) { const int sj = sabs - 3 + j;
                if (sj >= 0) { const bf16* rp = P + ((size_t)b * SEQ + sj) * NPROJ;
                    const v4u wq = *(const GAS v4u*)(rp + C_MQ + h * 64 + 8 * cg), wk = *(const GAS v4u*)(rp + C_MK + h * 64 + 8 * cg);
                    const f32x4 q0 = *(const GAS f32x4*)(cw + j * 512 + h * 64 + 8 * cg), q1 = *(const GAS f32x4*)(cw + j * 512 + h * 64 + 8 * cg + 4);
                    const f32x4 k0 = *(const GAS f32x4*)(cw + j * 512 + 256 + h * 64 + 8 * cg), k1 = *(const GAS f32x4*)(cw + j * 512 + 256 + h * 64 + 8 * cg + 4);
                    aq[0] += q0[0] * bflo(wq.x); aq[1] += q0[1] * bfhi(wq.x); aq[2] += q0[2] * bflo(wq.y); aq[3] += q0[3] * bfhi(wq.y);
                    aq[4] += q1[0] * bflo(wq.z); aq[5] += q1[1] * bfhi(wq.z); aq[6] += q1[2] * bflo(wq.w); aq[7] += q1[3] * bfhi(wq.w);
                    ak[0] += k0[0] * bflo(wk.x); ak[1] += k0[1] * bfhi(wk.x); ak[2] += k0[2] * bflo(wk.y); ak[3] += k0[3] * bfhi(wk.y);
                    ak[4] += k1[0] * bflo(wk.z); ak[5] += k1[1] * bfhi(wk.z); ak[6] += k1[2] * bflo(wk.w); ak[7] += k1[3] * bfhi(wk.w); } }
            const float Ml = fmaxf(m, GC[c * 64 + sl]), ainter = __expf(m - Ml), wsv = __expf(GA[c * 64 + sl] - M63);
            float qv[8], kv[8];
#pragma unroll
            for (int i = 0; i < 8; ++i) { qv[i] = 0.125f * aq[i] * __builtin_amdgcn_rcpf(1.f + __expf(-aq[i])); kv[i] = ak[i] * __builtin_amdgcn_rcpf(1.f + __expf(-ak[i])); }
            if (OUT) {
                v4u w; w.x = pk2(qv[0], qv[1]); w.y = pk2(qv[2], qv[3]); w.z = pk2(qv[4], qv[5]); w.w = pk2(qv[6], qv[7]); *(LAS v4u*)(lds + O_Q + sl * 144 + cg * 16) = w;
                w.x = pk2(qv[0] * ainter, qv[1] * ainter); w.y = pk2(qv[2] * ainter, qv[3] * ainter); w.z = pk2(qv[4] * ainter, qv[5] * ainter); w.w = pk2(qv[6] * ainter, qv[7] * ainter); *(LAS v4u*)(lds + O_QA + sl * 144 + cg * 16) = w;
                w.x = pk2(kv[0], kv[1]); w.y = pk2(kv[2], kv[3]); w.z = pk2(kv[4], kv[5]); w.w = pk2(kv[6], kv[7]); *(LAS v4u*)(lds + O_K + sl * 144 + cg * 16) = w;
            }
#pragma unroll
            for (int i = 0; i < 8; ++i) *(LAS bf16*)(lds + O_KWT + (8 * cg + i) * 144 + sl * 2) = (bf16)f2bf(kv[i] * wsv);
#pragma unroll
            for (int gi = 0; gi < 2; ++gi) { const int g8 = cg + 8 * gi; const v4u wv = *(const GAS v4u*)(P + (tc0 + sl) * NPROJ + C_MV + h * 128 + 8 * g8);
                const unsigned ww[4] = {wv.x, wv.y, wv.z, wv.w};
#pragma unroll
                for (int i = 0; i < 4; ++i) { *(LAS bf16*)(lds + O_VT + (8 * g8 + 2 * i) * 144 + sl * 2) = (bf16)(ww[i] & 0xffffu); *(LAS bf16*)(lds + O_VT + (8 * g8 + 2 * i + 1) * 144 + sl * 2) = (bf16)(ww[i] >> 16); } }
        }
        __syncthreads();
        if (OUT) {
            const int lt = wave >> 1, l = 16 * lt + fr; const float Ml = fmaxf(m, GC[c * 64 + l]);
            const bf16x8 bq0 = ldfrag(lds + O_Q, 16 * lt + fr, 16 * fq), bq1 = ldfrag(lds + O_Q, 16 * lt + fr, 64 + 16 * fq);
#pragma unroll
            for (int u = 0; u < 2; ++u) { const int stl = 2 * (wave & 1) + u; f32x4 acc = {0.f, 0.f, 0.f, 0.f};
                acc = MFMA16(ldfrag(lds + O_K, 16 * stl + fr, 16 * fq), bq0, acc); acc = MFMA16(ldfrag(lds + O_K, 16 * stl + fr, 64 + 16 * fq), bq1, acc);
                const f32x4 av = *(LAS const f32x4*)(GA + c * 64 + 16 * stl + 4 * fq); float wv[4];
#pragma unroll
                for (int r = 0; r < 4; ++r) { const int s = 16 * stl + 4 * fq + r; wv[r] = (s <= l) ? acc[r] * __expf(av[r] - Ml) : 0.f; }
                v2u w; w.x = cvtpk(wv[0], wv[1]); w.y = cvtpk(wv[2], wv[3]); *(LAS v2u*)(lds + O_S + l * 144 + (16 * stl + 4 * fq) * 2) = w; }
        }
        {
            const bf16x8 va0 = ldfrag(lds + O_VT, 16 * wave + fr, 16 * fq), va1 = ldfrag(lds + O_VT, 16 * wave + fr, 64 + 16 * fq);
#pragma unroll
            for (int j = 0; j < 4; ++j) { st[j] = st[j] * decay;
                st[j] = MFMA16(va0, ldfrag(lds + O_KWT, 16 * j + fr, 16 * fq), st[j]); st[j] = MFMA16(va1, ldfrag(lds + O_KWT, 16 * j + fr, 64 + 16 * fq), st[j]); }
            if (wave < 4) { st[4] = st[4] * decay;
                st[4] = MFMA16(ldfrag(lds + O_VT, 128 + fr, 16 * fq), ldfrag(lds + O_KWT, 16 * wave + fr, 16 * fq), st[4]);
                st[4] = MFMA16(ldfrag(lds + O_VT, 128 + fr, 64 + 16 * fq), ldfrag(lds + O_KWT, 16 * wave + fr, 64 + 16 * fq), st[4]); }
        }
        if (OUT) {
            __syncthreads();
            LAS const unsigned char* cx = lds + O_CX + (c & 1) * CXB;
            f32x4 nt[4], nd = {0.f, 0.f, 0.f, 0.f};
            {
                const bf16x8 va0 = ldfrag(lds + O_VT, 16 * wave + fr, 16 * fq), va1 = ldfrag(lds + O_VT, 16 * wave + fr, 64 + 16 * fq);
                const bf16x8 ca0 = ldfrag(cx, 16 * wave + fr, 16 * fq), ca1 = ldfrag(cx, 16 * wave + fr, 64 + 16 * fq);
#pragma unroll
                for (int lt = 0; lt < 4; ++lt) { f32x4 acc = {0.f, 0.f, 0.f, 0.f};
                    acc = MFMA16(va0, ldfrag(lds + O_S, 16 * lt + fr, 16 * fq), acc); acc = MFMA16(va1, ldfrag(lds + O_S, 16 * lt + fr, 64 + 16 * fq), acc);
                    acc = MFMA16(ca0, ldfrag(lds + O_QA, 16 * lt + fr, 16 * fq), acc); acc = MFMA16(ca1, ldfrag(lds + O_QA, 16 * lt + fr, 64 + 16 * fq), acc); nt[lt] = acc; }
                if (wave >= 4) { const int lt = wave - 4;
                    nd = MFMA16(ldfrag(lds + O_VT, 128 + fr, 16 * fq), ldfrag(lds + O_S, 16 * lt + fr, 16 * fq), nd); nd = MFMA16(ldfrag(lds + O_VT, 128 + fr, 64 + 16 * fq), ldfrag(lds + O_S, 16 * lt + fr, 64 + 16 * fq), nd);
                    nd = MFMA16(ldfrag(cx, 128 + fr, 16 * fq), ldfrag(lds + O_QA, 16 * lt + fr, 16 * fq), nd); nd = MFMA16(ldfrag(cx, 128 + fr, 64 + 16 * fq), ldfrag(lds + O_QA, 16 * lt + fr, 64 + 16 * fq), nd);
                    if (fq == 0) DEN[16 * lt + fr] = nd[0]; }
            }
            v2u mo[4];
#pragma unroll
            for (int lt = 0; lt < 4; ++lt) mo[lt] = *(const GAS v2u*)(P + (tc0 + 16 * lt + fr) * NPROJ + C_MO + h * 128 + 16 * wave + 4 * fq);
            __syncthreads();
#pragma unroll
            for (int lt = 0; lt < 4; ++lt) { const int l = 16 * lt + fr; const float Ml = fmaxf(m, GC[c * 64 + l]);
                const float inv = 1.0f / fmaxf(fabsf(DEN[l]), __expf(-(GB[c * 64 + l] + Ml)));
                nt[lt] = nt[lt] * inv; float ss = (nt[lt][0] * nt[lt][0] + nt[lt][1] * nt[lt][1]) + (nt[lt][2] * nt[lt][2] + nt[lt][3] * nt[lt][3]);
                ss += __shfl_xor(ss, 16); ss += __shfl_xor(ss, 32);
                if (fq == 0) SSQ[wave * 64 + l] = ss; }
            LAS unsigned char* cxn = lds + O_CX + ((c + 1) & 1) * CXB;
#pragma unroll
            for (int j = 0; j < 4; ++j)
#pragma unroll
                for (int r = 0; r < 4; ++r) *(LAS bf16*)(cxn + (16 * wave + 4 * fq + r) * 144 + (16 * j + fr) * 2) = (bf16)f2bf(st[j][r]);
            if (wave < 4) {
#pragma unroll
                for (int r = 0; r < 4; ++r) *(LAS bf16*)(cxn + (128 + 4 * fq + r) * 144 + (16 * wave + fr) * 2) = (bf16)f2bf(st[4][r]); }
            __syncthreads();
#pragma unroll
            for (int lt = 0; lt < 4; ++lt) { const int l = 16 * lt + fr; float tot = 0.f;
#pragma unroll
                for (int w2 = 0; w2 < 8; ++w2) tot += SSQ[w2 * 64 + l];
                const float rn = 1.0f / sqrtf(tot * (1.f / 128.f) + EPS);
                const float o0 = nt[lt][0] * rn * gsc[0] * bflo(mo[lt].x), o1 = nt[lt][1] * rn * gsc[1] * bfhi(mo[lt].x), o2 = nt[lt][2] * rn * gsc[2] * bflo(mo[lt].y), o3 = nt[lt][3] * rn * gsc[3] * bfhi(mo[lt].y);
                v2u w; w.x = pk2(o0, o1); w.y = pk2(o2, o3);
                *(GAS v2u*)(MI + (tc0 + l) * D + 512 + h * 128 + 16 * wave + 4 * fq) = w; }
        } else {
            __syncthreads();
        }
        m = bL + M63; Btot += bL;
    }
    if (!OUT) {
#pragma unroll
        for (int i = 0; i < 5; ++i)
#pragma unroll
            for (int r = 0; r < 4; ++r) MST[((size_t)wg * 20 + i * 4 + r) * NTHR + tid] = st[i][r];
        if (tid == 0) { MSC[wg * 2] = m; MSC[wg * 2 + 1] = Btot; }
    }
}

namespace at {
constexpr int O_K = 0, O_VT = 36864, VTS = 560  , O_END = O_VT + 64 * VTS;
static_assert(O_END <= 131072, "attention LDS");
}
__device__ __forceinline__ void phase_attn(const Args& A, LAS unsigned char* lds) {
    using namespace at;
    const int tid = threadIdx.x, lane = tid & 63, wave = __builtin_amdgcn_readfirstlane(tid >> 6), fr = lane & 15, fq = lane >> 4, G = gridDim.x;
    const bf16* P = (const bf16*)(A.ws + WS_PROJ); bf16* MI = (bf16*)(A.ws + WS_MIXIN); const float* sinks = (const float*)A.in[I_SINK];
    __syncthreads();
    for (int e = tid; e < 64 * 12; e += NTHR) { const int r = e / 12, cpair = e % 12; *(LAS unsigned*)(lds + O_VT + r * VTS + 512 + cpair * 4) = 0u; }
    for (int unit = blockIdx.x; unit < NB * 64 * 2; unit += G) {
        const int g = unit & 1, n = (unit >> 1) & 63, b = unit >> 7;
        const size_t tq0 = (size_t)b * SEQ + (size_t)n * 128;
        __syncthreads();
#pragma unroll
        for (int i = 0; i < 4; ++i) { const int item = tid + NTHR * i, row = item >> 3, ch = item & 7;
            v4u wk = {0u, 0u, 0u, 0u}, wv = {0u, 0u, 0u, 0u};
            if (n > 0 || row >= 128) { const bf16* rp = P + (tq0 - 128 + row) * NPROJ; wk = *(const GAS v4u*)(rp + C_AK + g * 64 + 8 * ch); wv = *(const GAS v4u*)(rp + C_AV + g * 64 + 8 * ch); }
            *(LAS v4u*)(lds + O_K + row * 144 + ch * 16) = wk;
            const unsigned ww[4] = {wv.x, wv.y, wv.z, wv.w};
#pragma unroll
            for (int k = 0; k < 4; ++k) { *(LAS bf16*)(lds + O_VT + (8 * ch + 2 * k) * VTS + row * 2) = (bf16)(ww[k] & 0xffffu); *(LAS bf16*)(lds + O_VT + (8 * ch + 2 * k + 1) * VTS + row * 2) = (bf16)(ww[k] >> 16); } }
        const int hq = 4 * g + (wave >> 1), qr0 = 64 * (wave & 1); const float sink = sinks[hq];
        __syncthreads();
        for (int qt = 0; qt < 4; ++qt) {
            const int i0 = qr0 + 16 * qt, st0 = i0 >> 4, iq = i0 + fr;
            const bf16* qp = P + (tq0 + iq) * NPROJ + C_AQ + hq * 64 + 8 * fq;
            const bf16x8 bq0 = *(const GAS bf16x8*)qp, bq1 = *(const GAS bf16x8*)(qp + 32);
            f32x4 sc[9]; float mx = sink;
#pragma unroll
            for (int t = 0; t < 9; ++t) { const int sb0 = 16 * (st0 + t); f32x4 acc = {0.f, 0.f, 0.f, 0.f};
                acc = MFMA16(ldfrag(lds + O_K, sb0 + fr, 16 * fq), bq0, acc); acc = MFMA16(ldfrag(lds + O_K, sb0 + fr, 64 + 16 * fq), bq1, acc);
#pragma unroll
                for (int r = 0; r < 4; ++r) { const int sb = sb0 + 4 * fq + r; const bool valid = (sb > iq) && (sb <= iq + 128) && (n > 0 || sb >= 128);
                    acc[r] = valid ? acc[r] : -3.0e38f; mx = fmaxf(mx, acc[r]); }
                sc[t] = acc; }
            mx = fmaxf(mx, __shfl_xor(mx, 16)); mx = fmaxf(mx, __shfl_xor(mx, 32));
            float lsum = 0.f;
#pragma unroll
            for (int t = 0; t < 9; ++t)
#pragma unroll
                for (int r = 0; r < 4; ++r) { const float p = (sc[t][r] > -1.0e38f) ? __expf(sc[t][r] - mx) : 0.f; sc[t][r] = p; lsum += p; }
            lsum += __shfl_xor(lsum, 16); lsum += __shfl_xor(lsum, 32); lsum += __expf(sink - mx);
            f32x4 oacc[4];
#pragma unroll
            for (int dt = 0; dt < 4; ++dt) oacc[dt] = (f32x4){0.f, 0.f, 0.f, 0.f};
#pragma unroll
            for (int ks = 0; ks < 5; ++ks) {
                union { bf16x8 v; unsigned u[4]; } pb;
                pb.u[0] = cvtpk(sc[2 * ks][0], sc[2 * ks][1]); pb.u[1] = cvtpk(sc[2 * ks][2], sc[2 * ks][3]);
                if (ks < 4) { pb.u[2] = cvtpk(sc[2 * ks + 1][0], sc[2 * ks + 1][1]); pb.u[3] = cvtpk(sc[2 * ks + 1][2], sc[2 * ks + 1][3]); } else { pb.u[2] = 0u; pb.u[3] = 0u; }
                const int sbb = 16 * (st0 + 2 * ks) + 4 * fq;
#pragma unroll
                for (int dt = 0; dt < 4; ++dt) { LAS const unsigned char* vp = lds + O_VT + (16 * dt + fr) * VTS + sbb * 2;
                    union { bf16x8 v; v2u h[2]; } va; va.h[0] = *(LAS const v2u*)vp; va.h[1] = *(LAS const v2u*)(vp + 32);
                    oacc[dt] = MFMA16(va.v, pb.v, oacc[dt]); } }
            const float il = 1.0f / lsum;
#pragma unroll
            for (int dt = 0; dt < 4; ++dt) { v2u w; w.x = pk2(oacc[dt][0] * il, oacc[dt][1] * il); w.y = pk2(oacc[dt][2] * il, oacc[dt][3] * il);
                *(GAS v2u*)(MI + (tq0 + iq) * D + hq * 64 + 16 * dt + 4 * fq) = w; }
        }
    }
}
typedef float f32x16 __attribute__((ext_vector_type(16)));
__device__ __forceinline__ unsigned fbits(float f) { return __builtin_bit_cast(unsigned, f); }
__device__ __forceinline__ float bfloat(unsigned u) { return __builtin_bit_cast(float, u); }

#define CE_DESC(a, b) do { const float _mx = __builtin_fmaxf(a, b), _mn = __builtin_fminf(a, b); a = _mx; b = _mn; } while (0)
__device__ __forceinline__ void bsort16(float (&v)[16]) {
#pragma unroll
    for (int k = 2; k <= 16; k <<= 1)
#pragma unroll
        for (int j = k >> 1; j > 0; j >>= 1)
#pragma unroll
            for (int i = 0; i < 16; ++i) { const int l = i ^ j; if (l > i) { if ((i & k) == 0) CE_DESC(v[i], v[l]); else CE_DESC(v[l], v[i]); } }
}
__device__ __forceinline__ void bmerge16(float (&v)[16], const float (&w)[16]) {
#pragma unroll
    for (int i = 0; i < 16; ++i) v[i] = __builtin_fmaxf(v[i], w[15 - i]);
#pragma unroll
    for (int j = 8; j > 0; j >>= 1)
#pragma unroll
        for (int i = 0; i < 16; ++i) { const int l = i ^ j; if (l > i) CE_DESC(v[i], v[l]); }
}
namespace tk {
constexpr int KS = 272;
constexpr int O_K1 = 0, O_K2 = 128 * KS, O_X = 2 * 128 * KS, O_END = O_X + 8 * 4096;
static_assert(O_END <= 131072, "topk LDS");
constexpr unsigned char CAND[64] = {
    0x00, 0x01, 0x02, 0x03, 0x04, 0x05, 0x06, 0x07, 0x08, 0x09, 0x0a, 0x0b, 0x0c, 0x0d, 0x0e, 0x0f,
    0x10, 0x11, 0x12, 0x13, 0x14, 0x15, 0x16, 0x17, 0x80, 0x90, 0xa0, 0xb0, 0xc0, 0xd0, 0xe0, 0xf0,
    0x20, 0x21, 0x22, 0x23, 0x24, 0x30, 0x31, 0x32, 0x33, 0x40, 0x41, 0x42, 0x50, 0x51, 0x60, 0x61,
    0x70, 0x71, 0xff, 0xff, 0xff, 0xff, 0xff, 0xff, 0xff, 0xff, 0xff, 0xff, 0xff, 0xff, 0xff, 0xff};
}
__device__ __forceinline__ void side_top16(const f32x16 (&acc)[4], int hh, float (&T)[16]) {
    float g1[16], g2[16];
#pragma unroll
    for (int r = 0; r < 16; ++r) { const unsigned key = (r & 3) + 8 * (r >> 2) + 4 * hh;
        T[r] = bfloat((fbits(acc[0][r]) & 0xffffff80u) | key);
        g1[r] = bfloat((fbits(acc[1][r]) & 0xffffff80u) | (32u + key)); }
    bsort16(T); bsort16(g1); bmerge16(T, g1);
#pragma unroll
    for (int r = 0; r < 16; ++r) { const unsigned key = (r & 3) + 8 * (r >> 2) + 4 * hh;
        g1[r] = bfloat((fbits(acc[2][r]) & 0xffffff80u) | (64u + key));
        g2[r] = bfloat((fbits(acc[3][r]) & 0xffffff80u) | (96u + key)); }
    bsort16(g1); bsort16(g2); bmerge16(g1, g2); bmerge16(T, g1);
#pragma unroll
    for (int r = 0; r < 16; ++r) g1[r] = __shfl_xor(T[r], 32);
    bmerge16(T, g1);
}
template <int SD> __device__ __forceinline__ void topk_side(const bf16* Q, LAS unsigned char* lds, int t, int h, int r32, int hh, float (&T)[16]) {
    using namespace tk;
    f32x16 acc[4];
#pragma unroll
    for (int mt = 0; mt < 4; ++mt)
#pragma unroll
        for (int r = 0; r < 16; ++r) acc[mt][r] = 0.f;
    const bf16* qp = Q + (size_t)t * 2048 + h * 256 + SD * 128 + 8 * hh; LAS const unsigned char* kimg = lds + (SD ? O_K2 : O_K1);
#pragma unroll
    for (int ks = 0; ks < 8; ++ks) { const bf16x8 bq = *(const GAS bf16x8*)(qp + 16 * ks);
#pragma unroll
        for (int mt = 0; mt < 4; ++mt) acc[mt] = __builtin_amdgcn_mfma_f32_32x32x16_bf16(*(LAS const bf16x8*)(kimg + (32 * mt + r32) * KS + 32 * ks + 16 * hh), bq, acc[mt], 0, 0, 0); }
    side_top16(acc, hh, T);
}
template <int Q> __device__ __forceinline__ float cand_val(const float (&T1)[16], const float (&T2)[16], int hh) {
    constexpr unsigned c0 = tk::CAND[2 * Q], c1 = tk::CAND[2 * Q + 1];
    const float s = (hh ? T1[(c1 >> 4) & 15] : T1[(c0 >> 4) & 15]) + (hh ? T2[c1 & 15] : T2[c0 & 15]); const unsigned code = hh ? c1 : c0;
    return (code == 0xffu) ? -3.0e38f : bfloat((fbits(s) & 0xffffff00u) | code);
}
__device__ __forceinline__ void phase_topk(const Args& A, LAS unsigned char* lds) {
    using namespace tk;
    const int tid = threadIdx.x, lane = tid & 63, wave = __builtin_amdgcn_readfirstlane(tid >> 6), G = gridDim.x;
    const bf16* Q = (const bf16*)(A.ws + WS_PROJ); const bf16* KB = (const bf16*)(A.ws + WS_KEYS);
    unsigned short* EI = (unsigned short*)(A.ws + WS_EIDX); float* GT = (float*)(A.ws + WS_GATE);
    const int h = blockIdx.x & 7, r32 = lane & 31, hh = lane >> 5;
    __syncthreads();
    for (int e = tid; e < 2 * 128 * 16; e += NTHR) { const int s = e >> 11, row = (e >> 4) & 127, ch = e & 15;
        *(LAS v4u*)(lds + (s ? O_K2 : O_K1) + row * KS + ch * 16) = *(const GAS v4u*)(KB + (size_t)s * 8 * 128 * 128 + ((size_t)h * 128 + row) * 128 + ch * 8); }
    __syncthreads();
    LAS float* XW = (LAS float*)(lds + O_X + wave * 4096) + r32 * 32;
    for (int tile = (int)(blockIdx.x >> 3); tile < M / 256; tile += (G >> 3)) {
        const int t = tile * 256 + 32 * wave + r32;
        float T1[16], T2[16];
        topk_side<0>(Q, lds, t, h, r32, hh, T1);
        topk_side<1>(Q, lds, t, h, r32, hh, T2);
        float c[16], w[16];
        c[0] = cand_val<0>(T1, T2, hh); w[0] = cand_val<16>(T1, T2, hh);
        c[1] = cand_val<1>(T1, T2, hh); w[1] = cand_val<17>(T1, T2, hh);
        c[2] = cand_val<2>(T1, T2, hh); w[2] = cand_val<18>(T1, T2, hh);
        c[3] = cand_val<3>(T1, T2, hh); w[3] = cand_val<19>(T1, T2, hh);
        c[4] = cand_val<4>(T1, T2, hh); w[4] = cand_val<20>(T1, T2, hh);
        c[5] = cand_val<5>(T1, T2, hh); w[5] = cand_val<21>(T1, T2, hh);
        c[6] = cand_val<6>(T1, T2, hh); w[6] = cand_val<22>(T1, T2, hh);
        c[7] = cand_val<7>(T1, T2, hh); w[7] = cand_val<23>(T1, T2, hh);
        c[8] = cand_val<8>(T1, T2, hh); w[8] = cand_val<24>(T1, T2, hh);
        c[9] = cand_val<9>(T1, T2, hh); w[9] = cand_val<25>(T1, T2, hh);
        c[10] = cand_val<10>(T1, T2, hh); w[10] = cand_val<26>(T1, T2, hh);
        c[11] = cand_val<11>(T1, T2, hh); w[11] = cand_val<27>(T1, T2, hh);
        c[12] = cand_val<12>(T1, T2, hh); w[12] = cand_val<28>(T1, T2, hh);
        c[13] = cand_val<13>(T1, T2, hh); w[13] = cand_val<29>(T1, T2, hh);
        c[14] = cand_val<14>(T1, T2, hh); w[14] = cand_val<30>(T1, T2, hh);
        c[15] = cand_val<15>(T1, T2, hh); w[15] = cand_val<31>(T1, T2, hh);
        bsort16(c); bsort16(w); bmerge16(c, w);
#pragma unroll
        for (int r = 0; r < 16; ++r) w[r] = __shfl_xor(c[r], 32);
        bmerge16(c, w);
        if (hh == 0) {
#pragma unroll
            for (int q4 = 0; q4 < 4; ++q4) { *(LAS f32x4*)(XW + 4 * q4) = (f32x4){T1[4 * q4], T1[4 * q4 + 1], T1[4 * q4 + 2], T1[4 * q4 + 3]};
                *(LAS f32x4*)(XW + 16 + 4 * q4) = (f32x4){T2[4 * q4], T2[4 * q4 + 1], T2[4 * q4 + 2], T2[4 * q4 + 3]}; } }
        asm volatile("s_waitcnt lgkmcnt(0)" ::: "memory");
        float ex[16], sum = 0.f; const float tmax = bfloat(fbits(c[0]) & 0xffffff00u);
#pragma unroll
        for (int r = 0; r < 16; ++r) { ex[r] = __expf(bfloat(fbits(c[r]) & 0xffffff00u) - tmax); sum += ex[r]; }
        const float isum = 1.0f / sum; const size_t ob = (size_t)t * NSLOT + (size_t)(8 * hh) * 8 + h;
#pragma unroll
        for (int r = 0; r < 8; ++r) { float ca = c[r], cb = c[8 + r], ea = ex[r], eb = ex[8 + r]; asm volatile("" : "+v"(ca), "+v"(cb), "+v"(ea), "+v"(eb)); const float cv = hh ? cb : ca, ev = hh ? eb : ea;
            const unsigned code = fbits(cv) & 0xffu;
            const unsigned i1 = fbits(XW[code >> 4]) & 127u, i2 = fbits(XW[16 + (code & 15)]) & 127u;
            EI[ob + 8 * r] = (unsigned short)(i1 * 128u + i2); GT[ob + 8 * r] = ev * isum; }
        asm volatile("s_waitcnt lgkmcnt(0)" ::: "memory");
    }
}
struct PeerIdx { v4u e0, e1; };
__device__ __forceinline__ PeerIdx peer_ld_idx(const unsigned short* EI, int t, int g) { PeerIdx r; r.e0 = *(const GAS v4u*)(EI + (size_t)t * NSLOT + 16 * g); r.e1 = *(const GAS v4u*)(EI + (size_t)t * NSLOT + 16 * g + 8); return r; }
template <int ROWB = 1024> __device__ __forceinline__ void peer_gather(const unsigned char* T8, const PeerIdx& ix, int colb, v4u (&raw)[16]) {
    const unsigned ew[8] = {ix.e0.x, ix.e0.y, ix.e0.z, ix.e0.w, ix.e1.x, ix.e1.y, ix.e1.z, ix.e1.w};
#pragma unroll
    for (int k = 0; k < 16; ++k) { const unsigned e = (k & 1) ? (ew[k >> 1] >> 16) : (ew[k >> 1] & 0xffffu); raw[k] = *(const GAS v4u*)(T8 + (size_t)e * ROWB + colb); }
}
__device__ __forceinline__ void cvt16_fp8_pk(const v4u w, f32x2 (&o)[8]) {
    const unsigned ww[4] = {w.x, w.y, w.z, w.w};
#pragma unroll
    for (int i = 0; i < 4; ++i) { o[2 * i] = __builtin_amdgcn_cvt_pk_f32_fp8((int)ww[i], false); o[2 * i + 1] = __builtin_amdgcn_cvt_pk_f32_fp8((int)ww[i], true); }
}
__device__ __forceinline__ void peer_u_reduce(const v4u (&raw)[16], const f32x2 (&hv)[8], float* PDrow, int lane, int g, int c) {
    float d[16];
#pragma unroll
    for (int k = 0; k < 16; ++k) { f32x2 uf[8]; cvt16_fp8_pk(raw[k], uf); f32x2 s = uf[0] * hv[0];
#pragma unroll
        for (int i = 1; i < 8; ++i) s += uf[i] * hv[i];
        d[k] = s.x + s.y; }
#pragma unroll
    for (int i = 0; i < 8; ++i) { const bool up = (lane & 4) != 0; const float keep = up ? d[i + 8] : d[i], send = up ? d[i] : d[i + 8]; d[i] = keep + __shfl_xor(send, 4); }
#pragma unroll
    for (int i = 0; i < 4; ++i) { const bool up = (lane & 2) != 0; const float keep = up ? d[i + 4] : d[i], send = up ? d[i] : d[i + 4]; d[i] = keep + __shfl_xor(send, 2); }
#pragma unroll
    for (int i = 0; i < 2; ++i) { const bool up = (lane & 1) != 0; const float keep = up ? d[i + 2] : d[i], send = up ? d[i] : d[i + 2]; d[i] = keep + __shfl_xor(send, 1); }
    *(GAS f32x2*)(PDrow + 16 * g + 2 * c) = (f32x2){d[0], d[1]};
}
__device__ __forceinline__ void ld16bf_pk(const bf16* p, f32x2 (&o)[8]) {
    const v4u w0 = *(const GAS v4u*)p, w1 = *(const GAS v4u*)(p + 8); const unsigned ww[8] = {w0.x, w0.y, w0.z, w0.w, w1.x, w1.y, w1.z, w1.w};
#pragma unroll
    for (int i = 0; i < 8; ++i) o[i] = (f32x2){bflo(ww[i]), bfhi(ww[i])};
}
__device__ __forceinline__ void peer_u_reduce_i4(const v4u (&raw)[16], const v4u hh, const v4u hl, int* PDrow, int lane, int g, int c) {
    int d[16];
#pragma unroll
    for (int k = 0; k < 16; ++k) { int sh = __builtin_amdgcn_sdot8((int)raw[k].x, (int)hh.x, 0, false), sl = __builtin_amdgcn_sdot8((int)raw[k].x, (int)hl.x, 0, false);
        sh = __builtin_amdgcn_sdot8((int)raw[k].y, (int)hh.y, sh, false); sl = __builtin_amdgcn_sdot8((int)raw[k].y, (int)hl.y, sl, false);
        sh = __builtin_amdgcn_sdot8((int)raw[k].z, (int)hh.z, sh, false); sl = __builtin_amdgcn_sdot8((int)raw[k].z, (int)hl.z, sl, false);
        sh = __builtin_amdgcn_sdot8((int)raw[k].w, (int)hh.w, sh, false); sl = __builtin_amdgcn_sdot8((int)raw[k].w, (int)hl.w, sl, false);
        d[k] = 16 * sh + sl; }
#pragma unroll
    for (int i = 0; i < 8; ++i) { const bool up = (lane & 4) != 0; const int keep = up ? d[i + 8] : d[i], send = up ? d[i] : d[i + 8]; d[i] = keep + __shfl_xor(send, 4); }
#pragma unroll
    for (int i = 0; i < 4; ++i) { const bool up = (lane & 2) != 0; const int keep = up ? d[i + 4] : d[i], send = up ? d[i] : d[i + 4]; d[i] = keep + __shfl_xor(send, 2); }
#pragma unroll
    for (int i = 0; i < 2; ++i) { const bool up = (lane & 1) != 0; const int keep = up ? d[i + 2] : d[i], send = up ? d[i] : d[i + 2]; d[i] = keep + __shfl_xor(send, 1); }
    *(GAS v2u*)(PDrow + 16 * g + 2 * c) = (v2u){(unsigned)d[0], (unsigned)d[1]};
}
__device__ __forceinline__ void phase_peer_u(const Args& A) {
    const int tid = threadIdx.x, lane = tid & 63, wave = tid >> 6, p = blockIdx.x & 7, q = p & 3, half = p >> 2, j = blockIdx.x >> 3, nj = gridDim.x >> 3, g = lane >> 3, c = lane & 7;
    const unsigned char* HH = (const unsigned char*)(A.ws + WS_H8); const unsigned char* HL = HH + 32 * MiB; const unsigned char* U4 = (const unsigned char*)(A.ws + WS_U8); const unsigned short* EI = (const unsigned short*)(A.ws + WS_EIDX);
    int* PD = (int*)(A.ws + WS_PD) + (size_t)q * M * NSLOT;
    const int tper = (M / 2) / nj, colb = 128 * q + 16 * c, tbeg = half * (M / 2) + j * tper, tend = tbeg + tper, tlast = tend - NWAVES + wave;
    int t = tbeg + wave;
    PeerIdx ix1 = peer_ld_idx(EI, min(t + NWAVES, tlast), g), ix2 = peer_ld_idx(EI, min(t + 2 * NWAVES, tlast), g);
    v4u rawa[16], rawb[16], hha, hla, hhb, hlb;
    { const PeerIdx ix0 = peer_ld_idx(EI, t, g); peer_gather<512>(U4, ix0, colb, rawa); hha = *(const GAS v4u*)(HH + (size_t)t * 512 + colb); hla = *(const GAS v4u*)(HL + (size_t)t * 512 + colb); }
    for (; t < tend; t += 2 * NWAVES) {
        const int t1 = t + NWAVES, t2 = min(t + 2 * NWAVES, tlast), t3 = min(t + 3 * NWAVES, tlast), t4 = min(t + 4 * NWAVES, tlast);
        const PeerIdx ix3 = peer_ld_idx(EI, t3, g);
        peer_gather<512>(U4, ix1, colb, rawb); hhb = *(const GAS v4u*)(HH + (size_t)t1 * 512 + colb); hlb = *(const GAS v4u*)(HL + (size_t)t1 * 512 + colb);
        peer_u_reduce_i4(rawa, hha, hla, PD + (size_t)t * NSLOT, lane, g, c);
        const PeerIdx ix4 = peer_ld_idx(EI, t4, g);
        peer_gather<512>(U4, ix2, colb, rawa); hha = *(const GAS v4u*)(HH + (size_t)t2 * 512 + colb); hla = *(const GAS v4u*)(HL + (size_t)t2 * 512 + colb);
        peer_u_reduce_i4(rawb, hhb, hlb, PD + (size_t)t1 * NSLOT, lane, g, c);
        ix1 = ix3; ix2 = ix4;
    }
}
__device__ __forceinline__ void phase_peer_act(const Args& A) {
    const int* PD = (const int*)(A.ws + WS_PD); const unsigned short* EI = (const unsigned short*)(A.ws + WS_EIDX); const float* GT = (const float*)(A.ws + WS_GATE);
    const float* usc = (const float*)(A.ws + WS_SC); const float* vsc = usc + NEXP; const float* hs = (const float*)(A.ws + WS_HS); float* ACT = (float*)(A.ws + WS_ACT);
    for (size_t i = (size_t)blockIdx.x * NTHR + threadIdx.x; i < (size_t)M * NSLOT; i += (size_t)gridDim.x * NTHR) {
        int si = 0;
#pragma unroll
        for (int p = 0; p < 4; ++p) si += PD[(size_t)p * M * NSLOT + i];
        const unsigned e = EI[i]; float s = (float)si * (usc[e] * hs[i >> 7]);
        ACT[i] = 0.5f * s * (1.f + erff(s * 0.70710678118654752f)) * GT[i] * vsc[e];
    }
}
struct PeerAct { f32x4 a0, a1, a2, a3; };
__device__ __forceinline__ PeerAct peer_ld_act(const float* ACT, int t, int g) { const GAS f32x4* ap = (const GAS f32x4*)(ACT + (size_t)t * NSLOT + 16 * g); PeerAct r; r.a0 = ap[0]; r.a1 = ap[1]; r.a2 = ap[2]; r.a3 = ap[3]; return r; }
__device__ __forceinline__ void peer_v_reduce(const v4u (&raw)[16], const PeerAct& pa, bf16* Yrow, float* ssy, int lane, int g, int c) {
    const float av[16] = {pa.a0[0], pa.a0[1], pa.a0[2], pa.a0[3], pa.a1[0], pa.a1[1], pa.a1[2], pa.a1[3], pa.a2[0], pa.a2[1], pa.a2[2], pa.a2[3], pa.a3[0], pa.a3[1], pa.a3[2], pa.a3[3]};
    f32x2 y2[8];
#pragma unroll
    for (int i = 0; i < 8; ++i) y2[i] = (f32x2){0.f, 0.f};
#pragma unroll
    for (int k = 0; k < 16; ++k) { f32x2 vf[8]; cvt16_fp8_pk(raw[k], vf); const f32x2 a2 = (f32x2){av[k], av[k]};
#pragma unroll
        for (int i = 0; i < 8; ++i) y2[i] += a2 * vf[i]; }
    float y[16];
#pragma unroll
    for (int i = 0; i < 8; ++i) { y[2 * i] = y2[i].x; y[2 * i + 1] = y2[i].y; }
#pragma unroll
    for (int i = 0; i < 8; ++i) { const bool up = (lane & 32) != 0; const float keep = up ? y[i + 8] : y[i], send = up ? y[i] : y[i + 8]; y[i] = keep + __shfl_xor(send, 32); }
#pragma unroll
    for (int i = 0; i < 4; ++i) { const bool up = (lane & 16) != 0; const float keep = up ? y[i + 4] : y[i], send = up ? y[i] : y[i + 4]; y[i] = keep + __shfl_xor(send, 16); }
#pragma unroll
    for (int i = 0; i < 2; ++i) { const bool up = (lane & 8) != 0; const float keep = up ? y[i + 2] : y[i], send = up ? y[i] : y[i + 2]; y[i] = keep + __shfl_xor(send, 8); }
    *(GAS unsigned*)(Yrow + 16 * c + 2 * g) = pk2(y[0], y[1]);
    const float ss = wave_sum(y[0] * y[0] + y[1] * y[1]);
    if (lane == 0) *ssy = ss;
}
__device__ __forceinline__ void phase_peer_v(const Args& A) {
    const int tid = threadIdx.x, lane = tid & 63, wave = tid >> 6, p = blockIdx.x & 7, j = blockIdx.x >> 3, nj = gridDim.x >> 3, g = lane >> 3, c = lane & 7;
    const unsigned char* V8 = (const unsigned char*)(A.ws + WS_V8); const unsigned short* EI = (const unsigned short*)(A.ws + WS_EIDX); const float* ACT = (const float*)(A.ws + WS_ACT);
    bf16* Y = (bf16*)(A.ws + WS_H); float* SSY = (float*)(A.ws + WS_SSY);
    const int tper = M / nj, colb = 128 * p + 16 * c, tend = (j + 1) * tper, tlast = tend - NWAVES + wave;
    int t = j * tper + wave;
    PeerIdx ix1 = peer_ld_idx(EI, min(t + NWAVES, tlast), g), ix2 = peer_ld_idx(EI, min(t + 2 * NWAVES, tlast), g);
    v4u rawa[16], rawb[16]; PeerAct aca, acb;
    { const PeerIdx ix0 = peer_ld_idx(EI, t, g); peer_gather(V8, ix0, colb, rawa); aca = peer_ld_act(ACT, t, g); }
    for (; t < tend; t += 2 * NWAVES) {
        const int t1 = t + NWAVES, t2 = min(t + 2 * NWAVES, tlast), t3 = min(t + 3 * NWAVES, tlast), t4 = min(t + 4 * NWAVES, tlast);
        const PeerIdx ix3 = peer_ld_idx(EI, t3, g);
        peer_gather(V8, ix1, colb, rawb); acb = peer_ld_act(ACT, t1, g);
        peer_v_reduce(rawa, aca, Y + (size_t)t * D + 128 * p, SSY + (size_t)t * 8 + p, lane, g, c);
        const PeerIdx ix4 = peer_ld_idx(EI, t4, g);
        peer_gather(V8, ix2, colb, rawa); aca = peer_ld_act(ACT, t2, g);
        peer_v_reduce(rawb, acb, Y + (size_t)t1 * D + 128 * p, SSY + (size_t)t1 * 8 + p, lane, g, c);
        ix1 = ix3; ix2 = ix4;
    }
}
__device__ __forceinline__ void phase_peer_final(const Args& A) {
    const int tid = threadIdx.x, lane = tid & 63, wave = tid >> 6, G = gridDim.x;
    const bf16* Y = (const bf16*)(A.ws + WS_H); const bf16* X1 = (const bf16*)(A.ws + WS_X1); const float* SSY = (const float*)(A.ws + WS_SSY); const float* mod = (const float*)(A.ws + WS_MOD); const float* gpost = (const float*)A.in[I_GPOST2]; float* out = A.out;
    for (int row = blockIdx.x * NWAVES + wave; row < M; row += G * NWAVES) {
        const int b = row / SEQ; const f32x4 s0 = *(const GAS f32x4*)(SSY + (size_t)row * 8), s1 = *(const GAS f32x4*)(SSY + (size_t)row * 8 + 4);
        const float rstd = 1.0f / sqrtf((((s0[0] + s0[1]) + (s0[2] + s0[3])) + ((s1[0] + s1[1]) + (s1[2] + s1[3]))) * (1.f / D) + EPS);
        GAS f32x4* orow = (GAS f32x4*)(out + (size_t)row * D) + lane; const GAS v2u* yr = (const GAS v2u*)(Y + (size_t)row * D) + lane; const GAS v2u* xr = (const GAS v2u*)(X1 + (size_t)row * D) + lane;
#pragma unroll
        for (int q = 0; q < 4; ++q) { const int k = 4 * (lane + 64 * q); const v2u xw = xr[64 * q]; f32x4 xv = {bflo(xw.x), bfhi(xw.x), bflo(xw.y), bfhi(xw.y)}; const v2u yw = yr[64 * q];
            const f32x4 g2 = *(const GAS f32x4*)(mod + b * 6144 + 5120 + k), gp = *(const GAS f32x4*)(gpost + k);
            xv[0] += g2[0] * (bflo(yw.x) * rstd * gp[0]); xv[1] += g2[1] * (bfhi(yw.x) * rstd * gp[1]); xv[2] += g2[2] * (bflo(yw.y) * rstd * gp[2]); xv[3] += g2[3] * (bfhi(yw.y) * rstd * gp[3]);
            orow[64 * q] = xv; }
    }
}

#ifdef PROBE_V_LOADS
__device__ __forceinline__ void probe_v_loads(const Args& A) {
    const int tid = threadIdx.x, lane = tid & 63, wave = tid >> 6, p = blockIdx.x & 7, j = blockIdx.x >> 3, nj = gridDim.x >> 3, g = lane >> 3, c = lane & 7;
    const unsigned char* V8 = (const unsigned char*)(A.ws + WS_V8); const unsigned short* EI = (const unsigned short*)(A.ws + WS_EIDX); const float* ACT = (const float*)(A.ws + WS_ACT);
    unsigned* DUMP = (unsigned*)(A.ws + WS_PD);
    const int tper = M / nj, colb = 128 * p + 16 * c, tend = (j + 1) * tper, tlast = tend - NWAVES + wave;
    int t = j * tper + wave;
    PeerIdx ix1 = peer_ld_idx(EI, min(t + NWAVES, tlast), g), ix2 = peer_ld_idx(EI, min(t + 2 * NWAVES, tlast), g);
    v4u rawa[16], rawb[16]; PeerAct aca, acb;
    { const PeerIdx ix0 = peer_ld_idx(EI, t, g); peer_gather(V8, ix0, colb, rawa); aca = peer_ld_act(ACT, t, g); }
    for (; t < tend; t += 2 * NWAVES) {
        const int t1 = t + NWAVES, t2 = min(t + 2 * NWAVES, tlast), t3 = min(t + 3 * NWAVES, tlast), t4 = min(t + 4 * NWAVES, tlast);
        const PeerIdx ix3 = peer_ld_idx(EI, t3, g);
        peer_gather(V8, ix1, colb, rawb); acb = peer_ld_act(ACT, t1, g);
        { unsigned s = __builtin_bit_cast(unsigned, aca.a0[0]) + __builtin_bit_cast(unsigned, aca.a3[3]);
#pragma unroll
          for (int k = 0; k < 16; ++k) s += (rawa[k].x + rawa[k].y) + (rawa[k].z + rawa[k].w);
          DUMP[(size_t)t * 512 + p * 64 + lane] = s; }
        const PeerIdx ix4 = peer_ld_idx(EI, t4, g);
        peer_gather(V8, ix2, colb, rawa); aca = peer_ld_act(ACT, t2, g);
        { unsigned s = __builtin_bit_cast(unsigned, acb.a0[0]) + __builtin_bit_cast(unsigned, acb.a3[3]);
#pragma unroll
          for (int k = 0; k < 16; ++k) s += (rawb[k].x + rawb[k].y) + (rawb[k].z + rawb[k].w);
          DUMP[(size_t)t1 * 512 + p * 64 + lane] = s; }
        ix1 = ix3; ix2 = ix4;
    }
}
#endif

#ifdef PROBE_INSTR
__device__ __forceinline__ void probe_instr(const Args& A) {
    f32x2 a[8]; float f[16]; unsigned w = threadIdx.x * 0x01010101u + 0x38383838u;
#pragma unroll
    for (int i = 0; i < 8; ++i) a[i] = (f32x2){1.0f + i, 2.0f + i};
#pragma unroll
    for (int i = 0; i < 16; ++i) f[i] = 1.0f + i;
    for (int it = 0; it < 10000; ++it) {
#if PROBE_INSTR == 1
#pragma unroll
        for (int i = 0; i < 8; ++i) { asm volatile("v_pk_fma_f32 %0, %1, %2, %0" : "+v"(a[i]) : "v"(a[(i + 1) & 7]), "v"(a[(i + 2) & 7])); asm volatile("v_pk_fma_f32 %0, %1, %2, %0" : "+v"(a[i]) : "v"(a[(i + 3) & 7]), "v"(a[(i + 4) & 7])); }
#elif PROBE_INSTR == 2
#pragma unroll
        for (int i = 0; i < 16; ++i) asm volatile("v_fma_f32 %0, %1, %2, %0" : "+v"(f[i]) : "v"(f[(i + 1) & 15]), "v"(f[(i + 2) & 15]));
#elif PROBE_INSTR == 3
#pragma unroll
        for (int i = 0; i < 8; ++i) { asm volatile("v_cvt_pk_f32_fp8 %0, %1" : "=v"(a[i]) : "v"(w)); asm volatile("v_cvt_pk_f32_fp8 %0, %1" : "=v"(a[i]) : "v"(w)); }
#elif PROBE_INSTR == 4
#pragma unroll
        for (int i = 0; i < 8; ++i) { asm volatile("v_cvt_scalef32_pk_f32_fp4 %0, %1, 1.0" : "=v"(a[i]) : "v"(w)); asm volatile("v_cvt_scalef32_pk_f32_fp4 %0, %1, 1.0" : "=v"(a[i]) : "v"(w)); }
#elif PROBE_INSTR == 5
#pragma unroll
        for (int i = 0; i < 16; ++i) asm volatile("v_pk_fma_f16 %0, %1, %2, %0" : "+v"(f[i]) : "v"(f[(i + 1) & 15]), "v"(f[(i + 2) & 15]));
#elif PROBE_INSTR == 7
#pragma unroll
        for (int i = 0; i < 16; ++i) asm volatile("v_dot8c_i32_i4 %0, %1, %2" : "+v"(f[i]) : "v"(f[(i + 1) & 15]), "v"(w));
#elif PROBE_INSTR == 8
#pragma unroll
        for (int i = 0; i < 16; ++i) asm volatile("v_dot4c_i32_i8 %0, %1, %2" : "+v"(f[i]) : "v"(f[(i + 1) & 15]), "v"(w));
#elif PROBE_INSTR == 9
#pragma unroll
        for (int i = 0; i < 16; ++i) asm volatile("v_perm_b32 %0, %1, %2, %3" : "=v"(f[i]) : "v"(f[(i + 1) & 15]), "v"(f[(i + 2) & 15]), "v"(w));
#elif PROBE_INSTR == 10
#pragma unroll
        for (int i = 0; i < 16; ++i) asm volatile("v_mfma_f32_16x16x32_fp8_fp8 %0, %1, %2, %0" : "+v"(*(f32x4*)&f[4 * (i & 3)]) : "v"(a[i & 7]), "v"(a[(i + 1) & 7]));
#elif PROBE_INSTR == 6
#pragma unroll
        for (int i = 0; i < 16; ++i) asm volatile("v_cvt_scalef32_pk_f16_fp4 %0, %1, 1.0" : "=v"(f[i]) : "v"(w));
#endif
    }
    float s = 0.f;
#pragma unroll
    for (int i = 0; i < 8; ++i) s += a[i].x + a[i].y;
#pragma unroll
    for (int i = 0; i < 16; ++i) s += f[i];
    if (s == 123.456f) ((float*)(A.ws + WS_PD))[threadIdx.x] = s;
}
#endif
#ifndef MK_N_LAUNCHES
#define MK_N_LAUNCHES 1
#endif
constexpr int N_PHASES = 13;
typedef const __attribute__((address_space(4))) Args* KArgP;
__device__ __forceinline__ const Args& kargs() { KArgP p = (KArgP)__builtin_amdgcn_kernarg_segment_ptr(); asm volatile("" : "+s"(p)); return *(const Args*)p; }
__global__ void __launch_bounds__(NTHR, 2) hymba_fwd(Args A_) {
    extern __shared__ __attribute__((aligned(16))) unsigned char lds_raw[];
    LAS unsigned char* lds = (LAS unsigned char*)lds_raw;
    const int lo = A_.ph_lo, hi = A_.ph_hi;
#define A kargs()
#define ws (kargs().ws)
#ifndef DBLMASK
#define DBLMASK 0
#endif
#define IN(k) (lo <= (k) && (k) < hi)
#define REP(k) for (int _rep = 0; _rep < (((DBLMASK) >> (k)) & 1) + 1; ++_rep)
    for (int u = threadIdx.x; u < (LDS_BYTES - RING_BYTES) / 4; u += NTHR) ((LAS unsigned*)(lds + RING_BYTES))[u] = 0u;
    __syncthreads();
    XcdBarrier xbar = xcd_barrier_post((unsigned*)(ws + WS_CTL) + CW_BAR, (volatile LAS unsigned*)(lds + MISC_OFF + 32));
#define SEAM(k) do { if (IN(k) && IN((k) + 1)) { if ((k) == 0) cg::this_grid().sync(); else xcd_barrier(xbar); } } while (0)

    if (IN(0)) REP(0) { phase_mod(A, lds); } SEAM(0);
    if (IN(1)) REP(1) { phase_convert(A, lds); phase_prenorm(A); } SEAM(1);
    if (IN(2)) REP(2) {
        pg8::Gemm g{(const pg8::bf16_t*)(ws + WS_H), (const pg8::bf16_t*)(ws + WS_WIN), M, NIN_PAD, D}; pg8::StaticOrder S; S.init(M, NIN_PAD, gridDim.x, (int)blockIdx.x);
        pg8::EpiProj E{(pg8::bf16_t*)(ws + WS_PROJ), NPROJ, (float*)(ws + WS_GATES), (const int*)A.in[I_POS], (const float*)A.in[I_BI], (const float*)A.in[I_BF]};
        pg8::gemm_phase<pg8::EpiProj, pg8::StaticOrder, true, true>(lds, g, S, E);
    } SEAM(2);
    if (IN(3)) REP(3) {
        phase_attn(A, lds);
        for (int wg = blockIdx.x; wg < 256; wg += gridDim.x) mlstm_group<false>(A, lds, wg);
    } SEAM(3);
    if (IN(4)) REP(4) { for (int wg = blockIdx.x; wg < 256; wg += gridDim.x) mlstm_group<true>(A, lds, wg); } SEAM(4);
    if (IN(5)) REP(5) {
        pg8::Gemm g{(const pg8::bf16_t*)(ws + WS_MIXIN), (const pg8::bf16_t*)(ws + WS_WOUT), M, D, D}; pg8::StaticOrder S; S.init(M, D, gridDim.x, (int)blockIdx.x);
        pg8::EpiMix E{(pg8::bf16_t*)(ws + WS_MIX), D, (float*)(ws + WS_SSQ)};
        pg8::gemm_phase<pg8::EpiMix, pg8::StaticOrder, true, true>(lds, g, S, E);
    } SEAM(5);
    if (IN(6)) REP(6) { phase_mid(A); } SEAM(6);
    if (IN(7)) REP(7) {
        pg8::Gemm g{(const pg8::bf16_t*)(ws + WS_H), (const pg8::bf16_t*)(ws + WS_WQ), M, 2048, D}; pg8::StaticOrder S; S.init(M, 2048, gridDim.x, (int)blockIdx.x);
        pg8::EpiPlain E{(pg8::bf16_t*)(ws + WS_PROJ), 2048};
        pg8::gemm_phase<pg8::EpiPlain, pg8::StaticOrder, true, true>(lds, g, S, E);
    } SEAM(7);
    if (IN(8)) REP(8) { phase_topk(A, lds); } SEAM(8);
    if (IN(9)) REP(9) { phase_peer_u(A); } SEAM(9);
    if (IN(10)) REP(10) { phase_peer_act(A); } SEAM(10);
#ifdef PROBE_INSTR
    if (IN(11)) { probe_instr(A); }
#endif
#ifdef PROBE_V_LOADS
    if (IN(11)) { probe_v_loads(A); }
#endif
    if (IN(11)) REP(11) { phase_peer_v(A); } SEAM(11);
    if (IN(12)) REP(12) { phase_peer_final(A); }
#undef IN
#undef SEAM
#undef A
#undef ws
}

extern "C" void kernel_launch(void* const* d_in, const int* in_sizes, int n_in, void* d_out, int out_size, void* d_ws, size_t ws_size, hipStream_t stream) {
    static int grid = 0;
    if (grid == 0) {
        if (n_in != 21 || in_sizes[0] != M * D || out_size != M * D || ws_size < WS_END) { fprintf(stderr, "kernel_launch: unexpected shapes (n_in %d, in0 %d, out %d, ws %zu < %zu)\n", n_in, n_in > 0 ? in_sizes[0] : -1, out_size, ws_size, (size_t)WS_END); grid = -1; return; }
        int dev = 0, cus = 0, per_cu = 0;
        if (hipGetDevice(&dev) != hipSuccess || hipDeviceGetAttribute(&cus, hipDeviceAttributeMultiprocessorCount, dev) != hipSuccess) { grid = -1; return; }
        if (hipFuncSetAttribute((const void*)hymba_fwd, hipFuncAttributeMaxDynamicSharedMemorySize, LDS_BYTES) != hipSuccess) { fprintf(stderr, "kernel_launch: hipFuncSetAttribute failed\n"); grid = -1; return; }
        if (hipOccupancyMaxActiveBlocksPerMultiprocessor(&per_cu, (const void*)hymba_fwd, NTHR, LDS_BYTES) != hipSuccess || per_cu < 1) { fprintf(stderr, "kernel_launch: occupancy query says %d blocks per CU\n", per_cu); per_cu = 1; }
        (void)hipGetLastError();
        grid = cus;
        if (grid != 256) fprintf(stderr, "kernel_launch: note: %d CUs (built for 256)\n", grid);
    }
    if (grid < 0) return;
    (void)hipMemsetAsync((char*)d_ws + WS_CTL, 0, CTL_ZERO_BYTES, stream);
    Args a{};
    for (int i = 0; i < 21; ++i) a.in[i] = d_in[i];
    a.out = (float*)d_out; a.ws = (unsigned char*)d_ws;
    if (MK_N_LAUNCHES == 1) {
        a.ph_lo = 0; a.ph_hi = N_PHASES;
        void* args[] = {&a};
        const hipError_t e = hipLaunchCooperativeKernel((const void*)hymba_fwd, dim3(grid), dim3(NTHR), args, LDS_BYTES, stream);
        if (e != hipSuccess) fprintf(stderr, "kernel_launch: cooperative launch failed: %s (grid %d)\n", hipGetErrorString(e), grid);
    } else {
        for (int p = 0; p < N_PHASES; ++p) { a.ph_lo = p; a.ph_hi = p + 1; hipLaunchKernelGGL(hymba_fwd, dim3(grid), dim3(NTHR), LDS_BYTES, stream, a); }
    }
}
```

```cpp
#include <hip/hip_runtime.h>
#include <hip/hip_cooperative_groups.h>
#include <cstdio>
#include <cstdint>
namespace cg = cooperative_groups;
namespace pg8 {
#define PG8_LAS __attribute__((address_space(3)))
typedef unsigned short bf16_t;
typedef short bf16x8 __attribute__((ext_vector_type(8)));
typedef float f32x4 __attribute__((ext_vector_type(4)));
typedef unsigned u32x4 __attribute__((ext_vector_type(4)));
constexpr int BM = 256, BK = 64, HALF = 128, HTB = HALF * BK * 2  , STAGE_BYTES = 8 * HTB, NXCD = 8, WGM = 8;

__host__ __device__ __forceinline__ int lds_byte(int r, int c) { const int st = (r >> 4) * 2 + (c >> 5), rr = r & 15, cc = c & 31, ob = rr * 64 + cc * 2; return st * 1024 + (ob ^ (((ob >> 9) & 1) << 5)); }
__host__ __device__ __forceinline__ void stage_rc(int b, int& R, int& C) { const int st = b / 1024, sb = b % 1024, swz = sb ^ (((sb >> 9) & 1) << 5); R = (st >> 1) * 16 + swz / 64; C = (st & 1) * 32 + (swz % 64) / 2; }
__host__ __device__ __forceinline__ int perm32(int rho) { const int n = rho >> 4, i = rho & 15; return 8 * (i >> 2) + 4 * n + (i & 3); }

struct Unit { int pm, pn; };
struct Gemm { const bf16_t* A; const bf16_t* Bt; int M, N, K; };

struct StaticOrder {
    int nM, nN, nwg, G, c;
    __host__ __device__ void init(int M, int N, int G_, int c_) { nM = M / BM; nN = N / BM; nwg = nM * nN; G = G_; c = c_; }
    __host__ __device__ bool next(int i, Unit& u) const {
        const long L = (long)i * G + c; if (L >= nwg) return false;
        int wgid = (int)L; { const int q = nwg / NXCD, r = nwg % NXCD, xcd = wgid % NXCD, off = wgid / NXCD; wgid = (xcd < r ? xcd * (q + 1) : r * (q + 1) + (xcd - r) * q) + off; }
        const int nig = WGM * nN, gid = wgid / nig, fm = gid * WGM, gsz = (nM - fm) < WGM ? (nM - fm) : WGM;
        u.pm = fm + ((wgid % nig) % gsz); u.pn = (wgid % nig) / gsz; return true;
    }
    __device__ __forceinline__ void a_ready(const Unit&) const {}
    __device__ __forceinline__ void done(const Unit&) const {}
};

__device__ __forceinline__ unsigned cvt_pk_bf16(float lo, float hi) { unsigned r; asm volatile("v_cvt_pk_bf16_f32 %0, %1, %2" : "=v"(r) : "v"(lo), "v"(hi)); return r; }
typedef float f32x2 __attribute__((ext_vector_type(2)));
__device__ __forceinline__ f32x2 gelu_pk(f32x2 v) {
    const f32x2 av = __builtin_elementwise_abs(v), d = av * 0.2316418882f + 1.0f;
    f32x2 t; t.x = __builtin_amdgcn_rcpf(d.x); t.y = __builtin_amdgcn_rcpf(d.y);
    f32x2 q = t * 0.5307027145f + (-0.7265760135f); q = q * t + 0.7107068705f; q = q * t + (-0.142248368f); q = q * t + 0.127414796f; q = q * t;
    const f32x2 s = (v * v) * (-0.72134752044f);
    f32x2 e; e.x = __builtin_amdgcn_exp2f(s.x); e.y = __builtin_amdgcn_exp2f(s.y);
    const f32x2 m = v * (q * e), r = v - m;
    f32x2 o; o.x = v.x < 0.f ? m.x : r.x; o.y = v.y < 0.f ? m.y : r.y; return o;
}

__device__ __forceinline__ u32x4 pack8(const f32x4 v0, const f32x4 v1) { u32x4 w; w.x = cvt_pk_bf16(v0[0], v0[1]); w.y = cvt_pk_bf16(v0[2], v0[3]); w.z = cvt_pk_bf16(v1[0], v1[1]); w.w = cvt_pk_bf16(v1[2], v1[3]); return w; }

struct EpiPlain {
    static constexpr bool PERM = true, AFTER_DRAIN = false;
    bf16_t* O; int ldc;
    __device__ __forceinline__ void operator()(const f32x4 (&acc)[2][2][4][2], const Unit& u, int wr, int wc, int fr, int fq) const {
        const int row0 = u.pm * BM + wr * 64 + fr, col0 = u.pn * BM + wc * 32 + 8 * fq;
#pragma unroll
        for (int ai = 0; ai < 2; ++ai)
#pragma unroll
            for (int m = 0; m < 4; ++m) { bf16_t* rowp = O + (size_t)(row0 + ai * HALF + m * 16) * ldc + col0;
#pragma unroll
                for (int bj = 0; bj < 2; ++bj) *(u32x4*)(rowp + bj * HALF) = pack8(acc[ai][bj][m][0], acc[ai][bj][m][1]); }
    }
};

struct EpiProj {
    static constexpr bool PERM = true, AFTER_DRAIN = false;
    bf16_t* P; int ldc; float* gates; const int* pos; const float* b_i; const float* b_f;
    __device__ __forceinline__ void operator()(const f32x4 (&acc)[2][2][4][2], const Unit& u, int wr, int wc, int fr, int fq) const {
        const int row0 = u.pm * BM + wr * 64 + fr, col0 = u.pn * BM + wc * 32 + 8 * fq, pn = u.pn;
        if (pn == 9) {
            if (wc == 0 && fq == 0) {
                const f32x4 bi = {b_i[0], b_i[1], b_i[2], b_i[3]}, bf = {b_f[0], b_f[1], b_f[2], b_f[3]};
#pragma unroll
                for (int ai = 0; ai < 2; ++ai)
#pragma unroll
                    for (int m = 0; m < 4; ++m) { const int row = row0 + ai * HALF + m * 16;
                        const f32x4 iv = acc[ai][0][m][0] + bi, fv = acc[ai][0][m][1] + bf; f32x4 lf;
#pragma unroll
                        for (int j = 0; j < 4; ++j) lf[j] = fminf(fv[j], 0.f) - log1pf(__expf(-fabsf(fv[j])));
                        *(f32x4*)(gates + (size_t)row * 8) = iv; *(f32x4*)(gates + (size_t)row * 8 + 4) = lf; }
            }
            return;
        }
#pragma unroll
        for (int ai = 0; ai < 2; ++ai)
#pragma unroll
            for (int m = 0; m < 4; ++m) { const int row = row0 + ai * HALF + m * 16; bf16_t* rowp = P + (size_t)row * ldc + col0;
                const float posf = (pn <= 2) ? (float)pos[row] : 0.f;
#pragma unroll
                for (int bj = 0; bj < 2; ++bj) { f32x4 v0 = acc[ai][bj][m][0], v1 = acc[ai][bj][m][1];
                    const bool rope = (pn < 2) || (pn == 2 && bj == 0);
                    if (rope) {
                        const int p0 = ((col0 + bj * HALF) & 63) >> 1; const float sc = (pn < 2) ? 0.125f : 1.0f;
                        float x[8] = {v0[0], v0[1], v0[2], v0[3], v1[0], v1[1], v1[2], v1[3]};
#pragma unroll
                        for (int q = 0; q < 4; ++q) { const float invf = __builtin_amdgcn_exp2f(-(float)(p0 + q) * 0.41524101186092029f);
                            float r = posf * invf * 0.15915494309189535f; r = r - floorf(r);
                            const float c = __builtin_amdgcn_cosf(r) * sc, s = __builtin_amdgcn_sinf(r) * sc;
                            const float x1 = x[2 * q], x2 = x[2 * q + 1]; x[2 * q] = x1 * c - x2 * s; x[2 * q + 1] = x2 * c + x1 * s; }
                        v0 = (f32x4){x[0], x[1], x[2], x[3]}; v1 = (f32x4){x[4], x[5], x[6], x[7]};
                    } else if (pn >= 7) {
#pragma unroll
                        for (int j = 0; j < 4; ++j) { v0[j] = __builtin_amdgcn_rcpf(1.f + __expf(-v0[j])); v1[j] = __builtin_amdgcn_rcpf(1.f + __expf(-v1[j])); }
                    }
                    *(u32x4*)(rowp + bj * HALF) = pack8(v0, v1); } }
    }
};

struct EpiMix {
    static constexpr bool PERM = true, AFTER_DRAIN = false;
    bf16_t* O; int ldc; float* sumsq;
    __device__ __forceinline__ void operator()(const f32x4 (&acc)[2][2][4][2], const Unit& u, int wr, int wc, int fr, int fq) const {
        const int row0 = u.pm * BM + wr * 64 + fr, col0 = u.pn * BM + wc * 32 + 8 * fq;
#pragma unroll
        for (int ai = 0; ai < 2; ++ai)
#pragma unroll
            for (int m = 0; m < 4; ++m) { const int row = row0 + ai * HALF + m * 16; bf16_t* rowp = O + (size_t)row * ldc + col0; float s = 0.f;
#pragma unroll
                for (int bj = 0; bj < 2; ++bj) { const f32x4 v0 = acc[ai][bj][m][0], v1 = acc[ai][bj][m][1];
                    s += (v0[0] * v0[0] + v0[1] * v0[1]) + (v0[2] * v0[2] + v0[3] * v0[3]) + (v1[0] * v1[0] + v1[1] * v1[1]) + (v1[2] * v1[2] + v1[3] * v1[3]);
                    *(u32x4*)(rowp + bj * HALF) = pack8(v0, v1); }
                s += __shfl_xor(s, 16); s += __shfl_xor(s, 32);
                if (fq == 0) sumsq[(size_t)row * 16 + u.pn * 4 + wc] = s; }
    }
};
template <class Epi, class Sched, bool ALIGN_EPI = false, bool SP2 = false>
__device__ __forceinline__ void gemm_phase(PG8_LAS unsigned char* lds, const Gemm g, const Sched& S, const Epi& E) {
    const int tid = threadIdx.x, wid = __builtin_amdgcn_readfirstlane(tid >> 6), lane = tid & 63, wr = wid >> 2, wc = wid & 3, fr = lane & 15, fq = lane >> 4;
    const int K = g.K, nt = K / BK;
    unsigned voffA[2], voffB[2];
#pragma unroll
    for (int i = 0; i < 2; ++i) { int R, C; stage_rc(tid * 16 + i * 8192, R, C); const int Rb = Epi::PERM ? ((R & ~31) + perm32(R & 31)) : R;
        voffA[i] = (unsigned)(R * K + C) * 2u; voffB[i] = (unsigned)(Rb * K + C) * 2u; }
    const size_t kstep = (size_t)(BK * 2);
    const size_t hstep = (size_t)HALF * K * 2;
    const size_t tstep = 2 * hstep;
    const unsigned ldsw = (unsigned)wid * 1024u;
    const int aoff = lds_byte(wr * 64 + fr, fq * 8), boff = lds_byte(wc * 32 + fr, fq * 8);
#define PG8_SA(b, h) (((b) * 2 + (h)) * HTB)
#define PG8_SB(b, h) ((4 + (b) * 2 + (h)) * HTB)
#define PG8_STAGE(bufoff, gbase, voff) do { _Pragma("unroll") for (int _i = 0; _i < 2; ++_i) \
        __builtin_amdgcn_global_load_lds((const unsigned*)((const char*)(gbase) + (voff)[_i]), (PG8_LAS unsigned*)(lds + (bufoff) + ldsw + _i * 8192), 16, 0, 0); } while (0)
#define PG8_LDA(dst, b, h) do { _Pragma("unroll") for (int m = 0; m < 4; ++m) _Pragma("unroll") for (int k = 0; k < 2; ++k) dst[m][k] = *(const PG8_LAS bf16x8*)(lds + PG8_SA(b, h) + aoff + m * 2048 + k * 1024); } while (0)
#define PG8_LDB(dst, b, h) do { _Pragma("unroll") for (int n = 0; n < 2; ++n) _Pragma("unroll") for (int k = 0; k < 2; ++k) dst[n][k] = *(const PG8_LAS bf16x8*)(lds + PG8_SB(b, h) + boff + n * 2048 + k * 1024); } while (0)
#define PG8_MMA(ai, bj, At, Bt) do { __builtin_amdgcn_s_setprio(1); _Pragma("unroll") for (int m = 0; m < 4; ++m) _Pragma("unroll") for (int n = 0; n < 2; ++n) _Pragma("unroll") for (int k = 0; k < 2; ++k) \
        acc[ai][bj][m][n] = __builtin_amdgcn_mfma_f32_16x16x32_bf16(Bt[n][k], At[m][k], acc[ai][bj][m][n], 0, 0, 0); __builtin_amdgcn_s_setprio(0); } while (0)
#define PG8_WAIT_V(n) asm volatile("s_waitcnt vmcnt(" #n ")" ::: "memory")
#define PG8_WAIT_L(n) asm volatile("s_waitcnt lgkmcnt(" #n ")" ::: "memory")
#define PG8_BAR __builtin_amdgcn_s_barrier()
#define PG8_SCHED __builtin_amdgcn_sched_barrier(0)
    Unit cur, nxt; int ui = 0;
    if (!S.next(0, cur)) return;
    f32x4 acc[2][2][4][2];
#pragma unroll
    for (int a = 0; a < 2; ++a)
#pragma unroll
        for (int b = 0; b < 2; ++b)
#pragma unroll
            for (int m = 0; m < 4; ++m)
#pragma unroll
                for (int n = 0; n < 2; ++n) acc[a][b][m][n] = (f32x4){0.f, 0.f, 0.f, 0.f};
    bf16x8 At[4][2], B0[2][2], B1[2][2];
    const char* cA = (const char*)g.A + (size_t)cur.pm * tstep; const char* cB = (const char*)g.Bt + (size_t)cur.pn * tstep;
    S.a_ready(cur);
    if constexpr (SP2) {
        PG8_STAGE(PG8_SB(0, 0), cB, voffB); PG8_STAGE(PG8_SB(0, 1), cB + hstep, voffB); PG8_STAGE(PG8_SA(0, 0), cA, voffA); PG8_STAGE(PG8_SA(0, 1), cA + hstep, voffA);
        if (wr == 1) PG8_BAR;
        PG8_WAIT_V(2); PG8_BAR;
        PG8_STAGE(PG8_SB(1, 0), cB + kstep, voffB); PG8_STAGE(PG8_SA(1, 0), cA + kstep, voffA); PG8_STAGE(PG8_SB(1, 1), cB + hstep + kstep, voffB);
        PG8_WAIT_V(6); PG8_BAR;
    } else {
        PG8_STAGE(PG8_SB(0, 0), cB, voffB); PG8_STAGE(PG8_SA(0, 0), cA, voffA); PG8_STAGE(PG8_SB(0, 1), cB + hstep, voffB); PG8_STAGE(PG8_SA(0, 1), cA + hstep, voffA);
        if (wr == 1) PG8_BAR;
        PG8_WAIT_V(4); PG8_BAR;
        PG8_STAGE(PG8_SB(1, 0), cB + kstep, voffB); PG8_STAGE(PG8_SA(1, 0), cA + kstep, voffA); PG8_STAGE(PG8_SB(1, 1), cB + hstep + kstep, voffB);
        PG8_WAIT_V(6); PG8_BAR;
    }
    for (;;) {
        const bool has_next = S.next(ui + 1, nxt);
        const char* nA = has_next ? (const char*)g.A + (size_t)nxt.pm * tstep : cA; const char* nB = has_next ? (const char*)g.Bt + (size_t)nxt.pn * tstep : cB;
        for (int t = 0; t < nt; t += 2) {
            const bool last = (t == nt - 2);
            const char* a1 = cA + (size_t)(t + 1) * kstep;
            const char* a2 = last ? nA : cA + (size_t)(t + 2) * kstep; const char* b2 = last ? nB : cB + (size_t)(t + 2) * kstep;
            const char* a3 = a2 + kstep; const char* b3 = b2 + kstep;
            if (last && has_next) S.a_ready(nxt);
            if constexpr (SP2) {
            PG8_LDB(B0, 0, 0); PG8_LDB(B1, 0, 1); PG8_SCHED; PG8_LDA(At, 0, 0); PG8_STAGE(PG8_SA(1, 1), a1 + hstep, voffA);
            PG8_WAIT_V(8); PG8_WAIT_L(0); PG8_BAR; PG8_MMA(0, 0, At, B0); PG8_MMA(0, 1, At, B1); PG8_BAR; PG8_SCHED;
            PG8_LDA(At, 0, 1); PG8_STAGE(PG8_SB(0, 0), b2, voffB); PG8_STAGE(PG8_SB(0, 1), b2 + hstep, voffB); PG8_STAGE(PG8_SA(0, 0), a2, voffA);
            PG8_WAIT_V(8); PG8_WAIT_L(0); PG8_BAR; PG8_MMA(1, 0, At, B0); PG8_MMA(1, 1, At, B1); PG8_BAR; PG8_SCHED;
            PG8_LDB(B0, 1, 0); PG8_LDB(B1, 1, 1); PG8_SCHED; PG8_LDA(At, 1, 0); PG8_STAGE(PG8_SA(0, 1), a2 + hstep, voffA);
            PG8_WAIT_V(8); PG8_WAIT_L(0); PG8_BAR; PG8_MMA(0, 0, At, B0); PG8_MMA(0, 1, At, B1); PG8_BAR; PG8_SCHED;
            PG8_LDA(At, 1, 1); PG8_STAGE(PG8_SB(1, 0), b3, voffB); PG8_STAGE(PG8_SB(1, 1), b3 + hstep, voffB); PG8_STAGE(PG8_SA(1, 0), a3, voffA);
            PG8_WAIT_V(8); PG8_WAIT_L(0); PG8_BAR; PG8_MMA(1, 0, At, B0); PG8_MMA(1, 1, At, B1); PG8_BAR; PG8_SCHED;
            } else {
            PG8_LDB(B0, 0, 0); PG8_SCHED; PG8_LDA(At, 0, 0); PG8_STAGE(PG8_SA(1, 1), a1 + hstep, voffA);
            PG8_WAIT_L(8); PG8_BAR; PG8_WAIT_L(0); PG8_MMA(0, 0, At, B0); PG8_BAR; PG8_SCHED;
            PG8_LDB(B1, 0, 1); PG8_STAGE(PG8_SB(0, 0), b2, voffB);
            PG8_BAR; PG8_WAIT_L(0); PG8_MMA(0, 1, At, B1); PG8_BAR;
            PG8_LDA(At, 0, 1); PG8_STAGE(PG8_SA(0, 0), a2, voffA);
            PG8_BAR; PG8_WAIT_L(0); PG8_MMA(1, 0, At, B0); PG8_BAR; PG8_SCHED;
            PG8_STAGE(PG8_SB(0, 1), b2 + hstep, voffB);
            PG8_WAIT_V(6); PG8_BAR; PG8_MMA(1, 1, At, B1); PG8_BAR;
            PG8_LDB(B0, 1, 0); PG8_SCHED; PG8_LDA(At, 1, 0); PG8_STAGE(PG8_SA(0, 1), a2 + hstep, voffA);
            PG8_WAIT_L(8); PG8_BAR; PG8_WAIT_L(0); PG8_MMA(0, 0, At, B0); PG8_BAR; PG8_SCHED;
            PG8_LDB(B1, 1, 1); PG8_STAGE(PG8_SB(1, 0), b3, voffB);
            PG8_BAR; PG8_WAIT_L(0); PG8_MMA(0, 1, At, B1); PG8_BAR;
            PG8_LDA(At, 1, 1); PG8_STAGE(PG8_SA(1, 0), a3, voffA);
            PG8_BAR; PG8_WAIT_L(0); PG8_MMA(1, 0, At, B0); PG8_BAR; PG8_SCHED;
            PG8_STAGE(PG8_SB(1, 1), b3 + hstep, voffB);
            PG8_WAIT_V(6); PG8_BAR; PG8_MMA(1, 1, At, B1); PG8_BAR;
            }
        }
        if constexpr (ALIGN_EPI) { if (wr == 0) PG8_BAR; }
        if constexpr (!Epi::AFTER_DRAIN) { E(acc, cur, wr, wc, fr, fq); S.done(cur); }
        if (!has_next) break;
#pragma unroll
        for (int a = 0; a < 2; ++a)
#pragma unroll
            for (int b = 0; b < 2; ++b)
#pragma unroll
                for (int m = 0; m < 4; ++m)
#pragma unroll
                    for (int n = 0; n < 2; ++n) acc[a][b][m][n] = (f32x4){0.f, 0.f, 0.f, 0.f};
        cur = nxt; cA = nA; cB = nB; ++ui;
        if constexpr (ALIGN_EPI) { if (wr == 1) PG8_BAR; }
    }
    PG8_WAIT_V(0);
    if constexpr (!ALIGN_EPI) { if (wr == 0) PG8_BAR; }
    PG8_BAR;
    if constexpr (Epi::AFTER_DRAIN) { E.fused(acc, cur, wr, wc, fr, fq, lds, wid, lane); S.done(cur); }
#undef PG8_SA
#undef PG8_SB
#undef PG8_STAGE
#undef PG8_LDA
#undef PG8_LDB
#undef PG8_MMA
#undef PG8_WAIT_V
#undef PG8_WAIT_L
#undef PG8_BAR
#undef PG8_SCHED
}
}
constexpr int NB = 8, SEQ = 8192, D = 1024, M = NB * SEQ;
constexpr int DIN = 2312, NPROJ = 2304, NIN_PAD = 2560;
constexpr int C_AQ = 0, C_AK = 512, C_AV = 640, C_MQ = 768, C_MK = 1024, C_MV = 1280, C_MO = 1792;
constexpr int NEXP = 16384, NSLOT = 128;
constexpr float EPS = 1e-6f;
constexpr int NWAVES = 8, NTHR = 512;

constexpr size_t MiB = 1u << 20;
constexpr size_t WS_CTL = 0, CTL_ZERO_BYTES = 1 * MiB;
constexpr size_t WS_MOD = 1 * MiB;
constexpr size_t WS_WIN = 2 * MiB;
constexpr size_t WS_WOUT = 8 * MiB;
constexpr size_t WS_WQ = 10 * MiB;
constexpr size_t WS_KEYS = 14 * MiB;
constexpr size_t WS_GATES = 16 * MiB;
constexpr size_t WS_SSQ = 832 * MiB;
constexpr size_t WS_MST = 20 * MiB;
constexpr size_t WS_U8 = 32 * MiB, WS_V8 = 48 * MiB;
constexpr size_t WS_SC = 64 * MiB;
constexpr size_t WS_H = 96 * MiB;
constexpr size_t WS_PROJ = 224 * MiB;
constexpr size_t WS_MIXIN = 512 * MiB;
constexpr size_t WS_MIX = 640 * MiB;
constexpr size_t WS_EIDX = 768 * MiB, WS_GATE = 800 * MiB;
constexpr size_t WS_PD = 224 * MiB;
constexpr size_t WS_X1 = 512 * MiB;
constexpr size_t WS_ACT = 840 * MiB;
constexpr size_t WS_SSY = 872 * MiB;
constexpr size_t WS_H8 = 880 * MiB;
constexpr size_t WS_HS = 944 * MiB;
constexpr size_t WS_END = 945 * MiB;
constexpr int CW_BAR = 4096;
constexpr int CW_SUMSQ = 65536;
static_assert((CW_SUMSQ + M) * 4 <= (int)CTL_ZERO_BYTES, "ctl");

constexpr int RING_BYTES = 131072, MISC_OFF = RING_BYTES + 320, LDS_BYTES = 147456;

#define GAS __attribute__((address_space(1)))
#define LAS __attribute__((address_space(3)))
typedef unsigned short bf16;
typedef unsigned v4u __attribute__((ext_vector_type(4)));
typedef unsigned v2u __attribute__((ext_vector_type(2)));
typedef float f32x4 __attribute__((ext_vector_type(4)));
typedef GAS unsigned gu32;
#define LDS_WAIT() asm volatile("s_waitcnt lgkmcnt(0)" ::: "memory")
#define VM_WAIT() asm volatile("s_waitcnt vmcnt(0)" ::: "memory")
__device__ __forceinline__ unsigned f2bf(float f) { unsigned u = __builtin_bit_cast(unsigned, f); return (u + 0x7fffu + ((u >> 16) & 1u)) >> 16; }
__device__ __forceinline__ unsigned pk2(float lo, float hi) { return f2bf(lo) | (f2bf(hi) << 16); }
__device__ __forceinline__ float bflo(unsigned w) { return __builtin_bit_cast(float, w << 16); }
__device__ __forceinline__ float bfhi(unsigned w) { return __builtin_bit_cast(float, w & 0xffff0000u); }
__device__ __forceinline__ float bf1(bf16 h) { return __builtin_bit_cast(float, (unsigned)h << 16); }
__device__ __forceinline__ float wave_sum(float v) {
#pragma unroll
    for (int o = 1; o < 64; o <<= 1) v += __shfl_xor(v, o);
    return v;
}
__device__ __forceinline__ float wave_max(float v) {
#pragma unroll
    for (int o = 1; o < 64; o <<= 1) v = fmaxf(v, __shfl_xor(v, o));
    return v;
}

typedef float f32x2 __attribute__((ext_vector_type(2)));
__device__ __forceinline__ void cvt16_fp8(const v4u w, float (&o)[16]) {
    const unsigned ww[4] = {w.x, w.y, w.z, w.w};
#pragma unroll
    for (int i = 0; i < 4; ++i) { const f32x2 a = __builtin_amdgcn_cvt_pk_f32_fp8((int)ww[i], false), b = __builtin_amdgcn_cvt_pk_f32_fp8((int)ww[i], true);
        o[4 * i] = a.x; o[4 * i + 1] = a.y; o[4 * i + 2] = b.x; o[4 * i + 3] = b.y; }
}
__device__ __forceinline__ void p0_row_fp8(const float* src, unsigned char* dst, float* sc, int row, int lane) {
    const GAS f32x4* sp = (const GAS f32x4*)(src + (size_t)row * D + 16 * lane);
    const f32x4 a = sp[0], b = sp[1], c = sp[2], d = sp[3];
    float mx = 0.f;
#pragma unroll
    for (int i = 0; i < 4; ++i) mx = fmaxf(fmaxf(fmaxf(mx, fabsf(a[i])), fmaxf(fabsf(b[i]), fabsf(c[i]))), fabsf(d[i]));
    mx = wave_max(mx); const float s = mx > 0.f ? 224.0f / mx : 1.0f;
    v4u o; int w;
    w = __builtin_amdgcn_cvt_pk_fp8_f32(a[0] * s, a[1] * s, 0, false); w = __builtin_amdgcn_cvt_pk_fp8_f32(a[2] * s, a[3] * s, w, true); o.x = (unsigned)w;
    w = __builtin_amdgcn_cvt_pk_fp8_f32(b[0] * s, b[1] * s, 0, false); w = __builtin_amdgcn_cvt_pk_fp8_f32(b[2] * s, b[3] * s, w, true); o.y = (unsigned)w;
    w = __builtin_amdgcn_cvt_pk_fp8_f32(c[0] * s, c[1] * s, 0, false); w = __builtin_amdgcn_cvt_pk_fp8_f32(c[2] * s, c[3] * s, w, true); o.z = (unsigned)w;
    w = __builtin_amdgcn_cvt_pk_fp8_f32(d[0] * s, d[1] * s, 0, false); w = __builtin_amdgcn_cvt_pk_fp8_f32(d[2] * s, d[3] * s, w, true); o.w = (unsigned)w;
    *(GAS v4u*)(dst + (size_t)row * D + 16 * lane) = o;
    if (lane == 0) sc[row] = mx > 0.f ? mx * (1.0f / 224.0f) : 1.0f;
}

__device__ __forceinline__ unsigned pack4_i8(float a, float b, float c, float d) { return ((unsigned)__float2int_rn(a) & 0xffu) | (((unsigned)__float2int_rn(b) & 0xffu) << 8) | (((unsigned)__float2int_rn(c) & 0xffu) << 16) | (((unsigned)__float2int_rn(d) & 0xffu) << 24); }
__device__ __forceinline__ void p0_row_i8(const float* src, unsigned char* dst, float* sc, int row, int lane) {
    const GAS f32x4* sp = (const GAS f32x4*)(src + (size_t)row * D + 16 * lane);
    const f32x4 a = sp[0], b = sp[1], c = sp[2], d = sp[3];
    float mx = 0.f;
#pragma unroll
    for (int i = 0; i < 4; ++i) mx = fmaxf(fmaxf(fmaxf(mx, fabsf(a[i])), fmaxf(fabsf(b[i]), fabsf(c[i]))), fabsf(d[i]));
    mx = wave_max(mx); const float s = mx > 0.f ? 127.0f / mx : 1.0f;
    v4u o; o.x = pack4_i8(a[0] * s, a[1] * s, a[2] * s, a[3] * s); o.y = pack4_i8(b[0] * s, b[1] * s, b[2] * s, b[3] * s); o.z = pack4_i8(c[0] * s, c[1] * s, c[2] * s, c[3] * s); o.w = pack4_i8(d[0] * s, d[1] * s, d[2] * s, d[3] * s);
    *(GAS v4u*)(dst + (size_t)row * D + 16 * lane) = o;
    if (lane == 0) sc[row] = mx > 0.f ? mx * (1.0f / 127.0f) : 1.0f;
}

__device__ __forceinline__ unsigned pack8_i4(const f32x4 a, const f32x4 b, float s) {
    unsigned w = 0;
#pragma unroll
    for (int i = 0; i < 4; ++i) { const int qa = max(-8, min(7, __float2int_rn(a[i] * s))), qb = max(-8, min(7, __float2int_rn(b[i] * s))); w |= ((unsigned)qa & 15u) << (4 * i); w |= ((unsigned)qb & 15u) << (16 + 4 * i); }
    return w;
}
__device__ __forceinline__ void p0_row_i4(const float* src, unsigned char* dst, float* sc, int row, int lane) {
    const GAS f32x4* sp = (const GAS f32x4*)(src + (size_t)row * D + 16 * lane);
    const f32x4 a = sp[0], b = sp[1], c = sp[2], d = sp[3];
    float ss = 0.f;
#pragma unroll
    for (int i = 0; i < 4; ++i) ss += (a[i] * a[i] + b[i] * b[i]) + (c[i] * c[i] + d[i] * d[i]);
    ss = wave_sum(ss); const float sig = sqrtf(ss * (1.f / D)), s = sig > 0.f ? 3.0f / sig : 1.0f;
    v2u o; o.x = pack8_i4(a, b, s); o.y = pack8_i4(c, d, s);
    *(GAS v2u*)(dst + (size_t)row * (D / 2) + 8 * lane) = o;
    if (lane == 0) sc[row] = sig > 0.f ? sig * (1.0f / 3.0f) : 1.0f;
}

__device__ __forceinline__ unsigned pack8_fp4(const f32x4 a, const f32x4 b, float s) {
    unsigned w = 0;
    w = __builtin_amdgcn_cvt_scalef32_pk_fp4_f32(w, fminf(fmaxf(a[0] * s, -6.f), 6.f), fminf(fmaxf(a[1] * s, -6.f), 6.f), 1.0f, 0);
    w = __builtin_amdgcn_cvt_scalef32_pk_fp4_f32(w, fminf(fmaxf(a[2] * s, -6.f), 6.f), fminf(fmaxf(a[3] * s, -6.f), 6.f), 1.0f, 1);
    w = __builtin_amdgcn_cvt_scalef32_pk_fp4_f32(w, fminf(fmaxf(b[0] * s, -6.f), 6.f), fminf(fmaxf(b[1] * s, -6.f), 6.f), 1.0f, 2);
    w = __builtin_amdgcn_cvt_scalef32_pk_fp4_f32(w, fminf(fmaxf(b[2] * s, -6.f), 6.f), fminf(fmaxf(b[3] * s, -6.f), 6.f), 1.0f, 3);
    return w;
}
__device__ __forceinline__ void p0_row_fp4(const float* src, unsigned char* dst, float* sc, int row, int lane) {
    const GAS f32x4* sp = (const GAS f32x4*)(src + (size_t)row * D + 16 * lane);
    const f32x4 a = sp[0], b = sp[1], c = sp[2], d = sp[3];
    float mx = 0.f;
#pragma unroll
    for (int i = 0; i < 4; ++i) mx = fmaxf(fmaxf(fmaxf(mx, fabsf(a[i])), fmaxf(fabsf(b[i]), fabsf(c[i]))), fabsf(d[i]));
    mx = wave_max(mx); const float s = mx > 0.f ? 7.0f / mx : 1.0f;
    v2u o; o.x = pack8_fp4(a, b, s); o.y = pack8_fp4(c, d, s);
    *(GAS v2u*)(dst + (size_t)row * (D / 2) + 8 * lane) = o;
    if (lane == 0) sc[row] = mx > 0.f ? mx * (1.0f / 7.0f) : 1.0f;
}
#define XB_TMO      128
#define XB_XCNT(j)  (256  + 64 * (j))
#define XB_XSUB(j)  (1280 + 64 * (j))
#define XB_XGEN(j)  (2304 + 64 * (j))
#define XB_TOP      3328
#define XB_TOPGEN   3392
#define XCD_BAR_WORDS 3456
#define XB_SPIN_CAP (1u << 18)

__device__ __forceinline__ unsigned xb_ld(unsigned* p)              { return __hip_atomic_load(p, __ATOMIC_RELAXED, __HIP_MEMORY_SCOPE_AGENT); }
__device__ __forceinline__ unsigned xb_add(unsigned* p, unsigned v) { return __hip_atomic_fetch_add(p, v, __ATOMIC_RELAXED, __HIP_MEMORY_SCOPE_AGENT); }
__device__ __forceinline__ unsigned xb_xcc_id() { return (unsigned)__builtin_amdgcn_s_getreg((3 << 11) | 20) & 0xFu; }
#define XB_SPIN(cond, bar) do { unsigned _sp = 0; while (cond) { __builtin_amdgcn_s_sleep(1); \
    if ((++_sp & 255u) == 0u) { if (xb_ld(&(bar)[XB_TMO])) break; if (_sp > XB_SPIN_CAP) { atomicAdd(&(bar)[XB_TMO], 1u); break; } } } } while (0)

struct XcdBarrier {
    unsigned* bar; unsigned x;
    volatile LAS unsigned* st;
};

__device__ __forceinline__ XcdBarrier xcd_barrier_post(unsigned* bar, volatile LAS unsigned* st) {
    XcdBarrier b; b.bar = bar; b.x = xb_xcc_id(); b.st = st;
    if (threadIdx.x == 0) (void)xb_add(&bar[XB_XCNT(b.x)], 1u);
    return b;
}
__device__ __forceinline__ void xcd_barrier_complete(unsigned* bar, unsigned x, unsigned& nloc, unsigned& nx) {
    const unsigned G = gridDim.x * gridDim.y * gridDim.z;
    unsigned sum, cnt, mine, sp = 0u;
    for (;;) {
        sum = 0u; cnt = 0u; mine = 0u;
#pragma unroll
        for (unsigned j = 0; j < 16; ++j) { const unsigned c = xb_ld(&bar[XB_XCNT(j)]); sum += c; cnt += (c > 0u) ? 1u : 0u; mine = (j == x) ? c : mine; }
        if (sum == G) break;
        __builtin_amdgcn_s_sleep(1);
        if ((++sp & 255u) == 0u) { if (xb_ld(&bar[XB_TMO])) break; if (sp > XB_SPIN_CAP) { atomicAdd(&bar[XB_TMO], 1u); break; } }
    }
    nloc = mine > 0u ? mine : 1u; nx = cnt > 0u ? cnt : 1u;
}

__device__ __forceinline__ void xcd_barrier(const XcdBarrier& b) {
    asm volatile("s_waitcnt vmcnt(0)" ::: "memory");
    __syncthreads();
    if (threadIdx.x == 0) {
        unsigned* bar = b.bar;
        __builtin_amdgcn_s_waitcnt(0);
        unsigned nloc = b.st[0], nx = b.st[1];
        if (nloc == 0u) { xcd_barrier_complete(bar, b.x, nloc, nx); b.st[0] = nloc; b.st[1] = nx; }
        const unsigned old = xb_add(&bar[XB_XSUB(b.x)], 1u);
        const unsigned gen = old / nloc;
        if (old + 1u == (gen + 1u) * nloc) {
            __builtin_amdgcn_fence(__ATOMIC_RELEASE, "agent");
            asm volatile("s_waitcnt vmcnt(0)" ::: "memory");
            const unsigned og = xb_add(&bar[XB_TOP], 1u);
            const unsigned tg = og / nx;
            if (og + 1u == (tg + 1u) * nx) xb_add(&bar[XB_TOPGEN], 1u);
            else XB_SPIN(xb_ld(&bar[XB_TOPGEN]) == tg, bar);
            __builtin_amdgcn_fence(__ATOMIC_ACQUIRE, "agent");
            xb_add(&bar[XB_XGEN(b.x)], 1u);
            asm volatile("s_waitcnt vmcnt(0)" ::: "memory");
        } else {
            XB_SPIN(xb_ld(&bar[XB_XGEN(b.x)]) == gen, bar);
            __builtin_amdgcn_fence(__ATOMIC_ACQUIRE, "agent");
            asm volatile("s_waitcnt vmcnt(0)" ::: "memory");
        }
    }
    __syncthreads();
}
struct Args { const void* in[21]; float* out; unsigned char* ws; int ph_lo, ph_hi; };
enum { I_X = 0, I_C, I_POS, I_WMOD, I_BMOD, I_GPRE1, I_GPOST1, I_WIN, I_CONVW, I_BI, I_BF, I_MNG, I_SINK, I_WOUT, I_GPRE2, I_GPOST2, I_WQ, I_K1, I_K2, I_U, I_V };

__device__ __forceinline__ int newcol(int o) {
    if (o < 640) { const int hd = o >> 6, d = o & 63; return (hd << 6) + 2 * (d & 31) + (d >> 5); }
    if (o < 1792) return o;
    if (o < 1800) return 2304 + (o - 1792);
    return o - 8;
}
template <bool REMAP>
__device__ __forceinline__ void p0_transpose_item(const float* W, int K, int N, bf16* WT, LAS float* scr, int item, int lane) {
    const int nblk = (N + 31) / 32, kb = item / nblk, nb = item % nblk, k0 = 64 * kb, n0 = 32 * nb;
    const int ncol = n0 + (lane & 31);
#pragma unroll 8
    for (int i = 0; i < 32; ++i) { const int kk = 2 * i + (lane >> 5); scr[kk * 33 + (lane & 31)] = (ncol < N) ? W[(size_t)(k0 + kk) * N + ncol] : 0.f; }
    LDS_WAIT(); asm volatile("" ::: "memory");
    const int c = lane & 7;
#pragma unroll
    for (int j = 0; j < 4; ++j) { const int n = (lane >> 3) + 8 * j; const LAS float* s = scr + (8 * c) * 33 + n;
        v4u o; o.x = pk2(s[0 * 33], s[1 * 33]); o.y = pk2(s[2 * 33], s[3 * 33]); o.z = pk2(s[4 * 33], s[5 * 33]); o.w = pk2(s[6 * 33], s[7 * 33]);
        if (n0 + n < N) { const int drow = REMAP ? newcol(n0 + n) : (n0 + n); *(GAS v4u*)(WT + (size_t)drow * K + k0 + 8 * c) = o; } }
    LDS_WAIT(); asm volatile("" ::: "memory");
}
__device__ __forceinline__ void p0_convert(const float* src, bf16* dst, size_t n, int gt, int ngt) {
    for (size_t i = (size_t)gt * 8; i < n; i += (size_t)ngt * 8) {
        const f32x4 a = *(const GAS f32x4*)(src + i), b = *(const GAS f32x4*)(src + i + 4);
        v4u o; o.x = pk2(a[0], a[1]); o.y = pk2(a[2], a[3]); o.z = pk2(b[0], b[1]); o.w = pk2(b[2], b[3]);
        *(GAS v4u*)(dst + i) = o; }
}
__device__ __forceinline__ void phase_mod(const Args& A, LAS unsigned char* lds) {
    const int tid = threadIdx.x, G = gridDim.x, blk = blockIdx.x;
    unsigned char* ws = A.ws;
    const float* c = (const float*)A.in[I_C]; const float* wm = (const float*)A.in[I_WMOD]; const float* bm = (const float*)A.in[I_BMOD];
    float* mod = (float*)(ws + WS_MOD); LAS float* cs = (LAS float*)lds; LAS float* red = cs + 8 * 1024;
    for (int e = tid; e < 8 * 1024 / 4; e += NTHR) *(LAS f32x4*)(cs + 4 * e) = *(const GAS f32x4*)(c + 4 * e);
    __syncthreads();
    for (int it = blk; it < 6144 / 24; it += G) {
        const int kg = tid >> 5, col = tid & 31, j = it * 24 + (col < 24 ? col : 23); float acc[8];
#pragma unroll
        for (int b = 0; b < 8; ++b) acc[b] = 0.f;
#pragma unroll 16
        for (int i = 0; i < 64; ++i) { const int k = kg + 16 * i; const float w = wm[(size_t)k * 6144 + j];
#pragma unroll
            for (int b = 0; b < 8; ++b) acc[b] += cs[b * 1024 + k] * w; }
#pragma unroll
        for (int b = 0; b < 8; ++b) red[(kg * 32 + col) * 8 + b] = acc[b];
        __syncthreads();
        if (tid < 256) { const int b = tid >> 5, cc = tid & 31; float s = 0.f;
#pragma unroll
            for (int g = 0; g < 16; ++g) s += red[(g * 32 + cc) * 8 + b];
            if (cc < 24) mod[b * 6144 + it * 24 + cc] = s + bm[it * 24 + cc]; }
        __syncthreads();
    }
}
__device__ __forceinline__ void phase_convert(const Args& A, LAS unsigned char* lds) {
    const int tid = threadIdx.x, lane = tid & 63, wave = tid >> 6, G = gridDim.x, blk = blockIdx.x;
    unsigned char* ws = A.ws;
    {
        LAS float* scr = (LAS float*)(lds + wave * 16384);
        const int gw = blk * NWAVES + wave, NGW = G * NWAVES;
        const int I_IN = (D / 64) * ((DIN + 31) / 32), I_OUT = (D / 64) * (D / 32), I_Q = (D / 64) * (2048 / 32);
        bf16* win = (bf16*)(ws + WS_WIN); bf16* wout = (bf16*)(ws + WS_WOUT); bf16* wq = (bf16*)(ws + WS_WQ);
        for (int it = gw; it < I_IN + I_OUT + I_Q; it += NGW) {
            int r = it;
            if (r < I_IN) { p0_transpose_item<true>((const float*)A.in[I_WIN], D, DIN, win, scr, r, lane); continue; } r -= I_IN;
            if (r < I_OUT) { p0_transpose_item<false>((const float*)A.in[I_WOUT], D, D, wout, scr, r, lane); continue; } r -= I_OUT;
            p0_transpose_item<false>((const float*)A.in[I_WQ], D, 2048, wq, scr, r, lane);
        }
        const int gt = blk * NTHR + tid, ngt = G * NTHR;
        for (int i = gt; i < (NIN_PAD - DIN) * D / 8; i += ngt) *(GAS v4u*)(win + (size_t)DIN * D + (size_t)i * 8) = (v4u){0u, 0u, 0u, 0u};
        p0_convert((const float*)A.in[I_K1], (bf16*)(ws + WS_KEYS), (size_t)8 * 128 * 128, gt, ngt);
        p0_convert((const float*)A.in[I_K2], (bf16*)(ws + WS_KEYS) + 8 * 128 * 128, (size_t)8 * 128 * 128, gt, ngt);
        for (int r = gw; r < 2 * NEXP; r += NGW) { if (r < NEXP) p0_row_i4((const float*)A.in[I_U], ws + WS_U8, (float*)(ws + WS_SC), r, lane); else p0_row_fp4((const float*)A.in[I_V], ws + WS_V8, (float*)(ws + WS_SC) + NEXP, r - NEXP, lane); }
    }
}

__device__ __forceinline__ void phase_prenorm(const Args& A) {
    const int tid = threadIdx.x, lane = tid & 63, wave = tid >> 6, G = gridDim.x;
    const float* x = (const float*)A.in[I_X]; const float* g = (const float*)A.in[I_GPRE1]; const float* mod = (const float*)(A.ws + WS_MOD);
    bf16* H = (bf16*)(A.ws + WS_H);
    for (int row = blockIdx.x * NWAVES + wave; row < M; row += G * NWAVES) {
        const int b = row / SEQ; const GAS f32x4* xr = (const GAS f32x4*)(x + (size_t)row * D) + lane;
        f32x4 v[4]; float s = 0.f;
#pragma unroll
        for (int j = 0; j < 4; ++j) { v[j] = xr[64 * j]; s += (v[j][0] * v[j][0] + v[j][1] * v[j][1]) + (v[j][2] * v[j][2] + v[j][3] * v[j][3]); }
        const float rstd = 1.0f / sqrtf(wave_sum(s) * (1.f / D) + EPS);
        GAS v2u* o = (GAS v2u*)(H + (size_t)row * D) + lane;
#pragma unroll
        for (int j = 0; j < 4; ++j) { const int k = 4 * (lane + 64 * j);
            const f32x4 gg = *(const GAS f32x4*)(g + k), sh = *(const GAS f32x4*)(mod + b * 6144 + k), sc = *(const GAS f32x4*)(mod + b * 6144 + 1024 + k);
            f32x4 y;
#pragma unroll
            for (int i = 0; i < 4; ++i) y[i] = v[j][i] * rstd * gg[i] * (1.f + sc[i]) + sh[i];
            v2u w; w.x = pk2(y[0], y[1]); w.y = pk2(y[2], y[3]); o[64 * j] = w; }
    }
}

__device__ __forceinline__ void phase_mid(const Args& A) {
    const int tid = threadIdx.x, lane = tid & 63, wave = tid >> 6, G = gridDim.x;
    const float* x = (const float*)A.in[I_X]; const float* gpost = (const float*)A.in[I_GPOST1]; const float* gpre = (const float*)A.in[I_GPRE2];
    const float* mod = (const float*)(A.ws + WS_MOD); const float* sumsq = (const float*)(A.ws + WS_SSQ);
    const bf16* MIX = (const bf16*)(A.ws + WS_MIX); bf16* H = (bf16*)(A.ws + WS_H); bf16* X1 = (bf16*)(A.ws + WS_X1);
    for (int row = blockIdx.x * NWAVES + wave; row < M; row += G * NWAVES) {
        const int b = row / SEQ; const GAS f32x4* xr = (const GAS f32x4*)(x + (size_t)row * D) + lane; const GAS v2u* mr = (const GAS v2u*)(MIX + (size_t)row * D) + lane;
        const f32x4 q0 = *(const GAS f32x4*)(sumsq + (size_t)row * 16), q1 = *(const GAS f32x4*)(sumsq + (size_t)row * 16 + 4), q2 = *(const GAS f32x4*)(sumsq + (size_t)row * 16 + 8), q3 = *(const GAS f32x4*)(sumsq + (size_t)row * 16 + 12);
        const float rm = 1.0f / sqrtf(((((q0[0] + q0[1]) + (q0[2] + q0[3])) + ((q1[0] + q1[1]) + (q1[2] + q1[3]))) + (((q2[0] + q2[1]) + (q2[2] + q2[3])) + ((q3[0] + q3[1]) + (q3[2] + q3[3])))) * (1.f / D) + EPS);
        f32x4 v[4]; float s = 0.f;
#pragma unroll
        for (int j = 0; j < 4; ++j) { const int k = 4 * (lane + 64 * j); const f32x4 xv = xr[64 * j]; const v2u mw = mr[64 * j];
            const f32x4 gp = *(const GAS f32x4*)(gpost + k), g1 = *(const GAS f32x4*)(mod + b * 6144 + 2048 + k);
            const float mx[4] = {bflo(mw.x), bfhi(mw.x), bflo(mw.y), bfhi(mw.y)};
#pragma unroll
            for (int i = 0; i < 4; ++i) { v[j][i] = xv[i] + g1[i] * (mx[i] * rm * gp[i]); s += v[j][i] * v[j][i]; }
            { v2u w; w.x = pk2(v[j][0], v[j][1]); w.y = pk2(v[j][2], v[j][3]); *((GAS v2u*)(X1 + (size_t)row * D) + lane + 64 * j) = w; } }
        const float rstd = 1.0f / sqrtf(wave_sum(s) * (1.f / D) + EPS);
        GAS v2u* o = (GAS v2u*)(H + (size_t)row * D) + lane; float amx = 0.f;
#pragma unroll
        for (int j = 0; j < 4; ++j) { const int k = 4 * (lane + 64 * j);
            const f32x4 gg = *(const GAS f32x4*)(gpre + k), sh = *(const GAS f32x4*)(mod + b * 6144 + 3072 + k), sc = *(const GAS f32x4*)(mod + b * 6144 + 4096 + k);
#pragma unroll
            for (int i = 0; i < 4; ++i) { v[j][i] = v[j][i] * rstd * gg[i] * (1.f + sc[i]) + sh[i]; amx = fmaxf(amx, fabsf(v[j][i])); }
            v2u w; w.x = pk2(v[j][0], v[j][1]); w.y = pk2(v[j][2], v[j][3]); o[64 * j] = w; }
        amx = wave_max(amx); const float s8 = amx > 0.f ? 119.0f / amx : 1.0f;
        GAS unsigned short* ohh = (GAS unsigned short*)((unsigned char*)A.ws + WS_H8 + (size_t)row * (D / 2)) + lane; GAS unsigned short* ohl = (GAS unsigned short*)((unsigned char*)A.ws + WS_H8 + 32 * MiB + (size_t)row * (D / 2)) + lane;
#pragma unroll
        for (int j = 0; j < 4; ++j) { unsigned whh = 0, whl = 0;
#pragma unroll
            for (int i = 0; i < 4; ++i) { const int tq = __float2int_rn(v[j][i] * s8) + 8; whh |= ((unsigned)(tq >> 4) & 15u) << (4 * i); whl |= ((unsigned)((tq & 15) - 8) & 15u) << (4 * i); }
            ohh[64 * j] = (unsigned short)whh; ohl[64 * j] = (unsigned short)whl; }
        if (lane == 0) ((float*)(A.ws + WS_HS))[row] = amx > 0.f ? amx * (1.0f / 119.0f) : 1.0f;
    }
}
__device__ __forceinline__ void load64bf(const bf16* p, float (&o)[64]) {
#pragma unroll
    for (int i = 0; i < 8; ++i) { const v4u w = *(const GAS v4u*)(p + 8 * i);
        o[8 * i + 0] = bflo(w.x); o[8 * i + 1] = bfhi(w.x); o[8 * i + 2] = bflo(w.y); o[8 * i + 3] = bfhi(w.y);
        o[8 * i + 4] = bflo(w.z); o[8 * i + 5] = bfhi(w.z); o[8 * i + 6] = bflo(w.w); o[8 * i + 7] = bfhi(w.w); }
}
__device__ __forceinline__ void phase_attn_naive(const Args& A, int vb, int nvb) {
    const bf16* P = (const bf16*)(A.ws + WS_PROJ); bf16* MI = (bf16*)(A.ws + WS_MIXIN); const float* sinks = (const float*)A.in[I_SINK];
    for (int task = vb * NTHR + (int)threadIdx.x; task < 8 * M; task += nvb * NTHR) {
        const int h = task / M, t = task % M, s = t % SEQ, kvh = h >> 2;
        float q[64], o[64];
        load64bf(P + (size_t)t * NPROJ + C_AQ + h * 64, q);
#pragma unroll
        for (int d = 0; d < 64; ++d) o[d] = 0.f;
        float mx = sinks[h], l = 1.f;
        for (int j = 0; j < 128; ++j) {
            const int sj = s - 127 + j; const bool valid = sj >= 0; const int tk = valid ? (t - 127 + j) : t;
            const bf16* kr = P + (size_t)tk * NPROJ + C_AK + kvh * 64; float sc = 0.f;
#pragma unroll
            for (int i = 0; i < 8; ++i) { const v4u w = *(const GAS v4u*)(kr + 8 * i);
                sc += q[8 * i + 0] * bflo(w.x) + q[8 * i + 1] * bfhi(w.x) + q[8 * i + 2] * bflo(w.y) + q[8 * i + 3] * bfhi(w.y)
                    + q[8 * i + 4] * bflo(w.z) + q[8 * i + 5] * bfhi(w.z) + q[8 * i + 6] * bflo(w.w) + q[8 * i + 7] * bfhi(w.w); }
            if (valid) {
                const float mn = fmaxf(mx, sc), al = __expf(mx - mn), p = __expf(sc - mn); mx = mn; l = l * al + p;
                const bf16* vr = P + (size_t)tk * NPROJ + C_AV + kvh * 64;
#pragma unroll
                for (int i = 0; i < 8; ++i) { const v4u w = *(const GAS v4u*)(vr + 8 * i);
                    o[8 * i + 0] = o[8 * i + 0] * al + p * bflo(w.x); o[8 * i + 1] = o[8 * i + 1] * al + p * bfhi(w.x);
                    o[8 * i + 2] = o[8 * i + 2] * al + p * bflo(w.y); o[8 * i + 3] = o[8 * i + 3] * al + p * bfhi(w.y);
                    o[8 * i + 4] = o[8 * i + 4] * al + p * bflo(w.z); o[8 * i + 5] = o[8 * i + 5] * al + p * bfhi(w.z);
                    o[8 * i + 6] = o[8 * i + 6] * al + p * bflo(w.w); o[8 * i + 7] = o[8 * i + 7] * al + p * bfhi(w.w); }
            }
        }
        const float il = 1.f / l; bf16* orow = MI + (size_t)t * D + h * 64;
#pragma unroll
        for (int i = 0; i < 8; ++i) { v4u w; w.x = pk2(o[8 * i] * il, o[8 * i + 1] * il); w.y = pk2(o[8 * i + 2] * il, o[8 * i + 3] * il);
            w.z = pk2(o[8 * i + 4] * il, o[8 * i + 5] * il); w.w = pk2(o[8 * i + 6] * il, o[8 * i + 7] * il); *(GAS v4u*)(orow + 8 * i) = w; }
    }
}

__device__ __forceinline__ void phase_mlstm_naive(const Args& A, LAS unsigned char* lds, int bh) {
    const int tid = threadIdx.x, lane = tid & 63, wave = tid >> 6, b = bh >> 2, h = bh & 3, dv = tid >> 2, part = tid & 3;
    const bf16* P = (const bf16*)(A.ws + WS_PROJ); bf16* MI = (bf16*)(A.ws + WS_MIXIN); const float* gates = (const float*)(A.ws + WS_GATES);
    const float* cw = (const float*)A.in[I_CONVW]; const float* ng = (const float*)A.in[I_MNG];
    LAS float* qs = (LAS float*)lds; LAS float* ks = qs + 64 * 64; LAS float* vs = ks + 64 * 64; LAS float* ig = vs + 64 * 128; LAS float* lfg = ig + 64; LAS float* hb = lfg + 64;
    float C[16], n[16]; float m = 0.f;
#pragma unroll
    for (int j = 0; j < 16; ++j) { C[j] = 0.f; n[j] = 0.f; }
    for (int ch = 0; ch < SEQ / 64; ++ch) {
        const int s0 = ch * 64; const size_t t0 = (size_t)b * SEQ + s0;
        for (int e = tid; e < 64 * 64; e += NTHR) { const int l = e >> 6, dk = e & 63; float aq = 0.f, ak = 0.f;
#pragma unroll
            for (int j = 0; j < 4; ++j) { const int sj = s0 + l - 3 + j; if (sj >= 0) { const bf16* r = P + ((size_t)b * SEQ + sj) * NPROJ;
                aq += cw[j * 512 + h * 64 + dk] * bf1(r[C_MQ + h * 64 + dk]); ak += cw[j * 512 + 256 + h * 64 + dk] * bf1(r[C_MK + h * 64 + dk]); } }
            qs[e] = 0.125f * aq / (1.f + __expf(-aq)); ks[e] = ak / (1.f + __expf(-ak)); }
        for (int e = tid; e < 64 * 128; e += NTHR) { const int l = e >> 7, d = e & 127; vs[e] = bf1(P[(t0 + l) * NPROJ + C_MV + h * 128 + d]); }
        if (tid < 64) { ig[tid] = gates[(t0 + tid) * 8 + h]; lfg[tid] = gates[(t0 + tid) * 8 + 4 + h]; }
        __syncthreads();
        for (int l = 0; l < 64; ++l) {
            const float lf = lfg[l], ii = ig[l], mn = fmaxf(lf + m, ii), fd = __expf(lf + m - mn), iw = __expf(ii - mn), vv = vs[l * 128 + dv] * iw;
            float num = 0.f, den = 0.f;
#pragma unroll
            for (int j = 0; j < 16; ++j) { const float kk = ks[l * 64 + part * 16 + j], qq = qs[l * 64 + part * 16 + j];
                C[j] = fd * C[j] + vv * kk; n[j] = fd * n[j] + iw * kk; num += C[j] * qq; den += n[j] * qq; }
            num += __shfl_xor(num, 1); num += __shfl_xor(num, 2); den += __shfl_xor(den, 1); den += __shfl_xor(den, 2);
            if (part == 0) hb[l * 128 + dv] = num / fmaxf(fabsf(den), __expf(-mn));
            m = mn;
        }
        __syncthreads();
        for (int l = wave * 8; l < wave * 8 + 8; ++l) { const float a0 = hb[l * 128 + lane], a1 = hb[l * 128 + 64 + lane];
            const float r = 1.0f / sqrtf(wave_sum(a0 * a0 + a1 * a1) * (1.f / 128.f) + EPS);
            const bf16* pr = P + (t0 + l) * NPROJ + C_MO + h * 128; bf16* orow = MI + (t0 + l) * D + 512 + h * 128;
            orow[lane] = (bf16)f2bf(a0 * r * ng[h * 128 + lane] * bf1(pr[lane])); orow[64 + lane] = (bf16)f2bf(a1 * r * ng[h * 128 + 64 + lane] * bf1(pr[64 + lane])); }
        __syncthreads();
    }
}

__device__ __forceinline__ void ld16bf(const bf16* p, float (&o)[16]) {
    const v4u w0 = *(const GAS v4u*)p, w1 = *(const GAS v4u*)(p + 8);
    o[0] = bflo(w0.x); o[1] = bfhi(w0.x); o[2] = bflo(w0.y); o[3] = bfhi(w0.y); o[4] = bflo(w0.z); o[5] = bfhi(w0.z); o[6] = bflo(w0.w); o[7] = bfhi(w0.w);
    o[8] = bflo(w1.x); o[9] = bfhi(w1.x); o[10] = bflo(w1.y); o[11] = bfhi(w1.y); o[12] = bflo(w1.z); o[13] = bfhi(w1.z); o[14] = bflo(w1.w); o[15] = bfhi(w1.w);
}
typedef short bf16x8 __attribute__((ext_vector_type(8)));
#define MFMA16(a, b, c) __builtin_amdgcn_mfma_f32_16x16x32_bf16((a), (b), (c), 0, 0, 0)
__device__ __forceinline__ bf16x8 ldfrag(LAS const unsigned char* img, int row, int kbyte) { return *(LAS const bf16x8*)(img + row * 144 + kbyte); }
__device__ __forceinline__ unsigned cvtpk(float lo, float hi) { unsigned r; asm volatile("v_cvt_pk_bf16_f32 %0, %1, %2" : "=v"(r) : "v"(lo), "v"(hi)); return r; }

namespace ml {
constexpr int O_Q = 0, O_QA = 9216, O_K = 18432, O_KWT = 27648, O_VT = 36864, O_CX = 57600, CXB = 20736, O_S = 99072, O_GB = 108288, O_GA = O_GB + 4096, O_GC = O_GA + 4096, O_DEN = O_GC + 4096, O_SSQ = O_DEN + 256, O_END = O_SSQ + 2048;
static_assert(O_END <= 131072, "mlstm LDS");
constexpr size_t MST_SC = 11 * MiB;
}
template <bool OUT>
__device__ __forceinline__ void mlstm_group(const Args& A, LAS unsigned char* lds, int wg) {
    using namespace ml;
    const int tid = threadIdx.x, lane = tid & 63, wave = __builtin_amdgcn_readfirstlane(tid >> 6), fr = lane & 15, fq = lane >> 4;
    const int bh = wg >> 3, grp = wg & 7, b = bh >> 2, h = bh & 3;
    const size_t tg0 = (size_t)b * SEQ + (size_t)grp * 1024;
    const bf16* P = (const bf16*)(A.ws + WS_PROJ); bf16* MI = (bf16*)(A.ws + WS_MIXIN); const float* gates = (const float*)(A.ws + WS_GATES);
    const float* cw = (const float*)A.in[I_CONVW]; const float* ng = (const float*)A.in[I_MNG];
    float* MST = (float*)(A.ws + WS_MST); float* MSC = (float*)(A.ws + WS_MST + MST_SC);
    LAS float* GB = (LAS float*)(lds + O_GB); LAS float* GA = (LAS float*)(lds + O_GA); LAS float* GC = (LAS float*)(lds + O_GC);
    LAS float* DEN = (LAS float*)(lds + O_DEN); LAS float* SSQ = (LAS float*)(lds + O_SSQ);
    __syncthreads();
#pragma unroll
    for (int cc = 0; cc < 2; ++cc) { const int c = 2 * wave + cc; const size_t t = tg0 + c * 64 + lane;
        float bc = gates[t * 8 + 4 + h]; const float ii = gates[t * 8 + h];
#pragma unroll
        for (int o = 1; o < 64; o <<= 1) { const float v = __shfl_up(bc, o); if (lane >= o) bc += v; }
        const float a = ii - bc; float cm = a;
#pragma unroll
        for (int o = 1; o < 64; o <<= 1) { const float v = __shfl_up(cm, o); if (lane >= o) cm = fmaxf(cm, v); }
        GB[c * 64 + lane] = bc; GA[c * 64 + lane] = a; GC[c * 64 + lane] = cm; }
    for (int e = tid; e < 16 * 32; e += NTHR) { const int r = e >> 5, cpair = e & 31; *(LAS unsigned*)(lds + O_VT + (128 + r) * 144 + cpair * 4) = (r == 0) ? 0x3F803F80u : 0u; }
    f32x4 st[5];
#pragma unroll
    for (int i = 0; i < 5; ++i) st[i] = (f32x4){0.f, 0.f, 0.f, 0.f};
    float m = OUT ? 0.f : -__builtin_inff(); float Btot = 0.f;
    if (OUT) {
        for (int gp = 0; gp < grp; ++gp) { const int wgp = bh * 8 + gp; const float mg = MSC[wgp * 2], Bg = MSC[wgp * 2 + 1];
            const float mn = fmaxf(Bg + m, mg), f0 = __expf(Bg + m - mn), f1 = __expf(mg - mn);
#pragma unroll
            for (int i = 0; i < 5; ++i)
#pragma unroll
                for (int r = 0; r < 4; ++r) st[i][r] = f0 * st[i][r] + f1 * MST[((size_t)wgp * 20 + i * 4 + r) * NTHR + tid];
            m = mn; }
#pragma unroll
        for (int j = 0; j < 4; ++j)
#pragma unroll
            for (int r = 0; r < 4; ++r) *(LAS bf16*)(lds + O_CX + (16 * wave + 4 * fq + r) * 144 + (16 * j + fr) * 2) = (bf16)f2bf(st[j][r]);
        if (wave < 4) {
#pragma unroll
            for (int r = 0; r < 4; ++r) *(LAS bf16*)(lds + O_CX + (128 + 4 * fq + r) * 144 + (16 * wave + fr) * 2) = (bf16)f2bf(st[4][r]); }
    }
    float gsc[4];
#pragma unroll
    for (int r = 0; r < 4; ++r) gsc[r] = ng[h * 128 + 16 * wave + 4 * fq + r];
    const int sl = tid >> 3, cg = tid & 7;
    __syncthreads();
    for (int c = 0; c < 16; ++c) {
        const float bL = GB[c * 64 + 63], M63 = fmaxf(m, GC[c * 64 + 63]), decay = __expf(m - M63);
        const size_t tc0 = tg0 + (size_t)c * 64;
        {
            const int sabs = grp * 1024 + c * 64 + sl;
            float aq[8], ak[8];
#pragma unroll
            for (int i = 0; i < 8; ++i) { aq[i] = 0.f; ak[i] = 0.f; }
#pragma unroll
            for (int j = 0; j < 4; ++j) { const int sj = sabs - 3 + j;
                if (sj >= 0) { const bf16* rp = P + ((size_t)b * SEQ + sj) * NPROJ;
                    const v4u wq = *(const GAS v4u*)(rp + C_MQ + h * 64 + 8 * cg), wk = *(const GAS v4u*)(rp + C_MK + h * 64 + 8 * cg);
                    const f32x4 q0 = *(const GAS f32x4*)(cw + j * 512 + h * 64 + 8 * cg), q1 = *(const GAS f32x4*)(cw + j * 512 + h * 64 + 8 * cg + 4);
                    const f32x4 k0 = *(const GAS f32x4*)(cw + j * 512 + 256 + h * 64 + 8 * cg), k1 = *(const GAS f32x4*)(cw + j * 512 + 256 + h * 64 + 8 * cg + 4);
                    aq[0] += q0[0] * bflo(wq.x); aq[1] += q0[1] * bfhi(wq.x); aq[2] += q0[2] * bflo(wq.y); aq[3] += q0[3] * bfhi(wq.y);
                    aq[4] += q1[0] * bflo(wq.z); aq[5] += q1[1] * bfhi(wq.z); aq[6] += q1[2] * bflo(wq.w); aq[7] += q1[3] * bfhi(wq.w);
                    ak[0] += k0[0] * bflo(wk.x); ak[1] += k0[1] * bfhi(wk.x); ak[2] += k0[2] * bflo(wk.y); ak[3] += k0[3] * bfhi(wk.y);
                    ak[4] += k1[0] * bflo(wk.z); ak[5] += k1[1] * bfhi(wk.z); ak[6] += k1[2] * bflo(wk.w); ak[7] += k1[3] * bfhi(wk.w); } }
            const float Ml = fmaxf(m, GC[c * 64 + sl]), ainter = __expf(m - Ml), wsv = __expf(GA[c * 64 + sl] - M63);
            float qv[8], kv[8];
#pragma unroll
            for (int i = 0; i < 8; ++i) { qv[i] = 0.125f * aq[i] * __builtin_amdgcn_rcpf(1.f + __expf(-aq[i])); kv[i] = ak[i] * __builtin_amdgcn_rcpf(1.f + __expf(-ak[i])); }
            if (OUT) {
                v4u w; w.x = pk2(qv[0], qv[1]); w.y = pk2(qv[2], qv[3]); w.z = pk2(qv[4], qv[5]); w.w = pk2(qv[6], qv[7]); *(LAS v4u*)(lds + O_Q + sl * 144 + cg * 16) = w;
                w.x = pk2(qv[0] * ainter, qv[1] * ainter); w.y = pk2(qv[2] * ainter, qv[3] * ainter); w.z = pk2(qv[4] * ainter, qv[5] * ainter); w.w = pk2(qv[6] * ainter, qv[7] * ainter); *(LAS v4u*)(lds + O_QA + sl * 144 + cg * 16) = w;
                w.x = pk2(kv[0], kv[1]); w.y = pk2(kv[2], kv[3]); w.z = pk2(kv[4], kv[5]); w.w = pk2(kv[6], kv[7]); *(LAS v4u*)(lds + O_K + sl * 144 + cg * 16) = w;
            }
#pragma unroll
            for (int i = 0; i < 8; ++i) *(LAS bf16*)(lds + O_KWT + (8 * cg + i) * 144 + sl * 2) = (bf16)f2bf(kv[i] * wsv);
#pragma unroll
            for (int gi = 0; gi < 2; ++gi) { const int g8 = cg + 8 * gi; const v4u wv = *(const GAS v4u*)(P + (tc0 + sl) * NPROJ + C_MV + h * 128 + 8 * g8);
                const unsigned ww[4] = {wv.x, wv.y, wv.z, wv.w};
#pragma unroll
                for (int i = 0; i < 4; ++i) { *(LAS bf16*)(lds + O_VT + (8 * g8 + 2 * i) * 144 + sl * 2) = (bf16)(ww[i] & 0xffffu); *(LAS bf16*)(lds + O_VT + (8 * g8 + 2 * i + 1) * 144 + sl * 2) = (bf16)(ww[i] >> 16); } }
        }
        __syncthreads();
        if (OUT) {
            const int lt = wave >> 1, l = 16 * lt + fr; const float Ml = fmaxf(m, GC[c * 64 + l]);
            const bf16x8 bq0 = ldfrag(lds + O_Q, 16 * lt + fr, 16 * fq), bq1 = ldfrag(lds + O_Q, 16 * lt + fr, 64 + 16 * fq);
#pragma unroll
            for (int u = 0; u < 2; ++u) { const int stl = 2 * (wave & 1) + u; f32x4 acc = {0.f, 0.f, 0.f, 0.f};
                acc = MFMA16(ldfrag(lds + O_K, 16 * stl + fr, 16 * fq), bq0, acc); acc = MFMA16(ldfrag(lds + O_K, 16 * stl + fr, 64 + 16 * fq), bq1, acc);
                const f32x4 av = *(LAS const f32x4*)(GA + c * 64 + 16 * stl + 4 * fq); float wv[4];
#pragma unroll
                for (int r = 0; r < 4; ++r) { const int s = 16 * stl + 4 * fq + r; wv[r] = (s <= l) ? acc[r] * __expf(av[r] - Ml) : 0.f; }
                v2u w; w.x = cvtpk(wv[0], wv[1]); w.y = cvtpk(wv[2], wv[3]); *(LAS v2u*)(lds + O_S + l * 144 + (16 * stl + 4 * fq) * 2) = w; }
        }
        {
            const bf16x8 va0 = ldfrag(lds + O_VT, 16 * wave + fr, 16 * fq), va1 = ldfrag(lds + O_VT, 16 * wave + fr, 64 + 16 * fq);
#pragma unroll
            for (int j = 0; j < 4; ++j) { st[j] = st[j] * decay;
                st[j] = MFMA16(va0, ldfrag(lds + O_KWT, 16 * j + fr, 16 * fq), st[j]); st[j] = MFMA16(va1, ldfrag(lds + O_KWT, 16 * j + fr, 64 + 16 * fq), st[j]); }
            if (wave < 4) { st[4] = st[4] * decay;
                st[4] = MFMA16(ldfrag(lds + O_VT, 128 + fr, 16 * fq), ldfrag(lds + O_KWT, 16 * wave + fr, 16 * fq), st[4]);
                st[4] = MFMA16(ldfrag(lds + O_VT, 128 + fr, 64 + 16 * fq), ldfrag(lds + O_KWT, 16 * wave + fr, 64 + 16 * fq), st[4]); }
        }
        if (OUT) {
            __syncthreads();
            LAS const unsigned char* cx = lds + O_CX + (c & 1) * CXB;
            f32x4 nt[4], nd = {0.f, 0.f, 0.f, 0.f};
            {
                const bf16x8 va0 = ldfrag(lds + O_VT, 16 * wave + fr, 16 * fq), va1 = ldfrag(lds + O_VT, 16 * wave + fr, 64 + 16 * fq);
                const bf16x8 ca0 = ldfrag(cx, 16 * wave + fr, 16 * fq), ca1 = ldfrag(cx, 16 * wave + fr, 64 + 16 * fq);
#pragma unroll
                for (int lt = 0; lt < 4; ++lt) { f32x4 acc = {0.f, 0.f, 0.f, 0.f};
                    acc = MFMA16(va0, ldfrag(lds + O_S, 16 * lt + fr, 16 * fq), acc); acc = MFMA16(va1, ldfrag(lds + O_S, 16 * lt + fr, 64 + 16 * fq), acc);
                    acc = MFMA16(ca0, ldfrag(lds + O_QA, 16 * lt + fr, 16 * fq), acc); acc = MFMA16(ca1, ldfrag(lds + O_QA, 16 * lt + fr, 64 + 16 * fq), acc); nt[lt] = acc; }
                if (wave >= 4) { const int lt = wave - 4;
                    nd = MFMA16(ldfrag(lds + O_VT, 128 + fr, 16 * fq), ldfrag(lds + O_S, 16 * lt + fr, 16 * fq), nd); nd = MFMA16(ldfrag(lds + O_VT, 128 + fr, 64 + 16 * fq), ldfrag(lds + O_S, 16 * lt + fr, 64 + 16 * fq), nd);
                    nd = MFMA16(ldfrag(cx, 128 + fr, 16 * fq), ldfrag(lds + O_QA, 16 * lt + fr, 16 * fq), nd); nd = MFMA16(ldfrag(cx, 128 + fr, 64 + 16 * fq), ldfrag(lds + O_QA, 16 * lt + fr, 64 + 16 * fq), nd);
                    if (fq == 0) DEN[16 * lt + fr] = nd[0]; }
            }
            v2u mo[4];
#pragma unroll
            for (int lt = 0; lt < 4; ++lt) mo[lt] = *(const GAS v2u*)(P + (tc0 + 16 * lt + fr) * NPROJ + C_MO + h * 128 + 16 * wave + 4 * fq);
            __syncthreads();
#pragma unroll
            for (int lt = 0; lt < 4; ++lt) { const int l = 16 * lt + fr; const float Ml = fmaxf(m, GC[c * 64 + l]);
                const float inv = 1.0f / fmaxf(fabsf(DEN[l]), __expf(-(GB[c * 64 + l] + Ml)));
                nt[lt] = nt[lt] * inv; float ss = (nt[lt][0] * nt[lt][0] + nt[lt][1] * nt[lt][1]) + (nt[lt][2] * nt[lt][2] + nt[lt][3] * nt[lt][3]);
                ss += __shfl_xor(ss, 16); ss += __shfl_xor(ss, 32);
                if (fq == 0) SSQ[wave * 64 + l] = ss; }
            LAS unsigned char* cxn = lds + O_CX + ((c + 1) & 1) * CXB;
#pragma unroll
            for (int j = 0; j < 4; ++j)
#pragma unroll
                for (int r = 0; r < 4; ++r) *(LAS bf16*)(cxn + (16 * wave + 4 * fq + r) * 144 + (16 * j + fr) * 2) = (bf16)f2bf(st[j][r]);
            if (wave < 4) {
#pragma unroll
                for (int r = 0; r < 4; ++r) *(LAS bf16*)(cxn + (128 + 4 * fq + r) * 144 + (16 * wave + fr) * 2) = (bf16)f2bf(st[4][r]); }
            __syncthreads();
#pragma unroll
            for (int lt = 0; lt < 4; ++lt) { const int l = 16 * lt + fr; float tot = 0.f;
#pragma unroll
                for (int w2 = 0; w2 < 8; ++w2) tot += SSQ[w2 * 64 + l];
                const float rn = 1.0f / sqrtf(tot * (1.f / 128.f) + EPS);
                const float o0 = nt[lt][0] * rn * gsc[0] * bflo(mo[lt].x), o1 = nt[lt][1] * rn * gsc[1] * bfhi(mo[lt].x), o2 = nt[lt][2] * rn * gsc[2] * bflo(mo[lt].y), o3 = nt[lt][3] * rn * gsc[3] * bfhi(mo[lt].y);
                v2u w; w.x = pk2(o0, o1); w.y = pk2(o2, o3);
                *(GAS v2u*)(MI + (tc0 + l) * D + 512 + h * 128 + 16 * wave + 4 * fq) = w; }
        } else {
            __syncthreads();
        }
        m = bL + M63; Btot += bL;
    }
    if (!OUT) {
#pragma unroll
        for (int i = 0; i < 5; ++i)
#pragma unroll
            for (int r = 0; r < 4; ++r) MST[((size_t)wg * 20 + i * 4 + r) * NTHR + tid] = st[i][r];
        if (tid == 0) { MSC[wg * 2] = m; MSC[wg * 2 + 1] = Btot; }
    }
}

namespace at {
constexpr int O_K = 0, O_VT = 36864, VTS = 560  , O_END = O_VT + 64 * VTS;
static_assert(O_END <= 131072, "attention LDS");
}
__device__ __forceinline__ void phase_attn(const Args& A, LAS unsigned char* lds) {
    using namespace at;
    const int tid = threadIdx.x, lane = tid & 63, wave = __builtin_amdgcn_readfirstlane(tid >> 6), fr = lane & 15, fq = lane >> 4, G = gridDim.x;
    const bf16* P = (const bf16*)(A.ws + WS_PROJ); bf16* MI = (bf16*)(A.ws + WS_MIXIN); const float* sinks = (const float*)A.in[I_SINK];
    __syncthreads();
    for (int e = tid; e < 64 * 12; e += NTHR) { const int r = e / 12, cpair = e % 12; *(LAS unsigned*)(lds + O_VT + r * VTS + 512 + cpair * 4) = 0u; }
    for (int unit = blockIdx.x; unit < NB * 64 * 2; unit += G) {
        const int g = unit & 1, n = (unit >> 1) & 63, b = unit >> 7;
        const size_t tq0 = (size_t)b * SEQ + (size_t)n * 128;
        __syncthreads();
#pragma unroll
        for (int i = 0; i < 4; ++i) { const int item = tid + NTHR * i, row = item >> 3, ch = item & 7;
            v4u wk = {0u, 0u, 0u, 0u}, wv = {0u, 0u, 0u, 0u};
            if (n > 0 || row >= 128) { const bf16* rp = P + (tq0 - 128 + row) * NPROJ; wk = *(const GAS v4u*)(rp + C_AK + g * 64 + 8 * ch); wv = *(const GAS v4u*)(rp + C_AV + g * 64 + 8 * ch); }
            *(LAS v4u*)(lds + O_K + row * 144 + ch * 16) = wk;
            const unsigned ww[4] = {wv.x, wv.y, wv.z, wv.w};
#pragma unroll
            for (int k = 0; k < 4; ++k) { *(LAS bf16*)(lds + O_VT + (8 * ch + 2 * k) * VTS + row * 2) = (bf16)(ww[k] & 0xffffu); *(LAS bf16*)(lds + O_VT + (8 * ch + 2 * k + 1) * VTS + row * 2) = (bf16)(ww[k] >> 16); } }
        const int hq = 4 * g + (wave >> 1), qr0 = 64 * (wave & 1); const float sink = sinks[hq];
        __syncthreads();
        for (int qt = 0; qt < 4; ++qt) {
            const int i0 = qr0 + 16 * qt, st0 = i0 >> 4, iq = i0 + fr;
            const bf16* qp = P + (tq0 + iq) * NPROJ + C_AQ + hq * 64 + 8 * fq;
            const bf16x8 bq0 = *(const GAS bf16x8*)qp, bq1 = *(const GAS bf16x8*)(qp + 32);
            f32x4 sc[9]; float mx = sink;
#pragma unroll
            for (int t = 0; t < 9; ++t) { const int sb0 = 16 * (st0 + t); f32x4 acc = {0.f, 0.f, 0.f, 0.f};
                acc = MFMA16(ldfrag(lds + O_K, sb0 + fr, 16 * fq), bq0, acc); acc = MFMA16(ldfrag(lds + O_K, sb0 + fr, 64 + 16 * fq), bq1, acc);
#pragma unroll
                for (int r = 0; r < 4; ++r) { const int sb = sb0 + 4 * fq + r; const bool valid = (sb > iq) && (sb <= iq + 128) && (n > 0 || sb >= 128);
                    acc[r] = valid ? acc[r] : -3.0e38f; mx = fmaxf(mx, acc[r]); }
                sc[t] = acc; }
            mx = fmaxf(mx, __shfl_xor(mx, 16)); mx = fmaxf(mx, __shfl_xor(mx, 32));
            float lsum = 0.f;
#pragma unroll
            for (int t = 0; t < 9; ++t)
#pragma unroll
                for (int r = 0; r < 4; ++r) { const float p = (sc[t][r] > -1.0e38f) ? __expf(sc[t][r] - mx) : 0.f; sc[t][r] = p; lsum += p; }
            lsum += __shfl_xor(lsum, 16); lsum += __shfl_xor(lsum, 32); lsum += __expf(sink - mx);
            f32x4 oacc[4];
#pragma unroll
            for (int dt = 0; dt < 4; ++dt) oacc[dt] = (f32x4){0.f, 0.f, 0.f, 0.f};
#pragma unroll
            for (int ks = 0; ks < 5; ++ks) {
                union { bf16x8 v; unsigned u[4]; } pb;
                pb.u[0] = cvtpk(sc[2 * ks][0], sc[2 * ks][1]); pb.u[1] = cvtpk(sc[2 * ks][2], sc[2 * ks][3]);
                if (ks < 4) { pb.u[2] = cvtpk(sc[2 * ks + 1][0], sc[2 * ks + 1][1]); pb.u[3] = cvtpk(sc[2 * ks + 1][2], sc[2 * ks + 1][3]); } else { pb.u[2] = 0u; pb.u[3] = 0u; }
                const int sbb = 16 * (st0 + 2 * ks) + 4 * fq;
#pragma unroll
                for (int dt = 0; dt < 4; ++dt) { LAS const unsigned char* vp = lds + O_VT + (16 * dt + fr) * VTS + sbb * 2;
                    union { bf16x8 v; v2u h[2]; } va; va.h[0] = *(LAS const v2u*)vp; va.h[1] = *(LAS const v2u*)(vp + 32);
                    oacc[dt] = MFMA16(va.v, pb.v, oacc[dt]); } }
            const float il = 1.0f / lsum;
#pragma unroll
            for (int dt = 0; dt < 4; ++dt) { v2u w; w.x = pk2(oacc[dt][0] * il, oacc[dt][1] * il); w.y = pk2(oacc[dt][2] * il, oacc[dt][3] * il);
                *(GAS v2u*)(MI + (tq0 + iq) * D + hq * 64 + 16 * dt + 4 * fq) = w; }
        }
    }
}
typedef float f32x16 __attribute__((ext_vector_type(16)));
__device__ __forceinline__ unsigned fbits(float f) { return __builtin_bit_cast(unsigned, f); }
__device__ __forceinline__ float bfloat(unsigned u) { return __builtin_bit_cast(float, u); }

#define CE_DESC(a, b) do { const float _mx = __builtin_fmaxf(a, b), _mn = __builtin_fminf(a, b); a = _mx; b = _mn; } while (0)
__device__ __forceinline__ void bsort16(float (&v)[16]) {
#pragma unroll
    for (int k = 2; k <= 16; k <<= 1)
#pragma unroll
        for (int j = k >> 1; j > 0; j >>= 1)
#pragma unroll
            for (int i = 0; i < 16; ++i) { const int l = i ^ j; if (l > i) { if ((i & k) == 0) CE_DESC(v[i], v[l]); else CE_DESC(v[l], v[i]); } }
}
__device__ __forceinline__ void bmerge16(float (&v)[16], const float (&w)[16]) {
#pragma unroll
    for (int i = 0; i < 16; ++i) v[i] = __builtin_fmaxf(v[i], w[15 - i]);
#pragma unroll
    for (int j = 8; j > 0; j >>= 1)
#pragma unroll
        for (int i = 0; i < 16; ++i) { const int l = i ^ j; if (l > i) CE_DESC(v[i], v[l]); }
}
namespace tk {
constexpr int KS = 272;
constexpr int O_K1 = 0, O_K2 = 128 * KS, O_X = 2 * 128 * KS, O_END = O_X + 8 * 4096;
static_assert(O_END <= 131072, "topk LDS");
constexpr unsigned char CAND[64] = {
    0x00, 0x01, 0x02, 0x03, 0x04, 0x05, 0x06, 0x07, 0x08, 0x09, 0x0a, 0x0b, 0x0c, 0x0d, 0x0e, 0x0f,
    0x10, 0x11, 0x12, 0x13, 0x14, 0x15, 0x16, 0x17, 0x80, 0x90, 0xa0, 0xb0, 0xc0, 0xd0, 0xe0, 0xf0,
    0x20, 0x21, 0x22, 0x23, 0x24, 0x30, 0x31, 0x32, 0x33, 0x40, 0x41, 0x42, 0x50, 0x51, 0x60, 0x61,
    0x70, 0x71, 0xff, 0xff, 0xff, 0xff, 0xff, 0xff, 0xff, 0xff, 0xff, 0xff, 0xff, 0xff, 0xff, 0xff};
}
__device__ __forceinline__ void side_top16(const f32x16 (&acc)[4], int hh, float (&T)[16]) {
    float g1[16], g2[16];
#pragma unroll
    for (int r = 0; r < 16; ++r) { const unsigned key = (r & 3) + 8 * (r >> 2) + 4 * hh;
        T[r] = bfloat((fbits(acc[0][r]) & 0xffffff80u) | key);
        g1[r] = bfloat((fbits(acc[1][r]) & 0xffffff80u) | (32u + key)); }
    bsort16(T); bsort16(g1); bmerge16(T, g1);
#pragma unroll
    for (int r = 0; r < 16; ++r) { const unsigned key = (r & 3) + 8 * (r >> 2) + 4 * hh;
        g1[r] = bfloat((fbits(acc[2][r]) & 0xffffff80u) | (64u + key));
        g2[r] = bfloat((fbits(acc[3][r]) & 0xffffff80u) | (96u + key)); }
    bsort16(g1); bsort16(g2); bmerge16(g1, g2); bmerge16(T, g1);
#pragma unroll
    for (int r = 0; r < 16; ++r) g1[r] = __shfl_xor(T[r], 32);
    bmerge16(T, g1);
}
template <int SD> __device__ __forceinline__ void topk_side(const bf16* Q, LAS unsigned char* lds, int t, int h, int r32, int hh, float (&T)[16]) {
    using namespace tk;
    f32x16 acc[4];
#pragma unroll
    for (int mt = 0; mt < 4; ++mt)
#pragma unroll
        for (int r = 0; r < 16; ++r) acc[mt][r] = 0.f;
    const bf16* qp = Q + (size_t)t * 2048 + h * 256 + SD * 128 + 8 * hh; LAS const unsigned char* kimg = lds + (SD ? O_K2 : O_K1);
#pragma unroll
    for (int ks = 0; ks < 8; ++ks) { const bf16x8 bq = *(const GAS bf16x8*)(qp + 16 * ks);
#pragma unroll
        for (int mt = 0; mt < 4; ++mt) acc[mt] = __builtin_amdgcn_mfma_f32_32x32x16_bf16(*(LAS const bf16x8*)(kimg + (32 * mt + r32) * KS + 32 * ks + 16 * hh), bq, acc[mt], 0, 0, 0); }
    side_top16(acc, hh, T);
}
template <int Q> __device__ __forceinline__ float cand_val(const float (&T1)[16], const float (&T2)[16], int hh) {
    constexpr unsigned c0 = tk::CAND[2 * Q], c1 = tk::CAND[2 * Q + 1];
    const float s = (hh ? T1[(c1 >> 4) & 15] : T1[(c0 >> 4) & 15]) + (hh ? T2[c1 & 15] : T2[c0 & 15]); const unsigned code = hh ? c1 : c0;
    return (code == 0xffu) ? -3.0e38f : bfloat((fbits(s) & 0xffffff00u) | code);
}
__device__ __forceinline__ void phase_topk(const Args& A, LAS unsigned char* lds) {
    using namespace tk;
    const int tid = threadIdx.x, lane = tid & 63, wave = __builtin_amdgcn_readfirstlane(tid >> 6), G = gridDim.x;
    const bf16* Q = (const bf16*)(A.ws + WS_PROJ); const bf16* KB = (const bf16*)(A.ws + WS_KEYS);
    unsigned short* EI = (unsigned short*)(A.ws + WS_EIDX); float* GT = (float*)(A.ws + WS_GATE);
    const int h = blockIdx.x & 7, r32 = lane & 31, hh = lane >> 5;
    __syncthreads();
    for (int e = tid; e < 2 * 128 * 16; e += NTHR) { const int s = e >> 11, row = (e >> 4) & 127, ch = e & 15;
        *(LAS v4u*)(lds + (s ? O_K2 : O_K1) + row * KS + ch * 16) = *(const GAS v4u*)(KB + (size_t)s * 8 * 128 * 128 + ((size_t)h * 128 + row) * 128 + ch * 8); }
    __syncthreads();
    LAS float* XW = (LAS float*)(lds + O_X + wave * 4096) + r32 * 32;
    for (int tile = (int)(blockIdx.x >> 3); tile < M / 256; tile += (G >> 3)) {
        const int t = tile * 256 + 32 * wave + r32;
        float T1[16], T2[16];
        topk_side<0>(Q, lds, t, h, r32, hh, T1);
        topk_side<1>(Q, lds, t, h, r32, hh, T2);
        float c[16], w[16];
        c[0] = cand_val<0>(T1, T2, hh); w[0] = cand_val<16>(T1, T2, hh);
        c[1] = cand_val<1>(T1, T2, hh); w[1] = cand_val<17>(T1, T2, hh);
        c[2] = cand_val<2>(T1, T2, hh); w[2] = cand_val<18>(T1, T2, hh);
        c[3] = cand_val<3>(T1, T2, hh); w[3] = cand_val<19>(T1, T2, hh);
        c[4] = cand_val<4>(T1, T2, hh); w[4] = cand_val<20>(T1, T2, hh);
        c[5] = cand_val<5>(T1, T2, hh); w[5] = cand_val<21>(T1, T2, hh);
        c[6] = cand_val<6>(T1, T2, hh); w[6] = cand_val<22>(T1, T2, hh);
        c[7] = cand_val<7>(T1, T2, hh); w[7] = cand_val<23>(T1, T2, hh);
        c[8] = cand_val<8>(T1, T2, hh); w[8] = cand_val<24>(T1, T2, hh);
        c[9] = cand_val<9>(T1, T2, hh); w[9] = cand_val<25>(T1, T2, hh);
        c[10] = cand_val<10>(T1, T2, hh); w[10] = cand_val<26>(T1, T2, hh);
        c[11] = cand_val<11>(T1, T2, hh); w[11] = cand_val<27>(T1, T2, hh);
        c[12] = cand_val<12>(T1, T2, hh); w[12] = cand_val<28>(T1, T2, hh);
        c[13] = cand_val<13>(T1, T2, hh); w[13] = cand_val<29>(T1, T2, hh);
        c[14] = cand_val<14>(T1, T2, hh); w[14] = cand_val<30>(T1, T2, hh);
        c[15] = cand_val<15>(T1, T2, hh); w[15] = cand_val<31>(T1, T2, hh);
        bsort16(c); bsort16(w); bmerge16(c, w);
#pragma unroll
        for (int r = 0; r < 16; ++r) w[r] = __shfl_xor(c[r], 32);
        bmerge16(c, w);
        if (hh == 0) {
#pragma unroll
            for (int q4 = 0; q4 < 4; ++q4) { *(LAS f32x4*)(XW + 4 * q4) = (f32x4){T1[4 * q4], T1[4 * q4 + 1], T1[4 * q4 + 2], T1[4 * q4 + 3]};
                *(LAS f32x4*)(XW + 16 + 4 * q4) = (f32x4){T2[4 * q4], T2[4 * q4 + 1], T2[4 * q4 + 2], T2[4 * q4 + 3]}; } }
        asm volatile("s_waitcnt lgkmcnt(0)" ::: "memory");
        float ex[16], sum = 0.f; const float tmax = bfloat(fbits(c[0]) & 0xffffff00u);
#pragma unroll
        for (int r = 0; r < 16; ++r) { ex[r] = __expf(bfloat(fbits(c[r]) & 0xffffff00u) - tmax); sum += ex[r]; }
        const float isum = 1.0f / sum; const size_t ob = (size_t)t * NSLOT + (size_t)(8 * hh) * 8 + h;
#pragma unroll
        for (int r = 0; r < 8; ++r) { float ca = c[r], cb = c[8 + r], ea = ex[r], eb = ex[8 + r]; asm volatile("" : "+v"(ca), "+v"(cb), "+v"(ea), "+v"(eb)); const float cv = hh ? cb : ca, ev = hh ? eb : ea;
            const unsigned code = fbits(cv) & 0xffu;
            const unsigned i1 = fbits(XW[code >> 4]) & 127u, i2 = fbits(XW[16 + (code & 15)]) & 127u;
            EI[ob + 8 * r] = (unsigned short)(i1 * 128u + i2); GT[ob + 8 * r] = ev * isum; }
        asm volatile("s_waitcnt lgkmcnt(0)" ::: "memory");
    }
}
struct PeerIdx { v4u e0, e1; };
__device__ __forceinline__ PeerIdx peer_ld_idx(const unsigned short* EI, int t, int g) { PeerIdx r; r.e0 = *(const GAS v4u*)(EI + (size_t)t * NSLOT + 16 * g); r.e1 = *(const GAS v4u*)(EI + (size_t)t * NSLOT + 16 * g + 8); return r; }
template <int ROWB = 1024> __device__ __forceinline__ void peer_gather(const unsigned char* T8, const PeerIdx& ix, int colb, v4u (&raw)[16]) {
    const unsigned ew[8] = {ix.e0.x, ix.e0.y, ix.e0.z, ix.e0.w, ix.e1.x, ix.e1.y, ix.e1.z, ix.e1.w};
#pragma unroll
    for (int k = 0; k < 16; ++k) { const unsigned e = (k & 1) ? (ew[k >> 1] >> 16) : (ew[k >> 1] & 0xffffu); raw[k] = *(const GAS v4u*)(T8 + (size_t)e * ROWB + colb); }
}
__device__ __forceinline__ void cvt16_fp8_pk(const v4u w, f32x2 (&o)[8]) {
    const unsigned ww[4] = {w.x, w.y, w.z, w.w};
#pragma unroll
    for (int i = 0; i < 4; ++i) { o[2 * i] = __builtin_amdgcn_cvt_pk_f32_fp8((int)ww[i], false); o[2 * i + 1] = __builtin_amdgcn_cvt_pk_f32_fp8((int)ww[i], true); }
}
__device__ __forceinline__ void peer_u_reduce(const v4u (&raw)[16], const f32x2 (&hv)[8], float* PDrow, int lane, int g, int c) {
    float d[16];
#pragma unroll
    for (int k = 0; k < 16; ++k) { f32x2 uf[8]; cvt16_fp8_pk(raw[k], uf); f32x2 s = uf[0] * hv[0];
#pragma unroll
        for (int i = 1; i < 8; ++i) s += uf[i] * hv[i];
        d[k] = s.x + s.y; }
#pragma unroll
    for (int i = 0; i < 8; ++i) { const bool up = (lane & 4) != 0; const float keep = up ? d[i + 8] : d[i], send = up ? d[i] : d[i + 8]; d[i] = keep + __shfl_xor(send, 4); }
#pragma unroll
    for (int i = 0; i < 4; ++i) { const bool up = (lane & 2) != 0; const float keep = up ? d[i + 4] : d[i], send = up ? d[i] : d[i + 4]; d[i] = keep + __shfl_xor(send, 2); }
#pragma unroll
    for (int i = 0; i < 2; ++i) { const bool up = (lane & 1) != 0; const float keep = up ? d[i + 2] : d[i], send = up ? d[i] : d[i + 2]; d[i] = keep + __shfl_xor(send, 1); }
    *(GAS f32x2*)(PDrow + 16 * g + 2 * c) = (f32x2){d[0], d[1]};
}
__device__ __forceinline__ void ld16bf_pk(const bf16* p, f32x2 (&o)[8]) {
    const v4u w0 = *(const GAS v4u*)p, w1 = *(const GAS v4u*)(p + 8); const unsigned ww[8] = {w0.x, w0.y, w0.z, w0.w, w1.x, w1.y, w1.z, w1.w};
#pragma unroll
    for (int i = 0; i < 8; ++i) o[i] = (f32x2){bflo(ww[i]), bfhi(ww[i])};
}
__device__ __forceinline__ void peer_u_reduce_i4(const v4u (&raw)[16], const v4u hh, const v4u hl, int* PDrow, int lane, int g, int c) {
    int d[16];
#pragma unroll
    for (int k = 0; k < 16; ++k) { int sh = __builtin_amdgcn_sdot8((int)raw[k].x, (int)hh.x, 0, false), sl = __builtin_amdgcn_sdot8((int)raw[k].x, (int)hl.x, 0, false);
        sh = __builtin_amdgcn_sdot8((int)raw[k].y, (int)hh.y, sh, false); sl = __builtin_amdgcn_sdot8((int)raw[k].y, (int)hl.y, sl, false);
        sh = __builtin_amdgcn_sdot8((int)raw[k].z, (int)hh.z, sh, false); sl = __builtin_amdgcn_sdot8((int)raw[k].z, (int)hl.z, sl, false);
        sh = __builtin_amdgcn_sdot8((int)raw[k].w, (int)hh.w, sh, false); sl = __builtin_amdgcn_sdot8((int)raw[k].w, (int)hl.w, sl, false);
        d[k] = 16 * sh + sl; }
#pragma unroll
    for (int i = 0; i < 8; ++i) { const bool up = (lane & 4) != 0; const int keep = up ? d[i + 8] : d[i], send = up ? d[i] : d[i + 8]; d[i] = keep + __shfl_xor(send, 4); }
#pragma unroll
    for (int i = 0; i < 4; ++i) { const bool up = (lane & 2) != 0; const int keep = up ? d[i + 4] : d[i], send = up ? d[i] : d[i + 4]; d[i] = keep + __shfl_xor(send, 2); }
#pragma unroll
    for (int i = 0; i < 2; ++i) { const bool up = (lane & 1) != 0; const int keep = up ? d[i + 2] : d[i], send = up ? d[i] : d[i + 2]; d[i] = keep + __shfl_xor(send, 1); }
    *(GAS v2u*)(PDrow + 16 * g + 2 * c) = (v2u){(unsigned)d[0], (unsigned)d[1]};
}
__device__ __forceinline__ void phase_peer_u(const Args& A) {
    const int tid = threadIdx.x, lane = tid & 63, wave = tid >> 6, p = blockIdx.x & 7, q = p & 3, half = p >> 2, j = blockIdx.x >> 3, nj = gridDim.x >> 3, g = lane >> 3, c = lane & 7;
    const unsigned char* HH = (const unsigned char*)(A.ws + WS_H8); const unsigned char* HL = HH + 32 * MiB; const unsigned char* U4 = (const unsigned char*)(A.ws + WS_U8); const unsigned short* EI = (const unsigned short*)(A.ws + WS_EIDX);
    int* PD = (int*)(A.ws + WS_PD) + (size_t)q * M * NSLOT;
    const int tper = (M / 2) / nj, colb = 128 * q + 16 * c, tbeg = half * (M / 2) + j * tper, tend = tbeg + tper, tlast = tend - NWAVES + wave;
    int t = tbeg + wave;
    PeerIdx ix1 = peer_ld_idx(EI, min(t + NWAVES, tlast), g), ix2 = peer_ld_idx(EI, min(t + 2 * NWAVES, tlast), g);
    v4u rawa[16], rawb[16], hha, hla, hhb, hlb;
    { const PeerIdx ix0 = peer_ld_idx(EI, t, g); peer_gather<512>(U4, ix0, colb, rawa); hha = *(const GAS v4u*)(HH + (size_t)t * 512 + colb); hla = *(const GAS v4u*)(HL + (size_t)t * 512 + colb); }
    for (; t < tend; t += 2 * NWAVES) {
        const int t1 = t + NWAVES, t2 = min(t + 2 * NWAVES, tlast), t3 = min(t + 3 * NWAVES, tlast), t4 = min(t + 4 * NWAVES, tlast);
        const PeerIdx ix3 = peer_ld_idx(EI, t3, g);
        peer_gather<512>(U4, ix1, colb, rawb); hhb = *(const GAS v4u*)(HH + (size_t)t1 * 512 + colb); hlb = *(const GAS v4u*)(HL + (size_t)t1 * 512 + colb);
        peer_u_reduce_i4(rawa, hha, hla, PD + (size_t)t * NSLOT, lane, g, c);
        const PeerIdx ix4 = peer_ld_idx(EI, t4, g);
        peer_gather<512>(U4, ix2, colb, rawa); hha = *(const GAS v4u*)(HH + (size_t)t2 * 512 + colb); hla = *(const GAS v4u*)(HL + (size_t)t2 * 512 + colb);
        peer_u_reduce_i4(rawb, hhb, hlb, PD + (size_t)t1 * NSLOT, lane, g, c);
        ix1 = ix3; ix2 = ix4;
    }
}
__device__ __forceinline__ void phase_peer_act(const Args& A) {
    const int* PD = (const int*)(A.ws + WS_PD); const unsigned short* EI = (const unsigned short*)(A.ws + WS_EIDX); const float* GT = (const float*)(A.ws + WS_GATE);
    const float* usc = (const float*)(A.ws + WS_SC); const float* vsc = usc + NEXP; const float* hs = (const float*)(A.ws + WS_HS); float* ACT = (float*)(A.ws + WS_ACT);
    for (size_t i = (size_t)blockIdx.x * NTHR + threadIdx.x; i < (size_t)M * NSLOT; i += (size_t)gridDim.x * NTHR) {
        int si = 0;
#pragma unroll
        for (int p = 0; p < 4; ++p) si += PD[(size_t)p * M * NSLOT + i];
        const unsigned e = EI[i]; float s = (float)si * (usc[e] * hs[i >> 7]);
        ACT[i] = 0.5f * s * (1.f + erff(s * 0.70710678118654752f)) * GT[i] * vsc[e];
    }
}
struct PeerAct { f32x4 a0, a1, a2, a3; };
__device__ __forceinline__ PeerAct peer_ld_act(const float* ACT, int t, int g) { const GAS f32x4* ap = (const GAS f32x4*)(ACT + (size_t)t * NSLOT + 16 * g); PeerAct r; r.a0 = ap[0]; r.a1 = ap[1]; r.a2 = ap[2]; r.a3 = ap[3]; return r; }
__device__ __forceinline__ void peer_v_reduce(const v4u (&raw)[16], const PeerAct& pa, bf16* Yrow, float* ssy, int lane, int g, int c) {
    const float av[16] = {pa.a0[0], pa.a0[1], pa.a0[2], pa.a0[3], pa.a1[0], pa.a1[1], pa.a1[2], pa.a1[3], pa.a2[0], pa.a2[1], pa.a2[2], pa.a2[3], pa.a3[0], pa.a3[1], pa.a3[2], pa.a3[3]};
    f32x2 y2[16];
#pragma unroll
    for (int i = 0; i < 16; ++i) y2[i] = (f32x2){0.f, 0.f};
#pragma unroll
    for (int k = 0; k < 16; ++k) { const unsigned ww[4] = {raw[k].x, raw[k].y, raw[k].z, raw[k].w}; const f32x2 a2 = (f32x2){av[k], av[k]};
#pragma unroll
        for (int w = 0; w < 4; ++w) { y2[4 * w + 0] += a2 * __builtin_amdgcn_cvt_scalef32_pk_f32_fp4(ww[w], 1.0f, 0); y2[4 * w + 1] += a2 * __builtin_amdgcn_cvt_scalef32_pk_f32_fp4(ww[w], 1.0f, 1);
            y2[4 * w + 2] += a2 * __builtin_amdgcn_cvt_scalef32_pk_f32_fp4(ww[w], 1.0f, 2); y2[4 * w + 3] += a2 * __builtin_amdgcn_cvt_scalef32_pk_f32_fp4(ww[w], 1.0f, 3); } }
    float y[32];
#pragma unroll
    for (int i = 0; i < 16; ++i) { y[2 * i] = y2[i].x; y[2 * i + 1] = y2[i].y; }
#pragma unroll
    for (int i = 0; i < 16; ++i) { const bool up = (lane & 32) != 0; const float keep = up ? y[i + 16] : y[i], send = up ? y[i] : y[i + 16]; y[i] = keep + __shfl_xor(send, 32); }
#pragma unroll
    for (int i = 0; i < 8; ++i) { const bool up = (lane & 16) != 0; const float keep = up ? y[i + 8] : y[i], send = up ? y[i] : y[i + 8]; y[i] = keep + __shfl_xor(send, 16); }
#pragma unroll
    for (int i = 0; i < 4; ++i) { const bool up = (lane & 8) != 0; const float keep = up ? y[i + 4] : y[i], send = up ? y[i] : y[i + 4]; y[i] = keep + __shfl_xor(send, 8); }
    *(GAS v2u*)(Yrow + 32 * c + 4 * g) = (v2u){pk2(y[0], y[1]), pk2(y[2], y[3])};
    const float ss = wave_sum((y[0] * y[0] + y[1] * y[1]) + (y[2] * y[2] + y[3] * y[3]));
    if (lane == 0) *ssy = ss;
}
__device__ __forceinline__ void phase_peer_v(const Args& A) {
    const int tid = threadIdx.x, lane = tid & 63, wave = tid >> 6, p = blockIdx.x & 7, q = p & 3, half = p >> 2, j = blockIdx.x >> 3, nj = gridDim.x >> 3, g = lane >> 3, c = lane & 7;
    const unsigned char* V4 = (const unsigned char*)(A.ws + WS_V8); const unsigned short* EI = (const unsigned short*)(A.ws + WS_EIDX); const float* ACT = (const float*)(A.ws + WS_ACT);
    bf16* Y = (bf16*)(A.ws + WS_H); float* SSY = (float*)(A.ws + WS_SSY);
    const int tper = (M / 2) / nj, colb = 128 * q + 16 * c, tbeg = half * (M / 2) + j * tper, tend = tbeg + tper, tlast = tend - NWAVES + wave;
    int t = tbeg + wave;
    PeerIdx ix1 = peer_ld_idx(EI, min(t + NWAVES, tlast), g), ix2 = peer_ld_idx(EI, min(t + 2 * NWAVES, tlast), g);
    v4u rawa[16], rawb[16]; PeerAct aca, acb;
    { const PeerIdx ix0 = peer_ld_idx(EI, t, g); peer_gather<512>(V4, ix0, colb, rawa); aca = peer_ld_act(ACT, t, g); }
    for (; t < tend; t += 2 * NWAVES) {
        const int t1 = t + NWAVES, t2 = min(t + 2 * NWAVES, tlast), t3 = min(t + 3 * NWAVES, tlast), t4 = min(t + 4 * NWAVES, tlast);
        const PeerIdx ix3 = peer_ld_idx(EI, t3, g);
        peer_gather<512>(V4, ix1, colb, rawb); acb = peer_ld_act(ACT, t1, g);
        peer_v_reduce(rawa, aca, Y + (size_t)t * D + 256 * q, SSY + (size_t)t * 8 + q, lane, g, c);
        const PeerIdx ix4 = peer_ld_idx(EI, t4, g);
        peer_gather<512>(V4, ix2, colb, rawa); aca = peer_ld_act(ACT, t2, g);
        peer_v_reduce(rawb, acb, Y + (size_t)t1 * D + 256 * q, SSY + (size_t)t1 * 8 + q, lane, g, c);
        ix1 = ix3; ix2 = ix4;
    }
}
__device__ __forceinline__ void phase_peer_final(const Args& A) {
    const int tid = threadIdx.x, lane = tid & 63, wave = tid >> 6, G = gridDim.x;
    const bf16* Y = (const bf16*)(A.ws + WS_H); const bf16* X1 = (const bf16*)(A.ws + WS_X1); const float* SSY = (const float*)(A.ws + WS_SSY); const float* mod = (const float*)(A.ws + WS_MOD); const float* gpost = (const float*)A.in[I_GPOST2]; float* out = A.out;
    for (int row = blockIdx.x * NWAVES + wave; row < M; row += G * NWAVES) {
        const int b = row / SEQ; const f32x4 s0 = *(const GAS f32x4*)(SSY + (size_t)row * 8);
        const float rstd = 1.0f / sqrtf(((s0[0] + s0[1]) + (s0[2] + s0[3])) * (1.f / D) + EPS);
        GAS f32x4* orow = (GAS f32x4*)(out + (size_t)row * D) + lane; const GAS v2u* yr = (const GAS v2u*)(Y + (size_t)row * D) + lane; const GAS v2u* xr = (const GAS v2u*)(X1 + (size_t)row * D) + lane;
#pragma unroll
        for (int q = 0; q < 4; ++q) { const int k = 4 * (lane + 64 * q); const v2u xw = xr[64 * q]; f32x4 xv = {bflo(xw.x), bfhi(xw.x), bflo(xw.y), bfhi(xw.y)}; const v2u yw = yr[64 * q];
            const f32x4 g2 = *(const GAS f32x4*)(mod + b * 6144 + 5120 + k), gp = *(const GAS f32x4*)(gpost + k);
            xv[0] += g2[0] * (bflo(yw.x) * rstd * gp[0]); xv[1] += g2[1] * (bfhi(yw.x) * rstd * gp[1]); xv[2] += g2[2] * (bflo(yw.y) * rstd * gp[2]); xv[3] += g2[3] * (bfhi(yw.y) * rstd * gp[3]);
            orow[64 * q] = xv; }
    }
}

#ifdef PROBE_V_LOADS
__device__ __forceinline__ void probe_v_loads(const Args& A) {
    const int tid = threadIdx.x, lane = tid & 63, wave = tid >> 6, p = blockIdx.x & 7, j = blockIdx.x >> 3, nj = gridDim.x >> 3, g = lane >> 3, c = lane & 7;
    const unsigned char* V8 = (const unsigned char*)(A.ws + WS_V8); const unsigned short* EI = (const unsigned short*)(A.ws + WS_EIDX); const float* ACT = (const float*)(A.ws + WS_ACT);
    unsigned* DUMP = (unsigned*)(A.ws + WS_PD);
    const int tper = M / nj, colb = 128 * p + 16 * c, tend = (j + 1) * tper, tlast = tend - NWAVES + wave;
    int t = j * tper + wave;
    PeerIdx ix1 = peer_ld_idx(EI, min(t + NWAVES, tlast), g), ix2 = peer_ld_idx(EI, min(t + 2 * NWAVES, tlast), g);
    v4u rawa[16], rawb[16]; PeerAct aca, acb;
    { const PeerIdx ix0 = peer_ld_idx(EI, t, g); peer_gather(V8, ix0, colb, rawa); aca = peer_ld_act(ACT, t, g); }
    for (; t < tend; t += 2 * NWAVES) {
        const int t1 = t + NWAVES, t2 = min(t + 2 * NWAVES, tlast), t3 = min(t + 3 * NWAVES, tlast), t4 = min(t + 4 * NWAVES, tlast);
        const PeerIdx ix3 = peer_ld_idx(EI, t3, g);
        peer_gather(V8, ix1, colb, rawb); acb = peer_ld_act(ACT, t1, g);
        { unsigned s = __builtin_bit_cast(unsigned, aca.a0[0]) + __builtin_bit_cast(unsigned, aca.a3[3]);
#pragma unroll
          for (int k = 0; k < 16; ++k) s += (rawa[k].x + rawa[k].y) + (rawa[k].z + rawa[k].w);
          DUMP[(size_t)t * 512 + p * 64 + lane] = s; }
        const PeerIdx ix4 = peer_ld_idx(EI, t4, g);
        peer_gather(V8, ix2, colb, rawa); aca = peer_ld_act(ACT, t2, g);
        { unsigned s = __builtin_bit_cast(unsigned, acb.a0[0]) + __builtin_bit_cast(unsigned, acb.a3[3]);
#pragma unroll
          for (int k = 0; k < 16; ++k) s += (rawb[k].x + rawb[k].y) + (rawb[k].z + rawb[k].w);
          DUMP[(size_t)t1 * 512 + p * 64 + lane] = s; }
        ix1 = ix3; ix2 = ix4;
    }
}
#endif

#ifdef PROBE_INSTR
__device__ __forceinline__ void probe_instr(const Args& A) {
    f32x2 a[8]; float f[16]; unsigned w = threadIdx.x * 0x01010101u + 0x38383838u;
#pragma unroll
    for (int i = 0; i < 8; ++i) a[i] = (f32x2){1.0f + i, 2.0f + i};
#pragma unroll
    for (int i = 0; i < 16; ++i) f[i] = 1.0f + i;
    for (int it = 0; it < 10000; ++it) {
#if PROBE_INSTR == 1
#pragma unroll
        for (int i = 0; i < 8; ++i) { asm volatile("v_pk_fma_f32 %0, %1, %2, %0" : "+v"(a[i]) : "v"(a[(i + 1) & 7]), "v"(a[(i + 2) & 7])); asm volatile("v_pk_fma_f32 %0, %1, %2, %0" : "+v"(a[i]) : "v"(a[(i + 3) & 7]), "v"(a[(i + 4) & 7])); }
#elif PROBE_INSTR == 2
#pragma unroll
        for (int i = 0; i < 16; ++i) asm volatile("v_fma_f32 %0, %1, %2, %0" : "+v"(f[i]) : "v"(f[(i + 1) & 15]), "v"(f[(i + 2) & 15]));
#elif PROBE_INSTR == 3
#pragma unroll
        for (int i = 0; i < 8; ++i) { asm volatile("v_cvt_pk_f32_fp8 %0, %1" : "=v"(a[i]) : "v"(w)); asm volatile("v_cvt_pk_f32_fp8 %0, %1" : "=v"(a[i]) : "v"(w)); }
#elif PROBE_INSTR == 4
#pragma unroll
        for (int i = 0; i < 8; ++i) { asm volatile("v_cvt_scalef32_pk_f32_fp4 %0, %1, 1.0" : "=v"(a[i]) : "v"(w)); asm volatile("v_cvt_scalef32_pk_f32_fp4 %0, %1, 1.0" : "=v"(a[i]) : "v"(w)); }
#elif PROBE_INSTR == 5
#pragma unroll
        for (int i = 0; i < 16; ++i) asm volatile("v_pk_fma_f16 %0, %1, %2, %0" : "+v"(f[i]) : "v"(f[(i + 1) & 15]), "v"(f[(i + 2) & 15]));
#elif PROBE_INSTR == 7
#pragma unroll
        for (int i = 0; i < 16; ++i) asm volatile("v_dot8c_i32_i4 %0, %1, %2" : "+v"(f[i]) : "v"(f[(i + 1) & 15]), "v"(w));
#elif PROBE_INSTR == 8
#pragma unroll
        for (int i = 0; i < 16; ++i) asm volatile("v_dot4c_i32_i8 %0, %1, %2" : "+v"(f[i]) : "v"(f[(i + 1) & 15]), "v"(w));
#elif PROBE_INSTR == 9
#pragma unroll
        for (int i = 0; i < 16; ++i) asm volatile("v_perm_b32 %0, %1, %2, %3" : "=v"(f[i]) : "v"(f[(i + 1) & 15]), "v"(f[(i + 2) & 15]), "v"(w));
#elif PROBE_INSTR == 10
#pragma unroll
        for (int i = 0; i < 16; ++i) asm volatile("v_mfma_f32_16x16x32_fp8_fp8 %0, %1, %2, %0" : "+v"(*(f32x4*)&f[4 * (i & 3)]) : "v"(a[i & 7]), "v"(a[(i + 1) & 7]));
#elif PROBE_INSTR == 6
#pragma unroll
        for (int i = 0; i < 16; ++i) asm volatile("v_cvt_scalef32_pk_f16_fp4 %0, %1, 1.0" : "=v"(f[i]) : "v"(w));
#endif
    }
    float s = 0.f;
#pragma unroll
    for (int i = 0; i < 8; ++i) s += a[i].x + a[i].y;
#pragma unroll
    for (int i = 0; i < 16; ++i) s += f[i];
    if (s == 123.456f) ((float*)(A.ws + WS_PD))[threadIdx.x] = s;
}
#endif
#ifndef MK_N_LAUNCHES
#define MK_N_LAUNCHES 1
#endif
constexpr int N_PHASES = 13;
typedef const __attribute__((address_space(4))) Args* KArgP;
__device__ __forceinline__ const Args& kargs() { KArgP p = (KArgP)__builtin_amdgcn_kernarg_segment_ptr(); asm volatile("" : "+s"(p)); return *(const Args*)p; }
__global__ void __launch_bounds__(NTHR, 2) hymba_fwd(Args A_) {
    extern __shared__ __attribute__((aligned(16))) unsigned char lds_raw[];
    LAS unsigned char* lds = (LAS unsigned char*)lds_raw;
    const int lo = A_.ph_lo, hi = A_.ph_hi;
#define A kargs()
#define ws (kargs().ws)
#ifndef DBLMASK
#define DBLMASK 0
#endif
#define IN(k) (lo <= (k) && (k) < hi)
#define REP(k) for (int _rep = 0; _rep < (((DBLMASK) >> (k)) & 1) + 1; ++_rep)
    for (int u = threadIdx.x; u < (LDS_BYTES - RING_BYTES) / 4; u += NTHR) ((LAS unsigned*)(lds + RING_BYTES))[u] = 0u;
    __syncthreads();
    XcdBarrier xbar = xcd_barrier_post((unsigned*)(ws + WS_CTL) + CW_BAR, (volatile LAS unsigned*)(lds + MISC_OFF + 32));
#define SEAM(k) do { if (IN(k) && IN((k) + 1)) { if ((k) == 0) cg::this_grid().sync(); else xcd_barrier(xbar); } } while (0)

    if (IN(0)) REP(0) { phase_mod(A, lds); } SEAM(0);
    if (IN(1)) REP(1) { phase_convert(A, lds); phase_prenorm(A); } SEAM(1);
    if (IN(2)) REP(2) {
        pg8::Gemm g{(const pg8::bf16_t*)(ws + WS_H), (const pg8::bf16_t*)(ws + WS_WIN), M, NIN_PAD, D}; pg8::StaticOrder S; S.init(M, NIN_PAD, gridDim.x, (int)blockIdx.x);
        pg8::EpiProj E{(pg8::bf16_t*)(ws + WS_PROJ), NPROJ, (float*)(ws + WS_GATES), (const int*)A.in[I_POS], (const float*)A.in[I_BI], (const float*)A.in[I_BF]};
        pg8::gemm_phase<pg8::EpiProj, pg8::StaticOrder, true, true>(lds, g, S, E);
    } SEAM(2);
    if (IN(3)) REP(3) {
        phase_attn(A, lds);
        for (int wg = blockIdx.x; wg < 256; wg += gridDim.x) mlstm_group<false>(A, lds, wg);
    } SEAM(3);
    if (IN(4)) REP(4) { for (int wg = blockIdx.x; wg < 256; wg += gridDim.x) mlstm_group<true>(A, lds, wg); } SEAM(4);
    if (IN(5)) REP(5) {
        pg8::Gemm g{(const pg8::bf16_t*)(ws + WS_MIXIN), (const pg8::bf16_t*)(ws + WS_WOUT), M, D, D}; pg8::StaticOrder S; S.init(M, D, gridDim.x, (int)blockIdx.x);
        pg8::EpiMix E{(pg8::bf16_t*)(ws + WS_MIX), D, (float*)(ws + WS_SSQ)};
        pg8::gemm_phase<pg8::EpiMix, pg8::StaticOrder, true, true>(lds, g, S, E);
    } SEAM(5);
    if (IN(6)) REP(6) { phase_mid(A); } SEAM(6);
    if (IN(7)) REP(7) {
        pg8::Gemm g{(const pg8::bf16_t*)(ws + WS_H), (const pg8::bf16_t*)(ws + WS_WQ), M, 2048, D}; pg8::StaticOrder S; S.init(M, 2048, gridDim.x, (int)blockIdx.x);
        pg8::EpiPlain E{(pg8::bf16_t*)(ws + WS_PROJ), 2048};
        pg8::gemm_phase<pg8::EpiPlain, pg8::StaticOrder, true, true>(lds, g, S, E);
    } SEAM(7);
    if (IN(8)) REP(8) { phase_topk(A, lds); } SEAM(8);
    if (IN(9)) REP(9) { phase_peer_u(A); } SEAM(9);
    if (IN(10)) REP(10) { phase_peer_act(A); } SEAM(10);
#ifdef PROBE_INSTR
    if (IN(11)) { probe_instr(A); }
#endif
#ifdef PROBE_V_LOADS
    if (IN(11)) { probe_v_loads(A); }
#endif
    if (IN(11)) REP(11) { phase_peer_v(A); } SEAM(11);
    if (IN(12)) REP(12) { phase_peer_final(A); }
#undef IN
#undef SEAM
#undef A
#undef ws
}

extern "C" void kernel_launch(void* const* d_in, const int* in_sizes, int n_in, void* d_out, int out_size, void* d_ws, size_t ws_size, hipStream_t stream) {
    static int grid = 0;
    if (grid == 0) {
        if (n_in != 21 || in_sizes[0] != M * D || out_size != M * D || ws_size < WS_END) { fprintf(stderr, "kernel_launch: unexpected shapes (n_in %d, in0 %d, out %d, ws %zu < %zu)\n", n_in, n_in > 0 ? in_sizes[0] : -1, out_size, ws_size, (size_t)WS_END); grid = -1; return; }
        int dev = 0, cus = 0, per_cu = 0;
        if (hipGetDevice(&dev) != hipSuccess || hipDeviceGetAttribute(&cus, hipDeviceAttributeMultiprocessorCount, dev) != hipSuccess) { grid = -1; return; }
        if (hipFuncSetAttribute((const void*)hymba_fwd, hipFuncAttributeMaxDynamicSharedMemorySize, LDS_BYTES) != hipSuccess) { fprintf(stderr, "kernel_launch: hipFuncSetAttribute failed\n"); grid = -1; return; }
        if (hipOccupancyMaxActiveBlocksPerMultiprocessor(&per_cu, (const void*)hymba_fwd, NTHR, LDS_BYTES) != hipSuccess || per_cu < 1) { fprintf(stderr, "kernel_launch: occupancy query says %d blocks per CU\n", per_cu); per_cu = 1; }
        (void)hipGetLastError();
        grid = cus;
        if (grid != 256) fprintf(stderr, "kernel_launch: note: %d CUs (built for 256)\n", grid);
    }
    if (grid < 0) return;
    (void)hipMemsetAsync((char*)d_ws + WS_CTL, 0, CTL_ZERO_BYTES, stream);
    Args a{};
    for (int i = 0; i < 21; ++i) a.in[i] = d_in[i];
    a.out = (float*)d_out; a.ws = (unsigned char*)d_ws;
    if (MK_N_LAUNCHES == 1) {
        a.ph_lo = 0; a.ph_hi = N_PHASES;
        void* args[] = {&a};
        const hipError_t e = hipLaunchCooperativeKernel((const void*)hymba_fwd, dim3(grid), dim3(NTHR), args, LDS_BYTES, stream);
        if (e != hipSuccess) fprintf(stderr, "kernel_launch: cooperative launch failed: %s (grid %d)\n", hipGetErrorString(e), grid);
    } else {
        for (int p = 0; p < N_PHASES; ++p) { a.ph_lo = p; a.ph_hi = p + 1; hipLaunchKernelGGL(hymba_fwd, dim3(grid), dim3(NTHR), LDS_BYTES, stream, a); }
    }
}
```

```cpp
#include <hip/hip_runtime.h>
#include <hip/hip_cooperative_groups.h>
#include <cstdio>
#include <cstdint>
namespace cg = cooperative_groups;
namespace pg8 {
#define PG8_LAS __attribute__((address_space(3)))
typedef unsigned short bf16_t;
typedef short bf16x8 __attribute__((ext_vector_type(8)));
typedef float f32x4 __attribute__((ext_vector_type(4)));
typedef unsigned u32x4 __attribute__((ext_vector_type(4)));
constexpr int BM = 256, BK = 64, HALF = 128, HTB = HALF * BK * 2  , STAGE_BYTES = 8 * HTB, NXCD = 8, WGM = 8;

__host__ __device__ __forceinline__ int lds_byte(int r, int c) { const int st = (r >> 4) * 2 + (c >> 5), rr = r & 15, cc = c & 31, ob = rr * 64 + cc * 2; return st * 1024 + (ob ^ (((ob >> 9) & 1) << 5)); }
__host__ __device__ __forceinline__ void stage_rc(int b, int& R, int& C) { const int st = b / 1024, sb = b % 1024, swz = sb ^ (((sb >> 9) & 1) << 5); R = (st >> 1) * 16 + swz / 64; C = (st & 1) * 32 + (swz % 64) / 2; }
__host__ __device__ __forceinline__ int perm32(int rho) { const int n = rho >> 4, i = rho & 15; return 8 * (i >> 2) + 4 * n + (i & 3); }

struct Unit { int pm, pn; };
struct Gemm { const bf16_t* A; const bf16_t* Bt; int M, N, K; };

struct StaticOrder {
    int nM, nN, nwg, G, c;
    __host__ __device__ void init(int M, int N, int G_, int c_) { nM = M / BM; nN = N / BM; nwg = nM * nN; G = G_; c = c_; }
    __host__ __device__ bool next(int i, Unit& u) const {
        const long L = (long)i * G + c; if (L >= nwg) return false;
        int wgid = (int)L; { const int q = nwg / NXCD, r = nwg % NXCD, xcd = wgid % NXCD, off = wgid / NXCD; wgid = (xcd < r ? xcd * (q + 1) : r * (q + 1) + (xcd - r) * q) + off; }
        const int nig = WGM * nN, gid = wgid / nig, fm = gid * WGM, gsz = (nM - fm) < WGM ? (nM - fm) : WGM;
        u.pm = fm + ((wgid % nig) % gsz); u.pn = (wgid % nig) / gsz; return true;
    }
    __device__ __forceinline__ void a_ready(const Unit&) const {}
    __device__ __forceinline__ void done(const Unit&) const {}
};

__device__ __forceinline__ unsigned cvt_pk_bf16(float lo, float hi) { unsigned r; asm volatile("v_cvt_pk_bf16_f32 %0, %1, %2" : "=v"(r) : "v"(lo), "v"(hi)); return r; }
typedef float f32x2 __attribute__((ext_vector_type(2)));
__device__ __forceinline__ f32x2 gelu_pk(f32x2 v) {
    const f32x2 av = __builtin_elementwise_abs(v), d = av * 0.2316418882f + 1.0f;
    f32x2 t; t.x = __builtin_amdgcn_rcpf(d.x); t.y = __builtin_amdgcn_rcpf(d.y);
    f32x2 q = t * 0.5307027145f + (-0.7265760135f); q = q * t + 0.7107068705f; q = q * t + (-0.142248368f); q = q * t + 0.127414796f; q = q * t;
    const f32x2 s = (v * v) * (-0.72134752044f);
    f32x2 e; e.x = __builtin_amdgcn_exp2f(s.x); e.y = __builtin_amdgcn_exp2f(s.y);
    const f32x2 m = v * (q * e), r = v - m;
    f32x2 o; o.x = v.x < 0.f ? m.x : r.x; o.y = v.y < 0.f ? m.y : r.y; return o;
}

__device__ __forceinline__ u32x4 pack8(const f32x4 v0, const f32x4 v1) { u32x4 w; w.x = cvt_pk_bf16(v0[0], v0[1]); w.y = cvt_pk_bf16(v0[2], v0[3]); w.z = cvt_pk_bf16(v1[0], v1[1]); w.w = cvt_pk_bf16(v1[2], v1[3]); return w; }

struct EpiPlain {
    static constexpr bool PERM = true, AFTER_DRAIN = false;
    bf16_t* O; int ldc;
    __device__ __forceinline__ void operator()(const f32x4 (&acc)[2][2][4][2], const Unit& u, int wr, int wc, int fr, int fq) const {
        const int row0 = u.pm * BM + wr * 64 + fr, col0 = u.pn * BM + wc * 32 + 8 * fq;
#pragma unroll
        for (int ai = 0; ai < 2; ++ai)
#pragma unroll
            for (int m = 0; m < 4; ++m) { bf16_t* rowp = O + (size_t)(row0 + ai * HALF + m * 16) * ldc + col0;
#pragma unroll
                for (int bj = 0; bj < 2; ++bj) *(u32x4*)(rowp + bj * HALF) = pack8(acc[ai][bj][m][0], acc[ai][bj][m][1]); }
    }
};

struct EpiProj {
    static constexpr bool PERM = true, AFTER_DRAIN = false;
    bf16_t* P; int ldc; float* gates; const int* pos; const float* b_i; const float* b_f;
    __device__ __forceinline__ void operator()(const f32x4 (&acc)[2][2][4][2], const Unit& u, int wr, int wc, int fr, int fq) const {
        const int row0 = u.pm * BM + wr * 64 + fr, col0 = u.pn * BM + wc * 32 + 8 * fq, pn = u.pn;
        if (pn == 9) {
            if (wc == 0 && fq == 0) {
                const f32x4 bi = {b_i[0], b_i[1], b_i[2], b_i[3]}, bf = {b_f[0], b_f[1], b_f[2], b_f[3]};
#pragma unroll
                for (int ai = 0; ai < 2; ++ai)
#pragma unroll
                    for (int m = 0; m < 4; ++m) { const int row = row0 + ai * HALF + m * 16;
                        const f32x4 iv = acc[ai][0][m][0] + bi, fv = acc[ai][0][m][1] + bf; f32x4 lf;
#pragma unroll
                        for (int j = 0; j < 4; ++j) lf[j] = fminf(fv[j], 0.f) - log1pf(__expf(-fabsf(fv[j])));
                        *(f32x4*)(gates + (size_t)row * 8) = iv; *(f32x4*)(gates + (size_t)row * 8 + 4) = lf; }
            }
            return;
        }
#pragma unroll
        for (int ai = 0; ai < 2; ++ai)
#pragma unroll
            for (int m = 0; m < 4; ++m) { const int row = row0 + ai * HALF + m * 16; bf16_t* rowp = P + (size_t)row * ldc + col0;
                const float posf = (pn <= 2) ? (float)pos[row] : 0.f;
#pragma unroll
                for (int bj = 0; bj < 2; ++bj) { f32x4 v0 = acc[ai][bj][m][0], v1 = acc[ai][bj][m][1];
                    const bool rope = (pn < 2) || (pn == 2 && bj == 0);
                    if (rope) {
                        const int p0 = ((col0 + bj * HALF) & 63) >> 1; const float sc = (pn < 2) ? 0.125f : 1.0f;
                        float x[8] = {v0[0], v0[1], v0[2], v0[3], v1[0], v1[1], v1[2], v1[3]};
#pragma unroll
                        for (int q = 0; q < 4; ++q) { const float invf = __builtin_amdgcn_exp2f(-(float)(p0 + q) * 0.41524101186092029f);
                            float r = posf * invf * 0.15915494309189535f; r = r - floorf(r);
                            const float c = __builtin_amdgcn_cosf(r) * sc, s = __builtin_amdgcn_sinf(r) * sc;
                            const float x1 = x[2 * q], x2 = x[2 * q + 1]; x[2 * q] = x1 * c - x2 * s; x[2 * q + 1] = x2 * c + x1 * s; }
                        v0 = (f32x4){x[0], x[1], x[2], x[3]}; v1 = (f32x4){x[4], x[5], x[6], x[7]};
                    } else if (pn >= 7) {
#pragma unroll
                        for (int j = 0; j < 4; ++j) { v0[j] = __builtin_amdgcn_rcpf(1.f + __expf(-v0[j])); v1[j] = __builtin_amdgcn_rcpf(1.f + __expf(-v1[j])); }
                    }
                    *(u32x4*)(rowp + bj * HALF) = pack8(v0, v1); } }
    }
};

struct EpiMix {
    static constexpr bool PERM = true, AFTER_DRAIN = false;
    bf16_t* O; int ldc; float* sumsq;
    __device__ __forceinline__ void operator()(const f32x4 (&acc)[2][2][4][2], const Unit& u, int wr, int wc, int fr, int fq) const {
        const int row0 = u.pm * BM + wr * 64 + fr, col0 = u.pn * BM + wc * 32 + 8 * fq;
#pragma unroll
        for (int ai = 0; ai < 2; ++ai)
#pragma unroll
            for (int m = 0; m < 4; ++m) { const int row = row0 + ai * HALF + m * 16; bf16_t* rowp = O + (size_t)row * ldc + col0; float s = 0.f;
#pragma unroll
                for (int bj = 0; bj < 2; ++bj) { const f32x4 v0 = acc[ai][bj][m][0], v1 = acc[ai][bj][m][1];
                    s += (v0[0] * v0[0] + v0[1] * v0[1]) + (v0[2] * v0[2] + v0[3] * v0[3]) + (v1[0] * v1[0] + v1[1] * v1[1]) + (v1[2] * v1[2] + v1[3] * v1[3]);
                    *(u32x4*)(rowp + bj * HALF) = pack8(v0, v1); }
                s += __shfl_xor(s, 16); s += __shfl_xor(s, 32);
                if (fq == 0) sumsq[(size_t)row * 16 + u.pn * 4 + wc] = s; }
    }
};
template <class Epi, class Sched, bool ALIGN_EPI = false, bool SP2 = false>
__device__ __forceinline__ void gemm_phase(PG8_LAS unsigned char* lds, const Gemm g, const Sched& S, const Epi& E) {
    const int tid = threadIdx.x, wid = __builtin_amdgcn_readfirstlane(tid >> 6), lane = tid & 63, wr = wid >> 2, wc = wid & 3, fr = lane & 15, fq = lane >> 4;
    const int K = g.K, nt = K / BK;
    unsigned voffA[2], voffB[2];
#pragma unroll
    for (int i = 0; i < 2; ++i) { int R, C; stage_rc(tid * 16 + i * 8192, R, C); const int Rb = Epi::PERM ? ((R & ~31) + perm32(R & 31)) : R;
        voffA[i] = (unsigned)(R * K + C) * 2u; voffB[i] = (unsigned)(Rb * K + C) * 2u; }
    const size_t kstep = (size_t)(BK * 2);
    const size_t hstep = (size_t)HALF * K * 2;
    const size_t tstep = 2 * hstep;
    const unsigned ldsw = (unsigned)wid * 1024u;
    const int aoff = lds_byte(wr * 64 + fr, fq * 8), boff = lds_byte(wc * 32 + fr, fq * 8);
#define PG8_SA(b, h) (((b) * 2 + (h)) * HTB)
#define PG8_SB(b, h) ((4 + (b) * 2 + (h)) * HTB)
#define PG8_STAGE(bufoff, gbase, voff) do { _Pragma("unroll") for (int _i = 0; _i < 2; ++_i) \
        __builtin_amdgcn_global_load_lds((const unsigned*)((const char*)(gbase) + (voff)[_i]), (PG8_LAS unsigned*)(lds + (bufoff) + ldsw + _i * 8192), 16, 0, 0); } while (0)
#define PG8_LDA(dst, b, h) do { _Pragma("unroll") for (int m = 0; m < 4; ++m) _Pragma("unroll") for (int k = 0; k < 2; ++k) dst[m][k] = *(const PG8_LAS bf16x8*)(lds + PG8_SA(b, h) + aoff + m * 2048 + k * 1024); } while (0)
#define PG8_LDB(dst, b, h) do { _Pragma("unroll") for (int n = 0; n < 2; ++n) _Pragma("unroll") for (int k = 0; k < 2; ++k) dst[n][k] = *(const PG8_LAS bf16x8*)(lds + PG8_SB(b, h) + boff + n * 2048 + k * 1024); } while (0)
#define PG8_MMA(ai, bj, At, Bt) do { __builtin_amdgcn_s_setprio(1); _Pragma("unroll") for (int m = 0; m < 4; ++m) _Pragma("unroll") for (int n = 0; n < 2; ++n) _Pragma("unroll") for (int k = 0; k < 2; ++k) \
        acc[ai][bj][m][n] = __builtin_amdgcn_mfma_f32_16x16x32_bf16(Bt[n][k], At[m][k], acc[ai][bj][m][n], 0, 0, 0); __builtin_amdgcn_s_setprio(0); } while (0)
#define PG8_WAIT_V(n) asm volatile("s_waitcnt vmcnt(" #n ")" ::: "memory")
#define PG8_WAIT_L(n) asm volatile("s_waitcnt lgkmcnt(" #n ")" ::: "memory")
#define PG8_BAR __builtin_amdgcn_s_barrier()
#define PG8_SCHED __builtin_amdgcn_sched_barrier(0)
    Unit cur, nxt; int ui = 0;
    if (!S.next(0, cur)) return;
    f32x4 acc[2][2][4][2];
#pragma unroll
    for (int a = 0; a < 2; ++a)
#pragma unroll
        for (int b = 0; b < 2; ++b)
#pragma unroll
            for (int m = 0; m < 4; ++m)
#pragma unroll
                for (int n = 0; n < 2; ++n) acc[a][b][m][n] = (f32x4){0.f, 0.f, 0.f, 0.f};
    bf16x8 At[4][2], B0[2][2], B1[2][2];
    const char* cA = (const char*)g.A + (size_t)cur.pm * tstep; const char* cB = (const char*)g.Bt + (size_t)cur.pn * tstep;
    S.a_ready(cur);
    if constexpr (SP2) {
        PG8_STAGE(PG8_SB(0, 0), cB, voffB); PG8_STAGE(PG8_SB(0, 1), cB + hstep, voffB); PG8_STAGE(PG8_SA(0, 0), cA, voffA); PG8_STAGE(PG8_SA(0, 1), cA + hstep, voffA);
        if (wr == 1) PG8_BAR;
        PG8_WAIT_V(2); PG8_BAR;
        PG8_STAGE(PG8_SB(1, 0), cB + kstep, voffB); PG8_STAGE(PG8_SA(1, 0), cA + kstep, voffA); PG8_STAGE(PG8_SB(1, 1), cB + hstep + kstep, voffB);
        PG8_WAIT_V(6); PG8_BAR;
    } else {
        PG8_STAGE(PG8_SB(0, 0), cB, voffB); PG8_STAGE(PG8_SA(0, 0), cA, voffA); PG8_STAGE(PG8_SB(0, 1), cB + hstep, voffB); PG8_STAGE(PG8_SA(0, 1), cA + hstep, voffA);
        if (wr == 1) PG8_BAR;
        PG8_WAIT_V(4); PG8_BAR;
        PG8_STAGE(PG8_SB(1, 0), cB + kstep, voffB); PG8_STAGE(PG8_SA(1, 0), cA + kstep, voffA); PG8_STAGE(PG8_SB(1, 1), cB + hstep + kstep, voffB);
        PG8_WAIT_V(6); PG8_BAR;
    }
    for (;;) {
        const bool has_next = S.next(ui + 1, nxt);
        const char* nA = has_next ? (const char*)g.A + (size_t)nxt.pm * tstep : cA; const char* nB = has_next ? (const char*)g.Bt + (size_t)nxt.pn * tstep : cB;
        for (int t = 0; t < nt; t += 2) {
            const bool last = (t == nt - 2);
            const char* a1 = cA + (size_t)(t + 1) * kstep;
            const char* a2 = last ? nA : cA + (size_t)(t + 2) * kstep; const char* b2 = last ? nB : cB + (size_t)(t + 2) * kstep;
            const char* a3 = a2 + kstep; const char* b3 = b2 + kstep;
            if (last && has_next) S.a_ready(nxt);
            if constexpr (SP2) {
            PG8_LDB(B0, 0, 0); PG8_LDB(B1, 0, 1); PG8_SCHED; PG8_LDA(At, 0, 0); PG8_STAGE(PG8_SA(1, 1), a1 + hstep, voffA);
            PG8_WAIT_V(8); PG8_WAIT_L(0); PG8_BAR; PG8_MMA(0, 0, At, B0); PG8_MMA(0, 1, At, B1); PG8_BAR; PG8_SCHED;
            PG8_LDA(At, 0, 1); PG8_STAGE(PG8_SB(0, 0), b2, voffB); PG8_STAGE(PG8_SB(0, 1), b2 + hstep, voffB); PG8_STAGE(PG8_SA(0, 0), a2, voffA);
            PG8_WAIT_V(8); PG8_WAIT_L(0); PG8_BAR; PG8_MMA(1, 0, At, B0); PG8_MMA(1, 1, At, B1); PG8_BAR; PG8_SCHED;
            PG8_LDB(B0, 1, 0); PG8_LDB(B1, 1, 1); PG8_SCHED; PG8_LDA(At, 1, 0); PG8_STAGE(PG8_SA(0, 1), a2 + hstep, voffA);
            PG8_WAIT_V(8); PG8_WAIT_L(0); PG8_BAR; PG8_MMA(0, 0, At, B0); PG8_MMA(0, 1, At, B1); PG8_BAR; PG8_SCHED;
            PG8_LDA(At, 1, 1); PG8_STAGE(PG8_SB(1, 0), b3, voffB); PG8_STAGE(PG8_SB(1, 1), b3 + hstep, voffB); PG8_STAGE(PG8_SA(1, 0), a3, voffA);
            PG8_WAIT_V(8); PG8_WAIT_L(0); PG8_BAR; PG8_MMA(1, 0, At, B0); PG8_MMA(1, 1, At, B1); PG8_BAR; PG8_SCHED;
            } else {
            PG8_LDB(B0, 0, 0); PG8_SCHED; PG8_LDA(At, 0, 0); PG8_STAGE(PG8_SA(1, 1), a1 + hstep, voffA);
            PG8_WAIT_L(8); PG8_BAR; PG8_WAIT_L(0); PG8_MMA(0, 0, At, B0); PG8_BAR; PG8_SCHED;
            PG8_LDB(B1, 0, 1); PG8_STAGE(PG8_SB(0, 0), b2, voffB);
            PG8_BAR; PG8_WAIT_L(0); PG8_MMA(0, 1, At, B1); PG8_BAR;
            PG8_LDA(At, 0, 1); PG8_STAGE(PG8_SA(0, 0), a2, voffA);
            PG8_BAR; PG8_WAIT_L(0); PG8_MMA(1, 0, At, B0); PG8_BAR; PG8_SCHED;
            PG8_STAGE(PG8_SB(0, 1), b2 + hstep, voffB);
            PG8_WAIT_V(6); PG8_BAR; PG8_MMA(1, 1, At, B1); PG8_BAR;
            PG8_LDB(B0, 1, 0); PG8_SCHED; PG8_LDA(At, 1, 0); PG8_STAGE(PG8_SA(0, 1), a2 + hstep, voffA);
            PG8_WAIT_L(8); PG8_BAR; PG8_WAIT_L(0); PG8_MMA(0, 0, At, B0); PG8_BAR; PG8_SCHED;
            PG8_LDB(B1, 1, 1); PG8_STAGE(PG8_SB(1, 0), b3, voffB);
            PG8_BAR; PG8_WAIT_L(0); PG8_MMA(0, 1, At, B1); PG8_BAR;
            PG8_LDA(At, 1, 1); PG8_STAGE(PG8_SA(1, 0), a3, voffA);
            PG8_BAR; PG8_WAIT_L(0); PG8_MMA(1, 0, At, B0); PG8_BAR; PG8_SCHED;
            PG8_STAGE(PG8_SB(1, 1), b3 + hstep, voffB);
            PG8_WAIT_V(6); PG8_BAR; PG8_MMA(1, 1, At, B1); PG8_BAR;
            }
        }
        if constexpr (ALIGN_EPI) { if (wr == 0) PG8_BAR; }
        if constexpr (!Epi::AFTER_DRAIN) { E(acc, cur, wr, wc, fr, fq); S.done(cur); }
        if (!has_next) break;
#pragma unroll
        for (int a = 0; a < 2; ++a)
#pragma unroll
            for (int b = 0; b < 2; ++b)
#pragma unroll
                for (int m = 0; m < 4; ++m)
#pragma unroll
                    for (int n = 0; n < 2; ++n) acc[a][b][m][n] = (f32x4){0.f, 0.f, 0.f, 0.f};
        cur = nxt; cA = nA; cB = nB; ++ui;
        if constexpr (ALIGN_EPI) { if (wr == 1) PG8_BAR; }
    }
    PG8_WAIT_V(0);
    if constexpr (!ALIGN_EPI) { if (wr == 0) PG8_BAR; }
    PG8_BAR;
    if constexpr (Epi::AFTER_DRAIN) { E.fused(acc, cur, wr, wc, fr, fq, lds, wid, lane); S.done(cur); }
#undef PG8_SA
#undef PG8_SB
#undef PG8_STAGE
#undef PG8_LDA
#undef PG8_LDB
#undef PG8_MMA
#undef PG8_WAIT_V
#undef PG8_WAIT_L
#undef PG8_BAR
#undef PG8_SCHED
}
}
constexpr int NB = 8, SEQ = 8192, D = 1024, M = NB * SEQ;
constexpr int DIN = 2312, NPROJ = 2304, NIN_PAD = 2560;
constexpr int C_AQ = 0, C_AK = 512, C_AV = 640, C_MQ = 768, C_MK = 1024, C_MV = 1280, C_MO = 1792;
constexpr int NEXP = 16384, NSLOT = 128;
constexpr float EPS = 1e-6f;
constexpr int NWAVES = 8, NTHR = 512;

constexpr size_t MiB = 1u << 20;
constexpr size_t WS_CTL = 0, CTL_ZERO_BYTES = 1 * MiB;
constexpr size_t WS_MOD = 1 * MiB;
constexpr size_t WS_WIN = 2 * MiB;
constexpr size_t WS_WOUT = 8 * MiB;
constexpr size_t WS_WQ = 10 * MiB;
constexpr size_t WS_KEYS = 14 * MiB;
constexpr size_t WS_GATES = 16 * MiB;
constexpr size_t WS_SSQ = 832 * MiB;
constexpr size_t WS_MST = 20 * MiB;
constexpr size_t WS_U8 = 32 * MiB, WS_V8 = 48 * MiB;
constexpr size_t WS_SC = 64 * MiB;
constexpr size_t WS_H = 96 * MiB;
constexpr size_t WS_PROJ = 224 * MiB;
constexpr size_t WS_MIXIN = 512 * MiB;
constexpr size_t WS_MIX = 640 * MiB;
constexpr size_t WS_EIDX = 768 * MiB, WS_GATE = 800 * MiB;
constexpr size_t WS_PD = 224 * MiB;
constexpr size_t WS_X1 = 512 * MiB;
constexpr size_t WS_ACT = 840 * MiB;
constexpr size_t WS_SSY = 872 * MiB;
constexpr size_t WS_H8 = 880 * MiB;
constexpr size_t WS_HS = 944 * MiB;
constexpr size_t WS_END = 945 * MiB;
constexpr int CW_BAR = 4096;
constexpr int CW_SUMSQ = 65536;
static_assert((CW_SUMSQ + M) * 4 <= (int)CTL_ZERO_BYTES, "ctl");

constexpr int RING_BYTES = 131072, MISC_OFF = RING_BYTES + 320, LDS_BYTES = 147456;

#define GAS __attribute__((address_space(1)))
#define LAS __attribute__((address_space(3)))
typedef unsigned short bf16;
typedef unsigned v4u __attribute__((ext_vector_type(4)));
typedef unsigned v2u __attribute__((ext_vector_type(2)));
typedef float f32x4 __attribute__((ext_vector_type(4)));
typedef GAS unsigned gu32;
#define LDS_WAIT() asm volatile("s_waitcnt lgkmcnt(0)" ::: "memory")
#define VM_WAIT() asm volatile("s_waitcnt vmcnt(0)" ::: "memory")
__device__ __forceinline__ unsigned f2bf(float f) { unsigned u = __builtin_bit_cast(unsigned, f); return (u + 0x7fffu + ((u >> 16) & 1u)) >> 16; }
__device__ __forceinline__ unsigned pk2(float lo, float hi) { return f2bf(lo) | (f2bf(hi) << 16); }
__device__ __forceinline__ float bflo(unsigned w) { return __builtin_bit_cast(float, w << 16); }
__device__ __forceinline__ float bfhi(unsigned w) { return __builtin_bit_cast(float, w & 0xffff0000u); }
__device__ __forceinline__ float bf1(bf16 h) { return __builtin_bit_cast(float, (unsigned)h << 16); }
__device__ __forceinline__ float wave_sum(float v) {
#pragma unroll
    for (int o = 1; o < 64; o <<= 1) v += __shfl_xor(v, o);
    return v;
}
__device__ __forceinline__ float wave_max(float v) {
#pragma unroll
    for (int o = 1; o < 64; o <<= 1) v = fmaxf(v, __shfl_xor(v, o));
    return v;
}

typedef float f32x2 __attribute__((ext_vector_type(2)));
__device__ __forceinline__ void cvt16_fp8(const v4u w, float (&o)[16]) {
    const unsigned ww[4] = {w.x, w.y, w.z, w.w};
#pragma unroll
    for (int i = 0; i < 4; ++i) { const f32x2 a = __builtin_amdgcn_cvt_pk_f32_fp8((int)ww[i], false), b = __builtin_amdgcn_cvt_pk_f32_fp8((int)ww[i], true);
        o[4 * i] = a.x; o[4 * i + 1] = a.y; o[4 * i + 2] = b.x; o[4 * i + 3] = b.y; }
}
__device__ __forceinline__ void p0_row_fp8(const float* src, unsigned char* dst, float* sc, int row, int lane) {
    const GAS f32x4* sp = (const GAS f32x4*)(src + (size_t)row * D + 16 * lane);
    const f32x4 a = sp[0], b = sp[1], c = sp[2], d = sp[3];
    float mx = 0.f;
#pragma unroll
    for (int i = 0; i < 4; ++i) mx = fmaxf(fmaxf(fmaxf(mx, fabsf(a[i])), fmaxf(fabsf(b[i]), fabsf(c[i]))), fabsf(d[i]));
    mx = wave_max(mx); const float s = mx > 0.f ? 224.0f / mx : 1.0f;
    v4u o; int w;
    w = __builtin_amdgcn_cvt_pk_fp8_f32(a[0] * s, a[1] * s, 0, false); w = __builtin_amdgcn_cvt_pk_fp8_f32(a[2] * s, a[3] * s, w, true); o.x = (unsigned)w;
    w = __builtin_amdgcn_cvt_pk_fp8_f32(b[0] * s, b[1] * s, 0, false); w = __builtin_amdgcn_cvt_pk_fp8_f32(b[2] * s, b[3] * s, w, true); o.y = (unsigned)w;
    w = __builtin_amdgcn_cvt_pk_fp8_f32(c[0] * s, c[1] * s, 0, false); w = __builtin_amdgcn_cvt_pk_fp8_f32(c[2] * s, c[3] * s, w, true); o.z = (unsigned)w;
    w = __builtin_amdgcn_cvt_pk_fp8_f32(d[0] * s, d[1] * s, 0, false); w = __builtin_amdgcn_cvt_pk_fp8_f32(d[2] * s, d[3] * s, w, true); o.w = (unsigned)w;
    *(GAS v4u*)(dst + (size_t)row * D + 16 * lane) = o;
    if (lane == 0) sc[row] = mx > 0.f ? mx * (1.0f / 224.0f) : 1.0f;
}

__device__ __forceinline__ unsigned pack4_i8(float a, float b, float c, float d) { return ((unsigned)__float2int_rn(a) & 0xffu) | (((unsigned)__float2int_rn(b) & 0xffu) << 8) | (((unsigned)__float2int_rn(c) & 0xffu) << 16) | (((unsigned)__float2int_rn(d) & 0xffu) << 24); }
__device__ __forceinline__ void p0_row_i8(const float* src, unsigned char* dst, float* sc, int row, int lane) {
    const GAS f32x4* sp = (const GAS f32x4*)(src + (size_t)row * D + 16 * lane);
    const f32x4 a = sp[0], b = sp[1], c = sp[2], d = sp[3];
    float mx = 0.f;
#pragma unroll
    for (int i = 0; i < 4; ++i) mx = fmaxf(fmaxf(fmaxf(mx, fabsf(a[i])), fmaxf(fabsf(b[i]), fabsf(c[i]))), fabsf(d[i]));
    mx = wave_max(mx); const float s = mx > 0.f ? 127.0f / mx : 1.0f;
    v4u o; o.x = pack4_i8(a[0] * s, a[1] * s, a[2] * s, a[3] * s); o.y = pack4_i8(b[0] * s, b[1] * s, b[2] * s, b[3] * s); o.z = pack4_i8(c[0] * s, c[1] * s, c[2] * s, c[3] * s); o.w = pack4_i8(d[0] * s, d[1] * s, d[2] * s, d[3] * s);
    *(GAS v4u*)(dst + (size_t)row * D + 16 * lane) = o;
    if (lane == 0) sc[row] = mx > 0.f ? mx * (1.0f / 127.0f) : 1.0f;
}

__device__ __forceinline__ unsigned pack8_i4(const f32x4 a, const f32x4 b, float s) {
    unsigned w = 0;
#pragma unroll
    for (int i = 0; i < 4; ++i) { const int qa = max(-8, min(7, __float2int_rn(a[i] * s))), qb = max(-8, min(7, __float2int_rn(b[i] * s))); w |= ((unsigned)qa & 15u) << (4 * i); w |= ((unsigned)qb & 15u) << (16 + 4 * i); }
    return w;
}
__device__ __forceinline__ void p0_row_i4(const float* src, unsigned char* dst, float* sc, int row, int lane) {
    const GAS f32x4* sp = (const GAS f32x4*)(src + (size_t)row * D + 16 * lane);
    const f32x4 a = sp[0], b = sp[1], c = sp[2], d = sp[3];
    float ss = 0.f;
#pragma unroll
    for (int i = 0; i < 4; ++i) ss += (a[i] * a[i] + b[i] * b[i]) + (c[i] * c[i] + d[i] * d[i]);
    ss = wave_sum(ss); const float sig = sqrtf(ss * (1.f / D)), s = sig > 0.f ? 3.0f / sig : 1.0f;
    v2u o; o.x = pack8_i4(a, b, s); o.y = pack8_i4(c, d, s);
    *(GAS v2u*)(dst + (size_t)row * (D / 2) + 8 * lane) = o;
    if (lane == 0) sc[row] = sig > 0.f ? sig * (1.0f / 3.0f) : 1.0f;
}

__device__ __forceinline__ unsigned pack8_fp4(const f32x4 a, const f32x4 b, float s) {
    unsigned w = 0;
    w = __builtin_amdgcn_cvt_scalef32_pk_fp4_f32(w, fminf(fmaxf(a[0] * s, -6.f), 6.f), fminf(fmaxf(a[1] * s, -6.f), 6.f), 1.0f, 0);
    w = __builtin_amdgcn_cvt_scalef32_pk_fp4_f32(w, fminf(fmaxf(a[2] * s, -6.f), 6.f), fminf(fmaxf(a[3] * s, -6.f), 6.f), 1.0f, 1);
    w = __builtin_amdgcn_cvt_scalef32_pk_fp4_f32(w, fminf(fmaxf(b[0] * s, -6.f), 6.f), fminf(fmaxf(b[1] * s, -6.f), 6.f), 1.0f, 2);
    w = __builtin_amdgcn_cvt_scalef32_pk_fp4_f32(w, fminf(fmaxf(b[2] * s, -6.f), 6.f), fminf(fmaxf(b[3] * s, -6.f), 6.f), 1.0f, 3);
    return w;
}
__device__ __forceinline__ void p0_row_fp4(const float* src, unsigned char* dst, float* sc, int row, int lane) {
    const GAS f32x4* sp = (const GAS f32x4*)(src + (size_t)row * D + 16 * lane);
    const f32x4 a = sp[0], b = sp[1], c = sp[2], d = sp[3];
    float mx = 0.f;
#pragma unroll
    for (int i = 0; i < 4; ++i) mx = fmaxf(fmaxf(fmaxf(mx, fabsf(a[i])), fmaxf(fabsf(b[i]), fabsf(c[i]))), fabsf(d[i]));
    mx = wave_max(mx); const float s = mx > 0.f ? 7.0f / mx : 1.0f;
    v2u o; o.x = pack8_fp4(a, b, s); o.y = pack8_fp4(c, d, s);
    *(GAS v2u*)(dst + (size_t)row * (D / 2) + 8 * lane) = o;
    if (lane == 0) sc[row] = mx > 0.f ? mx * (1.0f / 7.0f) : 1.0f;
}
#define XB_TMO      128
#define XB_XCNT(j)  (256  + 64 * (j))
#define XB_XSUB(j)  (1280 + 64 * (j))
#define XB_XGEN(j)  (2304 + 64 * (j))
#define XB_TOP      3328
#define XB_TOPGEN   3392
#define XCD_BAR_WORDS 3456
#define XB_SPIN_CAP (1u << 18)

__device__ __forceinline__ unsigned xb_ld(unsigned* p)              { return __hip_atomic_load(p, __ATOMIC_RELAXED, __HIP_MEMORY_SCOPE_AGENT); }
__device__ __forceinline__ unsigned xb_add(unsigned* p, unsigned v) { return __hip_atomic_fetch_add(p, v, __ATOMIC_RELAXED, __HIP_MEMORY_SCOPE_AGENT); }
__device__ __forceinline__ unsigned xb_xcc_id() { return (unsigned)__builtin_amdgcn_s_getreg((3 << 11) | 20) & 0xFu; }
#define XB_SPIN(cond, bar) do { unsigned _sp = 0; while (cond) { __builtin_amdgcn_s_sleep(1); \
    if ((++_sp & 255u) == 0u) { if (xb_ld(&(bar)[XB_TMO])) break; if (_sp > XB_SPIN_CAP) { atomicAdd(&(bar)[XB_TMO], 1u); break; } } } } while (0)

struct XcdBarrier {
    unsigned* bar; unsigned x;
    volatile LAS unsigned* st;
};

__device__ __forceinline__ XcdBarrier xcd_barrier_post(unsigned* bar, volatile LAS unsigned* st) {
    XcdBarrier b; b.bar = bar; b.x = xb_xcc_id(); b.st = st;
    if (threadIdx.x == 0) (void)xb_add(&bar[XB_XCNT(b.x)], 1u);
    return b;
}
__device__ __forceinline__ void xcd_barrier_complete(unsigned* bar, unsigned x, unsigned& nloc, unsigned& nx) {
    const unsigned G = gridDim.x * gridDim.y * gridDim.z;
    unsigned sum, cnt, mine, sp = 0u;
    for (;;) {
        sum = 0u; cnt = 0u; mine = 0u;
#pragma unroll
        for (unsigned j = 0; j < 16; ++j) { const unsigned c = xb_ld(&bar[XB_XCNT(j)]); sum += c; cnt += (c > 0u) ? 1u : 0u; mine = (j == x) ? c : mine; }
        if (sum == G) break;
        __builtin_amdgcn_s_sleep(1);
        if ((++sp & 255u) == 0u) { if (xb_ld(&bar[XB_TMO])) break; if (sp > XB_SPIN_CAP) { atomicAdd(&bar[XB_TMO], 1u); break; } }
    }
    nloc = mine > 0u ? mine : 1u; nx = cnt > 0u ? cnt : 1u;
}

__device__ __forceinline__ void xcd_barrier(const XcdBarrier& b) {
    asm volatile("s_waitcnt vmcnt(0)" ::: "memory");
    __syncthreads();
    if (threadIdx.x == 0) {
        unsigned* bar = b.bar;
        __builtin_amdgcn_s_waitcnt(0);
        unsigned nloc = b.st[0], nx = b.st[1];
        if (nloc == 0u) { xcd_barrier_complete(bar, b.x, nloc, nx); b.st[0] = nloc; b.st[1] = nx; }
        const unsigned old = xb_add(&bar[XB_XSUB(b.x)], 1u);
        const unsigned gen = old / nloc;
        if (old + 1u == (gen + 1u) * nloc) {
            __builtin_amdgcn_fence(__ATOMIC_RELEASE, "agent");
            asm volatile("s_waitcnt vmcnt(0)" ::: "memory");
            const unsigned og = xb_add(&bar[XB_TOP], 1u);
            const unsigned tg = og / nx;
            if (og + 1u == (tg + 1u) * nx) xb_add(&bar[XB_TOPGEN], 1u);
            else XB_SPIN(xb_ld(&bar[XB_TOPGEN]) == tg, bar);
            __builtin_amdgcn_fence(__ATOMIC_ACQUIRE, "agent");
            xb_add(&bar[XB_XGEN(b.x)], 1u);
            asm volatile("s_waitcnt vmcnt(0)" ::: "memory");
        } else {
            XB_SPIN(xb_ld(&bar[XB_XGEN(b.x)]) == gen, bar);
            __builtin_amdgcn_fence(__ATOMIC_ACQUIRE, "agent");
            asm volatile("s_waitcnt vmcnt(0)" ::: "memory");
        }
    }
    __syncthreads();
}
struct Args { const void* in[21]; float* out; unsigned char* ws; int ph_lo, ph_hi; };
enum { I_X = 0, I_C, I_POS, I_WMOD, I_BMOD, I_GPRE1, I_GPOST1, I_WIN, I_CONVW, I_BI, I_BF, I_MNG, I_SINK, I_WOUT, I_GPRE2, I_GPOST2, I_WQ, I_K1, I_K2, I_U, I_V };

__device__ __forceinline__ int newcol(int o) {
    if (o < 640) { const int hd = o >> 6, d = o & 63; return (hd << 6) + 2 * (d & 31) + (d >> 5); }
    if (o < 1792) return o;
    if (o < 1800) return 2304 + (o - 1792);
    return o - 8;
}
template <bool REMAP>
__device__ __forceinline__ void p0_transpose_item(const float* W, int K, int N, bf16* WT, LAS float* scr, int item, int lane) {
    const int nblk = (N + 31) / 32, kb = item / nblk, nb = item % nblk, k0 = 64 * kb, n0 = 32 * nb;
    const int ncol = n0 + (lane & 31);
#pragma unroll 8
    for (int i = 0; i < 32; ++i) { const int kk = 2 * i + (lane >> 5); scr[kk * 33 + (lane & 31)] = (ncol < N) ? W[(size_t)(k0 + kk) * N + ncol] : 0.f; }
    LDS_WAIT(); asm volatile("" ::: "memory");
    const int c = lane & 7;
#pragma unroll
    for (int j = 0; j < 4; ++j) { const int n = (lane >> 3) + 8 * j; const LAS float* s = scr + (8 * c) * 33 + n;
        v4u o; o.x = pk2(s[0 * 33], s[1 * 33]); o.y = pk2(s[2 * 33], s[3 * 33]); o.z = pk2(s[4 * 33], s[5 * 33]); o.w = pk2(s[6 * 33], s[7 * 33]);
        if (n0 + n < N) { const int drow = REMAP ? newcol(n0 + n) : (n0 + n); *(GAS v4u*)(WT + (size_t)drow * K + k0 + 8 * c) = o; } }
    LDS_WAIT(); asm volatile("" ::: "memory");
}
__device__ __forceinline__ void p0_convert(const float* src, bf16* dst, size_t n, int gt, int ngt) {
    for (size_t i = (size_t)gt * 8; i < n; i += (size_t)ngt * 8) {
        const f32x4 a = *(const GAS f32x4*)(src + i), b = *(const GAS f32x4*)(src + i + 4);
        v4u o; o.x = pk2(a[0], a[1]); o.y = pk2(a[2], a[3]); o.z = pk2(b[0], b[1]); o.w = pk2(b[2], b[3]);
        *(GAS v4u*)(dst + i) = o; }
}
__device__ __forceinline__ void phase_mod(const Args& A, LAS unsigned char* lds) {
    const int tid = threadIdx.x, G = gridDim.x, blk = blockIdx.x;
    unsigned char* ws = A.ws;
    const float* c = (const float*)A.in[I_C]; const float* wm = (const float*)A.in[I_WMOD]; const float* bm = (const float*)A.in[I_BMOD];
    float* mod = (float*)(ws + WS_MOD); LAS float* cs = (LAS float*)lds; LAS float* red = cs + 8 * 1024;
    for (int e = tid; e < 8 * 1024 / 4; e += NTHR) *(LAS f32x4*)(cs + 4 * e) = *(const GAS f32x4*)(c + 4 * e);
    __syncthreads();
    for (int it = blk; it < 6144 / 24; it += G) {
        const int kg = tid >> 5, col = tid & 31, j = it * 24 + (col < 24 ? col : 23); float acc[8];
#pragma unroll
        for (int b = 0; b < 8; ++b) acc[b] = 0.f;
#pragma unroll 16
        for (int i = 0; i < 64; ++i) { const int k = kg + 16 * i; const float w = wm[(size_t)k * 6144 + j];
#pragma unroll
            for (int b = 0; b < 8; ++b) acc[b] += cs[b * 1024 + k] * w; }
#pragma unroll
        for (int b = 0; b < 8; ++b) red[(kg * 32 + col) * 8 + b] = acc[b];
        __syncthreads();
        if (tid < 256) { const int b = tid >> 5, cc = tid & 31; float s = 0.f;
#pragma unroll
            for (int g = 0; g < 16; ++g) s += red[(g * 32 + cc) * 8 + b];
            if (cc < 24) mod[b * 6144 + it * 24 + cc] = s + bm[it * 24 + cc]; }
        __syncthreads();
    }
}
__device__ __forceinline__ void phase_convert(const Args& A, LAS unsigned char* lds) {
    const int tid = threadIdx.x, lane = tid & 63, wave = tid >> 6, G = gridDim.x, blk = blockIdx.x;
    unsigned char* ws = A.ws;
    {
        LAS float* scr = (LAS float*)(lds + wave * 16384);
        const int gw = blk * NWAVES + wave, NGW = G * NWAVES;
        const int I_IN = (D / 64) * ((DIN + 31) / 32), I_OUT = (D / 64) * (D / 32), I_Q = (D / 64) * (2048 / 32);
        bf16* win = (bf16*)(ws + WS_WIN); bf16* wout = (bf16*)(ws + WS_WOUT); bf16* wq = (bf16*)(ws + WS_WQ);
        for (int it = gw; it < I_IN + I_OUT + I_Q; it += NGW) {
            int r = it;
            if (r < I_IN) { p0_transpose_item<true>((const float*)A.in[I_WIN], D, DIN, win, scr, r, lane); continue; } r -= I_IN;
            if (r < I_OUT) { p0_transpose_item<false>((const float*)A.in[I_WOUT], D, D, wout, scr, r, lane); continue; } r -= I_OUT;
            p0_transpose_item<false>((const float*)A.in[I_WQ], D, 2048, wq, scr, r, lane);
        }
        const int gt = blk * NTHR + tid, ngt = G * NTHR;
        for (int i = gt; i < (NIN_PAD - DIN) * D / 8; i += ngt) *(GAS v4u*)(win + (size_t)DIN * D + (size_t)i * 8) = (v4u){0u, 0u, 0u, 0u};
        p0_convert((const float*)A.in[I_K1], (bf16*)(ws + WS_KEYS), (size_t)8 * 128 * 128, gt, ngt);
        p0_convert((const float*)A.in[I_K2], (bf16*)(ws + WS_KEYS) + 8 * 128 * 128, (size_t)8 * 128 * 128, gt, ngt);
        for (int r = gw; r < 2 * NEXP; r += NGW) { if (r < NEXP) p0_row_i4((const float*)A.in[I_U], ws + WS_U8, (float*)(ws + WS_SC), r, lane); else p0_row_fp4((const float*)A.in[I_V], ws + WS_V8, (float*)(ws + WS_SC) + NEXP, r - NEXP, lane); }
    }
}

__device__ __forceinline__ void phase_prenorm(const Args& A) {
    const int tid = threadIdx.x, lane = tid & 63, wave = tid >> 6, G = gridDim.x;
    const float* x = (const float*)A.in[I_X]; const float* g = (const float*)A.in[I_GPRE1]; const float* mod = (const float*)(A.ws + WS_MOD);
    bf16* H = (bf16*)(A.ws + WS_H);
    for (int row = blockIdx.x * NWAVES + wave; row < M; row += G * NWAVES) {
        const int b = row / SEQ; const GAS f32x4* xr = (const GAS f32x4*)(x + (size_t)row * D) + lane;
        f32x4 v[4]; float s = 0.f;
#pragma unroll
        for (int j = 0; j < 4; ++j) { v[j] = xr[64 * j]; s += (v[j][0] * v[j][0] + v[j][1] * v[j][1]) + (v[j][2] * v[j][2] + v[j][3] * v[j][3]); }
        const float rstd = 1.0f / sqrtf(wave_sum(s) * (1.f / D) + EPS);
        GAS v2u* o = (GAS v2u*)(H + (size_t)row * D) + lane;
#pragma unroll
        for (int j = 0; j < 4; ++j) { const int k = 4 * (lane + 64 * j);
            const f32x4 gg = *(const GAS f32x4*)(g + k), sh = *(const GAS f32x4*)(mod + b * 6144 + k), sc = *(const GAS f32x4*)(mod + b * 6144 + 1024 + k);
            f32x4 y;
#pragma unroll
            for (int i = 0; i < 4; ++i) y[i] = v[j][i] * rstd * gg[i] * (1.f + sc[i]) + sh[i];
            v2u w; w.x = pk2(y[0], y[1]); w.y = pk2(y[2], y[3]); o[64 * j] = w; }
    }
}

__device__ __forceinline__ void phase_mid(const Args& A) {
    const int tid = threadIdx.x, lane = tid & 63, wave = tid >> 6, G = gridDim.x;
    const float* x = (const float*)A.in[I_X]; const float* gpost = (const float*)A.in[I_GPOST1]; const float* gpre = (const float*)A.in[I_GPRE2];
    const float* mod = (const float*)(A.ws + WS_MOD); const float* sumsq = (const float*)(A.ws + WS_SSQ);
    const bf16* MIX = (const bf16*)(A.ws + WS_MIX); bf16* H = (bf16*)(A.ws + WS_H); bf16* X1 = (bf16*)(A.ws + WS_X1);
    for (int row = blockIdx.x * NWAVES + wave; row < M; row += G * NWAVES) {
        const int b = row / SEQ; const GAS f32x4* xr = (const GAS f32x4*)(x + (size_t)row * D) + lane; const GAS v2u* mr = (const GAS v2u*)(MIX + (size_t)row * D) + lane;
        const f32x4 q0 = *(const GAS f32x4*)(sumsq + (size_t)row * 16), q1 = *(const GAS f32x4*)(sumsq + (size_t)row * 16 + 4), q2 = *(const GAS f32x4*)(sumsq + (size_t)row * 16 + 8), q3 = *(const GAS f32x4*)(sumsq + (size_t)row * 16 + 12);
        const float rm = 1.0f / sqrtf(((((q0[0] + q0[1]) + (q0[2] + q0[3])) + ((q1[0] + q1[1]) + (q1[2] + q1[3]))) + (((q2[0] + q2[1]) + (q2[2] + q2[3])) + ((q3[0] + q3[1]) + (q3[2] + q3[3])))) * (1.f / D) + EPS);
        f32x4 v[4]; float s = 0.f;
#pragma unroll
        for (int j = 0; j < 4; ++j) { const int k = 4 * (lane + 64 * j); const f32x4 xv = xr[64 * j]; const v2u mw = mr[64 * j];
            const f32x4 gp = *(const GAS f32x4*)(gpost + k), g1 = *(const GAS f32x4*)(mod + b * 6144 + 2048 + k);
            const float mx[4] = {bflo(mw.x), bfhi(mw.x), bflo(mw.y), bfhi(mw.y)};
#pragma unroll
            for (int i = 0; i < 4; ++i) { v[j][i] = xv[i] + g1[i] * (mx[i] * rm * gp[i]); s += v[j][i] * v[j][i]; }
            { v2u w; w.x = pk2(v[j][0], v[j][1]); w.y = pk2(v[j][2], v[j][3]); *((GAS v2u*)(X1 + (size_t)row * D) + lane + 64 * j) = w; } }
        const float rstd = 1.0f / sqrtf(wave_sum(s) * (1.f / D) + EPS);
        GAS v2u* o = (GAS v2u*)(H + (size_t)row * D) + lane; float amx = 0.f;
#pragma unroll
        for (int j = 0; j < 4; ++j) { const int k = 4 * (lane + 64 * j);
            const f32x4 gg = *(const GAS f32x4*)(gpre + k), sh = *(const GAS f32x4*)(mod + b * 6144 + 3072 + k), sc = *(const GAS f32x4*)(mod + b * 6144 + 4096 + k);
#pragma unroll
            for (int i = 0; i < 4; ++i) { v[j][i] = v[j][i] * rstd * gg[i] * (1.f + sc[i]) + sh[i]; amx = fmaxf(amx, fabsf(v[j][i])); }
            v2u w; w.x = pk2(v[j][0], v[j][1]); w.y = pk2(v[j][2], v[j][3]); o[64 * j] = w; }
        amx = wave_max(amx); const float s8 = amx > 0.f ? 119.0f / amx : 1.0f;
        GAS unsigned short* ohh = (GAS unsigned short*)((unsigned char*)A.ws + WS_H8 + (size_t)row * (D / 2)) + lane; GAS unsigned short* ohl = (GAS unsigned short*)((unsigned char*)A.ws + WS_H8 + 32 * MiB + (size_t)row * (D / 2)) + lane;
#pragma unroll
        for (int j = 0; j < 4; ++j) { unsigned whh = 0, whl = 0;
#pragma unroll
            for (int i = 0; i < 4; ++i) { const int tq = __float2int_rn(v[j][i] * s8) + 8; whh |= ((unsigned)(tq >> 4) & 15u) << (4 * i); whl |= ((unsigned)((tq & 15) - 8) & 15u) << (4 * i); }
            ohh[64 * j] = (unsigned short)whh; ohl[64 * j] = (unsigned short)whl; }
        if (lane == 0) ((float*)(A.ws + WS_HS))[row] = amx > 0.f ? amx * (1.0f / 119.0f) : 1.0f;
    }
}
__device__ __forceinline__ void load64bf(const bf16* p, float (&o)[64]) {
#pragma unroll
    for (int i = 0; i < 8; ++i) { const v4u w = *(const GAS v4u*)(p + 8 * i);
        o[8 * i + 0] = bflo(w.x); o[8 * i + 1] = bfhi(w.x); o[8 * i + 2] = bflo(w.y); o[8 * i + 3] = bfhi(w.y);
        o[8 * i + 4] = bflo(w.z); o[8 * i + 5] = bfhi(w.z); o[8 * i + 6] = bflo(w.w); o[8 * i + 7] = bfhi(w.w); }
}
__device__ __forceinline__ void phase_attn_naive(const Args& A, int vb, int nvb) {
    const bf16* P = (const bf16*)(A.ws + WS_PROJ); bf16* MI = (bf16*)(A.ws + WS_MIXIN); const float* sinks = (const float*)A.in[I_SINK];
    for (int task = vb * NTHR + (int)threadIdx.x; task < 8 * M; task += nvb * NTHR) {
        const int h = task / M, t = task % M, s = t % SEQ, kvh = h >> 2;
        float q[64], o[64];
        load64bf(P + (size_t)t * NPROJ + C_AQ + h * 64, q);
#pragma unroll
        for (int d = 0; d < 64; ++d) o[d] = 0.f;
        float mx = sinks[h], l = 1.f;
        for (int j = 0; j < 128; ++j) {
            const int sj = s - 127 + j; const bool valid = sj >= 0; const int tk = valid ? (t - 127 + j) : t;
            const bf16* kr = P + (size_t)tk * NPROJ + C_AK + kvh * 64; float sc = 0.f;
#pragma unroll
            for (int i = 0; i < 8; ++i) { const v4u w = *(const GAS v4u*)(kr + 8 * i);
                sc += q[8 * i + 0] * bflo(w.x) + q[8 * i + 1] * bfhi(w.x) + q[8 * i + 2] * bflo(w.y) + q[8 * i + 3] * bfhi(w.y)
                    + q[8 * i + 4] * bflo(w.z) + q[8 * i + 5] * bfhi(w.z) + q[8 * i + 6] * bflo(w.w) + q[8 * i + 7] * bfhi(w.w); }
            if (valid) {
                const float mn = fmaxf(mx, sc), al = __expf(mx - mn), p = __expf(sc - mn); mx = mn; l = l * al + p;
                const bf16* vr = P + (size_t)tk * NPROJ + C_AV + kvh * 64;
#pragma unroll
                for (int i = 0; i < 8; ++i) { const v4u w = *(const GAS v4u*)(vr + 8 * i);
                    o[8 * i + 0] = o[8 * i + 0] * al + p * bflo(w.x); o[8 * i + 1] = o[8 * i + 1] * al + p * bfhi(w.x);
                    o[8 * i + 2] = o[8 * i + 2] * al + p * bflo(w.y); o[8 * i + 3] = o[8 * i + 3] * al + p * bfhi(w.y);
                    o[8 * i + 4] = o[8 * i + 4] * al + p * bflo(w.z); o[8 * i + 5] = o[8 * i + 5] * al + p * bfhi(w.z);
                    o[8 * i + 6] = o[8 * i + 6] * al + p * bflo(w.w); o[8 * i + 7] = o[8 * i + 7] * al + p * bfhi(w.w); }
            }
        }
        const float il = 1.f / l; bf16* orow = MI + (size_t)t * D + h * 64;
#pragma unroll
        for (int i = 0; i < 8; ++i) { v4u w; w.x = pk2(o[8 * i] * il, o[8 * i + 1] * il); w.y = pk2(o[8 * i + 2] * il, o[8 * i + 3] * il);
            w.z = pk2(o[8 * i + 4] * il, o[8 * i + 5] * il); w.w = pk2(o[8 * i + 6] * il, o[8 * i + 7] * il); *(GAS v4u*)(orow + 8 * i) = w; }
    }
}

__device__ __forceinline__ void phase_mlstm_naive(const Args& A, LAS unsigned char* lds, int bh) {
    const int tid = threadIdx.x, lane = tid & 63, wave = tid >> 6, b = bh >> 2, h = bh & 3, dv = tid >> 2, part = tid & 3;
    const bf16* P = (const bf16*)(A.ws + WS_PROJ); bf16* MI = (bf16*)(A.ws + WS_MIXIN); const float* gates = (const float*)(A.ws + WS_GATES);
    const float* cw = (const float*)A.in[I_CONVW]; const float* ng = (const float*)A.in[I_MNG];
    LAS float* qs = (LAS float*)lds; LAS float* ks = qs + 64 * 64; LAS float* vs = ks + 64 * 64; LAS float* ig = vs + 64 * 128; LAS float* lfg = ig + 64; LAS float* hb = lfg + 64;
    float C[16], n[16]; float m = 0.f;
#pragma unroll
    for (int j = 0; j < 16; ++j) { C[j] = 0.f; n[j] = 0.f; }
    for (int ch = 0; ch < SEQ / 64; ++ch) {
        const int s0 = ch * 64; const size_t t0 = (size_t)b * SEQ + s0;
        for (int e = tid; e < 64 * 64; e += NTHR) { const int l = e >> 6, dk = e & 63; float aq = 0.f, ak = 0.f;
#pragma unroll
            for (int j = 0; j < 4; ++j) { const int sj = s0 + l - 3 + j; if (sj >= 0) { const bf16* r = P + ((size_t)b * SEQ + sj) * NPROJ;
                aq += cw[j * 512 + h * 64 + dk] * bf1(r[C_MQ + h * 64 + dk]); ak += cw[j * 512 + 256 + h * 64 + dk] * bf1(r[C_MK + h * 64 + dk]); } }
            qs[e] = 0.125f * aq / (1.f + __expf(-aq)); ks[e] = ak / (1.f + __expf(-ak)); }
        for (int e = tid; e < 64 * 128; e += NTHR) { const int l = e >> 7, d = e & 127; vs[e] = bf1(P[(t0 + l) * NPROJ + C_MV + h * 128 + d]); }
        if (tid < 64) { ig[tid] = gates[(t0 + tid) * 8 + h]; lfg[tid] = gates[(t0 + tid) * 8 + 4 + h]; }
        __syncthreads();
        for (int l = 0; l < 64; ++l) {
            const float lf = lfg[l], ii = ig[l], mn = fmaxf(lf + m, ii), fd = __expf(lf + m - mn), iw = __expf(ii - mn), vv = vs[l * 128 + dv] * iw;
            float num = 0.f, den = 0.f;
#pragma unroll
            for (int j = 0; j < 16; ++j) { const float kk = ks[l * 64 + part * 16 + j], qq = qs[l * 64 + part * 16 + j];
                C[j] = fd * C[j] + vv * kk; n[j] = fd * n[j] + iw * kk; num += C[j] * qq; den += n[j] * qq; }
            num += __shfl_xor(num, 1); num += __shfl_xor(num, 2); den += __shfl_xor(den, 1); den += __shfl_xor(den, 2);
            if (part == 0) hb[l * 128 + dv] = num / fmaxf(fabsf(den), __expf(-mn));
            m = mn;
        }
        __syncthreads();
        for (int l = wave * 8; l < wave * 8 + 8; ++l) { const float a0 = hb[l * 128 + lane], a1 = hb[l * 128 + 64 + lane];
            const float r = 1.0f / sqrtf(wave_sum(a0 * a0 + a1 * a1) * (1.f / 128.f) + EPS);
            const bf16* pr = P + (t0 + l) * NPROJ + C_MO + h * 128; bf16* orow = MI + (t0 + l) * D + 512 + h * 128;
            orow[lane] = (bf16)f2bf(a0 * r * ng[h * 128 + lane] * bf1(pr[lane])); orow[64 + lane] = (bf16)f2bf(a1 * r * ng[h * 128 + 64 + lane] * bf1(pr[64 + lane])); }
        __syncthreads();
    }
}

__device__ __forceinline__ void ld16bf(const bf16* p, float (&o)[16]) {
    const v4u w0 = *(const GAS v4u*)p, w1 = *(const GAS v4u*)(p + 8);
    o[0] = bflo(w0.x); o[1] = bfhi(w0.x); o[2] = bflo(w0.y); o[3] = bfhi(w0.y); o[4] = bflo(w0.z); o[5] = bfhi(w0.z); o[6] = bflo(w0.w); o[7] = bfhi(w0.w);
    o[8] = bflo(w1.x); o[9] = bfhi(w1.x); o[10] = bflo(w1.y); o[11] = bfhi(w1.y); o[12] = bflo(w1.z); o[13] = bfhi(w1.z); o[14] = bflo(w1.w); o[15] = bfhi(w1.w);
}
typedef short bf16x8 __attribute__((ext_vector_type(8)));
#define MFMA16(a, b, c) __builtin_amdgcn_mfma_f32_16x16x32_bf16((a), (b), (c), 0, 0, 0)
__device__ __forceinline__ bf16x8 ldfrag(LAS const unsigned char* img, int row, int kbyte) { return *(LAS const bf16x8*)(img + row * 144 + kbyte); }
__device__ __forceinline__ unsigned cvtpk(float lo, float hi) { unsigned r; asm volatile("v_cvt_pk_bf16_f32 %0, %1, %2" : "=v"(r) : "v"(lo), "v"(hi)); return r; }

namespace ml {
constexpr int O_Q = 0, O_QA = 9216, O_K = 18432, O_KWT = 27648, O_VT = 36864, O_CX = 57600, CXB = 20736, O_S = 99072, O_GB = 108288, O_GA = O_GB + 4096, O_GC = O_GA + 4096, O_DEN = O_GC + 4096, O_SSQ = O_DEN + 256, O_END = O_SSQ + 2048;
static_assert(O_END <= 131072, "mlstm LDS");
constexpr size_t MST_SC = 11 * MiB;
}
template <bool OUT>
__device__ __forceinline__ void mlstm_group(const Args& A, LAS unsigned char* lds, int wg) {
    using namespace ml;
    const int tid = threadIdx.x, lane = tid & 63, wave = __builtin_amdgcn_readfirstlane(tid >> 6), fr = lane & 15, fq = lane >> 4;
    const int bh = wg >> 3, grp = wg & 7, b = bh >> 2, h = bh & 3;
    const size_t tg0 = (size_t)b * SEQ + (size_t)grp * 1024;
    const bf16* P = (const bf16*)(A.ws + WS_PROJ); bf16* MI = (bf16*)(A.ws + WS_MIXIN); const float* gates = (const float*)(A.ws + WS_GATES);
    const float* cw = (const float*)A.in[I_CONVW]; const float* ng = (const float*)A.in[I_MNG];
    float* MST = (float*)(A.ws + WS_MST); float* MSC = (float*)(A.ws + WS_MST + MST_SC);
    LAS float* GB = (LAS float*)(lds + O_GB); LAS float* GA = (LAS float*)(lds + O_GA); LAS float* GC = (LAS float*)(lds + O_GC);
    LAS float* DEN = (LAS float*)(lds + O_DEN); LAS float* SSQ = (LAS float*)(lds + O_SSQ);
    __syncthreads();
#pragma unroll
    for (int cc = 0; cc < 2; ++cc) { const int c = 2 * wave + cc; const size_t t = tg0 + c * 64 + lane;
        float bc = gates[t * 8 + 4 + h]; const float ii = gates[t * 8 + h];
#pragma unroll
        for (int o = 1; o < 64; o <<= 1) { const float v = __shfl_up(bc, o); if (lane >= o) bc += v; }
        const float a = ii - bc; float cm = a;
#pragma unroll
        for (int o = 1; o < 64; o <<= 1) { const float v = __shfl_up(cm, o); if (lane >= o) cm = fmaxf(cm, v); }
        GB[c * 64 + lane] = bc; GA[c * 64 + lane] = a; GC[c * 64 + lane] = cm; }
    for (int e = tid; e < 16 * 32; e += NTHR) { const int r = e >> 5, cpair = e & 31; *(LAS unsigned*)(lds + O_VT + (128 + r) * 144 + cpair * 4) = (r == 0) ? 0x3F803F80u : 0u; }
    f32x4 st[5];
#pragma unroll
    for (int i = 0; i < 5; ++i) st[i] = (f32x4){0.f, 0.f, 0.f, 0.f};
    float m = OUT ? 0.f : -__builtin_inff(); float Btot = 0.f;
    if (OUT) {
        for (int gp = 0; gp < grp; ++gp) { const int wgp = bh * 8 + gp; const float mg = MSC[wgp * 2], Bg = MSC[wgp * 2 + 1];
            const float mn = fmaxf(Bg + m, mg), f0 = __expf(Bg + m - mn), f1 = __expf(mg - mn);
#pragma unroll
            for (int i = 0; i < 5; ++i)
#pragma unroll
                for (int r = 0; r < 4; ++r) st[i][r] = f0 * st[i][r] + f1 * MST[((size_t)wgp * 20 + i * 4 + r) * NTHR + tid];
            m = mn; }
#pragma unroll
        for (int j = 0; j < 4; ++j)
#pragma unroll
            for (int r = 0; r < 4; ++r) *(LAS bf16*)(lds + O_CX + (16 * wave + 4 * fq + r) * 144 + (16 * j + fr) * 2) = (bf16)f2bf(st[j][r]);
        if (wave < 4) {
#pragma unroll
            for (int r = 0; r < 4; ++r) *(LAS bf16*)(lds + O_CX + (128 + 4 * fq + r) * 144 + (16 * wave + fr) * 2) = (bf16)f2bf(st[4][r]); }
    }
    float gsc[4];
#pragma unroll
    for (int r = 0; r < 4; ++r) gsc[r] = ng[h * 128 + 16 * wave + 4 * fq + r];
    const int sl = tid >> 3, cg = tid & 7;
    __syncthreads();
    for (int c = 0; c < 16; ++c) {
        const float bL = GB[c * 64 + 63], M63 = fmaxf(m, GC[c * 64 + 63]), decay = __expf(m - M63);
        const size_t tc0 = tg0 + (size_t)c * 64;
        {
            const int sabs = grp * 1024 + c * 64 + sl;
            float aq[8], ak[8];
#pragma unroll
            for (int i = 0; i < 8; ++i) { aq[i] = 0.f; ak[i] = 0.f; }
#pragma unroll
            for (int j = 0; j < 4; ++j) { const int sj = sabs - 3 + j;
                if (sj >= 0) { const bf16* rp = P + ((size_t)b * SEQ + sj) * NPROJ;
                    const v4u wq = *(const GAS v4u*)(rp + C_MQ + h * 64 + 8 * cg), wk = *(const GAS v4u*)(rp + C_MK + h * 64 + 8 * cg);
                    const f32x4 q0 = *(const GAS f32x4*)(cw + j * 512 + h * 64 + 8 * cg), q1 = *(const GAS f32x4*)(cw + j * 512 + h * 64 + 8 * cg + 4);
                    const f32x4 k0 = *(const GAS f32x4*)(cw + j * 512 + 256 + h * 64 + 8 * cg), k1 = *(const GAS f32x4*)(cw + j * 512 + 256 + h * 64 + 8 * cg + 4);
                    aq[0] += q0[0] * bflo(wq.x); aq[1] += q0[1] * bfhi(wq.x); aq[2] += q0[2] * bflo(wq.y); aq[3] += q0[3] * bfhi(wq.y);
                    aq[4] += q1[0] * bflo(wq.z); aq[5] += q1[1] * bfhi(wq.z); aq[6] += q1[2] * bflo(wq.w); aq[7] += q1[3] * bfhi(wq.w);
                    ak[0] += k0[0] * bflo(wk.x); ak[1] += k0[1] * bfhi(wk.x); ak[2] += k0[2] * bflo(wk.y); ak[3] += k0[3] * bfhi(wk.y);
                    ak[4] += k1[0] * bflo(wk.z); ak[5] += k1[1] * bfhi(wk.z); ak[6] += k1[2] * bflo(wk.w); ak[7] += k1[3] * bfhi(wk.w); } }
            const float Ml = fmaxf(m, GC[c * 64 + sl]), ainter = __expf(m - Ml), wsv = __expf(GA[c * 64 + sl] - M63);
            float qv[8], kv[8];
#pragma unroll
            for (int i = 0; i < 8; ++i) { qv[i] = 0.125f * aq[i] * __builtin_amdgcn_rcpf(1.f + __expf(-aq[i])); kv[i] = ak[i] * __builtin_amdgcn_rcpf(1.f + __expf(-ak[i])); }
            if (OUT) {
                v4u w; w.x = pk2(qv[0], qv[1]); w.y = pk2(qv[2], qv[3]); w.z = pk2(qv[4], qv[5]); w.w = pk2(qv[6], qv[7]); *(LAS v4u*)(lds + O_Q + sl * 144 + cg * 16) = w;
                w.x = pk2(qv[0] * ainter, qv[1] * ainter); w.y = pk2(qv[2] * ainter, qv[3] * ainter); w.z = pk2(qv[4] * ainter, qv[5] * ainter); w.w = pk2(qv[6] * ainter, qv[7] * ainter); *(LAS v4u*)(lds + O_QA + sl * 144 + cg * 16) = w;
                w.x = pk2(kv[0], kv[1]); w.y = pk2(kv[2], kv[3]); w.z = pk2(kv[4], kv[5]); w.w = pk2(kv[6], kv[7]); *(LAS v4u*)(lds + O_K + sl * 144 + cg * 16) = w;
            }
#pragma unroll
            for (int i = 0; i < 8; ++i) *(LAS bf16*)(lds + O_KWT + (8 * cg + i) * 144 + sl * 2) = (bf16)f2bf(kv[i] * wsv);
#pragma unroll
            for (int gi = 0; gi < 2; ++gi) { const int g8 = cg + 8 * gi; const v4u wv = *(const GAS v4u*)(P + (tc0 + sl) * NPROJ + C_MV + h * 128 + 8 * g8);
                const unsigned ww[4] = {wv.x, wv.y, wv.z, wv.w};
#pragma unroll
                for (int i = 0; i < 4; ++i) { *(LAS bf16*)(lds + O_VT + (8 * g8 + 2 * i) * 144 + sl * 2) = (bf16)(ww[i] & 0xffffu); *(LAS bf16*)(lds + O_VT + (8 * g8 + 2 * i + 1) * 144 + sl * 2) = (bf16)(ww[i] >> 16); } }
        }
        __syncthreads();
        if (OUT) {
            const int lt = wave >> 1, l = 16 * lt + fr; const float Ml = fmaxf(m, GC[c * 64 + l]);
            const bf16x8 bq0 = ldfrag(lds + O_Q, 16 * lt + fr, 16 * fq), bq1 = ldfrag(lds + O_Q, 16 * lt + fr, 64 + 16 * fq);
#pragma unroll
            for (int u = 0; u < 2; ++u) { const int stl = 2 * (wave & 1) + u; f32x4 acc = {0.f, 0.f, 0.f, 0.f};
                acc = MFMA16(ldfrag(lds + O_K, 16 * stl + fr, 16 * fq), bq0, acc); acc = MFMA16(ldfrag(lds + O_K, 16 * stl + fr, 64 + 16 * fq), bq1, acc);
                const f32x4 av = *(LAS const f32x4*)(GA + c * 64 + 16 * stl + 4 * fq); float wv[4];
#pragma unroll
                for (int r = 0; r < 4; ++r) { const int s = 16 * stl + 4 * fq + r; wv[r] = (s <= l) ? acc[r] * __expf(av[r] - Ml) : 0.f; }
                v2u w; w.x = cvtpk(wv[0], wv[1]); w.y = cvtpk(wv[2], wv[3]); *(LAS v2u*)(lds + O_S + l * 144 + (16 * stl + 4 * fq) * 2) = w; }
        }
        {
            const bf16x8 va0 = ldfrag(lds + O_VT, 16 * wave + fr, 16 * fq), va1 = ldfrag(lds + O_VT, 16 * wave + fr, 64 + 16 * fq);
#pragma unroll
            for (int j = 0; j < 4; ++j) { st[j] = st[j] * decay;
                st[j] = MFMA16(va0, ldfrag(lds + O_KWT, 16 * j + fr, 16 * fq), st[j]); st[j] = MFMA16(va1, ldfrag(lds + O_KWT, 16 * j + fr, 64 + 16 * fq), st[j]); }
            if (wave < 4) { st[4] = st[4] * decay;
                st[4] = MFMA16(ldfrag(lds + O_VT, 128 + fr, 16 * fq), ldfrag(lds + O_KWT, 16 * wave + fr, 16 * fq), st[4]);
                st[4] = MFMA16(ldfrag(lds + O_VT, 128 + fr, 64 + 16 * fq), ldfrag(lds + O_KWT, 16 * wave + fr, 64 + 16 * fq), st[4]); }
        }
        if (OUT) {
            __syncthreads();
            LAS const unsigned char* cx = lds + O_CX + (c & 1) * CXB;
            f32x4 nt[4], nd = {0.f, 0.f, 0.f, 0.f};
            {
                const bf16x8 va0 = ldfrag(lds + O_VT, 16 * wave + fr, 16 * fq), va1 = ldfrag(lds + O_VT, 16 * wave + fr, 64 + 16 * fq);
                const bf16x8 ca0 = ldfrag(cx, 16 * wave + fr, 16 * fq), ca1 = ldfrag(cx, 16 * wave + fr, 64 + 16 * fq);
#pragma unroll
                for (int lt = 0; lt < 4; ++lt) { f32x4 acc = {0.f, 0.f, 0.f, 0.f};
                    acc = MFMA16(va0, ldfrag(lds + O_S, 16 * lt + fr, 16 * fq), acc); acc = MFMA16(va1, ldfrag(lds + O_S, 16 * lt + fr, 64 + 16 * fq), acc);
                    acc = MFMA16(ca0, ldfrag(lds + O_QA, 16 * lt + fr, 16 * fq), acc); acc = MFMA16(ca1, ldfrag(lds + O_QA, 16 * lt + fr, 64 + 16 * fq), acc); nt[lt] = acc; }
                if (wave >= 4) { const int lt = wave - 4;
                    nd = MFMA16(ldfrag(lds + O_VT, 128 + fr, 16 * fq), ldfrag(lds + O_S, 16 * lt + fr, 16 * fq), nd); nd = MFMA16(ldfrag(lds + O_VT, 128 + fr, 64 + 16 * fq), ldfrag(lds + O_S, 16 * lt + fr, 64 + 16 * fq), nd);
                    nd = MFMA16(ldfrag(cx, 128 + fr, 16 * fq), ldfrag(lds + O_QA, 16 * lt + fr, 16 * fq), nd); nd = MFMA16(ldfrag(cx, 128 + fr, 64 + 16 * fq), ldfrag(lds + O_QA, 16 * lt + fr, 64 + 16 * fq), nd);
                    if (fq == 0) DEN[16 * lt + fr] = nd[0]; }
            }
            v2u mo[4];
#pragma unroll
            for (int lt = 0; lt < 4; ++lt) mo[lt] = *(const GAS v2u*)(P + (tc0 + 16 * lt + fr) * NPROJ + C_MO + h * 128 + 16 * wave + 4 * fq);
            __syncthreads();
#pragma unroll
            for (int lt = 0; lt < 4; ++lt) { const int l = 16 * lt + fr; const float Ml = fmaxf(m, GC[c * 64 + l]);
                const float inv = 1.0f / fmaxf(fabsf(DEN[l]), __expf(-(GB[c * 64 + l] + Ml)));
                nt[lt] = nt[lt] * inv; float ss = (nt[lt][0] * nt[lt][0] + nt[lt][1] * nt[lt][1]) + (nt[lt][2] * nt[lt][2] + nt[lt][3] * nt[lt][3]);
                ss += __shfl_xor(ss, 16); ss += __shfl_xor(ss, 32);
                if (fq == 0) SSQ[wave * 64 + l] = ss; }
            LAS unsigned char* cxn = lds + O_CX + ((c + 1) & 1) * CXB;
#pragma unroll
            for (int j = 0; j < 4; ++j)
#pragma unroll
                for (int r = 0; r < 4; ++r) *(LAS bf16*)(cxn + (16 * wave + 4 * fq + r) * 144 + (16 * j + fr) * 2) = (bf16)f2bf(st[j][r]);
            if (wave < 4) {
#pragma unroll
                for (int r = 0; r < 4; ++r) *(LAS bf16*)(cxn + (128 + 4 * fq + r) * 144 + (16 * wave + fr) * 2) = (bf16)f2bf(st[4][r]); }
            __syncthreads();
#pragma unroll
            for (int lt = 0; lt < 4; ++lt) { const int l = 16 * lt + fr; float tot = 0.f;
#pragma unroll
                for (int w2 = 0; w2 < 8; ++w2) tot += SSQ[w2 * 64 + l];
                const float rn = 1.0f / sqrtf(tot * (1.f / 128.f) + EPS);
                const float o0 = nt[lt][0] * rn * gsc[0] * bflo(mo[lt].x), o1 = nt[lt][1] * rn * gsc[1] * bfhi(mo[lt].x), o2 = nt[lt][2] * rn * gsc[2] * bflo(mo[lt].y), o3 = nt[lt][3] * rn * gsc[3] * bfhi(mo[lt].y);
                v2u w; w.x = pk2(o0, o1); w.y = pk2(o2, o3);
                *(GAS v2u*)(MI + (tc0 + l) * D + 512 + h * 128 + 16 * wave + 4 * fq) = w; }
        } else {
            __syncthreads();
        }
        m = bL + M63; Btot += bL;
    }
    if (!OUT) {
#pragma unroll
        for (int i = 0; i < 5; ++i)
#pragma unroll
            for (int r = 0; r < 4; ++r) MST[((size_t)wg * 20 + i * 4 + r) * NTHR + tid] = st[i][r];
        if (tid == 0) { MSC[wg * 2] = m; MSC[wg * 2 + 1] = Btot; }
    }
}

namespace at {
constexpr int O_K = 0, O_VT = 36864, VTS = 560  , O_END = O_VT + 64 * VTS;
static_assert(O_END <= 131072, "attention LDS");
}
__device__ __forceinline__ void phase_attn(const Args& A, LAS unsigned char* lds) {
    using namespace at;
    const int tid = threadIdx.x, lane = tid & 63, wave = __builtin_amdgcn_readfirstlane(tid >> 6), fr = lane & 15, fq = lane >> 4, G = gridDim.x;
    const bf16* P = (const bf16*)(A.ws + WS_PROJ); bf16* MI = (bf16*)(A.ws + WS_MIXIN); const float* sinks = (const float*)A.in[I_SINK];
    __syncthreads();
    for (int e = tid; e < 64 * 12; e += NTHR) { const int r = e / 12, cpair = e % 12; *(LAS unsigned*)(lds + O_VT + r * VTS + 512 + cpair * 4) = 0u; }
    for (int unit = blockIdx.x; unit < NB * 64 * 2; unit += G) {
        const int g = unit & 1, n = (unit >> 1) & 63, b = unit >> 7;
        const size_t tq0 = (size_t)b * SEQ + (size_t)n * 128;
        __syncthreads();
#pragma unroll
        for (int i = 0; i < 4; ++i) { const int item = tid + NTHR * i, row = item >> 3, ch = item & 7;
            v4u wk = {0u, 0u, 0u, 0u}, wv = {0u, 0u, 0u, 0u};
            if (n > 0 || row >= 128) { const bf16* rp = P + (tq0 - 128 + row) * NPROJ; wk = *(const GAS v4u*)(rp + C_AK + g * 64 + 8 * ch); wv = *(const GAS v4u*)(rp + C_AV + g * 64 + 8 * ch); }
            *(LAS v4u*)(lds + O_K + row * 144 + ch * 16) = wk;
            const unsigned ww[4] = {wv.x, wv.y, wv.z, wv.w};
#pragma unroll
            for (int k = 0; k < 4; ++k) { *(LAS bf16*)(lds + O_VT + (8 * ch + 2 * k) * VTS + row * 2) = (bf16)(ww[k] & 0xffffu); *(LAS bf16*)(lds + O_VT + (8 * ch + 2 * k + 1) * VTS + row * 2) = (bf16)(ww[k] >> 16); } }
        const int hq = 4 * g + (wave >> 1), qr0 = 64 * (wave & 1); const float sink = sinks[hq];
        __syncthreads();
        for (int qt = 0; qt < 4; ++qt) {
            const int i0 = qr0 + 16 * qt, st0 = i0 >> 4, iq = i0 + fr;
            const bf16* qp = P + (tq0 + iq) * NPROJ + C_AQ + hq * 64 + 8 * fq;
            const bf16x8 bq0 = *(const GAS bf16x8*)qp, bq1 = *(const GAS bf16x8*)(qp + 32);
            f32x4 sc[9]; float mx = sink;
#pragma unroll
            for (int t = 0; t < 9; ++t) { const int sb0 = 16 * (st0 + t); f32x4 acc = {0.f, 0.f, 0.f, 0.f};
                acc = MFMA16(ldfrag(lds + O_K, sb0 + fr, 16 * fq), bq0, acc); acc = MFMA16(ldfrag(lds + O_K, sb0 + fr, 64 + 16 * fq), bq1, acc);
#pragma unroll
                for (int r = 0; r < 4; ++r) { const int sb = sb0 + 4 * fq + r; const bool valid = (sb > iq) && (sb <= iq + 128) && (n > 0 || sb >= 128);
                    acc[r] = valid ? acc[r] : -3.0e38f; mx = fmaxf(mx, acc[r]); }
                sc[t] = acc; }
            mx = fmaxf(mx, __shfl_xor(mx, 16)); mx = fmaxf(mx, __shfl_xor(mx, 32));
            float lsum = 0.f;
#pragma unroll
            for (int t = 0; t < 9; ++t)
#pragma unroll
                for (int r = 0; r < 4; ++r) { const float p = (sc[t][r] > -1.0e38f) ? __expf(sc[t][r] - mx) : 0.f; sc[t][r] = p; lsum += p; }
            lsum += __shfl_xor(lsum, 16); lsum += __shfl_xor(lsum, 32); lsum += __expf(sink - mx);
            f32x4 oacc[4];
#pragma unroll
            for (int dt = 0; dt < 4; ++dt) oacc[dt] = (f32x4){0.f, 0.f, 0.f, 0.f};
#pragma unroll
            for (int ks = 0; ks < 5; ++ks) {
                union { bf16x8 v; unsigned u[4]; } pb;
                pb.u[0] = cvtpk(sc[2 * ks][0], sc[2 * ks][1]); pb.u[1] = cvtpk(sc[2 * ks][2], sc[2 * ks][3]);
                if (ks < 4) { pb.u[2] = cvtpk(sc[2 * ks + 1][0], sc[2 * ks + 1][1]); pb.u[3] = cvtpk(sc[2 * ks + 1][2], sc[2 * ks + 1][3]); } else { pb.u[2] = 0u; pb.u[3] = 0u; }
                const int sbb = 16 * (st0 + 2 * ks) + 4 * fq;
#pragma unroll
                for (int dt = 0; dt < 4; ++dt) { LAS const unsigned char* vp = lds + O_VT + (16 * dt + fr) * VTS + sbb * 2;
                    union { bf16x8 v; v2u h[2]; } va; va.h[0] = *(LAS const v2u*)vp; va.h[1] = *(LAS const v2u*)(vp + 32);
                    oacc[dt] = MFMA16(va.v, pb.v, oacc[dt]); } }
            const float il = 1.0f / lsum;
#pragma unroll
            for (int dt = 0; dt < 4; ++dt) { v2u w; w.x = pk2(oacc[dt][0] * il, oacc[dt][1] * il); w.y = pk2(oacc[dt][2] * il, oacc[dt][3] * il);
                *(GAS v2u*)(MI + (tq0 + iq) * D + hq * 64 + 16 * dt + 4 * fq) = w; }
        }
    }
}
typedef float f32x16 __attribute__((ext_vector_type(16)));
__device__ __forceinline__ unsigned fbits(float f) { return __builtin_bit_cast(unsigned, f); }
__device__ __forceinline__ float bfloat(unsigned u) { return __builtin_bit_cast(float, u); }

#define CE_DESC(a, b) do { const float _mx = __builtin_fmaxf(a, b), _mn = __builtin_fminf(a, b); a = _mx; b = _mn; } while (0)
__device__ __forceinline__ void bsort16(float (&v)[16]) {
#pragma unroll
    for (int k = 2; k <= 16; k <<= 1)
#pragma unroll
        for (int j = k >> 1; j > 0; j >>= 1)
#pragma unroll
            for (int i = 0; i < 16; ++i) { const int l = i ^ j; if (l > i) { if ((i & k) == 0) CE_DESC(v[i], v[l]); else CE_DESC(v[l], v[i]); } }
}
__device__ __forceinline__ void bmerge16(float (&v)[16], const float (&w)[16]) {
#pragma unroll
    for (int i = 0; i < 16; ++i) v[i] = __builtin_fmaxf(v[i], w[15 - i]);
#pragma unroll
    for (int j = 8; j > 0; j >>= 1)
#pragma unroll
        for (int i = 0; i < 16; ++i) { const int l = i ^ j; if (l > i) CE_DESC(v[i], v[l]); }
}
namespace tk {
constexpr int KS = 272;
constexpr int O_K1 = 0, O_K2 = 128 * KS, O_X = 2 * 128 * KS, O_END = O_X + 8 * 4096;
static_assert(O_END <= 131072, "topk LDS");
constexpr unsigned char CAND[64] = {
    0x00, 0x01, 0x02, 0x03, 0x04, 0x05, 0x06, 0x07, 0x08, 0x09, 0x0a, 0x0b, 0x0c, 0x0d, 0x0e, 0x0f,
    0x10, 0x11, 0x12, 0x13, 0x14, 0x15, 0x16, 0x17, 0x80, 0x90, 0xa0, 0xb0, 0xc0, 0xd0, 0xe0, 0xf0,
    0x20, 0x21, 0x22, 0x23, 0x24, 0x30, 0x31, 0x32, 0x33, 0x40, 0x41, 0x42, 0x50, 0x51, 0x60, 0x61,
    0x70, 0x71, 0xff, 0xff, 0xff, 0xff, 0xff, 0xff, 0xff, 0xff, 0xff, 0xff, 0xff, 0xff, 0xff, 0xff};
}
__device__ __forceinline__ void side_top16(const f32x16 (&acc)[4], int hh, float (&T)[16]) {
    float g1[16], g2[16];
#pragma unroll
    for (int r = 0; r < 16; ++r) { const unsigned key = (r & 3) + 8 * (r >> 2) + 4 * hh;
        T[r] = bfloat((fbits(acc[0][r]) & 0xffffff80u) | key);
        g1[r] = bfloat((fbits(acc[1][r]) & 0xffffff80u) | (32u + key)); }
    bsort16(T); bsort16(g1); bmerge16(T, g1);
#pragma unroll
    for (int r = 0; r < 16; ++r) { const unsigned key = (r & 3) + 8 * (r >> 2) + 4 * hh;
        g1[r] = bfloat((fbits(acc[2][r]) & 0xffffff80u) | (64u + key));
        g2[r] = bfloat((fbits(acc[3][r]) & 0xffffff80u) | (96u + key)); }
    bsort16(g1); bsort16(g2); bmerge16(g1, g2); bmerge16(T, g1);
#pragma unroll
    for (int r = 0; r < 16; ++r) g1[r] = __shfl_xor(T[r], 32);
    bmerge16(T, g1);
}
template <int SD> __device__ __forceinline__ void topk_side(const bf16* Q, LAS unsigned char* lds, int t, int h, int r32, int hh, float (&T)[16]) {
    using namespace tk;
    f32x16 acc[4];
#pragma unroll
    for (int mt = 0; mt < 4; ++mt)
#pragma unroll
        for (int r = 0; r < 16; ++r) acc[mt][r] = 0.f;
    const bf16* qp = Q + (size_t)t * 2048 + h * 256 + SD * 128 + 8 * hh; LAS const unsigned char* kimg = lds + (SD ? O_K2 : O_K1);
#pragma unroll
    for (int ks = 0; ks < 8; ++ks) { const bf16x8 bq = *(const GAS bf16x8*)(qp + 16 * ks);
#pragma unroll
        for (int mt = 0; mt < 4; ++mt) acc[mt] = __builtin_amdgcn_mfma_f32_32x32x16_bf16(*(LAS const bf16x8*)(kimg + (32 * mt + r32) * KS + 32 * ks + 16 * hh), bq, acc[mt], 0, 0, 0); }
    side_top16(acc, hh, T);
}
template <int Q> __device__ __forceinline__ float cand_val(const float (&T1)[16], const float (&T2)[16], int hh) {
    constexpr unsigned c0 = tk::CAND[2 * Q], c1 = tk::CAND[2 * Q + 1];
    const float s = (hh ? T1[(c1 >> 4) & 15] : T1[(c0 >> 4) & 15]) + (hh ? T2[c1 & 15] : T2[c0 & 15]); const unsigned code = hh ? c1 : c0;
    return (code == 0xffu) ? -3.0e38f : bfloat((fbits(s) & 0xffffff00u) | code);
}
__device__ __forceinline__ void phase_topk(const Args& A, LAS unsigned char* lds) {
    using namespace tk;
    const int tid = threadIdx.x, lane = tid & 63, wave = __builtin_amdgcn_readfirstlane(tid >> 6), G = gridDim.x;
    const bf16* Q = (const bf16*)(A.ws + WS_PROJ); const bf16* KB = (const bf16*)(A.ws + WS_KEYS);
    unsigned short* EI = (unsigned short*)(A.ws + WS_EIDX); float* GT = (float*)(A.ws + WS_GATE);
    const int h = blockIdx.x & 7, r32 = lane & 31, hh = lane >> 5;
    __syncthreads();
    for (int e = tid; e < 2 * 128 * 16; e += NTHR) { const int s = e >> 11, row = (e >> 4) & 127, ch = e & 15;
        *(LAS v4u*)(lds + (s ? O_K2 : O_K1) + row * KS + ch * 16) = *(const GAS v4u*)(KB + (size_t)s * 8 * 128 * 128 + ((size_t)h * 128 + row) * 128 + ch * 8); }
    __syncthreads();
    LAS float* XW = (LAS float*)(lds + O_X + wave * 4096) + r32 * 32;
    for (int tile = (int)(blockIdx.x >> 3); tile < M / 256; tile += (G >> 3)) {
        const int t = tile * 256 + 32 * wave + r32;
        float T1[16], T2[16];
        topk_side<0>(Q, lds, t, h, r32, hh, T1);
        topk_side<1>(Q, lds, t, h, r32, hh, T2);
        float c[16], w[16];
        c[0] = cand_val<0>(T1, T2, hh); w[0] = cand_val<16>(T1, T2, hh);
        c[1] = cand_val<1>(T1, T2, hh); w[1] = cand_val<17>(T1, T2, hh);
        c[2] = cand_val<2>(T1, T2, hh); w[2] = cand_val<18>(T1, T2, hh);
        c[3] = cand_val<3>(T1, T2, hh); w[3] = cand_val<19>(T1, T2, hh);
        c[4] = cand_val<4>(T1, T2, hh); w[4] = cand_val<20>(T1, T2, hh);
        c[5] = cand_val<5>(T1, T2, hh); w[5] = cand_val<21>(T1, T2, hh);
        c[6] = cand_val<6>(T1, T2, hh); w[6] = cand_val<22>(T1, T2, hh);
        c[7] = cand_val<7>(T1, T2, hh); w[7] = cand_val<23>(T1, T2, hh);
        c[8] = cand_val<8>(T1, T2, hh); w[8] = cand_val<24>(T1, T2, hh);
        c[9] = cand_val<9>(T1, T2, hh); w[9] = cand_val<25>(T1, T2, hh);
        c[10] = cand_val<10>(T1, T2, hh); w[10] = cand_val<26>(T1, T2, hh);
        c[11] = cand_val<11>(T1, T2, hh); w[11] = cand_val<27>(T1, T2, hh);
        c[12] = cand_val<12>(T1, T2, hh); w[12] = cand_val<28>(T1, T2, hh);
        c[13] = cand_val<13>(T1, T2, hh); w[13] = cand_val<29>(T1, T2, hh);
        c[14] = cand_val<14>(T1, T2, hh); w[14] = cand_val<30>(T1, T2, hh);
        c[15] = cand_val<15>(T1, T2, hh); w[15] = cand_val<31>(T1, T2, hh);
        bsort16(c); bsort16(w); bmerge16(c, w);
#pragma unroll
        for (int r = 0; r < 16; ++r) w[r] = __shfl_xor(c[r], 32);
        bmerge16(c, w);
        if (hh == 0) {
#pragma unroll
            for (int q4 = 0; q4 < 4; ++q4) { *(LAS f32x4*)(XW + 4 * q4) = (f32x4){T1[4 * q4], T1[4 * q4 + 1], T1[4 * q4 + 2], T1[4 * q4 + 3]};
                *(LAS f32x4*)(XW + 16 + 4 * q4) = (f32x4){T2[4 * q4], T2[4 * q4 + 1], T2[4 * q4 + 2], T2[4 * q4 + 3]}; } }
        asm volatile("s_waitcnt lgkmcnt(0)" ::: "memory");
        float ex[16], sum = 0.f; const float tmax = bfloat(fbits(c[0]) & 0xffffff00u);
#pragma unroll
        for (int r = 0; r < 16; ++r) { ex[r] = __expf(bfloat(fbits(c[r]) & 0xffffff00u) - tmax); sum += ex[r]; }
        const float isum = 1.0f / sum; const size_t ob = (size_t)t * NSLOT + (size_t)(8 * hh) * 8 + h;
#pragma unroll
        for (int r = 0; r < 8; ++r) { float ca = c[r], cb = c[8 + r], ea = ex[r], eb = ex[8 + r]; asm volatile("" : "+v"(ca), "+v"(cb), "+v"(ea), "+v"(eb)); const float cv = hh ? cb : ca, ev = hh ? eb : ea;
            const unsigned code = fbits(cv) & 0xffu;
            const unsigned i1 = fbits(XW[code >> 4]) & 127u, i2 = fbits(XW[16 + (code & 15)]) & 127u;
            EI[ob + 8 * r] = (unsigned short)(i1 * 128u + i2); GT[ob + 8 * r] = ev * isum; }
        asm volatile("s_waitcnt lgkmcnt(0)" ::: "memory");
    }
}
struct PeerIdx { v4u e0, e1; };
__device__ __forceinline__ PeerIdx peer_ld_idx(const unsigned short* EI, int t, int g) { PeerIdx r; r.e0 = *(const GAS v4u*)(EI + (size_t)t * NSLOT + 16 * g); r.e1 = *(const GAS v4u*)(EI + (size_t)t * NSLOT + 16 * g + 8); return r; }
template <int ROWB = 1024> __device__ __forceinline__ void peer_gather(const unsigned char* T8, const PeerIdx& ix, int colb, v4u (&raw)[16]) {
    const unsigned ew[8] = {ix.e0.x, ix.e0.y, ix.e0.z, ix.e0.w, ix.e1.x, ix.e1.y, ix.e1.z, ix.e1.w};
#pragma unroll
    for (int k = 0; k < 16; ++k) { const unsigned e = (k & 1) ? (ew[k >> 1] >> 16) : (ew[k >> 1] & 0xffffu); raw[k] = *(const GAS v4u*)(T8 + (size_t)e * ROWB + colb); }
}
__device__ __forceinline__ void cvt16_fp8_pk(const v4u w, f32x2 (&o)[8]) {
    const unsigned ww[4] = {w.x, w.y, w.z, w.w};
#pragma unroll
    for (int i = 0; i < 4; ++i) { o[2 * i] = __builtin_amdgcn_cvt_pk_f32_fp8((int)ww[i], false); o[2 * i + 1] = __builtin_amdgcn_cvt_pk_f32_fp8((int)ww[i], true); }
}
__device__ __forceinline__ void peer_u_reduce(const v4u (&raw)[16], const f32x2 (&hv)[8], float* PDrow, int lane, int g, int c) {
    float d[16];
#pragma unroll
    for (int k = 0; k < 16; ++k) { f32x2 uf[8]; cvt16_fp8_pk(raw[k], uf); f32x2 s = uf[0] * hv[0];
#pragma unroll
        for (int i = 1; i < 8; ++i) s += uf[i] * hv[i];
        d[k] = s.x + s.y; }
#pragma unroll
    for (int i = 0; i < 8; ++i) { const bool up = (lane & 4) != 0; const float keep = up ? d[i + 8] : d[i], send = up ? d[i] : d[i + 8]; d[i] = keep + __shfl_xor(send, 4); }
#pragma unroll
    for (int i = 0; i < 4; ++i) { const bool up = (lane & 2) != 0; const float keep = up ? d[i + 4] : d[i], send = up ? d[i] : d[i + 4]; d[i] = keep + __shfl_xor(send, 2); }
#pragma unroll
    for (int i = 0; i < 2; ++i) { const bool up = (lane & 1) != 0; const float keep = up ? d[i + 2] : d[i], send = up ? d[i] : d[i + 2]; d[i] = keep + __shfl_xor(send, 1); }
    *(GAS f32x2*)(PDrow + 16 * g + 2 * c) = (f32x2){d[0], d[1]};
}
__device__ __forceinline__ void ld16bf_pk(const bf16* p, f32x2 (&o)[8]) {
    const v4u w0 = *(const GAS v4u*)p, w1 = *(const GAS v4u*)(p + 8); const unsigned ww[8] = {w0.x, w0.y, w0.z, w0.w, w1.x, w1.y, w1.z, w1.w};
#pragma unroll
    for (int i = 0; i < 8; ++i) o[i] = (f32x2){bflo(ww[i]), bfhi(ww[i])};
}
__device__ __forceinline__ void peer_u_reduce_i4(const v4u (&raw)[16], const v4u hh, const v4u hl, int* PDrow, int lane, int g, int c) {
    int d[16];
#pragma unroll
    for (int k = 0; k < 16; ++k) { int sh = __builtin_amdgcn_sdot8((int)raw[k].x, (int)hh.x, 0, false), sl = __builtin_amdgcn_sdot8((int)raw[k].x, (int)hl.x, 0, false);
        sh = __builtin_amdgcn_sdot8((int)raw[k].y, (int)hh.y, sh, false); sl = __builtin_amdgcn_sdot8((int)raw[k].y, (int)hl.y, sl, false);
        sh = __builtin_amdgcn_sdot8((int)raw[k].z, (int)hh.z, sh, false); sl = __builtin_amdgcn_sdot8((int)raw[k].z, (int)hl.z, sl, false);
        sh = __builtin_amdgcn_sdot8((int)raw[k].w, (int)hh.w, sh, false); sl = __builtin_amdgcn_sdot8((int)raw[k].w, (int)hl.w, sl, false);
        d[k] = 16 * sh + sl; }
#pragma unroll
    for (int i = 0; i < 8; ++i) { const bool up = (lane & 4) != 0; const int keep = up ? d[i + 8] : d[i], send = up ? d[i] : d[i + 8]; d[i] = keep + __shfl_xor(send, 4); }
#pragma unroll
    for (int i = 0; i < 4; ++i) { const bool up = (lane & 2) != 0; const int keep = up ? d[i + 4] : d[i], send = up ? d[i] : d[i + 4]; d[i] = keep + __shfl_xor(send, 2); }
#pragma unroll
    for (int i = 0; i < 2; ++i) { const bool up = (lane & 1) != 0; const int keep = up ? d[i + 2] : d[i], send = up ? d[i] : d[i + 2]; d[i] = keep + __shfl_xor(send, 1); }
    *(GAS v2u*)(PDrow + 16 * g + 2 * c) = (v2u){(unsigned)d[0], (unsigned)d[1]};
}
__device__ __forceinline__ void phase_peer_u(const Args& A) {
    const int tid = threadIdx.x, lane = tid & 63, wave = tid >> 6, p = blockIdx.x & 7, q = p & 3, half = p >> 2, j = blockIdx.x >> 3, nj = gridDim.x >> 3, g = lane >> 3, c = lane & 7;
    const unsigned char* HH = (const unsigned char*)(A.ws + WS_H8); const unsigned char* HL = HH + 32 * MiB; const unsigned char* U4 = (const unsigned char*)(A.ws + WS_U8); const unsigned short* EI = (const unsigned short*)(A.ws + WS_EIDX);
    int* PD = (int*)(A.ws + WS_PD) + (size_t)q * M * NSLOT;
    const int tper = (M / 2) / nj, colb = 128 * q + 16 * c, tbeg = half * (M / 2) + j * tper, tend = tbeg + tper, tlast = tend - NWAVES + wave;
    int t = tbeg + wave;
    PeerIdx ix1 = peer_ld_idx(EI, min(t + NWAVES, tlast), g), ix2 = peer_ld_idx(EI, min(t + 2 * NWAVES, tlast), g);
    v4u rawa[16], rawb[16], hha, hla, hhb, hlb;
    { const PeerIdx ix0 = peer_ld_idx(EI, t, g); peer_gather<512>(U4, ix0, colb, rawa); hha = *(const GAS v4u*)(HH + (size_t)t * 512 + colb); hla = *(const GAS v4u*)(HL + (size_t)t * 512 + colb); }
    for (; t < tend; t += 2 * NWAVES) {
        const int t1 = t + NWAVES, t2 = min(t + 2 * NWAVES, tlast), t3 = min(t + 3 * NWAVES, tlast), t4 = min(t + 4 * NWAVES, tlast);
        const PeerIdx ix3 = peer_ld_idx(EI, t3, g);
        peer_gather<512>(U4, ix1, colb, rawb); hhb = *(const GAS v4u*)(HH + (size_t)t1 * 512 + colb); hlb = *(const GAS v4u*)(HL + (size_t)t1 * 512 + colb);
        peer_u_reduce_i4(rawa, hha, hla, PD + (size_t)t * NSLOT, lane, g, c);
        const PeerIdx ix4 = peer_ld_idx(EI, t4, g);
        peer_gather<512>(U4, ix2, colb, rawa); hha = *(const GAS v4u*)(HH + (size_t)t2 * 512 + colb); hla = *(const GAS v4u*)(HL + (size_t)t2 * 512 + colb);
        peer_u_reduce_i4(rawb, hhb, hlb, PD + (size_t)t1 * NSLOT, lane, g, c);
        ix1 = ix3; ix2 = ix4;
    }
}
__device__ __forceinline__ void phase_peer_act(const Args& A) {
    const int* PD = (const int*)(A.ws + WS_PD); const unsigned short* EI = (const unsigned short*)(A.ws + WS_EIDX); const float* GT = (const float*)(A.ws + WS_GATE);
    const float* usc = (const float*)(A.ws + WS_SC); const float* vsc = usc + NEXP; const float* hs = (const float*)(A.ws + WS_HS); float* ACT = (float*)(A.ws + WS_ACT);
    for (size_t i = (size_t)blockIdx.x * NTHR + threadIdx.x; i < (size_t)M * NSLOT; i += (size_t)gridDim.x * NTHR) {
        int si = 0;
#pragma unroll
        for (int p = 0; p < 4; ++p) si += PD[(size_t)p * M * NSLOT + i];
        const unsigned e = EI[i]; float s = (float)si * (usc[e] * hs[i >> 7]);
        ACT[i] = 0.5f * s * (1.f + erff(s * 0.70710678118654752f)) * GT[i] * vsc[e];
    }
}
struct PeerAct { f32x4 a0, a1, a2, a3; };
__device__ __forceinline__ PeerAct peer_ld_act(const float* ACT, int t, int g) { const GAS f32x4* ap = (const GAS f32x4*)(ACT + (size_t)t * NSLOT + 16 * g); PeerAct r; r.a0 = ap[0]; r.a1 = ap[1]; r.a2 = ap[2]; r.a3 = ap[3]; return r; }
__device__ __forceinline__ void peer_v_accum(const v4u (&raw)[16], const PeerAct& pa, f32x2 (&y2)[16]) {
    const float av[16] = {pa.a0[0], pa.a0[1], pa.a0[2], pa.a0[3], pa.a1[0], pa.a1[1], pa.a1[2], pa.a1[3], pa.a2[0], pa.a2[1], pa.a2[2], pa.a2[3], pa.a3[0], pa.a3[1], pa.a3[2], pa.a3[3]};
#pragma unroll
    for (int k = 0; k < 16; ++k) { const unsigned ww[4] = {raw[k].x, raw[k].y, raw[k].z, raw[k].w}; const f32x2 a2 = (f32x2){av[k], av[k]};
#pragma unroll
        for (int w = 0; w < 4; ++w) { y2[4 * w + 0] += a2 * __builtin_amdgcn_cvt_scalef32_pk_f32_fp4(ww[w], 1.0f, 0); y2[4 * w + 1] += a2 * __builtin_amdgcn_cvt_scalef32_pk_f32_fp4(ww[w], 1.0f, 1);
            y2[4 * w + 2] += a2 * __builtin_amdgcn_cvt_scalef32_pk_f32_fp4(ww[w], 1.0f, 2); y2[4 * w + 3] += a2 * __builtin_amdgcn_cvt_scalef32_pk_f32_fp4(ww[w], 1.0f, 3); } }
}
__device__ __forceinline__ void peer_v_store(f32x2 (&y2)[16], bf16* Yp, float* ssy, int c) {
    float ss = 0.f; unsigned w[16];
#pragma unroll
    for (int i = 0; i < 16; ++i) { ss += y2[i].x * y2[i].x + y2[i].y * y2[i].y; w[i] = pk2(y2[i].x, y2[i].y); y2[i] = (f32x2){0.f, 0.f}; }
#pragma unroll
    for (int i = 0; i < 4; ++i) *(GAS v4u*)(Yp + 8 * i) = (v4u){w[4 * i], w[4 * i + 1], w[4 * i + 2], w[4 * i + 3]};
    ss += __shfl_xor(ss, 1); ss += __shfl_xor(ss, 2); ss += __shfl_xor(ss, 4);
    if (c == 0) *ssy = ss;
}
__device__ __forceinline__ void phase_peer_v(const Args& A) {
    const int tid = threadIdx.x, lane = tid & 63, wave = tid >> 6, p = blockIdx.x & 7, q = p & 3, half = p >> 2, j = blockIdx.x >> 3, nj = gridDim.x >> 3, g = lane >> 3, c = lane & 7;
    const unsigned char* V4 = (const unsigned char*)(A.ws + WS_V8); const unsigned short* EI = (const unsigned short*)(A.ws + WS_EIDX); const float* ACT = (const float*)(A.ws + WS_ACT);
    bf16* Y = (bf16*)(A.ws + WS_H); float* SSY = (float*)(A.ws + WS_SSY);
    const int tper = (M / 2) / nj, colb = 128 * q + 16 * c, tbeg = half * (M / 2) + j * tper + wave * (tper / NWAVES);
    const int nstep = (tper / NWAVES / 8) * 8;
    auto rowof = [&](int s) { s = min(s, nstep - 1); return (size_t)(tbeg + 8 * (s >> 3) + g) * 8 + (s & 7); };
    f32x2 y2[16];
#pragma unroll
    for (int i = 0; i < 16; ++i) y2[i] = (f32x2){0.f, 0.f};
    auto ldidx = [&](int s) { const size_t r = rowof(s); PeerIdx x; x.e0 = *(const GAS v4u*)(EI + r * 16); x.e1 = *(const GAS v4u*)(EI + r * 16 + 8); return x; };
    auto ldact = [&](int s) { const GAS f32x4* ap = (const GAS f32x4*)(ACT + rowof(s) * 16); PeerAct r; r.a0 = ap[0]; r.a1 = ap[1]; r.a2 = ap[2]; r.a3 = ap[3]; return r; };
    PeerIdx ix1 = ldidx(1), ix2 = ldidx(2);
    v4u rawa[16], rawb[16]; PeerAct aca, acb;
    { const PeerIdx ix0 = ldidx(0); peer_gather<512>(V4, ix0, colb, rawa); aca = ldact(0); }
    for (int s = 0; s < nstep; s += 2) {
        const PeerIdx ix3 = ldidx(s + 3);
        peer_gather<512>(V4, ix1, colb, rawb); acb = ldact(s + 1);
        peer_v_accum(rawa, aca, y2);
        const PeerIdx ix4 = ldidx(s + 4);
        peer_gather<512>(V4, ix2, colb, rawa); aca = ldact(s + 2);
        peer_v_accum(rawb, acb, y2);
        if ((s & 7) == 6) { const int t = tbeg + 8 * (s >> 3) + g; peer_v_store(y2, Y + (size_t)t * D + 256 * q + 32 * c, SSY + (size_t)t * 8 + q, c); }
        ix1 = ix3; ix2 = ix4;
    }
}
__device__ __forceinline__ void phase_peer_final(const Args& A) {
    const int tid = threadIdx.x, lane = tid & 63, wave = tid >> 6, G = gridDim.x;
    const bf16* Y = (const bf16*)(A.ws + WS_H); const bf16* X1 = (const bf16*)(A.ws + WS_X1); const float* SSY = (const float*)(A.ws + WS_SSY); const float* mod = (const float*)(A.ws + WS_MOD); const float* gpost = (const float*)A.in[I_GPOST2]; float* out = A.out;
    for (int row = blockIdx.x * NWAVES + wave; row < M; row += G * NWAVES) {
        const int b = row / SEQ; const f32x4 s0 = *(const GAS f32x4*)(SSY + (size_t)row * 8);
        const float rstd = 1.0f / sqrtf(((s0[0] + s0[1]) + (s0[2] + s0[3])) * (1.f / D) + EPS);
        GAS f32x4* orow = (GAS f32x4*)(out + (size_t)row * D) + lane; const GAS v2u* yr = (const GAS v2u*)(Y + (size_t)row * D) + lane; const GAS v2u* xr = (const GAS v2u*)(X1 + (size_t)row * D) + lane;
#pragma unroll
        for (int q = 0; q < 4; ++q) { const int k = 4 * (lane + 64 * q); const v2u xw = xr[64 * q]; f32x4 xv = {bflo(xw.x), bfhi(xw.x), bflo(xw.y), bfhi(xw.y)}; const v2u yw = yr[64 * q];
            const f32x4 g2 = *(const GAS f32x4*)(mod + b * 6144 + 5120 + k), gp = *(const GAS f32x4*)(gpost + k);
            xv[0] += g2[0] * (bflo(yw.x) * rstd * gp[0]); xv[1] += g2[1] * (bfhi(yw.x) * rstd * gp[1]); xv[2] += g2[2] * (bflo(yw.y) * rstd * gp[2]); xv[3] += g2[3] * (bfhi(yw.y) * rstd * gp[3]);
            orow[64 * q] = xv; }
    }
}

#ifdef PROBE_V_LOADS
__device__ __forceinline__ void probe_v_loads(const Args& A) {
    const int tid = threadIdx.x, lane = tid & 63, wave = tid >> 6, p = blockIdx.x & 7, j = blockIdx.x >> 3, nj = gridDim.x >> 3, g = lane >> 3, c = lane & 7;
    const unsigned char* V8 = (const unsigned char*)(A.ws + WS_V8); const unsigned short* EI = (const unsigned short*)(A.ws + WS_EIDX); const float* ACT = (const float*)(A.ws + WS_ACT);
    unsigned* DUMP = (unsigned*)(A.ws + WS_PD);
    const int tper = M / nj, colb = 128 * p + 16 * c, tend = (j + 1) * tper, tlast = tend - NWAVES + wave;
    int t = j * tper + wave;
    PeerIdx ix1 = peer_ld_idx(EI, min(t + NWAVES, tlast), g), ix2 = peer_ld_idx(EI, min(t + 2 * NWAVES, tlast), g);
    v4u rawa[16], rawb[16]; PeerAct aca, acb;
    { const PeerIdx ix0 = peer_ld_idx(EI, t, g); peer_gather(V8, ix0, colb, rawa); aca = peer_ld_act(ACT, t, g); }
    for (; t < tend; t += 2 * NWAVES) {
        const int t1 = t + NWAVES, t2 = min(t + 2 * NWAVES, tlast), t3 = min(t + 3 * NWAVES, tlast), t4 = min(t + 4 * NWAVES, tlast);
        const PeerIdx ix3 = peer_ld_idx(EI, t3, g);
        peer_gather(V8, ix1, colb, rawb); acb = peer_ld_act(ACT, t1, g);
        { unsigned s = __builtin_bit_cast(unsigned, aca.a0[0]) + __builtin_bit_cast(unsigned, aca.a3[3]);
#pragma unroll
          for (int k = 0; k < 16; ++k) s += (rawa[k].x + rawa[k].y) + (rawa[k].z + rawa[k].w);
          DUMP[(size_t)t * 512 + p * 64 + lane] = s; }
        const PeerIdx ix4 = peer_ld_idx(EI, t4, g);
        peer_gather(V8, ix2, colb, rawa); aca = peer_ld_act(ACT, t2, g);
        { unsigned s = __builtin_bit_cast(unsigned, acb.a0[0]) + __builtin_bit_cast(unsigned, acb.a3[3]);
#pragma unroll
          for (int k = 0; k < 16; ++k) s += (rawb[k].x + rawb[k].y) + (rawb[k].z + rawb[k].w);
          DUMP[(size_t)t1 * 512 + p * 64 + lane] = s; }
        ix1 = ix3; ix2 = ix4;
    }
}
#endif

#ifdef PROBE_INSTR
__device__ __forceinline__ void probe_instr(const Args& A) {
    f32x2 a[8]; float f[16]; unsigned w = threadIdx.x * 0x01010101u + 0x38383838u;
#pragma unroll
    for (int i = 0; i < 8; ++i) a[i] = (f32x2){1.0f + i, 2.0f + i};
#pragma unroll
    for (int i = 0; i < 16; ++i) f[i] = 1.0f + i;
    for (int it = 0; it < 10000; ++it) {
#if PROBE_INSTR == 1
#pragma unroll
        for (int i = 0; i < 8; ++i) { asm volatile("v_pk_fma_f32 %0, %1, %2, %0" : "+v"(a[i]) : "v"(a[(i + 1) & 7]), "v"(a[(i + 2) & 7])); asm volatile("v_pk_fma_f32 %0, %1, %2, %0" : "+v"(a[i]) : "v"(a[(i + 3) & 7]), "v"(a[(i + 4) & 7])); }
#elif PROBE_INSTR == 2
#pragma unroll
        for (int i = 0; i < 16; ++i) asm volatile("v_fma_f32 %0, %1, %2, %0" : "+v"(f[i]) : "v"(f[(i + 1) & 15]), "v"(f[(i + 2) & 15]));
#elif PROBE_INSTR == 3
#pragma unroll
        for (int i = 0; i < 8; ++i) { asm volatile("v_cvt_pk_f32_fp8 %0, %1" : "=v"(a[i]) : "v"(w)); asm volatile("v_cvt_pk_f32_fp8 %0, %1" : "=v"(a[i]) : "v"(w)); }
#elif PROBE_INSTR == 4
#pragma unroll
        for (int i = 0; i < 8; ++i) { asm volatile("v_cvt_scalef32_pk_f32_fp4 %0, %1, 1.0" : "=v"(a[i]) : "v"(w)); asm volatile("v_cvt_scalef32_pk_f32_fp4 %0, %1, 1.0" : "=v"(a[i]) : "v"(w)); }
#elif PROBE_INSTR == 5
#pragma unroll
        for (int i = 0; i < 16; ++i) asm volatile("v_pk_fma_f16 %0, %1, %2, %0" : "+v"(f[i]) : "v"(f[(i + 1) & 15]), "v"(f[(i + 2) & 15]));
#elif PROBE_INSTR == 7
#pragma unroll
        for (int i = 0; i < 16; ++i) asm volatile("v_dot8c_i32_i4 %0, %1, %2" : "+v"(f[i]) : "v"(f[(i + 1) & 15]), "v"(w));
#elif PROBE_INSTR == 8
#pragma unroll
        for (int i = 0; i < 16; ++i) asm volatile("v_dot4c_i32_i8 %0, %1, %2" : "+v"(f[i]) : "v"(f[(i + 1) & 15]), "v"(w));
#elif PROBE_INSTR == 9
#pragma unroll
        for (int i = 0; i < 16; ++i) asm volatile("v_perm_b32 %0, %1, %2, %3" : "=v"(f[i]) : "v"(f[(i + 1) & 15]), "v"(f[(i + 2) & 15]), "v"(w));
#elif PROBE_INSTR == 10
#pragma unroll
        for (int i = 0; i < 16; ++i) asm volatile("v_mfma_f32_16x16x32_fp8_fp8 %0, %1, %2, %0" : "+v"(*(f32x4*)&f[4 * (i & 3)]) : "v"(a[i & 7]), "v"(a[(i + 1) & 7]));
#elif PROBE_INSTR == 6
#pragma unroll
        for (int i = 0; i < 16; ++i) asm volatile("v_cvt_scalef32_pk_f16_fp4 %0, %1, 1.0" : "=v"(f[i]) : "v"(w));
#endif
    }
    float s = 0.f;
#pragma unroll
    for (int i = 0; i < 8; ++i) s += a[i].x + a[i].y;
#pragma unroll
    for (int i = 0; i < 16; ++i) s += f[i];
    if (s == 123.456f) ((float*)(A.ws + WS_PD))[threadIdx.x] = s;
}
#endif
#ifndef MK_N_LAUNCHES
#define MK_N_LAUNCHES 1
#endif
constexpr int N_PHASES = 13;
typedef const __attribute__((address_space(4))) Args* KArgP;
__device__ __forceinline__ const Args& kargs() { KArgP p = (KArgP)__builtin_amdgcn_kernarg_segment_ptr(); asm volatile("" : "+s"(p)); return *(const Args*)p; }
__global__ void __launch_bounds__(NTHR, 2) hymba_fwd(Args A_) {
    extern __shared__ __attribute__((aligned(16))) unsigned char lds_raw[];
    LAS unsigned char* lds = (LAS unsigned char*)lds_raw;
    const int lo = A_.ph_lo, hi = A_.ph_hi;
#define A kargs()
#define ws (kargs().ws)
#ifndef DBLMASK
#define DBLMASK 0
#endif
#define IN(k) (lo <= (k) && (k) < hi)
#define REP(k) for (int _rep = 0; _rep < (((DBLMASK) >> (k)) & 1) + 1; ++_rep)
    for (int u = threadIdx.x; u < (LDS_BYTES - RING_BYTES) / 4; u += NTHR) ((LAS unsigned*)(lds + RING_BYTES))[u] = 0u;
    __syncthreads();
    XcdBarrier xbar = xcd_barrier_post((unsigned*)(ws + WS_CTL) + CW_BAR, (volatile LAS unsigned*)(lds + MISC_OFF + 32));
#define SEAM(k) do { if (IN(k) && IN((k) + 1)) { if ((k) == 0) cg::this_grid().sync(); else xcd_barrier(xbar); } } while (0)

    if (IN(0)) REP(0) { phase_mod(A, lds); } SEAM(0);
    if (IN(1)) REP(1) { phase_convert(A, lds); phase_prenorm(A); } SEAM(1);
    if (IN(2)) REP(2) {
        pg8::Gemm g{(const pg8::bf16_t*)(ws + WS_H), (const pg8::bf16_t*)(ws + WS_WIN), M, NIN_PAD, D}; pg8::StaticOrder S; S.init(M, NIN_PAD, gridDim.x, (int)blockIdx.x);
        pg8::EpiProj E{(pg8::bf16_t*)(ws + WS_PROJ), NPROJ, (float*)(ws + WS_GATES), (const int*)A.in[I_POS], (const float*)A.in[I_BI], (const float*)A.in[I_BF]};
        pg8::gemm_phase<pg8::EpiProj, pg8::StaticOrder, true, true>(lds, g, S, E);
    } SEAM(2);
    if (IN(3)) REP(3) {
        phase_attn(A, lds);
        for (int wg = blockIdx.x; wg < 256; wg += gridDim.x) mlstm_group<false>(A, lds, wg);
    } SEAM(3);
    if (IN(4)) REP(4) { for (int wg = blockIdx.x; wg < 256; wg += gridDim.x) mlstm_group<true>(A, lds, wg); } SEAM(4);
    if (IN(5)) REP(5) {
        pg8::Gemm g{(const pg8::bf16_t*)(ws + WS_MIXIN), (const pg8::bf16_t*)(ws + WS_WOUT), M, D, D}; pg8::StaticOrder S; S.init(M, D, gridDim.x, (int)blockIdx.x);
        pg8::EpiMix E{(pg8::bf16_t*)(ws + WS_MIX), D, (float*)(ws + WS_SSQ)};
        pg8::gemm_phase<pg8::EpiMix, pg8::StaticOrder, true, true>(lds, g, S, E);
    } SEAM(5);
    if (IN(6)) REP(6) { phase_mid(A); } SEAM(6);
    if (IN(7)) REP(7) {
        pg8::Gemm g{(const pg8::bf16_t*)(ws + WS_H), (const pg8::bf16_t*)(ws + WS_WQ), M, 2048, D}; pg8::StaticOrder S; S.init(M, 2048, gridDim.x, (int)blockIdx.x);
        pg8::EpiPlain E{(pg8::bf16_t*)(ws + WS_PROJ), 2048};
        pg8::gemm_phase<pg8::EpiPlain, pg8::StaticOrder, true, true>(lds, g, S, E);
    } SEAM(7);
    if (IN(8)) REP(8) { phase_topk(A, lds); } SEAM(8);
    if (IN(9)) REP(9) { phase_peer_u(A); } SEAM(9);
    if (IN(10)) REP(10) { phase_peer_act(A); } SEAM(10);
#ifdef PROBE_INSTR
    if (IN(11)) { probe_instr(A); }
#endif
#ifdef PROBE_V_LOADS
    if (IN(11)) { probe_v_loads(A); }
#endif
    if (IN(11)) REP(11) { phase_peer_v(A); } SEAM(11);
    if (IN(12)) REP(12) { phase_peer_final(A); }
#undef IN
#undef SEAM
#undef A
#undef ws
}

extern "C" void kernel_launch(void* const* d_in, const int* in_sizes, int n_in, void* d_out, int out_size, void* d_ws, size_t ws_size, hipStream_t stream) {
    static int grid = 0;
    if (grid == 0) {
        if (n_in != 21 || in_sizes[0] != M * D || out_size != M * D || ws_size < WS_END) { fprintf(stderr, "kernel_launch: unexpected shapes (n_in %d, in0 %d, out %d, ws %zu < %zu)\n", n_in, n_in > 0 ? in_sizes[0] : -1, out_size, ws_size, (size_t)WS_END); grid = -1; return; }
        int dev = 0, cus = 0, per_cu = 0;
        if (hipGetDevice(&dev) != hipSuccess || hipDeviceGetAttribute(&cus, hipDeviceAttributeMultiprocessorCount, dev) != hipSuccess) { grid = -1; return; }
        if (hipFuncSetAttribute((const void*)hymba_fwd, hipFuncAttributeMaxDynamicSharedMemorySize, LDS_BYTES) != hipSuccess) { fprintf(stderr, "kernel_launch: hipFuncSetAttribute failed\n"); grid = -1; return; }
        if (hipOccupancyMaxActiveBlocksPerMultiprocessor(&per_cu, (const void*)hymba_fwd, NTHR, LDS_BYTES) != hipSuccess || per_cu < 1) { fprintf(stderr, "kernel_launch: occupancy query says %d blocks per CU\n", per_cu); per_cu = 1; }
        (void)hipGetLastError();
        grid = cus;
        if (grid != 256) fprintf(stderr, "kernel_launch: note: %d CUs (built for 256)\n", grid);
    }
    if (grid < 0) return;
    (void)hipMemsetAsync((char*)d_ws + WS_CTL, 0, CTL_ZERO_BYTES, stream);
    Args a{};
    for (int i = 0; i < 21; ++i) a.in[i] = d_in[i];
    a.out = (float*)d_out; a.ws = (unsigned char*)d_ws;
    if (MK_N_LAUNCHES == 1) {
        a.ph_lo = 0; a.ph_hi = N_PHASES;
        void* args[] = {&a};
        const hipError_t e = hipLaunchCooperativeKernel((const void*)hymba_fwd, dim3(grid), dim3(NTHR), args, LDS_BYTES, stream);
        if (e != hipSuccess) fprintf(stderr, "kernel_launch: cooperative launch failed: %s (grid %d)\n", hipGetErrorString(e), grid);
    } else {
        for (int p = 0; p < N_PHASES; ++p) { a.ph_lo = p; a.ph_hi = p + 1; hipLaunchKernelGGL(hymba_fwd, dim3(grid), dim3(NTHR), LDS_BYTES, stream, a); }
    }
}
```

```cpp
#include <hip/hip_runtime.h>
#include <hip/hip_cooperative_groups.h>
#include <cstdio>
#include <cstdint>
namespace cg = cooperative_groups;
namespace pg8 {
#define PG8_LAS __attribute__((address_space(3)))
typedef unsigned short bf16_t;
typedef short bf16x8 __attribute__((ext_vector_type(8)));
typedef float f32x4 __attribute__((ext_vector_type(4)));
typedef unsigned u32x4 __attribute__((ext_vector_type(4)));
constexpr int BM = 256, BK = 64, HALF = 128, HTB = HALF * BK * 2  , STAGE_BYTES = 8 * HTB, NXCD = 8, WGM = 8;

__host__ __device__ __forceinline__ int lds_byte(int r, int c) { const int st = (r >> 4) * 2 + (c >> 5), rr = r & 15, cc = c & 31, ob = rr * 64 + cc * 2; return st * 1024 + (ob ^ (((ob >> 9) & 1) << 5)); }
__host__ __device__ __forceinline__ void stage_rc(int b, int& R, int& C) { const int st = b / 1024, sb = b % 1024, swz = sb ^ (((sb >> 9) & 1) << 5); R = (st >> 1) * 16 + swz / 64; C = (st & 1) * 32 + (swz % 64) / 2; }
__host__ __device__ __forceinline__ int perm32(int rho) { const int n = rho >> 4, i = rho & 15; return 8 * (i >> 2) + 4 * n + (i & 3); }

struct Unit { int pm, pn; };
struct Gemm { const bf16_t* A; const bf16_t* Bt; int M, N, K; };

struct StaticOrder {
    int nM, nN, nwg, G, c;
    __host__ __device__ void init(int M, int N, int G_, int c_) { nM = M / BM; nN = N / BM; nwg = nM * nN; G = G_; c = c_; }
    __host__ __device__ bool next(int i, Unit& u) const {
        const long L = (long)i * G + c; if (L >= nwg) return false;
        int wgid = (int)L; { const int q = nwg / NXCD, r = nwg % NXCD, xcd = wgid % NXCD, off = wgid / NXCD; wgid = (xcd < r ? xcd * (q + 1) : r * (q + 1) + (xcd - r) * q) + off; }
        const int nig = WGM * nN, gid = wgid / nig, fm = gid * WGM, gsz = (nM - fm) < WGM ? (nM - fm) : WGM;
        u.pm = fm + ((wgid % nig) % gsz); u.pn = (wgid % nig) / gsz; return true;
    }
    __device__ __forceinline__ void a_ready(const Unit&) const {}
    __device__ __forceinline__ void done(const Unit&) const {}
};

__device__ __forceinline__ unsigned cvt_pk_bf16(float lo, float hi) { unsigned r; asm volatile("v_cvt_pk_bf16_f32 %0, %1, %2" : "=v"(r) : "v"(lo), "v"(hi)); return r; }
typedef float f32x2 __attribute__((ext_vector_type(2)));
__device__ __forceinline__ f32x2 gelu_pk(f32x2 v) {
    const f32x2 av = __builtin_elementwise_abs(v), d = av * 0.2316418882f + 1.0f;
    f32x2 t; t.x = __builtin_amdgcn_rcpf(d.x); t.y = __builtin_amdgcn_rcpf(d.y);
    f32x2 q = t * 0.5307027145f + (-0.7265760135f); q = q * t + 0.7107068705f; q = q * t + (-0.142248368f); q = q * t + 0.127414796f; q = q * t;
    const f32x2 s = (v * v) * (-0.72134752044f);
    f32x2 e; e.x = __builtin_amdgcn_exp2f(s.x); e.y = __builtin_amdgcn_exp2f(s.y);
    const f32x2 m = v * (q * e), r = v - m;
    f32x2 o; o.x = v.x < 0.f ? m.x : r.x; o.y = v.y < 0.f ? m.y : r.y; return o;
}

__device__ __forceinline__ u32x4 pack8(const f32x4 v0, const f32x4 v1) { u32x4 w; w.x = cvt_pk_bf16(v0[0], v0[1]); w.y = cvt_pk_bf16(v0[2], v0[3]); w.z = cvt_pk_bf16(v1[0], v1[1]); w.w = cvt_pk_bf16(v1[2], v1[3]); return w; }

struct EpiPlain {
    static constexpr bool PERM = true, AFTER_DRAIN = false;
    bf16_t* O; int ldc;
    __device__ __forceinline__ void operator()(const f32x4 (&acc)[2][2][4][2], const Unit& u, int wr, int wc, int fr, int fq) const {
        const int row0 = u.pm * BM + wr * 64 + fr, col0 = u.pn * BM + wc * 32 + 8 * fq;
#pragma unroll
        for (int ai = 0; ai < 2; ++ai)
#pragma unroll
            for (int m = 0; m < 4; ++m) { bf16_t* rowp = O + (size_t)(row0 + ai * HALF + m * 16) * ldc + col0;
#pragma unroll
                for (int bj = 0; bj < 2; ++bj) *(u32x4*)(rowp + bj * HALF) = pack8(acc[ai][bj][m][0], acc[ai][bj][m][1]); }
    }
};

struct EpiProj {
    static constexpr bool PERM = true, AFTER_DRAIN = false;
    bf16_t* P; int ldc; float* gates; const int* pos; const float* b_i; const float* b_f;
    __device__ __forceinline__ void operator()(const f32x4 (&acc)[2][2][4][2], const Unit& u, int wr, int wc, int fr, int fq) const {
        const int row0 = u.pm * BM + wr * 64 + fr, col0 = u.pn * BM + wc * 32 + 8 * fq, pn = u.pn;
        if (pn == 9) {
            if (wc == 0 && fq == 0) {
                const f32x4 bi = {b_i[0], b_i[1], b_i[2], b_i[3]}, bf = {b_f[0], b_f[1], b_f[2], b_f[3]};
#pragma unroll
                for (int ai = 0; ai < 2; ++ai)
#pragma unroll
                    for (int m = 0; m < 4; ++m) { const int row = row0 + ai * HALF + m * 16;
                        const f32x4 iv = acc[ai][0][m][0] + bi, fv = acc[ai][0][m][1] + bf; f32x4 lf;
#pragma unroll
                        for (int j = 0; j < 4; ++j) lf[j] = fminf(fv[j], 0.f) - log1pf(__expf(-fabsf(fv[j])));
                        *(f32x4*)(gates + (size_t)row * 8) = iv; *(f32x4*)(gates + (size_t)row * 8 + 4) = lf; }
            }
            return;
        }
#pragma unroll
        for (int ai = 0; ai < 2; ++ai)
#pragma unroll
            for (int m = 0; m < 4; ++m) { const int row = row0 + ai * HALF + m * 16; bf16_t* rowp = P + (size_t)row * ldc + col0;
                const float posf = (pn <= 2) ? (float)pos[row] : 0.f;
#pragma unroll
                for (int bj = 0; bj < 2; ++bj) { f32x4 v0 = acc[ai][bj][m][0], v1 = acc[ai][bj][m][1];
                    const bool rope = (pn < 2) || (pn == 2 && bj == 0);
                    if (rope) {
                        const int p0 = ((col0 + bj * HALF) & 63) >> 1; const float sc = (pn < 2) ? 0.125f : 1.0f;
                        float x[8] = {v0[0], v0[1], v0[2], v0[3], v1[0], v1[1], v1[2], v1[3]};
#pragma unroll
                        for (int q = 0; q < 4; ++q) { const float invf = __builtin_amdgcn_exp2f(-(float)(p0 + q) * 0.41524101186092029f);
                            float r = posf * invf * 0.15915494309189535f; r = r - floorf(r);
                            const float c = __builtin_amdgcn_cosf(r) * sc, s = __builtin_amdgcn_sinf(r) * sc;
                            const float x1 = x[2 * q], x2 = x[2 * q + 1]; x[2 * q] = x1 * c - x2 * s; x[2 * q + 1] = x2 * c + x1 * s; }
                        v0 = (f32x4){x[0], x[1], x[2], x[3]}; v1 = (f32x4){x[4], x[5], x[6], x[7]};
                    } else if (pn >= 7) {
#pragma unroll
                        for (int j = 0; j < 4; ++j) { v0[j] = __builtin_amdgcn_rcpf(1.f + __expf(-v0[j])); v1[j] = __builtin_amdgcn_rcpf(1.f + __expf(-v1[j])); }
                    }
                    *(u32x4*)(rowp + bj * HALF) = pack8(v0, v1); } }
    }
};

struct EpiMix {
    static constexpr bool PERM = true, AFTER_DRAIN = false;
    bf16_t* O; int ldc; float* sumsq;
    __device__ __forceinline__ void operator()(const f32x4 (&acc)[2][2][4][2], const Unit& u, int wr, int wc, int fr, int fq) const {
        const int row0 = u.pm * BM + wr * 64 + fr, col0 = u.pn * BM + wc * 32 + 8 * fq;
#pragma unroll
        for (int ai = 0; ai < 2; ++ai)
#pragma unroll
            for (int m = 0; m < 4; ++m) { const int row = row0 + ai * HALF + m * 16; bf16_t* rowp = O + (size_t)row * ldc + col0; float s = 0.f;
#pragma unroll
                for (int bj = 0; bj < 2; ++bj) { const f32x4 v0 = acc[ai][bj][m][0], v1 = acc[ai][bj][m][1];
                    s += (v0[0] * v0[0] + v0[1] * v0[1]) + (v0[2] * v0[2] + v0[3] * v0[3]) + (v1[0] * v1[0] + v1[1] * v1[1]) + (v1[2] * v1[2] + v1[3] * v1[3]);
                    *(u32x4*)(rowp + bj * HALF) = pack8(v0, v1); }
                s += __shfl_xor(s, 16); s += __shfl_xor(s, 32);
                if (fq == 0) sumsq[(size_t)row * 16 + u.pn * 4 + wc] = s; }
    }
};
template <class Epi, class Sched, bool ALIGN_EPI = false, bool SP2 = false>
__device__ __forceinline__ void gemm_phase(PG8_LAS unsigned char* lds, const Gemm g, const Sched& S, const Epi& E) {
    const int tid = threadIdx.x, wid = __builtin_amdgcn_readfirstlane(tid >> 6), lane = tid & 63, wr = wid >> 2, wc = wid & 3, fr = lane & 15, fq = lane >> 4;
    const int K = g.K, nt = K / BK;
    unsigned voffA[2], voffB[2];
#pragma unroll
    for (int i = 0; i < 2; ++i) { int R, C; stage_rc(tid * 16 + i * 8192, R, C); const int Rb = Epi::PERM ? ((R & ~31) + perm32(R & 31)) : R;
        voffA[i] = (unsigned)(R * K + C) * 2u; voffB[i] = (unsigned)(Rb * K + C) * 2u; }
    const size_t kstep = (size_t)(BK * 2);
    const size_t hstep = (size_t)HALF * K * 2;
    const size_t tstep = 2 * hstep;
    const unsigned ldsw = (unsigned)wid * 1024u;
    const int aoff = lds_byte(wr * 64 + fr, fq * 8), boff = lds_byte(wc * 32 + fr, fq * 8);
#define PG8_SA(b, h) (((b) * 2 + (h)) * HTB)
#define PG8_SB(b, h) ((4 + (b) * 2 + (h)) * HTB)
#define PG8_STAGE(bufoff, gbase, voff) do { _Pragma("unroll") for (int _i = 0; _i < 2; ++_i) \
        __builtin_amdgcn_global_load_lds((const unsigned*)((const char*)(gbase) + (voff)[_i]), (PG8_LAS unsigned*)(lds + (bufoff) + ldsw + _i * 8192), 16, 0, 0); } while (0)
#define PG8_LDA(dst, b, h) do { _Pragma("unroll") for (int m = 0; m < 4; ++m) _Pragma("unroll") for (int k = 0; k < 2; ++k) dst[m][k] = *(const PG8_LAS bf16x8*)(lds + PG8_SA(b, h) + aoff + m * 2048 + k * 1024); } while (0)
#define PG8_LDB(dst, b, h) do { _Pragma("unroll") for (int n = 0; n < 2; ++n) _Pragma("unroll") for (int k = 0; k < 2; ++k) dst[n][k] = *(const PG8_LAS bf16x8*)(lds + PG8_SB(b, h) + boff + n * 2048 + k * 1024); } while (0)
#define PG8_MMA(ai, bj, At, Bt) do { __builtin_amdgcn_s_setprio(1); _Pragma("unroll") for (int m = 0; m < 4; ++m) _Pragma("unroll") for (int n = 0; n < 2; ++n) _Pragma("unroll") for (int k = 0; k < 2; ++k) \
        acc[ai][bj][m][n] = __builtin_amdgcn_mfma_f32_16x16x32_bf16(Bt[n][k], At[m][k], acc[ai][bj][m][n], 0, 0, 0); __builtin_amdgcn_s_setprio(0); } while (0)
#define PG8_WAIT_V(n) asm volatile("s_waitcnt vmcnt(" #n ")" ::: "memory")
#define PG8_WAIT_L(n) asm volatile("s_waitcnt lgkmcnt(" #n ")" ::: "memory")
#define PG8_BAR __builtin_amdgcn_s_barrier()
#define PG8_SCHED __builtin_amdgcn_sched_barrier(0)
    Unit cur, nxt; int ui = 0;
    if (!S.next(0, cur)) return;
    f32x4 acc[2][2][4][2];
#pragma unroll
    for (int a = 0; a < 2; ++a)
#pragma unroll
        for (int b = 0; b < 2; ++b)
#pragma unroll
            for (int m = 0; m < 4; ++m)
#pragma unroll
                for (int n = 0; n < 2; ++n) acc[a][b][m][n] = (f32x4){0.f, 0.f, 0.f, 0.f};
    bf16x8 At[4][2], B0[2][2], B1[2][2];
    const char* cA = (const char*)g.A + (size_t)cur.pm * tstep; const char* cB = (const char*)g.Bt + (size_t)cur.pn * tstep;
    S.a_ready(cur);
    if constexpr (SP2) {
        PG8_STAGE(PG8_SB(0, 0), cB, voffB); PG8_STAGE(PG8_SB(0, 1), cB + hstep, voffB); PG8_STAGE(PG8_SA(0, 0), cA, voffA); PG8_STAGE(PG8_SA(0, 1), cA + hstep, voffA);
        if (wr == 1) PG8_BAR;
        PG8_WAIT_V(2); PG8_BAR;
        PG8_STAGE(PG8_SB(1, 0), cB + kstep, voffB); PG8_STAGE(PG8_SA(1, 0), cA + kstep, voffA); PG8_STAGE(PG8_SB(1, 1), cB + hstep + kstep, voffB);
        PG8_WAIT_V(6); PG8_BAR;
    } else {
        PG8_STAGE(PG8_SB(0, 0), cB, voffB); PG8_STAGE(PG8_SA(0, 0), cA, voffA); PG8_STAGE(PG8_SB(0, 1), cB + hstep, voffB); PG8_STAGE(PG8_SA(0, 1), cA + hstep, voffA);
        if (wr == 1) PG8_BAR;
        PG8_WAIT_V(4); PG8_BAR;
        PG8_STAGE(PG8_SB(1, 0), cB + kstep, voffB); PG8_STAGE(PG8_SA(1, 0), cA + kstep, voffA); PG8_STAGE(PG8_SB(1, 1), cB + hstep + kstep, voffB);
        PG8_WAIT_V(6); PG8_BAR;
    }
    for (;;) {
        const bool has_next = S.next(ui + 1, nxt);
        const char* nA = has_next ? (const char*)g.A + (size_t)nxt.pm * tstep : cA; const char* nB = has_next ? (const char*)g.Bt + (size_t)nxt.pn * tstep : cB;
        for (int t = 0; t < nt; t += 2) {
            const bool last = (t == nt - 2);
            const char* a1 = cA + (size_t)(t + 1) * kstep;
            const char* a2 = last ? nA : cA + (size_t)(t + 2) * kstep; const char* b2 = last ? nB : cB + (size_t)(t + 2) * kstep;
            const char* a3 = a2 + kstep; const char* b3 = b2 + kstep;
            if (last && has_next) S.a_ready(nxt);
            if constexpr (SP2) {
            PG8_LDB(B0, 0, 0); PG8_LDB(B1, 0, 1); PG8_SCHED; PG8_LDA(At, 0, 0); PG8_STAGE(PG8_SA(1, 1), a1 + hstep, voffA);
            PG8_WAIT_V(8); PG8_WAIT_L(0); PG8_BAR; PG8_MMA(0, 0, At, B0); PG8_MMA(0, 1, At, B1); PG8_BAR; PG8_SCHED;
            PG8_LDA(At, 0, 1); PG8_STAGE(PG8_SB(0, 0), b2, voffB); PG8_STAGE(PG8_SB(0, 1), b2 + hstep, voffB); PG8_STAGE(PG8_SA(0, 0), a2, voffA);
            PG8_WAIT_V(8); PG8_WAIT_L(0); PG8_BAR; PG8_MMA(1, 0, At, B0); PG8_MMA(1, 1, At, B1); PG8_BAR; PG8_SCHED;
            PG8_LDB(B0, 1, 0); PG8_LDB(B1, 1, 1); PG8_SCHED; PG8_LDA(At, 1, 0); PG8_STAGE(PG8_SA(0, 1), a2 + hstep, voffA);
            PG8_WAIT_V(8); PG8_WAIT_L(0); PG8_BAR; PG8_MMA(0, 0, At, B0); PG8_MMA(0, 1, At, B1); PG8_BAR; PG8_SCHED;
            PG8_LDA(At, 1, 1); PG8_STAGE(PG8_SB(1, 0), b3, voffB); PG8_STAGE(PG8_SB(1, 1), b3 + hstep, voffB); PG8_STAGE(PG8_SA(1, 0), a3, voffA);
            PG8_WAIT_V(8); PG8_WAIT_L(0); PG8_BAR; PG8_MMA(1, 0, At, B0); PG8_MMA(1, 1, At, B1); PG8_BAR; PG8_SCHED;
            } else {
            PG8_LDB(B0, 0, 0); PG8_SCHED; PG8_LDA(At, 0, 0); PG8_STAGE(PG8_SA(1, 1), a1 + hstep, voffA);
            PG8_WAIT_L(8); PG8_BAR; PG8_WAIT_L(0); PG8_MMA(0, 0, At, B0); PG8_BAR; PG8_SCHED;
            PG8_LDB(B1, 0, 1); PG8_STAGE(PG8_SB(0, 0), b2, voffB);
            PG8_BAR; PG8_WAIT_L(0); PG8_MMA(0, 1, At, B1); PG8_BAR;
            PG8_LDA(At, 0, 1); PG8_STAGE(PG8_SA(0, 0), a2, voffA);
            PG8_BAR; PG8_WAIT_L(0); PG8_MMA(1, 0, At, B0); PG8_BAR; PG8_SCHED;
            PG8_STAGE(PG8_SB(0, 1), b2 + hstep, voffB);
            PG8_WAIT_V(6); PG8_BAR; PG8_MMA(1, 1, At, B1); PG8_BAR;
            PG8_LDB(B0, 1, 0); PG8_SCHED; PG8_LDA(At, 1, 0); PG8_STAGE(PG8_SA(0, 1), a2 + hstep, voffA);
            PG8_WAIT_L(8); PG8_BAR; PG8_WAIT_L(0); PG8_MMA(0, 0, At, B0); PG8_BAR; PG8_SCHED;
            PG8_LDB(B1, 1, 1); PG8_STAGE(PG8_SB(1, 0), b3, voffB);
            PG8_BAR; PG8_WAIT_L(0); PG8_MMA(0, 1, At, B1); PG8_BAR;
            PG8_LDA(At, 1, 1); PG8_STAGE(PG8_SA(1, 0), a3, voffA);
            PG8_BAR; PG8_WAIT_L(0); PG8_MMA(1, 0, At, B0); PG8_BAR; PG8_SCHED;
            PG8_STAGE(PG8_SB(1, 1), b3 + hstep, voffB);
            PG8_WAIT_V(6); PG8_BAR; PG8_MMA(1, 1, At, B1); PG8_BAR;
            }
        }
        if constexpr (ALIGN_EPI) { if (wr == 0) PG8_BAR; }
        if constexpr (!Epi::AFTER_DRAIN) { E(acc, cur, wr, wc, fr, fq); S.done(cur); }
        if (!has_next) break;
#pragma unroll
        for (int a = 0; a < 2; ++a)
#pragma unroll
            for (int b = 0; b < 2; ++b)
#pragma unroll
                for (int m = 0; m < 4; ++m)
#pragma unroll
                    for (int n = 0; n < 2; ++n) acc[a][b][m][n] = (f32x4){0.f, 0.f, 0.f, 0.f};
        cur = nxt; cA = nA; cB = nB; ++ui;
        if constexpr (ALIGN_EPI) { if (wr == 1) PG8_BAR; }
    }
    PG8_WAIT_V(0);
    if constexpr (!ALIGN_EPI) { if (wr == 0) PG8_BAR; }
    PG8_BAR;
    if constexpr (Epi::AFTER_DRAIN) { E.fused(acc, cur, wr, wc, fr, fq, lds, wid, lane); S.done(cur); }
#undef PG8_SA
#undef PG8_SB
#undef PG8_STAGE
#undef PG8_LDA
#undef PG8_LDB
#undef PG8_MMA
#undef PG8_WAIT_V
#undef PG8_WAIT_L
#undef PG8_BAR
#undef PG8_SCHED
}
}
constexpr int NB = 8, SEQ = 8192, D = 1024, M = NB * SEQ;
constexpr int DIN = 2312, NPROJ = 2304, NIN_PAD = 2560;
constexpr int C_AQ = 0, C_AK = 512, C_AV = 640, C_MQ = 768, C_MK = 1024, C_MV = 1280, C_MO = 1792;
constexpr int NEXP = 16384, NSLOT = 128;
constexpr float EPS = 1e-6f;
constexpr int NWAVES = 8, NTHR = 512;

constexpr size_t MiB = 1u << 20;
constexpr size_t WS_CTL = 0, CTL_ZERO_BYTES = 1 * MiB;
constexpr size_t WS_MOD = 1 * MiB;
constexpr size_t WS_WIN = 2 * MiB;
constexpr size_t WS_WOUT = 8 * MiB;
constexpr size_t WS_WQ = 10 * MiB;
constexpr size_t WS_KEYS = 14 * MiB;
constexpr size_t WS_GATES = 16 * MiB;
constexpr size_t WS_SSQ = 832 * MiB;
constexpr size_t WS_MST = 20 * MiB;
constexpr size_t WS_U8 = 32 * MiB, WS_V8 = 48 * MiB;
constexpr size_t WS_SC = 64 * MiB;
constexpr size_t WS_H = 96 * MiB;
constexpr size_t WS_PROJ = 224 * MiB;
constexpr size_t WS_MIXIN = 512 * MiB;
constexpr size_t WS_MIX = 640 * MiB;
constexpr size_t WS_EIDX = 768 * MiB, WS_GATE = 800 * MiB;
constexpr size_t WS_PD = 224 * MiB;
constexpr size_t WS_X1 = 512 * MiB;
constexpr size_t WS_ACT = 840 * MiB;
constexpr size_t WS_SSY = 872 * MiB;
constexpr size_t WS_H8 = 880 * MiB;
constexpr size_t WS_HS = 944 * MiB;
constexpr size_t WS_END = 945 * MiB;
constexpr int CW_BAR = 4096;
constexpr int CW_SUMSQ = 65536;
static_assert((CW_SUMSQ + M) * 4 <= (int)CTL_ZERO_BYTES, "ctl");

constexpr int RING_BYTES = 131072, MISC_OFF = RING_BYTES + 320, LDS_BYTES = 147456;

#define GAS __attribute__((address_space(1)))
#define LAS __attribute__((address_space(3)))
typedef unsigned short bf16;
typedef unsigned v4u __attribute__((ext_vector_type(4)));
typedef unsigned v2u __attribute__((ext_vector_type(2)));
typedef float f32x4 __attribute__((ext_vector_type(4)));
typedef GAS unsigned gu32;
#define LDS_WAIT() asm volatile("s_waitcnt lgkmcnt(0)" ::: "memory")
#define VM_WAIT() asm volatile("s_waitcnt vmcnt(0)" ::: "memory")
__device__ __forceinline__ unsigned f2bf(float f) { unsigned u = __builtin_bit_cast(unsigned, f); return (u + 0x7fffu + ((u >> 16) & 1u)) >> 16; }
__device__ __forceinline__ unsigned pk2(float lo, float hi) { return f2bf(lo) | (f2bf(hi) << 16); }
__device__ __forceinline__ float bflo(unsigned w) { return __builtin_bit_cast(float, w << 16); }
__device__ __forceinline__ float bfhi(unsigned w) { return __builtin_bit_cast(float, w & 0xffff0000u); }
__device__ __forceinline__ float bf1(bf16 h) { return __builtin_bit_cast(float, (unsigned)h << 16); }
__device__ __forceinline__ float wave_sum(float v) {
#pragma unroll
    for (int o = 1; o < 64; o <<= 1) v += __shfl_xor(v, o);
    return v;
}
__device__ __forceinline__ float wave_max(float v) {
#pragma unroll
    for (int o = 1; o < 64; o <<= 1) v = fmaxf(v, __shfl_xor(v, o));
    return v;
}

typedef float f32x2 __attribute__((ext_vector_type(2)));
__device__ __forceinline__ void cvt16_fp8(const v4u w, float (&o)[16]) {
    const unsigned ww[4] = {w.x, w.y, w.z, w.w};
#pragma unroll
    for (int i = 0; i < 4; ++i) { const f32x2 a = __builtin_amdgcn_cvt_pk_f32_fp8((int)ww[i], false), b = __builtin_amdgcn_cvt_pk_f32_fp8((int)ww[i], true);
        o[4 * i] = a.x; o[4 * i + 1] = a.y; o[4 * i + 2] = b.x; o[4 * i + 3] = b.y; }
}
__device__ __forceinline__ void p0_row_fp8(const float* src, unsigned char* dst, float* sc, int row, int lane) {
    const GAS f32x4* sp = (const GAS f32x4*)(src + (size_t)row * D + 16 * lane);
    const f32x4 a = sp[0], b = sp[1], c = sp[2], d = sp[3];
    float mx = 0.f;
#pragma unroll
    for (int i = 0; i < 4; ++i) mx = fmaxf(fmaxf(fmaxf(mx, fabsf(a[i])), fmaxf(fabsf(b[i]), fabsf(c[i]))), fabsf(d[i]));
    mx = wave_max(mx); const float s = mx > 0.f ? 224.0f / mx : 1.0f;
    v4u o; int w;
    w = __builtin_amdgcn_cvt_pk_fp8_f32(a[0] * s, a[1] * s, 0, false); w = __builtin_amdgcn_cvt_pk_fp8_f32(a[2] * s, a[3] * s, w, true); o.x = (unsigned)w;
    w = __builtin_amdgcn_cvt_pk_fp8_f32(b[0] * s, b[1] * s, 0, false); w = __builtin_amdgcn_cvt_pk_fp8_f32(b[2] * s, b[3] * s, w, true); o.y = (unsigned)w;
    w = __builtin_amdgcn_cvt_pk_fp8_f32(c[0] * s, c[1] * s, 0, false); w = __builtin_amdgcn_cvt_pk_fp8_f32(c[2] * s, c[3] * s, w, true); o.z = (unsigned)w;
    w = __builtin_amdgcn_cvt_pk_fp8_f32(d[0] * s, d[1] * s, 0, false); w = __builtin_amdgcn_cvt_pk_fp8_f32(d[2] * s, d[3] * s, w, true); o.w = (unsigned)w;
    *(GAS v4u*)(dst + (size_t)row * D + 16 * lane) = o;
    if (lane == 0) sc[row] = mx > 0.f ? mx * (1.0f / 224.0f) : 1.0f;
}

__device__ __forceinline__ unsigned pack4_i8(float a, float b, float c, float d) { return ((unsigned)__float2int_rn(a) & 0xffu) | (((unsigned)__float2int_rn(b) & 0xffu) << 8) | (((unsigned)__float2int_rn(c) & 0xffu) << 16) | (((unsigned)__float2int_rn(d) & 0xffu) << 24); }
__device__ __forceinline__ void p0_row_i8(const float* src, unsigned char* dst, float* sc, int row, int lane) {
    const GAS f32x4* sp = (const GAS f32x4*)(src + (size_t)row * D + 16 * lane);
    const f32x4 a = sp[0], b = sp[1], c = sp[2], d = sp[3];
    float mx = 0.f;
#pragma unroll
    for (int i = 0; i < 4; ++i) mx = fmaxf(fmaxf(fmaxf(mx, fabsf(a[i])), fmaxf(fabsf(b[i]), fabsf(c[i]))), fabsf(d[i]));
    mx = wave_max(mx); const float s = mx > 0.f ? 127.0f / mx : 1.0f;
    v4u o; o.x = pack4_i8(a[0] * s, a[1] * s, a[2] * s, a[3] * s); o.y = pack4_i8(b[0] * s, b[1] * s, b[2] * s, b[3] * s); o.z = pack4_i8(c[0] * s, c[1] * s, c[2] * s, c[3] * s); o.w = pack4_i8(d[0] * s, d[1] * s, d[2] * s, d[3] * s);
    *(GAS v4u*)(dst + (size_t)row * D + 16 * lane) = o;
    if (lane == 0) sc[row] = mx > 0.f ? mx * (1.0f / 127.0f) : 1.0f;
}

__device__ __forceinline__ unsigned pack8_i4(const f32x4 a, const f32x4 b, float s) {
    unsigned w = 0;
#pragma unroll
    for (int i = 0; i < 4; ++i) { const int qa = max(-8, min(7, __float2int_rn(a[i] * s))), qb = max(-8, min(7, __float2int_rn(b[i] * s))); w |= ((unsigned)qa & 15u) << (4 * i); w |= ((unsigned)qb & 15u) << (16 + 4 * i); }
    return w;
}
__device__ __forceinline__ void p0_row_i4(const float* src, unsigned char* dst, float* sc, int row, int lane) {
    const GAS f32x4* sp = (const GAS f32x4*)(src + (size_t)row * D + 16 * lane);
    const f32x4 a = sp[0], b = sp[1], c = sp[2], d = sp[3];
    float ss = 0.f;
#pragma unroll
    for (int i = 0; i < 4; ++i) ss += (a[i] * a[i] + b[i] * b[i]) + (c[i] * c[i] + d[i] * d[i]);
    ss = wave_sum(ss); const float sig = sqrtf(ss * (1.f / D)), s = sig > 0.f ? 3.0f / sig : 1.0f;
    v2u o; o.x = pack8_i4(a, b, s); o.y = pack8_i4(c, d, s);
    *(GAS v2u*)(dst + (size_t)row * (D / 2) + 8 * lane) = o;
    if (lane == 0) sc[row] = sig > 0.f ? sig * (1.0f / 3.0f) : 1.0f;
}

__device__ __forceinline__ unsigned pack8_fp4(const f32x4 a, const f32x4 b, float s) {
    unsigned w = 0;
    w = __builtin_amdgcn_cvt_scalef32_pk_fp4_f32(w, fminf(fmaxf(a[0] * s, -6.f), 6.f), fminf(fmaxf(a[1] * s, -6.f), 6.f), 1.0f, 0);
    w = __builtin_amdgcn_cvt_scalef32_pk_fp4_f32(w, fminf(fmaxf(a[2] * s, -6.f), 6.f), fminf(fmaxf(a[3] * s, -6.f), 6.f), 1.0f, 1);
    w = __builtin_amdgcn_cvt_scalef32_pk_fp4_f32(w, fminf(fmaxf(b[0] * s, -6.f), 6.f), fminf(fmaxf(b[1] * s, -6.f), 6.f), 1.0f, 2);
    w = __builtin_amdgcn_cvt_scalef32_pk_fp4_f32(w, fminf(fmaxf(b[2] * s, -6.f), 6.f), fminf(fmaxf(b[3] * s, -6.f), 6.f), 1.0f, 3);
    return w;
}
__device__ __forceinline__ void p0_row_fp4(const float* src, unsigned char* dst, float* sc, int row, int lane) {
    const GAS f32x4* sp = (const GAS f32x4*)(src + (size_t)row * D + 16 * lane);
    const f32x4 a = sp[0], b = sp[1], c = sp[2], d = sp[3];
    float mx = 0.f;
#pragma unroll
    for (int i = 0; i < 4; ++i) mx = fmaxf(fmaxf(fmaxf(mx, fabsf(a[i])), fmaxf(fabsf(b[i]), fabsf(c[i]))), fabsf(d[i]));
    mx = wave_max(mx); const float s = mx > 0.f ? 7.0f / mx : 1.0f;
    v2u o; o.x = pack8_fp4(a, b, s); o.y = pack8_fp4(c, d, s);
    *(GAS v2u*)(dst + (size_t)row * (D / 2) + 8 * lane) = o;
    if (lane == 0) sc[row] = mx > 0.f ? mx * (1.0f / 7.0f) : 1.0f;
}
#define XB_TMO      128
#define XB_XCNT(j)  (256  + 64 * (j))
#define XB_XSUB(j)  (1280 + 64 * (j))
#define XB_XGEN(j)  (2304 + 64 * (j))
#define XB_TOP      3328
#define XB_TOPGEN   3392
#define XCD_BAR_WORDS 3456
#define XB_SPIN_CAP (1u << 18)

__device__ __forceinline__ unsigned xb_ld(unsigned* p)              { return __hip_atomic_load(p, __ATOMIC_RELAXED, __HIP_MEMORY_SCOPE_AGENT); }
__device__ __forceinline__ unsigned xb_add(unsigned* p, unsigned v) { return __hip_atomic_fetch_add(p, v, __ATOMIC_RELAXED, __HIP_MEMORY_SCOPE_AGENT); }
__device__ __forceinline__ unsigned xb_xcc_id() { return (unsigned)__builtin_amdgcn_s_getreg((3 << 11) | 20) & 0xFu; }
#define XB_SPIN(cond, bar) do { unsigned _sp = 0; while (cond) { __builtin_amdgcn_s_sleep(1); \
    if ((++_sp & 255u) == 0u) { if (xb_ld(&(bar)[XB_TMO])) break; if (_sp > XB_SPIN_CAP) { atomicAdd(&(bar)[XB_TMO], 1u); break; } } } } while (0)

struct XcdBarrier {
    unsigned* bar; unsigned x;
    volatile LAS unsigned* st;
};

__device__ __forceinline__ XcdBarrier xcd_barrier_post(unsigned* bar, volatile LAS unsigned* st) {
    XcdBarrier b; b.bar = bar; b.x = xb_xcc_id(); b.st = st;
    if (threadIdx.x == 0) (void)xb_add(&bar[XB_XCNT(b.x)], 1u);
    return b;
}
__device__ __forceinline__ void xcd_barrier_complete(unsigned* bar, unsigned x, unsigned& nloc, unsigned& nx) {
    const unsigned G = gridDim.x * gridDim.y * gridDim.z;
    unsigned sum, cnt, mine, sp = 0u;
    for (;;) {
        sum = 0u; cnt = 0u; mine = 0u;
#pragma unroll
        for (unsigned j = 0; j < 16; ++j) { const unsigned c = xb_ld(&bar[XB_XCNT(j)]); sum += c; cnt += (c > 0u) ? 1u : 0u; mine = (j == x) ? c : mine; }
        if (sum == G) break;
        __builtin_amdgcn_s_sleep(1);
        if ((++sp & 255u) == 0u) { if (xb_ld(&bar[XB_TMO])) break; if (sp > XB_SPIN_CAP) { atomicAdd(&bar[XB_TMO], 1u); break; } }
    }
    nloc = mine > 0u ? mine : 1u; nx = cnt > 0u ? cnt : 1u;
}

__device__ __forceinline__ void xcd_barrier(const XcdBarrier& b) {
    asm volatile("s_waitcnt vmcnt(0)" ::: "memory");
    __syncthreads();
    if (threadIdx.x == 0) {
        unsigned* bar = b.bar;
        __builtin_amdgcn_s_waitcnt(0);
        unsigned nloc = b.st[0], nx = b.st[1];
        if (nloc == 0u) { xcd_barrier_complete(bar, b.x, nloc, nx); b.st[0] = nloc; b.st[1] = nx; }
        const unsigned old = xb_add(&bar[XB_XSUB(b.x)], 1u);
        const unsigned gen = old / nloc;
        if (old + 1u == (gen + 1u) * nloc) {
            __builtin_amdgcn_fence(__ATOMIC_RELEASE, "agent");
            asm volatile("s_waitcnt vmcnt(0)" ::: "memory");
            const unsigned og = xb_add(&bar[XB_TOP], 1u);
            const unsigned tg = og / nx;
            if (og + 1u == (tg + 1u) * nx) xb_add(&bar[XB_TOPGEN], 1u);
            else XB_SPIN(xb_ld(&bar[XB_TOPGEN]) == tg, bar);
            __builtin_amdgcn_fence(__ATOMIC_ACQUIRE, "agent");
            xb_add(&bar[XB_XGEN(b.x)], 1u);
            asm volatile("s_waitcnt vmcnt(0)" ::: "memory");
        } else {
            XB_SPIN(xb_ld(&bar[XB_XGEN(b.x)]) == gen, bar);
            __builtin_amdgcn_fence(__ATOMIC_ACQUIRE, "agent");
            asm volatile("s_waitcnt vmcnt(0)" ::: "memory");
        }
    }
    __syncthreads();
}
struct Args { const void* in[21]; float* out; unsigned char* ws; int ph_lo, ph_hi; };
enum { I_X = 0, I_C, I_POS, I_WMOD, I_BMOD, I_GPRE1, I_GPOST1, I_WIN, I_CONVW, I_BI, I_BF, I_MNG, I_SINK, I_WOUT, I_GPRE2, I_GPOST2, I_WQ, I_K1, I_K2, I_U, I_V };

__device__ __forceinline__ int newcol(int o) {
    if (o < 640) { const int hd = o >> 6, d = o & 63; return (hd << 6) + 2 * (d & 31) + (d >> 5); }
    if (o < 1792) return o;
    if (o < 1800) return 2304 + (o - 1792);
    return o - 8;
}
template <bool REMAP>
__device__ __forceinline__ void p0_transpose_item(const float* W, int K, int N, bf16* WT, LAS float* scr, int item, int lane) {
    const int nblk = (N + 31) / 32, kb = item / nblk, nb = item % nblk, k0 = 64 * kb, n0 = 32 * nb;
    const int ncol = n0 + (lane & 31);
#pragma unroll 8
    for (int i = 0; i < 32; ++i) { const int kk = 2 * i + (lane >> 5); scr[kk * 33 + (lane & 31)] = (ncol < N) ? W[(size_t)(k0 + kk) * N + ncol] : 0.f; }
    LDS_WAIT(); asm volatile("" ::: "memory");
    const int c = lane & 7;
#pragma unroll
    for (int j = 0; j < 4; ++j) { const int n = (lane >> 3) + 8 * j; const LAS float* s = scr + (8 * c) * 33 + n;
        v4u o; o.x = pk2(s[0 * 33], s[1 * 33]); o.y = pk2(s[2 * 33], s[3 * 33]); o.z = pk2(s[4 * 33], s[5 * 33]); o.w = pk2(s[6 * 33], s[7 * 33]);
        if (n0 + n < N) { const int drow = REMAP ? newcol(n0 + n) : (n0 + n); *(GAS v4u*)(WT + (size_t)drow * K + k0 + 8 * c) = o; } }
    LDS_WAIT(); asm volatile("" ::: "memory");
}
__device__ __forceinline__ void p0_convert(const float* src, bf16* dst, size_t n, int gt, int ngt) {
    for (size_t i = (size_t)gt * 8; i < n; i += (size_t)ngt * 8) {
        const f32x4 a = *(const GAS f32x4*)(src + i), b = *(const GAS f32x4*)(src + i + 4);
        v4u o; o.x = pk2(a[0], a[1]); o.y = pk2(a[2], a[3]); o.z = pk2(b[0], b[1]); o.w = pk2(b[2], b[3]);
        *(GAS v4u*)(dst + i) = o; }
}
__device__ __forceinline__ void phase_mod(const Args& A, LAS unsigned char* lds) {
    const int tid = threadIdx.x, G = gridDim.x, blk = blockIdx.x;
    unsigned char* ws = A.ws;
    const float* c = (const float*)A.in[I_C]; const float* wm = (const float*)A.in[I_WMOD]; const float* bm = (const float*)A.in[I_BMOD];
    float* mod = (float*)(ws + WS_MOD); LAS float* cs = (LAS float*)lds; LAS float* red = cs + 8 * 1024;
    for (int e = tid; e < 8 * 1024 / 4; e += NTHR) *(LAS f32x4*)(cs + 4 * e) = *(const GAS f32x4*)(c + 4 * e);
    __syncthreads();
    for (int it = blk; it < 6144 / 24; it += G) {
        const int kg = tid >> 5, col = tid & 31, j = it * 24 + (col < 24 ? col : 23); float acc[8];
#pragma unroll
        for (int b = 0; b < 8; ++b) acc[b] = 0.f;
#pragma unroll 16
        for (int i = 0; i < 64; ++i) { const int k = kg + 16 * i; const float w = wm[(size_t)k * 6144 + j];
#pragma unroll
            for (int b = 0; b < 8; ++b) acc[b] += cs[b * 1024 + k] * w; }
#pragma unroll
        for (int b = 0; b < 8; ++b) red[(kg * 32 + col) * 8 + b] = acc[b];
        __syncthreads();
        if (tid < 256) { const int b = tid >> 5, cc = tid & 31; float s = 0.f;
#pragma unroll
            for (int g = 0; g < 16; ++g) s += red[(g * 32 + cc) * 8 + b];
            if (cc < 24) mod[b * 6144 + it * 24 + cc] = s + bm[it * 24 + cc]; }
        __syncthreads();
    }
}
__device__ __forceinline__ void phase_convert(const Args& A, LAS unsigned char* lds) {
    const int tid = threadIdx.x, lane = tid & 63, wave = tid >> 6, G = gridDim.x, blk = blockIdx.x;
    unsigned char* ws = A.ws;
    {
        LAS float* scr = (LAS float*)(lds + wave * 16384);
        const int gw = blk * NWAVES + wave, NGW = G * NWAVES;
        const int I_IN = (D / 64) * ((DIN + 31) / 32), I_OUT = (D / 64) * (D / 32), I_Q = (D / 64) * (2048 / 32);
        bf16* win = (bf16*)(ws + WS_WIN); bf16* wout = (bf16*)(ws + WS_WOUT); bf16* wq = (bf16*)(ws + WS_WQ);
        for (int it = gw; it < I_IN + I_OUT + I_Q; it += NGW) {
            int r = it;
            if (r < I_IN) { p0_transpose_item<true>((const float*)A.in[I_WIN], D, DIN, win, scr, r, lane); continue; } r -= I_IN;
            if (r < I_OUT) { p0_transpose_item<false>((const float*)A.in[I_WOUT], D, D, wout, scr, r, lane); continue; } r -= I_OUT;
            p0_transpose_item<false>((const float*)A.in[I_WQ], D, 2048, wq, scr, r, lane);
        }
        const int gt = blk * NTHR + tid, ngt = G * NTHR;
        for (int i = gt; i < (NIN_PAD - DIN) * D / 8; i += ngt) *(GAS v4u*)(win + (size_t)DIN * D + (size_t)i * 8) = (v4u){0u, 0u, 0u, 0u};
        p0_convert((const float*)A.in[I_K1], (bf16*)(ws + WS_KEYS), (size_t)8 * 128 * 128, gt, ngt);
        p0_convert((const float*)A.in[I_K2], (bf16*)(ws + WS_KEYS) + 8 * 128 * 128, (size_t)8 * 128 * 128, gt, ngt);
        for (int r = gw; r < 2 * NEXP; r += NGW) { if (r < NEXP) p0_row_i4((const float*)A.in[I_U], ws + WS_U8, (float*)(ws + WS_SC), r, lane); else p0_row_fp4((const float*)A.in[I_V], ws + WS_V8, (float*)(ws + WS_SC) + NEXP, r - NEXP, lane); }
    }
}

__device__ __forceinline__ void phase_prenorm(const Args& A) {
    const int tid = threadIdx.x, lane = tid & 63, wave = tid >> 6, G = gridDim.x;
    const float* x = (const float*)A.in[I_X]; const float* g = (const float*)A.in[I_GPRE1]; const float* mod = (const float*)(A.ws + WS_MOD);
    bf16* H = (bf16*)(A.ws + WS_H);
    f32x4 gg[4];
#pragma unroll
    for (int j = 0; j < 4; ++j) gg[j] = *(const GAS f32x4*)(g + 4 * (lane + 64 * j));
    const int stride = G * NWAVES; int row = blockIdx.x * NWAVES + wave;
    f32x4 v[4], vn[4], shv[4], gsv[4]; int bcur = -1;
#pragma unroll
    for (int j = 0; j < 4; ++j) v[j] = ((const GAS f32x4*)(x + (size_t)row * D) + lane)[64 * j];
    for (; row < M; row += stride) {
        const int rn = min(row + stride, M - 1);
#pragma unroll
        for (int j = 0; j < 4; ++j) vn[j] = ((const GAS f32x4*)(x + (size_t)rn * D) + lane)[64 * j];
        const int b = row / SEQ; float s = 0.f;
        if (b != bcur) { bcur = b;
#pragma unroll
            for (int j = 0; j < 4; ++j) { const int k = 4 * (lane + 64 * j); shv[j] = *(const GAS f32x4*)(mod + b * 6144 + k); const f32x4 sc = *(const GAS f32x4*)(mod + b * 6144 + 1024 + k);
#pragma unroll
                for (int i = 0; i < 4; ++i) gsv[j][i] = gg[j][i] * (1.f + sc[i]); } }
#pragma unroll
        for (int j = 0; j < 4; ++j) s += (v[j][0] * v[j][0] + v[j][1] * v[j][1]) + (v[j][2] * v[j][2] + v[j][3] * v[j][3]);
        const float rstd = 1.0f / sqrtf(wave_sum(s) * (1.f / D) + EPS);
        GAS v2u* o = (GAS v2u*)(H + (size_t)row * D) + lane;
#pragma unroll
        for (int j = 0; j < 4; ++j) {
            f32x4 y;
#pragma unroll
            for (int i = 0; i < 4; ++i) y[i] = v[j][i] * rstd * gsv[j][i] + shv[j][i];
            v2u w; w.x = pk2(y[0], y[1]); w.y = pk2(y[2], y[3]); o[64 * j] = w; }
#pragma unroll
        for (int j = 0; j < 4; ++j) v[j] = vn[j];
    }
}

__device__ __forceinline__ void phase_mid(const Args& A) {
    const int tid = threadIdx.x, lane = tid & 63, wave = tid >> 6, G = gridDim.x;
    const float* x = (const float*)A.in[I_X]; const float* gpost = (const float*)A.in[I_GPOST1]; const float* gpre = (const float*)A.in[I_GPRE2];
    const float* mod = (const float*)(A.ws + WS_MOD); const float* sumsq = (const float*)(A.ws + WS_SSQ);
    const bf16* MIX = (const bf16*)(A.ws + WS_MIX); bf16* H = (bf16*)(A.ws + WS_H); bf16* X1 = (bf16*)(A.ws + WS_X1);
    const int stride = G * NWAVES; int row = blockIdx.x * NWAVES + wave;
    f32x4 xv[4], xn[4], q[4], qn[4], g1p[4], gs2[4], sh2[4]; v2u mw[4], mn[4]; int bcur = -1;
#pragma unroll
    for (int j = 0; j < 4; ++j) { xv[j] = ((const GAS f32x4*)(x + (size_t)row * D) + lane)[64 * j]; mw[j] = ((const GAS v2u*)(MIX + (size_t)row * D) + lane)[64 * j]; q[j] = *(const GAS f32x4*)(sumsq + (size_t)row * 16 + 4 * j); }
    for (; row < M; row += stride) {
        const int rn = min(row + stride, M - 1);
#pragma unroll
        for (int j = 0; j < 4; ++j) { xn[j] = ((const GAS f32x4*)(x + (size_t)rn * D) + lane)[64 * j]; mn[j] = ((const GAS v2u*)(MIX + (size_t)rn * D) + lane)[64 * j]; qn[j] = *(const GAS f32x4*)(sumsq + (size_t)rn * 16 + 4 * j); }
        const int b = row / SEQ;
        if (b != bcur) { bcur = b;
#pragma unroll
            for (int j = 0; j < 4; ++j) { const int k = 4 * (lane + 64 * j); const f32x4 gp = *(const GAS f32x4*)(gpost + k), g1 = *(const GAS f32x4*)(mod + b * 6144 + 2048 + k), gg = *(const GAS f32x4*)(gpre + k), sc = *(const GAS f32x4*)(mod + b * 6144 + 4096 + k);
                sh2[j] = *(const GAS f32x4*)(mod + b * 6144 + 3072 + k);
#pragma unroll
                for (int i = 0; i < 4; ++i) { g1p[j][i] = g1[i] * gp[i]; gs2[j][i] = gg[i] * (1.f + sc[i]); } } }
        const float rm = 1.0f / sqrtf(((((q[0][0] + q[0][1]) + (q[0][2] + q[0][3])) + ((q[1][0] + q[1][1]) + (q[1][2] + q[1][3]))) + (((q[2][0] + q[2][1]) + (q[2][2] + q[2][3])) + ((q[3][0] + q[3][1]) + (q[3][2] + q[3][3])))) * (1.f / D) + EPS);
        f32x4 v[4]; float s = 0.f;
#pragma unroll
        for (int j = 0; j < 4; ++j) {
            const float mx[4] = {bflo(mw[j].x), bfhi(mw[j].x), bflo(mw[j].y), bfhi(mw[j].y)};
#pragma unroll
            for (int i = 0; i < 4; ++i) { v[j][i] = xv[j][i] + g1p[j][i] * (mx[i] * rm); s += v[j][i] * v[j][i]; }
            { v2u w; w.x = pk2(v[j][0], v[j][1]); w.y = pk2(v[j][2], v[j][3]); *((GAS v2u*)(X1 + (size_t)row * D) + lane + 64 * j) = w; } }
        const float rstd = 1.0f / sqrtf(wave_sum(s) * (1.f / D) + EPS);
        GAS v2u* o = (GAS v2u*)(H + (size_t)row * D) + lane; float amx = 0.f;
#pragma unroll
        for (int j = 0; j < 4; ++j) {
#pragma unroll
            for (int i = 0; i < 4; ++i) { v[j][i] = v[j][i] * rstd * gs2[j][i] + sh2[j][i]; amx = fmaxf(amx, fabsf(v[j][i])); }
            v2u w; w.x = pk2(v[j][0], v[j][1]); w.y = pk2(v[j][2], v[j][3]); o[64 * j] = w; }
        amx = wave_max(amx); const float s8 = amx > 0.f ? 119.0f / amx : 1.0f;
        GAS unsigned short* ohh = (GAS unsigned short*)((unsigned char*)A.ws + WS_H8 + (size_t)row * (D / 2)) + lane; GAS unsigned short* ohl = (GAS unsigned short*)((unsigned char*)A.ws + WS_H8 + 32 * MiB + (size_t)row * (D / 2)) + lane;
#pragma unroll
        for (int j = 0; j < 4; ++j) { unsigned whh = 0, whl = 0;
#pragma unroll
            for (int i = 0; i < 4; ++i) { const int tq = __float2int_rn(v[j][i] * s8) + 8; whh |= ((unsigned)(tq >> 4) & 15u) << (4 * i); whl |= ((unsigned)((tq & 15) - 8) & 15u) << (4 * i); }
            ohh[64 * j] = (unsigned short)whh; ohl[64 * j] = (unsigned short)whl; }
        if (lane == 0) ((float*)(A.ws + WS_HS))[row] = amx > 0.f ? amx * (1.0f / 119.0f) : 1.0f;
#pragma unroll
        for (int j = 0; j < 4; ++j) { xv[j] = xn[j]; mw[j] = mn[j]; q[j] = qn[j]; }
    }
}
__device__ __forceinline__ void load64bf(const bf16* p, float (&o)[64]) {
#pragma unroll
    for (int i = 0; i < 8; ++i) { const v4u w = *(const GAS v4u*)(p + 8 * i);
        o[8 * i + 0] = bflo(w.x); o[8 * i + 1] = bfhi(w.x); o[8 * i + 2] = bflo(w.y); o[8 * i + 3] = bfhi(w.y);
        o[8 * i + 4] = bflo(w.z); o[8 * i + 5] = bfhi(w.z); o[8 * i + 6] = bflo(w.w); o[8 * i + 7] = bfhi(w.w); }
}
__device__ __forceinline__ void phase_attn_naive(const Args& A, int vb, int nvb) {
    const bf16* P = (const bf16*)(A.ws + WS_PROJ); bf16* MI = (bf16*)(A.ws + WS_MIXIN); const float* sinks = (const float*)A.in[I_SINK];
    for (int task = vb * NTHR + (int)threadIdx.x; task < 8 * M; task += nvb * NTHR) {
        const int h = task / M, t = task % M, s = t % SEQ, kvh = h >> 2;
        float q[64], o[64];
        load64bf(P + (size_t)t * NPROJ + C_AQ + h * 64, q);
#pragma unroll
        for (int d = 0; d < 64; ++d) o[d] = 0.f;
        float mx = sinks[h], l = 1.f;
        for (int j = 0; j < 128; ++j) {
            const int sj = s - 127 + j; const bool valid = sj >= 0; const int tk = valid ? (t - 127 + j) : t;
            const bf16* kr = P + (size_t)tk * NPROJ + C_AK + kvh * 64; float sc = 0.f;
#pragma unroll
            for (int i = 0; i < 8; ++i) { const v4u w = *(const GAS v4u*)(kr + 8 * i);
                sc += q[8 * i + 0] * bflo(w.x) + q[8 * i + 1] * bfhi(w.x) + q[8 * i + 2] * bflo(w.y) + q[8 * i + 3] * bfhi(w.y)
                    + q[8 * i + 4] * bflo(w.z) + q[8 * i + 5] * bfhi(w.z) + q[8 * i + 6] * bflo(w.w) + q[8 * i + 7] * bfhi(w.w); }
            if (valid) {
                const float mn = fmaxf(mx, sc), al = __expf(mx - mn), p = __expf(sc - mn); mx = mn; l = l * al + p;
                const bf16* vr = P + (size_t)tk * NPROJ + C_AV + kvh * 64;
#pragma unroll
                for (int i = 0; i < 8; ++i) { const v4u w = *(const GAS v4u*)(vr + 8 * i);
                    o[8 * i + 0] = o[8 * i + 0] * al + p * bflo(w.x); o[8 * i + 1] = o[8 * i + 1] * al + p * bfhi(w.x);
                    o[8 * i + 2] = o[8 * i + 2] * al + p * bflo(w.y); o[8 * i + 3] = o[8 * i + 3] * al + p * bfhi(w.y);
                    o[8 * i + 4] = o[8 * i + 4] * al + p * bflo(w.z); o[8 * i + 5] = o[8 * i + 5] * al + p * bfhi(w.z);
                    o[8 * i + 6] = o[8 * i + 6] * al + p * bflo(w.w); o[8 * i + 7] = o[8 * i + 7] * al + p * bfhi(w.w); }
            }
        }
        const float il = 1.f / l; bf16* orow = MI + (size_t)t * D + h * 64;
#pragma unroll
        for (int i = 0; i < 8; ++i) { v4u w; w.x = pk2(o[8 * i] * il, o[8 * i + 1] * il); w.y = pk2(o[8 * i + 2] * il, o[8 * i + 3] * il);
            w.z = pk2(o[8 * i + 4] * il, o[8 * i + 5] * il); w.w = pk2(o[8 * i + 6] * il, o[8 * i + 7] * il); *(GAS v4u*)(orow + 8 * i) = w; }
    }
}

__device__ __forceinline__ void phase_mlstm_naive(const Args& A, LAS unsigned char* lds, int bh) {
    const int tid = threadIdx.x, lane = tid & 63, wave = tid >> 6, b = bh >> 2, h = bh & 3, dv = tid >> 2, part = tid & 3;
    const bf16* P = (const bf16*)(A.ws + WS_PROJ); bf16* MI = (bf16*)(A.ws + WS_MIXIN); const float* gates = (const float*)(A.ws + WS_GATES);
    const float* cw = (const float*)A.in[I_CONVW]; const float* ng = (const float*)A.in[I_MNG];
    LAS float* qs = (LAS float*)lds; LAS float* ks = qs + 64 * 64; LAS float* vs = ks + 64 * 64; LAS float* ig = vs + 64 * 128; LAS float* lfg = ig + 64; LAS float* hb = lfg + 64;
    float C[16], n[16]; float m = 0.f;
#pragma unroll
    for (int j = 0; j < 16; ++j) { C[j] = 0.f; n[j] = 0.f; }
    for (int ch = 0; ch < SEQ / 64; ++ch) {
        const int s0 = ch * 64; const size_t t0 = (size_t)b * SEQ + s0;
        for (int e = tid; e < 64 * 64; e += NTHR) { const int l = e >> 6, dk = e & 63; float aq = 0.f, ak = 0.f;
#pragma unroll
            for (int j = 0; j < 4; ++j) { const int sj = s0 + l - 3 + j; if (sj >= 0) { const bf16* r = P + ((size_t)b * SEQ + sj) * NPROJ;
                aq += cw[j * 512 + h * 64 + dk] * bf1(r[C_MQ + h * 64 + dk]); ak += cw[j * 512 + 256 + h * 64 + dk] * bf1(r[C_MK + h * 64 + dk]); } }
            qs[e] = 0.125f * aq / (1.f + __expf(-aq)); ks[e] = ak / (1.f + __expf(-ak)); }
        for (int e = tid; e < 64 * 128; e += NTHR) { const int l = e >> 7, d = e & 127; vs[e] = bf1(P[(t0 + l) * NPROJ + C_MV + h * 128 + d]); }
        if (tid < 64) { ig[tid] = gates[(t0 + tid) * 8 + h]; lfg[tid] = gates[(t0 + tid) * 8 + 4 + h]; }
        __syncthreads();
        for (int l = 0; l < 64; ++l) {
            const float lf = lfg[l], ii = ig[l], mn = fmaxf(lf + m, ii), fd = __expf(lf + m - mn), iw = __expf(ii - mn), vv = vs[l * 128 + dv] * iw;
            float num = 0.f, den = 0.f;
#pragma unroll
            for (int j = 0; j < 16; ++j) { const float kk = ks[l * 64 + part * 16 + j], qq = qs[l * 64 + part * 16 + j];
                C[j] = fd * C[j] + vv * kk; n[j] = fd * n[j] + iw * kk; num += C[j] * qq; den += n[j] * qq; }
            num += __shfl_xor(num, 1); num += __shfl_xor(num, 2); den += __shfl_xor(den, 1); den += __shfl_xor(den, 2);
            if (part == 0) hb[l * 128 + dv] = num / fmaxf(fabsf(den), __expf(-mn));
            m = mn;
        }
        __syncthreads();
        for (int l = wave * 8; l < wave * 8 + 8; ++l) { const float a0 = hb[l * 128 + lane], a1 = hb[l * 128 + 64 + lane];
            const float r = 1.0f / sqrtf(wave_sum(a0 * a0 + a1 * a1) * (1.f / 128.f) + EPS);
            const bf16* pr = P + (t0 + l) * NPROJ + C_MO + h * 128; bf16* orow = MI + (t0 + l) * D + 512 + h * 128;
            orow[lane] = (bf16)f2bf(a0 * r * ng[h * 128 + lane] * bf1(pr[lane])); orow[64 + lane] = (bf16)f2bf(a1 * r * ng[h * 128 + 64 + lane] * bf1(pr[64 + lane])); }
        __syncthreads();
    }
}

__device__ __forceinline__ void ld16bf(const bf16* p, float (&o)[16]) {
    const v4u w0 = *(const GAS v4u*)p, w1 = *(const GAS v4u*)(p + 8);
    o[0] = bflo(w0.x); o[1] = bfhi(w0.x); o[2] = bflo(w0.y); o[3] = bfhi(w0.y); o[4] = bflo(w0.z); o[5] = bfhi(w0.z); o[6] = bflo(w0.w); o[7] = bfhi(w0.w);
    o[8] = bflo(w1.x); o[9] = bfhi(w1.x); o[10] = bflo(w1.y); o[11] = bfhi(w1.y); o[12] = bflo(w1.z); o[13] = bfhi(w1.z); o[14] = bflo(w1.w); o[15] = bfhi(w1.w);
}
typedef short bf16x8 __attribute__((ext_vector_type(8)));
#define MFMA16(a, b, c) __builtin_amdgcn_mfma_f32_16x16x32_bf16((a), (b), (c), 0, 0, 0)
__device__ __forceinline__ bf16x8 ldfrag(LAS const unsigned char* img, int row, int kbyte) { return *(LAS const bf16x8*)(img + row * 144 + kbyte); }
__device__ __forceinline__ unsigned cvtpk(float lo, float hi) { unsigned r; asm volatile("v_cvt_pk_bf16_f32 %0, %1, %2" : "=v"(r) : "v"(lo), "v"(hi)); return r; }

namespace ml {
constexpr int O_Q = 0, O_QA = 9216, O_K = 18432, O_KWT = 27648, O_VT = 36864, O_CX = 57600, CXB = 20736, O_S = 99072, O_GB = 108288, O_GA = O_GB + 4096, O_GC = O_GA + 4096, O_DEN = O_GC + 4096, O_SSQ = O_DEN + 256, O_END = O_SSQ + 2048;
static_assert(O_END <= 131072, "mlstm LDS");
constexpr size_t MST_SC = 11 * MiB;
}
template <bool OUT>
__device__ __forceinline__ void mlstm_group(const Args& A, LAS unsigned char* lds, int wg) {
    using namespace ml;
    const int tid = threadIdx.x, lane = tid & 63, wave = __builtin_amdgcn_readfirstlane(tid >> 6), fr = lane & 15, fq = lane >> 4;
    const int bh = wg >> 3, grp = wg & 7, b = bh >> 2, h = bh & 3;
    const size_t tg0 = (size_t)b * SEQ + (size_t)grp * 1024;
    const bf16* P = (const bf16*)(A.ws + WS_PROJ); bf16* MI = (bf16*)(A.ws + WS_MIXIN); const float* gates = (const float*)(A.ws + WS_GATES);
    const float* cw = (const float*)A.in[I_CONVW]; const float* ng = (const float*)A.in[I_MNG];
    float* MST = (float*)(A.ws + WS_MST); float* MSC = (float*)(A.ws + WS_MST + MST_SC);
    LAS float* GB = (LAS float*)(lds + O_GB); LAS float* GA = (LAS float*)(lds + O_GA); LAS float* GC = (LAS float*)(lds + O_GC);
    LAS float* DEN = (LAS float*)(lds + O_DEN); LAS float* SSQ = (LAS float*)(lds + O_SSQ);
    __syncthreads();
#pragma unroll
    for (int cc = 0; cc < 2; ++cc) { const int c = 2 * wave + cc; const size_t t = tg0 + c * 64 + lane;
        float bc = gates[t * 8 + 4 + h]; const float ii = gates[t * 8 + h];
#pragma unroll
        for (int o = 1; o < 64; o <<= 1) { const float v = __shfl_up(bc, o); if (lane >= o) bc += v; }
        const float a = ii - bc; float cm = a;
#pragma unroll
        for (int o = 1; o < 64; o <<= 1) { const float v = __shfl_up(cm, o); if (lane >= o) cm = fmaxf(cm, v); }
        GB[c * 64 + lane] = bc; GA[c * 64 + lane] = a; GC[c * 64 + lane] = cm; }
    for (int e = tid; e < 16 * 32; e += NTHR) { const int r = e >> 5, cpair = e & 31; *(LAS unsigned*)(lds + O_VT + (128 + r) * 144 + cpair * 4) = (r == 0) ? 0x3F803F80u : 0u; }
    f32x4 st[5];
#pragma unroll
    for (int i = 0; i < 5; ++i) st[i] = (f32x4){0.f, 0.f, 0.f, 0.f};
    float m = OUT ? 0.f : -__builtin_inff(); float Btot = 0.f;
    if (OUT) {
        for (int gp = 0; gp < grp; ++gp) { const int wgp = bh * 8 + gp; const float mg = MSC[wgp * 2], Bg = MSC[wgp * 2 + 1];
            const float mn = fmaxf(Bg + m, mg), f0 = __expf(Bg + m - mn), f1 = __expf(mg - mn);
#pragma unroll
            for (int i = 0; i < 5; ++i)
#pragma unroll
                for (int r = 0; r < 4; ++r) st[i][r] = f0 * st[i][r] + f1 * MST[((size_t)wgp * 20 + i * 4 + r) * NTHR + tid];
            m = mn; }
#pragma unroll
        for (int j = 0; j < 4; ++j)
#pragma unroll
            for (int r = 0; r < 4; ++r) *(LAS bf16*)(lds + O_CX + (16 * wave + 4 * fq + r) * 144 + (16 * j + fr) * 2) = (bf16)f2bf(st[j][r]);
        if (wave < 4) {
#pragma unroll
            for (int r = 0; r < 4; ++r) *(LAS bf16*)(lds + O_CX + (128 + 4 * fq + r) * 144 + (16 * wave + fr) * 2) = (bf16)f2bf(st[4][r]); }
    }
    float gsc[4];
#pragma unroll
    for (int r = 0; r < 4; ++r) gsc[r] = ng[h * 128 + 16 * wave + 4 * fq + r];
    const int sl = tid >> 3, cg = tid & 7;
    __syncthreads();
    for (int c = 0; c < 16; ++c) {
        const float bL = GB[c * 64 + 63], M63 = fmaxf(m, GC[c * 64 + 63]), decay = __expf(m - M63);
        const size_t tc0 = tg0 + (size_t)c * 64;
        {
            const int sabs = grp * 1024 + c * 64 + sl;
            float aq[8], ak[8];
#pragma unroll
            for (int i = 0; i < 8; ++i) { aq[i] = 0.f; ak[i] = 0.f; }
#pragma unroll
            for (int j = 0; j < 4; ++j) { const int sj = sabs - 3 + j;
                if (sj >= 0) { const bf16* rp = P + ((size_t)b * SEQ + sj) * NPROJ;
                    const v4u wq = *(const GAS v4u*)(rp + C_MQ + h * 64 + 8 * cg), wk = *(const GAS v4u*)(rp + C_MK + h * 64 + 8 * cg);
                    const f32x4 q0 = *(const GAS f32x4*)(cw + j * 512 + h * 64 + 8 * cg), q1 = *(const GAS f32x4*)(cw + j * 512 + h * 64 + 8 * cg + 4);
                    const f32x4 k0 = *(const GAS f32x4*)(cw + j * 512 + 256 + h * 64 + 8 * cg), k1 = *(const GAS f32x4*)(cw + j * 512 + 256 + h * 64 + 8 * cg + 4);
                    aq[0] += q0[0] * bflo(wq.x); aq[1] += q0[1] * bfhi(wq.x); aq[2] += q0[2] * bflo(wq.y); aq[3] += q0[3] * bfhi(wq.y);
                    aq[4] += q1[0] * bflo(wq.z); aq[5] += q1[1] * bfhi(wq.z); aq[6] += q1[2] * bflo(wq.w); aq[7] += q1[3] * bfhi(wq.w);
                    ak[0] += k0[0] * bflo(wk.x); ak[1] += k0[1] * bfhi(wk.x); ak[2] += k0[2] * bflo(wk.y); ak[3] += k0[3] * bfhi(wk.y);
                    ak[4] += k1[0] * bflo(wk.z); ak[5] += k1[1] * bfhi(wk.z); ak[6] += k1[2] * bflo(wk.w); ak[7] += k1[3] * bfhi(wk.w); } }
            const float Ml = fmaxf(m, GC[c * 64 + sl]), ainter = __expf(m - Ml), wsv = __expf(GA[c * 64 + sl] - M63);
            float qv[8], kv[8];
#pragma unroll
            for (int i = 0; i < 8; ++i) { qv[i] = 0.125f * aq[i] * __builtin_amdgcn_rcpf(1.f + __expf(-aq[i])); kv[i] = ak[i] * __builtin_amdgcn_rcpf(1.f + __expf(-ak[i])); }
            if (OUT) {
                v4u w; w.x = pk2(qv[0], qv[1]); w.y = pk2(qv[2], qv[3]); w.z = pk2(qv[4], qv[5]); w.w = pk2(qv[6], qv[7]); *(LAS v4u*)(lds + O_Q + sl * 144 + cg * 16) = w;
                w.x = pk2(qv[0] * ainter, qv[1] * ainter); w.y = pk2(qv[2] * ainter, qv[3] * ainter); w.z = pk2(qv[4] * ainter, qv[5] * ainter); w.w = pk2(qv[6] * ainter, qv[7] * ainter); *(LAS v4u*)(lds + O_QA + sl * 144 + cg * 16) = w;
                w.x = pk2(kv[0], kv[1]); w.y = pk2(kv[2], kv[3]); w.z = pk2(kv[4], kv[5]); w.w = pk2(kv[6], kv[7]); *(LAS v4u*)(lds + O_K + sl * 144 + cg * 16) = w;
            }
#pragma unroll
            for (int i = 0; i < 8; ++i) *(LAS bf16*)(lds + O_KWT + (8 * cg + i) * 144 + sl * 2) = (bf16)f2bf(kv[i] * wsv);
#pragma unroll
            for (int gi = 0; gi < 2; ++gi) { const int g8 = cg + 8 * gi; const v4u wv = *(const GAS v4u*)(P + (tc0 + sl) * NPROJ + C_MV + h * 128 + 8 * g8);
                const unsigned ww[4] = {wv.x, wv.y, wv.z, wv.w};
#pragma unroll
                for (int i = 0; i < 4; ++i) { *(LAS bf16*)(lds + O_VT + (8 * g8 + 2 * i) * 144 + sl * 2) = (bf16)(ww[i] & 0xffffu); *(LAS bf16*)(lds + O_VT + (8 * g8 + 2 * i + 1) * 144 + sl * 2) = (bf16)(ww[i] >> 16); } }
        }
        __syncthreads();
        if (OUT) {
            const int lt = wave >> 1, l = 16 * lt + fr; const float Ml = fmaxf(m, GC[c * 64 + l]);
            const bf16x8 bq0 = ldfrag(lds + O_Q, 16 * lt + fr, 16 * fq), bq1 = ldfrag(lds + O_Q, 16 * lt + fr, 64 + 16 * fq);
#pragma unroll
            for (int u = 0; u < 2; ++u) { const int stl = 2 * (wave & 1) + u; f32x4 acc = {0.f, 0.f, 0.f, 0.f};
                acc = MFMA16(ldfrag(lds + O_K, 16 * stl + fr, 16 * fq), bq0, acc); acc = MFMA16(ldfrag(lds + O_K, 16 * stl + fr, 64 + 16 * fq), bq1, acc);
                const f32x4 av = *(LAS const f32x4*)(GA + c * 64 + 16 * stl + 4 * fq); float wv[4];
#pragma unroll
                for (int r = 0; r < 4; ++r) { const int s = 16 * stl + 4 * fq + r; wv[r] = (s <= l) ? acc[r] * __expf(av[r] - Ml) : 0.f; }
                v2u w; w.x = cvtpk(wv[0], wv[1]); w.y = cvtpk(wv[2], wv[3]); *(LAS v2u*)(lds + O_S + l * 144 + (16 * stl + 4 * fq) * 2) = w; }
        }
        {
            const bf16x8 va0 = ldfrag(lds + O_VT, 16 * wave + fr, 16 * fq), va1 = ldfrag(lds + O_VT, 16 * wave + fr, 64 + 16 * fq);
#pragma unroll
            for (int j = 0; j < 4; ++j) { st[j] = st[j] * decay;
                st[j] = MFMA16(va0, ldfrag(lds + O_KWT, 16 * j + fr, 16 * fq), st[j]); st[j] = MFMA16(va1, ldfrag(lds + O_KWT, 16 * j + fr, 64 + 16 * fq), st[j]); }
            if (wave < 4) { st[4] = st[4] * decay;
                st[4] = MFMA16(ldfrag(lds + O_VT, 128 + fr, 16 * fq), ldfrag(lds + O_KWT, 16 * wave + fr, 16 * fq), st[4]);
                st[4] = MFMA16(ldfrag(lds + O_VT, 128 + fr, 64 + 16 * fq), ldfrag(lds + O_KWT, 16 * wave + fr, 64 + 16 * fq), st[4]); }
        }
        if (OUT) {
            __syncthreads();
            LAS const unsigned char* cx = lds + O_CX + (c & 1) * CXB;
            f32x4 nt[4], nd = {0.f, 0.f, 0.f, 0.f};
            {
                const bf16x8 va0 = ldfrag(lds + O_VT, 16 * wave + fr, 16 * fq), va1 = ldfrag(lds + O_VT, 16 * wave + fr, 64 + 16 * fq);
                const bf16x8 ca0 = ldfrag(cx, 16 * wave + fr, 16 * fq), ca1 = ldfrag(cx, 16 * wave + fr, 64 + 16 * fq);
#pragma unroll
                for (int lt = 0; lt < 4; ++lt) { f32x4 acc = {0.f, 0.f, 0.f, 0.f};
                    acc = MFMA16(va0, ldfrag(lds + O_S, 16 * lt + fr, 16 * fq), acc); acc = MFMA16(va1, ldfrag(lds + O_S, 16 * lt + fr, 64 + 16 * fq), acc);
                    acc = MFMA16(ca0, ldfrag(lds + O_QA, 16 * lt + fr, 16 * fq), acc); acc = MFMA16(ca1, ldfrag(lds + O_QA, 16 * lt + fr, 64 + 16 * fq), acc); nt[lt] = acc; }
                if (wave >= 4) { const int lt = wave - 4;
                    nd = MFMA16(ldfrag(lds + O_VT, 128 + fr, 16 * fq), ldfrag(lds + O_S, 16 * lt + fr, 16 * fq), nd); nd = MFMA16(ldfrag(lds + O_VT, 128 + fr, 64 + 16 * fq), ldfrag(lds + O_S, 16 * lt + fr, 64 + 16 * fq), nd);
                    nd = MFMA16(ldfrag(cx, 128 + fr, 16 * fq), ldfrag(lds + O_QA, 16 * lt + fr, 16 * fq), nd); nd = MFMA16(ldfrag(cx, 128 + fr, 64 + 16 * fq), ldfrag(lds + O_QA, 16 * lt + fr, 64 + 16 * fq), nd);
                    if (fq == 0) DEN[16 * lt + fr] = nd[0]; }
            }
            v2u mo[4];
#pragma unroll
            for (int lt = 0; lt < 4; ++lt) mo[lt] = *(const GAS v2u*)(P + (tc0 + 16 * lt + fr) * NPROJ + C_MO + h * 128 + 16 * wave + 4 * fq);
            __syncthreads();
#pragma unroll
            for (int lt = 0; lt < 4; ++lt) { const int l = 16 * lt + fr; const float Ml = fmaxf(m, GC[c * 64 + l]);
                const float inv = 1.0f / fmaxf(fabsf(DEN[l]), __expf(-(GB[c * 64 + l] + Ml)));
                nt[lt] = nt[lt] * inv; float ss = (nt[lt][0] * nt[lt][0] + nt[lt][1] * nt[lt][1]) + (nt[lt][2] * nt[lt][2] + nt[lt][3] * nt[lt][3]);
                ss += __shfl_xor(ss, 16); ss += __shfl_xor(ss, 32);
                if (fq == 0) SSQ[wave * 64 + l] = ss; }
            LAS unsigned char* cxn = lds + O_CX + ((c + 1) & 1) * CXB;
#pragma unroll
            for (int j = 0; j < 4; ++j)
#pragma unroll
                for (int r = 0; r < 4; ++r) *(LAS bf16*)(cxn + (16 * wave + 4 * fq + r) * 144 + (16 * j + fr) * 2) = (bf16)f2bf(st[j][r]);
            if (wave < 4) {
#pragma unroll
                for (int r = 0; r < 4; ++r) *(LAS bf16*)(cxn + (128 + 4 * fq + r) * 144 + (16 * wave + fr) * 2) = (bf16)f2bf(st[4][r]); }
            __syncthreads();
#pragma unroll
            for (int lt = 0; lt < 4; ++lt) { const int l = 16 * lt + fr; float tot = 0.f;
#pragma unroll
                for (int w2 = 0; w2 < 8; ++w2) tot += SSQ[w2 * 64 + l];
                const float rn = 1.0f / sqrtf(tot * (1.f / 128.f) + EPS);
                const float o0 = nt[lt][0] * rn * gsc[0] * bflo(mo[lt].x), o1 = nt[lt][1] * rn * gsc[1] * bfhi(mo[lt].x), o2 = nt[lt][2] * rn * gsc[2] * bflo(mo[lt].y), o3 = nt[lt][3] * rn * gsc[3] * bfhi(mo[lt].y);
                v2u w; w.x = pk2(o0, o1); w.y = pk2(o2, o3);
                *(GAS v2u*)(MI + (tc0 + l) * D + 512 + h * 128 + 16 * wave + 4 * fq) = w; }
        } else {
            __syncthreads();
        }
        m = bL + M63; Btot += bL;
    }
    if (!OUT) {
#pragma unroll
        for (int i = 0; i < 5; ++i)
#pragma unroll
            for (int r = 0; r < 4; ++r) MST[((size_t)wg * 20 + i * 4 + r) * NTHR + tid] = st[i][r];
        if (tid == 0) { MSC[wg * 2] = m; MSC[wg * 2 + 1] = Btot; }
    }
}

namespace at {
constexpr int O_K = 0, O_VT = 36864, VTS = 560  , O_END = O_VT + 64 * VTS;
static_assert(O_END <= 131072, "attention LDS");
}
__device__ __forceinline__ void phase_attn(const Args& A, LAS unsigned char* lds) {
    using namespace at;
    const int tid = threadIdx.x, lane = tid & 63, wave = __builtin_amdgcn_readfirstlane(tid >> 6), fr = lane & 15, fq = lane >> 4, G = gridDim.x;
    const bf16* P = (const bf16*)(A.ws + WS_PROJ); bf16* MI = (bf16*)(A.ws + WS_MIXIN); const float* sinks = (const float*)A.in[I_SINK];
    __syncthreads();
    for (int e = tid; e < 64 * 12; e += NTHR) { const int r = e / 12, cpair = e % 12; *(LAS unsigned*)(lds + O_VT + r * VTS + 512 + cpair * 4) = 0u; }
    for (int unit = blockIdx.x; unit < NB * 64 * 2; unit += G) {
        const int g = unit & 1, n = (unit >> 1) & 63, b = unit >> 7;
        const size_t tq0 = (size_t)b * SEQ + (size_t)n * 128;
        __syncthreads();
#pragma unroll
        for (int i = 0; i < 4; ++i) { const int item = tid + NTHR * i, row = item >> 3, ch = item & 7;
            v4u wk = {0u, 0u, 0u, 0u}, wv = {0u, 0u, 0u, 0u};
            if (n > 0 || row >= 128) { const bf16* rp = P + (tq0 - 128 + row) * NPROJ; wk = *(const GAS v4u*)(rp + C_AK + g * 64 + 8 * ch); wv = *(const GAS v4u*)(rp + C_AV + g * 64 + 8 * ch); }
            *(LAS v4u*)(lds + O_K + row * 144 + ch * 16) = wk;
            const unsigned ww[4] = {wv.x, wv.y, wv.z, wv.w};
#pragma unroll
            for (int k = 0; k < 4; ++k) { *(LAS bf16*)(lds + O_VT + (8 * ch + 2 * k) * VTS + row * 2) = (bf16)(ww[k] & 0xffffu); *(LAS bf16*)(lds + O_VT + (8 * ch + 2 * k + 1) * VTS + row * 2) = (bf16)(ww[k] >> 16); } }
        const int hq = 4 * g + (wave >> 1), qr0 = 64 * (wave & 1); const float sink = sinks[hq];
        __syncthreads();
        for (int qt = 0; qt < 4; ++qt) {
            const int i0 = qr0 + 16 * qt, st0 = i0 >> 4, iq = i0 + fr;
            const bf16* qp = P + (tq0 + iq) * NPROJ + C_AQ + hq * 64 + 8 * fq;
            const bf16x8 bq0 = *(const GAS bf16x8*)qp, bq1 = *(const GAS bf16x8*)(qp + 32);
            f32x4 sc[9]; float mx = sink;
#pragma unroll
            for (int t = 0; t < 9; ++t) { const int sb0 = 16 * (st0 + t); f32x4 acc = {0.f, 0.f, 0.f, 0.f};
                acc = MFMA16(ldfrag(lds + O_K, sb0 + fr, 16 * fq), bq0, acc); acc = MFMA16(ldfrag(lds + O_K, sb0 + fr, 64 + 16 * fq), bq1, acc);
#pragma unroll
                for (int r = 0; r < 4; ++r) { const int sb = sb0 + 4 * fq + r; const bool valid = (sb > iq) && (sb <= iq + 128) && (n > 0 || sb >= 128);
                    acc[r] = valid ? acc[r] : -3.0e38f; mx = fmaxf(mx, acc[r]); }
                sc[t] = acc; }
            mx = fmaxf(mx, __shfl_xor(mx, 16)); mx = fmaxf(mx, __shfl_xor(mx, 32));
            float lsum = 0.f;
#pragma unroll
            for (int t = 0; t < 9; ++t)
#pragma unroll
                for (int r = 0; r < 4; ++r) { const float p = (sc[t][r] > -1.0e38f) ? __expf(sc[t][r] - mx) : 0.f; sc[t][r] = p; lsum += p; }
            lsum += __shfl_xor(lsum, 16); lsum += __shfl_xor(lsum, 32); lsum += __expf(sink - mx);
            f32x4 oacc[4];
#pragma unroll
            for (int dt = 0; dt < 4; ++dt) oacc[dt] = (f32x4){0.f, 0.f, 0.f, 0.f};
#pragma unroll
            for (int ks = 0; ks < 5; ++ks) {
                union { bf16x8 v; unsigned u[4]; } pb;
                pb.u[0] = cvtpk(sc[2 * ks][0], sc[2 * ks][1]); pb.u[1] = cvtpk(sc[2 * ks][2], sc[2 * ks][3]);
                if (ks < 4) { pb.u[2] = cvtpk(sc[2 * ks + 1][0], sc[2 * ks + 1][1]); pb.u[3] = cvtpk(sc[2 * ks + 1][2], sc[2 * ks + 1][3]); } else { pb.u[2] = 0u; pb.u[3] = 0u; }
                const int sbb = 16 * (st0 + 2 * ks) + 4 * fq;
#pragma unroll
                for (int dt = 0; dt < 4; ++dt) { LAS const unsigned char* vp = lds + O_VT + (16 * dt + fr) * VTS + sbb * 2;
                    union { bf16x8 v; v2u h[2]; } va; va.h[0] = *(LAS const v2u*)vp; va.h[1] = *(LAS const v2u*)(vp + 32);
                    oacc[dt] = MFMA16(va.v, pb.v, oacc[dt]); } }
            const float il = 1.0f / lsum;
#pragma unroll
            for (int dt = 0; dt < 4; ++dt) { v2u w; w.x = pk2(oacc[dt][0] * il, oacc[dt][1] * il); w.y = pk2(oacc[dt][2] * il, oacc[dt][3] * il);
                *(GAS v2u*)(MI + (tq0 + iq) * D + hq * 64 + 16 * dt + 4 * fq) = w; }
        }
    }
}
typedef float f32x16 __attribute__((ext_vector_type(16)));
__device__ __forceinline__ unsigned fbits(float f) { return __builtin_bit_cast(unsigned, f); }
__device__ __forceinline__ float bfloat(unsigned u) { return __builtin_bit_cast(float, u); }

#define CE_DESC(a, b) do { const float _mx = __builtin_fmaxf(a, b), _mn = __builtin_fminf(a, b); a = _mx; b = _mn; } while (0)
__device__ __forceinline__ void bsort16(float (&v)[16]) {
#pragma unroll
    for (int k = 2; k <= 16; k <<= 1)
#pragma unroll
        for (int j = k >> 1; j > 0; j >>= 1)
#pragma unroll
            for (int i = 0; i < 16; ++i) { const int l = i ^ j; if (l > i) { if ((i & k) == 0) CE_DESC(v[i], v[l]); else CE_DESC(v[l], v[i]); } }
}
__device__ __forceinline__ void bmerge16(float (&v)[16], const float (&w)[16]) {
#pragma unroll
    for (int i = 0; i < 16; ++i) v[i] = __builtin_fmaxf(v[i], w[15 - i]);
#pragma unroll
    for (int j = 8; j > 0; j >>= 1)
#pragma unroll
        for (int i = 0; i < 16; ++i) { const int l = i ^ j; if (l > i) CE_DESC(v[i], v[l]); }
}
namespace tk {
constexpr int KS = 272;
constexpr int O_K1 = 0, O_K2 = 128 * KS, O_X = 2 * 128 * KS, O_END = O_X + 8 * 4096;
static_assert(O_END <= 131072, "topk LDS");
constexpr unsigned char CAND[64] = {
    0x00, 0x01, 0x02, 0x03, 0x04, 0x05, 0x06, 0x07, 0x08, 0x09, 0x0a, 0x0b, 0x0c, 0x0d, 0x0e, 0x0f,
    0x10, 0x11, 0x12, 0x13, 0x14, 0x15, 0x16, 0x17, 0x80, 0x90, 0xa0, 0xb0, 0xc0, 0xd0, 0xe0, 0xf0,
    0x20, 0x21, 0x22, 0x23, 0x24, 0x30, 0x31, 0x32, 0x33, 0x40, 0x41, 0x42, 0x50, 0x51, 0x60, 0x61,
    0x70, 0x71, 0xff, 0xff, 0xff, 0xff, 0xff, 0xff, 0xff, 0xff, 0xff, 0xff, 0xff, 0xff, 0xff, 0xff};
}
__device__ __forceinline__ void side_top16(const f32x16 (&acc)[4], int hh, float (&T)[16]) {
    float g1[16], g2[16];
#pragma unroll
    for (int r = 0; r < 16; ++r) { const unsigned key = (r & 3) + 8 * (r >> 2) + 4 * hh;
        T[r] = bfloat((fbits(acc[0][r]) & 0xffffff80u) | key);
        g1[r] = bfloat((fbits(acc[1][r]) & 0xffffff80u) | (32u + key)); }
    bsort16(T); bsort16(g1); bmerge16(T, g1);
#pragma unroll
    for (int r = 0; r < 16; ++r) { const unsigned key = (r & 3) + 8 * (r >> 2) + 4 * hh;
        g1[r] = bfloat((fbits(acc[2][r]) & 0xffffff80u) | (64u + key));
        g2[r] = bfloat((fbits(acc[3][r]) & 0xffffff80u) | (96u + key)); }
    bsort16(g1); bsort16(g2); bmerge16(g1, g2); bmerge16(T, g1);
#pragma unroll
    for (int r = 0; r < 16; ++r) g1[r] = __shfl_xor(T[r], 32);
    bmerge16(T, g1);
}
template <int SD> __device__ __forceinline__ void topk_side(const bf16* Q, LAS unsigned char* lds, int t, int h, int r32, int hh, float (&T)[16]) {
    using namespace tk;
    f32x16 acc[4];
#pragma unroll
    for (int mt = 0; mt < 4; ++mt)
#pragma unroll
        for (int r = 0; r < 16; ++r) acc[mt][r] = 0.f;
    const bf16* qp = Q + (size_t)t * 2048 + h * 256 + SD * 128 + 8 * hh; LAS const unsigned char* kimg = lds + (SD ? O_K2 : O_K1);
#pragma unroll
    for (int ks = 0; ks < 8; ++ks) { const bf16x8 bq = *(const GAS bf16x8*)(qp + 16 * ks);
#pragma unroll
        for (int mt = 0; mt < 4; ++mt) acc[mt] = __builtin_amdgcn_mfma_f32_32x32x16_bf16(*(LAS const bf16x8*)(kimg + (32 * mt + r32) * KS + 32 * ks + 16 * hh), bq, acc[mt], 0, 0, 0); }
    side_top16(acc, hh, T);
}
template <int Q> __device__ __forceinline__ float cand_val(const float (&T1)[16], const float (&T2)[16], int hh) {
    constexpr unsigned c0 = tk::CAND[2 * Q], c1 = tk::CAND[2 * Q + 1];
    const float s = (hh ? T1[(c1 >> 4) & 15] : T1[(c0 >> 4) & 15]) + (hh ? T2[c1 & 15] : T2[c0 & 15]); const unsigned code = hh ? c1 : c0;
    return (code == 0xffu) ? -3.0e38f : bfloat((fbits(s) & 0xffffff00u) | code);
}
__device__ __forceinline__ void phase_topk(const Args& A, LAS unsigned char* lds) {
    using namespace tk;
    const int tid = threadIdx.x, lane = tid & 63, wave = __builtin_amdgcn_readfirstlane(tid >> 6), G = gridDim.x;
    const bf16* Q = (const bf16*)(A.ws + WS_PROJ); const bf16* KB = (const bf16*)(A.ws + WS_KEYS);
    unsigned short* EI = (unsigned short*)(A.ws + WS_EIDX); float* GT = (float*)(A.ws + WS_GATE);
    const int h = blockIdx.x & 7, r32 = lane & 31, hh = lane >> 5;
    __syncthreads();
    for (int e = tid; e < 2 * 128 * 16; e += NTHR) { const int s = e >> 11, row = (e >> 4) & 127, ch = e & 15;
        *(LAS v4u*)(lds + (s ? O_K2 : O_K1) + row * KS + ch * 16) = *(const GAS v4u*)(KB + (size_t)s * 8 * 128 * 128 + ((size_t)h * 128 + row) * 128 + ch * 8); }
    __syncthreads();
    LAS float* XW = (LAS float*)(lds + O_X + wave * 4096) + r32 * 32;
    for (int tile = (int)(blockIdx.x >> 3); tile < M / 256; tile += (G >> 3)) {
        const int t = tile * 256 + 32 * wave + r32;
        float T1[16], T2[16];
        topk_side<0>(Q, lds, t, h, r32, hh, T1);
        topk_side<1>(Q, lds, t, h, r32, hh, T2);
        float c[16], w[16];
        c[0] = cand_val<0>(T1, T2, hh); w[0] = cand_val<16>(T1, T2, hh);
        c[1] = cand_val<1>(T1, T2, hh); w[1] = cand_val<17>(T1, T2, hh);
        c[2] = cand_val<2>(T1, T2, hh); w[2] = cand_val<18>(T1, T2, hh);
        c[3] = cand_val<3>(T1, T2, hh); w[3] = cand_val<19>(T1, T2, hh);
        c[4] = cand_val<4>(T1, T2, hh); w[4] = cand_val<20>(T1, T2, hh);
        c[5] = cand_val<5>(T1, T2, hh); w[5] = cand_val<21>(T1, T2, hh);
        c[6] = cand_val<6>(T1, T2, hh); w[6] = cand_val<22>(T1, T2, hh);
        c[7] = cand_val<7>(T1, T2, hh); w[7] = cand_val<23>(T1, T2, hh);
        c[8] = cand_val<8>(T1, T2, hh); w[8] = cand_val<24>(T1, T2, hh);
        c[9] = cand_val<9>(T1, T2, hh); w[9] = cand_val<25>(T1, T2, hh);
        c[10] = cand_val<10>(T1, T2, hh); w[10] = cand_val<26>(T1, T2, hh);
        c[11] = cand_val<11>(T1, T2, hh); w[11] = cand_val<27>(T1, T2, hh);
        c[12] = cand_val<12>(T1, T2, hh); w[12] = cand_val<28>(T1, T2, hh);
        c[13] = cand_val<13>(T1, T2, hh); w[13] = cand_val<29>(T1, T2, hh);
        c[14] = cand_val<14>(T1, T2, hh); w[14] = cand_val<30>(T1, T2, hh);
        c[15] = cand_val<15>(T1, T2, hh); w[15] = cand_val<31>(T1, T2, hh);
        bsort16(c); bsort16(w); bmerge16(c, w);
#pragma unroll
        for (int r = 0; r < 16; ++r) w[r] = __shfl_xor(c[r], 32);
        bmerge16(c, w);
        if (hh == 0) {
#pragma unroll
            for (int q4 = 0; q4 < 4; ++q4) { *(LAS f32x4*)(XW + 4 * q4) = (f32x4){T1[4 * q4], T1[4 * q4 + 1], T1[4 * q4 + 2], T1[4 * q4 + 3]};
                *(LAS f32x4*)(XW + 16 + 4 * q4) = (f32x4){T2[4 * q4], T2[4 * q4 + 1], T2[4 * q4 + 2], T2[4 * q4 + 3]}; } }
        asm volatile("s_waitcnt lgkmcnt(0)" ::: "memory");
        float ex[16], sum = 0.f; const float tmax = bfloat(fbits(c[0]) & 0xffffff00u);
#pragma unroll
        for (int r = 0; r < 16; ++r) { ex[r] = __expf(bfloat(fbits(c[r]) & 0xffffff00u) - tmax); sum += ex[r]; }
        const float isum = 1.0f / sum; const size_t ob = (size_t)t * NSLOT + (size_t)(8 * hh) * 8 + h;
#pragma unroll
        for (int r = 0; r < 8; ++r) { float ca = c[r], cb = c[8 + r], ea = ex[r], eb = ex[8 + r]; asm volatile("" : "+v"(ca), "+v"(cb), "+v"(ea), "+v"(eb)); const float cv = hh ? cb : ca, ev = hh ? eb : ea;
            const unsigned code = fbits(cv) & 0xffu;
            const unsigned i1 = fbits(XW[code >> 4]) & 127u, i2 = fbits(XW[16 + (code & 15)]) & 127u;
            EI[ob + 8 * r] = (unsigned short)(i1 * 128u + i2); GT[ob + 8 * r] = ev * isum; }
        asm volatile("s_waitcnt lgkmcnt(0)" ::: "memory");
    }
}
struct PeerIdx { v4u e0, e1; };
__device__ __forceinline__ PeerIdx peer_ld_idx(const unsigned short* EI, int t, int g) { PeerIdx r; r.e0 = *(const GAS v4u*)(EI + (size_t)t * NSLOT + 16 * g); r.e1 = *(const GAS v4u*)(EI + (size_t)t * NSLOT + 16 * g + 8); return r; }
template <int ROWB = 1024> __device__ __forceinline__ void peer_gather(const unsigned char* T8, const PeerIdx& ix, int colb, v4u (&raw)[16]) {
    const unsigned ew[8] = {ix.e0.x, ix.e0.y, ix.e0.z, ix.e0.w, ix.e1.x, ix.e1.y, ix.e1.z, ix.e1.w};
#pragma unroll
    for (int k = 0; k < 16; ++k) { const unsigned e = (k & 1) ? (ew[k >> 1] >> 16) : (ew[k >> 1] & 0xffffu); raw[k] = *(const GAS v4u*)(T8 + (size_t)e * ROWB + colb); }
}
__device__ __forceinline__ void cvt16_fp8_pk(const v4u w, f32x2 (&o)[8]) {
    const unsigned ww[4] = {w.x, w.y, w.z, w.w};
#pragma unroll
    for (int i = 0; i < 4; ++i) { o[2 * i] = __builtin_amdgcn_cvt_pk_f32_fp8((int)ww[i], false); o[2 * i + 1] = __builtin_amdgcn_cvt_pk_f32_fp8((int)ww[i], true); }
}
__device__ __forceinline__ void peer_u_reduce(const v4u (&raw)[16], const f32x2 (&hv)[8], float* PDrow, int lane, int g, int c) {
    float d[16];
#pragma unroll
    for (int k = 0; k < 16; ++k) { f32x2 uf[8]; cvt16_fp8_pk(raw[k], uf); f32x2 s = uf[0] * hv[0];
#pragma unroll
        for (int i = 1; i < 8; ++i) s += uf[i] * hv[i];
        d[k] = s.x + s.y; }
#pragma unroll
    for (int i = 0; i < 8; ++i) { const bool up = (lane & 4) != 0; const float keep = up ? d[i + 8] : d[i], send = up ? d[i] : d[i + 8]; d[i] = keep + __shfl_xor(send, 4); }
#pragma unroll
    for (int i = 0; i < 4; ++i) { const bool up = (lane & 2) != 0; const float keep = up ? d[i + 4] : d[i], send = up ? d[i] : d[i + 4]; d[i] = keep + __shfl_xor(send, 2); }
#pragma unroll
    for (int i = 0; i < 2; ++i) { const bool up = (lane & 1) != 0; const float keep = up ? d[i + 2] : d[i], send = up ? d[i] : d[i + 2]; d[i] = keep + __shfl_xor(send, 1); }
    *(GAS f32x2*)(PDrow + 16 * g + 2 * c) = (f32x2){d[0], d[1]};
}
__device__ __forceinline__ void ld16bf_pk(const bf16* p, f32x2 (&o)[8]) {
    const v4u w0 = *(const GAS v4u*)p, w1 = *(const GAS v4u*)(p + 8); const unsigned ww[8] = {w0.x, w0.y, w0.z, w0.w, w1.x, w1.y, w1.z, w1.w};
#pragma unroll
    for (int i = 0; i < 8; ++i) o[i] = (f32x2){bflo(ww[i]), bfhi(ww[i])};
}
__device__ __forceinline__ void peer_u_reduce_i4(const v4u (&raw)[16], const v4u hh, const v4u hl, int* PDrow, int lane, int g, int c) {
    int d[16];
#pragma unroll
    for (int k = 0; k < 16; ++k) { int sh = __builtin_amdgcn_sdot8((int)raw[k].x, (int)hh.x, 0, false), sl = __builtin_amdgcn_sdot8((int)raw[k].x, (int)hl.x, 0, false);
        sh = __builtin_amdgcn_sdot8((int)raw[k].y, (int)hh.y, sh, false); sl = __builtin_amdgcn_sdot8((int)raw[k].y, (int)hl.y, sl, false);
        sh = __builtin_amdgcn_sdot8((int)raw[k].z, (int)hh.z, sh, false); sl = __builtin_amdgcn_sdot8((int)raw[k].z, (int)hl.z, sl, false);
        sh = __builtin_amdgcn_sdot8((int)raw[k].w, (int)hh.w, sh, false); sl = __builtin_amdgcn_sdot8((int)raw[k].w, (int)hl.w, sl, false);
        d[k] = 16 * sh + sl; }
#pragma unroll
    for (int i = 0; i < 8; ++i) { const bool up = (lane & 4) != 0; const int keep = up ? d[i + 8] : d[i], send = up ? d[i] : d[i + 8]; d[i] = keep + __shfl_xor(send, 4); }
#pragma unroll
    for (int i = 0; i < 4; ++i) { const bool up = (lane & 2) != 0; const int keep = up ? d[i + 4] : d[i], send = up ? d[i] : d[i + 4]; d[i] = keep + __shfl_xor(send, 2); }
#pragma unroll
    for (int i = 0; i < 2; ++i) { const bool up = (lane & 1) != 0; const int keep = up ? d[i + 2] : d[i], send = up ? d[i] : d[i + 2]; d[i] = keep + __shfl_xor(send, 1); }
    *(GAS v2u*)(PDrow + 16 * g + 2 * c) = (v2u){(unsigned)d[0], (unsigned)d[1]};
}
__device__ __forceinline__ void phase_peer_u(const Args& A) {
    const int tid = threadIdx.x, lane = tid & 63, wave = tid >> 6, p = blockIdx.x & 7, q = p & 3, half = p >> 2, j = blockIdx.x >> 3, nj = gridDim.x >> 3, g = lane >> 3, c = lane & 7;
    const unsigned char* HH = (const unsigned char*)(A.ws + WS_H8); const unsigned char* HL = HH + 32 * MiB; const unsigned char* U4 = (const unsigned char*)(A.ws + WS_U8); const unsigned short* EI = (const unsigned short*)(A.ws + WS_EIDX);
    int* PD = (int*)(A.ws + WS_PD) + (size_t)q * M * NSLOT;
    const int tper = (M / 2) / nj, colb = 128 * q + 16 * c, tbeg = half * (M / 2) + j * tper, tend = tbeg + tper, tlast = tend - NWAVES + wave;
    int t = tbeg + wave;
    PeerIdx ix1 = peer_ld_idx(EI, min(t + NWAVES, tlast), g), ix2 = peer_ld_idx(EI, min(t + 2 * NWAVES, tlast), g);
    v4u rawa[16], rawb[16], hha, hla, hhb, hlb;
    { const PeerIdx ix0 = peer_ld_idx(EI, t, g); peer_gather<512>(U4, ix0, colb, rawa); hha = *(const GAS v4u*)(HH + (size_t)t * 512 + colb); hla = *(const GAS v4u*)(HL + (size_t)t * 512 + colb); }
    for (; t < tend; t += 2 * NWAVES) {
        const int t1 = t + NWAVES, t2 = min(t + 2 * NWAVES, tlast), t3 = min(t + 3 * NWAVES, tlast), t4 = min(t + 4 * NWAVES, tlast);
        const PeerIdx ix3 = peer_ld_idx(EI, t3, g);
        peer_gather<512>(U4, ix1, colb, rawb); hhb = *(const GAS v4u*)(HH + (size_t)t1 * 512 + colb); hlb = *(const GAS v4u*)(HL + (size_t)t1 * 512 + colb);
        peer_u_reduce_i4(rawa, hha, hla, PD + (size_t)t * NSLOT, lane, g, c);
        const PeerIdx ix4 = peer_ld_idx(EI, t4, g);
        peer_gather<512>(U4, ix2, colb, rawa); hha = *(const GAS v4u*)(HH + (size_t)t2 * 512 + colb); hla = *(const GAS v4u*)(HL + (size_t)t2 * 512 + colb);
        peer_u_reduce_i4(rawb, hhb, hlb, PD + (size_t)t1 * NSLOT, lane, g, c);
        ix1 = ix3; ix2 = ix4;
    }
}
__device__ __forceinline__ void phase_peer_act(const Args& A) {
    const int* PD = (const int*)(A.ws + WS_PD); const unsigned short* EI = (const unsigned short*)(A.ws + WS_EIDX); const float* GT = (const float*)(A.ws + WS_GATE);
    const float* usc = (const float*)(A.ws + WS_SC); const float* vsc = usc + NEXP; const float* hs = (const float*)(A.ws + WS_HS); float* ACT = (float*)(A.ws + WS_ACT);
    for (size_t i = (size_t)blockIdx.x * NTHR + threadIdx.x; i < (size_t)M * NSLOT; i += (size_t)gridDim.x * NTHR) {
        int si = 0;
#pragma unroll
        for (int p = 0; p < 4; ++p) si += PD[(size_t)p * M * NSLOT + i];
        const unsigned e = EI[i]; float s = (float)si * (usc[e] * hs[i >> 7]);
        ACT[i] = 0.5f * s * (1.f + erff(s * 0.70710678118654752f)) * GT[i] * vsc[e];
    }
}
struct PeerAct { f32x4 a0, a1, a2, a3; };
__device__ __forceinline__ PeerAct peer_ld_act(const float* ACT, int t, int g) { const GAS f32x4* ap = (const GAS f32x4*)(ACT + (size_t)t * NSLOT + 16 * g); PeerAct r; r.a0 = ap[0]; r.a1 = ap[1]; r.a2 = ap[2]; r.a3 = ap[3]; return r; }
__device__ __forceinline__ void peer_v_accum(const v4u (&raw)[16], const PeerAct& pa, f32x2 (&y2)[16]) {
    const float av[16] = {pa.a0[0], pa.a0[1], pa.a0[2], pa.a0[3], pa.a1[0], pa.a1[1], pa.a1[2], pa.a1[3], pa.a2[0], pa.a2[1], pa.a2[2], pa.a2[3], pa.a3[0], pa.a3[1], pa.a3[2], pa.a3[3]};
#pragma unroll
    for (int k = 0; k < 16; ++k) { const unsigned ww[4] = {raw[k].x, raw[k].y, raw[k].z, raw[k].w}; const f32x2 a2 = (f32x2){av[k], av[k]};
#pragma unroll
        for (int w = 0; w < 4; ++w) { y2[4 * w + 0] += a2 * __builtin_amdgcn_cvt_scalef32_pk_f32_fp4(ww[w], 1.0f, 0); y2[4 * w + 1] += a2 * __builtin_amdgcn_cvt_scalef32_pk_f32_fp4(ww[w], 1.0f, 1);
            y2[4 * w + 2] += a2 * __builtin_amdgcn_cvt_scalef32_pk_f32_fp4(ww[w], 1.0f, 2); y2[4 * w + 3] += a2 * __builtin_amdgcn_cvt_scalef32_pk_f32_fp4(ww[w], 1.0f, 3); } }
}
__device__ __forceinline__ void peer_v_store(f32x2 (&y2)[16], bf16* Yp, float* ssy, int c) {
    float ss = 0.f; unsigned w[16];
#pragma unroll
    for (int i = 0; i < 16; ++i) { ss += y2[i].x * y2[i].x + y2[i].y * y2[i].y; w[i] = pk2(y2[i].x, y2[i].y); y2[i] = (f32x2){0.f, 0.f}; }
#pragma unroll
    for (int i = 0; i < 4; ++i) *(GAS v4u*)(Yp + 8 * i) = (v4u){w[4 * i], w[4 * i + 1], w[4 * i + 2], w[4 * i + 3]};
    ss += __shfl_xor(ss, 1); ss += __shfl_xor(ss, 2); ss += __shfl_xor(ss, 4);
    if (c == 0) *ssy = ss;
}
__device__ __forceinline__ void phase_peer_v(const Args& A) {
    const int tid = threadIdx.x, lane = tid & 63, wave = tid >> 6, p = blockIdx.x & 7, q = p & 3, half = p >> 2, j = blockIdx.x >> 3, nj = gridDim.x >> 3, g = lane >> 3, c = lane & 7;
    const unsigned char* V4 = (const unsigned char*)(A.ws + WS_V8); const unsigned short* EI = (const unsigned short*)(A.ws + WS_EIDX); const float* ACT = (const float*)(A.ws + WS_ACT);
    bf16* Y = (bf16*)(A.ws + WS_H); float* SSY = (float*)(A.ws + WS_SSY);
    const int tper = (M / 2) / nj, colb = 128 * q + 16 * c, tbeg = half * (M / 2) + j * tper + wave * (tper / NWAVES);
    const int nstep = (tper / NWAVES / 8) * 8;
    auto rowof = [&](int s) { s = min(s, nstep - 1); return (size_t)(tbeg + 8 * (s >> 3) + g) * 8 + (s & 7); };
    f32x2 y2[16];
#pragma unroll
    for (int i = 0; i < 16; ++i) y2[i] = (f32x2){0.f, 0.f};
    auto ldidx = [&](int s) { const size_t r = rowof(s); PeerIdx x; x.e0 = *(const GAS v4u*)(EI + r * 16); x.e1 = *(const GAS v4u*)(EI + r * 16 + 8); return x; };
    auto ldact = [&](int s) { const GAS f32x4* ap = (const GAS f32x4*)(ACT + rowof(s) * 16); PeerAct r; r.a0 = ap[0]; r.a1 = ap[1]; r.a2 = ap[2]; r.a3 = ap[3]; return r; };
    PeerIdx ix1 = ldidx(1), ix2 = ldidx(2);
    v4u rawa[16], rawb[16]; PeerAct aca, acb;
    { const PeerIdx ix0 = ldidx(0); peer_gather<512>(V4, ix0, colb, rawa); aca = ldact(0); }
    for (int s = 0; s < nstep; s += 2) {
        const PeerIdx ix3 = ldidx(s + 3);
        peer_gather<512>(V4, ix1, colb, rawb); acb = ldact(s + 1);
        peer_v_accum(rawa, aca, y2);
        const PeerIdx ix4 = ldidx(s + 4);
        peer_gather<512>(V4, ix2, colb, rawa); aca = ldact(s + 2);
        peer_v_accum(rawb, acb, y2);
        if ((s & 7) == 6) { const int t = tbeg + 8 * (s >> 3) + g; peer_v_store(y2, Y + (size_t)t * D + 256 * q + 32 * c, SSY + (size_t)t * 8 + q, c); }
        ix1 = ix3; ix2 = ix4;
    }
}
__device__ __forceinline__ void phase_peer_final(const Args& A) {
    const int tid = threadIdx.x, lane = tid & 63, wave = tid >> 6, G = gridDim.x;
    const bf16* Y = (const bf16*)(A.ws + WS_H); const bf16* X1 = (const bf16*)(A.ws + WS_X1); const float* SSY = (const float*)(A.ws + WS_SSY); const float* mod = (const float*)(A.ws + WS_MOD); const float* gpost = (const float*)A.in[I_GPOST2]; float* out = A.out;
    f32x4 gp[4];
#pragma unroll
    for (int q = 0; q < 4; ++q) gp[q] = *(const GAS f32x4*)(gpost + 4 * (lane + 64 * q));
    const int stride = G * NWAVES; int row = blockIdx.x * NWAVES + wave;
    v2u xw[4], yw[4], xwn[4], ywn[4]; f32x4 s0, s0n, g2p[4]; int bcur = -1;
#pragma unroll
    for (int q = 0; q < 4; ++q) { xw[q] = ((const GAS v2u*)(X1 + (size_t)row * D) + lane)[64 * q]; yw[q] = ((const GAS v2u*)(Y + (size_t)row * D) + lane)[64 * q]; }
    s0 = *(const GAS f32x4*)(SSY + (size_t)row * 8);
    for (; row < M; row += stride) {
        const int rn = min(row + stride, M - 1);
#pragma unroll
        for (int q = 0; q < 4; ++q) { xwn[q] = ((const GAS v2u*)(X1 + (size_t)rn * D) + lane)[64 * q]; ywn[q] = ((const GAS v2u*)(Y + (size_t)rn * D) + lane)[64 * q]; }
        s0n = *(const GAS f32x4*)(SSY + (size_t)rn * 8);
        const int b = row / SEQ;
        if (b != bcur) { bcur = b;
#pragma unroll
            for (int q = 0; q < 4; ++q) { const f32x4 g2 = *(const GAS f32x4*)(mod + b * 6144 + 5120 + 4 * (lane + 64 * q));
#pragma unroll
                for (int i = 0; i < 4; ++i) g2p[q][i] = g2[i] * gp[q][i]; } }
        const float rstd = 1.0f / sqrtf(((s0[0] + s0[1]) + (s0[2] + s0[3])) * (1.f / D) + EPS);
        GAS f32x4* orow = (GAS f32x4*)(out + (size_t)row * D) + lane;
#pragma unroll
        for (int q = 0; q < 4; ++q) { f32x4 xv = {bflo(xw[q].x), bfhi(xw[q].x), bflo(xw[q].y), bfhi(xw[q].y)};
            xv[0] += g2p[q][0] * (bflo(yw[q].x) * rstd); xv[1] += g2p[q][1] * (bfhi(yw[q].x) * rstd); xv[2] += g2p[q][2] * (bflo(yw[q].y) * rstd); xv[3] += g2p[q][3] * (bfhi(yw[q].y) * rstd);
            orow[64 * q] = xv; }
#pragma unroll
        for (int q = 0; q < 4; ++q) { xw[q] = xwn[q]; yw[q] = ywn[q]; }
        s0 = s0n;
    }
}
#ifdef PROBE_V_LOADS
__device__ __forceinline__ void probe_v_loads(const Args& A) {
    const int tid = threadIdx.x, lane = tid & 63, wave = tid >> 6, p = blockIdx.x & 7, j = blockIdx.x >> 3, nj = gridDim.x >> 3, g = lane >> 3, c = lane & 7;
    const unsigned char* V8 = (const unsigned char*)(A.ws + WS_V8); const unsigned short* EI = (const unsigned short*)(A.ws + WS_EIDX); const float* ACT = (const float*)(A.ws + WS_ACT);
    unsigned* DUMP = (unsigned*)(A.ws + WS_PD);
    const int tper = M / nj, colb = 128 * p + 16 * c, tend = (j + 1) * tper, tlast = tend - NWAVES + wave;
    int t = j * tper + wave;
    PeerIdx ix1 = peer_ld_idx(EI, min(t + NWAVES, tlast), g), ix2 = peer_ld_idx(EI, min(t + 2 * NWAVES, tlast), g);
    v4u rawa[16], rawb[16]; PeerAct aca, acb;
    { const PeerIdx ix0 = peer_ld_idx(EI, t, g); peer_gather(V8, ix0, colb, rawa); aca = peer_ld_act(ACT, t, g); }
    for (; t < tend; t += 2 * NWAVES) {
        const int t1 = t + NWAVES, t2 = min(t + 2 * NWAVES, tlast), t3 = min(t + 3 * NWAVES, tlast), t4 = min(t + 4 * NWAVES, tlast);
        const PeerIdx ix3 = peer_ld_idx(EI, t3, g);
        peer_gather(V8, ix1, colb, rawb); acb = peer_ld_act(ACT, t1, g);
        { unsigned s = __builtin_bit_cast(unsigned, aca.a0[0]) + __builtin_bit_cast(unsigned, aca.a3[3]);
#pragma unroll
          for (int k = 0; k < 16; ++k) s += (rawa[k].x + rawa[k].y) + (rawa[k].z + rawa[k].w);
          DUMP[(size_t)t * 512 + p * 64 + lane] = s; }
        const PeerIdx ix4 = peer_ld_idx(EI, t4, g);
        peer_gather(V8, ix2, colb, rawa); aca = peer_ld_act(ACT, t2, g);
        { unsigned s = __builtin_bit_cast(unsigned, acb.a0[0]) + __builtin_bit_cast(unsigned, acb.a3[3]);
#pragma unroll
          for (int k = 0; k < 16; ++k) s += (rawb[k].x + rawb[k].y) + (rawb[k].z + rawb[k].w);
          DUMP[(size_t)t1 * 512 + p * 64 + lane] = s; }
        ix1 = ix3; ix2 = ix4;
    }
}
#endif

#ifdef PROBE_INSTR
__device__ __forceinline__ void probe_instr(const Args& A) {
    f32x2 a[8]; float f[16]; unsigned w = threadIdx.x * 0x01010101u + 0x38383838u;
#pragma unroll
    for (int i = 0; i < 8; ++i) a[i] = (f32x2){1.0f + i, 2.0f + i};
#pragma unroll
    for (int i = 0; i < 16; ++i) f[i] = 1.0f + i;
    for (int it = 0; it < 10000; ++it) {
#if PROBE_INSTR == 1
#pragma unroll
        for (int i = 0; i < 8; ++i) { asm volatile("v_pk_fma_f32 %0, %1, %2, %0" : "+v"(a[i]) : "v"(a[(i + 1) & 7]), "v"(a[(i + 2) & 7])); asm volatile("v_pk_fma_f32 %0, %1, %2, %0" : "+v"(a[i]) : "v"(a[(i + 3) & 7]), "v"(a[(i + 4) & 7])); }
#elif PROBE_INSTR == 2
#pragma unroll
        for (int i = 0; i < 16; ++i) asm volatile("v_fma_f32 %0, %1, %2, %0" : "+v"(f[i]) : "v"(f[(i + 1) & 15]), "v"(f[(i + 2) & 15]));
#elif PROBE_INSTR == 3
#pragma unroll
        for (int i = 0; i < 8; ++i) { asm volatile("v_cvt_pk_f32_fp8 %0, %1" : "=v"(a[i]) : "v"(w)); asm volatile("v_cvt_pk_f32_fp8 %0, %1" : "=v"(a[i]) : "v"(w)); }
#elif PROBE_INSTR == 4
#pragma unroll
        for (int i = 0; i < 8; ++i) { asm volatile("v_cvt_scalef32_pk_f32_fp4 %0, %1, 1.0" : "=v"(a[i]) : "v"(w)); asm volatile("v_cvt_scalef32_pk_f32_fp4 %0, %1, 1.0" : "=v"(a[i]) : "v"(w)); }
#elif PROBE_INSTR == 5
#pragma unroll
        for (int i = 0; i < 16; ++i) asm volatile("v_pk_fma_f16 %0, %1, %2, %0" : "+v"(f[i]) : "v"(f[(i + 1) & 15]), "v"(f[(i + 2) & 15]));
#elif PROBE_INSTR == 7
#pragma unroll
        for (int i = 0; i < 16; ++i) asm volatile("v_dot8c_i32_i4 %0, %1, %2" : "+v"(f[i]) : "v"(f[(i + 1) & 15]), "v"(w));
#elif PROBE_INSTR == 8
#pragma unroll
        for (int i = 0; i < 16; ++i) asm volatile("v_dot4c_i32_i8 %0, %1, %2" : "+v"(f[i]) : "v"(f[(i + 1) & 15]), "v"(w));
#elif PROBE_INSTR == 9
#pragma unroll
        for (int i = 0; i < 16; ++i) asm volatile("v_perm_b32 %0, %1, %2, %3" : "=v"(f[i]) : "v"(f[(i + 1) & 15]), "v"(f[(i + 2) & 15]), "v"(w));
#elif PROBE_INSTR == 10
#pragma unroll
        for (int i = 0; i < 16; ++i) asm volatile("v_mfma_f32_16x16x32_fp8_fp8 %0, %1, %2, %0" : "+v"(*(f32x4*)&f[4 * (i & 3)]) : "v"(a[i & 7]), "v"(a[(i + 1) & 7]));
#elif PROBE_INSTR == 6
#pragma unroll
        for (int i = 0; i < 16; ++i) asm volatile("v_cvt_scalef32_pk_f16_fp4 %0, %1, 1.0" : "=v"(f[i]) : "v"(w));
#endif
    }
    float s = 0.f;
#pragma unroll
    for (int i = 0; i < 8; ++i) s += a[i].x + a[i].y;
#pragma unroll
    for (int i = 0; i < 16; ++i) s += f[i];
    if (s == 123.456f) ((float*)(A.ws + WS_PD))[threadIdx.x] = s;
}
#endif
#ifndef MK_N_LAUNCHES
#define MK_N_LAUNCHES 1
#endif
constexpr int N_PHASES = 13;
typedef const __attribute__((address_space(4))) Args* KArgP;
__device__ __forceinline__ const Args& kargs() { KArgP p = (KArgP)__builtin_amdgcn_kernarg_segment_ptr(); asm volatile("" : "+s"(p)); return *(const Args*)p; }
__global__ void __launch_bounds__(NTHR, 2) hymba_fwd(Args A_) {
    extern __shared__ __attribute__((aligned(16))) unsigned char lds_raw[];
    LAS unsigned char* lds = (LAS unsigned char*)lds_raw;
    const int lo = A_.ph_lo, hi = A_.ph_hi;
#define A kargs()
#define ws (kargs().ws)
#ifndef DBLMASK
#define DBLMASK 0
#endif
#define IN(k) (lo <= (k) && (k) < hi)
#define REP(k) for (int _rep = 0; _rep < (((DBLMASK) >> (k)) & 1) + 1; ++_rep)
    for (int u = threadIdx.x; u < (LDS_BYTES - RING_BYTES) / 4; u += NTHR) ((LAS unsigned*)(lds + RING_BYTES))[u] = 0u;
    __syncthreads();
    XcdBarrier xbar = xcd_barrier_post((unsigned*)(ws + WS_CTL) + CW_BAR, (volatile LAS unsigned*)(lds + MISC_OFF + 32));
#define SEAM(k) do { if (IN(k) && IN((k) + 1)) { if ((k) == 0) cg::this_grid().sync(); else xcd_barrier(xbar); } } while (0)

    if (IN(0)) REP(0) { phase_mod(A, lds); } SEAM(0);
    if (IN(1)) REP(1) { phase_convert(A, lds); phase_prenorm(A); } SEAM(1);
    if (IN(2)) REP(2) {
        pg8::Gemm g{(const pg8::bf16_t*)(ws + WS_H), (const pg8::bf16_t*)(ws + WS_WIN), M, NIN_PAD, D}; pg8::StaticOrder S; S.init(M, NIN_PAD, gridDim.x, (int)blockIdx.x);
        pg8::EpiProj E{(pg8::bf16_t*)(ws + WS_PROJ), NPROJ, (float*)(ws + WS_GATES), (const int*)A.in[I_POS], (const float*)A.in[I_BI], (const float*)A.in[I_BF]};
        pg8::gemm_phase<pg8::EpiProj, pg8::StaticOrder, true, true>(lds, g, S, E);
    } SEAM(2);
    if (IN(3)) REP(3) {
        phase_attn(A, lds);
        for (int wg = blockIdx.x; wg < 256; wg += gridDim.x) mlstm_group<false>(A, lds, wg);
    } SEAM(3);
    if (IN(4)) REP(4) { for (int wg = blockIdx.x; wg < 256; wg += gridDim.x) mlstm_group<true>(A, lds, wg); } SEAM(4);
    if (IN(5)) REP(5) {
        pg8::Gemm g{(const pg8::bf16_t*)(ws + WS_MIXIN), (const pg8::bf16_t*)(ws + WS_WOUT), M, D, D}; pg8::StaticOrder S; S.init(M, D, gridDim.x, (int)blockIdx.x);
        pg8::EpiMix E{(pg8::bf16_t*)(ws + WS_MIX), D, (float*)(ws + WS_SSQ)};
        pg8::gemm_phase<pg8::EpiMix, pg8::StaticOrder, true, true>(lds, g, S, E);
    } SEAM(5);
    if (IN(6)) REP(6) { phase_mid(A); } SEAM(6);
    if (IN(7)) REP(7) {
        pg8::Gemm g{(const pg8::bf16_t*)(ws + WS_H), (const pg8::bf16_t*)(ws + WS_WQ), M, 2048, D}; pg8::StaticOrder S; S.init(M, 2048, gridDim.x, (int)blockIdx.x);
        pg8::EpiPlain E{(pg8::bf16_t*)(ws + WS_PROJ), 2048};
        pg8::gemm_phase<pg8::EpiPlain, pg8::StaticOrder, true, true>(lds, g, S, E);
    } SEAM(7);
    if (IN(8)) REP(8) { phase_topk(A, lds); } SEAM(8);
    if (IN(9)) REP(9) { phase_peer_u(A); } SEAM(9);
    if (IN(10)) REP(10) { phase_peer_act(A); } SEAM(10);
#ifdef PROBE_INSTR
    if (IN(11)) { probe_instr(A); }
#endif
#ifdef PROBE_V_LOADS
    if (IN(11)) { probe_v_loads(A); }
#endif
    if (IN(11)) REP(11) { phase_peer_v(A); } SEAM(11);
    if (IN(12)) REP(12) { phase_peer_final(A); }
#undef IN
#undef SEAM
#undef A
#undef ws
}

extern "C" void kernel_launch(void* const* d_in, const int* in_sizes, int n_in, void* d_out, int out_size, void* d_ws, size_t ws_size, hipStream_t stream) {
    static int grid = 0;
    if (grid == 0) {
        if (n_in != 21 || in_sizes[0] != M * D || out_size != M * D || ws_size < WS_END) { fprintf(stderr, "kernel_launch: unexpected shapes (n_in %d, in0 %d, out %d, ws %zu < %zu)\n", n_in, n_in > 0 ? in_sizes[0] : -1, out_size, ws_size, (size_t)WS_END); grid = -1; return; }
        int dev = 0, cus = 0, per_cu = 0;
        if (hipGetDevice(&dev) != hipSuccess || hipDeviceGetAttribute(&cus, hipDeviceAttributeMultiprocessorCount, dev) != hipSuccess) { grid = -1; return; }
        if (hipFuncSetAttribute((const void*)hymba_fwd, hipFuncAttributeMaxDynamicSharedMemorySize, LDS_BYTES) != hipSuccess) { fprintf(stderr, "kernel_launch: hipFuncSetAttribute failed\n"); grid = -1; return; }
        if (hipOccupancyMaxActiveBlocksPerMultiprocessor(&per_cu, (const void*)hymba_fwd, NTHR, LDS_BYTES) != hipSuccess || per_cu < 1) { fprintf(stderr, "kernel_launch: occupancy query says %d blocks per CU\n", per_cu); per_cu = 1; }
        (void)hipGetLastError();
        grid = cus;
        if (grid != 256) fprintf(stderr, "kernel_launch: note: %d CUs (built for 256)\n", grid);
    }
    if (grid < 0) return;
    (void)hipMemsetAsync((char*)d_ws + WS_CTL, 0, CTL_ZERO_BYTES, stream);
    Args a{};
    for (int i = 0; i < 21; ++i) a.in[i] = d_in[i];
    a.out = (float*)d_out; a.ws = (unsigned char*)d_ws;
    if (MK_N_LAUNCHES == 1) {
        a.ph_lo = 0; a.ph_hi = N_PHASES;
        void* args[] = {&a};
        const hipError_t e = hipLaunchCooperativeKernel((const void*)hymba_fwd, dim3(grid), dim3(NTHR), args, LDS_BYTES, stream);
        if (e != hipSuccess) fprintf(stderr, "kernel_launch: cooperative launch failed: %s (grid %d)\n", hipGetErrorString(e), grid);
    } else {
        for (int p = 0; p < N_PHASES; ++p) { a.ph_lo = p; a.ph_hi = p + 1; hipLaunchKernelGGL(hymba_fwd, dim3(grid), dim3(NTHR), LDS_BYTES, stream, a); }
    }
}
```

```cpp
#include <hip/hip_runtime.h>
#include <hip/hip_cooperative_groups.h>
#include <cstdio>
#include <cstdint>
namespace cg = cooperative_groups;
namespace pg8 {
#define PG8_LAS __attribute__((address_space(3)))
typedef unsigned short bf16_t;
typedef short bf16x8 __attribute__((ext_vector_type(8)));
typedef float f32x4 __attribute__((ext_vector_type(4)));
typedef unsigned u32x4 __attribute__((ext_vector_type(4)));
constexpr int BM = 256, BK = 64, HALF = 128, HTB = HALF * BK * 2  , STAGE_BYTES = 8 * HTB, NXCD = 8, WGM = 8;

__host__ __device__ __forceinline__ int lds_byte(int r, int c) { const int st = (r >> 4) * 2 + (c >> 5), rr = r & 15, cc = c & 31, ob = rr * 64 + cc * 2; return st * 1024 + (ob ^ (((ob >> 9) & 1) << 5)); }
__host__ __device__ __forceinline__ void stage_rc(int b, int& R, int& C) { const int st = b / 1024, sb = b % 1024, swz = sb ^ (((sb >> 9) & 1) << 5); R = (st >> 1) * 16 + swz / 64; C = (st & 1) * 32 + (swz % 64) / 2; }
__host__ __device__ __forceinline__ int perm32(int rho) { const int n = rho >> 4, i = rho & 15; return 8 * (i >> 2) + 4 * n + (i & 3); }

struct Unit { int pm, pn; };
struct Gemm { const bf16_t* A; const bf16_t* Bt; int M, N, K; };

struct StaticOrder {
    int nM, nN, nwg, G, c;
    __host__ __device__ void init(int M, int N, int G_, int c_) { nM = M / BM; nN = N / BM; nwg = nM * nN; G = G_; c = c_; }
    __host__ __device__ bool next(int i, Unit& u) const {
        const long L = (long)i * G + c; if (L >= nwg) return false;
        int wgid = (int)L; { const int q = nwg / NXCD, r = nwg % NXCD, xcd = wgid % NXCD, off = wgid / NXCD; wgid = (xcd < r ? xcd * (q + 1) : r * (q + 1) + (xcd - r) * q) + off; }
        const int nig = WGM * nN, gid = wgid / nig, fm = gid * WGM, gsz = (nM - fm) < WGM ? (nM - fm) : WGM;
        u.pm = fm + ((wgid % nig) % gsz); u.pn = (wgid % nig) / gsz; return true;
    }
    __device__ __forceinline__ void a_ready(const Unit&) const {}
    __device__ __forceinline__ void done(const Unit&) const {}
};

__device__ __forceinline__ unsigned cvt_pk_bf16(float lo, float hi) { unsigned r; asm volatile("v_cvt_pk_bf16_f32 %0, %1, %2" : "=v"(r) : "v"(lo), "v"(hi)); return r; }
typedef float f32x2 __attribute__((ext_vector_type(2)));
__device__ __forceinline__ f32x2 gelu_pk(f32x2 v) {
    const f32x2 av = __builtin_elementwise_abs(v), d = av * 0.2316418882f + 1.0f;
    f32x2 t; t.x = __builtin_amdgcn_rcpf(d.x); t.y = __builtin_amdgcn_rcpf(d.y);
    f32x2 q = t * 0.5307027145f + (-0.7265760135f); q = q * t + 0.7107068705f; q = q * t + (-0.142248368f); q = q * t + 0.127414796f; q = q * t;
    const f32x2 s = (v * v) * (-0.72134752044f);
    f32x2 e; e.x = __builtin_amdgcn_exp2f(s.x); e.y = __builtin_amdgcn_exp2f(s.y);
    const f32x2 m = v * (q * e), r = v - m;
    f32x2 o; o.x = v.x < 0.f ? m.x : r.x; o.y = v.y < 0.f ? m.y : r.y; return o;
}

__device__ __forceinline__ u32x4 pack8(const f32x4 v0, const f32x4 v1) { u32x4 w; w.x = cvt_pk_bf16(v0[0], v0[1]); w.y = cvt_pk_bf16(v0[2], v0[3]); w.z = cvt_pk_bf16(v1[0], v1[1]); w.w = cvt_pk_bf16(v1[2], v1[3]); return w; }

struct EpiPlain {
    static constexpr bool PERM = true, AFTER_DRAIN = false;
    bf16_t* O; int ldc;
    __device__ __forceinline__ void operator()(const f32x4 (&acc)[2][2][4][2], const Unit& u, int wr, int wc, int fr, int fq) const {
        const int row0 = u.pm * BM + wr * 64 + fr, col0 = u.pn * BM + wc * 32 + 8 * fq;
#pragma unroll
        for (int ai = 0; ai < 2; ++ai)
#pragma unroll
            for (int m = 0; m < 4; ++m) { bf16_t* rowp = O + (size_t)(row0 + ai * HALF + m * 16) * ldc + col0;
#pragma unroll
                for (int bj = 0; bj < 2; ++bj) *(u32x4*)(rowp + bj * HALF) = pack8(acc[ai][bj][m][0], acc[ai][bj][m][1]); }
    }
};

struct EpiProj {
    static constexpr bool PERM = true, AFTER_DRAIN = false;
    bf16_t* P; int ldc; float* gates; const int* pos; const float* b_i; const float* b_f;
    __device__ __forceinline__ void operator()(const f32x4 (&acc)[2][2][4][2], const Unit& u, int wr, int wc, int fr, int fq) const {
        const int row0 = u.pm * BM + wr * 64 + fr, col0 = u.pn * BM + wc * 32 + 8 * fq, pn = u.pn;
        if (pn == 9) {
            if (wc == 0 && fq == 0) {
                const f32x4 bi = {b_i[0], b_i[1], b_i[2], b_i[3]}, bf = {b_f[0], b_f[1], b_f[2], b_f[3]};
#pragma unroll
                for (int ai = 0; ai < 2; ++ai)
#pragma unroll
                    for (int m = 0; m < 4; ++m) { const int row = row0 + ai * HALF + m * 16;
                        const f32x4 iv = acc[ai][0][m][0] + bi, fv = acc[ai][0][m][1] + bf; f32x4 lf;
#pragma unroll
                        for (int j = 0; j < 4; ++j) lf[j] = fminf(fv[j], 0.f) - log1pf(__expf(-fabsf(fv[j])));
                        *(f32x4*)(gates + (size_t)row * 8) = iv; *(f32x4*)(gates + (size_t)row * 8 + 4) = lf; }
            }
            return;
        }
#pragma unroll
        for (int ai = 0; ai < 2; ++ai)
#pragma unroll
            for (int m = 0; m < 4; ++m) { const int row = row0 + ai * HALF + m * 16; bf16_t* rowp = P + (size_t)row * ldc + col0;
                const float posf = (pn <= 2) ? (float)pos[row] : 0.f;
#pragma unroll
                for (int bj = 0; bj < 2; ++bj) { f32x4 v0 = acc[ai][bj][m][0], v1 = acc[ai][bj][m][1];
                    const bool rope = (pn < 2) || (pn == 2 && bj == 0);
                    if (rope) {
                        const int p0 = ((col0 + bj * HALF) & 63) >> 1; const float sc = (pn < 2) ? 0.125f : 1.0f;
                        float x[8] = {v0[0], v0[1], v0[2], v0[3], v1[0], v1[1], v1[2], v1[3]};
#pragma unroll
                        for (int q = 0; q < 4; ++q) { const float invf = __builtin_amdgcn_exp2f(-(float)(p0 + q) * 0.41524101186092029f);
                            float r = posf * invf * 0.15915494309189535f; r = r - floorf(r);
                            const float c = __builtin_amdgcn_cosf(r) * sc, s = __builtin_amdgcn_sinf(r) * sc;
                            const float x1 = x[2 * q], x2 = x[2 * q + 1]; x[2 * q] = x1 * c - x2 * s; x[2 * q + 1] = x2 * c + x1 * s; }
                        v0 = (f32x4){x[0], x[1], x[2], x[3]}; v1 = (f32x4){x[4], x[5], x[6], x[7]};
                    } else if (pn >= 7) {
#pragma unroll
                        for (int j = 0; j < 4; ++j) { v0[j] = __builtin_amdgcn_rcpf(1.f + __expf(-v0[j])); v1[j] = __builtin_amdgcn_rcpf(1.f + __expf(-v1[j])); }
                    }
                    *(u32x4*)(rowp + bj * HALF) = pack8(v0, v1); } }
    }
};

struct EpiMix {
    static constexpr bool PERM = true, AFTER_DRAIN = false;
    bf16_t* O; int ldc; float* sumsq;
    __device__ __forceinline__ void operator()(const f32x4 (&acc)[2][2][4][2], const Unit& u, int wr, int wc, int fr, int fq) const {
        const int row0 = u.pm * BM + wr * 64 + fr, col0 = u.pn * BM + wc * 32 + 8 * fq;
#pragma unroll
        for (int ai = 0; ai < 2; ++ai)
#pragma unroll
            for (int m = 0; m < 4; ++m) { const int row = row0 + ai * HALF + m * 16; bf16_t* rowp = O + (size_t)row * ldc + col0; float s = 0.f;
#pragma unroll
                for (int bj = 0; bj < 2; ++bj) { const f32x4 v0 = acc[ai][bj][m][0], v1 = acc[ai][bj][m][1];
                    s += (v0[0] * v0[0] + v0[1] * v0[1]) + (v0[2] * v0[2] + v0[3] * v0[3]) + (v1[0] * v1[0] + v1[1] * v1[1]) + (v1[2] * v1[2] + v1[3] * v1[3]);
                    *(u32x4*)(rowp + bj * HALF) = pack8(v0, v1); }
                s += __shfl_xor(s, 16); s += __shfl_xor(s, 32);
                if (fq == 0) sumsq[(size_t)row * 16 + u.pn * 4 + wc] = s; }
    }
};
template <class Epi, class Sched, bool ALIGN_EPI = false, bool SP2 = false>
__device__ __forceinline__ void gemm_phase(PG8_LAS unsigned char* lds, const Gemm g, const Sched& S, const Epi& E) {
    const int tid = threadIdx.x, wid = __builtin_amdgcn_readfirstlane(tid >> 6), lane = tid & 63, wr = wid >> 2, wc = wid & 3, fr = lane & 15, fq = lane >> 4;
    const int K = g.K, nt = K / BK;
    unsigned voffA[2], voffB[2];
#pragma unroll
    for (int i = 0; i < 2; ++i) { int R, C; stage_rc(tid * 16 + i * 8192, R, C); const int Rb = Epi::PERM ? ((R & ~31) + perm32(R & 31)) : R;
        voffA[i] = (unsigned)(R * K + C) * 2u; voffB[i] = (unsigned)(Rb * K + C) * 2u; }
    const size_t kstep = (size_t)(BK * 2);
    const size_t hstep = (size_t)HALF * K * 2;
    const size_t tstep = 2 * hstep;
    const unsigned ldsw = (unsigned)wid * 1024u;
    const int aoff = lds_byte(wr * 64 + fr, fq * 8), boff = lds_byte(wc * 32 + fr, fq * 8);
#define PG8_SA(b, h) (((b) * 2 + (h)) * HTB)
#define PG8_SB(b, h) ((4 + (b) * 2 + (h)) * HTB)
#define PG8_STAGE(bufoff, gbase, voff) do { _Pragma("unroll") for (int _i = 0; _i < 2; ++_i) \
        __builtin_amdgcn_global_load_lds((const unsigned*)((const char*)(gbase) + (voff)[_i]), (PG8_LAS unsigned*)(lds + (bufoff) + ldsw + _i * 8192), 16, 0, 0); } while (0)
#define PG8_LDA(dst, b, h) do { _Pragma("unroll") for (int m = 0; m < 4; ++m) _Pragma("unroll") for (int k = 0; k < 2; ++k) dst[m][k] = *(const PG8_LAS bf16x8*)(lds + PG8_SA(b, h) + aoff + m * 2048 + k * 1024); } while (0)
#define PG8_LDB(dst, b, h) do { _Pragma("unroll") for (int n = 0; n < 2; ++n) _Pragma("unroll") for (int k = 0; k < 2; ++k) dst[n][k] = *(const PG8_LAS bf16x8*)(lds + PG8_SB(b, h) + boff + n * 2048 + k * 1024); } while (0)
#define PG8_MMA(ai, bj, At, Bt) do { __builtin_amdgcn_s_setprio(1); _Pragma("unroll") for (int m = 0; m < 4; ++m) _Pragma("unroll") for (int n = 0; n < 2; ++n) _Pragma("unroll") for (int k = 0; k < 2; ++k) \
        acc[ai][bj][m][n] = __builtin_amdgcn_mfma_f32_16x16x32_bf16(Bt[n][k], At[m][k], acc[ai][bj][m][n], 0, 0, 0); __builtin_amdgcn_s_setprio(0); } while (0)
#define PG8_WAIT_V(n) asm volatile("s_waitcnt vmcnt(" #n ")" ::: "memory")
#define PG8_WAIT_L(n) asm volatile("s_waitcnt lgkmcnt(" #n ")" ::: "memory")
#define PG8_BAR __builtin_amdgcn_s_barrier()
#define PG8_SCHED __builtin_amdgcn_sched_barrier(0)
    Unit cur, nxt; int ui = 0;
    if (!S.next(0, cur)) return;
    f32x4 acc[2][2][4][2];
#pragma unroll
    for (int a = 0; a < 2; ++a)
#pragma unroll
        for (int b = 0; b < 2; ++b)
#pragma unroll
            for (int m = 0; m < 4; ++m)
#pragma unroll
                for (int n = 0; n < 2; ++n) acc[a][b][m][n] = (f32x4){0.f, 0.f, 0.f, 0.f};
    bf16x8 At[4][2], B0[2][2], B1[2][2];
    const char* cA = (const char*)g.A + (size_t)cur.pm * tstep; const char* cB = (const char*)g.Bt + (size_t)cur.pn * tstep;
    S.a_ready(cur);
    if constexpr (SP2) {
        PG8_STAGE(PG8_SB(0, 0), cB, voffB); PG8_STAGE(PG8_SB(0, 1), cB + hstep, voffB); PG8_STAGE(PG8_SA(0, 0), cA, voffA); PG8_STAGE(PG8_SA(0, 1), cA + hstep, voffA);
        if (wr == 1) PG8_BAR;
        PG8_WAIT_V(2); PG8_BAR;
        PG8_STAGE(PG8_SB(1, 0), cB + kstep, voffB); PG8_STAGE(PG8_SA(1, 0), cA + kstep, voffA); PG8_STAGE(PG8_SB(1, 1), cB + hstep + kstep, voffB);
        PG8_WAIT_V(6); PG8_BAR;
    } else {
        PG8_STAGE(PG8_SB(0, 0), cB, voffB); PG8_STAGE(PG8_SA(0, 0), cA, voffA); PG8_STAGE(PG8_SB(0, 1), cB + hstep, voffB); PG8_STAGE(PG8_SA(0, 1), cA + hstep, voffA);
        if (wr == 1) PG8_BAR;
        PG8_WAIT_V(4); PG8_BAR;
        PG8_STAGE(PG8_SB(1, 0), cB + kstep, voffB); PG8_STAGE(PG8_SA(1, 0), cA + kstep, voffA); PG8_STAGE(PG8_SB(1, 1), cB + hstep + kstep, voffB);
        PG8_WAIT_V(6); PG8_BAR;
    }
    for (;;) {
        const bool has_next = S.next(ui + 1, nxt);
        const char* nA = has_next ? (const char*)g.A + (size_t)nxt.pm * tstep : cA; const char* nB = has_next ? (const char*)g.Bt + (size_t)nxt.pn * tstep : cB;
        for (int t = 0; t < nt; t += 2) {
            const bool last = (t == nt - 2);
            const char* a1 = cA + (size_t)(t + 1) * kstep;
            const char* a2 = last ? nA : cA + (size_t)(t + 2) * kstep; const char* b2 = last ? nB : cB + (size_t)(t + 2) * kstep;
            const char* a3 = a2 + kstep; const char* b3 = b2 + kstep;
            if (last && has_next) S.a_ready(nxt);
            if constexpr (SP2) {
            PG8_LDB(B0, 0, 0); PG8_LDB(B1, 0, 1); PG8_SCHED; PG8_LDA(At, 0, 0); PG8_STAGE(PG8_SA(1, 1), a1 + hstep, voffA);
            PG8_WAIT_V(8); PG8_WAIT_L(0); PG8_BAR; PG8_MMA(0, 0, At, B0); PG8_MMA(0, 1, At, B1); PG8_BAR; PG8_SCHED;
            PG8_LDA(At, 0, 1); PG8_STAGE(PG8_SB(0, 0), b2, voffB); PG8_STAGE(PG8_SB(0, 1), b2 + hstep, voffB); PG8_STAGE(PG8_SA(0, 0), a2, voffA);
            PG8_WAIT_V(8); PG8_WAIT_L(0); PG8_BAR; PG8_MMA(1, 0, At, B0); PG8_MMA(1, 1, At, B1); PG8_BAR; PG8_SCHED;
            PG8_LDB(B0, 1, 0); PG8_LDB(B1, 1, 1); PG8_SCHED; PG8_LDA(At, 1, 0); PG8_STAGE(PG8_SA(0, 1), a2 + hstep, voffA);
            PG8_WAIT_V(8); PG8_WAIT_L(0); PG8_BAR; PG8_MMA(0, 0, At, B0); PG8_MMA(0, 1, At, B1); PG8_BAR; PG8_SCHED;
            PG8_LDA(At, 1, 1); PG8_STAGE(PG8_SB(1, 0), b3, voffB); PG8_STAGE(PG8_SB(1, 1), b3 + hstep, voffB); PG8_STAGE(PG8_SA(1, 0), a3, voffA);
            PG8_WAIT_V(8); PG8_WAIT_L(0); PG8_BAR; PG8_MMA(1, 0, At, B0); PG8_MMA(1, 1, At, B1); PG8_BAR; PG8_SCHED;
            } else {
            PG8_LDB(B0, 0, 0); PG8_SCHED; PG8_LDA(At, 0, 0); PG8_STAGE(PG8_SA(1, 1), a1 + hstep, voffA);
            PG8_WAIT_L(8); PG8_BAR; PG8_WAIT_L(0); PG8_MMA(0, 0, At, B0); PG8_BAR; PG8_SCHED;
            PG8_LDB(B1, 0, 1); PG8_STAGE(PG8_SB(0, 0), b2, voffB);
            PG8_BAR; PG8_WAIT_L(0); PG8_MMA(0, 1, At, B1); PG8_BAR;
            PG8_LDA(At, 0, 1); PG8_STAGE(PG8_SA(0, 0), a2, voffA);
            PG8_BAR; PG8_WAIT_L(0); PG8_MMA(1, 0, At, B0); PG8_BAR; PG8_SCHED;
            PG8_STAGE(PG8_SB(0, 1), b2 + hstep, voffB);
            PG8_WAIT_V(6); PG8_BAR; PG8_MMA(1, 1, At, B1); PG8_BAR;
            PG8_LDB(B0, 1, 0); PG8_SCHED; PG8_LDA(At, 1, 0); PG8_STAGE(PG8_SA(0, 1), a2 + hstep, voffA);
            PG8_WAIT_L(8); PG8_BAR; PG8_WAIT_L(0); PG8_MMA(0, 0, At, B0); PG8_BAR; PG8_SCHED;
            PG8_LDB(B1, 1, 1); PG8_STAGE(PG8_SB(1, 0), b3, voffB);
            PG8_BAR; PG8_WAIT_L(0); PG8_MMA(0, 1, At, B1); PG8_BAR;
            PG8_LDA(At, 1, 1); PG8_STAGE(PG8_SA(1, 0), a3, voffA);
            PG8_BAR; PG8_WAIT_L(0); PG8_MMA(1, 0, At, B0); PG8_BAR; PG8_SCHED;
            PG8_STAGE(PG8_SB(1, 1), b3 + hstep, voffB);
            PG8_WAIT_V(6); PG8_BAR; PG8_MMA(1, 1, At, B1); PG8_BAR;
            }
        }
        if constexpr (ALIGN_EPI) { if (wr == 0) PG8_BAR; }
        if constexpr (!Epi::AFTER_DRAIN) { E(acc, cur, wr, wc, fr, fq); S.done(cur); }
        if (!has_next) break;
#pragma unroll
        for (int a = 0; a < 2; ++a)
#pragma unroll
            for (int b = 0; b < 2; ++b)
#pragma unroll
                for (int m = 0; m < 4; ++m)
#pragma unroll
                    for (int n = 0; n < 2; ++n) acc[a][b][m][n] = (f32x4){0.f, 0.f, 0.f, 0.f};
        cur = nxt; cA = nA; cB = nB; ++ui;
        if constexpr (ALIGN_EPI) { if (wr == 1) PG8_BAR; }
    }
    PG8_WAIT_V(0);
    if constexpr (!ALIGN_EPI) { if (wr == 0) PG8_BAR; }
    PG8_BAR;
    if constexpr (Epi::AFTER_DRAIN) { E.fused(acc, cur, wr, wc, fr, fq, lds, wid, lane); S.done(cur); }
#undef PG8_SA
#undef PG8_SB
#undef PG8_STAGE
#undef PG8_LDA
#undef PG8_LDB
#undef PG8_MMA
#undef PG8_WAIT_V
#undef PG8_WAIT_L
#undef PG8_BAR
#undef PG8_SCHED
}
}
constexpr int NB = 8, SEQ = 8192, D = 1024, M = NB * SEQ;
constexpr int DIN = 2312, NPROJ = 2304, NIN_PAD = 2560;
constexpr int C_AQ = 0, C_AK = 512, C_AV = 640, C_MQ = 768, C_MK = 1024, C_MV = 1280, C_MO = 1792;
constexpr int NEXP = 16384, NSLOT = 128;
constexpr float EPS = 1e-6f;
constexpr int NWAVES = 8, NTHR = 512;

constexpr size_t MiB = 1u << 20;
constexpr size_t WS_CTL = 0, CTL_ZERO_BYTES = 1 * MiB;
constexpr size_t WS_MOD = 1 * MiB;
constexpr size_t WS_WIN = 2 * MiB;
constexpr size_t WS_WOUT = 8 * MiB;
constexpr size_t WS_WQ = 10 * MiB;
constexpr size_t WS_KEYS = 14 * MiB;
constexpr size_t WS_GATES = 16 * MiB;
constexpr size_t WS_SSQ = 832 * MiB;
constexpr size_t WS_MST = 20 * MiB;
constexpr size_t WS_U8 = 32 * MiB, WS_V8 = 48 * MiB;
constexpr size_t WS_SC = 64 * MiB;
constexpr size_t WS_H = 96 * MiB;
constexpr size_t WS_PROJ = 224 * MiB;
constexpr size_t WS_MIXIN = 512 * MiB;
constexpr size_t WS_MIX = 640 * MiB;
constexpr size_t WS_EIDX = 768 * MiB, WS_GATE = 800 * MiB;
constexpr size_t WS_PD = 224 * MiB;
constexpr size_t WS_X1 = 512 * MiB;
constexpr size_t WS_ACT = 840 * MiB;
constexpr size_t WS_SSY = 872 * MiB;
constexpr size_t WS_H8 = 880 * MiB;
constexpr size_t WS_HS = 944 * MiB;
constexpr size_t WS_END = 945 * MiB;
constexpr int CW_BAR = 4096;
constexpr int CW_SUMSQ = 65536;
static_assert((CW_SUMSQ + M) * 4 <= (int)CTL_ZERO_BYTES, "ctl");

constexpr int RING_BYTES = 131072, MISC_OFF = RING_BYTES + 320, LDS_BYTES = 147456;

#define GAS __attribute__((address_space(1)))
#define LAS __attribute__((address_space(3)))
typedef unsigned short bf16;
typedef unsigned v4u __attribute__((ext_vector_type(4)));
typedef unsigned v2u __attribute__((ext_vector_type(2)));
typedef float f32x4 __attribute__((ext_vector_type(4)));
typedef GAS unsigned gu32;
#define LDS_WAIT() asm volatile("s_waitcnt lgkmcnt(0)" ::: "memory")
#define VM_WAIT() asm volatile("s_waitcnt vmcnt(0)" ::: "memory")
__device__ __forceinline__ unsigned f2bf(float f) { unsigned u = __builtin_bit_cast(unsigned, f); return (u + 0x7fffu + ((u >> 16) & 1u)) >> 16; }
__device__ __forceinline__ unsigned pk2(float lo, float hi) { return f2bf(lo) | (f2bf(hi) << 16); }
__device__ __forceinline__ float bflo(unsigned w) { return __builtin_bit_cast(float, w << 16); }
__device__ __forceinline__ float bfhi(unsigned w) { return __builtin_bit_cast(float, w & 0xffff0000u); }
__device__ __forceinline__ float bf1(bf16 h) { return __builtin_bit_cast(float, (unsigned)h << 16); }
__device__ __forceinline__ float wave_sum(float v) {
#pragma unroll
    for (int o = 1; o < 64; o <<= 1) v += __shfl_xor(v, o);
    return v;
}
__device__ __forceinline__ float wave_max(float v) {
#pragma unroll
    for (int o = 1; o < 64; o <<= 1) v = fmaxf(v, __shfl_xor(v, o));
    return v;
}

typedef float f32x2 __attribute__((ext_vector_type(2)));
__device__ __forceinline__ void cvt16_fp8(const v4u w, float (&o)[16]) {
    const unsigned ww[4] = {w.x, w.y, w.z, w.w};
#pragma unroll
    for (int i = 0; i < 4; ++i) { const f32x2 a = __builtin_amdgcn_cvt_pk_f32_fp8((int)ww[i], false), b = __builtin_amdgcn_cvt_pk_f32_fp8((int)ww[i], true);
        o[4 * i] = a.x; o[4 * i + 1] = a.y; o[4 * i + 2] = b.x; o[4 * i + 3] = b.y; }
}
__device__ __forceinline__ void p0_row_fp8(const float* src, unsigned char* dst, float* sc, int row, int lane) {
    const GAS f32x4* sp = (const GAS f32x4*)(src + (size_t)row * D + 16 * lane);
    const f32x4 a = sp[0], b = sp[1], c = sp[2], d = sp[3];
    float mx = 0.f;
#pragma unroll
    for (int i = 0; i < 4; ++i) mx = fmaxf(fmaxf(fmaxf(mx, fabsf(a[i])), fmaxf(fabsf(b[i]), fabsf(c[i]))), fabsf(d[i]));
    mx = wave_max(mx); const float s = mx > 0.f ? 224.0f / mx : 1.0f;
    v4u o; int w;
    w = __builtin_amdgcn_cvt_pk_fp8_f32(a[0] * s, a[1] * s, 0, false); w = __builtin_amdgcn_cvt_pk_fp8_f32(a[2] * s, a[3] * s, w, true); o.x = (unsigned)w;
    w = __builtin_amdgcn_cvt_pk_fp8_f32(b[0] * s, b[1] * s, 0, false); w = __builtin_amdgcn_cvt_pk_fp8_f32(b[2] * s, b[3] * s, w, true); o.y = (unsigned)w;
    w = __builtin_amdgcn_cvt_pk_fp8_f32(c[0] * s, c[1] * s, 0, false); w = __builtin_amdgcn_cvt_pk_fp8_f32(c[2] * s, c[3] * s, w, true); o.z = (unsigned)w;
    w = __builtin_amdgcn_cvt_pk_fp8_f32(d[0] * s, d[1] * s, 0, false); w = __builtin_amdgcn_cvt_pk_fp8_f32(d[2] * s, d[3] * s, w, true); o.w = (unsigned)w;
    *(GAS v4u*)(dst + (size_t)row * D + 16 * lane) = o;
    if (lane == 0) sc[row] = mx > 0.f ? mx * (1.0f / 224.0f) : 1.0f;
}

__device__ __forceinline__ unsigned pack4_i8(float a, float b, float c, float d) { return ((unsigned)__float2int_rn(a) & 0xffu) | (((unsigned)__float2int_rn(b) & 0xffu) << 8) | (((unsigned)__float2int_rn(c) & 0xffu) << 16) | (((unsigned)__float2int_rn(d) & 0xffu) << 24); }
__device__ __forceinline__ void p0_row_i8(const float* src, unsigned char* dst, float* sc, int row, int lane) {
    const GAS f32x4* sp = (const GAS f32x4*)(src + (size_t)row * D + 16 * lane);
    const f32x4 a = sp[0], b = sp[1], c = sp[2], d = sp[3];
    float mx = 0.f;
#pragma unroll
    for (int i = 0; i < 4; ++i) mx = fmaxf(fmaxf(fmaxf(mx, fabsf(a[i])), fmaxf(fabsf(b[i]), fabsf(c[i]))), fabsf(d[i]));
    mx = wave_max(mx); const float s = mx > 0.f ? 127.0f / mx : 1.0f;
    v4u o; o.x = pack4_i8(a[0] * s, a[1] * s, a[2] * s, a[3] * s); o.y = pack4_i8(b[0] * s, b[1] * s, b[2] * s, b[3] * s); o.z = pack4_i8(c[0] * s, c[1] * s, c[2] * s, c[3] * s); o.w = pack4_i8(d[0] * s, d[1] * s, d[2] * s, d[3] * s);
    *(GAS v4u*)(dst + (size_t)row * D + 16 * lane) = o;
    if (lane == 0) sc[row] = mx > 0.f ? mx * (1.0f / 127.0f) : 1.0f;
}

__device__ __forceinline__ unsigned pack8_i4(const f32x4 a, const f32x4 b, float s) {
    unsigned w = 0;
#pragma unroll
    for (int i = 0; i < 4; ++i) { const int qa = max(-8, min(7, __float2int_rn(a[i] * s))), qb = max(-8, min(7, __float2int_rn(b[i] * s))); w |= ((unsigned)qa & 15u) << (4 * i); w |= ((unsigned)qb & 15u) << (16 + 4 * i); }
    return w;
}
__device__ __forceinline__ void p0_row_i4(const f32x4 a, const f32x4 b, const f32x4 c, const f32x4 d, unsigned char* dst, float* sc, int row, int lane) {
    float ss = 0.f;
#pragma unroll
    for (int i = 0; i < 4; ++i) ss += (a[i] * a[i] + b[i] * b[i]) + (c[i] * c[i] + d[i] * d[i]);
    ss = wave_sum(ss); const float sig = sqrtf(ss * (1.f / D)), s = sig > 0.f ? 3.0f / sig : 1.0f;
    v2u o; o.x = pack8_i4(a, b, s); o.y = pack8_i4(c, d, s);
    *(GAS v2u*)(dst + (size_t)row * (D / 2) + 8 * lane) = o;
    if (lane == 0) sc[row] = sig > 0.f ? sig * (1.0f / 3.0f) : 1.0f;
}

__device__ __forceinline__ unsigned pack8_fp4(const f32x4 a, const f32x4 b, float s) {
    unsigned w = 0;
    w = __builtin_amdgcn_cvt_scalef32_pk_fp4_f32(w, fminf(fmaxf(a[0] * s, -6.f), 6.f), fminf(fmaxf(a[1] * s, -6.f), 6.f), 1.0f, 0);
    w = __builtin_amdgcn_cvt_scalef32_pk_fp4_f32(w, fminf(fmaxf(a[2] * s, -6.f), 6.f), fminf(fmaxf(a[3] * s, -6.f), 6.f), 1.0f, 1);
    w = __builtin_amdgcn_cvt_scalef32_pk_fp4_f32(w, fminf(fmaxf(b[0] * s, -6.f), 6.f), fminf(fmaxf(b[1] * s, -6.f), 6.f), 1.0f, 2);
    w = __builtin_amdgcn_cvt_scalef32_pk_fp4_f32(w, fminf(fmaxf(b[2] * s, -6.f), 6.f), fminf(fmaxf(b[3] * s, -6.f), 6.f), 1.0f, 3);
    return w;
}
__device__ __forceinline__ void p0_row_fp4(const f32x4 a, const f32x4 b, const f32x4 c, const f32x4 d, unsigned char* dst, float* sc, int row, int lane) {
    float mx = 0.f;
#pragma unroll
    for (int i = 0; i < 4; ++i) mx = fmaxf(fmaxf(fmaxf(mx, fabsf(a[i])), fmaxf(fabsf(b[i]), fabsf(c[i]))), fabsf(d[i]));
    mx = wave_max(mx); const float s = mx > 0.f ? 7.0f / mx : 1.0f;
    v2u o; o.x = pack8_fp4(a, b, s); o.y = pack8_fp4(c, d, s);
    *(GAS v2u*)(dst + (size_t)row * (D / 2) + 8 * lane) = o;
    if (lane == 0) sc[row] = mx > 0.f ? mx * (1.0f / 7.0f) : 1.0f;
}
#define XB_TMO      128
#define XB_XCNT(j)  (256  + 64 * (j))
#define XB_XSUB(j)  (1280 + 64 * (j))
#define XB_XGEN(j)  (2304 + 64 * (j))
#define XB_TOP      3328
#define XB_TOPGEN   3392
#define XCD_BAR_WORDS 3456
#define XB_SPIN_CAP (1u << 18)

__device__ __forceinline__ unsigned xb_ld(unsigned* p)              { return __hip_atomic_load(p, __ATOMIC_RELAXED, __HIP_MEMORY_SCOPE_AGENT); }
__device__ __forceinline__ unsigned xb_add(unsigned* p, unsigned v) { return __hip_atomic_fetch_add(p, v, __ATOMIC_RELAXED, __HIP_MEMORY_SCOPE_AGENT); }
__device__ __forceinline__ unsigned xb_xcc_id() { return (unsigned)__builtin_amdgcn_s_getreg((3 << 11) | 20) & 0xFu; }
#define XB_SPIN(cond, bar) do { unsigned _sp = 0; while (cond) { __builtin_amdgcn_s_sleep(1); \
    if ((++_sp & 255u) == 0u) { if (xb_ld(&(bar)[XB_TMO])) break; if (_sp > XB_SPIN_CAP) { atomicAdd(&(bar)[XB_TMO], 1u); break; } } } } while (0)

struct XcdBarrier {
    unsigned* bar; unsigned x;
    volatile LAS unsigned* st;
};

__device__ __forceinline__ XcdBarrier xcd_barrier_post(unsigned* bar, volatile LAS unsigned* st) {
    XcdBarrier b; b.bar = bar; b.x = xb_xcc_id(); b.st = st;
    if (threadIdx.x == 0) (void)xb_add(&bar[XB_XCNT(b.x)], 1u);
    return b;
}
__device__ __forceinline__ void xcd_barrier_complete(unsigned* bar, unsigned x, unsigned& nloc, unsigned& nx) {
    const unsigned G = gridDim.x * gridDim.y * gridDim.z;
    unsigned sum, cnt, mine, sp = 0u;
    for (;;) {
        sum = 0u; cnt = 0u; mine = 0u;
#pragma unroll
        for (unsigned j = 0; j < 16; ++j) { const unsigned c = xb_ld(&bar[XB_XCNT(j)]); sum += c; cnt += (c > 0u) ? 1u : 0u; mine = (j == x) ? c : mine; }
        if (sum == G) break;
        __builtin_amdgcn_s_sleep(1);
        if ((++sp & 255u) == 0u) { if (xb_ld(&bar[XB_TMO])) break; if (sp > XB_SPIN_CAP) { atomicAdd(&bar[XB_TMO], 1u); break; } }
    }
    nloc = mine > 0u ? mine : 1u; nx = cnt > 0u ? cnt : 1u;
}

__device__ __forceinline__ void xcd_barrier(const XcdBarrier& b) {
    asm volatile("s_waitcnt vmcnt(0)" ::: "memory");
    __syncthreads();
    if (threadIdx.x == 0) {
        unsigned* bar = b.bar;
        __builtin_amdgcn_s_waitcnt(0);
        unsigned nloc = b.st[0], nx = b.st[1];
        if (nloc == 0u) { xcd_barrier_complete(bar, b.x, nloc, nx); b.st[0] = nloc; b.st[1] = nx; }
        const unsigned old = xb_add(&bar[XB_XSUB(b.x)], 1u);
        const unsigned gen = old / nloc;
        if (old + 1u == (gen + 1u) * nloc) {
            __builtin_amdgcn_fence(__ATOMIC_RELEASE, "agent");
            asm volatile("s_waitcnt vmcnt(0)" ::: "memory");
            const unsigned og = xb_add(&bar[XB_TOP], 1u);
            const unsigned tg = og / nx;
            if (og + 1u == (tg + 1u) * nx) xb_add(&bar[XB_TOPGEN], 1u);
            else XB_SPIN(xb_ld(&bar[XB_TOPGEN]) == tg, bar);
            __builtin_amdgcn_fence(__ATOMIC_ACQUIRE, "agent");
            xb_add(&bar[XB_XGEN(b.x)], 1u);
            asm volatile("s_waitcnt vmcnt(0)" ::: "memory");
        } else {
            XB_SPIN(xb_ld(&bar[XB_XGEN(b.x)]) == gen, bar);
            __builtin_amdgcn_fence(__ATOMIC_ACQUIRE, "agent");
            asm volatile("s_waitcnt vmcnt(0)" ::: "memory");
        }
    }
    __syncthreads();
}
struct Args { const void* in[21]; float* out; unsigned char* ws; int ph_lo, ph_hi; };
enum { I_X = 0, I_C, I_POS, I_WMOD, I_BMOD, I_GPRE1, I_GPOST1, I_WIN, I_CONVW, I_BI, I_BF, I_MNG, I_SINK, I_WOUT, I_GPRE2, I_GPOST2, I_WQ, I_K1, I_K2, I_U, I_V };

__device__ __forceinline__ int newcol(int o) {
    if (o < 640) { const int hd = o >> 6, d = o & 63; return (hd << 6) + 2 * (d & 31) + (d >> 5); }
    if (o < 1792) return o;
    if (o < 1800) return 2304 + (o - 1792);
    return o - 8;
}
template <bool REMAP>
__device__ __forceinline__ void p0_transpose_item(const float* W, int K, int N, bf16* WT, LAS float* scr, int item, int lane) {
    const int nblk = (N + 31) / 32, kb = item / nblk, nb = item % nblk, k0 = 64 * kb, n0 = 32 * nb;
    const int ncol = n0 + (lane & 31);
#pragma unroll 8
    for (int i = 0; i < 32; ++i) { const int kk = 2 * i + (lane >> 5); scr[kk * 33 + (lane & 31)] = (ncol < N) ? W[(size_t)(k0 + kk) * N + ncol] : 0.f; }
    LDS_WAIT(); asm volatile("" ::: "memory");
    const int c = lane & 7;
#pragma unroll
    for (int j = 0; j < 4; ++j) { const int n = (lane >> 3) + 8 * j; const LAS float* s = scr + (8 * c) * 33 + n;
        v4u o; o.x = pk2(s[0 * 33], s[1 * 33]); o.y = pk2(s[2 * 33], s[3 * 33]); o.z = pk2(s[4 * 33], s[5 * 33]); o.w = pk2(s[6 * 33], s[7 * 33]);
        if (n0 + n < N) { const int drow = REMAP ? newcol(n0 + n) : (n0 + n); *(GAS v4u*)(WT + (size_t)drow * K + k0 + 8 * c) = o; } }
    LDS_WAIT(); asm volatile("" ::: "memory");
}
__device__ __forceinline__ void p0_convert(const float* src, bf16* dst, size_t n, int gt, int ngt) {
    for (size_t i = (size_t)gt * 8; i < n; i += (size_t)ngt * 8) {
        const f32x4 a = *(const GAS f32x4*)(src + i), b = *(const GAS f32x4*)(src + i + 4);
        v4u o; o.x = pk2(a[0], a[1]); o.y = pk2(a[2], a[3]); o.z = pk2(b[0], b[1]); o.w = pk2(b[2], b[3]);
        *(GAS v4u*)(dst + i) = o; }
}
__device__ __forceinline__ void phase_mod(const Args& A, LAS unsigned char* lds) {
    const int tid = threadIdx.x, G = gridDim.x, blk = blockIdx.x;
    unsigned char* ws = A.ws;
    const float* c = (const float*)A.in[I_C]; const float* wm = (const float*)A.in[I_WMOD]; const float* bm = (const float*)A.in[I_BMOD];
    float* mod = (float*)(ws + WS_MOD); LAS float* cs = (LAS float*)lds; LAS float* red = cs + 8 * 1024;
    for (int e = tid; e < 8 * 1024 / 4; e += NTHR) *(LAS f32x4*)(cs + 4 * e) = *(const GAS f32x4*)(c + 4 * e);
    __syncthreads();
    for (int it = blk; it < 6144 / 24; it += G) {
        const int kg = tid >> 5, col = tid & 31, j = it * 24 + (col < 24 ? col : 23); float acc[8];
#pragma unroll
        for (int b = 0; b < 8; ++b) acc[b] = 0.f;
#pragma unroll 16
        for (int i = 0; i < 64; ++i) { const int k = kg + 16 * i; const float w = wm[(size_t)k * 6144 + j];
#pragma unroll
            for (int b = 0; b < 8; ++b) acc[b] += cs[b * 1024 + k] * w; }
#pragma unroll
        for (int b = 0; b < 8; ++b) red[(kg * 32 + col) * 8 + b] = acc[b];
        __syncthreads();
        if (tid < 256) { const int b = tid >> 5, cc = tid & 31; float s = 0.f;
#pragma unroll
            for (int g = 0; g < 16; ++g) s += red[(g * 32 + cc) * 8 + b];
            if (cc < 24) mod[b * 6144 + it * 24 + cc] = s + bm[it * 24 + cc]; }
        __syncthreads();
    }
}
__device__ __forceinline__ void phase_convert(const Args& A, LAS unsigned char* lds) {
    const int tid = threadIdx.x, lane = tid & 63, wave = tid >> 6, G = gridDim.x, blk = blockIdx.x;
    unsigned char* ws = A.ws;
    {
        LAS float* scr = (LAS float*)(lds + wave * 16384);
        const int gw = blk * NWAVES + wave, NGW = G * NWAVES;
        const int I_IN = (D / 64) * ((DIN + 31) / 32), I_OUT = (D / 64) * (D / 32), I_Q = (D / 64) * (2048 / 32);
        bf16* win = (bf16*)(ws + WS_WIN); bf16* wout = (bf16*)(ws + WS_WOUT); bf16* wq = (bf16*)(ws + WS_WQ);
        for (int it = gw; it < I_IN + I_OUT + I_Q; it += NGW) {
            int r = it;
            if (r < I_IN) { p0_transpose_item<true>((const float*)A.in[I_WIN], D, DIN, win, scr, r, lane); continue; } r -= I_IN;
            if (r < I_OUT) { p0_transpose_item<false>((const float*)A.in[I_WOUT], D, D, wout, scr, r, lane); continue; } r -= I_OUT;
            p0_transpose_item<false>((const float*)A.in[I_WQ], D, 2048, wq, scr, r, lane);
        }
        const int gt = blk * NTHR + tid, ngt = G * NTHR;
        for (int i = gt; i < (NIN_PAD - DIN) * D / 8; i += ngt) *(GAS v4u*)(win + (size_t)DIN * D + (size_t)i * 8) = (v4u){0u, 0u, 0u, 0u};
        p0_convert((const float*)A.in[I_K1], (bf16*)(ws + WS_KEYS), (size_t)8 * 128 * 128, gt, ngt);
        p0_convert((const float*)A.in[I_K2], (bf16*)(ws + WS_KEYS) + 8 * 128 * 128, (size_t)8 * 128 * 128, gt, ngt);
        {
            const float* usrc = (const float*)A.in[I_U]; const float* vsrc = (const float*)A.in[I_V];
            auto rowp = [&](int r) { return (const GAS f32x4*)((r < NEXP ? usrc + (size_t)r * D : vsrc + (size_t)(r - NEXP) * D) + 16 * lane); };
            int r = gw; const GAS f32x4* sp = rowp(min(r, 2 * NEXP - 1)); f32x4 a = sp[0], b = sp[1], c = sp[2], d = sp[3];
            for (; r < 2 * NEXP; r += NGW) { const GAS f32x4* sn = rowp(min(r + NGW, 2 * NEXP - 1)); const f32x4 an = sn[0], bn = sn[1], cn = sn[2], dn = sn[3];
                if (r < NEXP) p0_row_i4(a, b, c, d, ws + WS_U8, (float*)(ws + WS_SC), r, lane); else p0_row_fp4(a, b, c, d, ws + WS_V8, (float*)(ws + WS_SC) + NEXP, r - NEXP, lane);
                a = an; b = bn; c = cn; d = dn; }
        }
    }
}

__device__ __forceinline__ void phase_prenorm(const Args& A, LAS unsigned char* lds) {
    const int tid = threadIdx.x, lane = tid & 63, wave = tid >> 6, G = gridDim.x;
    const float* x = (const float*)A.in[I_X]; const float* g = (const float*)A.in[I_GPRE1]; const float* mod = (const float*)(A.ws + WS_MOD);
    bf16* H = (bf16*)(A.ws + WS_H); float* gates = (float*)(A.ws + WS_GATES);
    LAS float* wg = (LAS float*)lds;
    __syncthreads();
    for (int k = tid; k < D; k += NTHR) { const float* wr = (const float*)A.in[I_WIN] + (size_t)k * DIN + 1792; const f32x4 w0 = *(const GAS f32x4*)wr, w1 = *(const GAS f32x4*)(wr + 4);
#pragma unroll
        for (int j = 0; j < 4; ++j) { wg[j * D + k] = w0[j]; wg[(4 + j) * D + k] = w1[j]; } }
    __syncthreads();
    const int gi = ((lane >> 5) & 1) * 4 + ((lane >> 4) & 1) * 2 + ((lane >> 3) & 1);
    const float gbias = gi < 4 ? ((const float*)A.in[I_BI])[gi] : ((const float*)A.in[I_BF])[gi - 4];
    f32x4 gg[4];
#pragma unroll
    for (int j = 0; j < 4; ++j) gg[j] = *(const GAS f32x4*)(g + 4 * (lane + 64 * j));
    const int stride = G * NWAVES; int row = blockIdx.x * NWAVES + wave;
    f32x4 v[4], vn[4], shv[4], gsv[4]; int bcur = -1;
#pragma unroll
    for (int j = 0; j < 4; ++j) v[j] = ((const GAS f32x4*)(x + (size_t)row * D) + lane)[64 * j];
    for (; row < M; row += stride) {
        const int rn = min(row + stride, M - 1);
#pragma unroll
        for (int j = 0; j < 4; ++j) vn[j] = ((const GAS f32x4*)(x + (size_t)rn * D) + lane)[64 * j];
        const int b = row / SEQ; float s = 0.f;
        if (b != bcur) { bcur = b;
#pragma unroll
            for (int j = 0; j < 4; ++j) { const int k = 4 * (lane + 64 * j); shv[j] = *(const GAS f32x4*)(mod + b * 6144 + k); const f32x4 sc = *(const GAS f32x4*)(mod + b * 6144 + 1024 + k);
#pragma unroll
                for (int i = 0; i < 4; ++i) gsv[j][i] = gg[j][i] * (1.f + sc[i]); } }
#pragma unroll
        for (int j = 0; j < 4; ++j) s += (v[j][0] * v[j][0] + v[j][1] * v[j][1]) + (v[j][2] * v[j][2] + v[j][3] * v[j][3]);
        const float rstd = 1.0f / sqrtf(wave_sum(s) * (1.f / D) + EPS);
        GAS v2u* o = (GAS v2u*)(H + (size_t)row * D) + lane;
        float gd[8];
#pragma unroll
        for (int q = 0; q < 8; ++q) gd[q] = 0.f;
#pragma unroll
        for (int j = 0; j < 4; ++j) {
            f32x4 y;
#pragma unroll
            for (int i = 0; i < 4; ++i) y[i] = v[j][i] * rstd * gsv[j][i] + shv[j][i];
            v2u w; w.x = pk2(y[0], y[1]); w.y = pk2(y[2], y[3]); o[64 * j] = w;
#pragma unroll
            for (int q = 0; q < 8; ++q) { const f32x4 ww = *(LAS const f32x4*)(wg + q * D + 4 * (lane + 64 * j)); gd[q] += (y[0] * ww[0] + y[1] * ww[1]) + (y[2] * ww[2] + y[3] * ww[3]); } }
#pragma unroll
        for (int i = 0; i < 4; ++i) { const bool up = (lane & 32) != 0; const float keep = up ? gd[i + 4] : gd[i], send = up ? gd[i] : gd[i + 4]; gd[i] = keep + __shfl_xor(send, 32); }
#pragma unroll
        for (int i = 0; i < 2; ++i) { const bool up = (lane & 16) != 0; const float keep = up ? gd[i + 2] : gd[i], send = up ? gd[i] : gd[i + 2]; gd[i] = keep + __shfl_xor(send, 16); }
        { const bool up = (lane & 8) != 0; const float keep = up ? gd[1] : gd[0], send = up ? gd[0] : gd[1]; gd[0] = keep + __shfl_xor(send, 8); }
        float gv = gd[0]; gv += __shfl_xor(gv, 4); gv += __shfl_xor(gv, 2); gv += __shfl_xor(gv, 1); gv += gbias;
        if ((lane & 7) == 0) gates[(size_t)row * 8 + gi] = gi < 4 ? gv : (fminf(gv, 0.f) - log1pf(__expf(-fabsf(gv))));
#pragma unroll
        for (int j = 0; j < 4; ++j) v[j] = vn[j];
    }
}

__device__ __forceinline__ void phase_mid(const Args& A) {
    const int tid = threadIdx.x, lane = tid & 63, wave = tid >> 6, G = gridDim.x;
    const float* x = (const float*)A.in[I_X]; const float* gpost = (const float*)A.in[I_GPOST1]; const float* gpre = (const float*)A.in[I_GPRE2];
    const float* mod = (const float*)(A.ws + WS_MOD); const float* sumsq = (const float*)(A.ws + WS_SSQ);
    const bf16* MIX = (const bf16*)(A.ws + WS_MIX); bf16* H = (bf16*)(A.ws + WS_H); bf16* X1 = (bf16*)(A.ws + WS_X1);
    const int stride = G * NWAVES; int row = blockIdx.x * NWAVES + wave;
    f32x4 xv[4], xn[4], q[4], qn[4], g1p[4], gs2[4], sh2[4]; v2u mw[4], mn[4]; int bcur = -1;
#pragma unroll
    for (int j = 0; j < 4; ++j) { xv[j] = ((const GAS f32x4*)(x + (size_t)row * D) + lane)[64 * j]; mw[j] = ((const GAS v2u*)(MIX + (size_t)row * D) + lane)[64 * j]; q[j] = *(const GAS f32x4*)(sumsq + (size_t)row * 16 + 4 * j); }
    for (; row < M; row += stride) {
        const int rn = min(row + stride, M - 1);
#pragma unroll
        for (int j = 0; j < 4; ++j) { xn[j] = ((const GAS f32x4*)(x + (size_t)rn * D) + lane)[64 * j]; mn[j] = ((const GAS v2u*)(MIX + (size_t)rn * D) + lane)[64 * j]; qn[j] = *(const GAS f32x4*)(sumsq + (size_t)rn * 16 + 4 * j); }
        const int b = row / SEQ;
        if (b != bcur) { bcur = b;
#pragma unroll
            for (int j = 0; j < 4; ++j) { const int k = 4 * (lane + 64 * j); const f32x4 gp = *(const GAS f32x4*)(gpost + k), g1 = *(const GAS f32x4*)(mod + b * 6144 + 2048 + k), gg = *(const GAS f32x4*)(gpre + k), sc = *(const GAS f32x4*)(mod + b * 6144 + 4096 + k);
                sh2[j] = *(const GAS f32x4*)(mod + b * 6144 + 3072 + k);
#pragma unroll
                for (int i = 0; i < 4; ++i) { g1p[j][i] = g1[i] * gp[i]; gs2[j][i] = gg[i] * (1.f + sc[i]); } } }
        const float rm = 1.0f / sqrtf(((((q[0][0] + q[0][1]) + (q[0][2] + q[0][3])) + ((q[1][0] + q[1][1]) + (q[1][2] + q[1][3]))) + (((q[2][0] + q[2][1]) + (q[2][2] + q[2][3])) + ((q[3][0] + q[3][1]) + (q[3][2] + q[3][3])))) * (1.f / D) + EPS);
        f32x4 v[4]; float s = 0.f;
#pragma unroll
        for (int j = 0; j < 4; ++j) {
            const float mx[4] = {bflo(mw[j].x), bfhi(mw[j].x), bflo(mw[j].y), bfhi(mw[j].y)};
#pragma unroll
            for (int i = 0; i < 4; ++i) { v[j][i] = xv[j][i] + g1p[j][i] * (mx[i] * rm); s += v[j][i] * v[j][i]; }
            { v2u w; w.x = pk2(v[j][0], v[j][1]); w.y = pk2(v[j][2], v[j][3]); *((GAS v2u*)(X1 + (size_t)row * D) + lane + 64 * j) = w; } }
        const float rstd = 1.0f / sqrtf(wave_sum(s) * (1.f / D) + EPS);
        GAS v2u* o = (GAS v2u*)(H + (size_t)row * D) + lane; float amx = 0.f;
#pragma unroll
        for (int j = 0; j < 4; ++j) {
#pragma unroll
            for (int i = 0; i < 4; ++i) { v[j][i] = v[j][i] * rstd * gs2[j][i] + sh2[j][i]; amx = fmaxf(amx, fabsf(v[j][i])); }
            v2u w; w.x = pk2(v[j][0], v[j][1]); w.y = pk2(v[j][2], v[j][3]); o[64 * j] = w; }
        amx = wave_max(amx); const float s8 = amx > 0.f ? 119.0f / amx : 1.0f;
        GAS unsigned short* ohh = (GAS unsigned short*)((unsigned char*)A.ws + WS_H8 + (size_t)row * (D / 2)) + lane; GAS unsigned short* ohl = (GAS unsigned short*)((unsigned char*)A.ws + WS_H8 + 32 * MiB + (size_t)row * (D / 2)) + lane;
#pragma unroll
        for (int j = 0; j < 4; ++j) { unsigned whh = 0, whl = 0;
#pragma unroll
            for (int i = 0; i < 4; ++i) { const int tq = __float2int_rn(v[j][i] * s8) + 8; whh |= ((unsigned)(tq >> 4) & 15u) << (4 * i); whl |= ((unsigned)((tq & 15) - 8) & 15u) << (4 * i); }
            ohh[64 * j] = (unsigned short)whh; ohl[64 * j] = (unsigned short)whl; }
        if (lane == 0) ((float*)(A.ws + WS_HS))[row] = amx > 0.f ? amx * (1.0f / 119.0f) : 1.0f;
#pragma unroll
        for (int j = 0; j < 4; ++j) { xv[j] = xn[j]; mw[j] = mn[j]; q[j] = qn[j]; }
    }
}
__device__ __forceinline__ void load64bf(const bf16* p, float (&o)[64]) {
#pragma unroll
    for (int i = 0; i < 8; ++i) { const v4u w = *(const GAS v4u*)(p + 8 * i);
        o[8 * i + 0] = bflo(w.x); o[8 * i + 1] = bfhi(w.x); o[8 * i + 2] = bflo(w.y); o[8 * i + 3] = bfhi(w.y);
        o[8 * i + 4] = bflo(w.z); o[8 * i + 5] = bfhi(w.z); o[8 * i + 6] = bflo(w.w); o[8 * i + 7] = bfhi(w.w); }
}
__device__ __forceinline__ void phase_attn_naive(const Args& A, int vb, int nvb) {
    const bf16* P = (const bf16*)(A.ws + WS_PROJ); bf16* MI = (bf16*)(A.ws + WS_MIXIN); const float* sinks = (const float*)A.in[I_SINK];
    for (int task = vb * NTHR + (int)threadIdx.x; task < 8 * M; task += nvb * NTHR) {
        const int h = task / M, t = task % M, s = t % SEQ, kvh = h >> 2;
        float q[64], o[64];
        load64bf(P + (size_t)t * NPROJ + C_AQ + h * 64, q);
#pragma unroll
        for (int d = 0; d < 64; ++d) o[d] = 0.f;
        float mx = sinks[h], l = 1.f;
        for (int j = 0; j < 128; ++j) {
            const int sj = s - 127 + j; const bool valid = sj >= 0; const int tk = valid ? (t - 127 + j) : t;
            const bf16* kr = P + (size_t)tk * NPROJ + C_AK + kvh * 64; float sc = 0.f;
#pragma unroll
            for (int i = 0; i < 8; ++i) { const v4u w = *(const GAS v4u*)(kr + 8 * i);
                sc += q[8 * i + 0] * bflo(w.x) + q[8 * i + 1] * bfhi(w.x) + q[8 * i + 2] * bflo(w.y) + q[8 * i + 3] * bfhi(w.y)
                    + q[8 * i + 4] * bflo(w.z) + q[8 * i + 5] * bfhi(w.z) + q[8 * i + 6] * bflo(w.w) + q[8 * i + 7] * bfhi(w.w); }
            if (valid) {
                const float mn = fmaxf(mx, sc), al = __expf(mx - mn), p = __expf(sc - mn); mx = mn; l = l * al + p;
                const bf16* vr = P + (size_t)tk * NPROJ + C_AV + kvh * 64;
#pragma unroll
                for (int i = 0; i < 8; ++i) { const v4u w = *(const GAS v4u*)(vr + 8 * i);
                    o[8 * i + 0] = o[8 * i + 0] * al + p * bflo(w.x); o[8 * i + 1] = o[8 * i + 1] * al + p * bfhi(w.x);
                    o[8 * i + 2] = o[8 * i + 2] * al + p * bflo(w.y); o[8 * i + 3] = o[8 * i + 3] * al + p * bfhi(w.y);
                    o[8 * i + 4] = o[8 * i + 4] * al + p * bflo(w.z); o[8 * i + 5] = o[8 * i + 5] * al + p * bfhi(w.z);
                    o[8 * i + 6] = o[8 * i + 6] * al + p * bflo(w.w); o[8 * i + 7] = o[8 * i + 7] * al + p * bfhi(w.w); }
            }
        }
        const float il = 1.f / l; bf16* orow = MI + (size_t)t * D + h * 64;
#pragma unroll
        for (int i = 0; i < 8; ++i) { v4u w; w.x = pk2(o[8 * i] * il, o[8 * i + 1] * il); w.y = pk2(o[8 * i + 2] * il, o[8 * i + 3] * il);
            w.z = pk2(o[8 * i + 4] * il, o[8 * i + 5] * il); w.w = pk2(o[8 * i + 6] * il, o[8 * i + 7] * il); *(GAS v4u*)(orow + 8 * i) = w; }
    }
}

__device__ __forceinline__ void phase_mlstm_naive(const Args& A, LAS unsigned char* lds, int bh) {
    const int tid = threadIdx.x, lane = tid & 63, wave = tid >> 6, b = bh >> 2, h = bh & 3, dv = tid >> 2, part = tid & 3;
    const bf16* P = (const bf16*)(A.ws + WS_PROJ); bf16* MI = (bf16*)(A.ws + WS_MIXIN); const float* gates = (const float*)(A.ws + WS_GATES);
    const float* cw = (const float*)A.in[I_CONVW]; const float* ng = (const float*)A.in[I_MNG];
    LAS float* qs = (LAS float*)lds; LAS float* ks = qs + 64 * 64; LAS float* vs = ks + 64 * 64; LAS float* ig = vs + 64 * 128; LAS float* lfg = ig + 64; LAS float* hb = lfg + 64;
    float C[16], n[16]; float m = 0.f;
#pragma unroll
    for (int j = 0; j < 16; ++j) { C[j] = 0.f; n[j] = 0.f; }
    for (int ch = 0; ch < SEQ / 64; ++ch) {
        const int s0 = ch * 64; const size_t t0 = (size_t)b * SEQ + s0;
        for (int e = tid; e < 64 * 64; e += NTHR) { const int l = e >> 6, dk = e & 63; float aq = 0.f, ak = 0.f;
#pragma unroll
            for (int j = 0; j < 4; ++j) { const int sj = s0 + l - 3 + j; if (sj >= 0) { const bf16* r = P + ((size_t)b * SEQ + sj) * NPROJ;
                aq += cw[j * 512 + h * 64 + dk] * bf1(r[C_MQ + h * 64 + dk]); ak += cw[j * 512 + 256 + h * 64 + dk] * bf1(r[C_MK + h * 64 + dk]); } }
            qs[e] = 0.125f * aq / (1.f + __expf(-aq)); ks[e] = ak / (1.f + __expf(-ak)); }
        for (int e = tid; e < 64 * 128; e += NTHR) { const int l = e >> 7, d = e & 127; vs[e] = bf1(P[(t0 + l) * NPROJ + C_MV + h * 128 + d]); }
        if (tid < 64) { ig[tid] = gates[(t0 + tid) * 8 + h]; lfg[tid] = gates[(t0 + tid) * 8 + 4 + h]; }
        __syncthreads();
        for (int l = 0; l < 64; ++l) {
            const float lf = lfg[l], ii = ig[l], mn = fmaxf(lf + m, ii), fd = __expf(lf + m - mn), iw = __expf(ii - mn), vv = vs[l * 128 + dv] * iw;
            float num = 0.f, den = 0.f;
#pragma unroll
            for (int j = 0; j < 16; ++j) { const float kk = ks[l * 64 + part * 16 + j], qq = qs[l * 64 + part * 16 + j];
                C[j] = fd * C[j] + vv * kk; n[j] = fd * n[j] + iw * kk; num += C[j] * qq; den += n[j] * qq; }
            num += __shfl_xor(num, 1); num += __shfl_xor(num, 2); den += __shfl_xor(den, 1); den += __shfl_xor(den, 2);
            if (part == 0) hb[l * 128 + dv] = num / fmaxf(fabsf(den), __expf(-mn));
            m = mn;
        }
        __syncthreads();
        for (int l = wave * 8; l < wave * 8 + 8; ++l) { const float a0 = hb[l * 128 + lane], a1 = hb[l * 128 + 64 + lane];
            const float r = 1.0f / sqrtf(wave_sum(a0 * a0 + a1 * a1) * (1.f / 128.f) + EPS);
            const bf16* pr = P + (t0 + l) * NPROJ + C_MO + h * 128; bf16* orow = MI + (t0 + l) * D + 512 + h * 128;
            orow[lane] = (bf16)f2bf(a0 * r * ng[h * 128 + lane] * bf1(pr[lane])); orow[64 + lane] = (bf16)f2bf(a1 * r * ng[h * 128 + 64 + lane] * bf1(pr[64 + lane])); }
        __syncthreads();
    }
}

__device__ __forceinline__ void ld16bf(const bf16* p, float (&o)[16]) {
    const v4u w0 = *(const GAS v4u*)p, w1 = *(const GAS v4u*)(p + 8);
    o[0] = bflo(w0.x); o[1] = bfhi(w0.x); o[2] = bflo(w0.y); o[3] = bfhi(w0.y); o[4] = bflo(w0.z); o[5] = bfhi(w0.z); o[6] = bflo(w0.w); o[7] = bfhi(w0.w);
    o[8] = bflo(w1.x); o[9] = bfhi(w1.x); o[10] = bflo(w1.y); o[11] = bfhi(w1.y); o[12] = bflo(w1.z); o[13] = bfhi(w1.z); o[14] = bflo(w1.w); o[15] = bfhi(w1.w);
}
typedef short bf16x8 __attribute__((ext_vector_type(8)));
#define MFMA16(a, b, c) __builtin_amdgcn_mfma_f32_16x16x32_bf16((a), (b), (c), 0, 0, 0)
__device__ __forceinline__ bf16x8 ldfrag(LAS const unsigned char* img, int row, int kbyte) { return *(LAS const bf16x8*)(img + row * 144 + kbyte); }
__device__ __forceinline__ unsigned cvtpk(float lo, float hi) { unsigned r; asm volatile("v_cvt_pk_bf16_f32 %0, %1, %2" : "=v"(r) : "v"(lo), "v"(hi)); return r; }

namespace ml {
constexpr int O_Q = 0, O_QA = 9216, O_K = 18432, O_KWT = 27648, O_VT = 36864, O_CX = 57600, CXB = 20736, O_S = 99072, O_GB = 108288, O_GA = O_GB + 4096, O_GC = O_GA + 4096, O_DEN = O_GC + 4096, O_SSQ = O_DEN + 256, O_END = O_SSQ + 2048;
static_assert(O_END <= 131072, "mlstm LDS");
constexpr size_t MST_SC = 11 * MiB;
}
template <bool OUT>
__device__ __forceinline__ void mlstm_group(const Args& A, LAS unsigned char* lds, int wg) {
    using namespace ml;
    const int tid = threadIdx.x, lane = tid & 63, wave = __builtin_amdgcn_readfirstlane(tid >> 6), fr = lane & 15, fq = lane >> 4;
    const int bh = wg >> 3, grp = wg & 7, b = bh >> 2, h = bh & 3;
    const size_t tg0 = (size_t)b * SEQ + (size_t)grp * 1024;
    const bf16* P = (const bf16*)(A.ws + WS_PROJ); bf16* MI = (bf16*)(A.ws + WS_MIXIN); const float* gates = (const float*)(A.ws + WS_GATES);
    const float* cw = (const float*)A.in[I_CONVW]; const float* ng = (const float*)A.in[I_MNG];
    float* MST = (float*)(A.ws + WS_MST); float* MSC = (float*)(A.ws + WS_MST + MST_SC);
    LAS float* GB = (LAS float*)(lds + O_GB); LAS float* GA = (LAS float*)(lds + O_GA); LAS float* GC = (LAS float*)(lds + O_GC);
    LAS float* DEN = (LAS float*)(lds + O_DEN); LAS float* SSQ = (LAS float*)(lds + O_SSQ);
    __syncthreads();
#pragma unroll
    for (int cc = 0; cc < 2; ++cc) { const int c = 2 * wave + cc; const size_t t = tg0 + c * 64 + lane;
        float bc = gates[t * 8 + 4 + h]; const float ii = gates[t * 8 + h];
#pragma unroll
        for (int o = 1; o < 64; o <<= 1) { const float v = __shfl_up(bc, o); if (lane >= o) bc += v; }
        const float a = ii - bc; float cm = a;
#pragma unroll
        for (int o = 1; o < 64; o <<= 1) { const float v = __shfl_up(cm, o); if (lane >= o) cm = fmaxf(cm, v); }
        GB[c * 64 + lane] = bc; GA[c * 64 + lane] = a; GC[c * 64 + lane] = cm; }
    for (int e = tid; e < 16 * 32; e += NTHR) { const int r = e >> 5, cpair = e & 31; *(LAS unsigned*)(lds + O_VT + (128 + r) * 144 + cpair * 4) = (r == 0) ? 0x3F803F80u : 0u; }
    f32x4 st[5];
#pragma unroll
    for (int i = 0; i < 5; ++i) st[i] = (f32x4){0.f, 0.f, 0.f, 0.f};
    float m = OUT ? 0.f : -__builtin_inff(); float Btot = 0.f;
    if (OUT) {
        for (int gp = 0; gp < grp; ++gp) { const int wgp = bh * 8 + gp; const float mg = MSC[wgp * 2], Bg = MSC[wgp * 2 + 1];
            const float mn = fmaxf(Bg + m, mg), f0 = __expf(Bg + m - mn), f1 = __expf(mg - mn);
#pragma unroll
            for (int i = 0; i < 5; ++i)
#pragma unroll
                for (int r = 0; r < 4; ++r) st[i][r] = f0 * st[i][r] + f1 * MST[((size_t)wgp * 20 + i * 4 + r) * NTHR + tid];
            m = mn; }
#pragma unroll
        for (int j = 0; j < 4; ++j)
#pragma unroll
            for (int r = 0; r < 4; ++r) *(LAS bf16*)(lds + O_CX + (16 * wave + 4 * fq + r) * 144 + (16 * j + fr) * 2) = (bf16)f2bf(st[j][r]);
        if (wave < 4) {
#pragma unroll
            for (int r = 0; r < 4; ++r) *(LAS bf16*)(lds + O_CX + (128 + 4 * fq + r) * 144 + (16 * wave + fr) * 2) = (bf16)f2bf(st[4][r]); }
    }
    float gsc[4];
#pragma unroll
    for (int r = 0; r < 4; ++r) gsc[r] = ng[h * 128 + 16 * wave + 4 * fq + r];
    const int sl = tid >> 3, cg = tid & 7;
    __syncthreads();
    for (int c = 0; c < 16; ++c) {
        const float bL = GB[c * 64 + 63], M63 = fmaxf(m, GC[c * 64 + 63]), decay = __expf(m - M63);
        const size_t tc0 = tg0 + (size_t)c * 64;
        {
            const int sabs = grp * 1024 + c * 64 + sl;
            float aq[8], ak[8];
#pragma unroll
            for (int i = 0; i < 8; ++i) { aq[i] = 0.f; ak[i] = 0.f; }
#pragma unroll
            for (int j = 0; j < 4; ++j) { const int sj = sabs - 3 + j;
                if (sj >= 0) { const bf16* rp = P + ((size_t)b * SEQ + sj) * NPROJ;
                    const v4u wq = *(const GAS v4u*)(rp + C_MQ + h * 64 + 8 * cg), wk = *(const GAS v4u*)(rp + C_MK + h * 64 + 8 * cg);
                    const f32x4 q0 = *(const GAS f32x4*)(cw + j * 512 + h * 64 + 8 * cg), q1 = *(const GAS f32x4*)(cw + j * 512 + h * 64 + 8 * cg + 4);
                    const f32x4 k0 = *(const GAS f32x4*)(cw + j * 512 + 256 + h * 64 + 8 * cg), k1 = *(const GAS f32x4*)(cw + j * 512 + 256 + h * 64 + 8 * cg + 4);
                    aq[0] += q0[0] * bflo(wq.x); aq[1] += q0[1] * bfhi(wq.x); aq[2] += q0[2] * bflo(wq.y); aq[3] += q0[3] * bfhi(wq.y);
                    aq[4] += q1[0] * bflo(wq.z); aq[5] += q1[1] * bfhi(wq.z); aq[6] += q1[2] * bflo(wq.w); aq[7] += q1[3] * bfhi(wq.w);
                    ak[0] += k0[0] * bflo(wk.x); ak[1] += k0[1] * bfhi(wk.x); ak[2] += k0[2] * bflo(wk.y); ak[3] += k0[3] * bfhi(wk.y);
                    ak[4] += k1[0] * bflo(wk.z); ak[5] += k1[1] * bfhi(wk.z); ak[6] += k1[2] * bflo(wk.w); ak[7] += k1[3] * bfhi(wk.w); } }
            const float Ml = fmaxf(m, GC[c * 64 + sl]), ainter = __expf(m - Ml), wsv = __expf(GA[c * 64 + sl] - M63);
            float qv[8], kv[8];
#pragma unroll
            for (int i = 0; i < 8; ++i) { qv[i] = 0.125f * aq[i] * __builtin_amdgcn_rcpf(1.f + __expf(-aq[i])); kv[i] = ak[i] * __builtin_amdgcn_rcpf(1.f + __expf(-ak[i])); }
            if (OUT) {
                v4u w; w.x = pk2(qv[0], qv[1]); w.y = pk2(qv[2], qv[3]); w.z = pk2(qv[4], qv[5]); w.w = pk2(qv[6], qv[7]); *(LAS v4u*)(lds + O_Q + sl * 144 + cg * 16) = w;
                w.x = pk2(qv[0] * ainter, qv[1] * ainter); w.y = pk2(qv[2] * ainter, qv[3] * ainter); w.z = pk2(qv[4] * ainter, qv[5] * ainter); w.w = pk2(qv[6] * ainter, qv[7] * ainter); *(LAS v4u*)(lds + O_QA + sl * 144 + cg * 16) = w;
                w.x = pk2(kv[0], kv[1]); w.y = pk2(kv[2], kv[3]); w.z = pk2(kv[4], kv[5]); w.w = pk2(kv[6], kv[7]); *(LAS v4u*)(lds + O_K + sl * 144 + cg * 16) = w;
            }
#pragma unroll
            for (int i = 0; i < 8; ++i) *(LAS bf16*)(lds + O_KWT + (8 * cg + i) * 144 + sl * 2) = (bf16)f2bf(kv[i] * wsv);
#pragma unroll
            for (int gi = 0; gi < 2; ++gi) { const int g8 = cg + 8 * gi; const v4u wv = *(const GAS v4u*)(P + (tc0 + sl) * NPROJ + C_MV + h * 128 + 8 * g8);
                const unsigned ww[4] = {wv.x, wv.y, wv.z, wv.w};
#pragma unroll
                for (int i = 0; i < 4; ++i) { *(LAS bf16*)(lds + O_VT + (8 * g8 + 2 * i) * 144 + sl * 2) = (bf16)(ww[i] & 0xffffu); *(LAS bf16*)(lds + O_VT + (8 * g8 + 2 * i + 1) * 144 + sl * 2) = (bf16)(ww[i] >> 16); } }
        }
        __syncthreads();
        if (OUT) {
            const int lt = wave >> 1, l = 16 * lt + fr; const float Ml = fmaxf(m, GC[c * 64 + l]);
            const bf16x8 bq0 = ldfrag(lds + O_Q, 16 * lt + fr, 16 * fq), bq1 = ldfrag(lds + O_Q, 16 * lt + fr, 64 + 16 * fq);
#pragma unroll
            for (int u = 0; u < 2; ++u) { const int stl = 2 * (wave & 1) + u; f32x4 acc = {0.f, 0.f, 0.f, 0.f};
                acc = MFMA16(ldfrag(lds + O_K, 16 * stl + fr, 16 * fq), bq0, acc); acc = MFMA16(ldfrag(lds + O_K, 16 * stl + fr, 64 + 16 * fq), bq1, acc);
                const f32x4 av = *(LAS const f32x4*)(GA + c * 64 + 16 * stl + 4 * fq); float wv[4];
#pragma unroll
                for (int r = 0; r < 4; ++r) { const int s = 16 * stl + 4 * fq + r; wv[r] = (s <= l) ? acc[r] * __expf(av[r] - Ml) : 0.f; }
                v2u w; w.x = cvtpk(wv[0], wv[1]); w.y = cvtpk(wv[2], wv[3]); *(LAS v2u*)(lds + O_S + l * 144 + (16 * stl + 4 * fq) * 2) = w; }
        }
        {
            const bf16x8 va0 = ldfrag(lds + O_VT, 16 * wave + fr, 16 * fq), va1 = ldfrag(lds + O_VT, 16 * wave + fr, 64 + 16 * fq);
#pragma unroll
            for (int j = 0; j < 4; ++j) { st[j] = st[j] * decay;
                st[j] = MFMA16(va0, ldfrag(lds + O_KWT, 16 * j + fr, 16 * fq), st[j]); st[j] = MFMA16(va1, ldfrag(lds + O_KWT, 16 * j + fr, 64 + 16 * fq), st[j]); }
            if (wave < 4) { st[4] = st[4] * decay;
                st[4] = MFMA16(ldfrag(lds + O_VT, 128 + fr, 16 * fq), ldfrag(lds + O_KWT, 16 * wave + fr, 16 * fq), st[4]);
                st[4] = MFMA16(ldfrag(lds + O_VT, 128 + fr, 64 + 16 * fq), ldfrag(lds + O_KWT, 16 * wave + fr, 64 + 16 * fq), st[4]); }
        }
        if (OUT) {
            __syncthreads();
            LAS const unsigned char* cx = lds + O_CX + (c & 1) * CXB;
            f32x4 nt[4], nd = {0.f, 0.f, 0.f, 0.f};
            {
                const bf16x8 va0 = ldfrag(lds + O_VT, 16 * wave + fr, 16 * fq), va1 = ldfrag(lds + O_VT, 16 * wave + fr, 64 + 16 * fq);
                const bf16x8 ca0 = ldfrag(cx, 16 * wave + fr, 16 * fq), ca1 = ldfrag(cx, 16 * wave + fr, 64 + 16 * fq);
#pragma unroll
                for (int lt = 0; lt < 4; ++lt) { f32x4 acc = {0.f, 0.f, 0.f, 0.f};
                    acc = MFMA16(va0, ldfrag(lds + O_S, 16 * lt + fr, 16 * fq), acc); acc = MFMA16(va1, ldfrag(lds + O_S, 16 * lt + fr, 64 + 16 * fq), acc);
                    acc = MFMA16(ca0, ldfrag(lds + O_QA, 16 * lt + fr, 16 * fq), acc); acc = MFMA16(ca1, ldfrag(lds + O_QA, 16 * lt + fr, 64 + 16 * fq), acc); nt[lt] = acc; }
                if (wave >= 4) { const int lt = wave - 4;
                    nd = MFMA16(ldfrag(lds + O_VT, 128 + fr, 16 * fq), ldfrag(lds + O_S, 16 * lt + fr, 16 * fq), nd); nd = MFMA16(ldfrag(lds + O_VT, 128 + fr, 64 + 16 * fq), ldfrag(lds + O_S, 16 * lt + fr, 64 + 16 * fq), nd);
                    nd = MFMA16(ldfrag(cx, 128 + fr, 16 * fq), ldfrag(lds + O_QA, 16 * lt + fr, 16 * fq), nd); nd = MFMA16(ldfrag(cx, 128 + fr, 64 + 16 * fq), ldfrag(lds + O_QA, 16 * lt + fr, 64 + 16 * fq), nd);
                    if (fq == 0) DEN[16 * lt + fr] = nd[0]; }
            }
            v2u mo[4];
#pragma unroll
            for (int lt = 0; lt < 4; ++lt) mo[lt] = *(const GAS v2u*)(P + (tc0 + 16 * lt + fr) * NPROJ + C_MO + h * 128 + 16 * wave + 4 * fq);
            __syncthreads();
#pragma unroll
            for (int lt = 0; lt < 4; ++lt) { const int l = 16 * lt + fr; const float Ml = fmaxf(m, GC[c * 64 + l]);
                const float inv = 1.0f / fmaxf(fabsf(DEN[l]), __expf(-(GB[c * 64 + l] + Ml)));
                nt[lt] = nt[lt] * inv; float ss = (nt[lt][0] * nt[lt][0] + nt[lt][1] * nt[lt][1]) + (nt[lt][2] * nt[lt][2] + nt[lt][3] * nt[lt][3]);
                ss += __shfl_xor(ss, 16); ss += __shfl_xor(ss, 32);
                if (fq == 0) SSQ[wave * 64 + l] = ss; }
            LAS unsigned char* cxn = lds + O_CX + ((c + 1) & 1) * CXB;
#pragma unroll
            for (int j = 0; j < 4; ++j)
#pragma unroll
                for (int r = 0; r < 4; ++r) *(LAS bf16*)(cxn + (16 * wave + 4 * fq + r) * 144 + (16 * j + fr) * 2) = (bf16)f2bf(st[j][r]);
            if (wave < 4) {
#pragma unroll
                for (int r = 0; r < 4; ++r) *(LAS bf16*)(cxn + (128 + 4 * fq + r) * 144 + (16 * wave + fr) * 2) = (bf16)f2bf(st[4][r]); }
            __syncthreads();
#pragma unroll
            for (int lt = 0; lt < 4; ++lt) { const int l = 16 * lt + fr; float tot = 0.f;
#pragma unroll
                for (int w2 = 0; w2 < 8; ++w2) tot += SSQ[w2 * 64 + l];
                const float rn = 1.0f / sqrtf(tot * (1.f / 128.f) + EPS);
                const float o0 = nt[lt][0] * rn * gsc[0] * bflo(mo[lt].x), o1 = nt[lt][1] * rn * gsc[1] * bfhi(mo[lt].x), o2 = nt[lt][2] * rn * gsc[2] * bflo(mo[lt].y), o3 = nt[lt][3] * rn * gsc[3] * bfhi(mo[lt].y);
                v2u w; w.x = pk2(o0, o1); w.y = pk2(o2, o3);
                *(GAS v2u*)(MI + (tc0 + l) * D + 512 + h * 128 + 16 * wave + 4 * fq) = w; }
        } else {
            __syncthreads();
        }
        m = bL + M63; Btot += bL;
    }
    if (!OUT) {
#pragma unroll
        for (int i = 0; i < 5; ++i)
#pragma unroll
            for (int r = 0; r < 4; ++r) MST[((size_t)wg * 20 + i * 4 + r) * NTHR + tid] = st[i][r];
        if (tid == 0) { MSC[wg * 2] = m; MSC[wg * 2 + 1] = Btot; }
    }
}

namespace at {
constexpr int O_K = 0, O_VT = 36864, VTS = 560  , O_END = O_VT + 64 * VTS;
static_assert(O_END <= 131072, "attention LDS");
}
__device__ __forceinline__ void phase_attn(const Args& A, LAS unsigned char* lds) {
    using namespace at;
    const int tid = threadIdx.x, lane = tid & 63, wave = __builtin_amdgcn_readfirstlane(tid >> 6), fr = lane & 15, fq = lane >> 4, G = gridDim.x;
    const bf16* P = (const bf16*)(A.ws + WS_PROJ); bf16* MI = (bf16*)(A.ws + WS_MIXIN); const float* sinks = (const float*)A.in[I_SINK];
    __syncthreads();
    for (int e = tid; e < 64 * 12; e += NTHR) { const int r = e / 12, cpair = e % 12; *(LAS unsigned*)(lds + O_VT + r * VTS + 512 + cpair * 4) = 0u; }
    for (int unit = blockIdx.x; unit < NB * 64 * 2; unit += G) {
        const int g = unit & 1, n = (unit >> 1) & 63, b = unit >> 7;
        const size_t tq0 = (size_t)b * SEQ + (size_t)n * 128;
        __syncthreads();
#pragma unroll
        for (int i = 0; i < 4; ++i) { const int item = tid + NTHR * i, row = item >> 3, ch = item & 7;
            v4u wk = {0u, 0u, 0u, 0u}, wv = {0u, 0u, 0u, 0u};
            if (n > 0 || row >= 128) { const bf16* rp = P + (tq0 - 128 + row) * NPROJ; wk = *(const GAS v4u*)(rp + C_AK + g * 64 + 8 * ch); wv = *(const GAS v4u*)(rp + C_AV + g * 64 + 8 * ch); }
            *(LAS v4u*)(lds + O_K + row * 144 + ch * 16) = wk;
            const unsigned ww[4] = {wv.x, wv.y, wv.z, wv.w};
#pragma unroll
            for (int k = 0; k < 4; ++k) { *(LAS bf16*)(lds + O_VT + (8 * ch + 2 * k) * VTS + row * 2) = (bf16)(ww[k] & 0xffffu); *(LAS bf16*)(lds + O_VT + (8 * ch + 2 * k + 1) * VTS + row * 2) = (bf16)(ww[k] >> 16); } }
        const int hq = 4 * g + (wave >> 1), qr0 = 64 * (wave & 1); const float sink = sinks[hq];
        __syncthreads();
        for (int qt = 0; qt < 4; ++qt) {
            const int i0 = qr0 + 16 * qt, st0 = i0 >> 4, iq = i0 + fr;
            const bf16* qp = P + (tq0 + iq) * NPROJ + C_AQ + hq * 64 + 8 * fq;
            const bf16x8 bq0 = *(const GAS bf16x8*)qp, bq1 = *(const GAS bf16x8*)(qp + 32);
            f32x4 sc[9]; float mx = sink;
#pragma unroll
            for (int t = 0; t < 9; ++t) { const int sb0 = 16 * (st0 + t); f32x4 acc = {0.f, 0.f, 0.f, 0.f};
                acc = MFMA16(ldfrag(lds + O_K, sb0 + fr, 16 * fq), bq0, acc); acc = MFMA16(ldfrag(lds + O_K, sb0 + fr, 64 + 16 * fq), bq1, acc);
#pragma unroll
                for (int r = 0; r < 4; ++r) { const int sb = sb0 + 4 * fq + r; const bool valid = (sb > iq) && (sb <= iq + 128) && (n > 0 || sb >= 128);
                    acc[r] = valid ? acc[r] : -3.0e38f; mx = fmaxf(mx, acc[r]); }
                sc[t] = acc; }
            mx = fmaxf(mx, __shfl_xor(mx, 16)); mx = fmaxf(mx, __shfl_xor(mx, 32));
            float lsum = 0.f;
#pragma unroll
            for (int t = 0; t < 9; ++t)
#pragma unroll
                for (int r = 0; r < 4; ++r) { const float p = (sc[t][r] > -1.0e38f) ? __expf(sc[t][r] - mx) : 0.f; sc[t][r] = p; lsum += p; }
            lsum += __shfl_xor(lsum, 16); lsum += __shfl_xor(lsum, 32); lsum += __expf(sink - mx);
            f32x4 oacc[4];
#pragma unroll
            for (int dt = 0; dt < 4; ++dt) oacc[dt] = (f32x4){0.f, 0.f, 0.f, 0.f};
#pragma unroll
            for (int ks = 0; ks < 5; ++ks) {
                union { bf16x8 v; unsigned u[4]; } pb;
                pb.u[0] = cvtpk(sc[2 * ks][0], sc[2 * ks][1]); pb.u[1] = cvtpk(sc[2 * ks][2], sc[2 * ks][3]);
                if (ks < 4) { pb.u[2] = cvtpk(sc[2 * ks + 1][0], sc[2 * ks + 1][1]); pb.u[3] = cvtpk(sc[2 * ks + 1][2], sc[2 * ks + 1][3]); } else { pb.u[2] = 0u; pb.u[3] = 0u; }
                const int sbb = 16 * (st0 + 2 * ks) + 4 * fq;
#pragma unroll
                for (int dt = 0; dt < 4; ++dt) { LAS const unsigned char* vp = lds + O_VT + (16 * dt + fr) * VTS + sbb * 2;
                    union { bf16x8 v; v2u h[2]; } va; va.h[0] = *(LAS const v2u*)vp; va.h[1] = *(LAS const v2u*)(vp + 32);
                    oacc[dt] = MFMA16(va.v, pb.v, oacc[dt]); } }
            const float il = 1.0f / lsum;
#pragma unroll
            for (int dt = 0; dt < 4; ++dt) { v2u w; w.x = pk2(oacc[dt][0] * il, oacc[dt][1] * il); w.y = pk2(oacc[dt][2] * il, oacc[dt][3] * il);
                *(GAS v2u*)(MI + (tq0 + iq) * D + hq * 64 + 16 * dt + 4 * fq) = w; }
        }
    }
}
typedef float f32x16 __attribute__((ext_vector_type(16)));
__device__ __forceinline__ unsigned fbits(float f) { return __builtin_bit_cast(unsigned, f); }
__device__ __forceinline__ float bfloat(unsigned u) { return __builtin_bit_cast(float, u); }

#define CE_DESC(a, b) do { const float _mx = __builtin_fmaxf(a, b), _mn = __builtin_fminf(a, b); a = _mx; b = _mn; } while (0)
__device__ __forceinline__ void bsort16(float (&v)[16]) {
#pragma unroll
    for (int k = 2; k <= 16; k <<= 1)
#pragma unroll
        for (int j = k >> 1; j > 0; j >>= 1)
#pragma unroll
            for (int i = 0; i < 16; ++i) { const int l = i ^ j; if (l > i) { if ((i & k) == 0) CE_DESC(v[i], v[l]); else CE_DESC(v[l], v[i]); } }
}
__device__ __forceinline__ void bmerge16(float (&v)[16], const float (&w)[16]) {
#pragma unroll
    for (int i = 0; i < 16; ++i) v[i] = __builtin_fmaxf(v[i], w[15 - i]);
#pragma unroll
    for (int j = 8; j > 0; j >>= 1)
#pragma unroll
        for (int i = 0; i < 16; ++i) { const int l = i ^ j; if (l > i) CE_DESC(v[i], v[l]); }
}
namespace tk {
constexpr int KS = 272;
constexpr int O_K1 = 0, O_K2 = 128 * KS, O_X = 2 * 128 * KS, O_END = O_X + 8 * 4096;
static_assert(O_END <= 131072, "topk LDS");
constexpr unsigned char CAND[64] = {
    0x00, 0x01, 0x02, 0x03, 0x04, 0x05, 0x06, 0x07, 0x08, 0x09, 0x0a, 0x0b, 0x0c, 0x0d, 0x0e, 0x0f,
    0x10, 0x11, 0x12, 0x13, 0x14, 0x15, 0x16, 0x17, 0x80, 0x90, 0xa0, 0xb0, 0xc0, 0xd0, 0xe0, 0xf0,
    0x20, 0x21, 0x22, 0x23, 0x24, 0x30, 0x31, 0x32, 0x33, 0x40, 0x41, 0x42, 0x50, 0x51, 0x60, 0x61,
    0x70, 0x71, 0xff, 0xff, 0xff, 0xff, 0xff, 0xff, 0xff, 0xff, 0xff, 0xff, 0xff, 0xff, 0xff, 0xff};
}
__device__ __forceinline__ void side_top16(const f32x16 (&acc)[4], int hh, float (&T)[16]) {
    float g1[16], g2[16];
#pragma unroll
    for (int r = 0; r < 16; ++r) { const unsigned key = (r & 3) + 8 * (r >> 2) + 4 * hh;
        T[r] = bfloat((fbits(acc[0][r]) & 0xffffff80u) | key);
        g1[r] = bfloat((fbits(acc[1][r]) & 0xffffff80u) | (32u + key)); }
    bsort16(T); bsort16(g1); bmerge16(T, g1);
#pragma unroll
    for (int r = 0; r < 16; ++r) { const unsigned key = (r & 3) + 8 * (r >> 2) + 4 * hh;
        g1[r] = bfloat((fbits(acc[2][r]) & 0xffffff80u) | (64u + key));
        g2[r] = bfloat((fbits(acc[3][r]) & 0xffffff80u) | (96u + key)); }
    bsort16(g1); bsort16(g2); bmerge16(g1, g2); bmerge16(T, g1);
#pragma unroll
    for (int r = 0; r < 16; ++r) g1[r] = __shfl_xor(T[r], 32);
    bmerge16(T, g1);
}
template <int SD> __device__ __forceinline__ void topk_side(const bf16* Q, LAS unsigned char* lds, int t, int h, int r32, int hh, float (&T)[16]) {
    using namespace tk;
    f32x16 acc[4];
#pragma unroll
    for (int mt = 0; mt < 4; ++mt)
#pragma unroll
        for (int r = 0; r < 16; ++r) acc[mt][r] = 0.f;
    const bf16* qp = Q + (size_t)t * 2048 + h * 256 + SD * 128 + 8 * hh; LAS const unsigned char* kimg = lds + (SD ? O_K2 : O_K1);
#pragma unroll
    for (int ks = 0; ks < 8; ++ks) { const bf16x8 bq = *(const GAS bf16x8*)(qp + 16 * ks);
#pragma unroll
        for (int mt = 0; mt < 4; ++mt) acc[mt] = __builtin_amdgcn_mfma_f32_32x32x16_bf16(*(LAS const bf16x8*)(kimg + (32 * mt + r32) * KS + 32 * ks + 16 * hh), bq, acc[mt], 0, 0, 0); }
    side_top16(acc, hh, T);
}
template <int Q> __device__ __forceinline__ float cand_val(const float (&T1)[16], const float (&T2)[16], int hh) {
    constexpr unsigned c0 = tk::CAND[2 * Q], c1 = tk::CAND[2 * Q + 1];
    const float s = (hh ? T1[(c1 >> 4) & 15] : T1[(c0 >> 4) & 15]) + (hh ? T2[c1 & 15] : T2[c0 & 15]); const unsigned code = hh ? c1 : c0;
    return (code == 0xffu) ? -3.0e38f : bfloat((fbits(s) & 0xffffff00u) | code);
}
__device__ __forceinline__ void phase_topk(const Args& A, LAS unsigned char* lds) {
    using namespace tk;
    const int tid = threadIdx.x, lane = tid & 63, wave = __builtin_amdgcn_readfirstlane(tid >> 6), G = gridDim.x;
    const bf16* Q = (const bf16*)(A.ws + WS_PROJ); const bf16* KB = (const bf16*)(A.ws + WS_KEYS);
    unsigned short* EI = (unsigned short*)(A.ws + WS_EIDX); float* GT = (float*)(A.ws + WS_GATE);
    const int h = blockIdx.x & 7, r32 = lane & 31, hh = lane >> 5;
    __syncthreads();
    for (int e = tid; e < 2 * 128 * 16; e += NTHR) { const int s = e >> 11, row = (e >> 4) & 127, ch = e & 15;
        *(LAS v4u*)(lds + (s ? O_K2 : O_K1) + row * KS + ch * 16) = *(const GAS v4u*)(KB + (size_t)s * 8 * 128 * 128 + ((size_t)h * 128 + row) * 128 + ch * 8); }
    __syncthreads();
    LAS float* XW = (LAS float*)(lds + O_X + wave * 4096) + r32 * 32;
    for (int tile = (int)(blockIdx.x >> 3); tile < M / 256; tile += (G >> 3)) {
        const int t = tile * 256 + 32 * wave + r32;
        float T1[16], T2[16];
        topk_side<0>(Q, lds, t, h, r32, hh, T1);
        topk_side<1>(Q, lds, t, h, r32, hh, T2);
        float c[16], w[16];
        c[0] = cand_val<0>(T1, T2, hh); w[0] = cand_val<16>(T1, T2, hh);
        c[1] = cand_val<1>(T1, T2, hh); w[1] = cand_val<17>(T1, T2, hh);
        c[2] = cand_val<2>(T1, T2, hh); w[2] = cand_val<18>(T1, T2, hh);
        c[3] = cand_val<3>(T1, T2, hh); w[3] = cand_val<19>(T1, T2, hh);
        c[4] = cand_val<4>(T1, T2, hh); w[4] = cand_val<20>(T1, T2, hh);
        c[5] = cand_val<5>(T1, T2, hh); w[5] = cand_val<21>(T1, T2, hh);
        c[6] = cand_val<6>(T1, T2, hh); w[6] = cand_val<22>(T1, T2, hh);
        c[7] = cand_val<7>(T1, T2, hh); w[7] = cand_val<23>(T1, T2, hh);
        c[8] = cand_val<8>(T1, T2, hh); w[8] = cand_val<24>(T1, T2, hh);
        c[9] = cand_val<9>(T1, T2, hh); w[9] = cand_val<25>(T1, T2, hh);
        c[10] = cand_val<10>(T1, T2, hh); w[10] = cand_val<26>(T1, T2, hh);
        c[11] = cand_val<11>(T1, T2, hh); w[11] = cand_val<27>(T1, T2, hh);
        c[12] = cand_val<12>(T1, T2, hh); w[12] = cand_val<28>(T1, T2, hh);
        c[13] = cand_val<13>(T1, T2, hh); w[13] = cand_val<29>(T1, T2, hh);
        c[14] = cand_val<14>(T1, T2, hh); w[14] = cand_val<30>(T1, T2, hh);
        c[15] = cand_val<15>(T1, T2, hh); w[15] = cand_val<31>(T1, T2, hh);
        bsort16(c); bsort16(w); bmerge16(c, w);
#pragma unroll
        for (int r = 0; r < 16; ++r) w[r] = __shfl_xor(c[r], 32);
        bmerge16(c, w);
        if (hh == 0) {
#pragma unroll
            for (int q4 = 0; q4 < 4; ++q4) { *(LAS f32x4*)(XW + 4 * q4) = (f32x4){T1[4 * q4], T1[4 * q4 + 1], T1[4 * q4 + 2], T1[4 * q4 + 3]};
                *(LAS f32x4*)(XW + 16 + 4 * q4) = (f32x4){T2[4 * q4], T2[4 * q4 + 1], T2[4 * q4 + 2], T2[4 * q4 + 3]}; } }
        asm volatile("s_waitcnt lgkmcnt(0)" ::: "memory");
        float ex[16], sum = 0.f; const float tmax = bfloat(fbits(c[0]) & 0xffffff00u);
#pragma unroll
        for (int r = 0; r < 16; ++r) { ex[r] = __expf(bfloat(fbits(c[r]) & 0xffffff00u) - tmax); sum += ex[r]; }
        const float isum = 1.0f / sum; const size_t ob = (size_t)t * NSLOT + (size_t)(8 * hh) * 8 + h;
#pragma unroll
        for (int r = 0; r < 8; ++r) { float ca = c[r], cb = c[8 + r], ea = ex[r], eb = ex[8 + r]; asm volatile("" : "+v"(ca), "+v"(cb), "+v"(ea), "+v"(eb)); const float cv = hh ? cb : ca, ev = hh ? eb : ea;
            const unsigned code = fbits(cv) & 0xffu;
            const unsigned i1 = fbits(XW[code >> 4]) & 127u, i2 = fbits(XW[16 + (code & 15)]) & 127u;
            EI[ob + 8 * r] = (unsigned short)(i1 * 128u + i2); GT[ob + 8 * r] = ev * isum; }
        asm volatile("s_waitcnt lgkmcnt(0)" ::: "memory");
    }
}
struct PeerIdx { v4u e0, e1; };
__device__ __forceinline__ PeerIdx peer_ld_idx(const unsigned short* EI, int t, int g) { PeerIdx r; r.e0 = *(const GAS v4u*)(EI + (size_t)t * NSLOT + 16 * g); r.e1 = *(const GAS v4u*)(EI + (size_t)t * NSLOT + 16 * g + 8); return r; }
template <int ROWB = 1024> __device__ __forceinline__ void peer_gather(const unsigned char* T8, const PeerIdx& ix, int colb, v4u (&raw)[16]) {
    const unsigned ew[8] = {ix.e0.x, ix.e0.y, ix.e0.z, ix.e0.w, ix.e1.x, ix.e1.y, ix.e1.z, ix.e1.w};
#pragma unroll
    for (int k = 0; k < 16; ++k) { const unsigned e = (k & 1) ? (ew[k >> 1] >> 16) : (ew[k >> 1] & 0xffffu); raw[k] = *(const GAS v4u*)(T8 + (size_t)e * ROWB + colb); }
}
__device__ __forceinline__ void cvt16_fp8_pk(const v4u w, f32x2 (&o)[8]) {
    const unsigned ww[4] = {w.x, w.y, w.z, w.w};
#pragma unroll
    for (int i = 0; i < 4; ++i) { o[2 * i] = __builtin_amdgcn_cvt_pk_f32_fp8((int)ww[i], false); o[2 * i + 1] = __builtin_amdgcn_cvt_pk_f32_fp8((int)ww[i], true); }
}
__device__ __forceinline__ void peer_u_reduce(const v4u (&raw)[16], const f32x2 (&hv)[8], float* PDrow, int lane, int g, int c) {
    float d[16];
#pragma unroll
    for (int k = 0; k < 16; ++k) { f32x2 uf[8]; cvt16_fp8_pk(raw[k], uf); f32x2 s = uf[0] * hv[0];
#pragma unroll
        for (int i = 1; i < 8; ++i) s += uf[i] * hv[i];
        d[k] = s.x + s.y; }
#pragma unroll
    for (int i = 0; i < 8; ++i) { const bool up = (lane & 4) != 0; const float keep = up ? d[i + 8] : d[i], send = up ? d[i] : d[i + 8]; d[i] = keep + __shfl_xor(send, 4); }
#pragma unroll
    for (int i = 0; i < 4; ++i) { const bool up = (lane & 2) != 0; const float keep = up ? d[i + 4] : d[i], send = up ? d[i] : d[i + 4]; d[i] = keep + __shfl_xor(send, 2); }
#pragma unroll
    for (int i = 0; i < 2; ++i) { const bool up = (lane & 1) != 0; const float keep = up ? d[i + 2] : d[i], send = up ? d[i] : d[i + 2]; d[i] = keep + __shfl_xor(send, 1); }
    *(GAS f32x2*)(PDrow + 16 * g + 2 * c) = (f32x2){d[0], d[1]};
}
__device__ __forceinline__ void ld16bf_pk(const bf16* p, f32x2 (&o)[8]) {
    const v4u w0 = *(const GAS v4u*)p, w1 = *(const GAS v4u*)(p + 8); const unsigned ww[8] = {w0.x, w0.y, w0.z, w0.w, w1.x, w1.y, w1.z, w1.w};
#pragma unroll
    for (int i = 0; i < 8; ++i) o[i] = (f32x2){bflo(ww[i]), bfhi(ww[i])};
}
__device__ __forceinline__ void peer_u_reduce_i4(const v4u (&raw)[16], const v4u hh, const v4u hl, int* PDrow, int lane, int g, int c) {
    int d[16];
#pragma unroll
    for (int k = 0; k < 16; ++k) { int sh = __builtin_amdgcn_sdot8((int)raw[k].x, (int)hh.x, 0, false), sl = __builtin_amdgcn_sdot8((int)raw[k].x, (int)hl.x, 0, false);
        sh = __builtin_amdgcn_sdot8((int)raw[k].y, (int)hh.y, sh, false); sl = __builtin_amdgcn_sdot8((int)raw[k].y, (int)hl.y, sl, false);
        sh = __builtin_amdgcn_sdot8((int)raw[k].z, (int)hh.z, sh, false); sl = __builtin_amdgcn_sdot8((int)raw[k].z, (int)hl.z, sl, false);
        sh = __builtin_amdgcn_sdot8((int)raw[k].w, (int)hh.w, sh, false); sl = __builtin_amdgcn_sdot8((int)raw[k].w, (int)hl.w, sl, false);
        d[k] = 16 * sh + sl; }
#pragma unroll
    for (int i = 0; i < 8; ++i) { const bool up = (lane & 4) != 0; const int keep = up ? d[i + 8] : d[i], send = up ? d[i] : d[i + 8]; d[i] = keep + __shfl_xor(send, 4); }
#pragma unroll
    for (int i = 0; i < 4; ++i) { const bool up = (lane & 2) != 0; const int keep = up ? d[i + 4] : d[i], send = up ? d[i] : d[i + 4]; d[i] = keep + __shfl_xor(send, 2); }
#pragma unroll
    for (int i = 0; i < 2; ++i) { const bool up = (lane & 1) != 0; const int keep = up ? d[i + 2] : d[i], send = up ? d[i] : d[i + 2]; d[i] = keep + __shfl_xor(send, 1); }
    *(GAS v2u*)(PDrow + 16 * g + 2 * c) = (v2u){(unsigned)d[0], (unsigned)d[1]};
}
__device__ __forceinline__ void phase_peer_u(const Args& A) {
    const int tid = threadIdx.x, lane = tid & 63, wave = tid >> 6, p = blockIdx.x & 7, q = p & 3, half = p >> 2, j = blockIdx.x >> 3, nj = gridDim.x >> 3, g = lane >> 3, c = lane & 7;
    const unsigned char* HH = (const unsigned char*)(A.ws + WS_H8); const unsigned char* HL = HH + 32 * MiB; const unsigned char* U4 = (const unsigned char*)(A.ws + WS_U8); const unsigned short* EI = (const unsigned short*)(A.ws + WS_EIDX);
    int* PD = (int*)(A.ws + WS_PD) + (size_t)q * M * NSLOT;
    const int tper = (M / 2) / nj, colb = 128 * q + 16 * c, tbeg = half * (M / 2) + j * tper, tend = tbeg + tper, tlast = tend - NWAVES + wave;
    int t = tbeg + wave;
    PeerIdx ix1 = peer_ld_idx(EI, min(t + NWAVES, tlast), g), ix2 = peer_ld_idx(EI, min(t + 2 * NWAVES, tlast), g);
    v4u rawa[16], rawb[16], hha, hla, hhb, hlb;
    { const PeerIdx ix0 = peer_ld_idx(EI, t, g); peer_gather<512>(U4, ix0, colb, rawa); hha = *(const GAS v4u*)(HH + (size_t)t * 512 + colb); hla = *(const GAS v4u*)(HL + (size_t)t * 512 + colb); }
    for (; t < tend; t += 2 * NWAVES) {
        const int t1 = t + NWAVES, t2 = min(t + 2 * NWAVES, tlast), t3 = min(t + 3 * NWAVES, tlast), t4 = min(t + 4 * NWAVES, tlast);
        const PeerIdx ix3 = peer_ld_idx(EI, t3, g);
        peer_gather<512>(U4, ix1, colb, rawb); hhb = *(const GAS v4u*)(HH + (size_t)t1 * 512 + colb); hlb = *(const GAS v4u*)(HL + (size_t)t1 * 512 + colb);
        peer_u_reduce_i4(rawa, hha, hla, PD + (size_t)t * NSLOT, lane, g, c);
        const PeerIdx ix4 = peer_ld_idx(EI, t4, g);
        peer_gather<512>(U4, ix2, colb, rawa); hha = *(const GAS v4u*)(HH + (size_t)t2 * 512 + colb); hla = *(const GAS v4u*)(HL + (size_t)t2 * 512 + colb);
        peer_u_reduce_i4(rawb, hhb, hlb, PD + (size_t)t1 * NSLOT, lane, g, c);
        ix1 = ix3; ix2 = ix4;
    }
}
__device__ __forceinline__ void phase_peer_act(const Args& A) {
    const int* PD = (const int*)(A.ws + WS_PD); const unsigned short* EI = (const unsigned short*)(A.ws + WS_EIDX); const float* GT = (const float*)(A.ws + WS_GATE);
    const float* usc = (const float*)(A.ws + WS_SC); const float* vsc = usc + NEXP; const float* hs = (const float*)(A.ws + WS_HS); float* ACT = (float*)(A.ws + WS_ACT);
    typedef int i32x4 __attribute__((ext_vector_type(4)));
    for (size_t i = ((size_t)blockIdx.x * NTHR + threadIdx.x) * 4; i < (size_t)M * NSLOT; i += (size_t)gridDim.x * NTHR * 4) {
        const i32x4 p0 = *(const GAS i32x4*)(PD + i), p1 = *(const GAS i32x4*)(PD + (size_t)M * NSLOT + i), p2 = *(const GAS i32x4*)(PD + (size_t)2 * M * NSLOT + i), p3 = *(const GAS i32x4*)(PD + (size_t)3 * M * NSLOT + i);
        const v2u ew = *(const GAS v2u*)(EI + i); const f32x4 gt = *(const GAS f32x4*)(GT + i); const float hsv = hs[i >> 7];
        const unsigned e[4] = {ew.x & 0xffffu, ew.x >> 16, ew.y & 0xffffu, ew.y >> 16};
        const i32x4 si = (p0 + p1) + (p2 + p3); f32x4 o;
#pragma unroll
        for (int k = 0; k < 4; ++k) { const float s = (float)si[k] * (usc[e[k]] * hsv); o[k] = 0.5f * s * (1.f + erff(s * 0.70710678118654752f)) * gt[k] * vsc[e[k]]; }
        *(GAS f32x4*)(ACT + i) = o;
    }
}
struct PeerAct { f32x4 a0, a1, a2, a3; };
__device__ __forceinline__ PeerAct peer_ld_act(const float* ACT, int t, int g) { const GAS f32x4* ap = (const GAS f32x4*)(ACT + (size_t)t * NSLOT + 16 * g); PeerAct r; r.a0 = ap[0]; r.a1 = ap[1]; r.a2 = ap[2]; r.a3 = ap[3]; return r; }
__device__ __forceinline__ void peer_v_accum(const v4u (&raw)[16], const PeerAct& pa, f32x2 (&y2)[16]) {
    const float av[16] = {pa.a0[0], pa.a0[1], pa.a0[2], pa.a0[3], pa.a1[0], pa.a1[1], pa.a1[2], pa.a1[3], pa.a2[0], pa.a2[1], pa.a2[2], pa.a2[3], pa.a3[0], pa.a3[1], pa.a3[2], pa.a3[3]};
#pragma unroll
    for (int k = 0; k < 16; ++k) { const unsigned ww[4] = {raw[k].x, raw[k].y, raw[k].z, raw[k].w}; const f32x2 a2 = (f32x2){av[k], av[k]};
#pragma unroll
        for (int w = 0; w < 4; ++w) { y2[4 * w + 0] += a2 * __builtin_amdgcn_cvt_scalef32_pk_f32_fp4(ww[w], 1.0f, 0); y2[4 * w + 1] += a2 * __builtin_amdgcn_cvt_scalef32_pk_f32_fp4(ww[w], 1.0f, 1);
            y2[4 * w + 2] += a2 * __builtin_amdgcn_cvt_scalef32_pk_f32_fp4(ww[w], 1.0f, 2); y2[4 * w + 3] += a2 * __builtin_amdgcn_cvt_scalef32_pk_f32_fp4(ww[w], 1.0f, 3); } }
}
__device__ __forceinline__ void peer_v_store(f32x2 (&y2)[16], bf16* Yp, float* ssy, int c) {
    float ss = 0.f; unsigned w[16];
#pragma unroll
    for (int i = 0; i < 16; ++i) { ss += y2[i].x * y2[i].x + y2[i].y * y2[i].y; w[i] = pk2(y2[i].x, y2[i].y); y2[i] = (f32x2){0.f, 0.f}; }
#pragma unroll
    for (int i = 0; i < 4; ++i) *(GAS v4u*)(Yp + 8 * i) = (v4u){w[4 * i], w[4 * i + 1], w[4 * i + 2], w[4 * i + 3]};
    ss += __shfl_xor(ss, 1); ss += __shfl_xor(ss, 2); ss += __shfl_xor(ss, 4);
    if (c == 0) *ssy = ss;
}
__device__ __forceinline__ void phase_peer_v(const Args& A) {
    const int tid = threadIdx.x, lane = tid & 63, wave = tid >> 6, p = blockIdx.x & 7, q = p & 3, half = p >> 2, j = blockIdx.x >> 3, nj = gridDim.x >> 3, g = lane >> 3, c = lane & 7;
    const unsigned char* V4 = (const unsigned char*)(A.ws + WS_V8); const unsigned short* EI = (const unsigned short*)(A.ws + WS_EIDX); const float* ACT = (const float*)(A.ws + WS_ACT);
    bf16* Y = (bf16*)(A.ws + WS_H); float* SSY = (float*)(A.ws + WS_SSY);
    const int tper = (M / 2) / nj, colb = 128 * q + 16 * c, tbeg = half * (M / 2) + j * tper + wave * (tper / NWAVES);
    const int nstep = (tper / NWAVES / 8) * 8;
    auto rowof = [&](int s) { s = min(s, nstep - 1); return (size_t)(tbeg + 8 * (s >> 3) + g) * 8 + (s & 7); };
    f32x2 y2[16];
#pragma unroll
    for (int i = 0; i < 16; ++i) y2[i] = (f32x2){0.f, 0.f};
    auto ldidx = [&](int s) { const size_t r = rowof(s); PeerIdx x; x.e0 = *(const GAS v4u*)(EI + r * 16); x.e1 = *(const GAS v4u*)(EI + r * 16 + 8); return x; };
    auto ldact = [&](int s) { const GAS f32x4* ap = (const GAS f32x4*)(ACT + rowof(s) * 16); PeerAct r; r.a0 = ap[0]; r.a1 = ap[1]; r.a2 = ap[2]; r.a3 = ap[3]; return r; };
    PeerIdx ix1 = ldidx(1), ix2 = ldidx(2);
    v4u rawa[16], rawb[16]; PeerAct aca, acb;
    { const PeerIdx ix0 = ldidx(0); peer_gather<512>(V4, ix0, colb, rawa); aca = ldact(0); }
    for (int s = 0; s < nstep; s += 2) {
        const PeerIdx ix3 = ldidx(s + 3);
        peer_gather<512>(V4, ix1, colb, rawb); acb = ldact(s + 1);
        peer_v_accum(rawa, aca, y2);
        const PeerIdx ix4 = ldidx(s + 4);
        peer_gather<512>(V4, ix2, colb, rawa); aca = ldact(s + 2);
        peer_v_accum(rawb, acb, y2);
        if ((s & 7) == 6) { const int t = tbeg + 8 * (s >> 3) + g; peer_v_store(y2, Y + (size_t)t * D + 256 * q + 32 * c, SSY + (size_t)t * 8 + q, c); }
        ix1 = ix3; ix2 = ix4;
    }
}
__device__ __forceinline__ void phase_peer_final(const Args& A) {
    const int tid = threadIdx.x, lane = tid & 63, wave = tid >> 6, G = gridDim.x;
    const bf16* Y = (const bf16*)(A.ws + WS_H); const bf16* X1 = (const bf16*)(A.ws + WS_X1); const float* SSY = (const float*)(A.ws + WS_SSY); const float* mod = (const float*)(A.ws + WS_MOD); const float* gpost = (const float*)A.in[I_GPOST2]; float* out = A.out;
    f32x4 gp[4];
#pragma unroll
    for (int q = 0; q < 4; ++q) gp[q] = *(const GAS f32x4*)(gpost + 4 * (lane + 64 * q));
    const int stride = G * NWAVES; int row = blockIdx.x * NWAVES + wave;
    v2u xw[4], yw[4], xwn[4], ywn[4]; f32x4 s0, s0n, g2p[4]; int bcur = -1;
#pragma unroll
    for (int q = 0; q < 4; ++q) { xw[q] = ((const GAS v2u*)(X1 + (size_t)row * D) + lane)[64 * q]; yw[q] = ((const GAS v2u*)(Y + (size_t)row * D) + lane)[64 * q]; }
    s0 = *(const GAS f32x4*)(SSY + (size_t)row * 8);
    for (; row < M; row += stride) {
        const int rn = min(row + stride, M - 1);
#pragma unroll
        for (int q = 0; q < 4; ++q) { xwn[q] = ((const GAS v2u*)(X1 + (size_t)rn * D) + lane)[64 * q]; ywn[q] = ((const GAS v2u*)(Y + (size_t)rn * D) + lane)[64 * q]; }
        s0n = *(const GAS f32x4*)(SSY + (size_t)rn * 8);
        const int b = row / SEQ;
        if (b != bcur) { bcur = b;
#pragma unroll
            for (int q = 0; q < 4; ++q) { const f32x4 g2 = *(const GAS f32x4*)(mod + b * 6144 + 5120 + 4 * (lane + 64 * q));
#pragma unroll
                for (int i = 0; i < 4; ++i) g2p[q][i] = g2[i] * gp[q][i]; } }
        const float rstd = 1.0f / sqrtf(((s0[0] + s0[1]) + (s0[2] + s0[3])) * (1.f / D) + EPS);
        GAS f32x4* orow = (GAS f32x4*)(out + (size_t)row * D) + lane;
#pragma unroll
        for (int q = 0; q < 4; ++q) { f32x4 xv = {bflo(xw[q].x), bfhi(xw[q].x), bflo(xw[q].y), bfhi(xw[q].y)};
            xv[0] += g2p[q][0] * (bflo(yw[q].x) * rstd); xv[1] += g2p[q][1] * (bfhi(yw[q].x) * rstd); xv[2] += g2p[q][2] * (bflo(yw[q].y) * rstd); xv[3] += g2p[q][3] * (bfhi(yw[q].y) * rstd);
            orow[64 * q] = xv; }
#pragma unroll
        for (int q = 0; q < 4; ++q) { xw[q] = xwn[q]; yw[q] = ywn[q]; }
        s0 = s0n;
    }
}
#ifdef PROBE_V_LOADS
__device__ __forceinline__ void probe_v_loads(const Args& A) {
    const int tid = threadIdx.x, lane = tid & 63, wave = tid >> 6, p = blockIdx.x & 7, j = blockIdx.x >> 3, nj = gridDim.x >> 3, g = lane >> 3, c = lane & 7;
    const unsigned char* V8 = (const unsigned char*)(A.ws + WS_V8); const unsigned short* EI = (const unsigned short*)(A.ws + WS_EIDX); const float* ACT = (const float*)(A.ws + WS_ACT);
    unsigned* DUMP = (unsigned*)(A.ws + WS_PD);
    const int tper = M / nj, colb = 128 * p + 16 * c, tend = (j + 1) * tper, tlast = tend - NWAVES + wave;
    int t = j * tper + wave;
    PeerIdx ix1 = peer_ld_idx(EI, min(t + NWAVES, tlast), g), ix2 = peer_ld_idx(EI, min(t + 2 * NWAVES, tlast), g);
    v4u rawa[16], rawb[16]; PeerAct aca, acb;
    { const PeerIdx ix0 = peer_ld_idx(EI, t, g); peer_gather(V8, ix0, colb, rawa); aca = peer_ld_act(ACT, t, g); }
    for (; t < tend; t += 2 * NWAVES) {
        const int t1 = t + NWAVES, t2 = min(t + 2 * NWAVES, tlast), t3 = min(t + 3 * NWAVES, tlast), t4 = min(t + 4 * NWAVES, tlast);
        const PeerIdx ix3 = peer_ld_idx(EI, t3, g);
        peer_gather(V8, ix1, colb, rawb); acb = peer_ld_act(ACT, t1, g);
        { unsigned s = __builtin_bit_cast(unsigned, aca.a0[0]) + __builtin_bit_cast(unsigned, aca.a3[3]);
#pragma unroll
          for (int k = 0; k < 16; ++k) s += (rawa[k].x + rawa[k].y) + (rawa[k].z + rawa[k].w);
          DUMP[(size_t)t * 512 + p * 64 + lane] = s; }
        const PeerIdx ix4 = peer_ld_idx(EI, t4, g);
        peer_gather(V8, ix2, colb, rawa); aca = peer_ld_act(ACT, t2, g);
        { unsigned s = __builtin_bit_cast(unsigned, acb.a0[0]) + __builtin_bit_cast(unsigned, acb.a3[3]);
#pragma unroll
          for (int k = 0; k < 16; ++k) s += (rawb[k].x + rawb[k].y) + (rawb[k].z + rawb[k].w);
          DUMP[(size_t)t1 * 512 + p * 64 + lane] = s; }
        ix1 = ix3; ix2 = ix4;
    }
}
#endif

#ifdef PROBE_INSTR
__device__ __forceinline__ void probe_instr(const Args& A) {
    f32x2 a[8]; float f[16]; unsigned w = threadIdx.x * 0x01010101u + 0x38383838u;
#pragma unroll
    for (int i = 0; i < 8; ++i) a[i] = (f32x2){1.0f + i, 2.0f + i};
#pragma unroll
    for (int i = 0; i < 16; ++i) f[i] = 1.0f + i;
    for (int it = 0; it < 10000; ++it) {
#if PROBE_INSTR == 1
#pragma unroll
        for (int i = 0; i < 8; ++i) { asm volatile("v_pk_fma_f32 %0, %1, %2, %0" : "+v"(a[i]) : "v"(a[(i + 1) & 7]), "v"(a[(i + 2) & 7])); asm volatile("v_pk_fma_f32 %0, %1, %2, %0" : "+v"(a[i]) : "v"(a[(i + 3) & 7]), "v"(a[(i + 4) & 7])); }
#elif PROBE_INSTR == 2
#pragma unroll
        for (int i = 0; i < 16; ++i) asm volatile("v_fma_f32 %0, %1, %2, %0" : "+v"(f[i]) : "v"(f[(i + 1) & 15]), "v"(f[(i + 2) & 15]));
#elif PROBE_INSTR == 3
#pragma unroll
        for (int i = 0; i < 8; ++i) { asm volatile("v_cvt_pk_f32_fp8 %0, %1" : "=v"(a[i]) : "v"(w)); asm volatile("v_cvt_pk_f32_fp8 %0, %1" : "=v"(a[i]) : "v"(w)); }
#elif PROBE_INSTR == 4
#pragma unroll
        for (int i = 0; i < 8; ++i) { asm volatile("v_cvt_scalef32_pk_f32_fp4 %0, %1, 1.0" : "=v"(a[i]) : "v"(w)); asm volatile("v_cvt_scalef32_pk_f32_fp4 %0, %1, 1.0" : "=v"(a[i]) : "v"(w)); }
#elif PROBE_INSTR == 5
#pragma unroll
        for (int i = 0; i < 16; ++i) asm volatile("v_pk_fma_f16 %0, %1, %2, %0" : "+v"(f[i]) : "v"(f[(i + 1) & 15]), "v"(f[(i + 2) & 15]));
#elif PROBE_INSTR == 7
#pragma unroll
        for (int i = 0; i < 16; ++i) asm volatile("v_dot8c_i32_i4 %0, %1, %2" : "+v"(f[i]) : "v"(f[(i + 1) & 15]), "v"(w));
#elif PROBE_INSTR == 8
#pragma unroll
        for (int i = 0; i < 16; ++i) asm volatile("v_dot4c_i32_i8 %0, %1, %2" : "+v"(f[i]) : "v"(f[(i + 1) & 15]), "v"(w));
#elif PROBE_INSTR == 9
#pragma unroll
        for (int i = 0; i < 16; ++i) asm volatile("v_perm_b32 %0, %1, %2, %3" : "=v"(f[i]) : "v"(f[(i + 1) & 15]), "v"(f[(i + 2) & 15]), "v"(w));
#elif PROBE_INSTR == 10
#pragma unroll
        for (int i = 0; i < 16; ++i) asm volatile("v_mfma_f32_16x16x32_fp8_fp8 %0, %1, %2, %0" : "+v"(*(f32x4*)&f[4 * (i & 3)]) : "v"(a[i & 7]), "v"(a[(i + 1) & 7]));
#elif PROBE_INSTR == 6
#pragma unroll
        for (int i = 0; i < 16; ++i) asm volatile("v_cvt_scalef32_pk_f16_fp4 %0, %1, 1.0" : "=v"(f[i]) : "v"(w));
#endif
    }
    float s = 0.f;
#pragma unroll
    for (int i = 0; i < 8; ++i) s += a[i].x + a[i].y;
#pragma unroll
    for (int i = 0; i < 16; ++i) s += f[i];
    if (s == 123.456f) ((float*)(A.ws + WS_PD))[threadIdx.x] = s;
}
#endif
#ifndef MK_N_LAUNCHES
#define MK_N_LAUNCHES 1
#endif
constexpr int N_PHASES = 13;
typedef const __attribute__((address_space(4))) Args* KArgP;
__device__ __forceinline__ const Args& kargs() { KArgP p = (KArgP)__builtin_amdgcn_kernarg_segment_ptr(); asm volatile("" : "+s"(p)); return *(const Args*)p; }
__global__ void __launch_bounds__(NTHR, 2) hymba_fwd(Args A_) {
    extern __shared__ __attribute__((aligned(16))) unsigned char lds_raw[];
    LAS unsigned char* lds = (LAS unsigned char*)lds_raw;
    const int lo = A_.ph_lo, hi = A_.ph_hi;
#define A kargs()
#define ws (kargs().ws)
#ifndef DBLMASK
#define DBLMASK 0
#endif
#define IN(k) (lo <= (k) && (k) < hi)
#define REP(k) for (int _rep = 0; _rep < (((DBLMASK) >> (k)) & 1) + 1; ++_rep)
    for (int u = threadIdx.x; u < (LDS_BYTES - RING_BYTES) / 4; u += NTHR) ((LAS unsigned*)(lds + RING_BYTES))[u] = 0u;
    __syncthreads();
    XcdBarrier xbar = xcd_barrier_post((unsigned*)(ws + WS_CTL) + CW_BAR, (volatile LAS unsigned*)(lds + MISC_OFF + 32));
#define SEAM(k) do { if (IN(k) && IN((k) + 1)) { if ((k) == 0) cg::this_grid().sync(); else xcd_barrier(xbar); } } while (0)

    if (IN(0)) REP(0) { phase_mod(A, lds); } SEAM(0);
    if (IN(1)) REP(1) { phase_convert(A, lds); phase_prenorm(A, lds); } SEAM(1);
    if (IN(2)) REP(2) {
        pg8::Gemm g{(const pg8::bf16_t*)(ws + WS_H), (const pg8::bf16_t*)(ws + WS_WIN), M, NPROJ, D}; pg8::StaticOrder S; S.init(M, NPROJ, gridDim.x, (int)blockIdx.x);
        pg8::EpiProj E{(pg8::bf16_t*)(ws + WS_PROJ), NPROJ, (float*)(ws + WS_GATES), (const int*)A.in[I_POS], (const float*)A.in[I_BI], (const float*)A.in[I_BF]};
        pg8::gemm_phase<pg8::EpiProj, pg8::StaticOrder, true, true>(lds, g, S, E);
    } SEAM(2);
    if (IN(3)) REP(3) {
        phase_attn(A, lds);
        for (int wg = blockIdx.x; wg < 256; wg += gridDim.x) mlstm_group<false>(A, lds, wg);
    } SEAM(3);
    if (IN(4)) REP(4) { for (int wg = blockIdx.x; wg < 256; wg += gridDim.x) mlstm_group<true>(A, lds, wg); } SEAM(4);
    if (IN(5)) REP(5) {
        pg8::Gemm g{(const pg8::bf16_t*)(ws + WS_MIXIN), (const pg8::bf16_t*)(ws + WS_WOUT), M, D, D}; pg8::StaticOrder S; S.init(M, D, gridDim.x, (int)blockIdx.x);
        pg8::EpiMix E{(pg8::bf16_t*)(ws + WS_MIX), D, (float*)(ws + WS_SSQ)};
        pg8::gemm_phase<pg8::EpiMix, pg8::StaticOrder, true, true>(lds, g, S, E);
    } SEAM(5);
    if (IN(6)) REP(6) { phase_mid(A); } SEAM(6);
    if (IN(7)) REP(7) {
        pg8::Gemm g{(const pg8::bf16_t*)(ws + WS_H), (const pg8::bf16_t*)(ws + WS_WQ), M, 2048, D}; pg8::StaticOrder S; S.init(M, 2048, gridDim.x, (int)blockIdx.x);
        pg8::EpiPlain E{(pg8::bf16_t*)(ws + WS_PROJ), 2048};
        pg8::gemm_phase<pg8::EpiPlain, pg8::StaticOrder, true, true>(lds, g, S, E);
    } SEAM(7);
    if (IN(8)) REP(8) { phase_topk(A, lds); } SEAM(8);
    if (IN(9)) REP(9) { phase_peer_u(A); } SEAM(9);
    if (IN(10)) REP(10) { phase_peer_act(A); } SEAM(10);
#ifdef PROBE_INSTR
    if (IN(11)) { probe_instr(A); }
#endif
#ifdef PROBE_V_LOADS
    if (IN(11)) { probe_v_loads(A); }
#endif
    if (IN(11)) REP(11) { phase_peer_v(A); } SEAM(11);
    if (IN(12)) REP(12) { phase_peer_final(A); }
#undef IN
#undef SEAM
#undef A
#undef ws
}

extern "C" void kernel_launch(void* const* d_in, const int* in_sizes, int n_in, void* d_out, int out_size, void* d_ws, size_t ws_size, hipStream_t stream) {
    static int grid = 0;
    if (grid == 0) {
        if (n_in != 21 || in_sizes[0] != M * D || out_size != M * D || ws_size < WS_END) { fprintf(stderr, "kernel_launch: unexpected shapes (n_in %d, in0 %d, out %d, ws %zu < %zu)\n", n_in, n_in > 0 ? in_sizes[0] : -1, out_size, ws_size, (size_t)WS_END); grid = -1; return; }
        int dev = 0, cus = 0, per_cu = 0;
        if (hipGetDevice(&dev) != hipSuccess || hipDeviceGetAttribute(&cus, hipDeviceAttributeMultiprocessorCount, dev) != hipSuccess) { grid = -1; return; }
        if (hipFuncSetAttribute((const void*)hymba_fwd, hipFuncAttributeMaxDynamicSharedMemorySize, LDS_BYTES) != hipSuccess) { fprintf(stderr, "kernel_launch: hipFuncSetAttribute failed\n"); grid = -1; return; }
        if (hipOccupancyMaxActiveBlocksPerMultiprocessor(&per_cu, (const void*)hymba_fwd, NTHR, LDS_BYTES) != hipSuccess || per_cu < 1) { fprintf(stderr, "kernel_launch: occupancy query says %d blocks per CU\n", per_cu); per_cu = 1; }
        (void)hipGetLastError();
        grid = cus;
        if (grid != 256) fprintf(stderr, "kernel_launch: note: %d CUs (built for 256)\n", grid);
    }
    if (grid < 0) return;
    (void)hipMemsetAsync((char*)d_ws + WS_CTL, 0, CTL_ZERO_BYTES, stream);
    Args a{};
    for (int i = 0; i < 21; ++i) a.in[i] = d_in[i];
    a.out = (float*)d_out; a.ws = (unsigned char*)d_ws;
    if (MK_N_LAUNCHES == 1) {
        a.ph_lo = 0; a.ph_hi = N_PHASES;
        void* args[] = {&a};
        const hipError_t e = hipLaunchCooperativeKernel((const void*)hymba_fwd, dim3(grid), dim3(NTHR), args, LDS_BYTES, stream);
        if (e != hipSuccess) fprintf(stderr, "kernel_launch: cooperative launch failed: %s (grid %d)\n", hipGetErrorString(e), grid);
    } else {
        for (int p = 0; p < N_PHASES; ++p) { a.ph_lo = p; a.ph_hi = p + 1; hipLaunchKernelGGL(hymba_fwd, dim3(grid), dim3(NTHR), LDS_BYTES, stream, a); }
    }
}
```

```cpp
#include <hip/hip_runtime.h>
#include <hip/hip_cooperative_groups.h>
#include <cstdio>
#include <cstdint>
namespace cg = cooperative_groups;
namespace pg8 {
#define PG8_LAS __attribute__((address_space(3)))
typedef unsigned short bf16_t;
typedef short bf16x8 __attribute__((ext_vector_type(8)));
typedef float f32x4 __attribute__((ext_vector_type(4)));
typedef unsigned u32x4 __attribute__((ext_vector_type(4)));
constexpr int BM = 256, BK = 64, HALF = 128, HTB = HALF * BK * 2  , STAGE_BYTES = 8 * HTB, NXCD = 8, WGM = 8;

__host__ __device__ __forceinline__ int lds_byte(int r, int c) { const int st = (r >> 4) * 2 + (c >> 5), rr = r & 15, cc = c & 31, ob = rr * 64 + cc * 2; return st * 1024 + (ob ^ (((ob >> 9) & 1) << 5)); }
__host__ __device__ __forceinline__ void stage_rc(int b, int& R, int& C) { const int st = b / 1024, sb = b % 1024, swz = sb ^ (((sb >> 9) & 1) << 5); R = (st >> 1) * 16 + swz / 64; C = (st & 1) * 32 + (swz % 64) / 2; }
__host__ __device__ __forceinline__ int perm32(int rho) { const int n = rho >> 4, i = rho & 15; return 8 * (i >> 2) + 4 * n + (i & 3); }

struct Unit { int pm, pn; };
struct Gemm { const bf16_t* A; const bf16_t* Bt; int M, N, K; };

struct StaticOrder {
    int nM, nN, nwg, G, c;
    __host__ __device__ void init(int M, int N, int G_, int c_) { nM = M / BM; nN = N / BM; nwg = nM * nN; G = G_; c = c_; }
    __host__ __device__ bool next(int i, Unit& u) const {
        const long L = (long)i * G + c; if (L >= nwg) return false;
        int wgid = (int)L; { const int q = nwg / NXCD, r = nwg % NXCD, xcd = wgid % NXCD, off = wgid / NXCD; wgid = (xcd < r ? xcd * (q + 1) : r * (q + 1) + (xcd - r) * q) + off; }
        const int nig = WGM * nN, gid = wgid / nig, fm = gid * WGM, gsz = (nM - fm) < WGM ? (nM - fm) : WGM;
        u.pm = fm + ((wgid % nig) % gsz); u.pn = (wgid % nig) / gsz; return true;
    }
    __device__ __forceinline__ void a_ready(const Unit&) const {}
    __device__ __forceinline__ void done(const Unit&) const {}
};

__device__ __forceinline__ unsigned cvt_pk_bf16(float lo, float hi) { unsigned r; asm volatile("v_cvt_pk_bf16_f32 %0, %1, %2" : "=v"(r) : "v"(lo), "v"(hi)); return r; }
typedef float f32x2 __attribute__((ext_vector_type(2)));
__device__ __forceinline__ f32x2 gelu_pk(f32x2 v) {
    const f32x2 av = __builtin_elementwise_abs(v), d = av * 0.2316418882f + 1.0f;
    f32x2 t; t.x = __builtin_amdgcn_rcpf(d.x); t.y = __builtin_amdgcn_rcpf(d.y);
    f32x2 q = t * 0.5307027145f + (-0.7265760135f); q = q * t + 0.7107068705f; q = q * t + (-0.142248368f); q = q * t + 0.127414796f; q = q * t;
    const f32x2 s = (v * v) * (-0.72134752044f);
    f32x2 e; e.x = __builtin_amdgcn_exp2f(s.x); e.y = __builtin_amdgcn_exp2f(s.y);
    const f32x2 m = v * (q * e), r = v - m;
    f32x2 o; o.x = v.x < 0.f ? m.x : r.x; o.y = v.y < 0.f ? m.y : r.y; return o;
}

__device__ __forceinline__ u32x4 pack8(const f32x4 v0, const f32x4 v1) { u32x4 w; w.x = cvt_pk_bf16(v0[0], v0[1]); w.y = cvt_pk_bf16(v0[2], v0[3]); w.z = cvt_pk_bf16(v1[0], v1[1]); w.w = cvt_pk_bf16(v1[2], v1[3]); return w; }

struct EpiPlain {
    static constexpr bool PERM = true, AFTER_DRAIN = false;
    bf16_t* O; int ldc;
    __device__ __forceinline__ void operator()(const f32x4 (&acc)[2][2][4][2], const Unit& u, int wr, int wc, int fr, int fq) const {
        const int row0 = u.pm * BM + wr * 64 + fr, col0 = u.pn * BM + wc * 32 + 8 * fq;
#pragma unroll
        for (int ai = 0; ai < 2; ++ai)
#pragma unroll
            for (int m = 0; m < 4; ++m) { bf16_t* rowp = O + (size_t)(row0 + ai * HALF + m * 16) * ldc + col0;
#pragma unroll
                for (int bj = 0; bj < 2; ++bj) *(u32x4*)(rowp + bj * HALF) = pack8(acc[ai][bj][m][0], acc[ai][bj][m][1]); }
    }
};

struct EpiProj {
    static constexpr bool PERM = true, AFTER_DRAIN = false;
    bf16_t* P; int ldc; float* gates; const int* pos; const float* b_i; const float* b_f;
    __device__ __forceinline__ void operator()(const f32x4 (&acc)[2][2][4][2], const Unit& u, int wr, int wc, int fr, int fq) const {
        const int row0 = u.pm * BM + wr * 64 + fr, col0 = u.pn * BM + wc * 32 + 8 * fq, pn = u.pn;
        if (pn == 9) {
            if (wc == 0 && fq == 0) {
                const f32x4 bi = {b_i[0], b_i[1], b_i[2], b_i[3]}, bf = {b_f[0], b_f[1], b_f[2], b_f[3]};
#pragma unroll
                for (int ai = 0; ai < 2; ++ai)
#pragma unroll
                    for (int m = 0; m < 4; ++m) { const int row = row0 + ai * HALF + m * 16;
                        const f32x4 iv = acc[ai][0][m][0] + bi, fv = acc[ai][0][m][1] + bf; f32x4 lf;
#pragma unroll
                        for (int j = 0; j < 4; ++j) lf[j] = fminf(fv[j], 0.f) - log1pf(__expf(-fabsf(fv[j])));
                        *(f32x4*)(gates + (size_t)row * 8) = iv; *(f32x4*)(gates + (size_t)row * 8 + 4) = lf; }
            }
            return;
        }
#pragma unroll
        for (int ai = 0; ai < 2; ++ai)
#pragma unroll
            for (int m = 0; m < 4; ++m) { const int row = row0 + ai * HALF + m * 16; bf16_t* rowp = P + (size_t)row * ldc + col0;
                const float posf = (pn <= 2) ? (float)pos[row] : 0.f;
#pragma unroll
                for (int bj = 0; bj < 2; ++bj) { f32x4 v0 = acc[ai][bj][m][0], v1 = acc[ai][bj][m][1];
                    const bool rope = (pn < 2) || (pn == 2 && bj == 0);
                    if (rope) {
                        const int p0 = ((col0 + bj * HALF) & 63) >> 1; const float sc = (pn < 2) ? 0.125f : 1.0f;
                        float x[8] = {v0[0], v0[1], v0[2], v0[3], v1[0], v1[1], v1[2], v1[3]};
#pragma unroll
                        for (int q = 0; q < 4; ++q) { const float invf = __builtin_amdgcn_exp2f(-(float)(p0 + q) * 0.41524101186092029f);
                            float r = posf * invf * 0.15915494309189535f; r = r - floorf(r);
                            const float c = __builtin_amdgcn_cosf(r) * sc, s = __builtin_amdgcn_sinf(r) * sc;
                            const float x1 = x[2 * q], x2 = x[2 * q + 1]; x[2 * q] = x1 * c - x2 * s; x[2 * q + 1] = x2 * c + x1 * s; }
                        v0 = (f32x4){x[0], x[1], x[2], x[3]}; v1 = (f32x4){x[4], x[5], x[6], x[7]};
                    } else if (pn >= 7) {
#pragma unroll
                        for (int j = 0; j < 4; ++j) { v0[j] = __builtin_amdgcn_rcpf(1.f + __expf(-v0[j])); v1[j] = __builtin_amdgcn_rcpf(1.f + __expf(-v1[j])); }
                    }
                    *(u32x4*)(rowp + bj * HALF) = pack8(v0, v1); } }
    }
};

struct EpiMix {
    static constexpr bool PERM = true, AFTER_DRAIN = false;
    bf16_t* O; int ldc; float* sumsq;
    __device__ __forceinline__ void operator()(const f32x4 (&acc)[2][2][4][2], const Unit& u, int wr, int wc, int fr, int fq) const {
        const int row0 = u.pm * BM + wr * 64 + fr, col0 = u.pn * BM + wc * 32 + 8 * fq;
#pragma unroll
        for (int ai = 0; ai < 2; ++ai)
#pragma unroll
            for (int m = 0; m < 4; ++m) { const int row = row0 + ai * HALF + m * 16; bf16_t* rowp = O + (size_t)row * ldc + col0; float s = 0.f;
#pragma unroll
                for (int bj = 0; bj < 2; ++bj) { const f32x4 v0 = acc[ai][bj][m][0], v1 = acc[ai][bj][m][1];
                    s += (v0[0] * v0[0] + v0[1] * v0[1]) + (v0[2] * v0[2] + v0[3] * v0[3]) + (v1[0] * v1[0] + v1[1] * v1[1]) + (v1[2] * v1[2] + v1[3] * v1[3]);
                    *(u32x4*)(rowp + bj * HALF) = pack8(v0, v1); }
                s += __shfl_xor(s, 16); s += __shfl_xor(s, 32);
                if (fq == 0) sumsq[(size_t)row * 16 + u.pn * 4 + wc] = s; }
    }
};
template <class Epi, class Sched, bool ALIGN_EPI = false, bool SP2 = false>
__device__ __forceinline__ void gemm_phase(PG8_LAS unsigned char* lds, const Gemm g, const Sched& S, const Epi& E) {
    const int tid = threadIdx.x, wid = __builtin_amdgcn_readfirstlane(tid >> 6), lane = tid & 63, wr = wid >> 2, wc = wid & 3, fr = lane & 15, fq = lane >> 4;
    const int K = g.K, nt = K / BK;
    unsigned voffA[2], voffB[2];
#pragma unroll
    for (int i = 0; i < 2; ++i) { int R, C; stage_rc(tid * 16 + i * 8192, R, C); const int Rb = Epi::PERM ? ((R & ~31) + perm32(R & 31)) : R;
        voffA[i] = (unsigned)(R * K + C) * 2u; voffB[i] = (unsigned)(Rb * K + C) * 2u; }
    const size_t kstep = (size_t)(BK * 2);
    const size_t hstep = (size_t)HALF * K * 2;
    const size_t tstep = 2 * hstep;
    const unsigned ldsw = (unsigned)wid * 1024u;
    const int aoff = lds_byte(wr * 64 + fr, fq * 8), boff = lds_byte(wc * 32 + fr, fq * 8);
#define PG8_SA(b, h) (((b) * 2 + (h)) * HTB)
#define PG8_SB(b, h) ((4 + (b) * 2 + (h)) * HTB)
#define PG8_STAGE(bufoff, gbase, voff) do { _Pragma("unroll") for (int _i = 0; _i < 2; ++_i) \
        __builtin_amdgcn_global_load_lds((const unsigned*)((const char*)(gbase) + (voff)[_i]), (PG8_LAS unsigned*)(lds + (bufoff) + ldsw + _i * 8192), 16, 0, 0); } while (0)
#define PG8_LDA(dst, b, h) do { _Pragma("unroll") for (int m = 0; m < 4; ++m) _Pragma("unroll") for (int k = 0; k < 2; ++k) dst[m][k] = *(const PG8_LAS bf16x8*)(lds + PG8_SA(b, h) + aoff + m * 2048 + k * 1024); } while (0)
#define PG8_LDB(dst, b, h) do { _Pragma("unroll") for (int n = 0; n < 2; ++n) _Pragma("unroll") for (int k = 0; k < 2; ++k) dst[n][k] = *(const PG8_LAS bf16x8*)(lds + PG8_SB(b, h) + boff + n * 2048 + k * 1024); } while (0)
#define PG8_MMA(ai, bj, At, Bt) do { __builtin_amdgcn_s_setprio(1); _Pragma("unroll") for (int m = 0; m < 4; ++m) _Pragma("unroll") for (int n = 0; n < 2; ++n) _Pragma("unroll") for (int k = 0; k < 2; ++k) \
        acc[ai][bj][m][n] = __builtin_amdgcn_mfma_f32_16x16x32_bf16(Bt[n][k], At[m][k], acc[ai][bj][m][n], 0, 0, 0); __builtin_amdgcn_s_setprio(0); } while (0)
#define PG8_WAIT_V(n) asm volatile("s_waitcnt vmcnt(" #n ")" ::: "memory")
#define PG8_WAIT_L(n) asm volatile("s_waitcnt lgkmcnt(" #n ")" ::: "memory")
#define PG8_BAR __builtin_amdgcn_s_barrier()
#define PG8_SCHED __builtin_amdgcn_sched_barrier(0)
    Unit cur, nxt; int ui = 0;
    if (!S.next(0, cur)) return;
    f32x4 acc[2][2][4][2];
#pragma unroll
    for (int a = 0; a < 2; ++a)
#pragma unroll
        for (int b = 0; b < 2; ++b)
#pragma unroll
            for (int m = 0; m < 4; ++m)
#pragma unroll
                for (int n = 0; n < 2; ++n) acc[a][b][m][n] = (f32x4){0.f, 0.f, 0.f, 0.f};
    bf16x8 At[4][2], B0[2][2], B1[2][2];
    const char* cA = (const char*)g.A + (size_t)cur.pm * tstep; const char* cB = (const char*)g.Bt + (size_t)cur.pn * tstep;
    S.a_ready(cur);
    if constexpr (SP2) {
        PG8_STAGE(PG8_SB(0, 0), cB, voffB); PG8_STAGE(PG8_SB(0, 1), cB + hstep, voffB); PG8_STAGE(PG8_SA(0, 0), cA, voffA); PG8_STAGE(PG8_SA(0, 1), cA + hstep, voffA);
        if (wr == 1) PG8_BAR;
        PG8_WAIT_V(2); PG8_BAR;
        PG8_STAGE(PG8_SB(1, 0), cB + kstep, voffB); PG8_STAGE(PG8_SA(1, 0), cA + kstep, voffA); PG8_STAGE(PG8_SB(1, 1), cB + hstep + kstep, voffB);
        PG8_WAIT_V(6); PG8_BAR;
    } else {
        PG8_STAGE(PG8_SB(0, 0), cB, voffB); PG8_STAGE(PG8_SA(0, 0), cA, voffA); PG8_STAGE(PG8_SB(0, 1), cB + hstep, voffB); PG8_STAGE(PG8_SA(0, 1), cA + hstep, voffA);
        if (wr == 1) PG8_BAR;
        PG8_WAIT_V(4); PG8_BAR;
        PG8_STAGE(PG8_SB(1, 0), cB + kstep, voffB); PG8_STAGE(PG8_SA(1, 0), cA + kstep, voffA); PG8_STAGE(PG8_SB(1, 1), cB + hstep + kstep, voffB);
        PG8_WAIT_V(6); PG8_BAR;
    }
    for (;;) {
        const bool has_next = S.next(ui + 1, nxt);
        const char* nA = has_next ? (const char*)g.A + (size_t)nxt.pm * tstep : cA; const char* nB = has_next ? (const char*)g.Bt + (size_t)nxt.pn * tstep : cB;
        for (int t = 0; t < nt; t += 2) {
            const bool last = (t == nt - 2);
            const char* a1 = cA + (size_t)(t + 1) * kstep;
            const char* a2 = last ? nA : cA + (size_t)(t + 2) * kstep; const char* b2 = last ? nB : cB + (size_t)(t + 2) * kstep;
            const char* a3 = a2 + kstep; const char* b3 = b2 + kstep;
            if (last && has_next) S.a_ready(nxt);
            if constexpr (SP2) {
            PG8_LDB(B0, 0, 0); PG8_LDB(B1, 0, 1); PG8_SCHED; PG8_LDA(At, 0, 0); PG8_STAGE(PG8_SA(1, 1), a1 + hstep, voffA);
            PG8_WAIT_V(8); PG8_WAIT_L(0); PG8_BAR; PG8_MMA(0, 0, At, B0); PG8_MMA(0, 1, At, B1); PG8_BAR; PG8_SCHED;
            PG8_LDA(At, 0, 1); PG8_STAGE(PG8_SB(0, 0), b2, voffB); PG8_STAGE(PG8_SB(0, 1), b2 + hstep, voffB); PG8_STAGE(PG8_SA(0, 0), a2, voffA);
            PG8_WAIT_V(8); PG8_WAIT_L(0); PG8_BAR; PG8_MMA(1, 0, At, B0); PG8_MMA(1, 1, At, B1); PG8_BAR; PG8_SCHED;
            PG8_LDB(B0, 1, 0); PG8_LDB(B1, 1, 1); PG8_SCHED; PG8_LDA(At, 1, 0); PG8_STAGE(PG8_SA(0, 1), a2 + hstep, voffA);
            PG8_WAIT_V(8); PG8_WAIT_L(0); PG8_BAR; PG8_MMA(0, 0, At, B0); PG8_MMA(0, 1, At, B1); PG8_BAR; PG8_SCHED;
            PG8_LDA(At, 1, 1); PG8_STAGE(PG8_SB(1, 0), b3, voffB); PG8_STAGE(PG8_SB(1, 1), b3 + hstep, voffB); PG8_STAGE(PG8_SA(1, 0), a3, voffA);
            PG8_WAIT_V(8); PG8_WAIT_L(0); PG8_BAR; PG8_MMA(1, 0, At, B0); PG8_MMA(1, 1, At, B1); PG8_BAR; PG8_SCHED;
            } else {
            PG8_LDB(B0, 0, 0); PG8_SCHED; PG8_LDA(At, 0, 0); PG8_STAGE(PG8_SA(1, 1), a1 + hstep, voffA);
            PG8_WAIT_L(8); PG8_BAR; PG8_WAIT_L(0); PG8_MMA(0, 0, At, B0); PG8_BAR; PG8_SCHED;
            PG8_LDB(B1, 0, 1); PG8_STAGE(PG8_SB(0, 0), b2, voffB);
            PG8_BAR; PG8_WAIT_L(0); PG8_MMA(0, 1, At, B1); PG8_BAR;
            PG8_LDA(At, 0, 1); PG8_STAGE(PG8_SA(0, 0), a2, voffA);
            PG8_BAR; PG8_WAIT_L(0); PG8_MMA(1, 0, At, B0); PG8_BAR; PG8_SCHED;
            PG8_STAGE(PG8_SB(0, 1), b2 + hstep, voffB);
            PG8_WAIT_V(6); PG8_BAR; PG8_MMA(1, 1, At, B1); PG8_BAR;
            PG8_LDB(B0, 1, 0); PG8_SCHED; PG8_LDA(At, 1, 0); PG8_STAGE(PG8_SA(0, 1), a2 + hstep, voffA);
            PG8_WAIT_L(8); PG8_BAR; PG8_WAIT_L(0); PG8_MMA(0, 0, At, B0); PG8_BAR; PG8_SCHED;
            PG8_LDB(B1, 1, 1); PG8_STAGE(PG8_SB(1, 0), b3, voffB);
            PG8_BAR; PG8_WAIT_L(0); PG8_MMA(0, 1, At, B1); PG8_BAR;
            PG8_LDA(At, 1, 1); PG8_STAGE(PG8_SA(1, 0), a3, voffA);
            PG8_BAR; PG8_WAIT_L(0); PG8_MMA(1, 0, At, B0); PG8_BAR; PG8_SCHED;
            PG8_STAGE(PG8_SB(1, 1), b3 + hstep, voffB);
            PG8_WAIT_V(6); PG8_BAR; PG8_MMA(1, 1, At, B1); PG8_BAR;
            }
        }
        if constexpr (ALIGN_EPI) { if (wr == 0) PG8_BAR; }
        if constexpr (!Epi::AFTER_DRAIN) { E(acc, cur, wr, wc, fr, fq); S.done(cur); }
        if (!has_next) break;
#pragma unroll
        for (int a = 0; a < 2; ++a)
#pragma unroll
            for (int b = 0; b < 2; ++b)
#pragma unroll
                for (int m = 0; m < 4; ++m)
#pragma unroll
                    for (int n = 0; n < 2; ++n) acc[a][b][m][n] = (f32x4){0.f, 0.f, 0.f, 0.f};
        cur = nxt; cA = nA; cB = nB; ++ui;
        if constexpr (ALIGN_EPI) { if (wr == 1) PG8_BAR; }
    }
    PG8_WAIT_V(0);
    if constexpr (!ALIGN_EPI) { if (wr == 0) PG8_BAR; }
    PG8_BAR;
    if constexpr (Epi::AFTER_DRAIN) { E.fused(acc, cur, wr, wc, fr, fq, lds, wid, lane); S.done(cur); }
#undef PG8_SA
#undef PG8_SB
#undef PG8_STAGE
#undef PG8_LDA
#undef PG8_LDB
#undef PG8_MMA
#undef PG8_WAIT_V
#undef PG8_WAIT_L
#undef PG8_BAR
#undef PG8_SCHED
}
}
constexpr int NB = 8, SEQ = 8192, D = 1024, M = NB * SEQ;
constexpr int DIN = 2312, NPROJ = 2304, NIN_PAD = 2560;
constexpr int C_AQ = 0, C_AK = 512, C_AV = 640, C_MQ = 768, C_MK = 1024, C_MV = 1280, C_MO = 1792;
constexpr int NEXP = 16384, NSLOT = 128;
constexpr float EPS = 1e-6f;
constexpr int NWAVES = 8, NTHR = 512;

constexpr size_t MiB = 1u << 20;
constexpr size_t WS_CTL = 0, CTL_ZERO_BYTES = 1 * MiB;
constexpr size_t WS_MOD = 1 * MiB;
constexpr size_t WS_WIN = 2 * MiB;
constexpr size_t WS_WOUT = 8 * MiB;
constexpr size_t WS_WQ = 10 * MiB;
constexpr size_t WS_KEYS = 14 * MiB;
constexpr size_t WS_GATES = 16 * MiB;
constexpr size_t WS_SSQ = 832 * MiB;
constexpr size_t WS_MST = 20 * MiB;
constexpr size_t WS_U8 = 32 * MiB, WS_V8 = 48 * MiB;
constexpr size_t WS_SC = 64 * MiB;
constexpr size_t WS_H = 96 * MiB;
constexpr size_t WS_PROJ = 224 * MiB;
constexpr size_t WS_MIXIN = 512 * MiB;
constexpr size_t WS_MIX = 640 * MiB;
constexpr size_t WS_EIDX = 768 * MiB, WS_GATE = 800 * MiB;
constexpr size_t WS_PD = 224 * MiB;
constexpr size_t WS_X1 = 512 * MiB;
constexpr size_t WS_ACT = 840 * MiB;
constexpr size_t WS_SSY = 872 * MiB;
constexpr size_t WS_H8 = 880 * MiB;
constexpr size_t WS_HS = 944 * MiB;
constexpr size_t WS_END = 945 * MiB;
constexpr int CW_BAR = 4096;
constexpr int CW_SUMSQ = 65536;
static_assert((CW_SUMSQ + M) * 4 <= (int)CTL_ZERO_BYTES, "ctl");

constexpr int RING_BYTES = 131072, MISC_OFF = RING_BYTES + 320, LDS_BYTES = 147456;

#define GAS __attribute__((address_space(1)))
#define LAS __attribute__((address_space(3)))
typedef unsigned short bf16;
typedef unsigned v4u __attribute__((ext_vector_type(4)));
typedef unsigned v2u __attribute__((ext_vector_type(2)));
typedef float f32x4 __attribute__((ext_vector_type(4)));
typedef GAS unsigned gu32;
#define LDS_WAIT() asm volatile("s_waitcnt lgkmcnt(0)" ::: "memory")
#define VM_WAIT() asm volatile("s_waitcnt vmcnt(0)" ::: "memory")
__device__ __forceinline__ unsigned f2bf(float f) { unsigned u = __builtin_bit_cast(unsigned, f); return (u + 0x7fffu + ((u >> 16) & 1u)) >> 16; }
__device__ __forceinline__ unsigned pk2(float lo, float hi) { return f2bf(lo) | (f2bf(hi) << 16); }
__device__ __forceinline__ float bflo(unsigned w) { return __builtin_bit_cast(float, w << 16); }
__device__ __forceinline__ float bfhi(unsigned w) { return __builtin_bit_cast(float, w & 0xffff0000u); }
__device__ __forceinline__ float bf1(bf16 h) { return __builtin_bit_cast(float, (unsigned)h << 16); }
__device__ __forceinline__ float wave_sum(float v) {
#pragma unroll
    for (int o = 1; o < 64; o <<= 1) v += __shfl_xor(v, o);
    return v;
}
__device__ __forceinline__ float wave_max(float v) {
#pragma unroll
    for (int o = 1; o < 64; o <<= 1) v = fmaxf(v, __shfl_xor(v, o));
    return v;
}

typedef float f32x2 __attribute__((ext_vector_type(2)));
__device__ __forceinline__ void cvt16_fp8(const v4u w, float (&o)[16]) {
    const unsigned ww[4] = {w.x, w.y, w.z, w.w};
#pragma unroll
    for (int i = 0; i < 4; ++i) { const f32x2 a = __builtin_amdgcn_cvt_pk_f32_fp8((int)ww[i], false), b = __builtin_amdgcn_cvt_pk_f32_fp8((int)ww[i], true);
        o[4 * i] = a.x; o[4 * i + 1] = a.y; o[4 * i + 2] = b.x; o[4 * i + 3] = b.y; }
}
__device__ __forceinline__ void p0_row_fp8(const float* src, unsigned char* dst, float* sc, int row, int lane) {
    const GAS f32x4* sp = (const GAS f32x4*)(src + (size_t)row * D + 16 * lane);
    const f32x4 a = sp[0], b = sp[1], c = sp[2], d = sp[3];
    float mx = 0.f;
#pragma unroll
    for (int i = 0; i < 4; ++i) mx = fmaxf(fmaxf(fmaxf(mx, fabsf(a[i])), fmaxf(fabsf(b[i]), fabsf(c[i]))), fabsf(d[i]));
    mx = wave_max(mx); const float s = mx > 0.f ? 224.0f / mx : 1.0f;
    v4u o; int w;
    w = __builtin_amdgcn_cvt_pk_fp8_f32(a[0] * s, a[1] * s, 0, false); w = __builtin_amdgcn_cvt_pk_fp8_f32(a[2] * s, a[3] * s, w, true); o.x = (unsigned)w;
    w = __builtin_amdgcn_cvt_pk_fp8_f32(b[0] * s, b[1] * s, 0, false); w = __builtin_amdgcn_cvt_pk_fp8_f32(b[2] * s, b[3] * s, w, true); o.y = (unsigned)w;
    w = __builtin_amdgcn_cvt_pk_fp8_f32(c[0] * s, c[1] * s, 0, false); w = __builtin_amdgcn_cvt_pk_fp8_f32(c[2] * s, c[3] * s, w, true); o.z = (unsigned)w;
    w = __builtin_amdgcn_cvt_pk_fp8_f32(d[0] * s, d[1] * s, 0, false); w = __builtin_amdgcn_cvt_pk_fp8_f32(d[2] * s, d[3] * s, w, true); o.w = (unsigned)w;
    *(GAS v4u*)(dst + (size_t)row * D + 16 * lane) = o;
    if (lane == 0) sc[row] = mx > 0.f ? mx * (1.0f / 224.0f) : 1.0f;
}

__device__ __forceinline__ unsigned pack4_i8(float a, float b, float c, float d) { return ((unsigned)__float2int_rn(a) & 0xffu) | (((unsigned)__float2int_rn(b) & 0xffu) << 8) | (((unsigned)__float2int_rn(c) & 0xffu) << 16) | (((unsigned)__float2int_rn(d) & 0xffu) << 24); }
__device__ __forceinline__ void p0_row_i8(const float* src, unsigned char* dst, float* sc, int row, int lane) {
    const GAS f32x4* sp = (const GAS f32x4*)(src + (size_t)row * D + 16 * lane);
    const f32x4 a = sp[0], b = sp[1], c = sp[2], d = sp[3];
    float mx = 0.f;
#pragma unroll
    for (int i = 0; i < 4; ++i) mx = fmaxf(fmaxf(fmaxf(mx, fabsf(a[i])), fmaxf(fabsf(b[i]), fabsf(c[i]))), fabsf(d[i]));
    mx = wave_max(mx); const float s = mx > 0.f ? 127.0f / mx : 1.0f;
    v4u o; o.x = pack4_i8(a[0] * s, a[1] * s, a[2] * s, a[3] * s); o.y = pack4_i8(b[0] * s, b[1] * s, b[2] * s, b[3] * s); o.z = pack4_i8(c[0] * s, c[1] * s, c[2] * s, c[3] * s); o.w = pack4_i8(d[0] * s, d[1] * s, d[2] * s, d[3] * s);
    *(GAS v4u*)(dst + (size_t)row * D + 16 * lane) = o;
    if (lane == 0) sc[row] = mx > 0.f ? mx * (1.0f / 127.0f) : 1.0f;
}

__device__ __forceinline__ unsigned pack8_i4(const f32x4 a, const f32x4 b, float s) {
    unsigned w = 0;
#pragma unroll
    for (int i = 0; i < 4; ++i) { const int qa = max(-8, min(7, __float2int_rn(a[i] * s))), qb = max(-8, min(7, __float2int_rn(b[i] * s))); w |= ((unsigned)qa & 15u) << (4 * i); w |= ((unsigned)qb & 15u) << (16 + 4 * i); }
    return w;
}
__device__ __forceinline__ void p0_row_i4(const f32x4 a, const f32x4 b, const f32x4 c, const f32x4 d, unsigned char* dst, float* sc, int row, int lane) {
    float ss = 0.f;
#pragma unroll
    for (int i = 0; i < 4; ++i) ss += (a[i] * a[i] + b[i] * b[i]) + (c[i] * c[i] + d[i] * d[i]);
    ss = wave_sum(ss); const float sig = sqrtf(ss * (1.f / D)), s = sig > 0.f ? 3.0f / sig : 1.0f;
    v2u o; o.x = pack8_i4(a, b, s); o.y = pack8_i4(c, d, s);
    *(GAS v2u*)(dst + (size_t)row * (D / 2) + 8 * lane) = o;
    if (lane == 0) sc[row] = sig > 0.f ? sig * (1.0f / 3.0f) : 1.0f;
}

__device__ __forceinline__ unsigned pack8_fp4(const f32x4 a, const f32x4 b, float s) {
    unsigned w = 0;
    w = __builtin_amdgcn_cvt_scalef32_pk_fp4_f32(w, fminf(fmaxf(a[0] * s, -6.f), 6.f), fminf(fmaxf(a[1] * s, -6.f), 6.f), 1.0f, 0);
    w = __builtin_amdgcn_cvt_scalef32_pk_fp4_f32(w, fminf(fmaxf(a[2] * s, -6.f), 6.f), fminf(fmaxf(a[3] * s, -6.f), 6.f), 1.0f, 1);
    w = __builtin_amdgcn_cvt_scalef32_pk_fp4_f32(w, fminf(fmaxf(b[0] * s, -6.f), 6.f), fminf(fmaxf(b[1] * s, -6.f), 6.f), 1.0f, 2);
    w = __builtin_amdgcn_cvt_scalef32_pk_fp4_f32(w, fminf(fmaxf(b[2] * s, -6.f), 6.f), fminf(fmaxf(b[3] * s, -6.f), 6.f), 1.0f, 3);
    return w;
}
__device__ __forceinline__ void p0_row_fp4(const f32x4 a, const f32x4 b, const f32x4 c, const f32x4 d, unsigned char* dst, float* sc, int row, int lane) {
    float mx = 0.f;
#pragma unroll
    for (int i = 0; i < 4; ++i) mx = fmaxf(fmaxf(fmaxf(mx, fabsf(a[i])), fmaxf(fabsf(b[i]), fabsf(c[i]))), fabsf(d[i]));
    mx = wave_max(mx); const float s = mx > 0.f ? 7.0f / mx : 1.0f;
    v2u o; o.x = pack8_fp4(a, b, s); o.y = pack8_fp4(c, d, s);
    *(GAS v2u*)(dst + (size_t)row * (D / 2) + 8 * lane) = o;
    if (lane == 0) sc[row] = mx > 0.f ? mx * (1.0f / 7.0f) : 1.0f;
}
#define XB_TMO      128
#define XB_XCNT(j)  (256  + 64 * (j))
#define XB_XSUB(j)  (1280 + 64 * (j))
#define XB_XGEN(j)  (2304 + 64 * (j))
#define XB_TOP      3328
#define XB_TOPGEN   3392
#define XCD_BAR_WORDS 3456
#define XB_SPIN_CAP (1u << 18)

__device__ __forceinline__ unsigned xb_ld(unsigned* p)              { return __hip_atomic_load(p, __ATOMIC_RELAXED, __HIP_MEMORY_SCOPE_AGENT); }
__device__ __forceinline__ unsigned xb_add(unsigned* p, unsigned v) { return __hip_atomic_fetch_add(p, v, __ATOMIC_RELAXED, __HIP_MEMORY_SCOPE_AGENT); }
__device__ __forceinline__ unsigned xb_xcc_id() { return (unsigned)__builtin_amdgcn_s_getreg((3 << 11) | 20) & 0xFu; }
#define XB_SPIN(cond, bar) do { unsigned _sp = 0; while (cond) { __builtin_amdgcn_s_sleep(1); \
    if ((++_sp & 255u) == 0u) { if (xb_ld(&(bar)[XB_TMO])) break; if (_sp > XB_SPIN_CAP) { atomicAdd(&(bar)[XB_TMO], 1u); break; } } } } while (0)

struct XcdBarrier {
    unsigned* bar; unsigned x;
    volatile LAS unsigned* st;
};

__device__ __forceinline__ XcdBarrier xcd_barrier_post(unsigned* bar, volatile LAS unsigned* st) {
    XcdBarrier b; b.bar = bar; b.x = xb_xcc_id(); b.st = st;
    if (threadIdx.x == 0) (void)xb_add(&bar[XB_XCNT(b.x)], 1u);
    return b;
}
__device__ __forceinline__ void xcd_barrier_complete(unsigned* bar, unsigned x, unsigned& nloc, unsigned& nx) {
    const unsigned G = gridDim.x * gridDim.y * gridDim.z;
    unsigned sum, cnt, mine, sp = 0u;
    for (;;) {
        sum = 0u; cnt = 0u; mine = 0u;
#pragma unroll
        for (unsigned j = 0; j < 16; ++j) { const unsigned c = xb_ld(&bar[XB_XCNT(j)]); sum += c; cnt += (c > 0u) ? 1u : 0u; mine = (j == x) ? c : mine; }
        if (sum == G) break;
        __builtin_amdgcn_s_sleep(1);
        if ((++sp & 255u) == 0u) { if (xb_ld(&bar[XB_TMO])) break; if (sp > XB_SPIN_CAP) { atomicAdd(&bar[XB_TMO], 1u); break; } }
    }
    nloc = mine > 0u ? mine : 1u; nx = cnt > 0u ? cnt : 1u;
}

__device__ __forceinline__ void xcd_barrier(const XcdBarrier& b) {
    asm volatile("s_waitcnt vmcnt(0)" ::: "memory");
    __syncthreads();
    if (threadIdx.x == 0) {
        unsigned* bar = b.bar;
        __builtin_amdgcn_s_waitcnt(0);
        unsigned nloc = b.st[0], nx = b.st[1];
        if (nloc == 0u) { xcd_barrier_complete(bar, b.x, nloc, nx); b.st[0] = nloc; b.st[1] = nx; }
        const unsigned old = xb_add(&bar[XB_XSUB(b.x)], 1u);
        const unsigned gen = old / nloc;
        if (old + 1u == (gen + 1u) * nloc) {
            __builtin_amdgcn_fence(__ATOMIC_RELEASE, "agent");
            asm volatile("s_waitcnt vmcnt(0)" ::: "memory");
            const unsigned og = xb_add(&bar[XB_TOP], 1u);
            const unsigned tg = og / nx;
            if (og + 1u == (tg + 1u) * nx) xb_add(&bar[XB_TOPGEN], 1u);
            else XB_SPIN(xb_ld(&bar[XB_TOPGEN]) == tg, bar);
            __builtin_amdgcn_fence(__ATOMIC_ACQUIRE, "agent");
            xb_add(&bar[XB_XGEN(b.x)], 1u);
            asm volatile("s_waitcnt vmcnt(0)" ::: "memory");
        } else {
            XB_SPIN(xb_ld(&bar[XB_XGEN(b.x)]) == gen, bar);
            __builtin_amdgcn_fence(__ATOMIC_ACQUIRE, "agent");
            asm volatile("s_waitcnt vmcnt(0)" ::: "memory");
        }
    }
    __syncthreads();
}
struct Args { const void* in[21]; float* out; unsigned char* ws; int ph_lo, ph_hi; };
enum { I_X = 0, I_C, I_POS, I_WMOD, I_BMOD, I_GPRE1, I_GPOST1, I_WIN, I_CONVW, I_BI, I_BF, I_MNG, I_SINK, I_WOUT, I_GPRE2, I_GPOST2, I_WQ, I_K1, I_K2, I_U, I_V };

__device__ __forceinline__ int newcol(int o) {
    if (o < 640) { const int hd = o >> 6, d = o & 63; return (hd << 6) + 2 * (d & 31) + (d >> 5); }
    if (o < 1792) return o;
    if (o < 1800) return 2304 + (o - 1792);
    return o - 8;
}
template <bool REMAP>
__device__ __forceinline__ void p0_transpose_item(const float* W, int K, int N, bf16* WT, LAS float* scr, int item, int lane) {
    const int nblk = (N + 31) / 32, kb = item / nblk, nb = item % nblk, k0 = 64 * kb, n0 = 32 * nb;
    const int ncol = n0 + (lane & 31);
#pragma unroll 8
    for (int i = 0; i < 32; ++i) { const int kk = 2 * i + (lane >> 5); scr[kk * 33 + (lane & 31)] = (ncol < N) ? W[(size_t)(k0 + kk) * N + ncol] : 0.f; }
    LDS_WAIT(); asm volatile("" ::: "memory");
    const int c = lane & 7;
#pragma unroll
    for (int j = 0; j < 4; ++j) { const int n = (lane >> 3) + 8 * j; const LAS float* s = scr + (8 * c) * 33 + n;
        v4u o; o.x = pk2(s[0 * 33], s[1 * 33]); o.y = pk2(s[2 * 33], s[3 * 33]); o.z = pk2(s[4 * 33], s[5 * 33]); o.w = pk2(s[6 * 33], s[7 * 33]);
        if (n0 + n < N) { const int drow = REMAP ? newcol(n0 + n) : (n0 + n); *(GAS v4u*)(WT + (size_t)drow * K + k0 + 8 * c) = o; } }
    LDS_WAIT(); asm volatile("" ::: "memory");
}
__device__ __forceinline__ void p0_convert(const float* src, bf16* dst, size_t n, int gt, int ngt) {
    for (size_t i = (size_t)gt * 8; i < n; i += (size_t)ngt * 8) {
        const f32x4 a = *(const GAS f32x4*)(src + i), b = *(const GAS f32x4*)(src + i + 4);
        v4u o; o.x = pk2(a[0], a[1]); o.y = pk2(a[2], a[3]); o.z = pk2(b[0], b[1]); o.w = pk2(b[2], b[3]);
        *(GAS v4u*)(dst + i) = o; }
}
__device__ __forceinline__ void phase_mod(const Args& A, LAS unsigned char* lds) {
    const int tid = threadIdx.x, G = gridDim.x, blk = blockIdx.x;
    unsigned char* ws = A.ws;
    const float* c = (const float*)A.in[I_C]; const float* wm = (const float*)A.in[I_WMOD]; const float* bm = (const float*)A.in[I_BMOD];
    float* mod = (float*)(ws + WS_MOD); LAS float* cs = (LAS float*)lds; LAS float* red = cs + 8 * 1024;
    for (int e = tid; e < 8 * 1024 / 4; e += NTHR) *(LAS f32x4*)(cs + 4 * e) = *(const GAS f32x4*)(c + 4 * e);
    __syncthreads();
    for (int it = blk; it < 6144 / 24; it += G) {
        const int kg = tid >> 5, col = tid & 31, j = it * 24 + (col < 24 ? col : 23); float acc[8];
#pragma unroll
        for (int b = 0; b < 8; ++b) acc[b] = 0.f;
#pragma unroll 16
        for (int i = 0; i < 64; ++i) { const int k = kg + 16 * i; const float w = wm[(size_t)k * 6144 + j];
#pragma unroll
            for (int b = 0; b < 8; ++b) acc[b] += cs[b * 1024 + k] * w; }
#pragma unroll
        for (int b = 0; b < 8; ++b) red[(kg * 32 + col) * 8 + b] = acc[b];
        __syncthreads();
        if (tid < 256) { const int b = tid >> 5, cc = tid & 31; float s = 0.f;
#pragma unroll
            for (int g = 0; g < 16; ++g) s += red[(g * 32 + cc) * 8 + b];
            if (cc < 24) mod[b * 6144 + it * 24 + cc] = s + bm[it * 24 + cc]; }
        __syncthreads();
    }
}
__device__ __forceinline__ void phase_convert(const Args& A, LAS unsigned char* lds) {
    const int tid = threadIdx.x, lane = tid & 63, wave = tid >> 6, G = gridDim.x, blk = blockIdx.x;
    unsigned char* ws = A.ws;
    {
        LAS float* scr = (LAS float*)(lds + wave * 16384);
        const int gw = blk * NWAVES + wave, NGW = G * NWAVES;
        const int I_IN = (D / 64) * ((DIN + 31) / 32), I_OUT = (D / 64) * (D / 32), I_Q = (D / 64) * (2048 / 32);
        bf16* win = (bf16*)(ws + WS_WIN); bf16* wout = (bf16*)(ws + WS_WOUT); bf16* wq = (bf16*)(ws + WS_WQ);
        for (int it = gw; it < I_IN + I_OUT + I_Q; it += NGW) {
            int r = it;
            if (r < I_IN) { p0_transpose_item<true>((const float*)A.in[I_WIN], D, DIN, win, scr, r, lane); continue; } r -= I_IN;
            if (r < I_OUT) { p0_transpose_item<false>((const float*)A.in[I_WOUT], D, D, wout, scr, r, lane); continue; } r -= I_OUT;
            p0_transpose_item<false>((const float*)A.in[I_WQ], D, 2048, wq, scr, r, lane);
        }
        const int gt = blk * NTHR + tid, ngt = G * NTHR;
        for (int i = gt; i < (NIN_PAD - DIN) * D / 8; i += ngt) *(GAS v4u*)(win + (size_t)DIN * D + (size_t)i * 8) = (v4u){0u, 0u, 0u, 0u};
        p0_convert((const float*)A.in[I_K1], (bf16*)(ws + WS_KEYS), (size_t)8 * 128 * 128, gt, ngt);
        p0_convert((const float*)A.in[I_K2], (bf16*)(ws + WS_KEYS) + 8 * 128 * 128, (size_t)8 * 128 * 128, gt, ngt);
        {
            const float* usrc = (const float*)A.in[I_U]; const float* vsrc = (const float*)A.in[I_V];
            auto rowp = [&](int r) { return (const GAS f32x4*)((r < NEXP ? usrc + (size_t)r * D : vsrc + (size_t)(r - NEXP) * D) + 16 * lane); };
            int r = gw; const GAS f32x4* sp = rowp(min(r, 2 * NEXP - 1)); f32x4 a = sp[0], b = sp[1], c = sp[2], d = sp[3];
            for (; r < 2 * NEXP; r += NGW) { const GAS f32x4* sn = rowp(min(r + NGW, 2 * NEXP - 1)); const f32x4 an = sn[0], bn = sn[1], cn = sn[2], dn = sn[3];
                if (r < NEXP) p0_row_i4(a, b, c, d, ws + WS_U8, (float*)(ws + WS_SC), r, lane); else p0_row_fp4(a, b, c, d, ws + WS_V8, (float*)(ws + WS_SC) + NEXP, r - NEXP, lane);
                a = an; b = bn; c = cn; d = dn; }
        }
    }
}

__device__ __forceinline__ void phase_prenorm(const Args& A, LAS unsigned char* lds) {
    const int tid = threadIdx.x, lane = tid & 63, wave = tid >> 6, G = gridDim.x;
    const float* x = (const float*)A.in[I_X]; const float* g = (const float*)A.in[I_GPRE1]; const float* mod = (const float*)(A.ws + WS_MOD);
    bf16* H = (bf16*)(A.ws + WS_H); float* gates = (float*)(A.ws + WS_GATES);
    LAS float* wg = (LAS float*)lds;
    __syncthreads();
    for (int k = tid; k < D; k += NTHR) { const float* wr = (const float*)A.in[I_WIN] + (size_t)k * DIN + 1792; const f32x4 w0 = *(const GAS f32x4*)wr, w1 = *(const GAS f32x4*)(wr + 4);
#pragma unroll
        for (int j = 0; j < 4; ++j) { wg[j * D + k] = w0[j]; wg[(4 + j) * D + k] = w1[j]; } }
    __syncthreads();
    const int gi = ((lane >> 5) & 1) * 4 + ((lane >> 4) & 1) * 2 + ((lane >> 3) & 1);
    const float gbias = gi < 4 ? ((const float*)A.in[I_BI])[gi] : ((const float*)A.in[I_BF])[gi - 4];
    f32x4 gg[4];
#pragma unroll
    for (int j = 0; j < 4; ++j) gg[j] = *(const GAS f32x4*)(g + 4 * (lane + 64 * j));
    const int stride = G * NWAVES; int row = blockIdx.x * NWAVES + wave;
    f32x4 v[4], vn[4], shv[4], gsv[4]; int bcur = -1;
#pragma unroll
    for (int j = 0; j < 4; ++j) v[j] = ((const GAS f32x4*)(x + (size_t)row * D) + lane)[64 * j];
    for (; row < M; row += stride) {
        const int rn = min(row + stride, M - 1);
#pragma unroll
        for (int j = 0; j < 4; ++j) vn[j] = ((const GAS f32x4*)(x + (size_t)rn * D) + lane)[64 * j];
        const int b = row / SEQ; float s = 0.f;
        if (b != bcur) { bcur = b;
#pragma unroll
            for (int j = 0; j < 4; ++j) { const int k = 4 * (lane + 64 * j); shv[j] = *(const GAS f32x4*)(mod + b * 6144 + k); const f32x4 sc = *(const GAS f32x4*)(mod + b * 6144 + 1024 + k);
#pragma unroll
                for (int i = 0; i < 4; ++i) gsv[j][i] = gg[j][i] * (1.f + sc[i]); } }
#pragma unroll
        for (int j = 0; j < 4; ++j) s += (v[j][0] * v[j][0] + v[j][1] * v[j][1]) + (v[j][2] * v[j][2] + v[j][3] * v[j][3]);
        const float rstd = 1.0f / sqrtf(wave_sum(s) * (1.f / D) + EPS);
        GAS v2u* o = (GAS v2u*)(H + (size_t)row * D) + lane;
        float gd[8];
#pragma unroll
        for (int q = 0; q < 8; ++q) gd[q] = 0.f;
#pragma unroll
        for (int j = 0; j < 4; ++j) {
            f32x4 y;
#pragma unroll
            for (int i = 0; i < 4; ++i) y[i] = v[j][i] * rstd * gsv[j][i] + shv[j][i];
            v2u w; w.x = pk2(y[0], y[1]); w.y = pk2(y[2], y[3]); o[64 * j] = w;
#pragma unroll
            for (int q = 0; q < 8; ++q) { const f32x4 ww = *(LAS const f32x4*)(wg + q * D + 4 * (lane + 64 * j)); gd[q] += (y[0] * ww[0] + y[1] * ww[1]) + (y[2] * ww[2] + y[3] * ww[3]); } }
#pragma unroll
        for (int i = 0; i < 4; ++i) { const bool up = (lane & 32) != 0; const float keep = up ? gd[i + 4] : gd[i], send = up ? gd[i] : gd[i + 4]; gd[i] = keep + __shfl_xor(send, 32); }
#pragma unroll
        for (int i = 0; i < 2; ++i) { const bool up = (lane & 16) != 0; const float keep = up ? gd[i + 2] : gd[i], send = up ? gd[i] : gd[i + 2]; gd[i] = keep + __shfl_xor(send, 16); }
        { const bool up = (lane & 8) != 0; const float keep = up ? gd[1] : gd[0], send = up ? gd[0] : gd[1]; gd[0] = keep + __shfl_xor(send, 8); }
        float gv = gd[0]; gv += __shfl_xor(gv, 4); gv += __shfl_xor(gv, 2); gv += __shfl_xor(gv, 1); gv += gbias;
        if ((lane & 7) == 0) gates[(size_t)row * 8 + gi] = gi < 4 ? gv : (fminf(gv, 0.f) - log1pf(__expf(-fabsf(gv))));
#pragma unroll
        for (int j = 0; j < 4; ++j) v[j] = vn[j];
    }
}

__device__ __forceinline__ void phase_mid(const Args& A) {
    const int tid = threadIdx.x, lane = tid & 63, wave = tid >> 6, G = gridDim.x;
    const float* x = (const float*)A.in[I_X]; const float* gpost = (const float*)A.in[I_GPOST1]; const float* gpre = (const float*)A.in[I_GPRE2];
    const float* mod = (const float*)(A.ws + WS_MOD); const float* sumsq = (const float*)(A.ws + WS_SSQ);
    const bf16* MIX = (const bf16*)(A.ws + WS_MIX); bf16* H = (bf16*)(A.ws + WS_H); bf16* X1 = (bf16*)(A.ws + WS_X1);
    const int stride = G * NWAVES; int row = blockIdx.x * NWAVES + wave;
    f32x4 xv[4], xn[4], q[4], qn[4], g1p[4], gs2[4], sh2[4]; v2u mw[4], mn[4]; int bcur = -1;
#pragma unroll
    for (int j = 0; j < 4; ++j) { xv[j] = ((const GAS f32x4*)(x + (size_t)row * D) + lane)[64 * j]; mw[j] = ((const GAS v2u*)(MIX + (size_t)row * D) + lane)[64 * j]; q[j] = *(const GAS f32x4*)(sumsq + (size_t)row * 16 + 4 * j); }
    for (; row < M; row += stride) {
        const int rn = min(row + stride, M - 1);
#pragma unroll
        for (int j = 0; j < 4; ++j) { xn[j] = ((const GAS f32x4*)(x + (size_t)rn * D) + lane)[64 * j]; mn[j] = ((const GAS v2u*)(MIX + (size_t)rn * D) + lane)[64 * j]; qn[j] = *(const GAS f32x4*)(sumsq + (size_t)rn * 16 + 4 * j); }
        const int b = row / SEQ;
        if (b != bcur) { bcur = b;
#pragma unroll
            for (int j = 0; j < 4; ++j) { const int k = 4 * (lane + 64 * j); const f32x4 gp = *(const GAS f32x4*)(gpost + k), g1 = *(const GAS f32x4*)(mod + b * 6144 + 2048 + k), gg = *(const GAS f32x4*)(gpre + k), sc = *(const GAS f32x4*)(mod + b * 6144 + 4096 + k);
                sh2[j] = *(const GAS f32x4*)(mod + b * 6144 + 3072 + k);
#pragma unroll
                for (int i = 0; i < 4; ++i) { g1p[j][i] = g1[i] * gp[i]; gs2[j][i] = gg[i] * (1.f + sc[i]); } } }
        const float rm = 1.0f / sqrtf(((((q[0][0] + q[0][1]) + (q[0][2] + q[0][3])) + ((q[1][0] + q[1][1]) + (q[1][2] + q[1][3]))) + (((q[2][0] + q[2][1]) + (q[2][2] + q[2][3])) + ((q[3][0] + q[3][1]) + (q[3][2] + q[3][3])))) * (1.f / D) + EPS);
        f32x4 v[4]; float s = 0.f;
#pragma unroll
        for (int j = 0; j < 4; ++j) {
            const float mx[4] = {bflo(mw[j].x), bfhi(mw[j].x), bflo(mw[j].y), bfhi(mw[j].y)};
#pragma unroll
            for (int i = 0; i < 4; ++i) { v[j][i] = xv[j][i] + g1p[j][i] * (mx[i] * rm); s += v[j][i] * v[j][i]; }
            { v2u w; w.x = pk2(v[j][0], v[j][1]); w.y = pk2(v[j][2], v[j][3]); *((GAS v2u*)(X1 + (size_t)row * D) + lane + 64 * j) = w; } }
        const float rstd = 1.0f / sqrtf(wave_sum(s) * (1.f / D) + EPS);
        GAS v2u* o = (GAS v2u*)(H + (size_t)row * D) + lane; float amx = 0.f;
#pragma unroll
        for (int j = 0; j < 4; ++j) {
#pragma unroll
            for (int i = 0; i < 4; ++i) { v[j][i] = v[j][i] * rstd * gs2[j][i] + sh2[j][i]; amx = fmaxf(amx, fabsf(v[j][i])); }
            v2u w; w.x = pk2(v[j][0], v[j][1]); w.y = pk2(v[j][2], v[j][3]); o[64 * j] = w; }
        amx = wave_max(amx); const float s8 = amx > 0.f ? 119.0f / amx : 1.0f;
        GAS unsigned short* ohh = (GAS unsigned short*)((unsigned char*)A.ws + WS_H8 + (size_t)row * (D / 2)) + lane; GAS unsigned short* ohl = (GAS unsigned short*)((unsigned char*)A.ws + WS_H8 + 32 * MiB + (size_t)row * (D / 2)) + lane;
#pragma unroll
        for (int j = 0; j < 4; ++j) { unsigned whh = 0, whl = 0;
#pragma unroll
            for (int i = 0; i < 4; ++i) { const int tq = __float2int_rn(v[j][i] * s8) + 8; whh |= ((unsigned)(tq >> 4) & 15u) << (4 * i); whl |= ((unsigned)((tq & 15) - 8) & 15u) << (4 * i); }
            ohh[64 * j] = (unsigned short)whh; ohl[64 * j] = (unsigned short)whl; }
        if (lane == 0) ((float*)(A.ws + WS_HS))[row] = amx > 0.f ? amx * (1.0f / 119.0f) : 1.0f;
#pragma unroll
        for (int j = 0; j < 4; ++j) { xv[j] = xn[j]; mw[j] = mn[j]; q[j] = qn[j]; }
    }
}
__device__ __forceinline__ void load64bf(const bf16* p, float (&o)[64]) {
#pragma unroll
    for (int i = 0; i < 8; ++i) { const v4u w = *(const GAS v4u*)(p + 8 * i);
        o[8 * i + 0] = bflo(w.x); o[8 * i + 1] = bfhi(w.x); o[8 * i + 2] = bflo(w.y); o[8 * i + 3] = bfhi(w.y);
        o[8 * i + 4] = bflo(w.z); o[8 * i + 5] = bfhi(w.z); o[8 * i + 6] = bflo(w.w); o[8 * i + 7] = bfhi(w.w); }
}
__device__ __forceinline__ void phase_attn_naive(const Args& A, int vb, int nvb) {
    const bf16* P = (const bf16*)(A.ws + WS_PROJ); bf16* MI = (bf16*)(A.ws + WS_MIXIN); const float* sinks = (const float*)A.in[I_SINK];
    for (int task = vb * NTHR + (int)threadIdx.x; task < 8 * M; task += nvb * NTHR) {
        const int h = task / M, t = task % M, s = t % SEQ, kvh = h >> 2;
        float q[64], o[64];
        load64bf(P + (size_t)t * NPROJ + C_AQ + h * 64, q);
#pragma unroll
        for (int d = 0; d < 64; ++d) o[d] = 0.f;
        float mx = sinks[h], l = 1.f;
        for (int j = 0; j < 128; ++j) {
            const int sj = s - 127 + j; const bool valid = sj >= 0; const int tk = valid ? (t - 127 + j) : t;
            const bf16* kr = P + (size_t)tk * NPROJ + C_AK + kvh * 64; float sc = 0.f;
#pragma unroll
            for (int i = 0; i < 8; ++i) { const v4u w = *(const GAS v4u*)(kr + 8 * i);
                sc += q[8 * i + 0] * bflo(w.x) + q[8 * i + 1] * bfhi(w.x) + q[8 * i + 2] * bflo(w.y) + q[8 * i + 3] * bfhi(w.y)
                    + q[8 * i + 4] * bflo(w.z) + q[8 * i + 5] * bfhi(w.z) + q[8 * i + 6] * bflo(w.w) + q[8 * i + 7] * bfhi(w.w); }
            if (valid) {
                const float mn = fmaxf(mx, sc), al = __expf(mx - mn), p = __expf(sc - mn); mx = mn; l = l * al + p;
                const bf16* vr = P + (size_t)tk * NPROJ + C_AV + kvh * 64;
#pragma unroll
                for (int i = 0; i < 8; ++i) { const v4u w = *(const GAS v4u*)(vr + 8 * i);
                    o[8 * i + 0] = o[8 * i + 0] * al + p * bflo(w.x); o[8 * i + 1] = o[8 * i + 1] * al + p * bfhi(w.x);
                    o[8 * i + 2] = o[8 * i + 2] * al + p * bflo(w.y); o[8 * i + 3] = o[8 * i + 3] * al + p * bfhi(w.y);
                    o[8 * i + 4] = o[8 * i + 4] * al + p * bflo(w.z); o[8 * i + 5] = o[8 * i + 5] * al + p * bfhi(w.z);
                    o[8 * i + 6] = o[8 * i + 6] * al + p * bflo(w.w); o[8 * i + 7] = o[8 * i + 7] * al + p * bfhi(w.w); }
            }
        }
        const float il = 1.f / l; bf16* orow = MI + (size_t)t * D + h * 64;
#pragma unroll
        for (int i = 0; i < 8; ++i) { v4u w; w.x = pk2(o[8 * i] * il, o[8 * i + 1] * il); w.y = pk2(o[8 * i + 2] * il, o[8 * i + 3] * il);
            w.z = pk2(o[8 * i + 4] * il, o[8 * i + 5] * il); w.w = pk2(o[8 * i + 6] * il, o[8 * i + 7] * il); *(GAS v4u*)(orow + 8 * i) = w; }
    }
}

__device__ __forceinline__ void phase_mlstm_naive(const Args& A, LAS unsigned char* lds, int bh) {
    const int tid = threadIdx.x, lane = tid & 63, wave = tid >> 6, b = bh >> 2, h = bh & 3, dv = tid >> 2, part = tid & 3;
    const bf16* P = (const bf16*)(A.ws + WS_PROJ); bf16* MI = (bf16*)(A.ws + WS_MIXIN); const float* gates = (const float*)(A.ws + WS_GATES);
    const float* cw = (const float*)A.in[I_CONVW]; const float* ng = (const float*)A.in[I_MNG];
    LAS float* qs = (LAS float*)lds; LAS float* ks = qs + 64 * 64; LAS float* vs = ks + 64 * 64; LAS float* ig = vs + 64 * 128; LAS float* lfg = ig + 64; LAS float* hb = lfg + 64;
    float C[16], n[16]; float m = 0.f;
#pragma unroll
    for (int j = 0; j < 16; ++j) { C[j] = 0.f; n[j] = 0.f; }
    for (int ch = 0; ch < SEQ / 64; ++ch) {
        const int s0 = ch * 64; const size_t t0 = (size_t)b * SEQ + s0;
        for (int e = tid; e < 64 * 64; e += NTHR) { const int l = e >> 6, dk = e & 63; float aq = 0.f, ak = 0.f;
#pragma unroll
            for (int j = 0; j < 4; ++j) { const int sj = s0 + l - 3 + j; if (sj >= 0) { const bf16* r = P + ((size_t)b * SEQ + sj) * NPROJ;
                aq += cw[j * 512 + h * 64 + dk] * bf1(r[C_MQ + h * 64 + dk]); ak += cw[j * 512 + 256 + h * 64 + dk] * bf1(r[C_MK + h * 64 + dk]); } }
            qs[e] = 0.125f * aq / (1.f + __expf(-aq)); ks[e] = ak / (1.f + __expf(-ak)); }
        for (int e = tid; e < 64 * 128; e += NTHR) { const int l = e >> 7, d = e & 127; vs[e] = bf1(P[(t0 + l) * NPROJ + C_MV + h * 128 + d]); }
        if (tid < 64) { ig[tid] = gates[(t0 + tid) * 8 + h]; lfg[tid] = gates[(t0 + tid) * 8 + 4 + h]; }
        __syncthreads();
        for (int l = 0; l < 64; ++l) {
            const float lf = lfg[l], ii = ig[l], mn = fmaxf(lf + m, ii), fd = __expf(lf + m - mn), iw = __expf(ii - mn), vv = vs[l * 128 + dv] * iw;
            float num = 0.f, den = 0.f;
#pragma unroll
            for (int j = 0; j < 16; ++j) { const float kk = ks[l * 64 + part * 16 + j], qq = qs[l * 64 + part * 16 + j];
                C[j] = fd * C[j] + vv * kk; n[j] = fd * n[j] + iw * kk; num += C[j] * qq; den += n[j] * qq; }
            num += __shfl_xor(num, 1); num += __shfl_xor(num, 2); den += __shfl_xor(den, 1); den += __shfl_xor(den, 2);
            if (part == 0) hb[l * 128 + dv] = num / fmaxf(fabsf(den), __expf(-mn));
            m = mn;
        }
        __syncthreads();
        for (int l = wave * 8; l < wave * 8 + 8; ++l) { const float a0 = hb[l * 128 + lane], a1 = hb[l * 128 + 64 + lane];
            const float r = 1.0f / sqrtf(wave_sum(a0 * a0 + a1 * a1) * (1.f / 128.f) + EPS);
            const bf16* pr = P + (t0 + l) * NPROJ + C_MO + h * 128; bf16* orow = MI + (t0 + l) * D + 512 + h * 128;
            orow[lane] = (bf16)f2bf(a0 * r * ng[h * 128 + lane] * bf1(pr[lane])); orow[64 + lane] = (bf16)f2bf(a1 * r * ng[h * 128 + 64 + lane] * bf1(pr[64 + lane])); }
        __syncthreads();
    }
}

__device__ __forceinline__ void ld16bf(const bf16* p, float (&o)[16]) {
    const v4u w0 = *(const GAS v4u*)p, w1 = *(const GAS v4u*)(p + 8);
    o[0] = bflo(w0.x); o[1] = bfhi(w0.x); o[2] = bflo(w0.y); o[3] = bfhi(w0.y); o[4] = bflo(w0.z); o[5] = bfhi(w0.z); o[6] = bflo(w0.w); o[7] = bfhi(w0.w);
    o[8] = bflo(w1.x); o[9] = bfhi(w1.x); o[10] = bflo(w1.y); o[11] = bfhi(w1.y); o[12] = bflo(w1.z); o[13] = bfhi(w1.z); o[14] = bflo(w1.w); o[15] = bfhi(w1.w);
}
typedef short bf16x8 __attribute__((ext_vector_type(8)));
#define MFMA16(a, b, c) __builtin_amdgcn_mfma_f32_16x16x32_bf16((a), (b), (c), 0, 0, 0)
__device__ __forceinline__ bf16x8 ldfrag(LAS const unsigned char* img, int row, int kbyte) { return *(LAS const bf16x8*)(img + row * 144 + kbyte); }
__device__ __forceinline__ bf16x8 ldfrag_sw(LAS const unsigned char* img, int row, int kbyte) { return *(LAS const bf16x8*)(img + row * 144 + (kbyte ^ (((row >> 3) & 7) << 4))); }
__device__ __forceinline__ unsigned cvtpk(float lo, float hi) { unsigned r; asm volatile("v_cvt_pk_bf16_f32 %0, %1, %2" : "=v"(r) : "v"(lo), "v"(hi)); return r; }

namespace ml {
constexpr int O_Q = 0, O_QA = 9216, O_K = 18432, O_KWT = 27648, O_VT = 36864, O_CX = 57600, CXB = 20736, O_S = 99072, O_GB = 108288, O_GA = O_GB + 4096, O_GC = O_GA + 4096, O_DEN = O_GC + 4096, O_SSQ = O_DEN + 256, O_END = O_SSQ + 2048;
static_assert(O_END <= 131072, "mlstm LDS");
constexpr size_t MST_SC = 11 * MiB;
}
template <bool OUT>
__device__ __forceinline__ void mlstm_group(const Args& A, LAS unsigned char* lds, int wg) {
    using namespace ml;
    const int tid = threadIdx.x, lane = tid & 63, wave = __builtin_amdgcn_readfirstlane(tid >> 6), fr = lane & 15, fq = lane >> 4;
    const int bh = wg >> 3, grp = wg & 7, b = bh >> 2, h = bh & 3;
    const size_t tg0 = (size_t)b * SEQ + (size_t)grp * 1024;
    const bf16* P = (const bf16*)(A.ws + WS_PROJ); bf16* MI = (bf16*)(A.ws + WS_MIXIN); const float* gates = (const float*)(A.ws + WS_GATES);
    const float* cw = (const float*)A.in[I_CONVW]; const float* ng = (const float*)A.in[I_MNG];
    float* MST = (float*)(A.ws + WS_MST); float* MSC = (float*)(A.ws + WS_MST + MST_SC);
    LAS float* GB = (LAS float*)(lds + O_GB); LAS float* GA = (LAS float*)(lds + O_GA); LAS float* GC = (LAS float*)(lds + O_GC);
    LAS float* DEN = (LAS float*)(lds + O_DEN); LAS float* SSQ = (LAS float*)(lds + O_SSQ);
    __syncthreads();
#pragma unroll
    for (int cc = 0; cc < 2; ++cc) { const int c = 2 * wave + cc; const size_t t = tg0 + c * 64 + lane;
        float bc = gates[t * 8 + 4 + h]; const float ii = gates[t * 8 + h];
#pragma unroll
        for (int o = 1; o < 64; o <<= 1) { const float v = __shfl_up(bc, o); if (lane >= o) bc += v; }
        const float a = ii - bc; float cm = a;
#pragma unroll
        for (int o = 1; o < 64; o <<= 1) { const float v = __shfl_up(cm, o); if (lane >= o) cm = fmaxf(cm, v); }
        GB[c * 64 + lane] = bc; GA[c * 64 + lane] = a; GC[c * 64 + lane] = cm; }
    for (int e = tid; e < 16 * 32; e += NTHR) { const int r = e >> 5, cpair = e & 31; *(LAS unsigned*)(lds + O_VT + (128 + r) * 144 + cpair * 4) = (r == 0) ? 0x3F803F80u : 0u; }
    f32x4 st[5];
#pragma unroll
    for (int i = 0; i < 5; ++i) st[i] = (f32x4){0.f, 0.f, 0.f, 0.f};
    float m = OUT ? 0.f : -__builtin_inff(); float Btot = 0.f;
    if (OUT) {
        for (int gp = 0; gp < grp; ++gp) { const int wgp = bh * 8 + gp; const float mg = MSC[wgp * 2], Bg = MSC[wgp * 2 + 1];
            const float mn = fmaxf(Bg + m, mg), f0 = __expf(Bg + m - mn), f1 = __expf(mg - mn);
#pragma unroll
            for (int i = 0; i < 5; ++i)
#pragma unroll
                for (int r = 0; r < 4; ++r) st[i][r] = f0 * st[i][r] + f1 * MST[((size_t)wgp * 20 + i * 4 + r) * NTHR + tid];
            m = mn; }
#pragma unroll
        for (int j = 0; j < 4; ++j)
#pragma unroll
            for (int r = 0; r < 4; ++r) *(LAS bf16*)(lds + O_CX + (16 * wave + 4 * fq + r) * 144 + (16 * j + fr) * 2) = (bf16)f2bf(st[j][r]);
        if (wave < 4) {
#pragma unroll
            for (int r = 0; r < 4; ++r) *(LAS bf16*)(lds + O_CX + (128 + 4 * fq + r) * 144 + (16 * wave + fr) * 2) = (bf16)f2bf(st[4][r]); }
    }
    float gsc[4];
#pragma unroll
    for (int r = 0; r < 4; ++r) gsc[r] = ng[h * 128 + 16 * wave + 4 * fq + r];
    const int sl = tid >> 3, cg = tid & 7;
    __syncthreads();
    for (int c = 0; c < 16; ++c) {
        const float bL = GB[c * 64 + 63], M63 = fmaxf(m, GC[c * 64 + 63]), decay = __expf(m - M63);
        const size_t tc0 = tg0 + (size_t)c * 64;
        {
            const int sabs = grp * 1024 + c * 64 + sl;
            float aq[8], ak[8];
#pragma unroll
            for (int i = 0; i < 8; ++i) { aq[i] = 0.f; ak[i] = 0.f; }
#pragma unroll
            for (int j = 0; j < 4; ++j) { const int sj = sabs - 3 + j;
                if (sj >= 0) { const bf16* rp = P + ((size_t)b * SEQ + sj) * NPROJ;
                    const v4u wq = *(const GAS v4u*)(rp + C_MQ + h * 64 + 8 * cg), wk = *(const GAS v4u*)(rp + C_MK + h * 64 + 8 * cg);
                    const f32x4 q0 = *(const GAS f32x4*)(cw + j * 512 + h * 64 + 8 * cg), q1 = *(const GAS f32x4*)(cw + j * 512 + h * 64 + 8 * cg + 4);
                    const f32x4 k0 = *(const GAS f32x4*)(cw + j * 512 + 256 + h * 64 + 8 * cg), k1 = *(const GAS f32x4*)(cw + j * 512 + 256 + h * 64 + 8 * cg + 4);
                    aq[0] += q0[0] * bflo(wq.x); aq[1] += q0[1] * bfhi(wq.x); aq[2] += q0[2] * bflo(wq.y); aq[3] += q0[3] * bfhi(wq.y);
                    aq[4] += q1[0] * bflo(wq.z); aq[5] += q1[1] * bfhi(wq.z); aq[6] += q1[2] * bflo(wq.w); aq[7] += q1[3] * bfhi(wq.w);
                    ak[0] += k0[0] * bflo(wk.x); ak[1] += k0[1] * bfhi(wk.x); ak[2] += k0[2] * bflo(wk.y); ak[3] += k0[3] * bfhi(wk.y);
                    ak[4] += k1[0] * bflo(wk.z); ak[5] += k1[1] * bfhi(wk.z); ak[6] += k1[2] * bflo(wk.w); ak[7] += k1[3] * bfhi(wk.w); } }
            const float Ml = fmaxf(m, GC[c * 64 + sl]), ainter = __expf(m - Ml), wsv = __expf(GA[c * 64 + sl] - M63);
            float qv[8], kv[8];
#pragma unroll
            for (int i = 0; i < 8; ++i) { qv[i] = 0.125f * aq[i] * __builtin_amdgcn_rcpf(1.f + __expf(-aq[i])); kv[i] = ak[i] * __builtin_amdgcn_rcpf(1.f + __expf(-ak[i])); }
            if (OUT) {
                v4u w; w.x = pk2(qv[0], qv[1]); w.y = pk2(qv[2], qv[3]); w.z = pk2(qv[4], qv[5]); w.w = pk2(qv[6], qv[7]); *(LAS v4u*)(lds + O_Q + sl * 144 + cg * 16) = w;
                w.x = pk2(qv[0] * ainter, qv[1] * ainter); w.y = pk2(qv[2] * ainter, qv[3] * ainter); w.z = pk2(qv[4] * ainter, qv[5] * ainter); w.w = pk2(qv[6] * ainter, qv[7] * ainter); *(LAS v4u*)(lds + O_QA + sl * 144 + cg * 16) = w;
                w.x = pk2(kv[0], kv[1]); w.y = pk2(kv[2], kv[3]); w.z = pk2(kv[4], kv[5]); w.w = pk2(kv[6], kv[7]); *(LAS v4u*)(lds + O_K + sl * 144 + cg * 16) = w;
            }
#pragma unroll
            for (int i = 0; i < 8; ++i) *(LAS bf16*)(lds + O_KWT + (8 * cg + i) * 144 + (sl ^ (8 * cg)) * 2) = (bf16)f2bf(kv[i] * wsv);
#pragma unroll
            for (int gi = 0; gi < 2; ++gi) { const int g8 = cg + 8 * gi; const v4u wv = *(const GAS v4u*)(P + (tc0 + sl) * NPROJ + C_MV + h * 128 + 8 * g8);
                const unsigned ww[4] = {wv.x, wv.y, wv.z, wv.w};
#pragma unroll
                for (int i = 0; i < 4; ++i) { *(LAS bf16*)(lds + O_VT + (8 * g8 + 2 * i) * 144 + (sl ^ (8 * cg)) * 2) = (bf16)(ww[i] & 0xffffu); *(LAS bf16*)(lds + O_VT + (8 * g8 + 2 * i + 1) * 144 + (sl ^ (8 * cg)) * 2) = (bf16)(ww[i] >> 16); } }
        }
        __syncthreads();
        if (OUT) {
            const int lt = wave >> 1, l = 16 * lt + fr; const float Ml = fmaxf(m, GC[c * 64 + l]);
            const bf16x8 bq0 = ldfrag(lds + O_Q, 16 * lt + fr, 16 * fq), bq1 = ldfrag(lds + O_Q, 16 * lt + fr, 64 + 16 * fq);
#pragma unroll
            for (int u = 0; u < 2; ++u) { const int stl = 2 * (wave & 1) + u; f32x4 acc = {0.f, 0.f, 0.f, 0.f};
                acc = MFMA16(ldfrag(lds + O_K, 16 * stl + fr, 16 * fq), bq0, acc); acc = MFMA16(ldfrag(lds + O_K, 16 * stl + fr, 64 + 16 * fq), bq1, acc);
                const f32x4 av = *(LAS const f32x4*)(GA + c * 64 + 16 * stl + 4 * fq); float wv[4];
#pragma unroll
                for (int r = 0; r < 4; ++r) { const int s = 16 * stl + 4 * fq + r; wv[r] = (s <= l) ? acc[r] * __expf(av[r] - Ml) : 0.f; }
                v2u w; w.x = cvtpk(wv[0], wv[1]); w.y = cvtpk(wv[2], wv[3]); *(LAS v2u*)(lds + O_S + l * 144 + (16 * stl + 4 * fq) * 2) = w; }
        }
        {
            const bf16x8 va0 = ldfrag_sw(lds + O_VT, 16 * wave + fr, 16 * fq), va1 = ldfrag_sw(lds + O_VT, 16 * wave + fr, 64 + 16 * fq);
#pragma unroll
            for (int j = 0; j < 4; ++j) { st[j] = st[j] * decay;
                st[j] = MFMA16(va0, ldfrag_sw(lds + O_KWT, 16 * j + fr, 16 * fq), st[j]); st[j] = MFMA16(va1, ldfrag_sw(lds + O_KWT, 16 * j + fr, 64 + 16 * fq), st[j]); }
            if (wave < 4) { st[4] = st[4] * decay;
                st[4] = MFMA16(ldfrag_sw(lds + O_VT, 128 + fr, 16 * fq), ldfrag_sw(lds + O_KWT, 16 * wave + fr, 16 * fq), st[4]);
                st[4] = MFMA16(ldfrag_sw(lds + O_VT, 128 + fr, 64 + 16 * fq), ldfrag_sw(lds + O_KWT, 16 * wave + fr, 64 + 16 * fq), st[4]); }
        }
        if (OUT) {
            __syncthreads();
            LAS const unsigned char* cx = lds + O_CX + (c & 1) * CXB;
            f32x4 nt[4], nd = {0.f, 0.f, 0.f, 0.f};
            {
                const bf16x8 va0 = ldfrag_sw(lds + O_VT, 16 * wave + fr, 16 * fq), va1 = ldfrag_sw(lds + O_VT, 16 * wave + fr, 64 + 16 * fq);
                const bf16x8 ca0 = ldfrag(cx, 16 * wave + fr, 16 * fq), ca1 = ldfrag(cx, 16 * wave + fr, 64 + 16 * fq);
#pragma unroll
                for (int lt = 0; lt < 4; ++lt) { f32x4 acc = {0.f, 0.f, 0.f, 0.f};
                    acc = MFMA16(va0, ldfrag(lds + O_S, 16 * lt + fr, 16 * fq), acc); acc = MFMA16(va1, ldfrag(lds + O_S, 16 * lt + fr, 64 + 16 * fq), acc);
                    acc = MFMA16(ca0, ldfrag(lds + O_QA, 16 * lt + fr, 16 * fq), acc); acc = MFMA16(ca1, ldfrag(lds + O_QA, 16 * lt + fr, 64 + 16 * fq), acc); nt[lt] = acc; }
                if (wave >= 4) { const int lt = wave - 4;
                    nd = MFMA16(ldfrag_sw(lds + O_VT, 128 + fr, 16 * fq), ldfrag(lds + O_S, 16 * lt + fr, 16 * fq), nd); nd = MFMA16(ldfrag_sw(lds + O_VT, 128 + fr, 64 + 16 * fq), ldfrag(lds + O_S, 16 * lt + fr, 64 + 16 * fq), nd);
                    nd = MFMA16(ldfrag(cx, 128 + fr, 16 * fq), ldfrag(lds + O_QA, 16 * lt + fr, 16 * fq), nd); nd = MFMA16(ldfrag(cx, 128 + fr, 64 + 16 * fq), ldfrag(lds + O_QA, 16 * lt + fr, 64 + 16 * fq), nd);
                    if (fq == 0) DEN[16 * lt + fr] = nd[0]; }
            }
            v2u mo[4];
#pragma unroll
            for (int lt = 0; lt < 4; ++lt) mo[lt] = *(const GAS v2u*)(P + (tc0 + 16 * lt + fr) * NPROJ + C_MO + h * 128 + 16 * wave + 4 * fq);
            __syncthreads();
#pragma unroll
            for (int lt = 0; lt < 4; ++lt) { const int l = 16 * lt + fr; const float Ml = fmaxf(m, GC[c * 64 + l]);
                const float inv = 1.0f / fmaxf(fabsf(DEN[l]), __expf(-(GB[c * 64 + l] + Ml)));
                nt[lt] = nt[lt] * inv; float ss = (nt[lt][0] * nt[lt][0] + nt[lt][1] * nt[lt][1]) + (nt[lt][2] * nt[lt][2] + nt[lt][3] * nt[lt][3]);
                ss += __shfl_xor(ss, 16); ss += __shfl_xor(ss, 32);
                if (fq == 0) SSQ[wave * 64 + l] = ss; }
            LAS unsigned char* cxn = lds + O_CX + ((c + 1) & 1) * CXB;
#pragma unroll
            for (int j = 0; j < 4; ++j)
#pragma unroll
                for (int r = 0; r < 4; ++r) *(LAS bf16*)(cxn + (16 * wave + 4 * fq + r) * 144 + (16 * j + fr) * 2) = (bf16)f2bf(st[j][r]);
            if (wave < 4) {
#pragma unroll
                for (int r = 0; r < 4; ++r) *(LAS bf16*)(cxn + (128 + 4 * fq + r) * 144 + (16 * wave + fr) * 2) = (bf16)f2bf(st[4][r]); }
            __syncthreads();
#pragma unroll
            for (int lt = 0; lt < 4; ++lt) { const int l = 16 * lt + fr; float tot = 0.f;
#pragma unroll
                for (int w2 = 0; w2 < 8; ++w2) tot += SSQ[w2 * 64 + l];
                const float rn = 1.0f / sqrtf(tot * (1.f / 128.f) + EPS);
                const float o0 = nt[lt][0] * rn * gsc[0] * bflo(mo[lt].x), o1 = nt[lt][1] * rn * gsc[1] * bfhi(mo[lt].x), o2 = nt[lt][2] * rn * gsc[2] * bflo(mo[lt].y), o3 = nt[lt][3] * rn * gsc[3] * bfhi(mo[lt].y);
                v2u w; w.x = pk2(o0, o1); w.y = pk2(o2, o3);
                *(GAS v2u*)(MI + (tc0 + l) * D + 512 + h * 128 + 16 * wave + 4 * fq) = w; }
        } else {
            __syncthreads();
        }
        m = bL + M63; Btot += bL;
    }
    if (!OUT) {
#pragma unroll
        for (int i = 0; i < 5; ++i)
#pragma unroll
            for (int r = 0; r < 4; ++r) MST[((size_t)wg * 20 + i * 4 + r) * NTHR + tid] = st[i][r];
        if (tid == 0) { MSC[wg * 2] = m; MSC[wg * 2 + 1] = Btot; }
    }
}

namespace at {
constexpr int O_K = 0, O_VT = 36864, VTS = 592  , O_END = O_VT + 64 * VTS;
static_assert(O_END <= 131072, "attention LDS");
}
__device__ __forceinline__ void phase_attn(const Args& A, LAS unsigned char* lds) {
    using namespace at;
    const int tid = threadIdx.x, lane = tid & 63, wave = __builtin_amdgcn_readfirstlane(tid >> 6), fr = lane & 15, fq = lane >> 4, G = gridDim.x;
    const bf16* P = (const bf16*)(A.ws + WS_PROJ); bf16* MI = (bf16*)(A.ws + WS_MIXIN); const float* sinks = (const float*)A.in[I_SINK];
    __syncthreads();
    for (int e = tid; e < 64 * 16; e += NTHR) { const int r = e >> 4, cpair = e & 15; *(LAS unsigned*)(lds + O_VT + r * VTS + 512 + cpair * 4) = 0u; }
    for (int unit = blockIdx.x; unit < NB * 64 * 2; unit += G) {
        const int g = unit & 1, n = (unit >> 1) & 63, b = unit >> 7;
        const size_t tq0 = (size_t)b * SEQ + (size_t)n * 128;
        __syncthreads();
#pragma unroll
        for (int i = 0; i < 4; ++i) { const int item = tid + NTHR * i, row = item >> 3, ch = item & 7;
            v4u wk = {0u, 0u, 0u, 0u}, wv = {0u, 0u, 0u, 0u};
            if (n > 0 || row >= 128) { const bf16* rp = P + (tq0 - 128 + row) * NPROJ; wk = *(const GAS v4u*)(rp + C_AK + g * 64 + 8 * ch); wv = *(const GAS v4u*)(rp + C_AV + g * 64 + 8 * ch); }
            *(LAS v4u*)(lds + O_K + row * 144 + ch * 16) = wk;
            const unsigned ww[4] = {wv.x, wv.y, wv.z, wv.w};
#pragma unroll
            for (int k = 0; k < 4; ++k) { *(LAS bf16*)(lds + O_VT + (8 * ch + 2 * k) * VTS + (row ^ (4 * ch)) * 2) = (bf16)(ww[k] & 0xffffu); *(LAS bf16*)(lds + O_VT + (8 * ch + 2 * k + 1) * VTS + (row ^ (4 * ch)) * 2) = (bf16)(ww[k] >> 16); } }
        const int hq = 4 * g + (wave >> 1), qr0 = 64 * (wave & 1); const float sink = sinks[hq];
        __syncthreads();
        for (int qt = 0; qt < 4; ++qt) {
            const int i0 = qr0 + 16 * qt, st0 = i0 >> 4, iq = i0 + fr;
            const bf16* qp = P + (tq0 + iq) * NPROJ + C_AQ + hq * 64 + 8 * fq;
            const bf16x8 bq0 = *(const GAS bf16x8*)qp, bq1 = *(const GAS bf16x8*)(qp + 32);
            f32x4 sc[9]; float mx = sink;
#pragma unroll
            for (int t = 0; t < 9; ++t) { const int sb0 = 16 * (st0 + t); f32x4 acc = {0.f, 0.f, 0.f, 0.f};
                acc = MFMA16(ldfrag(lds + O_K, sb0 + fr, 16 * fq), bq0, acc); acc = MFMA16(ldfrag(lds + O_K, sb0 + fr, 64 + 16 * fq), bq1, acc);
#pragma unroll
                for (int r = 0; r < 4; ++r) { const int sb = sb0 + 4 * fq + r; const bool valid = (sb > iq) && (sb <= iq + 128) && (n > 0 || sb >= 128);
                    acc[r] = valid ? acc[r] : -3.0e38f; mx = fmaxf(mx, acc[r]); }
                sc[t] = acc; }
            mx = fmaxf(mx, __shfl_xor(mx, 16)); mx = fmaxf(mx, __shfl_xor(mx, 32));
            float lsum = 0.f;
#pragma unroll
            for (int t = 0; t < 9; ++t)
#pragma unroll
                for (int r = 0; r < 4; ++r) { const float p = (sc[t][r] > -1.0e38f) ? __expf(sc[t][r] - mx) : 0.f; sc[t][r] = p; lsum += p; }
            lsum += __shfl_xor(lsum, 16); lsum += __shfl_xor(lsum, 32); lsum += __expf(sink - mx);
            f32x4 oacc[4];
#pragma unroll
            for (int dt = 0; dt < 4; ++dt) oacc[dt] = (f32x4){0.f, 0.f, 0.f, 0.f};
#pragma unroll
            for (int ks = 0; ks < 5; ++ks) {
                union { bf16x8 v; unsigned u[4]; } pb;
                pb.u[0] = cvtpk(sc[2 * ks][0], sc[2 * ks][1]); pb.u[1] = cvtpk(sc[2 * ks][2], sc[2 * ks][3]);
                if (ks < 4) { pb.u[2] = cvtpk(sc[2 * ks + 1][0], sc[2 * ks + 1][1]); pb.u[3] = cvtpk(sc[2 * ks + 1][2], sc[2 * ks + 1][3]); } else { pb.u[2] = 0u; pb.u[3] = 0u; }
                const int sbb = 16 * (st0 + 2 * ks) + 4 * fq;
#pragma unroll
                for (int dt = 0; dt < 4; ++dt) { const int dd = 16 * dt + fr, sx = 4 * ((dd >> 3) & 7); LAS const unsigned char* vrow = lds + O_VT + dd * VTS;
                    union { bf16x8 v; v2u h[2]; } va; va.h[0] = *(LAS const v2u*)(vrow + (sbb ^ sx) * 2); va.h[1] = *(LAS const v2u*)(vrow + ((sbb + 16) ^ sx) * 2);
                    oacc[dt] = MFMA16(va.v, pb.v, oacc[dt]); } }
            const float il = 1.0f / lsum;
#pragma unroll
            for (int dt = 0; dt < 4; ++dt) { v2u w; w.x = pk2(oacc[dt][0] * il, oacc[dt][1] * il); w.y = pk2(oacc[dt][2] * il, oacc[dt][3] * il);
                *(GAS v2u*)(MI + (tq0 + iq) * D + hq * 64 + 16 * dt + 4 * fq) = w; }
        }
    }
}
typedef float f32x16 __attribute__((ext_vector_type(16)));
__device__ __forceinline__ unsigned fbits(float f) { return __builtin_bit_cast(unsigned, f); }
__device__ __forceinline__ float bfloat(unsigned u) { return __builtin_bit_cast(float, u); }

#define CE_DESC(a, b) do { const float _mx = __builtin_fmaxf(a, b), _mn = __builtin_fminf(a, b); a = _mx; b = _mn; } while (0)
__device__ __forceinline__ void bsort16(float (&v)[16]) {
#pragma unroll
    for (int k = 2; k <= 16; k <<= 1)
#pragma unroll
        for (int j = k >> 1; j > 0; j >>= 1)
#pragma unroll
            for (int i = 0; i < 16; ++i) { const int l = i ^ j; if (l > i) { if ((i & k) == 0) CE_DESC(v[i], v[l]); else CE_DESC(v[l], v[i]); } }
}
__device__ __forceinline__ void bmerge16(float (&v)[16], const float (&w)[16]) {
#pragma unroll
    for (int i = 0; i < 16; ++i) v[i] = __builtin_fmaxf(v[i], w[15 - i]);
#pragma unroll
    for (int j = 8; j > 0; j >>= 1)
#pragma unroll
        for (int i = 0; i < 16; ++i) { const int l = i ^ j; if (l > i) CE_DESC(v[i], v[l]); }
}
namespace tk {
constexpr int KS = 272;
constexpr int O_K1 = 0, O_K2 = 128 * KS, O_X = 2 * 128 * KS, O_END = O_X + 8 * 4096;
static_assert(O_END <= 131072, "topk LDS");
constexpr unsigned char CAND[64] = {
    0x00, 0x01, 0x02, 0x03, 0x04, 0x05, 0x06, 0x07, 0x08, 0x09, 0x0a, 0x0b, 0x0c, 0x0d, 0x0e, 0x0f,
    0x10, 0x11, 0x12, 0x13, 0x14, 0x15, 0x16, 0x17, 0x80, 0x90, 0xa0, 0xb0, 0xc0, 0xd0, 0xe0, 0xf0,
    0x20, 0x21, 0x22, 0x23, 0x24, 0x30, 0x31, 0x32, 0x33, 0x40, 0x41, 0x42, 0x50, 0x51, 0x60, 0x61,
    0x70, 0x71, 0xff, 0xff, 0xff, 0xff, 0xff, 0xff, 0xff, 0xff, 0xff, 0xff, 0xff, 0xff, 0xff, 0xff};
}
__device__ __forceinline__ void side_top16(const f32x16 (&acc)[4], int hh, float (&T)[16]) {
    float g1[16], g2[16];
#pragma unroll
    for (int r = 0; r < 16; ++r) { const unsigned key = (r & 3) + 8 * (r >> 2) + 4 * hh;
        T[r] = bfloat((fbits(acc[0][r]) & 0xffffff80u) | key);
        g1[r] = bfloat((fbits(acc[1][r]) & 0xffffff80u) | (32u + key)); }
    bsort16(T); bsort16(g1); bmerge16(T, g1);
#pragma unroll
    for (int r = 0; r < 16; ++r) { const unsigned key = (r & 3) + 8 * (r >> 2) + 4 * hh;
        g1[r] = bfloat((fbits(acc[2][r]) & 0xffffff80u) | (64u + key));
        g2[r] = bfloat((fbits(acc[3][r]) & 0xffffff80u) | (96u + key)); }
    bsort16(g1); bsort16(g2); bmerge16(g1, g2); bmerge16(T, g1);
#pragma unroll
    for (int r = 0; r < 16; ++r) g1[r] = __shfl_xor(T[r], 32);
    bmerge16(T, g1);
}
template <int SD> __device__ __forceinline__ void topk_side(const bf16* Q, LAS unsigned char* lds, int t, int h, int r32, int hh, float (&T)[16]) {
    using namespace tk;
    f32x16 acc[4];
#pragma unroll
    for (int mt = 0; mt < 4; ++mt)
#pragma unroll
        for (int r = 0; r < 16; ++r) acc[mt][r] = 0.f;
    const bf16* qp = Q + (size_t)t * 2048 + h * 256 + SD * 128 + 8 * hh; LAS const unsigned char* kimg = lds + (SD ? O_K2 : O_K1);
#pragma unroll
    for (int ks = 0; ks < 8; ++ks) { const bf16x8 bq = *(const GAS bf16x8*)(qp + 16 * ks);
#pragma unroll
        for (int mt = 0; mt < 4; ++mt) acc[mt] = __builtin_amdgcn_mfma_f32_32x32x16_bf16(*(LAS const bf16x8*)(kimg + (32 * mt + r32) * KS + 32 * ks + 16 * hh), bq, acc[mt], 0, 0, 0); }
    side_top16(acc, hh, T);
}
template <int Q> __device__ __forceinline__ float cand_val(const float (&T1)[16], const float (&T2)[16], int hh) {
    constexpr unsigned c0 = tk::CAND[2 * Q], c1 = tk::CAND[2 * Q + 1];
    const float s = (hh ? T1[(c1 >> 4) & 15] : T1[(c0 >> 4) & 15]) + (hh ? T2[c1 & 15] : T2[c0 & 15]); const unsigned code = hh ? c1 : c0;
    return (code == 0xffu) ? -3.0e38f : bfloat((fbits(s) & 0xffffff00u) | code);
}
__device__ __forceinline__ void phase_topk(const Args& A, LAS unsigned char* lds) {
    using namespace tk;
    const int tid = threadIdx.x, lane = tid & 63, wave = __builtin_amdgcn_readfirstlane(tid >> 6), G = gridDim.x;
    const bf16* Q = (const bf16*)(A.ws + WS_PROJ); const bf16* KB = (const bf16*)(A.ws + WS_KEYS);
    unsigned short* EI = (unsigned short*)(A.ws + WS_EIDX); float* GT = (float*)(A.ws + WS_GATE);
    const int h = blockIdx.x & 7, r32 = lane & 31, hh = lane >> 5;
    __syncthreads();
    for (int e = tid; e < 2 * 128 * 16; e += NTHR) { const int s = e >> 11, row = (e >> 4) & 127, ch = e & 15;
        *(LAS v4u*)(lds + (s ? O_K2 : O_K1) + row * KS + ch * 16) = *(const GAS v4u*)(KB + (size_t)s * 8 * 128 * 128 + ((size_t)h * 128 + row) * 128 + ch * 8); }
    __syncthreads();
    LAS float* XW = (LAS float*)(lds + O_X + wave * 4096) + r32 * 32;
    for (int tile = (int)(blockIdx.x >> 3); tile < M / 256; tile += (G >> 3)) {
        const int t = tile * 256 + 32 * wave + r32;
        float T1[16], T2[16];
        topk_side<0>(Q, lds, t, h, r32, hh, T1);
        topk_side<1>(Q, lds, t, h, r32, hh, T2);
        float c[16], w[16];
        c[0] = cand_val<0>(T1, T2, hh); w[0] = cand_val<16>(T1, T2, hh);
        c[1] = cand_val<1>(T1, T2, hh); w[1] = cand_val<17>(T1, T2, hh);
        c[2] = cand_val<2>(T1, T2, hh); w[2] = cand_val<18>(T1, T2, hh);
        c[3] = cand_val<3>(T1, T2, hh); w[3] = cand_val<19>(T1, T2, hh);
        c[4] = cand_val<4>(T1, T2, hh); w[4] = cand_val<20>(T1, T2, hh);
        c[5] = cand_val<5>(T1, T2, hh); w[5] = cand_val<21>(T1, T2, hh);
        c[6] = cand_val<6>(T1, T2, hh); w[6] = cand_val<22>(T1, T2, hh);
        c[7] = cand_val<7>(T1, T2, hh); w[7] = cand_val<23>(T1, T2, hh);
        c[8] = cand_val<8>(T1, T2, hh); w[8] = cand_val<24>(T1, T2, hh);
        c[9] = cand_val<9>(T1, T2, hh); w[9] = cand_val<25>(T1, T2, hh);
        c[10] = cand_val<10>(T1, T2, hh); w[10] = cand_val<26>(T1, T2, hh);
        c[11] = cand_val<11>(T1, T2, hh); w[11] = cand_val<27>(T1, T2, hh);
        c[12] = cand_val<12>(T1, T2, hh); w[12] = cand_val<28>(T1, T2, hh);
        c[13] = cand_val<13>(T1, T2, hh); w[13] = cand_val<29>(T1, T2, hh);
        c[14] = cand_val<14>(T1, T2, hh); w[14] = cand_val<30>(T1, T2, hh);
        c[15] = cand_val<15>(T1, T2, hh); w[15] = cand_val<31>(T1, T2, hh);
        bsort16(c); bsort16(w); bmerge16(c, w);
#pragma unroll
        for (int r = 0; r < 16; ++r) w[r] = __shfl_xor(c[r], 32);
        bmerge16(c, w);
        if (hh == 0) {
#pragma unroll
            for (int q4 = 0; q4 < 4; ++q4) { *(LAS f32x4*)(XW + 4 * q4) = (f32x4){T1[4 * q4], T1[4 * q4 + 1], T1[4 * q4 + 2], T1[4 * q4 + 3]};
                *(LAS f32x4*)(XW + 16 + 4 * q4) = (f32x4){T2[4 * q4], T2[4 * q4 + 1], T2[4 * q4 + 2], T2[4 * q4 + 3]}; } }
        asm volatile("s_waitcnt lgkmcnt(0)" ::: "memory");
        float ex[16], sum = 0.f; const float tmax = bfloat(fbits(c[0]) & 0xffffff00u);
#pragma unroll
        for (int r = 0; r < 16; ++r) { ex[r] = __expf(bfloat(fbits(c[r]) & 0xffffff00u) - tmax); sum += ex[r]; }
        const float isum = 1.0f / sum; const size_t ob = (size_t)t * NSLOT + (size_t)(8 * hh) * 8 + h;
#pragma unroll
        for (int r = 0; r < 8; ++r) { float ca = c[r], cb = c[8 + r], ea = ex[r], eb = ex[8 + r]; asm volatile("" : "+v"(ca), "+v"(cb), "+v"(ea), "+v"(eb)); const float cv = hh ? cb : ca, ev = hh ? eb : ea;
            const unsigned code = fbits(cv) & 0xffu;
            const unsigned i1 = fbits(XW[code >> 4]) & 127u, i2 = fbits(XW[16 + (code & 15)]) & 127u;
            EI[ob + 8 * r] = (unsigned short)(i1 * 128u + i2); GT[ob + 8 * r] = ev * isum; }
        asm volatile("s_waitcnt lgkmcnt(0)" ::: "memory");
    }
}
struct PeerIdx { v4u e0, e1; };
__device__ __forceinline__ PeerIdx peer_ld_idx(const unsigned short* EI, int t, int g) { PeerIdx r; r.e0 = *(const GAS v4u*)(EI + (size_t)t * NSLOT + 16 * g); r.e1 = *(const GAS v4u*)(EI + (size_t)t * NSLOT + 16 * g + 8); return r; }
template <int ROWB = 1024> __device__ __forceinline__ void peer_gather(const unsigned char* T8, const PeerIdx& ix, int colb, v4u (&raw)[16]) {
    const unsigned ew[8] = {ix.e0.x, ix.e0.y, ix.e0.z, ix.e0.w, ix.e1.x, ix.e1.y, ix.e1.z, ix.e1.w};
#pragma unroll
    for (int k = 0; k < 16; ++k) { const unsigned e = (k & 1) ? (ew[k >> 1] >> 16) : (ew[k >> 1] & 0xffffu); raw[k] = *(const GAS v4u*)(T8 + (size_t)e * ROWB + colb); }
}
__device__ __forceinline__ void cvt16_fp8_pk(const v4u w, f32x2 (&o)[8]) {
    const unsigned ww[4] = {w.x, w.y, w.z, w.w};
#pragma unroll
    for (int i = 0; i < 4; ++i) { o[2 * i] = __builtin_amdgcn_cvt_pk_f32_fp8((int)ww[i], false); o[2 * i + 1] = __builtin_amdgcn_cvt_pk_f32_fp8((int)ww[i], true); }
}
__device__ __forceinline__ void peer_u_reduce(const v4u (&raw)[16], const f32x2 (&hv)[8], float* PDrow, int lane, int g, int c) {
    float d[16];
#pragma unroll
    for (int k = 0; k < 16; ++k) { f32x2 uf[8]; cvt16_fp8_pk(raw[k], uf); f32x2 s = uf[0] * hv[0];
#pragma unroll
        for (int i = 1; i < 8; ++i) s += uf[i] * hv[i];
        d[k] = s.x + s.y; }
#pragma unroll
    for (int i = 0; i < 8; ++i) { const bool up = (lane & 4) != 0; const float keep = up ? d[i + 8] : d[i], send = up ? d[i] : d[i + 8]; d[i] = keep + __shfl_xor(send, 4); }
#pragma unroll
    for (int i = 0; i < 4; ++i) { const bool up = (lane & 2) != 0; const float keep = up ? d[i + 4] : d[i], send = up ? d[i] : d[i + 4]; d[i] = keep + __shfl_xor(send, 2); }
#pragma unroll
    for (int i = 0; i < 2; ++i) { const bool up = (lane & 1) != 0; const float keep = up ? d[i + 2] : d[i], send = up ? d[i] : d[i + 2]; d[i] = keep + __shfl_xor(send, 1); }
    *(GAS f32x2*)(PDrow + 16 * g + 2 * c) = (f32x2){d[0], d[1]};
}
__device__ __forceinline__ void ld16bf_pk(const bf16* p, f32x2 (&o)[8]) {
    const v4u w0 = *(const GAS v4u*)p, w1 = *(const GAS v4u*)(p + 8); const unsigned ww[8] = {w0.x, w0.y, w0.z, w0.w, w1.x, w1.y, w1.z, w1.w};
#pragma unroll
    for (int i = 0; i < 8; ++i) o[i] = (f32x2){bflo(ww[i]), bfhi(ww[i])};
}
__device__ __forceinline__ void peer_u_reduce_i4(const v4u (&raw)[16], const v4u hh, const v4u hl, int* PDrow, int lane, int g, int c) {
    int d[16];
#pragma unroll
    for (int k = 0; k < 16; ++k) { int sh = __builtin_amdgcn_sdot8((int)raw[k].x, (int)hh.x, 0, false), sl = __builtin_amdgcn_sdot8((int)raw[k].x, (int)hl.x, 0, false);
        sh = __builtin_amdgcn_sdot8((int)raw[k].y, (int)hh.y, sh, false); sl = __builtin_amdgcn_sdot8((int)raw[k].y, (int)hl.y, sl, false);
        sh = __builtin_amdgcn_sdot8((int)raw[k].z, (int)hh.z, sh, false); sl = __builtin_amdgcn_sdot8((int)raw[k].z, (int)hl.z, sl, false);
        sh = __builtin_amdgcn_sdot8((int)raw[k].w, (int)hh.w, sh, false); sl = __builtin_amdgcn_sdot8((int)raw[k].w, (int)hl.w, sl, false);
        d[k] = 16 * sh + sl; }
#pragma unroll
    for (int i = 0; i < 8; ++i) { const bool up = (lane & 4) != 0; const int keep = up ? d[i + 8] : d[i], send = up ? d[i] : d[i + 8]; d[i] = keep + __shfl_xor(send, 4); }
#pragma unroll
    for (int i = 0; i < 4; ++i) { const bool up = (lane & 2) != 0; const int keep = up ? d[i + 4] : d[i], send = up ? d[i] : d[i + 4]; d[i] = keep + __shfl_xor(send, 2); }
#pragma unroll
    for (int i = 0; i < 2; ++i) { const bool up = (lane & 1) != 0; const int keep = up ? d[i + 2] : d[i], send = up ? d[i] : d[i + 2]; d[i] = keep + __shfl_xor(send, 1); }
    *(GAS v2u*)(PDrow + 16 * g + 2 * c) = (v2u){(unsigned)d[0], (unsigned)d[1]};
}
__device__ __forceinline__ void phase_peer_u(const Args& A) {
    const int tid = threadIdx.x, lane = tid & 63, wave = tid >> 6, p = blockIdx.x & 7, q = p & 3, half = p >> 2, j = blockIdx.x >> 3, nj = gridDim.x >> 3, g = lane >> 3, c = lane & 7;
    const unsigned char* HH = (const unsigned char*)(A.ws + WS_H8); const unsigned char* HL = HH + 32 * MiB; const unsigned char* U4 = (const unsigned char*)(A.ws + WS_U8); const unsigned short* EI = (const unsigned short*)(A.ws + WS_EIDX);
    int* PD = (int*)(A.ws + WS_PD) + (size_t)q * M * NSLOT;
    const int tper = (M / 2) / nj, colb = 128 * q + 16 * c, tbeg = half * (M / 2) + j * tper, tend = tbeg + tper, tlast = tend - NWAVES + wave;
    int t = tbeg + wave;
    PeerIdx ix1 = peer_ld_idx(EI, min(t + NWAVES, tlast), g), ix2 = peer_ld_idx(EI, min(t + 2 * NWAVES, tlast), g);
    v4u rawa[16], rawb[16], hha, hla, hhb, hlb;
    { const PeerIdx ix0 = peer_ld_idx(EI, t, g); peer_gather<512>(U4, ix0, colb, rawa); hha = *(const GAS v4u*)(HH + (size_t)t * 512 + colb); hla = *(const GAS v4u*)(HL + (size_t)t * 512 + colb); }
    for (; t < tend; t += 2 * NWAVES) {
        const int t1 = t + NWAVES, t2 = min(t + 2 * NWAVES, tlast), t3 = min(t + 3 * NWAVES, tlast), t4 = min(t + 4 * NWAVES, tlast);
        const PeerIdx ix3 = peer_ld_idx(EI, t3, g);
        peer_gather<512>(U4, ix1, colb, rawb); hhb = *(const GAS v4u*)(HH + (size_t)t1 * 512 + colb); hlb = *(const GAS v4u*)(HL + (size_t)t1 * 512 + colb);
        peer_u_reduce_i4(rawa, hha, hla, PD + (size_t)t * NSLOT, lane, g, c);
        const PeerIdx ix4 = peer_ld_idx(EI, t4, g);
        peer_gather<512>(U4, ix2, colb, rawa); hha = *(const GAS v4u*)(HH + (size_t)t2 * 512 + colb); hla = *(const GAS v4u*)(HL + (size_t)t2 * 512 + colb);
        peer_u_reduce_i4(rawb, hhb, hlb, PD + (size_t)t1 * NSLOT, lane, g, c);
        ix1 = ix3; ix2 = ix4;
    }
}
__device__ __forceinline__ void phase_peer_act(const Args& A) {
    const int* PD = (const int*)(A.ws + WS_PD); const unsigned short* EI = (const unsigned short*)(A.ws + WS_EIDX); const float* GT = (const float*)(A.ws + WS_GATE);
    const float* usc = (const float*)(A.ws + WS_SC); const float* vsc = usc + NEXP; const float* hs = (const float*)(A.ws + WS_HS); float* ACT = (float*)(A.ws + WS_ACT);
    typedef int i32x4 __attribute__((ext_vector_type(4)));
    for (size_t i = ((size_t)blockIdx.x * NTHR + threadIdx.x) * 4; i < (size_t)M * NSLOT; i += (size_t)gridDim.x * NTHR * 4) {
        const i32x4 p0 = *(const GAS i32x4*)(PD + i), p1 = *(const GAS i32x4*)(PD + (size_t)M * NSLOT + i), p2 = *(const GAS i32x4*)(PD + (size_t)2 * M * NSLOT + i), p3 = *(const GAS i32x4*)(PD + (size_t)3 * M * NSLOT + i);
        const v2u ew = *(const GAS v2u*)(EI + i); const f32x4 gt = *(const GAS f32x4*)(GT + i); const float hsv = hs[i >> 7];
        const unsigned e[4] = {ew.x & 0xffffu, ew.x >> 16, ew.y & 0xffffu, ew.y >> 16};
        const i32x4 si = (p0 + p1) + (p2 + p3); f32x4 o;
#pragma unroll
        for (int k = 0; k < 4; ++k) { const float s = (float)si[k] * (usc[e[k]] * hsv); o[k] = 0.5f * s * (1.f + erff(s * 0.70710678118654752f)) * gt[k] * vsc[e[k]]; }
        *(GAS f32x4*)(ACT + i) = o;
    }
}
struct PeerAct { f32x4 a0, a1, a2, a3; };
__device__ __forceinline__ PeerAct peer_ld_act(const float* ACT, int t, int g) { const GAS f32x4* ap = (const GAS f32x4*)(ACT + (size_t)t * NSLOT + 16 * g); PeerAct r; r.a0 = ap[0]; r.a1 = ap[1]; r.a2 = ap[2]; r.a3 = ap[3]; return r; }
__device__ __forceinline__ void peer_v_accum(const v4u (&raw)[16], const PeerAct& pa, f32x2 (&y2)[16]) {
    const float av[16] = {pa.a0[0], pa.a0[1], pa.a0[2], pa.a0[3], pa.a1[0], pa.a1[1], pa.a1[2], pa.a1[3], pa.a2[0], pa.a2[1], pa.a2[2], pa.a2[3], pa.a3[0], pa.a3[1], pa.a3[2], pa.a3[3]};
#pragma unroll
    for (int k = 0; k < 16; ++k) { const unsigned ww[4] = {raw[k].x, raw[k].y, raw[k].z, raw[k].w}; const f32x2 a2 = (f32x2){av[k], av[k]};
#pragma unroll
        for (int w = 0; w < 4; ++w) { y2[4 * w + 0] += a2 * __builtin_amdgcn_cvt_scalef32_pk_f32_fp4(ww[w], 1.0f, 0); y2[4 * w + 1] += a2 * __builtin_amdgcn_cvt_scalef32_pk_f32_fp4(ww[w], 1.0f, 1);
            y2[4 * w + 2] += a2 * __builtin_amdgcn_cvt_scalef32_pk_f32_fp4(ww[w], 1.0f, 2); y2[4 * w + 3] += a2 * __builtin_amdgcn_cvt_scalef32_pk_f32_fp4(ww[w], 1.0f, 3); } }
}
__device__ __forceinline__ void peer_v_store(f32x2 (&y2)[16], bf16* Yp, float* ssy, int c) {
    float ss = 0.f; unsigned w[16];
#pragma unroll
    for (int i = 0; i < 16; ++i) { ss += y2[i].x * y2[i].x + y2[i].y * y2[i].y; w[i] = pk2(y2[i].x, y2[i].y); y2[i] = (f32x2){0.f, 0.f}; }
#pragma unroll
    for (int i = 0; i < 4; ++i) *(GAS v4u*)(Yp + 8 * i) = (v4u){w[4 * i], w[4 * i + 1], w[4 * i + 2], w[4 * i + 3]};
    ss += __shfl_xor(ss, 1); ss += __shfl_xor(ss, 2); ss += __shfl_xor(ss, 4);
    if (c == 0) *ssy = ss;
}
__device__ __forceinline__ void phase_peer_v(const Args& A) {
    const int tid = threadIdx.x, lane = tid & 63, wave = tid >> 6, p = blockIdx.x & 7, q = p & 3, half = p >> 2, j = blockIdx.x >> 3, nj = gridDim.x >> 3, g = lane >> 3, c = lane & 7;
    const unsigned char* V4 = (const unsigned char*)(A.ws + WS_V8); const unsigned short* EI = (const unsigned short*)(A.ws + WS_EIDX); const float* ACT = (const float*)(A.ws + WS_ACT);
    bf16* Y = (bf16*)(A.ws + WS_H); float* SSY = (float*)(A.ws + WS_SSY);
    const int tper = (M / 2) / nj, colb = 128 * q + 16 * c, tbeg = half * (M / 2) + j * tper + wave * (tper / NWAVES);
    const int nstep = (tper / NWAVES / 8) * 8;
    auto rowof = [&](int s) { s = min(s, nstep - 1); return (size_t)(tbeg + 8 * (s >> 3) + g) * 8 + (s & 7); };
    f32x2 y2[16];
#pragma unroll
    for (int i = 0; i < 16; ++i) y2[i] = (f32x2){0.f, 0.f};
    auto ldidx = [&](int s) { const size_t r = rowof(s); PeerIdx x; x.e0 = *(const GAS v4u*)(EI + r * 16); x.e1 = *(const GAS v4u*)(EI + r * 16 + 8); return x; };
    auto ldact = [&](int s) { const GAS f32x4* ap = (const GAS f32x4*)(ACT + rowof(s) * 16); PeerAct r; r.a0 = ap[0]; r.a1 = ap[1]; r.a2 = ap[2]; r.a3 = ap[3]; return r; };
    PeerIdx ix1 = ldidx(1), ix2 = ldidx(2);
    v4u rawa[16], rawb[16]; PeerAct aca, acb;
    { const PeerIdx ix0 = ldidx(0); peer_gather<512>(V4, ix0, colb, rawa); aca = ldact(0); }
    for (int s = 0; s < nstep; s += 2) {
        const PeerIdx ix3 = ldidx(s + 3);
        peer_gather<512>(V4, ix1, colb, rawb); acb = ldact(s + 1);
        peer_v_accum(rawa, aca, y2);
        const PeerIdx ix4 = ldidx(s + 4);
        peer_gather<512>(V4, ix2, colb, rawa); aca = ldact(s + 2);
        peer_v_accum(rawb, acb, y2);
        if ((s & 7) == 6) { const int t = tbeg + 8 * (s >> 3) + g; peer_v_store(y2, Y + (size_t)t * D + 256 * q + 32 * c, SSY + (size_t)t * 8 + q, c); }
        ix1 = ix3; ix2 = ix4;
    }
}
__device__ __forceinline__ void phase_peer_final(const Args& A) {
    const int tid = threadIdx.x, lane = tid & 63, wave = tid >> 6, G = gridDim.x;
    const bf16* Y = (const bf16*)(A.ws + WS_H); const bf16* X1 = (const bf16*)(A.ws + WS_X1); const float* SSY = (const float*)(A.ws + WS_SSY); const float* mod = (const float*)(A.ws + WS_MOD); const float* gpost = (const float*)A.in[I_GPOST2]; float* out = A.out;
    f32x4 gp[4];
#pragma unroll
    for (int q = 0; q < 4; ++q) gp[q] = *(const GAS f32x4*)(gpost + 4 * (lane + 64 * q));
    const int stride = G * NWAVES; int row = blockIdx.x * NWAVES + wave;
    v2u xw[4], yw[4], xwn[4], ywn[4]; f32x4 s0, s0n, g2p[4]; int bcur = -1;
#pragma unroll
    for (int q = 0; q < 4; ++q) { xw[q] = ((const GAS v2u*)(X1 + (size_t)row * D) + lane)[64 * q]; yw[q] = ((const GAS v2u*)(Y + (size_t)row * D) + lane)[64 * q]; }
    s0 = *(const GAS f32x4*)(SSY + (size_t)row * 8);
    for (; row < M; row += stride) {
        const int rn = min(row + stride, M - 1);
#pragma unroll
        for (int q = 0; q < 4; ++q) { xwn[q] = ((const GAS v2u*)(X1 + (size_t)rn * D) + lane)[64 * q]; ywn[q] = ((const GAS v2u*)(Y + (size_t)rn * D) + lane)[64 * q]; }
        s0n = *(const GAS f32x4*)(SSY + (size_t)rn * 8);
        const int b = row / SEQ;
        if (b != bcur) { bcur = b;
#pragma unroll
            for (int q = 0; q < 4; ++q) { const f32x4 g2 = *(const GAS f32x4*)(mod + b * 6144 + 5120 + 4 * (lane + 64 * q));
#pragma unroll
                for (int i = 0; i < 4; ++i) g2p[q][i] = g2[i] * gp[q][i]; } }
        const float rstd = 1.0f / sqrtf(((s0[0] + s0[1]) + (s0[2] + s0[3])) * (1.f / D) + EPS);
        GAS f32x4* orow = (GAS f32x4*)(out + (size_t)row * D) + lane;
#pragma unroll
        for (int q = 0; q < 4; ++q) { f32x4 xv = {bflo(xw[q].x), bfhi(xw[q].x), bflo(xw[q].y), bfhi(xw[q].y)};
            xv[0] += g2p[q][0] * (bflo(yw[q].x) * rstd); xv[1] += g2p[q][1] * (bfhi(yw[q].x) * rstd); xv[2] += g2p[q][2] * (bflo(yw[q].y) * rstd); xv[3] += g2p[q][3] * (bfhi(yw[q].y) * rstd);
            orow[64 * q] = xv; }
#pragma unroll
        for (int q = 0; q < 4; ++q) { xw[q] = xwn[q]; yw[q] = ywn[q]; }
        s0 = s0n;
    }
}
#ifdef PROBE_V_LOADS
__device__ __forceinline__ void probe_v_loads(const Args& A) {
    const int tid = threadIdx.x, lane = tid & 63, wave = tid >> 6, p = blockIdx.x & 7, j = blockIdx.x >> 3, nj = gridDim.x >> 3, g = lane >> 3, c = lane & 7;
    const unsigned char* V8 = (const unsigned char*)(A.ws + WS_V8); const unsigned short* EI = (const unsigned short*)(A.ws + WS_EIDX); const float* ACT = (const float*)(A.ws + WS_ACT);
    unsigned* DUMP = (unsigned*)(A.ws + WS_PD);
    const int tper = M / nj, colb = 128 * p + 16 * c, tend = (j + 1) * tper, tlast = tend - NWAVES + wave;
    int t = j * tper + wave;
    PeerIdx ix1 = peer_ld_idx(EI, min(t + NWAVES, tlast), g), ix2 = peer_ld_idx(EI, min(t + 2 * NWAVES, tlast), g);
    v4u rawa[16], rawb[16]; PeerAct aca, acb;
    { const PeerIdx ix0 = peer_ld_idx(EI, t, g); peer_gather(V8, ix0, colb, rawa); aca = peer_ld_act(ACT, t, g); }
    for (; t < tend; t += 2 * NWAVES) {
        const int t1 = t + NWAVES, t2 = min(t + 2 * NWAVES, tlast), t3 = min(t + 3 * NWAVES, tlast), t4 = min(t + 4 * NWAVES, tlast);
        const PeerIdx ix3 = peer_ld_idx(EI, t3, g);
        peer_gather(V8, ix1, colb, rawb); acb = peer_ld_act(ACT, t1, g);
        { unsigned s = __builtin_bit_cast(unsigned, aca.a0[0]) + __builtin_bit_cast(unsigned, aca.a3[3]);
#pragma unroll
          for (int k = 0; k < 16; ++k) s += (rawa[k].x + rawa[k].y) + (rawa[k].z + rawa[k].w);
          DUMP[(size_t)t * 512 + p * 64 + lane] = s; }
        const PeerIdx ix4 = peer_ld_idx(EI, t4, g);
        peer_gather(V8, ix2, colb, rawa); aca = peer_ld_act(ACT, t2, g);
        { unsigned s = __builtin_bit_cast(unsigned, acb.a0[0]) + __builtin_bit_cast(unsigned, acb.a3[3]);
#pragma unroll
          for (int k = 0; k < 16; ++k) s += (rawb[k].x + rawb[k].y) + (rawb[k].z + rawb[k].w);
          DUMP[(size_t)t1 * 512 + p * 64 + lane] = s; }
        ix1 = ix3; ix2 = ix4;
    }
}
#endif

#ifdef PROBE_INSTR
__device__ __forceinline__ void probe_instr(const Args& A) {
    f32x2 a[8]; float f[16]; unsigned w = threadIdx.x * 0x01010101u + 0x38383838u;
#pragma unroll
    for (int i = 0; i < 8; ++i) a[i] = (f32x2){1.0f + i, 2.0f + i};
#pragma unroll
    for (int i = 0; i < 16; ++i) f[i] = 1.0f + i;
    for (int it = 0; it < 10000; ++it) {
#if PROBE_INSTR == 1
#pragma unroll
        for (int i = 0; i < 8; ++i) { asm volatile("v_pk_fma_f32 %0, %1, %2, %0" : "+v"(a[i]) : "v"(a[(i + 1) & 7]), "v"(a[(i + 2) & 7])); asm volatile("v_pk_fma_f32 %0, %1, %2, %0" : "+v"(a[i]) : "v"(a[(i + 3) & 7]), "v"(a[(i + 4) & 7])); }
#elif PROBE_INSTR == 2
#pragma unroll
        for (int i = 0; i < 16; ++i) asm volatile("v_fma_f32 %0, %1, %2, %0" : "+v"(f[i]) : "v"(f[(i + 1) & 15]), "v"(f[(i + 2) & 15]));
#elif PROBE_INSTR == 3
#pragma unroll
        for (int i = 0; i < 8; ++i) { asm volatile("v_cvt_pk_f32_fp8 %0, %1" : "=v"(a[i]) : "v"(w)); asm volatile("v_cvt_pk_f32_fp8 %0, %1" : "=v"(a[i]) : "v"(w)); }
#elif PROBE_INSTR == 4
#pragma unroll
        for (int i = 0; i < 8; ++i) { asm volatile("v_cvt_scalef32_pk_f32_fp4 %0, %1, 1.0" : "=v"(a[i]) : "v"(w)); asm volatile("v_cvt_scalef32_pk_f32_fp4 %0, %1, 1.0" : "=v"(a[i]) : "v"(w)); }
#elif PROBE_INSTR == 5
#pragma unroll
        for (int i = 0; i < 16; ++i) asm volatile("v_pk_fma_f16 %0, %1, %2, %0" : "+v"(f[i]) : "v"(f[(i + 1) & 15]), "v"(f[(i + 2) & 15]));
#elif PROBE_INSTR == 7
#pragma unroll
        for (int i = 0; i < 16; ++i) asm volatile("v_dot8c_i32_i4 %0, %1, %2" : "+v"(f[i]) : "v"(f[(i + 1) & 15]), "v"(w));
#elif PROBE_INSTR == 8
#pragma unroll
        for (int i = 0; i < 16; ++i) asm volatile("v_dot4c_i32_i8 %0, %1, %2" : "+v"(f[i]) : "v"(f[(i + 1) & 15]), "v"(w));
#elif PROBE_INSTR == 9
#pragma unroll
        for (int i = 0; i < 16; ++i) asm volatile("v_perm_b32 %0, %1, %2, %3" : "=v"(f[i]) : "v"(f[(i + 1) & 15]), "v"(f[(i + 2) & 15]), "v"(w));
#elif PROBE_INSTR == 10
#pragma unroll
        for (int i = 0; i < 16; ++i) asm volatile("v_mfma_f32_16x16x32_fp8_fp8 %0, %1, %2, %0" : "+v"(*(f32x4*)&f[4 * (i & 3)]) : "v"(a[i & 7]), "v"(a[(i + 1) & 7]));
#elif PROBE_INSTR == 6
#pragma unroll
        for (int i = 0; i < 16; ++i) asm volatile("v_cvt_scalef32_pk_f16_fp4 %0, %1, 1.0" : "=v"(f[i]) : "v"(w));
#endif
    }
    float s = 0.f;
#pragma unroll
    for (int i = 0; i < 8; ++i) s += a[i].x + a[i].y;
#pragma unroll
    for (int i = 0; i < 16; ++i) s += f[i];
    if (s == 123.456f) ((float*)(A.ws + WS_PD))[threadIdx.x] = s;
}
#endif
#ifndef MK_N_LAUNCHES
#define MK_N_LAUNCHES 1
#endif
constexpr int N_PHASES = 13;
typedef const __attribute__((address_space(4))) Args* KArgP;
__device__ __forceinline__ const Args& kargs() { KArgP p = (KArgP)__builtin_amdgcn_kernarg_segment_ptr(); asm volatile("" : "+s"(p)); return *(const Args*)p; }
__global__ void __launch_bounds__(NTHR, 2) hymba_fwd(Args A_) {
    extern __shared__ __attribute__((aligned(16))) unsigned char lds_raw[];
    LAS unsigned char* lds = (LAS unsigned char*)lds_raw;
    const int lo = A_.ph_lo, hi = A_.ph_hi;
#define A kargs()
#define ws (kargs().ws)
#ifndef DBLMASK
#define DBLMASK 0
#endif
#ifndef ONLYMASK
#define ONLYMASK 0xffff
#endif
#define IN(k) ((((ONLYMASK) >> (k)) & 1) && lo <= (k) && (k) < hi)
#define REP(k) for (int _rep = 0; _rep < (((DBLMASK) >> (k)) & 1) + 1; ++_rep)
    for (int u = threadIdx.x; u < (LDS_BYTES - RING_BYTES) / 4; u += NTHR) ((LAS unsigned*)(lds + RING_BYTES))[u] = 0u;
    __syncthreads();
    XcdBarrier xbar = xcd_barrier_post((unsigned*)(ws + WS_CTL) + CW_BAR, (volatile LAS unsigned*)(lds + MISC_OFF + 32));
#define SEAM(k) do { if (IN(k) && IN((k) + 1)) { if ((k) == 0) cg::this_grid().sync(); else xcd_barrier(xbar); } } while (0)

    if (IN(0)) REP(0) { phase_mod(A, lds); } SEAM(0);
    if (IN(1)) REP(1) { phase_convert(A, lds); phase_prenorm(A, lds); } SEAM(1);
    if (IN(2)) REP(2) {
        pg8::Gemm g{(const pg8::bf16_t*)(ws + WS_H), (const pg8::bf16_t*)(ws + WS_WIN), M, NPROJ, D}; pg8::StaticOrder S; S.init(M, NPROJ, gridDim.x, (int)blockIdx.x);
        pg8::EpiProj E{(pg8::bf16_t*)(ws + WS_PROJ), NPROJ, (float*)(ws + WS_GATES), (const int*)A.in[I_POS], (const float*)A.in[I_BI], (const float*)A.in[I_BF]};
        pg8::gemm_phase<pg8::EpiProj, pg8::StaticOrder, true, true>(lds, g, S, E);
    } SEAM(2);
    if (IN(3)) REP(3) {
        phase_attn(A, lds);
        for (int wg = blockIdx.x; wg < 256; wg += gridDim.x) mlstm_group<false>(A, lds, wg);
    } SEAM(3);
    if (IN(4)) REP(4) { for (int wg = blockIdx.x; wg < 256; wg += gridDim.x) mlstm_group<true>(A, lds, wg); } SEAM(4);
    if (IN(5)) REP(5) {
        pg8::Gemm g{(const pg8::bf16_t*)(ws + WS_MIXIN), (const pg8::bf16_t*)(ws + WS_WOUT), M, D, D}; pg8::StaticOrder S; S.init(M, D, gridDim.x, (int)blockIdx.x);
        pg8::EpiMix E{(pg8::bf16_t*)(ws + WS_MIX), D, (float*)(ws + WS_SSQ)};
        pg8::gemm_phase<pg8::EpiMix, pg8::StaticOrder, true, true>(lds, g, S, E);
    } SEAM(5);
    if (IN(6)) REP(6) { phase_mid(A); } SEAM(6);
    if (IN(7)) REP(7) {
        pg8::Gemm g{(const pg8::bf16_t*)(ws + WS_H), (const pg8::bf16_t*)(ws + WS_WQ), M, 2048, D}; pg8::StaticOrder S; S.init(M, 2048, gridDim.x, (int)blockIdx.x);
        pg8::EpiPlain E{(pg8::bf16_t*)(ws + WS_PROJ), 2048};
        pg8::gemm_phase<pg8::EpiPlain, pg8::StaticOrder, true, true>(lds, g, S, E);
    } SEAM(7);
    if (IN(8)) REP(8) { phase_topk(A, lds); } SEAM(8);
    if (IN(9)) REP(9) { phase_peer_u(A); } SEAM(9);
    if (IN(10)) REP(10) { phase_peer_act(A); } SEAM(10);
#ifdef PROBE_INSTR
    if (IN(11)) { probe_instr(A); }
#endif
#ifdef PROBE_V_LOADS
    if (IN(11)) { probe_v_loads(A); }
#endif
    if (IN(11)) REP(11) { phase_peer_v(A); } SEAM(11);
    if (IN(12)) REP(12) { phase_peer_final(A); }
#undef IN
#undef SEAM
#undef A
#undef ws
}

extern "C" void kernel_launch(void* const* d_in, const int* in_sizes, int n_in, void* d_out, int out_size, void* d_ws, size_t ws_size, hipStream_t stream) {
    static int grid = 0;
    if (grid == 0) {
        if (n_in != 21 || in_sizes[0] != M * D || out_size != M * D || ws_size < WS_END) { fprintf(stderr, "kernel_launch: unexpected shapes (n_in %d, in0 %d, out %d, ws %zu < %zu)\n", n_in, n_in > 0 ? in_sizes[0] : -1, out_size, ws_size, (size_t)WS_END); grid = -1; return; }
        int dev = 0, cus = 0, per_cu = 0;
        if (hipGetDevice(&dev) != hipSuccess || hipDeviceGetAttribute(&cus, hipDeviceAttributeMultiprocessorCount, dev) != hipSuccess) { grid = -1; return; }
        if (hipFuncSetAttribute((const void*)hymba_fwd, hipFuncAttributeMaxDynamicSharedMemorySize, LDS_BYTES) != hipSuccess) { fprintf(stderr, "kernel_launch: hipFuncSetAttribute failed\n"); grid = -1; return; }
        if (hipOccupancyMaxActiveBlocksPerMultiprocessor(&per_cu, (const void*)hymba_fwd, NTHR, LDS_BYTES) != hipSuccess || per_cu < 1) { fprintf(stderr, "kernel_launch: occupancy query says %d blocks per CU\n", per_cu); per_cu = 1; }
        (void)hipGetLastError();
        grid = cus;
        if (grid != 256) fprintf(stderr, "kernel_launch: note: %d CUs (built for 256)\n", grid);
    }
    if (grid < 0) return;
    (void)hipMemsetAsync((char*)d_ws + WS_CTL, 0, CTL_ZERO_BYTES, stream);
    Args a{};
    for (int i = 0; i < 21; ++i) a.in[i] = d_in[i];
    a.out = (float*)d_out; a.ws = (unsigned char*)d_ws;
    if (MK_N_LAUNCHES == 1) {
        a.ph_lo = 0; a.ph_hi = N_PHASES;
        void* args[] = {&a};
        const hipError_t e = hipLaunchCooperativeKernel((const void*)hymba_fwd, dim3(grid), dim3(NTHR), args, LDS_BYTES, stream);
        if (e != hipSuccess) fprintf(stderr, "kernel_launch: cooperative launch failed: %s (grid %d)\n", hipGetErrorString(e), grid);
    } else {
        for (int p = 0; p < N_PHASES; ++p) { a.ph_lo = p; a.ph_hi = p + 1; hipLaunchKernelGGL(hymba_fwd, dim3(grid), dim3(NTHR), LDS_BYTES, stream, a); }
    }
}
```

```cpp
#include <hip/hip_runtime.h>
#include <hip/hip_cooperative_groups.h>
#include <cstdio>
#include <cstdint>
namespace cg = cooperative_groups;
namespace pg8 {
#define PG8_LAS __attribute__((address_space(3)))
typedef unsigned short bf16_t;
typedef short bf16x8 __attribute__((ext_vector_type(8)));
typedef float f32x4 __attribute__((ext_vector_type(4)));
typedef unsigned u32x4 __attribute__((ext_vector_type(4)));
constexpr int BM = 256, BK = 64, HALF = 128, HTB = HALF * BK * 2  , STAGE_BYTES = 8 * HTB, NXCD = 8, WGM = 8;

__host__ __device__ __forceinline__ int lds_byte(int r, int c) { const int st = (r >> 4) * 2 + (c >> 5), rr = r & 15, cc = c & 31, ob = rr * 64 + cc * 2; return st * 1024 + (ob ^ (((ob >> 9) & 1) << 5)); }
__host__ __device__ __forceinline__ void stage_rc(int b, int& R, int& C) { const int st = b / 1024, sb = b % 1024, swz = sb ^ (((sb >> 9) & 1) << 5); R = (st >> 1) * 16 + swz / 64; C = (st & 1) * 32 + (swz % 64) / 2; }
__host__ __device__ __forceinline__ int perm32(int rho) { const int n = rho >> 4, i = rho & 15; return 8 * (i >> 2) + 4 * n + (i & 3); }

struct Unit { int pm, pn; };
struct Gemm { const bf16_t* A; const bf16_t* Bt; int M, N, K; };

struct StaticOrder {
    int nM, nN, nwg, G, c;
    __host__ __device__ void init(int M, int N, int G_, int c_) { nM = M / BM; nN = N / BM; nwg = nM * nN; G = G_; c = c_; }
    __host__ __device__ bool next(int i, Unit& u) const {
        const long L = (long)i * G + c; if (L >= nwg) return false;
        int wgid = (int)L; { const int q = nwg / NXCD, r = nwg % NXCD, xcd = wgid % NXCD, off = wgid / NXCD; wgid = (xcd < r ? xcd * (q + 1) : r * (q + 1) + (xcd - r) * q) + off; }
        const int nig = WGM * nN, gid = wgid / nig, fm = gid * WGM, gsz = (nM - fm) < WGM ? (nM - fm) : WGM;
        u.pm = fm + ((wgid % nig) % gsz); u.pn = (wgid % nig) / gsz; return true;
    }
    __device__ __forceinline__ void a_ready(const Unit&) const {}
    __device__ __forceinline__ void done(const Unit&) const {}
};

__device__ __forceinline__ unsigned cvt_pk_bf16(float lo, float hi) { unsigned r; asm volatile("v_cvt_pk_bf16_f32 %0, %1, %2" : "=v"(r) : "v"(lo), "v"(hi)); return r; }
typedef float f32x2 __attribute__((ext_vector_type(2)));
__device__ __forceinline__ f32x2 gelu_pk(f32x2 v) {
    const f32x2 av = __builtin_elementwise_abs(v), d = av * 0.2316418882f + 1.0f;
    f32x2 t; t.x = __builtin_amdgcn_rcpf(d.x); t.y = __builtin_amdgcn_rcpf(d.y);
    f32x2 q = t * 0.5307027145f + (-0.7265760135f); q = q * t + 0.7107068705f; q = q * t + (-0.142248368f); q = q * t + 0.127414796f; q = q * t;
    const f32x2 s = (v * v) * (-0.72134752044f);
    f32x2 e; e.x = __builtin_amdgcn_exp2f(s.x); e.y = __builtin_amdgcn_exp2f(s.y);
    const f32x2 m = v * (q * e), r = v - m;
    f32x2 o; o.x = v.x < 0.f ? m.x : r.x; o.y = v.y < 0.f ? m.y : r.y; return o;
}

__device__ __forceinline__ u32x4 pack8(const f32x4 v0, const f32x4 v1) { u32x4 w; w.x = cvt_pk_bf16(v0[0], v0[1]); w.y = cvt_pk_bf16(v0[2], v0[3]); w.z = cvt_pk_bf16(v1[0], v1[1]); w.w = cvt_pk_bf16(v1[2], v1[3]); return w; }

struct EpiPlain {
    static constexpr bool PERM = true, AFTER_DRAIN = false;
    bf16_t* O; int ldc;
    __device__ __forceinline__ void operator()(const f32x4 (&acc)[2][2][4][2], const Unit& u, int wr, int wc, int fr, int fq) const {
        const int row0 = u.pm * BM + wr * 64 + fr, col0 = u.pn * BM + wc * 32 + 8 * fq;
#pragma unroll
        for (int ai = 0; ai < 2; ++ai)
#pragma unroll
            for (int m = 0; m < 4; ++m) { bf16_t* rowp = O + (size_t)(row0 + ai * HALF + m * 16) * ldc + col0;
#pragma unroll
                for (int bj = 0; bj < 2; ++bj) *(u32x4*)(rowp + bj * HALF) = pack8(acc[ai][bj][m][0], acc[ai][bj][m][1]); }
    }
};

struct EpiProj {
    static constexpr bool PERM = true, AFTER_DRAIN = false;
    bf16_t* P; int ldc; float* gates; const int* pos; const float* b_i; const float* b_f;
    __device__ __forceinline__ void operator()(const f32x4 (&acc)[2][2][4][2], const Unit& u, int wr, int wc, int fr, int fq) const {
        const int row0 = u.pm * BM + wr * 64 + fr, col0 = u.pn * BM + wc * 32 + 8 * fq, pn = u.pn;
        if (pn == 9) {
            if (wc == 0 && fq == 0) {
                const f32x4 bi = {b_i[0], b_i[1], b_i[2], b_i[3]}, bf = {b_f[0], b_f[1], b_f[2], b_f[3]};
#pragma unroll
                for (int ai = 0; ai < 2; ++ai)
#pragma unroll
                    for (int m = 0; m < 4; ++m) { const int row = row0 + ai * HALF + m * 16;
                        const f32x4 iv = acc[ai][0][m][0] + bi, fv = acc[ai][0][m][1] + bf; f32x4 lf;
#pragma unroll
                        for (int j = 0; j < 4; ++j) lf[j] = fminf(fv[j], 0.f) - log1pf(__expf(-fabsf(fv[j])));
                        *(f32x4*)(gates + (size_t)row * 8) = iv; *(f32x4*)(gates + (size_t)row * 8 + 4) = lf; }
            }
            return;
        }
#pragma unroll
        for (int ai = 0; ai < 2; ++ai)
#pragma unroll
            for (int m = 0; m < 4; ++m) { const int row = row0 + ai * HALF + m * 16; bf16_t* rowp = P + (size_t)row * ldc + col0;
                const float posf = (pn <= 2) ? (float)pos[row] : 0.f;
#pragma unroll
                for (int bj = 0; bj < 2; ++bj) { f32x4 v0 = acc[ai][bj][m][0], v1 = acc[ai][bj][m][1];
                    const bool rope = (pn < 2) || (pn == 2 && bj == 0);
                    if (rope) {
                        const int p0 = ((col0 + bj * HALF) & 63) >> 1; const float sc = (pn < 2) ? 0.125f : 1.0f;
                        float x[8] = {v0[0], v0[1], v0[2], v0[3], v1[0], v1[1], v1[2], v1[3]};
#pragma unroll
                        for (int q = 0; q < 4; ++q) { const float invf = __builtin_amdgcn_exp2f(-(float)(p0 + q) * 0.41524101186092029f);
                            float r = posf * invf * 0.15915494309189535f; r = r - floorf(r);
                            const float c = __builtin_amdgcn_cosf(r) * sc, s = __builtin_amdgcn_sinf(r) * sc;
                            const float x1 = x[2 * q], x2 = x[2 * q + 1]; x[2 * q] = x1 * c - x2 * s; x[2 * q + 1] = x2 * c + x1 * s; }
                        v0 = (f32x4){x[0], x[1], x[2], x[3]}; v1 = (f32x4){x[4], x[5], x[6], x[7]};
                    } else if (pn >= 7) {
#pragma unroll
                        for (int j = 0; j < 4; ++j) { v0[j] = __builtin_amdgcn_rcpf(1.f + __expf(-v0[j])); v1[j] = __builtin_amdgcn_rcpf(1.f + __expf(-v1[j])); }
                    }
                    *(u32x4*)(rowp + bj * HALF) = pack8(v0, v1); } }
    }
};

struct EpiMix {
    static constexpr bool PERM = true, AFTER_DRAIN = false;
    bf16_t* O; int ldc; float* sumsq;
    __device__ __forceinline__ void operator()(const f32x4 (&acc)[2][2][4][2], const Unit& u, int wr, int wc, int fr, int fq) const {
        const int row0 = u.pm * BM + wr * 64 + fr, col0 = u.pn * BM + wc * 32 + 8 * fq;
#pragma unroll
        for (int ai = 0; ai < 2; ++ai)
#pragma unroll
            for (int m = 0; m < 4; ++m) { const int row = row0 + ai * HALF + m * 16; bf16_t* rowp = O + (size_t)row * ldc + col0; float s = 0.f;
#pragma unroll
                for (int bj = 0; bj < 2; ++bj) { const f32x4 v0 = acc[ai][bj][m][0], v1 = acc[ai][bj][m][1];
                    s += (v0[0] * v0[0] + v0[1] * v0[1]) + (v0[2] * v0[2] + v0[3] * v0[3]) + (v1[0] * v1[0] + v1[1] * v1[1]) + (v1[2] * v1[2] + v1[3] * v1[3]);
                    *(u32x4*)(rowp + bj * HALF) = pack8(v0, v1); }
                s += __shfl_xor(s, 16); s += __shfl_xor(s, 32);
                if (fq == 0) sumsq[(size_t)row * 16 + u.pn * 4 + wc] = s; }
    }
};
template <class Epi, class Sched, bool ALIGN_EPI = false, bool SP2 = false>
__device__ __forceinline__ void gemm_phase(PG8_LAS unsigned char* lds, const Gemm g, const Sched& S, const Epi& E) {
    const int tid = threadIdx.x, wid = __builtin_amdgcn_readfirstlane(tid >> 6), lane = tid & 63, wr = wid >> 2, wc = wid & 3, fr = lane & 15, fq = lane >> 4;
    const int K = g.K, nt = K / BK;
    unsigned voffA[2], voffB[2];
#pragma unroll
    for (int i = 0; i < 2; ++i) { int R, C; stage_rc(tid * 16 + i * 8192, R, C); const int Rb = Epi::PERM ? ((R & ~31) + perm32(R & 31)) : R;
        voffA[i] = (unsigned)(R * K + C) * 2u; voffB[i] = (unsigned)(Rb * K + C) * 2u; }
    const size_t kstep = (size_t)(BK * 2);
    const size_t hstep = (size_t)HALF * K * 2;
    const size_t tstep = 2 * hstep;
    const unsigned ldsw = (unsigned)wid * 1024u;
    const int aoff = lds_byte(wr * 64 + fr, fq * 8), boff = lds_byte(wc * 32 + fr, fq * 8);
#define PG8_SA(b, h) (((b) * 2 + (h)) * HTB)
#define PG8_SB(b, h) ((4 + (b) * 2 + (h)) * HTB)
#define PG8_STAGE(bufoff, gbase, voff) do { _Pragma("unroll") for (int _i = 0; _i < 2; ++_i) \
        __builtin_amdgcn_global_load_lds((const unsigned*)((const char*)(gbase) + (voff)[_i]), (PG8_LAS unsigned*)(lds + (bufoff) + ldsw + _i * 8192), 16, 0, 0); } while (0)
#define PG8_LDA(dst, b, h) do { _Pragma("unroll") for (int m = 0; m < 4; ++m) _Pragma("unroll") for (int k = 0; k < 2; ++k) dst[m][k] = *(const PG8_LAS bf16x8*)(lds + PG8_SA(b, h) + aoff + m * 2048 + k * 1024); } while (0)
#define PG8_LDB(dst, b, h) do { _Pragma("unroll") for (int n = 0; n < 2; ++n) _Pragma("unroll") for (int k = 0; k < 2; ++k) dst[n][k] = *(const PG8_LAS bf16x8*)(lds + PG8_SB(b, h) + boff + n * 2048 + k * 1024); } while (0)
#define PG8_MMA(ai, bj, At, Bt) do { __builtin_amdgcn_s_setprio(1); _Pragma("unroll") for (int m = 0; m < 4; ++m) _Pragma("unroll") for (int n = 0; n < 2; ++n) _Pragma("unroll") for (int k = 0; k < 2; ++k) \
        acc[ai][bj][m][n] = __builtin_amdgcn_mfma_f32_16x16x32_bf16(Bt[n][k], At[m][k], acc[ai][bj][m][n], 0, 0, 0); __builtin_amdgcn_s_setprio(0); } while (0)
#define PG8_WAIT_V(n) asm volatile("s_waitcnt vmcnt(" #n ")" ::: "memory")
#define PG8_WAIT_L(n) asm volatile("s_waitcnt lgkmcnt(" #n ")" ::: "memory")
#define PG8_BAR __builtin_amdgcn_s_barrier()
#define PG8_SCHED __builtin_amdgcn_sched_barrier(0)
    Unit cur, nxt; int ui = 0;
    if (!S.next(0, cur)) return;
    f32x4 acc[2][2][4][2];
#pragma unroll
    for (int a = 0; a < 2; ++a)
#pragma unroll
        for (int b = 0; b < 2; ++b)
#pragma unroll
            for (int m = 0; m < 4; ++m)
#pragma unroll
                for (int n = 0; n < 2; ++n) acc[a][b][m][n] = (f32x4){0.f, 0.f, 0.f, 0.f};
    bf16x8 At[4][2], B0[2][2], B1[2][2];
    const char* cA = (const char*)g.A + (size_t)cur.pm * tstep; const char* cB = (const char*)g.Bt + (size_t)cur.pn * tstep;
    S.a_ready(cur);
    if constexpr (SP2) {
        PG8_STAGE(PG8_SB(0, 0), cB, voffB); PG8_STAGE(PG8_SB(0, 1), cB + hstep, voffB); PG8_STAGE(PG8_SA(0, 0), cA, voffA); PG8_STAGE(PG8_SA(0, 1), cA + hstep, voffA);
        if (wr == 1) PG8_BAR;
        PG8_WAIT_V(2); PG8_BAR;
        PG8_STAGE(PG8_SB(1, 0), cB + kstep, voffB); PG8_STAGE(PG8_SA(1, 0), cA + kstep, voffA); PG8_STAGE(PG8_SB(1, 1), cB + hstep + kstep, voffB);
        PG8_WAIT_V(6); PG8_BAR;
    } else {
        PG8_STAGE(PG8_SB(0, 0), cB, voffB); PG8_STAGE(PG8_SA(0, 0), cA, voffA); PG8_STAGE(PG8_SB(0, 1), cB + hstep, voffB); PG8_STAGE(PG8_SA(0, 1), cA + hstep, voffA);
        if (wr == 1) PG8_BAR;
        PG8_WAIT_V(4); PG8_BAR;
        PG8_STAGE(PG8_SB(1, 0), cB + kstep, voffB); PG8_STAGE(PG8_SA(1, 0), cA + kstep, voffA); PG8_STAGE(PG8_SB(1, 1), cB + hstep + kstep, voffB);
        PG8_WAIT_V(6); PG8_BAR;
    }
    for (;;) {
        const bool has_next = S.next(ui + 1, nxt);
        const char* nA = has_next ? (const char*)g.A + (size_t)nxt.pm * tstep : cA; const char* nB = has_next ? (const char*)g.Bt + (size_t)nxt.pn * tstep : cB;
        for (int t = 0; t < nt; t += 2) {
            const bool last = (t == nt - 2);
            const char* a1 = cA + (size_t)(t + 1) * kstep;
            const char* a2 = last ? nA : cA + (size_t)(t + 2) * kstep; const char* b2 = last ? nB : cB + (size_t)(t + 2) * kstep;
            const char* a3 = a2 + kstep; const char* b3 = b2 + kstep;
            if (last && has_next) S.a_ready(nxt);
            if constexpr (SP2) {
            PG8_LDB(B0, 0, 0); PG8_LDB(B1, 0, 1); PG8_SCHED; PG8_LDA(At, 0, 0); PG8_STAGE(PG8_SA(1, 1), a1 + hstep, voffA);
            PG8_WAIT_V(8); PG8_WAIT_L(0); PG8_BAR; PG8_MMA(0, 0, At, B0); PG8_MMA(0, 1, At, B1); PG8_BAR; PG8_SCHED;
            PG8_LDA(At, 0, 1); PG8_STAGE(PG8_SB(0, 0), b2, voffB); PG8_STAGE(PG8_SB(0, 1), b2 + hstep, voffB); PG8_STAGE(PG8_SA(0, 0), a2, voffA);
            PG8_WAIT_V(8); PG8_WAIT_L(0); PG8_BAR; PG8_MMA(1, 0, At, B0); PG8_MMA(1, 1, At, B1); PG8_BAR; PG8_SCHED;
            PG8_LDB(B0, 1, 0); PG8_LDB(B1, 1, 1); PG8_SCHED; PG8_LDA(At, 1, 0); PG8_STAGE(PG8_SA(0, 1), a2 + hstep, voffA);
            PG8_WAIT_V(8); PG8_WAIT_L(0); PG8_BAR; PG8_MMA(0, 0, At, B0); PG8_MMA(0, 1, At, B1); PG8_BAR; PG8_SCHED;
            PG8_LDA(At, 1, 1); PG8_STAGE(PG8_SB(1, 0), b3, voffB); PG8_STAGE(PG8_SB(1, 1), b3 + hstep, voffB); PG8_STAGE(PG8_SA(1, 0), a3, voffA);
            PG8_WAIT_V(8); PG8_WAIT_L(0); PG8_BAR; PG8_MMA(1, 0, At, B0); PG8_MMA(1, 1, At, B1); PG8_BAR; PG8_SCHED;
            } else {
            PG8_LDB(B0, 0, 0); PG8_SCHED; PG8_LDA(At, 0, 0); PG8_STAGE(PG8_SA(1, 1), a1 + hstep, voffA);
            PG8_WAIT_L(8); PG8_BAR; PG8_WAIT_L(0); PG8_MMA(0, 0, At, B0); PG8_BAR; PG8_SCHED;
            PG8_LDB(B1, 0, 1); PG8_STAGE(PG8_SB(0, 0), b2, voffB);
            PG8_BAR; PG8_WAIT_L(0); PG8_MMA(0, 1, At, B1); PG8_BAR;
            PG8_LDA(At, 0, 1); PG8_STAGE(PG8_SA(0, 0), a2, voffA);
            PG8_BAR; PG8_WAIT_L(0); PG8_MMA(1, 0, At, B0); PG8_BAR; PG8_SCHED;
            PG8_STAGE(PG8_SB(0, 1), b2 + hstep, voffB);
            PG8_WAIT_V(6); PG8_BAR; PG8_MMA(1, 1, At, B1); PG8_BAR;
            PG8_LDB(B0, 1, 0); PG8_SCHED; PG8_LDA(At, 1, 0); PG8_STAGE(PG8_SA(0, 1), a2 + hstep, voffA);
            PG8_WAIT_L(8); PG8_BAR; PG8_WAIT_L(0); PG8_MMA(0, 0, At, B0); PG8_BAR; PG8_SCHED;
            PG8_LDB(B1, 1, 1); PG8_STAGE(PG8_SB(1, 0), b3, voffB);
            PG8_BAR; PG8_WAIT_L(0); PG8_MMA(0, 1, At, B1); PG8_BAR;
            PG8_LDA(At, 1, 1); PG8_STAGE(PG8_SA(1, 0), a3, voffA);
            PG8_BAR; PG8_WAIT_L(0); PG8_MMA(1, 0, At, B0); PG8_BAR; PG8_SCHED;
            PG8_STAGE(PG8_SB(1, 1), b3 + hstep, voffB);
            PG8_WAIT_V(6); PG8_BAR; PG8_MMA(1, 1, At, B1); PG8_BAR;
            }
        }
        if constexpr (ALIGN_EPI) { if (wr == 0) PG8_BAR; }
        if constexpr (!Epi::AFTER_DRAIN) { E(acc, cur, wr, wc, fr, fq); S.done(cur); }
        if (!has_next) break;
#pragma unroll
        for (int a = 0; a < 2; ++a)
#pragma unroll
            for (int b = 0; b < 2; ++b)
#pragma unroll
                for (int m = 0; m < 4; ++m)
#pragma unroll
                    for (int n = 0; n < 2; ++n) acc[a][b][m][n] = (f32x4){0.f, 0.f, 0.f, 0.f};
        cur = nxt; cA = nA; cB = nB; ++ui;
        if constexpr (ALIGN_EPI) { if (wr == 1) PG8_BAR; }
    }
    PG8_WAIT_V(0);
    if constexpr (!ALIGN_EPI) { if (wr == 0) PG8_BAR; }
    PG8_BAR;
    if constexpr (Epi::AFTER_DRAIN) { E.fused(acc, cur, wr, wc, fr, fq, lds, wid, lane); S.done(cur); }
#undef PG8_SA
#undef PG8_SB
#undef PG8_STAGE
#undef PG8_LDA
#undef PG8_LDB
#undef PG8_MMA
#undef PG8_WAIT_V
#undef PG8_WAIT_L
#undef PG8_BAR
#undef PG8_SCHED
}
}
constexpr int NB = 8, SEQ = 8192, D = 1024, M = NB * SEQ;
constexpr int DIN = 2312, NPROJ = 2304, NIN_PAD = 2560;
constexpr int C_AQ = 0, C_AK = 512, C_AV = 640, C_MQ = 768, C_MK = 1024, C_MV = 1280, C_MO = 1792;
constexpr int NEXP = 16384, NSLOT = 128;
constexpr float EPS = 1e-6f;
constexpr int NWAVES = 8, NTHR = 512;

constexpr size_t MiB = 1u << 20;
constexpr size_t WS_CTL = 0, CTL_ZERO_BYTES = 1 * MiB;
constexpr size_t WS_MOD = 1 * MiB;
constexpr size_t WS_WIN = 2 * MiB;
constexpr size_t WS_WOUT = 8 * MiB;
constexpr size_t WS_WQ = 10 * MiB;
constexpr size_t WS_KEYS = 14 * MiB;
constexpr size_t WS_GATES = 16 * MiB;
constexpr size_t WS_SSQ = 832 * MiB;
constexpr size_t WS_MST = 20 * MiB;
constexpr size_t WS_U8 = 32 * MiB, WS_V8 = 48 * MiB;
constexpr size_t WS_SC = 64 * MiB;
constexpr size_t WS_H = 96 * MiB;
constexpr size_t WS_PROJ = 224 * MiB;
constexpr size_t WS_MIXIN = 512 * MiB;
constexpr size_t WS_MIX = 640 * MiB;
constexpr size_t WS_EIDX = 768 * MiB, WS_GATE = 800 * MiB;
constexpr size_t WS_PD = 224 * MiB;
constexpr size_t WS_X1 = 512 * MiB;
constexpr size_t WS_ACT = 840 * MiB;
constexpr size_t WS_SSY = 872 * MiB;
constexpr size_t WS_H8 = 880 * MiB;
constexpr size_t WS_HS = 944 * MiB;
constexpr size_t WS_END = 945 * MiB;
constexpr int CW_BAR = 4096;
constexpr int CW_SUMSQ = 65536;
static_assert((CW_SUMSQ + M) * 4 <= (int)CTL_ZERO_BYTES, "ctl");

constexpr int RING_BYTES = 131072, MISC_OFF = RING_BYTES + 320, LDS_BYTES = 147456;

#define GAS __attribute__((address_space(1)))
#define LAS __attribute__((address_space(3)))
typedef unsigned short bf16;
typedef unsigned v4u __attribute__((ext_vector_type(4)));
typedef unsigned v2u __attribute__((ext_vector_type(2)));
typedef float f32x4 __attribute__((ext_vector_type(4)));
typedef GAS unsigned gu32;
#define LDS_WAIT() asm volatile("s_waitcnt lgkmcnt(0)" ::: "memory")
#define VM_WAIT() asm volatile("s_waitcnt vmcnt(0)" ::: "memory")
__device__ __forceinline__ unsigned f2bf(float f) { unsigned u = __builtin_bit_cast(unsigned, f); return (u + 0x7fffu + ((u >> 16) & 1u)) >> 16; }
__device__ __forceinline__ unsigned pk2(float lo, float hi) { return f2bf(lo) | (f2bf(hi) << 16); }
__device__ __forceinline__ float bflo(unsigned w) { return __builtin_bit_cast(float, w << 16); }
__device__ __forceinline__ float bfhi(unsigned w) { return __builtin_bit_cast(float, w & 0xffff0000u); }
__device__ __forceinline__ float bf1(bf16 h) { return __builtin_bit_cast(float, (unsigned)h << 16); }
__device__ __forceinline__ float wave_sum(float v) {
#pragma unroll
    for (int o = 1; o < 64; o <<= 1) v += __shfl_xor(v, o);
    return v;
}
__device__ __forceinline__ float wave_max(float v) {
#pragma unroll
    for (int o = 1; o < 64; o <<= 1) v = fmaxf(v, __shfl_xor(v, o));
    return v;
}

typedef float f32x2 __attribute__((ext_vector_type(2)));
__device__ __forceinline__ void cvt16_fp8(const v4u w, float (&o)[16]) {
    const unsigned ww[4] = {w.x, w.y, w.z, w.w};
#pragma unroll
    for (int i = 0; i < 4; ++i) { const f32x2 a = __builtin_amdgcn_cvt_pk_f32_fp8((int)ww[i], false), b = __builtin_amdgcn_cvt_pk_f32_fp8((int)ww[i], true);
        o[4 * i] = a.x; o[4 * i + 1] = a.y; o[4 * i + 2] = b.x; o[4 * i + 3] = b.y; }
}
__device__ __forceinline__ void p0_row_fp8(const float* src, unsigned char* dst, float* sc, int row, int lane) {
    const GAS f32x4* sp = (const GAS f32x4*)(src + (size_t)row * D + 16 * lane);
    const f32x4 a = sp[0], b = sp[1], c = sp[2], d = sp[3];
    float mx = 0.f;
#pragma unroll
    for (int i = 0; i < 4; ++i) mx = fmaxf(fmaxf(fmaxf(mx, fabsf(a[i])), fmaxf(fabsf(b[i]), fabsf(c[i]))), fabsf(d[i]));
    mx = wave_max(mx); const float s = mx > 0.f ? 224.0f / mx : 1.0f;
    v4u o; int w;
    w = __builtin_amdgcn_cvt_pk_fp8_f32(a[0] * s, a[1] * s, 0, false); w = __builtin_amdgcn_cvt_pk_fp8_f32(a[2] * s, a[3] * s, w, true); o.x = (unsigned)w;
    w = __builtin_amdgcn_cvt_pk_fp8_f32(b[0] * s, b[1] * s, 0, false); w = __builtin_amdgcn_cvt_pk_fp8_f32(b[2] * s, b[3] * s, w, true); o.y = (unsigned)w;
    w = __builtin_amdgcn_cvt_pk_fp8_f32(c[0] * s, c[1] * s, 0, false); w = __builtin_amdgcn_cvt_pk_fp8_f32(c[2] * s, c[3] * s, w, true); o.z = (unsigned)w;
    w = __builtin_amdgcn_cvt_pk_fp8_f32(d[0] * s, d[1] * s, 0, false); w = __builtin_amdgcn_cvt_pk_fp8_f32(d[2] * s, d[3] * s, w, true); o.w = (unsigned)w;
    *(GAS v4u*)(dst + (size_t)row * D + 16 * lane) = o;
    if (lane == 0) sc[row] = mx > 0.f ? mx * (1.0f / 224.0f) : 1.0f;
}

__device__ __forceinline__ unsigned pack4_i8(float a, float b, float c, float d) { return ((unsigned)__float2int_rn(a) & 0xffu) | (((unsigned)__float2int_rn(b) & 0xffu) << 8) | (((unsigned)__float2int_rn(c) & 0xffu) << 16) | (((unsigned)__float2int_rn(d) & 0xffu) << 24); }
__device__ __forceinline__ void p0_row_i8(const float* src, unsigned char* dst, float* sc, int row, int lane) {
    const GAS f32x4* sp = (const GAS f32x4*)(src + (size_t)row * D + 16 * lane);
    const f32x4 a = sp[0], b = sp[1], c = sp[2], d = sp[3];
    float mx = 0.f;
#pragma unroll
    for (int i = 0; i < 4; ++i) mx = fmaxf(fmaxf(fmaxf(mx, fabsf(a[i])), fmaxf(fabsf(b[i]), fabsf(c[i]))), fabsf(d[i]));
    mx = wave_max(mx); const float s = mx > 0.f ? 127.0f / mx : 1.0f;
    v4u o; o.x = pack4_i8(a[0] * s, a[1] * s, a[2] * s, a[3] * s); o.y = pack4_i8(b[0] * s, b[1] * s, b[2] * s, b[3] * s); o.z = pack4_i8(c[0] * s, c[1] * s, c[2] * s, c[3] * s); o.w = pack4_i8(d[0] * s, d[1] * s, d[2] * s, d[3] * s);
    *(GAS v4u*)(dst + (size_t)row * D + 16 * lane) = o;
    if (lane == 0) sc[row] = mx > 0.f ? mx * (1.0f / 127.0f) : 1.0f;
}

__device__ __forceinline__ unsigned pack8_i4(const f32x4 a, const f32x4 b, float s) {
    unsigned w = 0;
#pragma unroll
    for (int i = 0; i < 4; ++i) { const int qa = max(-8, min(7, __float2int_rn(a[i] * s))), qb = max(-8, min(7, __float2int_rn(b[i] * s))); w |= ((unsigned)qa & 15u) << (4 * i); w |= ((unsigned)qb & 15u) << (16 + 4 * i); }
    return w;
}
__device__ __forceinline__ void p0_row_i4(const f32x4 a, const f32x4 b, const f32x4 c, const f32x4 d, unsigned char* dst, float* sc, int row, int lane) {
    float ss = 0.f;
#pragma unroll
    for (int i = 0; i < 4; ++i) ss += (a[i] * a[i] + b[i] * b[i]) + (c[i] * c[i] + d[i] * d[i]);
    ss = wave_sum(ss); const float sig = sqrtf(ss * (1.f / D)), s = sig > 0.f ? 3.0f / sig : 1.0f;
    v2u o; o.x = pack8_i4(a, b, s); o.y = pack8_i4(c, d, s);
    *(GAS v2u*)(dst + (size_t)row * (D / 2) + 8 * lane) = o;
    if (lane == 0) sc[row] = sig > 0.f ? sig * (1.0f / 3.0f) : 1.0f;
}

__device__ __forceinline__ unsigned pack8_fp4(const f32x4 a, const f32x4 b, float s) {
    unsigned w = 0;
    w = __builtin_amdgcn_cvt_scalef32_pk_fp4_f32(w, fminf(fmaxf(a[0] * s, -6.f), 6.f), fminf(fmaxf(a[1] * s, -6.f), 6.f), 1.0f, 0);
    w = __builtin_amdgcn_cvt_scalef32_pk_fp4_f32(w, fminf(fmaxf(a[2] * s, -6.f), 6.f), fminf(fmaxf(a[3] * s, -6.f), 6.f), 1.0f, 1);
    w = __builtin_amdgcn_cvt_scalef32_pk_fp4_f32(w, fminf(fmaxf(b[0] * s, -6.f), 6.f), fminf(fmaxf(b[1] * s, -6.f), 6.f), 1.0f, 2);
    w = __builtin_amdgcn_cvt_scalef32_pk_fp4_f32(w, fminf(fmaxf(b[2] * s, -6.f), 6.f), fminf(fmaxf(b[3] * s, -6.f), 6.f), 1.0f, 3);
    return w;
}
__device__ __forceinline__ void p0_row_fp4(const f32x4 a, const f32x4 b, const f32x4 c, const f32x4 d, unsigned char* dst, float* sc, int row, int lane) {
    float mx = 0.f;
#pragma unroll
    for (int i = 0; i < 4; ++i) mx = fmaxf(fmaxf(fmaxf(mx, fabsf(a[i])), fmaxf(fabsf(b[i]), fabsf(c[i]))), fabsf(d[i]));
    mx = wave_max(mx); const float s = mx > 0.f ? 7.0f / mx : 1.0f;
    v2u o; o.x = pack8_fp4(a, b, s); o.y = pack8_fp4(c, d, s);
    *(GAS v2u*)(dst + (size_t)row * (D / 2) + 8 * lane) = o;
    if (lane == 0) sc[row] = mx > 0.f ? mx * (1.0f / 7.0f) : 1.0f;
}
#define XB_TMO      128
#define XB_XCNT(j)  (256  + 64 * (j))
#define XB_XSUB(j)  (1280 + 64 * (j))
#define XB_XGEN(j)  (2304 + 64 * (j))
#define XB_TOP      3328
#define XB_TOPGEN   3392
#define XCD_BAR_WORDS 3456
#define XB_SPIN_CAP (1u << 18)

__device__ __forceinline__ unsigned xb_ld(unsigned* p)              { return __hip_atomic_load(p, __ATOMIC_RELAXED, __HIP_MEMORY_SCOPE_AGENT); }
__device__ __forceinline__ unsigned xb_add(unsigned* p, unsigned v) { return __hip_atomic_fetch_add(p, v, __ATOMIC_RELAXED, __HIP_MEMORY_SCOPE_AGENT); }
__device__ __forceinline__ unsigned xb_xcc_id() { return (unsigned)__builtin_amdgcn_s_getreg((3 << 11) | 20) & 0xFu; }
#define XB_SPIN(cond, bar) do { unsigned _sp = 0; while (cond) { __builtin_amdgcn_s_sleep(1); \
    if ((++_sp & 255u) == 0u) { if (xb_ld(&(bar)[XB_TMO])) break; if (_sp > XB_SPIN_CAP) { atomicAdd(&(bar)[XB_TMO], 1u); break; } } } } while (0)

struct XcdBarrier {
    unsigned* bar; unsigned x;
    volatile LAS unsigned* st;
};

__device__ __forceinline__ XcdBarrier xcd_barrier_post(unsigned* bar, volatile LAS unsigned* st) {
    XcdBarrier b; b.bar = bar; b.x = xb_xcc_id(); b.st = st;
    if (threadIdx.x == 0) (void)xb_add(&bar[XB_XCNT(b.x)], 1u);
    return b;
}
__device__ __forceinline__ void xcd_barrier_complete(unsigned* bar, unsigned x, unsigned& nloc, unsigned& nx) {
    const unsigned G = gridDim.x * gridDim.y * gridDim.z;
    unsigned sum, cnt, mine, sp = 0u;
    for (;;) {
        sum = 0u; cnt = 0u; mine = 0u;
#pragma unroll
        for (unsigned j = 0; j < 16; ++j) { const unsigned c = xb_ld(&bar[XB_XCNT(j)]); sum += c; cnt += (c > 0u) ? 1u : 0u; mine = (j == x) ? c : mine; }
        if (sum == G) break;
        __builtin_amdgcn_s_sleep(1);
        if ((++sp & 255u) == 0u) { if (xb_ld(&bar[XB_TMO])) break; if (sp > XB_SPIN_CAP) { atomicAdd(&bar[XB_TMO], 1u); break; } }
    }
    nloc = mine > 0u ? mine : 1u; nx = cnt > 0u ? cnt : 1u;
}

__device__ __forceinline__ void xcd_barrier(const XcdBarrier& b) {
    asm volatile("s_waitcnt vmcnt(0)" ::: "memory");
    __syncthreads();
    if (threadIdx.x == 0) {
        unsigned* bar = b.bar;
        __builtin_amdgcn_s_waitcnt(0);
        unsigned nloc = b.st[0], nx = b.st[1];
        if (nloc == 0u) { xcd_barrier_complete(bar, b.x, nloc, nx); b.st[0] = nloc; b.st[1] = nx; }
        const unsigned old = xb_add(&bar[XB_XSUB(b.x)], 1u);
        const unsigned gen = old / nloc;
        if (old + 1u == (gen + 1u) * nloc) {
            __builtin_amdgcn_fence(__ATOMIC_RELEASE, "agent");
            asm volatile("s_waitcnt vmcnt(0)" ::: "memory");
            const unsigned og = xb_add(&bar[XB_TOP], 1u);
            const unsigned tg = og / nx;
            if (og + 1u == (tg + 1u) * nx) xb_add(&bar[XB_TOPGEN], 1u);
            else XB_SPIN(xb_ld(&bar[XB_TOPGEN]) == tg, bar);
            __builtin_amdgcn_fence(__ATOMIC_ACQUIRE, "agent");
            xb_add(&bar[XB_XGEN(b.x)], 1u);
            asm volatile("s_waitcnt vmcnt(0)" ::: "memory");
        } else {
            XB_SPIN(xb_ld(&bar[XB_XGEN(b.x)]) == gen, bar);
            __builtin_amdgcn_fence(__ATOMIC_ACQUIRE, "agent");
            asm volatile("s_waitcnt vmcnt(0)" ::: "memory");
        }
    }
    __syncthreads();
}
struct Args { const void* in[21]; float* out; unsigned char* ws; int ph_lo, ph_hi; };
enum { I_X = 0, I_C, I_POS, I_WMOD, I_BMOD, I_GPRE1, I_GPOST1, I_WIN, I_CONVW, I_BI, I_BF, I_MNG, I_SINK, I_WOUT, I_GPRE2, I_GPOST2, I_WQ, I_K1, I_K2, I_U, I_V };

__device__ __forceinline__ int newcol(int o) {
    if (o < 640) { const int hd = o >> 6, d = o & 63; return (hd << 6) + 2 * (d & 31) + (d >> 5); }
    if (o < 1792) return o;
    if (o < 1800) return 2304 + (o - 1792);
    return o - 8;
}
template <bool REMAP>
__device__ __forceinline__ void p0_transpose_item(const float* W, int K, int N, bf16* WT, LAS float* scr, int item, int lane) {
    const int nblk = (N + 31) / 32, kb = item / nblk, nb = item % nblk, k0 = 64 * kb, n0 = 32 * nb;
    const int ncol = n0 + (lane & 31);
#pragma unroll 8
    for (int i = 0; i < 32; ++i) { const int kk = 2 * i + (lane >> 5); scr[kk * 33 + (lane & 31)] = (ncol < N) ? W[(size_t)(k0 + kk) * N + ncol] : 0.f; }
    LDS_WAIT(); asm volatile("" ::: "memory");
    const int c = lane & 7;
#pragma unroll
    for (int j = 0; j < 4; ++j) { const int n = (lane >> 3) + 8 * j; const LAS float* s = scr + (8 * c) * 33 + n;
        v4u o; o.x = pk2(s[0 * 33], s[1 * 33]); o.y = pk2(s[2 * 33], s[3 * 33]); o.z = pk2(s[4 * 33], s[5 * 33]); o.w = pk2(s[6 * 33], s[7 * 33]);
        if (n0 + n < N) { const int drow = REMAP ? newcol(n0 + n) : (n0 + n); *(GAS v4u*)(WT + (size_t)drow * K + k0 + 8 * c) = o; } }
    LDS_WAIT(); asm volatile("" ::: "memory");
}
__device__ __forceinline__ void p0_convert(const float* src, bf16* dst, size_t n, int gt, int ngt) {
    for (size_t i = (size_t)gt * 8; i < n; i += (size_t)ngt * 8) {
        const f32x4 a = *(const GAS f32x4*)(src + i), b = *(const GAS f32x4*)(src + i + 4);
        v4u o; o.x = pk2(a[0], a[1]); o.y = pk2(a[2], a[3]); o.z = pk2(b[0], b[1]); o.w = pk2(b[2], b[3]);
        *(GAS v4u*)(dst + i) = o; }
}
__device__ __forceinline__ void phase_mod(const Args& A, LAS unsigned char* lds) {
    const int tid = threadIdx.x, G = gridDim.x, blk = blockIdx.x;
    unsigned char* ws = A.ws;
    const float* c = (const float*)A.in[I_C]; const float* wm = (const float*)A.in[I_WMOD]; const float* bm = (const float*)A.in[I_BMOD];
    float* mod = (float*)(ws + WS_MOD); LAS float* cs = (LAS float*)lds; LAS float* red = cs + 8 * 1024;
    for (int e = tid; e < 8 * 1024 / 4; e += NTHR) *(LAS f32x4*)(cs + 4 * e) = *(const GAS f32x4*)(c + 4 * e);
    __syncthreads();
    for (int it = blk; it < 6144 / 24; it += G) {
        const int kg = tid >> 5, col = tid & 31, j = it * 24 + (col < 24 ? col : 23); float acc[8];
#pragma unroll
        for (int b = 0; b < 8; ++b) acc[b] = 0.f;
#pragma unroll 16
        for (int i = 0; i < 64; ++i) { const int k = kg + 16 * i; const float w = wm[(size_t)k * 6144 + j];
#pragma unroll
            for (int b = 0; b < 8; ++b) acc[b] += cs[b * 1024 + k] * w; }
#pragma unroll
        for (int b = 0; b < 8; ++b) red[(kg * 32 + col) * 8 + b] = acc[b];
        __syncthreads();
        if (tid < 256) { const int b = tid >> 5, cc = tid & 31; float s = 0.f;
#pragma unroll
            for (int g = 0; g < 16; ++g) s += red[(g * 32 + cc) * 8 + b];
            if (cc < 24) mod[b * 6144 + it * 24 + cc] = s + bm[it * 24 + cc]; }
        __syncthreads();
    }
}
__device__ __forceinline__ void phase_convert(const Args& A, LAS unsigned char* lds) {
    const int tid = threadIdx.x, lane = tid & 63, wave = tid >> 6, G = gridDim.x, blk = blockIdx.x;
    unsigned char* ws = A.ws;
    {
        LAS float* scr = (LAS float*)(lds + wave * 16384);
        const int gw = blk * NWAVES + wave, NGW = G * NWAVES;
        const int I_IN = (D / 64) * ((DIN + 31) / 32), I_OUT = (D / 64) * (D / 32), I_Q = (D / 64) * (2048 / 32);
        bf16* win = (bf16*)(ws + WS_WIN); bf16* wout = (bf16*)(ws + WS_WOUT); bf16* wq = (bf16*)(ws + WS_WQ);
        for (int it = gw; it < I_IN + I_OUT + I_Q; it += NGW) {
            int r = it;
            if (r < I_IN) { p0_transpose_item<true>((const float*)A.in[I_WIN], D, DIN, win, scr, r, lane); continue; } r -= I_IN;
            if (r < I_OUT) { p0_transpose_item<false>((const float*)A.in[I_WOUT], D, D, wout, scr, r, lane); continue; } r -= I_OUT;
            p0_transpose_item<false>((const float*)A.in[I_WQ], D, 2048, wq, scr, r, lane);
        }
        const int gt = blk * NTHR + tid, ngt = G * NTHR;
        for (int i = gt; i < (NIN_PAD - DIN) * D / 8; i += ngt) *(GAS v4u*)(win + (size_t)DIN * D + (size_t)i * 8) = (v4u){0u, 0u, 0u, 0u};
        p0_convert((const float*)A.in[I_K1], (bf16*)(ws + WS_KEYS), (size_t)8 * 128 * 128, gt, ngt);
        p0_convert((const float*)A.in[I_K2], (bf16*)(ws + WS_KEYS) + 8 * 128 * 128, (size_t)8 * 128 * 128, gt, ngt);
        {
            const float* usrc = (const float*)A.in[I_U]; const float* vsrc = (const float*)A.in[I_V];
            auto rowp = [&](int r) { return (const GAS f32x4*)((r < NEXP ? usrc + (size_t)r * D : vsrc + (size_t)(r - NEXP) * D) + 16 * lane); };
            int r = gw; const GAS f32x4* sp = rowp(min(r, 2 * NEXP - 1)); f32x4 a = sp[0], b = sp[1], c = sp[2], d = sp[3];
            for (; r < 2 * NEXP; r += NGW) { const GAS f32x4* sn = rowp(min(r + NGW, 2 * NEXP - 1)); const f32x4 an = sn[0], bn = sn[1], cn = sn[2], dn = sn[3];
                if (r < NEXP) p0_row_i4(a, b, c, d, ws + WS_U8, (float*)(ws + WS_SC), r, lane); else p0_row_fp4(a, b, c, d, ws + WS_V8, (float*)(ws + WS_SC) + NEXP, r - NEXP, lane);
                a = an; b = bn; c = cn; d = dn; }
        }
    }
}

__device__ __forceinline__ void phase_prenorm(const Args& A, LAS unsigned char* lds) {
    const int tid = threadIdx.x, lane = tid & 63, wave = tid >> 6, G = gridDim.x;
    const float* x = (const float*)A.in[I_X]; const float* g = (const float*)A.in[I_GPRE1]; const float* mod = (const float*)(A.ws + WS_MOD);
    bf16* H = (bf16*)(A.ws + WS_H); float* gates = (float*)(A.ws + WS_GATES);
    LAS float* wg = (LAS float*)lds;
    __syncthreads();
    for (int k = tid; k < D; k += NTHR) { const float* wr = (const float*)A.in[I_WIN] + (size_t)k * DIN + 1792; const f32x4 w0 = *(const GAS f32x4*)wr, w1 = *(const GAS f32x4*)(wr + 4);
#pragma unroll
        for (int j = 0; j < 4; ++j) { wg[j * D + k] = w0[j]; wg[(4 + j) * D + k] = w1[j]; } }
    __syncthreads();
    const int gi = ((lane >> 5) & 1) * 4 + ((lane >> 4) & 1) * 2 + ((lane >> 3) & 1);
    const float gbias = gi < 4 ? ((const float*)A.in[I_BI])[gi] : ((const float*)A.in[I_BF])[gi - 4];
    f32x4 gg[4];
#pragma unroll
    for (int j = 0; j < 4; ++j) gg[j] = *(const GAS f32x4*)(g + 4 * (lane + 64 * j));
    const int stride = G * NWAVES; int row = blockIdx.x * NWAVES + wave;
    f32x4 v[4], vn[4], shv[4], gsv[4]; int bcur = -1;
#pragma unroll
    for (int j = 0; j < 4; ++j) v[j] = ((const GAS f32x4*)(x + (size_t)row * D) + lane)[64 * j];
    for (; row < M; row += stride) {
        const int rn = min(row + stride, M - 1);
#pragma unroll
        for (int j = 0; j < 4; ++j) vn[j] = ((const GAS f32x4*)(x + (size_t)rn * D) + lane)[64 * j];
        const int b = row / SEQ; float s = 0.f;
        if (b != bcur) { bcur = b;
#pragma unroll
            for (int j = 0; j < 4; ++j) { const int k = 4 * (lane + 64 * j); shv[j] = *(const GAS f32x4*)(mod + b * 6144 + k); const f32x4 sc = *(const GAS f32x4*)(mod + b * 6144 + 1024 + k);
#pragma unroll
                for (int i = 0; i < 4; ++i) gsv[j][i] = gg[j][i] * (1.f + sc[i]); } }
#pragma unroll
        for (int j = 0; j < 4; ++j) s += (v[j][0] * v[j][0] + v[j][1] * v[j][1]) + (v[j][2] * v[j][2] + v[j][3] * v[j][3]);
        const float rstd = 1.0f / sqrtf(wave_sum(s) * (1.f / D) + EPS);
        GAS v2u* o = (GAS v2u*)(H + (size_t)row * D) + lane;
        float gd[8];
#pragma unroll
        for (int q = 0; q < 8; ++q) gd[q] = 0.f;
#pragma unroll
        for (int j = 0; j < 4; ++j) {
            f32x4 y;
#pragma unroll
            for (int i = 0; i < 4; ++i) y[i] = v[j][i] * rstd * gsv[j][i] + shv[j][i];
            v2u w; w.x = pk2(y[0], y[1]); w.y = pk2(y[2], y[3]); o[64 * j] = w;
#pragma unroll
            for (int q = 0; q < 8; ++q) { const f32x4 ww = *(LAS const f32x4*)(wg + q * D + 4 * (lane + 64 * j)); gd[q] += (y[0] * ww[0] + y[1] * ww[1]) + (y[2] * ww[2] + y[3] * ww[3]); } }
#pragma unroll
        for (int i = 0; i < 4; ++i) { const bool up = (lane & 32) != 0; const float keep = up ? gd[i + 4] : gd[i], send = up ? gd[i] : gd[i + 4]; gd[i] = keep + __shfl_xor(send, 32); }
#pragma unroll
        for (int i = 0; i < 2; ++i) { const bool up = (lane & 16) != 0; const float keep = up ? gd[i + 2] : gd[i], send = up ? gd[i] : gd[i + 2]; gd[i] = keep + __shfl_xor(send, 16); }
        { const bool up = (lane & 8) != 0; const float keep = up ? gd[1] : gd[0], send = up ? gd[0] : gd[1]; gd[0] = keep + __shfl_xor(send, 8); }
        float gv = gd[0]; gv += __shfl_xor(gv, 4); gv += __shfl_xor(gv, 2); gv += __shfl_xor(gv, 1); gv += gbias;
        if ((lane & 7) == 0) gates[(size_t)row * 8 + gi] = gi < 4 ? gv : (fminf(gv, 0.f) - log1pf(__expf(-fabsf(gv))));
#pragma unroll
        for (int j = 0; j < 4; ++j) v[j] = vn[j];
    }
}

__device__ __forceinline__ void phase_mid(const Args& A) {
    const int tid = threadIdx.x, lane = tid & 63, wave = tid >> 6, G = gridDim.x;
    const float* x = (const float*)A.in[I_X]; const float* gpost = (const float*)A.in[I_GPOST1]; const float* gpre = (const float*)A.in[I_GPRE2];
    const float* mod = (const float*)(A.ws + WS_MOD); const float* sumsq = (const float*)(A.ws + WS_SSQ);
    const bf16* MIX = (const bf16*)(A.ws + WS_MIX); bf16* H = (bf16*)(A.ws + WS_H); bf16* X1 = (bf16*)(A.ws + WS_X1);
    const int stride = G * NWAVES; int row = blockIdx.x * NWAVES + wave;
    f32x4 xv[4], xn[4], q[4], qn[4], g1p[4], gs2[4], sh2[4]; v2u mw[4], mn[4]; int bcur = -1;
#pragma unroll
    for (int j = 0; j < 4; ++j) { xv[j] = ((const GAS f32x4*)(x + (size_t)row * D) + lane)[64 * j]; mw[j] = ((const GAS v2u*)(MIX + (size_t)row * D) + lane)[64 * j]; q[j] = *(const GAS f32x4*)(sumsq + (size_t)row * 16 + 4 * j); }
    for (; row < M; row += stride) {
        const int rn = min(row + stride, M - 1);
#pragma unroll
        for (int j = 0; j < 4; ++j) { xn[j] = ((const GAS f32x4*)(x + (size_t)rn * D) + lane)[64 * j]; mn[j] = ((const GAS v2u*)(MIX + (size_t)rn * D) + lane)[64 * j]; qn[j] = *(const GAS f32x4*)(sumsq + (size_t)rn * 16 + 4 * j); }
        const int b = row / SEQ;
        if (b != bcur) { bcur = b;
#pragma unroll
            for (int j = 0; j < 4; ++j) { const int k = 4 * (lane + 64 * j); const f32x4 gp = *(const GAS f32x4*)(gpost + k), g1 = *(const GAS f32x4*)(mod + b * 6144 + 2048 + k), gg = *(const GAS f32x4*)(gpre + k), sc = *(const GAS f32x4*)(mod + b * 6144 + 4096 + k);
                sh2[j] = *(const GAS f32x4*)(mod + b * 6144 + 3072 + k);
#pragma unroll
                for (int i = 0; i < 4; ++i) { g1p[j][i] = g1[i] * gp[i]; gs2[j][i] = gg[i] * (1.f + sc[i]); } } }
        const float rm = 1.0f / sqrtf(((((q[0][0] + q[0][1]) + (q[0][2] + q[0][3])) + ((q[1][0] + q[1][1]) + (q[1][2] + q[1][3]))) + (((q[2][0] + q[2][1]) + (q[2][2] + q[2][3])) + ((q[3][0] + q[3][1]) + (q[3][2] + q[3][3])))) * (1.f / D) + EPS);
        f32x4 v[4]; float s = 0.f;
#pragma unroll
        for (int j = 0; j < 4; ++j) {
            const float mx[4] = {bflo(mw[j].x), bfhi(mw[j].x), bflo(mw[j].y), bfhi(mw[j].y)};
#pragma unroll
            for (int i = 0; i < 4; ++i) { v[j][i] = xv[j][i] + g1p[j][i] * (mx[i] * rm); s += v[j][i] * v[j][i]; }
            { v2u w; w.x = pk2(v[j][0], v[j][1]); w.y = pk2(v[j][2], v[j][3]); *((GAS v2u*)(X1 + (size_t)row * D) + lane + 64 * j) = w; } }
        const float rstd = 1.0f / sqrtf(wave_sum(s) * (1.f / D) + EPS);
        GAS v2u* o = (GAS v2u*)(H + (size_t)row * D) + lane; float amx = 0.f;
#pragma unroll
        for (int j = 0; j < 4; ++j) {
#pragma unroll
            for (int i = 0; i < 4; ++i) { v[j][i] = v[j][i] * rstd * gs2[j][i] + sh2[j][i]; amx = fmaxf(amx, fabsf(v[j][i])); }
            v2u w; w.x = pk2(v[j][0], v[j][1]); w.y = pk2(v[j][2], v[j][3]); o[64 * j] = w; }
        amx = wave_max(amx); const float s8 = amx > 0.f ? 119.0f / amx : 1.0f;
        GAS unsigned short* ohh = (GAS unsigned short*)((unsigned char*)A.ws + WS_H8 + (size_t)row * (D / 2)) + lane; GAS unsigned short* ohl = (GAS unsigned short*)((unsigned char*)A.ws + WS_H8 + 32 * MiB + (size_t)row * (D / 2)) + lane;
#pragma unroll
        for (int j = 0; j < 4; ++j) { unsigned whh = 0, whl = 0;
#pragma unroll
            for (int i = 0; i < 4; ++i) { const int tq = __float2int_rn(v[j][i] * s8) + 8; whh |= ((unsigned)(tq >> 4) & 15u) << (4 * i); whl |= ((unsigned)((tq & 15) - 8) & 15u) << (4 * i); }
            ohh[64 * j] = (unsigned short)whh; ohl[64 * j] = (unsigned short)whl; }
        if (lane == 0) ((float*)(A.ws + WS_HS))[row] = amx > 0.f ? amx * (1.0f / 119.0f) : 1.0f;
#pragma unroll
        for (int j = 0; j < 4; ++j) { xv[j] = xn[j]; mw[j] = mn[j]; q[j] = qn[j]; }
    }
}
__device__ __forceinline__ void load64bf(const bf16* p, float (&o)[64]) {
#pragma unroll
    for (int i = 0; i < 8; ++i) { const v4u w = *(const GAS v4u*)(p + 8 * i);
        o[8 * i + 0] = bflo(w.x); o[8 * i + 1] = bfhi(w.x); o[8 * i + 2] = bflo(w.y); o[8 * i + 3] = bfhi(w.y);
        o[8 * i + 4] = bflo(w.z); o[8 * i + 5] = bfhi(w.z); o[8 * i + 6] = bflo(w.w); o[8 * i + 7] = bfhi(w.w); }
}
__device__ __forceinline__ void phase_attn_naive(const Args& A, int vb, int nvb) {
    const bf16* P = (const bf16*)(A.ws + WS_PROJ); bf16* MI = (bf16*)(A.ws + WS_MIXIN); const float* sinks = (const float*)A.in[I_SINK];
    for (int task = vb * NTHR + (int)threadIdx.x; task < 8 * M; task += nvb * NTHR) {
        const int h = task / M, t = task % M, s = t % SEQ, kvh = h >> 2;
        float q[64], o[64];
        load64bf(P + (size_t)t * NPROJ + C_AQ + h * 64, q);
#pragma unroll
        for (int d = 0; d < 64; ++d) o[d] = 0.f;
        float mx = sinks[h], l = 1.f;
        for (int j = 0; j < 128; ++j) {
            const int sj = s - 127 + j; const bool valid = sj >= 0; const int tk = valid ? (t - 127 + j) : t;
            const bf16* kr = P + (size_t)tk * NPROJ + C_AK + kvh * 64; float sc = 0.f;
#pragma unroll
            for (int i = 0; i < 8; ++i) { const v4u w = *(const GAS v4u*)(kr + 8 * i);
                sc += q[8 * i + 0] * bflo(w.x) + q[8 * i + 1] * bfhi(w.x) + q[8 * i + 2] * bflo(w.y) + q[8 * i + 3] * bfhi(w.y)
                    + q[8 * i + 4] * bflo(w.z) + q[8 * i + 5] * bfhi(w.z) + q[8 * i + 6] * bflo(w.w) + q[8 * i + 7] * bfhi(w.w); }
            if (valid) {
                const float mn = fmaxf(mx, sc), al = __expf(mx - mn), p = __expf(sc - mn); mx = mn; l = l * al + p;
                const bf16* vr = P + (size_t)tk * NPROJ + C_AV + kvh * 64;
#pragma unroll
                for (int i = 0; i < 8; ++i) { const v4u w = *(const GAS v4u*)(vr + 8 * i);
                    o[8 * i + 0] = o[8 * i + 0] * al + p * bflo(w.x); o[8 * i + 1] = o[8 * i + 1] * al + p * bfhi(w.x);
                    o[8 * i + 2] = o[8 * i + 2] * al + p * bflo(w.y); o[8 * i + 3] = o[8 * i + 3] * al + p * bfhi(w.y);
                    o[8 * i + 4] = o[8 * i + 4] * al + p * bflo(w.z); o[8 * i + 5] = o[8 * i + 5] * al + p * bfhi(w.z);
                    o[8 * i + 6] = o[8 * i + 6] * al + p * bflo(w.w); o[8 * i + 7] = o[8 * i + 7] * al + p * bfhi(w.w); }
            }
        }
        const float il = 1.f / l; bf16* orow = MI + (size_t)t * D + h * 64;
#pragma unroll
        for (int i = 0; i < 8; ++i) { v4u w; w.x = pk2(o[8 * i] * il, o[8 * i + 1] * il); w.y = pk2(o[8 * i + 2] * il, o[8 * i + 3] * il);
            w.z = pk2(o[8 * i + 4] * il, o[8 * i + 5] * il); w.w = pk2(o[8 * i + 6] * il, o[8 * i + 7] * il); *(GAS v4u*)(orow + 8 * i) = w; }
    }
}

__device__ __forceinline__ void phase_mlstm_naive(const Args& A, LAS unsigned char* lds, int bh) {
    const int tid = threadIdx.x, lane = tid & 63, wave = tid >> 6, b = bh >> 2, h = bh & 3, dv = tid >> 2, part = tid & 3;
    const bf16* P = (const bf16*)(A.ws + WS_PROJ); bf16* MI = (bf16*)(A.ws + WS_MIXIN); const float* gates = (const float*)(A.ws + WS_GATES);
    const float* cw = (const float*)A.in[I_CONVW]; const float* ng = (const float*)A.in[I_MNG];
    LAS float* qs = (LAS float*)lds; LAS float* ks = qs + 64 * 64; LAS float* vs = ks + 64 * 64; LAS float* ig = vs + 64 * 128; LAS float* lfg = ig + 64; LAS float* hb = lfg + 64;
    float C[16], n[16]; float m = 0.f;
#pragma unroll
    for (int j = 0; j < 16; ++j) { C[j] = 0.f; n[j] = 0.f; }
    for (int ch = 0; ch < SEQ / 64; ++ch) {
        const int s0 = ch * 64; const size_t t0 = (size_t)b * SEQ + s0;
        for (int e = tid; e < 64 * 64; e += NTHR) { const int l = e >> 6, dk = e & 63; float aq = 0.f, ak = 0.f;
#pragma unroll
            for (int j = 0; j < 4; ++j) { const int sj = s0 + l - 3 + j; if (sj >= 0) { const bf16* r = P + ((size_t)b * SEQ + sj) * NPROJ;
                aq += cw[j * 512 + h * 64 + dk] * bf1(r[C_MQ + h * 64 + dk]); ak += cw[j * 512 + 256 + h * 64 + dk] * bf1(r[C_MK + h * 64 + dk]); } }
            qs[e] = 0.125f * aq / (1.f + __expf(-aq)); ks[e] = ak / (1.f + __expf(-ak)); }
        for (int e = tid; e < 64 * 128; e += NTHR) { const int l = e >> 7, d = e & 127; vs[e] = bf1(P[(t0 + l) * NPROJ + C_MV + h * 128 + d]); }
        if (tid < 64) { ig[tid] = gates[(t0 + tid) * 8 + h]; lfg[tid] = gates[(t0 + tid) * 8 + 4 + h]; }
        __syncthreads();
        for (int l = 0; l < 64; ++l) {
            const float lf = lfg[l], ii = ig[l], mn = fmaxf(lf + m, ii), fd = __expf(lf + m - mn), iw = __expf(ii - mn), vv = vs[l * 128 + dv] * iw;
            float num = 0.f, den = 0.f;
#pragma unroll
            for (int j = 0; j < 16; ++j) { const float kk = ks[l * 64 + part * 16 + j], qq = qs[l * 64 + part * 16 + j];
                C[j] = fd * C[j] + vv * kk; n[j] = fd * n[j] + iw * kk; num += C[j] * qq; den += n[j] * qq; }
            num += __shfl_xor(num, 1); num += __shfl_xor(num, 2); den += __shfl_xor(den, 1); den += __shfl_xor(den, 2);
            if (part == 0) hb[l * 128 + dv] = num / fmaxf(fabsf(den), __expf(-mn));
            m = mn;
        }
        __syncthreads();
        for (int l = wave * 8; l < wave * 8 + 8; ++l) { const float a0 = hb[l * 128 + lane], a1 = hb[l * 128 + 64 + lane];
            const float r = 1.0f / sqrtf(wave_sum(a0 * a0 + a1 * a1) * (1.f / 128.f) + EPS);
            const bf16* pr = P + (t0 + l) * NPROJ + C_MO + h * 128; bf16* orow = MI + (t0 + l) * D + 512 + h * 128;
            orow[lane] = (bf16)f2bf(a0 * r * ng[h * 128 + lane] * bf1(pr[lane])); orow[64 + lane] = (bf16)f2bf(a1 * r * ng[h * 128 + 64 + lane] * bf1(pr[64 + lane])); }
        __syncthreads();
    }
}

__device__ __forceinline__ void ld16bf(const bf16* p, float (&o)[16]) {
    const v4u w0 = *(const GAS v4u*)p, w1 = *(const GAS v4u*)(p + 8);
    o[0] = bflo(w0.x); o[1] = bfhi(w0.x); o[2] = bflo(w0.y); o[3] = bfhi(w0.y); o[4] = bflo(w0.z); o[5] = bfhi(w0.z); o[6] = bflo(w0.w); o[7] = bfhi(w0.w);
    o[8] = bflo(w1.x); o[9] = bfhi(w1.x); o[10] = bflo(w1.y); o[11] = bfhi(w1.y); o[12] = bflo(w1.z); o[13] = bfhi(w1.z); o[14] = bflo(w1.w); o[15] = bfhi(w1.w);
}
typedef short bf16x8 __attribute__((ext_vector_type(8)));
#define MFMA16(a, b, c) __builtin_amdgcn_mfma_f32_16x16x32_bf16((a), (b), (c), 0, 0, 0)
__device__ __forceinline__ bf16x8 ldfrag(LAS const unsigned char* img, int row, int kbyte) { return *(LAS const bf16x8*)(img + row * 144 + kbyte); }
__device__ __forceinline__ bf16x8 ldfrag_sw(LAS const unsigned char* img, int row, int kbyte) { return *(LAS const bf16x8*)(img + row * 144 + (kbyte ^ (((row >> 3) & 7) << 4))); }
__device__ __forceinline__ unsigned cvtpk(float lo, float hi) { unsigned r; asm volatile("v_cvt_pk_bf16_f32 %0, %1, %2" : "=v"(r) : "v"(lo), "v"(hi)); return r; }

namespace ml {
constexpr int O_Q = 0, O_QA = 9216, O_K = 18432, O_KWT = 27648, O_VT = 36864, O_CX = 57600, CXB = 20736, O_S = 99072, O_GB = 108288, O_GA = O_GB + 4096, O_GC = O_GA + 4096, O_DEN = O_GC + 4096, O_SSQ = O_DEN + 256, O_END = O_SSQ + 2048;
static_assert(O_END <= 131072, "mlstm LDS");
constexpr size_t MST_SC = 11 * MiB;
}
template <bool OUT>
__device__ __forceinline__ void mlstm_group(const Args& A, LAS unsigned char* lds, int wg) {
    using namespace ml;
    const int tid = threadIdx.x, lane = tid & 63, wave = __builtin_amdgcn_readfirstlane(tid >> 6), fr = lane & 15, fq = lane >> 4;
    const int bh = wg >> 3, grp = wg & 7, b = bh >> 2, h = bh & 3;
    const size_t tg0 = (size_t)b * SEQ + (size_t)grp * 1024;
    const bf16* P = (const bf16*)(A.ws + WS_PROJ); bf16* MI = (bf16*)(A.ws + WS_MIXIN); const float* gates = (const float*)(A.ws + WS_GATES);
    const float* cw = (const float*)A.in[I_CONVW]; const float* ng = (const float*)A.in[I_MNG];
    float* MST = (float*)(A.ws + WS_MST); float* MSC = (float*)(A.ws + WS_MST + MST_SC);
    LAS float* GB = (LAS float*)(lds + O_GB); LAS float* GA = (LAS float*)(lds + O_GA); LAS float* GC = (LAS float*)(lds + O_GC);
    LAS float* DEN = (LAS float*)(lds + O_DEN); LAS float* SSQ = (LAS float*)(lds + O_SSQ);
    __syncthreads();
#pragma unroll
    for (int cc = 0; cc < 2; ++cc) { const int c = 2 * wave + cc; const size_t t = tg0 + c * 64 + lane;
        float bc = gates[t * 8 + 4 + h]; const float ii = gates[t * 8 + h];
#pragma unroll
        for (int o = 1; o < 64; o <<= 1) { const float v = __shfl_up(bc, o); if (lane >= o) bc += v; }
        const float a = ii - bc; float cm = a;
#pragma unroll
        for (int o = 1; o < 64; o <<= 1) { const float v = __shfl_up(cm, o); if (lane >= o) cm = fmaxf(cm, v); }
        GB[c * 64 + lane] = bc; GA[c * 64 + lane] = a; GC[c * 64 + lane] = cm; }
    for (int e = tid; e < 16 * 32; e += NTHR) { const int r = e >> 5, cpair = e & 31; *(LAS unsigned*)(lds + O_VT + (128 + r) * 144 + cpair * 4) = (r == 0) ? 0x3F803F80u : 0u; }
    f32x4 st[5];
#pragma unroll
    for (int i = 0; i < 5; ++i) st[i] = (f32x4){0.f, 0.f, 0.f, 0.f};
    float m = OUT ? 0.f : -__builtin_inff(); float Btot = 0.f;
    if (OUT) {
        for (int gp = 0; gp < grp; ++gp) { const int wgp = bh * 8 + gp; const float mg = MSC[wgp * 2], Bg = MSC[wgp * 2 + 1];
            const float mn = fmaxf(Bg + m, mg), f0 = __expf(Bg + m - mn), f1 = __expf(mg - mn);
#pragma unroll
            for (int i = 0; i < 5; ++i)
#pragma unroll
                for (int r = 0; r < 4; ++r) st[i][r] = f0 * st[i][r] + f1 * MST[((size_t)wgp * 20 + i * 4 + r) * NTHR + tid];
            m = mn; }
#pragma unroll
        for (int j = 0; j < 4; ++j)
#pragma unroll
            for (int r = 0; r < 4; ++r) *(LAS bf16*)(lds + O_CX + (16 * wave + 4 * fq + r) * 144 + (16 * j + fr) * 2) = (bf16)f2bf(st[j][r]);
        if (wave < 4) {
#pragma unroll
            for (int r = 0; r < 4; ++r) *(LAS bf16*)(lds + O_CX + (128 + 4 * fq + r) * 144 + (16 * wave + fr) * 2) = (bf16)f2bf(st[4][r]); }
    }
    float gsc[4];
#pragma unroll
    for (int r = 0; r < 4; ++r) gsc[r] = ng[h * 128 + 16 * wave + 4 * fq + r];
    const int sl = tid >> 3, cg = tid & 7;
    __syncthreads();
    for (int c = 0; c < 16; ++c) {
        const float bL = GB[c * 64 + 63], M63 = fmaxf(m, GC[c * 64 + 63]), decay = __expf(m - M63);
        const size_t tc0 = tg0 + (size_t)c * 64;
        {
            const int sabs = grp * 1024 + c * 64 + sl;
            float aq[8], ak[8];
#pragma unroll
            for (int i = 0; i < 8; ++i) { aq[i] = 0.f; ak[i] = 0.f; }
#pragma unroll
            for (int j = 0; j < 4; ++j) { const int sj = sabs - 3 + j;
                if (sj >= 0) { const bf16* rp = P + ((size_t)b * SEQ + sj) * NPROJ;
                    const v4u wq = *(const GAS v4u*)(rp + C_MQ + h * 64 + 8 * cg), wk = *(const GAS v4u*)(rp + C_MK + h * 64 + 8 * cg);
                    const f32x4 q0 = *(const GAS f32x4*)(cw + j * 512 + h * 64 + 8 * cg), q1 = *(const GAS f32x4*)(cw + j * 512 + h * 64 + 8 * cg + 4);
                    const f32x4 k0 = *(const GAS f32x4*)(cw + j * 512 + 256 + h * 64 + 8 * cg), k1 = *(const GAS f32x4*)(cw + j * 512 + 256 + h * 64 + 8 * cg + 4);
                    aq[0] += q0[0] * bflo(wq.x); aq[1] += q0[1] * bfhi(wq.x); aq[2] += q0[2] * bflo(wq.y); aq[3] += q0[3] * bfhi(wq.y);
                    aq[4] += q1[0] * bflo(wq.z); aq[5] += q1[1] * bfhi(wq.z); aq[6] += q1[2] * bflo(wq.w); aq[7] += q1[3] * bfhi(wq.w);
                    ak[0] += k0[0] * bflo(wk.x); ak[1] += k0[1] * bfhi(wk.x); ak[2] += k0[2] * bflo(wk.y); ak[3] += k0[3] * bfhi(wk.y);
                    ak[4] += k1[0] * bflo(wk.z); ak[5] += k1[1] * bfhi(wk.z); ak[6] += k1[2] * bflo(wk.w); ak[7] += k1[3] * bfhi(wk.w); } }
            const float Ml = fmaxf(m, GC[c * 64 + sl]), ainter = __expf(m - Ml), wsv = __expf(GA[c * 64 + sl] - M63);
            float qv[8], kv[8];
#pragma unroll
            for (int i = 0; i < 8; ++i) { qv[i] = 0.125f * aq[i] * __builtin_amdgcn_rcpf(1.f + __expf(-aq[i])); kv[i] = ak[i] * __builtin_amdgcn_rcpf(1.f + __expf(-ak[i])); }
            if (OUT) {
                v4u w; w.x = pk2(qv[0], qv[1]); w.y = pk2(qv[2], qv[3]); w.z = pk2(qv[4], qv[5]); w.w = pk2(qv[6], qv[7]); *(LAS v4u*)(lds + O_Q + sl * 144 + cg * 16) = w;
                w.x = pk2(qv[0] * ainter, qv[1] * ainter); w.y = pk2(qv[2] * ainter, qv[3] * ainter); w.z = pk2(qv[4] * ainter, qv[5] * ainter); w.w = pk2(qv[6] * ainter, qv[7] * ainter); *(LAS v4u*)(lds + O_QA + sl * 144 + cg * 16) = w;
                w.x = pk2(kv[0], kv[1]); w.y = pk2(kv[2], kv[3]); w.z = pk2(kv[4], kv[5]); w.w = pk2(kv[6], kv[7]); *(LAS v4u*)(lds + O_K + sl * 144 + cg * 16) = w;
            }
#pragma unroll
            for (int i = 0; i < 8; ++i) *(LAS bf16*)(lds + O_KWT + (8 * cg + i) * 144 + (sl ^ (8 * cg)) * 2) = (bf16)f2bf(kv[i] * wsv);
#pragma unroll
            for (int gi = 0; gi < 2; ++gi) { const int g8 = cg + 8 * gi; const v4u wv = *(const GAS v4u*)(P + (tc0 + sl) * NPROJ + C_MV + h * 128 + 8 * g8);
                const unsigned ww[4] = {wv.x, wv.y, wv.z, wv.w};
#pragma unroll
                for (int i = 0; i < 4; ++i) { *(LAS bf16*)(lds + O_VT + (8 * g8 + 2 * i) * 144 + (sl ^ (8 * cg)) * 2) = (bf16)(ww[i] & 0xffffu); *(LAS bf16*)(lds + O_VT + (8 * g8 + 2 * i + 1) * 144 + (sl ^ (8 * cg)) * 2) = (bf16)(ww[i] >> 16); } }
        }
        __syncthreads();
        if (OUT) {
            const int lt = wave >> 1, l = 16 * lt + fr; const float Ml = fmaxf(m, GC[c * 64 + l]);
            const bf16x8 bq0 = ldfrag(lds + O_Q, 16 * lt + fr, 16 * fq), bq1 = ldfrag(lds + O_Q, 16 * lt + fr, 64 + 16 * fq);
#pragma unroll
            for (int u = 0; u < 2; ++u) { const int stl = 2 * (wave & 1) + u; f32x4 acc = {0.f, 0.f, 0.f, 0.f};
                acc = MFMA16(ldfrag(lds + O_K, 16 * stl + fr, 16 * fq), bq0, acc); acc = MFMA16(ldfrag(lds + O_K, 16 * stl + fr, 64 + 16 * fq), bq1, acc);
                const f32x4 av = *(LAS const f32x4*)(GA + c * 64 + 16 * stl + 4 * fq); float wv[4];
#pragma unroll
                for (int r = 0; r < 4; ++r) { const int s = 16 * stl + 4 * fq + r; wv[r] = (s <= l) ? acc[r] * __expf(av[r] - Ml) : 0.f; }
                v2u w; w.x = cvtpk(wv[0], wv[1]); w.y = cvtpk(wv[2], wv[3]); *(LAS v2u*)(lds + O_S + l * 144 + (16 * stl + 4 * fq) * 2) = w; }
        }
        {
            const bf16x8 va0 = ldfrag_sw(lds + O_VT, 16 * wave + fr, 16 * fq), va1 = ldfrag_sw(lds + O_VT, 16 * wave + fr, 64 + 16 * fq);
#pragma unroll
            for (int j = 0; j < 4; ++j) { st[j] = st[j] * decay;
                st[j] = MFMA16(va0, ldfrag_sw(lds + O_KWT, 16 * j + fr, 16 * fq), st[j]); st[j] = MFMA16(va1, ldfrag_sw(lds + O_KWT, 16 * j + fr, 64 + 16 * fq), st[j]); }
            if (wave < 4) { st[4] = st[4] * decay;
                st[4] = MFMA16(ldfrag_sw(lds + O_VT, 128 + fr, 16 * fq), ldfrag_sw(lds + O_KWT, 16 * wave + fr, 16 * fq), st[4]);
                st[4] = MFMA16(ldfrag_sw(lds + O_VT, 128 + fr, 64 + 16 * fq), ldfrag_sw(lds + O_KWT, 16 * wave + fr, 64 + 16 * fq), st[4]); }
        }
        if (OUT) {
            __syncthreads();
            LAS const unsigned char* cx = lds + O_CX + (c & 1) * CXB;
            f32x4 nt[4], nd = {0.f, 0.f, 0.f, 0.f};
            {
                const bf16x8 va0 = ldfrag_sw(lds + O_VT, 16 * wave + fr, 16 * fq), va1 = ldfrag_sw(lds + O_VT, 16 * wave + fr, 64 + 16 * fq);
                const bf16x8 ca0 = ldfrag(cx, 16 * wave + fr, 16 * fq), ca1 = ldfrag(cx, 16 * wave + fr, 64 + 16 * fq);
#pragma unroll
                for (int lt = 0; lt < 4; ++lt) { f32x4 acc = {0.f, 0.f, 0.f, 0.f};
                    acc = MFMA16(va0, ldfrag(lds + O_S, 16 * lt + fr, 16 * fq), acc); acc = MFMA16(va1, ldfrag(lds + O_S, 16 * lt + fr, 64 + 16 * fq), acc);
                    acc = MFMA16(ca0, ldfrag(lds + O_QA, 16 * lt + fr, 16 * fq), acc); acc = MFMA16(ca1, ldfrag(lds + O_QA, 16 * lt + fr, 64 + 16 * fq), acc); nt[lt] = acc; }
                if (wave >= 4) { const int lt = wave - 4;
                    nd = MFMA16(ldfrag_sw(lds + O_VT, 128 + fr, 16 * fq), ldfrag(lds + O_S, 16 * lt + fr, 16 * fq), nd); nd = MFMA16(ldfrag_sw(lds + O_VT, 128 + fr, 64 + 16 * fq), ldfrag(lds + O_S, 16 * lt + fr, 64 + 16 * fq), nd);
                    nd = MFMA16(ldfrag(cx, 128 + fr, 16 * fq), ldfrag(lds + O_QA, 16 * lt + fr, 16 * fq), nd); nd = MFMA16(ldfrag(cx, 128 + fr, 64 + 16 * fq), ldfrag(lds + O_QA, 16 * lt + fr, 64 + 16 * fq), nd);
                    if (fq == 0) DEN[16 * lt + fr] = nd[0]; }
            }
            v2u mo[4];
#pragma unroll
            for (int lt = 0; lt < 4; ++lt) mo[lt] = *(const GAS v2u*)(P + (tc0 + 16 * lt + fr) * NPROJ + C_MO + h * 128 + 16 * wave + 4 * fq);
            __syncthreads();
#pragma unroll
            for (int lt = 0; lt < 4; ++lt) { const int l = 16 * lt + fr; const float Ml = fmaxf(m, GC[c * 64 + l]);
                const float inv = 1.0f / fmaxf(fabsf(DEN[l]), __expf(-(GB[c * 64 + l] + Ml)));
                nt[lt] = nt[lt] * inv; float ss = (nt[lt][0] * nt[lt][0] + nt[lt][1] * nt[lt][1]) + (nt[lt][2] * nt[lt][2] + nt[lt][3] * nt[lt][3]);
                ss += __shfl_xor(ss, 16); ss += __shfl_xor(ss, 32);
                if (fq == 0) SSQ[wave * 64 + l] = ss; }
            LAS unsigned char* cxn = lds + O_CX + ((c + 1) & 1) * CXB;
#pragma unroll
            for (int j = 0; j < 4; ++j)
#pragma unroll
                for (int r = 0; r < 4; ++r) *(LAS bf16*)(cxn + (16 * wave + 4 * fq + r) * 144 + (16 * j + fr) * 2) = (bf16)f2bf(st[j][r]);
            if (wave < 4) {
#pragma unroll
                for (int r = 0; r < 4; ++r) *(LAS bf16*)(cxn + (128 + 4 * fq + r) * 144 + (16 * wave + fr) * 2) = (bf16)f2bf(st[4][r]); }
            __syncthreads();
#pragma unroll
            for (int lt = 0; lt < 4; ++lt) { const int l = 16 * lt + fr; float tot = 0.f;
#pragma unroll
                for (int w2 = 0; w2 < 8; ++w2) tot += SSQ[w2 * 64 + l];
                const float rn = 1.0f / sqrtf(tot * (1.f / 128.f) + EPS);
                const float o0 = nt[lt][0] * rn * gsc[0] * bflo(mo[lt].x), o1 = nt[lt][1] * rn * gsc[1] * bfhi(mo[lt].x), o2 = nt[lt][2] * rn * gsc[2] * bflo(mo[lt].y), o3 = nt[lt][3] * rn * gsc[3] * bfhi(mo[lt].y);
                v2u w; w.x = pk2(o0, o1); w.y = pk2(o2, o3);
                *(GAS v2u*)(MI + (tc0 + l) * D + 512 + h * 128 + 16 * wave + 4 * fq) = w; }
        } else {
            __syncthreads();
        }
        m = bL + M63; Btot += bL;
    }
    if (!OUT) {
#pragma unroll
        for (int i = 0; i < 5; ++i)
#pragma unroll
            for (int r = 0; r < 4; ++r) MST[((size_t)wg * 20 + i * 4 + r) * NTHR + tid] = st[i][r];
        if (tid == 0) { MSC[wg * 2] = m; MSC[wg * 2 + 1] = Btot; }
    }
}

namespace at {
constexpr int O_K = 0, O_VT = 36864, VTS = 592  , O_END = O_VT + 64 * VTS;
static_assert(O_END <= 131072, "attention LDS");
}
__device__ __forceinline__ void phase_attn(const Args& A, LAS unsigned char* lds) {
    using namespace at;
    const int tid = threadIdx.x, lane = tid & 63, wave = __builtin_amdgcn_readfirstlane(tid >> 6), fr = lane & 15, fq = lane >> 4, G = gridDim.x;
    const bf16* P = (const bf16*)(A.ws + WS_PROJ); bf16* MI = (bf16*)(A.ws + WS_MIXIN); const float* sinks = (const float*)A.in[I_SINK];
    __syncthreads();
    for (int e = tid; e < 64 * 16; e += NTHR) { const int r = e >> 4, cpair = e & 15; *(LAS unsigned*)(lds + O_VT + r * VTS + 512 + cpair * 4) = 0u; }
    for (int unit = blockIdx.x; unit < NB * 64 * 2; unit += G) {
        const int g = unit & 1, n = (unit >> 1) & 63, b = unit >> 7;
        const size_t tq0 = (size_t)b * SEQ + (size_t)n * 128;
        __syncthreads();
#pragma unroll
        for (int i = 0; i < 4; ++i) { const int item = tid + NTHR * i, row = item >> 3, ch = item & 7;
            v4u wk = {0u, 0u, 0u, 0u}, wv = {0u, 0u, 0u, 0u};
            if (n > 0 || row >= 128) { const bf16* rp = P + (tq0 - 128 + row) * NPROJ; wk = *(const GAS v4u*)(rp + C_AK + g * 64 + 8 * ch); wv = *(const GAS v4u*)(rp + C_AV + g * 64 + 8 * ch); }
            *(LAS v4u*)(lds + O_K + row * 144 + ch * 16) = wk;
            const unsigned ww[4] = {wv.x, wv.y, wv.z, wv.w};
#pragma unroll
            for (int k = 0; k < 4; ++k) { *(LAS bf16*)(lds + O_VT + (8 * ch + 2 * k) * VTS + (row ^ (4 * ch)) * 2) = (bf16)(ww[k] & 0xffffu); *(LAS bf16*)(lds + O_VT + (8 * ch + 2 * k + 1) * VTS + (row ^ (4 * ch)) * 2) = (bf16)(ww[k] >> 16); } }
        const int hq = 4 * g + (wave >> 1), qr0 = 64 * (wave & 1); const float sink = sinks[hq];
        __syncthreads();
        for (int qt = 0; qt < 4; ++qt) {
            const int i0 = qr0 + 16 * qt, st0 = i0 >> 4, iq = i0 + fr;
            const bf16* qp = P + (tq0 + iq) * NPROJ + C_AQ + hq * 64 + 8 * fq;
            const bf16x8 bq0 = *(const GAS bf16x8*)qp, bq1 = *(const GAS bf16x8*)(qp + 32);
            f32x4 sc[9]; float mx = sink;
#pragma unroll
            for (int t = 0; t < 9; ++t) { const int sb0 = 16 * (st0 + t); f32x4 acc = {0.f, 0.f, 0.f, 0.f};
                acc = MFMA16(ldfrag(lds + O_K, sb0 + fr, 16 * fq), bq0, acc); acc = MFMA16(ldfrag(lds + O_K, sb0 + fr, 64 + 16 * fq), bq1, acc);
#pragma unroll
                for (int r = 0; r < 4; ++r) { const int sb = sb0 + 4 * fq + r; const bool valid = (sb > iq) && (sb <= iq + 128) && (n > 0 || sb >= 128);
                    acc[r] = valid ? acc[r] : -3.0e38f; mx = fmaxf(mx, acc[r]); }
                sc[t] = acc; }
            mx = fmaxf(mx, __shfl_xor(mx, 16)); mx = fmaxf(mx, __shfl_xor(mx, 32));
            float lsum = 0.f;
#pragma unroll
            for (int t = 0; t < 9; ++t)
#pragma unroll
                for (int r = 0; r < 4; ++r) { const float p = (sc[t][r] > -1.0e38f) ? __expf(sc[t][r] - mx) : 0.f; sc[t][r] = p; lsum += p; }
            lsum += __shfl_xor(lsum, 16); lsum += __shfl_xor(lsum, 32); lsum += __expf(sink - mx);
            f32x4 oacc[4];
#pragma unroll
            for (int dt = 0; dt < 4; ++dt) oacc[dt] = (f32x4){0.f, 0.f, 0.f, 0.f};
#pragma unroll
            for (int ks = 0; ks < 5; ++ks) {
                union { bf16x8 v; unsigned u[4]; } pb;
                pb.u[0] = cvtpk(sc[2 * ks][0], sc[2 * ks][1]); pb.u[1] = cvtpk(sc[2 * ks][2], sc[2 * ks][3]);
                if (ks < 4) { pb.u[2] = cvtpk(sc[2 * ks + 1][0], sc[2 * ks + 1][1]); pb.u[3] = cvtpk(sc[2 * ks + 1][2], sc[2 * ks + 1][3]); } else { pb.u[2] = 0u; pb.u[3] = 0u; }
                const int sbb = 16 * (st0 + 2 * ks) + 4 * fq;
#pragma unroll
                for (int dt = 0; dt < 4; ++dt) { const int dd = 16 * dt + fr, sx = 4 * ((dd >> 3) & 7); LAS const unsigned char* vrow = lds + O_VT + dd * VTS;
                    union { bf16x8 v; v2u h[2]; } va; va.h[0] = *(LAS const v2u*)(vrow + (sbb ^ sx) * 2); va.h[1] = *(LAS const v2u*)(vrow + ((sbb + 16) ^ sx) * 2);
                    oacc[dt] = MFMA16(va.v, pb.v, oacc[dt]); } }
            const float il = 1.0f / lsum;
#pragma unroll
            for (int dt = 0; dt < 4; ++dt) { v2u w; w.x = pk2(oacc[dt][0] * il, oacc[dt][1] * il); w.y = pk2(oacc[dt][2] * il, oacc[dt][3] * il);
                *(GAS v2u*)(MI + (tq0 + iq) * D + hq * 64 + 16 * dt + 4 * fq) = w; }
        }
    }
}
typedef float f32x16 __attribute__((ext_vector_type(16)));
__device__ __forceinline__ unsigned fbits(float f) { return __builtin_bit_cast(unsigned, f); }
__device__ __forceinline__ float bfloat(unsigned u) { return __builtin_bit_cast(float, u); }

#define CE_DESC(a, b) do { const float _mx = __builtin_fmaxf(a, b), _mn = __builtin_fminf(a, b); a = _mx; b = _mn; } while (0)
__device__ __forceinline__ void bsort16(float (&v)[16]) {
#pragma unroll
    for (int k = 2; k <= 16; k <<= 1)
#pragma unroll
        for (int j = k >> 1; j > 0; j >>= 1)
#pragma unroll
            for (int i = 0; i < 16; ++i) { const int l = i ^ j; if (l > i) { if ((i & k) == 0) CE_DESC(v[i], v[l]); else CE_DESC(v[l], v[i]); } }
}
__device__ __forceinline__ void bmerge16(float (&v)[16], const float (&w)[16]) {
#pragma unroll
    for (int i = 0; i < 16; ++i) v[i] = __builtin_fmaxf(v[i], w[15 - i]);
#pragma unroll
    for (int j = 8; j > 0; j >>= 1)
#pragma unroll
        for (int i = 0; i < 16; ++i) { const int l = i ^ j; if (l > i) CE_DESC(v[i], v[l]); }
}
namespace tk {
constexpr int KS = 272;
constexpr int O_K1 = 0, O_K2 = 128 * KS, O_X = 2 * 128 * KS, O_END = O_X + 8 * 4096;
static_assert(O_END <= 131072, "topk LDS");
constexpr unsigned char CAND[64] = {
    0x00, 0x01, 0x02, 0x03, 0x04, 0x05, 0x06, 0x07, 0x08, 0x09, 0x0a, 0x0b, 0x0c, 0x0d, 0x0e, 0x0f,
    0x10, 0x11, 0x12, 0x13, 0x14, 0x15, 0x16, 0x17, 0x80, 0x90, 0xa0, 0xb0, 0xc0, 0xd0, 0xe0, 0xf0,
    0x20, 0x21, 0x22, 0x23, 0x24, 0x30, 0x31, 0x32, 0x33, 0x40, 0x41, 0x42, 0x50, 0x51, 0x60, 0x61,
    0x70, 0x71, 0xff, 0xff, 0xff, 0xff, 0xff, 0xff, 0xff, 0xff, 0xff, 0xff, 0xff, 0xff, 0xff, 0xff};
}
__device__ __forceinline__ void side_top16(const f32x16 (&acc)[4], int hh, float (&T)[16]) {
    float g1[16], g2[16];
#pragma unroll
    for (int r = 0; r < 16; ++r) { const unsigned key = (r & 3) + 8 * (r >> 2) + 4 * hh;
        T[r] = bfloat((fbits(acc[0][r]) & 0xffffff80u) | key);
        g1[r] = bfloat((fbits(acc[1][r]) & 0xffffff80u) | (32u + key)); }
    bsort16(T); bsort16(g1); bmerge16(T, g1);
#pragma unroll
    for (int r = 0; r < 16; ++r) { const unsigned key = (r & 3) + 8 * (r >> 2) + 4 * hh;
        g1[r] = bfloat((fbits(acc[2][r]) & 0xffffff80u) | (64u + key));
        g2[r] = bfloat((fbits(acc[3][r]) & 0xffffff80u) | (96u + key)); }
    bsort16(g1); bsort16(g2); bmerge16(g1, g2); bmerge16(T, g1);
#pragma unroll
    for (int r = 0; r < 16; ++r) g1[r] = __shfl_xor(T[r], 32);
    bmerge16(T, g1);
}
struct TopkQ { bf16x8 f[8]; };
template <int SD> __device__ __forceinline__ void topk_ldq(const bf16* Q, int t, int h, int hh, TopkQ& q) {
    const bf16* qp = Q + (size_t)t * 2048 + h * 256 + SD * 128 + 8 * hh;
#pragma unroll
    for (int ks = 0; ks < 8; ++ks) q.f[ks] = *(const GAS bf16x8*)(qp + 16 * ks);
}
template <int SD> __device__ __forceinline__ void topk_scores(const TopkQ& q, LAS unsigned char* lds, int r32, int hh, f32x16 (&acc)[4]) {
    using namespace tk;
#pragma unroll
    for (int mt = 0; mt < 4; ++mt)
#pragma unroll
        for (int r = 0; r < 16; ++r) acc[mt][r] = 0.f;
    LAS const unsigned char* kimg = lds + (SD ? O_K2 : O_K1);
#pragma unroll
    for (int ks = 0; ks < 8; ++ks) {
#pragma unroll
        for (int mt = 0; mt < 4; ++mt) acc[mt] = __builtin_amdgcn_mfma_f32_32x32x16_bf16(*(LAS const bf16x8*)(kimg + (32 * mt + r32) * KS + 32 * ks + 16 * hh), q.f[ks], acc[mt], 0, 0, 0); }
}
template <int Q> __device__ __forceinline__ float cand_val(const float (&T1)[16], const float (&T2)[16], int hh) {
    constexpr unsigned c0 = tk::CAND[2 * Q], c1 = tk::CAND[2 * Q + 1];
    const float s = (hh ? T1[(c1 >> 4) & 15] : T1[(c0 >> 4) & 15]) + (hh ? T2[c1 & 15] : T2[c0 & 15]); const unsigned code = hh ? c1 : c0;
    return (code == 0xffu) ? -3.0e38f : bfloat((fbits(s) & 0xffffff00u) | code);
}
__device__ __forceinline__ void phase_topk(const Args& A, LAS unsigned char* lds) {
    using namespace tk;
    const int tid = threadIdx.x, lane = tid & 63, wave = __builtin_amdgcn_readfirstlane(tid >> 6), G = gridDim.x;
    const bf16* Q = (const bf16*)(A.ws + WS_PROJ); const bf16* KB = (const bf16*)(A.ws + WS_KEYS);
    unsigned short* EI = (unsigned short*)(A.ws + WS_EIDX); float* GT = (float*)(A.ws + WS_GATE);
    const int h = blockIdx.x & 7, r32 = lane & 31, hh = lane >> 5;
    __syncthreads();
    for (int e = tid; e < 2 * 128 * 16; e += NTHR) { const int s = e >> 11, row = (e >> 4) & 127, ch = e & 15;
        *(LAS v4u*)(lds + (s ? O_K2 : O_K1) + row * KS + ch * 16) = *(const GAS v4u*)(KB + (size_t)s * 8 * 128 * 128 + ((size_t)h * 128 + row) * 128 + ch * 8); }
    __syncthreads();
    LAS float* XW = (LAS float*)(lds + O_X + wave * 4096) + r32 * 32;
    TopkQ qf; topk_ldq<0>(Q, (int)(blockIdx.x >> 3) * 256 + 32 * wave + r32, h, hh, qf);
    for (int tile = (int)(blockIdx.x >> 3); tile < M / 256; tile += (G >> 3)) {
        const int t = tile * 256 + 32 * wave + r32;
        float T1[16], T2[16];
        { f32x16 acc[4]; topk_scores<0>(qf, lds, r32, hh, acc);
          topk_ldq<1>(Q, t, h, hh, qf);
          side_top16(acc, hh, T1); }
        { f32x16 acc[4]; topk_scores<1>(qf, lds, r32, hh, acc);
          const int tn = min(tile + (int)(G >> 3), M / 256 - 1) * 256 + 32 * wave + r32; topk_ldq<0>(Q, tn, h, hh, qf);
          side_top16(acc, hh, T2); }
        float c[16], w[16];
        c[0] = cand_val<0>(T1, T2, hh); w[0] = cand_val<16>(T1, T2, hh);
        c[1] = cand_val<1>(T1, T2, hh); w[1] = cand_val<17>(T1, T2, hh);
        c[2] = cand_val<2>(T1, T2, hh); w[2] = cand_val<18>(T1, T2, hh);
        c[3] = cand_val<3>(T1, T2, hh); w[3] = cand_val<19>(T1, T2, hh);
        c[4] = cand_val<4>(T1, T2, hh); w[4] = cand_val<20>(T1, T2, hh);
        c[5] = cand_val<5>(T1, T2, hh); w[5] = cand_val<21>(T1, T2, hh);
        c[6] = cand_val<6>(T1, T2, hh); w[6] = cand_val<22>(T1, T2, hh);
        c[7] = cand_val<7>(T1, T2, hh); w[7] = cand_val<23>(T1, T2, hh);
        c[8] = cand_val<8>(T1, T2, hh); w[8] = cand_val<24>(T1, T2, hh);
        c[9] = cand_val<9>(T1, T2, hh); w[9] = cand_val<25>(T1, T2, hh);
        c[10] = cand_val<10>(T1, T2, hh); w[10] = cand_val<26>(T1, T2, hh);
        c[11] = cand_val<11>(T1, T2, hh); w[11] = cand_val<27>(T1, T2, hh);
        c[12] = cand_val<12>(T1, T2, hh); w[12] = cand_val<28>(T1, T2, hh);
        c[13] = cand_val<13>(T1, T2, hh); w[13] = cand_val<29>(T1, T2, hh);
        c[14] = cand_val<14>(T1, T2, hh); w[14] = cand_val<30>(T1, T2, hh);
        c[15] = cand_val<15>(T1, T2, hh); w[15] = cand_val<31>(T1, T2, hh);
        bsort16(c); bsort16(w); bmerge16(c, w);
#pragma unroll
        for (int r = 0; r < 16; ++r) w[r] = __shfl_xor(c[r], 32);
        bmerge16(c, w);
        if (hh == 0) {
#pragma unroll
            for (int q4 = 0; q4 < 4; ++q4) { *(LAS f32x4*)(XW + 4 * q4) = (f32x4){T1[4 * q4], T1[4 * q4 + 1], T1[4 * q4 + 2], T1[4 * q4 + 3]};
                *(LAS f32x4*)(XW + 16 + 4 * q4) = (f32x4){T2[4 * q4], T2[4 * q4 + 1], T2[4 * q4 + 2], T2[4 * q4 + 3]}; } }
        asm volatile("s_waitcnt lgkmcnt(0)" ::: "memory");
        float ex[16], sum = 0.f; const float tmax = bfloat(fbits(c[0]) & 0xffffff00u);
#pragma unroll
        for (int r = 0; r < 16; ++r) { ex[r] = __expf(bfloat(fbits(c[r]) & 0xffffff00u) - tmax); sum += ex[r]; }
        const float isum = 1.0f / sum; const size_t ob = (size_t)t * NSLOT + (size_t)(8 * hh) * 8 + h;
#pragma unroll
        for (int r = 0; r < 8; ++r) { float ca = c[r], cb = c[8 + r], ea = ex[r], eb = ex[8 + r]; asm volatile("" : "+v"(ca), "+v"(cb), "+v"(ea), "+v"(eb)); const float cv = hh ? cb : ca, ev = hh ? eb : ea;
            const unsigned code = fbits(cv) & 0xffu;
            const unsigned i1 = fbits(XW[code >> 4]) & 127u, i2 = fbits(XW[16 + (code & 15)]) & 127u;
            EI[ob + 8 * r] = (unsigned short)(i1 * 128u + i2); GT[ob + 8 * r] = ev * isum; }
        asm volatile("s_waitcnt lgkmcnt(0)" ::: "memory");
    }
}
struct PeerIdx { v4u e0, e1; };
__device__ __forceinline__ PeerIdx peer_ld_idx(const unsigned short* EI, int t, int g) { PeerIdx r; r.e0 = *(const GAS v4u*)(EI + (size_t)t * NSLOT + 16 * g); r.e1 = *(const GAS v4u*)(EI + (size_t)t * NSLOT + 16 * g + 8); return r; }
template <int ROWB = 1024> __device__ __forceinline__ void peer_gather(const unsigned char* T8, const PeerIdx& ix, int colb, v4u (&raw)[16]) {
    const unsigned ew[8] = {ix.e0.x, ix.e0.y, ix.e0.z, ix.e0.w, ix.e1.x, ix.e1.y, ix.e1.z, ix.e1.w};
#pragma unroll
    for (int k = 0; k < 16; ++k) { const unsigned e = (k & 1) ? (ew[k >> 1] >> 16) : (ew[k >> 1] & 0xffffu); raw[k] = *(const GAS v4u*)(T8 + (size_t)e * ROWB + colb); }
}
__device__ __forceinline__ void cvt16_fp8_pk(const v4u w, f32x2 (&o)[8]) {
    const unsigned ww[4] = {w.x, w.y, w.z, w.w};
#pragma unroll
    for (int i = 0; i < 4; ++i) { o[2 * i] = __builtin_amdgcn_cvt_pk_f32_fp8((int)ww[i], false); o[2 * i + 1] = __builtin_amdgcn_cvt_pk_f32_fp8((int)ww[i], true); }
}
__device__ __forceinline__ void peer_u_reduce(const v4u (&raw)[16], const f32x2 (&hv)[8], float* PDrow, int lane, int g, int c) {
    float d[16];
#pragma unroll
    for (int k = 0; k < 16; ++k) { f32x2 uf[8]; cvt16_fp8_pk(raw[k], uf); f32x2 s = uf[0] * hv[0];
#pragma unroll
        for (int i = 1; i < 8; ++i) s += uf[i] * hv[i];
        d[k] = s.x + s.y; }
#pragma unroll
    for (int i = 0; i < 8; ++i) { const bool up = (lane & 4) != 0; const float keep = up ? d[i + 8] : d[i], send = up ? d[i] : d[i + 8]; d[i] = keep + __shfl_xor(send, 4); }
#pragma unroll
    for (int i = 0; i < 4; ++i) { const bool up = (lane & 2) != 0; const float keep = up ? d[i + 4] : d[i], send = up ? d[i] : d[i + 4]; d[i] = keep + __shfl_xor(send, 2); }
#pragma unroll
    for (int i = 0; i < 2; ++i) { const bool up = (lane & 1) != 0; const float keep = up ? d[i + 2] : d[i], send = up ? d[i] : d[i + 2]; d[i] = keep + __shfl_xor(send, 1); }
    *(GAS f32x2*)(PDrow + 16 * g + 2 * c) = (f32x2){d[0], d[1]};
}
__device__ __forceinline__ void ld16bf_pk(const bf16* p, f32x2 (&o)[8]) {
    const v4u w0 = *(const GAS v4u*)p, w1 = *(const GAS v4u*)(p + 8); const unsigned ww[8] = {w0.x, w0.y, w0.z, w0.w, w1.x, w1.y, w1.z, w1.w};
#pragma unroll
    for (int i = 0; i < 8; ++i) o[i] = (f32x2){bflo(ww[i]), bfhi(ww[i])};
}
__device__ __forceinline__ void peer_u_reduce_i4(const v4u (&raw)[16], const v4u hh, const v4u hl, int* PDrow, int lane, int g, int c) {
    int d[16];
#pragma unroll
    for (int k = 0; k < 16; ++k) { int sh = __builtin_amdgcn_sdot8((int)raw[k].x, (int)hh.x, 0, false), sl = __builtin_amdgcn_sdot8((int)raw[k].x, (int)hl.x, 0, false);
        sh = __builtin_amdgcn_sdot8((int)raw[k].y, (int)hh.y, sh, false); sl = __builtin_amdgcn_sdot8((int)raw[k].y, (int)hl.y, sl, false);
        sh = __builtin_amdgcn_sdot8((int)raw[k].z, (int)hh.z, sh, false); sl = __builtin_amdgcn_sdot8((int)raw[k].z, (int)hl.z, sl, false);
        sh = __builtin_amdgcn_sdot8((int)raw[k].w, (int)hh.w, sh, false); sl = __builtin_amdgcn_sdot8((int)raw[k].w, (int)hl.w, sl, false);
        d[k] = 16 * sh + sl; }
#pragma unroll
    for (int i = 0; i < 8; ++i) { const bool up = (lane & 4) != 0; const int keep = up ? d[i + 8] : d[i], send = up ? d[i] : d[i + 8]; d[i] = keep + __shfl_xor(send, 4); }
#pragma unroll
    for (int i = 0; i < 4; ++i) { const bool up = (lane & 2) != 0; const int keep = up ? d[i + 4] : d[i], send = up ? d[i] : d[i + 4]; d[i] = keep + __shfl_xor(send, 2); }
#pragma unroll
    for (int i = 0; i < 2; ++i) { const bool up = (lane & 1) != 0; const int keep = up ? d[i + 2] : d[i], send = up ? d[i] : d[i + 2]; d[i] = keep + __shfl_xor(send, 1); }
    *(GAS v2u*)(PDrow + 16 * g + 2 * c) = (v2u){(unsigned)d[0], (unsigned)d[1]};
}
__device__ __forceinline__ void phase_peer_u(const Args& A) {
    const int tid = threadIdx.x, lane = tid & 63, wave = tid >> 6, p = blockIdx.x & 7, q = p & 3, half = p >> 2, j = blockIdx.x >> 3, nj = gridDim.x >> 3, g = lane >> 3, c = lane & 7;
    const unsigned char* HH = (const unsigned char*)(A.ws + WS_H8); const unsigned char* HL = HH + 32 * MiB; const unsigned char* U4 = (const unsigned char*)(A.ws + WS_U8); const unsigned short* EI = (const unsigned short*)(A.ws + WS_EIDX);
    int* PD = (int*)(A.ws + WS_PD) + (size_t)q * M * NSLOT;
    const int tper = (M / 2) / nj, colb = 128 * q + 16 * c, tbeg = half * (M / 2) + j * tper, tend = tbeg + tper, tlast = tend - NWAVES + wave;
    int t = tbeg + wave;
    PeerIdx ix1 = peer_ld_idx(EI, min(t + NWAVES, tlast), g), ix2 = peer_ld_idx(EI, min(t + 2 * NWAVES, tlast), g);
    v4u rawa[16], rawb[16], hha, hla, hhb, hlb;
    { const PeerIdx ix0 = peer_ld_idx(EI, t, g); peer_gather<512>(U4, ix0, colb, rawa); hha = *(const GAS v4u*)(HH + (size_t)t * 512 + colb); hla = *(const GAS v4u*)(HL + (size_t)t * 512 + colb); }
    for (; t < tend; t += 2 * NWAVES) {
        const int t1 = t + NWAVES, t2 = min(t + 2 * NWAVES, tlast), t3 = min(t + 3 * NWAVES, tlast), t4 = min(t + 4 * NWAVES, tlast);
        const PeerIdx ix3 = peer_ld_idx(EI, t3, g);
        peer_gather<512>(U4, ix1, colb, rawb); hhb = *(const GAS v4u*)(HH + (size_t)t1 * 512 + colb); hlb = *(const GAS v4u*)(HL + (size_t)t1 * 512 + colb);
        peer_u_reduce_i4(rawa, hha, hla, PD + (size_t)t * NSLOT, lane, g, c);
        const PeerIdx ix4 = peer_ld_idx(EI, t4, g);
        peer_gather<512>(U4, ix2, colb, rawa); hha = *(const GAS v4u*)(HH + (size_t)t2 * 512 + colb); hla = *(const GAS v4u*)(HL + (size_t)t2 * 512 + colb);
        peer_u_reduce_i4(rawb, hhb, hlb, PD + (size_t)t1 * NSLOT, lane, g, c);
        ix1 = ix3; ix2 = ix4;
    }
}
__device__ __forceinline__ void phase_peer_act(const Args& A) {
    const int* PD = (const int*)(A.ws + WS_PD); const unsigned short* EI = (const unsigned short*)(A.ws + WS_EIDX); const float* GT = (const float*)(A.ws + WS_GATE);
    const float* usc = (const float*)(A.ws + WS_SC); const float* vsc = usc + NEXP; const float* hs = (const float*)(A.ws + WS_HS); float* ACT = (float*)(A.ws + WS_ACT);
    typedef int i32x4 __attribute__((ext_vector_type(4)));
    for (size_t i = ((size_t)blockIdx.x * NTHR + threadIdx.x) * 4; i < (size_t)M * NSLOT; i += (size_t)gridDim.x * NTHR * 4) {
        const i32x4 p0 = *(const GAS i32x4*)(PD + i), p1 = *(const GAS i32x4*)(PD + (size_t)M * NSLOT + i), p2 = *(const GAS i32x4*)(PD + (size_t)2 * M * NSLOT + i), p3 = *(const GAS i32x4*)(PD + (size_t)3 * M * NSLOT + i);
        const v2u ew = *(const GAS v2u*)(EI + i); const f32x4 gt = *(const GAS f32x4*)(GT + i); const float hsv = hs[i >> 7];
        const unsigned e[4] = {ew.x & 0xffffu, ew.x >> 16, ew.y & 0xffffu, ew.y >> 16};
        const i32x4 si = (p0 + p1) + (p2 + p3); f32x4 o;
#pragma unroll
        for (int k = 0; k < 4; ++k) { const float s = (float)si[k] * (usc[e[k]] * hsv); o[k] = 0.5f * s * (1.f + erff(s * 0.70710678118654752f)) * gt[k] * vsc[e[k]]; }
        *(GAS f32x4*)(ACT + i) = o;
    }
}
struct PeerAct { f32x4 a0, a1, a2, a3; };
__device__ __forceinline__ PeerAct peer_ld_act(const float* ACT, int t, int g) { const GAS f32x4* ap = (const GAS f32x4*)(ACT + (size_t)t * NSLOT + 16 * g); PeerAct r; r.a0 = ap[0]; r.a1 = ap[1]; r.a2 = ap[2]; r.a3 = ap[3]; return r; }
__device__ __forceinline__ void peer_v_accum(const v4u (&raw)[16], const PeerAct& pa, f32x2 (&y2)[16]) {
    const float av[16] = {pa.a0[0], pa.a0[1], pa.a0[2], pa.a0[3], pa.a1[0], pa.a1[1], pa.a1[2], pa.a1[3], pa.a2[0], pa.a2[1], pa.a2[2], pa.a2[3], pa.a3[0], pa.a3[1], pa.a3[2], pa.a3[3]};
#pragma unroll
    for (int k = 0; k < 16; ++k) { const unsigned ww[4] = {raw[k].x, raw[k].y, raw[k].z, raw[k].w}; const f32x2 a2 = (f32x2){av[k], av[k]};
#pragma unroll
        for (int w = 0; w < 4; ++w) { y2[4 * w + 0] += a2 * __builtin_amdgcn_cvt_scalef32_pk_f32_fp4(ww[w], 1.0f, 0); y2[4 * w + 1] += a2 * __builtin_amdgcn_cvt_scalef32_pk_f32_fp4(ww[w], 1.0f, 1);
            y2[4 * w + 2] += a2 * __builtin_amdgcn_cvt_scalef32_pk_f32_fp4(ww[w], 1.0f, 2); y2[4 * w + 3] += a2 * __builtin_amdgcn_cvt_scalef32_pk_f32_fp4(ww[w], 1.0f, 3); } }
}
__device__ __forceinline__ void peer_v_store(f32x2 (&y2)[16], bf16* Yp, float* ssy, int c) {
    float ss = 0.f; unsigned w[16];
#pragma unroll
    for (int i = 0; i < 16; ++i) { ss += y2[i].x * y2[i].x + y2[i].y * y2[i].y; w[i] = pk2(y2[i].x, y2[i].y); y2[i] = (f32x2){0.f, 0.f}; }
#pragma unroll
    for (int i = 0; i < 4; ++i) *(GAS v4u*)(Yp + 8 * i) = (v4u){w[4 * i], w[4 * i + 1], w[4 * i + 2], w[4 * i + 3]};
    ss += __shfl_xor(ss, 1); ss += __shfl_xor(ss, 2); ss += __shfl_xor(ss, 4);
    if (c == 0) *ssy = ss;
}
__device__ __forceinline__ void phase_peer_v(const Args& A) {
    const int tid = threadIdx.x, lane = tid & 63, wave = tid >> 6, p = blockIdx.x & 7, q = p & 3, half = p >> 2, j = blockIdx.x >> 3, nj = gridDim.x >> 3, g = lane >> 3, c = lane & 7;
    const unsigned char* V4 = (const unsigned char*)(A.ws + WS_V8); const unsigned short* EI = (const unsigned short*)(A.ws + WS_EIDX); const float* ACT = (const float*)(A.ws + WS_ACT);
    bf16* Y = (bf16*)(A.ws + WS_H); float* SSY = (float*)(A.ws + WS_SSY);
    const int tper = (M / 2) / nj, colb = 128 * q + 16 * c, tbeg = half * (M / 2) + j * tper + wave * (tper / NWAVES);
    const int nstep = (tper / NWAVES / 8) * 8;
    auto rowof = [&](int s) { s = min(s, nstep - 1); return (size_t)(tbeg + 8 * (s >> 3) + g) * 8 + (s & 7); };
    f32x2 y2[16];
#pragma unroll
    for (int i = 0; i < 16; ++i) y2[i] = (f32x2){0.f, 0.f};
    auto ldidx = [&](int s) { const size_t r = rowof(s); PeerIdx x; x.e0 = *(const GAS v4u*)(EI + r * 16); x.e1 = *(const GAS v4u*)(EI + r * 16 + 8); return x; };
    auto ldact = [&](int s) { const GAS f32x4* ap = (const GAS f32x4*)(ACT + rowof(s) * 16); PeerAct r; r.a0 = ap[0]; r.a1 = ap[1]; r.a2 = ap[2]; r.a3 = ap[3]; return r; };
    PeerIdx ix1 = ldidx(1), ix2 = ldidx(2);
    v4u rawa[16], rawb[16]; PeerAct aca, acb;
    { const PeerIdx ix0 = ldidx(0); peer_gather<512>(V4, ix0, colb, rawa); aca = ldact(0); }
    for (int s = 0; s < nstep; s += 2) {
        const PeerIdx ix3 = ldidx(s + 3);
        peer_gather<512>(V4, ix1, colb, rawb); acb = ldact(s + 1);
        peer_v_accum(rawa, aca, y2);
        const PeerIdx ix4 = ldidx(s + 4);
        peer_gather<512>(V4, ix2, colb, rawa); aca = ldact(s + 2);
        peer_v_accum(rawb, acb, y2);
        if ((s & 7) == 6) { const int t = tbeg + 8 * (s >> 3) + g; peer_v_store(y2, Y + (size_t)t * D + 256 * q + 32 * c, SSY + (size_t)t * 8 + q, c); }
        ix1 = ix3; ix2 = ix4;
    }
}
__device__ __forceinline__ void phase_peer_final(const Args& A) {
    const int tid = threadIdx.x, lane = tid & 63, wave = tid >> 6, G = gridDim.x;
    const bf16* Y = (const bf16*)(A.ws + WS_H); const bf16* X1 = (const bf16*)(A.ws + WS_X1); const float* SSY = (const float*)(A.ws + WS_SSY); const float* mod = (const float*)(A.ws + WS_MOD); const float* gpost = (const float*)A.in[I_GPOST2]; float* out = A.out;
    f32x4 gp[4];
#pragma unroll
    for (int q = 0; q < 4; ++q) gp[q] = *(const GAS f32x4*)(gpost + 4 * (lane + 64 * q));
    const int stride = G * NWAVES; int row = blockIdx.x * NWAVES + wave;
    v2u xw[4], yw[4], xwn[4], ywn[4]; f32x4 s0, s0n, g2p[4]; int bcur = -1;
#pragma unroll
    for (int q = 0; q < 4; ++q) { xw[q] = ((const GAS v2u*)(X1 + (size_t)row * D) + lane)[64 * q]; yw[q] = ((const GAS v2u*)(Y + (size_t)row * D) + lane)[64 * q]; }
    s0 = *(const GAS f32x4*)(SSY + (size_t)row * 8);
    for (; row < M; row += stride) {
        const int rn = min(row + stride, M - 1);
#pragma unroll
        for (int q = 0; q < 4; ++q) { xwn[q] = ((const GAS v2u*)(X1 + (size_t)rn * D) + lane)[64 * q]; ywn[q] = ((const GAS v2u*)(Y + (size_t)rn * D) + lane)[64 * q]; }
        s0n = *(const GAS f32x4*)(SSY + (size_t)rn * 8);
        const int b = row / SEQ;
        if (b != bcur) { bcur = b;
#pragma unroll
            for (int q = 0; q < 4; ++q) { const f32x4 g2 = *(const GAS f32x4*)(mod + b * 6144 + 5120 + 4 * (lane + 64 * q));
#pragma unroll
                for (int i = 0; i < 4; ++i) g2p[q][i] = g2[i] * gp[q][i]; } }
        const float rstd = 1.0f / sqrtf(((s0[0] + s0[1]) + (s0[2] + s0[3])) * (1.f / D) + EPS);
        GAS f32x4* orow = (GAS f32x4*)(out + (size_t)row * D) + lane;
#pragma unroll
        for (int q = 0; q < 4; ++q) { f32x4 xv = {bflo(xw[q].x), bfhi(xw[q].x), bflo(xw[q].y), bfhi(xw[q].y)};
            xv[0] += g2p[q][0] * (bflo(yw[q].x) * rstd); xv[1] += g2p[q][1] * (bfhi(yw[q].x) * rstd); xv[2] += g2p[q][2] * (bflo(yw[q].y) * rstd); xv[3] += g2p[q][3] * (bfhi(yw[q].y) * rstd);
            orow[64 * q] = xv; }
#pragma unroll
        for (int q = 0; q < 4; ++q) { xw[q] = xwn[q]; yw[q] = ywn[q]; }
        s0 = s0n;
    }
}
#ifdef PROBE_V_LOADS
__device__ __forceinline__ void probe_v_loads(const Args& A) {
    const int tid = threadIdx.x, lane = tid & 63, wave = tid >> 6, p = blockIdx.x & 7, j = blockIdx.x >> 3, nj = gridDim.x >> 3, g = lane >> 3, c = lane & 7;
    const unsigned char* V8 = (const unsigned char*)(A.ws + WS_V8); const unsigned short* EI = (const unsigned short*)(A.ws + WS_EIDX); const float* ACT = (const float*)(A.ws + WS_ACT);
    unsigned* DUMP = (unsigned*)(A.ws + WS_PD);
    const int tper = M / nj, colb = 128 * p + 16 * c, tend = (j + 1) * tper, tlast = tend - NWAVES + wave;
    int t = j * tper + wave;
    PeerIdx ix1 = peer_ld_idx(EI, min(t + NWAVES, tlast), g), ix2 = peer_ld_idx(EI, min(t + 2 * NWAVES, tlast), g);
    v4u rawa[16], rawb[16]; PeerAct aca, acb;
    { const PeerIdx ix0 = peer_ld_idx(EI, t, g); peer_gather(V8, ix0, colb, rawa); aca = peer_ld_act(ACT, t, g); }
    for (; t < tend; t += 2 * NWAVES) {
        const int t1 = t + NWAVES, t2 = min(t + 2 * NWAVES, tlast), t3 = min(t + 3 * NWAVES, tlast), t4 = min(t + 4 * NWAVES, tlast);
        const PeerIdx ix3 = peer_ld_idx(EI, t3, g);
        peer_gather(V8, ix1, colb, rawb); acb = peer_ld_act(ACT, t1, g);
        { unsigned s = __builtin_bit_cast(unsigned, aca.a0[0]) + __builtin_bit_cast(unsigned, aca.a3[3]);
#pragma unroll
          for (int k = 0; k < 16; ++k) s += (rawa[k].x + rawa[k].y) + (rawa[k].z + rawa[k].w);
          DUMP[(size_t)t * 512 + p * 64 + lane] = s; }
        const PeerIdx ix4 = peer_ld_idx(EI, t4, g);
        peer_gather(V8, ix2, colb, rawa); aca = peer_ld_act(ACT, t2, g);
        { unsigned s = __builtin_bit_cast(unsigned, acb.a0[0]) + __builtin_bit_cast(unsigned, acb.a3[3]);
#pragma unroll
          for (int k = 0; k < 16; ++k) s += (rawb[k].x + rawb[k].y) + (rawb[k].z + rawb[k].w);
          DUMP[(size_t)t1 * 512 + p * 64 + lane] = s; }
        ix1 = ix3; ix2 = ix4;
    }
}
#endif

#ifdef PROBE_INSTR
__device__ __forceinline__ void probe_instr(const Args& A) {
    f32x2 a[8]; float f[16]; unsigned w = threadIdx.x * 0x01010101u + 0x38383838u;
#pragma unroll
    for (int i = 0; i < 8; ++i) a[i] = (f32x2){1.0f + i, 2.0f + i};
#pragma unroll
    for (int i = 0; i < 16; ++i) f[i] = 1.0f + i;
    for (int it = 0; it < 10000; ++it) {
#if PROBE_INSTR == 1
#pragma unroll
        for (int i = 0; i < 8; ++i) { asm volatile("v_pk_fma_f32 %0, %1, %2, %0" : "+v"(a[i]) : "v"(a[(i + 1) & 7]), "v"(a[(i + 2) & 7])); asm volatile("v_pk_fma_f32 %0, %1, %2, %0" : "+v"(a[i]) : "v"(a[(i + 3) & 7]), "v"(a[(i + 4) & 7])); }
#elif PROBE_INSTR == 2
#pragma unroll
        for (int i = 0; i < 16; ++i) asm volatile("v_fma_f32 %0, %1, %2, %0" : "+v"(f[i]) : "v"(f[(i + 1) & 15]), "v"(f[(i + 2) & 15]));
#elif PROBE_INSTR == 3
#pragma unroll
        for (int i = 0; i < 8; ++i) { asm volatile("v_cvt_pk_f32_fp8 %0, %1" : "=v"(a[i]) : "v"(w)); asm volatile("v_cvt_pk_f32_fp8 %0, %1" : "=v"(a[i]) : "v"(w)); }
#elif PROBE_INSTR == 4
#pragma unroll
        for (int i = 0; i < 8; ++i) { asm volatile("v_cvt_scalef32_pk_f32_fp4 %0, %1, 1.0" : "=v"(a[i]) : "v"(w)); asm volatile("v_cvt_scalef32_pk_f32_fp4 %0, %1, 1.0" : "=v"(a[i]) : "v"(w)); }
#elif PROBE_INSTR == 5
#pragma unroll
        for (int i = 0; i < 16; ++i) asm volatile("v_pk_fma_f16 %0, %1, %2, %0" : "+v"(f[i]) : "v"(f[(i + 1) & 15]), "v"(f[(i + 2) & 15]));
#elif PROBE_INSTR == 7
#pragma unroll
        for (int i = 0; i < 16; ++i) asm volatile("v_dot8c_i32_i4 %0, %1, %2" : "+v"(f[i]) : "v"(f[(i + 1) & 15]), "v"(w));
#elif PROBE_INSTR == 8
#pragma unroll
        for (int i = 0; i < 16; ++i) asm volatile("v_dot4c_i32_i8 %0, %1, %2" : "+v"(f[i]) : "v"(f[(i + 1) & 15]), "v"(w));
#elif PROBE_INSTR == 9
#pragma unroll
        for (int i = 0; i < 16; ++i) asm volatile("v_perm_b32 %0, %1, %2, %3" : "=v"(f[i]) : "v"(f[(i + 1) & 15]), "v"(f[(i + 2) & 15]), "v"(w));
#elif PROBE_INSTR == 10
#pragma unroll
        for (int i = 0; i < 16; ++i) asm volatile("v_mfma_f32_16x16x32_fp8_fp8 %0, %1, %2, %0" : "+v"(*(f32x4*)&f[4 * (i & 3)]) : "v"(a[i & 7]), "v"(a[(i + 1) & 7]));
#elif PROBE_INSTR == 6
#pragma unroll
        for (int i = 0; i < 16; ++i) asm volatile("v_cvt_scalef32_pk_f16_fp4 %0, %1, 1.0" : "=v"(f[i]) : "v"(w));
#endif
    }
    float s = 0.f;
#pragma unroll
    for (int i = 0; i < 8; ++i) s += a[i].x + a[i].y;
#pragma unroll
    for (int i = 0; i < 16; ++i) s += f[i];
    if (s == 123.456f) ((float*)(A.ws + WS_PD))[threadIdx.x] = s;
}
#endif
#ifndef MK_N_LAUNCHES
#define MK_N_LAUNCHES 1
#endif
constexpr int N_PHASES = 13;
typedef const __attribute__((address_space(4))) Args* KArgP;
__device__ __forceinline__ const Args& kargs() { KArgP p = (KArgP)__builtin_amdgcn_kernarg_segment_ptr(); asm volatile("" : "+s"(p)); return *(const Args*)p; }
__global__ void __launch_bounds__(NTHR, 2) hymba_fwd(Args A_) {
    extern __shared__ __attribute__((aligned(16))) unsigned char lds_raw[];
    LAS unsigned char* lds = (LAS unsigned char*)lds_raw;
    const int lo = A_.ph_lo, hi = A_.ph_hi;
#define A kargs()
#define ws (kargs().ws)
#ifndef DBLMASK
#define DBLMASK 0
#endif
#ifndef ONLYMASK
#define ONLYMASK 0xffff
#endif
#define IN(k) ((((ONLYMASK) >> (k)) & 1) && lo <= (k) && (k) < hi)
#define REP(k) for (int _rep = 0; _rep < (((DBLMASK) >> (k)) & 1) + 1; ++_rep)
    for (int u = threadIdx.x; u < (LDS_BYTES - RING_BYTES) / 4; u += NTHR) ((LAS unsigned*)(lds + RING_BYTES))[u] = 0u;
    __syncthreads();
    (void)xcd_barrier_post((unsigned*)(ws + WS_CTL) + CW_BAR, (volatile LAS unsigned*)(lds + MISC_OFF + 32));
#define SEAM(k) do { if (IN(k) && IN((k) + 1)) { if ((k) == 0) cg::this_grid().sync(); else { XcdBarrier xb_; xb_.bar = (unsigned*)(ws + WS_CTL) + CW_BAR; xb_.x = xb_xcc_id(); xb_.st = (volatile LAS unsigned*)(lds + MISC_OFF + 32); xcd_barrier(xb_); } } } while (0)

    if (IN(0)) REP(0) { phase_mod(A, lds); } SEAM(0);
    if (IN(1)) REP(1) { phase_convert(A, lds); phase_prenorm(A, lds); } SEAM(1);
    if (IN(2)) REP(2) {
        pg8::Gemm g{(const pg8::bf16_t*)(ws + WS_H), (const pg8::bf16_t*)(ws + WS_WIN), M, NPROJ, D}; pg8::StaticOrder S; S.init(M, NPROJ, gridDim.x, (int)blockIdx.x);
        pg8::EpiProj E{(pg8::bf16_t*)(ws + WS_PROJ), NPROJ, (float*)(ws + WS_GATES), (const int*)A.in[I_POS], (const float*)A.in[I_BI], (const float*)A.in[I_BF]};
        pg8::gemm_phase<pg8::EpiProj, pg8::StaticOrder, true, true>(lds, g, S, E);
    } SEAM(2);
    if (IN(3)) REP(3) {
        phase_attn(A, lds);
        for (int wg = blockIdx.x; wg < 256; wg += gridDim.x) mlstm_group<false>(A, lds, wg);
    } SEAM(3);
    if (IN(4)) REP(4) { for (int wg = blockIdx.x; wg < 256; wg += gridDim.x) mlstm_group<true>(A, lds, wg); } SEAM(4);
    if (IN(5)) REP(5) {
        pg8::Gemm g{(const pg8::bf16_t*)(ws + WS_MIXIN), (const pg8::bf16_t*)(ws + WS_WOUT), M, D, D}; pg8::StaticOrder S; S.init(M, D, gridDim.x, (int)blockIdx.x);
        pg8::EpiMix E{(pg8::bf16_t*)(ws + WS_MIX), D, (float*)(ws + WS_SSQ)};
        pg8::gemm_phase<pg8::EpiMix, pg8::StaticOrder, true, true>(lds, g, S, E);
    } SEAM(5);
    if (IN(6)) REP(6) { phase_mid(A); } SEAM(6);
    if (IN(7)) REP(7) {
        pg8::Gemm g{(const pg8::bf16_t*)(ws + WS_H), (const pg8::bf16_t*)(ws + WS_WQ), M, 2048, D}; pg8::StaticOrder S; S.init(M, 2048, gridDim.x, (int)blockIdx.x);
        pg8::EpiPlain E{(pg8::bf16_t*)(ws + WS_PROJ), 2048};
        pg8::gemm_phase<pg8::EpiPlain, pg8::StaticOrder, true, true>(lds, g, S, E);
    } SEAM(7);
    if (IN(8)) REP(8) { phase_topk(A, lds); } SEAM(8);
    if (IN(9)) REP(9) { phase_peer_u(A); } SEAM(9);
    if (IN(10)) REP(10) { phase_peer_act(A); } SEAM(10);
#ifdef PROBE_INSTR
    if (IN(11)) { probe_instr(A); }
#endif
#ifdef PROBE_V_LOADS
    if (IN(11)) { probe_v_loads(A); }
#endif
    if (IN(11)) REP(11) { phase_peer_v(A); } SEAM(11);
    if (IN(12)) REP(12) { phase_peer_final(A); }
#undef IN
#undef SEAM
#undef A
#undef ws
}

extern "C" void kernel_launch(void* const* d_in, const int* in_sizes, int n_in, void* d_out, int out_size, void* d_ws, size_t ws_size, hipStream_t stream) {
    static int grid = 0;
    if (grid == 0) {
        if (n_in != 21 || in_sizes[0] != M * D || out_size != M * D || ws_size < WS_END) { fprintf(stderr, "kernel_launch: unexpected shapes (n_in %d, in0 %d, out %d, ws %zu < %zu)\n", n_in, n_in > 0 ? in_sizes[0] : -1, out_size, ws_size, (size_t)WS_END); grid = -1; return; }
        int dev = 0, cus = 0, per_cu = 0;
        if (hipGetDevice(&dev) != hipSuccess || hipDeviceGetAttribute(&cus, hipDeviceAttributeMultiprocessorCount, dev) != hipSuccess) { grid = -1; return; }
        if (hipFuncSetAttribute((const void*)hymba_fwd, hipFuncAttributeMaxDynamicSharedMemorySize, LDS_BYTES) != hipSuccess) { fprintf(stderr, "kernel_launch: hipFuncSetAttribute failed\n"); grid = -1; return; }
        if (hipOccupancyMaxActiveBlocksPerMultiprocessor(&per_cu, (const void*)hymba_fwd, NTHR, LDS_BYTES) != hipSuccess || per_cu < 1) { fprintf(stderr, "kernel_launch: occupancy query says %d blocks per CU\n", per_cu); per_cu = 1; }
        (void)hipGetLastError();
        grid = cus;
        if (grid != 256) fprintf(stderr, "kernel_launch: note: %d CUs (built for 256)\n", grid);
    }
    if (grid < 0) return;
    (void)hipMemsetAsync((char*)d_ws + WS_CTL, 0, CTL_ZERO_BYTES, stream);
    Args a{};
    for (int i = 0; i < 21; ++i) a.in[i] = d_in[i];
    a.out = (float*)d_out; a.ws = (unsigned char*)d_ws;
    if (MK_N_LAUNCHES == 1) {
        a.ph_lo = 0; a.ph_hi = N_PHASES;
        void* args[] = {&a};
        const hipError_t e = hipLaunchCooperativeKernel((const void*)hymba_fwd, dim3(grid), dim3(NTHR), args, LDS_BYTES, stream);
        if (e != hipSuccess) fprintf(stderr, "kernel_launch: cooperative launch failed: %s (grid %d)\n", hipGetErrorString(e), grid);
    } else {
        for (int p = 0; p < N_PHASES; ++p) { a.ph_lo = p; a.ph_hi = p + 1; hipLaunchKernelGGL(hymba_fwd, dim3(grid), dim3(NTHR), LDS_BYTES, stream, a); }
    }
}
```

```cpp
#include <hip/hip_runtime.h>
#include <hip/hip_cooperative_groups.h>
#include <cstdio>
#include <cstdint>
namespace cg = cooperative_groups;
namespace pg8 {
#define PG8_LAS __attribute__((address_space(3)))
typedef unsigned short bf16_t;
typedef short bf16x8 __attribute__((ext_vector_type(8)));
typedef float f32x4 __attribute__((ext_vector_type(4)));
typedef unsigned u32x4 __attribute__((ext_vector_type(4)));
constexpr int BM = 256, BK = 64, HALF = 128, HTB = HALF * BK * 2  , STAGE_BYTES = 8 * HTB, NXCD = 8, WGM = 8;

__host__ __device__ __forceinline__ int lds_byte(int r, int c) { const int st = (r >> 4) * 2 + (c >> 5), rr = r & 15, cc = c & 31, ob = rr * 64 + cc * 2; return st * 1024 + (ob ^ (((ob >> 9) & 1) << 5)); }
__host__ __device__ __forceinline__ void stage_rc(int b, int& R, int& C) { const int st = b / 1024, sb = b % 1024, swz = sb ^ (((sb >> 9) & 1) << 5); R = (st >> 1) * 16 + swz / 64; C = (st & 1) * 32 + (swz % 64) / 2; }
__host__ __device__ __forceinline__ int perm32(int rho) { const int n = rho >> 4, i = rho & 15; return 8 * (i >> 2) + 4 * n + (i & 3); }

struct Unit { int pm, pn; };
struct Gemm { const bf16_t* A; const bf16_t* Bt; int M, N, K; };

struct StaticOrder {
    int nM, nN, nwg, G, c;
    __host__ __device__ void init(int M, int N, int G_, int c_) { nM = M / BM; nN = N / BM; nwg = nM * nN; G = G_; c = c_; }
    __host__ __device__ bool next(int i, Unit& u) const {
        const long L = (long)i * G + c; if (L >= nwg) return false;
        int wgid = (int)L; { const int q = nwg / NXCD, r = nwg % NXCD, xcd = wgid % NXCD, off = wgid / NXCD; wgid = (xcd < r ? xcd * (q + 1) : r * (q + 1) + (xcd - r) * q) + off; }
        const int nig = WGM * nN, gid = wgid / nig, fm = gid * WGM, gsz = (nM - fm) < WGM ? (nM - fm) : WGM;
        u.pm = fm + ((wgid % nig) % gsz); u.pn = (wgid % nig) / gsz; return true;
    }
    __device__ __forceinline__ void a_ready(const Unit&) const {}
    __device__ __forceinline__ void done(const Unit&) const {}
};

__device__ __forceinline__ unsigned cvt_pk_bf16(float lo, float hi) { unsigned r; asm volatile("v_cvt_pk_bf16_f32 %0, %1, %2" : "=v"(r) : "v"(lo), "v"(hi)); return r; }
typedef float f32x2 __attribute__((ext_vector_type(2)));
__device__ __forceinline__ f32x2 gelu_pk(f32x2 v) {
    const f32x2 av = __builtin_elementwise_abs(v), d = av * 0.2316418882f + 1.0f;
    f32x2 t; t.x = __builtin_amdgcn_rcpf(d.x); t.y = __builtin_amdgcn_rcpf(d.y);
    f32x2 q = t * 0.5307027145f + (-0.7265760135f); q = q * t + 0.7107068705f; q = q * t + (-0.142248368f); q = q * t + 0.127414796f; q = q * t;
    const f32x2 s = (v * v) * (-0.72134752044f);
    f32x2 e; e.x = __builtin_amdgcn_exp2f(s.x); e.y = __builtin_amdgcn_exp2f(s.y);
    const f32x2 m = v * (q * e), r = v - m;
    f32x2 o; o.x = v.x < 0.f ? m.x : r.x; o.y = v.y < 0.f ? m.y : r.y; return o;
}

__device__ __forceinline__ u32x4 pack8(const f32x4 v0, const f32x4 v1) { u32x4 w; w.x = cvt_pk_bf16(v0[0], v0[1]); w.y = cvt_pk_bf16(v0[2], v0[3]); w.z = cvt_pk_bf16(v1[0], v1[1]); w.w = cvt_pk_bf16(v1[2], v1[3]); return w; }

struct EpiPlain {
    static constexpr bool PERM = true, AFTER_DRAIN = false;
    bf16_t* O; int ldc;
    __device__ __forceinline__ void operator()(const f32x4 (&acc)[2][2][4][2], const Unit& u, int wr, int wc, int fr, int fq) const {
        const int row0 = u.pm * BM + wr * 64 + fr, col0 = u.pn * BM + wc * 32 + 8 * fq;
#pragma unroll
        for (int ai = 0; ai < 2; ++ai)
#pragma unroll
            for (int m = 0; m < 4; ++m) { bf16_t* rowp = O + (size_t)(row0 + ai * HALF + m * 16) * ldc + col0;
#pragma unroll
                for (int bj = 0; bj < 2; ++bj) *(u32x4*)(rowp + bj * HALF) = pack8(acc[ai][bj][m][0], acc[ai][bj][m][1]); }
    }
};

struct EpiProj {
    static constexpr bool PERM = true, AFTER_DRAIN = false;
    bf16_t* P; int ldc; float* gates; const int* pos; const float* b_i; const float* b_f;
    __device__ __forceinline__ void operator()(const f32x4 (&acc)[2][2][4][2], const Unit& u, int wr, int wc, int fr, int fq) const {
        const int row0 = u.pm * BM + wr * 64 + fr, col0 = u.pn * BM + wc * 32 + 8 * fq, pn = u.pn;
        if (pn == 9) {
            if (wc == 0 && fq == 0) {
                const f32x4 bi = {b_i[0], b_i[1], b_i[2], b_i[3]}, bf = {b_f[0], b_f[1], b_f[2], b_f[3]};
#pragma unroll
                for (int ai = 0; ai < 2; ++ai)
#pragma unroll
                    for (int m = 0; m < 4; ++m) { const int row = row0 + ai * HALF + m * 16;
                        const f32x4 iv = acc[ai][0][m][0] + bi, fv = acc[ai][0][m][1] + bf; f32x4 lf;
#pragma unroll
                        for (int j = 0; j < 4; ++j) lf[j] = fminf(fv[j], 0.f) - log1pf(__expf(-fabsf(fv[j])));
                        *(f32x4*)(gates + (size_t)row * 8) = iv; *(f32x4*)(gates + (size_t)row * 8 + 4) = lf; }
            }
            return;
        }
#pragma unroll
        for (int ai = 0; ai < 2; ++ai)
#pragma unroll
            for (int m = 0; m < 4; ++m) { const int row = row0 + ai * HALF + m * 16; bf16_t* rowp = P + (size_t)row * ldc + col0;
                const float posf = (pn <= 2) ? (float)pos[row] : 0.f;
#pragma unroll
                for (int bj = 0; bj < 2; ++bj) { f32x4 v0 = acc[ai][bj][m][0], v1 = acc[ai][bj][m][1];
                    const bool rope = (pn < 2) || (pn == 2 && bj == 0);
                    if (rope) {
                        const int p0 = ((col0 + bj * HALF) & 63) >> 1; const float sc = (pn < 2) ? 0.125f : 1.0f;
                        float x[8] = {v0[0], v0[1], v0[2], v0[3], v1[0], v1[1], v1[2], v1[3]};
#pragma unroll
                        for (int q = 0; q < 4; ++q) { const float invf = __builtin_amdgcn_exp2f(-(float)(p0 + q) * 0.41524101186092029f);
                            float r = posf * invf * 0.15915494309189535f; r = r - floorf(r);
                            const float c = __builtin_amdgcn_cosf(r) * sc, s = __builtin_amdgcn_sinf(r) * sc;
                            const float x1 = x[2 * q], x2 = x[2 * q + 1]; x[2 * q] = x1 * c - x2 * s; x[2 * q + 1] = x2 * c + x1 * s; }
                        v0 = (f32x4){x[0], x[1], x[2], x[3]}; v1 = (f32x4){x[4], x[5], x[6], x[7]};
                    } else if (pn >= 7) {
#pragma unroll
                        for (int j = 0; j < 4; ++j) { v0[j] = __builtin_amdgcn_rcpf(1.f + __expf(-v0[j])); v1[j] = __builtin_amdgcn_rcpf(1.f + __expf(-v1[j])); }
                    }
                    *(u32x4*)(rowp + bj * HALF) = pack8(v0, v1); } }
    }
};

struct EpiMix {
    static constexpr bool PERM = true, AFTER_DRAIN = false;
    bf16_t* O; int ldc; float* sumsq;
    __device__ __forceinline__ void operator()(const f32x4 (&acc)[2][2][4][2], const Unit& u, int wr, int wc, int fr, int fq) const {
        const int row0 = u.pm * BM + wr * 64 + fr, col0 = u.pn * BM + wc * 32 + 8 * fq;
#pragma unroll
        for (int ai = 0; ai < 2; ++ai)
#pragma unroll
            for (int m = 0; m < 4; ++m) { const int row = row0 + ai * HALF + m * 16; bf16_t* rowp = O + (size_t)row * ldc + col0; float s = 0.f;
#pragma unroll
                for (int bj = 0; bj < 2; ++bj) { const f32x4 v0 = acc[ai][bj][m][0], v1 = acc[ai][bj][m][1];
                    s += (v0[0] * v0[0] + v0[1] * v0[1]) + (v0[2] * v0[2] + v0[3] * v0[3]) + (v1[0] * v1[0] + v1[1] * v1[1]) + (v1[2] * v1[2] + v1[3] * v1[3]);
                    *(u32x4*)(rowp + bj * HALF) = pack8(v0, v1); }
                s += __shfl_xor(s, 16); s += __shfl_xor(s, 32);
                if (fq == 0) sumsq[(size_t)row * 16 + u.pn * 4 + wc] = s; }
    }
};
template <class Epi, class Sched, bool ALIGN_EPI = false, bool SP2 = false>
__device__ __forceinline__ void gemm_phase(PG8_LAS unsigned char* lds, const Gemm g, const Sched& S, const Epi& E) {
    const int tid = threadIdx.x, wid = __builtin_amdgcn_readfirstlane(tid >> 6), lane = tid & 63, wr = wid >> 2, wc = wid & 3, fr = lane & 15, fq = lane >> 4;
    const int K = g.K, nt = K / BK;
    unsigned voffA[2], voffB[2];
#pragma unroll
    for (int i = 0; i < 2; ++i) { int R, C; stage_rc(tid * 16 + i * 8192, R, C); const int Rb = Epi::PERM ? ((R & ~31) + perm32(R & 31)) : R;
        voffA[i] = (unsigned)(R * K + C) * 2u; voffB[i] = (unsigned)(Rb * K + C) * 2u; }
    const size_t kstep = (size_t)(BK * 2);
    const size_t hstep = (size_t)HALF * K * 2;
    const size_t tstep = 2 * hstep;
    const unsigned ldsw = (unsigned)wid * 1024u;
    const int aoff = lds_byte(wr * 64 + fr, fq * 8), boff = lds_byte(wc * 32 + fr, fq * 8);
#define PG8_SA(b, h) (((b) * 2 + (h)) * HTB)
#define PG8_SB(b, h) ((4 + (b) * 2 + (h)) * HTB)
#define PG8_STAGE(bufoff, gbase, voff) do { _Pragma("unroll") for (int _i = 0; _i < 2; ++_i) \
        __builtin_amdgcn_global_load_lds((const unsigned*)((const char*)(gbase) + (voff)[_i]), (PG8_LAS unsigned*)(lds + (bufoff) + ldsw + _i * 8192), 16, 0, 0); } while (0)
#define PG8_LDA(dst, b, h) do { _Pragma("unroll") for (int m = 0; m < 4; ++m) _Pragma("unroll") for (int k = 0; k < 2; ++k) dst[m][k] = *(const PG8_LAS bf16x8*)(lds + PG8_SA(b, h) + aoff + m * 2048 + k * 1024); } while (0)
#define PG8_LDB(dst, b, h) do { _Pragma("unroll") for (int n = 0; n < 2; ++n) _Pragma("unroll") for (int k = 0; k < 2; ++k) dst[n][k] = *(const PG8_LAS bf16x8*)(lds + PG8_SB(b, h) + boff + n * 2048 + k * 1024); } while (0)
#define PG8_MMA(ai, bj, At, Bt) do { __builtin_amdgcn_s_setprio(1); _Pragma("unroll") for (int m = 0; m < 4; ++m) _Pragma("unroll") for (int n = 0; n < 2; ++n) _Pragma("unroll") for (int k = 0; k < 2; ++k) \
        acc[ai][bj][m][n] = __builtin_amdgcn_mfma_f32_16x16x32_bf16(Bt[n][k], At[m][k], acc[ai][bj][m][n], 0, 0, 0); __builtin_amdgcn_s_setprio(0); } while (0)
#define PG8_WAIT_V(n) asm volatile("s_waitcnt vmcnt(" #n ")" ::: "memory")
#define PG8_WAIT_L(n) asm volatile("s_waitcnt lgkmcnt(" #n ")" ::: "memory")
#define PG8_BAR __builtin_amdgcn_s_barrier()
#define PG8_SCHED __builtin_amdgcn_sched_barrier(0)
    Unit cur, nxt; int ui = 0;
    if (!S.next(0, cur)) return;
    f32x4 acc[2][2][4][2];
#pragma unroll
    for (int a = 0; a < 2; ++a)
#pragma unroll
        for (int b = 0; b < 2; ++b)
#pragma unroll
            for (int m = 0; m < 4; ++m)
#pragma unroll
                for (int n = 0; n < 2; ++n) acc[a][b][m][n] = (f32x4){0.f, 0.f, 0.f, 0.f};
    bf16x8 At[4][2], B0[2][2], B1[2][2];
    const char* cA = (const char*)g.A + (size_t)cur.pm * tstep; const char* cB = (const char*)g.Bt + (size_t)cur.pn * tstep;
    S.a_ready(cur);
    if constexpr (SP2) {
        PG8_STAGE(PG8_SB(0, 0), cB, voffB); PG8_STAGE(PG8_SB(0, 1), cB + hstep, voffB); PG8_STAGE(PG8_SA(0, 0), cA, voffA); PG8_STAGE(PG8_SA(0, 1), cA + hstep, voffA);
        if (wr == 1) PG8_BAR;
        PG8_WAIT_V(2); PG8_BAR;
        PG8_STAGE(PG8_SB(1, 0), cB + kstep, voffB); PG8_STAGE(PG8_SA(1, 0), cA + kstep, voffA); PG8_STAGE(PG8_SB(1, 1), cB + hstep + kstep, voffB);
        PG8_WAIT_V(6); PG8_BAR;
    } else {
        PG8_STAGE(PG8_SB(0, 0), cB, voffB); PG8_STAGE(PG8_SA(0, 0), cA, voffA); PG8_STAGE(PG8_SB(0, 1), cB + hstep, voffB); PG8_STAGE(PG8_SA(0, 1), cA + hstep, voffA);
        if (wr == 1) PG8_BAR;
        PG8_WAIT_V(4); PG8_BAR;
        PG8_STAGE(PG8_SB(1, 0), cB + kstep, voffB); PG8_STAGE(PG8_SA(1, 0), cA + kstep, voffA); PG8_STAGE(PG8_SB(1, 1), cB + hstep + kstep, voffB);
        PG8_WAIT_V(6); PG8_BAR;
    }
    for (;;) {
        const bool has_next = S.next(ui + 1, nxt);
        const char* nA = has_next ? (const char*)g.A + (size_t)nxt.pm * tstep : cA; const char* nB = has_next ? (const char*)g.Bt + (size_t)nxt.pn * tstep : cB;
        for (int t = 0; t < nt; t += 2) {
            const bool last = (t == nt - 2);
            const char* a1 = cA + (size_t)(t + 1) * kstep;
            const char* a2 = last ? nA : cA + (size_t)(t + 2) * kstep; const char* b2 = last ? nB : cB + (size_t)(t + 2) * kstep;
            const char* a3 = a2 + kstep; const char* b3 = b2 + kstep;
            if (last && has_next) S.a_ready(nxt);
            if constexpr (SP2) {
            PG8_LDB(B0, 0, 0); PG8_LDB(B1, 0, 1); PG8_SCHED; PG8_LDA(At, 0, 0); PG8_STAGE(PG8_SA(1, 1), a1 + hstep, voffA);
            PG8_WAIT_V(8); PG8_WAIT_L(0); PG8_BAR; PG8_MMA(0, 0, At, B0); PG8_MMA(0, 1, At, B1); PG8_BAR; PG8_SCHED;
            PG8_LDA(At, 0, 1); PG8_STAGE(PG8_SB(0, 0), b2, voffB); PG8_STAGE(PG8_SB(0, 1), b2 + hstep, voffB); PG8_STAGE(PG8_SA(0, 0), a2, voffA);
            PG8_WAIT_V(8); PG8_WAIT_L(0); PG8_BAR; PG8_MMA(1, 0, At, B0); PG8_MMA(1, 1, At, B1); PG8_BAR; PG8_SCHED;
            PG8_LDB(B0, 1, 0); PG8_LDB(B1, 1, 1); PG8_SCHED; PG8_LDA(At, 1, 0); PG8_STAGE(PG8_SA(0, 1), a2 + hstep, voffA);
            PG8_WAIT_V(8); PG8_WAIT_L(0); PG8_BAR; PG8_MMA(0, 0, At, B0); PG8_MMA(0, 1, At, B1); PG8_BAR; PG8_SCHED;
            PG8_LDA(At, 1, 1); PG8_STAGE(PG8_SB(1, 0), b3, voffB); PG8_STAGE(PG8_SB(1, 1), b3 + hstep, voffB); PG8_STAGE(PG8_SA(1, 0), a3, voffA);
            PG8_WAIT_V(8); PG8_WAIT_L(0); PG8_BAR; PG8_MMA(1, 0, At, B0); PG8_MMA(1, 1, At, B1); PG8_BAR; PG8_SCHED;
            } else {
            PG8_LDB(B0, 0, 0); PG8_SCHED; PG8_LDA(At, 0, 0); PG8_STAGE(PG8_SA(1, 1), a1 + hstep, voffA);
            PG8_WAIT_L(8); PG8_BAR; PG8_WAIT_L(0); PG8_MMA(0, 0, At, B0); PG8_BAR; PG8_SCHED;
            PG8_LDB(B1, 0, 1); PG8_STAGE(PG8_SB(0, 0), b2, voffB);
            PG8_BAR; PG8_WAIT_L(0); PG8_MMA(0, 1, At, B1); PG8_BAR;
            PG8_LDA(At, 0, 1); PG8_STAGE(PG8_SA(0, 0), a2, voffA);
            PG8_BAR; PG8_WAIT_L(0); PG8_MMA(1, 0, At, B0); PG8_BAR; PG8_SCHED;
            PG8_STAGE(PG8_SB(0, 1), b2 + hstep, voffB);
            PG8_WAIT_V(6); PG8_BAR; PG8_MMA(1, 1, At, B1); PG8_BAR;
            PG8_LDB(B0, 1, 0); PG8_SCHED; PG8_LDA(At, 1, 0); PG8_STAGE(PG8_SA(0, 1), a2 + hstep, voffA);
            PG8_WAIT_L(8); PG8_BAR; PG8_WAIT_L(0); PG8_MMA(0, 0, At, B0); PG8_BAR; PG8_SCHED;
            PG8_LDB(B1, 1, 1); PG8_STAGE(PG8_SB(1, 0), b3, voffB);
            PG8_BAR; PG8_WAIT_L(0); PG8_MMA(0, 1, At, B1); PG8_BAR;
            PG8_LDA(At, 1, 1); PG8_STAGE(PG8_SA(1, 0), a3, voffA);
            PG8_BAR; PG8_WAIT_L(0); PG8_MMA(1, 0, At, B0); PG8_BAR; PG8_SCHED;
            PG8_STAGE(PG8_SB(1, 1), b3 + hstep, voffB);
            PG8_WAIT_V(6); PG8_BAR; PG8_MMA(1, 1, At, B1); PG8_BAR;
            }
        }
        if constexpr (ALIGN_EPI) { if (wr == 0) PG8_BAR; }
        if constexpr (!Epi::AFTER_DRAIN) { E(acc, cur, wr, wc, fr, fq); S.done(cur); }
        if (!has_next) break;
#pragma unroll
        for (int a = 0; a < 2; ++a)
#pragma unroll
            for (int b = 0; b < 2; ++b)
#pragma unroll
                for (int m = 0; m < 4; ++m)
#pragma unroll
                    for (int n = 0; n < 2; ++n) acc[a][b][m][n] = (f32x4){0.f, 0.f, 0.f, 0.f};
        cur = nxt; cA = nA; cB = nB; ++ui;
        if constexpr (ALIGN_EPI) { if (wr == 1) PG8_BAR; }
    }
    PG8_WAIT_V(0);
    if constexpr (!ALIGN_EPI) { if (wr == 0) PG8_BAR; }
    PG8_BAR;
    if constexpr (Epi::AFTER_DRAIN) { E.fused(acc, cur, wr, wc, fr, fq, lds, wid, lane); S.done(cur); }
#undef PG8_SA
#undef PG8_SB
#undef PG8_STAGE
#undef PG8_LDA
#undef PG8_LDB
#undef PG8_MMA
#undef PG8_WAIT_V
#undef PG8_WAIT_L
#undef PG8_BAR
#undef PG8_SCHED
}
}
constexpr int NB = 8, SEQ = 8192, D = 1024, M = NB * SEQ;
constexpr int DIN = 2312, NPROJ = 2304, NIN_PAD = 2560;
constexpr int C_AQ = 0, C_AK = 512, C_AV = 640, C_MQ = 768, C_MK = 1024, C_MV = 1280, C_MO = 1792;
constexpr int NEXP = 16384, NSLOT = 128;
constexpr float EPS = 1e-6f;
constexpr int NWAVES = 8, NTHR = 512;

constexpr size_t MiB = 1u << 20;
constexpr size_t WS_CTL = 0, CTL_ZERO_BYTES = 1 * MiB;
constexpr size_t WS_MOD = 1 * MiB;
constexpr size_t WS_WIN = 2 * MiB;
constexpr size_t WS_WOUT = 8 * MiB;
constexpr size_t WS_WQ = 10 * MiB;
constexpr size_t WS_KEYS = 14 * MiB;
constexpr size_t WS_GATES = 16 * MiB;
constexpr size_t WS_SSQ = 832 * MiB;
constexpr size_t WS_MST = 20 * MiB;
constexpr size_t WS_U8 = 32 * MiB, WS_V8 = 48 * MiB;
constexpr size_t WS_SC = 64 * MiB;
constexpr size_t WS_H = 96 * MiB;
constexpr size_t WS_PROJ = 224 * MiB;
constexpr size_t WS_MIXIN = 512 * MiB;
constexpr size_t WS_MIX = 640 * MiB;
constexpr size_t WS_EIDX = 768 * MiB, WS_GATE = 800 * MiB;
constexpr size_t WS_PD = 224 * MiB;
constexpr size_t WS_X1 = 512 * MiB;
constexpr size_t WS_ACT = 840 * MiB;
constexpr size_t WS_SSY = 872 * MiB;
constexpr size_t WS_H8 = 880 * MiB;
constexpr size_t WS_HS = 944 * MiB;
constexpr size_t WS_END = 945 * MiB;
constexpr int CW_BAR = 4096;
constexpr int CW_SUMSQ = 65536;
static_assert((CW_SUMSQ + M) * 4 <= (int)CTL_ZERO_BYTES, "ctl");

constexpr int RING_BYTES = 131072, MISC_OFF = RING_BYTES + 320, LDS_BYTES = 147456;

#define GAS __attribute__((address_space(1)))
#define LAS __attribute__((address_space(3)))
typedef unsigned short bf16;
typedef unsigned v4u __attribute__((ext_vector_type(4)));
typedef unsigned v2u __attribute__((ext_vector_type(2)));
typedef float f32x4 __attribute__((ext_vector_type(4)));
typedef GAS unsigned gu32;
#define LDS_WAIT() asm volatile("s_waitcnt lgkmcnt(0)" ::: "memory")
#define VM_WAIT() asm volatile("s_waitcnt vmcnt(0)" ::: "memory")
__device__ __forceinline__ unsigned f2bf(float f) { unsigned u = __builtin_bit_cast(unsigned, f); return (u + 0x7fffu + ((u >> 16) & 1u)) >> 16; }
__device__ __forceinline__ unsigned pk2(float lo, float hi) { return f2bf(lo) | (f2bf(hi) << 16); }
__device__ __forceinline__ float bflo(unsigned w) { return __builtin_bit_cast(float, w << 16); }
__device__ __forceinline__ float bfhi(unsigned w) { return __builtin_bit_cast(float, w & 0xffff0000u); }
__device__ __forceinline__ float bf1(bf16 h) { return __builtin_bit_cast(float, (unsigned)h << 16); }
__device__ __forceinline__ float wave_sum(float v) {
#pragma unroll
    for (int o = 1; o < 64; o <<= 1) v += __shfl_xor(v, o);
    return v;
}
__device__ __forceinline__ float wave_max(float v) {
#pragma unroll
    for (int o = 1; o < 64; o <<= 1) v = fmaxf(v, __shfl_xor(v, o));
    return v;
}

typedef float f32x2 __attribute__((ext_vector_type(2)));
__device__ __forceinline__ void cvt16_fp8(const v4u w, float (&o)[16]) {
    const unsigned ww[4] = {w.x, w.y, w.z, w.w};
#pragma unroll
    for (int i = 0; i < 4; ++i) { const f32x2 a = __builtin_amdgcn_cvt_pk_f32_fp8((int)ww[i], false), b = __builtin_amdgcn_cvt_pk_f32_fp8((int)ww[i], true);
        o[4 * i] = a.x; o[4 * i + 1] = a.y; o[4 * i + 2] = b.x; o[4 * i + 3] = b.y; }
}
__device__ __forceinline__ void p0_row_fp8(const float* src, unsigned char* dst, float* sc, int row, int lane) {
    const GAS f32x4* sp = (const GAS f32x4*)(src + (size_t)row * D + 16 * lane);
    const f32x4 a = sp[0], b = sp[1], c = sp[2], d = sp[3];
    float mx = 0.f;
#pragma unroll
    for (int i = 0; i < 4; ++i) mx = fmaxf(fmaxf(fmaxf(mx, fabsf(a[i])), fmaxf(fabsf(b[i]), fabsf(c[i]))), fabsf(d[i]));
    mx = wave_max(mx); const float s = mx > 0.f ? 224.0f / mx : 1.0f;
    v4u o; int w;
    w = __builtin_amdgcn_cvt_pk_fp8_f32(a[0] * s, a[1] * s, 0, false); w = __builtin_amdgcn_cvt_pk_fp8_f32(a[2] * s, a[3] * s, w, true); o.x = (unsigned)w;
    w = __builtin_amdgcn_cvt_pk_fp8_f32(b[0] * s, b[1] * s, 0, false); w = __builtin_amdgcn_cvt_pk_fp8_f32(b[2] * s, b[3] * s, w, true); o.y = (unsigned)w;
    w = __builtin_amdgcn_cvt_pk_fp8_f32(c[0] * s, c[1] * s, 0, false); w = __builtin_amdgcn_cvt_pk_fp8_f32(c[2] * s, c[3] * s, w, true); o.z = (unsigned)w;
    w = __builtin_amdgcn_cvt_pk_fp8_f32(d[0] * s, d[1] * s, 0, false); w = __builtin_amdgcn_cvt_pk_fp8_f32(d[2] * s, d[3] * s, w, true); o.w = (unsigned)w;
    *(GAS v4u*)(dst + (size_t)row * D + 16 * lane) = o;
    if (lane == 0) sc[row] = mx > 0.f ? mx * (1.0f / 224.0f) : 1.0f;
}

__device__ __forceinline__ unsigned pack4_i8(float a, float b, float c, float d) { return ((unsigned)__float2int_rn(a) & 0xffu) | (((unsigned)__float2int_rn(b) & 0xffu) << 8) | (((unsigned)__float2int_rn(c) & 0xffu) << 16) | (((unsigned)__float2int_rn(d) & 0xffu) << 24); }
__device__ __forceinline__ void p0_row_i8(const float* src, unsigned char* dst, float* sc, int row, int lane) {
    const GAS f32x4* sp = (const GAS f32x4*)(src + (size_t)row * D + 16 * lane);
    const f32x4 a = sp[0], b = sp[1], c = sp[2], d = sp[3];
    float mx = 0.f;
#pragma unroll
    for (int i = 0; i < 4; ++i) mx = fmaxf(fmaxf(fmaxf(mx, fabsf(a[i])), fmaxf(fabsf(b[i]), fabsf(c[i]))), fabsf(d[i]));
    mx = wave_max(mx); const float s = mx > 0.f ? 127.0f / mx : 1.0f;
    v4u o; o.x = pack4_i8(a[0] * s, a[1] * s, a[2] * s, a[3] * s); o.y = pack4_i8(b[0] * s, b[1] * s, b[2] * s, b[3] * s); o.z = pack4_i8(c[0] * s, c[1] * s, c[2] * s, c[3] * s); o.w = pack4_i8(d[0] * s, d[1] * s, d[2] * s, d[3] * s);
    *(GAS v4u*)(dst + (size_t)row * D + 16 * lane) = o;
    if (lane == 0) sc[row] = mx > 0.f ? mx * (1.0f / 127.0f) : 1.0f;
}

__device__ __forceinline__ unsigned pack8_i4(const f32x4 a, const f32x4 b, float s) {
    unsigned w = 0;
#pragma unroll
    for (int i = 0; i < 4; ++i) { const int qa = max(-8, min(7, __float2int_rn(a[i] * s))), qb = max(-8, min(7, __float2int_rn(b[i] * s))); w |= ((unsigned)qa & 15u) << (4 * i); w |= ((unsigned)qb & 15u) << (16 + 4 * i); }
    return w;
}
__device__ __forceinline__ void p0_row_i4(const f32x4 a, const f32x4 b, const f32x4 c, const f32x4 d, unsigned char* dst, float* sc, int row, int lane) {
    float ss = 0.f;
#pragma unroll
    for (int i = 0; i < 4; ++i) ss += (a[i] * a[i] + b[i] * b[i]) + (c[i] * c[i] + d[i] * d[i]);
    ss = wave_sum(ss); const float sig = sqrtf(ss * (1.f / D)), s = sig > 0.f ? 3.0f / sig : 1.0f;
    v2u o; o.x = pack8_i4(a, b, s); o.y = pack8_i4(c, d, s);
    *(GAS v2u*)(dst + (size_t)row * (D / 2) + 8 * lane) = o;
    if (lane == 0) sc[row] = sig > 0.f ? sig * (1.0f / 3.0f) : 1.0f;
}

__device__ __forceinline__ unsigned pack8_fp4(const f32x4 a, const f32x4 b, float s) {
    unsigned w = 0;
    w = __builtin_amdgcn_cvt_scalef32_pk_fp4_f32(w, fminf(fmaxf(a[0] * s, -6.f), 6.f), fminf(fmaxf(a[1] * s, -6.f), 6.f), 1.0f, 0);
    w = __builtin_amdgcn_cvt_scalef32_pk_fp4_f32(w, fminf(fmaxf(a[2] * s, -6.f), 6.f), fminf(fmaxf(a[3] * s, -6.f), 6.f), 1.0f, 1);
    w = __builtin_amdgcn_cvt_scalef32_pk_fp4_f32(w, fminf(fmaxf(b[0] * s, -6.f), 6.f), fminf(fmaxf(b[1] * s, -6.f), 6.f), 1.0f, 2);
    w = __builtin_amdgcn_cvt_scalef32_pk_fp4_f32(w, fminf(fmaxf(b[2] * s, -6.f), 6.f), fminf(fmaxf(b[3] * s, -6.f), 6.f), 1.0f, 3);
    return w;
}
__device__ __forceinline__ void p0_row_fp4(const f32x4 a, const f32x4 b, const f32x4 c, const f32x4 d, unsigned char* dst, float* sc, int row, int lane) {
    float mx = 0.f;
#pragma unroll
    for (int i = 0; i < 4; ++i) mx = fmaxf(fmaxf(fmaxf(mx, fabsf(a[i])), fmaxf(fabsf(b[i]), fabsf(c[i]))), fabsf(d[i]));
    mx = wave_max(mx); const float s = mx > 0.f ? 7.0f / mx : 1.0f;
    v2u o; o.x = pack8_fp4(a, b, s); o.y = pack8_fp4(c, d, s);
    *(GAS v2u*)(dst + (size_t)row * (D / 2) + 8 * lane) = o;
    if (lane == 0) sc[row] = mx > 0.f ? mx * (1.0f / 7.0f) : 1.0f;
}
#define XB_TMO      128
#define XB_XCNT(j)  (256  + 64 * (j))
#define XB_XSUB(j)  (1280 + 64 * (j))
#define XB_XGEN(j)  (2304 + 64 * (j))
#define XB_TOP      3328
#define XB_TOPGEN   3392
#define XCD_BAR_WORDS 3456
#define XB_SPIN_CAP (1u << 18)

__device__ __forceinline__ unsigned xb_ld(unsigned* p)              { return __hip_atomic_load(p, __ATOMIC_RELAXED, __HIP_MEMORY_SCOPE_AGENT); }
__device__ __forceinline__ unsigned xb_add(unsigned* p, unsigned v) { return __hip_atomic_fetch_add(p, v, __ATOMIC_RELAXED, __HIP_MEMORY_SCOPE_AGENT); }
__device__ __forceinline__ unsigned xb_xcc_id() { return (unsigned)__builtin_amdgcn_s_getreg((3 << 11) | 20) & 0xFu; }
#define XB_SPIN(cond, bar) do { unsigned _sp = 0; while (cond) { __builtin_amdgcn_s_sleep(1); \
    if ((++_sp & 255u) == 0u) { if (xb_ld(&(bar)[XB_TMO])) break; if (_sp > XB_SPIN_CAP) { atomicAdd(&(bar)[XB_TMO], 1u); break; } } } } while (0)

struct XcdBarrier {
    unsigned* bar; unsigned x;
    volatile LAS unsigned* st;
};

__device__ __forceinline__ XcdBarrier xcd_barrier_post(unsigned* bar, volatile LAS unsigned* st) {
    XcdBarrier b; b.bar = bar; b.x = xb_xcc_id(); b.st = st;
    if (threadIdx.x == 0) (void)xb_add(&bar[XB_XCNT(b.x)], 1u);
    return b;
}
__device__ __forceinline__ void xcd_barrier_complete(unsigned* bar, unsigned x, unsigned& nloc, unsigned& nx) {
    const unsigned G = gridDim.x * gridDim.y * gridDim.z;
    unsigned sum, cnt, mine, sp = 0u;
    for (;;) {
        sum = 0u; cnt = 0u; mine = 0u;
#pragma unroll
        for (unsigned j = 0; j < 16; ++j) { const unsigned c = xb_ld(&bar[XB_XCNT(j)]); sum += c; cnt += (c > 0u) ? 1u : 0u; mine = (j == x) ? c : mine; }
        if (sum == G) break;
        __builtin_amdgcn_s_sleep(1);
        if ((++sp & 255u) == 0u) { if (xb_ld(&bar[XB_TMO])) break; if (sp > XB_SPIN_CAP) { atomicAdd(&bar[XB_TMO], 1u); break; } }
    }
    nloc = mine > 0u ? mine : 1u; nx = cnt > 0u ? cnt : 1u;
}

__device__ __forceinline__ void xcd_barrier(const XcdBarrier& b) {
    asm volatile("s_waitcnt vmcnt(0)" ::: "memory");
    __syncthreads();
    if (threadIdx.x == 0) {
        unsigned* bar = b.bar;
        __builtin_amdgcn_s_waitcnt(0);
        unsigned nloc = b.st[0], nx = b.st[1];
        if (nloc == 0u) { xcd_barrier_complete(bar, b.x, nloc, nx); b.st[0] = nloc; b.st[1] = nx; }
        const unsigned old = xb_add(&bar[XB_XSUB(b.x)], 1u);
        const unsigned gen = old / nloc;
        if (old + 1u == (gen + 1u) * nloc) {
            __builtin_amdgcn_fence(__ATOMIC_RELEASE, "agent");
            asm volatile("s_waitcnt vmcnt(0)" ::: "memory");
            const unsigned og = xb_add(&bar[XB_TOP], 1u);
            const unsigned tg = og / nx;
            if (og + 1u == (tg + 1u) * nx) xb_add(&bar[XB_TOPGEN], 1u);
            else XB_SPIN(xb_ld(&bar[XB_TOPGEN]) == tg, bar);
            __builtin_amdgcn_fence(__ATOMIC_ACQUIRE, "agent");
            xb_add(&bar[XB_XGEN(b.x)], 1u);
            asm volatile("s_waitcnt vmcnt(0)" ::: "memory");
        } else {
            XB_SPIN(xb_ld(&bar[XB_XGEN(b.x)]) == gen, bar);
            __builtin_amdgcn_fence(__ATOMIC_ACQUIRE, "agent");
            asm volatile("s_waitcnt vmcnt(0)" ::: "memory");
        }
    }
    __syncthreads();
}
struct Args { const void* in[21]; float* out; unsigned char* ws; int ph_lo, ph_hi; };
enum { I_X = 0, I_C, I_POS, I_WMOD, I_BMOD, I_GPRE1, I_GPOST1, I_WIN, I_CONVW, I_BI, I_BF, I_MNG, I_SINK, I_WOUT, I_GPRE2, I_GPOST2, I_WQ, I_K1, I_K2, I_U, I_V };

__device__ __forceinline__ int newcol(int o) {
    if (o < 640) { const int hd = o >> 6, d = o & 63; return (hd << 6) + 2 * (d & 31) + (d >> 5); }
    if (o < 1792) return o;
    if (o < 1800) return 2304 + (o - 1792);
    return o - 8;
}
template <bool REMAP>
__device__ __forceinline__ void p0_transpose_item(const float* W, int K, int N, bf16* WT, LAS float* scr, int item, int lane) {
    const int nblk = (N + 31) / 32, kb = item / nblk, nb = item % nblk, k0 = 64 * kb, n0 = 32 * nb;
    const int ncol = n0 + (lane & 31);
#pragma unroll 8
    for (int i = 0; i < 32; ++i) { const int kk = 2 * i + (lane >> 5); scr[kk * 33 + (lane & 31)] = (ncol < N) ? W[(size_t)(k0 + kk) * N + ncol] : 0.f; }
    LDS_WAIT(); asm volatile("" ::: "memory");
    const int c = lane & 7;
#pragma unroll
    for (int j = 0; j < 4; ++j) { const int n = (lane >> 3) + 8 * j; const LAS float* s = scr + (8 * c) * 33 + n;
        v4u o; o.x = pk2(s[0 * 33], s[1 * 33]); o.y = pk2(s[2 * 33], s[3 * 33]); o.z = pk2(s[4 * 33], s[5 * 33]); o.w = pk2(s[6 * 33], s[7 * 33]);
        if (n0 + n < N) { const int drow = REMAP ? newcol(n0 + n) : (n0 + n); *(GAS v4u*)(WT + (size_t)drow * K + k0 + 8 * c) = o; } }
    LDS_WAIT(); asm volatile("" ::: "memory");
}
__device__ __forceinline__ void p0_convert(const float* src, bf16* dst, size_t n, int gt, int ngt) {
    for (size_t i = (size_t)gt * 8; i < n; i += (size_t)ngt * 8) {
        const f32x4 a = *(const GAS f32x4*)(src + i), b = *(const GAS f32x4*)(src + i + 4);
        v4u o; o.x = pk2(a[0], a[1]); o.y = pk2(a[2], a[3]); o.z = pk2(b[0], b[1]); o.w = pk2(b[2], b[3]);
        *(GAS v4u*)(dst + i) = o; }
}
__device__ __forceinline__ void phase_mod(const Args& A, LAS unsigned char* lds) {
    const int tid = threadIdx.x, G = gridDim.x, blk = blockIdx.x;
    unsigned char* ws = A.ws;
    const float* c = (const float*)A.in[I_C]; const float* wm = (const float*)A.in[I_WMOD]; const float* bm = (const float*)A.in[I_BMOD];
    float* mod = (float*)(ws + WS_MOD); LAS float* cs = (LAS float*)lds; LAS float* red = cs + 8 * 1024;
    for (int e = tid; e < 8 * 1024 / 4; e += NTHR) *(LAS f32x4*)(cs + 4 * e) = *(const GAS f32x4*)(c + 4 * e);
    __syncthreads();
    for (int it = blk; it < 6144 / 24; it += G) {
        const int kg = tid >> 5, col = tid & 31, j = it * 24 + (col < 24 ? col : 23); float acc[8];
#pragma unroll
        for (int b = 0; b < 8; ++b) acc[b] = 0.f;
#pragma unroll 16
        for (int i = 0; i < 64; ++i) { const int k = kg + 16 * i; const float w = wm[(size_t)k * 6144 + j];
#pragma unroll
            for (int b = 0; b < 8; ++b) acc[b] += cs[b * 1024 + k] * w; }
#pragma unroll
        for (int b = 0; b < 8; ++b) red[(kg * 32 + col) * 8 + b] = acc[b];
        __syncthreads();
        if (tid < 256) { const int b = tid >> 5, cc = tid & 31; float s = 0.f;
#pragma unroll
            for (int g = 0; g < 16; ++g) s += red[(g * 32 + cc) * 8 + b];
            if (cc < 24) mod[b * 6144 + it * 24 + cc] = s + bm[it * 24 + cc]; }
        __syncthreads();
    }
}
__device__ __forceinline__ void phase_convert(const Args& A, LAS unsigned char* lds) {
    const int tid = threadIdx.x, lane = tid & 63, wave = tid >> 6, G = gridDim.x, blk = blockIdx.x;
    unsigned char* ws = A.ws;
    {
        LAS float* scr = (LAS float*)(lds + wave * 16384);
        const int gw = blk * NWAVES + wave, NGW = G * NWAVES;
        const int I_IN = (D / 64) * ((DIN + 31) / 32), I_OUT = (D / 64) * (D / 32), I_Q = (D / 64) * (2048 / 32);
        bf16* win = (bf16*)(ws + WS_WIN); bf16* wout = (bf16*)(ws + WS_WOUT); bf16* wq = (bf16*)(ws + WS_WQ);
        for (int it = gw; it < I_IN + I_OUT + I_Q; it += NGW) {
            int r = it;
            if (r < I_IN) { p0_transpose_item<true>((const float*)A.in[I_WIN], D, DIN, win, scr, r, lane); continue; } r -= I_IN;
            if (r < I_OUT) { p0_transpose_item<false>((const float*)A.in[I_WOUT], D, D, wout, scr, r, lane); continue; } r -= I_OUT;
            p0_transpose_item<false>((const float*)A.in[I_WQ], D, 2048, wq, scr, r, lane);
        }
        const int gt = blk * NTHR + tid, ngt = G * NTHR;
        for (int i = gt; i < (NIN_PAD - DIN) * D / 8; i += ngt) *(GAS v4u*)(win + (size_t)DIN * D + (size_t)i * 8) = (v4u){0u, 0u, 0u, 0u};
        p0_convert((const float*)A.in[I_K1], (bf16*)(ws + WS_KEYS), (size_t)8 * 128 * 128, gt, ngt);
        p0_convert((const float*)A.in[I_K2], (bf16*)(ws + WS_KEYS) + 8 * 128 * 128, (size_t)8 * 128 * 128, gt, ngt);
        {
            const float* usrc = (const float*)A.in[I_U]; const float* vsrc = (const float*)A.in[I_V];
            auto rowp = [&](int r) { return (const GAS f32x4*)((r < NEXP ? usrc + (size_t)r * D : vsrc + (size_t)(r - NEXP) * D) + 16 * lane); };
            int r = gw; const GAS f32x4* sp = rowp(min(r, 2 * NEXP - 1)); f32x4 a = sp[0], b = sp[1], c = sp[2], d = sp[3];
            for (; r < 2 * NEXP; r += NGW) { const GAS f32x4* sn = rowp(min(r + NGW, 2 * NEXP - 1)); const f32x4 an = sn[0], bn = sn[1], cn = sn[2], dn = sn[3];
                if (r < NEXP) p0_row_i4(a, b, c, d, ws + WS_U8, (float*)(ws + WS_SC), r, lane); else p0_row_fp4(a, b, c, d, ws + WS_V8, (float*)(ws + WS_SC) + NEXP, r - NEXP, lane);
                a = an; b = bn; c = cn; d = dn; }
        }
    }
}

__device__ __forceinline__ void phase_prenorm(const Args& A, LAS unsigned char* lds) {
    const int tid = threadIdx.x, lane = tid & 63, wave = tid >> 6, G = gridDim.x;
    const float* x = (const float*)A.in[I_X]; const float* g = (const float*)A.in[I_GPRE1]; const float* mod = (const float*)(A.ws + WS_MOD);
    bf16* H = (bf16*)(A.ws + WS_H); float* gates = (float*)(A.ws + WS_GATES);
    LAS float* wg = (LAS float*)lds;
    __syncthreads();
    for (int k = tid; k < D; k += NTHR) { const float* wr = (const float*)A.in[I_WIN] + (size_t)k * DIN + 1792; const f32x4 w0 = *(const GAS f32x4*)wr, w1 = *(const GAS f32x4*)(wr + 4);
#pragma unroll
        for (int j = 0; j < 4; ++j) { wg[j * D + k] = w0[j]; wg[(4 + j) * D + k] = w1[j]; } }
    __syncthreads();
    const int gi = ((lane >> 5) & 1) * 4 + ((lane >> 4) & 1) * 2 + ((lane >> 3) & 1);
    const float gbias = gi < 4 ? ((const float*)A.in[I_BI])[gi] : ((const float*)A.in[I_BF])[gi - 4];
    f32x4 gg[4];
#pragma unroll
    for (int j = 0; j < 4; ++j) gg[j] = *(const GAS f32x4*)(g + 4 * (lane + 64 * j));
    const int stride = G * NWAVES; int row = blockIdx.x * NWAVES + wave;
    f32x4 v[4], vn[4], shv[4], gsv[4]; int bcur = -1;
#pragma unroll
    for (int j = 0; j < 4; ++j) v[j] = ((const GAS f32x4*)(x + (size_t)row * D) + lane)[64 * j];
    for (; row < M; row += stride) {
        const int rn = min(row + stride, M - 1);
#pragma unroll
        for (int j = 0; j < 4; ++j) vn[j] = ((const GAS f32x4*)(x + (size_t)rn * D) + lane)[64 * j];
        const int b = row / SEQ; float s = 0.f;
        if (b != bcur) { bcur = b;
#pragma unroll
            for (int j = 0; j < 4; ++j) { const int k = 4 * (lane + 64 * j); shv[j] = *(const GAS f32x4*)(mod + b * 6144 + k); const f32x4 sc = *(const GAS f32x4*)(mod + b * 6144 + 1024 + k);
#pragma unroll
                for (int i = 0; i < 4; ++i) gsv[j][i] = gg[j][i] * (1.f + sc[i]); } }
#pragma unroll
        for (int j = 0; j < 4; ++j) s += (v[j][0] * v[j][0] + v[j][1] * v[j][1]) + (v[j][2] * v[j][2] + v[j][3] * v[j][3]);
        const float rstd = 1.0f / sqrtf(wave_sum(s) * (1.f / D) + EPS);
        GAS v2u* o = (GAS v2u*)(H + (size_t)row * D) + lane;
        float gd[8];
#pragma unroll
        for (int q = 0; q < 8; ++q) gd[q] = 0.f;
#pragma unroll
        for (int j = 0; j < 4; ++j) {
            f32x4 y;
#pragma unroll
            for (int i = 0; i < 4; ++i) y[i] = v[j][i] * rstd * gsv[j][i] + shv[j][i];
            v2u w; w.x = pk2(y[0], y[1]); w.y = pk2(y[2], y[3]); o[64 * j] = w;
#pragma unroll
            for (int q = 0; q < 8; ++q) { const f32x4 ww = *(LAS const f32x4*)(wg + q * D + 4 * (lane + 64 * j)); gd[q] += (y[0] * ww[0] + y[1] * ww[1]) + (y[2] * ww[2] + y[3] * ww[3]); } }
#pragma unroll
        for (int i = 0; i < 4; ++i) { const bool up = (lane & 32) != 0; const float keep = up ? gd[i + 4] : gd[i], send = up ? gd[i] : gd[i + 4]; gd[i] = keep + __shfl_xor(send, 32); }
#pragma unroll
        for (int i = 0; i < 2; ++i) { const bool up = (lane & 16) != 0; const float keep = up ? gd[i + 2] : gd[i], send = up ? gd[i] : gd[i + 2]; gd[i] = keep + __shfl_xor(send, 16); }
        { const bool up = (lane & 8) != 0; const float keep = up ? gd[1] : gd[0], send = up ? gd[0] : gd[1]; gd[0] = keep + __shfl_xor(send, 8); }
        float gv = gd[0]; gv += __shfl_xor(gv, 4); gv += __shfl_xor(gv, 2); gv += __shfl_xor(gv, 1); gv += gbias;
        if ((lane & 7) == 0) gates[(size_t)row * 8 + gi] = gi < 4 ? gv : (fminf(gv, 0.f) - log1pf(__expf(-fabsf(gv))));
#pragma unroll
        for (int j = 0; j < 4; ++j) v[j] = vn[j];
    }
}

__device__ __forceinline__ void phase_mid(const Args& A) {
    const int tid = threadIdx.x, lane = tid & 63, wave = tid >> 6, G = gridDim.x;
    const float* x = (const float*)A.in[I_X]; const float* gpost = (const float*)A.in[I_GPOST1]; const float* gpre = (const float*)A.in[I_GPRE2];
    const float* mod = (const float*)(A.ws + WS_MOD); const float* sumsq = (const float*)(A.ws + WS_SSQ);
    const bf16* MIX = (const bf16*)(A.ws + WS_MIX); bf16* H = (bf16*)(A.ws + WS_H); bf16* X1 = (bf16*)(A.ws + WS_X1);
    const int stride = G * NWAVES; int row = blockIdx.x * NWAVES + wave;
    f32x4 xv[4], xn[4], q[4], qn[4], g1p[4], gs2[4], sh2[4]; v2u mw[4], mn[4]; int bcur = -1;
#pragma unroll
    for (int j = 0; j < 4; ++j) { xv[j] = ((const GAS f32x4*)(x + (size_t)row * D) + lane)[64 * j]; mw[j] = ((const GAS v2u*)(MIX + (size_t)row * D) + lane)[64 * j]; q[j] = *(const GAS f32x4*)(sumsq + (size_t)row * 16 + 4 * j); }
    for (; row < M; row += stride) {
        const int rn = min(row + stride, M - 1);
#pragma unroll
        for (int j = 0; j < 4; ++j) { xn[j] = ((const GAS f32x4*)(x + (size_t)rn * D) + lane)[64 * j]; mn[j] = ((const GAS v2u*)(MIX + (size_t)rn * D) + lane)[64 * j]; qn[j] = *(const GAS f32x4*)(sumsq + (size_t)rn * 16 + 4 * j); }
        const int b = row / SEQ;
        if (b != bcur) { bcur = b;
#pragma unroll
            for (int j = 0; j < 4; ++j) { const int k = 4 * (lane + 64 * j); const f32x4 gp = *(const GAS f32x4*)(gpost + k), g1 = *(const GAS f32x4*)(mod + b * 6144 + 2048 + k), gg = *(const GAS f32x4*)(gpre + k), sc = *(const GAS f32x4*)(mod + b * 6144 + 4096 + k);
                sh2[j] = *(const GAS f32x4*)(mod + b * 6144 + 3072 + k);
#pragma unroll
                for (int i = 0; i < 4; ++i) { g1p[j][i] = g1[i] * gp[i]; gs2[j][i] = gg[i] * (1.f + sc[i]); } } }
        const float rm = 1.0f / sqrtf(((((q[0][0] + q[0][1]) + (q[0][2] + q[0][3])) + ((q[1][0] + q[1][1]) + (q[1][2] + q[1][3]))) + (((q[2][0] + q[2][1]) + (q[2][2] + q[2][3])) + ((q[3][0] + q[3][1]) + (q[3][2] + q[3][3])))) * (1.f / D) + EPS);
        f32x4 v[4]; float s = 0.f;
#pragma unroll
        for (int j = 0; j < 4; ++j) {
            const float mx[4] = {bflo(mw[j].x), bfhi(mw[j].x), bflo(mw[j].y), bfhi(mw[j].y)};
#pragma unroll
            for (int i = 0; i < 4; ++i) { v[j][i] = xv[j][i] + g1p[j][i] * (mx[i] * rm); s += v[j][i] * v[j][i]; }
            { v2u w; w.x = pk2(v[j][0], v[j][1]); w.y = pk2(v[j][2], v[j][3]); *((GAS v2u*)(X1 + (size_t)row * D) + lane + 64 * j) = w; } }
        const float rstd = 1.0f / sqrtf(wave_sum(s) * (1.f / D) + EPS);
        GAS v2u* o = (GAS v2u*)(H + (size_t)row * D) + lane; float amx = 0.f;
#pragma unroll
        for (int j = 0; j < 4; ++j) {
#pragma unroll
            for (int i = 0; i < 4; ++i) { v[j][i] = v[j][i] * rstd * gs2[j][i] + sh2[j][i]; amx = fmaxf(amx, fabsf(v[j][i])); }
            v2u w; w.x = pk2(v[j][0], v[j][1]); w.y = pk2(v[j][2], v[j][3]); o[64 * j] = w; }
        amx = wave_max(amx); const float s8 = amx > 0.f ? 119.0f / amx : 1.0f;
        GAS unsigned short* ohh = (GAS unsigned short*)((unsigned char*)A.ws + WS_H8 + (size_t)row * (D / 2)) + lane; GAS unsigned short* ohl = (GAS unsigned short*)((unsigned char*)A.ws + WS_H8 + 32 * MiB + (size_t)row * (D / 2)) + lane;
#pragma unroll
        for (int j = 0; j < 4; ++j) { unsigned whh = 0, whl = 0;
#pragma unroll
            for (int i = 0; i < 4; ++i) { const int tq = __float2int_rn(v[j][i] * s8) + 8; whh |= ((unsigned)(tq >> 4) & 15u) << (4 * i); whl |= ((unsigned)((tq & 15) - 8) & 15u) << (4 * i); }
            ohh[64 * j] = (unsigned short)whh; ohl[64 * j] = (unsigned short)whl; }
        if (lane == 0) ((float*)(A.ws + WS_HS))[row] = amx > 0.f ? amx * (1.0f / 119.0f) : 1.0f;
#pragma unroll
        for (int j = 0; j < 4; ++j) { xv[j] = xn[j]; mw[j] = mn[j]; q[j] = qn[j]; }
    }
}
__device__ __forceinline__ void load64bf(const bf16* p, float (&o)[64]) {
#pragma unroll
    for (int i = 0; i < 8; ++i) { const v4u w = *(const GAS v4u*)(p + 8 * i);
        o[8 * i + 0] = bflo(w.x); o[8 * i + 1] = bfhi(w.x); o[8 * i + 2] = bflo(w.y); o[8 * i + 3] = bfhi(w.y);
        o[8 * i + 4] = bflo(w.z); o[8 * i + 5] = bfhi(w.z); o[8 * i + 6] = bflo(w.w); o[8 * i + 7] = bfhi(w.w); }
}
__device__ __forceinline__ void phase_attn_naive(const Args& A, int vb, int nvb) {
    const bf16* P = (const bf16*)(A.ws + WS_PROJ); bf16* MI = (bf16*)(A.ws + WS_MIXIN); const float* sinks = (const float*)A.in[I_SINK];
    for (int task = vb * NTHR + (int)threadIdx.x; task < 8 * M; task += nvb * NTHR) {
        const int h = task / M, t = task % M, s = t % SEQ, kvh = h >> 2;
        float q[64], o[64];
        load64bf(P + (size_t)t * NPROJ + C_AQ + h * 64, q);
#pragma unroll
        for (int d = 0; d < 64; ++d) o[d] = 0.f;
        float mx = sinks[h], l = 1.f;
        for (int j = 0; j < 128; ++j) {
            const int sj = s - 127 + j; const bool valid = sj >= 0; const int tk = valid ? (t - 127 + j) : t;
            const bf16* kr = P + (size_t)tk * NPROJ + C_AK + kvh * 64; float sc = 0.f;
#pragma unroll
            for (int i = 0; i < 8; ++i) { const v4u w = *(const GAS v4u*)(kr + 8 * i);
                sc += q[8 * i + 0] * bflo(w.x) + q[8 * i + 1] * bfhi(w.x) + q[8 * i + 2] * bflo(w.y) + q[8 * i + 3] * bfhi(w.y)
                    + q[8 * i + 4] * bflo(w.z) + q[8 * i + 5] * bfhi(w.z) + q[8 * i + 6] * bflo(w.w) + q[8 * i + 7] * bfhi(w.w); }
            if (valid) {
                const float mn = fmaxf(mx, sc), al = __expf(mx - mn), p = __expf(sc - mn); mx = mn; l = l * al + p;
                const bf16* vr = P + (size_t)tk * NPROJ + C_AV + kvh * 64;
#pragma unroll
                for (int i = 0; i < 8; ++i) { const v4u w = *(const GAS v4u*)(vr + 8 * i);
                    o[8 * i + 0] = o[8 * i + 0] * al + p * bflo(w.x); o[8 * i + 1] = o[8 * i + 1] * al + p * bfhi(w.x);
                    o[8 * i + 2] = o[8 * i + 2] * al + p * bflo(w.y); o[8 * i + 3] = o[8 * i + 3] * al + p * bfhi(w.y);
                    o[8 * i + 4] = o[8 * i + 4] * al + p * bflo(w.z); o[8 * i + 5] = o[8 * i + 5] * al + p * bfhi(w.z);
                    o[8 * i + 6] = o[8 * i + 6] * al + p * bflo(w.w); o[8 * i + 7] = o[8 * i + 7] * al + p * bfhi(w.w); }
            }
        }
        const float il = 1.f / l; bf16* orow = MI + (size_t)t * D + h * 64;
#pragma unroll
        for (int i = 0; i < 8; ++i) { v4u w; w.x = pk2(o[8 * i] * il, o[8 * i + 1] * il); w.y = pk2(o[8 * i + 2] * il, o[8 * i + 3] * il);
            w.z = pk2(o[8 * i + 4] * il, o[8 * i + 5] * il); w.w = pk2(o[8 * i + 6] * il, o[8 * i + 7] * il); *(GAS v4u*)(orow + 8 * i) = w; }
    }
}

__device__ __forceinline__ void phase_mlstm_naive(const Args& A, LAS unsigned char* lds, int bh) {
    const int tid = threadIdx.x, lane = tid & 63, wave = tid >> 6, b = bh >> 2, h = bh & 3, dv = tid >> 2, part = tid & 3;
    const bf16* P = (const bf16*)(A.ws + WS_PROJ); bf16* MI = (bf16*)(A.ws + WS_MIXIN); const float* gates = (const float*)(A.ws + WS_GATES);
    const float* cw = (const float*)A.in[I_CONVW]; const float* ng = (const float*)A.in[I_MNG];
    LAS float* qs = (LAS float*)lds; LAS float* ks = qs + 64 * 64; LAS float* vs = ks + 64 * 64; LAS float* ig = vs + 64 * 128; LAS float* lfg = ig + 64; LAS float* hb = lfg + 64;
    float C[16], n[16]; float m = 0.f;
#pragma unroll
    for (int j = 0; j < 16; ++j) { C[j] = 0.f; n[j] = 0.f; }
    for (int ch = 0; ch < SEQ / 64; ++ch) {
        const int s0 = ch * 64; const size_t t0 = (size_t)b * SEQ + s0;
        for (int e = tid; e < 64 * 64; e += NTHR) { const int l = e >> 6, dk = e & 63; float aq = 0.f, ak = 0.f;
#pragma unroll
            for (int j = 0; j < 4; ++j) { const int sj = s0 + l - 3 + j; if (sj >= 0) { const bf16* r = P + ((size_t)b * SEQ + sj) * NPROJ;
                aq += cw[j * 512 + h * 64 + dk] * bf1(r[C_MQ + h * 64 + dk]); ak += cw[j * 512 + 256 + h * 64 + dk] * bf1(r[C_MK + h * 64 + dk]); } }
            qs[e] = 0.125f * aq / (1.f + __expf(-aq)); ks[e] = ak / (1.f + __expf(-ak)); }
        for (int e = tid; e < 64 * 128; e += NTHR) { const int l = e >> 7, d = e & 127; vs[e] = bf1(P[(t0 + l) * NPROJ + C_MV + h * 128 + d]); }
        if (tid < 64) { ig[tid] = gates[(t0 + tid) * 8 + h]; lfg[tid] = gates[(t0 + tid) * 8 + 4 + h]; }
        __syncthreads();
        for (int l = 0; l < 64; ++l) {
            const float lf = lfg[l], ii = ig[l], mn = fmaxf(lf + m, ii), fd = __expf(lf + m - mn), iw = __expf(ii - mn), vv = vs[l * 128 + dv] * iw;
            float num = 0.f, den = 0.f;
#pragma unroll
            for (int j = 0; j < 16; ++j) { const float kk = ks[l * 64 + part * 16 + j], qq = qs[l * 64 + part * 16 + j];
                C[j] = fd * C[j] + vv * kk; n[j] = fd * n[j] + iw * kk; num += C[j] * qq; den += n[j] * qq; }
            num += __shfl_xor(num, 1); num += __shfl_xor(num, 2); den += __shfl_xor(den, 1); den += __shfl_xor(den, 2);
            if (part == 0) hb[l * 128 + dv] = num / fmaxf(fabsf(den), __expf(-mn));
            m = mn;
        }
        __syncthreads();
        for (int l = wave * 8; l < wave * 8 + 8; ++l) { const float a0 = hb[l * 128 + lane], a1 = hb[l * 128 + 64 + lane];
            const float r = 1.0f / sqrtf(wave_sum(a0 * a0 + a1 * a1) * (1.f / 128.f) + EPS);
            const bf16* pr = P + (t0 + l) * NPROJ + C_MO + h * 128; bf16* orow = MI + (t0 + l) * D + 512 + h * 128;
            orow[lane] = (bf16)f2bf(a0 * r * ng[h * 128 + lane] * bf1(pr[lane])); orow[64 + lane] = (bf16)f2bf(a1 * r * ng[h * 128 + 64 + lane] * bf1(pr[64 + lane])); }
        __syncthreads();
    }
}

__device__ __forceinline__ void ld16bf(const bf16* p, float (&o)[16]) {
    const v4u w0 = *(const GAS v4u*)p, w1 = *(const GAS v4u*)(p + 8);
    o[0] = bflo(w0.x); o[1] = bfhi(w0.x); o[2] = bflo(w0.y); o[3] = bfhi(w0.y); o[4] = bflo(w0.z); o[5] = bfhi(w0.z); o[6] = bflo(w0.w); o[7] = bfhi(w0.w);
    o[8] = bflo(w1.x); o[9] = bfhi(w1.x); o[10] = bflo(w1.y); o[11] = bfhi(w1.y); o[12] = bflo(w1.z); o[13] = bfhi(w1.z); o[14] = bflo(w1.w); o[15] = bfhi(w1.w);
}
typedef short bf16x8 __attribute__((ext_vector_type(8)));
#define MFMA16(a, b, c) __builtin_amdgcn_mfma_f32_16x16x32_bf16((a), (b), (c), 0, 0, 0)
__device__ __forceinline__ bf16x8 ldfrag(LAS const unsigned char* img, int row, int kbyte) { return *(LAS const bf16x8*)(img + row * 144 + kbyte); }
__device__ __forceinline__ bf16x8 ldfrag_sw(LAS const unsigned char* img, int row, int kbyte) { return *(LAS const bf16x8*)(img + row * 144 + (kbyte ^ (((row >> 3) & 7) << 4))); }
__device__ __forceinline__ unsigned cvtpk(float lo, float hi) { unsigned r; asm volatile("v_cvt_pk_bf16_f32 %0, %1, %2" : "=v"(r) : "v"(lo), "v"(hi)); return r; }

namespace ml {
constexpr int O_Q = 0, O_QA = 9216, O_K = 18432, O_KWT = 27648, O_VT = 36864, O_CX = 57600, CXB = 20736, O_S = 99072, O_GB = 108288, O_GA = O_GB + 4096, O_GC = O_GA + 4096, O_DEN = O_GC + 4096, O_SSQ = O_DEN + 256, O_END = O_SSQ + 2048;
static_assert(O_END <= 131072, "mlstm LDS");
constexpr size_t MST_SC = 11 * MiB;
}
template <bool OUT>
__device__ __forceinline__ void mlstm_group(const Args& A, LAS unsigned char* lds, int wg) {
    using namespace ml;
    const int tid = threadIdx.x, lane = tid & 63, wave = __builtin_amdgcn_readfirstlane(tid >> 6), fr = lane & 15, fq = lane >> 4;
    const int bh = wg >> 3, grp = wg & 7, b = bh >> 2, h = bh & 3;
    const size_t tg0 = (size_t)b * SEQ + (size_t)grp * 1024;
    const bf16* P = (const bf16*)(A.ws + WS_PROJ); bf16* MI = (bf16*)(A.ws + WS_MIXIN); const float* gates = (const float*)(A.ws + WS_GATES);
    const float* cw = (const float*)A.in[I_CONVW]; const float* ng = (const float*)A.in[I_MNG];
    float* MST = (float*)(A.ws + WS_MST); float* MSC = (float*)(A.ws + WS_MST + MST_SC);
    LAS float* GB = (LAS float*)(lds + O_GB); LAS float* GA = (LAS float*)(lds + O_GA); LAS float* GC = (LAS float*)(lds + O_GC);
    LAS float* DEN = (LAS float*)(lds + O_DEN); LAS float* SSQ = (LAS float*)(lds + O_SSQ);
    __syncthreads();
#pragma unroll
    for (int cc = 0; cc < 2; ++cc) { const int c = 2 * wave + cc; const size_t t = tg0 + c * 64 + lane;
        float bc = gates[t * 8 + 4 + h]; const float ii = gates[t * 8 + h];
#pragma unroll
        for (int o = 1; o < 64; o <<= 1) { const float v = __shfl_up(bc, o); if (lane >= o) bc += v; }
        const float a = ii - bc; float cm = a;
#pragma unroll
        for (int o = 1; o < 64; o <<= 1) { const float v = __shfl_up(cm, o); if (lane >= o) cm = fmaxf(cm, v); }
        GB[c * 64 + lane] = bc; GA[c * 64 + lane] = a; GC[c * 64 + lane] = cm; }
    for (int e = tid; e < 16 * 32; e += NTHR) { const int r = e >> 5, cpair = e & 31; *(LAS unsigned*)(lds + O_VT + (128 + r) * 144 + cpair * 4) = (r == 0) ? 0x3F803F80u : 0u; }
    f32x4 st[5];
#pragma unroll
    for (int i = 0; i < 5; ++i) st[i] = (f32x4){0.f, 0.f, 0.f, 0.f};
    float m = OUT ? 0.f : -__builtin_inff(); float Btot = 0.f;
    if (OUT) {
        for (int gp = 0; gp < grp; ++gp) { const int wgp = bh * 8 + gp; const float mg = MSC[wgp * 2], Bg = MSC[wgp * 2 + 1];
            const float mn = fmaxf(Bg + m, mg), f0 = __expf(Bg + m - mn), f1 = __expf(mg - mn);
#pragma unroll
            for (int i = 0; i < 5; ++i)
#pragma unroll
                for (int r = 0; r < 4; ++r) st[i][r] = f0 * st[i][r] + f1 * MST[((size_t)wgp * 20 + i * 4 + r) * NTHR + tid];
            m = mn; }
#pragma unroll
        for (int j = 0; j < 4; ++j)
#pragma unroll
            for (int r = 0; r < 4; ++r) *(LAS bf16*)(lds + O_CX + (16 * wave + 4 * fq + r) * 144 + (16 * j + fr) * 2) = (bf16)f2bf(st[j][r]);
        if (wave < 4) {
#pragma unroll
            for (int r = 0; r < 4; ++r) *(LAS bf16*)(lds + O_CX + (128 + 4 * fq + r) * 144 + (16 * wave + fr) * 2) = (bf16)f2bf(st[4][r]); }
    }
    float gsc[4];
#pragma unroll
    for (int r = 0; r < 4; ++r) gsc[r] = ng[h * 128 + 16 * wave + 4 * fq + r];
    const int sl = tid >> 3, cg = tid & 7;
    __syncthreads();
    for (int c = 0; c < 16; ++c) {
        const float bL = GB[c * 64 + 63], M63 = fmaxf(m, GC[c * 64 + 63]), decay = __expf(m - M63);
        const size_t tc0 = tg0 + (size_t)c * 64;
        {
            const int sabs = grp * 1024 + c * 64 + sl;
            float aq[8], ak[8];
#pragma unroll
            for (int i = 0; i < 8; ++i) { aq[i] = 0.f; ak[i] = 0.f; }
#pragma unroll
            for (int j = 0; j < 4; ++j) { const int sj = sabs - 3 + j;
                if (sj >= 0) { const bf16* rp = P + ((size_t)b * SEQ + sj) * NPROJ;
                    const v4u wq = *(const GAS v4u*)(rp + C_MQ + h * 64 + 8 * cg), wk = *(const GAS v4u*)(rp + C_MK + h * 64 + 8 * cg);
                    const f32x4 q0 = *(const GAS f32x4*)(cw + j * 512 + h * 64 + 8 * cg), q1 = *(const GAS f32x4*)(cw + j * 512 + h * 64 + 8 * cg + 4);
                    const f32x4 k0 = *(const GAS f32x4*)(cw + j * 512 + 256 + h * 64 + 8 * cg), k1 = *(const GAS f32x4*)(cw + j * 512 + 256 + h * 64 + 8 * cg + 4);
                    aq[0] += q0[0] * bflo(wq.x); aq[1] += q0[1] * bfhi(wq.x); aq[2] += q0[2] * bflo(wq.y); aq[3] += q0[3] * bfhi(wq.y);
                    aq[4] += q1[0] * bflo(wq.z); aq[5] += q1[1] * bfhi(wq.z); aq[6] += q1[2] * bflo(wq.w); aq[7] += q1[3] * bfhi(wq.w);
                    ak[0] += k0[0] * bflo(wk.x); ak[1] += k0[1] * bfhi(wk.x); ak[2] += k0[2] * bflo(wk.y); ak[3] += k0[3] * bfhi(wk.y);
                    ak[4] += k1[0] * bflo(wk.z); ak[5] += k1[1] * bfhi(wk.z); ak[6] += k1[2] * bflo(wk.w); ak[7] += k1[3] * bfhi(wk.w); } }
            const float Ml = fmaxf(m, GC[c * 64 + sl]), ainter = __expf(m - Ml), wsv = __expf(GA[c * 64 + sl] - M63);
            float qv[8], kv[8];
#pragma unroll
            for (int i = 0; i < 8; ++i) { qv[i] = 0.125f * aq[i] * __builtin_amdgcn_rcpf(1.f + __expf(-aq[i])); kv[i] = ak[i] * __builtin_amdgcn_rcpf(1.f + __expf(-ak[i])); }
            if (OUT) {
                v4u w; w.x = pk2(qv[0], qv[1]); w.y = pk2(qv[2], qv[3]); w.z = pk2(qv[4], qv[5]); w.w = pk2(qv[6], qv[7]); *(LAS v4u*)(lds + O_Q + sl * 144 + cg * 16) = w;
                w.x = pk2(qv[0] * ainter, qv[1] * ainter); w.y = pk2(qv[2] * ainter, qv[3] * ainter); w.z = pk2(qv[4] * ainter, qv[5] * ainter); w.w = pk2(qv[6] * ainter, qv[7] * ainter); *(LAS v4u*)(lds + O_QA + sl * 144 + cg * 16) = w;
                w.x = pk2(kv[0], kv[1]); w.y = pk2(kv[2], kv[3]); w.z = pk2(kv[4], kv[5]); w.w = pk2(kv[6], kv[7]); *(LAS v4u*)(lds + O_K + sl * 144 + cg * 16) = w;
            }
#pragma unroll
            for (int i = 0; i < 8; ++i) *(LAS bf16*)(lds + O_KWT + (8 * cg + i) * 144 + (sl ^ (8 * cg)) * 2) = (bf16)f2bf(kv[i] * wsv);
#pragma unroll
            for (int gi = 0; gi < 2; ++gi) { const int g8 = cg + 8 * gi; const v4u wv = *(const GAS v4u*)(P + (tc0 + sl) * NPROJ + C_MV + h * 128 + 8 * g8);
                const unsigned ww[4] = {wv.x, wv.y, wv.z, wv.w};
#pragma unroll
                for (int i = 0; i < 4; ++i) { *(LAS bf16*)(lds + O_VT + (8 * g8 + 2 * i) * 144 + (sl ^ (8 * cg)) * 2) = (bf16)(ww[i] & 0xffffu); *(LAS bf16*)(lds + O_VT + (8 * g8 + 2 * i + 1) * 144 + (sl ^ (8 * cg)) * 2) = (bf16)(ww[i] >> 16); } }
        }
        __syncthreads();
        v2u mo[4];
        if (OUT) {
#pragma unroll
            for (int lt = 0; lt < 4; ++lt) mo[lt] = *(const GAS v2u*)(P + (tc0 + 16 * lt + fr) * NPROJ + C_MO + h * 128 + 16 * wave + 4 * fq); }
        if (OUT) {
            const int lt = wave >> 1, l = 16 * lt + fr; const float Ml = fmaxf(m, GC[c * 64 + l]);
            const bf16x8 bq0 = ldfrag(lds + O_Q, 16 * lt + fr, 16 * fq), bq1 = ldfrag(lds + O_Q, 16 * lt + fr, 64 + 16 * fq);
#pragma unroll
            for (int u = 0; u < 2; ++u) { const int stl = 2 * (wave & 1) + u; f32x4 acc = {0.f, 0.f, 0.f, 0.f};
                acc = MFMA16(ldfrag(lds + O_K, 16 * stl + fr, 16 * fq), bq0, acc); acc = MFMA16(ldfrag(lds + O_K, 16 * stl + fr, 64 + 16 * fq), bq1, acc);
                const f32x4 av = *(LAS const f32x4*)(GA + c * 64 + 16 * stl + 4 * fq); float wv[4];
#pragma unroll
                for (int r = 0; r < 4; ++r) { const int s = 16 * stl + 4 * fq + r; wv[r] = (s <= l) ? acc[r] * __expf(av[r] - Ml) : 0.f; }
                v2u w; w.x = cvtpk(wv[0], wv[1]); w.y = cvtpk(wv[2], wv[3]); *(LAS v2u*)(lds + O_S + l * 144 + (16 * stl + 4 * fq) * 2) = w; }
        }
        {
            const bf16x8 va0 = ldfrag_sw(lds + O_VT, 16 * wave + fr, 16 * fq), va1 = ldfrag_sw(lds + O_VT, 16 * wave + fr, 64 + 16 * fq);
#pragma unroll
            for (int j = 0; j < 4; ++j) { st[j] = st[j] * decay;
                st[j] = MFMA16(va0, ldfrag_sw(lds + O_KWT, 16 * j + fr, 16 * fq), st[j]); st[j] = MFMA16(va1, ldfrag_sw(lds + O_KWT, 16 * j + fr, 64 + 16 * fq), st[j]); }
            if (wave < 4) { st[4] = st[4] * decay;
                st[4] = MFMA16(ldfrag_sw(lds + O_VT, 128 + fr, 16 * fq), ldfrag_sw(lds + O_KWT, 16 * wave + fr, 16 * fq), st[4]);
                st[4] = MFMA16(ldfrag_sw(lds + O_VT, 128 + fr, 64 + 16 * fq), ldfrag_sw(lds + O_KWT, 16 * wave + fr, 64 + 16 * fq), st[4]); }
        }
        if (OUT) {
            __syncthreads();
            LAS const unsigned char* cx = lds + O_CX + (c & 1) * CXB;
            f32x4 nt[4], nd = {0.f, 0.f, 0.f, 0.f};
            {
                const bf16x8 va0 = ldfrag_sw(lds + O_VT, 16 * wave + fr, 16 * fq), va1 = ldfrag_sw(lds + O_VT, 16 * wave + fr, 64 + 16 * fq);
                const bf16x8 ca0 = ldfrag(cx, 16 * wave + fr, 16 * fq), ca1 = ldfrag(cx, 16 * wave + fr, 64 + 16 * fq);
#pragma unroll
                for (int lt = 0; lt < 4; ++lt) { f32x4 acc = {0.f, 0.f, 0.f, 0.f};
                    acc = MFMA16(va0, ldfrag(lds + O_S, 16 * lt + fr, 16 * fq), acc); acc = MFMA16(va1, ldfrag(lds + O_S, 16 * lt + fr, 64 + 16 * fq), acc);
                    acc = MFMA16(ca0, ldfrag(lds + O_QA, 16 * lt + fr, 16 * fq), acc); acc = MFMA16(ca1, ldfrag(lds + O_QA, 16 * lt + fr, 64 + 16 * fq), acc); nt[lt] = acc; }
                if (wave >= 4) { const int lt = wave - 4;
                    nd = MFMA16(ldfrag_sw(lds + O_VT, 128 + fr, 16 * fq), ldfrag(lds + O_S, 16 * lt + fr, 16 * fq), nd); nd = MFMA16(ldfrag_sw(lds + O_VT, 128 + fr, 64 + 16 * fq), ldfrag(lds + O_S, 16 * lt + fr, 64 + 16 * fq), nd);
                    nd = MFMA16(ldfrag(cx, 128 + fr, 16 * fq), ldfrag(lds + O_QA, 16 * lt + fr, 16 * fq), nd); nd = MFMA16(ldfrag(cx, 128 + fr, 64 + 16 * fq), ldfrag(lds + O_QA, 16 * lt + fr, 64 + 16 * fq), nd);
                    if (fq == 0) DEN[16 * lt + fr] = nd[0]; }
            }
            __syncthreads();
#pragma unroll
            for (int lt = 0; lt < 4; ++lt) { const int l = 16 * lt + fr; const float Ml = fmaxf(m, GC[c * 64 + l]);
                const float inv = 1.0f / fmaxf(fabsf(DEN[l]), __expf(-(GB[c * 64 + l] + Ml)));
                nt[lt] = nt[lt] * inv; float ss = (nt[lt][0] * nt[lt][0] + nt[lt][1] * nt[lt][1]) + (nt[lt][2] * nt[lt][2] + nt[lt][3] * nt[lt][3]);
                ss += __shfl_xor(ss, 16); ss += __shfl_xor(ss, 32);
                if (fq == 0) SSQ[wave * 64 + l] = ss; }
            LAS unsigned char* cxn = lds + O_CX + ((c + 1) & 1) * CXB;
#pragma unroll
            for (int j = 0; j < 4; ++j)
#pragma unroll
                for (int r = 0; r < 4; ++r) *(LAS bf16*)(cxn + (16 * wave + 4 * fq + r) * 144 + (16 * j + fr) * 2) = (bf16)f2bf(st[j][r]);
            if (wave < 4) {
#pragma unroll
                for (int r = 0; r < 4; ++r) *(LAS bf16*)(cxn + (128 + 4 * fq + r) * 144 + (16 * wave + fr) * 2) = (bf16)f2bf(st[4][r]); }
            __syncthreads();
#pragma unroll
            for (int lt = 0; lt < 4; ++lt) { const int l = 16 * lt + fr; float tot = 0.f;
#pragma unroll
                for (int w2 = 0; w2 < 8; ++w2) tot += SSQ[w2 * 64 + l];
                const float rn = 1.0f / sqrtf(tot * (1.f / 128.f) + EPS);
                const float o0 = nt[lt][0] * rn * gsc[0] * bflo(mo[lt].x), o1 = nt[lt][1] * rn * gsc[1] * bfhi(mo[lt].x), o2 = nt[lt][2] * rn * gsc[2] * bflo(mo[lt].y), o3 = nt[lt][3] * rn * gsc[3] * bfhi(mo[lt].y);
                v2u w; w.x = pk2(o0, o1); w.y = pk2(o2, o3);
                *(GAS v2u*)(MI + (tc0 + l) * D + 512 + h * 128 + 16 * wave + 4 * fq) = w; }
        } else {
            __syncthreads();
        }
        m = bL + M63; Btot += bL;
    }
    if (!OUT) {
#pragma unroll
        for (int i = 0; i < 5; ++i)
#pragma unroll
            for (int r = 0; r < 4; ++r) MST[((size_t)wg * 20 + i * 4 + r) * NTHR + tid] = st[i][r];
        if (tid == 0) { MSC[wg * 2] = m; MSC[wg * 2 + 1] = Btot; }
    }
}

namespace at {
constexpr int O_K = 0, O_VT = 36864, VTS = 592  , O_END = O_VT + 64 * VTS;
static_assert(O_END <= 131072, "attention LDS");
}
__device__ __forceinline__ void phase_attn(const Args& A, LAS unsigned char* lds) {
    using namespace at;
    const int tid = threadIdx.x, lane = tid & 63, wave = __builtin_amdgcn_readfirstlane(tid >> 6), fr = lane & 15, fq = lane >> 4, G = gridDim.x;
    const bf16* P = (const bf16*)(A.ws + WS_PROJ); bf16* MI = (bf16*)(A.ws + WS_MIXIN); const float* sinks = (const float*)A.in[I_SINK];
    __syncthreads();
    for (int e = tid; e < 64 * 16; e += NTHR) { const int r = e >> 4, cpair = e & 15; *(LAS unsigned*)(lds + O_VT + r * VTS + 512 + cpair * 4) = 0u; }
    v4u pk_[4], pv_[4];
#define ATT_LOAD(uu) do { const int g_ = (uu) & 1, n_ = ((uu) >> 1) & 63, b_ = (uu) >> 7; const size_t tq_ = (size_t)b_ * SEQ + (size_t)n_ * 128; _Pragma("unroll") for (int i_ = 0; i_ < 4; ++i_) { const int item_ = tid + NTHR * i_, row_ = item_ >> 3, ch_ = item_ & 7; \
        pk_[i_] = (v4u){0u, 0u, 0u, 0u}; pv_[i_] = (v4u){0u, 0u, 0u, 0u}; if (n_ > 0 || row_ >= 128) { const bf16* rp_ = P + (tq_ - 128 + row_) * NPROJ; pk_[i_] = *(const GAS v4u*)(rp_ + C_AK + g_ * 64 + 8 * ch_); pv_[i_] = *(const GAS v4u*)(rp_ + C_AV + g_ * 64 + 8 * ch_); } } } while (0)
    if ((int)blockIdx.x < NB * 64 * 2) ATT_LOAD((int)blockIdx.x);
    for (int unit = blockIdx.x; unit < NB * 64 * 2; unit += G) {
        const int g = unit & 1, n = (unit >> 1) & 63, b = unit >> 7;
        const size_t tq0 = (size_t)b * SEQ + (size_t)n * 128;
        __syncthreads();
#pragma unroll
        for (int i = 0; i < 4; ++i) { const int item = tid + NTHR * i, row = item >> 3, ch = item & 7;
            const v4u wk = pk_[i], wv = pv_[i];
            *(LAS v4u*)(lds + O_K + row * 144 + ch * 16) = wk;
            const unsigned ww[4] = {wv.x, wv.y, wv.z, wv.w};
#pragma unroll
            for (int k = 0; k < 4; ++k) { *(LAS bf16*)(lds + O_VT + (8 * ch + 2 * k) * VTS + (row ^ (4 * ch)) * 2) = (bf16)(ww[k] & 0xffffu); *(LAS bf16*)(lds + O_VT + (8 * ch + 2 * k + 1) * VTS + (row ^ (4 * ch)) * 2) = (bf16)(ww[k] >> 16); } }
        if (unit + G < NB * 64 * 2) ATT_LOAD(unit + G);
        const int hq = 4 * g + (wave >> 1), qr0 = 64 * (wave & 1); const float sink = sinks[hq];
        __syncthreads();
        for (int qt = 0; qt < 4; ++qt) {
            const int i0 = qr0 + 16 * qt, st0 = i0 >> 4, iq = i0 + fr;
            const bf16* qp = P + (tq0 + iq) * NPROJ + C_AQ + hq * 64 + 8 * fq;
            const bf16x8 bq0 = *(const GAS bf16x8*)qp, bq1 = *(const GAS bf16x8*)(qp + 32);
            f32x4 sc[9]; float mx = sink;
#pragma unroll
            for (int t = 0; t < 9; ++t) { const int sb0 = 16 * (st0 + t); f32x4 acc = {0.f, 0.f, 0.f, 0.f};
                acc = MFMA16(ldfrag(lds + O_K, sb0 + fr, 16 * fq), bq0, acc); acc = MFMA16(ldfrag(lds + O_K, sb0 + fr, 64 + 16 * fq), bq1, acc);
#pragma unroll
                for (int r = 0; r < 4; ++r) { const int sb = sb0 + 4 * fq + r; const bool valid = (sb > iq) && (sb <= iq + 128) && (n > 0 || sb >= 128);
                    acc[r] = valid ? acc[r] : -3.0e38f; mx = fmaxf(mx, acc[r]); }
                sc[t] = acc; }
            mx = fmaxf(mx, __shfl_xor(mx, 16)); mx = fmaxf(mx, __shfl_xor(mx, 32));
            float lsum = 0.f;
#pragma unroll
            for (int t = 0; t < 9; ++t)
#pragma unroll
                for (int r = 0; r < 4; ++r) { const float p = (sc[t][r] > -1.0e38f) ? __expf(sc[t][r] - mx) : 0.f; sc[t][r] = p; lsum += p; }
            lsum += __shfl_xor(lsum, 16); lsum += __shfl_xor(lsum, 32); lsum += __expf(sink - mx);
            f32x4 oacc[4];
#pragma unroll
            for (int dt = 0; dt < 4; ++dt) oacc[dt] = (f32x4){0.f, 0.f, 0.f, 0.f};
#pragma unroll
            for (int ks = 0; ks < 5; ++ks) {
                union { bf16x8 v; unsigned u[4]; } pb;
                pb.u[0] = cvtpk(sc[2 * ks][0], sc[2 * ks][1]); pb.u[1] = cvtpk(sc[2 * ks][2], sc[2 * ks][3]);
                if (ks < 4) { pb.u[2] = cvtpk(sc[2 * ks + 1][0], sc[2 * ks + 1][1]); pb.u[3] = cvtpk(sc[2 * ks + 1][2], sc[2 * ks + 1][3]); } else { pb.u[2] = 0u; pb.u[3] = 0u; }
                const int sbb = 16 * (st0 + 2 * ks) + 4 * fq;
#pragma unroll
                for (int dt = 0; dt < 4; ++dt) { const int dd = 16 * dt + fr, sx = 4 * ((dd >> 3) & 7); LAS const unsigned char* vrow = lds + O_VT + dd * VTS;
                    union { bf16x8 v; v2u h[2]; } va; va.h[0] = *(LAS const v2u*)(vrow + (sbb ^ sx) * 2); va.h[1] = *(LAS const v2u*)(vrow + ((sbb + 16) ^ sx) * 2);
                    oacc[dt] = MFMA16(va.v, pb.v, oacc[dt]); } }
            const float il = 1.0f / lsum;
#pragma unroll
            for (int dt = 0; dt < 4; ++dt) { v2u w; w.x = pk2(oacc[dt][0] * il, oacc[dt][1] * il); w.y = pk2(oacc[dt][2] * il, oacc[dt][3] * il);
                *(GAS v2u*)(MI + (tq0 + iq) * D + hq * 64 + 16 * dt + 4 * fq) = w; }
        }
    }
#undef ATT_LOAD
}
typedef float f32x16 __attribute__((ext_vector_type(16)));
__device__ __forceinline__ unsigned fbits(float f) { return __builtin_bit_cast(unsigned, f); }
__device__ __forceinline__ float bfloat(unsigned u) { return __builtin_bit_cast(float, u); }

#define CE_DESC(a, b) do { const float _mx = __builtin_fmaxf(a, b), _mn = __builtin_fminf(a, b); a = _mx; b = _mn; } while (0)
__device__ __forceinline__ void bsort16(float (&v)[16]) {
#pragma unroll
    for (int k = 2; k <= 16; k <<= 1)
#pragma unroll
        for (int j = k >> 1; j > 0; j >>= 1)
#pragma unroll
            for (int i = 0; i < 16; ++i) { const int l = i ^ j; if (l > i) { if ((i & k) == 0) CE_DESC(v[i], v[l]); else CE_DESC(v[l], v[i]); } }
}
__device__ __forceinline__ void bmerge16(float (&v)[16], const float (&w)[16]) {
#pragma unroll
    for (int i = 0; i < 16; ++i) v[i] = __builtin_fmaxf(v[i], w[15 - i]);
#pragma unroll
    for (int j = 8; j > 0; j >>= 1)
#pragma unroll
        for (int i = 0; i < 16; ++i) { const int l = i ^ j; if (l > i) CE_DESC(v[i], v[l]); }
}
namespace tk {
constexpr int KS = 272;
constexpr int O_K1 = 0, O_K2 = 128 * KS, O_X = 2 * 128 * KS, O_END = O_X + 8 * 4096;
static_assert(O_END <= 131072, "topk LDS");
constexpr unsigned char CAND[64] = {
    0x00, 0x01, 0x02, 0x03, 0x04, 0x05, 0x06, 0x07, 0x08, 0x09, 0x0a, 0x0b, 0x0c, 0x0d, 0x0e, 0x0f,
    0x10, 0x11, 0x12, 0x13, 0x14, 0x15, 0x16, 0x17, 0x80, 0x90, 0xa0, 0xb0, 0xc0, 0xd0, 0xe0, 0xf0,
    0x20, 0x21, 0x22, 0x23, 0x24, 0x30, 0x31, 0x32, 0x33, 0x40, 0x41, 0x42, 0x50, 0x51, 0x60, 0x61,
    0x70, 0x71, 0xff, 0xff, 0xff, 0xff, 0xff, 0xff, 0xff, 0xff, 0xff, 0xff, 0xff, 0xff, 0xff, 0xff};
}
__device__ __forceinline__ void side_top16(const f32x16 (&acc)[4], int hh, float (&T)[16]) {
    float g1[16], g2[16];
#pragma unroll
    for (int r = 0; r < 16; ++r) { const unsigned key = (r & 3) + 8 * (r >> 2) + 4 * hh;
        T[r] = bfloat((fbits(acc[0][r]) & 0xffffff80u) | key);
        g1[r] = bfloat((fbits(acc[1][r]) & 0xffffff80u) | (32u + key)); }
    bsort16(T); bsort16(g1); bmerge16(T, g1);
#pragma unroll
    for (int r = 0; r < 16; ++r) { const unsigned key = (r & 3) + 8 * (r >> 2) + 4 * hh;
        g1[r] = bfloat((fbits(acc[2][r]) & 0xffffff80u) | (64u + key));
        g2[r] = bfloat((fbits(acc[3][r]) & 0xffffff80u) | (96u + key)); }
    bsort16(g1); bsort16(g2); bmerge16(g1, g2); bmerge16(T, g1);
#pragma unroll
    for (int r = 0; r < 16; ++r) g1[r] = __shfl_xor(T[r], 32);
    bmerge16(T, g1);
}
struct TopkQ { bf16x8 f[8]; };
template <int SD> __device__ __forceinline__ void topk_ldq(const bf16* Q, int t, int h, int hh, TopkQ& q) {
    const bf16* qp = Q + (size_t)t * 2048 + h * 256 + SD * 128 + 8 * hh;
#pragma unroll
    for (int ks = 0; ks < 8; ++ks) q.f[ks] = *(const GAS bf16x8*)(qp + 16 * ks);
}
template <int SD> __device__ __forceinline__ void topk_scores(const TopkQ& q, LAS unsigned char* lds, int r32, int hh, f32x16 (&acc)[4]) {
    using namespace tk;
#pragma unroll
    for (int mt = 0; mt < 4; ++mt)
#pragma unroll
        for (int r = 0; r < 16; ++r) acc[mt][r] = 0.f;
    LAS const unsigned char* kimg = lds + (SD ? O_K2 : O_K1);
#pragma unroll
    for (int ks = 0; ks < 8; ++ks) {
#pragma unroll
        for (int mt = 0; mt < 4; ++mt) acc[mt] = __builtin_amdgcn_mfma_f32_32x32x16_bf16(*(LAS const bf16x8*)(kimg + (32 * mt + r32) * KS + 32 * ks + 16 * hh), q.f[ks], acc[mt], 0, 0, 0); }
}
template <int Q> __device__ __forceinline__ float cand_val(const float (&T1)[16], const float (&T2)[16], int hh) {
    constexpr unsigned c0 = tk::CAND[2 * Q], c1 = tk::CAND[2 * Q + 1];
    const float s = (hh ? T1[(c1 >> 4) & 15] : T1[(c0 >> 4) & 15]) + (hh ? T2[c1 & 15] : T2[c0 & 15]); const unsigned code = hh ? c1 : c0;
    return (code == 0xffu) ? -3.0e38f : bfloat((fbits(s) & 0xffffff00u) | code);
}
__device__ __forceinline__ void phase_topk(const Args& A, LAS unsigned char* lds) {
    using namespace tk;
    const int tid = threadIdx.x, lane = tid & 63, wave = __builtin_amdgcn_readfirstlane(tid >> 6), G = gridDim.x;
    const bf16* Q = (const bf16*)(A.ws + WS_PROJ); const bf16* KB = (const bf16*)(A.ws + WS_KEYS);
    unsigned short* EI = (unsigned short*)(A.ws + WS_EIDX); float* GT = (float*)(A.ws + WS_GATE);
    const int h = blockIdx.x & 7, r32 = lane & 31, hh = lane >> 5;
    __syncthreads();
    for (int e = tid; e < 2 * 128 * 16; e += NTHR) { const int s = e >> 11, row = (e >> 4) & 127, ch = e & 15;
        *(LAS v4u*)(lds + (s ? O_K2 : O_K1) + row * KS + ch * 16) = *(const GAS v4u*)(KB + (size_t)s * 8 * 128 * 128 + ((size_t)h * 128 + row) * 128 + ch * 8); }
    __syncthreads();
    LAS float* XW = (LAS float*)(lds + O_X + wave * 4096) + r32 * 32;
    TopkQ qf; topk_ldq<0>(Q, (int)(blockIdx.x >> 3) * 256 + 32 * wave + r32, h, hh, qf);
    for (int tile = (int)(blockIdx.x >> 3); tile < M / 256; tile += (G >> 3)) {
        const int t = tile * 256 + 32 * wave + r32;
        float T1[16], T2[16];
        { f32x16 acc[4]; topk_scores<0>(qf, lds, r32, hh, acc);
          topk_ldq<1>(Q, t, h, hh, qf);
          side_top16(acc, hh, T1); }
        { f32x16 acc[4]; topk_scores<1>(qf, lds, r32, hh, acc);
          const int tn = min(tile + (int)(G >> 3), M / 256 - 1) * 256 + 32 * wave + r32; topk_ldq<0>(Q, tn, h, hh, qf);
          side_top16(acc, hh, T2); }
        float c[16], w[16];
        c[0] = cand_val<0>(T1, T2, hh); w[0] = cand_val<16>(T1, T2, hh);
        c[1] = cand_val<1>(T1, T2, hh); w[1] = cand_val<17>(T1, T2, hh);
        c[2] = cand_val<2>(T1, T2, hh); w[2] = cand_val<18>(T1, T2, hh);
        c[3] = cand_val<3>(T1, T2, hh); w[3] = cand_val<19>(T1, T2, hh);
        c[4] = cand_val<4>(T1, T2, hh); w[4] = cand_val<20>(T1, T2, hh);
        c[5] = cand_val<5>(T1, T2, hh); w[5] = cand_val<21>(T1, T2, hh);
        c[6] = cand_val<6>(T1, T2, hh); w[6] = cand_val<22>(T1, T2, hh);
        c[7] = cand_val<7>(T1, T2, hh); w[7] = cand_val<23>(T1, T2, hh);
        c[8] = cand_val<8>(T1, T2, hh); w[8] = cand_val<24>(T1, T2, hh);
        c[9] = cand_val<9>(T1, T2, hh); w[9] = cand_val<25>(T1, T2, hh);
        c[10] = cand_val<10>(T1, T2, hh); w[10] = cand_val<26>(T1, T2, hh);
        c[11] = cand_val<11>(T1, T2, hh); w[11] = cand_val<27>(T1, T2, hh);
        c[12] = cand_val<12>(T1, T2, hh); w[12] = cand_val<28>(T1, T2, hh);
        c[13] = cand_val<13>(T1, T2, hh); w[13] = cand_val<29>(T1, T2, hh);
        c[14] = cand_val<14>(T1, T2, hh); w[14] = cand_val<30>(T1, T2, hh);
        c[15] = cand_val<15>(T1, T2, hh); w[15] = cand_val<31>(T1, T2, hh);
        bsort16(c); bsort16(w); bmerge16(c, w);
#pragma unroll
        for (int r = 0; r < 16; ++r) w[r] = __shfl_xor(c[r], 32);
        bmerge16(c, w);
        if (hh == 0) {
#pragma unroll
            for (int q4 = 0; q4 < 4; ++q4) { *(LAS f32x4*)(XW + 4 * q4) = (f32x4){T1[4 * q4], T1[4 * q4 + 1], T1[4 * q4 + 2], T1[4 * q4 + 3]};
                *(LAS f32x4*)(XW + 16 + 4 * q4) = (f32x4){T2[4 * q4], T2[4 * q4 + 1], T2[4 * q4 + 2], T2[4 * q4 + 3]}; } }
        asm volatile("s_waitcnt lgkmcnt(0)" ::: "memory");
        float ex[16], sum = 0.f; const float tmax = bfloat(fbits(c[0]) & 0xffffff00u);
#pragma unroll
        for (int r = 0; r < 16; ++r) { ex[r] = __expf(bfloat(fbits(c[r]) & 0xffffff00u) - tmax); sum += ex[r]; }
        const float isum = 1.0f / sum; const size_t ob = (size_t)t * NSLOT + (size_t)(8 * hh) * 8 + h;
#pragma unroll
        for (int r = 0; r < 8; ++r) { float ca = c[r], cb = c[8 + r], ea = ex[r], eb = ex[8 + r]; asm volatile("" : "+v"(ca), "+v"(cb), "+v"(ea), "+v"(eb)); const float cv = hh ? cb : ca, ev = hh ? eb : ea;
            const unsigned code = fbits(cv) & 0xffu;
            const unsigned i1 = fbits(XW[code >> 4]) & 127u, i2 = fbits(XW[16 + (code & 15)]) & 127u;
            EI[ob + 8 * r] = (unsigned short)(i1 * 128u + i2); GT[ob + 8 * r] = ev * isum; }
        asm volatile("s_waitcnt lgkmcnt(0)" ::: "memory");
    }
}
struct PeerIdx { v4u e0, e1; };
__device__ __forceinline__ PeerIdx peer_ld_idx(const unsigned short* EI, int t, int g) { PeerIdx r; r.e0 = *(const GAS v4u*)(EI + (size_t)t * NSLOT + 16 * g); r.e1 = *(const GAS v4u*)(EI + (size_t)t * NSLOT + 16 * g + 8); return r; }
template <int ROWB = 1024> __device__ __forceinline__ void peer_gather(const unsigned char* T8, const PeerIdx& ix, int colb, v4u (&raw)[16]) {
    const unsigned ew[8] = {ix.e0.x, ix.e0.y, ix.e0.z, ix.e0.w, ix.e1.x, ix.e1.y, ix.e1.z, ix.e1.w};
#pragma unroll
    for (int k = 0; k < 16; ++k) { const unsigned e = (k & 1) ? (ew[k >> 1] >> 16) : (ew[k >> 1] & 0xffffu); raw[k] = *(const GAS v4u*)(T8 + (size_t)e * ROWB + colb); }
}
__device__ __forceinline__ void cvt16_fp8_pk(const v4u w, f32x2 (&o)[8]) {
    const unsigned ww[4] = {w.x, w.y, w.z, w.w};
#pragma unroll
    for (int i = 0; i < 4; ++i) { o[2 * i] = __builtin_amdgcn_cvt_pk_f32_fp8((int)ww[i], false); o[2 * i + 1] = __builtin_amdgcn_cvt_pk_f32_fp8((int)ww[i], true); }
}
__device__ __forceinline__ void peer_u_reduce(const v4u (&raw)[16], const f32x2 (&hv)[8], float* PDrow, int lane, int g, int c) {
    float d[16];
#pragma unroll
    for (int k = 0; k < 16; ++k) { f32x2 uf[8]; cvt16_fp8_pk(raw[k], uf); f32x2 s = uf[0] * hv[0];
#pragma unroll
        for (int i = 1; i < 8; ++i) s += uf[i] * hv[i];
        d[k] = s.x + s.y; }
#pragma unroll
    for (int i = 0; i < 8; ++i) { const bool up = (lane & 4) != 0; const float keep = up ? d[i + 8] : d[i], send = up ? d[i] : d[i + 8]; d[i] = keep + __shfl_xor(send, 4); }
#pragma unroll
    for (int i = 0; i < 4; ++i) { const bool up = (lane & 2) != 0; const float keep = up ? d[i + 4] : d[i], send = up ? d[i] : d[i + 4]; d[i] = keep + __shfl_xor(send, 2); }
#pragma unroll
    for (int i = 0; i < 2; ++i) { const bool up = (lane & 1) != 0; const float keep = up ? d[i + 2] : d[i], send = up ? d[i] : d[i + 2]; d[i] = keep + __shfl_xor(send, 1); }
    *(GAS f32x2*)(PDrow + 16 * g + 2 * c) = (f32x2){d[0], d[1]};
}
__device__ __forceinline__ void ld16bf_pk(const bf16* p, f32x2 (&o)[8]) {
    const v4u w0 = *(const GAS v4u*)p, w1 = *(const GAS v4u*)(p + 8); const unsigned ww[8] = {w0.x, w0.y, w0.z, w0.w, w1.x, w1.y, w1.z, w1.w};
#pragma unroll
    for (int i = 0; i < 8; ++i) o[i] = (f32x2){bflo(ww[i]), bfhi(ww[i])};
}
__device__ __forceinline__ void peer_u_reduce_i4(const v4u (&raw)[16], const v4u hh, const v4u hl, int* PDrow, int lane, int g, int c) {
    int d[16];
#pragma unroll
    for (int k = 0; k < 16; ++k) { int sh = __builtin_amdgcn_sdot8((int)raw[k].x, (int)hh.x, 0, false), sl = __builtin_amdgcn_sdot8((int)raw[k].x, (int)hl.x, 0, false);
        sh = __builtin_amdgcn_sdot8((int)raw[k].y, (int)hh.y, sh, false); sl = __builtin_amdgcn_sdot8((int)raw[k].y, (int)hl.y, sl, false);
        sh = __builtin_amdgcn_sdot8((int)raw[k].z, (int)hh.z, sh, false); sl = __builtin_amdgcn_sdot8((int)raw[k].z, (int)hl.z, sl, false);
        sh = __builtin_amdgcn_sdot8((int)raw[k].w, (int)hh.w, sh, false); sl = __builtin_amdgcn_sdot8((int)raw[k].w, (int)hl.w, sl, false);
        d[k] = 16 * sh + sl; }
#pragma unroll
    for (int i = 0; i < 8; ++i) { const bool up = (lane & 4) != 0; const int keep = up ? d[i + 8] : d[i], send = up ? d[i] : d[i + 8]; d[i] = keep + __shfl_xor(send, 4); }
#pragma unroll
    for (int i = 0; i < 4; ++i) { const bool up = (lane & 2) != 0; const int keep = up ? d[i + 4] : d[i], send = up ? d[i] : d[i + 4]; d[i] = keep + __shfl_xor(send, 2); }
#pragma unroll
    for (int i = 0; i < 2; ++i) { const bool up = (lane & 1) != 0; const int keep = up ? d[i + 2] : d[i], send = up ? d[i] : d[i + 2]; d[i] = keep + __shfl_xor(send, 1); }
    *(GAS v2u*)(PDrow + 16 * g + 2 * c) = (v2u){(unsigned)d[0], (unsigned)d[1]};
}
__device__ __forceinline__ void phase_peer_u(const Args& A) {
    const int tid = threadIdx.x, lane = tid & 63, wave = tid >> 6, p = blockIdx.x & 7, q = p & 3, half = p >> 2, j = blockIdx.x >> 3, nj = gridDim.x >> 3, g = lane >> 3, c = lane & 7;
    const unsigned char* HH = (const unsigned char*)(A.ws + WS_H8); const unsigned char* HL = HH + 32 * MiB; const unsigned char* U4 = (const unsigned char*)(A.ws + WS_U8); const unsigned short* EI = (const unsigned short*)(A.ws + WS_EIDX);
    int* PD = (int*)(A.ws + WS_PD) + (size_t)q * M * NSLOT;
    const int tper = (M / 2) / nj, colb = 128 * q + 16 * c, tbeg = half * (M / 2) + j * tper, tend = tbeg + tper, tlast = tend - NWAVES + wave;
    int t = tbeg + wave;
    PeerIdx ix1 = peer_ld_idx(EI, min(t + NWAVES, tlast), g), ix2 = peer_ld_idx(EI, min(t + 2 * NWAVES, tlast), g);
    v4u rawa[16], rawb[16], hha, hla, hhb, hlb;
    { const PeerIdx ix0 = peer_ld_idx(EI, t, g); peer_gather<512>(U4, ix0, colb, rawa); hha = *(const GAS v4u*)(HH + (size_t)t * 512 + colb); hla = *(const GAS v4u*)(HL + (size_t)t * 512 + colb); }
    for (; t < tend; t += 2 * NWAVES) {
        const int t1 = t + NWAVES, t2 = min(t + 2 * NWAVES, tlast), t3 = min(t + 3 * NWAVES, tlast), t4 = min(t + 4 * NWAVES, tlast);
        const PeerIdx ix3 = peer_ld_idx(EI, t3, g);
        peer_gather<512>(U4, ix1, colb, rawb); hhb = *(const GAS v4u*)(HH + (size_t)t1 * 512 + colb); hlb = *(const GAS v4u*)(HL + (size_t)t1 * 512 + colb);
        peer_u_reduce_i4(rawa, hha, hla, PD + (size_t)t * NSLOT, lane, g, c);
        const PeerIdx ix4 = peer_ld_idx(EI, t4, g);
        peer_gather<512>(U4, ix2, colb, rawa); hha = *(const GAS v4u*)(HH + (size_t)t2 * 512 + colb); hla = *(const GAS v4u*)(HL + (size_t)t2 * 512 + colb);
        peer_u_reduce_i4(rawb, hhb, hlb, PD + (size_t)t1 * NSLOT, lane, g, c);
        ix1 = ix3; ix2 = ix4;
    }
}
__device__ __forceinline__ void phase_peer_act(const Args& A) {
    const int* PD = (const int*)(A.ws + WS_PD); const unsigned short* EI = (const unsigned short*)(A.ws + WS_EIDX); const float* GT = (const float*)(A.ws + WS_GATE);
    const float* usc = (const float*)(A.ws + WS_SC); const float* vsc = usc + NEXP; const float* hs = (const float*)(A.ws + WS_HS); float* ACT = (float*)(A.ws + WS_ACT);
    typedef int i32x4 __attribute__((ext_vector_type(4)));
    for (size_t i = ((size_t)blockIdx.x * NTHR + threadIdx.x) * 4; i < (size_t)M * NSLOT; i += (size_t)gridDim.x * NTHR * 4) {
        const i32x4 p0 = *(const GAS i32x4*)(PD + i), p1 = *(const GAS i32x4*)(PD + (size_t)M * NSLOT + i), p2 = *(const GAS i32x4*)(PD + (size_t)2 * M * NSLOT + i), p3 = *(const GAS i32x4*)(PD + (size_t)3 * M * NSLOT + i);
        const v2u ew = *(const GAS v2u*)(EI + i); const f32x4 gt = *(const GAS f32x4*)(GT + i); const float hsv = hs[i >> 7];
        const unsigned e[4] = {ew.x & 0xffffu, ew.x >> 16, ew.y & 0xffffu, ew.y >> 16};
        const i32x4 si = (p0 + p1) + (p2 + p3); f32x4 o;
#pragma unroll
        for (int k = 0; k < 4; ++k) { const float s = (float)si[k] * (usc[e[k]] * hsv); o[k] = 0.5f * s * (1.f + erff(s * 0.70710678118654752f)) * gt[k] * vsc[e[k]]; }
        *(GAS f32x4*)(ACT + i) = o;
    }
}
struct PeerAct { f32x4 a0, a1, a2, a3; };
__device__ __forceinline__ PeerAct peer_ld_act(const float* ACT, int t, int g) { const GAS f32x4* ap = (const GAS f32x4*)(ACT + (size_t)t * NSLOT + 16 * g); PeerAct r; r.a0 = ap[0]; r.a1 = ap[1]; r.a2 = ap[2]; r.a3 = ap[3]; return r; }
__device__ __forceinline__ void peer_v_accum(const v4u (&raw)[16], const PeerAct& pa, f32x2 (&y2)[16]) {
    const float av[16] = {pa.a0[0], pa.a0[1], pa.a0[2], pa.a0[3], pa.a1[0], pa.a1[1], pa.a1[2], pa.a1[3], pa.a2[0], pa.a2[1], pa.a2[2], pa.a2[3], pa.a3[0], pa.a3[1], pa.a3[2], pa.a3[3]};
#pragma unroll
    for (int k = 0; k < 16; ++k) { const unsigned ww[4] = {raw[k].x, raw[k].y, raw[k].z, raw[k].w}; const f32x2 a2 = (f32x2){av[k], av[k]};
#pragma unroll
        for (int w = 0; w < 4; ++w) { y2[4 * w + 0] += a2 * __builtin_amdgcn_cvt_scalef32_pk_f32_fp4(ww[w], 1.0f, 0); y2[4 * w + 1] += a2 * __builtin_amdgcn_cvt_scalef32_pk_f32_fp4(ww[w], 1.0f, 1);
            y2[4 * w + 2] += a2 * __builtin_amdgcn_cvt_scalef32_pk_f32_fp4(ww[w], 1.0f, 2); y2[4 * w + 3] += a2 * __builtin_amdgcn_cvt_scalef32_pk_f32_fp4(ww[w], 1.0f, 3); } }
}
__device__ __forceinline__ void peer_v_store(f32x2 (&y2)[16], bf16* Yp, float* ssy, int c) {
    float ss = 0.f; unsigned w[16];
#pragma unroll
    for (int i = 0; i < 16; ++i) { ss += y2[i].x * y2[i].x + y2[i].y * y2[i].y; w[i] = pk2(y2[i].x, y2[i].y); y2[i] = (f32x2){0.f, 0.f}; }
#pragma unroll
    for (int i = 0; i < 4; ++i) *(GAS v4u*)(Yp + 8 * i) = (v4u){w[4 * i], w[4 * i + 1], w[4 * i + 2], w[4 * i + 3]};
    ss += __shfl_xor(ss, 1); ss += __shfl_xor(ss, 2); ss += __shfl_xor(ss, 4);
    if (c == 0) *ssy = ss;
}
__device__ __forceinline__ void phase_peer_v(const Args& A) {
    const int tid = threadIdx.x, lane = tid & 63, wave = tid >> 6, p = blockIdx.x & 7, q = p & 3, half = p >> 2, j = blockIdx.x >> 3, nj = gridDim.x >> 3, g = lane >> 3, c = lane & 7;
    const unsigned char* V4 = (const unsigned char*)(A.ws + WS_V8); const unsigned short* EI = (const unsigned short*)(A.ws + WS_EIDX); const float* ACT = (const float*)(A.ws + WS_ACT);
    bf16* Y = (bf16*)(A.ws + WS_H); float* SSY = (float*)(A.ws + WS_SSY);
    const int tper = (M / 2) / nj, colb = 128 * q + 16 * c, tbeg = half * (M / 2) + j * tper + wave * (tper / NWAVES);
    const int nstep = (tper / NWAVES / 8) * 8;
    auto rowof = [&](int s) { s = min(s, nstep - 1); return (size_t)(tbeg + 8 * (s >> 3) + g) * 8 + (s & 7); };
    f32x2 y2[16];
#pragma unroll
    for (int i = 0; i < 16; ++i) y2[i] = (f32x2){0.f, 0.f};
    auto ldidx = [&](int s) { const size_t r = rowof(s); PeerIdx x; x.e0 = *(const GAS v4u*)(EI + r * 16); x.e1 = *(const GAS v4u*)(EI + r * 16 + 8); return x; };
    auto ldact = [&](int s) { const GAS f32x4* ap = (const GAS f32x4*)(ACT + rowof(s) * 16); PeerAct r; r.a0 = ap[0]; r.a1 = ap[1]; r.a2 = ap[2]; r.a3 = ap[3]; return r; };
    PeerIdx ix1 = ldidx(1), ix2 = ldidx(2);
    v4u rawa[16], rawb[16]; PeerAct aca, acb;
    { const PeerIdx ix0 = ldidx(0); peer_gather<512>(V4, ix0, colb, rawa); aca = ldact(0); }
    for (int s = 0; s < nstep; s += 2) {
        const PeerIdx ix3 = ldidx(s + 3);
        peer_gather<512>(V4, ix1, colb, rawb); acb = ldact(s + 1);
        peer_v_accum(rawa, aca, y2);
        const PeerIdx ix4 = ldidx(s + 4);
        peer_gather<512>(V4, ix2, colb, rawa); aca = ldact(s + 2);
        peer_v_accum(rawb, acb, y2);
        if ((s & 7) == 6) { const int t = tbeg + 8 * (s >> 3) + g; peer_v_store(y2, Y + (size_t)t * D + 256 * q + 32 * c, SSY + (size_t)t * 8 + q, c); }
        ix1 = ix3; ix2 = ix4;
    }
}
__device__ __forceinline__ void phase_peer_final(const Args& A) {
    const int tid = threadIdx.x, lane = tid & 63, wave = tid >> 6, G = gridDim.x;
    const bf16* Y = (const bf16*)(A.ws + WS_H); const bf16* X1 = (const bf16*)(A.ws + WS_X1); const float* SSY = (const float*)(A.ws + WS_SSY); const float* mod = (const float*)(A.ws + WS_MOD); const float* gpost = (const float*)A.in[I_GPOST2]; float* out = A.out;
    f32x4 gp[4];
#pragma unroll
    for (int q = 0; q < 4; ++q) gp[q] = *(const GAS f32x4*)(gpost + 4 * (lane + 64 * q));
    const int stride = G * NWAVES; int row = blockIdx.x * NWAVES + wave;
    v2u xw[4], yw[4], xwn[4], ywn[4]; f32x4 s0, s0n, g2p[4]; int bcur = -1;
#pragma unroll
    for (int q = 0; q < 4; ++q) { xw[q] = ((const GAS v2u*)(X1 + (size_t)row * D) + lane)[64 * q]; yw[q] = ((const GAS v2u*)(Y + (size_t)row * D) + lane)[64 * q]; }
    s0 = *(const GAS f32x4*)(SSY + (size_t)row * 8);
    for (; row < M; row += stride) {
        const int rn = min(row + stride, M - 1);
#pragma unroll
        for (int q = 0; q < 4; ++q) { xwn[q] = ((const GAS v2u*)(X1 + (size_t)rn * D) + lane)[64 * q]; ywn[q] = ((const GAS v2u*)(Y + (size_t)rn * D) + lane)[64 * q]; }
        s0n = *(const GAS f32x4*)(SSY + (size_t)rn * 8);
        const int b = row / SEQ;
        if (b != bcur) { bcur = b;
#pragma unroll
            for (int q = 0; q < 4; ++q) { const f32x4 g2 = *(const GAS f32x4*)(mod + b * 6144 + 5120 + 4 * (lane + 64 * q));
#pragma unroll
                for (int i = 0; i < 4; ++i) g2p[q][i] = g2[i] * gp[q][i]; } }
        const float rstd = 1.0f / sqrtf(((s0[0] + s0[1]) + (s0[2] + s0[3])) * (1.f / D) + EPS);
        GAS f32x4* orow = (GAS f32x4*)(out + (size_t)row * D) + lane;
#pragma unroll
        for (int q = 0; q < 4; ++q) { f32x4 xv = {bflo(xw[q].x), bfhi(xw[q].x), bflo(xw[q].y), bfhi(xw[q].y)};
            xv[0] += g2p[q][0] * (bflo(yw[q].x) * rstd); xv[1] += g2p[q][1] * (bfhi(yw[q].x) * rstd); xv[2] += g2p[q][2] * (bflo(yw[q].y) * rstd); xv[3] += g2p[q][3] * (bfhi(yw[q].y) * rstd);
            orow[64 * q] = xv; }
#pragma unroll
        for (int q = 0; q < 4; ++q) { xw[q] = xwn[q]; yw[q] = ywn[q]; }
        s0 = s0n;
    }
}
#ifdef PROBE_V_LOADS
__device__ __forceinline__ void probe_v_loads(const Args& A) {
    const int tid = threadIdx.x, lane = tid & 63, wave = tid >> 6, p = blockIdx.x & 7, j = blockIdx.x >> 3, nj = gridDim.x >> 3, g = lane >> 3, c = lane & 7;
    const unsigned char* V8 = (const unsigned char*)(A.ws + WS_V8); const unsigned short* EI = (const unsigned short*)(A.ws + WS_EIDX); const float* ACT = (const float*)(A.ws + WS_ACT);
    unsigned* DUMP = (unsigned*)(A.ws + WS_PD);
    const int tper = M / nj, colb = 128 * p + 16 * c, tend = (j + 1) * tper, tlast = tend - NWAVES + wave;
    int t = j * tper + wave;
    PeerIdx ix1 = peer_ld_idx(EI, min(t + NWAVES, tlast), g), ix2 = peer_ld_idx(EI, min(t + 2 * NWAVES, tlast), g);
    v4u rawa[16], rawb[16]; PeerAct aca, acb;
    { const PeerIdx ix0 = peer_ld_idx(EI, t, g); peer_gather(V8, ix0, colb, rawa); aca = peer_ld_act(ACT, t, g); }
    for (; t < tend; t += 2 * NWAVES) {
        const int t1 = t + NWAVES, t2 = min(t + 2 * NWAVES, tlast), t3 = min(t + 3 * NWAVES, tlast), t4 = min(t + 4 * NWAVES, tlast);
        const PeerIdx ix3 = peer_ld_idx(EI, t3, g);
        peer_gather(V8, ix1, colb, rawb); acb = peer_ld_act(ACT, t1, g);
        { unsigned s = __builtin_bit_cast(unsigned, aca.a0[0]) + __builtin_bit_cast(unsigned, aca.a3[3]);
#pragma unroll
          for (int k = 0; k < 16; ++k) s += (rawa[k].x + rawa[k].y) + (rawa[k].z + rawa[k].w);
          DUMP[(size_t)t * 512 + p * 64 + lane] = s; }
        const PeerIdx ix4 = peer_ld_idx(EI, t4, g);
        peer_gather(V8, ix2, colb, rawa); aca = peer_ld_act(ACT, t2, g);
        { unsigned s = __builtin_bit_cast(unsigned, acb.a0[0]) + __builtin_bit_cast(unsigned, acb.a3[3]);
#pragma unroll
          for (int k = 0; k < 16; ++k) s += (rawb[k].x + rawb[k].y) + (rawb[k].z + rawb[k].w);
          DUMP[(size_t)t1 * 512 + p * 64 + lane] = s; }
        ix1 = ix3; ix2 = ix4;
    }
}
#endif

#ifdef PROBE_INSTR
__device__ __forceinline__ void probe_instr(const Args& A) {
    f32x2 a[8]; float f[16]; unsigned w = threadIdx.x * 0x01010101u + 0x38383838u;
#pragma unroll
    for (int i = 0; i < 8; ++i) a[i] = (f32x2){1.0f + i, 2.0f + i};
#pragma unroll
    for (int i = 0; i < 16; ++i) f[i] = 1.0f + i;
    for (int it = 0; it < 10000; ++it) {
#if PROBE_INSTR == 1
#pragma unroll
        for (int i = 0; i < 8; ++i) { asm volatile("v_pk_fma_f32 %0, %1, %2, %0" : "+v"(a[i]) : "v"(a[(i + 1) & 7]), "v"(a[(i + 2) & 7])); asm volatile("v_pk_fma_f32 %0, %1, %2, %0" : "+v"(a[i]) : "v"(a[(i + 3) & 7]), "v"(a[(i + 4) & 7])); }
#elif PROBE_INSTR == 2
#pragma unroll
        for (int i = 0; i < 16; ++i) asm volatile("v_fma_f32 %0, %1, %2, %0" : "+v"(f[i]) : "v"(f[(i + 1) & 15]), "v"(f[(i + 2) & 15]));
#elif PROBE_INSTR == 3
#pragma unroll
        for (int i = 0; i < 8; ++i) { asm volatile("v_cvt_pk_f32_fp8 %0, %1" : "=v"(a[i]) : "v"(w)); asm volatile("v_cvt_pk_f32_fp8 %0, %1" : "=v"(a[i]) : "v"(w)); }
#elif PROBE_INSTR == 4
#pragma unroll
        for (int i = 0; i < 8; ++i) { asm volatile("v_cvt_scalef32_pk_f32_fp4 %0, %1, 1.0" : "=v"(a[i]) : "v"(w)); asm volatile("v_cvt_scalef32_pk_f32_fp4 %0, %1, 1.0" : "=v"(a[i]) : "v"(w)); }
#elif PROBE_INSTR == 5
#pragma unroll
        for (int i = 0; i < 16; ++i) asm volatile("v_pk_fma_f16 %0, %1, %2, %0" : "+v"(f[i]) : "v"(f[(i + 1) & 15]), "v"(f[(i + 2) & 15]));
#elif PROBE_INSTR == 7
#pragma unroll
        for (int i = 0; i < 16; ++i) asm volatile("v_dot8c_i32_i4 %0, %1, %2" : "+v"(f[i]) : "v"(f[(i + 1) & 15]), "v"(w));
#elif PROBE_INSTR == 8
#pragma unroll
        for (int i = 0; i < 16; ++i) asm volatile("v_dot4c_i32_i8 %0, %1, %2" : "+v"(f[i]) : "v"(f[(i + 1) & 15]), "v"(w));
#elif PROBE_INSTR == 9
#pragma unroll
        for (int i = 0; i < 16; ++i) asm volatile("v_perm_b32 %0, %1, %2, %3" : "=v"(f[i]) : "v"(f[(i + 1) & 15]), "v"(f[(i + 2) & 15]), "v"(w));
#elif PROBE_INSTR == 10
#pragma unroll
        for (int i = 0; i < 16; ++i) asm volatile("v_mfma_f32_16x16x32_fp8_fp8 %0, %1, %2, %0" : "+v"(*(f32x4*)&f[4 * (i & 3)]) : "v"(a[i & 7]), "v"(a[(i + 1) & 7]));
#elif PROBE_INSTR == 6
#pragma unroll
        for (int i = 0; i < 16; ++i) asm volatile("v_cvt_scalef32_pk_f16_fp4 %0, %1, 1.0" : "=v"(f[i]) : "v"(w));
#endif
    }
    float s = 0.f;
#pragma unroll
    for (int i = 0; i < 8; ++i) s += a[i].x + a[i].y;
#pragma unroll
    for (int i = 0; i < 16; ++i) s += f[i];
    if (s == 123.456f) ((float*)(A.ws + WS_PD))[threadIdx.x] = s;
}
#endif
#ifndef MK_N_LAUNCHES
#define MK_N_LAUNCHES 1
#endif
constexpr int N_PHASES = 13;
typedef const __attribute__((address_space(4))) Args* KArgP;
__device__ __forceinline__ const Args& kargs() { KArgP p = (KArgP)__builtin_amdgcn_kernarg_segment_ptr(); asm volatile("" : "+s"(p)); return *(const Args*)p; }
__global__ void __launch_bounds__(NTHR, 2) hymba_fwd(Args A_) {
    extern __shared__ __attribute__((aligned(16))) unsigned char lds_raw[];
    LAS unsigned char* lds = (LAS unsigned char*)lds_raw;
    const int lo = A_.ph_lo, hi = A_.ph_hi;
#define A kargs()
#define ws (kargs().ws)
#ifndef DBLMASK
#define DBLMASK 0
#endif
#ifndef ONLYMASK
#define ONLYMASK 0xffff
#endif
#define IN(k) ((((ONLYMASK) >> (k)) & 1) && lo <= (k) && (k) < hi)
#define REP(k) for (int _rep = 0; _rep < (((DBLMASK) >> (k)) & 1) + 1; ++_rep)
    for (int u = threadIdx.x; u < (LDS_BYTES - RING_BYTES) / 4; u += NTHR) ((LAS unsigned*)(lds + RING_BYTES))[u] = 0u;
    __syncthreads();
    (void)xcd_barrier_post((unsigned*)(ws + WS_CTL) + CW_BAR, (volatile LAS unsigned*)(lds + MISC_OFF + 32));
#define SEAM(k) do { if (IN(k) && IN((k) + 1)) { if ((k) == 0) cg::this_grid().sync(); else { XcdBarrier xb_; xb_.bar = (unsigned*)(ws + WS_CTL) + CW_BAR; xb_.x = xb_xcc_id(); xb_.st = (volatile LAS unsigned*)(lds + MISC_OFF + 32); xcd_barrier(xb_); } } } while (0)

    if (IN(0)) REP(0) { phase_mod(A, lds); } SEAM(0);
    if (IN(1)) REP(1) { phase_convert(A, lds); phase_prenorm(A, lds); } SEAM(1);
    if (IN(2)) REP(2) {
        pg8::Gemm g{(const pg8::bf16_t*)(ws + WS_H), (const pg8::bf16_t*)(ws + WS_WIN), M, NPROJ, D}; pg8::StaticOrder S; S.init(M, NPROJ, gridDim.x, (int)blockIdx.x);
        pg8::EpiProj E{(pg8::bf16_t*)(ws + WS_PROJ), NPROJ, (float*)(ws + WS_GATES), (const int*)A.in[I_POS], (const float*)A.in[I_BI], (const float*)A.in[I_BF]};
        pg8::gemm_phase<pg8::EpiProj, pg8::StaticOrder, true, true>(lds, g, S, E);
    } SEAM(2);
    if (IN(3)) REP(3) {
        phase_attn(A, lds);
        for (int wg = blockIdx.x; wg < 256; wg += gridDim.x) mlstm_group<false>(A, lds, wg);
    } SEAM(3);
    if (IN(4)) REP(4) { for (int wg = blockIdx.x; wg < 256; wg += gridDim.x) mlstm_group<true>(A, lds, wg); } SEAM(4);
    if (IN(5)) REP(5) {
        pg8::Gemm g{(const pg8::bf16_t*)(ws + WS_MIXIN), (const pg8::bf16_t*)(ws + WS_WOUT), M, D, D}; pg8::StaticOrder S; S.init(M, D, gridDim.x, (int)blockIdx.x);
        pg8::EpiMix E{(pg8::bf16_t*)(ws + WS_MIX), D, (float*)(ws + WS_SSQ)};
        pg8::gemm_phase<pg8::EpiMix, pg8::StaticOrder, true, true>(lds, g, S, E);
    } SEAM(5);
    if (IN(6)) REP(6) { phase_mid(A); } SEAM(6);
    if (IN(7)) REP(7) {
        pg8::Gemm g{(const pg8::bf16_t*)(ws + WS_H), (const pg8::bf16_t*)(ws + WS_WQ), M, 2048, D}; pg8::StaticOrder S; S.init(M, 2048, gridDim.x, (int)blockIdx.x);
        pg8::EpiPlain E{(pg8::bf16_t*)(ws + WS_PROJ), 2048};
        pg8::gemm_phase<pg8::EpiPlain, pg8::StaticOrder, true, true>(lds, g, S, E);
    } SEAM(7);
    if (IN(8)) REP(8) { phase_topk(A, lds); } SEAM(8);
    if (IN(9)) REP(9) { phase_peer_u(A); } SEAM(9);
    if (IN(10)) REP(10) { phase_peer_act(A); } SEAM(10);
#ifdef PROBE_INSTR
    if (IN(11)) { probe_instr(A); }
#endif
#ifdef PROBE_V_LOADS
    if (IN(11)) { probe_v_loads(A); }
#endif
    if (IN(11)) REP(11) { phase_peer_v(A); } SEAM(11);
    if (IN(12)) REP(12) { phase_peer_final(A); }
#undef IN
#undef SEAM
#undef A
#undef ws
}

extern "C" void kernel_launch(void* const* d_in, const int* in_sizes, int n_in, void* d_out, int out_size, void* d_ws, size_t ws_size, hipStream_t stream) {
    static int grid = 0;
    if (grid == 0) {
        if (n_in != 21 || in_sizes[0] != M * D || out_size != M * D || ws_size < WS_END) { fprintf(stderr, "kernel_launch: unexpected shapes (n_in %d, in0 %d, out %d, ws %zu < %zu)\n", n_in, n_in > 0 ? in_sizes[0] : -1, out_size, ws_size, (size_t)WS_END); grid = -1; return; }
        int dev = 0, cus = 0, per_cu = 0;
        if (hipGetDevice(&dev) != hipSuccess || hipDeviceGetAttribute(&cus, hipDeviceAttributeMultiprocessorCount, dev) != hipSuccess) { grid = -1; return; }
        if (hipFuncSetAttribute((const void*)hymba_fwd, hipFuncAttributeMaxDynamicSharedMemorySize, LDS_BYTES) != hipSuccess) { fprintf(stderr, "kernel_launch: hipFuncSetAttribute failed\n"); grid = -1; return; }
        if (hipOccupancyMaxActiveBlocksPerMultiprocessor(&per_cu, (const void*)hymba_fwd, NTHR, LDS_BYTES) != hipSuccess || per_cu < 1) { fprintf(stderr, "kernel_launch: occupancy query says %d blocks per CU\n", per_cu); per_cu = 1; }
        (void)hipGetLastError();
        grid = cus;
        if (grid != 256) fprintf(stderr, "kernel_launch: note: %d CUs (built for 256)\n", grid);
    }
    if (grid < 0) return;
    (void)hipMemsetAsync((char*)d_ws + WS_CTL, 0, CTL_ZERO_BYTES, stream);
    Args a{};
    for (int i = 0; i < 21; ++i) a.in[i] = d_in[i];
    a.out = (float*)d_out; a.ws = (unsigned char*)d_ws;
    if (MK_N_LAUNCHES == 1) {
        a.ph_lo = 0; a.ph_hi = N_PHASES;
        void* args[] = {&a};
        const hipError_t e = hipLaunchCooperativeKernel((const void*)hymba_fwd, dim3(grid), dim3(NTHR), args, LDS_BYTES, stream);
        if (e != hipSuccess) fprintf(stderr, "kernel_launch: cooperative launch failed: %s (grid %d)\n", hipGetErrorString(e), grid);
    } else {
        for (int p = 0; p < N_PHASES; ++p) { a.ph_lo = p; a.ph_hi = p + 1; hipLaunchKernelGGL(hymba_fwd, dim3(grid), dim3(NTHR), LDS_BYTES, stream, a); }
    }
}
```

```cpp
#include <hip/hip_runtime.h>
#include <hip/hip_cooperative_groups.h>
#include <cstdio>
#include <cstdint>
namespace cg = cooperative_groups;
namespace pg8 {
#define PG8_LAS __attribute__((address_space(3)))
typedef unsigned short bf16_t;
typedef short bf16x8 __attribute__((ext_vector_type(8)));
typedef float f32x4 __attribute__((ext_vector_type(4)));
typedef unsigned u32x4 __attribute__((ext_vector_type(4)));
constexpr int BM = 256, BK = 64, HALF = 128, HTB = HALF * BK * 2  , STAGE_BYTES = 8 * HTB, NXCD = 8, WGM = 8;

__host__ __device__ __forceinline__ int lds_byte(int r, int c) { const int st = (r >> 4) * 2 + (c >> 5), rr = r & 15, cc = c & 31, ob = rr * 64 + cc * 2; return st * 1024 + (ob ^ (((ob >> 9) & 1) << 5)); }
__host__ __device__ __forceinline__ void stage_rc(int b, int& R, int& C) { const int st = b / 1024, sb = b % 1024, swz = sb ^ (((sb >> 9) & 1) << 5); R = (st >> 1) * 16 + swz / 64; C = (st & 1) * 32 + (swz % 64) / 2; }
__host__ __device__ __forceinline__ int perm32(int rho) { const int n = rho >> 4, i = rho & 15; return 8 * (i >> 2) + 4 * n + (i & 3); }

struct Unit { int pm, pn; };
struct Gemm { const bf16_t* A; const bf16_t* Bt; int M, N, K; };

struct StaticOrder {
    int nM, nN, nwg, G, c;
    __host__ __device__ void init(int M, int N, int G_, int c_) { nM = M / BM; nN = N / BM; nwg = nM * nN; G = G_; c = c_; }
    __host__ __device__ bool next(int i, Unit& u) const {
        const long L = (long)i * G + c; if (L >= nwg) return false;
        int wgid = (int)L; { const int q = nwg / NXCD, r = nwg % NXCD, xcd = wgid % NXCD, off = wgid / NXCD; wgid = (xcd < r ? xcd * (q + 1) : r * (q + 1) + (xcd - r) * q) + off; }
        const int nig = WGM * nN, gid = wgid / nig, fm = gid * WGM, gsz = (nM - fm) < WGM ? (nM - fm) : WGM;
        u.pm = fm + ((wgid % nig) % gsz); u.pn = (wgid % nig) / gsz; return true;
    }
    __device__ __forceinline__ void a_ready(const Unit&) const {}
    __device__ __forceinline__ void done(const Unit&) const {}
};

__device__ __forceinline__ unsigned cvt_pk_bf16(float lo, float hi) { unsigned r; asm volatile("v_cvt_pk_bf16_f32 %0, %1, %2" : "=v"(r) : "v"(lo), "v"(hi)); return r; }
typedef float f32x2 __attribute__((ext_vector_type(2)));
__device__ __forceinline__ f32x2 gelu_pk(f32x2 v) {
    const f32x2 av = __builtin_elementwise_abs(v), d = av * 0.2316418882f + 1.0f;
    f32x2 t; t.x = __builtin_amdgcn_rcpf(d.x); t.y = __builtin_amdgcn_rcpf(d.y);
    f32x2 q = t * 0.5307027145f + (-0.7265760135f); q = q * t + 0.7107068705f; q = q * t + (-0.142248368f); q = q * t + 0.127414796f; q = q * t;
    const f32x2 s = (v * v) * (-0.72134752044f);
    f32x2 e; e.x = __builtin_amdgcn_exp2f(s.x); e.y = __builtin_amdgcn_exp2f(s.y);
    const f32x2 m = v * (q * e), r = v - m;
    f32x2 o; o.x = v.x < 0.f ? m.x : r.x; o.y = v.y < 0.f ? m.y : r.y; return o;
}

__device__ __forceinline__ u32x4 pack8(const f32x4 v0, const f32x4 v1) { u32x4 w; w.x = cvt_pk_bf16(v0[0], v0[1]); w.y = cvt_pk_bf16(v0[2], v0[3]); w.z = cvt_pk_bf16(v1[0], v1[1]); w.w = cvt_pk_bf16(v1[2], v1[3]); return w; }

struct EpiPlain {
    static constexpr bool PERM = true, AFTER_DRAIN = false;
    bf16_t* O; int ldc;
    __device__ __forceinline__ void operator()(const f32x4 (&acc)[2][2][4][2], const Unit& u, int wr, int wc, int fr, int fq) const {
        const int row0 = u.pm * BM + wr * 64 + fr, col0 = u.pn * BM + wc * 32 + 8 * fq;
#pragma unroll
        for (int ai = 0; ai < 2; ++ai)
#pragma unroll
            for (int m = 0; m < 4; ++m) { bf16_t* rowp = O + (size_t)(row0 + ai * HALF + m * 16) * ldc + col0;
#pragma unroll
                for (int bj = 0; bj < 2; ++bj) *(u32x4*)(rowp + bj * HALF) = pack8(acc[ai][bj][m][0], acc[ai][bj][m][1]); }
    }
};

struct EpiProj {
    static constexpr bool PERM = true, AFTER_DRAIN = false;
    bf16_t* P; int ldc; float* gates; const int* pos; const float* b_i; const float* b_f;
    __device__ __forceinline__ void operator()(const f32x4 (&acc)[2][2][4][2], const Unit& u, int wr, int wc, int fr, int fq) const {
        const int row0 = u.pm * BM + wr * 64 + fr, col0 = u.pn * BM + wc * 32 + 8 * fq, pn = u.pn;
        if (pn == 9) {
            if (wc == 0 && fq == 0) {
                const f32x4 bi = {b_i[0], b_i[1], b_i[2], b_i[3]}, bf = {b_f[0], b_f[1], b_f[2], b_f[3]};
#pragma unroll
                for (int ai = 0; ai < 2; ++ai)
#pragma unroll
                    for (int m = 0; m < 4; ++m) { const int row = row0 + ai * HALF + m * 16;
                        const f32x4 iv = acc[ai][0][m][0] + bi, fv = acc[ai][0][m][1] + bf; f32x4 lf;
#pragma unroll
                        for (int j = 0; j < 4; ++j) lf[j] = fminf(fv[j], 0.f) - log1pf(__expf(-fabsf(fv[j])));
                        *(f32x4*)(gates + (size_t)row * 8) = iv; *(f32x4*)(gates + (size_t)row * 8 + 4) = lf; }
            }
            return;
        }
#pragma unroll
        for (int ai = 0; ai < 2; ++ai)
#pragma unroll
            for (int m = 0; m < 4; ++m) { const int row = row0 + ai * HALF + m * 16; bf16_t* rowp = P + (size_t)row * ldc + col0;
                const float posf = (pn <= 2) ? (float)pos[row] : 0.f;
#pragma unroll
                for (int bj = 0; bj < 2; ++bj) { f32x4 v0 = acc[ai][bj][m][0], v1 = acc[ai][bj][m][1];
                    const bool rope = (pn < 2) || (pn == 2 && bj == 0);
                    if (rope) {
                        const int p0 = ((col0 + bj * HALF) & 63) >> 1; const float sc = (pn < 2) ? 0.125f : 1.0f;
                        float x[8] = {v0[0], v0[1], v0[2], v0[3], v1[0], v1[1], v1[2], v1[3]};
#pragma unroll
                        for (int q = 0; q < 4; ++q) { const float invf = __builtin_amdgcn_exp2f(-(float)(p0 + q) * 0.41524101186092029f);
                            float r = posf * invf * 0.15915494309189535f; r = r - floorf(r);
                            const float c = __builtin_amdgcn_cosf(r) * sc, s = __builtin_amdgcn_sinf(r) * sc;
                            const float x1 = x[2 * q], x2 = x[2 * q + 1]; x[2 * q] = x1 * c - x2 * s; x[2 * q + 1] = x2 * c + x1 * s; }
                        v0 = (f32x4){x[0], x[1], x[2], x[3]}; v1 = (f32x4){x[4], x[5], x[6], x[7]};
                    } else if (pn >= 7) {
#pragma unroll
                        for (int j = 0; j < 4; ++j) { v0[j] = __builtin_amdgcn_rcpf(1.f + __expf(-v0[j])); v1[j] = __builtin_amdgcn_rcpf(1.f + __expf(-v1[j])); }
                    }
                    *(u32x4*)(rowp + bj * HALF) = pack8(v0, v1); } }
    }
};

struct EpiMix {
    static constexpr bool PERM = true, AFTER_DRAIN = false;
    bf16_t* O; int ldc; float* sumsq;
    __device__ __forceinline__ void operator()(const f32x4 (&acc)[2][2][4][2], const Unit& u, int wr, int wc, int fr, int fq) const {
        const int row0 = u.pm * BM + wr * 64 + fr, col0 = u.pn * BM + wc * 32 + 8 * fq;
#pragma unroll
        for (int ai = 0; ai < 2; ++ai)
#pragma unroll
            for (int m = 0; m < 4; ++m) { const int row = row0 + ai * HALF + m * 16; bf16_t* rowp = O + (size_t)row * ldc + col0; float s = 0.f;
#pragma unroll
                for (int bj = 0; bj < 2; ++bj) { const f32x4 v0 = acc[ai][bj][m][0], v1 = acc[ai][bj][m][1];
                    s += (v0[0] * v0[0] + v0[1] * v0[1]) + (v0[2] * v0[2] + v0[3] * v0[3]) + (v1[0] * v1[0] + v1[1] * v1[1]) + (v1[2] * v1[2] + v1[3] * v1[3]);
                    *(u32x4*)(rowp + bj * HALF) = pack8(v0, v1); }
                s += __shfl_xor(s, 16); s += __shfl_xor(s, 32);
                if (fq == 0) sumsq[(size_t)row * 16 + u.pn * 4 + wc] = s; }
    }
};
template <class Epi, class Sched, bool ALIGN_EPI = false, bool SP2 = false>
__device__ __forceinline__ void gemm_phase(PG8_LAS unsigned char* lds, const Gemm g, const Sched& S, const Epi& E) {
    const int tid = threadIdx.x, wid = __builtin_amdgcn_readfirstlane(tid >> 6), lane = tid & 63, wr = wid >> 2, wc = wid & 3, fr = lane & 15, fq = lane >> 4;
    const int K = g.K, nt = K / BK;
    unsigned voffA[2], voffB[2];
#pragma unroll
    for (int i = 0; i < 2; ++i) { int R, C; stage_rc(tid * 16 + i * 8192, R, C); const int Rb = Epi::PERM ? ((R & ~31) + perm32(R & 31)) : R;
        voffA[i] = (unsigned)(R * K + C) * 2u; voffB[i] = (unsigned)(Rb * K + C) * 2u; }
    const size_t kstep = (size_t)(BK * 2);
    const size_t hstep = (size_t)HALF * K * 2;
    const size_t tstep = 2 * hstep;
    const unsigned ldsw = (unsigned)wid * 1024u;
    const int aoff = lds_byte(wr * 64 + fr, fq * 8), boff = lds_byte(wc * 32 + fr, fq * 8);
#define PG8_SA(b, h) (((b) * 2 + (h)) * HTB)
#define PG8_SB(b, h) ((4 + (b) * 2 + (h)) * HTB)
#define PG8_STAGE(bufoff, gbase, voff) do { _Pragma("unroll") for (int _i = 0; _i < 2; ++_i) \
        __builtin_amdgcn_global_load_lds((const unsigned*)((const char*)(gbase) + (voff)[_i]), (PG8_LAS unsigned*)(lds + (bufoff) + ldsw + _i * 8192), 16, 0, 0); } while (0)
#define PG8_LDA(dst, b, h) do { _Pragma("unroll") for (int m = 0; m < 4; ++m) _Pragma("unroll") for (int k = 0; k < 2; ++k) dst[m][k] = *(const PG8_LAS bf16x8*)(lds + PG8_SA(b, h) + aoff + m * 2048 + k * 1024); } while (0)
#define PG8_LDB(dst, b, h) do { _Pragma("unroll") for (int n = 0; n < 2; ++n) _Pragma("unroll") for (int k = 0; k < 2; ++k) dst[n][k] = *(const PG8_LAS bf16x8*)(lds + PG8_SB(b, h) + boff + n * 2048 + k * 1024); } while (0)
#define PG8_MMA(ai, bj, At, Bt) do { __builtin_amdgcn_s_setprio(1); _Pragma("unroll") for (int m = 0; m < 4; ++m) _Pragma("unroll") for (int n = 0; n < 2; ++n) _Pragma("unroll") for (int k = 0; k < 2; ++k) \
        acc[ai][bj][m][n] = __builtin_amdgcn_mfma_f32_16x16x32_bf16(Bt[n][k], At[m][k], acc[ai][bj][m][n], 0, 0, 0); __builtin_amdgcn_s_setprio(0); } while (0)
#define PG8_WAIT_V(n) asm volatile("s_waitcnt vmcnt(" #n ")" ::: "memory")
#define PG8_WAIT_L(n) asm volatile("s_waitcnt lgkmcnt(" #n ")" ::: "memory")
#define PG8_BAR __builtin_amdgcn_s_barrier()
#define PG8_SCHED __builtin_amdgcn_sched_barrier(0)
    Unit cur, nxt; int ui = 0;
    if (!S.next(0, cur)) return;
    f32x4 acc[2][2][4][2];
#pragma unroll
    for (int a = 0; a < 2; ++a)
#pragma unroll
        for (int b = 0; b < 2; ++b)
#pragma unroll
            for (int m = 0; m < 4; ++m)
#pragma unroll
                for (int n = 0; n < 2; ++n) acc[a][b][m][n] = (f32x4){0.f, 0.f, 0.f, 0.f};
    bf16x8 At[4][2], B0[2][2], B1[2][2];
    const char* cA = (const char*)g.A + (size_t)cur.pm * tstep; const char* cB = (const char*)g.Bt + (size_t)cur.pn * tstep;
    S.a_ready(cur);
    if constexpr (SP2) {
        PG8_STAGE(PG8_SB(0, 0), cB, voffB); PG8_STAGE(PG8_SB(0, 1), cB + hstep, voffB); PG8_STAGE(PG8_SA(0, 0), cA, voffA); PG8_STAGE(PG8_SA(0, 1), cA + hstep, voffA);
        if (wr == 1) PG8_BAR;
        PG8_WAIT_V(2); PG8_BAR;
        PG8_STAGE(PG8_SB(1, 0), cB + kstep, voffB); PG8_STAGE(PG8_SA(1, 0), cA + kstep, voffA); PG8_STAGE(PG8_SB(1, 1), cB + hstep + kstep, voffB);
        PG8_WAIT_V(6); PG8_BAR;
    } else {
        PG8_STAGE(PG8_SB(0, 0), cB, voffB); PG8_STAGE(PG8_SA(0, 0), cA, voffA); PG8_STAGE(PG8_SB(0, 1), cB + hstep, voffB); PG8_STAGE(PG8_SA(0, 1), cA + hstep, voffA);
        if (wr == 1) PG8_BAR;
        PG8_WAIT_V(4); PG8_BAR;
        PG8_STAGE(PG8_SB(1, 0), cB + kstep, voffB); PG8_STAGE(PG8_SA(1, 0), cA + kstep, voffA); PG8_STAGE(PG8_SB(1, 1), cB + hstep + kstep, voffB);
        PG8_WAIT_V(6); PG8_BAR;
    }
    for (;;) {
        const bool has_next = S.next(ui + 1, nxt);
        const char* nA = has_next ? (const char*)g.A + (size_t)nxt.pm * tstep : cA; const char* nB = has_next ? (const char*)g.Bt + (size_t)nxt.pn * tstep : cB;
        for (int t = 0; t < nt; t += 2) {
            const bool last = (t == nt - 2);
            const char* a1 = cA + (size_t)(t + 1) * kstep;
            const char* a2 = last ? nA : cA + (size_t)(t + 2) * kstep; const char* b2 = last ? nB : cB + (size_t)(t + 2) * kstep;
            const char* a3 = a2 + kstep; const char* b3 = b2 + kstep;
            if (last && has_next) S.a_ready(nxt);
            if constexpr (SP2) {
            PG8_LDB(B0, 0, 0); PG8_LDB(B1, 0, 1); PG8_SCHED; PG8_LDA(At, 0, 0); PG8_STAGE(PG8_SA(1, 1), a1 + hstep, voffA);
            PG8_WAIT_V(8); PG8_WAIT_L(0); PG8_BAR; PG8_MMA(0, 0, At, B0); PG8_MMA(0, 1, At, B1); PG8_BAR; PG8_SCHED;
            PG8_LDA(At, 0, 1); PG8_STAGE(PG8_SB(0, 0), b2, voffB); PG8_STAGE(PG8_SB(0, 1), b2 + hstep, voffB); PG8_STAGE(PG8_SA(0, 0), a2, voffA);
            PG8_WAIT_V(8); PG8_WAIT_L(0); PG8_BAR; PG8_MMA(1, 0, At, B0); PG8_MMA(1, 1, At, B1); PG8_BAR; PG8_SCHED;
            PG8_LDB(B0, 1, 0); PG8_LDB(B1, 1, 1); PG8_SCHED; PG8_LDA(At, 1, 0); PG8_STAGE(PG8_SA(0, 1), a2 + hstep, voffA);
            PG8_WAIT_V(8); PG8_WAIT_L(0); PG8_BAR; PG8_MMA(0, 0, At, B0); PG8_MMA(0, 1, At, B1); PG8_BAR; PG8_SCHED;
            PG8_LDA(At, 1, 1); PG8_STAGE(PG8_SB(1, 0), b3, voffB); PG8_STAGE(PG8_SB(1, 1), b3 + hstep, voffB); PG8_STAGE(PG8_SA(1, 0), a3, voffA);
            PG8_WAIT_V(8); PG8_WAIT_L(0); PG8_BAR; PG8_MMA(1, 0, At, B0); PG8_MMA(1, 1, At, B1); PG8_BAR; PG8_SCHED;
            } else {
            PG8_LDB(B0, 0, 0); PG8_SCHED; PG8_LDA(At, 0, 0); PG8_STAGE(PG8_SA(1, 1), a1 + hstep, voffA);
            PG8_WAIT_L(8); PG8_BAR; PG8_WAIT_L(0); PG8_MMA(0, 0, At, B0); PG8_BAR; PG8_SCHED;
            PG8_LDB(B1, 0, 1); PG8_STAGE(PG8_SB(0, 0), b2, voffB);
            PG8_BAR; PG8_WAIT_L(0); PG8_MMA(0, 1, At, B1); PG8_BAR;
            PG8_LDA(At, 0, 1); PG8_STAGE(PG8_SA(0, 0), a2, voffA);
            PG8_BAR; PG8_WAIT_L(0); PG8_MMA(1, 0, At, B0); PG8_BAR; PG8_SCHED;
            PG8_STAGE(PG8_SB(0, 1), b2 + hstep, voffB);
            PG8_WAIT_V(6); PG8_BAR; PG8_MMA(1, 1, At, B1); PG8_BAR;
            PG8_LDB(B0, 1, 0); PG8_SCHED; PG8_LDA(At, 1, 0); PG8_STAGE(PG8_SA(0, 1), a2 + hstep, voffA);
            PG8_WAIT_L(8); PG8_BAR; PG8_WAIT_L(0); PG8_MMA(0, 0, At, B0); PG8_BAR; PG8_SCHED;
            PG8_LDB(B1, 1, 1); PG8_STAGE(PG8_SB(1, 0), b3, voffB);
            PG8_BAR; PG8_WAIT_L(0); PG8_MMA(0, 1, At, B1); PG8_BAR;
            PG8_LDA(At, 1, 1); PG8_STAGE(PG8_SA(1, 0), a3, voffA);
            PG8_BAR; PG8_WAIT_L(0); PG8_MMA(1, 0, At, B0); PG8_BAR; PG8_SCHED;
            PG8_STAGE(PG8_SB(1, 1), b3 + hstep, voffB);
            PG8_WAIT_V(6); PG8_BAR; PG8_MMA(1, 1, At, B1); PG8_BAR;
            }
        }
        if constexpr (ALIGN_EPI) { if (wr == 0) PG8_BAR; }
        if constexpr (!Epi::AFTER_DRAIN) { E(acc, cur, wr, wc, fr, fq); S.done(cur); }
        if (!has_next) break;
#pragma unroll
        for (int a = 0; a < 2; ++a)
#pragma unroll
            for (int b = 0; b < 2; ++b)
#pragma unroll
                for (int m = 0; m < 4; ++m)
#pragma unroll
                    for (int n = 0; n < 2; ++n) acc[a][b][m][n] = (f32x4){0.f, 0.f, 0.f, 0.f};
        cur = nxt; cA = nA; cB = nB; ++ui;
        if constexpr (ALIGN_EPI) { if (wr == 1) PG8_BAR; }
    }
    PG8_WAIT_V(0);
    if constexpr (!ALIGN_EPI) { if (wr == 0) PG8_BAR; }
    PG8_BAR;
    if constexpr (Epi::AFTER_DRAIN) { E.fused(acc, cur, wr, wc, fr, fq, lds, wid, lane); S.done(cur); }
#undef PG8_SA
#undef PG8_SB
#undef PG8_STAGE
#undef PG8_LDA
#undef PG8_LDB
#undef PG8_MMA
#undef PG8_WAIT_V
#undef PG8_WAIT_L
#undef PG8_BAR
#undef PG8_SCHED
}
}
constexpr int NB = 8, SEQ = 8192, D = 1024, M = NB * SEQ;
constexpr int DIN = 2312, NPROJ = 2304, NIN_PAD = 2560;
constexpr int C_AQ = 0, C_AK = 512, C_AV = 640, C_MQ = 768, C_MK = 1024, C_MV = 1280, C_MO = 1792;
constexpr int NEXP = 16384, NSLOT = 128;
constexpr float EPS = 1e-6f;
constexpr int NWAVES = 8, NTHR = 512;

constexpr size_t MiB = 1u << 20;
constexpr size_t WS_CTL = 0, CTL_ZERO_BYTES = 1 * MiB;
constexpr size_t WS_MOD = 1 * MiB;
constexpr size_t WS_WIN = 2 * MiB;
constexpr size_t WS_WOUT = 8 * MiB;
constexpr size_t WS_WQ = 10 * MiB;
constexpr size_t WS_KEYS = 14 * MiB;
constexpr size_t WS_GATES = 16 * MiB;
constexpr size_t WS_SSQ = 832 * MiB;
constexpr size_t WS_MST = 20 * MiB;
constexpr size_t WS_U8 = 32 * MiB, WS_V8 = 48 * MiB;
constexpr size_t WS_SC = 64 * MiB;
constexpr size_t WS_H = 96 * MiB;
constexpr size_t WS_PROJ = 224 * MiB;
constexpr size_t WS_MIXIN = 512 * MiB;
constexpr size_t WS_MIX = 640 * MiB;
constexpr size_t WS_EIDX = 768 * MiB, WS_GATE = 800 * MiB;
constexpr size_t WS_PD = 224 * MiB;
constexpr size_t WS_X1 = 512 * MiB;
constexpr size_t WS_ACT = 840 * MiB;
constexpr size_t WS_SSY = 872 * MiB;
constexpr size_t WS_H8 = 880 * MiB;
constexpr size_t WS_HS = 944 * MiB;
constexpr size_t WS_END = 945 * MiB;
constexpr int CW_BAR = 4096;
constexpr int CW_SUMSQ = 65536;
static_assert((CW_SUMSQ + M) * 4 <= (int)CTL_ZERO_BYTES, "ctl");

constexpr int RING_BYTES = 131072, MISC_OFF = RING_BYTES + 320, LDS_BYTES = 147456;

#define GAS __attribute__((address_space(1)))
#define LAS __attribute__((address_space(3)))
typedef unsigned short bf16;
typedef unsigned v4u __attribute__((ext_vector_type(4)));
typedef unsigned v2u __attribute__((ext_vector_type(2)));
typedef float f32x4 __attribute__((ext_vector_type(4)));
typedef GAS unsigned gu32;
#define LDS_WAIT() asm volatile("s_waitcnt lgkmcnt(0)" ::: "memory")
#define VM_WAIT() asm volatile("s_waitcnt vmcnt(0)" ::: "memory")
__device__ __forceinline__ unsigned f2bf(float f) { unsigned u = __builtin_bit_cast(unsigned, f); return (u + 0x7fffu + ((u >> 16) & 1u)) >> 16; }
__device__ __forceinline__ unsigned pk2(float lo, float hi) { return f2bf(lo) | (f2bf(hi) << 16); }
__device__ __forceinline__ float bflo(unsigned w) { return __builtin_bit_cast(float, w << 16); }
__device__ __forceinline__ float bfhi(unsigned w) { return __builtin_bit_cast(float, w & 0xffff0000u); }
__device__ __forceinline__ float bf1(bf16 h) { return __builtin_bit_cast(float, (unsigned)h << 16); }
__device__ __forceinline__ float wave_sum(float v) {
#pragma unroll
    for (int o = 1; o < 64; o <<= 1) v += __shfl_xor(v, o);
    return v;
}
__device__ __forceinline__ float wave_max(float v) {
#pragma unroll
    for (int o = 1; o < 64; o <<= 1) v = fmaxf(v, __shfl_xor(v, o));
    return v;
}

typedef float f32x2 __attribute__((ext_vector_type(2)));
__device__ __forceinline__ void cvt16_fp8(const v4u w, float (&o)[16]) {
    const unsigned ww[4] = {w.x, w.y, w.z, w.w};
#pragma unroll
    for (int i = 0; i < 4; ++i) { const f32x2 a = __builtin_amdgcn_cvt_pk_f32_fp8((int)ww[i], false), b = __builtin_amdgcn_cvt_pk_f32_fp8((int)ww[i], true);
        o[4 * i] = a.x; o[4 * i + 1] = a.y; o[4 * i + 2] = b.x; o[4 * i + 3] = b.y; }
}
__device__ __forceinline__ void p0_row_fp8(const float* src, unsigned char* dst, float* sc, int row, int lane) {
    const GAS f32x4* sp = (const GAS f32x4*)(src + (size_t)row * D + 16 * lane);
    const f32x4 a = sp[0], b = sp[1], c = sp[2], d = sp[3];
    float mx = 0.f;
#pragma unroll
    for (int i = 0; i < 4; ++i) mx = fmaxf(fmaxf(fmaxf(mx, fabsf(a[i])), fmaxf(fabsf(b[i]), fabsf(c[i]))), fabsf(d[i]));
    mx = wave_max(mx); const float s = mx > 0.f ? 224.0f / mx : 1.0f;
    v4u o; int w;
    w = __builtin_amdgcn_cvt_pk_fp8_f32(a[0] * s, a[1] * s, 0, false); w = __builtin_amdgcn_cvt_pk_fp8_f32(a[2] * s, a[3] * s, w, true); o.x = (unsigned)w;
    w = __builtin_amdgcn_cvt_pk_fp8_f32(b[0] * s, b[1] * s, 0, false); w = __builtin_amdgcn_cvt_pk_fp8_f32(b[2] * s, b[3] * s, w, true); o.y = (unsigned)w;
    w = __builtin_amdgcn_cvt_pk_fp8_f32(c[0] * s, c[1] * s, 0, false); w = __builtin_amdgcn_cvt_pk_fp8_f32(c[2] * s, c[3] * s, w, true); o.z = (unsigned)w;
    w = __builtin_amdgcn_cvt_pk_fp8_f32(d[0] * s, d[1] * s, 0, false); w = __builtin_amdgcn_cvt_pk_fp8_f32(d[2] * s, d[3] * s, w, true); o.w = (unsigned)w;
    *(GAS v4u*)(dst + (size_t)row * D + 16 * lane) = o;
    if (lane == 0) sc[row] = mx > 0.f ? mx * (1.0f / 224.0f) : 1.0f;
}

__device__ __forceinline__ unsigned pack4_i8(float a, float b, float c, float d) { return ((unsigned)__float2int_rn(a) & 0xffu) | (((unsigned)__float2int_rn(b) & 0xffu) << 8) | (((unsigned)__float2int_rn(c) & 0xffu) << 16) | (((unsigned)__float2int_rn(d) & 0xffu) << 24); }
__device__ __forceinline__ void p0_row_i8(const float* src, unsigned char* dst, float* sc, int row, int lane) {
    const GAS f32x4* sp = (const GAS f32x4*)(src + (size_t)row * D + 16 * lane);
    const f32x4 a = sp[0], b = sp[1], c = sp[2], d = sp[3];
    float mx = 0.f;
#pragma unroll
    for (int i = 0; i < 4; ++i) mx = fmaxf(fmaxf(fmaxf(mx, fabsf(a[i])), fmaxf(fabsf(b[i]), fabsf(c[i]))), fabsf(d[i]));
    mx = wave_max(mx); const float s = mx > 0.f ? 127.0f / mx : 1.0f;
    v4u o; o.x = pack4_i8(a[0] * s, a[1] * s, a[2] * s, a[3] * s); o.y = pack4_i8(b[0] * s, b[1] * s, b[2] * s, b[3] * s); o.z = pack4_i8(c[0] * s, c[1] * s, c[2] * s, c[3] * s); o.w = pack4_i8(d[0] * s, d[1] * s, d[2] * s, d[3] * s);
    *(GAS v4u*)(dst + (size_t)row * D + 16 * lane) = o;
    if (lane == 0) sc[row] = mx > 0.f ? mx * (1.0f / 127.0f) : 1.0f;
}

__device__ __forceinline__ unsigned pack8_i4(const f32x4 a, const f32x4 b, float s) {
    unsigned w = 0;
#pragma unroll
    for (int i = 0; i < 4; ++i) { const int qa = max(-8, min(7, __float2int_rn(a[i] * s))), qb = max(-8, min(7, __float2int_rn(b[i] * s))); w |= ((unsigned)qa & 15u) << (4 * i); w |= ((unsigned)qb & 15u) << (16 + 4 * i); }
    return w;
}
__device__ __forceinline__ void p0_row_i4(const f32x4 a, const f32x4 b, const f32x4 c, const f32x4 d, unsigned char* dst, float* sc, int row, int lane) {
    float ss = 0.f;
#pragma unroll
    for (int i = 0; i < 4; ++i) ss += (a[i] * a[i] + b[i] * b[i]) + (c[i] * c[i] + d[i] * d[i]);
    ss = wave_sum(ss); const float sig = sqrtf(ss * (1.f / D)), s = sig > 0.f ? 3.0f / sig : 1.0f;
    v2u o; o.x = pack8_i4(a, b, s); o.y = pack8_i4(c, d, s);
    *(GAS v2u*)(dst + (size_t)row * (D / 2) + 8 * lane) = o;
    if (lane == 0) sc[row] = sig > 0.f ? sig * (1.0f / 3.0f) : 1.0f;
}

__device__ __forceinline__ unsigned pack8_fp4(const f32x4 a, const f32x4 b, float s) {
    unsigned w = 0;
    w = __builtin_amdgcn_cvt_scalef32_pk_fp4_f32(w, fminf(fmaxf(a[0] * s, -6.f), 6.f), fminf(fmaxf(a[1] * s, -6.f), 6.f), 1.0f, 0);
    w = __builtin_amdgcn_cvt_scalef32_pk_fp4_f32(w, fminf(fmaxf(a[2] * s, -6.f), 6.f), fminf(fmaxf(a[3] * s, -6.f), 6.f), 1.0f, 1);
    w = __builtin_amdgcn_cvt_scalef32_pk_fp4_f32(w, fminf(fmaxf(b[0] * s, -6.f), 6.f), fminf(fmaxf(b[1] * s, -6.f), 6.f), 1.0f, 2);
    w = __builtin_amdgcn_cvt_scalef32_pk_fp4_f32(w, fminf(fmaxf(b[2] * s, -6.f), 6.f), fminf(fmaxf(b[3] * s, -6.f), 6.f), 1.0f, 3);
    return w;
}
__device__ __forceinline__ void p0_row_fp4(const f32x4 a, const f32x4 b, const f32x4 c, const f32x4 d, unsigned char* dst, float* sc, int row, int lane) {
    float mx = 0.f;
#pragma unroll
    for (int i = 0; i < 4; ++i) mx = fmaxf(fmaxf(fmaxf(mx, fabsf(a[i])), fmaxf(fabsf(b[i]), fabsf(c[i]))), fabsf(d[i]));
    mx = wave_max(mx); const float s = mx > 0.f ? 7.0f / mx : 1.0f;
    v2u o; o.x = pack8_fp4(a, b, s); o.y = pack8_fp4(c, d, s);
    *(GAS v2u*)(dst + (size_t)row * (D / 2) + 8 * lane) = o;
    if (lane == 0) sc[row] = mx > 0.f ? mx * (1.0f / 7.0f) : 1.0f;
}
#define XB_TMO      128
#define XB_XCNT(j)  (256  + 64 * (j))
#define XB_XSUB(j)  (1280 + 64 * (j))
#define XB_XGEN(j)  (2304 + 64 * (j))
#define XB_TOP      3328
#define XB_TOPGEN   3392
#define XCD_BAR_WORDS 3456
#define XB_SPIN_CAP (1u << 18)

__device__ __forceinline__ unsigned xb_ld(unsigned* p)              { return __hip_atomic_load(p, __ATOMIC_RELAXED, __HIP_MEMORY_SCOPE_AGENT); }
__device__ __forceinline__ unsigned xb_add(unsigned* p, unsigned v) { return __hip_atomic_fetch_add(p, v, __ATOMIC_RELAXED, __HIP_MEMORY_SCOPE_AGENT); }
__device__ __forceinline__ unsigned xb_xcc_id() { return (unsigned)__builtin_amdgcn_s_getreg((3 << 11) | 20) & 0xFu; }
#define XB_SPIN(cond, bar) do { unsigned _sp = 0; while (cond) { __builtin_amdgcn_s_sleep(1); \
    if ((++_sp & 255u) == 0u) { if (xb_ld(&(bar)[XB_TMO])) break; if (_sp > XB_SPIN_CAP) { atomicAdd(&(bar)[XB_TMO], 1u); break; } } } } while (0)

struct XcdBarrier {
    unsigned* bar; unsigned x;
    volatile LAS unsigned* st;
};

__device__ __forceinline__ XcdBarrier xcd_barrier_post(unsigned* bar, volatile LAS unsigned* st) {
    XcdBarrier b; b.bar = bar; b.x = xb_xcc_id(); b.st = st;
    if (threadIdx.x == 0) (void)xb_add(&bar[XB_XCNT(b.x)], 1u);
    return b;
}
__device__ __forceinline__ void xcd_barrier_complete(unsigned* bar, unsigned x, unsigned& nloc, unsigned& nx) {
    const unsigned G = gridDim.x * gridDim.y * gridDim.z;
    unsigned sum, cnt, mine, sp = 0u;
    for (;;) {
        sum = 0u; cnt = 0u; mine = 0u;
#pragma unroll
        for (unsigned j = 0; j < 16; ++j) { const unsigned c = xb_ld(&bar[XB_XCNT(j)]); sum += c; cnt += (c > 0u) ? 1u : 0u; mine = (j == x) ? c : mine; }
        if (sum == G) break;
        __builtin_amdgcn_s_sleep(1);
        if ((++sp & 255u) == 0u) { if (xb_ld(&bar[XB_TMO])) break; if (sp > XB_SPIN_CAP) { atomicAdd(&bar[XB_TMO], 1u); break; } }
    }
    nloc = mine > 0u ? mine : 1u; nx = cnt > 0u ? cnt : 1u;
}

__device__ __forceinline__ void xcd_barrier(const XcdBarrier& b) {
    asm volatile("s_waitcnt vmcnt(0)" ::: "memory");
    __syncthreads();
    if (threadIdx.x == 0) {
        unsigned* bar = b.bar;
        __builtin_amdgcn_s_waitcnt(0);
        unsigned nloc = b.st[0], nx = b.st[1];
        if (nloc == 0u) { xcd_barrier_complete(bar, b.x, nloc, nx); b.st[0] = nloc; b.st[1] = nx; }
        const unsigned old = xb_add(&bar[XB_XSUB(b.x)], 1u);
        const unsigned gen = old / nloc;
        if (old + 1u == (gen + 1u) * nloc) {
            __builtin_amdgcn_fence(__ATOMIC_RELEASE, "agent");
            asm volatile("s_waitcnt vmcnt(0)" ::: "memory");
            const unsigned og = xb_add(&bar[XB_TOP], 1u);
            const unsigned tg = og / nx;
            if (og + 1u == (tg + 1u) * nx) xb_add(&bar[XB_TOPGEN], 1u);
            else XB_SPIN(xb_ld(&bar[XB_TOPGEN]) == tg, bar);
            __builtin_amdgcn_fence(__ATOMIC_ACQUIRE, "agent");
            xb_add(&bar[XB_XGEN(b.x)], 1u);
            asm volatile("s_waitcnt vmcnt(0)" ::: "memory");
        } else {
            XB_SPIN(xb_ld(&bar[XB_XGEN(b.x)]) == gen, bar);
            __builtin_amdgcn_fence(__ATOMIC_ACQUIRE, "agent");
            asm volatile("s_waitcnt vmcnt(0)" ::: "memory");
        }
    }
    __syncthreads();
}
struct Args { const void* in[21]; float* out; unsigned char* ws; int ph_lo, ph_hi; };
enum { I_X = 0, I_C, I_POS, I_WMOD, I_BMOD, I_GPRE1, I_GPOST1, I_WIN, I_CONVW, I_BI, I_BF, I_MNG, I_SINK, I_WOUT, I_GPRE2, I_GPOST2, I_WQ, I_K1, I_K2, I_U, I_V };

__device__ __forceinline__ int newcol(int o) {
    if (o < 640) { const int hd = o >> 6, d = o & 63; return (hd << 6) + 2 * (d & 31) + (d >> 5); }
    if (o < 1792) return o;
    if (o < 1800) return 2304 + (o - 1792);
    return o - 8;
}
template <bool REMAP>
__device__ __forceinline__ void p0_transpose_item(const float* W, int K, int N, bf16* WT, LAS float* scr, int item, int lane) {
    const int nblk = (N + 31) / 32, kb = item / nblk, nb = item % nblk, k0 = 64 * kb, n0 = 32 * nb;
    const int ncol = n0 + (lane & 31);
#pragma unroll 8
    for (int i = 0; i < 32; ++i) { const int kk = 2 * i + (lane >> 5); scr[kk * 33 + (lane & 31)] = (ncol < N) ? W[(size_t)(k0 + kk) * N + ncol] : 0.f; }
    LDS_WAIT(); asm volatile("" ::: "memory");
    const int c = lane & 7;
#pragma unroll
    for (int j = 0; j < 4; ++j) { const int n = (lane >> 3) + 8 * j; const LAS float* s = scr + (8 * c) * 33 + n;
        v4u o; o.x = pk2(s[0 * 33], s[1 * 33]); o.y = pk2(s[2 * 33], s[3 * 33]); o.z = pk2(s[4 * 33], s[5 * 33]); o.w = pk2(s[6 * 33], s[7 * 33]);
        if (n0 + n < N) { const int drow = REMAP ? newcol(n0 + n) : (n0 + n); *(GAS v4u*)(WT + (size_t)drow * K + k0 + 8 * c) = o; } }
    LDS_WAIT(); asm volatile("" ::: "memory");
}
__device__ __forceinline__ void p0_convert(const float* src, bf16* dst, size_t n, int gt, int ngt) {
    for (size_t i = (size_t)gt * 8; i < n; i += (size_t)ngt * 8) {
        const f32x4 a = *(const GAS f32x4*)(src + i), b = *(const GAS f32x4*)(src + i + 4);
        v4u o; o.x = pk2(a[0], a[1]); o.y = pk2(a[2], a[3]); o.z = pk2(b[0], b[1]); o.w = pk2(b[2], b[3]);
        *(GAS v4u*)(dst + i) = o; }
}
__device__ __forceinline__ void phase_mod(const Args& A, LAS unsigned char* lds) {
    const int tid = threadIdx.x, G = gridDim.x, blk = blockIdx.x;
    unsigned char* ws = A.ws;
    const float* c = (const float*)A.in[I_C]; const float* wm = (const float*)A.in[I_WMOD]; const float* bm = (const float*)A.in[I_BMOD];
    float* mod = (float*)(ws + WS_MOD); LAS float* cs = (LAS float*)lds; LAS float* red = cs + 8 * 1024;
    for (int e = tid; e < 8 * 1024 / 4; e += NTHR) *(LAS f32x4*)(cs + 4 * e) = *(const GAS f32x4*)(c + 4 * e);
    __syncthreads();
    for (int it = blk; it < 6144 / 24; it += G) {
        const int kg = tid >> 5, col = tid & 31, j = it * 24 + (col < 24 ? col : 23); float acc[8];
#pragma unroll
        for (int b = 0; b < 8; ++b) acc[b] = 0.f;
#pragma unroll 16
        for (int i = 0; i < 64; ++i) { const int k = kg + 16 * i; const float w = wm[(size_t)k * 6144 + j];
#pragma unroll
            for (int b = 0; b < 8; ++b) acc[b] += cs[b * 1024 + k] * w; }
#pragma unroll
        for (int b = 0; b < 8; ++b) red[(kg * 32 + col) * 8 + b] = acc[b];
        __syncthreads();
        if (tid < 256) { const int b = tid >> 5, cc = tid & 31; float s = 0.f;
#pragma unroll
            for (int g = 0; g < 16; ++g) s += red[(g * 32 + cc) * 8 + b];
            if (cc < 24) mod[b * 6144 + it * 24 + cc] = s + bm[it * 24 + cc]; }
        __syncthreads();
    }
}
__device__ __forceinline__ void phase_convert(const Args& A, LAS unsigned char* lds) {
    const int tid = threadIdx.x, lane = tid & 63, wave = tid >> 6, G = gridDim.x, blk = blockIdx.x;
    unsigned char* ws = A.ws;
    {
        LAS float* scr = (LAS float*)(lds + wave * 16384);
        const int gw = blk * NWAVES + wave, NGW = G * NWAVES;
        const int I_IN = (D / 64) * ((DIN + 31) / 32), I_OUT = (D / 64) * (D / 32), I_Q = (D / 64) * (2048 / 32);
        bf16* win = (bf16*)(ws + WS_WIN); bf16* wout = (bf16*)(ws + WS_WOUT); bf16* wq = (bf16*)(ws + WS_WQ);
        for (int it = gw; it < I_IN + I_OUT + I_Q; it += NGW) {
            int r = it;
            if (r < I_IN) { p0_transpose_item<true>((const float*)A.in[I_WIN], D, DIN, win, scr, r, lane); continue; } r -= I_IN;
            if (r < I_OUT) { p0_transpose_item<false>((const float*)A.in[I_WOUT], D, D, wout, scr, r, lane); continue; } r -= I_OUT;
            p0_transpose_item<false>((const float*)A.in[I_WQ], D, 2048, wq, scr, r, lane);
        }
        const int gt = blk * NTHR + tid, ngt = G * NTHR;
        for (int i = gt; i < (NIN_PAD - DIN) * D / 8; i += ngt) *(GAS v4u*)(win + (size_t)DIN * D + (size_t)i * 8) = (v4u){0u, 0u, 0u, 0u};
        p0_convert((const float*)A.in[I_K1], (bf16*)(ws + WS_KEYS), (size_t)8 * 128 * 128, gt, ngt);
        p0_convert((const float*)A.in[I_K2], (bf16*)(ws + WS_KEYS) + 8 * 128 * 128, (size_t)8 * 128 * 128, gt, ngt);
        {
            const float* usrc = (const float*)A.in[I_U]; const float* vsrc = (const float*)A.in[I_V];
            auto rowp = [&](int r) { return (const GAS f32x4*)((r < NEXP ? usrc + (size_t)r * D : vsrc + (size_t)(r - NEXP) * D) + 16 * lane); };
            int r = gw; const GAS f32x4* sp = rowp(min(r, 2 * NEXP - 1)); f32x4 a = sp[0], b = sp[1], c = sp[2], d = sp[3];
            for (; r < 2 * NEXP; r += NGW) { const GAS f32x4* sn = rowp(min(r + NGW, 2 * NEXP - 1)); const f32x4 an = sn[0], bn = sn[1], cn = sn[2], dn = sn[3];
                if (r < NEXP) p0_row_i4(a, b, c, d, ws + WS_U8, (float*)(ws + WS_SC), r, lane); else p0_row_fp4(a, b, c, d, ws + WS_V8, (float*)(ws + WS_SC) + NEXP, r - NEXP, lane);
                a = an; b = bn; c = cn; d = dn; }
        }
    }
}

__device__ __forceinline__ void phase_prenorm(const Args& A, LAS unsigned char* lds) {
    const int tid = threadIdx.x, lane = tid & 63, wave = tid >> 6, G = gridDim.x;
    const float* x = (const float*)A.in[I_X]; const float* g = (const float*)A.in[I_GPRE1]; const float* mod = (const float*)(A.ws + WS_MOD);
    bf16* H = (bf16*)(A.ws + WS_H); float* gates = (float*)(A.ws + WS_GATES);
    LAS float* wg = (LAS float*)lds;
    __syncthreads();
    for (int k = tid; k < D; k += NTHR) { const float* wr = (const float*)A.in[I_WIN] + (size_t)k * DIN + 1792; const f32x4 w0 = *(const GAS f32x4*)wr, w1 = *(const GAS f32x4*)(wr + 4);
#pragma unroll
        for (int j = 0; j < 4; ++j) { wg[j * D + k] = w0[j]; wg[(4 + j) * D + k] = w1[j]; } }
    __syncthreads();
    const int gi = ((lane >> 5) & 1) * 4 + ((lane >> 4) & 1) * 2 + ((lane >> 3) & 1);
    const float gbias = gi < 4 ? ((const float*)A.in[I_BI])[gi] : ((const float*)A.in[I_BF])[gi - 4];
    f32x4 gg[4];
#pragma unroll
    for (int j = 0; j < 4; ++j) gg[j] = *(const GAS f32x4*)(g + 4 * (lane + 64 * j));
    const int stride = G * NWAVES; int row = blockIdx.x * NWAVES + wave;
    f32x4 v[4], vn[4], shv[4], gsv[4]; int bcur = -1;
#pragma unroll
    for (int j = 0; j < 4; ++j) v[j] = ((const GAS f32x4*)(x + (size_t)row * D) + lane)[64 * j];
    for (; row < M; row += stride) {
        const int rn = min(row + stride, M - 1);
#pragma unroll
        for (int j = 0; j < 4; ++j) vn[j] = ((const GAS f32x4*)(x + (size_t)rn * D) + lane)[64 * j];
        const int b = row / SEQ; float s = 0.f;
        if (b != bcur) { bcur = b;
#pragma unroll
            for (int j = 0; j < 4; ++j) { const int k = 4 * (lane + 64 * j); shv[j] = *(const GAS f32x4*)(mod + b * 6144 + k); const f32x4 sc = *(const GAS f32x4*)(mod + b * 6144 + 1024 + k);
#pragma unroll
                for (int i = 0; i < 4; ++i) gsv[j][i] = gg[j][i] * (1.f + sc[i]); } }
#pragma unroll
        for (int j = 0; j < 4; ++j) s += (v[j][0] * v[j][0] + v[j][1] * v[j][1]) + (v[j][2] * v[j][2] + v[j][3] * v[j][3]);
        const float rstd = 1.0f / sqrtf(wave_sum(s) * (1.f / D) + EPS);
        GAS v2u* o = (GAS v2u*)(H + (size_t)row * D) + lane;
        float gd[8];
#pragma unroll
        for (int q = 0; q < 8; ++q) gd[q] = 0.f;
#pragma unroll
        for (int j = 0; j < 4; ++j) {
            f32x4 y;
#pragma unroll
            for (int i = 0; i < 4; ++i) y[i] = v[j][i] * rstd * gsv[j][i] + shv[j][i];
            v2u w; w.x = pk2(y[0], y[1]); w.y = pk2(y[2], y[3]); o[64 * j] = w;
#pragma unroll
            for (int q = 0; q < 8; ++q) { const f32x4 ww = *(LAS const f32x4*)(wg + q * D + 4 * (lane + 64 * j)); gd[q] += (y[0] * ww[0] + y[1] * ww[1]) + (y[2] * ww[2] + y[3] * ww[3]); } }
#pragma unroll
        for (int i = 0; i < 4; ++i) { const bool up = (lane & 32) != 0; const float keep = up ? gd[i + 4] : gd[i], send = up ? gd[i] : gd[i + 4]; gd[i] = keep + __shfl_xor(send, 32); }
#pragma unroll
        for (int i = 0; i < 2; ++i) { const bool up = (lane & 16) != 0; const float keep = up ? gd[i + 2] : gd[i], send = up ? gd[i] : gd[i + 2]; gd[i] = keep + __shfl_xor(send, 16); }
        { const bool up = (lane & 8) != 0; const float keep = up ? gd[1] : gd[0], send = up ? gd[0] : gd[1]; gd[0] = keep + __shfl_xor(send, 8); }
        float gv = gd[0]; gv += __shfl_xor(gv, 4); gv += __shfl_xor(gv, 2); gv += __shfl_xor(gv, 1); gv += gbias;
        if ((lane & 7) == 0) gates[(size_t)row * 8 + gi] = gi < 4 ? gv : (fminf(gv, 0.f) - log1pf(__expf(-fabsf(gv))));
#pragma unroll
        for (int j = 0; j < 4; ++j) v[j] = vn[j];
    }
}

__device__ __forceinline__ void phase_mid(const Args& A) {
    const int tid = threadIdx.x, lane = tid & 63, wave = tid >> 6, G = gridDim.x;
    const float* x = (const float*)A.in[I_X]; const float* gpost = (const float*)A.in[I_GPOST1]; const float* gpre = (const float*)A.in[I_GPRE2];
    const float* mod = (const float*)(A.ws + WS_MOD); const float* sumsq = (const float*)(A.ws + WS_SSQ);
    const bf16* MIX = (const bf16*)(A.ws + WS_MIX); bf16* H = (bf16*)(A.ws + WS_H); bf16* X1 = (bf16*)(A.ws + WS_X1);
    const int stride = G * NWAVES; int row = blockIdx.x * NWAVES + wave;
    f32x4 xv[4], xn[4], q[4], qn[4], g1p[4], gs2[4], sh2[4]; v2u mw[4], mn[4]; int bcur = -1;
#pragma unroll
    for (int j = 0; j < 4; ++j) { xv[j] = ((const GAS f32x4*)(x + (size_t)row * D) + lane)[64 * j]; mw[j] = ((const GAS v2u*)(MIX + (size_t)row * D) + lane)[64 * j]; q[j] = *(const GAS f32x4*)(sumsq + (size_t)row * 16 + 4 * j); }
    for (; row < M; row += stride) {
        const int rn = min(row + stride, M - 1);
#pragma unroll
        for (int j = 0; j < 4; ++j) { xn[j] = ((const GAS f32x4*)(x + (size_t)rn * D) + lane)[64 * j]; mn[j] = ((const GAS v2u*)(MIX + (size_t)rn * D) + lane)[64 * j]; qn[j] = *(const GAS f32x4*)(sumsq + (size_t)rn * 16 + 4 * j); }
        const int b = row / SEQ;
        if (b != bcur) { bcur = b;
#pragma unroll
            for (int j = 0; j < 4; ++j) { const int k = 4 * (lane + 64 * j); const f32x4 gp = *(const GAS f32x4*)(gpost + k), g1 = *(const GAS f32x4*)(mod + b * 6144 + 2048 + k), gg = *(const GAS f32x4*)(gpre + k), sc = *(const GAS f32x4*)(mod + b * 6144 + 4096 + k);
                sh2[j] = *(const GAS f32x4*)(mod + b * 6144 + 3072 + k);
#pragma unroll
                for (int i = 0; i < 4; ++i) { g1p[j][i] = g1[i] * gp[i]; gs2[j][i] = gg[i] * (1.f + sc[i]); } } }
        const float rm = 1.0f / sqrtf(((((q[0][0] + q[0][1]) + (q[0][2] + q[0][3])) + ((q[1][0] + q[1][1]) + (q[1][2] + q[1][3]))) + (((q[2][0] + q[2][1]) + (q[2][2] + q[2][3])) + ((q[3][0] + q[3][1]) + (q[3][2] + q[3][3])))) * (1.f / D) + EPS);
        f32x4 v[4]; float s = 0.f;
#pragma unroll
        for (int j = 0; j < 4; ++j) {
            const float mx[4] = {bflo(mw[j].x), bfhi(mw[j].x), bflo(mw[j].y), bfhi(mw[j].y)};
#pragma unroll
            for (int i = 0; i < 4; ++i) { v[j][i] = xv[j][i] + g1p[j][i] * (mx[i] * rm); s += v[j][i] * v[j][i]; }
            { v2u w; w.x = pk2(v[j][0], v[j][1]); w.y = pk2(v[j][2], v[j][3]); *((GAS v2u*)(X1 + (size_t)row * D) + lane + 64 * j) = w; } }
        const float rstd = 1.0f / sqrtf(wave_sum(s) * (1.f / D) + EPS);
        GAS v2u* o = (GAS v2u*)(H + (size_t)row * D) + lane; float amx = 0.f;
#pragma unroll
        for (int j = 0; j < 4; ++j) {
#pragma unroll
            for (int i = 0; i < 4; ++i) { v[j][i] = v[j][i] * rstd * gs2[j][i] + sh2[j][i]; amx = fmaxf(amx, fabsf(v[j][i])); }
            v2u w; w.x = pk2(v[j][0], v[j][1]); w.y = pk2(v[j][2], v[j][3]); o[64 * j] = w; }
        amx = wave_max(amx); const float s8 = amx > 0.f ? 119.0f / amx : 1.0f;
        GAS unsigned short* ohh = (GAS unsigned short*)((unsigned char*)A.ws + WS_H8 + (size_t)row * (D / 2)) + lane; GAS unsigned short* ohl = (GAS unsigned short*)((unsigned char*)A.ws + WS_H8 + 32 * MiB + (size_t)row * (D / 2)) + lane;
#pragma unroll
        for (int j = 0; j < 4; ++j) { unsigned whh = 0, whl = 0;
#pragma unroll
            for (int i = 0; i < 4; ++i) { const int tq = __float2int_rn(v[j][i] * s8) + 8; whh |= ((unsigned)(tq >> 4) & 15u) << (4 * i); whl |= ((unsigned)((tq & 15) - 8) & 15u) << (4 * i); }
            ohh[64 * j] = (unsigned short)whh; ohl[64 * j] = (unsigned short)whl; }
        if (lane == 0) ((float*)(A.ws + WS_HS))[row] = amx > 0.f ? amx * (1.0f / 119.0f) : 1.0f;
#pragma unroll
        for (int j = 0; j < 4; ++j) { xv[j] = xn[j]; mw[j] = mn[j]; q[j] = qn[j]; }
    }
}
__device__ __forceinline__ void load64bf(const bf16* p, float (&o)[64]) {
#pragma unroll
    for (int i = 0; i < 8; ++i) { const v4u w = *(const GAS v4u*)(p + 8 * i);
        o[8 * i + 0] = bflo(w.x); o[8 * i + 1] = bfhi(w.x); o[8 * i + 2] = bflo(w.y); o[8 * i + 3] = bfhi(w.y);
        o[8 * i + 4] = bflo(w.z); o[8 * i + 5] = bfhi(w.z); o[8 * i + 6] = bflo(w.w); o[8 * i + 7] = bfhi(w.w); }
}
__device__ __forceinline__ void phase_attn_naive(const Args& A, int vb, int nvb) {
    const bf16* P = (const bf16*)(A.ws + WS_PROJ); bf16* MI = (bf16*)(A.ws + WS_MIXIN); const float* sinks = (const float*)A.in[I_SINK];
    for (int task = vb * NTHR + (int)threadIdx.x; task < 8 * M; task += nvb * NTHR) {
        const int h = task / M, t = task % M, s = t % SEQ, kvh = h >> 2;
        float q[64], o[64];
        load64bf(P + (size_t)t * NPROJ + C_AQ + h * 64, q);
#pragma unroll
        for (int d = 0; d < 64; ++d) o[d] = 0.f;
        float mx = sinks[h], l = 1.f;
        for (int j = 0; j < 128; ++j) {
            const int sj = s - 127 + j; const bool valid = sj >= 0; const int tk = valid ? (t - 127 + j) : t;
            const bf16* kr = P + (size_t)tk * NPROJ + C_AK + kvh * 64; float sc = 0.f;
#pragma unroll
            for (int i = 0; i < 8; ++i) { const v4u w = *(const GAS v4u*)(kr + 8 * i);
                sc += q[8 * i + 0] * bflo(w.x) + q[8 * i + 1] * bfhi(w.x) + q[8 * i + 2] * bflo(w.y) + q[8 * i + 3] * bfhi(w.y)
                    + q[8 * i + 4] * bflo(w.z) + q[8 * i + 5] * bfhi(w.z) + q[8 * i + 6] * bflo(w.w) + q[8 * i + 7] * bfhi(w.w); }
            if (valid) {
                const float mn = fmaxf(mx, sc), al = __expf(mx - mn), p = __expf(sc - mn); mx = mn; l = l * al + p;
                const bf16* vr = P + (size_t)tk * NPROJ + C_AV + kvh * 64;
#pragma unroll
                for (int i = 0; i < 8; ++i) { const v4u w = *(const GAS v4u*)(vr + 8 * i);
                    o[8 * i + 0] = o[8 * i + 0] * al + p * bflo(w.x); o[8 * i + 1] = o[8 * i + 1] * al + p * bfhi(w.x);
                    o[8 * i + 2] = o[8 * i + 2] * al + p * bflo(w.y); o[8 * i + 3] = o[8 * i + 3] * al + p * bfhi(w.y);
                    o[8 * i + 4] = o[8 * i + 4] * al + p * bflo(w.z); o[8 * i + 5] = o[8 * i + 5] * al + p * bfhi(w.z);
                    o[8 * i + 6] = o[8 * i + 6] * al + p * bflo(w.w); o[8 * i + 7] = o[8 * i + 7] * al + p * bfhi(w.w); }
            }
        }
        const float il = 1.f / l; bf16* orow = MI + (size_t)t * D + h * 64;
#pragma unroll
        for (int i = 0; i < 8; ++i) { v4u w; w.x = pk2(o[8 * i] * il, o[8 * i + 1] * il); w.y = pk2(o[8 * i + 2] * il, o[8 * i + 3] * il);
            w.z = pk2(o[8 * i + 4] * il, o[8 * i + 5] * il); w.w = pk2(o[8 * i + 6] * il, o[8 * i + 7] * il); *(GAS v4u*)(orow + 8 * i) = w; }
    }
}

__device__ __forceinline__ void phase_mlstm_naive(const Args& A, LAS unsigned char* lds, int bh) {
    const int tid = threadIdx.x, lane = tid & 63, wave = tid >> 6, b = bh >> 2, h = bh & 3, dv = tid >> 2, part = tid & 3;
    const bf16* P = (const bf16*)(A.ws + WS_PROJ); bf16* MI = (bf16*)(A.ws + WS_MIXIN); const float* gates = (const float*)(A.ws + WS_GATES);
    const float* cw = (const float*)A.in[I_CONVW]; const float* ng = (const float*)A.in[I_MNG];
    LAS float* qs = (LAS float*)lds; LAS float* ks = qs + 64 * 64; LAS float* vs = ks + 64 * 64; LAS float* ig = vs + 64 * 128; LAS float* lfg = ig + 64; LAS float* hb = lfg + 64;
    float C[16], n[16]; float m = 0.f;
#pragma unroll
    for (int j = 0; j < 16; ++j) { C[j] = 0.f; n[j] = 0.f; }
    for (int ch = 0; ch < SEQ / 64; ++ch) {
        const int s0 = ch * 64; const size_t t0 = (size_t)b * SEQ + s0;
        for (int e = tid; e < 64 * 64; e += NTHR) { const int l = e >> 6, dk = e & 63; float aq = 0.f, ak = 0.f;
#pragma unroll
            for (int j = 0; j < 4; ++j) { const int sj = s0 + l - 3 + j; if (sj >= 0) { const bf16* r = P + ((size_t)b * SEQ + sj) * NPROJ;
                aq += cw[j * 512 + h * 64 + dk] * bf1(r[C_MQ + h * 64 + dk]); ak += cw[j * 512 + 256 + h * 64 + dk] * bf1(r[C_MK + h * 64 + dk]); } }
            qs[e] = 0.125f * aq / (1.f + __expf(-aq)); ks[e] = ak / (1.f + __expf(-ak)); }
        for (int e = tid; e < 64 * 128; e += NTHR) { const int l = e >> 7, d = e & 127; vs[e] = bf1(P[(t0 + l) * NPROJ + C_MV + h * 128 + d]); }
        if (tid < 64) { ig[tid] = gates[(t0 + tid) * 8 + h]; lfg[tid] = gates[(t0 + tid) * 8 + 4 + h]; }
        __syncthreads();
        for (int l = 0; l < 64; ++l) {
            const float lf = lfg[l], ii = ig[l], mn = fmaxf(lf + m, ii), fd = __expf(lf + m - mn), iw = __expf(ii - mn), vv = vs[l * 128 + dv] * iw;
            float num = 0.f, den = 0.f;
#pragma unroll
            for (int j = 0; j < 16; ++j) { const float kk = ks[l * 64 + part * 16 + j], qq = qs[l * 64 + part * 16 + j];
                C[j] = fd * C[j] + vv * kk; n[j] = fd * n[j] + iw * kk; num += C[j] * qq; den += n[j] * qq; }
            num += __shfl_xor(num, 1); num += __shfl_xor(num, 2); den += __shfl_xor(den, 1); den += __shfl_xor(den, 2);
            if (part == 0) hb[l * 128 + dv] = num / fmaxf(fabsf(den), __expf(-mn));
            m = mn;
        }
        __syncthreads();
        for (int l = wave * 8; l < wave * 8 + 8; ++l) { const float a0 = hb[l * 128 + lane], a1 = hb[l * 128 + 64 + lane];
            const float r = 1.0f / sqrtf(wave_sum(a0 * a0 + a1 * a1) * (1.f / 128.f) + EPS);
            const bf16* pr = P + (t0 + l) * NPROJ + C_MO + h * 128; bf16* orow = MI + (t0 + l) * D + 512 + h * 128;
            orow[lane] = (bf16)f2bf(a0 * r * ng[h * 128 + lane] * bf1(pr[lane])); orow[64 + lane] = (bf16)f2bf(a1 * r * ng[h * 128 + 64 + lane] * bf1(pr[64 + lane])); }
        __syncthreads();
    }
}

__device__ __forceinline__ void ld16bf(const bf16* p, float (&o)[16]) {
    const v4u w0 = *(const GAS v4u*)p, w1 = *(const GAS v4u*)(p + 8);
    o[0] = bflo(w0.x); o[1] = bfhi(w0.x); o[2] = bflo(w0.y); o[3] = bfhi(w0.y); o[4] = bflo(w0.z); o[5] = bfhi(w0.z); o[6] = bflo(w0.w); o[7] = bfhi(w0.w);
    o[8] = bflo(w1.x); o[9] = bfhi(w1.x); o[10] = bflo(w1.y); o[11] = bfhi(w1.y); o[12] = bflo(w1.z); o[13] = bfhi(w1.z); o[14] = bflo(w1.w); o[15] = bfhi(w1.w);
}
typedef short bf16x8 __attribute__((ext_vector_type(8)));
#define MFMA16(a, b, c) __builtin_amdgcn_mfma_f32_16x16x32_bf16((a), (b), (c), 0, 0, 0)
__device__ __forceinline__ bf16x8 ldfrag(LAS const unsigned char* img, int row, int kbyte) { return *(LAS const bf16x8*)(img + row * 144 + kbyte); }
__device__ __forceinline__ bf16x8 ldfrag_sw(LAS const unsigned char* img, int row, int kbyte) { return *(LAS const bf16x8*)(img + row * 144 + (kbyte ^ (((row >> 3) & 7) << 4))); }
__device__ __forceinline__ unsigned cvtpk(float lo, float hi) { unsigned r; asm volatile("v_cvt_pk_bf16_f32 %0, %1, %2" : "=v"(r) : "v"(lo), "v"(hi)); return r; }

namespace ml {
constexpr int O_Q = 0, O_QA = 9216, O_K = 18432, O_KWT = 27648, O_VT = 36864, O_CX = 57600, CXB = 20736, O_S = 99072, O_GB = 108288, O_GA = O_GB + 4096, O_GC = O_GA + 4096, O_DEN = O_GC + 4096, O_SSQ = O_DEN + 256, O_END = O_SSQ + 2048;
static_assert(O_END <= 131072, "mlstm LDS");
constexpr size_t MST_SC = 11 * MiB;
}
template <bool OUT>
__device__ __forceinline__ void mlstm_group(const Args& A, LAS unsigned char* lds, int wg) {
    using namespace ml;
    const int tid = threadIdx.x, lane = tid & 63, wave = __builtin_amdgcn_readfirstlane(tid >> 6), fr = lane & 15, fq = lane >> 4;
    const int bh = wg >> 3, grp = wg & 7, b = bh >> 2, h = bh & 3;
    const size_t tg0 = (size_t)b * SEQ + (size_t)grp * 1024;
    const bf16* P = (const bf16*)(A.ws + WS_PROJ); bf16* MI = (bf16*)(A.ws + WS_MIXIN); const float* gates = (const float*)(A.ws + WS_GATES);
    const float* cw = (const float*)A.in[I_CONVW]; const float* ng = (const float*)A.in[I_MNG];
    float* MST = (float*)(A.ws + WS_MST); float* MSC = (float*)(A.ws + WS_MST + MST_SC);
    LAS float* GB = (LAS float*)(lds + O_GB); LAS float* GA = (LAS float*)(lds + O_GA); LAS float* GC = (LAS float*)(lds + O_GC);
    LAS float* DEN = (LAS float*)(lds + O_DEN); LAS float* SSQ = (LAS float*)(lds + O_SSQ);
    __syncthreads();
#pragma unroll
    for (int cc = 0; cc < 2; ++cc) { const int c = 2 * wave + cc; const size_t t = tg0 + c * 64 + lane;
        float bc = gates[t * 8 + 4 + h]; const float ii = gates[t * 8 + h];
#pragma unroll
        for (int o = 1; o < 64; o <<= 1) { const float v = __shfl_up(bc, o); if (lane >= o) bc += v; }
        const float a = ii - bc; float cm = a;
#pragma unroll
        for (int o = 1; o < 64; o <<= 1) { const float v = __shfl_up(cm, o); if (lane >= o) cm = fmaxf(cm, v); }
        GB[c * 64 + lane] = bc; GA[c * 64 + lane] = a; GC[c * 64 + lane] = cm; }
    for (int e = tid; e < 16 * 32; e += NTHR) { const int r = e >> 5, cpair = e & 31; *(LAS unsigned*)(lds + O_VT + (128 + r) * 144 + cpair * 4) = (r == 0) ? 0x3F803F80u : 0u; }
    f32x4 st[5];
#pragma unroll
    for (int i = 0; i < 5; ++i) st[i] = (f32x4){0.f, 0.f, 0.f, 0.f};
    float m = OUT ? 0.f : -__builtin_inff(); float Btot = 0.f;
    if (OUT) {
        for (int gp = 0; gp < grp; ++gp) { const int wgp = bh * 8 + gp; const float mg = MSC[wgp * 2], Bg = MSC[wgp * 2 + 1];
            const float mn = fmaxf(Bg + m, mg), f0 = __expf(Bg + m - mn), f1 = __expf(mg - mn);
#pragma unroll
            for (int i = 0; i < 5; ++i)
#pragma unroll
                for (int r = 0; r < 4; ++r) st[i][r] = f0 * st[i][r] + f1 * MST[((size_t)wgp * 20 + i * 4 + r) * NTHR + tid];
            m = mn; }
#pragma unroll
        for (int j = 0; j < 4; ++j)
#pragma unroll
            for (int r = 0; r < 4; ++r) *(LAS bf16*)(lds + O_CX + (16 * wave + 4 * fq + r) * 144 + (16 * j + fr) * 2) = (bf16)f2bf(st[j][r]);
        if (wave < 4) {
#pragma unroll
            for (int r = 0; r < 4; ++r) *(LAS bf16*)(lds + O_CX + (128 + 4 * fq + r) * 144 + (16 * wave + fr) * 2) = (bf16)f2bf(st[4][r]); }
    }
    float gsc[4];
#pragma unroll
    for (int r = 0; r < 4; ++r) gsc[r] = ng[h * 128 + 16 * wave + 4 * fq + r];
    const int sl = tid >> 3, cg = tid & 7;
    __syncthreads();
    for (int c = 0; c < 16; ++c) {
        const float bL = GB[c * 64 + 63], M63 = fmaxf(m, GC[c * 64 + 63]), decay = __expf(m - M63);
        const size_t tc0 = tg0 + (size_t)c * 64;
        {
            const int sabs = grp * 1024 + c * 64 + sl;
            float aq[8], ak[8];
#pragma unroll
            for (int i = 0; i < 8; ++i) { aq[i] = 0.f; ak[i] = 0.f; }
#pragma unroll
            for (int j = 0; j < 4; ++j) { const int sj = sabs - 3 + j;
                if (sj >= 0) { const bf16* rp = P + ((size_t)b * SEQ + sj) * NPROJ;
                    const v4u wq = *(const GAS v4u*)(rp + C_MQ + h * 64 + 8 * cg), wk = *(const GAS v4u*)(rp + C_MK + h * 64 + 8 * cg);
                    const f32x4 q0 = *(const GAS f32x4*)(cw + j * 512 + h * 64 + 8 * cg), q1 = *(const GAS f32x4*)(cw + j * 512 + h * 64 + 8 * cg + 4);
                    const f32x4 k0 = *(const GAS f32x4*)(cw + j * 512 + 256 + h * 64 + 8 * cg), k1 = *(const GAS f32x4*)(cw + j * 512 + 256 + h * 64 + 8 * cg + 4);
                    aq[0] += q0[0] * bflo(wq.x); aq[1] += q0[1] * bfhi(wq.x); aq[2] += q0[2] * bflo(wq.y); aq[3] += q0[3] * bfhi(wq.y);
                    aq[4] += q1[0] * bflo(wq.z); aq[5] += q1[1] * bfhi(wq.z); aq[6] += q1[2] * bflo(wq.w); aq[7] += q1[3] * bfhi(wq.w);
                    ak[0] += k0[0] * bflo(wk.x); ak[1] += k0[1] * bfhi(wk.x); ak[2] += k0[2] * bflo(wk.y); ak[3] += k0[3] * bfhi(wk.y);
                    ak[4] += k1[0] * bflo(wk.z); ak[5] += k1[1] * bfhi(wk.z); ak[6] += k1[2] * bflo(wk.w); ak[7] += k1[3] * bfhi(wk.w); } }
            const float Ml = fmaxf(m, GC[c * 64 + sl]), ainter = __expf(m - Ml), wsv = __expf(GA[c * 64 + sl] - M63);
            float qv[8], kv[8];
#pragma unroll
            for (int i = 0; i < 8; ++i) { qv[i] = 0.125f * aq[i] * __builtin_amdgcn_rcpf(1.f + __expf(-aq[i])); kv[i] = ak[i] * __builtin_amdgcn_rcpf(1.f + __expf(-ak[i])); }
            if (OUT) {
                v4u w; w.x = pk2(qv[0], qv[1]); w.y = pk2(qv[2], qv[3]); w.z = pk2(qv[4], qv[5]); w.w = pk2(qv[6], qv[7]); *(LAS v4u*)(lds + O_Q + sl * 144 + cg * 16) = w;
                w.x = pk2(qv[0] * ainter, qv[1] * ainter); w.y = pk2(qv[2] * ainter, qv[3] * ainter); w.z = pk2(qv[4] * ainter, qv[5] * ainter); w.w = pk2(qv[6] * ainter, qv[7] * ainter); *(LAS v4u*)(lds + O_QA + sl * 144 + cg * 16) = w;
                w.x = pk2(kv[0], kv[1]); w.y = pk2(kv[2], kv[3]); w.z = pk2(kv[4], kv[5]); w.w = pk2(kv[6], kv[7]); *(LAS v4u*)(lds + O_K + sl * 144 + cg * 16) = w;
            }
#pragma unroll
            for (int i = 0; i < 8; ++i) *(LAS bf16*)(lds + O_KWT + (8 * cg + i) * 144 + (sl ^ (8 * cg)) * 2) = (bf16)f2bf(kv[i] * wsv);
#pragma unroll
            for (int gi = 0; gi < 2; ++gi) { const int g8 = cg + 8 * gi; const v4u wv = *(const GAS v4u*)(P + (tc0 + sl) * NPROJ + C_MV + h * 128 + 8 * g8);
                const unsigned ww[4] = {wv.x, wv.y, wv.z, wv.w};
#pragma unroll
                for (int i = 0; i < 4; ++i) { *(LAS bf16*)(lds + O_VT + (8 * g8 + 2 * i) * 144 + (sl ^ (8 * cg)) * 2) = (bf16)(ww[i] & 0xffffu); *(LAS bf16*)(lds + O_VT + (8 * g8 + 2 * i + 1) * 144 + (sl ^ (8 * cg)) * 2) = (bf16)(ww[i] >> 16); } }
        }
        __syncthreads();
        v2u mo[4];
        if (OUT) {
#pragma unroll
            for (int lt = 0; lt < 4; ++lt) mo[lt] = *(const GAS v2u*)(P + (tc0 + 16 * lt + fr) * NPROJ + C_MO + h * 128 + 16 * wave + 4 * fq); }
        if (OUT) {
            const int lt = wave >> 1, l = 16 * lt + fr; const float Ml = fmaxf(m, GC[c * 64 + l]);
            const bf16x8 bq0 = ldfrag(lds + O_Q, 16 * lt + fr, 16 * fq), bq1 = ldfrag(lds + O_Q, 16 * lt + fr, 64 + 16 * fq);
#pragma unroll
            for (int u = 0; u < 2; ++u) { const int stl = 2 * (wave & 1) + u; f32x4 acc = {0.f, 0.f, 0.f, 0.f};
                acc = MFMA16(ldfrag(lds + O_K, 16 * stl + fr, 16 * fq), bq0, acc); acc = MFMA16(ldfrag(lds + O_K, 16 * stl + fr, 64 + 16 * fq), bq1, acc);
                const f32x4 av = *(LAS const f32x4*)(GA + c * 64 + 16 * stl + 4 * fq); float wv[4];
#pragma unroll
                for (int r = 0; r < 4; ++r) { const int s = 16 * stl + 4 * fq + r; wv[r] = (s <= l) ? acc[r] * __expf(av[r] - Ml) : 0.f; }
                v2u w; w.x = cvtpk(wv[0], wv[1]); w.y = cvtpk(wv[2], wv[3]); *(LAS v2u*)(lds + O_S + l * 144 + (16 * stl + 4 * fq) * 2) = w; }
        }
        {
            const bf16x8 va0 = ldfrag_sw(lds + O_VT, 16 * wave + fr, 16 * fq), va1 = ldfrag_sw(lds + O_VT, 16 * wave + fr, 64 + 16 * fq);
#pragma unroll
            for (int j = 0; j < 4; ++j) { st[j] = st[j] * decay;
                st[j] = MFMA16(va0, ldfrag_sw(lds + O_KWT, 16 * j + fr, 16 * fq), st[j]); st[j] = MFMA16(va1, ldfrag_sw(lds + O_KWT, 16 * j + fr, 64 + 16 * fq), st[j]); }
            if (wave < 4) { st[4] = st[4] * decay;
                st[4] = MFMA16(ldfrag_sw(lds + O_VT, 128 + fr, 16 * fq), ldfrag_sw(lds + O_KWT, 16 * wave + fr, 16 * fq), st[4]);
                st[4] = MFMA16(ldfrag_sw(lds + O_VT, 128 + fr, 64 + 16 * fq), ldfrag_sw(lds + O_KWT, 16 * wave + fr, 64 + 16 * fq), st[4]); }
        }
        if (OUT) {
            __syncthreads();
            LAS const unsigned char* cx = lds + O_CX + (c & 1) * CXB;
            f32x4 nt[4], nd = {0.f, 0.f, 0.f, 0.f};
            {
                const bf16x8 va0 = ldfrag_sw(lds + O_VT, 16 * wave + fr, 16 * fq), va1 = ldfrag_sw(lds + O_VT, 16 * wave + fr, 64 + 16 * fq);
                const bf16x8 ca0 = ldfrag(cx, 16 * wave + fr, 16 * fq), ca1 = ldfrag(cx, 16 * wave + fr, 64 + 16 * fq);
#pragma unroll
                for (int lt = 0; lt < 4; ++lt) { f32x4 acc = {0.f, 0.f, 0.f, 0.f};
                    acc = MFMA16(va0, ldfrag(lds + O_S, 16 * lt + fr, 16 * fq), acc); acc = MFMA16(va1, ldfrag(lds + O_S, 16 * lt + fr, 64 + 16 * fq), acc);
                    acc = MFMA16(ca0, ldfrag(lds + O_QA, 16 * lt + fr, 16 * fq), acc); acc = MFMA16(ca1, ldfrag(lds + O_QA, 16 * lt + fr, 64 + 16 * fq), acc); nt[lt] = acc; }
                if (wave >= 4) { const int lt = wave - 4;
                    nd = MFMA16(ldfrag_sw(lds + O_VT, 128 + fr, 16 * fq), ldfrag(lds + O_S, 16 * lt + fr, 16 * fq), nd); nd = MFMA16(ldfrag_sw(lds + O_VT, 128 + fr, 64 + 16 * fq), ldfrag(lds + O_S, 16 * lt + fr, 64 + 16 * fq), nd);
                    nd = MFMA16(ldfrag(cx, 128 + fr, 16 * fq), ldfrag(lds + O_QA, 16 * lt + fr, 16 * fq), nd); nd = MFMA16(ldfrag(cx, 128 + fr, 64 + 16 * fq), ldfrag(lds + O_QA, 16 * lt + fr, 64 + 16 * fq), nd);
                    if (fq == 0) DEN[16 * lt + fr] = nd[0]; }
            }
            __syncthreads();
#pragma unroll
            for (int lt = 0; lt < 4; ++lt) { const int l = 16 * lt + fr; const float Ml = fmaxf(m, GC[c * 64 + l]);
                const float inv = 1.0f / fmaxf(fabsf(DEN[l]), __expf(-(GB[c * 64 + l] + Ml)));
                nt[lt] = nt[lt] * inv; float ss = (nt[lt][0] * nt[lt][0] + nt[lt][1] * nt[lt][1]) + (nt[lt][2] * nt[lt][2] + nt[lt][3] * nt[lt][3]);
                ss += __shfl_xor(ss, 16); ss += __shfl_xor(ss, 32);
                if (fq == 0) SSQ[wave * 64 + l] = ss; }
            LAS unsigned char* cxn = lds + O_CX + ((c + 1) & 1) * CXB;
#pragma unroll
            for (int j = 0; j < 4; ++j)
#pragma unroll
                for (int r = 0; r < 4; ++r) *(LAS bf16*)(cxn + (16 * wave + 4 * fq + r) * 144 + (16 * j + fr) * 2) = (bf16)f2bf(st[j][r]);
            if (wave < 4) {
#pragma unroll
                for (int r = 0; r < 4; ++r) *(LAS bf16*)(cxn + (128 + 4 * fq + r) * 144 + (16 * wave + fr) * 2) = (bf16)f2bf(st[4][r]); }
            __syncthreads();
#pragma unroll
            for (int lt = 0; lt < 4; ++lt) { const int l = 16 * lt + fr; float tot = 0.f;
#pragma unroll
                for (int w2 = 0; w2 < 8; ++w2) tot += SSQ[w2 * 64 + l];
                const float rn = 1.0f / sqrtf(tot * (1.f / 128.f) + EPS);
                const float o0 = nt[lt][0] * rn * gsc[0] * bflo(mo[lt].x), o1 = nt[lt][1] * rn * gsc[1] * bfhi(mo[lt].x), o2 = nt[lt][2] * rn * gsc[2] * bflo(mo[lt].y), o3 = nt[lt][3] * rn * gsc[3] * bfhi(mo[lt].y);
                v2u w; w.x = pk2(o0, o1); w.y = pk2(o2, o3);
                *(GAS v2u*)(MI + (tc0 + l) * D + 512 + h * 128 + 16 * wave + 4 * fq) = w; }
        } else {
            __syncthreads();
        }
        m = bL + M63; Btot += bL;
    }
    if (!OUT) {
#pragma unroll
        for (int i = 0; i < 5; ++i)
#pragma unroll
            for (int r = 0; r < 4; ++r) MST[((size_t)wg * 20 + i * 4 + r) * NTHR + tid] = st[i][r];
        if (tid == 0) { MSC[wg * 2] = m; MSC[wg * 2 + 1] = Btot; }
    }
}

namespace at {
constexpr int O_K = 0, O_VT = 36864, VTS = 592  , O_END = O_VT + 64 * VTS;
static_assert(O_END <= 131072, "attention LDS");
}
__device__ __forceinline__ void phase_attn(const Args& A, LAS unsigned char* lds) {
    using namespace at;
    const int tid = threadIdx.x, lane = tid & 63, wave = __builtin_amdgcn_readfirstlane(tid >> 6), fr = lane & 15, fq = lane >> 4, G = gridDim.x;
    const bf16* P = (const bf16*)(A.ws + WS_PROJ); bf16* MI = (bf16*)(A.ws + WS_MIXIN); const float* sinks = (const float*)A.in[I_SINK];
    __syncthreads();
    for (int e = tid; e < 64 * 16; e += NTHR) { const int r = e >> 4, cpair = e & 15; *(LAS unsigned*)(lds + O_VT + r * VTS + 512 + cpair * 4) = 0u; }
    v4u pk_[4], pv_[4];
#define ATT_LOAD(uu) do { const int g_ = (uu) & 1, n_ = ((uu) >> 1) & 63, b_ = (uu) >> 7; const size_t tq_ = (size_t)b_ * SEQ + (size_t)n_ * 128; _Pragma("unroll") for (int i_ = 0; i_ < 4; ++i_) { const int item_ = tid + NTHR * i_, row_ = item_ >> 3, ch_ = item_ & 7; \
        pk_[i_] = (v4u){0u, 0u, 0u, 0u}; pv_[i_] = (v4u){0u, 0u, 0u, 0u}; if (n_ > 0 || row_ >= 128) { const bf16* rp_ = P + (tq_ - 128 + row_) * NPROJ; pk_[i_] = *(const GAS v4u*)(rp_ + C_AK + g_ * 64 + 8 * ch_); pv_[i_] = *(const GAS v4u*)(rp_ + C_AV + g_ * 64 + 8 * ch_); } } } while (0)
    if ((int)blockIdx.x < NB * 64 * 2) ATT_LOAD((int)blockIdx.x);
    for (int unit = blockIdx.x; unit < NB * 64 * 2; unit += G) {
        const int g = unit & 1, n = (unit >> 1) & 63, b = unit >> 7;
        const size_t tq0 = (size_t)b * SEQ + (size_t)n * 128;
        __syncthreads();
#pragma unroll
        for (int i = 0; i < 4; ++i) { const int item = tid + NTHR * i, row = item >> 3, ch = item & 7;
            const v4u wk = pk_[i], wv = pv_[i];
            *(LAS v4u*)(lds + O_K + row * 144 + ch * 16) = wk;
            const unsigned ww[4] = {wv.x, wv.y, wv.z, wv.w};
#pragma unroll
            for (int k = 0; k < 4; ++k) { *(LAS bf16*)(lds + O_VT + (8 * ch + 2 * k) * VTS + (row ^ (4 * ch)) * 2) = (bf16)(ww[k] & 0xffffu); *(LAS bf16*)(lds + O_VT + (8 * ch + 2 * k + 1) * VTS + (row ^ (4 * ch)) * 2) = (bf16)(ww[k] >> 16); } }
        if (unit + G < NB * 64 * 2) ATT_LOAD(unit + G);
        const int hq = 4 * g + (wave >> 1), qr0 = 64 * (wave & 1); const float sink = sinks[hq];
        __syncthreads();
        for (int qt = 0; qt < 4; ++qt) {
            const int i0 = qr0 + 16 * qt, st0 = i0 >> 4, iq = i0 + fr;
            const bf16* qp = P + (tq0 + iq) * NPROJ + C_AQ + hq * 64 + 8 * fq;
            const bf16x8 bq0 = *(const GAS bf16x8*)qp, bq1 = *(const GAS bf16x8*)(qp + 32);
            f32x4 sc[9]; float mx = sink;
#pragma unroll
            for (int t = 0; t < 9; ++t) { const int sb0 = 16 * (st0 + t); f32x4 acc = {0.f, 0.f, 0.f, 0.f};
                acc = MFMA16(ldfrag(lds + O_K, sb0 + fr, 16 * fq), bq0, acc); acc = MFMA16(ldfrag(lds + O_K, sb0 + fr, 64 + 16 * fq), bq1, acc);
#pragma unroll
                for (int r = 0; r < 4; ++r) { const int sb = sb0 + 4 * fq + r; const bool valid = (sb > iq) && (sb <= iq + 128) && (n > 0 || sb >= 128);
                    acc[r] = valid ? acc[r] : -3.0e38f; mx = fmaxf(mx, acc[r]); }
                sc[t] = acc; }
            mx = fmaxf(mx, __shfl_xor(mx, 16)); mx = fmaxf(mx, __shfl_xor(mx, 32));
            float lsum = 0.f;
#pragma unroll
            for (int t = 0; t < 9; ++t)
#pragma unroll
                for (int r = 0; r < 4; ++r) { const float p = (sc[t][r] > -1.0e38f) ? __expf(sc[t][r] - mx) : 0.f; sc[t][r] = p; lsum += p; }
            lsum += __shfl_xor(lsum, 16); lsum += __shfl_xor(lsum, 32); lsum += __expf(sink - mx);
            f32x4 oacc[4];
#pragma unroll
            for (int dt = 0; dt < 4; ++dt) oacc[dt] = (f32x4){0.f, 0.f, 0.f, 0.f};
#pragma unroll
            for (int ks = 0; ks < 5; ++ks) {
                union { bf16x8 v; unsigned u[4]; } pb;
                pb.u[0] = cvtpk(sc[2 * ks][0], sc[2 * ks][1]); pb.u[1] = cvtpk(sc[2 * ks][2], sc[2 * ks][3]);
                if (ks < 4) { pb.u[2] = cvtpk(sc[2 * ks + 1][0], sc[2 * ks + 1][1]); pb.u[3] = cvtpk(sc[2 * ks + 1][2], sc[2 * ks + 1][3]); } else { pb.u[2] = 0u; pb.u[3] = 0u; }
                const int sbb = 16 * (st0 + 2 * ks) + 4 * fq;
#pragma unroll
                for (int dt = 0; dt < 4; ++dt) { const int dd = 16 * dt + fr, sx = 4 * ((dd >> 3) & 7); LAS const unsigned char* vrow = lds + O_VT + dd * VTS;
                    union { bf16x8 v; v2u h[2]; } va; va.h[0] = *(LAS const v2u*)(vrow + (sbb ^ sx) * 2); va.h[1] = *(LAS const v2u*)(vrow + ((sbb + 16) ^ sx) * 2);
                    oacc[dt] = MFMA16(va.v, pb.v, oacc[dt]); } }
            const float il = 1.0f / lsum;
#pragma unroll
            for (int dt = 0; dt < 4; ++dt) { v2u w; w.x = pk2(oacc[dt][0] * il, oacc[dt][1] * il); w.y = pk2(oacc[dt][2] * il, oacc[dt][3] * il);
                *(GAS v2u*)(MI + (tq0 + iq) * D + hq * 64 + 16 * dt + 4 * fq) = w; }
        }
    }
#undef ATT_LOAD
}
typedef float f32x16 __attribute__((ext_vector_type(16)));
__device__ __forceinline__ unsigned fbits(float f) { return __builtin_bit_cast(unsigned, f); }
__device__ __forceinline__ float bfloat(unsigned u) { return __builtin_bit_cast(float, u); }

#define CE_DESC(a, b) do { const float _mx = __builtin_fmaxf(a, b), _mn = __builtin_fminf(a, b); a = _mx; b = _mn; } while (0)
__device__ __forceinline__ void bsort16(float (&v)[16]) {
#pragma unroll
    for (int k = 2; k <= 16; k <<= 1)
#pragma unroll
        for (int j = k >> 1; j > 0; j >>= 1)
#pragma unroll
            for (int i = 0; i < 16; ++i) { const int l = i ^ j; if (l > i) { if ((i & k) == 0) CE_DESC(v[i], v[l]); else CE_DESC(v[l], v[i]); } }
}
__device__ __forceinline__ void bmerge16(float (&v)[16], const float (&w)[16]) {
#pragma unroll
    for (int i = 0; i < 16; ++i) v[i] = __builtin_fmaxf(v[i], w[15 - i]);
#pragma unroll
    for (int j = 8; j > 0; j >>= 1)
#pragma unroll
        for (int i = 0; i < 16; ++i) { const int l = i ^ j; if (l > i) CE_DESC(v[i], v[l]); }
}
namespace tk {
constexpr int KS = 272;
constexpr int O_K1 = 0, O_K2 = 128 * KS, O_X = 2 * 128 * KS, O_END = O_X + 8 * 4096;
static_assert(O_END <= 131072, "topk LDS");
constexpr unsigned char CAND[64] = {
    0x00, 0x01, 0x02, 0x03, 0x04, 0x05, 0x06, 0x07, 0x08, 0x09, 0x0a, 0x0b, 0x0c, 0x0d, 0x0e, 0x0f,
    0x10, 0x11, 0x12, 0x13, 0x14, 0x15, 0x16, 0x17, 0x80, 0x90, 0xa0, 0xb0, 0xc0, 0xd0, 0xe0, 0xf0,
    0x20, 0x21, 0x22, 0x23, 0x24, 0x30, 0x31, 0x32, 0x33, 0x40, 0x41, 0x42, 0x50, 0x51, 0x60, 0x61,
    0x70, 0x71, 0xff, 0xff, 0xff, 0xff, 0xff, 0xff, 0xff, 0xff, 0xff, 0xff, 0xff, 0xff, 0xff, 0xff};
}
__device__ __forceinline__ void side_top16(const f32x16 (&acc)[4], int hh, float (&T)[16]) {
    float g1[16], g2[16];
#pragma unroll
    for (int r = 0; r < 16; ++r) { const unsigned key = (r & 3) + 8 * (r >> 2) + 4 * hh;
        T[r] = bfloat((fbits(acc[0][r]) & 0xffffff80u) | key);
        g1[r] = bfloat((fbits(acc[1][r]) & 0xffffff80u) | (32u + key)); }
    bsort16(T); bsort16(g1); bmerge16(T, g1);
#pragma unroll
    for (int r = 0; r < 16; ++r) { const unsigned key = (r & 3) + 8 * (r >> 2) + 4 * hh;
        g1[r] = bfloat((fbits(acc[2][r]) & 0xffffff80u) | (64u + key));
        g2[r] = bfloat((fbits(acc[3][r]) & 0xffffff80u) | (96u + key)); }
    bsort16(g1); bsort16(g2); bmerge16(g1, g2); bmerge16(T, g1);
#pragma unroll
    for (int r = 0; r < 16; ++r) g1[r] = __shfl_xor(T[r], 32);
    bmerge16(T, g1);
}
struct TopkQ { bf16x8 f[8]; };
template <int SD> __device__ __forceinline__ void topk_ldq(const bf16* Q, int t, int h, int hh, TopkQ& q) {
    const bf16* qp = Q + (size_t)t * 2048 + h * 256 + SD * 128 + 8 * hh;
#pragma unroll
    for (int ks = 0; ks < 8; ++ks) q.f[ks] = *(const GAS bf16x8*)(qp + 16 * ks);
}
template <int SD> __device__ __forceinline__ void topk_scores(const TopkQ& q, LAS unsigned char* lds, int r32, int hh, f32x16 (&acc)[4]) {
    using namespace tk;
#pragma unroll
    for (int mt = 0; mt < 4; ++mt)
#pragma unroll
        for (int r = 0; r < 16; ++r) acc[mt][r] = 0.f;
    LAS const unsigned char* kimg = lds + (SD ? O_K2 : O_K1);
#pragma unroll
    for (int ks = 0; ks < 8; ++ks) {
#pragma unroll
        for (int mt = 0; mt < 4; ++mt) acc[mt] = __builtin_amdgcn_mfma_f32_32x32x16_bf16(*(LAS const bf16x8*)(kimg + (32 * mt + r32) * KS + 32 * ks + 16 * hh), q.f[ks], acc[mt], 0, 0, 0); }
}
template <int Q> __device__ __forceinline__ float cand_val(const float (&T1)[16], const float (&T2)[16], int hh) {
    constexpr unsigned c0 = tk::CAND[2 * Q], c1 = tk::CAND[2 * Q + 1];
    const float s = (hh ? T1[(c1 >> 4) & 15] : T1[(c0 >> 4) & 15]) + (hh ? T2[c1 & 15] : T2[c0 & 15]); const unsigned code = hh ? c1 : c0;
    return (code == 0xffu) ? -3.0e38f : bfloat((fbits(s) & 0xffffff00u) | code);
}
__device__ __forceinline__ void phase_topk(const Args& A, LAS unsigned char* lds) {
    using namespace tk;
    const int tid = threadIdx.x, lane = tid & 63, wave = __builtin_amdgcn_readfirstlane(tid >> 6), G = gridDim.x;
    const bf16* Q = (const bf16*)(A.ws + WS_PROJ); const bf16* KB = (const bf16*)(A.ws + WS_KEYS);
    unsigned short* EI = (unsigned short*)(A.ws + WS_EIDX); float* GT = (float*)(A.ws + WS_GATE);
    const int h = blockIdx.x & 7, r32 = lane & 31, hh = lane >> 5;
    __syncthreads();
    for (int e = tid; e < 2 * 128 * 16; e += NTHR) { const int s = e >> 11, row = (e >> 4) & 127, ch = e & 15;
        *(LAS v4u*)(lds + (s ? O_K2 : O_K1) + row * KS + ch * 16) = *(const GAS v4u*)(KB + (size_t)s * 8 * 128 * 128 + ((size_t)h * 128 + row) * 128 + ch * 8); }
    __syncthreads();
    LAS float* XW = (LAS float*)(lds + O_X + wave * 4096) + r32 * 32;
    TopkQ qf; topk_ldq<0>(Q, (int)(blockIdx.x >> 3) * 256 + 32 * wave + r32, h, hh, qf);
    for (int tile = (int)(blockIdx.x >> 3); tile < M / 256; tile += (G >> 3)) {
        const int t = tile * 256 + 32 * wave + r32;
        float T1[16], T2[16];
        { f32x16 acc[4]; topk_scores<0>(qf, lds, r32, hh, acc);
          topk_ldq<1>(Q, t, h, hh, qf);
          side_top16(acc, hh, T1); }
        { f32x16 acc[4]; topk_scores<1>(qf, lds, r32, hh, acc);
          const int tn = min(tile + (int)(G >> 3), M / 256 - 1) * 256 + 32 * wave + r32; topk_ldq<0>(Q, tn, h, hh, qf);
          side_top16(acc, hh, T2); }
        float c[16], w[16];
        c[0] = cand_val<0>(T1, T2, hh); w[0] = cand_val<16>(T1, T2, hh);
        c[1] = cand_val<1>(T1, T2, hh); w[1] = cand_val<17>(T1, T2, hh);
        c[2] = cand_val<2>(T1, T2, hh); w[2] = cand_val<18>(T1, T2, hh);
        c[3] = cand_val<3>(T1, T2, hh); w[3] = cand_val<19>(T1, T2, hh);
        c[4] = cand_val<4>(T1, T2, hh); w[4] = cand_val<20>(T1, T2, hh);
        c[5] = cand_val<5>(T1, T2, hh); w[5] = cand_val<21>(T1, T2, hh);
        c[6] = cand_val<6>(T1, T2, hh); w[6] = cand_val<22>(T1, T2, hh);
        c[7] = cand_val<7>(T1, T2, hh); w[7] = cand_val<23>(T1, T2, hh);
        c[8] = cand_val<8>(T1, T2, hh); w[8] = cand_val<24>(T1, T2, hh);
        c[9] = cand_val<9>(T1, T2, hh); w[9] = cand_val<25>(T1, T2, hh);
        c[10] = cand_val<10>(T1, T2, hh); w[10] = cand_val<26>(T1, T2, hh);
        c[11] = cand_val<11>(T1, T2, hh); w[11] = cand_val<27>(T1, T2, hh);
        c[12] = cand_val<12>(T1, T2, hh); w[12] = cand_val<28>(T1, T2, hh);
        c[13] = cand_val<13>(T1, T2, hh); w[13] = cand_val<29>(T1, T2, hh);
        c[14] = cand_val<14>(T1, T2, hh); w[14] = cand_val<30>(T1, T2, hh);
        c[15] = cand_val<15>(T1, T2, hh); w[15] = cand_val<31>(T1, T2, hh);
        bsort16(c); bsort16(w); bmerge16(c, w);
#pragma unroll
        for (int r = 0; r < 16; ++r) w[r] = __shfl_xor(c[r], 32);
        bmerge16(c, w);
        if (hh == 0) {
#pragma unroll
            for (int q4 = 0; q4 < 4; ++q4) { *(LAS f32x4*)(XW + 4 * q4) = (f32x4){T1[4 * q4], T1[4 * q4 + 1], T1[4 * q4 + 2], T1[4 * q4 + 3]};
                *(LAS f32x4*)(XW + 16 + 4 * q4) = (f32x4){T2[4 * q4], T2[4 * q4 + 1], T2[4 * q4 + 2], T2[4 * q4 + 3]}; } }
        asm volatile("s_waitcnt lgkmcnt(0)" ::: "memory");
        float ex[16], sum = 0.f; const float tmax = bfloat(fbits(c[0]) & 0xffffff00u);
#pragma unroll
        for (int r = 0; r < 16; ++r) { ex[r] = __expf(bfloat(fbits(c[r]) & 0xffffff00u) - tmax); sum += ex[r]; }
        const float isum = 1.0f / sum; const size_t ob = (size_t)t * NSLOT + (size_t)(8 * hh) * 8 + h;
#pragma unroll
        for (int r = 0; r < 8; ++r) { float ca = c[r], cb = c[8 + r], ea = ex[r], eb = ex[8 + r]; asm volatile("" : "+v"(ca), "+v"(cb), "+v"(ea), "+v"(eb)); const float cv = hh ? cb : ca, ev = hh ? eb : ea;
            const unsigned code = fbits(cv) & 0xffu;
            const unsigned i1 = fbits(XW[code >> 4]) & 127u, i2 = fbits(XW[16 + (code & 15)]) & 127u;
            EI[ob + 8 * r] = (unsigned short)(i1 * 128u + i2); GT[ob + 8 * r] = ev * isum; }
        asm volatile("s_waitcnt lgkmcnt(0)" ::: "memory");
    }
}
struct PeerIdx { v4u e0, e1; };
__device__ __forceinline__ PeerIdx peer_ld_idx(const unsigned short* EI, int t, int g) { PeerIdx r; r.e0 = *(const GAS v4u*)(EI + (size_t)t * NSLOT + 16 * g); r.e1 = *(const GAS v4u*)(EI + (size_t)t * NSLOT + 16 * g + 8); return r; }
template <int ROWB = 1024> __device__ __forceinline__ void peer_gather(const unsigned char* T8, const PeerIdx& ix, int colb, v4u (&raw)[16]) {
    const unsigned ew[8] = {ix.e0.x, ix.e0.y, ix.e0.z, ix.e0.w, ix.e1.x, ix.e1.y, ix.e1.z, ix.e1.w};
#pragma unroll
    for (int k = 0; k < 16; ++k) { const unsigned e = (k & 1) ? (ew[k >> 1] >> 16) : (ew[k >> 1] & 0xffffu); raw[k] = *(const GAS v4u*)((const GAS unsigned char*)T8 + (unsigned)(e * (unsigned)ROWB + (unsigned)colb)); }
}
__device__ __forceinline__ void cvt16_fp8_pk(const v4u w, f32x2 (&o)[8]) {
    const unsigned ww[4] = {w.x, w.y, w.z, w.w};
#pragma unroll
    for (int i = 0; i < 4; ++i) { o[2 * i] = __builtin_amdgcn_cvt_pk_f32_fp8((int)ww[i], false); o[2 * i + 1] = __builtin_amdgcn_cvt_pk_f32_fp8((int)ww[i], true); }
}
__device__ __forceinline__ void peer_u_reduce(const v4u (&raw)[16], const f32x2 (&hv)[8], float* PDrow, int lane, int g, int c) {
    float d[16];
#pragma unroll
    for (int k = 0; k < 16; ++k) { f32x2 uf[8]; cvt16_fp8_pk(raw[k], uf); f32x2 s = uf[0] * hv[0];
#pragma unroll
        for (int i = 1; i < 8; ++i) s += uf[i] * hv[i];
        d[k] = s.x + s.y; }
#pragma unroll
    for (int i = 0; i < 8; ++i) { const bool up = (lane & 4) != 0; const float keep = up ? d[i + 8] : d[i], send = up ? d[i] : d[i + 8]; d[i] = keep + __shfl_xor(send, 4); }
#pragma unroll
    for (int i = 0; i < 4; ++i) { const bool up = (lane & 2) != 0; const float keep = up ? d[i + 4] : d[i], send = up ? d[i] : d[i + 4]; d[i] = keep + __shfl_xor(send, 2); }
#pragma unroll
    for (int i = 0; i < 2; ++i) { const bool up = (lane & 1) != 0; const float keep = up ? d[i + 2] : d[i], send = up ? d[i] : d[i + 2]; d[i] = keep + __shfl_xor(send, 1); }
    *(GAS f32x2*)(PDrow + 16 * g + 2 * c) = (f32x2){d[0], d[1]};
}
__device__ __forceinline__ void ld16bf_pk(const bf16* p, f32x2 (&o)[8]) {
    const v4u w0 = *(const GAS v4u*)p, w1 = *(const GAS v4u*)(p + 8); const unsigned ww[8] = {w0.x, w0.y, w0.z, w0.w, w1.x, w1.y, w1.z, w1.w};
#pragma unroll
    for (int i = 0; i < 8; ++i) o[i] = (f32x2){bflo(ww[i]), bfhi(ww[i])};
}
__device__ __forceinline__ void peer_u_reduce_i4(const v4u (&raw)[16], const v4u hh, const v4u hl, int* PDrow, int lane, int g, int c) {
    int d[16];
#pragma unroll
    for (int k = 0; k < 16; ++k) { int sh = __builtin_amdgcn_sdot8((int)raw[k].x, (int)hh.x, 0, false), sl = __builtin_amdgcn_sdot8((int)raw[k].x, (int)hl.x, 0, false);
        sh = __builtin_amdgcn_sdot8((int)raw[k].y, (int)hh.y, sh, false); sl = __builtin_amdgcn_sdot8((int)raw[k].y, (int)hl.y, sl, false);
        sh = __builtin_amdgcn_sdot8((int)raw[k].z, (int)hh.z, sh, false); sl = __builtin_amdgcn_sdot8((int)raw[k].z, (int)hl.z, sl, false);
        sh = __builtin_amdgcn_sdot8((int)raw[k].w, (int)hh.w, sh, false); sl = __builtin_amdgcn_sdot8((int)raw[k].w, (int)hl.w, sl, false);
        d[k] = 16 * sh + sl; }
#pragma unroll
    for (int i = 0; i < 8; ++i) { const bool up = (lane & 4) != 0; const int keep = up ? d[i + 8] : d[i], send = up ? d[i] : d[i + 8]; d[i] = keep + __shfl_xor(send, 4); }
#pragma unroll
    for (int i = 0; i < 4; ++i) { const bool up = (lane & 2) != 0; const int keep = up ? d[i + 4] : d[i], send = up ? d[i] : d[i + 4]; d[i] = keep + __shfl_xor(send, 2); }
#pragma unroll
    for (int i = 0; i < 2; ++i) { const bool up = (lane & 1) != 0; const int keep = up ? d[i + 2] : d[i], send = up ? d[i] : d[i + 2]; d[i] = keep + __shfl_xor(send, 1); }
    *(GAS v2u*)(PDrow + 16 * g + 2 * c) = (v2u){(unsigned)d[0], (unsigned)d[1]};
}
__device__ __forceinline__ void phase_peer_u(const Args& A, int part, int w0, int nw) {
    const int tid = threadIdx.x, lane = tid & 63, wave = (tid >> 6) - w0, p = blockIdx.x & 7, q = p & 3, half = p >> 2, j = blockIdx.x >> 3, nj = gridDim.x >> 3, g = lane >> 3, c = lane & 7;
    if (wave < 0 || wave >= nw) return;
    const unsigned char* HH = (const unsigned char*)(A.ws + WS_H8); const unsigned char* HL = HH + 32 * MiB; const unsigned char* U4 = (const unsigned char*)(A.ws + WS_U8); const unsigned short* EI = (const unsigned short*)(A.ws + WS_EIDX);
    int* PD = (int*)(A.ws + WS_PD) + (size_t)q * M * NSLOT;
    const int tper = (M / 2) / nj / 2, colb = 128 * q + 16 * c, tbeg = half * (M / 2) + (2 * j + part) * tper, tend = tbeg + tper, tlast = tend - nw + wave;
    const int NWAVES = nw;
    int t = tbeg + wave;
    PeerIdx ix1 = peer_ld_idx(EI, min(t + NWAVES, tlast), g), ix2 = peer_ld_idx(EI, min(t + 2 * NWAVES, tlast), g);
    v4u rawa[16], rawb[16], hha, hla, hhb, hlb;
    { const PeerIdx ix0 = peer_ld_idx(EI, t, g); peer_gather<512>(U4, ix0, colb, rawa); hha = *(const GAS v4u*)(HH + (size_t)t * 512 + colb); hla = *(const GAS v4u*)(HL + (size_t)t * 512 + colb); }
    for (; t < tend; t += 2 * NWAVES) {
        const int t1 = t + NWAVES, t2 = min(t + 2 * NWAVES, tlast), t3 = min(t + 3 * NWAVES, tlast), t4 = min(t + 4 * NWAVES, tlast);
        const PeerIdx ix3 = peer_ld_idx(EI, t3, g);
        peer_gather<512>(U4, ix1, colb, rawb); hhb = *(const GAS v4u*)(HH + (size_t)t1 * 512 + colb); hlb = *(const GAS v4u*)(HL + (size_t)t1 * 512 + colb);
        peer_u_reduce_i4(rawa, hha, hla, PD + (size_t)t * NSLOT, lane, g, c);
        const PeerIdx ix4 = peer_ld_idx(EI, t4, g);
        peer_gather<512>(U4, ix2, colb, rawa); hha = *(const GAS v4u*)(HH + (size_t)t2 * 512 + colb); hla = *(const GAS v4u*)(HL + (size_t)t2 * 512 + colb);
        peer_u_reduce_i4(rawb, hhb, hlb, PD + (size_t)t1 * NSLOT, lane, g, c);
        ix1 = ix3; ix2 = ix4;
    }
}
__device__ __forceinline__ void phase_peer_act(const Args& A, int part) {
    const int* PD = (const int*)(A.ws + WS_PD); const unsigned short* EI = (const unsigned short*)(A.ws + WS_EIDX); const float* GT = (const float*)(A.ws + WS_GATE);
    const float* usc = (const float*)(A.ws + WS_SC); const float* vsc = usc + NEXP; const float* hs = (const float*)(A.ws + WS_HS); float* ACT = (float*)(A.ws + WS_ACT);
    typedef int i32x4 __attribute__((ext_vector_type(4)));
    for (size_t i0 = ((size_t)blockIdx.x * NTHR + threadIdx.x) * 4; i0 < (size_t)(M / 2) * NSLOT; i0 += (size_t)gridDim.x * NTHR * 4) {
        const size_t tq = i0 >> 7; const size_t i = ((((tq >> 9) << 10) + (size_t)part * 512 + (tq & 511)) << 7) + (i0 & 127);
        const i32x4 p0 = *(const GAS i32x4*)(PD + i), p1 = *(const GAS i32x4*)(PD + (size_t)M * NSLOT + i), p2 = *(const GAS i32x4*)(PD + (size_t)2 * M * NSLOT + i), p3 = *(const GAS i32x4*)(PD + (size_t)3 * M * NSLOT + i);
        const v2u ew = *(const GAS v2u*)(EI + i); const f32x4 gt = *(const GAS f32x4*)(GT + i); const float hsv = hs[i >> 7];
        const unsigned e[4] = {ew.x & 0xffffu, ew.x >> 16, ew.y & 0xffffu, ew.y >> 16};
        const i32x4 si = (p0 + p1) + (p2 + p3); f32x4 o;
#pragma unroll
        for (int k = 0; k < 4; ++k) { const float s = (float)si[k] * (usc[e[k]] * hsv); o[k] = 0.5f * s * (1.f + erff(s * 0.70710678118654752f)) * gt[k] * vsc[e[k]]; }
        *(GAS f32x4*)(ACT + i) = o;
    }
}
struct PeerAct { f32x4 a0, a1, a2, a3; };
__device__ __forceinline__ PeerAct peer_ld_act(const float* ACT, int t, int g) { const GAS f32x4* ap = (const GAS f32x4*)(ACT + (size_t)t * NSLOT + 16 * g); PeerAct r; r.a0 = ap[0]; r.a1 = ap[1]; r.a2 = ap[2]; r.a3 = ap[3]; return r; }
__device__ __forceinline__ void peer_v_accum(const v4u (&raw)[16], const PeerAct& pa, f32x2 (&y2)[16]) {
    const float av[16] = {pa.a0[0], pa.a0[1], pa.a0[2], pa.a0[3], pa.a1[0], pa.a1[1], pa.a1[2], pa.a1[3], pa.a2[0], pa.a2[1], pa.a2[2], pa.a2[3], pa.a3[0], pa.a3[1], pa.a3[2], pa.a3[3]};
#pragma unroll
    for (int k = 0; k < 16; ++k) { const unsigned ww[4] = {raw[k].x, raw[k].y, raw[k].z, raw[k].w}; const f32x2 a2 = (f32x2){av[k], av[k]};
#pragma unroll
        for (int w = 0; w < 4; ++w) { y2[4 * w + 0] += a2 * __builtin_amdgcn_cvt_scalef32_pk_f32_fp4(ww[w], 1.0f, 0); y2[4 * w + 1] += a2 * __builtin_amdgcn_cvt_scalef32_pk_f32_fp4(ww[w], 1.0f, 1);
            y2[4 * w + 2] += a2 * __builtin_amdgcn_cvt_scalef32_pk_f32_fp4(ww[w], 1.0f, 2); y2[4 * w + 3] += a2 * __builtin_amdgcn_cvt_scalef32_pk_f32_fp4(ww[w], 1.0f, 3); } }
}
__device__ __forceinline__ void peer_v_store(f32x2 (&y2)[16], bf16* Yp, float* ssy, int c) {
    float ss = 0.f; unsigned w[16];
#pragma unroll
    for (int i = 0; i < 16; ++i) { ss += y2[i].x * y2[i].x + y2[i].y * y2[i].y; w[i] = pk2(y2[i].x, y2[i].y); y2[i] = (f32x2){0.f, 0.f}; }
#pragma unroll
    for (int i = 0; i < 4; ++i) *(GAS v4u*)(Yp + 8 * i) = (v4u){w[4 * i], w[4 * i + 1], w[4 * i + 2], w[4 * i + 3]};
    ss += __shfl_xor(ss, 1); ss += __shfl_xor(ss, 2); ss += __shfl_xor(ss, 4);
    if (c == 0) *ssy = ss;
}
__device__ __forceinline__ void phase_peer_v(const Args& A, int part, int w0, int nw) {
    const int tid = threadIdx.x, lane = tid & 63, wave = (tid >> 6) - w0, p = blockIdx.x & 7, q = p & 3, half = p >> 2, j = blockIdx.x >> 3, nj = gridDim.x >> 3, g = lane >> 3, c = lane & 7;
    if (wave < 0 || wave >= nw) return;
    const unsigned char* V4 = (const unsigned char*)(A.ws + WS_V8); const unsigned short* EI = (const unsigned short*)(A.ws + WS_EIDX); const float* ACT = (const float*)(A.ws + WS_ACT);
    bf16* Y = (bf16*)(A.ws + WS_H); float* SSY = (float*)(A.ws + WS_SSY);
    const int tper = (M / 2) / nj / 2, colb = 128 * q + 16 * c, tbeg = half * (M / 2) + (2 * j + part) * tper + wave * (tper / nw);
    const int nstep = (tper / nw / 8) * 8;
    auto rowof = [&](int s) { s = min(s, nstep - 1); return (size_t)(tbeg + 8 * (s >> 3) + g) * 8 + (s & 7); };
    f32x2 y2[16];
#pragma unroll
    for (int i = 0; i < 16; ++i) y2[i] = (f32x2){0.f, 0.f};
    auto ldidx = [&](int s) { const size_t r = rowof(s); PeerIdx x; x.e0 = *(const GAS v4u*)(EI + r * 16); x.e1 = *(const GAS v4u*)(EI + r * 16 + 8); return x; };
    auto ldact = [&](int s) { const GAS f32x4* ap = (const GAS f32x4*)(ACT + rowof(s) * 16); PeerAct r; r.a0 = ap[0]; r.a1 = ap[1]; r.a2 = ap[2]; r.a3 = ap[3]; return r; };
    PeerIdx ix1 = ldidx(1), ix2 = ldidx(2);
    v4u rawa[16], rawb[16]; PeerAct aca, acb;
    { const PeerIdx ix0 = ldidx(0); peer_gather<512>(V4, ix0, colb, rawa); aca = ldact(0); }
    for (int s = 0; s < nstep; s += 2) {
        const PeerIdx ix3 = ldidx(s + 3);
        peer_gather<512>(V4, ix1, colb, rawb); acb = ldact(s + 1);
        peer_v_accum(rawa, aca, y2);
        const PeerIdx ix4 = ldidx(s + 4);
        peer_gather<512>(V4, ix2, colb, rawa); aca = ldact(s + 2);
        peer_v_accum(rawb, acb, y2);
        if ((s & 7) == 6) { const int t = tbeg + 8 * (s >> 3) + g; peer_v_store(y2, Y + (size_t)t * D + 256 * q + 32 * c, SSY + (size_t)t * 8 + q, c); }
        ix1 = ix3; ix2 = ix4;
    }
}
__device__ __forceinline__ void phase_peer_final(const Args& A) {
    const int tid = threadIdx.x, lane = tid & 63, wave = tid >> 6, G = gridDim.x;
    const bf16* Y = (const bf16*)(A.ws + WS_H); const bf16* X1 = (const bf16*)(A.ws + WS_X1); const float* SSY = (const float*)(A.ws + WS_SSY); const float* mod = (const float*)(A.ws + WS_MOD); const float* gpost = (const float*)A.in[I_GPOST2]; float* out = A.out;
    f32x4 gp[4];
#pragma unroll
    for (int q = 0; q < 4; ++q) gp[q] = *(const GAS f32x4*)(gpost + 4 * (lane + 64 * q));
    const int stride = G * NWAVES; int row = blockIdx.x * NWAVES + wave;
    v2u xw[4], yw[4], xwn[4], ywn[4]; f32x4 s0, s0n, g2p[4]; int bcur = -1;
#pragma unroll
    for (int q = 0; q < 4; ++q) { xw[q] = ((const GAS v2u*)(X1 + (size_t)row * D) + lane)[64 * q]; yw[q] = ((const GAS v2u*)(Y + (size_t)row * D) + lane)[64 * q]; }
    s0 = *(const GAS f32x4*)(SSY + (size_t)row * 8);
    for (; row < M; row += stride) {
        const int rn = min(row + stride, M - 1);
#pragma unroll
        for (int q = 0; q < 4; ++q) { xwn[q] = ((const GAS v2u*)(X1 + (size_t)rn * D) + lane)[64 * q]; ywn[q] = ((const GAS v2u*)(Y + (size_t)rn * D) + lane)[64 * q]; }
        s0n = *(const GAS f32x4*)(SSY + (size_t)rn * 8);
        const int b = row / SEQ;
        if (b != bcur) { bcur = b;
#pragma unroll
            for (int q = 0; q < 4; ++q) { const f32x4 g2 = *(const GAS f32x4*)(mod + b * 6144 + 5120 + 4 * (lane + 64 * q));
#pragma unroll
                for (int i = 0; i < 4; ++i) g2p[q][i] = g2[i] * gp[q][i]; } }
        const float rstd = 1.0f / sqrtf(((s0[0] + s0[1]) + (s0[2] + s0[3])) * (1.f / D) + EPS);
        GAS f32x4* orow = (GAS f32x4*)(out + (size_t)row * D) + lane;
#pragma unroll
        for (int q = 0; q < 4; ++q) { f32x4 xv = {bflo(xw[q].x), bfhi(xw[q].x), bflo(xw[q].y), bfhi(xw[q].y)};
            xv[0] += g2p[q][0] * (bflo(yw[q].x) * rstd); xv[1] += g2p[q][1] * (bfhi(yw[q].x) * rstd); xv[2] += g2p[q][2] * (bflo(yw[q].y) * rstd); xv[3] += g2p[q][3] * (bfhi(yw[q].y) * rstd);
            orow[64 * q] = xv; }
#pragma unroll
        for (int q = 0; q < 4; ++q) { xw[q] = xwn[q]; yw[q] = ywn[q]; }
        s0 = s0n;
    }
}
#ifdef PROBE_V_LOADS
__device__ __forceinline__ void probe_v_loads(const Args& A) {
    const int tid = threadIdx.x, lane = tid & 63, wave = tid >> 6, p = blockIdx.x & 7, j = blockIdx.x >> 3, nj = gridDim.x >> 3, g = lane >> 3, c = lane & 7;
    const unsigned char* V8 = (const unsigned char*)(A.ws + WS_V8); const unsigned short* EI = (const unsigned short*)(A.ws + WS_EIDX); const float* ACT = (const float*)(A.ws + WS_ACT);
    unsigned* DUMP = (unsigned*)(A.ws + WS_PD);
    const int tper = M / nj, colb = 128 * p + 16 * c, tend = (j + 1) * tper, tlast = tend - NWAVES + wave;
    int t = j * tper + wave;
    PeerIdx ix1 = peer_ld_idx(EI, min(t + NWAVES, tlast), g), ix2 = peer_ld_idx(EI, min(t + 2 * NWAVES, tlast), g);
    v4u rawa[16], rawb[16]; PeerAct aca, acb;
    { const PeerIdx ix0 = peer_ld_idx(EI, t, g); peer_gather(V8, ix0, colb, rawa); aca = peer_ld_act(ACT, t, g); }
    for (; t < tend; t += 2 * NWAVES) {
        const int t1 = t + NWAVES, t2 = min(t + 2 * NWAVES, tlast), t3 = min(t + 3 * NWAVES, tlast), t4 = min(t + 4 * NWAVES, tlast);
        const PeerIdx ix3 = peer_ld_idx(EI, t3, g);
        peer_gather(V8, ix1, colb, rawb); acb = peer_ld_act(ACT, t1, g);
        { unsigned s = __builtin_bit_cast(unsigned, aca.a0[0]) + __builtin_bit_cast(unsigned, aca.a3[3]);
#pragma unroll
          for (int k = 0; k < 16; ++k) s += (rawa[k].x + rawa[k].y) + (rawa[k].z + rawa[k].w);
          DUMP[(size_t)t * 512 + p * 64 + lane] = s; }
        const PeerIdx ix4 = peer_ld_idx(EI, t4, g);
        peer_gather(V8, ix2, colb, rawa); aca = peer_ld_act(ACT, t2, g);
        { unsigned s = __builtin_bit_cast(unsigned, acb.a0[0]) + __builtin_bit_cast(unsigned, acb.a3[3]);
#pragma unroll
          for (int k = 0; k < 16; ++k) s += (rawb[k].x + rawb[k].y) + (rawb[k].z + rawb[k].w);
          DUMP[(size_t)t1 * 512 + p * 64 + lane] = s; }
        ix1 = ix3; ix2 = ix4;
    }
}
#endif

#ifdef PROBE_INSTR
__device__ __forceinline__ void probe_instr(const Args& A) {
    f32x2 a[8]; float f[16]; unsigned w = threadIdx.x * 0x01010101u + 0x38383838u;
#pragma unroll
    for (int i = 0; i < 8; ++i) a[i] = (f32x2){1.0f + i, 2.0f + i};
#pragma unroll
    for (int i = 0; i < 16; ++i) f[i] = 1.0f + i;
    for (int it = 0; it < 10000; ++it) {
#if PROBE_INSTR == 1
#pragma unroll
        for (int i = 0; i < 8; ++i) { asm volatile("v_pk_fma_f32 %0, %1, %2, %0" : "+v"(a[i]) : "v"(a[(i + 1) & 7]), "v"(a[(i + 2) & 7])); asm volatile("v_pk_fma_f32 %0, %1, %2, %0" : "+v"(a[i]) : "v"(a[(i + 3) & 7]), "v"(a[(i + 4) & 7])); }
#elif PROBE_INSTR == 2
#pragma unroll
        for (int i = 0; i < 16; ++i) asm volatile("v_fma_f32 %0, %1, %2, %0" : "+v"(f[i]) : "v"(f[(i + 1) & 15]), "v"(f[(i + 2) & 15]));
#elif PROBE_INSTR == 3
#pragma unroll
        for (int i = 0; i < 8; ++i) { asm volatile("v_cvt_pk_f32_fp8 %0, %1" : "=v"(a[i]) : "v"(w)); asm volatile("v_cvt_pk_f32_fp8 %0, %1" : "=v"(a[i]) : "v"(w)); }
#elif PROBE_INSTR == 4
#pragma unroll
        for (int i = 0; i < 8; ++i) { asm volatile("v_cvt_scalef32_pk_f32_fp4 %0, %1, 1.0" : "=v"(a[i]) : "v"(w)); asm volatile("v_cvt_scalef32_pk_f32_fp4 %0, %1, 1.0" : "=v"(a[i]) : "v"(w)); }
#elif PROBE_INSTR == 5
#pragma unroll
        for (int i = 0; i < 16; ++i) asm volatile("v_pk_fma_f16 %0, %1, %2, %0" : "+v"(f[i]) : "v"(f[(i + 1) & 15]), "v"(f[(i + 2) & 15]));
#elif PROBE_INSTR == 7
#pragma unroll
        for (int i = 0; i < 16; ++i) asm volatile("v_dot8c_i32_i4 %0, %1, %2" : "+v"(f[i]) : "v"(f[(i + 1) & 15]), "v"(w));
#elif PROBE_INSTR == 8
#pragma unroll
        for (int i = 0; i < 16; ++i) asm volatile("v_dot4c_i32_i8 %0, %1, %2" : "+v"(f[i]) : "v"(f[(i + 1) & 15]), "v"(w));
#elif PROBE_INSTR == 9
#pragma unroll
        for (int i = 0; i < 16; ++i) asm volatile("v_perm_b32 %0, %1, %2, %3" : "=v"(f[i]) : "v"(f[(i + 1) & 15]), "v"(f[(i + 2) & 15]), "v"(w));
#elif PROBE_INSTR == 10
#pragma unroll
        for (int i = 0; i < 16; ++i) asm volatile("v_mfma_f32_16x16x32_fp8_fp8 %0, %1, %2, %0" : "+v"(*(f32x4*)&f[4 * (i & 3)]) : "v"(a[i & 7]), "v"(a[(i + 1) & 7]));
#elif PROBE_INSTR == 6
#pragma unroll
        for (int i = 0; i < 16; ++i) asm volatile("v_cvt_scalef32_pk_f16_fp4 %0, %1, 1.0" : "=v"(f[i]) : "v"(w));
#endif
    }
    float s = 0.f;
#pragma unroll
    for (int i = 0; i < 8; ++i) s += a[i].x + a[i].y;
#pragma unroll
    for (int i = 0; i < 16; ++i) s += f[i];
    if (s == 123.456f) ((float*)(A.ws + WS_PD))[threadIdx.x] = s;
}
#endif
#ifndef GEMM_ALIGN
#define GEMM_ALIGN true
#endif
#ifndef GEMM_SP2
#define GEMM_SP2 true
#endif
#ifndef MK_N_LAUNCHES
#define MK_N_LAUNCHES 1
#endif
constexpr int N_PHASES = 15;
typedef const __attribute__((address_space(4))) Args* KArgP;
__device__ __forceinline__ const Args& kargs() { KArgP p = (KArgP)__builtin_amdgcn_kernarg_segment_ptr(); asm volatile("" : "+s"(p)); return *(const Args*)p; }
__global__ void __launch_bounds__(NTHR, 2) hymba_fwd(Args A_) {
    extern __shared__ __attribute__((aligned(16))) unsigned char lds_raw[];
    LAS unsigned char* lds = (LAS unsigned char*)lds_raw;
    const int lo = A_.ph_lo, hi = A_.ph_hi;
#define A kargs()
#define ws (kargs().ws)
#ifndef DBLMASK
#define DBLMASK 0
#endif
#ifndef ONLYMASK
#define ONLYMASK 0xffff
#endif
#define IN(k) ((((ONLYMASK) >> (k)) & 1) && lo <= (k) && (k) < hi)
#define REP(k) for (int _rep = 0; _rep < (((DBLMASK) >> (k)) & 1) + 1; ++_rep)
    for (int u = threadIdx.x; u < (LDS_BYTES - RING_BYTES) / 4; u += NTHR) ((LAS unsigned*)(lds + RING_BYTES))[u] = 0u;
    __syncthreads();
    (void)xcd_barrier_post((unsigned*)(ws + WS_CTL) + CW_BAR, (volatile LAS unsigned*)(lds + MISC_OFF + 32));
#define SEAM(k) do { if (IN(k) && IN((k) + 1)) { if ((k) == 0) cg::this_grid().sync(); else { XcdBarrier xb_; xb_.bar = (unsigned*)(ws + WS_CTL) + CW_BAR; xb_.x = xb_xcc_id(); xb_.st = (volatile LAS unsigned*)(lds + MISC_OFF + 32); xcd_barrier(xb_); } } } while (0)

    if (IN(0)) REP(0) { phase_mod(A, lds); } SEAM(0);
    if (IN(1)) REP(1) { phase_convert(A, lds); phase_prenorm(A, lds); } SEAM(1);
    if (IN(2)) REP(2) {
        pg8::Gemm g{(const pg8::bf16_t*)(ws + WS_H), (const pg8::bf16_t*)(ws + WS_WIN), M, NPROJ, D}; pg8::StaticOrder S; S.init(M, NPROJ, gridDim.x, (int)blockIdx.x);
        pg8::EpiProj E{(pg8::bf16_t*)(ws + WS_PROJ), NPROJ, (float*)(ws + WS_GATES), (const int*)A.in[I_POS], (const float*)A.in[I_BI], (const float*)A.in[I_BF]};
        pg8::gemm_phase<pg8::EpiProj, pg8::StaticOrder, GEMM_ALIGN, GEMM_SP2>(lds, g, S, E);
    } SEAM(2);
    if (IN(3)) REP(3) {
        phase_attn(A, lds);
        for (int wg = blockIdx.x; wg < 256; wg += gridDim.x) mlstm_group<false>(A, lds, wg);
    } SEAM(3);
    if (IN(4)) REP(4) { for (int wg = blockIdx.x; wg < 256; wg += gridDim.x) mlstm_group<true>(A, lds, wg); } SEAM(4);
    if (IN(5)) REP(5) {
        pg8::Gemm g{(const pg8::bf16_t*)(ws + WS_MIXIN), (const pg8::bf16_t*)(ws + WS_WOUT), M, D, D}; pg8::StaticOrder S; S.init(M, D, gridDim.x, (int)blockIdx.x);
        pg8::EpiMix E{(pg8::bf16_t*)(ws + WS_MIX), D, (float*)(ws + WS_SSQ)};
        pg8::gemm_phase<pg8::EpiMix, pg8::StaticOrder, GEMM_ALIGN, GEMM_SP2>(lds, g, S, E);
    } SEAM(5);
    if (IN(6)) REP(6) { phase_mid(A); } SEAM(6);
    if (IN(7)) REP(7) {
        pg8::Gemm g{(const pg8::bf16_t*)(ws + WS_H), (const pg8::bf16_t*)(ws + WS_WQ), M, 2048, D}; pg8::StaticOrder S; S.init(M, 2048, gridDim.x, (int)blockIdx.x);
        pg8::EpiPlain E{(pg8::bf16_t*)(ws + WS_PROJ), 2048};
        pg8::gemm_phase<pg8::EpiPlain, pg8::StaticOrder, GEMM_ALIGN, GEMM_SP2>(lds, g, S, E);
    } SEAM(7);
    if (IN(8)) REP(8) { phase_topk(A, lds); } SEAM(8);
    if (IN(9)) REP(9) { phase_peer_u(A, 0, 0, 8); } SEAM(9);
    if (IN(10)) REP(10) { phase_peer_act(A, 0); } SEAM(10);
    if (IN(11)) REP(11) { if ((threadIdx.x >> 6) < 4) phase_peer_v(A, 0, 0, 4); else phase_peer_u(A, 1, 4, 4); } SEAM(11);
    if (IN(12)) REP(12) { phase_peer_act(A, 1); } SEAM(12);
    if (IN(13)) REP(13) { phase_peer_v(A, 1, 0, 8); } SEAM(13);
    if (IN(14)) REP(14) { phase_peer_final(A); }
#undef IN
#undef SEAM
#undef A
#undef ws
}

extern "C" void kernel_launch(void* const* d_in, const int* in_sizes, int n_in, void* d_out, int out_size, void* d_ws, size_t ws_size, hipStream_t stream) {
    static int grid = 0;
    if (grid == 0) {
        if (n_in != 21 || in_sizes[0] != M * D || out_size != M * D || ws_size < WS_END) { fprintf(stderr, "kernel_launch: unexpected shapes (n_in %d, in0 %d, out %d, ws %zu < %zu)\n", n_in, n_in > 0 ? in_sizes[0] : -1, out_size, ws_size, (size_t)WS_END); grid = -1; return; }
        int dev = 0, cus = 0, per_cu = 0;
        if (hipGetDevice(&dev) != hipSuccess || hipDeviceGetAttribute(&cus, hipDeviceAttributeMultiprocessorCount, dev) != hipSuccess) { grid = -1; return; }
        if (hipFuncSetAttribute((const void*)hymba_fwd, hipFuncAttributeMaxDynamicSharedMemorySize, LDS_BYTES) != hipSuccess) { fprintf(stderr, "kernel_launch: hipFuncSetAttribute failed\n"); grid = -1; return; }
        if (hipOccupancyMaxActiveBlocksPerMultiprocessor(&per_cu, (const void*)hymba_fwd, NTHR, LDS_BYTES) != hipSuccess || per_cu < 1) { fprintf(stderr, "kernel_launch: occupancy query says %d blocks per CU\n", per_cu); per_cu = 1; }
        (void)hipGetLastError();
        grid = cus;
        if (grid != 256) fprintf(stderr, "kernel_launch: note: %d CUs (built for 256)\n", grid);
    }
    if (grid < 0) return;
    (void)hipMemsetAsync((char*)d_ws + WS_CTL, 0, CTL_ZERO_BYTES, stream);
    Args a{};
    for (int i = 0; i < 21; ++i) a.in[i] = d_in[i];
    a.out = (float*)d_out; a.ws = (unsigned char*)d_ws;
    if (MK_N_LAUNCHES == 1) {
        a.ph_lo = 0; a.ph_hi = N_PHASES;
        void* args[] = {&a};
        const hipError_t e = hipLaunchCooperativeKernel((const void*)hymba_fwd, dim3(grid), dim3(NTHR), args, LDS_BYTES, stream);
        if (e != hipSuccess) fprintf(stderr, "kernel_launch: cooperative launch failed: %s (grid %d)\n", hipGetErrorString(e), grid);
    } else {
        for (int p = 0; p < N_PHASES; ++p) { a.ph_lo = p; a.ph_hi = p + 1; hipLaunchKernelGGL(hymba_fwd, dim3(grid), dim3(NTHR), LDS_BYTES, stream, a); }
    }
}
```

```cpp
#include <hip/hip_runtime.h>
#include <hip/hip_cooperative_groups.h>
#include <cstdio>
#include <cstdint>
namespace cg = cooperative_groups;
namespace pg8 {
#define PG8_LAS __attribute__((address_space(3)))
typedef unsigned short bf16_t;
typedef short bf16x8 __attribute__((ext_vector_type(8)));
typedef float f32x4 __attribute__((ext_vector_type(4)));
typedef unsigned u32x4 __attribute__((ext_vector_type(4)));
constexpr int BM = 256, BK = 64, HALF = 128, HTB = HALF * BK * 2  , STAGE_BYTES = 8 * HTB, NXCD = 8, WGM = 8;

__host__ __device__ __forceinline__ int lds_byte(int r, int c) { const int st = (r >> 4) * 2 + (c >> 5), rr = r & 15, cc = c & 31, ob = rr * 64 + cc * 2; return st * 1024 + (ob ^ (((ob >> 9) & 1) << 5)); }
__host__ __device__ __forceinline__ void stage_rc(int b, int& R, int& C) { const int st = b / 1024, sb = b % 1024, swz = sb ^ (((sb >> 9) & 1) << 5); R = (st >> 1) * 16 + swz / 64; C = (st & 1) * 32 + (swz % 64) / 2; }
__host__ __device__ __forceinline__ int perm32(int rho) { const int n = rho >> 4, i = rho & 15; return 8 * (i >> 2) + 4 * n + (i & 3); }

struct Unit { int pm, pn; };
struct Gemm { const bf16_t* A; const bf16_t* Bt; int M, N, K; };

struct StaticOrder {
    int nM, nN, nwg, G, c;
    __host__ __device__ void init(int M, int N, int G_, int c_) { nM = M / BM; nN = N / BM; nwg = nM * nN; G = G_; c = c_; }
    __host__ __device__ bool next(int i, Unit& u) const {
        const long L = (long)i * G + c; if (L >= nwg) return false;
        int wgid = (int)L; { const int q = nwg / NXCD, r = nwg % NXCD, xcd = wgid % NXCD, off = wgid / NXCD; wgid = (xcd < r ? xcd * (q + 1) : r * (q + 1) + (xcd - r) * q) + off; }
        const int nig = WGM * nN, gid = wgid / nig, fm = gid * WGM, gsz = (nM - fm) < WGM ? (nM - fm) : WGM;
        u.pm = fm + ((wgid % nig) % gsz); u.pn = (wgid % nig) / gsz; return true;
    }
    __device__ __forceinline__ void a_ready(const Unit&) const {}
    __device__ __forceinline__ void done(const Unit&) const {}
};

__device__ __forceinline__ unsigned cvt_pk_bf16(float lo, float hi) { unsigned r; asm volatile("v_cvt_pk_bf16_f32 %0, %1, %2" : "=v"(r) : "v"(lo), "v"(hi)); return r; }
typedef float f32x2 __attribute__((ext_vector_type(2)));
__device__ __forceinline__ f32x2 gelu_pk(f32x2 v) {
    const f32x2 av = __builtin_elementwise_abs(v), d = av * 0.2316418882f + 1.0f;
    f32x2 t; t.x = __builtin_amdgcn_rcpf(d.x); t.y = __builtin_amdgcn_rcpf(d.y);
    f32x2 q = t * 0.5307027145f + (-0.7265760135f); q = q * t + 0.7107068705f; q = q * t + (-0.142248368f); q = q * t + 0.127414796f; q = q * t;
    const f32x2 s = (v * v) * (-0.72134752044f);
    f32x2 e; e.x = __builtin_amdgcn_exp2f(s.x); e.y = __builtin_amdgcn_exp2f(s.y);
    const f32x2 m = v * (q * e), r = v - m;
    f32x2 o; o.x = v.x < 0.f ? m.x : r.x; o.y = v.y < 0.f ? m.y : r.y; return o;
}

__device__ __forceinline__ u32x4 pack8(const f32x4 v0, const f32x4 v1) { u32x4 w; w.x = cvt_pk_bf16(v0[0], v0[1]); w.y = cvt_pk_bf16(v0[2], v0[3]); w.z = cvt_pk_bf16(v1[0], v1[1]); w.w = cvt_pk_bf16(v1[2], v1[3]); return w; }

struct EpiPlain {
    static constexpr bool PERM = true, AFTER_DRAIN = false;
    bf16_t* O; int ldc;
    __device__ __forceinline__ void operator()(const f32x4 (&acc)[2][2][4][2], const Unit& u, int wr, int wc, int fr, int fq) const {
        const int row0 = u.pm * BM + wr * 64 + fr, col0 = u.pn * BM + wc * 32 + 8 * fq;
#pragma unroll
        for (int ai = 0; ai < 2; ++ai)
#pragma unroll
            for (int m = 0; m < 4; ++m) { bf16_t* rowp = O + (size_t)(row0 + ai * HALF + m * 16) * ldc + col0;
#pragma unroll
                for (int bj = 0; bj < 2; ++bj) *(u32x4*)(rowp + bj * HALF) = pack8(acc[ai][bj][m][0], acc[ai][bj][m][1]); }
    }
};

struct EpiProj {
    static constexpr bool PERM = true, AFTER_DRAIN = false;
    bf16_t* P; int ldc; float* gates; const int* pos; const float* b_i; const float* b_f;
    __device__ __forceinline__ void operator()(const f32x4 (&acc)[2][2][4][2], const Unit& u, int wr, int wc, int fr, int fq) const {
        const int row0 = u.pm * BM + wr * 64 + fr, col0 = u.pn * BM + wc * 32 + 8 * fq, pn = u.pn;
        if (pn == 9) {
            if (wc == 0 && fq == 0) {
                const f32x4 bi = {b_i[0], b_i[1], b_i[2], b_i[3]}, bf = {b_f[0], b_f[1], b_f[2], b_f[3]};
#pragma unroll
                for (int ai = 0; ai < 2; ++ai)
#pragma unroll
                    for (int m = 0; m < 4; ++m) { const int row = row0 + ai * HALF + m * 16;
                        const f32x4 iv = acc[ai][0][m][0] + bi, fv = acc[ai][0][m][1] + bf; f32x4 lf;
#pragma unroll
                        for (int j = 0; j < 4; ++j) lf[j] = fminf(fv[j], 0.f) - log1pf(__expf(-fabsf(fv[j])));
                        *(f32x4*)(gates + (size_t)row * 8) = iv; *(f32x4*)(gates + (size_t)row * 8 + 4) = lf; }
            }
            return;
        }
#pragma unroll
        for (int ai = 0; ai < 2; ++ai)
#pragma unroll
            for (int m = 0; m < 4; ++m) { const int row = row0 + ai * HALF + m * 16; bf16_t* rowp = P + (size_t)row * ldc + col0;
                const float posf = (pn <= 2) ? (float)pos[row] : 0.f;
#pragma unroll
                for (int bj = 0; bj < 2; ++bj) { f32x4 v0 = acc[ai][bj][m][0], v1 = acc[ai][bj][m][1];
                    const bool rope = (pn < 2) || (pn == 2 && bj == 0);
                    if (rope) {
                        const int p0 = ((col0 + bj * HALF) & 63) >> 1; const float sc = (pn < 2) ? 0.125f : 1.0f;
                        float x[8] = {v0[0], v0[1], v0[2], v0[3], v1[0], v1[1], v1[2], v1[3]};
#pragma unroll
                        for (int q = 0; q < 4; ++q) { const float invf = __builtin_amdgcn_exp2f(-(float)(p0 + q) * 0.41524101186092029f);
                            float r = posf * invf * 0.15915494309189535f; r = r - floorf(r);
                            const float c = __builtin_amdgcn_cosf(r) * sc, s = __builtin_amdgcn_sinf(r) * sc;
                            const float x1 = x[2 * q], x2 = x[2 * q + 1]; x[2 * q] = x1 * c - x2 * s; x[2 * q + 1] = x2 * c + x1 * s; }
                        v0 = (f32x4){x[0], x[1], x[2], x[3]}; v1 = (f32x4){x[4], x[5], x[6], x[7]};
                    } else if (pn >= 7) {
#pragma unroll
                        for (int j = 0; j < 4; ++j) { v0[j] = __builtin_amdgcn_rcpf(1.f + __expf(-v0[j])); v1[j] = __builtin_amdgcn_rcpf(1.f + __expf(-v1[j])); }
                    }
                    *(u32x4*)(rowp + bj * HALF) = pack8(v0, v1); } }
    }
};

struct EpiMix {
    static constexpr bool PERM = true, AFTER_DRAIN = false;
    bf16_t* O; int ldc; float* sumsq;
    __device__ __forceinline__ void operator()(const f32x4 (&acc)[2][2][4][2], const Unit& u, int wr, int wc, int fr, int fq) const {
        const int row0 = u.pm * BM + wr * 64 + fr, col0 = u.pn * BM + wc * 32 + 8 * fq;
#pragma unroll
        for (int ai = 0; ai < 2; ++ai)
#pragma unroll
            for (int m = 0; m < 4; ++m) { const int row = row0 + ai * HALF + m * 16; bf16_t* rowp = O + (size_t)row * ldc + col0; float s = 0.f;
#pragma unroll
                for (int bj = 0; bj < 2; ++bj) { const f32x4 v0 = acc[ai][bj][m][0], v1 = acc[ai][bj][m][1];
                    s += (v0[0] * v0[0] + v0[1] * v0[1]) + (v0[2] * v0[2] + v0[3] * v0[3]) + (v1[0] * v1[0] + v1[1] * v1[1]) + (v1[2] * v1[2] + v1[3] * v1[3]);
                    *(u32x4*)(rowp + bj * HALF) = pack8(v0, v1); }
                s += __shfl_xor(s, 16); s += __shfl_xor(s, 32);
                if (fq == 0) sumsq[(size_t)row * 16 + u.pn * 4 + wc] = s; }
    }
};
template <class Epi, class Sched, bool ALIGN_EPI = false, bool SP2 = false>
__device__ __forceinline__ void gemm_phase(PG8_LAS unsigned char* lds, const Gemm g, const Sched& S, const Epi& E) {
    const int tid = threadIdx.x, wid = __builtin_amdgcn_readfirstlane(tid >> 6), lane = tid & 63, wr = wid >> 2, wc = wid & 3, fr = lane & 15, fq = lane >> 4;
    const int K = g.K, nt = K / BK;
    unsigned voffA[2], voffB[2];
#pragma unroll
    for (int i = 0; i < 2; ++i) { int R, C; stage_rc(tid * 16 + i * 8192, R, C); const int Rb = Epi::PERM ? ((R & ~31) + perm32(R & 31)) : R;
        voffA[i] = (unsigned)(R * K + C) * 2u; voffB[i] = (unsigned)(Rb * K + C) * 2u; }
    const size_t kstep = (size_t)(BK * 2);
    const size_t hstep = (size_t)HALF * K * 2;
    const size_t tstep = 2 * hstep;
    const unsigned ldsw = (unsigned)wid * 1024u;
    const int aoff = lds_byte(wr * 64 + fr, fq * 8), boff = lds_byte(wc * 32 + fr, fq * 8);
#define PG8_SA(b, h) (((b) * 2 + (h)) * HTB)
#define PG8_SB(b, h) ((4 + (b) * 2 + (h)) * HTB)
#define PG8_STAGE(bufoff, gbase, voff) do { _Pragma("unroll") for (int _i = 0; _i < 2; ++_i) \
        __builtin_amdgcn_global_load_lds((const unsigned*)((const char*)(gbase) + (voff)[_i]), (PG8_LAS unsigned*)(lds + (bufoff) + ldsw + _i * 8192), 16, 0, 0); } while (0)
#define PG8_LDA(dst, b, h) do { _Pragma("unroll") for (int m = 0; m < 4; ++m) _Pragma("unroll") for (int k = 0; k < 2; ++k) dst[m][k] = *(const PG8_LAS bf16x8*)(lds + PG8_SA(b, h) + aoff + m * 2048 + k * 1024); } while (0)
#define PG8_LDB(dst, b, h) do { _Pragma("unroll") for (int n = 0; n < 2; ++n) _Pragma("unroll") for (int k = 0; k < 2; ++k) dst[n][k] = *(const PG8_LAS bf16x8*)(lds + PG8_SB(b, h) + boff + n * 2048 + k * 1024); } while (0)
#define PG8_MMA(ai, bj, At, Bt) do { __builtin_amdgcn_s_setprio(1); _Pragma("unroll") for (int m = 0; m < 4; ++m) _Pragma("unroll") for (int n = 0; n < 2; ++n) _Pragma("unroll") for (int k = 0; k < 2; ++k) \
        acc[ai][bj][m][n] = __builtin_amdgcn_mfma_f32_16x16x32_bf16(Bt[n][k], At[m][k], acc[ai][bj][m][n], 0, 0, 0); __builtin_amdgcn_s_setprio(0); } while (0)
#define PG8_WAIT_V(n) asm volatile("s_waitcnt vmcnt(" #n ")" ::: "memory")
#define PG8_WAIT_L(n) asm volatile("s_waitcnt lgkmcnt(" #n ")" ::: "memory")
#define PG8_BAR __builtin_amdgcn_s_barrier()
#define PG8_SCHED __builtin_amdgcn_sched_barrier(0)
    Unit cur, nxt; int ui = 0;
    if (!S.next(0, cur)) return;
    f32x4 acc[2][2][4][2];
#pragma unroll
    for (int a = 0; a < 2; ++a)
#pragma unroll
        for (int b = 0; b < 2; ++b)
#pragma unroll
            for (int m = 0; m < 4; ++m)
#pragma unroll
                for (int n = 0; n < 2; ++n) acc[a][b][m][n] = (f32x4){0.f, 0.f, 0.f, 0.f};
    bf16x8 At[4][2], B0[2][2], B1[2][2];
    const char* cA = (const char*)g.A + (size_t)cur.pm * tstep; const char* cB = (const char*)g.Bt + (size_t)cur.pn * tstep;
    S.a_ready(cur);
    if constexpr (SP2) {
        PG8_STAGE(PG8_SB(0, 0), cB, voffB); PG8_STAGE(PG8_SB(0, 1), cB + hstep, voffB); PG8_STAGE(PG8_SA(0, 0), cA, voffA); PG8_STAGE(PG8_SA(0, 1), cA + hstep, voffA);
        if (wr == 1) PG8_BAR;
        PG8_WAIT_V(2); PG8_BAR;
        PG8_STAGE(PG8_SB(1, 0), cB + kstep, voffB); PG8_STAGE(PG8_SA(1, 0), cA + kstep, voffA); PG8_STAGE(PG8_SB(1, 1), cB + hstep + kstep, voffB);
        PG8_WAIT_V(6); PG8_BAR;
    } else {
        PG8_STAGE(PG8_SB(0, 0), cB, voffB); PG8_STAGE(PG8_SA(0, 0), cA, voffA); PG8_STAGE(PG8_SB(0, 1), cB + hstep, voffB); PG8_STAGE(PG8_SA(0, 1), cA + hstep, voffA);
        if (wr == 1) PG8_BAR;
        PG8_WAIT_V(4); PG8_BAR;
        PG8_STAGE(PG8_SB(1, 0), cB + kstep, voffB); PG8_STAGE(PG8_SA(1, 0), cA + kstep, voffA); PG8_STAGE(PG8_SB(1, 1), cB + hstep + kstep, voffB);
        PG8_WAIT_V(6); PG8_BAR;
    }
    for (;;) {
        const bool has_next = S.next(ui + 1, nxt);
        const char* nA = has_next ? (const char*)g.A + (size_t)nxt.pm * tstep : cA; const char* nB = has_next ? (const char*)g.Bt + (size_t)nxt.pn * tstep : cB;
        for (int t = 0; t < nt; t += 2) {
            const bool last = (t == nt - 2);
            const char* a1 = cA + (size_t)(t + 1) * kstep;
            const char* a2 = last ? nA : cA + (size_t)(t + 2) * kstep; const char* b2 = last ? nB : cB + (size_t)(t + 2) * kstep;
            const char* a3 = a2 + kstep; const char* b3 = b2 + kstep;
            if (last && has_next) S.a_ready(nxt);
            if constexpr (SP2) {
            PG8_LDB(B0, 0, 0); PG8_LDB(B1, 0, 1); PG8_SCHED; PG8_LDA(At, 0, 0); PG8_STAGE(PG8_SA(1, 1), a1 + hstep, voffA);
            PG8_WAIT_V(8); PG8_WAIT_L(0); PG8_BAR; PG8_MMA(0, 0, At, B0); PG8_MMA(0, 1, At, B1); PG8_BAR; PG8_SCHED;
            PG8_LDA(At, 0, 1); PG8_STAGE(PG8_SB(0, 0), b2, voffB); PG8_STAGE(PG8_SB(0, 1), b2 + hstep, voffB); PG8_STAGE(PG8_SA(0, 0), a2, voffA);
            PG8_WAIT_V(8); PG8_WAIT_L(0); PG8_BAR; PG8_MMA(1, 0, At, B0); PG8_MMA(1, 1, At, B1); PG8_BAR; PG8_SCHED;
            PG8_LDB(B0, 1, 0); PG8_LDB(B1, 1, 1); PG8_SCHED; PG8_LDA(At, 1, 0); PG8_STAGE(PG8_SA(0, 1), a2 + hstep, voffA);
            PG8_WAIT_V(8); PG8_WAIT_L(0); PG8_BAR; PG8_MMA(0, 0, At, B0); PG8_MMA(0, 1, At, B1); PG8_BAR; PG8_SCHED;
            PG8_LDA(At, 1, 1); PG8_STAGE(PG8_SB(1, 0), b3, voffB); PG8_STAGE(PG8_SB(1, 1), b3 + hstep, voffB); PG8_STAGE(PG8_SA(1, 0), a3, voffA);
            PG8_WAIT_V(8); PG8_WAIT_L(0); PG8_BAR; PG8_MMA(1, 0, At, B0); PG8_MMA(1, 1, At, B1); PG8_BAR; PG8_SCHED;
            } else {
            PG8_LDB(B0, 0, 0); PG8_SCHED; PG8_LDA(At, 0, 0); PG8_STAGE(PG8_SA(1, 1), a1 + hstep, voffA);
            PG8_WAIT_L(8); PG8_BAR; PG8_WAIT_L(0); PG8_MMA(0, 0, At, B0); PG8_BAR; PG8_SCHED;
            PG8_LDB(B1, 0, 1); PG8_STAGE(PG8_SB(0, 0), b2, voffB);
            PG8_BAR; PG8_WAIT_L(0); PG8_MMA(0, 1, At, B1); PG8_BAR;
            PG8_LDA(At, 0, 1); PG8_STAGE(PG8_SA(0, 0), a2, voffA);
            PG8_BAR; PG8_WAIT_L(0); PG8_MMA(1, 0, At, B0); PG8_BAR; PG8_SCHED;
            PG8_STAGE(PG8_SB(0, 1), b2 + hstep, voffB);
            PG8_WAIT_V(6); PG8_BAR; PG8_MMA(1, 1, At, B1); PG8_BAR;
            PG8_LDB(B0, 1, 0); PG8_SCHED; PG8_LDA(At, 1, 0); PG8_STAGE(PG8_SA(0, 1), a2 + hstep, voffA);
            PG8_WAIT_L(8); PG8_BAR; PG8_WAIT_L(0); PG8_MMA(0, 0, At, B0); PG8_BAR; PG8_SCHED;
            PG8_LDB(B1, 1, 1); PG8_STAGE(PG8_SB(1, 0), b3, voffB);
            PG8_BAR; PG8_WAIT_L(0); PG8_MMA(0, 1, At, B1); PG8_BAR;
            PG8_LDA(At, 1, 1); PG8_STAGE(PG8_SA(1, 0), a3, voffA);
            PG8_BAR; PG8_WAIT_L(0); PG8_MMA(1, 0, At, B0); PG8_BAR; PG8_SCHED;
            PG8_STAGE(PG8_SB(1, 1), b3 + hstep, voffB);
            PG8_WAIT_V(6); PG8_BAR; PG8_MMA(1, 1, At, B1); PG8_BAR;
            }
        }
        if constexpr (ALIGN_EPI) { if (wr == 0) PG8_BAR; }
        if constexpr (!Epi::AFTER_DRAIN) { E(acc, cur, wr, wc, fr, fq); S.done(cur); }
        if (!has_next) break;
#pragma unroll
        for (int a = 0; a < 2; ++a)
#pragma unroll
            for (int b = 0; b < 2; ++b)
#pragma unroll
                for (int m = 0; m < 4; ++m)
#pragma unroll
                    for (int n = 0; n < 2; ++n) acc[a][b][m][n] = (f32x4){0.f, 0.f, 0.f, 0.f};
        cur = nxt; cA = nA; cB = nB; ++ui;
        if constexpr (ALIGN_EPI) { if (wr == 1) PG8_BAR; }
    }
    PG8_WAIT_V(0);
    if constexpr (!ALIGN_EPI) { if (wr == 0) PG8_BAR; }
    PG8_BAR;
    if constexpr (Epi::AFTER_DRAIN) { E.fused(acc, cur, wr, wc, fr, fq, lds, wid, lane); S.done(cur); }
#undef PG8_SA
#undef PG8_SB
#undef PG8_STAGE
#undef PG8_LDA
#undef PG8_LDB
#undef PG8_MMA
#undef PG8_WAIT_V
#undef PG8_WAIT_L
#undef PG8_BAR
#undef PG8_SCHED
}
}
constexpr int NB = 8, SEQ = 8192, D = 1024, M = NB * SEQ;
constexpr int DIN = 2312, NPROJ = 2304, NIN_PAD = 2560;
constexpr int C_AQ = 0, C_AK = 512, C_AV = 640, C_MQ = 768, C_MK = 1024, C_MV = 1280, C_MO = 1792;
constexpr int NEXP = 16384, NSLOT = 128;
constexpr float EPS = 1e-6f;
constexpr int NWAVES = 8, NTHR = 512;

constexpr size_t MiB = 1u << 20;
constexpr size_t WS_CTL = 0, CTL_ZERO_BYTES = 1 * MiB;
constexpr size_t WS_MOD = 1 * MiB;
constexpr size_t WS_WIN = 2 * MiB;
constexpr size_t WS_WOUT = 8 * MiB;
constexpr size_t WS_WQ = 10 * MiB;
constexpr size_t WS_KEYS = 14 * MiB;
constexpr size_t WS_GATES = 16 * MiB;
constexpr size_t WS_SSQ = 832 * MiB;
constexpr size_t WS_MST = 20 * MiB;
constexpr size_t WS_U8 = 32 * MiB, WS_V8 = 48 * MiB;
constexpr size_t WS_SC = 64 * MiB;
constexpr size_t WS_H = 96 * MiB;
constexpr size_t WS_PROJ = 224 * MiB;
constexpr size_t WS_MIXIN = 512 * MiB;
constexpr size_t WS_MIX = 640 * MiB;
constexpr size_t WS_EIDX = 768 * MiB, WS_GATE = 800 * MiB;
constexpr size_t WS_PD = 224 * MiB;
constexpr size_t WS_X1 = 512 * MiB;
constexpr size_t WS_ACT = 840 * MiB;
constexpr size_t WS_SSY = 872 * MiB;
constexpr size_t WS_H8 = 880 * MiB;
constexpr size_t WS_HS = 944 * MiB;
constexpr size_t WS_END = 945 * MiB;
constexpr int CW_BAR = 4096;
constexpr int CW_SUMSQ = 65536;
static_assert((CW_SUMSQ + M) * 4 <= (int)CTL_ZERO_BYTES, "ctl");

constexpr int RING_BYTES = 131072, MISC_OFF = RING_BYTES + 320, LDS_BYTES = 147456;

#define GAS __attribute__((address_space(1)))
#define LAS __attribute__((address_space(3)))
typedef unsigned short bf16;
typedef unsigned v4u __attribute__((ext_vector_type(4)));
typedef unsigned v2u __attribute__((ext_vector_type(2)));
typedef float f32x4 __attribute__((ext_vector_type(4)));
typedef GAS unsigned gu32;
#define LDS_WAIT() asm volatile("s_waitcnt lgkmcnt(0)" ::: "memory")
#define VM_WAIT() asm volatile("s_waitcnt vmcnt(0)" ::: "memory")
__device__ __forceinline__ unsigned f2bf(float f) { unsigned u = __builtin_bit_cast(unsigned, f); return (u + 0x7fffu + ((u >> 16) & 1u)) >> 16; }
__device__ __forceinline__ unsigned pk2(float lo, float hi) { return f2bf(lo) | (f2bf(hi) << 16); }
__device__ __forceinline__ float bflo(unsigned w) { return __builtin_bit_cast(float, w << 16); }
__device__ __forceinline__ float bfhi(unsigned w) { return __builtin_bit_cast(float, w & 0xffff0000u); }
__device__ __forceinline__ float bf1(bf16 h) { return __builtin_bit_cast(float, (unsigned)h << 16); }
__device__ __forceinline__ float wave_sum(float v) {
#pragma unroll
    for (int o = 1; o < 64; o <<= 1) v += __shfl_xor(v, o);
    return v;
}
__device__ __forceinline__ float wave_max(float v) {
#pragma unroll
    for (int o = 1; o < 64; o <<= 1) v = fmaxf(v, __shfl_xor(v, o));
    return v;
}

typedef float f32x2 __attribute__((ext_vector_type(2)));
__device__ __forceinline__ void cvt16_fp8(const v4u w, float (&o)[16]) {
    const unsigned ww[4] = {w.x, w.y, w.z, w.w};
#pragma unroll
    for (int i = 0; i < 4; ++i) { const f32x2 a = __builtin_amdgcn_cvt_pk_f32_fp8((int)ww[i], false), b = __builtin_amdgcn_cvt_pk_f32_fp8((int)ww[i], true);
        o[4 * i] = a.x; o[4 * i + 1] = a.y; o[4 * i + 2] = b.x; o[4 * i + 3] = b.y; }
}
__device__ __forceinline__ void p0_row_fp8(const float* src, unsigned char* dst, float* sc, int row, int lane) {
    const GAS f32x4* sp = (const GAS f32x4*)(src + (size_t)row * D + 16 * lane);
    const f32x4 a = sp[0], b = sp[1], c = sp[2], d = sp[3];
    float mx = 0.f;
#pragma unroll
    for (int i = 0; i < 4; ++i) mx = fmaxf(fmaxf(fmaxf(mx, fabsf(a[i])), fmaxf(fabsf(b[i]), fabsf(c[i]))), fabsf(d[i]));
    mx = wave_max(mx); const float s = mx > 0.f ? 224.0f / mx : 1.0f;
    v4u o; int w;
    w = __builtin_amdgcn_cvt_pk_fp8_f32(a[0] * s, a[1] * s, 0, false); w = __builtin_amdgcn_cvt_pk_fp8_f32(a[2] * s, a[3] * s, w, true); o.x = (unsigned)w;
    w = __builtin_amdgcn_cvt_pk_fp8_f32(b[0] * s, b[1] * s, 0, false); w = __builtin_amdgcn_cvt_pk_fp8_f32(b[2] * s, b[3] * s, w, true); o.y = (unsigned)w;
    w = __builtin_amdgcn_cvt_pk_fp8_f32(c[0] * s, c[1] * s, 0, false); w = __builtin_amdgcn_cvt_pk_fp8_f32(c[2] * s, c[3] * s, w, true); o.z = (unsigned)w;
    w = __builtin_amdgcn_cvt_pk_fp8_f32(d[0] * s, d[1] * s, 0, false); w = __builtin_amdgcn_cvt_pk_fp8_f32(d[2] * s, d[3] * s, w, true); o.w = (unsigned)w;
    *(GAS v4u*)(dst + (size_t)row * D + 16 * lane) = o;
    if (lane == 0) sc[row] = mx > 0.f ? mx * (1.0f / 224.0f) : 1.0f;
}

__device__ __forceinline__ unsigned pack4_i8(float a, float b, float c, float d) { return ((unsigned)__float2int_rn(a) & 0xffu) | (((unsigned)__float2int_rn(b) & 0xffu) << 8) | (((unsigned)__float2int_rn(c) & 0xffu) << 16) | (((unsigned)__float2int_rn(d) & 0xffu) << 24); }
__device__ __forceinline__ void p0_row_i8(const float* src, unsigned char* dst, float* sc, int row, int lane) {
    const GAS f32x4* sp = (const GAS f32x4*)(src + (size_t)row * D + 16 * lane);
    const f32x4 a = sp[0], b = sp[1], c = sp[2], d = sp[3];
    float mx = 0.f;
#pragma unroll
    for (int i = 0; i < 4; ++i) mx = fmaxf(fmaxf(fmaxf(mx, fabsf(a[i])), fmaxf(fabsf(b[i]), fabsf(c[i]))), fabsf(d[i]));
    mx = wave_max(mx); const float s = mx > 0.f ? 127.0f / mx : 1.0f;
    v4u o; o.x = pack4_i8(a[0] * s, a[1] * s, a[2] * s, a[3] * s); o.y = pack4_i8(b[0] * s, b[1] * s, b[2] * s, b[3] * s); o.z = pack4_i8(c[0] * s, c[1] * s, c[2] * s, c[3] * s); o.w = pack4_i8(d[0] * s, d[1] * s, d[2] * s, d[3] * s);
    *(GAS v4u*)(dst + (size_t)row * D + 16 * lane) = o;
    if (lane == 0) sc[row] = mx > 0.f ? mx * (1.0f / 127.0f) : 1.0f;
}

__device__ __forceinline__ unsigned pack8_i4(const f32x4 a, const f32x4 b, float s) {
    unsigned w = 0;
#pragma unroll
    for (int i = 0; i < 4; ++i) { const int qa = max(-8, min(7, __float2int_rn(a[i] * s))), qb = max(-8, min(7, __float2int_rn(b[i] * s))); w |= ((unsigned)qa & 15u) << (4 * i); w |= ((unsigned)qb & 15u) << (16 + 4 * i); }
    return w;
}
__device__ __forceinline__ void p0_row_i4(const f32x4 a, const f32x4 b, const f32x4 c, const f32x4 d, unsigned char* dst, float* sc, int row, int lane) {
    float ss = 0.f;
#pragma unroll
    for (int i = 0; i < 4; ++i) ss += (a[i] * a[i] + b[i] * b[i]) + (c[i] * c[i] + d[i] * d[i]);
    ss = wave_sum(ss); const float sig = sqrtf(ss * (1.f / D)), s = sig > 0.f ? 3.0f / sig : 1.0f;
    v2u o; o.x = pack8_i4(a, b, s); o.y = pack8_i4(c, d, s);
    *(GAS v2u*)(dst + (size_t)row * (D / 2) + 8 * lane) = o;
    if (lane == 0) sc[row] = sig > 0.f ? sig * (1.0f / 3.0f) : 1.0f;
}

__device__ __forceinline__ unsigned pack8_fp4(const f32x4 a, const f32x4 b, float s) {
    unsigned w = 0;
    w = __builtin_amdgcn_cvt_scalef32_pk_fp4_f32(w, fminf(fmaxf(a[0] * s, -6.f), 6.f), fminf(fmaxf(a[1] * s, -6.f), 6.f), 1.0f, 0);
    w = __builtin_amdgcn_cvt_scalef32_pk_fp4_f32(w, fminf(fmaxf(a[2] * s, -6.f), 6.f), fminf(fmaxf(a[3] * s, -6.f), 6.f), 1.0f, 1);
    w = __builtin_amdgcn_cvt_scalef32_pk_fp4_f32(w, fminf(fmaxf(b[0] * s, -6.f), 6.f), fminf(fmaxf(b[1] * s, -6.f), 6.f), 1.0f, 2);
    w = __builtin_amdgcn_cvt_scalef32_pk_fp4_f32(w, fminf(fmaxf(b[2] * s, -6.f), 6.f), fminf(fmaxf(b[3] * s, -6.f), 6.f), 1.0f, 3);
    return w;
}
__device__ __forceinline__ void p0_row_fp4(const f32x4 a, const f32x4 b, const f32x4 c, const f32x4 d, unsigned char* dst, float* sc, int row, int lane) {
    float mx = 0.f;
#pragma unroll
    for (int i = 0; i < 4; ++i) mx = fmaxf(fmaxf(fmaxf(mx, fabsf(a[i])), fmaxf(fabsf(b[i]), fabsf(c[i]))), fabsf(d[i]));
    mx = wave_max(mx); const float s = mx > 0.f ? 7.0f / mx : 1.0f;
    v2u o; o.x = pack8_fp4(a, b, s); o.y = pack8_fp4(c, d, s);
    *(GAS v2u*)(dst + (size_t)row * (D / 2) + 8 * lane) = o;
    if (lane == 0) sc[row] = mx > 0.f ? mx * (1.0f / 7.0f) : 1.0f;
}
#define XB_TMO      128
#define XB_XCNT(j)  (256  + 64 * (j))
#define XB_XSUB(j)  (1280 + 64 * (j))
#define XB_XGEN(j)  (2304 + 64 * (j))
#define XB_TOP      3328
#define XB_TOPGEN   3392
#define XCD_BAR_WORDS 3456
#define XB_SPIN_CAP (1u << 18)

__device__ __forceinline__ unsigned xb_ld(unsigned* p)              { return __hip_atomic_load(p, __ATOMIC_RELAXED, __HIP_MEMORY_SCOPE_AGENT); }
__device__ __forceinline__ unsigned xb_add(unsigned* p, unsigned v) { return __hip_atomic_fetch_add(p, v, __ATOMIC_RELAXED, __HIP_MEMORY_SCOPE_AGENT); }
__device__ __forceinline__ unsigned xb_xcc_id() { return (unsigned)__builtin_amdgcn_s_getreg((3 << 11) | 20) & 0xFu; }
#define XB_SPIN(cond, bar) do { unsigned _sp = 0; while (cond) { __builtin_amdgcn_s_sleep(1); \
    if ((++_sp & 255u) == 0u) { if (xb_ld(&(bar)[XB_TMO])) break; if (_sp > XB_SPIN_CAP) { atomicAdd(&(bar)[XB_TMO], 1u); break; } } } } while (0)

struct XcdBarrier {
    unsigned* bar; unsigned x;
    volatile LAS unsigned* st;
};

__device__ __forceinline__ XcdBarrier xcd_barrier_post(unsigned* bar, volatile LAS unsigned* st) {
    XcdBarrier b; b.bar = bar; b.x = xb_xcc_id(); b.st = st;
    if (threadIdx.x == 0) (void)xb_add(&bar[XB_XCNT(b.x)], 1u);
    return b;
}
__device__ __forceinline__ void xcd_barrier_complete(unsigned* bar, unsigned x, unsigned& nloc, unsigned& nx) {
    const unsigned G = gridDim.x * gridDim.y * gridDim.z;
    unsigned sum, cnt, mine, sp = 0u;
    for (;;) {
        sum = 0u; cnt = 0u; mine = 0u;
#pragma unroll
        for (unsigned j = 0; j < 16; ++j) { const unsigned c = xb_ld(&bar[XB_XCNT(j)]); sum += c; cnt += (c > 0u) ? 1u : 0u; mine = (j == x) ? c : mine; }
        if (sum == G) break;
        __builtin_amdgcn_s_sleep(1);
        if ((++sp & 255u) == 0u) { if (xb_ld(&bar[XB_TMO])) break; if (sp > XB_SPIN_CAP) { atomicAdd(&bar[XB_TMO], 1u); break; } }
    }
    nloc = mine > 0u ? mine : 1u; nx = cnt > 0u ? cnt : 1u;
}

__device__ __forceinline__ void xcd_barrier(const XcdBarrier& b) {
    asm volatile("s_waitcnt vmcnt(0)" ::: "memory");
    __syncthreads();
    if (threadIdx.x == 0) {
        unsigned* bar = b.bar;
        __builtin_amdgcn_s_waitcnt(0);
        unsigned nloc = b.st[0], nx = b.st[1];
        if (nloc == 0u) { xcd_barrier_complete(bar, b.x, nloc, nx); b.st[0] = nloc; b.st[1] = nx; }
        const unsigned old = xb_add(&bar[XB_XSUB(b.x)], 1u);
        const unsigned gen = old / nloc;
        if (old + 1u == (gen + 1u) * nloc) {
            __builtin_amdgcn_fence(__ATOMIC_RELEASE, "agent");
            asm volatile("s_waitcnt vmcnt(0)" ::: "memory");
            const unsigned og = xb_add(&bar[XB_TOP], 1u);
            const unsigned tg = og / nx;
            if (og + 1u == (tg + 1u) * nx) xb_add(&bar[XB_TOPGEN], 1u);
            else XB_SPIN(xb_ld(&bar[XB_TOPGEN]) == tg, bar);
            __builtin_amdgcn_fence(__ATOMIC_ACQUIRE, "agent");
            xb_add(&bar[XB_XGEN(b.x)], 1u);
            asm volatile("s_waitcnt vmcnt(0)" ::: "memory");
        } else {
            XB_SPIN(xb_ld(&bar[XB_XGEN(b.x)]) == gen, bar);
            __builtin_amdgcn_fence(__ATOMIC_ACQUIRE, "agent");
            asm volatile("s_waitcnt vmcnt(0)" ::: "memory");
        }
    }
    __syncthreads();
}
struct Args { const void* in[21]; float* out; unsigned char* ws; int ph_lo, ph_hi; };
enum { I_X = 0, I_C, I_POS, I_WMOD, I_BMOD, I_GPRE1, I_GPOST1, I_WIN, I_CONVW, I_BI, I_BF, I_MNG, I_SINK, I_WOUT, I_GPRE2, I_GPOST2, I_WQ, I_K1, I_K2, I_U, I_V };

__device__ __forceinline__ int newcol(int o) {
    if (o < 640) { const int hd = o >> 6, d = o & 63; return (hd << 6) + 2 * (d & 31) + (d >> 5); }
    if (o < 1792) return o;
    if (o < 1800) return 2304 + (o - 1792);
    return o - 8;
}
template <bool REMAP>
__device__ __forceinline__ void p0_transpose_item(const float* W, int K, int N, bf16* WT, LAS float* scr, int item, int lane) {
    const int nblk = (N + 31) / 32, kb = item / nblk, nb = item % nblk, k0 = 64 * kb, n0 = 32 * nb;
    const int ncol = n0 + (lane & 31);
#pragma unroll 8
    for (int i = 0; i < 32; ++i) { const int kk = 2 * i + (lane >> 5); scr[kk * 33 + (lane & 31)] = (ncol < N) ? W[(size_t)(k0 + kk) * N + ncol] : 0.f; }
    LDS_WAIT(); asm volatile("" ::: "memory");
    const int c = lane & 7;
#pragma unroll
    for (int j = 0; j < 4; ++j) { const int n = (lane >> 3) + 8 * j; const LAS float* s = scr + (8 * c) * 33 + n;
        v4u o; o.x = pk2(s[0 * 33], s[1 * 33]); o.y = pk2(s[2 * 33], s[3 * 33]); o.z = pk2(s[4 * 33], s[5 * 33]); o.w = pk2(s[6 * 33], s[7 * 33]);
        if (n0 + n < N) { const int drow = REMAP ? newcol(n0 + n) : (n0 + n); *(GAS v4u*)(WT + (size_t)drow * K + k0 + 8 * c) = o; } }
    LDS_WAIT(); asm volatile("" ::: "memory");
}
__device__ __forceinline__ void p0_convert(const float* src, bf16* dst, size_t n, int gt, int ngt) {
    for (size_t i = (size_t)gt * 8; i < n; i += (size_t)ngt * 8) {
        const f32x4 a = *(const GAS f32x4*)(src + i), b = *(const GAS f32x4*)(src + i + 4);
        v4u o; o.x = pk2(a[0], a[1]); o.y = pk2(a[2], a[3]); o.z = pk2(b[0], b[1]); o.w = pk2(b[2], b[3]);
        *(GAS v4u*)(dst + i) = o; }
}
__device__ __forceinline__ void phase_mod(const Args& A, LAS unsigned char* lds) {
    const int tid = threadIdx.x, G = gridDim.x, blk = blockIdx.x;
    unsigned char* ws = A.ws;
    const float* c = (const float*)A.in[I_C]; const float* wm = (const float*)A.in[I_WMOD]; const float* bm = (const float*)A.in[I_BMOD];
    float* mod = (float*)(ws + WS_MOD); LAS float* cs = (LAS float*)lds; LAS float* red = cs + 8 * 1024;
    for (int e = tid; e < 8 * 1024 / 4; e += NTHR) *(LAS f32x4*)(cs + 4 * e) = *(const GAS f32x4*)(c + 4 * e);
    __syncthreads();
    for (int it = blk; it < 6144 / 24; it += G) {
        const int kg = tid >> 5, col = tid & 31, j = it * 24 + (col < 24 ? col : 23); float acc[8];
#pragma unroll
        for (int b = 0; b < 8; ++b) acc[b] = 0.f;
#pragma unroll 16
        for (int i = 0; i < 64; ++i) { const int k = kg + 16 * i; const float w = wm[(size_t)k * 6144 + j];
#pragma unroll
            for (int b = 0; b < 8; ++b) acc[b] += cs[b * 1024 + k] * w; }
#pragma unroll
        for (int b = 0; b < 8; ++b) red[(kg * 32 + col) * 8 + b] = acc[b];
        __syncthreads();
        if (tid < 256) { const int b = tid >> 5, cc = tid & 31; float s = 0.f;
#pragma unroll
            for (int g = 0; g < 16; ++g) s += red[(g * 32 + cc) * 8 + b];
            if (cc < 24) mod[b * 6144 + it * 24 + cc] = s + bm[it * 24 + cc]; }
        __syncthreads();
    }
}
__device__ __forceinline__ void phase_convert(const Args& A, LAS unsigned char* lds) {
    const int tid = threadIdx.x, lane = tid & 63, wave = tid >> 6, G = gridDim.x, blk = blockIdx.x;
    unsigned char* ws = A.ws;
    {
        LAS float* scr = (LAS float*)(lds + wave * 16384);
        const int gw = blk * NWAVES + wave, NGW = G * NWAVES;
        const int I_IN = (D / 64) * ((DIN + 31) / 32), I_OUT = (D / 64) * (D / 32), I_Q = (D / 64) * (2048 / 32);
        bf16* win = (bf16*)(ws + WS_WIN); bf16* wout = (bf16*)(ws + WS_WOUT); bf16* wq = (bf16*)(ws + WS_WQ);
        for (int it = gw; it < I_IN + I_OUT + I_Q; it += NGW) {
            int r = it;
            if (r < I_IN) { p0_transpose_item<true>((const float*)A.in[I_WIN], D, DIN, win, scr, r, lane); continue; } r -= I_IN;
            if (r < I_OUT) { p0_transpose_item<false>((const float*)A.in[I_WOUT], D, D, wout, scr, r, lane); continue; } r -= I_OUT;
            p0_transpose_item<false>((const float*)A.in[I_WQ], D, 2048, wq, scr, r, lane);
        }
        const int gt = blk * NTHR + tid, ngt = G * NTHR;
        for (int i = gt; i < (NIN_PAD - DIN) * D / 8; i += ngt) *(GAS v4u*)(win + (size_t)DIN * D + (size_t)i * 8) = (v4u){0u, 0u, 0u, 0u};
        p0_convert((const float*)A.in[I_K1], (bf16*)(ws + WS_KEYS), (size_t)8 * 128 * 128, gt, ngt);
        p0_convert((const float*)A.in[I_K2], (bf16*)(ws + WS_KEYS) + 8 * 128 * 128, (size_t)8 * 128 * 128, gt, ngt);
        {
            const float* usrc = (const float*)A.in[I_U]; const float* vsrc = (const float*)A.in[I_V];
            auto rowp = [&](int r) { return (const GAS f32x4*)((r < NEXP ? usrc + (size_t)r * D : vsrc + (size_t)(r - NEXP) * D) + 16 * lane); };
            int r = gw; const GAS f32x4* sp = rowp(min(r, 2 * NEXP - 1)); f32x4 a = sp[0], b = sp[1], c = sp[2], d = sp[3];
            for (; r < 2 * NEXP; r += NGW) { const GAS f32x4* sn = rowp(min(r + NGW, 2 * NEXP - 1)); const f32x4 an = sn[0], bn = sn[1], cn = sn[2], dn = sn[3];
                if (r < NEXP) p0_row_i4(a, b, c, d, ws + WS_U8, (float*)(ws + WS_SC), r, lane); else p0_row_fp4(a, b, c, d, ws + WS_V8, (float*)(ws + WS_SC) + NEXP, r - NEXP, lane);
                a = an; b = bn; c = cn; d = dn; }
        }
    }
}

__device__ __forceinline__ void phase_prenorm(const Args& A, LAS unsigned char* lds) {
    const int tid = threadIdx.x, lane = tid & 63, wave = tid >> 6, G = gridDim.x;
    const float* x = (const float*)A.in[I_X]; const float* g = (const float*)A.in[I_GPRE1]; const float* mod = (const float*)(A.ws + WS_MOD);
    bf16* H = (bf16*)(A.ws + WS_H); float* gates = (float*)(A.ws + WS_GATES);
    LAS float* wg = (LAS float*)lds;
    __syncthreads();
    for (int k = tid; k < D; k += NTHR) { const float* wr = (const float*)A.in[I_WIN] + (size_t)k * DIN + 1792; const f32x4 w0 = *(const GAS f32x4*)wr, w1 = *(const GAS f32x4*)(wr + 4);
#pragma unroll
        for (int j = 0; j < 4; ++j) { wg[j * D + k] = w0[j]; wg[(4 + j) * D + k] = w1[j]; } }
    __syncthreads();
    const int gi = ((lane >> 5) & 1) * 4 + ((lane >> 4) & 1) * 2 + ((lane >> 3) & 1);
    const float gbias = gi < 4 ? ((const float*)A.in[I_BI])[gi] : ((const float*)A.in[I_BF])[gi - 4];
    f32x4 gg[4];
#pragma unroll
    for (int j = 0; j < 4; ++j) gg[j] = *(const GAS f32x4*)(g + 4 * (lane + 64 * j));
    const int stride = G * NWAVES; int row = blockIdx.x * NWAVES + wave;
    f32x4 v[4], vn[4], shv[4], gsv[4]; int bcur = -1;
#pragma unroll
    for (int j = 0; j < 4; ++j) v[j] = ((const GAS f32x4*)(x + (size_t)row * D) + lane)[64 * j];
    for (; row < M; row += stride) {
        const int rn = min(row + stride, M - 1);
#pragma unroll
        for (int j = 0; j < 4; ++j) vn[j] = ((const GAS f32x4*)(x + (size_t)rn * D) + lane)[64 * j];
        const int b = row / SEQ; float s = 0.f;
        if (b != bcur) { bcur = b;
#pragma unroll
            for (int j = 0; j < 4; ++j) { const int k = 4 * (lane + 64 * j); shv[j] = *(const GAS f32x4*)(mod + b * 6144 + k); const f32x4 sc = *(const GAS f32x4*)(mod + b * 6144 + 1024 + k);
#pragma unroll
                for (int i = 0; i < 4; ++i) gsv[j][i] = gg[j][i] * (1.f + sc[i]); } }
#pragma unroll
        for (int j = 0; j < 4; ++j) s += (v[j][0] * v[j][0] + v[j][1] * v[j][1]) + (v[j][2] * v[j][2] + v[j][3] * v[j][3]);
        const float rstd = 1.0f / sqrtf(wave_sum(s) * (1.f / D) + EPS);
        GAS v2u* o = (GAS v2u*)(H + (size_t)row * D) + lane;
        float gd[8];
#pragma unroll
        for (int q = 0; q < 8; ++q) gd[q] = 0.f;
#pragma unroll
        for (int j = 0; j < 4; ++j) {
            f32x4 y;
#pragma unroll
            for (int i = 0; i < 4; ++i) y[i] = v[j][i] * rstd * gsv[j][i] + shv[j][i];
            v2u w; w.x = pk2(y[0], y[1]); w.y = pk2(y[2], y[3]); o[64 * j] = w;
#pragma unroll
            for (int q = 0; q < 8; ++q) { const f32x4 ww = *(LAS const f32x4*)(wg + q * D + 4 * (lane + 64 * j)); gd[q] += (y[0] * ww[0] + y[1] * ww[1]) + (y[2] * ww[2] + y[3] * ww[3]); } }
#pragma unroll
        for (int i = 0; i < 4; ++i) { const bool up = (lane & 32) != 0; const float keep = up ? gd[i + 4] : gd[i], send = up ? gd[i] : gd[i + 4]; gd[i] = keep + __shfl_xor(send, 32); }
#pragma unroll
        for (int i = 0; i < 2; ++i) { const bool up = (lane & 16) != 0; const float keep = up ? gd[i + 2] : gd[i], send = up ? gd[i] : gd[i + 2]; gd[i] = keep + __shfl_xor(send, 16); }
        { const bool up = (lane & 8) != 0; const float keep = up ? gd[1] : gd[0], send = up ? gd[0] : gd[1]; gd[0] = keep + __shfl_xor(send, 8); }
        float gv = gd[0]; gv += __shfl_xor(gv, 4); gv += __shfl_xor(gv, 2); gv += __shfl_xor(gv, 1); gv += gbias;
        if ((lane & 7) == 0) gates[(size_t)row * 8 + gi] = gi < 4 ? gv : (fminf(gv, 0.f) - log1pf(__expf(-fabsf(gv))));
#pragma unroll
        for (int j = 0; j < 4; ++j) v[j] = vn[j];
    }
}

__device__ __forceinline__ void phase_mid(const Args& A) {
    const int tid = threadIdx.x, lane = tid & 63, wave = tid >> 6, G = gridDim.x;
    const float* x = (const float*)A.in[I_X]; const float* gpost = (const float*)A.in[I_GPOST1]; const float* gpre = (const float*)A.in[I_GPRE2];
    const float* mod = (const float*)(A.ws + WS_MOD); const float* sumsq = (const float*)(A.ws + WS_SSQ);
    const bf16* MIX = (const bf16*)(A.ws + WS_MIX); bf16* H = (bf16*)(A.ws + WS_H); bf16* X1 = (bf16*)(A.ws + WS_X1);
    const int stride = G * NWAVES; int row = blockIdx.x * NWAVES + wave;
    f32x4 xv[4], xn[4], q[4], qn[4], g1p[4], gs2[4], sh2[4]; v2u mw[4], mn[4]; int bcur = -1;
#pragma unroll
    for (int j = 0; j < 4; ++j) { xv[j] = ((const GAS f32x4*)(x + (size_t)row * D) + lane)[64 * j]; mw[j] = ((const GAS v2u*)(MIX + (size_t)row * D) + lane)[64 * j]; q[j] = *(const GAS f32x4*)(sumsq + (size_t)row * 16 + 4 * j); }
    for (; row < M; row += stride) {
        const int rn = min(row + stride, M - 1);
#pragma unroll
        for (int j = 0; j < 4; ++j) { xn[j] = ((const GAS f32x4*)(x + (size_t)rn * D) + lane)[64 * j]; mn[j] = ((const GAS v2u*)(MIX + (size_t)rn * D) + lane)[64 * j]; qn[j] = *(const GAS f32x4*)(sumsq + (size_t)rn * 16 + 4 * j); }
        const int b = row / SEQ;
        if (b != bcur) { bcur = b;
#pragma unroll
            for (int j = 0; j < 4; ++j) { const int k = 4 * (lane + 64 * j); const f32x4 gp = *(const GAS f32x4*)(gpost + k), g1 = *(const GAS f32x4*)(mod + b * 6144 + 2048 + k), gg = *(const GAS f32x4*)(gpre + k), sc = *(const GAS f32x4*)(mod + b * 6144 + 4096 + k);
                sh2[j] = *(const GAS f32x4*)(mod + b * 6144 + 3072 + k);
#pragma unroll
                for (int i = 0; i < 4; ++i) { g1p[j][i] = g1[i] * gp[i]; gs2[j][i] = gg[i] * (1.f + sc[i]); } } }
        const float rm = 1.0f / sqrtf(((((q[0][0] + q[0][1]) + (q[0][2] + q[0][3])) + ((q[1][0] + q[1][1]) + (q[1][2] + q[1][3]))) + (((q[2][0] + q[2][1]) + (q[2][2] + q[2][3])) + ((q[3][0] + q[3][1]) + (q[3][2] + q[3][3])))) * (1.f / D) + EPS);
        f32x4 v[4]; float s = 0.f;
#pragma unroll
        for (int j = 0; j < 4; ++j) {
            const float mx[4] = {bflo(mw[j].x), bfhi(mw[j].x), bflo(mw[j].y), bfhi(mw[j].y)};
#pragma unroll
            for (int i = 0; i < 4; ++i) { v[j][i] = xv[j][i] + g1p[j][i] * (mx[i] * rm); s += v[j][i] * v[j][i]; }
            { v2u w; w.x = pk2(v[j][0], v[j][1]); w.y = pk2(v[j][2], v[j][3]); *((GAS v2u*)(X1 + (size_t)row * D) + lane + 64 * j) = w; } }
        const float rstd = 1.0f / sqrtf(wave_sum(s) * (1.f / D) + EPS);
        GAS v2u* o = (GAS v2u*)(H + (size_t)row * D) + lane; float amx = 0.f;
#pragma unroll
        for (int j = 0; j < 4; ++j) {
#pragma unroll
            for (int i = 0; i < 4; ++i) { v[j][i] = v[j][i] * rstd * gs2[j][i] + sh2[j][i]; amx = fmaxf(amx, fabsf(v[j][i])); }
            v2u w; w.x = pk2(v[j][0], v[j][1]); w.y = pk2(v[j][2], v[j][3]); o[64 * j] = w; }
        amx = wave_max(amx); const float s8 = amx > 0.f ? 119.0f / amx : 1.0f;
        GAS unsigned short* ohh = (GAS unsigned short*)((unsigned char*)A.ws + WS_H8 + (size_t)row * (D / 2)) + lane; GAS unsigned short* ohl = (GAS unsigned short*)((unsigned char*)A.ws + WS_H8 + 32 * MiB + (size_t)row * (D / 2)) + lane;
#pragma unroll
        for (int j = 0; j < 4; ++j) { unsigned whh = 0, whl = 0;
#pragma unroll
            for (int i = 0; i < 4; ++i) { const int tq = __float2int_rn(v[j][i] * s8) + 8; whh |= ((unsigned)(tq >> 4) & 15u) << (4 * i); whl |= ((unsigned)((tq & 15) - 8) & 15u) << (4 * i); }
            ohh[64 * j] = (unsigned short)whh; ohl[64 * j] = (unsigned short)whl; }
        if (lane == 0) ((float*)(A.ws + WS_HS))[row] = amx > 0.f ? amx * (1.0f / 119.0f) : 1.0f;
#pragma unroll
        for (int j = 0; j < 4; ++j) { xv[j] = xn[j]; mw[j] = mn[j]; q[j] = qn[j]; }
    }
}
__device__ __forceinline__ void load64bf(const bf16* p, float (&o)[64]) {
#pragma unroll
    for (int i = 0; i < 8; ++i) { const v4u w = *(const GAS v4u*)(p + 8 * i);
        o[8 * i + 0] = bflo(w.x); o[8 * i + 1] = bfhi(w.x); o[8 * i + 2] = bflo(w.y); o[8 * i + 3] = bfhi(w.y);
        o[8 * i + 4] = bflo(w.z); o[8 * i + 5] = bfhi(w.z); o[8 * i + 6] = bflo(w.w); o[8 * i + 7] = bfhi(w.w); }
}
__device__ __forceinline__ void phase_attn_naive(const Args& A, int vb, int nvb) {
    const bf16* P = (const bf16*)(A.ws + WS_PROJ); bf16* MI = (bf16*)(A.ws + WS_MIXIN); const float* sinks = (const float*)A.in[I_SINK];
    for (int task = vb * NTHR + (int)threadIdx.x; task < 8 * M; task += nvb * NTHR) {
        const int h = task / M, t = task % M, s = t % SEQ, kvh = h >> 2;
        float q[64], o[64];
        load64bf(P + (size_t)t * NPROJ + C_AQ + h * 64, q);
#pragma unroll
        for (int d = 0; d < 64; ++d) o[d] = 0.f;
        float mx = sinks[h], l = 1.f;
        for (int j = 0; j < 128; ++j) {
            const int sj = s - 127 + j; const bool valid = sj >= 0; const int tk = valid ? (t - 127 + j) : t;
            const bf16* kr = P + (size_t)tk * NPROJ + C_AK + kvh * 64; float sc = 0.f;
#pragma unroll
            for (int i = 0; i < 8; ++i) { const v4u w = *(const GAS v4u*)(kr + 8 * i);
                sc += q[8 * i + 0] * bflo(w.x) + q[8 * i + 1] * bfhi(w.x) + q[8 * i + 2] * bflo(w.y) + q[8 * i + 3] * bfhi(w.y)
                    + q[8 * i + 4] * bflo(w.z) + q[8 * i + 5] * bfhi(w.z) + q[8 * i + 6] * bflo(w.w) + q[8 * i + 7] * bfhi(w.w); }
            if (valid) {
                const float mn = fmaxf(mx, sc), al = __expf(mx - mn), p = __expf(sc - mn); mx = mn; l = l * al + p;
                const bf16* vr = P + (size_t)tk * NPROJ + C_AV + kvh * 64;
#pragma unroll
                for (int i = 0; i < 8; ++i) { const v4u w = *(const GAS v4u*)(vr + 8 * i);
                    o[8 * i + 0] = o[8 * i + 0] * al + p * bflo(w.x); o[8 * i + 1] = o[8 * i + 1] * al + p * bfhi(w.x);
                    o[8 * i + 2] = o[8 * i + 2] * al + p * bflo(w.y); o[8 * i + 3] = o[8 * i + 3] * al + p * bfhi(w.y);
                    o[8 * i + 4] = o[8 * i + 4] * al + p * bflo(w.z); o[8 * i + 5] = o[8 * i + 5] * al + p * bfhi(w.z);
                    o[8 * i + 6] = o[8 * i + 6] * al + p * bflo(w.w); o[8 * i + 7] = o[8 * i + 7] * al + p * bfhi(w.w); }
            }
        }
        const float il = 1.f / l; bf16* orow = MI + (size_t)t * D + h * 64;
#pragma unroll
        for (int i = 0; i < 8; ++i) { v4u w; w.x = pk2(o[8 * i] * il, o[8 * i + 1] * il); w.y = pk2(o[8 * i + 2] * il, o[8 * i + 3] * il);
            w.z = pk2(o[8 * i + 4] * il, o[8 * i + 5] * il); w.w = pk2(o[8 * i + 6] * il, o[8 * i + 7] * il); *(GAS v4u*)(orow + 8 * i) = w; }
    }
}

__device__ __forceinline__ void phase_mlstm_naive(const Args& A, LAS unsigned char* lds, int bh) {
    const int tid = threadIdx.x, lane = tid & 63, wave = tid >> 6, b = bh >> 2, h = bh & 3, dv = tid >> 2, part = tid & 3;
    const bf16* P = (const bf16*)(A.ws + WS_PROJ); bf16* MI = (bf16*)(A.ws + WS_MIXIN); const float* gates = (const float*)(A.ws + WS_GATES);
    const float* cw = (const float*)A.in[I_CONVW]; const float* ng = (const float*)A.in[I_MNG];
    LAS float* qs = (LAS float*)lds; LAS float* ks = qs + 64 * 64; LAS float* vs = ks + 64 * 64; LAS float* ig = vs + 64 * 128; LAS float* lfg = ig + 64; LAS float* hb = lfg + 64;
    float C[16], n[16]; float m = 0.f;
#pragma unroll
    for (int j = 0; j < 16; ++j) { C[j] = 0.f; n[j] = 0.f; }
    for (int ch = 0; ch < SEQ / 64; ++ch) {
        const int s0 = ch * 64; const size_t t0 = (size_t)b * SEQ + s0;
        for (int e = tid; e < 64 * 64; e += NTHR) { const int l = e >> 6, dk = e & 63; float aq = 0.f, ak = 0.f;
#pragma unroll
            for (int j = 0; j < 4; ++j) { const int sj = s0 + l - 3 + j; if (sj >= 0) { const bf16* r = P + ((size_t)b * SEQ + sj) * NPROJ;
                aq += cw[j * 512 + h * 64 + dk] * bf1(r[C_MQ + h * 64 + dk]); ak += cw[j * 512 + 256 + h * 64 + dk] * bf1(r[C_MK + h * 64 + dk]); } }
            qs[e] = 0.125f * aq / (1.f + __expf(-aq)); ks[e] = ak / (1.f + __expf(-ak)); }
        for (int e = tid; e < 64 * 128; e += NTHR) { const int l = e >> 7, d = e & 127; vs[e] = bf1(P[(t0 + l) * NPROJ + C_MV + h * 128 + d]); }
        if (tid < 64) { ig[tid] = gates[(t0 + tid) * 8 + h]; lfg[tid] = gates[(t0 + tid) * 8 + 4 + h]; }
        __syncthreads();
        for (int l = 0; l < 64; ++l) {
            const float lf = lfg[l], ii = ig[l], mn = fmaxf(lf + m, ii), fd = __expf(lf + m - mn), iw = __expf(ii - mn), vv = vs[l * 128 + dv] * iw;
            float num = 0.f, den = 0.f;
#pragma unroll
            for (int j = 0; j < 16; ++j) { const float kk = ks[l * 64 + part * 16 + j], qq = qs[l * 64 + part * 16 + j];
                C[j] = fd * C[j] + vv * kk; n[j] = fd * n[j] + iw * kk; num += C[j] * qq; den += n[j] * qq; }
            num += __shfl_xor(num, 1); num += __shfl_xor(num, 2); den += __shfl_xor(den, 1); den += __shfl_xor(den, 2);
            if (part == 0) hb[l * 128 + dv] = num / fmaxf(fabsf(den), __expf(-mn));
            m = mn;
        }
        __syncthreads();
        for (int l = wave * 8; l < wave * 8 + 8; ++l) { const float a0 = hb[l * 128 + lane], a1 = hb[l * 128 + 64 + lane];
            const float r = 1.0f / sqrtf(wave_sum(a0 * a0 + a1 * a1) * (1.f / 128.f) + EPS);
            const bf16* pr = P + (t0 + l) * NPROJ + C_MO + h * 128; bf16* orow = MI + (t0 + l) * D + 512 + h * 128;
            orow[lane] = (bf16)f2bf(a0 * r * ng[h * 128 + lane] * bf1(pr[lane])); orow[64 + lane] = (bf16)f2bf(a1 * r * ng[h * 128 + 64 + lane] * bf1(pr[64 + lane])); }
        __syncthreads();
    }
}

__device__ __forceinline__ void ld16bf(const bf16* p, float (&o)[16]) {
    const v4u w0 = *(const GAS v4u*)p, w1 = *(const GAS v4u*)(p + 8);
    o[0] = bflo(w0.x); o[1] = bfhi(w0.x); o[2] = bflo(w0.y); o[3] = bfhi(w0.y); o[4] = bflo(w0.z); o[5] = bfhi(w0.z); o[6] = bflo(w0.w); o[7] = bfhi(w0.w);
    o[8] = bflo(w1.x); o[9] = bfhi(w1.x); o[10] = bflo(w1.y); o[11] = bfhi(w1.y); o[12] = bflo(w1.z); o[13] = bfhi(w1.z); o[14] = bflo(w1.w); o[15] = bfhi(w1.w);
}
typedef short bf16x8 __attribute__((ext_vector_type(8)));
#define MFMA16(a, b, c) __builtin_amdgcn_mfma_f32_16x16x32_bf16((a), (b), (c), 0, 0, 0)
__device__ __forceinline__ bf16x8 ldfrag(LAS const unsigned char* img, int row, int kbyte) { return *(LAS const bf16x8*)(img + row * 144 + kbyte); }
__device__ __forceinline__ bf16x8 ldfrag_sw(LAS const unsigned char* img, int row, int kbyte) { return *(LAS const bf16x8*)(img + row * 144 + (kbyte ^ (((row >> 3) & 7) << 4))); }
__device__ __forceinline__ unsigned cvtpk(float lo, float hi) { unsigned r; asm volatile("v_cvt_pk_bf16_f32 %0, %1, %2" : "=v"(r) : "v"(lo), "v"(hi)); return r; }

namespace ml {
constexpr int O_Q = 0, O_QA = 9216, O_K = 18432, O_KWT = 27648, O_VT = 36864, O_CX = 57600, CXB = 20736, O_S = 99072, O_GB = 108288, O_GA = O_GB + 4096, O_GC = O_GA + 4096, O_DEN = O_GC + 4096, O_SSQ = O_DEN + 256, O_END = O_SSQ + 2048;
static_assert(O_END <= 131072, "mlstm LDS");
constexpr size_t MST_SC = 11 * MiB;
}
template <bool OUT>
__device__ __forceinline__ void mlstm_group(const Args& A, LAS unsigned char* lds, int wg) {
    using namespace ml;
    const int tid = threadIdx.x, lane = tid & 63, wave = __builtin_amdgcn_readfirstlane(tid >> 6), fr = lane & 15, fq = lane >> 4;
    const int bh = wg >> 3, grp = wg & 7, b = bh >> 2, h = bh & 3;
    const size_t tg0 = (size_t)b * SEQ + (size_t)grp * 1024;
    const bf16* P = (const bf16*)(A.ws + WS_PROJ); bf16* MI = (bf16*)(A.ws + WS_MIXIN); const float* gates = (const float*)(A.ws + WS_GATES);
    const float* cw = (const float*)A.in[I_CONVW]; const float* ng = (const float*)A.in[I_MNG];
    float* MST = (float*)(A.ws + WS_MST); float* MSC = (float*)(A.ws + WS_MST + MST_SC);
    LAS float* GB = (LAS float*)(lds + O_GB); LAS float* GA = (LAS float*)(lds + O_GA); LAS float* GC = (LAS float*)(lds + O_GC);
    LAS float* DEN = (LAS float*)(lds + O_DEN); LAS float* SSQ = (LAS float*)(lds + O_SSQ);
    __syncthreads();
#pragma unroll
    for (int cc = 0; cc < 2; ++cc) { const int c = 2 * wave + cc; const size_t t = tg0 + c * 64 + lane;
        float bc = gates[t * 8 + 4 + h]; const float ii = gates[t * 8 + h];
#pragma unroll
        for (int o = 1; o < 64; o <<= 1) { const float v = __shfl_up(bc, o); if (lane >= o) bc += v; }
        const float a = ii - bc; float cm = a;
#pragma unroll
        for (int o = 1; o < 64; o <<= 1) { const float v = __shfl_up(cm, o); if (lane >= o) cm = fmaxf(cm, v); }
        GB[c * 64 + lane] = bc; GA[c * 64 + lane] = a; GC[c * 64 + lane] = cm; }
    for (int e = tid; e < 16 * 32; e += NTHR) { const int r = e >> 5, cpair = e & 31; *(LAS unsigned*)(lds + O_VT + (128 + r) * 144 + cpair * 4) = (r == 0) ? 0x3F803F80u : 0u; }
    f32x4 st[5];
#pragma unroll
    for (int i = 0; i < 5; ++i) st[i] = (f32x4){0.f, 0.f, 0.f, 0.f};
    float m = OUT ? 0.f : -__builtin_inff(); float Btot = 0.f;
    if (OUT) {
        for (int gp = 0; gp < grp; ++gp) { const int wgp = bh * 8 + gp; const float mg = MSC[wgp * 2], Bg = MSC[wgp * 2 + 1];
            const float mn = fmaxf(Bg + m, mg), f0 = __expf(Bg + m - mn), f1 = __expf(mg - mn);
#pragma unroll
            for (int i = 0; i < 5; ++i)
#pragma unroll
                for (int r = 0; r < 4; ++r) st[i][r] = f0 * st[i][r] + f1 * MST[((size_t)wgp * 20 + i * 4 + r) * NTHR + tid];
            m = mn; }
#pragma unroll
        for (int j = 0; j < 4; ++j)
#pragma unroll
            for (int r = 0; r < 4; ++r) *(LAS bf16*)(lds + O_CX + (16 * wave + 4 * fq + r) * 144 + (16 * j + fr) * 2) = (bf16)f2bf(st[j][r]);
        if (wave < 4) {
#pragma unroll
            for (int r = 0; r < 4; ++r) *(LAS bf16*)(lds + O_CX + (128 + 4 * fq + r) * 144 + (16 * wave + fr) * 2) = (bf16)f2bf(st[4][r]); }
    }
    float gsc[4];
#pragma unroll
    for (int r = 0; r < 4; ++r) gsc[r] = ng[h * 128 + 16 * wave + 4 * fq + r];
    const int sl = tid >> 3, cg = tid & 7;
    __syncthreads();
    for (int c = 0; c < 16; ++c) {
        const float bL = GB[c * 64 + 63], M63 = fmaxf(m, GC[c * 64 + 63]), decay = __expf(m - M63);
        const size_t tc0 = tg0 + (size_t)c * 64;
        {
            const int sabs = grp * 1024 + c * 64 + sl;
            float aq[8], ak[8];
#pragma unroll
            for (int i = 0; i < 8; ++i) { aq[i] = 0.f; ak[i] = 0.f; }
#pragma unroll
            for (int j = 0; j < 4; ++j) { const int sj = sabs - 3 + j;
                if (sj >= 0) { const bf16* rp = P + ((size_t)b * SEQ + sj) * NPROJ;
                    const v4u wq = *(const GAS v4u*)(rp + C_MQ + h * 64 + 8 * cg), wk = *(const GAS v4u*)(rp + C_MK + h * 64 + 8 * cg);
                    const f32x4 q0 = *(const GAS f32x4*)(cw + j * 512 + h * 64 + 8 * cg), q1 = *(const GAS f32x4*)(cw + j * 512 + h * 64 + 8 * cg + 4);
                    const f32x4 k0 = *(const GAS f32x4*)(cw + j * 512 + 256 + h * 64 + 8 * cg), k1 = *(const GAS f32x4*)(cw + j * 512 + 256 + h * 64 + 8 * cg + 4);
                    aq[0] += q0[0] * bflo(wq.x); aq[1] += q0[1] * bfhi(wq.x); aq[2] += q0[2] * bflo(wq.y); aq[3] += q0[3] * bfhi(wq.y);
                    aq[4] += q1[0] * bflo(wq.z); aq[5] += q1[1] * bfhi(wq.z); aq[6] += q1[2] * bflo(wq.w); aq[7] += q1[3] * bfhi(wq.w);
                    ak[0] += k0[0] * bflo(wk.x); ak[1] += k0[1] * bfhi(wk.x); ak[2] += k0[2] * bflo(wk.y); ak[3] += k0[3] * bfhi(wk.y);
                    ak[4] += k1[0] * bflo(wk.z); ak[5] += k1[1] * bfhi(wk.z); ak[6] += k1[2] * bflo(wk.w); ak[7] += k1[3] * bfhi(wk.w); } }
            const float Ml = fmaxf(m, GC[c * 64 + sl]), ainter = __expf(m - Ml), wsv = __expf(GA[c * 64 + sl] - M63);
            float qv[8], kv[8];
#pragma unroll
            for (int i = 0; i < 8; ++i) { qv[i] = 0.125f * aq[i] * __builtin_amdgcn_rcpf(1.f + __expf(-aq[i])); kv[i] = ak[i] * __builtin_amdgcn_rcpf(1.f + __expf(-ak[i])); }
            if (OUT) {
                v4u w; w.x = pk2(qv[0], qv[1]); w.y = pk2(qv[2], qv[3]); w.z = pk2(qv[4], qv[5]); w.w = pk2(qv[6], qv[7]); *(LAS v4u*)(lds + O_Q + sl * 144 + cg * 16) = w;
                w.x = pk2(qv[0] * ainter, qv[1] * ainter); w.y = pk2(qv[2] * ainter, qv[3] * ainter); w.z = pk2(qv[4] * ainter, qv[5] * ainter); w.w = pk2(qv[6] * ainter, qv[7] * ainter); *(LAS v4u*)(lds + O_QA + sl * 144 + cg * 16) = w;
                w.x = pk2(kv[0], kv[1]); w.y = pk2(kv[2], kv[3]); w.z = pk2(kv[4], kv[5]); w.w = pk2(kv[6], kv[7]); *(LAS v4u*)(lds + O_K + sl * 144 + cg * 16) = w;
            }
#pragma unroll
            for (int i = 0; i < 8; ++i) *(LAS bf16*)(lds + O_KWT + (8 * cg + i) * 144 + (sl ^ (8 * cg)) * 2) = (bf16)f2bf(kv[i] * wsv);
#pragma unroll
            for (int gi = 0; gi < 2; ++gi) { const int g8 = cg + 8 * gi; const v4u wv = *(const GAS v4u*)(P + (tc0 + sl) * NPROJ + C_MV + h * 128 + 8 * g8);
                const unsigned ww[4] = {wv.x, wv.y, wv.z, wv.w};
#pragma unroll
                for (int i = 0; i < 4; ++i) { *(LAS bf16*)(lds + O_VT + (8 * g8 + 2 * i) * 144 + (sl ^ (8 * cg)) * 2) = (bf16)(ww[i] & 0xffffu); *(LAS bf16*)(lds + O_VT + (8 * g8 + 2 * i + 1) * 144 + (sl ^ (8 * cg)) * 2) = (bf16)(ww[i] >> 16); } }
        }
        __syncthreads();
        v2u mo[4];
        if (OUT) {
#pragma unroll
            for (int lt = 0; lt < 4; ++lt) mo[lt] = *(const GAS v2u*)(P + (tc0 + 16 * lt + fr) * NPROJ + C_MO + h * 128 + 16 * wave + 4 * fq); }
        if (OUT) {
            const int lt = wave >> 1, l = 16 * lt + fr; const float Ml = fmaxf(m, GC[c * 64 + l]);
            const bf16x8 bq0 = ldfrag(lds + O_Q, 16 * lt + fr, 16 * fq), bq1 = ldfrag(lds + O_Q, 16 * lt + fr, 64 + 16 * fq);
#pragma unroll
            for (int u = 0; u < 2; ++u) { const int stl = 2 * (wave & 1) + u; f32x4 acc = {0.f, 0.f, 0.f, 0.f};
                acc = MFMA16(ldfrag(lds + O_K, 16 * stl + fr, 16 * fq), bq0, acc); acc = MFMA16(ldfrag(lds + O_K, 16 * stl + fr, 64 + 16 * fq), bq1, acc);
                const f32x4 av = *(LAS const f32x4*)(GA + c * 64 + 16 * stl + 4 * fq); float wv[4];
#pragma unroll
                for (int r = 0; r < 4; ++r) { const int s = 16 * stl + 4 * fq + r; wv[r] = (s <= l) ? acc[r] * __expf(av[r] - Ml) : 0.f; }
                v2u w; w.x = cvtpk(wv[0], wv[1]); w.y = cvtpk(wv[2], wv[3]); *(LAS v2u*)(lds + O_S + l * 144 + (16 * stl + 4 * fq) * 2) = w; }
        }
        {
            const bf16x8 va0 = ldfrag_sw(lds + O_VT, 16 * wave + fr, 16 * fq), va1 = ldfrag_sw(lds + O_VT, 16 * wave + fr, 64 + 16 * fq);
#pragma unroll
            for (int j = 0; j < 4; ++j) { st[j] = st[j] * decay;
                st[j] = MFMA16(va0, ldfrag_sw(lds + O_KWT, 16 * j + fr, 16 * fq), st[j]); st[j] = MFMA16(va1, ldfrag_sw(lds + O_KWT, 16 * j + fr, 64 + 16 * fq), st[j]); }
            if (wave < 4) { st[4] = st[4] * decay;
                st[4] = MFMA16(ldfrag_sw(lds + O_VT, 128 + fr, 16 * fq), ldfrag_sw(lds + O_KWT, 16 * wave + fr, 16 * fq), st[4]);
                st[4] = MFMA16(ldfrag_sw(lds + O_VT, 128 + fr, 64 + 16 * fq), ldfrag_sw(lds + O_KWT, 16 * wave + fr, 64 + 16 * fq), st[4]); }
        }
        if (OUT) {
            __syncthreads();
            LAS const unsigned char* cx = lds + O_CX + (c & 1) * CXB;
            f32x4 nt[4], nd = {0.f, 0.f, 0.f, 0.f};
            {
                const bf16x8 va0 = ldfrag_sw(lds + O_VT, 16 * wave + fr, 16 * fq), va1 = ldfrag_sw(lds + O_VT, 16 * wave + fr, 64 + 16 * fq);
                const bf16x8 ca0 = ldfrag(cx, 16 * wave + fr, 16 * fq), ca1 = ldfrag(cx, 16 * wave + fr, 64 + 16 * fq);
#pragma unroll
                for (int lt = 0; lt < 4; ++lt) { f32x4 acc = {0.f, 0.f, 0.f, 0.f};
                    acc = MFMA16(va0, ldfrag(lds + O_S, 16 * lt + fr, 16 * fq), acc); acc = MFMA16(va1, ldfrag(lds + O_S, 16 * lt + fr, 64 + 16 * fq), acc);
                    acc = MFMA16(ca0, ldfrag(lds + O_QA, 16 * lt + fr, 16 * fq), acc); acc = MFMA16(ca1, ldfrag(lds + O_QA, 16 * lt + fr, 64 + 16 * fq), acc); nt[lt] = acc; }
                if (wave >= 4) { const int lt = wave - 4;
                    nd = MFMA16(ldfrag_sw(lds + O_VT, 128 + fr, 16 * fq), ldfrag(lds + O_S, 16 * lt + fr, 16 * fq), nd); nd = MFMA16(ldfrag_sw(lds + O_VT, 128 + fr, 64 + 16 * fq), ldfrag(lds + O_S, 16 * lt + fr, 64 + 16 * fq), nd);
                    nd = MFMA16(ldfrag(cx, 128 + fr, 16 * fq), ldfrag(lds + O_QA, 16 * lt + fr, 16 * fq), nd); nd = MFMA16(ldfrag(cx, 128 + fr, 64 + 16 * fq), ldfrag(lds + O_QA, 16 * lt + fr, 64 + 16 * fq), nd);
                    if (fq == 0) DEN[16 * lt + fr] = nd[0]; }
            }
            __syncthreads();
#pragma unroll
            for (int lt = 0; lt < 4; ++lt) { const int l = 16 * lt + fr; const float Ml = fmaxf(m, GC[c * 64 + l]);
                const float inv = 1.0f / fmaxf(fabsf(DEN[l]), __expf(-(GB[c * 64 + l] + Ml)));
                nt[lt] = nt[lt] * inv; float ss = (nt[lt][0] * nt[lt][0] + nt[lt][1] * nt[lt][1]) + (nt[lt][2] * nt[lt][2] + nt[lt][3] * nt[lt][3]);
                ss += __shfl_xor(ss, 16); ss += __shfl_xor(ss, 32);
                if (fq == 0) SSQ[wave * 64 + l] = ss; }
            LAS unsigned char* cxn = lds + O_CX + ((c + 1) & 1) * CXB;
#pragma unroll
            for (int j = 0; j < 4; ++j)
#pragma unroll
                for (int r = 0; r < 4; ++r) *(LAS bf16*)(cxn + (16 * wave + 4 * fq + r) * 144 + (16 * j + fr) * 2) = (bf16)f2bf(st[j][r]);
            if (wave < 4) {
#pragma unroll
                for (int r = 0; r < 4; ++r) *(LAS bf16*)(cxn + (128 + 4 * fq + r) * 144 + (16 * wave + fr) * 2) = (bf16)f2bf(st[4][r]); }
            __syncthreads();
#pragma unroll
            for (int lt = 0; lt < 4; ++lt) { const int l = 16 * lt + fr; float tot = 0.f;
#pragma unroll
                for (int w2 = 0; w2 < 8; ++w2) tot += SSQ[w2 * 64 + l];
                const float rn = 1.0f / sqrtf(tot * (1.f / 128.f) + EPS);
                const float o0 = nt[lt][0] * rn * gsc[0] * bflo(mo[lt].x), o1 = nt[lt][1] * rn * gsc[1] * bfhi(mo[lt].x), o2 = nt[lt][2] * rn * gsc[2] * bflo(mo[lt].y), o3 = nt[lt][3] * rn * gsc[3] * bfhi(mo[lt].y);
                v2u w; w.x = pk2(o0, o1); w.y = pk2(o2, o3);
                *(GAS v2u*)(MI + (tc0 + l) * D + 512 + h * 128 + 16 * wave + 4 * fq) = w; }
        } else {
            __syncthreads();
        }
        m = bL + M63; Btot += bL;
    }
    if (!OUT) {
#pragma unroll
        for (int i = 0; i < 5; ++i)
#pragma unroll
            for (int r = 0; r < 4; ++r) MST[((size_t)wg * 20 + i * 4 + r) * NTHR + tid] = st[i][r];
        if (tid == 0) { MSC[wg * 2] = m; MSC[wg * 2 + 1] = Btot; }
    }
}

namespace at {
constexpr int O_K = 0, O_VT = 36864, VTS = 592  , O_END = O_VT + 64 * VTS;
static_assert(O_END <= 131072, "attention LDS");
}
__device__ __forceinline__ void phase_attn(const Args& A, LAS unsigned char* lds) {
    using namespace at;
    const int tid = threadIdx.x, lane = tid & 63, wave = __builtin_amdgcn_readfirstlane(tid >> 6), fr = lane & 15, fq = lane >> 4, G = gridDim.x;
    const bf16* P = (const bf16*)(A.ws + WS_PROJ); bf16* MI = (bf16*)(A.ws + WS_MIXIN); const float* sinks = (const float*)A.in[I_SINK];
    __syncthreads();
    for (int e = tid; e < 64 * 16; e += NTHR) { const int r = e >> 4, cpair = e & 15; *(LAS unsigned*)(lds + O_VT + r * VTS + 512 + cpair * 4) = 0u; }
    v4u pk_[4], pv_[4];
#define ATT_LOAD(uu) do { const int g_ = (uu) & 1, n_ = ((uu) >> 1) & 63, b_ = (uu) >> 7; const size_t tq_ = (size_t)b_ * SEQ + (size_t)n_ * 128; _Pragma("unroll") for (int i_ = 0; i_ < 4; ++i_) { const int item_ = tid + NTHR * i_, row_ = item_ >> 3, ch_ = item_ & 7; \
        pk_[i_] = (v4u){0u, 0u, 0u, 0u}; pv_[i_] = (v4u){0u, 0u, 0u, 0u}; if (n_ > 0 || row_ >= 128) { const bf16* rp_ = P + (tq_ - 128 + row_) * NPROJ; pk_[i_] = *(const GAS v4u*)(rp_ + C_AK + g_ * 64 + 8 * ch_); pv_[i_] = *(const GAS v4u*)(rp_ + C_AV + g_ * 64 + 8 * ch_); } } } while (0)
    if ((int)blockIdx.x < NB * 64 * 2) ATT_LOAD((int)blockIdx.x);
    for (int unit = blockIdx.x; unit < NB * 64 * 2; unit += G) {
        const int g = unit & 1, n = (unit >> 1) & 63, b = unit >> 7;
        const size_t tq0 = (size_t)b * SEQ + (size_t)n * 128;
        __syncthreads();
#pragma unroll
        for (int i = 0; i < 4; ++i) { const int item = tid + NTHR * i, row = item >> 3, ch = item & 7;
            const v4u wk = pk_[i], wv = pv_[i];
            *(LAS v4u*)(lds + O_K + row * 144 + ch * 16) = wk;
            const unsigned ww[4] = {wv.x, wv.y, wv.z, wv.w};
#pragma unroll
            for (int k = 0; k < 4; ++k) { *(LAS bf16*)(lds + O_VT + (8 * ch + 2 * k) * VTS + (row ^ (4 * ch)) * 2) = (bf16)(ww[k] & 0xffffu); *(LAS bf16*)(lds + O_VT + (8 * ch + 2 * k + 1) * VTS + (row ^ (4 * ch)) * 2) = (bf16)(ww[k] >> 16); } }
        if (unit + G < NB * 64 * 2) ATT_LOAD(unit + G);
        const int hq = 4 * g + (wave >> 1), qr0 = 64 * (wave & 1); const float sink = sinks[hq];
        __syncthreads();
        for (int qt = 0; qt < 4; ++qt) {
            const int i0 = qr0 + 16 * qt, st0 = i0 >> 4, iq = i0 + fr;
            const bf16* qp = P + (tq0 + iq) * NPROJ + C_AQ + hq * 64 + 8 * fq;
            const bf16x8 bq0 = *(const GAS bf16x8*)qp, bq1 = *(const GAS bf16x8*)(qp + 32);
            f32x4 sc[9]; float mx = sink;
#pragma unroll
            for (int t = 0; t < 9; ++t) { const int sb0 = 16 * (st0 + t); f32x4 acc = {0.f, 0.f, 0.f, 0.f};
                acc = MFMA16(ldfrag(lds + O_K, sb0 + fr, 16 * fq), bq0, acc); acc = MFMA16(ldfrag(lds + O_K, sb0 + fr, 64 + 16 * fq), bq1, acc);
#pragma unroll
                for (int r = 0; r < 4; ++r) { const int sb = sb0 + 4 * fq + r; const bool valid = (sb > iq) && (sb <= iq + 128) && (n > 0 || sb >= 128);
                    acc[r] = valid ? acc[r] : -3.0e38f; mx = fmaxf(mx, acc[r]); }
                sc[t] = acc; }
            mx = fmaxf(mx, __shfl_xor(mx, 16)); mx = fmaxf(mx, __shfl_xor(mx, 32));
            float lsum = 0.f;
#pragma unroll
            for (int t = 0; t < 9; ++t)
#pragma unroll
                for (int r = 0; r < 4; ++r) { const float p = (sc[t][r] > -1.0e38f) ? __expf(sc[t][r] - mx) : 0.f; sc[t][r] = p; lsum += p; }
            lsum += __shfl_xor(lsum, 16); lsum += __shfl_xor(lsum, 32); lsum += __expf(sink - mx);
            f32x4 oacc[4];
#pragma unroll
            for (int dt = 0; dt < 4; ++dt) oacc[dt] = (f32x4){0.f, 0.f, 0.f, 0.f};
#pragma unroll
            for (int ks = 0; ks < 5; ++ks) {
                union { bf16x8 v; unsigned u[4]; } pb;
                pb.u[0] = cvtpk(sc[2 * ks][0], sc[2 * ks][1]); pb.u[1] = cvtpk(sc[2 * ks][2], sc[2 * ks][3]);
                if (ks < 4) { pb.u[2] = cvtpk(sc[2 * ks + 1][0], sc[2 * ks + 1][1]); pb.u[3] = cvtpk(sc[2 * ks + 1][2], sc[2 * ks + 1][3]); } else { pb.u[2] = 0u; pb.u[3] = 0u; }
                const int sbb = 16 * (st0 + 2 * ks) + 4 * fq;
#pragma unroll
                for (int dt = 0; dt < 4; ++dt) { const int dd = 16 * dt + fr, sx = 4 * ((dd >> 3) & 7); LAS const unsigned char* vrow = lds + O_VT + dd * VTS;
                    union { bf16x8 v; v2u h[2]; } va; va.h[0] = *(LAS const v2u*)(vrow + (sbb ^ sx) * 2); va.h[1] = *(LAS const v2u*)(vrow + ((sbb + 16) ^ sx) * 2);
                    oacc[dt] = MFMA16(va.v, pb.v, oacc[dt]); } }
            const float il = 1.0f / lsum;
#pragma unroll
            for (int dt = 0; dt < 4; ++dt) { v2u w; w.x = pk2(oacc[dt][0] * il, oacc[dt][1] * il); w.y = pk2(oacc[dt][2] * il, oacc[dt][3] * il);
                *(GAS v2u*)(MI + (tq0 + iq) * D + hq * 64 + 16 * dt + 4 * fq) = w; }
        }
    }
#undef ATT_LOAD
}
typedef float f32x16 __attribute__((ext_vector_type(16)));
__device__ __forceinline__ unsigned fbits(float f) { return __builtin_bit_cast(unsigned, f); }
__device__ __forceinline__ float bfloat(unsigned u) { return __builtin_bit_cast(float, u); }

#define CE_DESC(a, b) do { const float _mx = __builtin_fmaxf(a, b), _mn = __builtin_fminf(a, b); a = _mx; b = _mn; } while (0)
__device__ __forceinline__ void bsort16(float (&v)[16]) {
#pragma unroll
    for (int k = 2; k <= 16; k <<= 1)
#pragma unroll
        for (int j = k >> 1; j > 0; j >>= 1)
#pragma unroll
            for (int i = 0; i < 16; ++i) { const int l = i ^ j; if (l > i) { if ((i & k) == 0) CE_DESC(v[i], v[l]); else CE_DESC(v[l], v[i]); } }
}
__device__ __forceinline__ void bmerge16(float (&v)[16], const float (&w)[16]) {
#pragma unroll
    for (int i = 0; i < 16; ++i) v[i] = __builtin_fmaxf(v[i], w[15 - i]);
#pragma unroll
    for (int j = 8; j > 0; j >>= 1)
#pragma unroll
        for (int i = 0; i < 16; ++i) { const int l = i ^ j; if (l > i) CE_DESC(v[i], v[l]); }
}
namespace tk {
constexpr int KS = 272;
constexpr int O_K1 = 0, O_K2 = 128 * KS, O_X = 2 * 128 * KS, O_END = O_X + 8 * 4096;
static_assert(O_END <= 131072, "topk LDS");
constexpr unsigned char CAND[64] = {
    0x00, 0x01, 0x02, 0x03, 0x04, 0x05, 0x06, 0x07, 0x08, 0x09, 0x0a, 0x0b, 0x0c, 0x0d, 0x0e, 0x0f,
    0x10, 0x11, 0x12, 0x13, 0x14, 0x15, 0x16, 0x17, 0x80, 0x90, 0xa0, 0xb0, 0xc0, 0xd0, 0xe0, 0xf0,
    0x20, 0x21, 0x22, 0x23, 0x24, 0x30, 0x31, 0x32, 0x33, 0x40, 0x41, 0x42, 0x50, 0x51, 0x60, 0x61,
    0x70, 0x71, 0xff, 0xff, 0xff, 0xff, 0xff, 0xff, 0xff, 0xff, 0xff, 0xff, 0xff, 0xff, 0xff, 0xff};
}
__device__ __forceinline__ void side_top16(const f32x16 (&acc)[4], int hh, float (&T)[16]) {
    float g1[16], g2[16];
#pragma unroll
    for (int r = 0; r < 16; ++r) { const unsigned key = (r & 3) + 8 * (r >> 2) + 4 * hh;
        T[r] = bfloat((fbits(acc[0][r]) & 0xffffff80u) | key);
        g1[r] = bfloat((fbits(acc[1][r]) & 0xffffff80u) | (32u + key)); }
    bsort16(T); bsort16(g1); bmerge16(T, g1);
#pragma unroll
    for (int r = 0; r < 16; ++r) { const unsigned key = (r & 3) + 8 * (r >> 2) + 4 * hh;
        g1[r] = bfloat((fbits(acc[2][r]) & 0xffffff80u) | (64u + key));
        g2[r] = bfloat((fbits(acc[3][r]) & 0xffffff80u) | (96u + key)); }
    bsort16(g1); bsort16(g2); bmerge16(g1, g2); bmerge16(T, g1);
#pragma unroll
    for (int r = 0; r < 16; ++r) g1[r] = __shfl_xor(T[r], 32);
    bmerge16(T, g1);
}
struct TopkQ { bf16x8 f[8]; };
template <int SD> __device__ __forceinline__ void topk_ldq(const bf16* Q, int t, int h, int hh, TopkQ& q) {
    const bf16* qp = Q + (size_t)t * 2048 + h * 256 + SD * 128 + 8 * hh;
#pragma unroll
    for (int ks = 0; ks < 8; ++ks) q.f[ks] = *(const GAS bf16x8*)(qp + 16 * ks);
}
template <int SD> __device__ __forceinline__ void topk_scores(const TopkQ& q, LAS unsigned char* lds, int r32, int hh, f32x16 (&acc)[4]) {
    using namespace tk;
#pragma unroll
    for (int mt = 0; mt < 4; ++mt)
#pragma unroll
        for (int r = 0; r < 16; ++r) acc[mt][r] = 0.f;
    LAS const unsigned char* kimg = lds + (SD ? O_K2 : O_K1);
#pragma unroll
    for (int ks = 0; ks < 8; ++ks) {
#pragma unroll
        for (int mt = 0; mt < 4; ++mt) acc[mt] = __builtin_amdgcn_mfma_f32_32x32x16_bf16(*(LAS const bf16x8*)(kimg + (32 * mt + r32) * KS + 32 * ks + 16 * hh), q.f[ks], acc[mt], 0, 0, 0); }
}
template <int Q> __device__ __forceinline__ float cand_val(const float (&T1)[16], const float (&T2)[16], int hh) {
    constexpr unsigned c0 = tk::CAND[2 * Q], c1 = tk::CAND[2 * Q + 1];
    const float s = (hh ? T1[(c1 >> 4) & 15] : T1[(c0 >> 4) & 15]) + (hh ? T2[c1 & 15] : T2[c0 & 15]); const unsigned code = hh ? c1 : c0;
    return (code == 0xffu) ? -3.0e38f : bfloat((fbits(s) & 0xffffff00u) | code);
}
__device__ __forceinline__ void phase_topk(const Args& A, LAS unsigned char* lds) {
    using namespace tk;
    const int tid = threadIdx.x, lane = tid & 63, wave = __builtin_amdgcn_readfirstlane(tid >> 6), G = gridDim.x;
    const bf16* Q = (const bf16*)(A.ws + WS_PROJ); const bf16* KB = (const bf16*)(A.ws + WS_KEYS);
    unsigned short* EI = (unsigned short*)(A.ws + WS_EIDX); float* GT = (float*)(A.ws + WS_GATE);
    const int h = blockIdx.x & 7, r32 = lane & 31, hh = lane >> 5;
    __syncthreads();
    for (int e = tid; e < 2 * 128 * 16; e += NTHR) { const int s = e >> 11, row = (e >> 4) & 127, ch = e & 15;
        *(LAS v4u*)(lds + (s ? O_K2 : O_K1) + row * KS + ch * 16) = *(const GAS v4u*)(KB + (size_t)s * 8 * 128 * 128 + ((size_t)h * 128 + row) * 128 + ch * 8); }
    __syncthreads();
    LAS float* XW = (LAS float*)(lds + O_X + wave * 4096) + r32 * 32;
    TopkQ qf; topk_ldq<0>(Q, (int)(blockIdx.x >> 3) * 256 + 32 * wave + r32, h, hh, qf);
    for (int tile = (int)(blockIdx.x >> 3); tile < M / 256; tile += (G >> 3)) {
        const int t = tile * 256 + 32 * wave + r32;
        float T1[16], T2[16];
        { f32x16 acc[4]; topk_scores<0>(qf, lds, r32, hh, acc);
          topk_ldq<1>(Q, t, h, hh, qf);
          side_top16(acc, hh, T1); }
        { f32x16 acc[4]; topk_scores<1>(qf, lds, r32, hh, acc);
          const int tn = min(tile + (int)(G >> 3), M / 256 - 1) * 256 + 32 * wave + r32; topk_ldq<0>(Q, tn, h, hh, qf);
          side_top16(acc, hh, T2); }
        float c[16], w[16];
        c[0] = cand_val<0>(T1, T2, hh); w[0] = cand_val<16>(T1, T2, hh);
        c[1] = cand_val<1>(T1, T2, hh); w[1] = cand_val<17>(T1, T2, hh);
        c[2] = cand_val<2>(T1, T2, hh); w[2] = cand_val<18>(T1, T2, hh);
        c[3] = cand_val<3>(T1, T2, hh); w[3] = cand_val<19>(T1, T2, hh);
        c[4] = cand_val<4>(T1, T2, hh); w[4] = cand_val<20>(T1, T2, hh);
        c[5] = cand_val<5>(T1, T2, hh); w[5] = cand_val<21>(T1, T2, hh);
        c[6] = cand_val<6>(T1, T2, hh); w[6] = cand_val<22>(T1, T2, hh);
        c[7] = cand_val<7>(T1, T2, hh); w[7] = cand_val<23>(T1, T2, hh);
        c[8] = cand_val<8>(T1, T2, hh); w[8] = cand_val<24>(T1, T2, hh);
        c[9] = cand_val<9>(T1, T2, hh); w[9] = cand_val<25>(T1, T2, hh);
        c[10] = cand_val<10>(T1, T2, hh); w[10] = cand_val<26>(T1, T2, hh);
        c[11] = cand_val<11>(T1, T2, hh); w[11] = cand_val<27>(T1, T2, hh);
        c[12] = cand_val<12>(T1, T2, hh); w[12] = cand_val<28>(T1, T2, hh);
        c[13] = cand_val<13>(T1, T2, hh); w[13] = cand_val<29>(T1, T2, hh);
        c[14] = cand_val<14>(T1, T2, hh); w[14] = cand_val<30>(T1, T2, hh);
        c[15] = cand_val<15>(T1, T2, hh); w[15] = cand_val<31>(T1, T2, hh);
        bsort16(c); bsort16(w); bmerge16(c, w);
#pragma unroll
        for (int r = 0; r < 16; ++r) w[r] = __shfl_xor(c[r], 32);
        bmerge16(c, w);
        if (hh == 0) {
#pragma unroll
            for (int q4 = 0; q4 < 4; ++q4) { *(LAS f32x4*)(XW + 4 * q4) = (f32x4){T1[4 * q4], T1[4 * q4 + 1], T1[4 * q4 + 2], T1[4 * q4 + 3]};
                *(LAS f32x4*)(XW + 16 + 4 * q4) = (f32x4){T2[4 * q4], T2[4 * q4 + 1], T2[4 * q4 + 2], T2[4 * q4 + 3]}; } }
        asm volatile("s_waitcnt lgkmcnt(0)" ::: "memory");
        float ex[16], sum = 0.f; const float tmax = bfloat(fbits(c[0]) & 0xffffff00u);
#pragma unroll
        for (int r = 0; r < 16; ++r) { ex[r] = __expf(bfloat(fbits(c[r]) & 0xffffff00u) - tmax); sum += ex[r]; }
        const float isum = 1.0f / sum; const size_t ob = (size_t)t * NSLOT + (size_t)(8 * hh) * 8 + h;
#pragma unroll
        for (int r = 0; r < 8; ++r) { float ca = c[r], cb = c[8 + r], ea = ex[r], eb = ex[8 + r]; asm volatile("" : "+v"(ca), "+v"(cb), "+v"(ea), "+v"(eb)); const float cv = hh ? cb : ca, ev = hh ? eb : ea;
            const unsigned code = fbits(cv) & 0xffu;
            const unsigned i1 = fbits(XW[code >> 4]) & 127u, i2 = fbits(XW[16 + (code & 15)]) & 127u;
            EI[ob + 8 * r] = (unsigned short)(i1 * 128u + i2); GT[ob + 8 * r] = ev * isum; }
        asm volatile("s_waitcnt lgkmcnt(0)" ::: "memory");
    }
}
struct PeerIdx { v4u e0, e1; };
__device__ __forceinline__ PeerIdx peer_ld_idx(const unsigned short* EI, int t, int g) { PeerIdx r; r.e0 = *(const GAS v4u*)(EI + (size_t)t * NSLOT + 16 * g); r.e1 = *(const GAS v4u*)(EI + (size_t)t * NSLOT + 16 * g + 8); return r; }
template <int ROWB = 1024> __device__ __forceinline__ void peer_gather(const unsigned char* T8, const PeerIdx& ix, int colb, v4u (&raw)[16]) {
    const unsigned ew[8] = {ix.e0.x, ix.e0.y, ix.e0.z, ix.e0.w, ix.e1.x, ix.e1.y, ix.e1.z, ix.e1.w};
#pragma unroll
    for (int k = 0; k < 16; ++k) { const unsigned e = (k & 1) ? (ew[k >> 1] >> 16) : (ew[k >> 1] & 0xffffu); raw[k] = *(const GAS v4u*)(T8 + (size_t)e * ROWB + colb); }
}
__device__ __forceinline__ void cvt16_fp8_pk(const v4u w, f32x2 (&o)[8]) {
    const unsigned ww[4] = {w.x, w.y, w.z, w.w};
#pragma unroll
    for (int i = 0; i < 4; ++i) { o[2 * i] = __builtin_amdgcn_cvt_pk_f32_fp8((int)ww[i], false); o[2 * i + 1] = __builtin_amdgcn_cvt_pk_f32_fp8((int)ww[i], true); }
}
__device__ __forceinline__ void peer_u_reduce(const v4u (&raw)[16], const f32x2 (&hv)[8], float* PDrow, int lane, int g, int c) {
    float d[16];
#pragma unroll
    for (int k = 0; k < 16; ++k) { f32x2 uf[8]; cvt16_fp8_pk(raw[k], uf); f32x2 s = uf[0] * hv[0];
#pragma unroll
        for (int i = 1; i < 8; ++i) s += uf[i] * hv[i];
        d[k] = s.x + s.y; }
#pragma unroll
    for (int i = 0; i < 8; ++i) { const bool up = (lane & 4) != 0; const float keep = up ? d[i + 8] : d[i], send = up ? d[i] : d[i + 8]; d[i] = keep + __shfl_xor(send, 4); }
#pragma unroll
    for (int i = 0; i < 4; ++i) { const bool up = (lane & 2) != 0; const float keep = up ? d[i + 4] : d[i], send = up ? d[i] : d[i + 4]; d[i] = keep + __shfl_xor(send, 2); }
#pragma unroll
    for (int i = 0; i < 2; ++i) { const bool up = (lane & 1) != 0; const float keep = up ? d[i + 2] : d[i], send = up ? d[i] : d[i + 2]; d[i] = keep + __shfl_xor(send, 1); }
    *(GAS f32x2*)(PDrow + 16 * g + 2 * c) = (f32x2){d[0], d[1]};
}
__device__ __forceinline__ void ld16bf_pk(const bf16* p, f32x2 (&o)[8]) {
    const v4u w0 = *(const GAS v4u*)p, w1 = *(const GAS v4u*)(p + 8); const unsigned ww[8] = {w0.x, w0.y, w0.z, w0.w, w1.x, w1.y, w1.z, w1.w};
#pragma unroll
    for (int i = 0; i < 8; ++i) o[i] = (f32x2){bflo(ww[i]), bfhi(ww[i])};
}
__device__ __forceinline__ void peer_u_reduce_i4(const v4u (&raw)[16], const v4u hh, const v4u hl, int* PDrow, int lane, int g, int c) {
    int d[16];
#pragma unroll
    for (int k = 0; k < 16; ++k) { int sh = __builtin_amdgcn_sdot8((int)raw[k].x, (int)hh.x, 0, false), sl = __builtin_amdgcn_sdot8((int)raw[k].x, (int)hl.x, 0, false);
        sh = __builtin_amdgcn_sdot8((int)raw[k].y, (int)hh.y, sh, false); sl = __builtin_amdgcn_sdot8((int)raw[k].y, (int)hl.y, sl, false);
        sh = __builtin_amdgcn_sdot8((int)raw[k].z, (int)hh.z, sh, false); sl = __builtin_amdgcn_sdot8((int)raw[k].z, (int)hl.z, sl, false);
        sh = __builtin_amdgcn_sdot8((int)raw[k].w, (int)hh.w, sh, false); sl = __builtin_amdgcn_sdot8((int)raw[k].w, (int)hl.w, sl, false);
        d[k] = 16 * sh + sl; }
#pragma unroll
    for (int i = 0; i < 8; ++i) { const bool up = (lane & 4) != 0; const int keep = up ? d[i + 8] : d[i], send = up ? d[i] : d[i + 8]; d[i] = keep + __shfl_xor(send, 4); }
#pragma unroll
    for (int i = 0; i < 4; ++i) { const bool up = (lane & 2) != 0; const int keep = up ? d[i + 4] : d[i], send = up ? d[i] : d[i + 4]; d[i] = keep + __shfl_xor(send, 2); }
#pragma unroll
    for (int i = 0; i < 2; ++i) { const bool up = (lane & 1) != 0; const int keep = up ? d[i + 2] : d[i], send = up ? d[i] : d[i + 2]; d[i] = keep + __shfl_xor(send, 1); }
    *(GAS v2u*)(PDrow + 16 * g + 2 * c) = (v2u){(unsigned)d[0], (unsigned)d[1]};
}
__device__ __forceinline__ void phase_peer_u(const Args& A) {
    const int tid = threadIdx.x, lane = tid & 63, wave = tid >> 6, p = blockIdx.x & 7, q = p & 3, half = p >> 2, j = blockIdx.x >> 3, nj = gridDim.x >> 3, g = lane >> 3, c = lane & 7;
    const unsigned char* HH = (const unsigned char*)(A.ws + WS_H8); const unsigned char* HL = HH + 32 * MiB; const unsigned char* U4 = (const unsigned char*)(A.ws + WS_U8); const unsigned short* EI = (const unsigned short*)(A.ws + WS_EIDX);
    int* PD = (int*)(A.ws + WS_PD) + (size_t)q * M * NSLOT;
    const int tper = (M / 2) / nj, colb = 128 * q + 16 * c, tbeg = half * (M / 2) + j * tper, tend = tbeg + tper, tlast = tend - NWAVES + wave;
    int t = tbeg + wave;
    PeerIdx ix1 = peer_ld_idx(EI, min(t + NWAVES, tlast), g), ix2 = peer_ld_idx(EI, min(t + 2 * NWAVES, tlast), g);
    v4u rawa[16], rawb[16], hha, hla, hhb, hlb;
    { const PeerIdx ix0 = peer_ld_idx(EI, t, g); peer_gather<512>(U4, ix0, colb, rawa); hha = *(const GAS v4u*)(HH + (size_t)t * 512 + colb); hla = *(const GAS v4u*)(HL + (size_t)t * 512 + colb); }
    for (; t < tend; t += 2 * NWAVES) {
        const int t1 = t + NWAVES, t2 = min(t + 2 * NWAVES, tlast), t3 = min(t + 3 * NWAVES, tlast), t4 = min(t + 4 * NWAVES, tlast);
        const PeerIdx ix3 = peer_ld_idx(EI, t3, g);
        peer_gather<512>(U4, ix1, colb, rawb); hhb = *(const GAS v4u*)(HH + (size_t)t1 * 512 + colb); hlb = *(const GAS v4u*)(HL + (size_t)t1 * 512 + colb);
        peer_u_reduce_i4(rawa, hha, hla, PD + (size_t)t * NSLOT, lane, g, c);
        const PeerIdx ix4 = peer_ld_idx(EI, t4, g);
        peer_gather<512>(U4, ix2, colb, rawa); hha = *(const GAS v4u*)(HH + (size_t)t2 * 512 + colb); hla = *(const GAS v4u*)(HL + (size_t)t2 * 512 + colb);
        peer_u_reduce_i4(rawb, hhb, hlb, PD + (size_t)t1 * NSLOT, lane, g, c);
        ix1 = ix3; ix2 = ix4;
    }
}
__device__ __forceinline__ void phase_peer_act(const Args& A) {
    const int* PD = (const int*)(A.ws + WS_PD); const unsigned short* EI = (const unsigned short*)(A.ws + WS_EIDX); const float* GT = (const float*)(A.ws + WS_GATE);
    const float* usc = (const float*)(A.ws + WS_SC); const float* vsc = usc + NEXP; const float* hs = (const float*)(A.ws + WS_HS); float* ACT = (float*)(A.ws + WS_ACT);
    typedef int i32x4 __attribute__((ext_vector_type(4)));
    for (size_t i = ((size_t)blockIdx.x * NTHR + threadIdx.x) * 4; i < (size_t)M * NSLOT; i += (size_t)gridDim.x * NTHR * 4) {
        const i32x4 p0 = *(const GAS i32x4*)(PD + i), p1 = *(const GAS i32x4*)(PD + (size_t)M * NSLOT + i), p2 = *(const GAS i32x4*)(PD + (size_t)2 * M * NSLOT + i), p3 = *(const GAS i32x4*)(PD + (size_t)3 * M * NSLOT + i);
        const v2u ew = *(const GAS v2u*)(EI + i); const f32x4 gt = *(const GAS f32x4*)(GT + i); const float hsv = hs[i >> 7];
        const unsigned e[4] = {ew.x & 0xffffu, ew.x >> 16, ew.y & 0xffffu, ew.y >> 16};
        const i32x4 si = (p0 + p1) + (p2 + p3); f32x4 o;
#pragma unroll
        for (int k = 0; k < 4; ++k) { const float s = (float)si[k] * (usc[e[k]] * hsv); o[k] = 0.5f * s * (1.f + erff(s * 0.70710678118654752f)) * gt[k] * vsc[e[k]]; }
        *(GAS f32x4*)(ACT + i) = o;
    }
}
struct PeerAct { f32x4 a0, a1, a2, a3; };
__device__ __forceinline__ PeerAct peer_ld_act(const float* ACT, int t, int g) { const GAS f32x4* ap = (const GAS f32x4*)(ACT + (size_t)t * NSLOT + 16 * g); PeerAct r; r.a0 = ap[0]; r.a1 = ap[1]; r.a2 = ap[2]; r.a3 = ap[3]; return r; }
__device__ __forceinline__ void peer_v_accum(const v4u (&raw)[16], const PeerAct& pa, f32x2 (&y2)[16]) {
    const float av[16] = {pa.a0[0], pa.a0[1], pa.a0[2], pa.a0[3], pa.a1[0], pa.a1[1], pa.a1[2], pa.a1[3], pa.a2[0], pa.a2[1], pa.a2[2], pa.a2[3], pa.a3[0], pa.a3[1], pa.a3[2], pa.a3[3]};
#pragma unroll
    for (int k = 0; k < 16; ++k) { const unsigned ww[4] = {raw[k].x, raw[k].y, raw[k].z, raw[k].w}; const f32x2 a2 = (f32x2){av[k], av[k]};
#pragma unroll
        for (int w = 0; w < 4; ++w) { y2[4 * w + 0] += a2 * __builtin_amdgcn_cvt_scalef32_pk_f32_fp4(ww[w], 1.0f, 0); y2[4 * w + 1] += a2 * __builtin_amdgcn_cvt_scalef32_pk_f32_fp4(ww[w], 1.0f, 1);
            y2[4 * w + 2] += a2 * __builtin_amdgcn_cvt_scalef32_pk_f32_fp4(ww[w], 1.0f, 2); y2[4 * w + 3] += a2 * __builtin_amdgcn_cvt_scalef32_pk_f32_fp4(ww[w], 1.0f, 3); } }
}
__device__ __forceinline__ void peer_v_store(f32x2 (&y2)[16], bf16* Yp, float* ssy, int c) {
    float ss = 0.f; unsigned w[16];
#pragma unroll
    for (int i = 0; i < 16; ++i) { ss += y2[i].x * y2[i].x + y2[i].y * y2[i].y; w[i] = pk2(y2[i].x, y2[i].y); y2[i] = (f32x2){0.f, 0.f}; }
#pragma unroll
    for (int i = 0; i < 4; ++i) *(GAS v4u*)(Yp + 8 * i) = (v4u){w[4 * i], w[4 * i + 1], w[4 * i + 2], w[4 * i + 3]};
    ss += __shfl_xor(ss, 1); ss += __shfl_xor(ss, 2); ss += __shfl_xor(ss, 4);
    if (c == 0) *ssy = ss;
}
__device__ __forceinline__ void phase_peer_v(const Args& A) {
    const int tid = threadIdx.x, lane = tid & 63, wave = tid >> 6, p = blockIdx.x & 7, q = p & 3, half = p >> 2, j = blockIdx.x >> 3, nj = gridDim.x >> 3, g = lane >> 3, c = lane & 7;
    const unsigned char* V4 = (const unsigned char*)(A.ws + WS_V8); const unsigned short* EI = (const unsigned short*)(A.ws + WS_EIDX); const float* ACT = (const float*)(A.ws + WS_ACT);
    bf16* Y = (bf16*)(A.ws + WS_H); float* SSY = (float*)(A.ws + WS_SSY);
    const int tper = (M / 2) / nj, colb = 128 * q + 16 * c, tbeg = half * (M / 2) + j * tper + wave * (tper / NWAVES);
    const int nstep = (tper / NWAVES / 8) * 8;
    auto rowof = [&](int s) { s = min(s, nstep - 1); return (size_t)(tbeg + 8 * (s >> 3) + g) * 8 + (s & 7); };
    f32x2 y2[16];
#pragma unroll
    for (int i = 0; i < 16; ++i) y2[i] = (f32x2){0.f, 0.f};
    auto ldidx = [&](int s) { const size_t r = rowof(s); PeerIdx x; x.e0 = *(const GAS v4u*)(EI + r * 16); x.e1 = *(const GAS v4u*)(EI + r * 16 + 8); return x; };
    auto ldact = [&](int s) { const GAS f32x4* ap = (const GAS f32x4*)(ACT + rowof(s) * 16); PeerAct r; r.a0 = ap[0]; r.a1 = ap[1]; r.a2 = ap[2]; r.a3 = ap[3]; return r; };
    PeerIdx ix1 = ldidx(1), ix2 = ldidx(2);
    v4u rawa[16], rawb[16]; PeerAct aca, acb;
    { const PeerIdx ix0 = ldidx(0); peer_gather<512>(V4, ix0, colb, rawa); aca = ldact(0); }
    for (int s = 0; s < nstep; s += 2) {
        const PeerIdx ix3 = ldidx(s + 3);
        peer_gather<512>(V4, ix1, colb, rawb); acb = ldact(s + 1);
        peer_v_accum(rawa, aca, y2);
        const PeerIdx ix4 = ldidx(s + 4);
        peer_gather<512>(V4, ix2, colb, rawa); aca = ldact(s + 2);
        peer_v_accum(rawb, acb, y2);
        if ((s & 7) == 6) { const int t = tbeg + 8 * (s >> 3) + g; peer_v_store(y2, Y + (size_t)t * D + 256 * q + 32 * c, SSY + (size_t)t * 8 + q, c); }
        ix1 = ix3; ix2 = ix4;
    }
}
__device__ __forceinline__ void phase_peer_final(const Args& A) {
    const int tid = threadIdx.x, lane = tid & 63, wave = tid >> 6, G = gridDim.x;
    const bf16* Y = (const bf16*)(A.ws + WS_H); const bf16* X1 = (const bf16*)(A.ws + WS_X1); const float* SSY = (const float*)(A.ws + WS_SSY); const float* mod = (const float*)(A.ws + WS_MOD); const float* gpost = (const float*)A.in[I_GPOST2]; float* out = A.out;
    f32x4 gp[4];
#pragma unroll
    for (int q = 0; q < 4; ++q) gp[q] = *(const GAS f32x4*)(gpost + 4 * (lane + 64 * q));
    const int stride = G * NWAVES; int row = blockIdx.x * NWAVES + wave;
    v2u xw[4], yw[4], xwn[4], ywn[4]; f32x4 s0, s0n, g2p[4]; int bcur = -1;
#pragma unroll
    for (int q = 0; q < 4; ++q) { xw[q] = ((const GAS v2u*)(X1 + (size_t)row * D) + lane)[64 * q]; yw[q] = ((const GAS v2u*)(Y + (size_t)row * D) + lane)[64 * q]; }
    s0 = *(const GAS f32x4*)(SSY + (size_t)row * 8);
    for (; row < M; row += stride) {
        const int rn = min(row + stride, M - 1);
#pragma unroll
        for (int q = 0; q < 4; ++q) { xwn[q] = ((const GAS v2u*)(X1 + (size_t)rn * D) + lane)[64 * q]; ywn[q] = ((const GAS v2u*)(Y + (size_t)rn * D) + lane)[64 * q]; }
        s0n = *(const GAS f32x4*)(SSY + (size_t)rn * 8);
        const int b = row / SEQ;
        if (b != bcur) { bcur = b;
#pragma unroll
            for (int q = 0; q < 4; ++q) { const f32x4 g2 = *(const GAS f32x4*)(mod + b * 6144 + 5120 + 4 * (lane + 64 * q));
#pragma unroll
                for (int i = 0; i < 4; ++i) g2p[q][i] = g2[i] * gp[q][i]; } }
        const float rstd = 1.0f / sqrtf(((s0[0] + s0[1]) + (s0[2] + s0[3])) * (1.f / D) + EPS);
        GAS f32x4* orow = (GAS f32x4*)(out + (size_t)row * D) + lane;
#pragma unroll
        for (int q = 0; q < 4; ++q) { f32x4 xv = {bflo(xw[q].x), bfhi(xw[q].x), bflo(xw[q].y), bfhi(xw[q].y)};
            xv[0] += g2p[q][0] * (bflo(yw[q].x) * rstd); xv[1] += g2p[q][1] * (bfhi(yw[q].x) * rstd); xv[2] += g2p[q][2] * (bflo(yw[q].y) * rstd); xv[3] += g2p[q][3] * (bfhi(yw[q].y) * rstd);
            orow[64 * q] = xv; }
#pragma unroll
        for (int q = 0; q < 4; ++q) { xw[q] = xwn[q]; yw[q] = ywn[q]; }
        s0 = s0n;
    }
}
#ifdef PROBE_V_LOADS
__device__ __forceinline__ void probe_v_loads(const Args& A) {
    const int tid = threadIdx.x, lane = tid & 63, wave = tid >> 6, p = blockIdx.x & 7, j = blockIdx.x >> 3, nj = gridDim.x >> 3, g = lane >> 3, c = lane & 7;
    const unsigned char* V8 = (const unsigned char*)(A.ws + WS_V8); const unsigned short* EI = (const unsigned short*)(A.ws + WS_EIDX); const float* ACT = (const float*)(A.ws + WS_ACT);
    unsigned* DUMP = (unsigned*)(A.ws + WS_PD);
    const int tper = M / nj, colb = 128 * p + 16 * c, tend = (j + 1) * tper, tlast = tend - NWAVES + wave;
    int t = j * tper + wave;
    PeerIdx ix1 = peer_ld_idx(EI, min(t + NWAVES, tlast), g), ix2 = peer_ld_idx(EI, min(t + 2 * NWAVES, tlast), g);
    v4u rawa[16], rawb[16]; PeerAct aca, acb;
    { const PeerIdx ix0 = peer_ld_idx(EI, t, g); peer_gather(V8, ix0, colb, rawa); aca = peer_ld_act(ACT, t, g); }
    for (; t < tend; t += 2 * NWAVES) {
        const int t1 = t + NWAVES, t2 = min(t + 2 * NWAVES, tlast), t3 = min(t + 3 * NWAVES, tlast), t4 = min(t + 4 * NWAVES, tlast);
        const PeerIdx ix3 = peer_ld_idx(EI, t3, g);
        peer_gather(V8, ix1, colb, rawb); acb = peer_ld_act(ACT, t1, g);
        { unsigned s = __builtin_bit_cast(unsigned, aca.a0[0]) + __builtin_bit_cast(unsigned, aca.a3[3]);
#pragma unroll
          for (int k = 0; k < 16; ++k) s += (rawa[k].x + rawa[k].y) + (rawa[k].z + rawa[k].w);
          DUMP[(size_t)t * 512 + p * 64 + lane] = s; }
        const PeerIdx ix4 = peer_ld_idx(EI, t4, g);
        peer_gather(V8, ix2, colb, rawa); aca = peer_ld_act(ACT, t2, g);
        { unsigned s = __builtin_bit_cast(unsigned, acb.a0[0]) + __builtin_bit_cast(unsigned, acb.a3[3]);
#pragma unroll
          for (int k = 0; k < 16; ++k) s += (rawb[k].x + rawb[k].y) + (rawb[k].z + rawb[k].w);
          DUMP[(size_t)t1 * 512 + p * 64 + lane] = s; }
        ix1 = ix3; ix2 = ix4;
    }
}
#endif

#ifdef PROBE_INSTR
__device__ __forceinline__ void probe_instr(const Args& A) {
    f32x2 a[8]; float f[16]; unsigned w = threadIdx.x * 0x01010101u + 0x38383838u;
#pragma unroll
    for (int i = 0; i < 8; ++i) a[i] = (f32x2){1.0f + i, 2.0f + i};
#pragma unroll
    for (int i = 0; i < 16; ++i) f[i] = 1.0f + i;
    for (int it = 0; it < 10000; ++it) {
#if PROBE_INSTR == 1
#pragma unroll
        for (int i = 0; i < 8; ++i) { asm volatile("v_pk_fma_f32 %0, %1, %2, %0" : "+v"(a[i]) : "v"(a[(i + 1) & 7]), "v"(a[(i + 2) & 7])); asm volatile("v_pk_fma_f32 %0, %1, %2, %0" : "+v"(a[i]) : "v"(a[(i + 3) & 7]), "v"(a[(i + 4) & 7])); }
#elif PROBE_INSTR == 2
#pragma unroll
        for (int i = 0; i < 16; ++i) asm volatile("v_fma_f32 %0, %1, %2, %0" : "+v"(f[i]) : "v"(f[(i + 1) & 15]), "v"(f[(i + 2) & 15]));
#elif PROBE_INSTR == 3
#pragma unroll
        for (int i = 0; i < 8; ++i) { asm volatile("v_cvt_pk_f32_fp8 %0, %1" : "=v"(a[i]) : "v"(w)); asm volatile("v_cvt_pk_f32_fp8 %0, %1" : "=v"(a[i]) : "v"(w)); }
#elif PROBE_INSTR == 4
#pragma unroll
        for (int i = 0; i < 8; ++i) { asm volatile("v_cvt_scalef32_pk_f32_fp4 %0, %1, 1.0" : "=v"(a[i]) : "v"(w)); asm volatile("v_cvt_scalef32_pk_f32_fp4 %0, %1, 1.0" : "=v"(a[i]) : "v"(w)); }
#elif PROBE_INSTR == 5
#pragma unroll
        for (int i = 0; i < 16; ++i) asm volatile("v_pk_fma_f16 %0, %1, %2, %0" : "+v"(f[i]) : "v"(f[(i + 1) & 15]), "v"(f[(i + 2) & 15]));
#elif PROBE_INSTR == 7
#pragma unroll
        for (int i = 0; i < 16; ++i) asm volatile("v_dot8c_i32_i4 %0, %1, %2" : "+v"(f[i]) : "v"(f[(i + 1) & 15]), "v"(w));
#elif PROBE_INSTR == 8
#pragma unroll
        for (int i = 0; i < 16; ++i) asm volatile("v_dot4c_i32_i8 %0, %1, %2" : "+v"(f[i]) : "v"(f[(i + 1) & 15]), "v"(w));
#elif PROBE_INSTR == 9
#pragma unroll
        for (int i = 0; i < 16; ++i) asm volatile("v_perm_b32 %0, %1, %2, %3" : "=v"(f[i]) : "v"(f[(i + 1) & 15]), "v"(f[(i + 2) & 15]), "v"(w));
#elif PROBE_INSTR == 10
#pragma unroll
        for (int i = 0; i < 16; ++i) asm volatile("v_mfma_f32_16x16x32_fp8_fp8 %0, %1, %2, %0" : "+v"(*(f32x4*)&f[4 * (i & 3)]) : "v"(a[i & 7]), "v"(a[(i + 1) & 7]));
#elif PROBE_INSTR == 6
#pragma unroll
        for (int i = 0; i < 16; ++i) asm volatile("v_cvt_scalef32_pk_f16_fp4 %0, %1, 1.0" : "=v"(f[i]) : "v"(w));
#endif
    }
    float s = 0.f;
#pragma unroll
    for (int i = 0; i < 8; ++i) s += a[i].x + a[i].y;
#pragma unroll
    for (int i = 0; i < 16; ++i) s += f[i];
    if (s == 123.456f) ((float*)(A.ws + WS_PD))[threadIdx.x] = s;
}
#endif
#ifndef MK_N_LAUNCHES
#define MK_N_LAUNCHES 1
#endif
constexpr int N_PHASES = 13;
typedef const __attribute__((address_space(4))) Args* KArgP;
__device__ __forceinline__ const Args& kargs() { KArgP p = (KArgP)__builtin_amdgcn_kernarg_segment_ptr(); asm volatile("" : "+s"(p)); return *(const Args*)p; }
__global__ void __launch_bounds__(NTHR, 2) hymba_fwd(Args A_) {
    extern __shared__ __attribute__((aligned(16))) unsigned char lds_raw[];
    LAS unsigned char* lds = (LAS unsigned char*)lds_raw;
    const int lo = A_.ph_lo, hi = A_.ph_hi;
#define A kargs()
#define ws (kargs().ws)
#ifndef DBLMASK
#define DBLMASK 0
#endif
#ifndef ONLYMASK
#define ONLYMASK 0xffff
#endif
#define IN(k) ((((ONLYMASK) >> (k)) & 1) && lo <= (k) && (k) < hi)
#define REP(k) for (int _rep = 0; _rep < (((DBLMASK) >> (k)) & 1) + 1; ++_rep)
    for (int u = threadIdx.x; u < (LDS_BYTES - RING_BYTES) / 4; u += NTHR) ((LAS unsigned*)(lds + RING_BYTES))[u] = 0u;
    __syncthreads();
    (void)xcd_barrier_post((unsigned*)(ws + WS_CTL) + CW_BAR, (volatile LAS unsigned*)(lds + MISC_OFF + 32));
    if (hi < 0) cg::this_grid().sync();
#define SEAM(k) do { if (IN(k) && IN((k) + 1)) { { XcdBarrier xb_; xb_.bar = (unsigned*)(ws + WS_CTL) + CW_BAR; xb_.x = xb_xcc_id(); xb_.st = (volatile LAS unsigned*)(lds + MISC_OFF + 32); xcd_barrier(xb_); } } } while (0)

    if (IN(0)) REP(0) { phase_mod(A, lds); } SEAM(0);
    if (IN(1)) REP(1) { phase_convert(A, lds); phase_prenorm(A, lds); } SEAM(1);
    if (IN(2)) REP(2) {
        pg8::Gemm g{(const pg8::bf16_t*)(ws + WS_H), (const pg8::bf16_t*)(ws + WS_WIN), M, NPROJ, D}; pg8::StaticOrder S; S.init(M, NPROJ, gridDim.x, (int)blockIdx.x);
        pg8::EpiProj E{(pg8::bf16_t*)(ws + WS_PROJ), NPROJ, (float*)(ws + WS_GATES), (const int*)A.in[I_POS], (const float*)A.in[I_BI], (const float*)A.in[I_BF]};
        pg8::gemm_phase<pg8::EpiProj, pg8::StaticOrder, true, true>(lds, g, S, E);
    } SEAM(2);
    if (IN(3)) REP(3) {
        phase_attn(A, lds);
        for (int wg = blockIdx.x; wg < 256; wg += gridDim.x) mlstm_group<false>(A, lds, wg);
    } SEAM(3);
    if (IN(4)) REP(4) { for (int wg = blockIdx.x; wg < 256; wg += gridDim.x) mlstm_group<true>(A, lds, wg); } SEAM(4);
    if (IN(5)) REP(5) {
        pg8::Gemm g{(const pg8::bf16_t*)(ws + WS_MIXIN), (const pg8::bf16_t*)(ws + WS_WOUT), M, D, D}; pg8::StaticOrder S; S.init(M, D, gridDim.x, (int)blockIdx.x);
        pg8::EpiMix E{(pg8::bf16_t*)(ws + WS_MIX), D, (float*)(ws + WS_SSQ)};
        pg8::gemm_phase<pg8::EpiMix, pg8::StaticOrder, true, true>(lds, g, S, E);
    } SEAM(5);
    if (IN(6)) REP(6) { phase_mid(A); } SEAM(6);
    if (IN(7)) REP(7) {
        pg8::Gemm g{(const pg8::bf16_t*)(ws + WS_H), (const pg8::bf16_t*)(ws + WS_WQ), M, 2048, D}; pg8::StaticOrder S; S.init(M, 2048, gridDim.x, (int)blockIdx.x);
        pg8::EpiPlain E{(pg8::bf16_t*)(ws + WS_PROJ), 2048};
        pg8::gemm_phase<pg8::EpiPlain, pg8::StaticOrder, true, true>(lds, g, S, E);
    } SEAM(7);
    if (IN(8)) REP(8) { phase_topk(A, lds); } SEAM(8);
    if (IN(9)) REP(9) { phase_peer_u(A); } SEAM(9);
    if (IN(10)) REP(10) { phase_peer_act(A); } SEAM(10);
#ifdef PROBE_INSTR
    if (IN(11)) { probe_instr(A); }
#endif
#ifdef PROBE_V_LOADS
    if (IN(11)) { probe_v_loads(A); }
#endif
    if (IN(11)) REP(11) { phase_peer_v(A); } SEAM(11);
    if (IN(12)) REP(12) { phase_peer_final(A); }
#undef IN
#undef SEAM
#undef A
#undef ws
}

extern "C" void kernel_launch(void* const* d_in, const int* in_sizes, int n_in, void* d_out, int out_size, void* d_ws, size_t ws_size, hipStream_t stream) {
    static int grid = 0;
    if (grid == 0) {
        if (n_in != 21 || in_sizes[0] != M * D || out_size != M * D || ws_size < WS_END) { fprintf(stderr, "kernel_launch: unexpected shapes (n_in %d, in0 %d, out %d, ws %zu < %zu)\n", n_in, n_in > 0 ? in_sizes[0] : -1, out_size, ws_size, (size_t)WS_END); grid = -1; return; }
        int dev = 0, cus = 0, per_cu = 0;
        if (hipGetDevice(&dev) != hipSuccess || hipDeviceGetAttribute(&cus, hipDeviceAttributeMultiprocessorCount, dev) != hipSuccess) { grid = -1; return; }
        if (hipFuncSetAttribute((const void*)hymba_fwd, hipFuncAttributeMaxDynamicSharedMemorySize, LDS_BYTES) != hipSuccess) { fprintf(stderr, "kernel_launch: hipFuncSetAttribute failed\n"); grid = -1; return; }
        if (hipOccupancyMaxActiveBlocksPerMultiprocessor(&per_cu, (const void*)hymba_fwd, NTHR, LDS_BYTES) != hipSuccess || per_cu < 1) { fprintf(stderr, "kernel_launch: occupancy query says %d blocks per CU\n", per_cu); per_cu = 1; }
        (void)hipGetLastError();
        grid = cus;
        if (grid != 256) fprintf(stderr, "kernel_launch: note: %d CUs (built for 256)\n", grid);
    }
    if (grid < 0) return;
    (void)hipMemsetAsync((char*)d_ws + WS_CTL, 0, CTL_ZERO_BYTES, stream);
    Args a{};
    for (int i = 0; i < 21; ++i) a.in[i] = d_in[i];
    a.out = (float*)d_out; a.ws = (unsigned char*)d_ws;
    if (MK_N_LAUNCHES == 1) {
        a.ph_lo = 0; a.ph_hi = N_PHASES;
        void* args[] = {&a};
        const hipError_t e = hipLaunchCooperativeKernel((const void*)hymba_fwd, dim3(grid), dim3(NTHR), args, LDS_BYTES, stream);
        if (e != hipSuccess) fprintf(stderr, "kernel_launch: cooperative launch failed: %s (grid %d)\n", hipGetErrorString(e), grid);
    } else {
        for (int p = 0; p < N_PHASES; ++p) { a.ph_lo = p; a.ph_hi = p + 1; hipLaunchKernelGGL(hymba_fwd, dim3(grid), dim3(NTHR), LDS_BYTES, stream, a); }
    }
}
```

```cpp
#include <hip/hip_runtime.h>
#include <hip/hip_cooperative_groups.h>
#include <cstdio>
#include <cstdint>
namespace cg = cooperative_groups;
#define TABLES_IN_PASS2 1
namespace pg8 {
#define PG8_LAS __attribute__((address_space(3)))
typedef unsigned short bf16_t;
typedef short bf16x8 __attribute__((ext_vector_type(8)));
typedef float f32x4 __attribute__((ext_vector_type(4)));
typedef unsigned u32x4 __attribute__((ext_vector_type(4)));
constexpr int BM = 256, BK = 64, HALF = 128, HTB = HALF * BK * 2  , STAGE_BYTES = 8 * HTB, NXCD = 8, WGM = 8;

__host__ __device__ __forceinline__ int lds_byte(int r, int c) { const int st = (r >> 4) * 2 + (c >> 5), rr = r & 15, cc = c & 31, ob = rr * 64 + cc * 2; return st * 1024 + (ob ^ (((ob >> 9) & 1) << 5)); }
__host__ __device__ __forceinline__ void stage_rc(int b, int& R, int& C) { const int st = b / 1024, sb = b % 1024, swz = sb ^ (((sb >> 9) & 1) << 5); R = (st >> 1) * 16 + swz / 64; C = (st & 1) * 32 + (swz % 64) / 2; }
__host__ __device__ __forceinline__ int perm32(int rho) { const int n = rho >> 4, i = rho & 15; return 8 * (i >> 2) + 4 * n + (i & 3); }

struct Unit { int pm, pn; };
struct Gemm { const bf16_t* A; const bf16_t* Bt; int M, N, K; };

struct StaticOrder {
    int nM, nN, nwg, G, c;
    __host__ __device__ void init(int M, int N, int G_, int c_) { nM = M / BM; nN = N / BM; nwg = nM * nN; G = G_; c = c_; }
    __host__ __device__ bool next(int i, Unit& u) const {
        const long L = (long)i * G + c; if (L >= nwg) return false;
        int wgid = (int)L; { const int q = nwg / NXCD, r = nwg % NXCD, xcd = wgid % NXCD, off = wgid / NXCD; wgid = (xcd < r ? xcd * (q + 1) : r * (q + 1) + (xcd - r) * q) + off; }
        const int nig = WGM * nN, gid = wgid / nig, fm = gid * WGM, gsz = (nM - fm) < WGM ? (nM - fm) : WGM;
        u.pm = fm + ((wgid % nig) % gsz); u.pn = (wgid % nig) / gsz; return true;
    }
    __device__ __forceinline__ void a_ready(const Unit&) const {}
    __device__ __forceinline__ void done(const Unit&) const {}
};

__device__ __forceinline__ unsigned cvt_pk_bf16(float lo, float hi) { unsigned r; asm volatile("v_cvt_pk_bf16_f32 %0, %1, %2" : "=v"(r) : "v"(lo), "v"(hi)); return r; }
typedef float f32x2 __attribute__((ext_vector_type(2)));
__device__ __forceinline__ f32x2 gelu_pk(f32x2 v) {
    const f32x2 av = __builtin_elementwise_abs(v), d = av * 0.2316418882f + 1.0f;
    f32x2 t; t.x = __builtin_amdgcn_rcpf(d.x); t.y = __builtin_amdgcn_rcpf(d.y);
    f32x2 q = t * 0.5307027145f + (-0.7265760135f); q = q * t + 0.7107068705f; q = q * t + (-0.142248368f); q = q * t + 0.127414796f; q = q * t;
    const f32x2 s = (v * v) * (-0.72134752044f);
    f32x2 e; e.x = __builtin_amdgcn_exp2f(s.x); e.y = __builtin_amdgcn_exp2f(s.y);
    const f32x2 m = v * (q * e), r = v - m;
    f32x2 o; o.x = v.x < 0.f ? m.x : r.x; o.y = v.y < 0.f ? m.y : r.y; return o;
}

__device__ __forceinline__ u32x4 pack8(const f32x4 v0, const f32x4 v1) { u32x4 w; w.x = cvt_pk_bf16(v0[0], v0[1]); w.y = cvt_pk_bf16(v0[2], v0[3]); w.z = cvt_pk_bf16(v1[0], v1[1]); w.w = cvt_pk_bf16(v1[2], v1[3]); return w; }

struct EpiPlain {
    static constexpr bool PERM = true, AFTER_DRAIN = false;
    bf16_t* O; int ldc;
    __device__ __forceinline__ void operator()(const f32x4 (&acc)[2][2][4][2], const Unit& u, int wr, int wc, int fr, int fq) const {
        const int row0 = u.pm * BM + wr * 64 + fr, col0 = u.pn * BM + wc * 32 + 8 * fq;
#pragma unroll
        for (int ai = 0; ai < 2; ++ai)
#pragma unroll
            for (int m = 0; m < 4; ++m) { bf16_t* rowp = O + (size_t)(row0 + ai * HALF + m * 16) * ldc + col0;
#pragma unroll
                for (int bj = 0; bj < 2; ++bj) *(u32x4*)(rowp + bj * HALF) = pack8(acc[ai][bj][m][0], acc[ai][bj][m][1]); }
    }
};

struct EpiProj {
    static constexpr bool PERM = true, AFTER_DRAIN = false;
    bf16_t* P; int ldc; float* gates; const int* pos; const float* b_i; const float* b_f;
    __device__ __forceinline__ void operator()(const f32x4 (&acc)[2][2][4][2], const Unit& u, int wr, int wc, int fr, int fq) const {
        const int row0 = u.pm * BM + wr * 64 + fr, col0 = u.pn * BM + wc * 32 + 8 * fq, pn = u.pn;
        if (pn == 9) {
            if (wc == 0 && fq == 0) {
                const f32x4 bi = {b_i[0], b_i[1], b_i[2], b_i[3]}, bf = {b_f[0], b_f[1], b_f[2], b_f[3]};
#pragma unroll
                for (int ai = 0; ai < 2; ++ai)
#pragma unroll
                    for (int m = 0; m < 4; ++m) { const int row = row0 + ai * HALF + m * 16;
                        const f32x4 iv = acc[ai][0][m][0] + bi, fv = acc[ai][0][m][1] + bf; f32x4 lf;
#pragma unroll
                        for (int j = 0; j < 4; ++j) lf[j] = fminf(fv[j], 0.f) - log1pf(__expf(-fabsf(fv[j])));
                        *(f32x4*)(gates + (size_t)row * 8) = iv; *(f32x4*)(gates + (size_t)row * 8 + 4) = lf; }
            }
            return;
        }
#pragma unroll
        for (int ai = 0; ai < 2; ++ai)
#pragma unroll
            for (int m = 0; m < 4; ++m) { const int row = row0 + ai * HALF + m * 16; bf16_t* rowp = P + (size_t)row * ldc + col0;
                const float posf = (pn <= 2) ? (float)pos[row] : 0.f;
#pragma unroll
                for (int bj = 0; bj < 2; ++bj) { f32x4 v0 = acc[ai][bj][m][0], v1 = acc[ai][bj][m][1];
                    const bool rope = (pn < 2) || (pn == 2 && bj == 0);
                    if (rope) {
                        const int p0 = ((col0 + bj * HALF) & 63) >> 1; const float sc = (pn < 2) ? 0.125f : 1.0f;
                        float x[8] = {v0[0], v0[1], v0[2], v0[3], v1[0], v1[1], v1[2], v1[3]};
#pragma unroll
                        for (int q = 0; q < 4; ++q) { const float invf = __builtin_amdgcn_exp2f(-(float)(p0 + q) * 0.41524101186092029f);
                            float r = posf * invf * 0.15915494309189535f; r = r - floorf(r);
                            const float c = __builtin_amdgcn_cosf(r) * sc, s = __builtin_amdgcn_sinf(r) * sc;
                            const float x1 = x[2 * q], x2 = x[2 * q + 1]; x[2 * q] = x1 * c - x2 * s; x[2 * q + 1] = x2 * c + x1 * s; }
                        v0 = (f32x4){x[0], x[1], x[2], x[3]}; v1 = (f32x4){x[4], x[5], x[6], x[7]};
                    } else if (pn >= 7) {
#pragma unroll
                        for (int j = 0; j < 4; ++j) { v0[j] = __builtin_amdgcn_rcpf(1.f + __expf(-v0[j])); v1[j] = __builtin_amdgcn_rcpf(1.f + __expf(-v1[j])); }
                    }
                    *(u32x4*)(rowp + bj * HALF) = pack8(v0, v1); } }
    }
};

struct EpiMix {
    static constexpr bool PERM = true, AFTER_DRAIN = false;
    bf16_t* O; int ldc; float* sumsq;
    __device__ __forceinline__ void operator()(const f32x4 (&acc)[2][2][4][2], const Unit& u, int wr, int wc, int fr, int fq) const {
        const int row0 = u.pm * BM + wr * 64 + fr, col0 = u.pn * BM + wc * 32 + 8 * fq;
#pragma unroll
        for (int ai = 0; ai < 2; ++ai)
#pragma unroll
            for (int m = 0; m < 4; ++m) { const int row = row0 + ai * HALF + m * 16; bf16_t* rowp = O + (size_t)row * ldc + col0; float s = 0.f;
#pragma unroll
                for (int bj = 0; bj < 2; ++bj) { const f32x4 v0 = acc[ai][bj][m][0], v1 = acc[ai][bj][m][1];
                    s += (v0[0] * v0[0] + v0[1] * v0[1]) + (v0[2] * v0[2] + v0[3] * v0[3]) + (v1[0] * v1[0] + v1[1] * v1[1]) + (v1[2] * v1[2] + v1[3] * v1[3]);
                    *(u32x4*)(rowp + bj * HALF) = pack8(v0, v1); }
                s += __shfl_xor(s, 16); s += __shfl_xor(s, 32);
                if (fq == 0) sumsq[(size_t)row * 16 + u.pn * 4 + wc] = s; }
    }
};
template <class Epi, class Sched, bool ALIGN_EPI = false, bool SP2 = false>
__device__ __forceinline__ void gemm_phase(PG8_LAS unsigned char* lds, const Gemm g, const Sched& S, const Epi& E) {
    const int tid = threadIdx.x, wid = __builtin_amdgcn_readfirstlane(tid >> 6), lane = tid & 63, wr = wid >> 2, wc = wid & 3, fr = lane & 15, fq = lane >> 4;
    const int K = g.K, nt = K / BK;
    unsigned voffA[2], voffB[2];
#pragma unroll
    for (int i = 0; i < 2; ++i) { int R, C; stage_rc(tid * 16 + i * 8192, R, C); const int Rb = Epi::PERM ? ((R & ~31) + perm32(R & 31)) : R;
        voffA[i] = (unsigned)(R * K + C) * 2u; voffB[i] = (unsigned)(Rb * K + C) * 2u; }
    const size_t kstep = (size_t)(BK * 2);
    const size_t hstep = (size_t)HALF * K * 2;
    const size_t tstep = 2 * hstep;
    const unsigned ldsw = (unsigned)wid * 1024u;
    const int aoff = lds_byte(wr * 64 + fr, fq * 8), boff = lds_byte(wc * 32 + fr, fq * 8);
#define PG8_SA(b, h) (((b) * 2 + (h)) * HTB)
#define PG8_SB(b, h) ((4 + (b) * 2 + (h)) * HTB)
#define PG8_STAGE(bufoff, gbase, voff) do { _Pragma("unroll") for (int _i = 0; _i < 2; ++_i) \
        __builtin_amdgcn_global_load_lds((const unsigned*)((const char*)(gbase) + (voff)[_i]), (PG8_LAS unsigned*)(lds + (bufoff) + ldsw + _i * 8192), 16, 0, 0); } while (0)
#define PG8_LDA(dst, b, h) do { _Pragma("unroll") for (int m = 0; m < 4; ++m) _Pragma("unroll") for (int k = 0; k < 2; ++k) dst[m][k] = *(const PG8_LAS bf16x8*)(lds + PG8_SA(b, h) + aoff + m * 2048 + k * 1024); } while (0)
#define PG8_LDB(dst, b, h) do { _Pragma("unroll") for (int n = 0; n < 2; ++n) _Pragma("unroll") for (int k = 0; k < 2; ++k) dst[n][k] = *(const PG8_LAS bf16x8*)(lds + PG8_SB(b, h) + boff + n * 2048 + k * 1024); } while (0)
#define PG8_MMA(ai, bj, At, Bt) do { __builtin_amdgcn_s_setprio(1); _Pragma("unroll") for (int m = 0; m < 4; ++m) _Pragma("unroll") for (int n = 0; n < 2; ++n) _Pragma("unroll") for (int k = 0; k < 2; ++k) \
        acc[ai][bj][m][n] = __builtin_amdgcn_mfma_f32_16x16x32_bf16(Bt[n][k], At[m][k], acc[ai][bj][m][n], 0, 0, 0); __builtin_amdgcn_s_setprio(0); } while (0)
#define PG8_WAIT_V(n) asm volatile("s_waitcnt vmcnt(" #n ")" ::: "memory")
#define PG8_WAIT_L(n) asm volatile("s_waitcnt lgkmcnt(" #n ")" ::: "memory")
#define PG8_BAR __builtin_amdgcn_s_barrier()
#define PG8_SCHED __builtin_amdgcn_sched_barrier(0)
    Unit cur, nxt; int ui = 0;
    if (!S.next(0, cur)) return;
    f32x4 acc[2][2][4][2];
#pragma unroll
    for (int a = 0; a < 2; ++a)
#pragma unroll
        for (int b = 0; b < 2; ++b)
#pragma unroll
            for (int m = 0; m < 4; ++m)
#pragma unroll
                for (int n = 0; n < 2; ++n) acc[a][b][m][n] = (f32x4){0.f, 0.f, 0.f, 0.f};
    bf16x8 At[4][2], B0[2][2], B1[2][2];
    const char* cA = (const char*)g.A + (size_t)cur.pm * tstep; const char* cB = (const char*)g.Bt + (size_t)cur.pn * tstep;
    S.a_ready(cur);
    if constexpr (SP2) {
        PG8_STAGE(PG8_SB(0, 0), cB, voffB); PG8_STAGE(PG8_SB(0, 1), cB + hstep, voffB); PG8_STAGE(PG8_SA(0, 0), cA, voffA); PG8_STAGE(PG8_SA(0, 1), cA + hstep, voffA);
        if (wr == 1) PG8_BAR;
        PG8_WAIT_V(2); PG8_BAR;
        PG8_STAGE(PG8_SB(1, 0), cB + kstep, voffB); PG8_STAGE(PG8_SA(1, 0), cA + kstep, voffA); PG8_STAGE(PG8_SB(1, 1), cB + hstep + kstep, voffB);
        PG8_WAIT_V(6); PG8_BAR;
    } else {
        PG8_STAGE(PG8_SB(0, 0), cB, voffB); PG8_STAGE(PG8_SA(0, 0), cA, voffA); PG8_STAGE(PG8_SB(0, 1), cB + hstep, voffB); PG8_STAGE(PG8_SA(0, 1), cA + hstep, voffA);
        if (wr == 1) PG8_BAR;
        PG8_WAIT_V(4); PG8_BAR;
        PG8_STAGE(PG8_SB(1, 0), cB + kstep, voffB); PG8_STAGE(PG8_SA(1, 0), cA + kstep, voffA); PG8_STAGE(PG8_SB(1, 1), cB + hstep + kstep, voffB);
        PG8_WAIT_V(6); PG8_BAR;
    }
    for (;;) {
        const bool has_next = S.next(ui + 1, nxt);
        const char* nA = has_next ? (const char*)g.A + (size_t)nxt.pm * tstep : cA; const char* nB = has_next ? (const char*)g.Bt + (size_t)nxt.pn * tstep : cB;
        for (int t = 0; t < nt; t += 2) {
            const bool last = (t == nt - 2);
            const char* a1 = cA + (size_t)(t + 1) * kstep;
            const char* a2 = last ? nA : cA + (size_t)(t + 2) * kstep; const char* b2 = last ? nB : cB + (size_t)(t + 2) * kstep;
            const char* a3 = a2 + kstep; const char* b3 = b2 + kstep;
            if (last && has_next) S.a_ready(nxt);
            if constexpr (SP2) {
            PG8_LDB(B0, 0, 0); PG8_LDB(B1, 0, 1); PG8_SCHED; PG8_LDA(At, 0, 0); PG8_STAGE(PG8_SA(1, 1), a1 + hstep, voffA);
            PG8_WAIT_V(8); PG8_WAIT_L(0); PG8_BAR; PG8_MMA(0, 0, At, B0); PG8_MMA(0, 1, At, B1); PG8_BAR; PG8_SCHED;
            PG8_LDA(At, 0, 1); PG8_STAGE(PG8_SB(0, 0), b2, voffB); PG8_STAGE(PG8_SB(0, 1), b2 + hstep, voffB); PG8_STAGE(PG8_SA(0, 0), a2, voffA);
            PG8_WAIT_V(8); PG8_WAIT_L(0); PG8_BAR; PG8_MMA(1, 0, At, B0); PG8_MMA(1, 1, At, B1); PG8_BAR; PG8_SCHED;
            PG8_LDB(B0, 1, 0); PG8_LDB(B1, 1, 1); PG8_SCHED; PG8_LDA(At, 1, 0); PG8_STAGE(PG8_SA(0, 1), a2 + hstep, voffA);
            PG8_WAIT_V(8); PG8_WAIT_L(0); PG8_BAR; PG8_MMA(0, 0, At, B0); PG8_MMA(0, 1, At, B1); PG8_BAR; PG8_SCHED;
            PG8_LDA(At, 1, 1); PG8_STAGE(PG8_SB(1, 0), b3, voffB); PG8_STAGE(PG8_SB(1, 1), b3 + hstep, voffB); PG8_STAGE(PG8_SA(1, 0), a3, voffA);
            PG8_WAIT_V(8); PG8_WAIT_L(0); PG8_BAR; PG8_MMA(1, 0, At, B0); PG8_MMA(1, 1, At, B1); PG8_BAR; PG8_SCHED;
            } else {
            PG8_LDB(B0, 0, 0); PG8_SCHED; PG8_LDA(At, 0, 0); PG8_STAGE(PG8_SA(1, 1), a1 + hstep, voffA);
            PG8_WAIT_L(8); PG8_BAR; PG8_WAIT_L(0); PG8_MMA(0, 0, At, B0); PG8_BAR; PG8_SCHED;
            PG8_LDB(B1, 0, 1); PG8_STAGE(PG8_SB(0, 0), b2, voffB);
            PG8_BAR; PG8_WAIT_L(0); PG8_MMA(0, 1, At, B1); PG8_BAR;
            PG8_LDA(At, 0, 1); PG8_STAGE(PG8_SA(0, 0), a2, voffA);
            PG8_BAR; PG8_WAIT_L(0); PG8_MMA(1, 0, At, B0); PG8_BAR; PG8_SCHED;
            PG8_STAGE(PG8_SB(0, 1), b2 + hstep, voffB);
            PG8_WAIT_V(6); PG8_BAR; PG8_MMA(1, 1, At, B1); PG8_BAR;
            PG8_LDB(B0, 1, 0); PG8_SCHED; PG8_LDA(At, 1, 0); PG8_STAGE(PG8_SA(0, 1), a2 + hstep, voffA);
            PG8_WAIT_L(8); PG8_BAR; PG8_WAIT_L(0); PG8_MMA(0, 0, At, B0); PG8_BAR; PG8_SCHED;
            PG8_LDB(B1, 1, 1); PG8_STAGE(PG8_SB(1, 0), b3, voffB);
            PG8_BAR; PG8_WAIT_L(0); PG8_MMA(0, 1, At, B1); PG8_BAR;
            PG8_LDA(At, 1, 1); PG8_STAGE(PG8_SA(1, 0), a3, voffA);
            PG8_BAR; PG8_WAIT_L(0); PG8_MMA(1, 0, At, B0); PG8_BAR; PG8_SCHED;
            PG8_STAGE(PG8_SB(1, 1), b3 + hstep, voffB);
            PG8_WAIT_V(6); PG8_BAR; PG8_MMA(1, 1, At, B1); PG8_BAR;
            }
        }
        if constexpr (ALIGN_EPI) { if (wr == 0) PG8_BAR; }
        if constexpr (!Epi::AFTER_DRAIN) { E(acc, cur, wr, wc, fr, fq); S.done(cur); }
        if (!has_next) break;
#pragma unroll
        for (int a = 0; a < 2; ++a)
#pragma unroll
            for (int b = 0; b < 2; ++b)
#pragma unroll
                for (int m = 0; m < 4; ++m)
#pragma unroll
                    for (int n = 0; n < 2; ++n) acc[a][b][m][n] = (f32x4){0.f, 0.f, 0.f, 0.f};
        cur = nxt; cA = nA; cB = nB; ++ui;
        if constexpr (ALIGN_EPI) { if (wr == 1) PG8_BAR; }
    }
    PG8_WAIT_V(0);
    if constexpr (!ALIGN_EPI) { if (wr == 0) PG8_BAR; }
    PG8_BAR;
    if constexpr (Epi::AFTER_DRAIN) { E.fused(acc, cur, wr, wc, fr, fq, lds, wid, lane); S.done(cur); }
#undef PG8_SA
#undef PG8_SB
#undef PG8_STAGE
#undef PG8_LDA
#undef PG8_LDB
#undef PG8_MMA
#undef PG8_WAIT_V
#undef PG8_WAIT_L
#undef PG8_BAR
#undef PG8_SCHED
}
}
constexpr int NB = 8, SEQ = 8192, D = 1024, M = NB * SEQ;
constexpr int DIN = 2312, NPROJ = 2304, NIN_PAD = 2560;
constexpr int C_AQ = 0, C_AK = 512, C_AV = 640, C_MQ = 768, C_MK = 1024, C_MV = 1280, C_MO = 1792;
constexpr int NEXP = 16384, NSLOT = 128;
constexpr float EPS = 1e-6f;
constexpr int NWAVES = 8, NTHR = 512;

constexpr size_t MiB = 1u << 20;
constexpr size_t WS_CTL = 0, CTL_ZERO_BYTES = 1 * MiB;
constexpr size_t WS_MOD = 1 * MiB;
constexpr size_t WS_WIN = 2 * MiB;
constexpr size_t WS_WOUT = 8 * MiB;
constexpr size_t WS_WQ = 10 * MiB;
constexpr size_t WS_KEYS = 14 * MiB;
constexpr size_t WS_GATES = 16 * MiB;
constexpr size_t WS_SSQ = 832 * MiB;
constexpr size_t WS_MST = 20 * MiB;
constexpr size_t WS_U8 = 32 * MiB, WS_V8 = 48 * MiB;
constexpr size_t WS_SC = 64 * MiB;
constexpr size_t WS_H = 96 * MiB;
constexpr size_t WS_PROJ = 224 * MiB;
constexpr size_t WS_MIXIN = 512 * MiB;
constexpr size_t WS_MIX = 640 * MiB;
constexpr size_t WS_EIDX = 768 * MiB, WS_GATE = 800 * MiB;
constexpr size_t WS_PD = 224 * MiB;
constexpr size_t WS_X1 = 512 * MiB;
constexpr size_t WS_ACT = 840 * MiB;
constexpr size_t WS_W8 = 840 * MiB, WS_WSC = 864 * MiB;
constexpr size_t WS_SSY = 872 * MiB;
constexpr size_t WS_H8 = 880 * MiB;
constexpr size_t WS_HS = 944 * MiB;
constexpr size_t WS_END = 945 * MiB;
constexpr int CW_BAR = 4096;
constexpr int CW_SUMSQ = 65536;
static_assert((CW_SUMSQ + M) * 4 <= (int)CTL_ZERO_BYTES, "ctl");

constexpr int RING_BYTES = 131072, MISC_OFF = RING_BYTES + 320, LDS_BYTES = 147456;

#define GAS __attribute__((address_space(1)))
#define LAS __attribute__((address_space(3)))
typedef unsigned short bf16;
typedef unsigned v4u __attribute__((ext_vector_type(4)));
typedef unsigned v2u __attribute__((ext_vector_type(2)));
typedef float f32x4 __attribute__((ext_vector_type(4)));
typedef GAS unsigned gu32;
#define LDS_WAIT() asm volatile("s_waitcnt lgkmcnt(0)" ::: "memory")
#define VM_WAIT() asm volatile("s_waitcnt vmcnt(0)" ::: "memory")
typedef float f32x2_cv __attribute__((ext_vector_type(2)));
typedef __bf16 bf16x2_cv __attribute__((ext_vector_type(2)));
__device__ __forceinline__ unsigned pk2(float lo, float hi) { return __builtin_bit_cast(unsigned, __builtin_convertvector((f32x2_cv){lo, hi}, bf16x2_cv)); }
__device__ __forceinline__ unsigned f2bf(float f) { return pk2(f, 0.f) & 0xffffu; }
__device__ __forceinline__ float bflo(unsigned w) { return __builtin_bit_cast(float, w << 16); }
__device__ __forceinline__ float bfhi(unsigned w) { return __builtin_bit_cast(float, w & 0xffff0000u); }
__device__ __forceinline__ float bf1(bf16 h) { return __builtin_bit_cast(float, (unsigned)h << 16); }
__device__ __forceinline__ float wave_sum(float v) {
#pragma unroll
    for (int o = 1; o < 64; o <<= 1) v += __shfl_xor(v, o);
    return v;
}
__device__ __forceinline__ float wave_max(float v) {
#pragma unroll
    for (int o = 1; o < 64; o <<= 1) v = fmaxf(v, __shfl_xor(v, o));
    return v;
}

typedef float f32x2 __attribute__((ext_vector_type(2)));
__device__ __forceinline__ void cvt16_fp8(const v4u w, float (&o)[16]) {
    const unsigned ww[4] = {w.x, w.y, w.z, w.w};
#pragma unroll
    for (int i = 0; i < 4; ++i) { const f32x2 a = __builtin_amdgcn_cvt_pk_f32_fp8((int)ww[i], false), b = __builtin_amdgcn_cvt_pk_f32_fp8((int)ww[i], true);
        o[4 * i] = a.x; o[4 * i + 1] = a.y; o[4 * i + 2] = b.x; o[4 * i + 3] = b.y; }
}
__device__ __forceinline__ void p0_row_fp8(const float* src, unsigned char* dst, float* sc, int row, int lane) {
    const GAS f32x4* sp = (const GAS f32x4*)(src + (size_t)row * D + 16 * lane);
    const f32x4 a = sp[0], b = sp[1], c = sp[2], d = sp[3];
    float mx = 0.f;
#pragma unroll
    for (int i = 0; i < 4; ++i) mx = fmaxf(fmaxf(fmaxf(mx, fabsf(a[i])), fmaxf(fabsf(b[i]), fabsf(c[i]))), fabsf(d[i]));
    mx = wave_max(mx); const float s = mx > 0.f ? 224.0f / mx : 1.0f;
    v4u o; int w;
    w = __builtin_amdgcn_cvt_pk_fp8_f32(a[0] * s, a[1] * s, 0, false); w = __builtin_amdgcn_cvt_pk_fp8_f32(a[2] * s, a[3] * s, w, true); o.x = (unsigned)w;
    w = __builtin_amdgcn_cvt_pk_fp8_f32(b[0] * s, b[1] * s, 0, false); w = __builtin_amdgcn_cvt_pk_fp8_f32(b[2] * s, b[3] * s, w, true); o.y = (unsigned)w;
    w = __builtin_amdgcn_cvt_pk_fp8_f32(c[0] * s, c[1] * s, 0, false); w = __builtin_amdgcn_cvt_pk_fp8_f32(c[2] * s, c[3] * s, w, true); o.z = (unsigned)w;
    w = __builtin_amdgcn_cvt_pk_fp8_f32(d[0] * s, d[1] * s, 0, false); w = __builtin_amdgcn_cvt_pk_fp8_f32(d[2] * s, d[3] * s, w, true); o.w = (unsigned)w;
    *(GAS v4u*)(dst + (size_t)row * D + 16 * lane) = o;
    if (lane == 0) sc[row] = mx > 0.f ? mx * (1.0f / 224.0f) : 1.0f;
}

__device__ __forceinline__ unsigned pack4_i8(float a, float b, float c, float d) { return ((unsigned)__float2int_rn(a) & 0xffu) | (((unsigned)__float2int_rn(b) & 0xffu) << 8) | (((unsigned)__float2int_rn(c) & 0xffu) << 16) | (((unsigned)__float2int_rn(d) & 0xffu) << 24); }
__device__ __forceinline__ void p0_row_i8(const float* src, unsigned char* dst, float* sc, int row, int lane) {
    const GAS f32x4* sp = (const GAS f32x4*)(src + (size_t)row * D + 16 * lane);
    const f32x4 a = sp[0], b = sp[1], c = sp[2], d = sp[3];
    float mx = 0.f;
#pragma unroll
    for (int i = 0; i < 4; ++i) mx = fmaxf(fmaxf(fmaxf(mx, fabsf(a[i])), fmaxf(fabsf(b[i]), fabsf(c[i]))), fabsf(d[i]));
    mx = wave_max(mx); const float s = mx > 0.f ? 127.0f / mx : 1.0f;
    v4u o; o.x = pack4_i8(a[0] * s, a[1] * s, a[2] * s, a[3] * s); o.y = pack4_i8(b[0] * s, b[1] * s, b[2] * s, b[3] * s); o.z = pack4_i8(c[0] * s, c[1] * s, c[2] * s, c[3] * s); o.w = pack4_i8(d[0] * s, d[1] * s, d[2] * s, d[3] * s);
    *(GAS v4u*)(dst + (size_t)row * D + 16 * lane) = o;
    if (lane == 0) sc[row] = mx > 0.f ? mx * (1.0f / 127.0f) : 1.0f;
}

__device__ __forceinline__ unsigned pack8_i4(const f32x4 a, const f32x4 b, float s) {
    unsigned w = 0;
#pragma unroll
    for (int i = 0; i < 4; ++i) { const int qa = max(-8, min(7, __float2int_rn(a[i] * s))), qb = max(-8, min(7, __float2int_rn(b[i] * s))); w |= ((unsigned)qa & 15u) << (4 * i); w |= ((unsigned)qb & 15u) << (16 + 4 * i); }
    return w;
}
__device__ __forceinline__ void p0_row_i4(const f32x4 a, const f32x4 b, const f32x4 c, const f32x4 d, unsigned char* dst, float* sc, int row, int lane) {
    float ss = 0.f;
#pragma unroll
    for (int i = 0; i < 4; ++i) ss += (a[i] * a[i] + b[i] * b[i]) + (c[i] * c[i] + d[i] * d[i]);
    ss = wave_sum(ss); const float sig = sqrtf(ss * (1.f / D)), s = sig > 0.f ? 3.0f / sig : 1.0f;
    v2u o; o.x = pack8_i4(a, b, s); o.y = pack8_i4(c, d, s);
    *(GAS v2u*)(dst + (size_t)(lane >> 4) * ((size_t)NEXP * 128) + (size_t)row * 128 + 8 * (lane & 15)) = o;
    if (lane == 0) sc[2 * row] = sig > 0.f ? sig * (1.0f / 3.0f) : 1.0f;
}

__device__ __forceinline__ unsigned pack8_fp4(const f32x4 a, const f32x4 b, float s) {
    unsigned w = 0;
    w = __builtin_amdgcn_cvt_scalef32_pk_fp4_f32(w, fminf(fmaxf(a[0] * s, -6.f), 6.f), fminf(fmaxf(a[1] * s, -6.f), 6.f), 1.0f, 0);
    w = __builtin_amdgcn_cvt_scalef32_pk_fp4_f32(w, fminf(fmaxf(a[2] * s, -6.f), 6.f), fminf(fmaxf(a[3] * s, -6.f), 6.f), 1.0f, 1);
    w = __builtin_amdgcn_cvt_scalef32_pk_fp4_f32(w, fminf(fmaxf(b[0] * s, -6.f), 6.f), fminf(fmaxf(b[1] * s, -6.f), 6.f), 1.0f, 2);
    w = __builtin_amdgcn_cvt_scalef32_pk_fp4_f32(w, fminf(fmaxf(b[2] * s, -6.f), 6.f), fminf(fmaxf(b[3] * s, -6.f), 6.f), 1.0f, 3);
    return w;
}
__device__ __forceinline__ void p0_row_fp4(const f32x4 a, const f32x4 b, const f32x4 c, const f32x4 d, unsigned char* dst, float* sc, int row, int lane) {
    float mx = 0.f;
#pragma unroll
    for (int i = 0; i < 4; ++i) mx = fmaxf(fmaxf(fmaxf(mx, fabsf(a[i])), fmaxf(fabsf(b[i]), fabsf(c[i]))), fabsf(d[i]));
    mx = wave_max(mx); const float s = mx > 0.f ? 7.0f / mx : 1.0f;
    v2u o; o.x = pack8_fp4(a, b, s); o.y = pack8_fp4(c, d, s);
    *(GAS v2u*)(dst + (size_t)(lane >> 4) * ((size_t)NEXP * 128) + (size_t)row * 128 + 8 * (lane & 15)) = o;
    if (lane == 0) sc[2 * row] = mx > 0.f ? mx * (1.0f / 7.0f) : 1.0f;
}
#define XB_TMO      128
#define XB_XCNT(j)  (256  + 64 * (j))
#define XB_XSUB(j)  (1280 + 64 * (j))
#define XB_XGEN(j)  (2304 + 64 * (j))
#define XB_TOP      3328
#define XB_TOPGEN   3392
#define XCD_BAR_WORDS 3456
#define XB_SPIN_CAP (1u << 18)

__device__ __forceinline__ unsigned xb_ld(unsigned* p)              { return __hip_atomic_load(p, __ATOMIC_RELAXED, __HIP_MEMORY_SCOPE_AGENT); }
__device__ __forceinline__ unsigned xb_add(unsigned* p, unsigned v) { return __hip_atomic_fetch_add(p, v, __ATOMIC_RELAXED, __HIP_MEMORY_SCOPE_AGENT); }
__device__ __forceinline__ unsigned xb_xcc_id() { return (unsigned)__builtin_amdgcn_s_getreg((3 << 11) | 20) & 0xFu; }
#define XB_SPIN(cond, bar) do { unsigned _sp = 0; while (cond) { __builtin_amdgcn_s_sleep(1); \
    if ((++_sp & 255u) == 0u) { if (xb_ld(&(bar)[XB_TMO])) break; if (_sp > XB_SPIN_CAP) { atomicAdd(&(bar)[XB_TMO], 1u); break; } } } } while (0)

struct XcdBarrier {
    unsigned* bar; unsigned x;
    volatile LAS unsigned* st;
};

__device__ __forceinline__ XcdBarrier xcd_barrier_post(unsigned* bar, volatile LAS unsigned* st) {
    XcdBarrier b; b.bar = bar; b.x = xb_xcc_id(); b.st = st;
    if (threadIdx.x == 0) (void)xb_add(&bar[XB_XCNT(b.x)], 1u);
    return b;
}
__device__ __forceinline__ void xcd_barrier_complete(unsigned* bar, unsigned x, unsigned& nloc, unsigned& nx) {
    const unsigned G = gridDim.x * gridDim.y * gridDim.z;
    unsigned sum, cnt, mine, sp = 0u;
    for (;;) {
        sum = 0u; cnt = 0u; mine = 0u;
#pragma unroll
        for (unsigned j = 0; j < 16; ++j) { const unsigned c = xb_ld(&bar[XB_XCNT(j)]); sum += c; cnt += (c > 0u) ? 1u : 0u; mine = (j == x) ? c : mine; }
        if (sum == G) break;
        __builtin_amdgcn_s_sleep(1);
        if ((++sp & 255u) == 0u) { if (xb_ld(&bar[XB_TMO])) break; if (sp > XB_SPIN_CAP) { atomicAdd(&bar[XB_TMO], 1u); break; } }
    }
    nloc = mine > 0u ? mine : 1u; nx = cnt > 0u ? cnt : 1u;
}

__device__ __forceinline__ void xcd_barrier(const XcdBarrier& b) {
    asm volatile("s_waitcnt vmcnt(0)" ::: "memory");
    __syncthreads();
    if (threadIdx.x == 0) {
        unsigned* bar = b.bar;
        __builtin_amdgcn_s_waitcnt(0);
        unsigned nloc = b.st[0], nx = b.st[1];
        if (nloc == 0u) { xcd_barrier_complete(bar, b.x, nloc, nx); b.st[0] = nloc; b.st[1] = nx; }
        const unsigned old = xb_add(&bar[XB_XSUB(b.x)], 1u);
        const unsigned gen = old / nloc;
        if (old + 1u == (gen + 1u) * nloc) {
            __builtin_amdgcn_fence(__ATOMIC_RELEASE, "agent");
            asm volatile("s_waitcnt vmcnt(0)" ::: "memory");
            const unsigned og = xb_add(&bar[XB_TOP], 1u);
            const unsigned tg = og / nx;
            if (og + 1u == (tg + 1u) * nx) xb_add(&bar[XB_TOPGEN], 1u);
            else XB_SPIN(xb_ld(&bar[XB_TOPGEN]) == tg, bar);
            __builtin_amdgcn_fence(__ATOMIC_ACQUIRE, "agent");
            xb_add(&bar[XB_XGEN(b.x)], 1u);
            asm volatile("s_waitcnt vmcnt(0)" ::: "memory");
        } else {
            XB_SPIN(xb_ld(&bar[XB_XGEN(b.x)]) == gen, bar);
            __builtin_amdgcn_fence(__ATOMIC_ACQUIRE, "agent");
            asm volatile("s_waitcnt vmcnt(0)" ::: "memory");
        }
    }
    __syncthreads();
}
struct Args { const void* in[21]; float* out; unsigned char* ws; int ph_lo, ph_hi; };
enum { I_X = 0, I_C, I_POS, I_WMOD, I_BMOD, I_GPRE1, I_GPOST1, I_WIN, I_CONVW, I_BI, I_BF, I_MNG, I_SINK, I_WOUT, I_GPRE2, I_GPOST2, I_WQ, I_K1, I_K2, I_U, I_V };

__device__ __forceinline__ int newcol(int o) {
    if (o < 640) { const int hd = o >> 6, d = o & 63; return (hd << 6) + 2 * (d & 31) + (d >> 5); }
    if (o < 1792) return o;
    if (o < 1800) return 2304 + (o - 1792);
    return o - 8;
}
template <bool REMAP>
__device__ __forceinline__ void p0_transpose_item(const float* W, int K, int N, bf16* WT, LAS float* scr, int item, int lane) {
    const int nblk = (N + 31) / 32, kb = item / nblk, nb = item % nblk, k0 = 64 * kb, n0 = 32 * nb;
    const int ncol = n0 + (lane & 31);
#pragma unroll 8
    for (int i = 0; i < 32; ++i) { const int kk = 2 * i + (lane >> 5); scr[kk * 33 + (lane & 31)] = (ncol < N) ? W[(size_t)(k0 + kk) * N + ncol] : 0.f; }
    LDS_WAIT(); asm volatile("" ::: "memory");
    const int c = lane & 7;
#pragma unroll
    for (int j = 0; j < 4; ++j) { const int n = (lane >> 3) + 8 * j; const LAS float* s = scr + (8 * c) * 33 + n;
        v4u o; o.x = pk2(s[0 * 33], s[1 * 33]); o.y = pk2(s[2 * 33], s[3 * 33]); o.z = pk2(s[4 * 33], s[5 * 33]); o.w = pk2(s[6 * 33], s[7 * 33]);
        if (n0 + n < N) { const int drow = REMAP ? newcol(n0 + n) : (n0 + n); *(GAS v4u*)(WT + (size_t)drow * K + k0 + 8 * c) = o; } }
    LDS_WAIT(); asm volatile("" ::: "memory");
}
__device__ __forceinline__ void p0_convert(const float* src, bf16* dst, size_t n, int gt, int ngt) {
    for (size_t i = (size_t)gt * 8; i < n; i += (size_t)ngt * 8) {
        const f32x4 a = *(const GAS f32x4*)(src + i), b = *(const GAS f32x4*)(src + i + 4);
        v4u o; o.x = pk2(a[0], a[1]); o.y = pk2(a[2], a[3]); o.z = pk2(b[0], b[1]); o.w = pk2(b[2], b[3]);
        *(GAS v4u*)(dst + i) = o; }
}
__device__ __forceinline__ void phase_mod(const Args& A, LAS unsigned char* lds) {
    const int tid = threadIdx.x, G = gridDim.x, blk = blockIdx.x;
    unsigned char* ws = A.ws;
    const float* c = (const float*)A.in[I_C]; const float* wm = (const float*)A.in[I_WMOD]; const float* bm = (const float*)A.in[I_BMOD];
    float* mod = (float*)(ws + WS_MOD); LAS float* cs = (LAS float*)lds; LAS float* red = cs + 8 * 1024;
    for (int e = tid; e < 8 * 1024 / 4; e += NTHR) *(LAS f32x4*)(cs + 4 * e) = *(const GAS f32x4*)(c + 4 * e);
    __syncthreads();
    for (int it = blk; it < 6144 / 24; it += G) {
        const int kg = tid >> 5, col = tid & 31, j = it * 24 + (col < 24 ? col : 23); float acc[8];
#pragma unroll
        for (int b = 0; b < 8; ++b) acc[b] = 0.f;
#pragma unroll 16
        for (int i = 0; i < 64; ++i) { const int k = kg + 16 * i; const float w = wm[(size_t)k * 6144 + j];
#pragma unroll
            for (int b = 0; b < 8; ++b) acc[b] += cs[b * 1024 + k] * w; }
#pragma unroll
        for (int b = 0; b < 8; ++b) red[(kg * 32 + col) * 8 + b] = acc[b];
        __syncthreads();
        if (tid < 256) { const int b = tid >> 5, cc = tid & 31; float s = 0.f;
#pragma unroll
            for (int g = 0; g < 16; ++g) s += red[(g * 32 + cc) * 8 + b];
            if (cc < 24) mod[b * 6144 + it * 24 + cc] = s + bm[it * 24 + cc]; }
        __syncthreads();
    }
}
__device__ __forceinline__ void phase_convert(const Args& A, LAS unsigned char* lds) {
    const int tid = threadIdx.x, lane = tid & 63, wave = tid >> 6, G = gridDim.x, blk = blockIdx.x;
    unsigned char* ws = A.ws;
    {
        LAS float* scr = (LAS float*)(lds + wave * 16384);
        const int gw = blk * NWAVES + wave, NGW = G * NWAVES;
        const int I_IN = (D / 64) * ((DIN + 31) / 32), I_OUT = (D / 64) * (D / 32), I_Q = (D / 64) * (2048 / 32);
        bf16* win = (bf16*)(ws + WS_WIN); bf16* wout = (bf16*)(ws + WS_WOUT); bf16* wq = (bf16*)(ws + WS_WQ);
        for (int it = gw; it < I_IN + I_OUT + I_Q; it += NGW) {
            int r = it;
            if (r < I_IN) { p0_transpose_item<true>((const float*)A.in[I_WIN], D, DIN, win, scr, r, lane); continue; } r -= I_IN;
            if (r < I_OUT) { p0_transpose_item<false>((const float*)A.in[I_WOUT], D, D, wout, scr, r, lane); continue; } r -= I_OUT;
            p0_transpose_item<false>((const float*)A.in[I_WQ], D, 2048, wq, scr, r, lane);
        }
        const int gt = blk * NTHR + tid, ngt = G * NTHR;
        for (int i = gt; i < (NIN_PAD - DIN) * D / 8; i += ngt) *(GAS v4u*)(win + (size_t)DIN * D + (size_t)i * 8) = (v4u){0u, 0u, 0u, 0u};
        p0_convert((const float*)A.in[I_K1], (bf16*)(ws + WS_KEYS), (size_t)8 * 128 * 128, gt, ngt);
        p0_convert((const float*)A.in[I_K2], (bf16*)(ws + WS_KEYS) + 8 * 128 * 128, (size_t)8 * 128 * 128, gt, ngt);
#ifndef TABLES_IN_PASS2
        {
            const float* usrc = (const float*)A.in[I_U]; const float* vsrc = (const float*)A.in[I_V];
            {
                auto rowp = [&](int r) { return (const GAS f32x4*)(usrc + (size_t)r * D + 16 * lane); };
                int r = gw; const GAS f32x4* sp = rowp(min(r, NEXP - 1)); f32x4 a = sp[0], b = sp[1], c = sp[2], d = sp[3];
                for (; r < NEXP; r += NGW) { const GAS f32x4* sn = rowp(min(r + NGW, NEXP - 1)); const f32x4 an = sn[0], bn = sn[1], cn = sn[2], dn = sn[3];
                    p0_row_i4(a, b, c, d, ws + WS_U8, (float*)(ws + WS_SC), r, lane);
                    a = an; b = bn; c = cn; d = dn; }
            }
            {
                auto ldv = [&](int r, f32x4& a, f32x4& b, f32x4& c, f32x4& d) { const float* sp = vsrc + (size_t)r * D + (lane >> 4) * 256 + (lane & 15);
#pragma unroll
                    for (int i = 0; i < 4; ++i) { a[i] = sp[16 * i]; b[i] = sp[16 * (4 + i)]; c[i] = sp[16 * (8 + i)]; d[i] = sp[16 * (12 + i)]; } };
                int r = gw; f32x4 a, b, c, d; ldv(min(r, NEXP - 1), a, b, c, d);
                for (; r < NEXP; r += NGW) { f32x4 an, bn, cn, dn; ldv(min(r + NGW, NEXP - 1), an, bn, cn, dn);
                    p0_row_fp4(a, b, c, d, ws + WS_V8, (float*)(ws + WS_SC) + 1, r, lane);
                    a = an; b = bn; c = cn; d = dn; }
            }
        }
#endif
    }
}

__device__ __forceinline__ void phase_prenorm(const Args& A, LAS unsigned char* lds) {
    const int tid = threadIdx.x, lane = tid & 63, wave = tid >> 6, G = gridDim.x;
    const float* x = (const float*)A.in[I_X]; const float* g = (const float*)A.in[I_GPRE1]; const float* mod = (const float*)(A.ws + WS_MOD);
    bf16* H = (bf16*)(A.ws + WS_H); float* gates = (float*)(A.ws + WS_GATES);
    LAS float* wg = (LAS float*)lds;
    __syncthreads();
    for (int k = tid; k < D; k += NTHR) { const float* wr = (const float*)A.in[I_WIN] + (size_t)k * DIN + 1792; const f32x4 w0 = *(const GAS f32x4*)wr, w1 = *(const GAS f32x4*)(wr + 4);
#pragma unroll
        for (int j = 0; j < 4; ++j) { wg[j * D + k] = w0[j]; wg[(4 + j) * D + k] = w1[j]; } }
    __syncthreads();
    const int gi = ((lane >> 5) & 1) * 4 + ((lane >> 4) & 1) * 2 + ((lane >> 3) & 1);
    const float gbias = gi < 4 ? ((const float*)A.in[I_BI])[gi] : ((const float*)A.in[I_BF])[gi - 4];
    f32x4 gg[4];
#pragma unroll
    for (int j = 0; j < 4; ++j) gg[j] = *(const GAS f32x4*)(g + 4 * (lane + 64 * j));
    const int stride = G * NWAVES; int row = blockIdx.x * NWAVES + wave;
    f32x4 v[4], vn[4], shv[4], gsv[4]; int bcur = -1;
#pragma unroll
    for (int j = 0; j < 4; ++j) v[j] = ((const GAS f32x4*)(x + (size_t)row * D) + lane)[64 * j];
    for (; row < M; row += stride) {
        const int rn = min(row + stride, M - 1);
#pragma unroll
        for (int j = 0; j < 4; ++j) vn[j] = ((const GAS f32x4*)(x + (size_t)rn * D) + lane)[64 * j];
        const int b = row / SEQ; float s = 0.f;
        if (b != bcur) { bcur = b;
#pragma unroll
            for (int j = 0; j < 4; ++j) { const int k = 4 * (lane + 64 * j); shv[j] = *(const GAS f32x4*)(mod + b * 6144 + k); const f32x4 sc = *(const GAS f32x4*)(mod + b * 6144 + 1024 + k);
#pragma unroll
                for (int i = 0; i < 4; ++i) gsv[j][i] = gg[j][i] * (1.f + sc[i]); } }
#pragma unroll
        for (int j = 0; j < 4; ++j) s += (v[j][0] * v[j][0] + v[j][1] * v[j][1]) + (v[j][2] * v[j][2] + v[j][3] * v[j][3]);
        const float rstd = __builtin_amdgcn_rsqf(wave_sum(s) * (1.f / D) + EPS);
        GAS v2u* o = (GAS v2u*)(H + (size_t)row * D) + lane;
        float gd[8];
#pragma unroll
        for (int q = 0; q < 8; ++q) gd[q] = 0.f;
#pragma unroll
        for (int j = 0; j < 4; ++j) {
            f32x4 y;
#pragma unroll
            for (int i = 0; i < 4; ++i) y[i] = v[j][i] * rstd * gsv[j][i] + shv[j][i];
            v2u w; w.x = pk2(y[0], y[1]); w.y = pk2(y[2], y[3]); o[64 * j] = w;
#pragma unroll
            for (int q = 0; q < 8; ++q) { const f32x4 ww = *(LAS const f32x4*)(wg + q * D + 4 * (lane + 64 * j)); gd[q] += (y[0] * ww[0] + y[1] * ww[1]) + (y[2] * ww[2] + y[3] * ww[3]); } }
#pragma unroll
        for (int i = 0; i < 4; ++i) { const bool up = (lane & 32) != 0; const float keep = up ? gd[i + 4] : gd[i], send = up ? gd[i] : gd[i + 4]; gd[i] = keep + __shfl_xor(send, 32); }
#pragma unroll
        for (int i = 0; i < 2; ++i) { const bool up = (lane & 16) != 0; const float keep = up ? gd[i + 2] : gd[i], send = up ? gd[i] : gd[i + 2]; gd[i] = keep + __shfl_xor(send, 16); }
        { const bool up = (lane & 8) != 0; const float keep = up ? gd[1] : gd[0], send = up ? gd[0] : gd[1]; gd[0] = keep + __shfl_xor(send, 8); }
        float gv = gd[0]; gv += __shfl_xor(gv, 4); gv += __shfl_xor(gv, 2); gv += __shfl_xor(gv, 1); gv += gbias;
        if ((lane & 7) == 0) gates[(size_t)row * 8 + gi] = gi < 4 ? gv : (fminf(gv, 0.f) - log1pf(__expf(-fabsf(gv))));
#pragma unroll
        for (int j = 0; j < 4; ++j) v[j] = vn[j];
    }
}

__device__ __forceinline__ void phase_mid(const Args& A) {
    const int tid = threadIdx.x, lane = tid & 63, wave = tid >> 6, G = gridDim.x;
    const float* x = (const float*)A.in[I_X]; const float* gpost = (const float*)A.in[I_GPOST1]; const float* gpre = (const float*)A.in[I_GPRE2];
    const float* mod = (const float*)(A.ws + WS_MOD); const float* sumsq = (const float*)(A.ws + WS_SSQ);
    const bf16* MIX = (const bf16*)(A.ws + WS_MIX); bf16* H = (bf16*)(A.ws + WS_H); bf16* X1 = (bf16*)(A.ws + WS_X1);
    const int stride = G * NWAVES; int row = blockIdx.x * NWAVES + wave;
    f32x4 xv[4], xn[4], q[4], qn[4], g1p[4], gs2[4], sh2[4]; v2u mw[4], mn[4]; int bcur = -1;
#pragma unroll
    for (int j = 0; j < 4; ++j) { xv[j] = ((const GAS f32x4*)(x + (size_t)row * D) + lane)[64 * j]; mw[j] = ((const GAS v2u*)(MIX + (size_t)row * D) + lane)[64 * j]; q[j] = *(const GAS f32x4*)(sumsq + (size_t)row * 16 + 4 * j); }
    for (; row < M; row += stride) {
        const int rn = min(row + stride, M - 1);
#pragma unroll
        for (int j = 0; j < 4; ++j) { xn[j] = ((const GAS f32x4*)(x + (size_t)rn * D) + lane)[64 * j]; mn[j] = ((const GAS v2u*)(MIX + (size_t)rn * D) + lane)[64 * j]; qn[j] = *(const GAS f32x4*)(sumsq + (size_t)rn * 16 + 4 * j); }
        const int b = row / SEQ;
        if (b != bcur) { bcur = b;
#pragma unroll
            for (int j = 0; j < 4; ++j) { const int k = 4 * (lane + 64 * j); const f32x4 gp = *(const GAS f32x4*)(gpost + k), g1 = *(const GAS f32x4*)(mod + b * 6144 + 2048 + k), gg = *(const GAS f32x4*)(gpre + k), sc = *(const GAS f32x4*)(mod + b * 6144 + 4096 + k);
                sh2[j] = *(const GAS f32x4*)(mod + b * 6144 + 3072 + k);
#pragma unroll
                for (int i = 0; i < 4; ++i) { g1p[j][i] = g1[i] * gp[i]; gs2[j][i] = gg[i] * (1.f + sc[i]); } } }
        const float rm = __builtin_amdgcn_rsqf(((((q[0][0] + q[0][1]) + (q[0][2] + q[0][3])) + ((q[1][0] + q[1][1]) + (q[1][2] + q[1][3]))) + (((q[2][0] + q[2][1]) + (q[2][2] + q[2][3])) + ((q[3][0] + q[3][1]) + (q[3][2] + q[3][3])))) * (1.f / D) + EPS);
        f32x4 v[4]; float s = 0.f;
#pragma unroll
        for (int j = 0; j < 4; ++j) {
            const float mx[4] = {bflo(mw[j].x), bfhi(mw[j].x), bflo(mw[j].y), bfhi(mw[j].y)};
#pragma unroll
            for (int i = 0; i < 4; ++i) { v[j][i] = xv[j][i] + g1p[j][i] * (mx[i] * rm); s += v[j][i] * v[j][i]; }
            { v2u w; w.x = pk2(v[j][0], v[j][1]); w.y = pk2(v[j][2], v[j][3]); *((GAS v2u*)(X1 + (size_t)row * D) + lane + 64 * j) = w; } }
        const float rstd = __builtin_amdgcn_rsqf(wave_sum(s) * (1.f / D) + EPS);
        GAS v2u* o = (GAS v2u*)(H + (size_t)row * D) + lane; float amx = 0.f;
#pragma unroll
        for (int j = 0; j < 4; ++j) {
#pragma unroll
            for (int i = 0; i < 4; ++i) { v[j][i] = v[j][i] * rstd * gs2[j][i] + sh2[j][i]; amx = fmaxf(amx, fabsf(v[j][i])); }
            v2u w; w.x = pk2(v[j][0], v[j][1]); w.y = pk2(v[j][2], v[j][3]); o[64 * j] = w; }
        amx = wave_max(amx); const float s8 = amx > 0.f ? 119.0f * __builtin_amdgcn_rcpf(amx) : 1.0f;
        GAS unsigned short* ohh = (GAS unsigned short*)((unsigned char*)A.ws + WS_H8 + (size_t)row * (D / 2)) + lane; GAS unsigned short* ohl = (GAS unsigned short*)((unsigned char*)A.ws + WS_H8 + 32 * MiB + (size_t)row * (D / 2)) + lane;
#pragma unroll
        for (int j = 0; j < 4; ++j) { unsigned whh = 0, whl = 0;
#pragma unroll
            for (int i = 0; i < 4; ++i) { const int tq = __float2int_rn(v[j][i] * s8) + 8; whh |= ((unsigned)(tq >> 4) & 15u) << (4 * i); whl |= ((unsigned)((tq & 15) - 8) & 15u) << (4 * i); }
            ohh[64 * j] = (unsigned short)whh; ohl[64 * j] = (unsigned short)whl; }
        if (lane == 0) ((float*)(A.ws + WS_HS))[row] = amx > 0.f ? amx * (1.0f / 119.0f) : 1.0f;
#pragma unroll
        for (int j = 0; j < 4; ++j) { xv[j] = xn[j]; mw[j] = mn[j]; q[j] = qn[j]; }
    }
}
__device__ __forceinline__ void load64bf(const bf16* p, float (&o)[64]) {
#pragma unroll
    for (int i = 0; i < 8; ++i) { const v4u w = *(const GAS v4u*)(p + 8 * i);
        o[8 * i + 0] = bflo(w.x); o[8 * i + 1] = bfhi(w.x); o[8 * i + 2] = bflo(w.y); o[8 * i + 3] = bfhi(w.y);
        o[8 * i + 4] = bflo(w.z); o[8 * i + 5] = bfhi(w.z); o[8 * i + 6] = bflo(w.w); o[8 * i + 7] = bfhi(w.w); }
}
__device__ __forceinline__ void phase_attn_naive(const Args& A, int vb, int nvb) {
    const bf16* P = (const bf16*)(A.ws + WS_PROJ); bf16* MI = (bf16*)(A.ws + WS_MIXIN); const float* sinks = (const float*)A.in[I_SINK];
    for (int task = vb * NTHR + (int)threadIdx.x; task < 8 * M; task += nvb * NTHR) {
        const int h = task / M, t = task % M, s = t % SEQ, kvh = h >> 2;
        float q[64], o[64];
        load64bf(P + (size_t)t * NPROJ + C_AQ + h * 64, q);
#pragma unroll
        for (int d = 0; d < 64; ++d) o[d] = 0.f;
        float mx = sinks[h], l = 1.f;
        for (int j = 0; j < 128; ++j) {
            const int sj = s - 127 + j; const bool valid = sj >= 0; const int tk = valid ? (t - 127 + j) : t;
            const bf16* kr = P + (size_t)tk * NPROJ + C_AK + kvh * 64; float sc = 0.f;
#pragma unroll
            for (int i = 0; i < 8; ++i) { const v4u w = *(const GAS v4u*)(kr + 8 * i);
                sc += q[8 * i + 0] * bflo(w.x) + q[8 * i + 1] * bfhi(w.x) + q[8 * i + 2] * bflo(w.y) + q[8 * i + 3] * bfhi(w.y)
                    + q[8 * i + 4] * bflo(w.z) + q[8 * i + 5] * bfhi(w.z) + q[8 * i + 6] * bflo(w.w) + q[8 * i + 7] * bfhi(w.w); }
            if (valid) {
                const float mn = fmaxf(mx, sc), al = __expf(mx - mn), p = __expf(sc - mn); mx = mn; l = l * al + p;
                const bf16* vr = P + (size_t)tk * NPROJ + C_AV + kvh * 64;
#pragma unroll
                for (int i = 0; i < 8; ++i) { const v4u w = *(const GAS v4u*)(vr + 8 * i);
                    o[8 * i + 0] = o[8 * i + 0] * al + p * bflo(w.x); o[8 * i + 1] = o[8 * i + 1] * al + p * bfhi(w.x);
                    o[8 * i + 2] = o[8 * i + 2] * al + p * bflo(w.y); o[8 * i + 3] = o[8 * i + 3] * al + p * bfhi(w.y);
                    o[8 * i + 4] = o[8 * i + 4] * al + p * bflo(w.z); o[8 * i + 5] = o[8 * i + 5] * al + p * bfhi(w.z);
                    o[8 * i + 6] = o[8 * i + 6] * al + p * bflo(w.w); o[8 * i + 7] = o[8 * i + 7] * al + p * bfhi(w.w); }
            }
        }
        const float il = 1.f / l; bf16* orow = MI + (size_t)t * D + h * 64;
#pragma unroll
        for (int i = 0; i < 8; ++i) { v4u w; w.x = pk2(o[8 * i] * il, o[8 * i + 1] * il); w.y = pk2(o[8 * i + 2] * il, o[8 * i + 3] * il);
            w.z = pk2(o[8 * i + 4] * il, o[8 * i + 5] * il); w.w = pk2(o[8 * i + 6] * il, o[8 * i + 7] * il); *(GAS v4u*)(orow + 8 * i) = w; }
    }
}

__device__ __forceinline__ void phase_mlstm_naive(const Args& A, LAS unsigned char* lds, int bh) {
    const int tid = threadIdx.x, lane = tid & 63, wave = tid >> 6, b = bh >> 2, h = bh & 3, dv = tid >> 2, part = tid & 3;
    const bf16* P = (const bf16*)(A.ws + WS_PROJ); bf16* MI = (bf16*)(A.ws + WS_MIXIN); const float* gates = (const float*)(A.ws + WS_GATES);
    const float* cw = (const float*)A.in[I_CONVW]; const float* ng = (const float*)A.in[I_MNG];
    LAS float* qs = (LAS float*)lds; LAS float* ks = qs + 64 * 64; LAS float* vs = ks + 64 * 64; LAS float* ig = vs + 64 * 128; LAS float* lfg = ig + 64; LAS float* hb = lfg + 64;
    float C[16], n[16]; float m = 0.f;
#pragma unroll
    for (int j = 0; j < 16; ++j) { C[j] = 0.f; n[j] = 0.f; }
    for (int ch = 0; ch < SEQ / 64; ++ch) {
        const int s0 = ch * 64; const size_t t0 = (size_t)b * SEQ + s0;
        for (int e = tid; e < 64 * 64; e += NTHR) { const int l = e >> 6, dk = e & 63; float aq = 0.f, ak = 0.f;
#pragma unroll
            for (int j = 0; j < 4; ++j) { const int sj = s0 + l - 3 + j; if (sj >= 0) { const bf16* r = P + ((size_t)b * SEQ + sj) * NPROJ;
                aq += cw[j * 512 + h * 64 + dk] * bf1(r[C_MQ + h * 64 + dk]); ak += cw[j * 512 + 256 + h * 64 + dk] * bf1(r[C_MK + h * 64 + dk]); } }
            qs[e] = 0.125f * aq / (1.f + __expf(-aq)); ks[e] = ak / (1.f + __expf(-ak)); }
        for (int e = tid; e < 64 * 128; e += NTHR) { const int l = e >> 7, d = e & 127; vs[e] = bf1(P[(t0 + l) * NPROJ + C_MV + h * 128 + d]); }
        if (tid < 64) { ig[tid] = gates[(t0 + tid) * 8 + h]; lfg[tid] = gates[(t0 + tid) * 8 + 4 + h]; }
        __syncthreads();
        for (int l = 0; l < 64; ++l) {
            const float lf = lfg[l], ii = ig[l], mn = fmaxf(lf + m, ii), fd = __expf(lf + m - mn), iw = __expf(ii - mn), vv = vs[l * 128 + dv] * iw;
            float num = 0.f, den = 0.f;
#pragma unroll
            for (int j = 0; j < 16; ++j) { const float kk = ks[l * 64 + part * 16 + j], qq = qs[l * 64 + part * 16 + j];
                C[j] = fd * C[j] + vv * kk; n[j] = fd * n[j] + iw * kk; num += C[j] * qq; den += n[j] * qq; }
            num += __shfl_xor(num, 1); num += __shfl_xor(num, 2); den += __shfl_xor(den, 1); den += __shfl_xor(den, 2);
            if (part == 0) hb[l * 128 + dv] = num / fmaxf(fabsf(den), __expf(-mn));
            m = mn;
        }
        __syncthreads();
        for (int l = wave * 8; l < wave * 8 + 8; ++l) { const float a0 = hb[l * 128 + lane], a1 = hb[l * 128 + 64 + lane];
            const float r = 1.0f / sqrtf(wave_sum(a0 * a0 + a1 * a1) * (1.f / 128.f) + EPS);
            const bf16* pr = P + (t0 + l) * NPROJ + C_MO + h * 128; bf16* orow = MI + (t0 + l) * D + 512 + h * 128;
            orow[lane] = (bf16)f2bf(a0 * r * ng[h * 128 + lane] * bf1(pr[lane])); orow[64 + lane] = (bf16)f2bf(a1 * r * ng[h * 128 + 64 + lane] * bf1(pr[64 + lane])); }
        __syncthreads();
    }
}

__device__ __forceinline__ void ld16bf(const bf16* p, float (&o)[16]) {
    const v4u w0 = *(const GAS v4u*)p, w1 = *(const GAS v4u*)(p + 8);
    o[0] = bflo(w0.x); o[1] = bfhi(w0.x); o[2] = bflo(w0.y); o[3] = bfhi(w0.y); o[4] = bflo(w0.z); o[5] = bfhi(w0.z); o[6] = bflo(w0.w); o[7] = bfhi(w0.w);
    o[8] = bflo(w1.x); o[9] = bfhi(w1.x); o[10] = bflo(w1.y); o[11] = bfhi(w1.y); o[12] = bflo(w1.z); o[13] = bfhi(w1.z); o[14] = bflo(w1.w); o[15] = bfhi(w1.w);
}
typedef short bf16x8 __attribute__((ext_vector_type(8)));
#define MFMA16(a, b, c) __builtin_amdgcn_mfma_f32_16x16x32_bf16((a), (b), (c), 0, 0, 0)
__device__ __forceinline__ bf16x8 ldfrag(LAS const unsigned char* img, int row, int kbyte) { return *(LAS const bf16x8*)(img + row * 144 + kbyte); }
__device__ __forceinline__ bf16x8 ldfrag_sw(LAS const unsigned char* img, int row, int kbyte) { return *(LAS const bf16x8*)(img + row * 144 + (kbyte ^ (((row >> 3) & 7) << 4))); }
__device__ __forceinline__ unsigned cvtpk(float lo, float hi) { unsigned r; asm volatile("v_cvt_pk_bf16_f32 %0, %1, %2" : "=v"(r) : "v"(lo), "v"(hi)); return r; }

namespace ml {
constexpr int O_Q = 0, O_QA = 9216, O_K = 18432, O_KWT = 27648, O_VT = 36864, O_CX = 57600, CXB = 20736, O_S = 99072, O_GB = 108288, O_GA = O_GB + 4096, O_GC = O_GA + 4096, O_DEN = O_GC + 4096, O_SSQ = O_DEN + 256, O_END = O_SSQ + 2048;
static_assert(O_END <= 131072, "mlstm LDS");
constexpr size_t MST_SC = 11 * MiB;
}
template <bool OUT>
__device__ __forceinline__ void mlstm_group(const Args& A, LAS unsigned char* lds, int wg) {
    using namespace ml;
    const int tid = threadIdx.x, lane = tid & 63, wave = __builtin_amdgcn_readfirstlane(tid >> 6), fr = lane & 15, fq = lane >> 4;
    const int bh = wg >> 3, grp = wg & 7, b = bh >> 2, h = bh & 3;
    const size_t tg0 = (size_t)b * SEQ + (size_t)grp * 1024;
    const bf16* P = (const bf16*)(A.ws + WS_PROJ); bf16* MI = (bf16*)(A.ws + WS_MIXIN); const float* gates = (const float*)(A.ws + WS_GATES);
    const float* cw = (const float*)A.in[I_CONVW]; const float* ng = (const float*)A.in[I_MNG];
    float* MST = (float*)(A.ws + WS_MST); float* MSC = (float*)(A.ws + WS_MST + MST_SC);
    LAS float* GB = (LAS float*)(lds + O_GB); LAS float* GA = (LAS float*)(lds + O_GA); LAS float* GC = (LAS float*)(lds + O_GC);
    LAS float* DEN = (LAS float*)(lds + O_DEN); LAS float* SSQ = (LAS float*)(lds + O_SSQ);
    __syncthreads();
#pragma unroll
    for (int cc = 0; cc < 2; ++cc) { const int c = 2 * wave + cc; const size_t t = tg0 + c * 64 + lane;
        float bc = gates[t * 8 + 4 + h]; const float ii = gates[t * 8 + h];
#pragma unroll
        for (int o = 1; o < 64; o <<= 1) { const float v = __shfl_up(bc, o); if (lane >= o) bc += v; }
        const float a = ii - bc; float cm = a;
#pragma unroll
        for (int o = 1; o < 64; o <<= 1) { const float v = __shfl_up(cm, o); if (lane >= o) cm = fmaxf(cm, v); }
        GB[c * 64 + lane] = bc; GA[c * 64 + lane] = a; GC[c * 64 + lane] = cm; }
    for (int e = tid; e < 16 * 32; e += NTHR) { const int r = e >> 5, cpair = e & 31; *(LAS unsigned*)(lds + O_VT + (128 + r) * 144 + cpair * 4) = (r == 0) ? 0x3F803F80u : 0u; }
    f32x4 st[5];
#pragma unroll
    for (int i = 0; i < 5; ++i) st[i] = (f32x4){0.f, 0.f, 0.f, 0.f};
    float m = OUT ? 0.f : -__builtin_inff(); float Btot = 0.f;
    if (OUT) {
        for (int gp = 0; gp < grp; ++gp) { const int wgp = bh * 8 + gp; const float mg = MSC[wgp * 2], Bg = MSC[wgp * 2 + 1];
            const float mn = fmaxf(Bg + m, mg), f0 = __expf(Bg + m - mn), f1 = __expf(mg - mn);
#pragma unroll
            for (int i = 0; i < 5; ++i)
#pragma unroll
                for (int r = 0; r < 4; ++r) st[i][r] = f0 * st[i][r] + f1 * MST[((size_t)wgp * 20 + i * 4 + r) * NTHR + tid];
            m = mn; }
#pragma unroll
        for (int j = 0; j < 4; ++j)
#pragma unroll
            for (int r = 0; r < 4; ++r) *(LAS bf16*)(lds + O_CX + (16 * wave + 4 * fq + r) * 144 + (16 * j + fr) * 2) = (bf16)f2bf(st[j][r]);
        if (wave < 4) {
#pragma unroll
            for (int r = 0; r < 4; ++r) *(LAS bf16*)(lds + O_CX + (128 + 4 * fq + r) * 144 + (16 * wave + fr) * 2) = (bf16)f2bf(st[4][r]); }
    }
    float gsc[4];
#pragma unroll
    for (int r = 0; r < 4; ++r) gsc[r] = ng[h * 128 + 16 * wave + 4 * fq + r];
    const int sl = tid >> 3, cg = tid & 7;
    v4u pk[4], pvv[2]; f32x4 kw0[4], kw1[4];
    auto ld_rows = [&](int c) { const int sabs = grp * 1024 + c * 64 + sl;
#pragma unroll
        for (int j = 0; j < 4; ++j) { const int sj = max(sabs - 3 + j, 0); pk[j] = *(const GAS v4u*)(P + ((size_t)b * SEQ + sj) * NPROJ + C_MK + h * 64 + 8 * cg); }
#pragma unroll
        for (int gi = 0; gi < 2; ++gi) pvv[gi] = *(const GAS v4u*)(P + (tg0 + (size_t)c * 64 + sl) * NPROJ + C_MV + h * 128 + 8 * (cg + 8 * gi)); };
    if (!OUT) {
#pragma unroll
        for (int j = 0; j < 4; ++j) { kw0[j] = *(const GAS f32x4*)(cw + j * 512 + 256 + h * 64 + 8 * cg); kw1[j] = *(const GAS f32x4*)(cw + j * 512 + 256 + h * 64 + 8 * cg + 4); }
        ld_rows(0); }
    __syncthreads();
    for (int c = 0; c < 16; ++c) {
        const float bL = GB[c * 64 + 63], M63 = fmaxf(m, GC[c * 64 + 63]), decay = __expf(m - M63);
        const size_t tc0 = tg0 + (size_t)c * 64;
        if (!OUT) {
            const int sabs = grp * 1024 + c * 64 + sl; float ak[8];
#pragma unroll
            for (int i = 0; i < 8; ++i) ak[i] = 0.f;
#pragma unroll
            for (int j = 0; j < 4; ++j) { const float on = (sabs - 3 + j >= 0) ? 1.0f : 0.0f; const v4u wk = pk[j]; const f32x4 k0 = kw0[j] * on, k1 = kw1[j] * on;
                ak[0] += k0[0] * bflo(wk.x); ak[1] += k0[1] * bfhi(wk.x); ak[2] += k0[2] * bflo(wk.y); ak[3] += k0[3] * bfhi(wk.y);
                ak[4] += k1[0] * bflo(wk.z); ak[5] += k1[1] * bfhi(wk.z); ak[6] += k1[2] * bflo(wk.w); ak[7] += k1[3] * bfhi(wk.w); }
            const v4u wv0 = pvv[0], wv1 = pvv[1];
            if (c + 1 < 16) ld_rows(c + 1);
            const float wsv = __expf(GA[c * 64 + sl] - M63);
#pragma unroll
            for (int i = 0; i < 8; ++i) { const float kvv = ak[i] * __builtin_amdgcn_rcpf(1.f + __expf(-ak[i])); *(LAS bf16*)(lds + O_KWT + (8 * cg + i) * 144 + (sl ^ (8 * cg)) * 2) = (bf16)f2bf(kvv * wsv); }
#pragma unroll
            for (int gi = 0; gi < 2; ++gi) { const int g8 = cg + 8 * gi; const v4u wv = gi ? wv1 : wv0; const unsigned ww[4] = {wv.x, wv.y, wv.z, wv.w};
#pragma unroll
                for (int i = 0; i < 4; ++i) { *(LAS bf16*)(lds + O_VT + (8 * g8 + 2 * i) * 144 + (sl ^ (8 * cg)) * 2) = (bf16)(ww[i] & 0xffffu); *(LAS bf16*)(lds + O_VT + (8 * g8 + 2 * i + 1) * 144 + (sl ^ (8 * cg)) * 2) = (bf16)(ww[i] >> 16); } }
        } else {
            const int sabs = grp * 1024 + c * 64 + sl;
            float aq[8], ak[8];
#pragma unroll
            for (int i = 0; i < 8; ++i) { aq[i] = 0.f; ak[i] = 0.f; }
#pragma unroll
            for (int j = 0; j < 4; ++j) { const int sj = sabs - 3 + j;
                if (sj >= 0) { const bf16* rp = P + ((size_t)b * SEQ + sj) * NPROJ;
                    const v4u wq = *(const GAS v4u*)(rp + C_MQ + h * 64 + 8 * cg), wk = *(const GAS v4u*)(rp + C_MK + h * 64 + 8 * cg);
                    const f32x4 q0 = *(const GAS f32x4*)(cw + j * 512 + h * 64 + 8 * cg), q1 = *(const GAS f32x4*)(cw + j * 512 + h * 64 + 8 * cg + 4);
                    const f32x4 k0 = *(const GAS f32x4*)(cw + j * 512 + 256 + h * 64 + 8 * cg), k1 = *(const GAS f32x4*)(cw + j * 512 + 256 + h * 64 + 8 * cg + 4);
                    aq[0] += q0[0] * bflo(wq.x); aq[1] += q0[1] * bfhi(wq.x); aq[2] += q0[2] * bflo(wq.y); aq[3] += q0[3] * bfhi(wq.y);
                    aq[4] += q1[0] * bflo(wq.z); aq[5] += q1[1] * bfhi(wq.z); aq[6] += q1[2] * bflo(wq.w); aq[7] += q1[3] * bfhi(wq.w);
                    ak[0] += k0[0] * bflo(wk.x); ak[1] += k0[1] * bfhi(wk.x); ak[2] += k0[2] * bflo(wk.y); ak[3] += k0[3] * bfhi(wk.y);
                    ak[4] += k1[0] * bflo(wk.z); ak[5] += k1[1] * bfhi(wk.z); ak[6] += k1[2] * bflo(wk.w); ak[7] += k1[3] * bfhi(wk.w); } }
            const float Ml = fmaxf(m, GC[c * 64 + sl]), ainter = __expf(m - Ml), wsv = __expf(GA[c * 64 + sl] - M63);
            float qv[8], kv[8];
#pragma unroll
            for (int i = 0; i < 8; ++i) { qv[i] = 0.125f * aq[i] * __builtin_amdgcn_rcpf(1.f + __expf(-aq[i])); kv[i] = ak[i] * __builtin_amdgcn_rcpf(1.f + __expf(-ak[i])); }
            if (OUT) {
                v4u w; w.x = pk2(qv[0], qv[1]); w.y = pk2(qv[2], qv[3]); w.z = pk2(qv[4], qv[5]); w.w = pk2(qv[6], qv[7]); *(LAS v4u*)(lds + O_Q + sl * 144 + cg * 16) = w;
                w.x = pk2(qv[0] * ainter, qv[1] * ainter); w.y = pk2(qv[2] * ainter, qv[3] * ainter); w.z = pk2(qv[4] * ainter, qv[5] * ainter); w.w = pk2(qv[6] * ainter, qv[7] * ainter); *(LAS v4u*)(lds + O_QA + sl * 144 + cg * 16) = w;
                w.x = pk2(kv[0], kv[1]); w.y = pk2(kv[2], kv[3]); w.z = pk2(kv[4], kv[5]); w.w = pk2(kv[6], kv[7]); *(LAS v4u*)(lds + O_K + sl * 144 + cg * 16) = w;
            }
#pragma unroll
            for (int i = 0; i < 8; ++i) *(LAS bf16*)(lds + O_KWT + (8 * cg + i) * 144 + (sl ^ (8 * cg)) * 2) = (bf16)f2bf(kv[i] * wsv);
#pragma unroll
            for (int gi = 0; gi < 2; ++gi) { const int g8 = cg + 8 * gi; const v4u wv = *(const GAS v4u*)(P + (tc0 + sl) * NPROJ + C_MV + h * 128 + 8 * g8);
                const unsigned ww[4] = {wv.x, wv.y, wv.z, wv.w};
#pragma unroll
                for (int i = 0; i < 4; ++i) { *(LAS bf16*)(lds + O_VT + (8 * g8 + 2 * i) * 144 + (sl ^ (8 * cg)) * 2) = (bf16)(ww[i] & 0xffffu); *(LAS bf16*)(lds + O_VT + (8 * g8 + 2 * i + 1) * 144 + (sl ^ (8 * cg)) * 2) = (bf16)(ww[i] >> 16); } }
        }
        __syncthreads();
#ifdef TABLES_IN_PASS2
        f32x4 ta, tb, tcv, td; const int crow = (wg * 8 + wave) * 16 + c;
        if (OUT) {
            if (crow < NEXP) { const GAS f32x4* sp = (const GAS f32x4*)((const float*)A.in[I_U] + (size_t)crow * D + 16 * lane); ta = sp[0]; tb = sp[1]; tcv = sp[2]; td = sp[3]; }
            else { const float* sp = (const float*)A.in[I_V] + (size_t)(crow - NEXP) * D + (lane >> 4) * 256 + (lane & 15);
#pragma unroll
                for (int i = 0; i < 4; ++i) { ta[i] = sp[16 * i]; tb[i] = sp[16 * (4 + i)]; tcv[i] = sp[16 * (8 + i)]; td[i] = sp[16 * (12 + i)]; } } }
#endif
        v2u mo[4];
        if (OUT) {
#pragma unroll
            for (int lt = 0; lt < 4; ++lt) mo[lt] = *(const GAS v2u*)(P + (tc0 + 16 * lt + fr) * NPROJ + C_MO + h * 128 + 16 * wave + 4 * fq); }
        if (OUT) {
            const int lt = wave >> 1, l = 16 * lt + fr; const float Ml = fmaxf(m, GC[c * 64 + l]);
            const bf16x8 bq0 = ldfrag(lds + O_Q, 16 * lt + fr, 16 * fq), bq1 = ldfrag(lds + O_Q, 16 * lt + fr, 64 + 16 * fq);
#pragma unroll
            for (int u = 0; u < 2; ++u) { const int stl = 2 * (wave & 1) + u; f32x4 acc = {0.f, 0.f, 0.f, 0.f};
                acc = MFMA16(ldfrag(lds + O_K, 16 * stl + fr, 16 * fq), bq0, acc); acc = MFMA16(ldfrag(lds + O_K, 16 * stl + fr, 64 + 16 * fq), bq1, acc);
                const f32x4 av = *(LAS const f32x4*)(GA + c * 64 + 16 * stl + 4 * fq); float wv[4];
#pragma unroll
                for (int r = 0; r < 4; ++r) { const int s = 16 * stl + 4 * fq + r; wv[r] = (s <= l) ? acc[r] * __expf(av[r] - Ml) : 0.f; }
                v2u w; w.x = cvtpk(wv[0], wv[1]); w.y = cvtpk(wv[2], wv[3]); *(LAS v2u*)(lds + O_S + l * 144 + (16 * stl + 4 * fq) * 2) = w; }
        }
        {
            const bf16x8 va0 = ldfrag_sw(lds + O_VT, 16 * wave + fr, 16 * fq), va1 = ldfrag_sw(lds + O_VT, 16 * wave + fr, 64 + 16 * fq);
#pragma unroll
            for (int j = 0; j < 4; ++j) { st[j] = st[j] * decay;
                st[j] = MFMA16(va0, ldfrag_sw(lds + O_KWT, 16 * j + fr, 16 * fq), st[j]); st[j] = MFMA16(va1, ldfrag_sw(lds + O_KWT, 16 * j + fr, 64 + 16 * fq), st[j]); }
            if (wave < 4) { st[4] = st[4] * decay;
                st[4] = MFMA16(ldfrag_sw(lds + O_VT, 128 + fr, 16 * fq), ldfrag_sw(lds + O_KWT, 16 * wave + fr, 16 * fq), st[4]);
                st[4] = MFMA16(ldfrag_sw(lds + O_VT, 128 + fr, 64 + 16 * fq), ldfrag_sw(lds + O_KWT, 16 * wave + fr, 64 + 16 * fq), st[4]); }
        }
        if (OUT) {
            __syncthreads();
            LAS const unsigned char* cx = lds + O_CX + (c & 1) * CXB;
            f32x4 nt[4], nd = {0.f, 0.f, 0.f, 0.f};
            {
                const bf16x8 va0 = ldfrag_sw(lds + O_VT, 16 * wave + fr, 16 * fq), va1 = ldfrag_sw(lds + O_VT, 16 * wave + fr, 64 + 16 * fq);
                const bf16x8 ca0 = ldfrag(cx, 16 * wave + fr, 16 * fq), ca1 = ldfrag(cx, 16 * wave + fr, 64 + 16 * fq);
#pragma unroll
                for (int lt = 0; lt < 4; ++lt) { f32x4 acc = {0.f, 0.f, 0.f, 0.f};
                    acc = MFMA16(va0, ldfrag(lds + O_S, 16 * lt + fr, 16 * fq), acc); acc = MFMA16(va1, ldfrag(lds + O_S, 16 * lt + fr, 64 + 16 * fq), acc);
                    acc = MFMA16(ca0, ldfrag(lds + O_QA, 16 * lt + fr, 16 * fq), acc); acc = MFMA16(ca1, ldfrag(lds + O_QA, 16 * lt + fr, 64 + 16 * fq), acc); nt[lt] = acc; }
                if (wave >= 4) { const int lt = wave - 4;
                    nd = MFMA16(ldfrag_sw(lds + O_VT, 128 + fr, 16 * fq), ldfrag(lds + O_S, 16 * lt + fr, 16 * fq), nd); nd = MFMA16(ldfrag_sw(lds + O_VT, 128 + fr, 64 + 16 * fq), ldfrag(lds + O_S, 16 * lt + fr, 64 + 16 * fq), nd);
                    nd = MFMA16(ldfrag(cx, 128 + fr, 16 * fq), ldfrag(lds + O_QA, 16 * lt + fr, 16 * fq), nd); nd = MFMA16(ldfrag(cx, 128 + fr, 64 + 16 * fq), ldfrag(lds + O_QA, 16 * lt + fr, 64 + 16 * fq), nd);
                    if (fq == 0) DEN[16 * lt + fr] = nd[0]; }
            }
            __syncthreads();
#pragma unroll
            for (int lt = 0; lt < 4; ++lt) { const int l = 16 * lt + fr; const float Ml = fmaxf(m, GC[c * 64 + l]);
                const float inv = __builtin_amdgcn_rcpf(fmaxf(fabsf(DEN[l]), __expf(-(GB[c * 64 + l] + Ml))));
                nt[lt] = nt[lt] * inv; float ss = (nt[lt][0] * nt[lt][0] + nt[lt][1] * nt[lt][1]) + (nt[lt][2] * nt[lt][2] + nt[lt][3] * nt[lt][3]);
                ss += __shfl_xor(ss, 16); ss += __shfl_xor(ss, 32);
                if (fq == 0) SSQ[wave * 64 + l] = ss; }
            LAS unsigned char* cxn = lds + O_CX + ((c + 1) & 1) * CXB;
#pragma unroll
            for (int j = 0; j < 4; ++j)
#pragma unroll
                for (int r = 0; r < 4; ++r) *(LAS bf16*)(cxn + (16 * wave + 4 * fq + r) * 144 + (16 * j + fr) * 2) = (bf16)f2bf(st[j][r]);
            if (wave < 4) {
#pragma unroll
                for (int r = 0; r < 4; ++r) *(LAS bf16*)(cxn + (128 + 4 * fq + r) * 144 + (16 * wave + fr) * 2) = (bf16)f2bf(st[4][r]); }
            __syncthreads();
#pragma unroll
            for (int lt = 0; lt < 4; ++lt) { const int l = 16 * lt + fr; float tot = 0.f;
#pragma unroll
                for (int w2 = 0; w2 < 8; ++w2) tot += SSQ[w2 * 64 + l];
                const float rn = __builtin_amdgcn_rsqf(tot * (1.f / 128.f) + EPS);
                const float o0 = nt[lt][0] * rn * gsc[0] * bflo(mo[lt].x), o1 = nt[lt][1] * rn * gsc[1] * bfhi(mo[lt].x), o2 = nt[lt][2] * rn * gsc[2] * bflo(mo[lt].y), o3 = nt[lt][3] * rn * gsc[3] * bfhi(mo[lt].y);
                v2u w; w.x = pk2(o0, o1); w.y = pk2(o2, o3);
                *(GAS v2u*)(MI + (tc0 + l) * D + 512 + h * 128 + 16 * wave + 4 * fq) = w; }
#ifdef TABLES_IN_PASS2
            if (crow < NEXP) p0_row_i4(ta, tb, tcv, td, A.ws + WS_U8, (float*)(A.ws + WS_SC), crow, lane);
            else p0_row_fp4(ta, tb, tcv, td, A.ws + WS_V8, (float*)(A.ws + WS_SC) + 1, crow - NEXP, lane);
#endif
        } else {
            __syncthreads();
        }
        m = bL + M63; Btot += bL;
    }
    if (!OUT) {
#pragma unroll
        for (int i = 0; i < 5; ++i)
#pragma unroll
            for (int r = 0; r < 4; ++r) MST[((size_t)wg * 20 + i * 4 + r) * NTHR + tid] = st[i][r];
        if (tid == 0) { MSC[wg * 2] = m; MSC[wg * 2 + 1] = Btot; }
    }
}

namespace at {
constexpr int O_K = 0, O_VT = 36864, VTS = 592  , O_END = O_VT + 64 * VTS;
static_assert(O_END <= 131072, "attention LDS");
}
__device__ __forceinline__ void phase_attn(const Args& A, LAS unsigned char* lds) {
    using namespace at;
    const int tid = threadIdx.x, lane = tid & 63, wave = __builtin_amdgcn_readfirstlane(tid >> 6), fr = lane & 15, fq = lane >> 4, G = gridDim.x;
    const bf16* P = (const bf16*)(A.ws + WS_PROJ); bf16* MI = (bf16*)(A.ws + WS_MIXIN); const float* sinks = (const float*)A.in[I_SINK];
    __syncthreads();
    for (int e = tid; e < 64 * 16; e += NTHR) { const int r = e >> 4, cpair = e & 15; *(LAS unsigned*)(lds + O_VT + r * VTS + 512 + cpair * 4) = 0u; }
    v4u pk_[4], pv_[4];
#define ATT_LOAD(uu) do { const int g_ = (uu) & 1, n_ = ((uu) >> 1) & 63, b_ = (uu) >> 7; const size_t tq_ = (size_t)b_ * SEQ + (size_t)n_ * 128; _Pragma("unroll") for (int i_ = 0; i_ < 4; ++i_) { const int item_ = tid + NTHR * i_, row_ = item_ >> 3, ch_ = item_ & 7; \
        pk_[i_] = (v4u){0u, 0u, 0u, 0u}; pv_[i_] = (v4u){0u, 0u, 0u, 0u}; if (n_ > 0 || row_ >= 128) { const bf16* rp_ = P + (tq_ - 128 + row_) * NPROJ; pk_[i_] = *(const GAS v4u*)(rp_ + C_AK + g_ * 64 + 8 * ch_); pv_[i_] = *(const GAS v4u*)(rp_ + C_AV + g_ * 64 + 8 * ch_); } } } while (0)
    bf16x8 bqa, bqb;
#define ATT_LOADQ(uu, qt_) do { const int g_ = (uu) & 1, n_ = ((uu) >> 1) & 63, b_ = (uu) >> 7; const size_t tq_ = (size_t)b_ * SEQ + (size_t)n_ * 128; \
        const bf16* qp_ = P + (tq_ + 64 * (wave & 1) + 16 * (qt_) + fr) * NPROJ + C_AQ + (4 * g_ + (wave >> 1)) * 64 + 8 * fq; bqa = *(const GAS bf16x8*)qp_; bqb = *(const GAS bf16x8*)(qp_ + 32); } while (0)
    if ((int)blockIdx.x < NB * 64 * 2) { ATT_LOAD((int)blockIdx.x); ATT_LOADQ((int)blockIdx.x, 0); }
    for (int unit = blockIdx.x; unit < NB * 64 * 2; unit += G) {
        const int g = unit & 1, n = (unit >> 1) & 63, b = unit >> 7;
        const size_t tq0 = (size_t)b * SEQ + (size_t)n * 128;
        __syncthreads();
#pragma unroll
        for (int i = 0; i < 4; ++i) { const int item = tid + NTHR * i, row = item >> 3, ch = item & 7;
            const v4u wk = pk_[i], wv = pv_[i];
            *(LAS v4u*)(lds + O_K + row * 144 + ch * 16) = wk;
            const unsigned ww[4] = {wv.x, wv.y, wv.z, wv.w};
#pragma unroll
            for (int k = 0; k < 4; ++k) { *(LAS bf16*)(lds + O_VT + (8 * ch + 2 * k) * VTS + (row ^ (4 * ch)) * 2) = (bf16)(ww[k] & 0xffffu); *(LAS bf16*)(lds + O_VT + (8 * ch + 2 * k + 1) * VTS + (row ^ (4 * ch)) * 2) = (bf16)(ww[k] >> 16); } }
        if (unit + G < NB * 64 * 2) ATT_LOAD(unit + G);
        const int hq = 4 * g + (wave >> 1), qr0 = 64 * (wave & 1); const float sink = sinks[hq];
        __syncthreads();
        for (int qt = 0; qt < 4; ++qt) {
            const int i0 = qr0 + 16 * qt, st0 = i0 >> 4, iq = i0 + fr;
            const bf16x8 bq0 = bqa, bq1 = bqb;
            { const int un = (qt < 3) ? unit : min(unit + (int)G, NB * 64 * 2 - 1), qn = (qt < 3) ? qt + 1 : 0; ATT_LOADQ(un, qn); }
            f32x4 sc[9]; float mx = sink;
#pragma unroll
            for (int t = 0; t < 9; ++t) { const int sb0 = 16 * (st0 + t); f32x4 acc = {0.f, 0.f, 0.f, 0.f};
                acc = MFMA16(ldfrag(lds + O_K, sb0 + fr, 16 * fq), bq0, acc); acc = MFMA16(ldfrag(lds + O_K, sb0 + fr, 64 + 16 * fq), bq1, acc);
                if (t == 0) {
#pragma unroll
                    for (int r = 0; r < 4; ++r) acc[r] = (4 * fq + r > fr) ? acc[r] : -3.0e38f; }
                if (t == 8) {
#pragma unroll
                    for (int r = 0; r < 4; ++r) acc[r] = (4 * fq + r <= fr) ? acc[r] : -3.0e38f; }
                if (n == 0) {
#pragma unroll
                    for (int r = 0; r < 4; ++r) acc[r] = (sb0 + 4 * fq + r >= 128) ? acc[r] : -3.0e38f; }
#pragma unroll
                for (int r = 0; r < 4; ++r) mx = fmaxf(mx, acc[r]);
                sc[t] = acc; }
            mx = fmaxf(mx, __shfl_xor(mx, 16)); mx = fmaxf(mx, __shfl_xor(mx, 32));
            float lsum = 0.f;
#pragma unroll
            for (int t = 0; t < 9; ++t)
#pragma unroll
                for (int r = 0; r < 4; ++r) { const float p = __expf(sc[t][r] - mx); sc[t][r] = p; lsum += p; }
            lsum += __shfl_xor(lsum, 16); lsum += __shfl_xor(lsum, 32); lsum += __expf(sink - mx);
            f32x4 oacc[4];
#pragma unroll
            for (int dt = 0; dt < 4; ++dt) oacc[dt] = (f32x4){0.f, 0.f, 0.f, 0.f};
#pragma unroll
            for (int ks = 0; ks < 5; ++ks) {
                union { bf16x8 v; unsigned u[4]; } pb;
                pb.u[0] = cvtpk(sc[2 * ks][0], sc[2 * ks][1]); pb.u[1] = cvtpk(sc[2 * ks][2], sc[2 * ks][3]);
                if (ks < 4) { pb.u[2] = cvtpk(sc[2 * ks + 1][0], sc[2 * ks + 1][1]); pb.u[3] = cvtpk(sc[2 * ks + 1][2], sc[2 * ks + 1][3]); } else { pb.u[2] = 0u; pb.u[3] = 0u; }
                const int sbb = 16 * (st0 + 2 * ks) + 4 * fq;
#pragma unroll
                for (int dt = 0; dt < 4; ++dt) { const int dd = 16 * dt + fr, sx = 4 * ((dd >> 3) & 7); LAS const unsigned char* vrow = lds + O_VT + dd * VTS;
                    union { bf16x8 v; v2u h[2]; } va; va.h[0] = *(LAS const v2u*)(vrow + (sbb ^ sx) * 2); va.h[1] = *(LAS const v2u*)(vrow + ((sbb + 16) ^ sx) * 2);
                    oacc[dt] = MFMA16(va.v, pb.v, oacc[dt]); } }
            const float il = __builtin_amdgcn_rcpf(lsum);
#pragma unroll
            for (int dt = 0; dt < 4; ++dt) { v2u w; w.x = cvtpk(oacc[dt][0] * il, oacc[dt][1] * il); w.y = cvtpk(oacc[dt][2] * il, oacc[dt][3] * il);
                *(GAS v2u*)(MI + (tq0 + iq) * D + hq * 64 + 16 * dt + 4 * fq) = w; }
        }
    }
#undef ATT_LOAD
#undef ATT_LOADQ
}
typedef float f32x16 __attribute__((ext_vector_type(16)));
__device__ __forceinline__ unsigned fbits(float f) { return __builtin_bit_cast(unsigned, f); }
__device__ __forceinline__ float bfloat(unsigned u) { return __builtin_bit_cast(float, u); }

#define CE_DESC(a, b) do { const float _mx = __builtin_fmaxf(a, b), _mn = __builtin_fminf(a, b); a = _mx; b = _mn; } while (0)
namespace sn16 { constexpr int NC = 63; constexpr unsigned char CA[NC] = {0, 2, 0, 1, 1, 4, 6, 4, 5, 5, 0, 2, 2, 1, 3, 3, 1, 3, 5, 8, 10, 8, 9, 9, 12, 14, 12, 13, 13, 8, 10, 10, 9, 11, 11, 9, 11, 13, 0, 4, 4, 2, 6, 6, 2, 6, 10, 1, 5, 5, 3, 7, 7, 3, 7, 11, 1, 3, 5, 7, 9, 11, 13}; constexpr unsigned char CB[NC] = {1, 3, 2, 3, 2, 5, 7, 6, 7, 6, 4, 6, 4, 5, 7, 5, 2, 4, 6, 9, 11, 10, 11, 10, 13, 15, 14, 15, 14, 12, 14, 12, 13, 15, 13, 10, 12, 14, 8, 12, 8, 10, 14, 10, 4, 8, 12, 9, 13, 9, 11, 15, 11, 5, 9, 13, 2, 4, 6, 8, 10, 12, 14}; }
__device__ __forceinline__ void bsort16(float (&v)[16]) {
#pragma unroll
    for (int c = 0; c < sn16::NC; ++c) CE_DESC(v[sn16::CA[c]], v[sn16::CB[c]]);
}
__device__ __forceinline__ void bmerge16(float (&v)[16], const float (&w)[16]) {
#pragma unroll
    for (int i = 0; i < 16; ++i) v[i] = __builtin_fmaxf(v[i], w[15 - i]);
#pragma unroll
    for (int j = 8; j > 0; j >>= 1)
#pragma unroll
        for (int i = 0; i < 16; ++i) { const int l = i ^ j; if (l > i) CE_DESC(v[i], v[l]); }
}
namespace tk {
constexpr int KS = 272;
constexpr int O_K1 = 0, O_K2 = 128 * KS, O_X = 2 * 128 * KS, O_END = O_X + 8 * 4096;
static_assert(O_END <= 131072, "topk LDS");
constexpr unsigned char CAND[64] = {
    0x00, 0x01, 0x02, 0x03, 0x04, 0x05, 0x06, 0x07, 0x08, 0x09, 0x0a, 0x0b, 0x0c, 0x0d, 0x0e, 0x0f,
    0x10, 0x11, 0x12, 0x13, 0x14, 0x15, 0x16, 0x17, 0x80, 0x90, 0xa0, 0xb0, 0xc0, 0xd0, 0xe0, 0xf0,
    0x20, 0x21, 0x22, 0x23, 0x24, 0x30, 0x31, 0x32, 0x33, 0x40, 0x41, 0x42, 0x50, 0x51, 0x60, 0x61,
    0x70, 0x71, 0xff, 0xff, 0xff, 0xff, 0xff, 0xff, 0xff, 0xff, 0xff, 0xff, 0xff, 0xff, 0xff, 0xff};
}
__device__ __forceinline__ void side_top16(const f32x16 (&acc)[4], int hh, float (&T)[16]) {
    float g1[16], g2[16];
#pragma unroll
    for (int r = 0; r < 16; ++r) { const unsigned key = (r & 3) + 8 * (r >> 2) + 4 * hh;
        T[r] = bfloat((fbits(acc[0][r]) & 0xffffff80u) | key);
        g1[r] = bfloat((fbits(acc[1][r]) & 0xffffff80u) | (32u + key)); }
    bsort16(T); bsort16(g1); bmerge16(T, g1);
#pragma unroll
    for (int r = 0; r < 16; ++r) { const unsigned key = (r & 3) + 8 * (r >> 2) + 4 * hh;
        g1[r] = bfloat((fbits(acc[2][r]) & 0xffffff80u) | (64u + key));
        g2[r] = bfloat((fbits(acc[3][r]) & 0xffffff80u) | (96u + key)); }
    bsort16(g1); bsort16(g2); bmerge16(g1, g2); bmerge16(T, g1);
#pragma unroll
    for (int r = 0; r < 16; ++r) g1[r] = __shfl_xor(T[r], 32);
    bmerge16(T, g1);
}
struct TopkQ { bf16x8 f[8]; };
template <int SD> __device__ __forceinline__ void topk_ldq(const bf16* Q, int t, int h, int hh, TopkQ& q) {
    const bf16* qp = Q + (size_t)t * 2048 + h * 256 + SD * 128 + 8 * hh;
#pragma unroll
    for (int ks = 0; ks < 8; ++ks) q.f[ks] = *(const GAS bf16x8*)(qp + 16 * ks);
}
template <int SD> __device__ __forceinline__ void topk_scores(const TopkQ& q, LAS unsigned char* lds, int r32, int hh, f32x16 (&acc)[4]) {
    using namespace tk;
#pragma unroll
    for (int mt = 0; mt < 4; ++mt)
#pragma unroll
        for (int r = 0; r < 16; ++r) acc[mt][r] = 0.f;
    LAS const unsigned char* kimg = lds + (SD ? O_K2 : O_K1);
#pragma unroll
    for (int ks = 0; ks < 8; ++ks) {
#pragma unroll
        for (int mt = 0; mt < 4; ++mt) acc[mt] = __builtin_amdgcn_mfma_f32_32x32x16_bf16(*(LAS const bf16x8*)(kimg + (32 * mt + r32) * KS + 32 * ks + 16 * hh), q.f[ks], acc[mt], 0, 0, 0); }
}
template <int Q> __device__ __forceinline__ float cand_val(const float (&T1)[16], const float (&T2)[16], int hh) {
    constexpr unsigned c0 = tk::CAND[2 * Q], c1 = tk::CAND[2 * Q + 1];
    const float s = (hh ? T1[(c1 >> 4) & 15] : T1[(c0 >> 4) & 15]) + (hh ? T2[c1 & 15] : T2[c0 & 15]); const unsigned code = hh ? c1 : c0;
    return (code == 0xffu) ? -3.0e38f : bfloat((fbits(s) & 0xffffff00u) | code);
}
__device__ __forceinline__ void phase_topk(const Args& A, LAS unsigned char* lds) {
    using namespace tk;
    const int tid = threadIdx.x, lane = tid & 63, wave = __builtin_amdgcn_readfirstlane(tid >> 6), G = gridDim.x;
    const bf16* Q = (const bf16*)(A.ws + WS_PROJ); const bf16* KB = (const bf16*)(A.ws + WS_KEYS);
    unsigned short* EI = (unsigned short*)(A.ws + WS_EIDX); bf16* GT = (bf16*)(A.ws + WS_GATE);
    const int h = blockIdx.x & 7, r32 = lane & 31, hh = lane >> 5;
    __syncthreads();
    for (int e = tid; e < 2 * 128 * 16; e += NTHR) { const int s = e >> 11, row = (e >> 4) & 127, ch = e & 15;
        *(LAS v4u*)(lds + (s ? O_K2 : O_K1) + row * KS + ch * 16) = *(const GAS v4u*)(KB + (size_t)s * 8 * 128 * 128 + ((size_t)h * 128 + row) * 128 + ch * 8); }
    __syncthreads();
    LAS float* XW = (LAS float*)(lds + O_X + wave * 4096) + r32 * 32;
    TopkQ qf; topk_ldq<0>(Q, (int)(blockIdx.x >> 3) * 256 + 32 * wave + r32, h, hh, qf);
    for (int tile = (int)(blockIdx.x >> 3); tile < M / 256; tile += (G >> 3)) {
        const int t = tile * 256 + 32 * wave + r32;
        float T1[16], T2[16];
        { f32x16 acc[4]; topk_scores<0>(qf, lds, r32, hh, acc);
          topk_ldq<1>(Q, t, h, hh, qf);
          side_top16(acc, hh, T1); }
        { f32x16 acc[4]; topk_scores<1>(qf, lds, r32, hh, acc);
          const int tn = min(tile + (int)(G >> 3), M / 256 - 1) * 256 + 32 * wave + r32; topk_ldq<0>(Q, tn, h, hh, qf);
          side_top16(acc, hh, T2); }
        float c[16], w[16];
        c[0] = cand_val<0>(T1, T2, hh); w[0] = cand_val<16>(T1, T2, hh);
        c[1] = cand_val<1>(T1, T2, hh); w[1] = cand_val<17>(T1, T2, hh);
        c[2] = cand_val<2>(T1, T2, hh); w[2] = cand_val<18>(T1, T2, hh);
        c[3] = cand_val<3>(T1, T2, hh); w[3] = cand_val<19>(T1, T2, hh);
        c[4] = cand_val<4>(T1, T2, hh); w[4] = cand_val<20>(T1, T2, hh);
        c[5] = cand_val<5>(T1, T2, hh); w[5] = cand_val<21>(T1, T2, hh);
        c[6] = cand_val<6>(T1, T2, hh); w[6] = cand_val<22>(T1, T2, hh);
        c[7] = cand_val<7>(T1, T2, hh); w[7] = cand_val<23>(T1, T2, hh);
        c[8] = cand_val<8>(T1, T2, hh); w[8] = cand_val<24>(T1, T2, hh);
        c[9] = cand_val<9>(T1, T2, hh); w[9] = cand_val<25>(T1, T2, hh);
        c[10] = cand_val<10>(T1, T2, hh); w[10] = cand_val<26>(T1, T2, hh);
        c[11] = cand_val<11>(T1, T2, hh); w[11] = cand_val<27>(T1, T2, hh);
        c[12] = cand_val<12>(T1, T2, hh); w[12] = cand_val<28>(T1, T2, hh);
        c[13] = cand_val<13>(T1, T2, hh); w[13] = cand_val<29>(T1, T2, hh);
        c[14] = cand_val<14>(T1, T2, hh); w[14] = cand_val<30>(T1, T2, hh);
        c[15] = cand_val<15>(T1, T2, hh); w[15] = cand_val<31>(T1, T2, hh);
        bsort16(c); bsort16(w); bmerge16(c, w);
#pragma unroll
        for (int r = 0; r < 16; ++r) w[r] = __shfl_xor(c[r], 32);
        bmerge16(c, w);
        if (hh == 0) {
#pragma unroll
            for (int q4 = 0; q4 < 4; ++q4) { *(LAS f32x4*)(XW + 4 * q4) = (f32x4){T1[4 * q4], T1[4 * q4 + 1], T1[4 * q4 + 2], T1[4 * q4 + 3]};
                *(LAS f32x4*)(XW + 16 + 4 * q4) = (f32x4){T2[4 * q4], T2[4 * q4 + 1], T2[4 * q4 + 2], T2[4 * q4 + 3]}; } }
        asm volatile("s_waitcnt lgkmcnt(0)" ::: "memory");
        float ex[16], sum = 0.f; const float tmax = bfloat(fbits(c[0]) & 0xffffff00u);
#pragma unroll
        for (int r = 0; r < 16; ++r) { ex[r] = __expf(bfloat(fbits(c[r]) & 0xffffff00u) - tmax); sum += ex[r]; }
        const float isum = __builtin_amdgcn_rcpf(sum); const size_t ob = (size_t)t * NSLOT + (size_t)h * 16 + 8 * hh;
        unsigned eo[8], go[8];
#pragma unroll
        for (int r = 0; r < 8; ++r) { float ca = c[r], cb = c[8 + r], ea = ex[r], eb = ex[8 + r]; asm volatile("" : "+v"(ca), "+v"(cb), "+v"(ea), "+v"(eb)); const float cv = hh ? cb : ca, ev = hh ? eb : ea;
            const unsigned code = fbits(cv) & 0xffu;
            const unsigned i1 = fbits(XW[code >> 4]) & 127u, i2 = fbits(XW[16 + (code & 15)]) & 127u;
            eo[r] = i1 * 128u + i2; go[r] = f2bf(ev * isum); }
        *(GAS v4u*)(EI + ob) = (v4u){eo[0] | (eo[1] << 16), eo[2] | (eo[3] << 16), eo[4] | (eo[5] << 16), eo[6] | (eo[7] << 16)};
        *(GAS v4u*)(GT + ob) = (v4u){go[0] | (go[1] << 16), go[2] | (go[3] << 16), go[4] | (go[5] << 16), go[6] | (go[7] << 16)};
        asm volatile("s_waitcnt lgkmcnt(0)" ::: "memory");
    }
}
struct PeerIdx { v4u e0, e1; };
__device__ __forceinline__ PeerIdx peer_ld_idx(const unsigned short* EI, int t, int g) { PeerIdx r; r.e0 = *(const GAS v4u*)(EI + (size_t)t * NSLOT + 16 * g); r.e1 = *(const GAS v4u*)(EI + (size_t)t * NSLOT + 16 * g + 8); return r; }
template <int ROWB = 1024> __device__ __forceinline__ void peer_gather(const unsigned char* T8, const PeerIdx& ix, int colb, v4u (&raw)[16]) {
    const unsigned ew[8] = {ix.e0.x, ix.e0.y, ix.e0.z, ix.e0.w, ix.e1.x, ix.e1.y, ix.e1.z, ix.e1.w};
#pragma unroll
    for (int k = 0; k < 16; ++k) { const unsigned e = (k & 1) ? (ew[k >> 1] >> 16) : (ew[k >> 1] & 0xffffu); raw[k] = *(const GAS v4u*)(T8 + (size_t)e * ROWB + colb); }
}
__device__ __forceinline__ void cvt16_fp8_pk(const v4u w, f32x2 (&o)[8]) {
    const unsigned ww[4] = {w.x, w.y, w.z, w.w};
#pragma unroll
    for (int i = 0; i < 4; ++i) { o[2 * i] = __builtin_amdgcn_cvt_pk_f32_fp8((int)ww[i], false); o[2 * i + 1] = __builtin_amdgcn_cvt_pk_f32_fp8((int)ww[i], true); }
}
__device__ __forceinline__ void peer_u_reduce(const v4u (&raw)[16], const f32x2 (&hv)[8], float* PDrow, int lane, int g, int c) {
    float d[16];
#pragma unroll
    for (int k = 0; k < 16; ++k) { f32x2 uf[8]; cvt16_fp8_pk(raw[k], uf); f32x2 s = uf[0] * hv[0];
#pragma unroll
        for (int i = 1; i < 8; ++i) s += uf[i] * hv[i];
        d[k] = s.x + s.y; }
#pragma unroll
    for (int i = 0; i < 8; ++i) { const bool up = (lane & 4) != 0; const float keep = up ? d[i + 8] : d[i], send = up ? d[i] : d[i + 8]; d[i] = keep + __shfl_xor(send, 4); }
#pragma unroll
    for (int i = 0; i < 4; ++i) { const bool up = (lane & 2) != 0; const float keep = up ? d[i + 4] : d[i], send = up ? d[i] : d[i + 4]; d[i] = keep + __shfl_xor(send, 2); }
#pragma unroll
    for (int i = 0; i < 2; ++i) { const bool up = (lane & 1) != 0; const float keep = up ? d[i + 2] : d[i], send = up ? d[i] : d[i + 2]; d[i] = keep + __shfl_xor(send, 1); }
    *(GAS f32x2*)(PDrow + 16 * g + 2 * c) = (f32x2){d[0], d[1]};
}
__device__ __forceinline__ void ld16bf_pk(const bf16* p, f32x2 (&o)[8]) {
    const v4u w0 = *(const GAS v4u*)p, w1 = *(const GAS v4u*)(p + 8); const unsigned ww[8] = {w0.x, w0.y, w0.z, w0.w, w1.x, w1.y, w1.z, w1.w};
#pragma unroll
    for (int i = 0; i < 8; ++i) o[i] = (f32x2){bflo(ww[i]), bfhi(ww[i])};
}
__device__ __forceinline__ void peer_u_reduce_i4(const v4u (&raw)[16], const v4u hh, const v4u hl, bf16* PDrow, int lane, int g, int c) {
    int d[16];
#pragma unroll
    for (int k = 0; k < 16; ++k) { int sh = __builtin_amdgcn_sdot8((int)raw[k].x, (int)hh.x, 0, false), sl = __builtin_amdgcn_sdot8((int)raw[k].x, (int)hl.x, 0, false);
        sh = __builtin_amdgcn_sdot8((int)raw[k].y, (int)hh.y, sh, false); sl = __builtin_amdgcn_sdot8((int)raw[k].y, (int)hl.y, sl, false);
        sh = __builtin_amdgcn_sdot8((int)raw[k].z, (int)hh.z, sh, false); sl = __builtin_amdgcn_sdot8((int)raw[k].z, (int)hl.z, sl, false);
        sh = __builtin_amdgcn_sdot8((int)raw[k].w, (int)hh.w, sh, false); sl = __builtin_amdgcn_sdot8((int)raw[k].w, (int)hl.w, sl, false);
        d[k] = 16 * sh + sl; }
#pragma unroll
    for (int i = 0; i < 8; ++i) { const bool up = (lane & 4) != 0; const int keep = up ? d[i + 8] : d[i], send = up ? d[i] : d[i + 8]; d[i] = keep + __shfl_xor(send, 4); }
#pragma unroll
    for (int i = 0; i < 4; ++i) { const bool up = (lane & 2) != 0; const int keep = up ? d[i + 4] : d[i], send = up ? d[i] : d[i + 4]; d[i] = keep + __shfl_xor(send, 2); }
#pragma unroll
    for (int i = 0; i < 2; ++i) { const bool up = (lane & 1) != 0; const int keep = up ? d[i + 2] : d[i], send = up ? d[i] : d[i + 2]; d[i] = keep + __shfl_xor(send, 1); }
    __builtin_nontemporal_store(pk2((float)d[0], (float)d[1]), (GAS unsigned*)(PDrow + 16 * g + 2 * c));
}
__device__ __forceinline__ void phase_peer_u(const Args& A) {
    const int tid = threadIdx.x, lane = tid & 63, wave = tid >> 6, p = blockIdx.x & 7, q = p & 3, half = p >> 2, j = blockIdx.x >> 3, nj = gridDim.x >> 3, g = lane >> 3, c = lane & 7;
    const unsigned char* HH = (const unsigned char*)(A.ws + WS_H8); const unsigned char* HL = HH + 32 * MiB; const unsigned char* U4 = (const unsigned char*)(A.ws + WS_U8); const unsigned short* EI = (const unsigned short*)(A.ws + WS_EIDX);
    bf16* PD = (bf16*)(A.ws + WS_PD) + (size_t)q * M * NSLOT;
    const unsigned char* U4q = U4 + (size_t)q * ((size_t)NEXP * 128); const int colu = 16 * c;
    const int tper = (M / 2) / nj, colb = 128 * q + 16 * c, tbeg = half * (M / 2) + j * tper, tend = tbeg + tper, tlast = tend - NWAVES + wave;
    int t = tbeg + wave;
    PeerIdx ix1 = peer_ld_idx(EI, min(t + NWAVES, tlast), g), ix2 = peer_ld_idx(EI, min(t + 2 * NWAVES, tlast), g);
    v4u rawa[16], rawb[16], hha, hla, hhb, hlb;
    { const PeerIdx ix0 = peer_ld_idx(EI, t, g); peer_gather<128>(U4q, ix0, colu, rawa); hha = *(const GAS v4u*)(HH + (size_t)t * 512 + colb); hla = *(const GAS v4u*)(HL + (size_t)t * 512 + colb); }
    for (; t < tend; t += 2 * NWAVES) {
        const int t1 = t + NWAVES, t2 = min(t + 2 * NWAVES, tlast), t3 = min(t + 3 * NWAVES, tlast), t4 = min(t + 4 * NWAVES, tlast);
        const PeerIdx ix3 = peer_ld_idx(EI, t3, g);
        peer_gather<128>(U4q, ix1, colu, rawb); hhb = *(const GAS v4u*)(HH + (size_t)t1 * 512 + colb); hlb = *(const GAS v4u*)(HL + (size_t)t1 * 512 + colb);
        peer_u_reduce_i4(rawa, hha, hla, PD + (size_t)t * NSLOT, lane, g, c);
        const PeerIdx ix4 = peer_ld_idx(EI, t4, g);
        peer_gather<128>(U4q, ix2, colu, rawa); hha = *(const GAS v4u*)(HH + (size_t)t2 * 512 + colb); hla = *(const GAS v4u*)(HL + (size_t)t2 * 512 + colb);
        peer_u_reduce_i4(rawb, hhb, hlb, PD + (size_t)t1 * NSLOT, lane, g, c);
        ix1 = ix3; ix2 = ix4;
    }
}
__device__ __forceinline__ void phase_peer_act(const Args& A) {
    const bf16* PD = (const bf16*)(A.ws + WS_PD); const unsigned short* EI = (const unsigned short*)(A.ws + WS_EIDX); const bf16* GT = (const bf16*)(A.ws + WS_GATE);
    const float* usc = (const float*)(A.ws + WS_SC); const float* hs = (const float*)(A.ws + WS_HS);
    unsigned char* W8 = (unsigned char*)(A.ws + WS_W8); float* WSC = (float*)(A.ws + WS_WSC);
    typedef int i32x4 __attribute__((ext_vector_type(4)));
    for (size_t i = ((size_t)blockIdx.x * NTHR + threadIdx.x) * 4; i < (size_t)M * NSLOT; i += (size_t)gridDim.x * NTHR * 4) {
        const v2u p0 = *(const GAS v2u*)(PD + i), p1 = *(const GAS v2u*)(PD + (size_t)M * NSLOT + i), p2 = *(const GAS v2u*)(PD + (size_t)2 * M * NSLOT + i), p3 = *(const GAS v2u*)(PD + (size_t)3 * M * NSLOT + i);
        const v2u ew = *(const GAS v2u*)(EI + i); const v2u gw = *(const GAS v2u*)(GT + i); const f32x4 gt = {bflo(gw.x), bfhi(gw.x), bflo(gw.y), bfhi(gw.y)}; const float hsv = hs[i >> 7];
        const unsigned e[4] = {ew.x & 0xffffu, ew.x >> 16, ew.y & 0xffffu, ew.y >> 16};
        const f32x4 si = {(bflo(p0.x) + bflo(p1.x)) + (bflo(p2.x) + bflo(p3.x)), (bfhi(p0.x) + bfhi(p1.x)) + (bfhi(p2.x) + bfhi(p3.x)), (bflo(p0.y) + bflo(p1.y)) + (bflo(p2.y) + bflo(p3.y)), (bfhi(p0.y) + bfhi(p1.y)) + (bfhi(p2.y) + bfhi(p3.y))}; f32x4 o;
#pragma unroll
        for (int k = 0; k < 4; ++k) { const f32x2 sc = *(const GAS f32x2*)(usc + 2 * e[k]); const float s = si[k] * (sc.x * hsv); o[k] = 0.5f * s * (1.f + erff(s * 0.70710678118654752f)) * gt[k] * sc.y; }
        float am = fmaxf(fmaxf(fabsf(o[0]), fabsf(o[1])), fmaxf(fabsf(o[2]), fabsf(o[3])));
#pragma unroll
        for (int x = 1; x < 32; x <<= 1) am = fmaxf(am, __shfl_xor(am, x));
        const bool amok = am > 1e-30f; const float inv = amok ? 448.0f * __builtin_amdgcn_rcpf(am) : 1.0f;
        float sv[4];
#pragma unroll
        for (int k = 0; k < 4; ++k) sv[k] = fminf(fmaxf(o[k] * inv, -448.f), 448.f);
        int hi = __builtin_amdgcn_cvt_pk_fp8_f32(sv[0], sv[1], 0, false); hi = __builtin_amdgcn_cvt_pk_fp8_f32(sv[2], sv[3], hi, true);
        const f32x2 d01 = __builtin_amdgcn_cvt_pk_f32_fp8(hi, false), d23 = __builtin_amdgcn_cvt_pk_f32_fp8(hi, true);
        int lo = __builtin_amdgcn_cvt_pk_fp8_f32((sv[0] - d01.x) * 16.f, (sv[1] - d01.y) * 16.f, 0, false); lo = __builtin_amdgcn_cvt_pk_fp8_f32((sv[2] - d23.x) * 16.f, (sv[3] - d23.y) * 16.f, lo, true);
        const size_t t = i >> 7; const int pos = (int)(i & 127);
        *(GAS unsigned*)(W8 + t * 256 + pos) = (unsigned)hi; *(GAS unsigned*)(W8 + t * 256 + 128 + pos) = (unsigned)lo;
        if (pos == 0) WSC[t] = amok ? am * (1.0f / 448.0f) : 1.0f;
    }
}
typedef int i32x2 __attribute__((ext_vector_type(2)));
typedef int i32x8 __attribute__((ext_vector_type(8)));
struct PeerVA { v4u a0, a1; };
__device__ __forceinline__ void phase_peer_v(const Args& A, LAS unsigned char* lds) {
    const int tid = threadIdx.x, lane = tid & 63, wave = __builtin_amdgcn_readfirstlane(tid >> 6), p = blockIdx.x & 7, q = p & 3, half = p >> 2, j = blockIdx.x >> 3, nj = gridDim.x >> 3;
    const unsigned char* V4 = (const unsigned char*)(A.ws + WS_V8); const unsigned short* EI = (const unsigned short*)(A.ws + WS_EIDX);
    const unsigned char* W8 = (const unsigned char*)(A.ws + WS_W8); const float* WSC = (const float*)(A.ws + WS_WSC);
    bf16* Y = (bf16*)(A.ws + WS_H); float* SSY = (float*)(A.ws + WS_SSY);
    const int tper = (M / 2) / nj, nt_w = tper / NWAVES, t0 = half * (M / 2) + j * tper + wave * nt_w;
    const int n = lane & 15, g = lane >> 4, r8 = lane >> 3, c8 = lane & 7;
    const int srcoff0 = q * (NEXP * 128) + 16 * (c8 ^ (r8 >> 1)), srcoff1 = q * (NEXP * 128) + 16 * (c8 ^ (4 + (r8 >> 1)));
    LAS unsigned char* img = lds + wave * 16384;
    const int rdb = (32 * g + n) * 128, xo = 16 * (n >> 1) + 8 * (g & 1);
    struct Idx { unsigned lo, hi; };
    auto ldidx = [&](int i) { const unsigned short* ep = EI + (size_t)(t0 + i) * NSLOT + lane; Idx r; r.lo = ep[0]; r.hi = ep[64]; return r; };
    auto ldA = [&](int i) { const unsigned char* ap = W8 + (size_t)(t0 + i) * 256 + ((n >> 1) & 1) * 128 + 16 * g; PeerVA r; r.a0 = *(const GAS v4u*)ap; r.a1 = *(const GAS v4u*)(ap + 64); return r; };
    const bool alive = n < 4 && ((n & 1) == (g >> 1));
    auto fetch = [&](const Idx& ix) { unsigned e[16]; const int pk = (int)(ix.lo | (ix.hi << 16));
#pragma unroll
        for (int i = 0; i < 8; ++i) { const unsigned w = (unsigned)__shfl(pk, 8 * i + r8); e[i] = w & 0xffffu; e[8 + i] = w >> 16; }
        __builtin_amdgcn_sched_barrier(0);
#pragma unroll
        for (int i = 0; i < 16; ++i) __builtin_amdgcn_global_load_lds((const unsigned*)(V4 + (size_t)e[i] * 128 + ((i & 1) ? srcoff1 : srcoff0)), (LAS unsigned*)(img + i * 1024), 16, 0, 0); };
    Idx ixn; PeerVA an; float wscn;
    { const Idx ix0 = ldidx(0); fetch(ix0); ixn = ldidx(min(1, nt_w - 1)); an = ldA(0); wscn = WSC[t0]; }
    v4u yst0 = {0u, 0u, 0u, 0u}, yst1 = {0u, 0u, 0u, 0u}; float ssst = 0.f;
    for (int i = 0; i < nt_w; ++i) {
        asm volatile("s_waitcnt vmcnt(0)" ::: "memory");
        PeerVA ac = an; float wsc = wscn; Idx ixc = ixn;
        asm volatile("" : "+v"(ac.a0.x), "+v"(ac.a0.y), "+v"(ac.a0.z), "+v"(ac.a0.w), "+v"(ac.a1.x), "+v"(ac.a1.y), "+v"(ac.a1.z), "+v"(ac.a1.w), "+v"(wsc), "+v"(ixc.lo), "+v"(ixc.hi));
        i32x2 br[16][2];
#pragma unroll
        for (int nt = 0; nt < 16; ++nt) { const int ro = rdb + ((16 * (nt >> 1) + 8 * (nt & 1)) ^ xo);
            br[nt][0] = __builtin_amdgcn_ds_read_tr4_b64_v2i32((LAS i32x2*)(img + ro)); br[nt][1] = __builtin_amdgcn_ds_read_tr4_b64_v2i32((LAS i32x2*)(img + ro + 2048)); }
        asm volatile("s_waitcnt lgkmcnt(0)" ::: "memory");
        __builtin_amdgcn_sched_barrier(0);
        if (i + 1 < nt_w) fetch(ixc);
        ixn = ldidx(min(i + 2, nt_w - 1)); an = ldA(min(i + 1, nt_w - 1)); wscn = WSC[t0 + min(i + 1, nt_w - 1)];
        if (i > 0 && lane < 16) { const int t = t0 + i - 1; GAS v4u* yp = (GAS v4u*)(Y + (size_t)t * D + 256 * q + 16 * n); __builtin_nontemporal_store(yst0, yp); __builtin_nontemporal_store(yst1, yp + 1); if (lane == 0) *(GAS f32x2*)(SSY + (size_t)t * 8 + 2 * q) = (f32x2){ssst, 0.f}; }
        __builtin_amdgcn_sched_barrier(0);
        if (!alive) { ac.a0 = (v4u){0u, 0u, 0u, 0u}; ac.a1 = (v4u){0u, 0u, 0u, 0u}; }
        const i32x8 A8 = {(int)ac.a0.x, (int)ac.a0.y, (int)ac.a0.z, (int)ac.a0.w, (int)ac.a1.x, (int)ac.a1.y, (int)ac.a1.z, (int)ac.a1.w};
        float yv[16]; float ss = 0.f;
#pragma unroll
        for (int c2 = 0; c2 < 8; ++c2) { const i32x8 BX = {br[2 * c2][0].x, br[2 * c2][0].y, br[2 * c2][1].x, br[2 * c2][1].y, 0, 0, 0, 0}, BY = {br[2 * c2 + 1][0].x, br[2 * c2 + 1][0].y, br[2 * c2 + 1][1].x, br[2 * c2 + 1][1].y, 0, 0, 0, 0};
            const f32x4 dx = __builtin_amdgcn_mfma_scale_f32_16x16x128_f8f6f4(A8, BX, (f32x4){0.f, 0.f, 0.f, 0.f}, 0, 4, 0, 0x7f7f7f7f, 0, 0x7f7f7f7f);
            const f32x4 dy = __builtin_amdgcn_mfma_scale_f32_16x16x128_f8f6f4(A8, BY, (f32x4){0.f, 0.f, 0.f, 0.f}, 0, 4, 0, 0x7f7f7f7f, 0, 0x7f7f7f7f);
            yv[2 * c2] = ((dx[0] + dy[1]) + (dx[2] + dy[3]) * 0.0625f) * wsc; yv[2 * c2 + 1] = ((dy[0] + dx[1]) + (dy[2] + dx[3]) * 0.0625f) * wsc;
            ss += yv[2 * c2] * yv[2 * c2] + yv[2 * c2 + 1] * yv[2 * c2 + 1]; }
        ss += __shfl_xor(ss, 1); ss += __shfl_xor(ss, 2); ss += __shfl_xor(ss, 4); ss += __shfl_xor(ss, 8);
        yst0 = (v4u){pk2(yv[0], yv[1]), pk2(yv[2], yv[3]), pk2(yv[4], yv[5]), pk2(yv[6], yv[7])}; yst1 = (v4u){pk2(yv[8], yv[9]), pk2(yv[10], yv[11]), pk2(yv[12], yv[13]), pk2(yv[14], yv[15])}; ssst = ss;
    }
    if (lane < 16) { const int t = t0 + nt_w - 1; GAS v4u* yp = (GAS v4u*)(Y + (size_t)t * D + 256 * q + 16 * n); __builtin_nontemporal_store(yst0, yp); __builtin_nontemporal_store(yst1, yp + 1); if (lane == 0) *(GAS f32x2*)(SSY + (size_t)t * 8 + 2 * q) = (f32x2){ssst, 0.f}; }
    __syncthreads();
}
#ifdef V_SLOW
__device__ __forceinline__ void phase_peer_v_slow(const Args& A, LAS unsigned char* lds) {
    const int tid = threadIdx.x, p = blockIdx.x & 7, q = p & 3, half = p >> 2, j = blockIdx.x >> 3, nj = gridDim.x >> 3;
    const unsigned char* V4 = (const unsigned char*)(A.ws + WS_V8); const unsigned short* EI = (const unsigned short*)(A.ws + WS_EIDX);
    const unsigned char* W8 = (const unsigned char*)(A.ws + WS_W8); const float* WSC = (const float*)(A.ws + WS_WSC);
    bf16* Y = (bf16*)(A.ws + WS_H); float* SSY = (float*)(A.ws + WS_SSY);
    const int tper = (M / 2) / nj, tbeg = half * (M / 2) + j * tper;
    LAS float* red = (LAS float*)lds;
    const int c = tid & 255, tsub = tid >> 8, nn = c >> 4, nt = c & 15, P = 16 * nt + nn;
    for (int tb = 0; tb < tper; tb += 2) { const int t = tbeg + tb + tsub; float acc = 0.f;
        for (int k = 0; k < 128; ++k) { const unsigned e = EI[(size_t)t * NSLOT + k]; const unsigned byte = V4[(size_t)e * 512 + 128 * q + (P >> 1)]; const unsigned nib = (byte >> (4 * (P & 1))) & 15u;
            const float vv = __builtin_amdgcn_cvt_scalef32_pk_f32_fp4(nib, 1.0f, 0)[0];
            const unsigned hb = W8[(size_t)t * 256 + k], lb = W8[(size_t)t * 256 + 128 + k];
            const float w = __builtin_amdgcn_cvt_pk_f32_fp8((int)hb, false)[0] + __builtin_amdgcn_cvt_pk_f32_fp8((int)lb, false)[0] * 0.0625f;
            acc += w * vv; }
        acc *= WSC[t];
        Y[(size_t)t * D + 256 * q + c] = (bf16)f2bf(acc);
        __syncthreads(); red[tid] = acc * acc; __syncthreads();
        if (c < 2) { float ssum = 0.f; for (int x = 0; x < 256; ++x) if (((x >> 3) & 1) == c) ssum += red[tsub * 256 + x]; SSY[(size_t)t * 8 + 2 * q + c] = ssum; }
    }
    __syncthreads();
}
#endif
__device__ __forceinline__ void phase_peer_final(const Args& A) {
    const int tid = threadIdx.x, lane = tid & 63, wave = tid >> 6, G = gridDim.x;
    const bf16* Y = (const bf16*)(A.ws + WS_H); const bf16* X1 = (const bf16*)(A.ws + WS_X1); const float* SSY = (const float*)(A.ws + WS_SSY); const float* mod = (const float*)(A.ws + WS_MOD); const float* gpost = (const float*)A.in[I_GPOST2]; float* out = A.out;
    f32x4 gp[4];
#pragma unroll
    for (int q = 0; q < 4; ++q) gp[q] = *(const GAS f32x4*)(gpost + 4 * (lane + 64 * q));
    const int stride = G * NWAVES; int row = blockIdx.x * NWAVES + wave;
    v2u xw[4], yw[4], xwn[4], ywn[4]; f32x4 s0, s0n, s1, s1n, g2p[4]; int bcur = -1;
#pragma unroll
    for (int q = 0; q < 4; ++q) { xw[q] = ((const GAS v2u*)(X1 + (size_t)row * D) + lane)[64 * q]; yw[q] = ((const GAS v2u*)(Y + (size_t)row * D) + lane)[64 * q]; }
    s0 = *(const GAS f32x4*)(SSY + (size_t)row * 8); s1 = *(const GAS f32x4*)(SSY + (size_t)row * 8 + 4);
    for (; row < M; row += stride) {
        const int rn = min(row + stride, M - 1);
#pragma unroll
        for (int q = 0; q < 4; ++q) { xwn[q] = ((const GAS v2u*)(X1 + (size_t)rn * D) + lane)[64 * q]; ywn[q] = ((const GAS v2u*)(Y + (size_t)rn * D) + lane)[64 * q]; }
        s0n = *(const GAS f32x4*)(SSY + (size_t)rn * 8); s1n = *(const GAS f32x4*)(SSY + (size_t)rn * 8 + 4);
        const int b = row / SEQ;
        if (b != bcur) { bcur = b;
#pragma unroll
            for (int q = 0; q < 4; ++q) { const f32x4 g2 = *(const GAS f32x4*)(mod + b * 6144 + 5120 + 4 * (lane + 64 * q));
#pragma unroll
                for (int i = 0; i < 4; ++i) g2p[q][i] = g2[i] * gp[q][i]; } }
        const float rstd = __builtin_amdgcn_rsqf((((s0[0] + s0[1]) + (s0[2] + s0[3])) + ((s1[0] + s1[1]) + (s1[2] + s1[3]))) * (1.f / D) + EPS);
        GAS f32x4* orow = (GAS f32x4*)(out + (size_t)row * D) + lane;
#pragma unroll
        for (int q = 0; q < 4; ++q) { f32x4 xv = {bflo(xw[q].x), bfhi(xw[q].x), bflo(xw[q].y), bfhi(xw[q].y)};
            xv[0] += g2p[q][0] * (bflo(yw[q].x) * rstd); xv[1] += g2p[q][1] * (bfhi(yw[q].x) * rstd); xv[2] += g2p[q][2] * (bflo(yw[q].y) * rstd); xv[3] += g2p[q][3] * (bfhi(yw[q].y) * rstd);
#ifdef V_DIAG
            if (row == 0 && lane == 0 && q == 0) xv[0] += *(const float*)(A.ws + WS_WSC + MiB);
#endif
            orow[64 * q] = xv; }
#pragma unroll
        for (int q = 0; q < 4; ++q) { xw[q] = xwn[q]; yw[q] = ywn[q]; }
        s0 = s0n; s1 = s1n;
    }
}
#ifdef PROBE_V_LOADS
__device__ __forceinline__ void probe_v_loads(const Args& A) {
    const int tid = threadIdx.x, lane = tid & 63, wave = tid >> 6, p = blockIdx.x & 7, j = blockIdx.x >> 3, nj = gridDim.x >> 3, g = lane >> 3, c = lane & 7;
    const unsigned char* V8 = (const unsigned char*)(A.ws + WS_V8); const unsigned short* EI = (const unsigned short*)(A.ws + WS_EIDX); const float* ACT = (const float*)(A.ws + WS_ACT);
    unsigned* DUMP = (unsigned*)(A.ws + WS_PD);
    const int tper = M / nj, colb = 128 * p + 16 * c, tend = (j + 1) * tper, tlast = tend - NWAVES + wave;
    int t = j * tper + wave;
    PeerIdx ix1 = peer_ld_idx(EI, min(t + NWAVES, tlast), g), ix2 = peer_ld_idx(EI, min(t + 2 * NWAVES, tlast), g);
    v4u rawa[16], rawb[16]; PeerAct aca, acb;
    { const PeerIdx ix0 = peer_ld_idx(EI, t, g); peer_gather(V8, ix0, colb, rawa); aca = peer_ld_act(ACT, t, g); }
    for (; t < tend; t += 2 * NWAVES) {
        const int t1 = t + NWAVES, t2 = min(t + 2 * NWAVES, tlast), t3 = min(t + 3 * NWAVES, tlast), t4 = min(t + 4 * NWAVES, tlast);
        const PeerIdx ix3 = peer_ld_idx(EI, t3, g);
        peer_gather(V8, ix1, colb, rawb); acb = peer_ld_act(ACT, t1, g);
        { unsigned s = __builtin_bit_cast(unsigned, aca.a0[0]) + __builtin_bit_cast(unsigned, aca.a3[3]);
#pragma unroll
          for (int k = 0; k < 16; ++k) s += (rawa[k].x + rawa[k].y) + (rawa[k].z + rawa[k].w);
          DUMP[(size_t)t * 512 + p * 64 + lane] = s; }
        const PeerIdx ix4 = peer_ld_idx(EI, t4, g);
        peer_gather(V8, ix2, colb, rawa); aca = peer_ld_act(ACT, t2, g);
        { unsigned s = __builtin_bit_cast(unsigned, acb.a0[0]) + __builtin_bit_cast(unsigned, acb.a3[3]);
#pragma unroll
          for (int k = 0; k < 16; ++k) s += (rawb[k].x + rawb[k].y) + (rawb[k].z + rawb[k].w);
          DUMP[(size_t)t1 * 512 + p * 64 + lane] = s; }
        ix1 = ix3; ix2 = ix4;
    }
}
#endif

#ifdef PROBE_INSTR
__device__ __forceinline__ void probe_instr(const Args& A) {
    f32x2 a[8]; float f[16]; unsigned w = threadIdx.x * 0x01010101u + 0x38383838u;
#pragma unroll
    for (int i = 0; i < 8; ++i) a[i] = (f32x2){1.0f + i, 2.0f + i};
#pragma unroll
    for (int i = 0; i < 16; ++i) f[i] = 1.0f + i;
    for (int it = 0; it < 10000; ++it) {
#if PROBE_INSTR == 1
#pragma unroll
        for (int i = 0; i < 8; ++i) { asm volatile("v_pk_fma_f32 %0, %1, %2, %0" : "+v"(a[i]) : "v"(a[(i + 1) & 7]), "v"(a[(i + 2) & 7])); asm volatile("v_pk_fma_f32 %0, %1, %2, %0" : "+v"(a[i]) : "v"(a[(i + 3) & 7]), "v"(a[(i + 4) & 7])); }
#elif PROBE_INSTR == 2
#pragma unroll
        for (int i = 0; i < 16; ++i) asm volatile("v_fma_f32 %0, %1, %2, %0" : "+v"(f[i]) : "v"(f[(i + 1) & 15]), "v"(f[(i + 2) & 15]));
#elif PROBE_INSTR == 3
#pragma unroll
        for (int i = 0; i < 8; ++i) { asm volatile("v_cvt_pk_f32_fp8 %0, %1" : "=v"(a[i]) : "v"(w)); asm volatile("v_cvt_pk_f32_fp8 %0, %1" : "=v"(a[i]) : "v"(w)); }
#elif PROBE_INSTR == 4
#pragma unroll
        for (int i = 0; i < 8; ++i) { asm volatile("v_cvt_scalef32_pk_f32_fp4 %0, %1, 1.0" : "=v"(a[i]) : "v"(w)); asm volatile("v_cvt_scalef32_pk_f32_fp4 %0, %1, 1.0" : "=v"(a[i]) : "v"(w)); }
#elif PROBE_INSTR == 5
#pragma unroll
        for (int i = 0; i < 16; ++i) asm volatile("v_pk_fma_f16 %0, %1, %2, %0" : "+v"(f[i]) : "v"(f[(i + 1) & 15]), "v"(f[(i + 2) & 15]));
#elif PROBE_INSTR == 7
#pragma unroll
        for (int i = 0; i < 16; ++i) asm volatile("v_dot8c_i32_i4 %0, %1, %2" : "+v"(f[i]) : "v"(f[(i + 1) & 15]), "v"(w));
#elif PROBE_INSTR == 8
#pragma unroll
        for (int i = 0; i < 16; ++i) asm volatile("v_dot4c_i32_i8 %0, %1, %2" : "+v"(f[i]) : "v"(f[(i + 1) & 15]), "v"(w));
#elif PROBE_INSTR == 9
#pragma unroll
        for (int i = 0; i < 16; ++i) asm volatile("v_perm_b32 %0, %1, %2, %3" : "=v"(f[i]) : "v"(f[(i + 1) & 15]), "v"(f[(i + 2) & 15]), "v"(w));
#elif PROBE_INSTR == 10
#pragma unroll
        for (int i = 0; i < 16; ++i) asm volatile("v_mfma_f32_16x16x32_fp8_fp8 %0, %1, %2, %0" : "+v"(*(f32x4*)&f[4 * (i & 3)]) : "v"(a[i & 7]), "v"(a[(i + 1) & 7]));
#elif PROBE_INSTR == 6
#pragma unroll
        for (int i = 0; i < 16; ++i) asm volatile("v_cvt_scalef32_pk_f16_fp4 %0, %1, 1.0" : "=v"(f[i]) : "v"(w));
#endif
    }
    float s = 0.f;
#pragma unroll
    for (int i = 0; i < 8; ++i) s += a[i].x + a[i].y;
#pragma unroll
    for (int i = 0; i < 16; ++i) s += f[i];
    if (s == 123.456f) ((float*)(A.ws + WS_PD))[threadIdx.x] = s;
}
#endif
#ifndef MK_N_LAUNCHES
#define MK_N_LAUNCHES 1
#endif
constexpr int N_PHASES = 13;
typedef const __attribute__((address_space(4))) Args* KArgP;
__device__ __forceinline__ const Args& kargs() { KArgP p = (KArgP)__builtin_amdgcn_kernarg_segment_ptr(); asm volatile("" : "+s"(p)); return *(const Args*)p; }
__global__ void __launch_bounds__(NTHR, 2) hymba_fwd(Args A_) {
    extern __shared__ __attribute__((aligned(16))) unsigned char lds_raw[];
    LAS unsigned char* lds = (LAS unsigned char*)lds_raw;
    const int lo = A_.ph_lo, hi = A_.ph_hi;
#define A kargs()
#define ws (kargs().ws)
#ifndef DBLMASK
#define DBLMASK 0
#endif
#ifndef ONLYMASK
#define ONLYMASK 0xffff
#endif
#define IN(k) ((((ONLYMASK) >> (k)) & 1) && lo <= (k) && (k) < hi)
#define REP(k) for (int _rep = 0; _rep < (((DBLMASK) >> (k)) & 1) + 1; ++_rep)
    for (int u = threadIdx.x; u < (LDS_BYTES - RING_BYTES) / 4; u += NTHR) ((LAS unsigned*)(lds + RING_BYTES))[u] = 0u;
    __syncthreads();
    (void)xcd_barrier_post((unsigned*)(ws + WS_CTL) + CW_BAR, (volatile LAS unsigned*)(lds + MISC_OFF + 32));
    if (hi < 0) cg::this_grid().sync();
#define SEAM(k) do { if (IN(k) && IN((k) + 1)) { { XcdBarrier xb_; xb_.bar = (unsigned*)(ws + WS_CTL) + CW_BAR; xb_.x = xb_xcc_id(); xb_.st = (volatile LAS unsigned*)(lds + MISC_OFF + 32); xcd_barrier(xb_); } } } while (0)

    if (IN(0)) REP(0) { phase_mod(A, lds); } SEAM(0);
    if (IN(1)) REP(1) { phase_convert(A, lds); phase_prenorm(A, lds); } SEAM(1);
    if (IN(2)) REP(2) {
        pg8::Gemm g{(const pg8::bf16_t*)(ws + WS_H), (const pg8::bf16_t*)(ws + WS_WIN), M, NPROJ, D}; pg8::StaticOrder S; S.init(M, NPROJ, gridDim.x, (int)blockIdx.x);
        pg8::EpiProj E{(pg8::bf16_t*)(ws + WS_PROJ), NPROJ, (float*)(ws + WS_GATES), (const int*)A.in[I_POS], (const float*)A.in[I_BI], (const float*)A.in[I_BF]};
        pg8::gemm_phase<pg8::EpiProj, pg8::StaticOrder, true, true>(lds, g, S, E);
    } SEAM(2);
    if (IN(3)) REP(3) {
        phase_attn(A, lds);
        for (int wg = blockIdx.x; wg < 256; wg += gridDim.x) mlstm_group<false>(A, lds, wg);
    } SEAM(3);
    if (IN(4)) REP(4) { for (int wg = blockIdx.x; wg < 256; wg += gridDim.x) mlstm_group<true>(A, lds, wg); } SEAM(4);
    if (IN(5)) REP(5) {
        pg8::Gemm g{(const pg8::bf16_t*)(ws + WS_MIXIN), (const pg8::bf16_t*)(ws + WS_WOUT), M, D, D}; pg8::StaticOrder S; S.init(M, D, gridDim.x, (int)blockIdx.x);
        pg8::EpiMix E{(pg8::bf16_t*)(ws + WS_MIX), D, (float*)(ws + WS_SSQ)};
        pg8::gemm_phase<pg8::EpiMix, pg8::StaticOrder, true, true>(lds, g, S, E);
    } SEAM(5);
    if (IN(6)) REP(6) { phase_mid(A); } SEAM(6);
    if (IN(7)) REP(7) {
        pg8::Gemm g{(const pg8::bf16_t*)(ws + WS_H), (const pg8::bf16_t*)(ws + WS_WQ), M, 2048, D}; pg8::StaticOrder S; S.init(M, 2048, gridDim.x, (int)blockIdx.x);
        pg8::EpiPlain E{(pg8::bf16_t*)(ws + WS_PROJ), 2048};
        pg8::gemm_phase<pg8::EpiPlain, pg8::StaticOrder, true, true>(lds, g, S, E);
    } SEAM(7);
    if (IN(8)) REP(8) { phase_topk(A, lds); } SEAM(8);
    if (IN(9)) REP(9) { phase_peer_u(A); } SEAM(9);
    if (IN(10)) REP(10) { phase_peer_act(A); } SEAM(10);
#ifdef PROBE_INSTR
    if (IN(11)) { probe_instr(A); }
#endif
#ifdef PROBE_V_LOADS
    if (IN(11)) { probe_v_loads(A); }
#endif
#ifdef V_SLOW
    if (IN(11)) REP(11) { phase_peer_v_slow(A, lds);
#ifdef V_DIAG
        phase_peer_v(A, lds);
#endif
    } SEAM(11);
#else
    if (IN(11)) REP(11) { phase_peer_v(A, lds); } SEAM(11);
#endif
    if (IN(12)) REP(12) { phase_peer_final(A); }
#undef IN
#undef SEAM
#undef A
#undef ws
}

extern "C" void kernel_launch(void* const* d_in, const int* in_sizes, int n_in, void* d_out, int out_size, void* d_ws, size_t ws_size, hipStream_t stream) {
    static int grid = 0;
    if (grid == 0) {
        if (n_in != 21 || in_sizes[0] != M * D || out_size != M * D || ws_size < WS_END) { fprintf(stderr, "kernel_launch: unexpected shapes (n_in %d, in0 %d, out %d, ws %zu < %zu)\n", n_in, n_in > 0 ? in_sizes[0] : -1, out_size, ws_size, (size_t)WS_END); grid = -1; return; }
        int dev = 0, cus = 0, per_cu = 0;
        if (hipGetDevice(&dev) != hipSuccess || hipDeviceGetAttribute(&cus, hipDeviceAttributeMultiprocessorCount, dev) != hipSuccess) { grid = -1; return; }
        if (hipFuncSetAttribute((const void*)hymba_fwd, hipFuncAttributeMaxDynamicSharedMemorySize, LDS_BYTES) != hipSuccess) { fprintf(stderr, "kernel_launch: hipFuncSetAttribute failed\n"); grid = -1; return; }
        if (hipOccupancyMaxActiveBlocksPerMultiprocessor(&per_cu, (const void*)hymba_fwd, NTHR, LDS_BYTES) != hipSuccess || per_cu < 1) { fprintf(stderr, "kernel_launch: occupancy query says %d blocks per CU\n", per_cu); per_cu = 1; }
        (void)hipGetLastError();
        grid = cus;
        if (grid != 256) fprintf(stderr, "kernel_launch: note: %d CUs (built for 256)\n", grid);
    }
    if (grid < 0) return;
    (void)hipMemsetAsync((char*)d_ws + WS_CTL, 0, CTL_ZERO_BYTES, stream);
    Args a{};
    for (int i = 0; i < 21; ++i) a.in[i] = d_in[i];
    a.out = (float*)d_out; a.ws = (unsigned char*)d_ws;
    if (MK_N_LAUNCHES == 1) {
        a.ph_lo = 0; a.ph_hi = N_PHASES;
        void* args[] = {&a};
        const hipError_t e = hipLaunchCooperativeKernel((const void*)hymba_fwd, dim3(grid), dim3(NTHR), args, LDS_BYTES, stream);
        if (e != hipSuccess) fprintf(stderr, "kernel_launch: cooperative launch failed: %s (grid %d)\n", hipGetErrorString(e), grid);
    } else {
        for (int p = 0; p < N_PHASES; ++p) { a.ph_lo = p; a.ph_hi = p + 1; hipLaunchKernelGGL(hymba_fwd, dim3(grid), dim3(NTHR), LDS_BYTES, stream, a); }
    }
}
```

```cpp
#include <hip/hip_runtime.h>
#include <hip/hip_cooperative_groups.h>
#include <cstdio>
#include <cstdint>
namespace cg = cooperative_groups;
namespace pg8 {
#define PG8_LAS __attribute__((address_space(3)))
typedef unsigned short bf16_t;
typedef short bf16x8 __attribute__((ext_vector_type(8)));
typedef float f32x4 __attribute__((ext_vector_type(4)));
typedef unsigned u32x4 __attribute__((ext_vector_type(4)));
constexpr int BM = 256, BK = 64, HALF = 128, HTB = HALF * BK * 2  , STAGE_BYTES = 8 * HTB, NXCD = 8, WGM = 8;

__host__ __device__ __forceinline__ int lds_byte(int r, int c) { const int st = (r >> 4) * 2 + (c >> 5), rr = r & 15, cc = c & 31, ob = rr * 64 + cc * 2; return st * 1024 + (ob ^ (((ob >> 9) & 1) << 5)); }
__host__ __device__ __forceinline__ void stage_rc(int b, int& R, int& C) { const int st = b / 1024, sb = b % 1024, swz = sb ^ (((sb >> 9) & 1) << 5); R = (st >> 1) * 16 + swz / 64; C = (st & 1) * 32 + (swz % 64) / 2; }
__host__ __device__ __forceinline__ int perm32(int rho) { const int n = rho >> 4, i = rho & 15; return 8 * (i >> 2) + 4 * n + (i & 3); }

struct Unit { int pm, pn; };
struct Gemm { const bf16_t* A; const bf16_t* Bt; int M, N, K; };

struct StaticOrder {
    int nM, nN, nwg, G, c;
    __host__ __device__ void init(int M, int N, int G_, int c_) { nM = M / BM; nN = N / BM; nwg = nM * nN; G = G_; c = c_; }
    __host__ __device__ bool next(int i, Unit& u) const {
        const long L = (long)i * G + c; if (L >= nwg) return false;
        int wgid = (int)L; { const int q = nwg / NXCD, r = nwg % NXCD, xcd = wgid % NXCD, off = wgid / NXCD; wgid = (xcd < r ? xcd * (q + 1) : r * (q + 1) + (xcd - r) * q) + off; }
        const int nig = WGM * nN, gid = wgid / nig, fm = gid * WGM, gsz = (nM - fm) < WGM ? (nM - fm) : WGM;
        u.pm = fm + ((wgid % nig) % gsz); u.pn = (wgid % nig) / gsz; return true;
    }
    __device__ __forceinline__ void a_ready(const Unit&) const {}
    __device__ __forceinline__ void done(const Unit&) const {}
};

__device__ __forceinline__ unsigned cvt_pk_bf16(float lo, float hi) { unsigned r; asm volatile("v_cvt_pk_bf16_f32 %0, %1, %2" : "=v"(r) : "v"(lo), "v"(hi)); return r; }
typedef float f32x2 __attribute__((ext_vector_type(2)));
__device__ __forceinline__ f32x2 gelu_pk(f32x2 v) {
    const f32x2 av = __builtin_elementwise_abs(v), d = av * 0.2316418882f + 1.0f;
    f32x2 t; t.x = __builtin_amdgcn_rcpf(d.x); t.y = __builtin_amdgcn_rcpf(d.y);
    f32x2 q = t * 0.5307027145f + (-0.7265760135f); q = q * t + 0.7107068705f; q = q * t + (-0.142248368f); q = q * t + 0.127414796f; q = q * t;
    const f32x2 s = (v * v) * (-0.72134752044f);
    f32x2 e; e.x = __builtin_amdgcn_exp2f(s.x); e.y = __builtin_amdgcn_exp2f(s.y);
    const f32x2 m = v * (q * e), r = v - m;
    f32x2 o; o.x = v.x < 0.f ? m.x : r.x; o.y = v.y < 0.f ? m.y : r.y; return o;
}

__device__ __forceinline__ u32x4 pack8(const f32x4 v0, const f32x4 v1) { u32x4 w; w.x = cvt_pk_bf16(v0[0], v0[1]); w.y = cvt_pk_bf16(v0[2], v0[3]); w.z = cvt_pk_bf16(v1[0], v1[1]); w.w = cvt_pk_bf16(v1[2], v1[3]); return w; }

struct EpiPlain {
    static constexpr bool PERM = true, AFTER_DRAIN = false;
    bf16_t* O; int ldc;
    __device__ __forceinline__ void operator()(const f32x4 (&acc)[2][2][4][2], const Unit& u, int wr, int wc, int fr, int fq) const {
        const int row0 = u.pm * BM + wr * 64 + fr, col0 = u.pn * BM + wc * 32 + 8 * fq;
#pragma unroll
        for (int ai = 0; ai < 2; ++ai)
#pragma unroll
            for (int m = 0; m < 4; ++m) { bf16_t* rowp = O + (size_t)(row0 + ai * HALF + m * 16) * ldc + col0;
#pragma unroll
                for (int bj = 0; bj < 2; ++bj) *(u32x4*)(rowp + bj * HALF) = pack8(acc[ai][bj][m][0], acc[ai][bj][m][1]); }
    }
};

struct EpiProj {
    static constexpr bool PERM = true, AFTER_DRAIN = false;
    bf16_t* P; int ldc; float* gates; const int* pos; const float* b_i; const float* b_f;
    __device__ __forceinline__ void operator()(const f32x4 (&acc)[2][2][4][2], const Unit& u, int wr, int wc, int fr, int fq) const {
        const int row0 = u.pm * BM + wr * 64 + fr, col0 = u.pn * BM + wc * 32 + 8 * fq, pn = u.pn;
        if (pn == 9) {
            if (wc == 0 && fq == 0) {
                const f32x4 bi = {b_i[0], b_i[1], b_i[2], b_i[3]}, bf = {b_f[0], b_f[1], b_f[2], b_f[3]};
#pragma unroll
                for (int ai = 0; ai < 2; ++ai)
#pragma unroll
                    for (int m = 0; m < 4; ++m) { const int row = row0 + ai * HALF + m * 16;
                        const f32x4 iv = acc[ai][0][m][0] + bi, fv = acc[ai][0][m][1] + bf; f32x4 lf;
#pragma unroll
                        for (int j = 0; j < 4; ++j) lf[j] = fminf(fv[j], 0.f) - log1pf(__expf(-fabsf(fv[j])));
                        *(f32x4*)(gates + (size_t)row * 8) = iv; *(f32x4*)(gates + (size_t)row * 8 + 4) = lf; }
            }
            return;
        }
#pragma unroll
        for (int ai = 0; ai < 2; ++ai)
#pragma unroll
            for (int m = 0; m < 4; ++m) { const int row = row0 + ai * HALF + m * 16; bf16_t* rowp = P + (size_t)row * ldc + col0;
                const float posf = (pn <= 2) ? (float)pos[row] : 0.f;
#pragma unroll
                for (int bj = 0; bj < 2; ++bj) { f32x4 v0 = acc[ai][bj][m][0], v1 = acc[ai][bj][m][1];
                    const bool rope = (pn < 2) || (pn == 2 && bj == 0);
                    if (rope) {
                        const int p0 = ((col0 + bj * HALF) & 63) >> 1; const float sc = (pn < 2) ? 0.125f : 1.0f;
                        float x[8] = {v0[0], v0[1], v0[2], v0[3], v1[0], v1[1], v1[2], v1[3]};
#pragma unroll
                        for (int q = 0; q < 4; ++q) { const float invf = __builtin_amdgcn_exp2f(-(float)(p0 + q) * 0.41524101186092029f);
                            float r = posf * invf * 0.15915494309189535f; r = r - floorf(r);
                            const float c = __builtin_amdgcn_cosf(r) * sc, s = __builtin_amdgcn_sinf(r) * sc;
                            const float x1 = x[2 * q], x2 = x[2 * q + 1]; x[2 * q] = x1 * c - x2 * s; x[2 * q + 1] = x2 * c + x1 * s; }
                        v0 = (f32x4){x[0], x[1], x[2], x[3]}; v1 = (f32x4){x[4], x[5], x[6], x[7]};
                    } else if (pn >= 7) {
#pragma unroll
                        for (int j = 0; j < 4; ++j) { v0[j] = __builtin_amdgcn_rcpf(1.f + __expf(-v0[j])); v1[j] = __builtin_amdgcn_rcpf(1.f + __expf(-v1[j])); }
                    }
                    *(u32x4*)(rowp + bj * HALF) = pack8(v0, v1); } }
    }
};

struct EpiMix {
    static constexpr bool PERM = true, AFTER_DRAIN = false;
    bf16_t* O; int ldc; float* sumsq;
    __device__ __forceinline__ void operator()(const f32x4 (&acc)[2][2][4][2], const Unit& u, int wr, int wc, int fr, int fq) const {
        const int row0 = u.pm * BM + wr * 64 + fr, col0 = u.pn * BM + wc * 32 + 8 * fq;
#pragma unroll
        for (int ai = 0; ai < 2; ++ai)
#pragma unroll
            for (int m = 0; m < 4; ++m) { const int row = row0 + ai * HALF + m * 16; bf16_t* rowp = O + (size_t)row * ldc + col0; float s = 0.f;
#pragma unroll
                for (int bj = 0; bj < 2; ++bj) { const f32x4 v0 = acc[ai][bj][m][0], v1 = acc[ai][bj][m][1];
                    s += (v0[0] * v0[0] + v0[1] * v0[1]) + (v0[2] * v0[2] + v0[3] * v0[3]) + (v1[0] * v1[0] + v1[1] * v1[1]) + (v1[2] * v1[2] + v1[3] * v1[3]);
                    *(u32x4*)(rowp + bj * HALF) = pack8(v0, v1); }
                s += __shfl_xor(s, 16); s += __shfl_xor(s, 32);
                if (fq == 0) sumsq[(size_t)row * 16 + u.pn * 4 + wc] = s; }
    }
};
template <class Epi, class Sched, bool ALIGN_EPI = false, bool SP2 = false>
__device__ __forceinline__ void gemm_phase(PG8_LAS unsigned char* lds, const Gemm g, const Sched& S, const Epi& E) {
    const int tid = threadIdx.x, wid = __builtin_amdgcn_readfirstlane(tid >> 6), lane = tid & 63, wr = wid >> 2, wc = wid & 3, fr = lane & 15, fq = lane >> 4;
    const int K = g.K, nt = K / BK;
    unsigned voffA[2], voffB[2];
#pragma unroll
    for (int i = 0; i < 2; ++i) { int R, C; stage_rc(tid * 16 + i * 8192, R, C); const int Rb = Epi::PERM ? ((R & ~31) + perm32(R & 31)) : R;
        voffA[i] = (unsigned)(R * K + C) * 2u; voffB[i] = (unsigned)(Rb * K + C) * 2u; }
    const size_t kstep = (size_t)(BK * 2);
    const size_t hstep = (size_t)HALF * K * 2;
    const size_t tstep = 2 * hstep;
    const unsigned ldsw = (unsigned)wid * 1024u;
    const int aoff = lds_byte(wr * 64 + fr, fq * 8), boff = lds_byte(wc * 32 + fr, fq * 8);
#define PG8_SA(b, h) (((b) * 2 + (h)) * HTB)
#define PG8_SB(b, h) ((4 + (b) * 2 + (h)) * HTB)
#define PG8_STAGE(bufoff, gbase, voff) do { _Pragma("unroll") for (int _i = 0; _i < 2; ++_i) \
        __builtin_amdgcn_global_load_lds((const unsigned*)((const char*)(gbase) + (voff)[_i]), (PG8_LAS unsigned*)(lds + (bufoff) + ldsw + _i * 8192), 16, 0, 0); } while (0)
#define PG8_LDA(dst, b, h) do { _Pragma("unroll") for (int m = 0; m < 4; ++m) _Pragma("unroll") for (int k = 0; k < 2; ++k) dst[m][k] = *(const PG8_LAS bf16x8*)(lds + PG8_SA(b, h) + aoff + m * 2048 + k * 1024); } while (0)
#define PG8_LDB(dst, b, h) do { _Pragma("unroll") for (int n = 0; n < 2; ++n) _Pragma("unroll") for (int k = 0; k < 2; ++k) dst[n][k] = *(const PG8_LAS bf16x8*)(lds + PG8_SB(b, h) + boff + n * 2048 + k * 1024); } while (0)
#define PG8_MMA(ai, bj, At, Bt) do { __builtin_amdgcn_s_setprio(1); _Pragma("unroll") for (int m = 0; m < 4; ++m) _Pragma("unroll") for (int n = 0; n < 2; ++n) _Pragma("unroll") for (int k = 0; k < 2; ++k) \
        acc[ai][bj][m][n] = __builtin_amdgcn_mfma_f32_16x16x32_bf16(Bt[n][k], At[m][k], acc[ai][bj][m][n], 0, 0, 0); __builtin_amdgcn_s_setprio(0); } while (0)
#define PG8_WAIT_V(n) asm volatile("s_waitcnt vmcnt(" #n ")" ::: "memory")
#define PG8_WAIT_L(n) asm volatile("s_waitcnt lgkmcnt(" #n ")" ::: "memory")
#define PG8_BAR __builtin_amdgcn_s_barrier()
#define PG8_SCHED __builtin_amdgcn_sched_barrier(0)
    Unit cur, nxt; int ui = 0;
    if (!S.next(0, cur)) return;
    f32x4 acc[2][2][4][2];
#pragma unroll
    for (int a = 0; a < 2; ++a)
#pragma unroll
        for (int b = 0; b < 2; ++b)
#pragma unroll
            for (int m = 0; m < 4; ++m)
#pragma unroll
                for (int n = 0; n < 2; ++n) acc[a][b][m][n] = (f32x4){0.f, 0.f, 0.f, 0.f};
    bf16x8 At[4][2], B0[2][2], B1[2][2];
    const char* cA = (const char*)g.A + (size_t)cur.pm * tstep; const char* cB = (const char*)g.Bt + (size_t)cur.pn * tstep;
    S.a_ready(cur);
    if constexpr (SP2) {
        PG8_STAGE(PG8_SB(0, 0), cB, voffB); PG8_STAGE(PG8_SB(0, 1), cB + hstep, voffB); PG8_STAGE(PG8_SA(0, 0), cA, voffA); PG8_STAGE(PG8_SA(0, 1), cA + hstep, voffA);
        if (wr == 1) PG8_BAR;
        PG8_WAIT_V(2); PG8_BAR;
        PG8_STAGE(PG8_SB(1, 0), cB + kstep, voffB); PG8_STAGE(PG8_SA(1, 0), cA + kstep, voffA); PG8_STAGE(PG8_SB(1, 1), cB + hstep + kstep, voffB);
        PG8_WAIT_V(6); PG8_BAR;
    } else {
        PG8_STAGE(PG8_SB(0, 0), cB, voffB); PG8_STAGE(PG8_SA(0, 0), cA, voffA); PG8_STAGE(PG8_SB(0, 1), cB + hstep, voffB); PG8_STAGE(PG8_SA(0, 1), cA + hstep, voffA);
        if (wr == 1) PG8_BAR;
        PG8_WAIT_V(4); PG8_BAR;
        PG8_STAGE(PG8_SB(1, 0), cB + kstep, voffB); PG8_STAGE(PG8_SA(1, 0), cA + kstep, voffA); PG8_STAGE(PG8_SB(1, 1), cB + hstep + kstep, voffB);
        PG8_WAIT_V(6); PG8_BAR;
    }
    for (;;) {
        const bool has_next = S.next(ui + 1, nxt);
        const char* nA = has_next ? (const char*)g.A + (size_t)nxt.pm * tstep : cA; const char* nB = has_next ? (const char*)g.Bt + (size_t)nxt.pn * tstep : cB;
        for (int t = 0; t < nt; t += 2) {
            const bool last = (t == nt - 2);
            const char* a1 = cA + (size_t)(t + 1) * kstep;
            const char* a2 = last ? nA : cA + (size_t)(t + 2) * kstep; const char* b2 = last ? nB : cB + (size_t)(t + 2) * kstep;
            const char* a3 = a2 + kstep; const char* b3 = b2 + kstep;
            if (last && has_next) S.a_ready(nxt);
            if constexpr (SP2) {
            PG8_LDB(B0, 0, 0); PG8_LDB(B1, 0, 1); PG8_SCHED; PG8_LDA(At, 0, 0); PG8_STAGE(PG8_SA(1, 1), a1 + hstep, voffA);
            PG8_WAIT_V(8); PG8_WAIT_L(0); PG8_BAR; PG8_MMA(0, 0, At, B0); PG8_MMA(0, 1, At, B1); PG8_BAR; PG8_SCHED;
            PG8_LDA(At, 0, 1); PG8_STAGE(PG8_SB(0, 0), b2, voffB); PG8_STAGE(PG8_SB(0, 1), b2 + hstep, voffB); PG8_STAGE(PG8_SA(0, 0), a2, voffA);
            PG8_WAIT_V(8); PG8_WAIT_L(0); PG8_BAR; PG8_MMA(1, 0, At, B0); PG8_MMA(1, 1, At, B1); PG8_BAR; PG8_SCHED;
            PG8_LDB(B0, 1, 0); PG8_LDB(B1, 1, 1); PG8_SCHED; PG8_LDA(At, 1, 0); PG8_STAGE(PG8_SA(0, 1), a2 + hstep, voffA);
            PG8_WAIT_V(8); PG8_WAIT_L(0); PG8_BAR; PG8_MMA(0, 0, At, B0); PG8_MMA(0, 1, At, B1); PG8_BAR; PG8_SCHED;
            PG8_LDA(At, 1, 1); PG8_STAGE(PG8_SB(1, 0), b3, voffB); PG8_STAGE(PG8_SB(1, 1), b3 + hstep, voffB); PG8_STAGE(PG8_SA(1, 0), a3, voffA);
            PG8_WAIT_V(8); PG8_WAIT_L(0); PG8_BAR; PG8_MMA(1, 0, At, B0); PG8_MMA(1, 1, At, B1); PG8_BAR; PG8_SCHED;
            } else {
            PG8_LDB(B0, 0, 0); PG8_SCHED; PG8_LDA(At, 0, 0); PG8_STAGE(PG8_SA(1, 1), a1 + hstep, voffA);
            PG8_WAIT_L(8); PG8_BAR; PG8_WAIT_L(0); PG8_MMA(0, 0, At, B0); PG8_BAR; PG8_SCHED;
            PG8_LDB(B1, 0, 1); PG8_STAGE(PG8_SB(0, 0), b2, voffB);
            PG8_BAR; PG8_WAIT_L(0); PG8_MMA(0, 1, At, B1); PG8_BAR;
            PG8_LDA(At, 0, 1); PG8_STAGE(PG8_SA(0, 0), a2, voffA);
            PG8_BAR; PG8_WAIT_L(0); PG8_MMA(1, 0, At, B0); PG8_BAR; PG8_SCHED;
            PG8_STAGE(PG8_SB(0, 1), b2 + hstep, voffB);
            PG8_WAIT_V(6); PG8_BAR; PG8_MMA(1, 1, At, B1); PG8_BAR;
            PG8_LDB(B0, 1, 0); PG8_SCHED; PG8_LDA(At, 1, 0); PG8_STAGE(PG8_SA(0, 1), a2 + hstep, voffA);
            PG8_WAIT_L(8); PG8_BAR; PG8_WAIT_L(0); PG8_MMA(0, 0, At, B0); PG8_BAR; PG8_SCHED;
            PG8_LDB(B1, 1, 1); PG8_STAGE(PG8_SB(1, 0), b3, voffB);
            PG8_BAR; PG8_WAIT_L(0); PG8_MMA(0, 1, At, B1); PG8_BAR;
            PG8_LDA(At, 1, 1); PG8_STAGE(PG8_SA(1, 0), a3, voffA);
            PG8_BAR; PG8_WAIT_L(0); PG8_MMA(1, 0, At, B0); PG8_BAR; PG8_SCHED;
            PG8_STAGE(PG8_SB(1, 1), b3 + hstep, voffB);
            PG8_WAIT_V(6); PG8_BAR; PG8_MMA(1, 1, At, B1); PG8_BAR;
            }
        }
        if constexpr (ALIGN_EPI) { if (wr == 0) PG8_BAR; }
        if constexpr (!Epi::AFTER_DRAIN) { E(acc, cur, wr, wc, fr, fq); S.done(cur); }
        if (!has_next) break;
#pragma unroll
        for (int a = 0; a < 2; ++a)
#pragma unroll
            for (int b = 0; b < 2; ++b)
#pragma unroll
                for (int m = 0; m < 4; ++m)
#pragma unroll
                    for (int n = 0; n < 2; ++n) acc[a][b][m][n] = (f32x4){0.f, 0.f, 0.f, 0.f};
        cur = nxt; cA = nA; cB = nB; ++ui;
        if constexpr (ALIGN_EPI) { if (wr == 1) PG8_BAR; }
    }
    PG8_WAIT_V(0);
    if constexpr (!ALIGN_EPI) { if (wr == 0) PG8_BAR; }
    PG8_BAR;
    if constexpr (Epi::AFTER_DRAIN) { E.fused(acc, cur, wr, wc, fr, fq, lds, wid, lane); S.done(cur); }
#undef PG8_SA
#undef PG8_SB
#undef PG8_STAGE
#undef PG8_LDA
#undef PG8_LDB
#undef PG8_MMA
#undef PG8_WAIT_V
#undef PG8_WAIT_L
#undef PG8_BAR
#undef PG8_SCHED
}
}
constexpr int NB = 8, SEQ = 8192, D = 1024, M = NB * SEQ;
constexpr int DIN = 2312, NPROJ = 2304, NIN_PAD = 2560;
constexpr int C_AQ = 0, C_AK = 512, C_AV = 640, C_MQ = 768, C_MK = 1024, C_MV = 1280, C_MO = 1792;
constexpr int NEXP = 16384, NSLOT = 128;
constexpr float EPS = 1e-6f;
constexpr int NWAVES = 8, NTHR = 512;

constexpr size_t MiB = 1u << 20;
constexpr size_t WS_CTL = 0, CTL_ZERO_BYTES = 1 * MiB;
constexpr size_t WS_MOD = 1 * MiB;
constexpr size_t WS_WIN = 2 * MiB;
constexpr size_t WS_WOUT = 8 * MiB;
constexpr size_t WS_WQ = 10 * MiB;
constexpr size_t WS_KEYS = 14 * MiB;
constexpr size_t WS_GATES = 16 * MiB;
constexpr size_t WS_SSQ = 832 * MiB;
constexpr size_t WS_MST = 20 * MiB;
constexpr size_t WS_U8 = 32 * MiB, WS_V8 = 48 * MiB;
constexpr size_t WS_SC = 64 * MiB;
constexpr size_t WS_H = 96 * MiB;
constexpr size_t WS_PROJ = 224 * MiB;
constexpr size_t WS_MIXIN = 512 * MiB;
constexpr size_t WS_MIX = 640 * MiB;
constexpr size_t WS_EIDX = 768 * MiB, WS_GATE = 800 * MiB;
constexpr size_t WS_PD = 224 * MiB;
constexpr size_t WS_X1 = 512 * MiB;
constexpr size_t WS_ACT = 840 * MiB;
constexpr size_t WS_W8 = 840 * MiB, WS_WSC = 864 * MiB;
constexpr size_t WS_SSY = 872 * MiB;
constexpr size_t WS_H8 = 880 * MiB;
constexpr size_t WS_HS = 944 * MiB;
constexpr size_t WS_END = 945 * MiB;
constexpr int CW_BAR = 4096;
constexpr int CW_SUMSQ = 65536;
static_assert((CW_SUMSQ + M) * 4 <= (int)CTL_ZERO_BYTES, "ctl");

constexpr int RING_BYTES = 131072, MISC_OFF = RING_BYTES + 320, LDS_BYTES = 147456;

#define GAS __attribute__((address_space(1)))
#define LAS __attribute__((address_space(3)))
typedef unsigned short bf16;
typedef unsigned v4u __attribute__((ext_vector_type(4)));
typedef unsigned v2u __attribute__((ext_vector_type(2)));
typedef float f32x4 __attribute__((ext_vector_type(4)));
typedef GAS unsigned gu32;
#define LDS_WAIT() asm volatile("s_waitcnt lgkmcnt(0)" ::: "memory")
#define VM_WAIT() asm volatile("s_waitcnt vmcnt(0)" ::: "memory")
typedef float f32x2_cv __attribute__((ext_vector_type(2)));
typedef __bf16 bf16x2_cv __attribute__((ext_vector_type(2)));
__device__ __forceinline__ unsigned pk2(float lo, float hi) { return __builtin_bit_cast(unsigned, __builtin_convertvector((f32x2_cv){lo, hi}, bf16x2_cv)); }
__device__ __forceinline__ unsigned f2bf(float f) { return pk2(f, 0.f) & 0xffffu; }
__device__ __forceinline__ float bflo(unsigned w) { return __builtin_bit_cast(float, w << 16); }
__device__ __forceinline__ float bfhi(unsigned w) { return __builtin_bit_cast(float, w & 0xffff0000u); }
__device__ __forceinline__ float bf1(bf16 h) { return __builtin_bit_cast(float, (unsigned)h << 16); }
__device__ __forceinline__ float wave_sum(float v) {
#pragma unroll
    for (int o = 1; o < 64; o <<= 1) v += __shfl_xor(v, o);
    return v;
}
__device__ __forceinline__ float wave_max(float v) {
#pragma unroll
    for (int o = 1; o < 64; o <<= 1) v = fmaxf(v, __shfl_xor(v, o));
    return v;
}

typedef float f32x2 __attribute__((ext_vector_type(2)));
__device__ __forceinline__ void cvt16_fp8(const v4u w, float (&o)[16]) {
    const unsigned ww[4] = {w.x, w.y, w.z, w.w};
#pragma unroll
    for (int i = 0; i < 4; ++i) { const f32x2 a = __builtin_amdgcn_cvt_pk_f32_fp8((int)ww[i], false), b = __builtin_amdgcn_cvt_pk_f32_fp8((int)ww[i], true);
        o[4 * i] = a.x; o[4 * i + 1] = a.y; o[4 * i + 2] = b.x; o[4 * i + 3] = b.y; }
}
__device__ __forceinline__ void p0_row_fp8(const float* src, unsigned char* dst, float* sc, int row, int lane) {
    const GAS f32x4* sp = (const GAS f32x4*)(src + (size_t)row * D + 16 * lane);
    const f32x4 a = sp[0], b = sp[1], c = sp[2], d = sp[3];
    float mx = 0.f;
#pragma unroll
    for (int i = 0; i < 4; ++i) mx = fmaxf(fmaxf(fmaxf(mx, fabsf(a[i])), fmaxf(fabsf(b[i]), fabsf(c[i]))), fabsf(d[i]));
    mx = wave_max(mx); const float s = mx > 0.f ? 224.0f / mx : 1.0f;
    v4u o; int w;
    w = __builtin_amdgcn_cvt_pk_fp8_f32(a[0] * s, a[1] * s, 0, false); w = __builtin_amdgcn_cvt_pk_fp8_f32(a[2] * s, a[3] * s, w, true); o.x = (unsigned)w;
    w = __builtin_amdgcn_cvt_pk_fp8_f32(b[0] * s, b[1] * s, 0, false); w = __builtin_amdgcn_cvt_pk_fp8_f32(b[2] * s, b[3] * s, w, true); o.y = (unsigned)w;
    w = __builtin_amdgcn_cvt_pk_fp8_f32(c[0] * s, c[1] * s, 0, false); w = __builtin_amdgcn_cvt_pk_fp8_f32(c[2] * s, c[3] * s, w, true); o.z = (unsigned)w;
    w = __builtin_amdgcn_cvt_pk_fp8_f32(d[0] * s, d[1] * s, 0, false); w = __builtin_amdgcn_cvt_pk_fp8_f32(d[2] * s, d[3] * s, w, true); o.w = (unsigned)w;
    *(GAS v4u*)(dst + (size_t)row * D + 16 * lane) = o;
    if (lane == 0) sc[row] = mx > 0.f ? mx * (1.0f / 224.0f) : 1.0f;
}

__device__ __forceinline__ unsigned pack4_i8(float a, float b, float c, float d) { return ((unsigned)__float2int_rn(a) & 0xffu) | (((unsigned)__float2int_rn(b) & 0xffu) << 8) | (((unsigned)__float2int_rn(c) & 0xffu) << 16) | (((unsigned)__float2int_rn(d) & 0xffu) << 24); }
__device__ __forceinline__ void p0_row_i8(const float* src, unsigned char* dst, float* sc, int row, int lane) {
    const GAS f32x4* sp = (const GAS f32x4*)(src + (size_t)row * D + 16 * lane);
    const f32x4 a = sp[0], b = sp[1], c = sp[2], d = sp[3];
    float mx = 0.f;
#pragma unroll
    for (int i = 0; i < 4; ++i) mx = fmaxf(fmaxf(fmaxf(mx, fabsf(a[i])), fmaxf(fabsf(b[i]), fabsf(c[i]))), fabsf(d[i]));
    mx = wave_max(mx); const float s = mx > 0.f ? 127.0f / mx : 1.0f;
    v4u o; o.x = pack4_i8(a[0] * s, a[1] * s, a[2] * s, a[3] * s); o.y = pack4_i8(b[0] * s, b[1] * s, b[2] * s, b[3] * s); o.z = pack4_i8(c[0] * s, c[1] * s, c[2] * s, c[3] * s); o.w = pack4_i8(d[0] * s, d[1] * s, d[2] * s, d[3] * s);
    *(GAS v4u*)(dst + (size_t)row * D + 16 * lane) = o;
    if (lane == 0) sc[row] = mx > 0.f ? mx * (1.0f / 127.0f) : 1.0f;
}

__device__ __forceinline__ unsigned pack8_i4(const f32x4 a, const f32x4 b, float s) {
    unsigned w = 0;
#pragma unroll
    for (int i = 0; i < 4; ++i) { const int qa = max(-8, min(7, __float2int_rn(a[i] * s))), qb = max(-8, min(7, __float2int_rn(b[i] * s))); w |= ((unsigned)qa & 15u) << (4 * i); w |= ((unsigned)qb & 15u) << (16 + 4 * i); }
    return w;
}
__device__ __forceinline__ void p0_row_i4(const f32x4 a, const f32x4 b, const f32x4 c, const f32x4 d, unsigned char* dst, float* sc, int row, int lane) {
    float ss = 0.f;
#pragma unroll
    for (int i = 0; i < 4; ++i) ss += (a[i] * a[i] + b[i] * b[i]) + (c[i] * c[i] + d[i] * d[i]);
    ss = wave_sum(ss); const float sig = sqrtf(ss * (1.f / D)), s = sig > 0.f ? 3.0f / sig : 1.0f;
    v2u o; o.x = pack8_i4(a, b, s); o.y = pack8_i4(c, d, s);
    *(GAS v2u*)(dst + (size_t)(lane >> 4) * ((size_t)NEXP * 128) + (size_t)row * 128 + 8 * (lane & 15)) = o;
    if (lane == 0) sc[2 * row] = sig > 0.f ? sig * (1.0f / 3.0f) : 1.0f;
}

__device__ __forceinline__ unsigned pack8_fp4(const f32x4 a, const f32x4 b, float s) {
    unsigned w = 0;
    w = __builtin_amdgcn_cvt_scalef32_pk_fp4_f32(w, fminf(fmaxf(a[0] * s, -6.f), 6.f), fminf(fmaxf(a[1] * s, -6.f), 6.f), 1.0f, 0);
    w = __builtin_amdgcn_cvt_scalef32_pk_fp4_f32(w, fminf(fmaxf(a[2] * s, -6.f), 6.f), fminf(fmaxf(a[3] * s, -6.f), 6.f), 1.0f, 1);
    w = __builtin_amdgcn_cvt_scalef32_pk_fp4_f32(w, fminf(fmaxf(b[0] * s, -6.f), 6.f), fminf(fmaxf(b[1] * s, -6.f), 6.f), 1.0f, 2);
    w = __builtin_amdgcn_cvt_scalef32_pk_fp4_f32(w, fminf(fmaxf(b[2] * s, -6.f), 6.f), fminf(fmaxf(b[3] * s, -6.f), 6.f), 1.0f, 3);
    return w;
}
__device__ __forceinline__ void p0_row_fp4(const f32x4 a, const f32x4 b, const f32x4 c, const f32x4 d, unsigned char* dst, float* sc, int row, int lane) {
    float mx = 0.f;
#pragma unroll
    for (int i = 0; i < 4; ++i) mx = fmaxf(fmaxf(fmaxf(mx, fabsf(a[i])), fmaxf(fabsf(b[i]), fabsf(c[i]))), fabsf(d[i]));
    mx = wave_max(mx); const float s = mx > 0.f ? 7.0f / mx : 1.0f;
    v2u o; o.x = pack8_fp4(a, b, s); o.y = pack8_fp4(c, d, s);
    *(GAS v2u*)(dst + (size_t)(lane >> 4) * ((size_t)NEXP * 128) + (size_t)row * 128 + 8 * (lane & 15)) = o;
    if (lane == 0) sc[2 * row] = mx > 0.f ? mx * (1.0f / 7.0f) : 1.0f;
}
#define XB_TMO      128
#define XB_XCNT(j)  (256  + 64 * (j))
#define XB_XSUB(j)  (1280 + 64 * (j))
#define XB_XGEN(j)  (2304 + 64 * (j))
#define XB_TOP      3328
#define XB_TOPGEN   3392
#define XCD_BAR_WORDS 3456
#define XB_SPIN_CAP (1u << 18)

__device__ __forceinline__ unsigned xb_ld(unsigned* p)              { return __hip_atomic_load(p, __ATOMIC_RELAXED, __HIP_MEMORY_SCOPE_AGENT); }
__device__ __forceinline__ unsigned xb_add(unsigned* p, unsigned v) { return __hip_atomic_fetch_add(p, v, __ATOMIC_RELAXED, __HIP_MEMORY_SCOPE_AGENT); }
__device__ __forceinline__ unsigned xb_xcc_id() { return (unsigned)__builtin_amdgcn_s_getreg((3 << 11) | 20) & 0xFu; }
#define XB_SPIN(cond, bar) do { unsigned _sp = 0; while (cond) { __builtin_amdgcn_s_sleep(1); \
    if ((++_sp & 255u) == 0u) { if (xb_ld(&(bar)[XB_TMO])) break; if (_sp > XB_SPIN_CAP) { atomicAdd(&(bar)[XB_TMO], 1u); break; } } } } while (0)

struct XcdBarrier {
    unsigned* bar; unsigned x;
    volatile LAS unsigned* st;
};

__device__ __forceinline__ XcdBarrier xcd_barrier_post(unsigned* bar, volatile LAS unsigned* st) {
    XcdBarrier b; b.bar = bar; b.x = xb_xcc_id(); b.st = st;
    if (threadIdx.x == 0) (void)xb_add(&bar[XB_XCNT(b.x)], 1u);
    return b;
}
__device__ __forceinline__ void xcd_barrier_complete(unsigned* bar, unsigned x, unsigned& nloc, unsigned& nx) {
    const unsigned G = gridDim.x * gridDim.y * gridDim.z;
    unsigned sum, cnt, mine, sp = 0u;
    for (;;) {
        sum = 0u; cnt = 0u; mine = 0u;
#pragma unroll
        for (unsigned j = 0; j < 16; ++j) { const unsigned c = xb_ld(&bar[XB_XCNT(j)]); sum += c; cnt += (c > 0u) ? 1u : 0u; mine = (j == x) ? c : mine; }
        if (sum == G) break;
        __builtin_amdgcn_s_sleep(1);
        if ((++sp & 255u) == 0u) { if (xb_ld(&bar[XB_TMO])) break; if (sp > XB_SPIN_CAP) { atomicAdd(&bar[XB_TMO], 1u); break; } }
    }
    nloc = mine > 0u ? mine : 1u; nx = cnt > 0u ? cnt : 1u;
}

__device__ __forceinline__ void xcd_barrier(const XcdBarrier& b) {
    asm volatile("s_waitcnt vmcnt(0)" ::: "memory");
    __syncthreads();
    if (threadIdx.x == 0) {
        unsigned* bar = b.bar;
        __builtin_amdgcn_s_waitcnt(0);
        unsigned nloc = b.st[0], nx = b.st[1];
        if (nloc == 0u) { xcd_barrier_complete(bar, b.x, nloc, nx); b.st[0] = nloc; b.st[1] = nx; }
        const unsigned old = xb_add(&bar[XB_XSUB(b.x)], 1u);
        const unsigned gen = old / nloc;
        if (old + 1u == (gen + 1u) * nloc) {
            __builtin_amdgcn_fence(__ATOMIC_RELEASE, "agent");
            asm volatile("s_waitcnt vmcnt(0)" ::: "memory");
            const unsigned og = xb_add(&bar[XB_TOP], 1u);
            const unsigned tg = og / nx;
            if (og + 1u == (tg + 1u) * nx) xb_add(&bar[XB_TOPGEN], 1u);
            else XB_SPIN(xb_ld(&bar[XB_TOPGEN]) == tg, bar);
            __builtin_amdgcn_fence(__ATOMIC_ACQUIRE, "agent");
            xb_add(&bar[XB_XGEN(b.x)], 1u);
            asm volatile("s_waitcnt vmcnt(0)" ::: "memory");
        } else {
            XB_SPIN(xb_ld(&bar[XB_XGEN(b.x)]) == gen, bar);
            __builtin_amdgcn_fence(__ATOMIC_ACQUIRE, "agent");
            asm volatile("s_waitcnt vmcnt(0)" ::: "memory");
        }
    }
    __syncthreads();
}
struct Args { const void* in[21]; float* out; unsigned char* ws; int ph_lo, ph_hi; };
enum { I_X = 0, I_C, I_POS, I_WMOD, I_BMOD, I_GPRE1, I_GPOST1, I_WIN, I_CONVW, I_BI, I_BF, I_MNG, I_SINK, I_WOUT, I_GPRE2, I_GPOST2, I_WQ, I_K1, I_K2, I_U, I_V };

__device__ __forceinline__ int newcol(int o) {
    if (o < 640) { const int hd = o >> 6, d = o & 63; return (hd << 6) + 2 * (d & 31) + (d >> 5); }
    if (o < 1792) return o;
    if (o < 1800) return 2304 + (o - 1792);
    return o - 8;
}
template <bool REMAP>
__device__ __forceinline__ void p0_transpose_item(const float* W, int K, int N, bf16* WT, LAS float* scr, int item, int lane) {
    const int nblk = (N + 31) / 32, kb = item / nblk, nb = item % nblk, k0 = 64 * kb, n0 = 32 * nb;
    const int ncol = n0 + (lane & 31);
#pragma unroll 8
    for (int i = 0; i < 32; ++i) { const int kk = 2 * i + (lane >> 5); scr[kk * 33 + (lane & 31)] = (ncol < N) ? W[(size_t)(k0 + kk) * N + ncol] : 0.f; }
    LDS_WAIT(); asm volatile("" ::: "memory");
    const int c = lane & 7;
#pragma unroll
    for (int j = 0; j < 4; ++j) { const int n = (lane >> 3) + 8 * j; const LAS float* s = scr + (8 * c) * 33 + n;
        v4u o; o.x = pk2(s[0 * 33], s[1 * 33]); o.y = pk2(s[2 * 33], s[3 * 33]); o.z = pk2(s[4 * 33], s[5 * 33]); o.w = pk2(s[6 * 33], s[7 * 33]);
        if (n0 + n < N) { const int drow = REMAP ? newcol(n0 + n) : (n0 + n); *(GAS v4u*)(WT + (size_t)drow * K + k0 + 8 * c) = o; } }
    LDS_WAIT(); asm volatile("" ::: "memory");
}
__device__ __forceinline__ void p0_convert(const float* src, bf16* dst, size_t n, int gt, int ngt) {
    for (size_t i = (size_t)gt * 8; i < n; i += (size_t)ngt * 8) {
        const f32x4 a = *(const GAS f32x4*)(src + i), b = *(const GAS f32x4*)(src + i + 4);
        v4u o; o.x = pk2(a[0], a[1]); o.y = pk2(a[2], a[3]); o.z = pk2(b[0], b[1]); o.w = pk2(b[2], b[3]);
        *(GAS v4u*)(dst + i) = o; }
}
__device__ __forceinline__ void phase_mod(const Args& A, LAS unsigned char* lds) {
    const int tid = threadIdx.x, G = gridDim.x, blk = blockIdx.x;
    unsigned char* ws = A.ws;
    const float* c = (const float*)A.in[I_C]; const float* wm = (const float*)A.in[I_WMOD]; const float* bm = (const float*)A.in[I_BMOD];
    float* mod = (float*)(ws + WS_MOD); LAS float* cs = (LAS float*)lds; LAS float* red = cs + 8 * 1024;
    for (int e = tid; e < 8 * 1024 / 4; e += NTHR) *(LAS f32x4*)(cs + 4 * e) = *(const GAS f32x4*)(c + 4 * e);
    __syncthreads();
    for (int it = blk; it < 6144 / 24; it += G) {
        const int kg = tid >> 5, col = tid & 31, j = it * 24 + (col < 24 ? col : 23); float acc[8];
#pragma unroll
        for (int b = 0; b < 8; ++b) acc[b] = 0.f;
#pragma unroll 16
        for (int i = 0; i < 64; ++i) { const int k = kg + 16 * i; const float w = wm[(size_t)k * 6144 + j];
#pragma unroll
            for (int b = 0; b < 8; ++b) acc[b] += cs[b * 1024 + k] * w; }
#pragma unroll
        for (int b = 0; b < 8; ++b) red[(kg * 32 + col) * 8 + b] = acc[b];
        __syncthreads();
        if (tid < 256) { const int b = tid >> 5, cc = tid & 31; float s = 0.f;
#pragma unroll
            for (int g = 0; g < 16; ++g) s += red[(g * 32 + cc) * 8 + b];
            if (cc < 24) mod[b * 6144 + it * 24 + cc] = s + bm[it * 24 + cc]; }
        __syncthreads();
    }
}
__device__ __forceinline__ void phase_convert(const Args& A, LAS unsigned char* lds) {
    const int tid = threadIdx.x, lane = tid & 63, wave = tid >> 6, G = gridDim.x, blk = blockIdx.x;
    unsigned char* ws = A.ws;
    {
        LAS float* scr = (LAS float*)(lds + wave * 16384);
        const int gw = blk * NWAVES + wave, NGW = G * NWAVES;
        const int I_IN = (D / 64) * ((DIN + 31) / 32), I_OUT = (D / 64) * (D / 32), I_Q = (D / 64) * (2048 / 32);
        bf16* win = (bf16*)(ws + WS_WIN); bf16* wout = (bf16*)(ws + WS_WOUT); bf16* wq = (bf16*)(ws + WS_WQ);
        for (int it = gw; it < I_IN + I_OUT + I_Q; it += NGW) {
            int r = it;
            if (r < I_IN) { p0_transpose_item<true>((const float*)A.in[I_WIN], D, DIN, win, scr, r, lane); continue; } r -= I_IN;
            if (r < I_OUT) { p0_transpose_item<false>((const float*)A.in[I_WOUT], D, D, wout, scr, r, lane); continue; } r -= I_OUT;
            p0_transpose_item<false>((const float*)A.in[I_WQ], D, 2048, wq, scr, r, lane);
        }
        const int gt = blk * NTHR + tid, ngt = G * NTHR;
        for (int i = gt; i < (NIN_PAD - DIN) * D / 8; i += ngt) *(GAS v4u*)(win + (size_t)DIN * D + (size_t)i * 8) = (v4u){0u, 0u, 0u, 0u};
        p0_convert((const float*)A.in[I_K1], (bf16*)(ws + WS_KEYS), (size_t)8 * 128 * 128, gt, ngt);
        p0_convert((const float*)A.in[I_K2], (bf16*)(ws + WS_KEYS) + 8 * 128 * 128, (size_t)8 * 128 * 128, gt, ngt);
        {
            const float* usrc = (const float*)A.in[I_U]; const float* vsrc = (const float*)A.in[I_V];
            {
                auto rowp = [&](int r) { return (const GAS f32x4*)(usrc + (size_t)r * D + 16 * lane); };
                int r = gw; const GAS f32x4* sp = rowp(min(r, NEXP - 1)); f32x4 a = sp[0], b = sp[1], c = sp[2], d = sp[3];
                for (; r < NEXP; r += NGW) { const GAS f32x4* sn = rowp(min(r + NGW, NEXP - 1)); const f32x4 an = sn[0], bn = sn[1], cn = sn[2], dn = sn[3];
                    p0_row_i4(a, b, c, d, ws + WS_U8, (float*)(ws + WS_SC), r, lane);
                    a = an; b = bn; c = cn; d = dn; }
            }
            {
                auto ldv = [&](int r, f32x4& a, f32x4& b, f32x4& c, f32x4& d) { const float* sp = vsrc + (size_t)r * D + (lane >> 4) * 256 + (lane & 15);
#pragma unroll
                    for (int i = 0; i < 4; ++i) { a[i] = sp[16 * i]; b[i] = sp[16 * (4 + i)]; c[i] = sp[16 * (8 + i)]; d[i] = sp[16 * (12 + i)]; } };
                int r = gw; f32x4 a, b, c, d; ldv(min(r, NEXP - 1), a, b, c, d);
                for (; r < NEXP; r += NGW) { f32x4 an, bn, cn, dn; ldv(min(r + NGW, NEXP - 1), an, bn, cn, dn);
                    p0_row_fp4(a, b, c, d, ws + WS_V8, (float*)(ws + WS_SC) + 1, r, lane);
                    a = an; b = bn; c = cn; d = dn; }
            }
        }
    }
}

__device__ __forceinline__ void phase_prenorm(const Args& A, LAS unsigned char* lds) {
    const int tid = threadIdx.x, lane = tid & 63, wave = tid >> 6, G = gridDim.x;
    const float* x = (const float*)A.in[I_X]; const float* g = (const float*)A.in[I_GPRE1]; const float* mod = (const float*)(A.ws + WS_MOD);
    bf16* H = (bf16*)(A.ws + WS_H); float* gates = (float*)(A.ws + WS_GATES);
    LAS float* wg = (LAS float*)lds;
    __syncthreads();
    for (int k = tid; k < D; k += NTHR) { const float* wr = (const float*)A.in[I_WIN] + (size_t)k * DIN + 1792; const f32x4 w0 = *(const GAS f32x4*)wr, w1 = *(const GAS f32x4*)(wr + 4);
#pragma unroll
        for (int j = 0; j < 4; ++j) { wg[j * D + k] = w0[j]; wg[(4 + j) * D + k] = w1[j]; } }
    __syncthreads();
    const int gi = ((lane >> 5) & 1) * 4 + ((lane >> 4) & 1) * 2 + ((lane >> 3) & 1);
    const float gbias = gi < 4 ? ((const float*)A.in[I_BI])[gi] : ((const float*)A.in[I_BF])[gi - 4];
    f32x4 gg[4];
#pragma unroll
    for (int j = 0; j < 4; ++j) gg[j] = *(const GAS f32x4*)(g + 4 * (lane + 64 * j));
    const int stride = G * NWAVES; int row = blockIdx.x * NWAVES + wave;
    f32x4 v[4], vn[4], shv[4], gsv[4]; int bcur = -1;
#pragma unroll
    for (int j = 0; j < 4; ++j) v[j] = ((const GAS f32x4*)(x + (size_t)row * D) + lane)[64 * j];
    for (; row < M; row += stride) {
        const int rn = min(row + stride, M - 1);
#pragma unroll
        for (int j = 0; j < 4; ++j) vn[j] = ((const GAS f32x4*)(x + (size_t)rn * D) + lane)[64 * j];
        const int b = row / SEQ; float s = 0.f;
        if (b != bcur) { bcur = b;
#pragma unroll
            for (int j = 0; j < 4; ++j) { const int k = 4 * (lane + 64 * j); shv[j] = *(const GAS f32x4*)(mod + b * 6144 + k); const f32x4 sc = *(const GAS f32x4*)(mod + b * 6144 + 1024 + k);
#pragma unroll
                for (int i = 0; i < 4; ++i) gsv[j][i] = gg[j][i] * (1.f + sc[i]); } }
#pragma unroll
        for (int j = 0; j < 4; ++j) s += (v[j][0] * v[j][0] + v[j][1] * v[j][1]) + (v[j][2] * v[j][2] + v[j][3] * v[j][3]);
        const float rstd = __builtin_amdgcn_rsqf(wave_sum(s) * (1.f / D) + EPS);
        GAS v2u* o = (GAS v2u*)(H + (size_t)row * D) + lane;
        float gd[8];
#pragma unroll
        for (int q = 0; q < 8; ++q) gd[q] = 0.f;
#pragma unroll
        for (int j = 0; j < 4; ++j) {
            f32x4 y;
#pragma unroll
            for (int i = 0; i < 4; ++i) y[i] = v[j][i] * rstd * gsv[j][i] + shv[j][i];
            v2u w; w.x = pk2(y[0], y[1]); w.y = pk2(y[2], y[3]); o[64 * j] = w;
#pragma unroll
            for (int q = 0; q < 8; ++q) { const f32x4 ww = *(LAS const f32x4*)(wg + q * D + 4 * (lane + 64 * j)); gd[q] += (y[0] * ww[0] + y[1] * ww[1]) + (y[2] * ww[2] + y[3] * ww[3]); } }
#pragma unroll
        for (int i = 0; i < 4; ++i) { const bool up = (lane & 32) != 0; const float keep = up ? gd[i + 4] : gd[i], send = up ? gd[i] : gd[i + 4]; gd[i] = keep + __shfl_xor(send, 32); }
#pragma unroll
        for (int i = 0; i < 2; ++i) { const bool up = (lane & 16) != 0; const float keep = up ? gd[i + 2] : gd[i], send = up ? gd[i] : gd[i + 2]; gd[i] = keep + __shfl_xor(send, 16); }
        { const bool up = (lane & 8) != 0; const float keep = up ? gd[1] : gd[0], send = up ? gd[0] : gd[1]; gd[0] = keep + __shfl_xor(send, 8); }
        float gv = gd[0]; gv += __shfl_xor(gv, 4); gv += __shfl_xor(gv, 2); gv += __shfl_xor(gv, 1); gv += gbias;
        if ((lane & 7) == 0) gates[(size_t)row * 8 + gi] = gi < 4 ? gv : (fminf(gv, 0.f) - __logf(1.f + __expf(-fabsf(gv))));
#pragma unroll
        for (int j = 0; j < 4; ++j) v[j] = vn[j];
    }
}

__device__ __forceinline__ void phase_mid(const Args& A) {
    const int tid = threadIdx.x, lane = tid & 63, wave = tid >> 6, G = gridDim.x;
    const float* x = (const float*)A.in[I_X]; const float* gpost = (const float*)A.in[I_GPOST1]; const float* gpre = (const float*)A.in[I_GPRE2];
    const float* mod = (const float*)(A.ws + WS_MOD); const float* sumsq = (const float*)(A.ws + WS_SSQ);
    const bf16* MIX = (const bf16*)(A.ws + WS_MIX); bf16* H = (bf16*)(A.ws + WS_H); bf16* X1 = (bf16*)(A.ws + WS_X1);
    const int stride = G * NWAVES; int row = blockIdx.x * NWAVES + wave;
    f32x4 xv[4], xn[4], q[4], qn[4], g1p[4], gs2[4], sh2[4]; v2u mw[4], mn[4]; int bcur = -1;
#pragma unroll
    for (int j = 0; j < 4; ++j) { xv[j] = ((const GAS f32x4*)(x + (size_t)row * D) + lane)[64 * j]; mw[j] = ((const GAS v2u*)(MIX + (size_t)row * D) + lane)[64 * j]; q[j] = *(const GAS f32x4*)(sumsq + (size_t)row * 16 + 4 * j); }
    for (; row < M; row += stride) {
        const int rn = min(row + stride, M - 1);
#pragma unroll
        for (int j = 0; j < 4; ++j) { xn[j] = ((const GAS f32x4*)(x + (size_t)rn * D) + lane)[64 * j]; mn[j] = ((const GAS v2u*)(MIX + (size_t)rn * D) + lane)[64 * j]; qn[j] = *(const GAS f32x4*)(sumsq + (size_t)rn * 16 + 4 * j); }
        const int b = row / SEQ;
        if (b != bcur) { bcur = b;
#pragma unroll
            for (int j = 0; j < 4; ++j) { const int k = 4 * (lane + 64 * j); const f32x4 gp = *(const GAS f32x4*)(gpost + k), g1 = *(const GAS f32x4*)(mod + b * 6144 + 2048 + k), gg = *(const GAS f32x4*)(gpre + k), sc = *(const GAS f32x4*)(mod + b * 6144 + 4096 + k);
                sh2[j] = *(const GAS f32x4*)(mod + b * 6144 + 3072 + k);
#pragma unroll
                for (int i = 0; i < 4; ++i) { g1p[j][i] = g1[i] * gp[i]; gs2[j][i] = gg[i] * (1.f + sc[i]); } } }
        const float rm = __builtin_amdgcn_rsqf(((((q[0][0] + q[0][1]) + (q[0][2] + q[0][3])) + ((q[1][0] + q[1][1]) + (q[1][2] + q[1][3]))) + (((q[2][0] + q[2][1]) + (q[2][2] + q[2][3])) + ((q[3][0] + q[3][1]) + (q[3][2] + q[3][3])))) * (1.f / D) + EPS);
        f32x4 v[4]; float s = 0.f;
#pragma unroll
        for (int j = 0; j < 4; ++j) {
            const float mx[4] = {bflo(mw[j].x), bfhi(mw[j].x), bflo(mw[j].y), bfhi(mw[j].y)};
#pragma unroll
            for (int i = 0; i < 4; ++i) { v[j][i] = xv[j][i] + g1p[j][i] * (mx[i] * rm); s += v[j][i] * v[j][i]; }
            { v2u w; w.x = pk2(v[j][0], v[j][1]); w.y = pk2(v[j][2], v[j][3]); *((GAS v2u*)(X1 + (size_t)row * D) + lane + 64 * j) = w; } }
        const float rstd = __builtin_amdgcn_rsqf(wave_sum(s) * (1.f / D) + EPS);
        GAS v2u* o = (GAS v2u*)(H + (size_t)row * D) + lane; float amx = 0.f;
#pragma unroll
        for (int j = 0; j < 4; ++j) {
#pragma unroll
            for (int i = 0; i < 4; ++i) { v[j][i] = v[j][i] * rstd * gs2[j][i] + sh2[j][i]; amx = fmaxf(amx, fabsf(v[j][i])); }
            v2u w; w.x = pk2(v[j][0], v[j][1]); w.y = pk2(v[j][2], v[j][3]); o[64 * j] = w; }
        amx = wave_max(amx); const float s8 = amx > 0.f ? 119.0f * __builtin_amdgcn_rcpf(amx) : 1.0f;
        GAS unsigned short* ohh = (GAS unsigned short*)((unsigned char*)A.ws + WS_H8 + (size_t)row * (D / 2)) + lane; GAS unsigned short* ohl = (GAS unsigned short*)((unsigned char*)A.ws + WS_H8 + 32 * MiB + (size_t)row * (D / 2)) + lane;
#pragma unroll
        for (int j = 0; j < 4; ++j) { unsigned whh = 0, whl = 0;
#pragma unroll
            for (int i = 0; i < 4; ++i) { const int tq = __float2int_rn(v[j][i] * s8) + 8; whh |= ((unsigned)(tq >> 4) & 15u) << (4 * i); whl |= ((unsigned)((tq & 15) - 8) & 15u) << (4 * i); }
            ohh[64 * j] = (unsigned short)whh; ohl[64 * j] = (unsigned short)whl; }
        if (lane == 0) ((float*)(A.ws + WS_HS))[row] = amx > 0.f ? amx * (1.0f / 119.0f) : 1.0f;
#pragma unroll
        for (int j = 0; j < 4; ++j) { xv[j] = xn[j]; mw[j] = mn[j]; q[j] = qn[j]; }
    }
}
__device__ __forceinline__ void load64bf(const bf16* p, float (&o)[64]) {
#pragma unroll
    for (int i = 0; i < 8; ++i) { const v4u w = *(const GAS v4u*)(p + 8 * i);
        o[8 * i + 0] = bflo(w.x); o[8 * i + 1] = bfhi(w.x); o[8 * i + 2] = bflo(w.y); o[8 * i + 3] = bfhi(w.y);
        o[8 * i + 4] = bflo(w.z); o[8 * i + 5] = bfhi(w.z); o[8 * i + 6] = bflo(w.w); o[8 * i + 7] = bfhi(w.w); }
}
__device__ __forceinline__ void phase_attn_naive(const Args& A, int vb, int nvb) {
    const bf16* P = (const bf16*)(A.ws + WS_PROJ); bf16* MI = (bf16*)(A.ws + WS_MIXIN); const float* sinks = (const float*)A.in[I_SINK];
    for (int task = vb * NTHR + (int)threadIdx.x; task < 8 * M; task += nvb * NTHR) {
        const int h = task / M, t = task % M, s = t % SEQ, kvh = h >> 2;
        float q[64], o[64];
        load64bf(P + (size_t)t * NPROJ + C_AQ + h * 64, q);
#pragma unroll
        for (int d = 0; d < 64; ++d) o[d] = 0.f;
        float mx = sinks[h], l = 1.f;
        for (int j = 0; j < 128; ++j) {
            const int sj = s - 127 + j; const bool valid = sj >= 0; const int tk = valid ? (t - 127 + j) : t;
            const bf16* kr = P + (size_t)tk * NPROJ + C_AK + kvh * 64; float sc = 0.f;
#pragma unroll
            for (int i = 0; i < 8; ++i) { const v4u w = *(const GAS v4u*)(kr + 8 * i);
                sc += q[8 * i + 0] * bflo(w.x) + q[8 * i + 1] * bfhi(w.x) + q[8 * i + 2] * bflo(w.y) + q[8 * i + 3] * bfhi(w.y)
                    + q[8 * i + 4] * bflo(w.z) + q[8 * i + 5] * bfhi(w.z) + q[8 * i + 6] * bflo(w.w) + q[8 * i + 7] * bfhi(w.w); }
            if (valid) {
                const float mn = fmaxf(mx, sc), al = __expf(mx - mn), p = __expf(sc - mn); mx = mn; l = l * al + p;
                const bf16* vr = P + (size_t)tk * NPROJ + C_AV + kvh * 64;
#pragma unroll
                for (int i = 0; i < 8; ++i) { const v4u w = *(const GAS v4u*)(vr + 8 * i);
                    o[8 * i + 0] = o[8 * i + 0] * al + p * bflo(w.x); o[8 * i + 1] = o[8 * i + 1] * al + p * bfhi(w.x);
                    o[8 * i + 2] = o[8 * i + 2] * al + p * bflo(w.y); o[8 * i + 3] = o[8 * i + 3] * al + p * bfhi(w.y);
                    o[8 * i + 4] = o[8 * i + 4] * al + p * bflo(w.z); o[8 * i + 5] = o[8 * i + 5] * al + p * bfhi(w.z);
                    o[8 * i + 6] = o[8 * i + 6] * al + p * bflo(w.w); o[8 * i + 7] = o[8 * i + 7] * al + p * bfhi(w.w); }
            }
        }
        const float il = 1.f / l; bf16* orow = MI + (size_t)t * D + h * 64;
#pragma unroll
        for (int i = 0; i < 8; ++i) { v4u w; w.x = pk2(o[8 * i] * il, o[8 * i + 1] * il); w.y = pk2(o[8 * i + 2] * il, o[8 * i + 3] * il);
            w.z = pk2(o[8 * i + 4] * il, o[8 * i + 5] * il); w.w = pk2(o[8 * i + 6] * il, o[8 * i + 7] * il); *(GAS v4u*)(orow + 8 * i) = w; }
    }
}

__device__ __forceinline__ void phase_mlstm_naive(const Args& A, LAS unsigned char* lds, int bh) {
    const int tid = threadIdx.x, lane = tid & 63, wave = tid >> 6, b = bh >> 2, h = bh & 3, dv = tid >> 2, part = tid & 3;
    const bf16* P = (const bf16*)(A.ws + WS_PROJ); bf16* MI = (bf16*)(A.ws + WS_MIXIN); const float* gates = (const float*)(A.ws + WS_GATES);
    const float* cw = (const float*)A.in[I_CONVW]; const float* ng = (const float*)A.in[I_MNG];
    LAS float* qs = (LAS float*)lds; LAS float* ks = qs + 64 * 64; LAS float* vs = ks + 64 * 64; LAS float* ig = vs + 64 * 128; LAS float* lfg = ig + 64; LAS float* hb = lfg + 64;
    float C[16], n[16]; float m = 0.f;
#pragma unroll
    for (int j = 0; j < 16; ++j) { C[j] = 0.f; n[j] = 0.f; }
    for (int ch = 0; ch < SEQ / 64; ++ch) {
        const int s0 = ch * 64; const size_t t0 = (size_t)b * SEQ + s0;
        for (int e = tid; e < 64 * 64; e += NTHR) { const int l = e >> 6, dk = e & 63; float aq = 0.f, ak = 0.f;
#pragma unroll
            for (int j = 0; j < 4; ++j) { const int sj = s0 + l - 3 + j; if (sj >= 0) { const bf16* r = P + ((size_t)b * SEQ + sj) * NPROJ;
                aq += cw[j * 512 + h * 64 + dk] * bf1(r[C_MQ + h * 64 + dk]); ak += cw[j * 512 + 256 + h * 64 + dk] * bf1(r[C_MK + h * 64 + dk]); } }
            qs[e] = 0.125f * aq / (1.f + __expf(-aq)); ks[e] = ak / (1.f + __expf(-ak)); }
        for (int e = tid; e < 64 * 128; e += NTHR) { const int l = e >> 7, d = e & 127; vs[e] = bf1(P[(t0 + l) * NPROJ + C_MV + h * 128 + d]); }
        if (tid < 64) { ig[tid] = gates[(t0 + tid) * 8 + h]; lfg[tid] = gates[(t0 + tid) * 8 + 4 + h]; }
        __syncthreads();
        for (int l = 0; l < 64; ++l) {
            const float lf = lfg[l], ii = ig[l], mn = fmaxf(lf + m, ii), fd = __expf(lf + m - mn), iw = __expf(ii - mn), vv = vs[l * 128 + dv] * iw;
            float num = 0.f, den = 0.f;
#pragma unroll
            for (int j = 0; j < 16; ++j) { const float kk = ks[l * 64 + part * 16 + j], qq = qs[l * 64 + part * 16 + j];
                C[j] = fd * C[j] + vv * kk; n[j] = fd * n[j] + iw * kk; num += C[j] * qq; den += n[j] * qq; }
            num += __shfl_xor(num, 1); num += __shfl_xor(num, 2); den += __shfl_xor(den, 1); den += __shfl_xor(den, 2);
            if (part == 0) hb[l * 128 + dv] = num / fmaxf(fabsf(den), __expf(-mn));
            m = mn;
        }
        __syncthreads();
        for (int l = wave * 8; l < wave * 8 + 8; ++l) { const float a0 = hb[l * 128 + lane], a1 = hb[l * 128 + 64 + lane];
            const float r = 1.0f / sqrtf(wave_sum(a0 * a0 + a1 * a1) * (1.f / 128.f) + EPS);
            const bf16* pr = P + (t0 + l) * NPROJ + C_MO + h * 128; bf16* orow = MI + (t0 + l) * D + 512 + h * 128;
            orow[lane] = (bf16)f2bf(a0 * r * ng[h * 128 + lane] * bf1(pr[lane])); orow[64 + lane] = (bf16)f2bf(a1 * r * ng[h * 128 + 64 + lane] * bf1(pr[64 + lane])); }
        __syncthreads();
    }
}

__device__ __forceinline__ void ld16bf(const bf16* p, float (&o)[16]) {
    const v4u w0 = *(const GAS v4u*)p, w1 = *(const GAS v4u*)(p + 8);
    o[0] = bflo(w0.x); o[1] = bfhi(w0.x); o[2] = bflo(w0.y); o[3] = bfhi(w0.y); o[4] = bflo(w0.z); o[5] = bfhi(w0.z); o[6] = bflo(w0.w); o[7] = bfhi(w0.w);
    o[8] = bflo(w1.x); o[9] = bfhi(w1.x); o[10] = bflo(w1.y); o[11] = bfhi(w1.y); o[12] = bflo(w1.z); o[13] = bfhi(w1.z); o[14] = bflo(w1.w); o[15] = bfhi(w1.w);
}
typedef short bf16x8 __attribute__((ext_vector_type(8)));
#define MFMA16(a, b, c) __builtin_amdgcn_mfma_f32_16x16x32_bf16((a), (b), (c), 0, 0, 0)
__device__ __forceinline__ bf16x8 ldfrag(LAS const unsigned char* img, int row, int kbyte) { return *(LAS const bf16x8*)(img + row * 144 + kbyte); }
__device__ __forceinline__ bf16x8 ldfrag_sw(LAS const unsigned char* img, int row, int kbyte) { return *(LAS const bf16x8*)(img + row * 144 + (kbyte ^ (((row >> 3) & 7) << 4))); }
__device__ __forceinline__ unsigned cvtpk(float lo, float hi) { unsigned r; asm volatile("v_cvt_pk_bf16_f32 %0, %1, %2" : "=v"(r) : "v"(lo), "v"(hi)); return r; }

namespace ml {
constexpr int O_Q = 0, O_QA = 9216, O_K = 18432, O_KWT = 27648, O_VT = 36864, O_CX = 57600, CXB = 20736, O_S = 99072, O_GB = 108288, O_GA = O_GB + 4096, O_GC = O_GA + 4096, O_DEN = O_GC + 4096, O_SSQ = O_DEN + 256, O_END = O_SSQ + 2048;
static_assert(O_END <= 131072, "mlstm LDS");
constexpr size_t MST_SC = 11 * MiB;
}
template <bool OUT>
__device__ __forceinline__ void mlstm_group(const Args& A, LAS unsigned char* lds, int wg) {
    using namespace ml;
    const int tid = threadIdx.x, lane = tid & 63, wave = __builtin_amdgcn_readfirstlane(tid >> 6), fr = lane & 15, fq = lane >> 4;
    const int bh = wg >> 3, grp = wg & 7, b = bh >> 2, h = bh & 3;
    const size_t tg0 = (size_t)b * SEQ + (size_t)grp * 1024;
    const bf16* P = (const bf16*)(A.ws + WS_PROJ); bf16* MI = (bf16*)(A.ws + WS_MIXIN); const float* gates = (const float*)(A.ws + WS_GATES);
    const float* cw = (const float*)A.in[I_CONVW]; const float* ng = (const float*)A.in[I_MNG];
    float* MST = (float*)(A.ws + WS_MST); float* MSC = (float*)(A.ws + WS_MST + MST_SC);
    LAS float* GB = (LAS float*)(lds + O_GB); LAS float* GA = (LAS float*)(lds + O_GA); LAS float* GC = (LAS float*)(lds + O_GC);
    LAS float* DEN = (LAS float*)(lds + O_DEN); LAS float* SSQ = (LAS float*)(lds + O_SSQ);
    __syncthreads();
#pragma unroll
    for (int cc = 0; cc < 2; ++cc) { const int c = 2 * wave + cc; const size_t t = tg0 + c * 64 + lane;
        float bc = gates[t * 8 + 4 + h]; const float ii = gates[t * 8 + h];
#pragma unroll
        for (int o = 1; o < 64; o <<= 1) { const float v = __shfl_up(bc, o); if (lane >= o) bc += v; }
        const float a = ii - bc; float cm = a;
#pragma unroll
        for (int o = 1; o < 64; o <<= 1) { const float v = __shfl_up(cm, o); if (lane >= o) cm = fmaxf(cm, v); }
        GB[c * 64 + lane] = bc; GA[c * 64 + lane] = a; GC[c * 64 + lane] = cm; }
    for (int e = tid; e < 16 * 32; e += NTHR) { const int r = e >> 5, cpair = e & 31; *(LAS unsigned*)(lds + O_VT + (128 + r) * 144 + cpair * 4) = (r == 0) ? 0x3F803F80u : 0u; }
    f32x4 st[5];
#pragma unroll
    for (int i = 0; i < 5; ++i) st[i] = (f32x4){0.f, 0.f, 0.f, 0.f};
    float m = OUT ? 0.f : -__builtin_inff(); float Btot = 0.f;
    if (OUT) {
        for (int gp = 0; gp < grp; ++gp) { const int wgp = bh * 8 + gp; const float mg = MSC[wgp * 2], Bg = MSC[wgp * 2 + 1];
            const float mn = fmaxf(Bg + m, mg), f0 = __expf(Bg + m - mn), f1 = __expf(mg - mn);
#pragma unroll
            for (int i = 0; i < 5; ++i)
#pragma unroll
                for (int r = 0; r < 4; ++r) st[i][r] = f0 * st[i][r] + f1 * MST[((size_t)wgp * 20 + i * 4 + r) * NTHR + tid];
            m = mn; }
#pragma unroll
        for (int j = 0; j < 4; ++j)
#pragma unroll
            for (int r = 0; r < 4; ++r) *(LAS bf16*)(lds + O_CX + (16 * wave + 4 * fq + r) * 144 + (16 * j + fr) * 2) = (bf16)f2bf(st[j][r]);
        if (wave < 4) {
#pragma unroll
            for (int r = 0; r < 4; ++r) *(LAS bf16*)(lds + O_CX + (128 + 4 * fq + r) * 144 + (16 * wave + fr) * 2) = (bf16)f2bf(st[4][r]); }
    }
    float gsc[4];
#pragma unroll
    for (int r = 0; r < 4; ++r) gsc[r] = ng[h * 128 + 16 * wave + 4 * fq + r];
    const int sl = tid >> 3, cg = tid & 7;
    v4u pk[4], pvv[2]; f32x4 kw0[4], kw1[4];
    auto ld_rows = [&](int c) { const int sabs = grp * 1024 + c * 64 + sl;
#pragma unroll
        for (int j = 0; j < 4; ++j) { const int sj = max(sabs - 3 + j, 0); pk[j] = *(const GAS v4u*)(P + ((size_t)b * SEQ + sj) * NPROJ + C_MK + h * 64 + 8 * cg); }
#pragma unroll
        for (int gi = 0; gi < 2; ++gi) pvv[gi] = *(const GAS v4u*)(P + (tg0 + (size_t)c * 64 + sl) * NPROJ + C_MV + h * 128 + 8 * (cg + 8 * gi)); };
    if (!OUT) {
#pragma unroll
        for (int j = 0; j < 4; ++j) { kw0[j] = *(const GAS f32x4*)(cw + j * 512 + 256 + h * 64 + 8 * cg); kw1[j] = *(const GAS f32x4*)(cw + j * 512 + 256 + h * 64 + 8 * cg + 4); }
        ld_rows(0); }
    __syncthreads();
    for (int c = 0; c < 16; ++c) {
        const float bL = GB[c * 64 + 63], M63 = fmaxf(m, GC[c * 64 + 63]), decay = __expf(m - M63);
        const size_t tc0 = tg0 + (size_t)c * 64;
        if (!OUT) {
            const int sabs = grp * 1024 + c * 64 + sl; float ak[8];
#pragma unroll
            for (int i = 0; i < 8; ++i) ak[i] = 0.f;
#pragma unroll
            for (int j = 0; j < 4; ++j) { const float on = (sabs - 3 + j >= 0) ? 1.0f : 0.0f; const v4u wk = pk[j]; const f32x4 k0 = kw0[j] * on, k1 = kw1[j] * on;
                ak[0] += k0[0] * bflo(wk.x); ak[1] += k0[1] * bfhi(wk.x); ak[2] += k0[2] * bflo(wk.y); ak[3] += k0[3] * bfhi(wk.y);
                ak[4] += k1[0] * bflo(wk.z); ak[5] += k1[1] * bfhi(wk.z); ak[6] += k1[2] * bflo(wk.w); ak[7] += k1[3] * bfhi(wk.w); }
            const v4u wv0 = pvv[0], wv1 = pvv[1];
            if (c + 1 < 16) ld_rows(c + 1);
            const float wsv = __expf(GA[c * 64 + sl] - M63);
#pragma unroll
            for (int i = 0; i < 8; ++i) { const float kvv = ak[i] * __builtin_amdgcn_rcpf(1.f + __expf(-ak[i])); *(LAS bf16*)(lds + O_KWT + (8 * cg + i) * 144 + (sl ^ (8 * cg)) * 2) = (bf16)f2bf(kvv * wsv); }
#pragma unroll
            for (int gi = 0; gi < 2; ++gi) { const int g8 = cg + 8 * gi; const v4u wv = gi ? wv1 : wv0; const unsigned ww[4] = {wv.x, wv.y, wv.z, wv.w};
#pragma unroll
                for (int i = 0; i < 4; ++i) { *(LAS bf16*)(lds + O_VT + (8 * g8 + 2 * i) * 144 + (sl ^ (8 * cg)) * 2) = (bf16)(ww[i] & 0xffffu); *(LAS bf16*)(lds + O_VT + (8 * g8 + 2 * i + 1) * 144 + (sl ^ (8 * cg)) * 2) = (bf16)(ww[i] >> 16); } }
        } else {
            const int sabs = grp * 1024 + c * 64 + sl;
            float aq[8], ak[8];
#pragma unroll
            for (int i = 0; i < 8; ++i) { aq[i] = 0.f; ak[i] = 0.f; }
#pragma unroll
            for (int j = 0; j < 4; ++j) { const int sj = sabs - 3 + j;
                if (sj >= 0) { const bf16* rp = P + ((size_t)b * SEQ + sj) * NPROJ;
                    const v4u wq = *(const GAS v4u*)(rp + C_MQ + h * 64 + 8 * cg), wk = *(const GAS v4u*)(rp + C_MK + h * 64 + 8 * cg);
                    const f32x4 q0 = *(const GAS f32x4*)(cw + j * 512 + h * 64 + 8 * cg), q1 = *(const GAS f32x4*)(cw + j * 512 + h * 64 + 8 * cg + 4);
                    const f32x4 k0 = *(const GAS f32x4*)(cw + j * 512 + 256 + h * 64 + 8 * cg), k1 = *(const GAS f32x4*)(cw + j * 512 + 256 + h * 64 + 8 * cg + 4);
                    aq[0] += q0[0] * bflo(wq.x); aq[1] += q0[1] * bfhi(wq.x); aq[2] += q0[2] * bflo(wq.y); aq[3] += q0[3] * bfhi(wq.y);
                    aq[4] += q1[0] * bflo(wq.z); aq[5] += q1[1] * bfhi(wq.z); aq[6] += q1[2] * bflo(wq.w); aq[7] += q1[3] * bfhi(wq.w);
                    ak[0] += k0[0] * bflo(wk.x); ak[1] += k0[1] * bfhi(wk.x); ak[2] += k0[2] * bflo(wk.y); ak[3] += k0[3] * bfhi(wk.y);
                    ak[4] += k1[0] * bflo(wk.z); ak[5] += k1[1] * bfhi(wk.z); ak[6] += k1[2] * bflo(wk.w); ak[7] += k1[3] * bfhi(wk.w); } }
            const float Ml = fmaxf(m, GC[c * 64 + sl]), ainter = __expf(m - Ml), wsv = __expf(GA[c * 64 + sl] - M63);
            float qv[8], kv[8];
#pragma unroll
            for (int i = 0; i < 8; ++i) { qv[i] = 0.125f * aq[i] * __builtin_amdgcn_rcpf(1.f + __expf(-aq[i])); kv[i] = ak[i] * __builtin_amdgcn_rcpf(1.f + __expf(-ak[i])); }
            if (OUT) {
                v4u w; w.x = pk2(qv[0], qv[1]); w.y = pk2(qv[2], qv[3]); w.z = pk2(qv[4], qv[5]); w.w = pk2(qv[6], qv[7]); *(LAS v4u*)(lds + O_Q + sl * 144 + cg * 16) = w;
                w.x = pk2(qv[0] * ainter, qv[1] * ainter); w.y = pk2(qv[2] * ainter, qv[3] * ainter); w.z = pk2(qv[4] * ainter, qv[5] * ainter); w.w = pk2(qv[6] * ainter, qv[7] * ainter); *(LAS v4u*)(lds + O_QA + sl * 144 + cg * 16) = w;
                w.x = pk2(kv[0], kv[1]); w.y = pk2(kv[2], kv[3]); w.z = pk2(kv[4], kv[5]); w.w = pk2(kv[6], kv[7]); *(LAS v4u*)(lds + O_K + sl * 144 + cg * 16) = w;
            }
#pragma unroll
            for (int i = 0; i < 8; ++i) *(LAS bf16*)(lds + O_KWT + (8 * cg + i) * 144 + (sl ^ (8 * cg)) * 2) = (bf16)f2bf(kv[i] * wsv);
#pragma unroll
            for (int gi = 0; gi < 2; ++gi) { const int g8 = cg + 8 * gi; const v4u wv = *(const GAS v4u*)(P + (tc0 + sl) * NPROJ + C_MV + h * 128 + 8 * g8);
                const unsigned ww[4] = {wv.x, wv.y, wv.z, wv.w};
#pragma unroll
                for (int i = 0; i < 4; ++i) { *(LAS bf16*)(lds + O_VT + (8 * g8 + 2 * i) * 144 + (sl ^ (8 * cg)) * 2) = (bf16)(ww[i] & 0xffffu); *(LAS bf16*)(lds + O_VT + (8 * g8 + 2 * i + 1) * 144 + (sl ^ (8 * cg)) * 2) = (bf16)(ww[i] >> 16); } }
        }
        __syncthreads();
        v2u mo[4];
        if (OUT) {
#pragma unroll
            for (int lt = 0; lt < 4; ++lt) mo[lt] = *(const GAS v2u*)(P + (tc0 + 16 * lt + fr) * NPROJ + C_MO + h * 128 + 16 * wave + 4 * fq); }
        if (OUT) {
            const int lt = wave >> 1, l = 16 * lt + fr; const float Ml = fmaxf(m, GC[c * 64 + l]);
            const bf16x8 bq0 = ldfrag(lds + O_Q, 16 * lt + fr, 16 * fq), bq1 = ldfrag(lds + O_Q, 16 * lt + fr, 64 + 16 * fq);
#pragma unroll
            for (int u = 0; u < 2; ++u) { const int stl = 2 * (wave & 1) + u; f32x4 acc = {0.f, 0.f, 0.f, 0.f};
                acc = MFMA16(ldfrag(lds + O_K, 16 * stl + fr, 16 * fq), bq0, acc); acc = MFMA16(ldfrag(lds + O_K, 16 * stl + fr, 64 + 16 * fq), bq1, acc);
                const f32x4 av = *(LAS const f32x4*)(GA + c * 64 + 16 * stl + 4 * fq); float wv[4];
#pragma unroll
                for (int r = 0; r < 4; ++r) { const int s = 16 * stl + 4 * fq + r; wv[r] = (s <= l) ? acc[r] * __expf(av[r] - Ml) : 0.f; }
                v2u w; w.x = cvtpk(wv[0], wv[1]); w.y = cvtpk(wv[2], wv[3]); *(LAS v2u*)(lds + O_S + l * 144 + (16 * stl + 4 * fq) * 2) = w; }
        }
        {
            const bf16x8 va0 = ldfrag_sw(lds + O_VT, 16 * wave + fr, 16 * fq), va1 = ldfrag_sw(lds + O_VT, 16 * wave + fr, 64 + 16 * fq);
#pragma unroll
            for (int j = 0; j < 4; ++j) { st[j] = st[j] * decay;
                st[j] = MFMA16(va0, ldfrag_sw(lds + O_KWT, 16 * j + fr, 16 * fq), st[j]); st[j] = MFMA16(va1, ldfrag_sw(lds + O_KWT, 16 * j + fr, 64 + 16 * fq), st[j]); }
            if (wave < 4) { st[4] = st[4] * decay;
                st[4] = MFMA16(ldfrag_sw(lds + O_VT, 128 + fr, 16 * fq), ldfrag_sw(lds + O_KWT, 16 * wave + fr, 16 * fq), st[4]);
                st[4] = MFMA16(ldfrag_sw(lds + O_VT, 128 + fr, 64 + 16 * fq), ldfrag_sw(lds + O_KWT, 16 * wave + fr, 64 + 16 * fq), st[4]); }
        }
        if (OUT) {
            __syncthreads();
            LAS const unsigned char* cx = lds + O_CX + (c & 1) * CXB;
            f32x4 nt[4], nd = {0.f, 0.f, 0.f, 0.f};
            {
                const bf16x8 va0 = ldfrag_sw(lds + O_VT, 16 * wave + fr, 16 * fq), va1 = ldfrag_sw(lds + O_VT, 16 * wave + fr, 64 + 16 * fq);
                const bf16x8 ca0 = ldfrag(cx, 16 * wave + fr, 16 * fq), ca1 = ldfrag(cx, 16 * wave + fr, 64 + 16 * fq);
#pragma unroll
                for (int lt = 0; lt < 4; ++lt) { f32x4 acc = {0.f, 0.f, 0.f, 0.f};
                    acc = MFMA16(va0, ldfrag(lds + O_S, 16 * lt + fr, 16 * fq), acc); acc = MFMA16(va1, ldfrag(lds + O_S, 16 * lt + fr, 64 + 16 * fq), acc);
                    acc = MFMA16(ca0, ldfrag(lds + O_QA, 16 * lt + fr, 16 * fq), acc); acc = MFMA16(ca1, ldfrag(lds + O_QA, 16 * lt + fr, 64 + 16 * fq), acc); nt[lt] = acc; }
                if (wave >= 4) { const int lt = wave - 4;
                    nd = MFMA16(ldfrag_sw(lds + O_VT, 128 + fr, 16 * fq), ldfrag(lds + O_S, 16 * lt + fr, 16 * fq), nd); nd = MFMA16(ldfrag_sw(lds + O_VT, 128 + fr, 64 + 16 * fq), ldfrag(lds + O_S, 16 * lt + fr, 64 + 16 * fq), nd);
                    nd = MFMA16(ldfrag(cx, 128 + fr, 16 * fq), ldfrag(lds + O_QA, 16 * lt + fr, 16 * fq), nd); nd = MFMA16(ldfrag(cx, 128 + fr, 64 + 16 * fq), ldfrag(lds + O_QA, 16 * lt + fr, 64 + 16 * fq), nd);
                    if (fq == 0) DEN[16 * lt + fr] = nd[0]; }
            }
#pragma unroll
            for (int lt = 0; lt < 4; ++lt) { float ss = (nt[lt][0] * nt[lt][0] + nt[lt][1] * nt[lt][1]) + (nt[lt][2] * nt[lt][2] + nt[lt][3] * nt[lt][3]);
                ss += __shfl_xor(ss, 16); ss += __shfl_xor(ss, 32);
                if (fq == 0) SSQ[wave * 64 + 16 * lt + fr] = ss; }
            __syncthreads();
            LAS unsigned char* cxn = lds + O_CX + ((c + 1) & 1) * CXB;
#pragma unroll
            for (int j = 0; j < 4; ++j)
#pragma unroll
                for (int r = 0; r < 4; ++r) *(LAS bf16*)(cxn + (16 * wave + 4 * fq + r) * 144 + (16 * j + fr) * 2) = (bf16)f2bf(st[j][r]);
            if (wave < 4) {
#pragma unroll
                for (int r = 0; r < 4; ++r) *(LAS bf16*)(cxn + (128 + 4 * fq + r) * 144 + (16 * wave + fr) * 2) = (bf16)f2bf(st[4][r]); }
#pragma unroll
            for (int lt = 0; lt < 4; ++lt) { const int l = 16 * lt + fr; float tot = 0.f; const float Ml = fmaxf(m, GC[c * 64 + l]);
                const float inv = __builtin_amdgcn_rcpf(fmaxf(fabsf(DEN[l]), __expf(-(GB[c * 64 + l] + Ml))));
#pragma unroll
                for (int w2 = 0; w2 < 8; ++w2) tot += SSQ[w2 * 64 + l];
                const float rn = inv * __builtin_amdgcn_rsqf(tot * (inv * inv) * (1.f / 128.f) + EPS);
                const float o0 = nt[lt][0] * rn * gsc[0] * bflo(mo[lt].x), o1 = nt[lt][1] * rn * gsc[1] * bfhi(mo[lt].x), o2 = nt[lt][2] * rn * gsc[2] * bflo(mo[lt].y), o3 = nt[lt][3] * rn * gsc[3] * bfhi(mo[lt].y);
                v2u w; w.x = pk2(o0, o1); w.y = pk2(o2, o3);
                *(GAS v2u*)(MI + (tc0 + l) * D + 512 + h * 128 + 16 * wave + 4 * fq) = w; }
        } else {
            __syncthreads();
        }
        m = bL + M63; Btot += bL;
    }
    if (!OUT) {
#pragma unroll
        for (int i = 0; i < 5; ++i)
#pragma unroll
            for (int r = 0; r < 4; ++r) MST[((size_t)wg * 20 + i * 4 + r) * NTHR + tid] = st[i][r];
        if (tid == 0) { MSC[wg * 2] = m; MSC[wg * 2 + 1] = Btot; }
    }
}

namespace at {
constexpr int O_K = 0, O_VT = 36864, VTS = 592  , O_END = O_VT + 64 * VTS;
static_assert(O_END <= 131072, "attention LDS");
}
__device__ __forceinline__ void phase_attn(const Args& A, LAS unsigned char* lds) {
    using namespace at;
    const int tid = threadIdx.x, lane = tid & 63, wave = __builtin_amdgcn_readfirstlane(tid >> 6), fr = lane & 15, fq = lane >> 4, G = gridDim.x;
    const bf16* P = (const bf16*)(A.ws + WS_PROJ); bf16* MI = (bf16*)(A.ws + WS_MIXIN); const float* sinks = (const float*)A.in[I_SINK];
    __syncthreads();
    for (int e = tid; e < 64 * 16; e += NTHR) { const int r = e >> 4, cpair = e & 15; *(LAS unsigned*)(lds + O_VT + r * VTS + 512 + cpair * 4) = 0u; }
    v4u pk_[4], pv_[4];
#define ATT_LOAD(uu) do { const int g_ = (uu) & 1, n_ = ((uu) >> 1) & 63, b_ = (uu) >> 7; const size_t tq_ = (size_t)b_ * SEQ + (size_t)n_ * 128; _Pragma("unroll") for (int i_ = 0; i_ < 4; ++i_) { const int item_ = tid + NTHR * i_, row_ = item_ >> 3, ch_ = item_ & 7; \
        pk_[i_] = (v4u){0u, 0u, 0u, 0u}; pv_[i_] = (v4u){0u, 0u, 0u, 0u}; if (n_ > 0 || row_ >= 128) { const bf16* rp_ = P + (tq_ - 128 + row_) * NPROJ; pk_[i_] = *(const GAS v4u*)(rp_ + C_AK + g_ * 64 + 8 * ch_); pv_[i_] = *(const GAS v4u*)(rp_ + C_AV + g_ * 64 + 8 * ch_); } } } while (0)
    bf16x8 bqa, bqb;
#define ATT_LOADQ(uu, qt_) do { const int g_ = (uu) & 1, n_ = ((uu) >> 1) & 63, b_ = (uu) >> 7; const size_t tq_ = (size_t)b_ * SEQ + (size_t)n_ * 128; \
        const bf16* qp_ = P + (tq_ + 64 * (wave & 1) + 16 * (qt_) + fr) * NPROJ + C_AQ + (4 * g_ + (wave >> 1)) * 64 + 8 * fq; bqa = *(const GAS bf16x8*)qp_; bqb = *(const GAS bf16x8*)(qp_ + 32); } while (0)
    if ((int)blockIdx.x < NB * 64 * 2) { ATT_LOAD((int)blockIdx.x); ATT_LOADQ((int)blockIdx.x, 0); }
    for (int unit = blockIdx.x; unit < NB * 64 * 2; unit += G) {
        const int g = unit & 1, n = (unit >> 1) & 63, b = unit >> 7;
        const size_t tq0 = (size_t)b * SEQ + (size_t)n * 128;
        __syncthreads();
#pragma unroll
        for (int i = 0; i < 4; ++i) { const int item = tid + NTHR * i, row = item >> 3, ch = item & 7;
            const v4u wk = pk_[i], wv = pv_[i];
            *(LAS v4u*)(lds + O_K + row * 144 + ch * 16) = wk;
            const unsigned ww[4] = {wv.x, wv.y, wv.z, wv.w};
#pragma unroll
            for (int k = 0; k < 4; ++k) { *(LAS bf16*)(lds + O_VT + (8 * ch + 2 * k) * VTS + (row ^ (4 * ch)) * 2) = (bf16)(ww[k] & 0xffffu); *(LAS bf16*)(lds + O_VT + (8 * ch + 2 * k + 1) * VTS + (row ^ (4 * ch)) * 2) = (bf16)(ww[k] >> 16); } }
        if (unit + G < NB * 64 * 2) ATT_LOAD(unit + G);
        const int hq = 4 * g + (wave >> 1), qr0 = 64 * (wave & 1); const float sink = sinks[hq];
        __syncthreads();
        for (int qt = 0; qt < 4; ++qt) {
            const int i0 = qr0 + 16 * qt, st0 = i0 >> 4, iq = i0 + fr;
            const bf16x8 bq0 = bqa, bq1 = bqb;
            { const int un = (qt < 3) ? unit : min(unit + (int)G, NB * 64 * 2 - 1), qn = (qt < 3) ? qt + 1 : 0; ATT_LOADQ(un, qn); }
            f32x4 sc[9]; float mx = sink;
#pragma unroll
            for (int t = 0; t < 9; ++t) { const int sb0 = 16 * (st0 + t); f32x4 acc = {0.f, 0.f, 0.f, 0.f};
                acc = MFMA16(ldfrag(lds + O_K, sb0 + fr, 16 * fq), bq0, acc); acc = MFMA16(ldfrag(lds + O_K, sb0 + fr, 64 + 16 * fq), bq1, acc);
                if (t == 0) {
#pragma unroll
                    for (int r = 0; r < 4; ++r) acc[r] = (4 * fq + r > fr) ? acc[r] : -3.0e38f; }
                if (t == 8) {
#pragma unroll
                    for (int r = 0; r < 4; ++r) acc[r] = (4 * fq + r <= fr) ? acc[r] : -3.0e38f; }
                if (n == 0) {
#pragma unroll
                    for (int r = 0; r < 4; ++r) acc[r] = (sb0 + 4 * fq + r >= 128) ? acc[r] : -3.0e38f; }
#pragma unroll
                for (int r = 0; r < 4; ++r) mx = fmaxf(mx, acc[r]);
                sc[t] = acc; }
            mx = fmaxf(mx, __shfl_xor(mx, 16)); mx = fmaxf(mx, __shfl_xor(mx, 32));
            float lsum = 0.f;
#pragma unroll
            for (int t = 0; t < 9; ++t)
#pragma unroll
                for (int r = 0; r < 4; ++r) { const float p = __expf(sc[t][r] - mx); sc[t][r] = p; lsum += p; }
            lsum += __shfl_xor(lsum, 16); lsum += __shfl_xor(lsum, 32); lsum += __expf(sink - mx);
            f32x4 oacc[4];
#pragma unroll
            for (int dt = 0; dt < 4; ++dt) oacc[dt] = (f32x4){0.f, 0.f, 0.f, 0.f};
#pragma unroll
            for (int ks = 0; ks < 5; ++ks) {
                union { bf16x8 v; unsigned u[4]; } pb;
                pb.u[0] = cvtpk(sc[2 * ks][0], sc[2 * ks][1]); pb.u[1] = cvtpk(sc[2 * ks][2], sc[2 * ks][3]);
                if (ks < 4) { pb.u[2] = cvtpk(sc[2 * ks + 1][0], sc[2 * ks + 1][1]); pb.u[3] = cvtpk(sc[2 * ks + 1][2], sc[2 * ks + 1][3]); } else { pb.u[2] = 0u; pb.u[3] = 0u; }
                const int sbb = 16 * (st0 + 2 * ks) + 4 * fq;
#pragma unroll
                for (int dt = 0; dt < 4; ++dt) { const int dd = 16 * dt + fr, sx = 4 * ((dd >> 3) & 7); LAS const unsigned char* vrow = lds + O_VT + dd * VTS;
                    union { bf16x8 v; v2u h[2]; } va; va.h[0] = *(LAS const v2u*)(vrow + (sbb ^ sx) * 2); va.h[1] = *(LAS const v2u*)(vrow + ((sbb + 16) ^ sx) * 2);
                    oacc[dt] = MFMA16(va.v, pb.v, oacc[dt]); } }
            const float il = __builtin_amdgcn_rcpf(lsum);
#pragma unroll
            for (int dt = 0; dt < 4; ++dt) { v2u w; w.x = cvtpk(oacc[dt][0] * il, oacc[dt][1] * il); w.y = cvtpk(oacc[dt][2] * il, oacc[dt][3] * il);
                *(GAS v2u*)(MI + (tq0 + iq) * D + hq * 64 + 16 * dt + 4 * fq) = w; }
        }
    }
#undef ATT_LOAD
#undef ATT_LOADQ
}
typedef float f32x16 __attribute__((ext_vector_type(16)));
__device__ __forceinline__ unsigned fbits(float f) { return __builtin_bit_cast(unsigned, f); }
__device__ __forceinline__ float bfloat(unsigned u) { return __builtin_bit_cast(float, u); }

#define CE_DESC(a, b) do { const float _mx = __builtin_fmaxf(a, b), _mn = __builtin_fminf(a, b); a = _mx; b = _mn; } while (0)
namespace sn16 { constexpr int NC = 63; constexpr unsigned char CA[NC] = {0, 2, 0, 1, 1, 4, 6, 4, 5, 5, 0, 2, 2, 1, 3, 3, 1, 3, 5, 8, 10, 8, 9, 9, 12, 14, 12, 13, 13, 8, 10, 10, 9, 11, 11, 9, 11, 13, 0, 4, 4, 2, 6, 6, 2, 6, 10, 1, 5, 5, 3, 7, 7, 3, 7, 11, 1, 3, 5, 7, 9, 11, 13}; constexpr unsigned char CB[NC] = {1, 3, 2, 3, 2, 5, 7, 6, 7, 6, 4, 6, 4, 5, 7, 5, 2, 4, 6, 9, 11, 10, 11, 10, 13, 15, 14, 15, 14, 12, 14, 12, 13, 15, 13, 10, 12, 14, 8, 12, 8, 10, 14, 10, 4, 8, 12, 9, 13, 9, 11, 15, 11, 5, 9, 13, 2, 4, 6, 8, 10, 12, 14}; }
__device__ __forceinline__ void bsort16(float (&v)[16]) {
#pragma unroll
    for (int c = 0; c < sn16::NC; ++c) CE_DESC(v[sn16::CA[c]], v[sn16::CB[c]]);
}
__device__ __forceinline__ void bmerge16(float (&v)[16], const float (&w)[16]) {
#pragma unroll
    for (int i = 0; i < 16; ++i) v[i] = __builtin_fmaxf(v[i], w[15 - i]);
#pragma unroll
    for (int j = 8; j > 0; j >>= 1)
#pragma unroll
        for (int i = 0; i < 16; ++i) { const int l = i ^ j; if (l > i) CE_DESC(v[i], v[l]); }
}
namespace tk {
constexpr int KS = 272;
constexpr int O_K1 = 0, O_K2 = 128 * KS, O_X = 2 * 128 * KS, O_END = O_X + 8 * 4096;
static_assert(O_END <= 131072, "topk LDS");
constexpr unsigned char CAND[64] = {
    0x00, 0x01, 0x02, 0x03, 0x04, 0x05, 0x06, 0x07, 0x08, 0x09, 0x0a, 0x0b, 0x0c, 0x0d, 0x0e, 0x0f,
    0x10, 0x11, 0x12, 0x13, 0x14, 0x15, 0x16, 0x17, 0x80, 0x90, 0xa0, 0xb0, 0xc0, 0xd0, 0xe0, 0xf0,
    0x20, 0x21, 0x22, 0x23, 0x24, 0x30, 0x31, 0x32, 0x33, 0x40, 0x41, 0x42, 0x50, 0x51, 0x60, 0x61,
    0x70, 0x71, 0xff, 0xff, 0xff, 0xff, 0xff, 0xff, 0xff, 0xff, 0xff, 0xff, 0xff, 0xff, 0xff, 0xff};
}
__device__ __forceinline__ void side_top16(const f32x16 (&acc)[4], int hh, float (&T)[16]) {
    float g1[16], g2[16];
#pragma unroll
    for (int r = 0; r < 16; ++r) { const unsigned key = (r & 3) + 8 * (r >> 2) + 4 * hh;
        T[r] = bfloat((fbits(acc[0][r]) & 0xffffff80u) | key);
        g1[r] = bfloat((fbits(acc[1][r]) & 0xffffff80u) | (32u + key)); }
    bsort16(T); bsort16(g1); bmerge16(T, g1);
#pragma unroll
    for (int r = 0; r < 16; ++r) { const unsigned key = (r & 3) + 8 * (r >> 2) + 4 * hh;
        g1[r] = bfloat((fbits(acc[2][r]) & 0xffffff80u) | (64u + key));
        g2[r] = bfloat((fbits(acc[3][r]) & 0xffffff80u) | (96u + key)); }
    bsort16(g1); bsort16(g2); bmerge16(g1, g2); bmerge16(T, g1);
#pragma unroll
    for (int r = 0; r < 16; ++r) g1[r] = __shfl_xor(T[r], 32);
    bmerge16(T, g1);
}
struct TopkQ { bf16x8 f[8]; };
template <int SD> __device__ __forceinline__ void topk_ldq(const bf16* Q, int t, int h, int hh, TopkQ& q) {
    const bf16* qp = Q + (size_t)t * 2048 + h * 256 + SD * 128 + 8 * hh;
#pragma unroll
    for (int ks = 0; ks < 8; ++ks) q.f[ks] = *(const GAS bf16x8*)(qp + 16 * ks);
}
template <int SD> __device__ __forceinline__ void topk_scores(const TopkQ& q, LAS unsigned char* lds, int r32, int hh, f32x16 (&acc)[4]) {
    using namespace tk;
#pragma unroll
    for (int mt = 0; mt < 4; ++mt)
#pragma unroll
        for (int r = 0; r < 16; ++r) acc[mt][r] = 0.f;
    LAS const unsigned char* kimg = lds + (SD ? O_K2 : O_K1);
#pragma unroll
    for (int ks = 0; ks < 8; ++ks) {
#pragma unroll
        for (int mt = 0; mt < 4; ++mt) acc[mt] = __builtin_amdgcn_mfma_f32_32x32x16_bf16(*(LAS const bf16x8*)(kimg + (32 * mt + r32) * KS + 32 * ks + 16 * hh), q.f[ks], acc[mt], 0, 0, 0); }
}
template <int Q> __device__ __forceinline__ float cand_val(const float (&T1)[16], const float (&T2)[16], int hh) {
    constexpr unsigned c0 = tk::CAND[2 * Q], c1 = tk::CAND[2 * Q + 1];
    const float s = (hh ? T1[(c1 >> 4) & 15] : T1[(c0 >> 4) & 15]) + (hh ? T2[c1 & 15] : T2[c0 & 15]); const unsigned code = hh ? c1 : c0;
    return (code == 0xffu) ? -3.0e38f : bfloat((fbits(s) & 0xffffff00u) | code);
}
__device__ __forceinline__ void phase_topk(const Args& A, LAS unsigned char* lds) {
    using namespace tk;
    const int tid = threadIdx.x, lane = tid & 63, wave = __builtin_amdgcn_readfirstlane(tid >> 6), G = gridDim.x;
    const bf16* Q = (const bf16*)(A.ws + WS_PROJ); const bf16* KB = (const bf16*)(A.ws + WS_KEYS);
    unsigned short* EI = (unsigned short*)(A.ws + WS_EIDX); bf16* GT = (bf16*)(A.ws + WS_GATE);
    const int h = blockIdx.x & 7, r32 = lane & 31, hh = lane >> 5;
    __syncthreads();
    for (int e = tid; e < 2 * 128 * 16; e += NTHR) { const int s = e >> 11, row = (e >> 4) & 127, ch = e & 15;
        *(LAS v4u*)(lds + (s ? O_K2 : O_K1) + row * KS + ch * 16) = *(const GAS v4u*)(KB + (size_t)s * 8 * 128 * 128 + ((size_t)h * 128 + row) * 128 + ch * 8); }
    __syncthreads();
    LAS float* XW = (LAS float*)(lds + O_X + wave * 4096) + r32 * 32;
    TopkQ qf; topk_ldq<0>(Q, (int)(blockIdx.x >> 3) * 256 + 32 * wave + r32, h, hh, qf);
    for (int tile = (int)(blockIdx.x >> 3); tile < M / 256; tile += (G >> 3)) {
        const int t = tile * 256 + 32 * wave + r32;
        float T1[16], T2[16];
        { f32x16 acc[4]; topk_scores<0>(qf, lds, r32, hh, acc);
          topk_ldq<1>(Q, t, h, hh, qf);
          side_top16(acc, hh, T1); }
        { f32x16 acc[4]; topk_scores<1>(qf, lds, r32, hh, acc);
          const int tn = min(tile + (int)(G >> 3), M / 256 - 1) * 256 + 32 * wave + r32; topk_ldq<0>(Q, tn, h, hh, qf);
          side_top16(acc, hh, T2); }
        float c[16], w[16];
        c[0] = cand_val<0>(T1, T2, hh); w[0] = cand_val<16>(T1, T2, hh);
        c[1] = cand_val<1>(T1, T2, hh); w[1] = cand_val<17>(T1, T2, hh);
        c[2] = cand_val<2>(T1, T2, hh); w[2] = cand_val<18>(T1, T2, hh);
        c[3] = cand_val<3>(T1, T2, hh); w[3] = cand_val<19>(T1, T2, hh);
        c[4] = cand_val<4>(T1, T2, hh); w[4] = cand_val<20>(T1, T2, hh);
        c[5] = cand_val<5>(T1, T2, hh); w[5] = cand_val<21>(T1, T2, hh);
        c[6] = cand_val<6>(T1, T2, hh); w[6] = cand_val<22>(T1, T2, hh);
        c[7] = cand_val<7>(T1, T2, hh); w[7] = cand_val<23>(T1, T2, hh);
        c[8] = cand_val<8>(T1, T2, hh); w[8] = cand_val<24>(T1, T2, hh);
        c[9] = cand_val<9>(T1, T2, hh); w[9] = cand_val<25>(T1, T2, hh);
        c[10] = cand_val<10>(T1, T2, hh); w[10] = cand_val<26>(T1, T2, hh);
        c[11] = cand_val<11>(T1, T2, hh); w[11] = cand_val<27>(T1, T2, hh);
        c[12] = cand_val<12>(T1, T2, hh); w[12] = cand_val<28>(T1, T2, hh);
        c[13] = cand_val<13>(T1, T2, hh); w[13] = cand_val<29>(T1, T2, hh);
        c[14] = cand_val<14>(T1, T2, hh); w[14] = cand_val<30>(T1, T2, hh);
        c[15] = cand_val<15>(T1, T2, hh); w[15] = cand_val<31>(T1, T2, hh);
        bsort16(c); bsort16(w); bmerge16(c, w);
#pragma unroll
        for (int r = 0; r < 16; ++r) w[r] = __shfl_xor(c[r], 32);
        bmerge16(c, w);
        if (hh == 0) {
#pragma unroll
            for (int q4 = 0; q4 < 4; ++q4) { *(LAS f32x4*)(XW + 4 * q4) = (f32x4){T1[4 * q4], T1[4 * q4 + 1], T1[4 * q4 + 2], T1[4 * q4 + 3]};
                *(LAS f32x4*)(XW + 16 + 4 * q4) = (f32x4){T2[4 * q4], T2[4 * q4 + 1], T2[4 * q4 + 2], T2[4 * q4 + 3]}; } }
        asm volatile("s_waitcnt lgkmcnt(0)" ::: "memory");
        float ex[16], sum = 0.f; const float tmax = bfloat(fbits(c[0]) & 0xffffff00u);
#pragma unroll
        for (int r = 0; r < 16; ++r) { ex[r] = __expf(bfloat(fbits(c[r]) & 0xffffff00u) - tmax); sum += ex[r]; }
        const float isum = __builtin_amdgcn_rcpf(sum); const size_t ob = (size_t)t * NSLOT + (size_t)h * 16 + 8 * hh;
        unsigned eo[8], go[8];
#pragma unroll
        for (int r = 0; r < 8; ++r) { float ca = c[r], cb = c[8 + r], ea = ex[r], eb = ex[8 + r]; asm volatile("" : "+v"(ca), "+v"(cb), "+v"(ea), "+v"(eb)); const float cv = hh ? cb : ca, ev = hh ? eb : ea;
            const unsigned code = fbits(cv) & 0xffu;
            const unsigned i1 = fbits(XW[code >> 4]) & 127u, i2 = fbits(XW[16 + (code & 15)]) & 127u;
            eo[r] = i1 * 128u + i2; go[r] = f2bf(ev * isum); }
        *(GAS v4u*)(EI + ob) = (v4u){eo[0] | (eo[1] << 16), eo[2] | (eo[3] << 16), eo[4] | (eo[5] << 16), eo[6] | (eo[7] << 16)};
        *(GAS v4u*)(GT + ob) = (v4u){go[0] | (go[1] << 16), go[2] | (go[3] << 16), go[4] | (go[5] << 16), go[6] | (go[7] << 16)};
        asm volatile("s_waitcnt lgkmcnt(0)" ::: "memory");
    }
}
struct PeerIdx { v4u e0, e1; };
__device__ __forceinline__ PeerIdx peer_ld_idx(const unsigned short* EI, int t, int g) { PeerIdx r; r.e0 = *(const GAS v4u*)(EI + (size_t)t * NSLOT + 16 * g); r.e1 = *(const GAS v4u*)(EI + (size_t)t * NSLOT + 16 * g + 8); return r; }
template <int ROWB = 1024> __device__ __forceinline__ void peer_gather(const unsigned char* T8, const PeerIdx& ix, int colb, v4u (&raw)[16]) {
    const unsigned ew[8] = {ix.e0.x, ix.e0.y, ix.e0.z, ix.e0.w, ix.e1.x, ix.e1.y, ix.e1.z, ix.e1.w};
#pragma unroll
    for (int k = 0; k < 16; ++k) { const unsigned e = (k & 1) ? (ew[k >> 1] >> 16) : (ew[k >> 1] & 0xffffu); raw[k] = *(const GAS v4u*)(T8 + (size_t)e * ROWB + colb); }
}
__device__ __forceinline__ void cvt16_fp8_pk(const v4u w, f32x2 (&o)[8]) {
    const unsigned ww[4] = {w.x, w.y, w.z, w.w};
#pragma unroll
    for (int i = 0; i < 4; ++i) { o[2 * i] = __builtin_amdgcn_cvt_pk_f32_fp8((int)ww[i], false); o[2 * i + 1] = __builtin_amdgcn_cvt_pk_f32_fp8((int)ww[i], true); }
}
__device__ __forceinline__ void peer_u_reduce(const v4u (&raw)[16], const f32x2 (&hv)[8], float* PDrow, int lane, int g, int c) {
    float d[16];
#pragma unroll
    for (int k = 0; k < 16; ++k) { f32x2 uf[8]; cvt16_fp8_pk(raw[k], uf); f32x2 s = uf[0] * hv[0];
#pragma unroll
        for (int i = 1; i < 8; ++i) s += uf[i] * hv[i];
        d[k] = s.x + s.y; }
#pragma unroll
    for (int i = 0; i < 8; ++i) { const bool up = (lane & 4) != 0; const float keep = up ? d[i + 8] : d[i], send = up ? d[i] : d[i + 8]; d[i] = keep + __shfl_xor(send, 4); }
#pragma unroll
    for (int i = 0; i < 4; ++i) { const bool up = (lane & 2) != 0; const float keep = up ? d[i + 4] : d[i], send = up ? d[i] : d[i + 4]; d[i] = keep + __shfl_xor(send, 2); }
#pragma unroll
    for (int i = 0; i < 2; ++i) { const bool up = (lane & 1) != 0; const float keep = up ? d[i + 2] : d[i], send = up ? d[i] : d[i + 2]; d[i] = keep + __shfl_xor(send, 1); }
    *(GAS f32x2*)(PDrow + 16 * g + 2 * c) = (f32x2){d[0], d[1]};
}
__device__ __forceinline__ void ld16bf_pk(const bf16* p, f32x2 (&o)[8]) {
    const v4u w0 = *(const GAS v4u*)p, w1 = *(const GAS v4u*)(p + 8); const unsigned ww[8] = {w0.x, w0.y, w0.z, w0.w, w1.x, w1.y, w1.z, w1.w};
#pragma unroll
    for (int i = 0; i < 8; ++i) o[i] = (f32x2){bflo(ww[i]), bfhi(ww[i])};
}
__device__ __forceinline__ void peer_u_reduce_i4(const v4u (&raw)[16], const v4u hh, const v4u hl, bf16* PDrow, int lane, int g, int c) {
    int d[16];
#pragma unroll
    for (int k = 0; k < 16; ++k) { int sh = __builtin_amdgcn_sdot8((int)raw[k].x, (int)hh.x, 0, false), sl = __builtin_amdgcn_sdot8((int)raw[k].x, (int)hl.x, 0, false);
        sh = __builtin_amdgcn_sdot8((int)raw[k].y, (int)hh.y, sh, false); sl = __builtin_amdgcn_sdot8((int)raw[k].y, (int)hl.y, sl, false);
        sh = __builtin_amdgcn_sdot8((int)raw[k].z, (int)hh.z, sh, false); sl = __builtin_amdgcn_sdot8((int)raw[k].z, (int)hl.z, sl, false);
        sh = __builtin_amdgcn_sdot8((int)raw[k].w, (int)hh.w, sh, false); sl = __builtin_amdgcn_sdot8((int)raw[k].w, (int)hl.w, sl, false);
        d[k] = 16 * sh + sl; }
#pragma unroll
    for (int i = 0; i < 8; ++i) { const bool up = (lane & 4) != 0; const int keep = up ? d[i + 8] : d[i], send = up ? d[i] : d[i + 8]; d[i] = keep + __shfl_xor(send, 4); }
#pragma unroll
    for (int i = 0; i < 4; ++i) { const bool up = (lane & 2) != 0; const int keep = up ? d[i + 4] : d[i], send = up ? d[i] : d[i + 4]; d[i] = keep + __shfl_xor(send, 2); }
#pragma unroll
    for (int i = 0; i < 2; ++i) { const bool up = (lane & 1) != 0; const int keep = up ? d[i + 2] : d[i], send = up ? d[i] : d[i + 2]; d[i] = keep + __shfl_xor(send, 1); }
    __builtin_nontemporal_store(pk2((float)d[0], (float)d[1]), (GAS unsigned*)(PDrow + 16 * g + 2 * c));
}
__device__ __forceinline__ void phase_peer_u(const Args& A) {
    const int tid = threadIdx.x, lane = tid & 63, wave = tid >> 6, p = blockIdx.x & 7, q = p & 3, half = p >> 2, j = blockIdx.x >> 3, nj = gridDim.x >> 3, g = lane >> 3, c = lane & 7;
    const unsigned char* HH = (const unsigned char*)(A.ws + WS_H8); const unsigned char* HL = HH + 32 * MiB; const unsigned char* U4 = (const unsigned char*)(A.ws + WS_U8); const unsigned short* EI = (const unsigned short*)(A.ws + WS_EIDX);
    bf16* PD = (bf16*)(A.ws + WS_PD) + (size_t)q * M * NSLOT;
    const unsigned char* U4q = U4 + (size_t)q * ((size_t)NEXP * 128); const int colu = 16 * c;
    const int tper = (M / 2) / nj, colb = 128 * q + 16 * c, tbeg = half * (M / 2) + j * tper, tend = tbeg + tper, tlast = tend - NWAVES + wave;
    int t = tbeg + wave;
    PeerIdx ix1 = peer_ld_idx(EI, min(t + NWAVES, tlast), g), ix2 = peer_ld_idx(EI, min(t + 2 * NWAVES, tlast), g);
    v4u rawa[16], rawb[16], hha, hla, hhb, hlb;
    { const PeerIdx ix0 = peer_ld_idx(EI, t, g); peer_gather<128>(U4q, ix0, colu, rawa); hha = *(const GAS v4u*)(HH + (size_t)t * 512 + colb); hla = *(const GAS v4u*)(HL + (size_t)t * 512 + colb); }
    for (; t < tend; t += 2 * NWAVES) {
        const int t1 = t + NWAVES, t2 = min(t + 2 * NWAVES, tlast), t3 = min(t + 3 * NWAVES, tlast), t4 = min(t + 4 * NWAVES, tlast);
        const PeerIdx ix3 = peer_ld_idx(EI, t3, g);
        peer_gather<128>(U4q, ix1, colu, rawb); hhb = *(const GAS v4u*)(HH + (size_t)t1 * 512 + colb); hlb = *(const GAS v4u*)(HL + (size_t)t1 * 512 + colb);
        peer_u_reduce_i4(rawa, hha, hla, PD + (size_t)t * NSLOT, lane, g, c);
        const PeerIdx ix4 = peer_ld_idx(EI, t4, g);
        peer_gather<128>(U4q, ix2, colu, rawa); hha = *(const GAS v4u*)(HH + (size_t)t2 * 512 + colb); hla = *(const GAS v4u*)(HL + (size_t)t2 * 512 + colb);
        peer_u_reduce_i4(rawb, hhb, hlb, PD + (size_t)t1 * NSLOT, lane, g, c);
        ix1 = ix3; ix2 = ix4;
    }
}
__device__ __forceinline__ void phase_peer_act(const Args& A) {
    const bf16* PD = (const bf16*)(A.ws + WS_PD); const unsigned short* EI = (const unsigned short*)(A.ws + WS_EIDX); const bf16* GT = (const bf16*)(A.ws + WS_GATE);
    const float* usc = (const float*)(A.ws + WS_SC); const float* hs = (const float*)(A.ws + WS_HS);
    unsigned char* W8 = (unsigned char*)(A.ws + WS_W8); float* WSC = (float*)(A.ws + WS_WSC);
    typedef int i32x4 __attribute__((ext_vector_type(4)));
    for (size_t i = ((size_t)blockIdx.x * NTHR + threadIdx.x) * 4; i < (size_t)M * NSLOT; i += (size_t)gridDim.x * NTHR * 4) {
        const v2u p0 = *(const GAS v2u*)(PD + i), p1 = *(const GAS v2u*)(PD + (size_t)M * NSLOT + i), p2 = *(const GAS v2u*)(PD + (size_t)2 * M * NSLOT + i), p3 = *(const GAS v2u*)(PD + (size_t)3 * M * NSLOT + i);
        const v2u ew = *(const GAS v2u*)(EI + i); const v2u gw = *(const GAS v2u*)(GT + i); const f32x4 gt = {bflo(gw.x), bfhi(gw.x), bflo(gw.y), bfhi(gw.y)}; const float hsv = hs[i >> 7];
        const unsigned e[4] = {ew.x & 0xffffu, ew.x >> 16, ew.y & 0xffffu, ew.y >> 16};
        const f32x4 si = {(bflo(p0.x) + bflo(p1.x)) + (bflo(p2.x) + bflo(p3.x)), (bfhi(p0.x) + bfhi(p1.x)) + (bfhi(p2.x) + bfhi(p3.x)), (bflo(p0.y) + bflo(p1.y)) + (bflo(p2.y) + bflo(p3.y)), (bfhi(p0.y) + bfhi(p1.y)) + (bfhi(p2.y) + bfhi(p3.y))}; f32x4 o;
#pragma unroll
        for (int k = 0; k < 4; k += 2) { const f32x2 sc0 = *(const GAS f32x2*)(usc + 2 * e[k]), sc1 = *(const GAS f32x2*)(usc + 2 * e[k + 1]);
            const f32x2 gl = pg8::gelu_pk((f32x2){si[k] * (sc0.x * hsv), si[k + 1] * (sc1.x * hsv)});
            o[k] = gl.x * gt[k] * sc0.y; o[k + 1] = gl.y * gt[k + 1] * sc1.y; }
        float am = fmaxf(fmaxf(fabsf(o[0]), fabsf(o[1])), fmaxf(fabsf(o[2]), fabsf(o[3])));
#pragma unroll
        for (int x = 1; x < 32; x <<= 1) am = fmaxf(am, __shfl_xor(am, x));
        const bool amok = am > 1e-30f; const float inv = amok ? 448.0f * __builtin_amdgcn_rcpf(am) : 1.0f;
        float sv[4];
#pragma unroll
        for (int k = 0; k < 4; ++k) sv[k] = fminf(fmaxf(o[k] * inv, -448.f), 448.f);
        int hi = __builtin_amdgcn_cvt_pk_fp8_f32(sv[0], sv[1], 0, false); hi = __builtin_amdgcn_cvt_pk_fp8_f32(sv[2], sv[3], hi, true);
        const f32x2 d01 = __builtin_amdgcn_cvt_pk_f32_fp8(hi, false), d23 = __builtin_amdgcn_cvt_pk_f32_fp8(hi, true);
        int lo = __builtin_amdgcn_cvt_pk_fp8_f32((sv[0] - d01.x) * 16.f, (sv[1] - d01.y) * 16.f, 0, false); lo = __builtin_amdgcn_cvt_pk_fp8_f32((sv[2] - d23.x) * 16.f, (sv[3] - d23.y) * 16.f, lo, true);
        const size_t t = i >> 7; const int pos = (int)(i & 127);
        *(GAS unsigned*)(W8 + t * 256 + pos) = (unsigned)hi; *(GAS unsigned*)(W8 + t * 256 + 128 + pos) = (unsigned)lo;
        if (pos == 0) WSC[t] = amok ? am * (1.0f / 448.0f) : 1.0f;
    }
}
typedef int i32x2 __attribute__((ext_vector_type(2)));
typedef int i32x8 __attribute__((ext_vector_type(8)));
struct PeerVA { v4u a0, a1; };
__device__ __forceinline__ void phase_peer_v(const Args& A, LAS unsigned char* lds) {
    const int tid = threadIdx.x, lane = tid & 63, wave = __builtin_amdgcn_readfirstlane(tid >> 6), p = blockIdx.x & 7, q = p & 3, half = p >> 2, j = blockIdx.x >> 3, nj = gridDim.x >> 3;
    const unsigned char* V4 = (const unsigned char*)(A.ws + WS_V8); const unsigned short* EI = (const unsigned short*)(A.ws + WS_EIDX);
    const unsigned char* W8 = (const unsigned char*)(A.ws + WS_W8); const float* WSC = (const float*)(A.ws + WS_WSC);
    bf16* Y = (bf16*)(A.ws + WS_H); float* SSY = (float*)(A.ws + WS_SSY);
    const int tper = (M / 2) / nj, nt_w = tper / NWAVES, t0 = half * (M / 2) + j * tper + wave * nt_w;
    const int n = lane & 15, g = lane >> 4, r8 = lane >> 3, c8 = lane & 7;
    const int srcoff0 = q * (NEXP * 128) + 16 * (c8 ^ (r8 >> 1)), srcoff1 = q * (NEXP * 128) + 16 * (c8 ^ (4 + (r8 >> 1)));
    LAS unsigned char* img = lds + wave * 16384;
    const int rdb = (32 * g + n) * 128, xo = 16 * (n >> 1) + 8 * (g & 1);
    struct Idx { unsigned lo, hi; };
    auto ldidx = [&](int i) { const unsigned short* ep = EI + (size_t)(t0 + i) * NSLOT + lane; Idx r; r.lo = ep[0]; r.hi = ep[64]; return r; };
    auto ldA = [&](int i) { const unsigned char* ap = W8 + (size_t)(t0 + i) * 256 + ((n >> 1) & 1) * 128 + 16 * g; PeerVA r; r.a0 = *(const GAS v4u*)ap; r.a1 = *(const GAS v4u*)(ap + 64); return r; };
    const bool alive = n < 4 && ((n & 1) == (g >> 1));
    auto fetch = [&](const Idx& ix) { unsigned e[16]; const int pk = (int)(ix.lo | (ix.hi << 16));
#pragma unroll
        for (int i = 0; i < 8; ++i) { const unsigned w = (unsigned)__shfl(pk, 8 * i + r8); e[i] = w & 0xffffu; e[8 + i] = w >> 16; }
        __builtin_amdgcn_sched_barrier(0);
#pragma unroll
        for (int i = 0; i < 16; ++i) __builtin_amdgcn_global_load_lds((const unsigned*)(V4 + (size_t)e[i] * 128 + ((i & 1) ? srcoff1 : srcoff0)), (LAS unsigned*)(img + i * 1024), 16, 0, 0); };
    Idx ixn; PeerVA an; float wscn;
    { const Idx ix0 = ldidx(0); fetch(ix0); ixn = ldidx(min(1, nt_w - 1)); an = ldA(0); wscn = WSC[t0]; }
    v4u yst0 = {0u, 0u, 0u, 0u}, yst1 = {0u, 0u, 0u, 0u}; float ssst = 0.f;
    for (int i = 0; i < nt_w; ++i) {
        asm volatile("s_waitcnt vmcnt(0)" ::: "memory");
        PeerVA ac = an; float wsc = wscn; Idx ixc = ixn;
        asm volatile("" : "+v"(ac.a0.x), "+v"(ac.a0.y), "+v"(ac.a0.z), "+v"(ac.a0.w), "+v"(ac.a1.x), "+v"(ac.a1.y), "+v"(ac.a1.z), "+v"(ac.a1.w), "+v"(wsc), "+v"(ixc.lo), "+v"(ixc.hi));
        i32x2 br[16][2];
#pragma unroll
        for (int nt = 0; nt < 16; ++nt) { const int ro = rdb + ((16 * (nt >> 1) + 8 * (nt & 1)) ^ xo);
            br[nt][0] = __builtin_amdgcn_ds_read_tr4_b64_v2i32((LAS i32x2*)(img + ro)); br[nt][1] = __builtin_amdgcn_ds_read_tr4_b64_v2i32((LAS i32x2*)(img + ro + 2048)); }
        asm volatile("s_waitcnt lgkmcnt(0)" ::: "memory");
        __builtin_amdgcn_sched_barrier(0);
        if (i + 1 < nt_w) fetch(ixc);
        ixn = ldidx(min(i + 2, nt_w - 1)); an = ldA(min(i + 1, nt_w - 1)); wscn = WSC[t0 + min(i + 1, nt_w - 1)];
        if (i > 0 && lane < 16) { const int t = t0 + i - 1; GAS v4u* yp = (GAS v4u*)(Y + (size_t)t * D + 256 * q + 16 * n); __builtin_nontemporal_store(yst0, yp); __builtin_nontemporal_store(yst1, yp + 1); if (lane == 0) *(GAS f32x2*)(SSY + (size_t)t * 8 + 2 * q) = (f32x2){ssst, 0.f}; }
        __builtin_amdgcn_sched_barrier(0);
        if (!alive) { ac.a0 = (v4u){0u, 0u, 0u, 0u}; ac.a1 = (v4u){0u, 0u, 0u, 0u}; }
        const i32x8 A8 = {(int)ac.a0.x, (int)ac.a0.y, (int)ac.a0.z, (int)ac.a0.w, (int)ac.a1.x, (int)ac.a1.y, (int)ac.a1.z, (int)ac.a1.w};
        float yv[16]; float ss = 0.f;
#pragma unroll
        for (int c2 = 0; c2 < 8; ++c2) { const i32x8 BX = {br[2 * c2][0].x, br[2 * c2][0].y, br[2 * c2][1].x, br[2 * c2][1].y, 0, 0, 0, 0}, BY = {br[2 * c2 + 1][0].x, br[2 * c2 + 1][0].y, br[2 * c2 + 1][1].x, br[2 * c2 + 1][1].y, 0, 0, 0, 0};
            const f32x4 dx = __builtin_amdgcn_mfma_scale_f32_16x16x128_f8f6f4(A8, BX, (f32x4){0.f, 0.f, 0.f, 0.f}, 0, 4, 0, 0x7f7f7f7f, 0, 0x7f7f7f7f);
            const f32x4 dy = __builtin_amdgcn_mfma_scale_f32_16x16x128_f8f6f4(A8, BY, (f32x4){0.f, 0.f, 0.f, 0.f}, 0, 4, 0, 0x7f7f7f7f, 0, 0x7f7f7f7f);
            yv[2 * c2] = ((dx[0] + dy[1]) + (dx[2] + dy[3]) * 0.0625f) * wsc; yv[2 * c2 + 1] = ((dy[0] + dx[1]) + (dy[2] + dx[3]) * 0.0625f) * wsc;
            ss += yv[2 * c2] * yv[2 * c2] + yv[2 * c2 + 1] * yv[2 * c2 + 1]; }
        ss += __shfl_xor(ss, 1); ss += __shfl_xor(ss, 2); ss += __shfl_xor(ss, 4); ss += __shfl_xor(ss, 8);
        yst0 = (v4u){pk2(yv[0], yv[1]), pk2(yv[2], yv[3]), pk2(yv[4], yv[5]), pk2(yv[6], yv[7])}; yst1 = (v4u){pk2(yv[8], yv[9]), pk2(yv[10], yv[11]), pk2(yv[12], yv[13]), pk2(yv[14], yv[15])}; ssst = ss;
    }
    if (lane < 16) { const int t = t0 + nt_w - 1; GAS v4u* yp = (GAS v4u*)(Y + (size_t)t * D + 256 * q + 16 * n); __builtin_nontemporal_store(yst0, yp); __builtin_nontemporal_store(yst1, yp + 1); if (lane == 0) *(GAS f32x2*)(SSY + (size_t)t * 8 + 2 * q) = (f32x2){ssst, 0.f}; }
    __syncthreads();
}
#ifdef V_SLOW
__device__ __forceinline__ void phase_peer_v_slow(const Args& A, LAS unsigned char* lds) {
    const int tid = threadIdx.x, p = blockIdx.x & 7, q = p & 3, half = p >> 2, j = blockIdx.x >> 3, nj = gridDim.x >> 3;
    const unsigned char* V4 = (const unsigned char*)(A.ws + WS_V8); const unsigned short* EI = (const unsigned short*)(A.ws + WS_EIDX);
    const unsigned char* W8 = (const unsigned char*)(A.ws + WS_W8); const float* WSC = (const float*)(A.ws + WS_WSC);
    bf16* Y = (bf16*)(A.ws + WS_H); float* SSY = (float*)(A.ws + WS_SSY);
    const int tper = (M / 2) / nj, tbeg = half * (M / 2) + j * tper;
    LAS float* red = (LAS float*)lds;
    const int c = tid & 255, tsub = tid >> 8, nn = c >> 4, nt = c & 15, P = 16 * nt + nn;
    for (int tb = 0; tb < tper; tb += 2) { const int t = tbeg + tb + tsub; float acc = 0.f;
        for (int k = 0; k < 128; ++k) { const unsigned e = EI[(size_t)t * NSLOT + k]; const unsigned byte = V4[(size_t)e * 512 + 128 * q + (P >> 1)]; const unsigned nib = (byte >> (4 * (P & 1))) & 15u;
            const float vv = __builtin_amdgcn_cvt_scalef32_pk_f32_fp4(nib, 1.0f, 0)[0];
            const unsigned hb = W8[(size_t)t * 256 + k], lb = W8[(size_t)t * 256 + 128 + k];
            const float w = __builtin_amdgcn_cvt_pk_f32_fp8((int)hb, false)[0] + __builtin_amdgcn_cvt_pk_f32_fp8((int)lb, false)[0] * 0.0625f;
            acc += w * vv; }
        acc *= WSC[t];
        Y[(size_t)t * D + 256 * q + c] = (bf16)f2bf(acc);
        __syncthreads(); red[tid] = acc * acc; __syncthreads();
        if (c < 2) { float ssum = 0.f; for (int x = 0; x < 256; ++x) if (((x >> 3) & 1) == c) ssum += red[tsub * 256 + x]; SSY[(size_t)t * 8 + 2 * q + c] = ssum; }
    }
    __syncthreads();
}
#endif
__device__ __forceinline__ void phase_peer_final(const Args& A) {
    const int tid = threadIdx.x, lane = tid & 63, wave = tid >> 6, G = gridDim.x;
    const bf16* Y = (const bf16*)(A.ws + WS_H); const bf16* X1 = (const bf16*)(A.ws + WS_X1); const float* SSY = (const float*)(A.ws + WS_SSY); const float* mod = (const float*)(A.ws + WS_MOD); const float* gpost = (const float*)A.in[I_GPOST2]; float* out = A.out;
    f32x4 gp[4];
#pragma unroll
    for (int q = 0; q < 4; ++q) gp[q] = *(const GAS f32x4*)(gpost + 4 * (lane + 64 * q));
    const int stride = G * NWAVES; int row = blockIdx.x * NWAVES + wave;
    v2u xw[4], yw[4], xwn[4], ywn[4]; f32x4 s0, s0n, s1, s1n, g2p[4]; int bcur = -1;
#pragma unroll
    for (int q = 0; q < 4; ++q) { xw[q] = ((const GAS v2u*)(X1 + (size_t)row * D) + lane)[64 * q]; yw[q] = ((const GAS v2u*)(Y + (size_t)row * D) + lane)[64 * q]; }
    s0 = *(const GAS f32x4*)(SSY + (size_t)row * 8); s1 = *(const GAS f32x4*)(SSY + (size_t)row * 8 + 4);
    for (; row < M; row += stride) {
        const int rn = min(row + stride, M - 1);
#pragma unroll
        for (int q = 0; q < 4; ++q) { xwn[q] = ((const GAS v2u*)(X1 + (size_t)rn * D) + lane)[64 * q]; ywn[q] = ((const GAS v2u*)(Y + (size_t)rn * D) + lane)[64 * q]; }
        s0n = *(const GAS f32x4*)(SSY + (size_t)rn * 8); s1n = *(const GAS f32x4*)(SSY + (size_t)rn * 8 + 4);
        const int b = row / SEQ;
        if (b != bcur) { bcur = b;
#pragma unroll
            for (int q = 0; q < 4; ++q) { const f32x4 g2 = *(const GAS f32x4*)(mod + b * 6144 + 5120 + 4 * (lane + 64 * q));
#pragma unroll
                for (int i = 0; i < 4; ++i) g2p[q][i] = g2[i] * gp[q][i]; } }
        const float rstd = __builtin_amdgcn_rsqf((((s0[0] + s0[1]) + (s0[2] + s0[3])) + ((s1[0] + s1[1]) + (s1[2] + s1[3]))) * (1.f / D) + EPS);
        GAS f32x4* orow = (GAS f32x4*)(out + (size_t)row * D) + lane;
#pragma unroll
        for (int q = 0; q < 4; ++q) { f32x4 xv = {bflo(xw[q].x), bfhi(xw[q].x), bflo(xw[q].y), bfhi(xw[q].y)};
            xv[0] += g2p[q][0] * (bflo(yw[q].x) * rstd); xv[1] += g2p[q][1] * (bfhi(yw[q].x) * rstd); xv[2] += g2p[q][2] * (bflo(yw[q].y) * rstd); xv[3] += g2p[q][3] * (bfhi(yw[q].y) * rstd);
#ifdef V_DIAG
            if (row == 0 && lane == 0 && q == 0) xv[0] += *(const float*)(A.ws + WS_WSC + MiB);
#endif
            orow[64 * q] = xv; }
#pragma unroll
        for (int q = 0; q < 4; ++q) { xw[q] = xwn[q]; yw[q] = ywn[q]; }
        s0 = s0n; s1 = s1n;
    }
}
#ifdef PROBE_V_LOADS
__device__ __forceinline__ void probe_v_loads(const Args& A) {
    const int tid = threadIdx.x, lane = tid & 63, wave = tid >> 6, p = blockIdx.x & 7, j = blockIdx.x >> 3, nj = gridDim.x >> 3, g = lane >> 3, c = lane & 7;
    const unsigned char* V8 = (const unsigned char*)(A.ws + WS_V8); const unsigned short* EI = (const unsigned short*)(A.ws + WS_EIDX); const float* ACT = (const float*)(A.ws + WS_ACT);
    unsigned* DUMP = (unsigned*)(A.ws + WS_PD);
    const int tper = M / nj, colb = 128 * p + 16 * c, tend = (j + 1) * tper, tlast = tend - NWAVES + wave;
    int t = j * tper + wave;
    PeerIdx ix1 = peer_ld_idx(EI, min(t + NWAVES, tlast), g), ix2 = peer_ld_idx(EI, min(t + 2 * NWAVES, tlast), g);
    v4u rawa[16], rawb[16]; PeerAct aca, acb;
    { const PeerIdx ix0 = peer_ld_idx(EI, t, g); peer_gather(V8, ix0, colb, rawa); aca = peer_ld_act(ACT, t, g); }
    for (; t < tend; t += 2 * NWAVES) {
        const int t1 = t + NWAVES, t2 = min(t + 2 * NWAVES, tlast), t3 = min(t + 3 * NWAVES, tlast), t4 = min(t + 4 * NWAVES, tlast);
        const PeerIdx ix3 = peer_ld_idx(EI, t3, g);
        peer_gather(V8, ix1, colb, rawb); acb = peer_ld_act(ACT, t1, g);
        { unsigned s = __builtin_bit_cast(unsigned, aca.a0[0]) + __builtin_bit_cast(unsigned, aca.a3[3]);
#pragma unroll
          for (int k = 0; k < 16; ++k) s += (rawa[k].x + rawa[k].y) + (rawa[k].z + rawa[k].w);
          DUMP[(size_t)t * 512 + p * 64 + lane] = s; }
        const PeerIdx ix4 = peer_ld_idx(EI, t4, g);
        peer_gather(V8, ix2, colb, rawa); aca = peer_ld_act(ACT, t2, g);
        { unsigned s = __builtin_bit_cast(unsigned, acb.a0[0]) + __builtin_bit_cast(unsigned, acb.a3[3]);
#pragma unroll
          for (int k = 0; k < 16; ++k) s += (rawb[k].x + rawb[k].y) + (rawb[k].z + rawb[k].w);
          DUMP[(size_t)t1 * 512 + p * 64 + lane] = s; }
        ix1 = ix3; ix2 = ix4;
    }
}
#endif

#ifdef PROBE_INSTR
__device__ __forceinline__ void probe_instr(const Args& A) {
    f32x2 a[8]; float f[16]; unsigned w = threadIdx.x * 0x01010101u + 0x38383838u;
#pragma unroll
    for (int i = 0; i < 8; ++i) a[i] = (f32x2){1.0f + i, 2.0f + i};
#pragma unroll
    for (int i = 0; i < 16; ++i) f[i] = 1.0f + i;
    for (int it = 0; it < 10000; ++it) {
#if PROBE_INSTR == 1
#pragma unroll
        for (int i = 0; i < 8; ++i) { asm volatile("v_pk_fma_f32 %0, %1, %2, %0" : "+v"(a[i]) : "v"(a[(i + 1) & 7]), "v"(a[(i + 2) & 7])); asm volatile("v_pk_fma_f32 %0, %1, %2, %0" : "+v"(a[i]) : "v"(a[(i + 3) & 7]), "v"(a[(i + 4) & 7])); }
#elif PROBE_INSTR == 2
#pragma unroll
        for (int i = 0; i < 16; ++i) asm volatile("v_fma_f32 %0, %1, %2, %0" : "+v"(f[i]) : "v"(f[(i + 1) & 15]), "v"(f[(i + 2) & 15]));
#elif PROBE_INSTR == 3
#pragma unroll
        for (int i = 0; i < 8; ++i) { asm volatile("v_cvt_pk_f32_fp8 %0, %1" : "=v"(a[i]) : "v"(w)); asm volatile("v_cvt_pk_f32_fp8 %0, %1" : "=v"(a[i]) : "v"(w)); }
#elif PROBE_INSTR == 4
#pragma unroll
        for (int i = 0; i < 8; ++i) { asm volatile("v_cvt_scalef32_pk_f32_fp4 %0, %1, 1.0" : "=v"(a[i]) : "v"(w)); asm volatile("v_cvt_scalef32_pk_f32_fp4 %0, %1, 1.0" : "=v"(a[i]) : "v"(w)); }
#elif PROBE_INSTR == 5
#pragma unroll
        for (int i = 0; i < 16; ++i) asm volatile("v_pk_fma_f16 %0, %1, %2, %0" : "+v"(f[i]) : "v"(f[(i + 1) & 15]), "v"(f[(i + 2) & 15]));
#elif PROBE_INSTR == 7
#pragma unroll
        for (int i = 0; i < 16; ++i) asm volatile("v_dot8c_i32_i4 %0, %1, %2" : "+v"(f[i]) : "v"(f[(i + 1) & 15]), "v"(w));
#elif PROBE_INSTR == 8
#pragma unroll
        for (int i = 0; i < 16; ++i) asm volatile("v_dot4c_i32_i8 %0, %1, %2" : "+v"(f[i]) : "v"(f[(i + 1) & 15]), "v"(w));
#elif PROBE_INSTR == 9
#pragma unroll
        for (int i = 0; i < 16; ++i) asm volatile("v_perm_b32 %0, %1, %2, %3" : "=v"(f[i]) : "v"(f[(i + 1) & 15]), "v"(f[(i + 2) & 15]), "v"(w));
#elif PROBE_INSTR == 10
#pragma unroll
        for (int i = 0; i < 16; ++i) asm volatile("v_mfma_f32_16x16x32_fp8_fp8 %0, %1, %2, %0" : "+v"(*(f32x4*)&f[4 * (i & 3)]) : "v"(a[i & 7]), "v"(a[(i + 1) & 7]));
#elif PROBE_INSTR == 6
#pragma unroll
        for (int i = 0; i < 16; ++i) asm volatile("v_cvt_scalef32_pk_f16_fp4 %0, %1, 1.0" : "=v"(f[i]) : "v"(w));
#endif
    }
    float s = 0.f;
#pragma unroll
    for (int i = 0; i < 8; ++i) s += a[i].x + a[i].y;
#pragma unroll
    for (int i = 0; i < 16; ++i) s += f[i];
    if (s == 123.456f) ((float*)(A.ws + WS_PD))[threadIdx.x] = s;
}
#endif
#ifndef MK_N_LAUNCHES
#define MK_N_LAUNCHES 1
#endif
constexpr int N_PHASES = 13;
typedef const __attribute__((address_space(4))) Args* KArgP;
__device__ __forceinline__ const Args& kargs() { KArgP p = (KArgP)__builtin_amdgcn_kernarg_segment_ptr(); asm volatile("" : "+s"(p)); return *(const Args*)p; }
__global__ void __launch_bounds__(NTHR, 2) hymba_fwd(Args A_) {
    extern __shared__ __attribute__((aligned(16))) unsigned char lds_raw[];
    LAS unsigned char* lds = (LAS unsigned char*)lds_raw;
    const int lo = A_.ph_lo, hi = A_.ph_hi;
#define A kargs()
#define ws (kargs().ws)
#ifndef DBLMASK
#define DBLMASK 0
#endif
#ifndef ONLYMASK
#define ONLYMASK 0xffff
#endif
#define IN(k) ((((ONLYMASK) >> (k)) & 1) && lo <= (k) && (k) < hi)
#define REP(k) for (int _rep = 0; _rep < (((DBLMASK) >> (k)) & 1) + 1; ++_rep)
    for (int u = threadIdx.x; u < (LDS_BYTES - RING_BYTES) / 4; u += NTHR) ((LAS unsigned*)(lds + RING_BYTES))[u] = 0u;
    __syncthreads();
    (void)xcd_barrier_post((unsigned*)(ws + WS_CTL) + CW_BAR, (volatile LAS unsigned*)(lds + MISC_OFF + 32));
    if (hi < 0) cg::this_grid().sync();
#define SEAM(k) do { if (IN(k) && IN((k) + 1)) { { XcdBarrier xb_; xb_.bar = (unsigned*)(ws + WS_CTL) + CW_BAR; xb_.x = xb_xcc_id(); xb_.st = (volatile LAS unsigned*)(lds + MISC_OFF + 32); xcd_barrier(xb_); } } } while (0)

    if (IN(0)) REP(0) { phase_mod(A, lds); } SEAM(0);
    if (IN(1)) REP(1) { phase_convert(A, lds); phase_prenorm(A, lds); } SEAM(1);
    if (IN(2)) REP(2) {
        pg8::Gemm g{(const pg8::bf16_t*)(ws + WS_H), (const pg8::bf16_t*)(ws + WS_WIN), M, NPROJ, D}; pg8::StaticOrder S; S.init(M, NPROJ, gridDim.x, (int)blockIdx.x);
        pg8::EpiProj E{(pg8::bf16_t*)(ws + WS_PROJ), NPROJ, (float*)(ws + WS_GATES), (const int*)A.in[I_POS], (const float*)A.in[I_BI], (const float*)A.in[I_BF]};
        pg8::gemm_phase<pg8::EpiProj, pg8::StaticOrder, true, true>(lds, g, S, E);
    } SEAM(2);
    if (IN(3)) REP(3) {
        phase_attn(A, lds);
        for (int wg = blockIdx.x; wg < 256; wg += gridDim.x) mlstm_group<false>(A, lds, wg);
    } SEAM(3);
    if (IN(4)) REP(4) { for (int wg = blockIdx.x; wg < 256; wg += gridDim.x) mlstm_group<true>(A, lds, wg); } SEAM(4);
    if (IN(5)) REP(5) {
        pg8::Gemm g{(const pg8::bf16_t*)(ws + WS_MIXIN), (const pg8::bf16_t*)(ws + WS_WOUT), M, D, D}; pg8::StaticOrder S; S.init(M, D, gridDim.x, (int)blockIdx.x);
        pg8::EpiMix E{(pg8::bf16_t*)(ws + WS_MIX), D, (float*)(ws + WS_SSQ)};
        pg8::gemm_phase<pg8::EpiMix, pg8::StaticOrder, true, true>(lds, g, S, E);
    } SEAM(5);
    if (IN(6)) REP(6) { phase_mid(A); } SEAM(6);
    if (IN(7)) REP(7) {
        pg8::Gemm g{(const pg8::bf16_t*)(ws + WS_H), (const pg8::bf16_t*)(ws + WS_WQ), M, 2048, D}; pg8::StaticOrder S; S.init(M, 2048, gridDim.x, (int)blockIdx.x);
        pg8::EpiPlain E{(pg8::bf16_t*)(ws + WS_PROJ), 2048};
        pg8::gemm_phase<pg8::EpiPlain, pg8::StaticOrder, true, true>(lds, g, S, E);
    } SEAM(7);
    if (IN(8)) REP(8) { phase_topk(A, lds); } SEAM(8);
    if (IN(9)) REP(9) { phase_peer_u(A); } SEAM(9);
    if (IN(10)) REP(10) { phase_peer_act(A); } SEAM(10);
#ifdef PROBE_INSTR
    if (IN(11)) { probe_instr(A); }
#endif
#ifdef PROBE_V_LOADS
    if (IN(11)) { probe_v_loads(A); }
#endif
#ifdef V_SLOW
    if (IN(11)) REP(11) { phase_peer_v_slow(A, lds);
#ifdef V_DIAG
        phase_peer_v(A, lds);
#endif
    } SEAM(11);
#else
    if (IN(11)) REP(11) { phase_peer_v(A, lds); } SEAM(11);
#endif
    if (IN(12)) REP(12) { phase_peer_final(A); }
#undef IN
#undef SEAM
#undef A
#undef ws
}

extern "C" void kernel_launch(void* const* d_in, const int* in_sizes, int n_in, void* d_out, int out_size, void* d_ws, size_t ws_size, hipStream_t stream) {
    static int grid = 0;
    if (grid == 0) {
        if (n_in != 21 || in_sizes[0] != M * D || out_size != M * D || ws_size < WS_END) { fprintf(stderr, "kernel_launch: unexpected shapes (n_in %d, in0 %d, out %d, ws %zu < %zu)\n", n_in, n_in > 0 ? in_sizes[0] : -1, out_size, ws_size, (size_t)WS_END); grid = -1; return; }
        int dev = 0, cus = 0, per_cu = 0;
        if (hipGetDevice(&dev) != hipSuccess || hipDeviceGetAttribute(&cus, hipDeviceAttributeMultiprocessorCount, dev) != hipSuccess) { grid = -1; return; }
        if (hipFuncSetAttribute((const void*)hymba_fwd, hipFuncAttributeMaxDynamicSharedMemorySize, LDS_BYTES) != hipSuccess) { fprintf(stderr, "kernel_launch: hipFuncSetAttribute failed\n"); grid = -1; return; }
        if (hipOccupancyMaxActiveBlocksPerMultiprocessor(&per_cu, (const void*)hymba_fwd, NTHR, LDS_BYTES) != hipSuccess || per_cu < 1) { fprintf(stderr, "kernel_launch: occupancy query says %d blocks per CU\n", per_cu); per_cu = 1; }
        (void)hipGetLastError();
        grid = cus;
        if (grid != 256) fprintf(stderr, "kernel_launch: note: %d CUs (built for 256)\n", grid);
    }
    if (grid < 0) return;
    (void)hipMemsetAsync((char*)d_ws + WS_CTL, 0, CTL_ZERO_BYTES, stream);
    Args a{};
    for (int i = 0; i < 21; ++i) a.in[i] = d_in[i];
    a.out = (float*)d_out; a.ws = (unsigned char*)d_ws;
    if (MK_N_LAUNCHES == 1) {
        a.ph_lo = 0; a.ph_hi = N_PHASES;
        void* args[] = {&a};
        const hipError_t e = hipLaunchCooperativeKernel((const void*)hymba_fwd, dim3(grid), dim3(NTHR), args, LDS_BYTES, stream);
        if (e != hipSuccess) fprintf(stderr, "kernel_launch: cooperative launch failed: %s (grid %d)\n", hipGetErrorString(e), grid);
    } else {
        for (int p = 0; p < N_PHASES; ++p) { a.ph_lo = p; a.ph_hi = p + 1; hipLaunchKernelGGL(hymba_fwd, dim3(grid), dim3(NTHR), LDS_BYTES, stream, a); }
    }
}
```

```cpp
#include <hip/hip_runtime.h>
#include <hip/hip_cooperative_groups.h>
#include <cstdio>
#include <cstdint>
namespace cg = cooperative_groups;
namespace pg8 {
#define PG8_LAS __attribute__((address_space(3)))
typedef unsigned short bf16_t;
typedef short bf16x8 __attribute__((ext_vector_type(8)));
typedef float f32x4 __attribute__((ext_vector_type(4)));
typedef unsigned u32x4 __attribute__((ext_vector_type(4)));
constexpr int BM = 256, BK = 64, HALF = 128, HTB = HALF * BK * 2  , STAGE_BYTES = 8 * HTB, NXCD = 8, WGM = 8;

__host__ __device__ __forceinline__ int lds_byte(int r, int c) { const int st = (r >> 4) * 2 + (c >> 5), rr = r & 15, cc = c & 31, ob = rr * 64 + cc * 2; return st * 1024 + (ob ^ (((ob >> 9) & 1) << 5)); }
__host__ __device__ __forceinline__ void stage_rc(int b, int& R, int& C) { const int st = b / 1024, sb = b % 1024, swz = sb ^ (((sb >> 9) & 1) << 5); R = (st >> 1) * 16 + swz / 64; C = (st & 1) * 32 + (swz % 64) / 2; }
__host__ __device__ __forceinline__ int perm32(int rho) { const int n = rho >> 4, i = rho & 15; return 8 * (i >> 2) + 4 * n + (i & 3); }

struct Unit { int pm, pn; };
struct Gemm { const bf16_t* A; const bf16_t* Bt; int M, N, K; };

struct StaticOrder {
    int nM, nN, nwg, G, c;
    __host__ __device__ void init(int M, int N, int G_, int c_) { nM = M / BM; nN = N / BM; nwg = nM * nN; G = G_; c = c_; }
    __host__ __device__ bool next(int i, Unit& u) const {
        const long L = (long)i * G + c; if (L >= nwg) return false;
        int wgid = (int)L; { const int q = nwg / NXCD, r = nwg % NXCD, xcd = wgid % NXCD, off = wgid / NXCD; wgid = (xcd < r ? xcd * (q + 1) : r * (q + 1) + (xcd - r) * q) + off; }
        const int nig = WGM * nN, gid = wgid / nig, fm = gid * WGM, gsz = (nM - fm) < WGM ? (nM - fm) : WGM;
        u.pm = fm + ((wgid % nig) % gsz); u.pn = (wgid % nig) / gsz; return true;
    }
    __device__ __forceinline__ void a_ready(const Unit&) const {}
    __device__ __forceinline__ void done(const Unit&) const {}
};

__device__ __forceinline__ unsigned cvt_pk_bf16(float lo, float hi) { unsigned r; asm volatile("v_cvt_pk_bf16_f32 %0, %1, %2" : "=v"(r) : "v"(lo), "v"(hi)); return r; }
typedef float f32x2 __attribute__((ext_vector_type(2)));
__device__ __forceinline__ f32x2 gelu_pk(f32x2 v) {
    const f32x2 av = __builtin_elementwise_abs(v), d = av * 0.2316418882f + 1.0f;
    f32x2 t; t.x = __builtin_amdgcn_rcpf(d.x); t.y = __builtin_amdgcn_rcpf(d.y);
    f32x2 q = t * 0.5307027145f + (-0.7265760135f); q = q * t + 0.7107068705f; q = q * t + (-0.142248368f); q = q * t + 0.127414796f; q = q * t;
    const f32x2 s = (v * v) * (-0.72134752044f);
    f32x2 e; e.x = __builtin_amdgcn_exp2f(s.x); e.y = __builtin_amdgcn_exp2f(s.y);
    const f32x2 m = v * (q * e), r = v - m;
    f32x2 o; o.x = v.x < 0.f ? m.x : r.x; o.y = v.y < 0.f ? m.y : r.y; return o;
}

__device__ __forceinline__ u32x4 pack8(const f32x4 v0, const f32x4 v1) { u32x4 w; w.x = cvt_pk_bf16(v0[0], v0[1]); w.y = cvt_pk_bf16(v0[2], v0[3]); w.z = cvt_pk_bf16(v1[0], v1[1]); w.w = cvt_pk_bf16(v1[2], v1[3]); return w; }

struct EpiPlain {
    static constexpr bool PERM = true, AFTER_DRAIN = false;
    bf16_t* O; int ldc;
    __device__ __forceinline__ void operator()(const f32x4 (&acc)[2][2][4][2], const Unit& u, int wr, int wc, int fr, int fq) const {
        const int row0 = u.pm * BM + wr * 64 + fr, col0 = u.pn * BM + wc * 32 + 8 * fq;
#pragma unroll
        for (int ai = 0; ai < 2; ++ai)
#pragma unroll
            for (int m = 0; m < 4; ++m) { bf16_t* rowp = O + (size_t)(row0 + ai * HALF + m * 16) * ldc + col0;
#pragma unroll
                for (int bj = 0; bj < 2; ++bj) *(u32x4*)(rowp + bj * HALF) = pack8(acc[ai][bj][m][0], acc[ai][bj][m][1]); }
    }
};

struct EpiProj {
    static constexpr bool PERM = true, AFTER_DRAIN = false;
    bf16_t* P; int ldc; float* gates; const int* pos; const float* b_i; const float* b_f;
    __device__ __forceinline__ void operator()(const f32x4 (&acc)[2][2][4][2], const Unit& u, int wr, int wc, int fr, int fq) const {
        const int row0 = u.pm * BM + wr * 64 + fr, col0 = u.pn * BM + wc * 32 + 8 * fq, pn = u.pn;
        if (pn == 9) {
            if (wc == 0 && fq == 0) {
                const f32x4 bi = {b_i[0], b_i[1], b_i[2], b_i[3]}, bf = {b_f[0], b_f[1], b_f[2], b_f[3]};
#pragma unroll
                for (int ai = 0; ai < 2; ++ai)
#pragma unroll
                    for (int m = 0; m < 4; ++m) { const int row = row0 + ai * HALF + m * 16;
                        const f32x4 iv = acc[ai][0][m][0] + bi, fv = acc[ai][0][m][1] + bf; f32x4 lf;
#pragma unroll
                        for (int j = 0; j < 4; ++j) lf[j] = fminf(fv[j], 0.f) - log1pf(__expf(-fabsf(fv[j])));
                        *(f32x4*)(gates + (size_t)row * 8) = iv; *(f32x4*)(gates + (size_t)row * 8 + 4) = lf; }
            }
            return;
        }
#pragma unroll
        for (int ai = 0; ai < 2; ++ai)
#pragma unroll
            for (int m = 0; m < 4; ++m) { const int row = row0 + ai * HALF + m * 16; bf16_t* rowp = P + (size_t)row * ldc + col0;
                const float posf = (pn <= 2) ? (float)pos[row] : 0.f;
#pragma unroll
                for (int bj = 0; bj < 2; ++bj) { f32x4 v0 = acc[ai][bj][m][0], v1 = acc[ai][bj][m][1];
                    const bool rope = (pn < 2) || (pn == 2 && bj == 0);
                    if (rope) {
                        const int p0 = ((col0 + bj * HALF) & 63) >> 1; const float sc = (pn < 2) ? 0.125f : 1.0f;
                        float x[8] = {v0[0], v0[1], v0[2], v0[3], v1[0], v1[1], v1[2], v1[3]};
#pragma unroll
                        for (int q = 0; q < 4; ++q) { const float invf = __builtin_amdgcn_exp2f(-(float)(p0 + q) * 0.41524101186092029f);
                            float r = posf * invf * 0.15915494309189535f; r = r - floorf(r);
                            const float c = __builtin_amdgcn_cosf(r) * sc, s = __builtin_amdgcn_sinf(r) * sc;
                            const float x1 = x[2 * q], x2 = x[2 * q + 1]; x[2 * q] = x1 * c - x2 * s; x[2 * q + 1] = x2 * c + x1 * s; }
                        v0 = (f32x4){x[0], x[1], x[2], x[3]}; v1 = (f32x4){x[4], x[5], x[6], x[7]};
                    } else if (pn >= 7) {
#pragma unroll
                        for (int j = 0; j < 4; ++j) { v0[j] = __builtin_amdgcn_rcpf(1.f + __expf(-v0[j])); v1[j] = __builtin_amdgcn_rcpf(1.f + __expf(-v1[j])); }
                    }
                    *(u32x4*)(rowp + bj * HALF) = pack8(v0, v1); } }
    }
};

struct EpiMix {
    static constexpr bool PERM = true, AFTER_DRAIN = false;
    bf16_t* O; int ldc; float* sumsq;
    __device__ __forceinline__ void operator()(const f32x4 (&acc)[2][2][4][2], const Unit& u, int wr, int wc, int fr, int fq) const {
        const int row0 = u.pm * BM + wr * 64 + fr, col0 = u.pn * BM + wc * 32 + 8 * fq;
#pragma unroll
        for (int ai = 0; ai < 2; ++ai)
#pragma unroll
            for (int m = 0; m < 4; ++m) { const int row = row0 + ai * HALF + m * 16; bf16_t* rowp = O + (size_t)row * ldc + col0; float s = 0.f;
#pragma unroll
                for (int bj = 0; bj < 2; ++bj) { const f32x4 v0 = acc[ai][bj][m][0], v1 = acc[ai][bj][m][1];
                    s += (v0[0] * v0[0] + v0[1] * v0[1]) + (v0[2] * v0[2] + v0[3] * v0[3]) + (v1[0] * v1[0] + v1[1] * v1[1]) + (v1[2] * v1[2] + v1[3] * v1[3]);
                    *(u32x4*)(rowp + bj * HALF) = pack8(v0, v1); }
                s += __shfl_xor(s, 16); s += __shfl_xor(s, 32);
                if (fq == 0) sumsq[(size_t)row * 16 + u.pn * 4 + wc] = s; }
    }
};
template <class Epi, class Sched, bool ALIGN_EPI = false, bool SP2 = false>
__device__ __forceinline__ void gemm_phase(PG8_LAS unsigned char* lds, const Gemm g, const Sched& S, const Epi& E) {
    const int tid = threadIdx.x, wid = __builtin_amdgcn_readfirstlane(tid >> 6), lane = tid & 63, wr = wid >> 2, wc = wid & 3, fr = lane & 15, fq = lane >> 4;
    const int K = g.K, nt = K / BK;
    unsigned voffA[2], voffB[2];
#pragma unroll
    for (int i = 0; i < 2; ++i) { int R, C; stage_rc(tid * 16 + i * 8192, R, C); const int Rb = Epi::PERM ? ((R & ~31) + perm32(R & 31)) : R;
        voffA[i] = (unsigned)(R * K + C) * 2u; voffB[i] = (unsigned)(Rb * K + C) * 2u; }
    const size_t kstep = (size_t)(BK * 2);
    const size_t hstep = (size_t)HALF * K * 2;
    const size_t tstep = 2 * hstep;
    const unsigned ldsw = (unsigned)wid * 1024u;
    const int aoff = lds_byte(wr * 64 + fr, fq * 8), boff = lds_byte(wc * 32 + fr, fq * 8);
#define PG8_SA(b, h) (((b) * 2 + (h)) * HTB)
#define PG8_SB(b, h) ((4 + (b) * 2 + (h)) * HTB)
#define PG8_STAGE(bufoff, gbase, voff) do { _Pragma("unroll") for (int _i = 0; _i < 2; ++_i) \
        __builtin_amdgcn_global_load_lds((const unsigned*)((const char*)(gbase) + (voff)[_i]), (PG8_LAS unsigned*)(lds + (bufoff) + ldsw + _i * 8192), 16, 0, 0); } while (0)
#define PG8_LDA(dst, b, h) do { _Pragma("unroll") for (int m = 0; m < 4; ++m) _Pragma("unroll") for (int k = 0; k < 2; ++k) dst[m][k] = *(const PG8_LAS bf16x8*)(lds + PG8_SA(b, h) + aoff + m * 2048 + k * 1024); } while (0)
#define PG8_LDB(dst, b, h) do { _Pragma("unroll") for (int n = 0; n < 2; ++n) _Pragma("unroll") for (int k = 0; k < 2; ++k) dst[n][k] = *(const PG8_LAS bf16x8*)(lds + PG8_SB(b, h) + boff + n * 2048 + k * 1024); } while (0)
#define PG8_MMA(ai, bj, At, Bt) do { __builtin_amdgcn_s_setprio(1); _Pragma("unroll") for (int m = 0; m < 4; ++m) _Pragma("unroll") for (int n = 0; n < 2; ++n) _Pragma("unroll") for (int k = 0; k < 2; ++k) \
        acc[ai][bj][m][n] = __builtin_amdgcn_mfma_f32_16x16x32_bf16(Bt[n][k], At[m][k], acc[ai][bj][m][n], 0, 0, 0); __builtin_amdgcn_s_setprio(0); } while (0)
#define PG8_WAIT_V(n) asm volatile("s_waitcnt vmcnt(" #n ")" ::: "memory")
#define PG8_WAIT_L(n) asm volatile("s_waitcnt lgkmcnt(" #n ")" ::: "memory")
#define PG8_BAR __builtin_amdgcn_s_barrier()
#define PG8_SCHED __builtin_amdgcn_sched_barrier(0)
    Unit cur, nxt; int ui = 0;
    if (!S.next(0, cur)) return;
    f32x4 acc[2][2][4][2];
#pragma unroll
    for (int a = 0; a < 2; ++a)
#pragma unroll
        for (int b = 0; b < 2; ++b)
#pragma unroll
            for (int m = 0; m < 4; ++m)
#pragma unroll
                for (int n = 0; n < 2; ++n) acc[a][b][m][n] = (f32x4){0.f, 0.f, 0.f, 0.f};
    bf16x8 At[4][2], B0[2][2], B1[2][2];
    const char* cA = (const char*)g.A + (size_t)cur.pm * tstep; const char* cB = (const char*)g.Bt + (size_t)cur.pn * tstep;
    S.a_ready(cur);
    if constexpr (SP2) {
        PG8_STAGE(PG8_SB(0, 0), cB, voffB); PG8_STAGE(PG8_SB(0, 1), cB + hstep, voffB); PG8_STAGE(PG8_SA(0, 0), cA, voffA); PG8_STAGE(PG8_SA(0, 1), cA + hstep, voffA);
        if (wr == 1) PG8_BAR;
        PG8_WAIT_V(2); PG8_BAR;
        PG8_STAGE(PG8_SB(1, 0), cB + kstep, voffB); PG8_STAGE(PG8_SA(1, 0), cA + kstep, voffA); PG8_STAGE(PG8_SB(1, 1), cB + hstep + kstep, voffB);
        PG8_WAIT_V(6); PG8_BAR;
    } else {
        PG8_STAGE(PG8_SB(0, 0), cB, voffB); PG8_STAGE(PG8_SA(0, 0), cA, voffA); PG8_STAGE(PG8_SB(0, 1), cB + hstep, voffB); PG8_STAGE(PG8_SA(0, 1), cA + hstep, voffA);
        if (wr == 1) PG8_BAR;
        PG8_WAIT_V(4); PG8_BAR;
        PG8_STAGE(PG8_SB(1, 0), cB + kstep, voffB); PG8_STAGE(PG8_SA(1, 0), cA + kstep, voffA); PG8_STAGE(PG8_SB(1, 1), cB + hstep + kstep, voffB);
        PG8_WAIT_V(6); PG8_BAR;
    }
    for (;;) {
        const bool has_next = S.next(ui + 1, nxt);
        const char* nA = has_next ? (const char*)g.A + (size_t)nxt.pm * tstep : cA; const char* nB = has_next ? (const char*)g.Bt + (size_t)nxt.pn * tstep : cB;
        for (int t = 0; t < nt; t += 2) {
            const bool last = (t == nt - 2);
            const char* a1 = cA + (size_t)(t + 1) * kstep;
            const char* a2 = last ? nA : cA + (size_t)(t + 2) * kstep; const char* b2 = last ? nB : cB + (size_t)(t + 2) * kstep;
            const char* a3 = a2 + kstep; const char* b3 = b2 + kstep;
            if (last && has_next) S.a_ready(nxt);
            if constexpr (SP2) {
            PG8_LDB(B0, 0, 0); PG8_LDB(B1, 0, 1); PG8_SCHED; PG8_LDA(At, 0, 0); PG8_STAGE(PG8_SA(1, 1), a1 + hstep, voffA);
            PG8_WAIT_V(8); PG8_WAIT_L(0); PG8_BAR; PG8_MMA(0, 0, At, B0); PG8_MMA(0, 1, At, B1); PG8_BAR; PG8_SCHED;
            PG8_LDA(At, 0, 1); PG8_STAGE(PG8_SB(0, 0), b2, voffB); PG8_STAGE(PG8_SB(0, 1), b2 + hstep, voffB); PG8_STAGE(PG8_SA(0, 0), a2, voffA);
            PG8_WAIT_V(8); PG8_WAIT_L(0); PG8_BAR; PG8_MMA(1, 0, At, B0); PG8_MMA(1, 1, At, B1); PG8_BAR; PG8_SCHED;
            PG8_LDB(B0, 1, 0); PG8_LDB(B1, 1, 1); PG8_SCHED; PG8_LDA(At, 1, 0); PG8_STAGE(PG8_SA(0, 1), a2 + hstep, voffA);
            PG8_WAIT_V(8); PG8_WAIT_L(0); PG8_BAR; PG8_MMA(0, 0, At, B0); PG8_MMA(0, 1, At, B1); PG8_BAR; PG8_SCHED;
            PG8_LDA(At, 1, 1); PG8_STAGE(PG8_SB(1, 0), b3, voffB); PG8_STAGE(PG8_SB(1, 1), b3 + hstep, voffB); PG8_STAGE(PG8_SA(1, 0), a3, voffA);
            PG8_WAIT_V(8); PG8_WAIT_L(0); PG8_BAR; PG8_MMA(1, 0, At, B0); PG8_MMA(1, 1, At, B1); PG8_BAR; PG8_SCHED;
            } else {
            PG8_LDB(B0, 0, 0); PG8_SCHED; PG8_LDA(At, 0, 0); PG8_STAGE(PG8_SA(1, 1), a1 + hstep, voffA);
            PG8_WAIT_L(8); PG8_BAR; PG8_WAIT_L(0); PG8_MMA(0, 0, At, B0); PG8_BAR; PG8_SCHED;
            PG8_LDB(B1, 0, 1); PG8_STAGE(PG8_SB(0, 0), b2, voffB);
            PG8_BAR; PG8_WAIT_L(0); PG8_MMA(0, 1, At, B1); PG8_BAR;
            PG8_LDA(At, 0, 1); PG8_STAGE(PG8_SA(0, 0), a2, voffA);
            PG8_BAR; PG8_WAIT_L(0); PG8_MMA(1, 0, At, B0); PG8_BAR; PG8_SCHED;
            PG8_STAGE(PG8_SB(0, 1), b2 + hstep, voffB);
            PG8_WAIT_V(6); PG8_BAR; PG8_MMA(1, 1, At, B1); PG8_BAR;
            PG8_LDB(B0, 1, 0); PG8_SCHED; PG8_LDA(At, 1, 0); PG8_STAGE(PG8_SA(0, 1), a2 + hstep, voffA);
            PG8_WAIT_L(8); PG8_BAR; PG8_WAIT_L(0); PG8_MMA(0, 0, At, B0); PG8_BAR; PG8_SCHED;
            PG8_LDB(B1, 1, 1); PG8_STAGE(PG8_SB(1, 0), b3, voffB);
            PG8_BAR; PG8_WAIT_L(0); PG8_MMA(0, 1, At, B1); PG8_BAR;
            PG8_LDA(At, 1, 1); PG8_STAGE(PG8_SA(1, 0), a3, voffA);
            PG8_BAR; PG8_WAIT_L(0); PG8_MMA(1, 0, At, B0); PG8_BAR; PG8_SCHED;
            PG8_STAGE(PG8_SB(1, 1), b3 + hstep, voffB);
            PG8_WAIT_V(6); PG8_BAR; PG8_MMA(1, 1, At, B1); PG8_BAR;
            }
        }
        if constexpr (ALIGN_EPI) { if (wr == 0) PG8_BAR; }
        if constexpr (!Epi::AFTER_DRAIN) { E(acc, cur, wr, wc, fr, fq); S.done(cur); }
        if (!has_next) break;
#pragma unroll
        for (int a = 0; a < 2; ++a)
#pragma unroll
            for (int b = 0; b < 2; ++b)
#pragma unroll
                for (int m = 0; m < 4; ++m)
#pragma unroll
                    for (int n = 0; n < 2; ++n) acc[a][b][m][n] = (f32x4){0.f, 0.f, 0.f, 0.f};
        cur = nxt; cA = nA; cB = nB; ++ui;
        if constexpr (ALIGN_EPI) { if (wr == 1) PG8_BAR; }
    }
    PG8_WAIT_V(0);
    if constexpr (!ALIGN_EPI) { if (wr == 0) PG8_BAR; }
    PG8_BAR;
    if constexpr (Epi::AFTER_DRAIN) { E.fused(acc, cur, wr, wc, fr, fq, lds, wid, lane); S.done(cur); }
#undef PG8_SA
#undef PG8_SB
#undef PG8_STAGE
#undef PG8_LDA
#undef PG8_LDB
#undef PG8_MMA
#undef PG8_WAIT_V
#undef PG8_WAIT_L
#undef PG8_BAR
#undef PG8_SCHED
}
}
constexpr int NB = 8, SEQ = 8192, D = 1024, M = NB * SEQ;
constexpr int DIN = 2312, NPROJ = 2304, NIN_PAD = 2560;
constexpr int C_AQ = 0, C_AK = 512, C_AV = 640, C_MQ = 768, C_MK = 1024, C_MV = 1280, C_MO = 1792;
constexpr int NEXP = 16384, NSLOT = 128;
constexpr float EPS = 1e-6f;
constexpr int NWAVES = 8, NTHR = 512;

constexpr size_t MiB = 1u << 20;
constexpr size_t WS_CTL = 0, CTL_ZERO_BYTES = 1 * MiB;
constexpr size_t WS_MOD = 1 * MiB;
constexpr size_t WS_WIN = 2 * MiB;
constexpr size_t WS_WOUT = 8 * MiB;
constexpr size_t WS_WQ = 10 * MiB;
constexpr size_t WS_KEYS = 14 * MiB;
constexpr size_t WS_GATES = 16 * MiB;
constexpr size_t WS_SSQ = 832 * MiB;
constexpr size_t WS_MST = 20 * MiB;
constexpr size_t WS_U8 = 32 * MiB, WS_V8 = 48 * MiB;
constexpr size_t WS_SC = 64 * MiB;
constexpr size_t WS_H = 96 * MiB;
constexpr size_t WS_PROJ = 224 * MiB;
constexpr size_t WS_MIXIN = 512 * MiB;
constexpr size_t WS_MIX = 640 * MiB;
constexpr size_t WS_EIDX = 768 * MiB, WS_GATE = 800 * MiB;
constexpr size_t WS_PD = 224 * MiB;
constexpr size_t WS_X1 = 512 * MiB;
constexpr size_t WS_ACT = 840 * MiB;
constexpr size_t WS_W8 = 840 * MiB, WS_WSC = 864 * MiB;
constexpr size_t WS_SSY = 872 * MiB;
constexpr size_t WS_H8 = 880 * MiB;
constexpr size_t WS_HS = 944 * MiB;
constexpr size_t WS_END = 945 * MiB;
constexpr int CW_BAR = 4096;
constexpr int CW_SUMSQ = 65536;
static_assert((CW_SUMSQ + M) * 4 <= (int)CTL_ZERO_BYTES, "ctl");

constexpr int RING_BYTES = 131072, MISC_OFF = RING_BYTES + 320, LDS_BYTES = 147456;

#define GAS __attribute__((address_space(1)))
#define LAS __attribute__((address_space(3)))
typedef unsigned short bf16;
typedef unsigned v4u __attribute__((ext_vector_type(4)));
typedef unsigned v2u __attribute__((ext_vector_type(2)));
typedef float f32x4 __attribute__((ext_vector_type(4)));
typedef GAS unsigned gu32;
#define LDS_WAIT() asm volatile("s_waitcnt lgkmcnt(0)" ::: "memory")
#define VM_WAIT() asm volatile("s_waitcnt vmcnt(0)" ::: "memory")
#define LDS_SYNC() asm volatile("s_waitcnt lgkmcnt(0)\n\ts_barrier" ::: "memory")
typedef float f32x2_cv __attribute__((ext_vector_type(2)));
typedef __bf16 bf16x2_cv __attribute__((ext_vector_type(2)));
__device__ __forceinline__ unsigned pk2(float lo, float hi) { return __builtin_bit_cast(unsigned, __builtin_convertvector((f32x2_cv){lo, hi}, bf16x2_cv)); }
__device__ __forceinline__ unsigned f2bf(float f) { return pk2(f, 0.f) & 0xffffu; }
__device__ __forceinline__ float bflo(unsigned w) { return __builtin_bit_cast(float, w << 16); }
__device__ __forceinline__ float bfhi(unsigned w) { return __builtin_bit_cast(float, w & 0xffff0000u); }
__device__ __forceinline__ float bf1(bf16 h) { return __builtin_bit_cast(float, (unsigned)h << 16); }
__device__ __forceinline__ float wave_sum(float v) {
#pragma unroll
    for (int o = 1; o < 64; o <<= 1) v += __shfl_xor(v, o);
    return v;
}
__device__ __forceinline__ float wave_max(float v) {
#pragma unroll
    for (int o = 1; o < 64; o <<= 1) v = fmaxf(v, __shfl_xor(v, o));
    return v;
}

typedef float f32x2 __attribute__((ext_vector_type(2)));
__device__ __forceinline__ void cvt16_fp8(const v4u w, float (&o)[16]) {
    const unsigned ww[4] = {w.x, w.y, w.z, w.w};
#pragma unroll
    for (int i = 0; i < 4; ++i) { const f32x2 a = __builtin_amdgcn_cvt_pk_f32_fp8((int)ww[i], false), b = __builtin_amdgcn_cvt_pk_f32_fp8((int)ww[i], true);
        o[4 * i] = a.x; o[4 * i + 1] = a.y; o[4 * i + 2] = b.x; o[4 * i + 3] = b.y; }
}
__device__ __forceinline__ void p0_row_fp8(const float* src, unsigned char* dst, float* sc, int row, int lane) {
    const GAS f32x4* sp = (const GAS f32x4*)(src + (size_t)row * D + 16 * lane);
    const f32x4 a = sp[0], b = sp[1], c = sp[2], d = sp[3];
    float mx = 0.f;
#pragma unroll
    for (int i = 0; i < 4; ++i) mx = fmaxf(fmaxf(fmaxf(mx, fabsf(a[i])), fmaxf(fabsf(b[i]), fabsf(c[i]))), fabsf(d[i]));
    mx = wave_max(mx); const float s = mx > 0.f ? 224.0f / mx : 1.0f;
    v4u o; int w;
    w = __builtin_amdgcn_cvt_pk_fp8_f32(a[0] * s, a[1] * s, 0, false); w = __builtin_amdgcn_cvt_pk_fp8_f32(a[2] * s, a[3] * s, w, true); o.x = (unsigned)w;
    w = __builtin_amdgcn_cvt_pk_fp8_f32(b[0] * s, b[1] * s, 0, false); w = __builtin_amdgcn_cvt_pk_fp8_f32(b[2] * s, b[3] * s, w, true); o.y = (unsigned)w;
    w = __builtin_amdgcn_cvt_pk_fp8_f32(c[0] * s, c[1] * s, 0, false); w = __builtin_amdgcn_cvt_pk_fp8_f32(c[2] * s, c[3] * s, w, true); o.z = (unsigned)w;
    w = __builtin_amdgcn_cvt_pk_fp8_f32(d[0] * s, d[1] * s, 0, false); w = __builtin_amdgcn_cvt_pk_fp8_f32(d[2] * s, d[3] * s, w, true); o.w = (unsigned)w;
    *(GAS v4u*)(dst + (size_t)row * D + 16 * lane) = o;
    if (lane == 0) sc[row] = mx > 0.f ? mx * (1.0f / 224.0f) : 1.0f;
}

__device__ __forceinline__ unsigned pack4_i8(float a, float b, float c, float d) { return ((unsigned)__float2int_rn(a) & 0xffu) | (((unsigned)__float2int_rn(b) & 0xffu) << 8) | (((unsigned)__float2int_rn(c) & 0xffu) << 16) | (((unsigned)__float2int_rn(d) & 0xffu) << 24); }
__device__ __forceinline__ void p0_row_i8(const float* src, unsigned char* dst, float* sc, int row, int lane) {
    const GAS f32x4* sp = (const GAS f32x4*)(src + (size_t)row * D + 16 * lane);
    const f32x4 a = sp[0], b = sp[1], c = sp[2], d = sp[3];
    float mx = 0.f;
#pragma unroll
    for (int i = 0; i < 4; ++i) mx = fmaxf(fmaxf(fmaxf(mx, fabsf(a[i])), fmaxf(fabsf(b[i]), fabsf(c[i]))), fabsf(d[i]));
    mx = wave_max(mx); const float s = mx > 0.f ? 127.0f / mx : 1.0f;
    v4u o; o.x = pack4_i8(a[0] * s, a[1] * s, a[2] * s, a[3] * s); o.y = pack4_i8(b[0] * s, b[1] * s, b[2] * s, b[3] * s); o.z = pack4_i8(c[0] * s, c[1] * s, c[2] * s, c[3] * s); o.w = pack4_i8(d[0] * s, d[1] * s, d[2] * s, d[3] * s);
    *(GAS v4u*)(dst + (size_t)row * D + 16 * lane) = o;
    if (lane == 0) sc[row] = mx > 0.f ? mx * (1.0f / 127.0f) : 1.0f;
}

__device__ __forceinline__ unsigned pack8_i4(const f32x4 a, const f32x4 b, float s) {
    unsigned w = 0;
#pragma unroll
    for (int i = 0; i < 4; ++i) { const int qa = max(-8, min(7, __float2int_rn(a[i] * s))), qb = max(-8, min(7, __float2int_rn(b[i] * s))); w |= ((unsigned)qa & 15u) << (4 * i); w |= ((unsigned)qb & 15u) << (16 + 4 * i); }
    return w;
}
__device__ __forceinline__ void p0_row_i4(const f32x4 a, const f32x4 b, const f32x4 c, const f32x4 d, unsigned char* dst, float* sc, int row, int lane) {
    float ss = 0.f;
#pragma unroll
    for (int i = 0; i < 4; ++i) ss += (a[i] * a[i] + b[i] * b[i]) + (c[i] * c[i] + d[i] * d[i]);
    ss = wave_sum(ss); const float sig = sqrtf(ss * (1.f / D)), s = sig > 0.f ? 3.0f / sig : 1.0f;
    v2u o; o.x = pack8_i4(a, b, s); o.y = pack8_i4(c, d, s);
    *(GAS v2u*)(dst + (size_t)(lane >> 4) * ((size_t)NEXP * 128) + (size_t)row * 128 + 8 * (lane & 15)) = o;
    if (lane == 0) sc[2 * row] = sig > 0.f ? sig * (1.0f / 3.0f) : 1.0f;
}

__device__ __forceinline__ unsigned pack8_fp4(const f32x4 a, const f32x4 b, float s) {
    unsigned w = 0;
    w = __builtin_amdgcn_cvt_scalef32_pk_fp4_f32(w, fminf(fmaxf(a[0] * s, -6.f), 6.f), fminf(fmaxf(a[1] * s, -6.f), 6.f), 1.0f, 0);
    w = __builtin_amdgcn_cvt_scalef32_pk_fp4_f32(w, fminf(fmaxf(a[2] * s, -6.f), 6.f), fminf(fmaxf(a[3] * s, -6.f), 6.f), 1.0f, 1);
    w = __builtin_amdgcn_cvt_scalef32_pk_fp4_f32(w, fminf(fmaxf(b[0] * s, -6.f), 6.f), fminf(fmaxf(b[1] * s, -6.f), 6.f), 1.0f, 2);
    w = __builtin_amdgcn_cvt_scalef32_pk_fp4_f32(w, fminf(fmaxf(b[2] * s, -6.f), 6.f), fminf(fmaxf(b[3] * s, -6.f), 6.f), 1.0f, 3);
    return w;
}
__device__ __forceinline__ void p0_row_fp4(const f32x4 a, const f32x4 b, const f32x4 c, const f32x4 d, unsigned char* dst, float* sc, int row, int lane) {
    float mx = 0.f;
#pragma unroll
    for (int i = 0; i < 4; ++i) mx = fmaxf(fmaxf(fmaxf(mx, fabsf(a[i])), fmaxf(fabsf(b[i]), fabsf(c[i]))), fabsf(d[i]));
    mx = wave_max(mx); const float s = mx > 0.f ? 7.0f / mx : 1.0f;
    v2u o; o.x = pack8_fp4(a, b, s); o.y = pack8_fp4(c, d, s);
    *(GAS v2u*)(dst + (size_t)(lane >> 4) * ((size_t)NEXP * 128) + (size_t)row * 128 + 8 * (lane & 15)) = o;
    if (lane == 0) sc[2 * row] = mx > 0.f ? mx * (1.0f / 7.0f) : 1.0f;
}
#define XB_TMO      128
#define XB_XCNT(j)  (256  + 64 * (j))
#define XB_XSUB(j)  (1280 + 64 * (j))
#define XB_XGEN(j)  (2304 + 64 * (j))
#define XB_TOP      3328
#define XB_TOPGEN   3392
#define XCD_BAR_WORDS 3456
#define XB_SPIN_CAP (1u << 18)

__device__ __forceinline__ unsigned xb_ld(unsigned* p)              { return __hip_atomic_load(p, __ATOMIC_RELAXED, __HIP_MEMORY_SCOPE_AGENT); }
__device__ __forceinline__ unsigned xb_add(unsigned* p, unsigned v) { return __hip_atomic_fetch_add(p, v, __ATOMIC_RELAXED, __HIP_MEMORY_SCOPE_AGENT); }
__device__ __forceinline__ unsigned xb_xcc_id() { return (unsigned)__builtin_amdgcn_s_getreg((3 << 11) | 20) & 0xFu; }
#define XB_SPIN(cond, bar) do { unsigned _sp = 0; while (cond) { __builtin_amdgcn_s_sleep(1); \
    if ((++_sp & 255u) == 0u) { if (xb_ld(&(bar)[XB_TMO])) break; if (_sp > XB_SPIN_CAP) { atomicAdd(&(bar)[XB_TMO], 1u); break; } } } } while (0)

struct XcdBarrier {
    unsigned* bar; unsigned x;
    volatile LAS unsigned* st;
};

__device__ __forceinline__ XcdBarrier xcd_barrier_post(unsigned* bar, volatile LAS unsigned* st) {
    XcdBarrier b; b.bar = bar; b.x = xb_xcc_id(); b.st = st;
    if (threadIdx.x == 0) (void)xb_add(&bar[XB_XCNT(b.x)], 1u);
    return b;
}
__device__ __forceinline__ void xcd_barrier_complete(unsigned* bar, unsigned x, unsigned& nloc, unsigned& nx) {
    const unsigned G = gridDim.x * gridDim.y * gridDim.z;
    unsigned sum, cnt, mine, sp = 0u;
    for (;;) {
        sum = 0u; cnt = 0u; mine = 0u;
#pragma unroll
        for (unsigned j = 0; j < 16; ++j) { const unsigned c = xb_ld(&bar[XB_XCNT(j)]); sum += c; cnt += (c > 0u) ? 1u : 0u; mine = (j == x) ? c : mine; }
        if (sum == G) break;
        __builtin_amdgcn_s_sleep(1);
        if ((++sp & 255u) == 0u) { if (xb_ld(&bar[XB_TMO])) break; if (sp > XB_SPIN_CAP) { atomicAdd(&bar[XB_TMO], 1u); break; } }
    }
    nloc = mine > 0u ? mine : 1u; nx = cnt > 0u ? cnt : 1u;
}

__device__ __forceinline__ void xcd_barrier(const XcdBarrier& b) {
    asm volatile("s_waitcnt vmcnt(0)" ::: "memory");
    __syncthreads();
    if (threadIdx.x == 0) {
        unsigned* bar = b.bar;
        __builtin_amdgcn_s_waitcnt(0);
        unsigned nloc = b.st[0], nx = b.st[1];
        if (nloc == 0u) { xcd_barrier_complete(bar, b.x, nloc, nx); b.st[0] = nloc; b.st[1] = nx; }
        const unsigned old = xb_add(&bar[XB_XSUB(b.x)], 1u);
        const unsigned gen = old / nloc;
        if (old + 1u == (gen + 1u) * nloc) {
            __builtin_amdgcn_fence(__ATOMIC_RELEASE, "agent");
            asm volatile("s_waitcnt vmcnt(0)" ::: "memory");
            const unsigned og = xb_add(&bar[XB_TOP], 1u);
            const unsigned tg = og / nx;
            if (og + 1u == (tg + 1u) * nx) xb_add(&bar[XB_TOPGEN], 1u);
            else XB_SPIN(xb_ld(&bar[XB_TOPGEN]) == tg, bar);
            __builtin_amdgcn_fence(__ATOMIC_ACQUIRE, "agent");
            xb_add(&bar[XB_XGEN(b.x)], 1u);
            asm volatile("s_waitcnt vmcnt(0)" ::: "memory");
        } else {
            XB_SPIN(xb_ld(&bar[XB_XGEN(b.x)]) == gen, bar);
            __builtin_amdgcn_fence(__ATOMIC_ACQUIRE, "agent");
            asm volatile("s_waitcnt vmcnt(0)" ::: "memory");
        }
    }
    __syncthreads();
}
struct Args { const void* in[21]; float* out; unsigned char* ws; int ph_lo, ph_hi; };
enum { I_X = 0, I_C, I_POS, I_WMOD, I_BMOD, I_GPRE1, I_GPOST1, I_WIN, I_CONVW, I_BI, I_BF, I_MNG, I_SINK, I_WOUT, I_GPRE2, I_GPOST2, I_WQ, I_K1, I_K2, I_U, I_V };

__device__ __forceinline__ int newcol(int o) {
    if (o < 640) { const int hd = o >> 6, d = o & 63; return (hd << 6) + 2 * (d & 31) + (d >> 5); }
    if (o < 1792) return o;
    if (o < 1800) return 2304 + (o - 1792);
    return o - 8;
}
template <bool REMAP>
__device__ __forceinline__ void p0_transpose_item(const float* W, int K, int N, bf16* WT, LAS float* scr, int item, int lane) {
    const int nblk = (N + 31) / 32, kb = item / nblk, nb = item % nblk, k0 = 64 * kb, n0 = 32 * nb;
    const int ncol = n0 + (lane & 31);
#pragma unroll 8
    for (int i = 0; i < 32; ++i) { const int kk = 2 * i + (lane >> 5); scr[kk * 33 + (lane & 31)] = (ncol < N) ? W[(size_t)(k0 + kk) * N + ncol] : 0.f; }
    LDS_WAIT(); asm volatile("" ::: "memory");
    const int c = lane & 7;
#pragma unroll
    for (int j = 0; j < 4; ++j) { const int n = (lane >> 3) + 8 * j; const LAS float* s = scr + (8 * c) * 33 + n;
        v4u o; o.x = pk2(s[0 * 33], s[1 * 33]); o.y = pk2(s[2 * 33], s[3 * 33]); o.z = pk2(s[4 * 33], s[5 * 33]); o.w = pk2(s[6 * 33], s[7 * 33]);
        if (n0 + n < N) { const int drow = REMAP ? newcol(n0 + n) : (n0 + n); *(GAS v4u*)(WT + (size_t)drow * K + k0 + 8 * c) = o; } }
    LDS_WAIT(); asm volatile("" ::: "memory");
}
__device__ __forceinline__ void p0_convert(const float* src, bf16* dst, size_t n, int gt, int ngt) {
    for (size_t i = (size_t)gt * 8; i < n; i += (size_t)ngt * 8) {
        const f32x4 a = *(const GAS f32x4*)(src + i), b = *(const GAS f32x4*)(src + i + 4);
        v4u o; o.x = pk2(a[0], a[1]); o.y = pk2(a[2], a[3]); o.z = pk2(b[0], b[1]); o.w = pk2(b[2], b[3]);
        *(GAS v4u*)(dst + i) = o; }
}
__device__ __forceinline__ void phase_mod(const Args& A, LAS unsigned char* lds) {
    const int tid = threadIdx.x, G = gridDim.x, blk = blockIdx.x;
    unsigned char* ws = A.ws;
    const float* c = (const float*)A.in[I_C]; const float* wm = (const float*)A.in[I_WMOD]; const float* bm = (const float*)A.in[I_BMOD];
    float* mod = (float*)(ws + WS_MOD); LAS float* cs = (LAS float*)lds; LAS float* red = cs + 8 * 1024;
    for (int e = tid; e < 8 * 1024 / 4; e += NTHR) *(LAS f32x4*)(cs + 4 * e) = *(const GAS f32x4*)(c + 4 * e);
    __syncthreads();
    for (int it = blk; it < 6144 / 24; it += G) {
        const int kg = tid >> 5, col = tid & 31, j = it * 24 + (col < 24 ? col : 23); float acc[8];
#pragma unroll
        for (int b = 0; b < 8; ++b) acc[b] = 0.f;
#pragma unroll 16
        for (int i = 0; i < 64; ++i) { const int k = kg + 16 * i; const float w = wm[(size_t)k * 6144 + j];
#pragma unroll
            for (int b = 0; b < 8; ++b) acc[b] += cs[b * 1024 + k] * w; }
#pragma unroll
        for (int b = 0; b < 8; ++b) red[(kg * 32 + col) * 8 + b] = acc[b];
        __syncthreads();
        if (tid < 256) { const int b = tid >> 5, cc = tid & 31; float s = 0.f;
#pragma unroll
            for (int g = 0; g < 16; ++g) s += red[(g * 32 + cc) * 8 + b];
            if (cc < 24) mod[b * 6144 + it * 24 + cc] = s + bm[it * 24 + cc]; }
        __syncthreads();
    }
}
__device__ __forceinline__ void phase_convert(const Args& A, LAS unsigned char* lds) {
    const int tid = threadIdx.x, lane = tid & 63, wave = tid >> 6, G = gridDim.x, blk = blockIdx.x;
    unsigned char* ws = A.ws;
    {
        LAS float* scr = (LAS float*)(lds + wave * 16384);
        const int gw = blk * NWAVES + wave, NGW = G * NWAVES;
        const int I_IN = (D / 64) * ((DIN + 31) / 32), I_OUT = (D / 64) * (D / 32), I_Q = (D / 64) * (2048 / 32);
        bf16* win = (bf16*)(ws + WS_WIN); bf16* wout = (bf16*)(ws + WS_WOUT); bf16* wq = (bf16*)(ws + WS_WQ);
        for (int it = gw; it < I_IN + I_OUT + I_Q; it += NGW) {
            int r = it;
            if (r < I_IN) { p0_transpose_item<true>((const float*)A.in[I_WIN], D, DIN, win, scr, r, lane); continue; } r -= I_IN;
            if (r < I_OUT) { p0_transpose_item<false>((const float*)A.in[I_WOUT], D, D, wout, scr, r, lane); continue; } r -= I_OUT;
            p0_transpose_item<false>((const float*)A.in[I_WQ], D, 2048, wq, scr, r, lane);
        }
        const int gt = blk * NTHR + tid, ngt = G * NTHR;
        for (int i = gt; i < (NIN_PAD - DIN) * D / 8; i += ngt) *(GAS v4u*)(win + (size_t)DIN * D + (size_t)i * 8) = (v4u){0u, 0u, 0u, 0u};
        p0_convert((const float*)A.in[I_K1], (bf16*)(ws + WS_KEYS), (size_t)8 * 128 * 128, gt, ngt);
        p0_convert((const float*)A.in[I_K2], (bf16*)(ws + WS_KEYS) + 8 * 128 * 128, (size_t)8 * 128 * 128, gt, ngt);
        {
            const float* usrc = (const float*)A.in[I_U]; const float* vsrc = (const float*)A.in[I_V];
            {
                auto rowp = [&](int r) { return (const GAS f32x4*)(usrc + (size_t)r * D + 16 * lane); };
                int r = gw; const GAS f32x4* sp = rowp(min(r, NEXP - 1)); f32x4 a = sp[0], b = sp[1], c = sp[2], d = sp[3];
                for (; r < NEXP; r += NGW) { const GAS f32x4* sn = rowp(min(r + NGW, NEXP - 1)); const f32x4 an = sn[0], bn = sn[1], cn = sn[2], dn = sn[3];
                    p0_row_i4(a, b, c, d, ws + WS_U8, (float*)(ws + WS_SC), r, lane);
                    a = an; b = bn; c = cn; d = dn; }
            }
            {
                auto ldv = [&](int r, f32x4& a, f32x4& b, f32x4& c, f32x4& d) { const float* sp = vsrc + (size_t)r * D + (lane >> 4) * 256 + (lane & 15);
#pragma unroll
                    for (int i = 0; i < 4; ++i) { a[i] = sp[16 * i]; b[i] = sp[16 * (4 + i)]; c[i] = sp[16 * (8 + i)]; d[i] = sp[16 * (12 + i)]; } };
                int r = gw; f32x4 a, b, c, d; ldv(min(r, NEXP - 1), a, b, c, d);
                for (; r < NEXP; r += NGW) { f32x4 an, bn, cn, dn; ldv(min(r + NGW, NEXP - 1), an, bn, cn, dn);
                    p0_row_fp4(a, b, c, d, ws + WS_V8, (float*)(ws + WS_SC) + 1, r, lane);
                    a = an; b = bn; c = cn; d = dn; }
            }
        }
    }
}

__device__ __forceinline__ void phase_prenorm(const Args& A, LAS unsigned char* lds) {
    const int tid = threadIdx.x, lane = tid & 63, wave = tid >> 6, G = gridDim.x;
    const float* x = (const float*)A.in[I_X]; const float* g = (const float*)A.in[I_GPRE1]; const float* mod = (const float*)(A.ws + WS_MOD);
    bf16* H = (bf16*)(A.ws + WS_H); float* gates = (float*)(A.ws + WS_GATES);
    LAS float* wg = (LAS float*)lds;
    __syncthreads();
    for (int k = tid; k < D; k += NTHR) { const float* wr = (const float*)A.in[I_WIN] + (size_t)k * DIN + 1792; const f32x4 w0 = *(const GAS f32x4*)wr, w1 = *(const GAS f32x4*)(wr + 4);
#pragma unroll
        for (int j = 0; j < 4; ++j) { wg[j * D + k] = w0[j]; wg[(4 + j) * D + k] = w1[j]; } }
    __syncthreads();
    const int gi = ((lane >> 5) & 1) * 4 + ((lane >> 4) & 1) * 2 + ((lane >> 3) & 1);
    const float gbias = gi < 4 ? ((const float*)A.in[I_BI])[gi] : ((const float*)A.in[I_BF])[gi - 4];
    f32x4 gg[4];
#pragma unroll
    for (int j = 0; j < 4; ++j) gg[j] = *(const GAS f32x4*)(g + 4 * (lane + 64 * j));
    const int stride = G * NWAVES; int row = blockIdx.x * NWAVES + wave;
    f32x4 v[4], vn[4], shv[4], gsv[4]; int bcur = -1;
#pragma unroll
    for (int j = 0; j < 4; ++j) v[j] = ((const GAS f32x4*)(x + (size_t)row * D) + lane)[64 * j];
    for (; row < M; row += stride) {
        const int rn = min(row + stride, M - 1);
#pragma unroll
        for (int j = 0; j < 4; ++j) vn[j] = ((const GAS f32x4*)(x + (size_t)rn * D) + lane)[64 * j];
        const int b = row / SEQ; float s = 0.f;
        if (b != bcur) { bcur = b;
#pragma unroll
            for (int j = 0; j < 4; ++j) { const int k = 4 * (lane + 64 * j); shv[j] = *(const GAS f32x4*)(mod + b * 6144 + k); const f32x4 sc = *(const GAS f32x4*)(mod + b * 6144 + 1024 + k);
#pragma unroll
                for (int i = 0; i < 4; ++i) gsv[j][i] = gg[j][i] * (1.f + sc[i]); } }
#pragma unroll
        for (int j = 0; j < 4; ++j) s += (v[j][0] * v[j][0] + v[j][1] * v[j][1]) + (v[j][2] * v[j][2] + v[j][3] * v[j][3]);
        const float rstd = __builtin_amdgcn_rsqf(wave_sum(s) * (1.f / D) + EPS);
        GAS v2u* o = (GAS v2u*)(H + (size_t)row * D) + lane;
        float gd[8];
#pragma unroll
        for (int q = 0; q < 8; ++q) gd[q] = 0.f;
#pragma unroll
        for (int j = 0; j < 4; ++j) {
            f32x4 y;
#pragma unroll
            for (int i = 0; i < 4; ++i) y[i] = v[j][i] * rstd * gsv[j][i] + shv[j][i];
            v2u w; w.x = pk2(y[0], y[1]); w.y = pk2(y[2], y[3]); o[64 * j] = w;
#pragma unroll
            for (int q = 0; q < 8; ++q) { const f32x4 ww = *(LAS const f32x4*)(wg + q * D + 4 * (lane + 64 * j)); gd[q] += (y[0] * ww[0] + y[1] * ww[1]) + (y[2] * ww[2] + y[3] * ww[3]); } }
#pragma unroll
        for (int i = 0; i < 4; ++i) { const bool up = (lane & 32) != 0; const float keep = up ? gd[i + 4] : gd[i], send = up ? gd[i] : gd[i + 4]; gd[i] = keep + __shfl_xor(send, 32); }
#pragma unroll
        for (int i = 0; i < 2; ++i) { const bool up = (lane & 16) != 0; const float keep = up ? gd[i + 2] : gd[i], send = up ? gd[i] : gd[i + 2]; gd[i] = keep + __shfl_xor(send, 16); }
        { const bool up = (lane & 8) != 0; const float keep = up ? gd[1] : gd[0], send = up ? gd[0] : gd[1]; gd[0] = keep + __shfl_xor(send, 8); }
        float gv = gd[0]; gv += __shfl_xor(gv, 4); gv += __shfl_xor(gv, 2); gv += __shfl_xor(gv, 1); gv += gbias;
        if ((lane & 7) == 0) gates[(size_t)row * 8 + gi] = gi < 4 ? gv : (fminf(gv, 0.f) - __logf(1.f + __expf(-fabsf(gv))));
#pragma unroll
        for (int j = 0; j < 4; ++j) v[j] = vn[j];
    }
}

__device__ __forceinline__ void phase_mid(const Args& A) {
    const int tid = threadIdx.x, lane = tid & 63, wave = tid >> 6, G = gridDim.x;
    const float* x = (const float*)A.in[I_X]; const float* gpost = (const float*)A.in[I_GPOST1]; const float* gpre = (const float*)A.in[I_GPRE2];
    const float* mod = (const float*)(A.ws + WS_MOD); const float* sumsq = (const float*)(A.ws + WS_SSQ);
    const bf16* MIX = (const bf16*)(A.ws + WS_MIX); bf16* H = (bf16*)(A.ws + WS_H); bf16* X1 = (bf16*)(A.ws + WS_X1);
    const int stride = G * NWAVES; int row = blockIdx.x * NWAVES + wave;
    f32x4 xv[4], xn[4], q[4], qn[4], g1p[4], gs2[4], sh2[4]; v2u mw[4], mn[4]; int bcur = -1;
#pragma unroll
    for (int j = 0; j < 4; ++j) { xv[j] = ((const GAS f32x4*)(x + (size_t)row * D) + lane)[64 * j]; mw[j] = ((const GAS v2u*)(MIX + (size_t)row * D) + lane)[64 * j]; q[j] = *(const GAS f32x4*)(sumsq + (size_t)row * 16 + 4 * j); }
    for (; row < M; row += stride) {
        const int rn = min(row + stride, M - 1);
#pragma unroll
        for (int j = 0; j < 4; ++j) { xn[j] = ((const GAS f32x4*)(x + (size_t)rn * D) + lane)[64 * j]; mn[j] = ((const GAS v2u*)(MIX + (size_t)rn * D) + lane)[64 * j]; qn[j] = *(const GAS f32x4*)(sumsq + (size_t)rn * 16 + 4 * j); }
        const int b = row / SEQ;
        if (b != bcur) { bcur = b;
#pragma unroll
            for (int j = 0; j < 4; ++j) { const int k = 4 * (lane + 64 * j); const f32x4 gp = *(const GAS f32x4*)(gpost + k), g1 = *(const GAS f32x4*)(mod + b * 6144 + 2048 + k), gg = *(const GAS f32x4*)(gpre + k), sc = *(const GAS f32x4*)(mod + b * 6144 + 4096 + k);
                sh2[j] = *(const GAS f32x4*)(mod + b * 6144 + 3072 + k);
#pragma unroll
                for (int i = 0; i < 4; ++i) { g1p[j][i] = g1[i] * gp[i]; gs2[j][i] = gg[i] * (1.f + sc[i]); } } }
        const float rm = __builtin_amdgcn_rsqf(((((q[0][0] + q[0][1]) + (q[0][2] + q[0][3])) + ((q[1][0] + q[1][1]) + (q[1][2] + q[1][3]))) + (((q[2][0] + q[2][1]) + (q[2][2] + q[2][3])) + ((q[3][0] + q[3][1]) + (q[3][2] + q[3][3])))) * (1.f / D) + EPS);
        f32x4 v[4]; float s = 0.f;
#pragma unroll
        for (int j = 0; j < 4; ++j) {
            const float mx[4] = {bflo(mw[j].x), bfhi(mw[j].x), bflo(mw[j].y), bfhi(mw[j].y)};
#pragma unroll
            for (int i = 0; i < 4; ++i) { v[j][i] = xv[j][i] + g1p[j][i] * (mx[i] * rm); s += v[j][i] * v[j][i]; }
            { v2u w; w.x = pk2(v[j][0], v[j][1]); w.y = pk2(v[j][2], v[j][3]); *((GAS v2u*)(X1 + (size_t)row * D) + lane + 64 * j) = w; } }
        const float rstd = __builtin_amdgcn_rsqf(wave_sum(s) * (1.f / D) + EPS);
        GAS v2u* o = (GAS v2u*)(H + (size_t)row * D) + lane; float amx = 0.f;
#pragma unroll
        for (int j = 0; j < 4; ++j) {
#pragma unroll
            for (int i = 0; i < 4; ++i) { v[j][i] = v[j][i] * rstd * gs2[j][i] + sh2[j][i]; amx = fmaxf(amx, fabsf(v[j][i])); }
            v2u w; w.x = pk2(v[j][0], v[j][1]); w.y = pk2(v[j][2], v[j][3]); o[64 * j] = w; }
        amx = wave_max(amx); const float s8 = amx > 0.f ? 119.0f * __builtin_amdgcn_rcpf(amx) : 1.0f;
        GAS unsigned short* ohh = (GAS unsigned short*)((unsigned char*)A.ws + WS_H8 + (size_t)row * (D / 2)) + lane; GAS unsigned short* ohl = (GAS unsigned short*)((unsigned char*)A.ws + WS_H8 + 32 * MiB + (size_t)row * (D / 2)) + lane;
#pragma unroll
        for (int j = 0; j < 4; ++j) { unsigned whh = 0, whl = 0;
#pragma unroll
            for (int i = 0; i < 4; ++i) { const int tq = __float2int_rn(v[j][i] * s8) + 8; whh |= ((unsigned)(tq >> 4) & 15u) << (4 * i); whl |= ((unsigned)((tq & 15) - 8) & 15u) << (4 * i); }
            ohh[64 * j] = (unsigned short)whh; ohl[64 * j] = (unsigned short)whl; }
        if (lane == 0) ((float*)(A.ws + WS_HS))[row] = amx > 0.f ? amx * (1.0f / 119.0f) : 1.0f;
#pragma unroll
        for (int j = 0; j < 4; ++j) { xv[j] = xn[j]; mw[j] = mn[j]; q[j] = qn[j]; }
    }
}
__device__ __forceinline__ void load64bf(const bf16* p, float (&o)[64]) {
#pragma unroll
    for (int i = 0; i < 8; ++i) { const v4u w = *(const GAS v4u*)(p + 8 * i);
        o[8 * i + 0] = bflo(w.x); o[8 * i + 1] = bfhi(w.x); o[8 * i + 2] = bflo(w.y); o[8 * i + 3] = bfhi(w.y);
        o[8 * i + 4] = bflo(w.z); o[8 * i + 5] = bfhi(w.z); o[8 * i + 6] = bflo(w.w); o[8 * i + 7] = bfhi(w.w); }
}
__device__ __forceinline__ void phase_attn_naive(const Args& A, int vb, int nvb) {
    const bf16* P = (const bf16*)(A.ws + WS_PROJ); bf16* MI = (bf16*)(A.ws + WS_MIXIN); const float* sinks = (const float*)A.in[I_SINK];
    for (int task = vb * NTHR + (int)threadIdx.x; task < 8 * M; task += nvb * NTHR) {
        const int h = task / M, t = task % M, s = t % SEQ, kvh = h >> 2;
        float q[64], o[64];
        load64bf(P + (size_t)t * NPROJ + C_AQ + h * 64, q);
#pragma unroll
        for (int d = 0; d < 64; ++d) o[d] = 0.f;
        float mx = sinks[h], l = 1.f;
        for (int j = 0; j < 128; ++j) {
            const int sj = s - 127 + j; const bool valid = sj >= 0; const int tk = valid ? (t - 127 + j) : t;
            const bf16* kr = P + (size_t)tk * NPROJ + C_AK + kvh * 64; float sc = 0.f;
#pragma unroll
            for (int i = 0; i < 8; ++i) { const v4u w = *(const GAS v4u*)(kr + 8 * i);
                sc += q[8 * i + 0] * bflo(w.x) + q[8 * i + 1] * bfhi(w.x) + q[8 * i + 2] * bflo(w.y) + q[8 * i + 3] * bfhi(w.y)
                    + q[8 * i + 4] * bflo(w.z) + q[8 * i + 5] * bfhi(w.z) + q[8 * i + 6] * bflo(w.w) + q[8 * i + 7] * bfhi(w.w); }
            if (valid) {
                const float mn = fmaxf(mx, sc), al = __expf(mx - mn), p = __expf(sc - mn); mx = mn; l = l * al + p;
                const bf16* vr = P + (size_t)tk * NPROJ + C_AV + kvh * 64;
#pragma unroll
                for (int i = 0; i < 8; ++i) { const v4u w = *(const GAS v4u*)(vr + 8 * i);
                    o[8 * i + 0] = o[8 * i + 0] * al + p * bflo(w.x); o[8 * i + 1] = o[8 * i + 1] * al + p * bfhi(w.x);
                    o[8 * i + 2] = o[8 * i + 2] * al + p * bflo(w.y); o[8 * i + 3] = o[8 * i + 3] * al + p * bfhi(w.y);
                    o[8 * i + 4] = o[8 * i + 4] * al + p * bflo(w.z); o[8 * i + 5] = o[8 * i + 5] * al + p * bfhi(w.z);
                    o[8 * i + 6] = o[8 * i + 6] * al + p * bflo(w.w); o[8 * i + 7] = o[8 * i + 7] * al + p * bfhi(w.w); }
            }
        }
        const float il = 1.f / l; bf16* orow = MI + (size_t)t * D + h * 64;
#pragma unroll
        for (int i = 0; i < 8; ++i) { v4u w; w.x = pk2(o[8 * i] * il, o[8 * i + 1] * il); w.y = pk2(o[8 * i + 2] * il, o[8 * i + 3] * il);
            w.z = pk2(o[8 * i + 4] * il, o[8 * i + 5] * il); w.w = pk2(o[8 * i + 6] * il, o[8 * i + 7] * il); *(GAS v4u*)(orow + 8 * i) = w; }
    }
}

__device__ __forceinline__ void phase_mlstm_naive(const Args& A, LAS unsigned char* lds, int bh) {
    const int tid = threadIdx.x, lane = tid & 63, wave = tid >> 6, b = bh >> 2, h = bh & 3, dv = tid >> 2, part = tid & 3;
    const bf16* P = (const bf16*)(A.ws + WS_PROJ); bf16* MI = (bf16*)(A.ws + WS_MIXIN); const float* gates = (const float*)(A.ws + WS_GATES);
    const float* cw = (const float*)A.in[I_CONVW]; const float* ng = (const float*)A.in[I_MNG];
    LAS float* qs = (LAS float*)lds; LAS float* ks = qs + 64 * 64; LAS float* vs = ks + 64 * 64; LAS float* ig = vs + 64 * 128; LAS float* lfg = ig + 64; LAS float* hb = lfg + 64;
    float C[16], n[16]; float m = 0.f;
#pragma unroll
    for (int j = 0; j < 16; ++j) { C[j] = 0.f; n[j] = 0.f; }
    for (int ch = 0; ch < SEQ / 64; ++ch) {
        const int s0 = ch * 64; const size_t t0 = (size_t)b * SEQ + s0;
        for (int e = tid; e < 64 * 64; e += NTHR) { const int l = e >> 6, dk = e & 63; float aq = 0.f, ak = 0.f;
#pragma unroll
            for (int j = 0; j < 4; ++j) { const int sj = s0 + l - 3 + j; if (sj >= 0) { const bf16* r = P + ((size_t)b * SEQ + sj) * NPROJ;
                aq += cw[j * 512 + h * 64 + dk] * bf1(r[C_MQ + h * 64 + dk]); ak += cw[j * 512 + 256 + h * 64 + dk] * bf1(r[C_MK + h * 64 + dk]); } }
            qs[e] = 0.125f * aq / (1.f + __expf(-aq)); ks[e] = ak / (1.f + __expf(-ak)); }
        for (int e = tid; e < 64 * 128; e += NTHR) { const int l = e >> 7, d = e & 127; vs[e] = bf1(P[(t0 + l) * NPROJ + C_MV + h * 128 + d]); }
        if (tid < 64) { ig[tid] = gates[(t0 + tid) * 8 + h]; lfg[tid] = gates[(t0 + tid) * 8 + 4 + h]; }
        __syncthreads();
        for (int l = 0; l < 64; ++l) {
            const float lf = lfg[l], ii = ig[l], mn = fmaxf(lf + m, ii), fd = __expf(lf + m - mn), iw = __expf(ii - mn), vv = vs[l * 128 + dv] * iw;
            float num = 0.f, den = 0.f;
#pragma unroll
            for (int j = 0; j < 16; ++j) { const float kk = ks[l * 64 + part * 16 + j], qq = qs[l * 64 + part * 16 + j];
                C[j] = fd * C[j] + vv * kk; n[j] = fd * n[j] + iw * kk; num += C[j] * qq; den += n[j] * qq; }
            num += __shfl_xor(num, 1); num += __shfl_xor(num, 2); den += __shfl_xor(den, 1); den += __shfl_xor(den, 2);
            if (part == 0) hb[l * 128 + dv] = num / fmaxf(fabsf(den), __expf(-mn));
            m = mn;
        }
        __syncthreads();
        for (int l = wave * 8; l < wave * 8 + 8; ++l) { const float a0 = hb[l * 128 + lane], a1 = hb[l * 128 + 64 + lane];
            const float r = 1.0f / sqrtf(wave_sum(a0 * a0 + a1 * a1) * (1.f / 128.f) + EPS);
            const bf16* pr = P + (t0 + l) * NPROJ + C_MO + h * 128; bf16* orow = MI + (t0 + l) * D + 512 + h * 128;
            orow[lane] = (bf16)f2bf(a0 * r * ng[h * 128 + lane] * bf1(pr[lane])); orow[64 + lane] = (bf16)f2bf(a1 * r * ng[h * 128 + 64 + lane] * bf1(pr[64 + lane])); }
        __syncthreads();
    }
}

__device__ __forceinline__ void ld16bf(const bf16* p, float (&o)[16]) {
    const v4u w0 = *(const GAS v4u*)p, w1 = *(const GAS v4u*)(p + 8);
    o[0] = bflo(w0.x); o[1] = bfhi(w0.x); o[2] = bflo(w0.y); o[3] = bfhi(w0.y); o[4] = bflo(w0.z); o[5] = bfhi(w0.z); o[6] = bflo(w0.w); o[7] = bfhi(w0.w);
    o[8] = bflo(w1.x); o[9] = bfhi(w1.x); o[10] = bflo(w1.y); o[11] = bfhi(w1.y); o[12] = bflo(w1.z); o[13] = bfhi(w1.z); o[14] = bflo(w1.w); o[15] = bfhi(w1.w);
}
typedef short bf16x8 __attribute__((ext_vector_type(8)));
#define MFMA16(a, b, c) __builtin_amdgcn_mfma_f32_16x16x32_bf16((a), (b), (c), 0, 0, 0)
__device__ __forceinline__ bf16x8 ldfrag(LAS const unsigned char* img, int row, int kbyte) { return *(LAS const bf16x8*)(img + row * 144 + kbyte); }
__device__ __forceinline__ bf16x8 ldfrag_sw(LAS const unsigned char* img, int row, int kbyte) { return *(LAS const bf16x8*)(img + row * 144 + (kbyte ^ (((row >> 3) & 7) << 4))); }
__device__ __forceinline__ unsigned cvtpk(float lo, float hi) { unsigned r; asm volatile("v_cvt_pk_bf16_f32 %0, %1, %2" : "=v"(r) : "v"(lo), "v"(hi)); return r; }

namespace ml {
constexpr int O_Q = 0, O_QA = 9216, O_K = 18432, O_KWT = 27648, O_VT = 36864, O_CX = 57600, CXB = 20736, O_S = 99072, O_GB = 108288, O_GA = O_GB + 4096, O_GC = O_GA + 4096, O_DEN = O_GC + 4096, O_SSQ = O_DEN + 256, O_END = O_SSQ + 2048;
static_assert(O_END <= 131072, "mlstm LDS");
constexpr size_t MST_SC = 11 * MiB;
}
template <bool OUT>
__device__ __forceinline__ void mlstm_group(const Args& A, LAS unsigned char* lds, int wg) {
    using namespace ml;
    const int tid = threadIdx.x, lane = tid & 63, wave = __builtin_amdgcn_readfirstlane(tid >> 6), fr = lane & 15, fq = lane >> 4;
    const int bh = wg >> 3, grp = wg & 7, b = bh >> 2, h = bh & 3;
    const size_t tg0 = (size_t)b * SEQ + (size_t)grp * 1024;
    const bf16* P = (const bf16*)(A.ws + WS_PROJ); bf16* MI = (bf16*)(A.ws + WS_MIXIN); const float* gates = (const float*)(A.ws + WS_GATES);
    const float* cw = (const float*)A.in[I_CONVW]; const float* ng = (const float*)A.in[I_MNG];
    float* MST = (float*)(A.ws + WS_MST); float* MSC = (float*)(A.ws + WS_MST + MST_SC);
    LAS float* GB = (LAS float*)(lds + O_GB); LAS float* GA = (LAS float*)(lds + O_GA); LAS float* GC = (LAS float*)(lds + O_GC);
    LAS float* DEN = (LAS float*)(lds + O_DEN); LAS float* SSQ = (LAS float*)(lds + O_SSQ);
    __syncthreads();
#pragma unroll
    for (int cc = 0; cc < 2; ++cc) { const int c = 2 * wave + cc; const size_t t = tg0 + c * 64 + lane;
        float bc = gates[t * 8 + 4 + h]; const float ii = gates[t * 8 + h];
#pragma unroll
        for (int o = 1; o < 64; o <<= 1) { const float v = __shfl_up(bc, o); if (lane >= o) bc += v; }
        const float a = ii - bc; float cm = a;
#pragma unroll
        for (int o = 1; o < 64; o <<= 1) { const float v = __shfl_up(cm, o); if (lane >= o) cm = fmaxf(cm, v); }
        GB[c * 64 + lane] = bc; GA[c * 64 + lane] = a; GC[c * 64 + lane] = cm; }
    for (int e = tid; e < 16 * 32; e += NTHR) { const int r = e >> 5, cpair = e & 31; *(LAS unsigned*)(lds + O_VT + (128 + r) * 144 + cpair * 4) = (r == 0) ? 0x3F803F80u : 0u; }
    f32x4 st[5];
#pragma unroll
    for (int i = 0; i < 5; ++i) st[i] = (f32x4){0.f, 0.f, 0.f, 0.f};
    float m = OUT ? 0.f : -__builtin_inff(); float Btot = 0.f;
    if (OUT) {
        float nx[20], mgn = 0.f, Bgn = 0.f;
        auto ld_grp = [&](int gp) { const int wgp = bh * 8 + gp; mgn = MSC[wgp * 2]; Bgn = MSC[wgp * 2 + 1];
#pragma unroll
            for (int q = 0; q < 20; ++q) nx[q] = MST[((size_t)wgp * 20 + q) * NTHR + tid]; };
        if (grp > 0) ld_grp(0);
        for (int gp = 0; gp < grp; ++gp) { float cu[20]; const float mg = mgn, Bg = Bgn;
#pragma unroll
            for (int q = 0; q < 20; ++q) cu[q] = nx[q];
            if (gp + 1 < grp) ld_grp(gp + 1);
            const float mn = fmaxf(Bg + m, mg), f0 = __expf(Bg + m - mn), f1 = __expf(mg - mn);
#pragma unroll
            for (int i = 0; i < 5; ++i)
#pragma unroll
                for (int r = 0; r < 4; ++r) st[i][r] = f0 * st[i][r] + f1 * cu[i * 4 + r];
            m = mn; }
#pragma unroll
        for (int j = 0; j < 4; ++j)
#pragma unroll
            for (int r = 0; r < 4; ++r) *(LAS bf16*)(lds + O_CX + (16 * wave + 4 * fq + r) * 144 + (16 * j + fr) * 2) = (bf16)f2bf(st[j][r]);
        if (wave < 4) {
#pragma unroll
            for (int r = 0; r < 4; ++r) *(LAS bf16*)(lds + O_CX + (128 + 4 * fq + r) * 144 + (16 * wave + fr) * 2) = (bf16)f2bf(st[4][r]); }
    }
    float gsc[4];
#pragma unroll
    for (int r = 0; r < 4; ++r) gsc[r] = ng[h * 128 + 16 * wave + 4 * fq + r];
    const int sl = tid >> 3, cg = tid & 7;
    v4u pk[4], pvv[2]; f32x4 kw0[4], kw1[4];
    auto ld_rows = [&](int c) { const int sabs = grp * 1024 + c * 64 + sl;
#pragma unroll
        for (int j = 0; j < 4; ++j) { const int sj = max(sabs - 3 + j, 0); pk[j] = *(const GAS v4u*)(P + ((size_t)b * SEQ + sj) * NPROJ + C_MK + h * 64 + 8 * cg); }
#pragma unroll
        for (int gi = 0; gi < 2; ++gi) pvv[gi] = *(const GAS v4u*)(P + (tg0 + (size_t)c * 64 + sl) * NPROJ + C_MV + h * 128 + 8 * (cg + 8 * gi)); };
    if (!OUT) {
#pragma unroll
        for (int j = 0; j < 4; ++j) { kw0[j] = *(const GAS f32x4*)(cw + j * 512 + 256 + h * 64 + 8 * cg); kw1[j] = *(const GAS f32x4*)(cw + j * 512 + 256 + h * 64 + 8 * cg + 4); }
        ld_rows(0); }
    __syncthreads();
    for (int c = 0; c < 16; ++c) {
        const float bL = GB[c * 64 + 63], M63 = fmaxf(m, GC[c * 64 + 63]), decay = __expf(m - M63);
        const size_t tc0 = tg0 + (size_t)c * 64;
        if (!OUT) {
            const int sabs = grp * 1024 + c * 64 + sl; float ak[8];
#pragma unroll
            for (int i = 0; i < 8; ++i) ak[i] = 0.f;
#pragma unroll
            for (int j = 0; j < 4; ++j) { const float on = (sabs - 3 + j >= 0) ? 1.0f : 0.0f; const v4u wk = pk[j]; const f32x4 k0 = kw0[j] * on, k1 = kw1[j] * on;
                ak[0] += k0[0] * bflo(wk.x); ak[1] += k0[1] * bfhi(wk.x); ak[2] += k0[2] * bflo(wk.y); ak[3] += k0[3] * bfhi(wk.y);
                ak[4] += k1[0] * bflo(wk.z); ak[5] += k1[1] * bfhi(wk.z); ak[6] += k1[2] * bflo(wk.w); ak[7] += k1[3] * bfhi(wk.w); }
            const v4u wv0 = pvv[0], wv1 = pvv[1];
            if (c + 1 < 16) ld_rows(c + 1);
            const float wsv = __expf(GA[c * 64 + sl] - M63);
#pragma unroll
            for (int i = 0; i < 8; ++i) { const float kvv = ak[i] * __builtin_amdgcn_rcpf(1.f + __expf(-ak[i])); *(LAS bf16*)(lds + O_KWT + (8 * cg + i) * 144 + (sl ^ (8 * cg)) * 2) = (bf16)f2bf(kvv * wsv); }
#pragma unroll
            for (int gi = 0; gi < 2; ++gi) { const int g8 = cg + 8 * gi; const v4u wv = gi ? wv1 : wv0; const unsigned ww[4] = {wv.x, wv.y, wv.z, wv.w};
#pragma unroll
                for (int i = 0; i < 4; ++i) { *(LAS bf16*)(lds + O_VT + (8 * g8 + 2 * i) * 144 + (sl ^ (8 * cg)) * 2) = (bf16)(ww[i] & 0xffffu); *(LAS bf16*)(lds + O_VT + (8 * g8 + 2 * i + 1) * 144 + (sl ^ (8 * cg)) * 2) = (bf16)(ww[i] >> 16); } }
        } else {
            const int sabs = grp * 1024 + c * 64 + sl;
            float aq[8], ak[8];
#pragma unroll
            for (int i = 0; i < 8; ++i) { aq[i] = 0.f; ak[i] = 0.f; }
#pragma unroll
            for (int j = 0; j < 4; ++j) { const int sj = sabs - 3 + j;
                if (sj >= 0) { const bf16* rp = P + ((size_t)b * SEQ + sj) * NPROJ;
                    const v4u wq = *(const GAS v4u*)(rp + C_MQ + h * 64 + 8 * cg), wk = *(const GAS v4u*)(rp + C_MK + h * 64 + 8 * cg);
                    const f32x4 q0 = *(const GAS f32x4*)(cw + j * 512 + h * 64 + 8 * cg), q1 = *(const GAS f32x4*)(cw + j * 512 + h * 64 + 8 * cg + 4);
                    const f32x4 k0 = *(const GAS f32x4*)(cw + j * 512 + 256 + h * 64 + 8 * cg), k1 = *(const GAS f32x4*)(cw + j * 512 + 256 + h * 64 + 8 * cg + 4);
                    aq[0] += q0[0] * bflo(wq.x); aq[1] += q0[1] * bfhi(wq.x); aq[2] += q0[2] * bflo(wq.y); aq[3] += q0[3] * bfhi(wq.y);
                    aq[4] += q1[0] * bflo(wq.z); aq[5] += q1[1] * bfhi(wq.z); aq[6] += q1[2] * bflo(wq.w); aq[7] += q1[3] * bfhi(wq.w);
                    ak[0] += k0[0] * bflo(wk.x); ak[1] += k0[1] * bfhi(wk.x); ak[2] += k0[2] * bflo(wk.y); ak[3] += k0[3] * bfhi(wk.y);
                    ak[4] += k1[0] * bflo(wk.z); ak[5] += k1[1] * bfhi(wk.z); ak[6] += k1[2] * bflo(wk.w); ak[7] += k1[3] * bfhi(wk.w); } }
            const float Ml = fmaxf(m, GC[c * 64 + sl]), ainter = __expf(m - Ml), wsv = __expf(GA[c * 64 + sl] - M63);
            float qv[8], kv[8];
#pragma unroll
            for (int i = 0; i < 8; ++i) { qv[i] = 0.125f * aq[i] * __builtin_amdgcn_rcpf(1.f + __expf(-aq[i])); kv[i] = ak[i] * __builtin_amdgcn_rcpf(1.f + __expf(-ak[i])); }
            if (OUT) {
                v4u w; w.x = pk2(qv[0], qv[1]); w.y = pk2(qv[2], qv[3]); w.z = pk2(qv[4], qv[5]); w.w = pk2(qv[6], qv[7]); *(LAS v4u*)(lds + O_Q + sl * 144 + cg * 16) = w;
                w.x = pk2(qv[0] * ainter, qv[1] * ainter); w.y = pk2(qv[2] * ainter, qv[3] * ainter); w.z = pk2(qv[4] * ainter, qv[5] * ainter); w.w = pk2(qv[6] * ainter, qv[7] * ainter); *(LAS v4u*)(lds + O_QA + sl * 144 + cg * 16) = w;
                w.x = pk2(kv[0], kv[1]); w.y = pk2(kv[2], kv[3]); w.z = pk2(kv[4], kv[5]); w.w = pk2(kv[6], kv[7]); *(LAS v4u*)(lds + O_K + sl * 144 + cg * 16) = w;
            }
#pragma unroll
            for (int i = 0; i < 8; ++i) *(LAS bf16*)(lds + O_KWT + (8 * cg + i) * 144 + (sl ^ (8 * cg)) * 2) = (bf16)f2bf(kv[i] * wsv);
#pragma unroll
            for (int gi = 0; gi < 2; ++gi) { const int g8 = cg + 8 * gi; const v4u wv = *(const GAS v4u*)(P + (tc0 + sl) * NPROJ + C_MV + h * 128 + 8 * g8);
                const unsigned ww[4] = {wv.x, wv.y, wv.z, wv.w};
#pragma unroll
                for (int i = 0; i < 4; ++i) { *(LAS bf16*)(lds + O_VT + (8 * g8 + 2 * i) * 144 + (sl ^ (8 * cg)) * 2) = (bf16)(ww[i] & 0xffffu); *(LAS bf16*)(lds + O_VT + (8 * g8 + 2 * i + 1) * 144 + (sl ^ (8 * cg)) * 2) = (bf16)(ww[i] >> 16); } }
        }
        LDS_SYNC();
        v2u mo[4];
        if (OUT) {
#pragma unroll
            for (int lt = 0; lt < 4; ++lt) mo[lt] = *(const GAS v2u*)(P + (tc0 + 16 * lt + fr) * NPROJ + C_MO + h * 128 + 16 * wave + 4 * fq); }
        if (OUT) {
            const int lt = wave >> 1, l = 16 * lt + fr; const float Ml = fmaxf(m, GC[c * 64 + l]);
            const bf16x8 bq0 = ldfrag(lds + O_Q, 16 * lt + fr, 16 * fq), bq1 = ldfrag(lds + O_Q, 16 * lt + fr, 64 + 16 * fq);
#pragma unroll
            for (int u = 0; u < 2; ++u) { const int stl = 2 * (wave & 1) + u; f32x4 acc = {0.f, 0.f, 0.f, 0.f};
                acc = MFMA16(ldfrag(lds + O_K, 16 * stl + fr, 16 * fq), bq0, acc); acc = MFMA16(ldfrag(lds + O_K, 16 * stl + fr, 64 + 16 * fq), bq1, acc);
                const f32x4 av = *(LAS const f32x4*)(GA + c * 64 + 16 * stl + 4 * fq); float wv[4];
#pragma unroll
                for (int r = 0; r < 4; ++r) { const int s = 16 * stl + 4 * fq + r; wv[r] = (s <= l) ? acc[r] * __expf(av[r] - Ml) : 0.f; }
                v2u w; w.x = cvtpk(wv[0], wv[1]); w.y = cvtpk(wv[2], wv[3]); *(LAS v2u*)(lds + O_S + l * 144 + (16 * stl + 4 * fq) * 2) = w; }
        }
        {
            const bf16x8 va0 = ldfrag_sw(lds + O_VT, 16 * wave + fr, 16 * fq), va1 = ldfrag_sw(lds + O_VT, 16 * wave + fr, 64 + 16 * fq);
#pragma unroll
            for (int j = 0; j < 4; ++j) { st[j] = st[j] * decay;
                st[j] = MFMA16(va0, ldfrag_sw(lds + O_KWT, 16 * j + fr, 16 * fq), st[j]); st[j] = MFMA16(va1, ldfrag_sw(lds + O_KWT, 16 * j + fr, 64 + 16 * fq), st[j]); }
            if (wave < 4) { st[4] = st[4] * decay;
                st[4] = MFMA16(ldfrag_sw(lds + O_VT, 128 + fr, 16 * fq), ldfrag_sw(lds + O_KWT, 16 * wave + fr, 16 * fq), st[4]);
                st[4] = MFMA16(ldfrag_sw(lds + O_VT, 128 + fr, 64 + 16 * fq), ldfrag_sw(lds + O_KWT, 16 * wave + fr, 64 + 16 * fq), st[4]); }
        }
        if (OUT) {
            LDS_SYNC();
            LAS const unsigned char* cx = lds + O_CX + (c & 1) * CXB;
            f32x4 nt[4], nd = {0.f, 0.f, 0.f, 0.f};
            {
                const bf16x8 va0 = ldfrag_sw(lds + O_VT, 16 * wave + fr, 16 * fq), va1 = ldfrag_sw(lds + O_VT, 16 * wave + fr, 64 + 16 * fq);
                const bf16x8 ca0 = ldfrag(cx, 16 * wave + fr, 16 * fq), ca1 = ldfrag(cx, 16 * wave + fr, 64 + 16 * fq);
#pragma unroll
                for (int lt = 0; lt < 4; ++lt) { f32x4 acc = {0.f, 0.f, 0.f, 0.f};
                    acc = MFMA16(va0, ldfrag(lds + O_S, 16 * lt + fr, 16 * fq), acc); acc = MFMA16(va1, ldfrag(lds + O_S, 16 * lt + fr, 64 + 16 * fq), acc);
                    acc = MFMA16(ca0, ldfrag(lds + O_QA, 16 * lt + fr, 16 * fq), acc); acc = MFMA16(ca1, ldfrag(lds + O_QA, 16 * lt + fr, 64 + 16 * fq), acc); nt[lt] = acc; }
                if (wave >= 4) { const int lt = wave - 4;
                    nd = MFMA16(ldfrag_sw(lds + O_VT, 128 + fr, 16 * fq), ldfrag(lds + O_S, 16 * lt + fr, 16 * fq), nd); nd = MFMA16(ldfrag_sw(lds + O_VT, 128 + fr, 64 + 16 * fq), ldfrag(lds + O_S, 16 * lt + fr, 64 + 16 * fq), nd);
                    nd = MFMA16(ldfrag(cx, 128 + fr, 16 * fq), ldfrag(lds + O_QA, 16 * lt + fr, 16 * fq), nd); nd = MFMA16(ldfrag(cx, 128 + fr, 64 + 16 * fq), ldfrag(lds + O_QA, 16 * lt + fr, 64 + 16 * fq), nd);
                    if (fq == 0) DEN[16 * lt + fr] = nd[0]; }
            }
#pragma unroll
            for (int lt = 0; lt < 4; ++lt) { float ss = (nt[lt][0] * nt[lt][0] + nt[lt][1] * nt[lt][1]) + (nt[lt][2] * nt[lt][2] + nt[lt][3] * nt[lt][3]);
                ss += __shfl_xor(ss, 16); ss += __shfl_xor(ss, 32);
                if (fq == 0) SSQ[wave * 64 + 16 * lt + fr] = ss; }
            LDS_SYNC();
            LAS unsigned char* cxn = lds + O_CX + ((c + 1) & 1) * CXB;
#pragma unroll
            for (int j = 0; j < 4; ++j)
#pragma unroll
                for (int r = 0; r < 4; ++r) *(LAS bf16*)(cxn + (16 * wave + 4 * fq + r) * 144 + (16 * j + fr) * 2) = (bf16)f2bf(st[j][r]);
            if (wave < 4) {
#pragma unroll
                for (int r = 0; r < 4; ++r) *(LAS bf16*)(cxn + (128 + 4 * fq + r) * 144 + (16 * wave + fr) * 2) = (bf16)f2bf(st[4][r]); }
#pragma unroll
            for (int lt = 0; lt < 4; ++lt) { const int l = 16 * lt + fr; float tot = 0.f; const float Ml = fmaxf(m, GC[c * 64 + l]);
                const float inv = __builtin_amdgcn_rcpf(fmaxf(fabsf(DEN[l]), __expf(-(GB[c * 64 + l] + Ml))));
#pragma unroll
                for (int w2 = 0; w2 < 8; ++w2) tot += SSQ[w2 * 64 + l];
                const float rn = inv * __builtin_amdgcn_rsqf(tot * (inv * inv) * (1.f / 128.f) + EPS);
                const float o0 = nt[lt][0] * rn * gsc[0] * bflo(mo[lt].x), o1 = nt[lt][1] * rn * gsc[1] * bfhi(mo[lt].x), o2 = nt[lt][2] * rn * gsc[2] * bflo(mo[lt].y), o3 = nt[lt][3] * rn * gsc[3] * bfhi(mo[lt].y);
                v2u w; w.x = pk2(o0, o1); w.y = pk2(o2, o3);
                *(GAS v2u*)(MI + (tc0 + l) * D + 512 + h * 128 + 16 * wave + 4 * fq) = w; }
        } else {
            LDS_SYNC();
        }
        m = bL + M63; Btot += bL;
    }
    if (!OUT) {
#pragma unroll
        for (int i = 0; i < 5; ++i)
#pragma unroll
            for (int r = 0; r < 4; ++r) MST[((size_t)wg * 20 + i * 4 + r) * NTHR + tid] = st[i][r];
        if (tid == 0) { MSC[wg * 2] = m; MSC[wg * 2 + 1] = Btot; }
    }
}

namespace at {
constexpr int O_K = 0, O_VT = 36864, VTS = 592  , O_END = O_VT + 64 * VTS;
static_assert(O_END <= 131072, "attention LDS");
}
__device__ __forceinline__ void phase_attn(const Args& A, LAS unsigned char* lds) {
    using namespace at;
    const int tid = threadIdx.x, lane = tid & 63, wave = __builtin_amdgcn_readfirstlane(tid >> 6), fr = lane & 15, fq = lane >> 4, G = gridDim.x;
    const bf16* P = (const bf16*)(A.ws + WS_PROJ); bf16* MI = (bf16*)(A.ws + WS_MIXIN); const float* sinks = (const float*)A.in[I_SINK];
    __syncthreads();
    for (int e = tid; e < 64 * 16; e += NTHR) { const int r = e >> 4, cpair = e & 15; *(LAS unsigned*)(lds + O_VT + r * VTS + 512 + cpair * 4) = 0u; }
    v4u pk_[4], pv_[4];
#define ATT_LOAD(uu) do { const int g_ = (uu) & 1, n_ = ((uu) >> 1) & 63, b_ = (uu) >> 7; const size_t tq_ = (size_t)b_ * SEQ + (size_t)n_ * 128; _Pragma("unroll") for (int i_ = 0; i_ < 4; ++i_) { const int item_ = tid + NTHR * i_, row_ = item_ >> 3, ch_ = item_ & 7; \
        pk_[i_] = (v4u){0u, 0u, 0u, 0u}; pv_[i_] = (v4u){0u, 0u, 0u, 0u}; if (n_ > 0 || row_ >= 128) { const bf16* rp_ = P + (tq_ - 128 + row_) * NPROJ; pk_[i_] = *(const GAS v4u*)(rp_ + C_AK + g_ * 64 + 8 * ch_); pv_[i_] = *(const GAS v4u*)(rp_ + C_AV + g_ * 64 + 8 * ch_); } } } while (0)
    bf16x8 bqa, bqb;
#define ATT_LOADQ(uu, qt_) do { const int g_ = (uu) & 1, n_ = ((uu) >> 1) & 63, b_ = (uu) >> 7; const size_t tq_ = (size_t)b_ * SEQ + (size_t)n_ * 128; \
        const bf16* qp_ = P + (tq_ + 64 * (wave & 1) + 16 * (qt_) + fr) * NPROJ + C_AQ + (4 * g_ + (wave >> 1)) * 64 + 8 * fq; bqa = *(const GAS bf16x8*)qp_; bqb = *(const GAS bf16x8*)(qp_ + 32); } while (0)
    if ((int)blockIdx.x < NB * 64 * 2) { ATT_LOAD((int)blockIdx.x); ATT_LOADQ((int)blockIdx.x, 0); }
    for (int unit = blockIdx.x; unit < NB * 64 * 2; unit += G) {
        const int g = unit & 1, n = (unit >> 1) & 63, b = unit >> 7;
        const size_t tq0 = (size_t)b * SEQ + (size_t)n * 128;
        LDS_SYNC();
#pragma unroll
        for (int i = 0; i < 4; ++i) { const int item = tid + NTHR * i, row = item >> 3, ch = item & 7;
            const v4u wk = pk_[i], wv = pv_[i];
            *(LAS v4u*)(lds + O_K + row * 144 + ch * 16) = wk;
            const unsigned ww[4] = {wv.x, wv.y, wv.z, wv.w};
#pragma unroll
            for (int k = 0; k < 4; ++k) { *(LAS bf16*)(lds + O_VT + (8 * ch + 2 * k) * VTS + (row ^ (4 * ch)) * 2) = (bf16)(ww[k] & 0xffffu); *(LAS bf16*)(lds + O_VT + (8 * ch + 2 * k + 1) * VTS + (row ^ (4 * ch)) * 2) = (bf16)(ww[k] >> 16); } }
        if (unit + G < NB * 64 * 2) ATT_LOAD(unit + G);
        const int hq = 4 * g + (wave >> 1), qr0 = 64 * (wave & 1); const float sink = sinks[hq];
        LDS_SYNC();
        for (int qt = 0; qt < 4; ++qt) {
            const int i0 = qr0 + 16 * qt, st0 = i0 >> 4, iq = i0 + fr;
            const bf16x8 bq0 = bqa, bq1 = bqb;
            { const int un = (qt < 3) ? unit : min(unit + (int)G, NB * 64 * 2 - 1), qn = (qt < 3) ? qt + 1 : 0; ATT_LOADQ(un, qn); }
            f32x4 sc[9]; float mx = sink;
#pragma unroll
            for (int t = 0; t < 9; ++t) { const int sb0 = 16 * (st0 + t); f32x4 acc = {0.f, 0.f, 0.f, 0.f};
                acc = MFMA16(ldfrag(lds + O_K, sb0 + fr, 16 * fq), bq0, acc); acc = MFMA16(ldfrag(lds + O_K, sb0 + fr, 64 + 16 * fq), bq1, acc);
                if (t == 0) {
#pragma unroll
                    for (int r = 0; r < 4; ++r) acc[r] = (4 * fq + r > fr) ? acc[r] : -3.0e38f; }
                if (t == 8) {
#pragma unroll
                    for (int r = 0; r < 4; ++r) acc[r] = (4 * fq + r <= fr) ? acc[r] : -3.0e38f; }
                if (n == 0) {
#pragma unroll
                    for (int r = 0; r < 4; ++r) acc[r] = (sb0 + 4 * fq + r >= 128) ? acc[r] : -3.0e38f; }
#pragma unroll
                for (int r = 0; r < 4; ++r) mx = fmaxf(mx, acc[r]);
                sc[t] = acc; }
            mx = fmaxf(mx, __shfl_xor(mx, 16)); mx = fmaxf(mx, __shfl_xor(mx, 32));
            float lsum = 0.f;
#pragma unroll
            for (int t = 0; t < 9; ++t)
#pragma unroll
                for (int r = 0; r < 4; ++r) { const float p = __expf(sc[t][r] - mx); sc[t][r] = p; lsum += p; }
            lsum += __shfl_xor(lsum, 16); lsum += __shfl_xor(lsum, 32); lsum += __expf(sink - mx);
            f32x4 oacc[4];
#pragma unroll
            for (int dt = 0; dt < 4; ++dt) oacc[dt] = (f32x4){0.f, 0.f, 0.f, 0.f};
#pragma unroll
            for (int ks = 0; ks < 5; ++ks) {
                union { bf16x8 v; unsigned u[4]; } pb;
                pb.u[0] = cvtpk(sc[2 * ks][0], sc[2 * ks][1]); pb.u[1] = cvtpk(sc[2 * ks][2], sc[2 * ks][3]);
                if (ks < 4) { pb.u[2] = cvtpk(sc[2 * ks + 1][0], sc[2 * ks + 1][1]); pb.u[3] = cvtpk(sc[2 * ks + 1][2], sc[2 * ks + 1][3]); } else { pb.u[2] = 0u; pb.u[3] = 0u; }
                const int sbb = 16 * (st0 + 2 * ks) + 4 * fq;
#pragma unroll
                for (int dt = 0; dt < 4; ++dt) { const int dd = 16 * dt + fr, sx = 4 * ((dd >> 3) & 7); LAS const unsigned char* vrow = lds + O_VT + dd * VTS;
                    union { bf16x8 v; v2u h[2]; } va; va.h[0] = *(LAS const v2u*)(vrow + (sbb ^ sx) * 2); va.h[1] = *(LAS const v2u*)(vrow + ((sbb + 16) ^ sx) * 2);
                    oacc[dt] = MFMA16(va.v, pb.v, oacc[dt]); } }
            const float il = __builtin_amdgcn_rcpf(lsum);
#pragma unroll
            for (int dt = 0; dt < 4; ++dt) { v2u w; w.x = cvtpk(oacc[dt][0] * il, oacc[dt][1] * il); w.y = cvtpk(oacc[dt][2] * il, oacc[dt][3] * il);
                *(GAS v2u*)(MI + (tq0 + iq) * D + hq * 64 + 16 * dt + 4 * fq) = w; }
        }
    }
#undef ATT_LOAD
#undef ATT_LOADQ
}
typedef float f32x16 __attribute__((ext_vector_type(16)));
__device__ __forceinline__ unsigned fbits(float f) { return __builtin_bit_cast(unsigned, f); }
__device__ __forceinline__ float bfloat(unsigned u) { return __builtin_bit_cast(float, u); }

#define CE_DESC(a, b) do { const float _mx = __builtin_fmaxf(a, b), _mn = __builtin_fminf(a, b); a = _mx; b = _mn; } while (0)
namespace sn16 { constexpr int NC = 63; constexpr unsigned char CA[NC] = {0, 2, 0, 1, 1, 4, 6, 4, 5, 5, 0, 2, 2, 1, 3, 3, 1, 3, 5, 8, 10, 8, 9, 9, 12, 14, 12, 13, 13, 8, 10, 10, 9, 11, 11, 9, 11, 13, 0, 4, 4, 2, 6, 6, 2, 6, 10, 1, 5, 5, 3, 7, 7, 3, 7, 11, 1, 3, 5, 7, 9, 11, 13}; constexpr unsigned char CB[NC] = {1, 3, 2, 3, 2, 5, 7, 6, 7, 6, 4, 6, 4, 5, 7, 5, 2, 4, 6, 9, 11, 10, 11, 10, 13, 15, 14, 15, 14, 12, 14, 12, 13, 15, 13, 10, 12, 14, 8, 12, 8, 10, 14, 10, 4, 8, 12, 9, 13, 9, 11, 15, 11, 5, 9, 13, 2, 4, 6, 8, 10, 12, 14}; }
__device__ __forceinline__ void bsort16(float (&v)[16]) {
#pragma unroll
    for (int c = 0; c < sn16::NC; ++c) CE_DESC(v[sn16::CA[c]], v[sn16::CB[c]]);
}
__device__ __forceinline__ void bmerge16(float (&v)[16], const float (&w)[16]) {
#pragma unroll
    for (int i = 0; i < 16; ++i) v[i] = __builtin_fmaxf(v[i], w[15 - i]);
#pragma unroll
    for (int j = 8; j > 0; j >>= 1)
#pragma unroll
        for (int i = 0; i < 16; ++i) { const int l = i ^ j; if (l > i) CE_DESC(v[i], v[l]); }
}
namespace tk {
constexpr int KS = 272;
constexpr int O_K1 = 0, O_K2 = 128 * KS, O_X = 2 * 128 * KS, O_END = O_X + 8 * 4096;
static_assert(O_END <= 131072, "topk LDS");
constexpr unsigned char CAND[64] = {
    0x00, 0x01, 0x02, 0x03, 0x04, 0x05, 0x06, 0x07, 0x08, 0x09, 0x0a, 0x0b, 0x0c, 0x0d, 0x0e, 0x0f,
    0x10, 0x11, 0x12, 0x13, 0x14, 0x15, 0x16, 0x17, 0x80, 0x90, 0xa0, 0xb0, 0xc0, 0xd0, 0xe0, 0xf0,
    0x20, 0x21, 0x22, 0x23, 0x24, 0x30, 0x31, 0x32, 0x33, 0x40, 0x41, 0x42, 0x50, 0x51, 0x60, 0x61,
    0x70, 0x71, 0xff, 0xff, 0xff, 0xff, 0xff, 0xff, 0xff, 0xff, 0xff, 0xff, 0xff, 0xff, 0xff, 0xff};
}
__device__ __forceinline__ void side_top16(const f32x16 (&acc)[4], int hh, float (&T)[16]) {
    float g1[16], g2[16];
#pragma unroll
    for (int r = 0; r < 16; ++r) { const unsigned key = (r & 3) + 8 * (r >> 2) + 4 * hh;
        T[r] = bfloat((fbits(acc[0][r]) & 0xffffff80u) | key);
        g1[r] = bfloat((fbits(acc[1][r]) & 0xffffff80u) | (32u + key)); }
    bsort16(T); bsort16(g1); bmerge16(T, g1);
#pragma unroll
    for (int r = 0; r < 16; ++r) { const unsigned key = (r & 3) + 8 * (r >> 2) + 4 * hh;
        g1[r] = bfloat((fbits(acc[2][r]) & 0xffffff80u) | (64u + key));
        g2[r] = bfloat((fbits(acc[3][r]) & 0xffffff80u) | (96u + key)); }
    bsort16(g1); bsort16(g2); bmerge16(g1, g2); bmerge16(T, g1);
#pragma unroll
    for (int r = 0; r < 16; ++r) g1[r] = __shfl_xor(T[r], 32);
    bmerge16(T, g1);
}
struct TopkQ { bf16x8 f[8]; };
template <int SD> __device__ __forceinline__ void topk_ldq(const bf16* Q, int t, int h, int hh, TopkQ& q) {
    const bf16* qp = Q + (size_t)t * 2048 + h * 256 + SD * 128 + 8 * hh;
#pragma unroll
    for (int ks = 0; ks < 8; ++ks) q.f[ks] = *(const GAS bf16x8*)(qp + 16 * ks);
}
template <int SD> __device__ __forceinline__ void topk_scores(const TopkQ& q, LAS unsigned char* lds, int r32, int hh, f32x16 (&acc)[4]) {
    using namespace tk;
#pragma unroll
    for (int mt = 0; mt < 4; ++mt)
#pragma unroll
        for (int r = 0; r < 16; ++r) acc[mt][r] = 0.f;
    LAS const unsigned char* kimg = lds + (SD ? O_K2 : O_K1);
#pragma unroll
    for (int ks = 0; ks < 8; ++ks) {
#pragma unroll
        for (int mt = 0; mt < 4; ++mt) acc[mt] = __builtin_amdgcn_mfma_f32_32x32x16_bf16(*(LAS const bf16x8*)(kimg + (32 * mt + r32) * KS + 32 * ks + 16 * hh), q.f[ks], acc[mt], 0, 0, 0); }
}
template <int Q> __device__ __forceinline__ float cand_val(const float (&T1)[16], const float (&T2)[16], int hh) {
    constexpr unsigned c0 = tk::CAND[2 * Q], c1 = tk::CAND[2 * Q + 1];
    const float s = (hh ? T1[(c1 >> 4) & 15] : T1[(c0 >> 4) & 15]) + (hh ? T2[c1 & 15] : T2[c0 & 15]); const unsigned code = hh ? c1 : c0;
    return (code == 0xffu) ? -3.0e38f : bfloat((fbits(s) & 0xffffff00u) | code);
}
__device__ __forceinline__ void phase_topk(const Args& A, LAS unsigned char* lds) {
    using namespace tk;
    const int tid = threadIdx.x, lane = tid & 63, wave = __builtin_amdgcn_readfirstlane(tid >> 6), G = gridDim.x;
    const bf16* Q = (const bf16*)(A.ws + WS_PROJ); const bf16* KB = (const bf16*)(A.ws + WS_KEYS);
    unsigned short* EI = (unsigned short*)(A.ws + WS_EIDX); bf16* GT = (bf16*)(A.ws + WS_GATE);
    const int h = blockIdx.x & 7, r32 = lane & 31, hh = lane >> 5;
    __syncthreads();
    for (int e = tid; e < 2 * 128 * 16; e += NTHR) { const int s = e >> 11, row = (e >> 4) & 127, ch = e & 15;
        *(LAS v4u*)(lds + (s ? O_K2 : O_K1) + row * KS + ch * 16) = *(const GAS v4u*)(KB + (size_t)s * 8 * 128 * 128 + ((size_t)h * 128 + row) * 128 + ch * 8); }
    __syncthreads();
    LAS float* XW = (LAS float*)(lds + O_X + wave * 4096) + r32 * 32;
    TopkQ qf; topk_ldq<0>(Q, (int)(blockIdx.x >> 3) * 256 + 32 * wave + r32, h, hh, qf);
    for (int tile = (int)(blockIdx.x >> 3); tile < M / 256; tile += (G >> 3)) {
        const int t = tile * 256 + 32 * wave + r32;
        float T1[16], T2[16];
        { f32x16 acc[4]; topk_scores<0>(qf, lds, r32, hh, acc);
          topk_ldq<1>(Q, t, h, hh, qf);
          side_top16(acc, hh, T1); }
        { f32x16 acc[4]; topk_scores<1>(qf, lds, r32, hh, acc);
          const int tn = min(tile + (int)(G >> 3), M / 256 - 1) * 256 + 32 * wave + r32; topk_ldq<0>(Q, tn, h, hh, qf);
          side_top16(acc, hh, T2); }
        float c[16], w[16];
        c[0] = cand_val<0>(T1, T2, hh); w[0] = cand_val<16>(T1, T2, hh);
        c[1] = cand_val<1>(T1, T2, hh); w[1] = cand_val<17>(T1, T2, hh);
        c[2] = cand_val<2>(T1, T2, hh); w[2] = cand_val<18>(T1, T2, hh);
        c[3] = cand_val<3>(T1, T2, hh); w[3] = cand_val<19>(T1, T2, hh);
        c[4] = cand_val<4>(T1, T2, hh); w[4] = cand_val<20>(T1, T2, hh);
        c[5] = cand_val<5>(T1, T2, hh); w[5] = cand_val<21>(T1, T2, hh);
        c[6] = cand_val<6>(T1, T2, hh); w[6] = cand_val<22>(T1, T2, hh);
        c[7] = cand_val<7>(T1, T2, hh); w[7] = cand_val<23>(T1, T2, hh);
        c[8] = cand_val<8>(T1, T2, hh); w[8] = cand_val<24>(T1, T2, hh);
        c[9] = cand_val<9>(T1, T2, hh); w[9] = cand_val<25>(T1, T2, hh);
        c[10] = cand_val<10>(T1, T2, hh); w[10] = cand_val<26>(T1, T2, hh);
        c[11] = cand_val<11>(T1, T2, hh); w[11] = cand_val<27>(T1, T2, hh);
        c[12] = cand_val<12>(T1, T2, hh); w[12] = cand_val<28>(T1, T2, hh);
        c[13] = cand_val<13>(T1, T2, hh); w[13] = cand_val<29>(T1, T2, hh);
        c[14] = cand_val<14>(T1, T2, hh); w[14] = cand_val<30>(T1, T2, hh);
        c[15] = cand_val<15>(T1, T2, hh); w[15] = cand_val<31>(T1, T2, hh);
        bsort16(c); bsort16(w); bmerge16(c, w);
#pragma unroll
        for (int r = 0; r < 16; ++r) w[r] = __shfl_xor(c[r], 32);
        bmerge16(c, w);
        if (hh == 0) {
#pragma unroll
            for (int q4 = 0; q4 < 4; ++q4) { *(LAS f32x4*)(XW + 4 * q4) = (f32x4){T1[4 * q4], T1[4 * q4 + 1], T1[4 * q4 + 2], T1[4 * q4 + 3]};
                *(LAS f32x4*)(XW + 16 + 4 * q4) = (f32x4){T2[4 * q4], T2[4 * q4 + 1], T2[4 * q4 + 2], T2[4 * q4 + 3]}; } }
        asm volatile("s_waitcnt lgkmcnt(0)" ::: "memory");
        float ex[16], sum = 0.f; const float tmax = bfloat(fbits(c[0]) & 0xffffff00u);
#pragma unroll
        for (int r = 0; r < 16; ++r) { ex[r] = __expf(bfloat(fbits(c[r]) & 0xffffff00u) - tmax); sum += ex[r]; }
        const float isum = __builtin_amdgcn_rcpf(sum); const size_t ob = (size_t)t * NSLOT + (size_t)h * 16 + 8 * hh;
        unsigned eo[8], go[8];
#pragma unroll
        for (int r = 0; r < 8; ++r) { float ca = c[r], cb = c[8 + r], ea = ex[r], eb = ex[8 + r]; asm volatile("" : "+v"(ca), "+v"(cb), "+v"(ea), "+v"(eb)); const float cv = hh ? cb : ca, ev = hh ? eb : ea;
            const unsigned code = fbits(cv) & 0xffu;
            const unsigned i1 = fbits(XW[code >> 4]) & 127u, i2 = fbits(XW[16 + (code & 15)]) & 127u;
            eo[r] = i1 * 128u + i2; go[r] = f2bf(ev * isum); }
        *(GAS v4u*)(EI + ob) = (v4u){eo[0] | (eo[1] << 16), eo[2] | (eo[3] << 16), eo[4] | (eo[5] << 16), eo[6] | (eo[7] << 16)};
        *(GAS v4u*)(GT + ob) = (v4u){go[0] | (go[1] << 16), go[2] | (go[3] << 16), go[4] | (go[5] << 16), go[6] | (go[7] << 16)};
        asm volatile("s_waitcnt lgkmcnt(0)" ::: "memory");
    }
}
struct PeerIdx { v4u e0, e1; };
__device__ __forceinline__ PeerIdx peer_ld_idx(const unsigned short* EI, int t, int g) { PeerIdx r; r.e0 = *(const GAS v4u*)(EI + (size_t)t * NSLOT + 16 * g); r.e1 = *(const GAS v4u*)(EI + (size_t)t * NSLOT + 16 * g + 8); return r; }
template <int ROWB = 1024> __device__ __forceinline__ void peer_gather(const unsigned char* T8, const PeerIdx& ix, int colb, v4u (&raw)[16]) {
    const unsigned ew[8] = {ix.e0.x, ix.e0.y, ix.e0.z, ix.e0.w, ix.e1.x, ix.e1.y, ix.e1.z, ix.e1.w};
#pragma unroll
    for (int k = 0; k < 16; ++k) { const unsigned e = (k & 1) ? (ew[k >> 1] >> 16) : (ew[k >> 1] & 0xffffu); raw[k] = *(const GAS v4u*)(T8 + (size_t)e * ROWB + colb); }
}
__device__ __forceinline__ void cvt16_fp8_pk(const v4u w, f32x2 (&o)[8]) {
    const unsigned ww[4] = {w.x, w.y, w.z, w.w};
#pragma unroll
    for (int i = 0; i < 4; ++i) { o[2 * i] = __builtin_amdgcn_cvt_pk_f32_fp8((int)ww[i], false); o[2 * i + 1] = __builtin_amdgcn_cvt_pk_f32_fp8((int)ww[i], true); }
}
__device__ __forceinline__ void peer_u_reduce(const v4u (&raw)[16], const f32x2 (&hv)[8], float* PDrow, int lane, int g, int c) {
    float d[16];
#pragma unroll
    for (int k = 0; k < 16; ++k) { f32x2 uf[8]; cvt16_fp8_pk(raw[k], uf); f32x2 s = uf[0] * hv[0];
#pragma unroll
        for (int i = 1; i < 8; ++i) s += uf[i] * hv[i];
        d[k] = s.x + s.y; }
#pragma unroll
    for (int i = 0; i < 8; ++i) { const bool up = (lane & 4) != 0; const float keep = up ? d[i + 8] : d[i], send = up ? d[i] : d[i + 8]; d[i] = keep + __shfl_xor(send, 4); }
#pragma unroll
    for (int i = 0; i < 4; ++i) { const bool up = (lane & 2) != 0; const float keep = up ? d[i + 4] : d[i], send = up ? d[i] : d[i + 4]; d[i] = keep + __shfl_xor(send, 2); }
#pragma unroll
    for (int i = 0; i < 2; ++i) { const bool up = (lane & 1) != 0; const float keep = up ? d[i + 2] : d[i], send = up ? d[i] : d[i + 2]; d[i] = keep + __shfl_xor(send, 1); }
    *(GAS f32x2*)(PDrow + 16 * g + 2 * c) = (f32x2){d[0], d[1]};
}
__device__ __forceinline__ void ld16bf_pk(const bf16* p, f32x2 (&o)[8]) {
    const v4u w0 = *(const GAS v4u*)p, w1 = *(const GAS v4u*)(p + 8); const unsigned ww[8] = {w0.x, w0.y, w0.z, w0.w, w1.x, w1.y, w1.z, w1.w};
#pragma unroll
    for (int i = 0; i < 8; ++i) o[i] = (f32x2){bflo(ww[i]), bfhi(ww[i])};
}
__device__ __forceinline__ void peer_u_reduce_i4(const v4u (&raw)[16], const v4u hh, const v4u hl, bf16* PDrow, int lane, int g, int c) {
    int d[16];
#pragma unroll
    for (int k = 0; k < 16; ++k) { int sh = __builtin_amdgcn_sdot8((int)raw[k].x, (int)hh.x, 0, false), sl = __builtin_amdgcn_sdot8((int)raw[k].x, (int)hl.x, 0, false);
        sh = __builtin_amdgcn_sdot8((int)raw[k].y, (int)hh.y, sh, false); sl = __builtin_amdgcn_sdot8((int)raw[k].y, (int)hl.y, sl, false);
        sh = __builtin_amdgcn_sdot8((int)raw[k].z, (int)hh.z, sh, false); sl = __builtin_amdgcn_sdot8((int)raw[k].z, (int)hl.z, sl, false);
        sh = __builtin_amdgcn_sdot8((int)raw[k].w, (int)hh.w, sh, false); sl = __builtin_amdgcn_sdot8((int)raw[k].w, (int)hl.w, sl, false);
        d[k] = 16 * sh + sl; }
#pragma unroll
    for (int i = 0; i < 8; ++i) { const bool up = (lane & 4) != 0; const int keep = up ? d[i + 8] : d[i], send = up ? d[i] : d[i + 8]; d[i] = keep + __shfl_xor(send, 4); }
#pragma unroll
    for (int i = 0; i < 4; ++i) { const bool up = (lane & 2) != 0; const int keep = up ? d[i + 4] : d[i], send = up ? d[i] : d[i + 4]; d[i] = keep + __shfl_xor(send, 2); }
#pragma unroll
    for (int i = 0; i < 2; ++i) { const bool up = (lane & 1) != 0; const int keep = up ? d[i + 2] : d[i], send = up ? d[i] : d[i + 2]; d[i] = keep + __shfl_xor(send, 1); }
    __builtin_nontemporal_store(pk2((float)d[0], (float)d[1]), (GAS unsigned*)(PDrow + 16 * g + 2 * c));
}
__device__ __forceinline__ void phase_peer_u(const Args& A) {
    const int tid = threadIdx.x, lane = tid & 63, wave = tid >> 6, p = blockIdx.x & 7, q = p & 3, half = p >> 2, j = blockIdx.x >> 3, nj = gridDim.x >> 3, g = lane >> 3, c = lane & 7;
    const unsigned char* HH = (const unsigned char*)(A.ws + WS_H8); const unsigned char* HL = HH + 32 * MiB; const unsigned char* U4 = (const unsigned char*)(A.ws + WS_U8); const unsigned short* EI = (const unsigned short*)(A.ws + WS_EIDX);
    bf16* PD = (bf16*)(A.ws + WS_PD) + (size_t)q * M * NSLOT;
    const unsigned char* U4q = U4 + (size_t)q * ((size_t)NEXP * 128); const int colu = 16 * c;
    const int tper = (M / 2) / nj, colb = 128 * q + 16 * c, tbeg = half * (M / 2) + j * tper, tend = tbeg + tper, tlast = tend - NWAVES + wave;
    int t = tbeg + wave;
    PeerIdx ix1 = peer_ld_idx(EI, min(t + NWAVES, tlast), g), ix2 = peer_ld_idx(EI, min(t + 2 * NWAVES, tlast), g);
    v4u rawa[16], rawb[16], hha, hla, hhb, hlb;
    { const PeerIdx ix0 = peer_ld_idx(EI, t, g); peer_gather<128>(U4q, ix0, colu, rawa); hha = *(const GAS v4u*)(HH + (size_t)t * 512 + colb); hla = *(const GAS v4u*)(HL + (size_t)t * 512 + colb); }
    for (; t < tend; t += 2 * NWAVES) {
        const int t1 = t + NWAVES, t2 = min(t + 2 * NWAVES, tlast), t3 = min(t + 3 * NWAVES, tlast), t4 = min(t + 4 * NWAVES, tlast);
        const PeerIdx ix3 = peer_ld_idx(EI, t3, g);
        peer_gather<128>(U4q, ix1, colu, rawb); hhb = *(const GAS v4u*)(HH + (size_t)t1 * 512 + colb); hlb = *(const GAS v4u*)(HL + (size_t)t1 * 512 + colb);
        peer_u_reduce_i4(rawa, hha, hla, PD + (size_t)t * NSLOT, lane, g, c);
        const PeerIdx ix4 = peer_ld_idx(EI, t4, g);
        peer_gather<128>(U4q, ix2, colu, rawa); hha = *(const GAS v4u*)(HH + (size_t)t2 * 512 + colb); hla = *(const GAS v4u*)(HL + (size_t)t2 * 512 + colb);
        peer_u_reduce_i4(rawb, hhb, hlb, PD + (size_t)t1 * NSLOT, lane, g, c);
        ix1 = ix3; ix2 = ix4;
    }
}
__device__ __forceinline__ void phase_peer_act(const Args& A) {
    const bf16* PD = (const bf16*)(A.ws + WS_PD); const unsigned short* EI = (const unsigned short*)(A.ws + WS_EIDX); const bf16* GT = (const bf16*)(A.ws + WS_GATE);
    const float* usc = (const float*)(A.ws + WS_SC); const float* hs = (const float*)(A.ws + WS_HS);
    unsigned char* W8 = (unsigned char*)(A.ws + WS_W8); float* WSC = (float*)(A.ws + WS_WSC);
    typedef int i32x4 __attribute__((ext_vector_type(4)));
    for (size_t i = ((size_t)blockIdx.x * NTHR + threadIdx.x) * 4; i < (size_t)M * NSLOT; i += (size_t)gridDim.x * NTHR * 4) {
        const v2u p0 = *(const GAS v2u*)(PD + i), p1 = *(const GAS v2u*)(PD + (size_t)M * NSLOT + i), p2 = *(const GAS v2u*)(PD + (size_t)2 * M * NSLOT + i), p3 = *(const GAS v2u*)(PD + (size_t)3 * M * NSLOT + i);
        const v2u ew = *(const GAS v2u*)(EI + i); const v2u gw = *(const GAS v2u*)(GT + i); const f32x4 gt = {bflo(gw.x), bfhi(gw.x), bflo(gw.y), bfhi(gw.y)}; const float hsv = hs[i >> 7];
        const unsigned e[4] = {ew.x & 0xffffu, ew.x >> 16, ew.y & 0xffffu, ew.y >> 16};
        const f32x4 si = {(bflo(p0.x) + bflo(p1.x)) + (bflo(p2.x) + bflo(p3.x)), (bfhi(p0.x) + bfhi(p1.x)) + (bfhi(p2.x) + bfhi(p3.x)), (bflo(p0.y) + bflo(p1.y)) + (bflo(p2.y) + bflo(p3.y)), (bfhi(p0.y) + bfhi(p1.y)) + (bfhi(p2.y) + bfhi(p3.y))}; f32x4 o;
#pragma unroll
        for (int k = 0; k < 4; k += 2) { const f32x2 sc0 = *(const GAS f32x2*)(usc + 2 * e[k]), sc1 = *(const GAS f32x2*)(usc + 2 * e[k + 1]);
            const f32x2 gl = pg8::gelu_pk((f32x2){si[k] * (sc0.x * hsv), si[k + 1] * (sc1.x * hsv)});
            o[k] = gl.x * gt[k] * sc0.y; o[k + 1] = gl.y * gt[k + 1] * sc1.y; }
        float am = fmaxf(fmaxf(fabsf(o[0]), fabsf(o[1])), fmaxf(fabsf(o[2]), fabsf(o[3])));
#pragma unroll
        for (int x = 1; x < 32; x <<= 1) am = fmaxf(am, __shfl_xor(am, x));
        const bool amok = am > 1e-30f; const float inv = amok ? 448.0f * __builtin_amdgcn_rcpf(am) : 1.0f;
        float sv[4];
#pragma unroll
        for (int k = 0; k < 4; ++k) sv[k] = fminf(fmaxf(o[k] * inv, -448.f), 448.f);
        int hi = __builtin_amdgcn_cvt_pk_fp8_f32(sv[0], sv[1], 0, false); hi = __builtin_amdgcn_cvt_pk_fp8_f32(sv[2], sv[3], hi, true);
        const f32x2 d01 = __builtin_amdgcn_cvt_pk_f32_fp8(hi, false), d23 = __builtin_amdgcn_cvt_pk_f32_fp8(hi, true);
        int lo = __builtin_amdgcn_cvt_pk_fp8_f32((sv[0] - d01.x) * 16.f, (sv[1] - d01.y) * 16.f, 0, false); lo = __builtin_amdgcn_cvt_pk_fp8_f32((sv[2] - d23.x) * 16.f, (sv[3] - d23.y) * 16.f, lo, true);
        const size_t t = i >> 7; const int pos = (int)(i & 127);
        *(GAS unsigned*)(W8 + t * 256 + pos) = (unsigned)hi; *(GAS unsigned*)(W8 + t * 256 + 128 + pos) = (unsigned)lo;
        if (pos == 0) WSC[t] = amok ? am * (1.0f / 448.0f) : 1.0f;
    }
}
typedef int i32x2 __attribute__((ext_vector_type(2)));
typedef int i32x8 __attribute__((ext_vector_type(8)));
struct PeerVA { v4u a0, a1; };
__device__ __forceinline__ void phase_peer_v(const Args& A, LAS unsigned char* lds) {
    const int tid = threadIdx.x, lane = tid & 63, wave = __builtin_amdgcn_readfirstlane(tid >> 6), p = blockIdx.x & 7, q = p & 3, half = p >> 2, j = blockIdx.x >> 3, nj = gridDim.x >> 3;
    const unsigned char* V4 = (const unsigned char*)(A.ws + WS_V8); const unsigned short* EI = (const unsigned short*)(A.ws + WS_EIDX);
    const unsigned char* W8 = (const unsigned char*)(A.ws + WS_W8); const float* WSC = (const float*)(A.ws + WS_WSC);
    bf16* Y = (bf16*)(A.ws + WS_H); float* SSY = (float*)(A.ws + WS_SSY);
    const int tper = (M / 2) / nj, nt_w = tper / NWAVES, t0 = half * (M / 2) + j * tper + wave * nt_w;
    const int n = lane & 15, g = lane >> 4, r8 = lane >> 3, c8 = lane & 7;
    const int srcoff0 = q * (NEXP * 128) + 16 * (c8 ^ (r8 >> 1)), srcoff1 = q * (NEXP * 128) + 16 * (c8 ^ (4 + (r8 >> 1)));
    LAS unsigned char* img = lds + wave * 16384;
    const int rdb = (32 * g + n) * 128, xo = 16 * (n >> 1) + 8 * (g & 1);
    struct Idx { unsigned lo, hi; };
    auto ldidx = [&](int i) { const unsigned short* ep = EI + (size_t)(t0 + i) * NSLOT + lane; Idx r; r.lo = ep[0]; r.hi = ep[64]; return r; };
    auto ldA = [&](int i) { const unsigned char* ap = W8 + (size_t)(t0 + i) * 256 + ((n >> 1) & 1) * 128 + 16 * g; PeerVA r; r.a0 = *(const GAS v4u*)ap; r.a1 = *(const GAS v4u*)(ap + 64); return r; };
    const bool alive = n < 4 && ((n & 1) == (g >> 1));
    auto fetch = [&](const Idx& ix) { unsigned e[16]; const int pk = (int)(ix.lo | (ix.hi << 16));
#pragma unroll
        for (int i = 0; i < 8; ++i) { const unsigned w = (unsigned)__shfl(pk, 8 * i + r8); e[i] = w & 0xffffu; e[8 + i] = w >> 16; }
        __builtin_amdgcn_sched_barrier(0);
#pragma unroll
        for (int i = 0; i < 16; ++i) __builtin_amdgcn_global_load_lds((const unsigned*)(V4 + (size_t)e[i] * 128 + ((i & 1) ? srcoff1 : srcoff0)), (LAS unsigned*)(img + i * 1024), 16, 0, 0); };
    Idx ixn; PeerVA an; float wscn;
    { const Idx ix0 = ldidx(0); fetch(ix0); ixn = ldidx(min(1, nt_w - 1)); an = ldA(0); wscn = WSC[t0]; }
    v4u yst0 = {0u, 0u, 0u, 0u}, yst1 = {0u, 0u, 0u, 0u}; float ssst = 0.f;
    for (int i = 0; i < nt_w; ++i) {
        asm volatile("s_waitcnt vmcnt(0)" ::: "memory");
        PeerVA ac = an; float wsc = wscn; Idx ixc = ixn;
        asm volatile("" : "+v"(ac.a0.x), "+v"(ac.a0.y), "+v"(ac.a0.z), "+v"(ac.a0.w), "+v"(ac.a1.x), "+v"(ac.a1.y), "+v"(ac.a1.z), "+v"(ac.a1.w), "+v"(wsc), "+v"(ixc.lo), "+v"(ixc.hi));
        if (i > 0 && lane < 16) { const int t = t0 + i - 1; GAS v4u* yp = (GAS v4u*)(Y + (size_t)t * D + 256 * q + 16 * n); __builtin_nontemporal_store(yst0, yp); __builtin_nontemporal_store(yst1, yp + 1); if (lane == 0) *(GAS f32x2*)(SSY + (size_t)t * 8 + 2 * q) = (f32x2){ssst, 0.f}; }
        i32x2 br[16][2];
#pragma unroll
        for (int nt = 0; nt < 16; ++nt) { const int ro = rdb + ((16 * (nt >> 1) + 8 * (nt & 1)) ^ xo);
            br[nt][0] = __builtin_amdgcn_ds_read_tr4_b64_v2i32((LAS i32x2*)(img + ro)); br[nt][1] = __builtin_amdgcn_ds_read_tr4_b64_v2i32((LAS i32x2*)(img + ro + 2048)); }
        asm volatile("s_waitcnt lgkmcnt(0)" ::: "memory");
        __builtin_amdgcn_sched_barrier(0);
        if (i + 1 < nt_w) fetch(ixc);
        ixn = ldidx(min(i + 2, nt_w - 1)); an = ldA(min(i + 1, nt_w - 1)); wscn = WSC[t0 + min(i + 1, nt_w - 1)];
        __builtin_amdgcn_sched_barrier(0);
        if (!alive) { ac.a0 = (v4u){0u, 0u, 0u, 0u}; ac.a1 = (v4u){0u, 0u, 0u, 0u}; }
        const i32x8 A8 = {(int)ac.a0.x, (int)ac.a0.y, (int)ac.a0.z, (int)ac.a0.w, (int)ac.a1.x, (int)ac.a1.y, (int)ac.a1.z, (int)ac.a1.w};
        float yv[16]; float ss = 0.f;
#pragma unroll
        for (int c2 = 0; c2 < 8; ++c2) { const i32x8 BX = {br[2 * c2][0].x, br[2 * c2][0].y, br[2 * c2][1].x, br[2 * c2][1].y, 0, 0, 0, 0}, BY = {br[2 * c2 + 1][0].x, br[2 * c2 + 1][0].y, br[2 * c2 + 1][1].x, br[2 * c2 + 1][1].y, 0, 0, 0, 0};
            const f32x4 dx = __builtin_amdgcn_mfma_scale_f32_16x16x128_f8f6f4(A8, BX, (f32x4){0.f, 0.f, 0.f, 0.f}, 0, 4, 0, 0x7f7f7f7f, 0, 0x7f7f7f7f);
            const f32x4 dy = __builtin_amdgcn_mfma_scale_f32_16x16x128_f8f6f4(A8, BY, (f32x4){0.f, 0.f, 0.f, 0.f}, 0, 4, 0, 0x7f7f7f7f, 0, 0x7f7f7f7f);
            yv[2 * c2] = ((dx[0] + dy[1]) + (dx[2] + dy[3]) * 0.0625f) * wsc; yv[2 * c2 + 1] = ((dy[0] + dx[1]) + (dy[2] + dx[3]) * 0.0625f) * wsc;
            ss += yv[2 * c2] * yv[2 * c2] + yv[2 * c2 + 1] * yv[2 * c2 + 1]; }
        ss += __shfl_xor(ss, 1); ss += __shfl_xor(ss, 2); ss += __shfl_xor(ss, 4); ss += __shfl_xor(ss, 8);
        yst0 = (v4u){pk2(yv[0], yv[1]), pk2(yv[2], yv[3]), pk2(yv[4], yv[5]), pk2(yv[6], yv[7])}; yst1 = (v4u){pk2(yv[8], yv[9]), pk2(yv[10], yv[11]), pk2(yv[12], yv[13]), pk2(yv[14], yv[15])}; ssst = ss;
    }
    if (lane < 16) { const int t = t0 + nt_w - 1; GAS v4u* yp = (GAS v4u*)(Y + (size_t)t * D + 256 * q + 16 * n); __builtin_nontemporal_store(yst0, yp); __builtin_nontemporal_store(yst1, yp + 1); if (lane == 0) *(GAS f32x2*)(SSY + (size_t)t * 8 + 2 * q) = (f32x2){ssst, 0.f}; }
    __syncthreads();
}
#ifdef V_SLOW
__device__ __forceinline__ void phase_peer_v_slow(const Args& A, LAS unsigned char* lds) {
    const int tid = threadIdx.x, p = blockIdx.x & 7, q = p & 3, half = p >> 2, j = blockIdx.x >> 3, nj = gridDim.x >> 3;
    const unsigned char* V4 = (const unsigned char*)(A.ws + WS_V8); const unsigned short* EI = (const unsigned short*)(A.ws + WS_EIDX);
    const unsigned char* W8 = (const unsigned char*)(A.ws + WS_W8); const float* WSC = (const float*)(A.ws + WS_WSC);
    bf16* Y = (bf16*)(A.ws + WS_H); float* SSY = (float*)(A.ws + WS_SSY);
    const int tper = (M / 2) / nj, tbeg = half * (M / 2) + j * tper;
    LAS float* red = (LAS float*)lds;
    const int c = tid & 255, tsub = tid >> 8, nn = c >> 4, nt = c & 15, P = 16 * nt + nn;
    for (int tb = 0; tb < tper; tb += 2) { const int t = tbeg + tb + tsub; float acc = 0.f;
        for (int k = 0; k < 128; ++k) { const unsigned e = EI[(size_t)t * NSLOT + k]; const unsigned byte = V4[(size_t)e * 512 + 128 * q + (P >> 1)]; const unsigned nib = (byte >> (4 * (P & 1))) & 15u;
            const float vv = __builtin_amdgcn_cvt_scalef32_pk_f32_fp4(nib, 1.0f, 0)[0];
            const unsigned hb = W8[(size_t)t * 256 + k], lb = W8[(size_t)t * 256 + 128 + k];
            const float w = __builtin_amdgcn_cvt_pk_f32_fp8((int)hb, false)[0] + __builtin_amdgcn_cvt_pk_f32_fp8((int)lb, false)[0] * 0.0625f;
            acc += w * vv; }
        acc *= WSC[t];
        Y[(size_t)t * D + 256 * q + c] = (bf16)f2bf(acc);
        __syncthreads(); red[tid] = acc * acc; __syncthreads();
        if (c < 2) { float ssum = 0.f; for (int x = 0; x < 256; ++x) if (((x >> 3) & 1) == c) ssum += red[tsub * 256 + x]; SSY[(size_t)t * 8 + 2 * q + c] = ssum; }
    }
    __syncthreads();
}
#endif
__device__ __forceinline__ void phase_peer_final(const Args& A) {
    const int tid = threadIdx.x, lane = tid & 63, wave = tid >> 6, G = gridDim.x;
    const bf16* Y = (const bf16*)(A.ws + WS_H); const bf16* X1 = (const bf16*)(A.ws + WS_X1); const float* SSY = (const float*)(A.ws + WS_SSY); const float* mod = (const float*)(A.ws + WS_MOD); const float* gpost = (const float*)A.in[I_GPOST2]; float* out = A.out;
    f32x4 gp[4];
#pragma unroll
    for (int q = 0; q < 4; ++q) gp[q] = *(const GAS f32x4*)(gpost + 4 * (lane + 64 * q));
    const int stride = G * NWAVES; int row = blockIdx.x * NWAVES + wave;
    v2u xw[4], yw[4], xwn[4], ywn[4]; f32x4 s0, s0n, s1, s1n, g2p[4]; int bcur = -1;
#pragma unroll
    for (int q = 0; q < 4; ++q) { xw[q] = ((const GAS v2u*)(X1 + (size_t)row * D) + lane)[64 * q]; yw[q] = ((const GAS v2u*)(Y + (size_t)row * D) + lane)[64 * q]; }
    s0 = *(const GAS f32x4*)(SSY + (size_t)row * 8); s1 = *(const GAS f32x4*)(SSY + (size_t)row * 8 + 4);
    for (; row < M; row += stride) {
        const int rn = min(row + stride, M - 1);
#pragma unroll
        for (int q = 0; q < 4; ++q) { xwn[q] = ((const GAS v2u*)(X1 + (size_t)rn * D) + lane)[64 * q]; ywn[q] = ((const GAS v2u*)(Y + (size_t)rn * D) + lane)[64 * q]; }
        s0n = *(const GAS f32x4*)(SSY + (size_t)rn * 8); s1n = *(const GAS f32x4*)(SSY + (size_t)rn * 8 + 4);
        const int b = row / SEQ;
        if (b != bcur) { bcur = b;
#pragma unroll
            for (int q = 0; q < 4; ++q) { const f32x4 g2 = *(const GAS f32x4*)(mod + b * 6144 + 5120 + 4 * (lane + 64 * q));
#pragma unroll
                for (int i = 0; i < 4; ++i) g2p[q][i] = g2[i] * gp[q][i]; } }
        const float rstd = __builtin_amdgcn_rsqf((((s0[0] + s0[1]) + (s0[2] + s0[3])) + ((s1[0] + s1[1]) + (s1[2] + s1[3]))) * (1.f / D) + EPS);
        GAS f32x4* orow = (GAS f32x4*)(out + (size_t)row * D) + lane;
#pragma unroll
        for (int q = 0; q < 4; ++q) { f32x4 xv = {bflo(xw[q].x), bfhi(xw[q].x), bflo(xw[q].y), bfhi(xw[q].y)};
            xv[0] += g2p[q][0] * (bflo(yw[q].x) * rstd); xv[1] += g2p[q][1] * (bfhi(yw[q].x) * rstd); xv[2] += g2p[q][2] * (bflo(yw[q].y) * rstd); xv[3] += g2p[q][3] * (bfhi(yw[q].y) * rstd);
#ifdef V_DIAG
            if (row == 0 && lane == 0 && q == 0) xv[0] += *(const float*)(A.ws + WS_WSC + MiB);
#endif
            orow[64 * q] = xv; }
#pragma unroll
        for (int q = 0; q < 4; ++q) { xw[q] = xwn[q]; yw[q] = ywn[q]; }
        s0 = s0n; s1 = s1n;
    }
}
#ifdef PROBE_V_LOADS
__device__ __forceinline__ void probe_v_loads(const Args& A) {
    const int tid = threadIdx.x, lane = tid & 63, wave = tid >> 6, p = blockIdx.x & 7, j = blockIdx.x >> 3, nj = gridDim.x >> 3, g = lane >> 3, c = lane & 7;
    const unsigned char* V8 = (const unsigned char*)(A.ws + WS_V8); const unsigned short* EI = (const unsigned short*)(A.ws + WS_EIDX); const float* ACT = (const float*)(A.ws + WS_ACT);
    unsigned* DUMP = (unsigned*)(A.ws + WS_PD);
    const int tper = M / nj, colb = 128 * p + 16 * c, tend = (j + 1) * tper, tlast = tend - NWAVES + wave;
    int t = j * tper + wave;
    PeerIdx ix1 = peer_ld_idx(EI, min(t + NWAVES, tlast), g), ix2 = peer_ld_idx(EI, min(t + 2 * NWAVES, tlast), g);
    v4u rawa[16], rawb[16]; PeerAct aca, acb;
    { const PeerIdx ix0 = peer_ld_idx(EI, t, g); peer_gather(V8, ix0, colb, rawa); aca = peer_ld_act(ACT, t, g); }
    for (; t < tend; t += 2 * NWAVES) {
        const int t1 = t + NWAVES, t2 = min(t + 2 * NWAVES, tlast), t3 = min(t + 3 * NWAVES, tlast), t4 = min(t + 4 * NWAVES, tlast);
        const PeerIdx ix3 = peer_ld_idx(EI, t3, g);
        peer_gather(V8, ix1, colb, rawb); acb = peer_ld_act(ACT, t1, g);
        { unsigned s = __builtin_bit_cast(unsigned, aca.a0[0]) + __builtin_bit_cast(unsigned, aca.a3[3]);
#pragma unroll
          for (int k = 0; k < 16; ++k) s += (rawa[k].x + rawa[k].y) + (rawa[k].z + rawa[k].w);
          DUMP[(size_t)t * 512 + p * 64 + lane] = s; }
        const PeerIdx ix4 = peer_ld_idx(EI, t4, g);
        peer_gather(V8, ix2, colb, rawa); aca = peer_ld_act(ACT, t2, g);
        { unsigned s = __builtin_bit_cast(unsigned, acb.a0[0]) + __builtin_bit_cast(unsigned, acb.a3[3]);
#pragma unroll
          for (int k = 0; k < 16; ++k) s += (rawb[k].x + rawb[k].y) + (rawb[k].z + rawb[k].w);
          DUMP[(size_t)t1 * 512 + p * 64 + lane] = s; }
        ix1 = ix3; ix2 = ix4;
    }
}
#endif

#ifdef PROBE_INSTR
__device__ __forceinline__ void probe_instr(const Args& A) {
    f32x2 a[8]; float f[16]; unsigned w = threadIdx.x * 0x01010101u + 0x38383838u;
#pragma unroll
    for (int i = 0; i < 8; ++i) a[i] = (f32x2){1.0f + i, 2.0f + i};
#pragma unroll
    for (int i = 0; i < 16; ++i) f[i] = 1.0f + i;
    for (int it = 0; it < 10000; ++it) {
#if PROBE_INSTR == 1
#pragma unroll
        for (int i = 0; i < 8; ++i) { asm volatile("v_pk_fma_f32 %0, %1, %2, %0" : "+v"(a[i]) : "v"(a[(i + 1) & 7]), "v"(a[(i + 2) & 7])); asm volatile("v_pk_fma_f32 %0, %1, %2, %0" : "+v"(a[i]) : "v"(a[(i + 3) & 7]), "v"(a[(i + 4) & 7])); }
#elif PROBE_INSTR == 2
#pragma unroll
        for (int i = 0; i < 16; ++i) asm volatile("v_fma_f32 %0, %1, %2, %0" : "+v"(f[i]) : "v"(f[(i + 1) & 15]), "v"(f[(i + 2) & 15]));
#elif PROBE_INSTR == 3
#pragma unroll
        for (int i = 0; i < 8; ++i) { asm volatile("v_cvt_pk_f32_fp8 %0, %1" : "=v"(a[i]) : "v"(w)); asm volatile("v_cvt_pk_f32_fp8 %0, %1" : "=v"(a[i]) : "v"(w)); }
#elif PROBE_INSTR == 4
#pragma unroll
        for (int i = 0; i < 8; ++i) { asm volatile("v_cvt_scalef32_pk_f32_fp4 %0, %1, 1.0" : "=v"(a[i]) : "v"(w)); asm volatile("v_cvt_scalef32_pk_f32_fp4 %0, %1, 1.0" : "=v"(a[i]) : "v"(w)); }
#elif PROBE_INSTR == 5
#pragma unroll
        for (int i = 0; i < 16; ++i) asm volatile("v_pk_fma_f16 %0, %1, %2, %0" : "+v"(f[i]) : "v"(f[(i + 1) & 15]), "v"(f[(i + 2) & 15]));
#elif PROBE_INSTR == 7
#pragma unroll
        for (int i = 0; i < 16; ++i) asm volatile("v_dot8c_i32_i4 %0, %1, %2" : "+v"(f[i]) : "v"(f[(i + 1) & 15]), "v"(w));
#elif PROBE_INSTR == 8
#pragma unroll
        for (int i = 0; i < 16; ++i) asm volatile("v_dot4c_i32_i8 %0, %1, %2" : "+v"(f[i]) : "v"(f[(i + 1) & 15]), "v"(w));
#elif PROBE_INSTR == 9
#pragma unroll
        for (int i = 0; i < 16; ++i) asm volatile("v_perm_b32 %0, %1, %2, %3" : "=v"(f[i]) : "v"(f[(i + 1) & 15]), "v"(f[(i + 2) & 15]), "v"(w));
#elif PROBE_INSTR == 10
#pragma unroll
        for (int i = 0; i < 16; ++i) asm volatile("v_mfma_f32_16x16x32_fp8_fp8 %0, %1, %2, %0" : "+v"(*(f32x4*)&f[4 * (i & 3)]) : "v"(a[i & 7]), "v"(a[(i + 1) & 7]));
#elif PROBE_INSTR == 6
#pragma unroll
        for (int i = 0; i < 16; ++i) asm volatile("v_cvt_scalef32_pk_f16_fp4 %0, %1, 1.0" : "=v"(f[i]) : "v"(w));
#endif
    }
    float s = 0.f;
#pragma unroll
    for (int i = 0; i < 8; ++i) s += a[i].x + a[i].y;
#pragma unroll
    for (int i = 0; i < 16; ++i) s += f[i];
    if (s == 123.456f) ((float*)(A.ws + WS_PD))[threadIdx.x] = s;
}
#endif
#ifndef MK_N_LAUNCHES
#define MK_N_LAUNCHES 1
#endif
constexpr int N_PHASES = 13;
typedef const __attribute__((address_space(4))) Args* KArgP;
__device__ __forceinline__ const Args& kargs() { KArgP p = (KArgP)__builtin_amdgcn_kernarg_segment_ptr(); asm volatile("" : "+s"(p)); return *(const Args*)p; }
__global__ void __launch_bounds__(NTHR, 2) hymba_fwd(Args A_) {
    extern __shared__ __attribute__((aligned(16))) unsigned char lds_raw[];
    LAS unsigned char* lds = (LAS unsigned char*)lds_raw;
    const int lo = A_.ph_lo, hi = A_.ph_hi;
#define A kargs()
#define ws (kargs().ws)
#ifndef DBLMASK
#define DBLMASK 0
#endif
#ifndef ONLYMASK
#define ONLYMASK 0xffff
#endif
#define IN(k) ((((ONLYMASK) >> (k)) & 1) && lo <= (k) && (k) < hi)
#define REP(k) for (int _rep = 0; _rep < (((DBLMASK) >> (k)) & 1) + 1; ++_rep)
    for (int u = threadIdx.x; u < (LDS_BYTES - RING_BYTES) / 4; u += NTHR) ((LAS unsigned*)(lds + RING_BYTES))[u] = 0u;
    __syncthreads();
    (void)xcd_barrier_post((unsigned*)(ws + WS_CTL) + CW_BAR, (volatile LAS unsigned*)(lds + MISC_OFF + 32));
    if (hi < 0) cg::this_grid().sync();
#define SEAM(k) do { if (IN(k) && IN((k) + 1)) { { XcdBarrier xb_; xb_.bar = (unsigned*)(ws + WS_CTL) + CW_BAR; xb_.x = xb_xcc_id(); xb_.st = (volatile LAS unsigned*)(lds + MISC_OFF + 32); xcd_barrier(xb_); } } } while (0)

    if (IN(0)) REP(0) { phase_mod(A, lds); } SEAM(0);
    if (IN(1)) REP(1) { phase_convert(A, lds); phase_prenorm(A, lds); } SEAM(1);
    if (IN(2)) REP(2) {
        pg8::Gemm g{(const pg8::bf16_t*)(ws + WS_H), (const pg8::bf16_t*)(ws + WS_WIN), M, NPROJ, D}; pg8::StaticOrder S; S.init(M, NPROJ, gridDim.x, (int)blockIdx.x);
        pg8::EpiProj E{(pg8::bf16_t*)(ws + WS_PROJ), NPROJ, (float*)(ws + WS_GATES), (const int*)A.in[I_POS], (const float*)A.in[I_BI], (const float*)A.in[I_BF]};
        pg8::gemm_phase<pg8::EpiProj, pg8::StaticOrder, true, true>(lds, g, S, E);
    } SEAM(2);
    if (IN(3)) REP(3) {
        phase_attn(A, lds);
        for (int wg = blockIdx.x; wg < 256; wg += gridDim.x) mlstm_group<false>(A, lds, wg);
    } SEAM(3);
    if (IN(4)) REP(4) { for (int wg = blockIdx.x; wg < 256; wg += gridDim.x) mlstm_group<true>(A, lds, wg); } SEAM(4);
    if (IN(5)) REP(5) {
        pg8::Gemm g{(const pg8::bf16_t*)(ws + WS_MIXIN), (const pg8::bf16_t*)(ws + WS_WOUT), M, D, D}; pg8::StaticOrder S; S.init(M, D, gridDim.x, (int)blockIdx.x);
        pg8::EpiMix E{(pg8::bf16_t*)(ws + WS_MIX), D, (float*)(ws + WS_SSQ)};
        pg8::gemm_phase<pg8::EpiMix, pg8::StaticOrder, true, true>(lds, g, S, E);
    } SEAM(5);
    if (IN(6)) REP(6) { phase_mid(A); } SEAM(6);
    if (IN(7)) REP(7) {
        pg8::Gemm g{(const pg8::bf16_t*)(ws + WS_H), (const pg8::bf16_t*)(ws + WS_WQ), M, 2048, D}; pg8::StaticOrder S; S.init(M, 2048, gridDim.x, (int)blockIdx.x);
        pg8::EpiPlain E{(pg8::bf16_t*)(ws + WS_PROJ), 2048};
        pg8::gemm_phase<pg8::EpiPlain, pg8::StaticOrder, true, true>(lds, g, S, E);
    } SEAM(7);
    if (IN(8)) REP(8) { phase_topk(A, lds); } SEAM(8);
    if (IN(9)) REP(9) { phase_peer_u(A); } SEAM(9);
    if (IN(10)) REP(10) { phase_peer_act(A); } SEAM(10);
#ifdef PROBE_INSTR
    if (IN(11)) { probe_instr(A); }
#endif
#ifdef PROBE_V_LOADS
    if (IN(11)) { probe_v_loads(A); }
#endif
#ifdef V_SLOW
    if (IN(11)) REP(11) { phase_peer_v_slow(A, lds);
#ifdef V_DIAG
        phase_peer_v(A, lds);
#endif
    } SEAM(11);
#else
    if (IN(11)) REP(11) { phase_peer_v(A, lds); } SEAM(11);
#endif
    if (IN(12)) REP(12) { phase_peer_final(A); }
#undef IN
#undef SEAM
#undef A
#undef ws
}

extern "C" void kernel_launch(void* const* d_in, const int* in_sizes, int n_in, void* d_out, int out_size, void* d_ws, size_t ws_size, hipStream_t stream) {
    static int grid = 0;
    if (grid == 0) {
        if (n_in != 21 || in_sizes[0] != M * D || out_size != M * D || ws_size < WS_END) { fprintf(stderr, "kernel_launch: unexpected shapes (n_in %d, in0 %d, out %d, ws %zu < %zu)\n", n_in, n_in > 0 ? in_sizes[0] : -1, out_size, ws_size, (size_t)WS_END); grid = -1; return; }
        int dev = 0, cus = 0, per_cu = 0;
        if (hipGetDevice(&dev) != hipSuccess || hipDeviceGetAttribute(&cus, hipDeviceAttributeMultiprocessorCount, dev) != hipSuccess) { grid = -1; return; }
        if (hipFuncSetAttribute((const void*)hymba_fwd, hipFuncAttributeMaxDynamicSharedMemorySize, LDS_BYTES) != hipSuccess) { fprintf(stderr, "kernel_launch: hipFuncSetAttribute failed\n"); grid = -1; return; }
        if (hipOccupancyMaxActiveBlocksPerMultiprocessor(&per_cu, (const void*)hymba_fwd, NTHR, LDS_BYTES) != hipSuccess || per_cu < 1) { fprintf(stderr, "kernel_launch: occupancy query says %d blocks per CU\n", per_cu); per_cu = 1; }
        (void)hipGetLastError();
        grid = cus;
        if (grid != 256) fprintf(stderr, "kernel_launch: note: %d CUs (built for 256)\n", grid);
    }
    if (grid < 0) return;
    (void)hipMemsetAsync((char*)d_ws + WS_CTL, 0, CTL_ZERO_BYTES, stream);
    Args a{};
    for (int i = 0; i < 21; ++i) a.in[i] = d_in[i];
    a.out = (float*)d_out; a.ws = (unsigned char*)d_ws;
    if (MK_N_LAUNCHES == 1) {
        a.ph_lo = 0; a.ph_hi = N_PHASES;
        void* args[] = {&a};
        const hipError_t e = hipLaunchCooperativeKernel((const void*)hymba_fwd, dim3(grid), dim3(NTHR), args, LDS_BYTES, stream);
        if (e != hipSuccess) fprintf(stderr, "kernel_launch: cooperative launch failed: %s (grid %d)\n", hipGetErrorString(e), grid);
    } else {
        for (int p = 0; p < N_PHASES; ++p) { a.ph_lo = p; a.ph_hi = p + 1; hipLaunchKernelGGL(hymba_fwd, dim3(grid), dim3(NTHR), LDS_BYTES, stream, a); }
    }
}
```
